# Optimizing an MI355X kernel written in HIP

```python
import jax, jax.numpy as jnp
from jax import lax
import numpy as np

D_MODEL = 2048
BATCH = 4
SEQ = 4096
DEPTH = 2

N_MIXERS = 2
N_FOURIER_LAYERS = (DEPTH + 1) // 2
N_ATTN_LAYERS = DEPTH // 2
FOURIER_GROUPS = 8
FOURIER_GROUP_WIDTH = D_MODEL // FOURIER_GROUPS
HEAD_DIM = 64
N_Q_HEADS = D_MODEL // HEAD_DIM
N_KV_HEADS = N_Q_HEADS // 4
Q_PER_KV = N_Q_HEADS // N_KV_HEADS
QKV_WIDTH = (N_Q_HEADS + 2 * N_KV_HEADS) * HEAD_DIM
WINDOW = 128
BLOCK = 128
ROPE_THETA = 10000.0
PEER_HEADS = 8
N_KEYS = 128
N_EXPERTS = N_KEYS * N_KEYS
PEER_QUERY_DIM = 256
PEER_HALF = PEER_QUERY_DIM // 2
PEER_TOPK = 16
PEER_CHUNK = 128
EPS = 1e-6
NEG_INF = -1e30

kernel_name = "hybrid_fnet_swa_peer_encoder"


def rmsnorm(x, g):
    xf = x.astype(jnp.float32)
    y = xf * lax.rsqrt(jnp.mean(xf * xf, axis=-1, keepdims=True) + EPS)
    return (y * g.astype(jnp.float32)).astype(x.dtype)


def fourier_mixer(h, w_o):
    B, S, D = h.shape
    hg = h.astype(jnp.float32).reshape(B, S, FOURIER_GROUPS, FOURIER_GROUP_WIDTH)
    hg = jnp.transpose(hg, (0, 2, 1, 3))
    y = jnp.fft.fft2(hg, axes=(-2, -1), norm='ortho').real
    y = jnp.transpose(y, (0, 2, 1, 3)).reshape(B, S, D).astype(h.dtype)
    return y @ w_o


def rope(x, pos):
    hd = x.shape[-1]
    inv_freq = ROPE_THETA ** (-jnp.arange(0, hd, 2, dtype=jnp.float32) / hd)
    ang = pos[:, None] * inv_freq[None, :]
    cos = jnp.cos(ang)[None, :, None, :]
    sin = jnp.sin(ang)[None, :, None, :]
    xf = x.astype(jnp.float32)
    x1, x2 = xf[..., : hd // 2], xf[..., hd // 2:]
    out = jnp.concatenate([x1 * cos - x2 * sin, x2 * cos + x1 * sin], axis=-1)
    return out.astype(x.dtype)


def _band_windows(t, nb):
    B, S, KV, hd = t.shape
    tp = jnp.pad(t, ((0, 0), (BLOCK, BLOCK), (0, 0), (0, 0))).reshape(B, nb + 2, BLOCK, KV, hd)
    return jnp.concatenate([tp[:, :-2], tp[:, 1:-1], tp[:, 2:]], axis=2)


def windowed_gqa_mixer(h, w_qkv, w_o, sinks):
    B, S, D = h.shape
    nb = S // BLOCK
    qkv = h @ w_qkv
    q = qkv[..., : N_Q_HEADS * HEAD_DIM].reshape(B, S, N_Q_HEADS, HEAD_DIM)
    k = qkv[..., N_Q_HEADS * HEAD_DIM:(N_Q_HEADS + N_KV_HEADS) * HEAD_DIM].reshape(B, S, N_KV_HEADS, HEAD_DIM)
    v = qkv[..., (N_Q_HEADS + N_KV_HEADS) * HEAD_DIM:].reshape(B, S, N_KV_HEADS, HEAD_DIM)
    pos = jnp.arange(S, dtype=jnp.float32)
    q = rope(q, pos)
    k = rope(k, pos)
    qb = q.reshape(B, nb, BLOCK, N_KV_HEADS, Q_PER_KV, HEAD_DIM)
    kw = _band_windows(k, nb)
    vw = _band_windows(v, nb)
    scale = HEAD_DIM ** -0.5
    scores = jnp.einsum('bnqkgd,bnskd->bnkgqs', qb, kw).astype(jnp.float32) * scale
    qi = jnp.arange(BLOCK)[:, None]
    si = jnp.arange(3 * BLOCK)[None, :]
    band = jnp.abs(si - BLOCK - qi) <= WINDOW
    key_pos = jnp.arange(nb)[:, None] * BLOCK - BLOCK + jnp.arange(3 * BLOCK)[None, :]
    inside = (key_pos >= 0) & (key_pos < S)
    mask = band[None, :, :] & inside[:, None, :]
    scores = jnp.where(mask[None, :, None, None, :, :], scores, NEG_INF)
    sink = sinks.astype(jnp.float32).reshape(N_KV_HEADS, Q_PER_KV)[None, None, :, :, None, None]
    m = jnp.maximum(jnp.max(scores, axis=-1, keepdims=True), sink)
    p = jnp.exp(scores - m)
    p = p / (jnp.sum(p, axis=-1, keepdims=True) + jnp.exp(sink - m))
    out = jnp.einsum('bnkgqs,bnskd->bnqkgd', p.astype(vw.dtype), vw).reshape(B, S, D)
    return out @ w_o


def peer_mixer(h, w_q, sub_keys, u, v):
    B, S, D = h.shape
    T = B * S

    def chunk_fn(xc):
        C = xc.shape[0]
        q = (xc @ w_q).reshape(C, PEER_HEADS, 2, PEER_HALF)
        s = jnp.einsum('chpd,hpkd->chpk', q, sub_keys).astype(jnp.float32)
        s1, i1 = lax.top_k(s[:, :, 0], PEER_TOPK)
        s2, i2 = lax.top_k(s[:, :, 1], PEER_TOPK)
        cand = (s1[..., :, None] + s2[..., None, :]).reshape(C, PEER_HEADS, PEER_TOPK * PEER_TOPK)
        cidx = (i1[..., :, None] * N_KEYS + i2[..., None, :]).reshape(C, PEER_HEADS, PEER_TOPK * PEER_TOPK)
        top, sel = lax.top_k(cand, PEER_TOPK)
        eidx = jnp.take_along_axis(cidx, sel, axis=-1)
        g = jax.nn.softmax(top, axis=-1)
        u_sel = jnp.take(u, eidx, axis=0)
        a = jax.nn.gelu(jnp.einsum('chkd,cd->chk', u_sel, xc).astype(jnp.float32))
        v_sel = jnp.take(v, eidx, axis=0)
        return jnp.einsum('chk,chkd->cd', (g * a).astype(xc.dtype), v_sel)

    out = lax.map(chunk_fn, h.reshape(T // PEER_CHUNK, PEER_CHUNK, D))
    return out.reshape(B, S, D)


def setup_inputs(seed: int = 0) -> dict:
    key = jax.random.key(seed)
    ks = jax.random.split(key, 13)
    f32 = jnp.float32
    sd = D_MODEL ** -0.5
    x = jax.random.normal(ks[0], (BATCH, SEQ, D_MODEL), f32)
    mix_norm = 1.0 + 0.02 * jax.random.normal(ks[1], (DEPTH, D_MODEL), f32)
    ffn_norm = 1.0 + 0.02 * jax.random.normal(ks[2], (DEPTH, D_MODEL), f32)
    fourier_w_o = jax.random.normal(ks[3], (N_FOURIER_LAYERS, D_MODEL, D_MODEL), f32) * sd
    attn_w_qkv = jax.random.normal(ks[4], (N_ATTN_LAYERS, D_MODEL, QKV_WIDTH), f32) * sd
    attn_w_o = jax.random.normal(ks[5], (N_ATTN_LAYERS, D_MODEL, D_MODEL), f32) * sd
    attn_sinks = 0.5 * jax.random.normal(ks[6], (N_ATTN_LAYERS, N_Q_HEADS), f32)
    peer_w_q = jax.random.normal(ks[7], (DEPTH, D_MODEL, PEER_HEADS * PEER_QUERY_DIM), f32) * sd
    peer_sub_keys = jax.random.normal(ks[8], (DEPTH, PEER_HEADS, 2, N_KEYS, PEER_HALF), f32) * PEER_HALF ** -0.5
    peer_u = jax.random.normal(ks[9], (DEPTH, N_EXPERTS, D_MODEL), f32) * sd
    peer_v = jax.random.normal(ks[10], (DEPTH, N_EXPERTS, D_MODEL), f32) * (PEER_HEADS * PEER_TOPK) ** -0.5
    final_norm = 1.0 + 0.02 * jax.random.normal(ks[11], (D_MODEL,), f32)
    return {"x": x, "mix_norm": mix_norm, "ffn_norm": ffn_norm, "fourier_w_o": fourier_w_o,
            "attn_w_qkv": attn_w_qkv, "attn_w_o": attn_w_o, "attn_sinks": attn_sinks,
            "peer_w_q": peer_w_q, "peer_sub_keys": peer_sub_keys, "peer_u": peer_u,
            "peer_v": peer_v, "final_norm": final_norm}


def reference(x, mix_norm, ffn_norm, fourier_w_o, attn_w_qkv, attn_w_o, attn_sinks,
              peer_w_q, peer_sub_keys, peer_u, peer_v, final_norm):
    for i in range(DEPTH):
        h = rmsnorm(x, mix_norm[i])
        j = i // N_MIXERS
        if i % N_MIXERS == 0:
            x = x + fourier_mixer(h, fourier_w_o[j])
        else:
            x = x + windowed_gqa_mixer(h, attn_w_qkv[j], attn_w_o[j], attn_sinks[j])
        h = rmsnorm(x, ffn_norm[i])
        x = x + peer_mixer(h, peer_w_q[i], peer_sub_keys[i], peer_u[i], peer_v[i])
    return rmsnorm(x, final_norm)
```

```cpp
#include <hip/hip_runtime.h>
#include <cstdio>
#include <cstdint>
#include <cmath>

constexpr int DM = 2048, NB = 4, SEQ = 4096, T = NB * SEQ;
constexpr int FG = 8, FW = 256;
constexpr int HD = 64, NQH = 32, NKVH = 8, QKVW = 3072;
constexpr int PH = 8, NKEYS = 128, NEXP = 16384, PTOPK = 16;
constexpr float EPS = 1e-6f;

struct GemmP {
    const float* A; const float* B; float* C; const float* R;
    int M, N, K, lda, ldb, ldc;
    long sA, sB, sC;
    int transB, accum; float alpha;
};
__global__ void __launch_bounds__(256) k_sgemm(GemmP p) {
    __shared__ float As[16][68];
    __shared__ float Bs[16][68];
    const int bz = blockIdx.z;
    const float* A = p.A + (long)bz * p.sA;
    const float* B = p.B + (long)bz * p.sB;
    float* C = p.C + (long)bz * p.sC;
    const int m0 = blockIdx.y * 64, n0 = blockIdx.x * 64;
    const int tid = threadIdx.x, tx = tid & 15, ty = tid >> 4;
    float acc[4][4];
#pragma unroll
    for (int i = 0; i < 4; ++i)
#pragma unroll
        for (int j = 0; j < 4; ++j) acc[i][j] = 0.f;
    for (int k0 = 0; k0 < p.K; k0 += 16) {
        {
            const int m = tid >> 2, k4 = (tid & 3) * 4;
            const float4 v = *(const float4*)(A + (long)(m0 + m) * p.lda + k0 + k4);
            As[k4 + 0][m] = v.x; As[k4 + 1][m] = v.y; As[k4 + 2][m] = v.z; As[k4 + 3][m] = v.w;
        }
        if (p.transB) {
            const int n = tid >> 2, k4 = (tid & 3) * 4;
            const float4 v = *(const float4*)(B + (long)(n0 + n) * p.ldb + k0 + k4);
            Bs[k4 + 0][n] = v.x; Bs[k4 + 1][n] = v.y; Bs[k4 + 2][n] = v.z; Bs[k4 + 3][n] = v.w;
        } else {
            const int k = tid >> 4, n4 = (tid & 15) * 4;
            const float4 v = *(const float4*)(B + (long)(k0 + k) * p.ldb + n0 + n4);
            Bs[k][n4 + 0] = v.x; Bs[k][n4 + 1] = v.y; Bs[k][n4 + 2] = v.z; Bs[k][n4 + 3] = v.w;
        }
        __syncthreads();
#pragma unroll
        for (int k = 0; k < 16; ++k) {
            const float4 a = *(const float4*)&As[k][ty * 4];
            const float4 b = *(const float4*)&Bs[k][tx * 4];
            const float av[4] = {a.x, a.y, a.z, a.w}, bv[4] = {b.x, b.y, b.z, b.w};
#pragma unroll
            for (int i = 0; i < 4; ++i)
#pragma unroll
                for (int j = 0; j < 4; ++j) acc[i][j] += av[i] * bv[j];
        }
        __syncthreads();
    }
#pragma unroll
    for (int i = 0; i < 4; ++i) {
        const long off = (long)(m0 + ty * 4 + i) * p.ldc + n0 + tx * 4;
        float4 o;
        o.x = acc[i][0] * p.alpha; o.y = acc[i][1] * p.alpha; o.z = acc[i][2] * p.alpha; o.w = acc[i][3] * p.alpha;
        if (p.accum) { const float4 c = *(const float4*)(C + off); o.x += c.x; o.y += c.y; o.z += c.z; o.w += c.w; }
        if (p.R) { const float4 r = *(const float4*)(p.R + off); o.x += r.x; o.y += r.y; o.z += r.z; o.w += r.w; }
        *(float4*)(C + off) = o;
    }
}

__device__ __forceinline__ float wave_sum(float v) {
#pragma unroll
    for (int o = 1; o < 64; o <<= 1) v += __shfl_xor(v, o);
    return v;
}
__device__ __forceinline__ float wave_max(float v) {
#pragma unroll
    for (int o = 1; o < 64; o <<= 1) v = fmaxf(v, __shfl_xor(v, o));
    return v;
}

__global__ void __launch_bounds__(256) k_rmsnorm(const float* x, const float* g, float* out, int rows) {
    const int row = blockIdx.x * 4 + (threadIdx.x >> 6), lane = threadIdx.x & 63;
    if (row >= rows) return;
    const float4* xr = (const float4*)(x + (long)row * DM) + lane;
    const float4* gr = (const float4*)g + lane;
    float4 v[8]; float s = 0.f;
#pragma unroll
    for (int j = 0; j < 8; ++j) { v[j] = xr[64 * j]; s += v[j].x * v[j].x + v[j].y * v[j].y + v[j].z * v[j].z + v[j].w * v[j].w; }
    const float r = rsqrtf(wave_sum(s) * (1.f / DM) + EPS);
    float4* o = (float4*)(out + (long)row * DM) + lane;
#pragma unroll
    for (int j = 0; j < 8; ++j) { const float4 gg = gr[64 * j]; float4 w; w.x = v[j].x * r * gg.x; w.y = v[j].y * r * gg.y; w.z = v[j].z * r * gg.z; w.w = v[j].w * r * gg.w; o[64 * j] = w; }
}

__global__ void k_dft_tab(float* ct, float* st, int n, float scale) {
    const long idx = (long)blockIdx.x * blockDim.x + threadIdx.x;
    if (idx >= (long)n * n) return;
    const int i = (int)(idx / n), j = (int)(idx % n);
    const int m = (int)(((long)i * j) % n);
    const float ang = (float)m * (6.283185307179586f / (float)n);
    ct[idx] = cosf(ang) * scale; st[idx] = sinf(ang) * scale;
}

__device__ __forceinline__ void wave_argmax(float& v, int& i) {
#pragma unroll
    for (int o = 1; o < 64; o <<= 1) {
        const float ov = __shfl_xor(v, o); const int oi = __shfl_xor(i, o);
        if (ov > v || (ov == v && oi < i)) { v = ov; i = oi; }
    }
}
__global__ void __launch_bounds__(256) k_topk(const float* s, int* eidx, float* gw) {
    __shared__ float tv[4][2][16];
    __shared__ int ti[4][2][16];
    const int w = threadIdx.x >> 6, lane = threadIdx.x & 63;
    const long inst = (long)blockIdx.x * 4 + w;
    const float* sp = s + inst * 256;
    for (int half = 0; half < 2; ++half) {
        float a0 = sp[half * 128 + lane], a1 = sp[half * 128 + 64 + lane];
        for (int it = 0; it < 16; ++it) {
            float v; int i;
            if (a0 >= a1) { v = a0; i = lane; } else { v = a1; i = lane + 64; }
            wave_argmax(v, i);
            if (lane == 0) { tv[w][half][it] = v; ti[w][half][it] = i; }
            if (i == lane) a0 = -INFINITY;
            if (i == lane + 64) a1 = -INFINITY;
        }
    }
    __syncthreads();
    float cv[4]; int ci[4];
#pragma unroll
    for (int j = 0; j < 4; ++j) { const int c = lane + 64 * j; cv[j] = tv[w][0][c >> 4] + tv[w][1][c & 15]; ci[j] = c; }
    float topv = 0.f; int topc = 0; float mx = 0.f;
    for (int it = 0; it < 16; ++it) {
        float v = cv[0]; int i = ci[0];
#pragma unroll
        for (int j = 1; j < 4; ++j) if (cv[j] > v) { v = cv[j]; i = ci[j]; }
        wave_argmax(v, i);
        if (it == 0) mx = v;
        if (lane == it) { topv = v; topc = i; }
#pragma unroll
        for (int j = 0; j < 4; ++j) if (ci[j] == i) cv[j] = -INFINITY;
    }
    float e = (lane < 16) ? expf(topv - mx) : 0.f;
    const float sum = wave_sum(e);
    if (lane < 16) {
        eidx[inst * 16 + lane] = ti[w][0][topc >> 4] * NKEYS + ti[w][1][topc & 15];
        gw[inst * 16 + lane] = e / sum;
    }
}

__device__ __forceinline__ float gelu_tanh(float x) {
    const float u = 0.7978845608028654f * (x + 0.044715f * x * x * x);
    return 0.5f * x * (1.f + tanhf(u));
}

__global__ void __launch_bounds__(256) k_peer(float* xio, const float* ng, const int* eidx, const float* gw, const float* U, const float* V,
                                               const float* fin, float* out) {
    const int t = blockIdx.x * 4 + (threadIdx.x >> 6), lane = threadIdx.x & 63;
    float4* xr = (float4*)(xio + (long)t * DM) + lane;
    float4 xv[8], h[8], acc[8]; float s = 0.f;
#pragma unroll
    for (int j = 0; j < 8; ++j) { xv[j] = xr[64 * j]; s += xv[j].x * xv[j].x + xv[j].y * xv[j].y + xv[j].z * xv[j].z + xv[j].w * xv[j].w; acc[j] = make_float4(0.f, 0.f, 0.f, 0.f); }
    const float r = rsqrtf(wave_sum(s) * (1.f / DM) + EPS);
#pragma unroll
    for (int j = 0; j < 8; ++j) { const float4 gg = ((const float4*)ng)[lane + 64 * j]; h[j].x = xv[j].x * r * gg.x; h[j].y = xv[j].y * r * gg.y; h[j].z = xv[j].z * r * gg.z; h[j].w = xv[j].w * r * gg.w; }
    for (int e = 0; e < 128; ++e) {
        const int ei = eidx[(long)t * 128 + e]; const float g = gw[(long)t * 128 + e];
        const float4* ur = (const float4*)(U + (long)ei * DM) + lane;
        const float4* vr = (const float4*)(V + (long)ei * DM) + lane;
        float d = 0.f;
#pragma unroll
        for (int j = 0; j < 8; ++j) { const float4 u = ur[64 * j]; d += u.x * h[j].x + u.y * h[j].y + u.z * h[j].z + u.w * h[j].w; }
        d = wave_sum(d);
        const float wgt = g * gelu_tanh(d);
#pragma unroll
        for (int j = 0; j < 8; ++j) { const float4 v = vr[64 * j]; acc[j].x += wgt * v.x; acc[j].y += wgt * v.y; acc[j].z += wgt * v.z; acc[j].w += wgt * v.w; }
    }
    float s2 = 0.f;
#pragma unroll
    for (int j = 0; j < 8; ++j) { xv[j].x += acc[j].x; xv[j].y += acc[j].y; xv[j].z += acc[j].z; xv[j].w += acc[j].w; s2 += xv[j].x * xv[j].x + xv[j].y * xv[j].y + xv[j].z * xv[j].z + xv[j].w * xv[j].w; }
    if (fin) {
        const float r2 = rsqrtf(wave_sum(s2) * (1.f / DM) + EPS);
        float4* o = (float4*)(out + (long)t * DM) + lane;
#pragma unroll
        for (int j = 0; j < 8; ++j) { const float4 gg = ((const float4*)fin)[lane + 64 * j]; float4 w; w.x = xv[j].x * r2 * gg.x; w.y = xv[j].y * r2 * gg.y; w.z = xv[j].z * r2 * gg.z; w.w = xv[j].w * r2 * gg.w; o[64 * j] = w; }
    } else {
#pragma unroll
        for (int j = 0; j < 8; ++j) xr[64 * j] = xv[j];
    }
}

__global__ void k_rope(float* qkv) {
    const long idx = (long)blockIdx.x * blockDim.x + threadIdx.x;
    if (idx >= (long)T * 40 * 32) return;
    const int i = (int)(idx & 31); const int head = (int)((idx >> 5) % 40); const long t = idx / (40 * 32);
    const int pos = (int)(t % SEQ);
    const double inv = pow(10000.0, -(double)i / 32.0);
    const double ang = (double)pos * inv;
    const float c = (float)cos(ang), sn = (float)sin(ang);
    float* p = qkv + t * QKVW + head * 64 + i;
    const float x1 = p[0], x2 = p[32];
    p[0] = x1 * c - x2 * sn; p[32] = x2 * c + x1 * sn;
}

__global__ void __launch_bounds__(256) k_attn(const float* qkv, const float* sinks, float* o) {
    __shared__ float qs[4][64];
    __shared__ float ps[4][320];
    const int w = threadIdx.x >> 6, lane = threadIdx.x & 63;
    const long inst = (long)blockIdx.x * 4 + w;
    const int hq = (int)(inst & 31); const long t = inst >> 5; const int b = (int)(t / SEQ), sp = (int)(t % SEQ);
    const int kvh = hq >> 2;
    qs[w][lane] = qkv[t * QKVW + hq * 64 + lane];
    __syncthreads();
    float sc[5]; float mx = sinks[hq];
#pragma unroll
    for (int i = 0; i < 5; ++i) {
        const int kp = sp - 128 + lane + 64 * i;
        float d = -1e30f;
        if (kp >= 0 && kp < SEQ && kp <= sp + 128) {
            const float4* kr = (const float4*)(qkv + ((long)b * SEQ + kp) * QKVW + 2048 + kvh * 64);
            d = 0.f;
#pragma unroll
            for (int j = 0; j < 16; ++j) { const float4 kk = kr[j]; d += kk.x * qs[w][4 * j] + kk.y * qs[w][4 * j + 1] + kk.z * qs[w][4 * j + 2] + kk.w * qs[w][4 * j + 3]; }
            d *= 0.125f;
        }
        sc[i] = d; mx = fmaxf(mx, d);
    }
    mx = wave_max(mx);
    float sum = 0.f;
#pragma unroll
    for (int i = 0; i < 5; ++i) { const float p = (sc[i] > -1e29f) ? expf(sc[i] - mx) : 0.f; ps[w][lane + 64 * i] = p; sum += p; }
    sum = wave_sum(sum) + expf(sinks[hq] - mx);
    __syncthreads();
    float acc = 0.f;
    for (int j = 0; j < 320; ++j) {
        const int kp = sp - 128 + j;
        if (kp < 0 || kp >= SEQ) continue;
        const float p = ps[w][j];
        acc += p * qkv[((long)b * SEQ + kp) * QKVW + 2560 + kvh * 64 + lane];
    }
    o[t * DM + hq * 64 + lane] = acc / sum;
}

static void gemm(hipStream_t st, const float* A, const float* B, float* C, const float* R, int M, int N, int K, int lda, int ldb, int ldc,
                 long sA, long sB, long sC, int batch, int transB, int accum, float alpha) {
    GemmP p{}; p.A = A; p.B = B; p.C = C; p.R = R; p.M = M; p.N = N; p.K = K; p.lda = lda; p.ldb = ldb; p.ldc = ldc; p.sA = sA; p.sB = sB; p.sC = sC;
    p.transB = transB; p.accum = accum; p.alpha = alpha;
    hipLaunchKernelGGL(k_sgemm, dim3(N / 64, M / 64, batch), dim3(256), 0, st, p);
}

extern "C" void kernel_launch(void* const* d_in, const int* in_sizes, int n_in, void* d_out, int out_size, void* d_ws, size_t ws_size, hipStream_t stream) {
    const float* x = (const float*)d_in[0];
    const float* mix_norm = (const float*)d_in[1];
    const float* ffn_norm = (const float*)d_in[2];
    const float* f_wo = (const float*)d_in[3];
    const float* a_wqkv = (const float*)d_in[4];
    const float* a_wo = (const float*)d_in[5];
    const float* a_sinks = (const float*)d_in[6];
    const float* p_wq = (const float*)d_in[7];
    const float* p_keys = (const float*)d_in[8];
    const float* p_u = (const float*)d_in[9];
    const float* p_v = (const float*)d_in[10];
    const float* fin = (const float*)d_in[11];
    float* out = (float*)d_out;
    char* ws = (char*)d_ws;
    const size_t MB = 1u << 20;
    if (ws_size < 900 * MB) { fprintf(stderr, "ws too small: %zu\n", ws_size); return; }
    float* CS = (float*)(ws + 0);
    float* SS = (float*)(ws + 64 * MB);
    float* R0 = (float*)(ws + 0);
    float* H = (float*)(ws + 128 * MB);
    float* Z1 = (float*)(ws + 256 * MB);
    float* Z2 = (float*)(ws + 384 * MB);
    float* Y = (float*)(ws + 512 * MB);
    float* QKV = (float*)(ws + 640 * MB);
    int* EI = (int*)(ws + 832 * MB);
    float* GW = (float*)(ws + 840 * MB);
    float* CC = (float*)(ws + 848 * MB);
    float* SC = (float*)(ws + 849 * MB);

    hipLaunchKernelGGL(k_dft_tab, dim3((4096 * 4096) / 256), dim3(256), 0, stream, CS, SS, 4096, 1.f / 64.f);
    hipLaunchKernelGGL(k_dft_tab, dim3((256 * 256) / 256), dim3(256), 0, stream, CC, SC, 256, 1.f / 16.f);
    hipLaunchKernelGGL(k_rmsnorm, dim3(T / 4), dim3(256), 0, stream, x, mix_norm, H, T);
    gemm(stream, H, CC, Z1, nullptr, T * FG, FW, FW, FW, FW, FW, 0, 0, 0, 1, 0, 0, 1.f);
    gemm(stream, H, SC, Z2, nullptr, T * FG, FW, FW, FW, FW, FW, 0, 0, 0, 1, 0, 0, 1.f);
    for (int b = 0; b < NB; ++b) {
        gemm(stream, CS, Z1 + (long)b * SEQ * DM, Y + (long)b * SEQ * DM, nullptr, SEQ, FW, SEQ, SEQ, DM, DM, 0, FW, FW, FG, 0, 0, 1.f);
        gemm(stream, SS, Z2 + (long)b * SEQ * DM, Y + (long)b * SEQ * DM, nullptr, SEQ, FW, SEQ, SEQ, DM, DM, 0, FW, FW, FG, 0, 1, -1.f);
    }
    gemm(stream, Y, f_wo, out, x, T, DM, DM, DM, DM, DM, 0, 0, 0, 1, 0, 0, 1.f);
    hipLaunchKernelGGL(k_rmsnorm, dim3(T / 4), dim3(256), 0, stream, out, ffn_norm, H, T);
    gemm(stream, H, p_wq, Z1, nullptr, T, DM, DM, DM, DM, DM, 0, 0, 0, 1, 0, 0, 1.f);
    gemm(stream, Z1, p_keys, Z2, nullptr, T, NKEYS, 128, DM, 128, DM, 128, 128 * 128, 128, 16, 1, 0, 1.f);
    hipLaunchKernelGGL(k_topk, dim3(T * PH / 4), dim3(256), 0, stream, Z2, EI, GW);
    hipLaunchKernelGGL(k_peer, dim3(T / 4), dim3(256), 0, stream, out, ffn_norm, EI, GW, p_u, p_v, (const float*)nullptr, (float*)nullptr);
    hipLaunchKernelGGL(k_rmsnorm, dim3(T / 4), dim3(256), 0, stream, out, mix_norm + DM, H, T);
    gemm(stream, H, a_wqkv, QKV, nullptr, T, QKVW, DM, DM, QKVW, QKVW, 0, 0, 0, 1, 0, 0, 1.f);
    hipLaunchKernelGGL(k_rope, dim3((T * 40 * 32) / 256), dim3(256), 0, stream, QKV);
    hipLaunchKernelGGL(k_attn, dim3(T * NQH / 4), dim3(256), 0, stream, QKV, a_sinks, R0);
    gemm(stream, R0, a_wo, out, out, T, DM, DM, DM, DM, DM, 0, 0, 0, 1, 0, 0, 1.f);
    hipLaunchKernelGGL(k_rmsnorm, dim3(T / 4), dim3(256), 0, stream, out, ffn_norm + DM, H, T);
    gemm(stream, H, p_wq + (long)DM * DM, Z1, nullptr, T, DM, DM, DM, DM, DM, 0, 0, 0, 1, 0, 0, 1.f);
    gemm(stream, Z1, p_keys + (long)PH * 2 * 128 * 128, Z2, nullptr, T, NKEYS, 128, DM, 128, DM, 128, 128 * 128, 128, 16, 1, 0, 1.f);
    hipLaunchKernelGGL(k_topk, dim3(T * PH / 4), dim3(256), 0, stream, Z2, EI, GW);
    hipLaunchKernelGGL(k_peer, dim3(T / 4), dim3(256), 0, stream, out, ffn_norm + DM, EI, GW, p_u + (long)NEXP * DM, p_v + (long)NEXP * DM, fin, out);
}
```

```cpp
#include <hip/hip_runtime.h>
#include <cstdio>
#include <cstdint>
#include <cmath>

constexpr int DM = 2048, NB = 4, SEQ = 4096, T = NB * SEQ;
constexpr int FG = 8, FW = 256;
constexpr int HD = 64, NQH = 32, NKVH = 8, QKVW = 3072;
constexpr int PH = 8, NKEYS = 128, NEXP = 16384, PTOPK = 16;
constexpr float EPS = 1e-6f;
namespace pg8 {
#define PG8_LAS __attribute__((address_space(3)))
typedef unsigned short bf16_t;
typedef short bf16x8 __attribute__((ext_vector_type(8)));
typedef float f32x4 __attribute__((ext_vector_type(4)));
typedef unsigned u32x4 __attribute__((ext_vector_type(4)));
constexpr int BM = 256, BK = 64, HALF = 128, HTB = HALF * BK * 2  , STAGE_BYTES = 8 * HTB, NXCD = 8, WGM = 8;

__host__ __device__ __forceinline__ int lds_byte(int r, int c) { const int st = (r >> 4) * 2 + (c >> 5), rr = r & 15, cc = c & 31, ob = rr * 64 + cc * 2; return st * 1024 + (ob ^ (((ob >> 9) & 1) << 5)); }
__host__ __device__ __forceinline__ void stage_rc(int b, int& R, int& C) { const int st = b / 1024, sb = b % 1024, swz = sb ^ (((sb >> 9) & 1) << 5); R = (st >> 1) * 16 + swz / 64; C = (st & 1) * 32 + (swz % 64) / 2; }
__host__ __device__ __forceinline__ int perm32(int rho) { const int n = rho >> 4, i = rho & 15; return 8 * (i >> 2) + 4 * n + (i & 3); }

struct Unit { int pm, pn; };
struct Gemm { const bf16_t* A; const bf16_t* Bt; int M, N, K; };

struct StaticOrder {
    int nM, nN, nwg, G, c;
    __host__ __device__ void init(int M, int N, int G_, int c_) { nM = M / BM; nN = N / BM; nwg = nM * nN; G = G_; c = c_; }
    __host__ __device__ bool next(int i, Unit& u) const {
        const long L = (long)i * G + c; if (L >= nwg) return false;
        int wgid = (int)L; { const int q = nwg / NXCD, r = nwg % NXCD, xcd = wgid % NXCD, off = wgid / NXCD; wgid = (xcd < r ? xcd * (q + 1) : r * (q + 1) + (xcd - r) * q) + off; }
        const int nig = WGM * nN, gid = wgid / nig, fm = gid * WGM, gsz = (nM - fm) < WGM ? (nM - fm) : WGM;
        u.pm = fm + ((wgid % nig) % gsz); u.pn = (wgid % nig) / gsz; return true;
    }
    __device__ __forceinline__ void a_ready(const Unit&) const {}
    __device__ __forceinline__ void done(const Unit&) const {}
};

__device__ __forceinline__ unsigned cvt_pk_bf16(float lo, float hi) { unsigned r; asm volatile("v_cvt_pk_bf16_f32 %0, %1, %2" : "=v"(r) : "v"(lo), "v"(hi)); return r; }
typedef float f32x2 __attribute__((ext_vector_type(2)));
__device__ __forceinline__ u32x4 pack8(const f32x4 v0, const f32x4 v1) { u32x4 w; w.x = cvt_pk_bf16(v0[0], v0[1]); w.y = cvt_pk_bf16(v0[2], v0[3]); w.z = cvt_pk_bf16(v1[0], v1[1]); w.w = cvt_pk_bf16(v1[2], v1[3]); return w; }
struct EpiZt {
    static constexpr bool PERM = true, AFTER_DRAIN = false; bf16_t* Zt;
    __device__ __forceinline__ void operator()(const f32x4 (&acc)[2][2][4][2], const Unit& u, int wr, int wc, int fr, int fq) const {
        const int part = u.pm, j0 = u.pn * BM, bg = j0 >> 12, s0 = (j0 & 4095) + wc * 32 + 8 * fq;
        bf16_t* base = Zt + ((size_t)(bg * 256 + wr * 64 + fr) * 8192 + part * 4096 + s0);
#pragma unroll
        for (int ai = 0; ai < 2; ++ai)
#pragma unroll
            for (int m = 0; m < 4; ++m)
#pragma unroll
                for (int bj = 0; bj < 2; ++bj) *(u32x4*)(base + (ai * HALF + m * 16) * 8192 + bj * HALF) = pack8(acc[ai][bj][m][0], acc[ai][bj][m][1]);
    }
};
struct EpiY {
    static constexpr bool PERM = true, AFTER_DRAIN = false; bf16_t* Y;
    __device__ __forceinline__ void operator()(const f32x4 (&acc)[2][2][4][2], const Unit& u, int wr, int wc, int fr, int fq) const {
        const int bg = u.pn, b = bg >> 3, g = bg & 7;
        bf16_t* base = Y + ((size_t)(b * 4096 + u.pm * BM + wr * 64 + fr) * 2048 + g * 256 + wc * 32 + 8 * fq);
#pragma unroll
        for (int ai = 0; ai < 2; ++ai)
#pragma unroll
            for (int m = 0; m < 4; ++m)
#pragma unroll
                for (int bj = 0; bj < 2; ++bj) *(u32x4*)(base + (ai * HALF + m * 16) * 2048 + bj * HALF) = pack8(acc[ai][bj][m][0], acc[ai][bj][m][1]);
    }
};
struct EpiRes {
    static constexpr bool PERM = true, AFTER_DRAIN = false; const float* R; float* out; bf16_t* xb; float* ssq;
    __device__ __forceinline__ void operator()(const f32x4 (&acc)[2][2][4][2], const Unit& u, int wr, int wc, int fr, int fq) const {
        const int row0 = u.pm * BM + wr * 64 + fr; const size_t off0 = (size_t)row0 * 2048 + u.pn * BM + wc * 32 + 8 * fq;
        const float* Rb = R + off0; float* Ob = out + off0; bf16_t* Xb = xb + off0; float* Sb = ssq + row0;
#pragma unroll
        for (int ai = 0; ai < 2; ++ai)
#pragma unroll
            for (int m = 0; m < 4; ++m) { const int ro = (ai * HALF + m * 16) * 2048; float ss = 0.f;
#pragma unroll
                for (int bj = 0; bj < 2; ++bj) {
                    const f32x4 r0 = *(const f32x4*)(Rb + ro + bj * HALF), r1 = *(const f32x4*)(Rb + ro + bj * HALF + 4);
                    const f32x4 o0 = acc[ai][bj][m][0] + r0, o1 = acc[ai][bj][m][1] + r1;
                    *(f32x4*)(Ob + ro + bj * HALF) = o0; *(f32x4*)(Ob + ro + bj * HALF + 4) = o1;
                    *(u32x4*)(Xb + ro + bj * HALF) = pack8(o0, o1);
                    ss += (o0[0] * o0[0] + o0[1] * o0[1]) + (o0[2] * o0[2] + o0[3] * o0[3]) + (o1[0] * o1[0] + o1[1] * o1[1]) + (o1[2] * o1[2] + o1[3] * o1[3]); }
                ss += __shfl_xor(ss, 16); ss += __shfl_xor(ss, 32);
                if (fq == 0) unsafeAtomicAdd(Sb + ai * HALF + m * 16, ss);
                asm volatile("" ::: "memory"); }
    }
};
struct EpiScale {
    static constexpr bool PERM = true, AFTER_DRAIN = false; bf16_t* O; const float* ssq;
    __device__ __forceinline__ void operator()(const f32x4 (&acc)[2][2][4][2], const Unit& u, int wr, int wc, int fr, int fq) const {
        const int row0 = u.pm * BM + wr * 64 + fr;
        bf16_t* base = O + ((size_t)row0 * 2048 + u.pn * BM + wc * 32 + 8 * fq); const float* Sb = ssq + row0;
#pragma unroll
        for (int ai = 0; ai < 2; ++ai)
#pragma unroll
            for (int m = 0; m < 4; ++m) { const float rs = rsqrtf(Sb[ai * HALF + m * 16] * (1.f / 2048.f) + 1e-6f);
#pragma unroll
                for (int bj = 0; bj < 2; ++bj) *(u32x4*)(base + (ai * HALF + m * 16) * 2048 + bj * HALF) = pack8(acc[ai][bj][m][0] * rs, acc[ai][bj][m][1] * rs); }
    }
};
struct EpiQK {
    static constexpr bool PERM = true, AFTER_DRAIN = false; bf16_t* Q; bf16_t* K; const float* ssq; const float* rope; float qscale;
    __device__ __forceinline__ void operator()(const f32x4 (&acc)[2][2][4][2], const Unit& u, int wr, int wc, int fr, int fq) const {
        const int row0 = u.pm * BM + wr * 64 + fr; const bool isq = u.pn < 8;
        const int cl = wc * 32 + 8 * fq;
        bf16_t* base = isq ? (Q + ((size_t)row0 * 2048 + u.pn * BM + cl)) : (K + ((size_t)row0 * 512 + (u.pn - 8) * BM + cl));
        const int ld = isq ? 2048 : 512; const float sc = isq ? qscale : 1.f;
        const float* rp = rope + (size_t)(row0 & 4095) * 64 + (cl & 63);
        const float* Sb = ssq + row0;
#pragma unroll
        for (int ai = 0; ai < 2; ++ai)
#pragma unroll
            for (int m = 0; m < 4; ++m) { const int ro = ai * HALF + m * 16; const float rs = rsqrtf(Sb[ro] * (1.f / 2048.f) + 1e-6f) * sc;
                const f32x4 t0 = *(const f32x4*)(rp + (size_t)ro * 64), t1 = *(const f32x4*)(rp + (size_t)ro * 64 + 4);
#pragma unroll
                for (int bj = 0; bj < 2; ++bj) {
                    const f32x4 a = acc[ai][bj][m][0] * rs, b = acc[ai][bj][m][1] * rs; f32x4 oa, ob;
                    oa[0] = a[0] * t0[0] - a[1] * t0[1]; oa[1] = a[1] * t0[0] + a[0] * t0[1]; oa[2] = a[2] * t0[2] - a[3] * t0[3]; oa[3] = a[3] * t0[2] + a[2] * t0[3];
                    ob[0] = b[0] * t1[0] - b[1] * t1[1]; ob[1] = b[1] * t1[0] + b[0] * t1[1]; ob[2] = b[2] * t1[2] - b[3] * t1[3]; ob[3] = b[3] * t1[2] + b[2] * t1[3];
                    *(u32x4*)(base + (size_t)ro * ld + bj * HALF) = pack8(oa, ob); } }
    }
};
struct EpiVt {
    static constexpr bool PERM = true, AFTER_DRAIN = false; bf16_t* Vt; const float* ssq;
    __device__ __forceinline__ void operator()(const f32x4 (&acc)[2][2][4][2], const Unit& u, int wr, int wc, int fr, int fq) const {
        const int col0 = u.pn * BM + wc * 32 + 8 * fq;
        bf16_t* base = Vt + ((size_t)(u.pm * BM + wr * 64 + fr) * 16384 + col0);
        f32x4 r0[2], r1[2];
#pragma unroll
        for (int bj = 0; bj < 2; ++bj) { const f32x4 s0 = *(const f32x4*)(ssq + col0 + bj * HALF), s1 = *(const f32x4*)(ssq + col0 + bj * HALF + 4);
#pragma unroll
            for (int q = 0; q < 4; ++q) { r0[bj][q] = rsqrtf(s0[q] * (1.f / 2048.f) + 1e-6f); r1[bj][q] = rsqrtf(s1[q] * (1.f / 2048.f) + 1e-6f); } }
#pragma unroll
        for (int ai = 0; ai < 2; ++ai)
#pragma unroll
            for (int m = 0; m < 4; ++m)
#pragma unroll
                for (int bj = 0; bj < 2; ++bj) *(u32x4*)(base + (size_t)(ai * HALF + m * 16) * 16384 + bj * HALF) = pack8(acc[ai][bj][m][0] * r0[bj], acc[ai][bj][m][1] * r1[bj]);
    }
};
template <class Epi, class Sched, bool ALIGN_EPI = false, bool SP2 = false>
__device__ __forceinline__ void gemm_phase(PG8_LAS unsigned char* lds, const Gemm g, const Sched& S, const Epi& E) {
    const int tid = threadIdx.x, wid = __builtin_amdgcn_readfirstlane(tid >> 6), lane = tid & 63, wr = wid >> 2, wc = wid & 3, fr = lane & 15, fq = lane >> 4;
    const int K = g.K, nt = K / BK;
    unsigned voffA[2], voffB[2];
#pragma unroll
    for (int i = 0; i < 2; ++i) { int R, C; stage_rc(tid * 16 + i * 8192, R, C); const int Rb = Epi::PERM ? ((R & ~31) + perm32(R & 31)) : R;
        voffA[i] = (unsigned)(R * K + C) * 2u; voffB[i] = (unsigned)(Rb * K + C) * 2u; }
    const size_t kstep = (size_t)(BK * 2);
    const size_t hstep = (size_t)HALF * K * 2;
    const size_t tstep = 2 * hstep;
    const unsigned ldsw = (unsigned)wid * 1024u;
    const int aoff = lds_byte(wr * 64 + fr, fq * 8), boff = lds_byte(wc * 32 + fr, fq * 8);
#define PG8_SA(b, h) (((b) * 2 + (h)) * HTB)
#define PG8_SB(b, h) ((4 + (b) * 2 + (h)) * HTB)
#define PG8_STAGE(bufoff, gbase, voff) do { _Pragma("unroll") for (int _i = 0; _i < 2; ++_i) \
        __builtin_amdgcn_global_load_lds((const unsigned*)((const char*)(gbase) + (voff)[_i]), (PG8_LAS unsigned*)(lds + (bufoff) + ldsw + _i * 8192), 16, 0, 0); } while (0)
#define PG8_LDA(dst, b, h) do { _Pragma("unroll") for (int m = 0; m < 4; ++m) _Pragma("unroll") for (int k = 0; k < 2; ++k) dst[m][k] = *(const PG8_LAS bf16x8*)(lds + PG8_SA(b, h) + aoff + m * 2048 + k * 1024); } while (0)
#define PG8_LDB(dst, b, h) do { _Pragma("unroll") for (int n = 0; n < 2; ++n) _Pragma("unroll") for (int k = 0; k < 2; ++k) dst[n][k] = *(const PG8_LAS bf16x8*)(lds + PG8_SB(b, h) + boff + n * 2048 + k * 1024); } while (0)
#define PG8_MMA(ai, bj, At, Bt) do { __builtin_amdgcn_s_setprio(1); _Pragma("unroll") for (int m = 0; m < 4; ++m) _Pragma("unroll") for (int n = 0; n < 2; ++n) _Pragma("unroll") for (int k = 0; k < 2; ++k) \
        acc[ai][bj][m][n] = __builtin_amdgcn_mfma_f32_16x16x32_bf16(Bt[n][k], At[m][k], acc[ai][bj][m][n], 0, 0, 0); __builtin_amdgcn_s_setprio(0); } while (0)
#define PG8_WAIT_V(n) asm volatile("s_waitcnt vmcnt(" #n ")" ::: "memory")
#define PG8_WAIT_L(n) asm volatile("s_waitcnt lgkmcnt(" #n ")" ::: "memory")
#define PG8_BAR __builtin_amdgcn_s_barrier()
#define PG8_SCHED __builtin_amdgcn_sched_barrier(0)
    Unit cur, nxt; int ui = 0;
    if (!S.next(0, cur)) return;
    f32x4 acc[2][2][4][2];
#pragma unroll
    for (int a = 0; a < 2; ++a)
#pragma unroll
        for (int b = 0; b < 2; ++b)
#pragma unroll
            for (int m = 0; m < 4; ++m)
#pragma unroll
                for (int n = 0; n < 2; ++n) acc[a][b][m][n] = (f32x4){0.f, 0.f, 0.f, 0.f};
    bf16x8 At[4][2], B0[2][2], B1[2][2];
    const char* cA = (const char*)g.A + (size_t)cur.pm * tstep; const char* cB = (const char*)g.Bt + (size_t)cur.pn * tstep;
    S.a_ready(cur);
    if constexpr (SP2) {
        PG8_STAGE(PG8_SB(0, 0), cB, voffB); PG8_STAGE(PG8_SB(0, 1), cB + hstep, voffB); PG8_STAGE(PG8_SA(0, 0), cA, voffA); PG8_STAGE(PG8_SA(0, 1), cA + hstep, voffA);
        if (wr == 1) PG8_BAR;
        PG8_WAIT_V(2); PG8_BAR;
        PG8_STAGE(PG8_SB(1, 0), cB + kstep, voffB); PG8_STAGE(PG8_SA(1, 0), cA + kstep, voffA); PG8_STAGE(PG8_SB(1, 1), cB + hstep + kstep, voffB);
        PG8_WAIT_V(6); PG8_BAR;
    } else {
        PG8_STAGE(PG8_SB(0, 0), cB, voffB); PG8_STAGE(PG8_SA(0, 0), cA, voffA); PG8_STAGE(PG8_SB(0, 1), cB + hstep, voffB); PG8_STAGE(PG8_SA(0, 1), cA + hstep, voffA);
        if (wr == 1) PG8_BAR;
        PG8_WAIT_V(4); PG8_BAR;
        PG8_STAGE(PG8_SB(1, 0), cB + kstep, voffB); PG8_STAGE(PG8_SA(1, 0), cA + kstep, voffA); PG8_STAGE(PG8_SB(1, 1), cB + hstep + kstep, voffB);
        PG8_WAIT_V(6); PG8_BAR;
    }
    for (;;) {
        const bool has_next = S.next(ui + 1, nxt);
        const char* nA = has_next ? (const char*)g.A + (size_t)nxt.pm * tstep : cA; const char* nB = has_next ? (const char*)g.Bt + (size_t)nxt.pn * tstep : cB;
        for (int t = 0; t < nt; t += 2) {
            const bool last = (t == nt - 2);
            const char* a1 = cA + (size_t)(t + 1) * kstep;
            const char* a2 = last ? nA : cA + (size_t)(t + 2) * kstep; const char* b2 = last ? nB : cB + (size_t)(t + 2) * kstep;
            const char* a3 = a2 + kstep; const char* b3 = b2 + kstep;
            if (last && has_next) S.a_ready(nxt);
            if constexpr (SP2) {
            PG8_LDB(B0, 0, 0); PG8_LDB(B1, 0, 1); PG8_SCHED; PG8_LDA(At, 0, 0); PG8_STAGE(PG8_SA(1, 1), a1 + hstep, voffA);
            PG8_WAIT_V(8); PG8_WAIT_L(0); PG8_BAR; PG8_MMA(0, 0, At, B0); PG8_MMA(0, 1, At, B1); PG8_BAR; PG8_SCHED;
            PG8_LDA(At, 0, 1); PG8_STAGE(PG8_SB(0, 0), b2, voffB); PG8_STAGE(PG8_SB(0, 1), b2 + hstep, voffB); PG8_STAGE(PG8_SA(0, 0), a2, voffA);
            PG8_WAIT_V(8); PG8_WAIT_L(0); PG8_BAR; PG8_MMA(1, 0, At, B0); PG8_MMA(1, 1, At, B1); PG8_BAR; PG8_SCHED;
            PG8_LDB(B0, 1, 0); PG8_LDB(B1, 1, 1); PG8_SCHED; PG8_LDA(At, 1, 0); PG8_STAGE(PG8_SA(0, 1), a2 + hstep, voffA);
            PG8_WAIT_V(8); PG8_WAIT_L(0); PG8_BAR; PG8_MMA(0, 0, At, B0); PG8_MMA(0, 1, At, B1); PG8_BAR; PG8_SCHED;
            PG8_LDA(At, 1, 1); PG8_STAGE(PG8_SB(1, 0), b3, voffB); PG8_STAGE(PG8_SB(1, 1), b3 + hstep, voffB); PG8_STAGE(PG8_SA(1, 0), a3, voffA);
            PG8_WAIT_V(8); PG8_WAIT_L(0); PG8_BAR; PG8_MMA(1, 0, At, B0); PG8_MMA(1, 1, At, B1); PG8_BAR; PG8_SCHED;
            } else {
            PG8_LDB(B0, 0, 0); PG8_SCHED; PG8_LDA(At, 0, 0); PG8_STAGE(PG8_SA(1, 1), a1 + hstep, voffA);
            PG8_WAIT_L(8); PG8_BAR; PG8_WAIT_L(0); PG8_MMA(0, 0, At, B0); PG8_BAR; PG8_SCHED;
            PG8_LDB(B1, 0, 1); PG8_STAGE(PG8_SB(0, 0), b2, voffB);
            PG8_BAR; PG8_WAIT_L(0); PG8_MMA(0, 1, At, B1); PG8_BAR;
            PG8_LDA(At, 0, 1); PG8_STAGE(PG8_SA(0, 0), a2, voffA);
            PG8_BAR; PG8_WAIT_L(0); PG8_MMA(1, 0, At, B0); PG8_BAR; PG8_SCHED;
            PG8_STAGE(PG8_SB(0, 1), b2 + hstep, voffB);
            PG8_WAIT_V(6); PG8_BAR; PG8_MMA(1, 1, At, B1); PG8_BAR;
            PG8_LDB(B0, 1, 0); PG8_SCHED; PG8_LDA(At, 1, 0); PG8_STAGE(PG8_SA(0, 1), a2 + hstep, voffA);
            PG8_WAIT_L(8); PG8_BAR; PG8_WAIT_L(0); PG8_MMA(0, 0, At, B0); PG8_BAR; PG8_SCHED;
            PG8_LDB(B1, 1, 1); PG8_STAGE(PG8_SB(1, 0), b3, voffB);
            PG8_BAR; PG8_WAIT_L(0); PG8_MMA(0, 1, At, B1); PG8_BAR;
            PG8_LDA(At, 1, 1); PG8_STAGE(PG8_SA(1, 0), a3, voffA);
            PG8_BAR; PG8_WAIT_L(0); PG8_MMA(1, 0, At, B0); PG8_BAR; PG8_SCHED;
            PG8_STAGE(PG8_SB(1, 1), b3 + hstep, voffB);
            PG8_WAIT_V(6); PG8_BAR; PG8_MMA(1, 1, At, B1); PG8_BAR;
            }
        }
        if constexpr (ALIGN_EPI) { if (wr == 0) PG8_BAR; }
        if constexpr (!Epi::AFTER_DRAIN) { E(acc, cur, wr, wc, fr, fq); S.done(cur); }
        if (!has_next) break;
#pragma unroll
        for (int a = 0; a < 2; ++a)
#pragma unroll
            for (int b = 0; b < 2; ++b)
#pragma unroll
                for (int m = 0; m < 4; ++m)
#pragma unroll
                    for (int n = 0; n < 2; ++n) acc[a][b][m][n] = (f32x4){0.f, 0.f, 0.f, 0.f};
        cur = nxt; cA = nA; cB = nB; ++ui;
        if constexpr (ALIGN_EPI) { if (wr == 1) PG8_BAR; }
    }
    PG8_WAIT_V(0);
    if constexpr (!ALIGN_EPI) { if (wr == 0) PG8_BAR; }
    PG8_BAR;
    if constexpr (Epi::AFTER_DRAIN) { E.fused(acc, cur, wr, wc, fr, fq, lds, wid, lane); S.done(cur); }
#undef PG8_SA
#undef PG8_SB
#undef PG8_STAGE
#undef PG8_LDA
#undef PG8_LDB
#undef PG8_MMA
#undef PG8_WAIT_V
#undef PG8_WAIT_L
#undef PG8_BAR
#undef PG8_SCHED
}
}
#define GAS __attribute__((address_space(1)))
#define LAS __attribute__((address_space(3)))
typedef unsigned short bf16;
typedef unsigned v4u __attribute__((ext_vector_type(4)));
typedef unsigned v2u __attribute__((ext_vector_type(2)));
typedef float f32x4 __attribute__((ext_vector_type(4)));
constexpr int NWAVES = 8;
constexpr int LDS_BYTES = 147456;
constexpr size_t MiB = 1u << 20;
constexpr size_t WS_CTL = 0, CTL_BYTES = 1 * MiB;
constexpr size_t WS_SSQ_A = 256 * 1024, WS_SSQ_B = 320 * 1024, WS_SSQ_C = 384 * 1024;
constexpr size_t WS_WCS = 1 * MiB, WS_ROPE = 2 * MiB, WS_KEYS = 3 * MiB;
constexpr size_t WS_WOF = 8 * MiB, WS_WQKV = 16 * MiB, WS_WOA = 28 * MiB, WS_WQ0 = 36 * MiB, WS_WQ1 = 44 * MiB;
constexpr size_t WS_CS = 64 * MiB;
constexpr size_t WS_U0 = 128 * MiB, WS_V0 = 192 * MiB, WS_U1 = 256 * MiB, WS_V1 = 320 * MiB;
constexpr size_t WS_XG = 384 * MiB, WS_XB = 384 * MiB;
constexpr size_t WS_ZT = 448 * MiB;
constexpr size_t WS_Y = 576 * MiB;
constexpr size_t WS_Q = 448 * MiB;
constexpr size_t WS_EI = 640 * MiB, WS_GW = 648 * MiB;
constexpr size_t WS_QB = 448 * MiB, WS_KB = 512 * MiB, WS_VT = 528 * MiB, WS_O = 576 * MiB;

__device__ __forceinline__ unsigned f2bf(float f) { unsigned u = __builtin_bit_cast(unsigned, f); return (u + 0x7fffu + ((u >> 16) & 1u)) >> 16; }
__device__ __forceinline__ unsigned pk2(float lo, float hi) { return f2bf(lo) | (f2bf(hi) << 16); }

struct Args { const float* in[12]; float* out; unsigned char* ws; int ph_lo, ph_hi; };

__device__ __forceinline__ int qkv_row(int n) { if (n >= 2560) return n; const int d = n & 63, pc = (d < 32) ? 2 * d : 2 * (d - 32) + 1; return (n & ~63) + pc; }
template <int MODE>
__device__ __forceinline__ void transpose_item(const float* W, int K, int N, const float* gain, bf16* WT, LAS float* scr, int item, int lane) {
    const int nblk = N / 32, kb = item / nblk, nb = item % nblk, k0 = 64 * kb, n0 = 32 * nb;
#pragma unroll 8
    for (int i = 0; i < 32; ++i) { const int kk = 2 * i + (lane >> 5); float v = W[(size_t)(k0 + kk) * N + n0 + (lane & 31)]; if (gain) v *= gain[k0 + kk]; scr[kk * 33 + (lane & 31)] = v; }
    asm volatile("s_waitcnt lgkmcnt(0)" ::: "memory");
    const int c = lane & 7;
#pragma unroll
    for (int j = 0; j < 4; ++j) { const int n = (lane >> 3) + 8 * j; const LAS float* s = scr + (8 * c) * 33 + n;
        v4u o; o.x = pk2(s[0 * 33], s[1 * 33]); o.y = pk2(s[2 * 33], s[3 * 33]); o.z = pk2(s[4 * 33], s[5 * 33]); o.w = pk2(s[6 * 33], s[7 * 33]);
        const int row = (MODE == 1) ? qkv_row(n0 + n) : (n0 + n);
        *(v4u*)(WT + (size_t)row * K + k0 + 8 * c) = o; }
    asm volatile("s_waitcnt lgkmcnt(0)" ::: "memory");
}
__device__ __forceinline__ float wsum(float v) {
#pragma unroll
    for (int o = 1; o < 64; o <<= 1) v += __shfl_xor(v, o);
    return v;
}
__device__ __forceinline__ void cvt_stream(const float* src, bf16* dst, size_t n8, size_t gtid, size_t ngt) {
    for (size_t i = gtid; i < n8; i += ngt) {
        const f32x4 a = *(const f32x4*)(src + i * 8), b = *(const f32x4*)(src + i * 8 + 4);
        v4u o; o.x = pk2(a[0], a[1]); o.y = pk2(a[2], a[3]); o.z = pk2(b[0], b[1]); o.w = pk2(b[2], b[3]);
        *(v4u*)(dst + i * 8) = o;
    }
}
typedef float f32x16 __attribute__((ext_vector_type(16)));
typedef short s16x8 __attribute__((ext_vector_type(8)));
typedef __bf16 bf16x2_t __attribute__((ext_vector_type(2)));
__device__ __forceinline__ unsigned ordf(float f) { const unsigned u = __float_as_uint(f); return (u & 0x80000000u) ? ~u : (u | 0x80000000u); }
__device__ __forceinline__ float unordf(unsigned u) { return __uint_as_float((u & 0x80000000u) ? (u & 0x7fffffffu) : ~u); }
__device__ __forceinline__ unsigned umax_(unsigned a, unsigned b) { return a > b ? a : b; }
#define DPPU(v, ctrl) ((unsigned)__builtin_amdgcn_update_dpp(0, (int)(v), (ctrl), 0xf, 0xf, true))
#define DPPF(v, ctrl) __int_as_float(__builtin_amdgcn_update_dpp(0, __float_as_int(v), (ctrl), 0xf, 0xf, true))
__device__ __forceinline__ unsigned max32(unsigned v) {
    v = umax_(v, DPPU(v, 0xB1)); v = umax_(v, DPPU(v, 0x4E)); v = umax_(v, DPPU(v, 0x141)); v = umax_(v, DPPU(v, 0x140));
    const auto r = __builtin_amdgcn_permlane16_swap(v, v, false, false);
    return umax_(r[0], r[1]);
}
__device__ __forceinline__ float sum16(float v) {
    v += DPPF(v, 0xB1); v += DPPF(v, 0x4E); v += DPPF(v, 0x141); v += DPPF(v, 0x140); return v;
}
__device__ __forceinline__ unsigned bperm(unsigned v, int srclane) { return (unsigned)__builtin_amdgcn_ds_bpermute(srclane << 2, (int)v); }
__device__ __forceinline__ unsigned top16_of4(unsigned p0, unsigned p1, unsigned p2, unsigned p3, int c15) {
    unsigned W = 0u;
    for (int it = 0; it < 16; ++it) {
        const unsigned m = max32(umax_(umax_(p0, p1), umax_(p2, p3)));
        W = (c15 == it) ? m : W;
        p0 = (p0 == m) ? 0u : p0; p1 = (p1 == m) ? 0u : p1; p2 = (p2 == m) ? 0u : p2; p3 = (p3 == m) ? 0u : p3;
    }
    return W;
}
__device__ __forceinline__ unsigned top16_of2(unsigned p0, unsigned p1, int c15) {
    unsigned W = 0u;
    for (int it = 0; it < 16; ++it) {
        const unsigned m = max32(umax_(p0, p1));
        W = (c15 == it) ? m : W;
        p0 = (p0 == m) ? 0u : p0; p1 = (p1 == m) ? 0u : p1;
    }
    return W;
}
__device__ __forceinline__ void topk_unit(const bf16* q, const bf16* keys, int* EI, float* GW, int t0, int h, int lane) {
    const int c = lane & 31, hi = lane >> 5, c15 = lane & 15, hbase = lane & 32;
    int f0 = 0, f1 = 0;
    { int cnt = 0;
#pragma unroll
      for (int i = 0; i < 16; ++i)
#pragma unroll
        for (int j = 0; j < 16; ++j) if ((i + 1) * (j + 1) <= 16) { f0 = (cnt == c) ? (i * 16 + j) : f0; f1 = (cnt == c + 32) ? (i * 16 + j) : f1; ++cnt; } }
    unsigned W[2][16];
#pragma unroll
    for (int p = 0; p < 2; ++p) {
        f32x16 acc[4];
#pragma unroll
        for (int kb = 0; kb < 4; ++kb)
#pragma unroll
            for (int r = 0; r < 16; ++r) acc[kb][r] = 0.f;
        const bf16* qp = q + (size_t)(t0 + c) * 2048 + h * 256 + p * 128 + hi * 8;
        const bf16* kp = keys + (size_t)((h * 2 + p) * 128 + c) * 128 + hi * 8;
        asm volatile("" : "+v"(qp), "+v"(kp));
#pragma unroll 2
        for (int ks = 0; ks < 8; ++ks) {
            const s16x8 a = *(const s16x8*)(qp + ks * 16);
#pragma unroll
            for (int kb = 0; kb < 4; ++kb) { const s16x8 b = *(const s16x8*)(kp + kb * 32 * 128 + ks * 16); acc[kb] = __builtin_amdgcn_mfma_f32_32x32x16_bf16(a, b, acc[kb], 0, 0, 0); }
        }
#pragma unroll
        for (int r = 0; r < 16; ++r) {
            const unsigned p0 = (ordf(acc[0][r]) & ~127u) | (unsigned)(127 - c), p1 = (ordf(acc[1][r]) & ~127u) | (unsigned)(95 - c),
                           p2 = (ordf(acc[2][r]) & ~127u) | (unsigned)(63 - c), p3 = (ordf(acc[3][r]) & ~127u) | (unsigned)(31 - c);
            W[p][r] = top16_of4(p0, p1, p2, p3, c15);
        }
    }
#pragma unroll
    for (int r = 0; r < 16; ++r) {
        const unsigned w0 = W[0][r], w1 = W[1][r];
        const float a0 = unordf(bperm(w0, hbase + (f0 >> 4)) & ~127u), b0 = unordf(bperm(w1, hbase + (f0 & 15)) & ~127u);
        const float a1 = unordf(bperm(w0, hbase + (f1 >> 4)) & ~127u), b1 = unordf(bperm(w1, hbase + (f1 & 15)) & ~127u);
        const unsigned cp0 = (ordf(a0 + b0) & ~63u) | (unsigned)(63 - c);
        const unsigned cp1 = (c + 32 < 50) ? ((ordf(a1 + b1) & ~63u) | (unsigned)(31 - c)) : 0u;
        const unsigned Wc = top16_of2(cp0, cp1, c15);
        const int slot = 63 - (int)(Wc & 63u);
        const unsigned fa = bperm((unsigned)f0, hbase + (slot & 31)), fb = bperm((unsigned)f1, hbase + (slot & 31));
        const int flat = (slot < 32) ? (int)fa : (int)fb;
        const float val = unordf(Wc & ~63u);
        const float vmax = __uint_as_float(bperm(__float_as_uint(val), hbase));
        const float e = __expf(val - vmax);
        const float g = e / sum16(e);
        const int k1 = 127 - (int)(bperm(w0, hbase + (flat >> 4)) & 127u), k2 = 127 - (int)(bperm(w1, hbase + (flat & 15)) & 127u);
        const int tok = t0 + (r & 3) + 8 * (r >> 2) + 4 * hi;
        if (c < 16) { EI[(size_t)(tok * 8 + h) * 16 + c] = k1 * 128 + k2; GW[(size_t)(tok * 8 + h) * 16 + c] = g; }
    }
}

__device__ __forceinline__ float gelu_tanh_f(float x) {
    const float u = 0.7978845608028654f * (x + 0.044715f * x * x * x);
    const float e = __expf(2.f * u);
    const float th = 1.f - 2.f / (e + 1.f);
    return 0.5f * x * (1.f + th);
}
__device__ __forceinline__ float wave_sum_bfly(float v) {
#pragma unroll
    for (int o = 1; o < 64; o <<= 1) v += __shfl_xor(v, o);
    return v;
}
__device__ __forceinline__ void peer_token(float* xio, const float* gain, const int* EI, const float* GW, const bf16* Ub, const bf16* Vb, bf16* xb, float* ssq, const float* fin, int t, int lane) {
    float* xr = xio + (size_t)t * 2048 + 8 * lane;
    unsigned hb[16];
    {
        f32x4 xv[8]; float s = 0.f;
#pragma unroll
        for (int j = 0; j < 4; ++j) { xv[2 * j] = *(const f32x4*)(xr + 512 * j); xv[2 * j + 1] = *(const f32x4*)(xr + 512 * j + 4); }
#pragma unroll
        for (int j = 0; j < 8; ++j) s += (xv[j][0] * xv[j][0] + xv[j][1] * xv[j][1]) + (xv[j][2] * xv[j][2] + xv[j][3] * xv[j][3]);
        const float rs = rsqrtf(wave_sum_bfly(s) * (1.f / 2048.f) + EPS);
#pragma unroll
        for (int j = 0; j < 4; ++j) {
            const f32x4 g0 = *(const f32x4*)(gain + 512 * j + 8 * lane), g1 = *(const f32x4*)(gain + 512 * j + 8 * lane + 4);
            hb[4 * j + 0] = pk2(xv[2 * j][0] * rs * g0[0], xv[2 * j][1] * rs * g0[1]); hb[4 * j + 1] = pk2(xv[2 * j][2] * rs * g0[2], xv[2 * j][3] * rs * g0[3]);
            hb[4 * j + 2] = pk2(xv[2 * j + 1][0] * rs * g1[0], xv[2 * j + 1][1] * rs * g1[1]); hb[4 * j + 3] = pk2(xv[2 * j + 1][2] * rs * g1[2], xv[2 * j + 1][3] * rs * g1[3]);
        }
    }
    float acc[32];
#pragma unroll
    for (int i = 0; i < 32; ++i) acc[i] = 0.f;
    const int ei_lo = EI[(size_t)t * 128 + lane], ei_hi = EI[(size_t)t * 128 + 64 + lane];
    const float gw_lo = GW[(size_t)t * 128 + lane], gw_hi = GW[(size_t)t * 128 + 64 + lane];
    for (int half = 0; half < 2; ++half) {
    const int eiv = half ? ei_hi : ei_lo; const int gwv = __float_as_int(half ? gw_hi : gw_lo);
    for (int grp = 0; grp < 16; ++grp) {
        v4u uu[4][4], vv[4][4]; float gk[4];
#pragma unroll
        for (int k = 0; k < 4; ++k) {
            const int idx = grp * 4 + k;
            const int e = __builtin_amdgcn_readlane(eiv, idx);
            gk[k] = __int_as_float(__builtin_amdgcn_readlane(gwv, idx));
            const bf16* up = Ub + (size_t)e * 2048 + 8 * lane; const bf16* vp = Vb + (size_t)e * 2048 + 8 * lane;
#pragma unroll
            for (int j = 0; j < 4; ++j) { uu[k][j] = *(const v4u*)(up + 512 * j); vv[k][j] = *(const v4u*)(vp + 512 * j); }
        }
#pragma unroll
        for (int k = 0; k < 4; ++k) {
            float d = 0.f;
#pragma unroll
            for (int j = 0; j < 4; ++j) {
                const unsigned u0 = uu[k][j][0], u1 = uu[k][j][1], u2 = uu[k][j][2], u3 = uu[k][j][3];
                d = __builtin_amdgcn_fdot2_f32_bf16(__builtin_bit_cast(bf16x2_t, u0), __builtin_bit_cast(bf16x2_t, hb[4 * j + 0]), d, false);
                d = __builtin_amdgcn_fdot2_f32_bf16(__builtin_bit_cast(bf16x2_t, u1), __builtin_bit_cast(bf16x2_t, hb[4 * j + 1]), d, false);
                d = __builtin_amdgcn_fdot2_f32_bf16(__builtin_bit_cast(bf16x2_t, u2), __builtin_bit_cast(bf16x2_t, hb[4 * j + 2]), d, false);
                d = __builtin_amdgcn_fdot2_f32_bf16(__builtin_bit_cast(bf16x2_t, u3), __builtin_bit_cast(bf16x2_t, hb[4 * j + 3]), d, false);
            }
            d = wave_sum_bfly(d);
            const float wgt = gk[k] * gelu_tanh_f(d);
#pragma unroll
            for (int j = 0; j < 4; ++j) {
                const unsigned w4[4] = {vv[k][j].x, vv[k][j].y, vv[k][j].z, vv[k][j].w};
#pragma unroll
                for (int q = 0; q < 4; ++q) { acc[8 * j + 2 * q] += wgt * __uint_as_float(w4[q] << 16); acc[8 * j + 2 * q + 1] += wgt * __uint_as_float(w4[q] & 0xffff0000u); }
            }
        }
    }
    }
    float s2 = 0.f;
#pragma unroll
    for (int j = 0; j < 4; ++j) {
        const f32x4 x0 = *(const f32x4*)(xr + 512 * j), x1 = *(const f32x4*)(xr + 512 * j + 4);
#pragma unroll
        for (int q = 0; q < 4; ++q) { acc[8 * j + q] += x0[q]; acc[8 * j + 4 + q] += x1[q]; }
#pragma unroll
        for (int q = 0; q < 8; ++q) s2 += acc[8 * j + q] * acc[8 * j + q];
    }
    s2 = wave_sum_bfly(s2);
    if (fin) {
        const float r2 = rsqrtf(s2 * (1.f / 2048.f) + EPS);
#pragma unroll
        for (int j = 0; j < 4; ++j) {
            const f32x4 g0 = *(const f32x4*)(fin + 512 * j + 8 * lane), g1 = *(const f32x4*)(fin + 512 * j + 8 * lane + 4);
            f32x4 o0, o1;
#pragma unroll
            for (int q = 0; q < 4; ++q) { o0[q] = acc[8 * j + q] * r2 * g0[q]; o1[q] = acc[8 * j + 4 + q] * r2 * g1[q]; }
            *(f32x4*)(xr + 512 * j) = o0; *(f32x4*)(xr + 512 * j + 4) = o1;
        }
    } else {
        bf16* xbr = xb + (size_t)t * 2048 + 8 * lane;
#pragma unroll
        for (int j = 0; j < 4; ++j) {
            f32x4 o0, o1;
#pragma unroll
            for (int q = 0; q < 4; ++q) { o0[q] = acc[8 * j + q]; o1[q] = acc[8 * j + 4 + q]; }
            *(f32x4*)(xr + 512 * j) = o0; *(f32x4*)(xr + 512 * j + 4) = o1;
            v4u o; o.x = pk2(o0[0], o0[1]); o.y = pk2(o0[2], o0[3]); o.z = pk2(o1[0], o1[1]); o.w = pk2(o1[2], o1[3]);
            *(v4u*)(xbr + 512 * j) = o;
        }
        if (lane == 0) ssq[t] = s2;
    }
}
typedef short s16x4 __attribute__((ext_vector_type(4)));
__device__ __forceinline__ unsigned cvt_pk_bf16_(float lo, float hi) { unsigned r; asm volatile("v_cvt_pk_bf16_f32 %0, %1, %2" : "=v"(r) : "v"(lo), "v"(hi)); return r; }
__device__ __forceinline__ void attn_task(const bf16* Q, const bf16* K, const bf16* Vt, bf16* O, const float* sinks, int b, int hq, int q0, int lane) {
    const int c = lane & 31, hi = lane >> 5, kvh = hq >> 2;
    const size_t tb = (size_t)b * 4096;
    s16x8 qf[4];
    { const bf16* qp = Q + (tb + q0 + c) * 2048 + hq * 64 + hi * 8;
#pragma unroll
      for (int ks = 0; ks < 4; ++ks) qf[ks] = *(const s16x8*)(qp + ks * 16); }
    const float sink2 = sinks[hq] * 1.4426950408889634f;
    float m = sink2, l = (hi == 0) ? 1.f : 0.f;
    f32x16 o0, o1;
#pragma unroll
    for (int r = 0; r < 16; ++r) { o0[r] = 0.f; o1[r] = 0.f; }
    const bf16* kbase = K + tb * 512 + kvh * 64 + hi * 8 + (size_t)c * 512;
    const bf16* vbase = Vt + (size_t)(kvh * 64 + c) * 16384 + tb + 4 * hi;
    for (int kt = 0; kt < 9; ++kt) {
        const int key0 = q0 - 128 + 32 * kt;
        if (key0 < 0 || key0 >= 4096) continue;
        s16x8 kf[4]; s16x4 va[2][2][2];
#pragma unroll
        for (int ks = 0; ks < 4; ++ks) kf[ks] = *(const s16x8*)(kbase + (size_t)key0 * 512 + ks * 16);
#pragma unroll
        for (int db = 0; db < 2; ++db)
#pragma unroll
            for (int s = 0; s < 2; ++s) { const bf16* vp = vbase + (size_t)db * 32 * 16384 + key0 + 16 * s; va[db][s][0] = *(const s16x4*)vp; va[db][s][1] = *(const s16x4*)(vp + 8); }
        f32x16 sa;
#pragma unroll
        for (int r = 0; r < 16; ++r) sa[r] = 0.f;
#pragma unroll
        for (int ks = 0; ks < 4; ++ks) sa = __builtin_amdgcn_mfma_f32_32x32x16_bf16(kf[ks], qf[ks], sa, 0, 0, 0);
        if (kt == 0 || kt == 8) {
            const int dbase = key0 - (q0 + c) + 4 * hi;
#pragma unroll
            for (int r = 0; r < 16; ++r) { const int d = dbase + (r & 3) + 8 * (r >> 2); if (d < -128 || d > 128) sa[r] = -1e30f; }
        }
        float mx = sa[0];
#pragma unroll
        for (int r = 1; r < 16; ++r) mx = fmaxf(mx, sa[r]);
        { const auto rr = __builtin_amdgcn_permlane32_swap(__float_as_uint(mx), __float_as_uint(mx), false, false); mx = fmaxf(__uint_as_float(rr[0]), __uint_as_float(rr[1])); }
        const float mn = fmaxf(m, mx), alpha = __builtin_amdgcn_exp2f(m - mn);
        m = mn;
        float ps = 0.f;
#pragma unroll
        for (int r = 0; r < 16; ++r) { sa[r] = __builtin_amdgcn_exp2f(sa[r] - mn); ps += sa[r]; }
        l = l * alpha + ps;
#pragma unroll
        for (int r = 0; r < 16; ++r) { o0[r] *= alpha; o1[r] *= alpha; }
        s16x8 pf[2];
#pragma unroll
        for (int s = 0; s < 2; ++s) { v4u w; w.x = cvt_pk_bf16_(sa[8 * s + 0], sa[8 * s + 1]); w.y = cvt_pk_bf16_(sa[8 * s + 2], sa[8 * s + 3]); w.z = cvt_pk_bf16_(sa[8 * s + 4], sa[8 * s + 5]); w.w = cvt_pk_bf16_(sa[8 * s + 6], sa[8 * s + 7]);
            pf[s] = __builtin_bit_cast(s16x8, w); }
#pragma unroll
        for (int s = 0; s < 2; ++s) {
            const s16x8 v0 = __builtin_shufflevector(va[0][s][0], va[0][s][1], 0, 1, 2, 3, 4, 5, 6, 7), v1 = __builtin_shufflevector(va[1][s][0], va[1][s][1], 0, 1, 2, 3, 4, 5, 6, 7);
            o0 = __builtin_amdgcn_mfma_f32_32x32x16_bf16(v0, pf[s], o0, 0, 0, 0);
            o1 = __builtin_amdgcn_mfma_f32_32x32x16_bf16(v1, pf[s], o1, 0, 0, 0);
        }
    }
    { const auto rr = __builtin_amdgcn_permlane32_swap(__float_as_uint(l), __float_as_uint(l), false, false); l = __uint_as_float(rr[0]) + __uint_as_float(rr[1]); }
    const float il = 1.f / l;
    bf16* op = O + (tb + q0 + c) * 2048 + hq * 64 + 4 * hi;
#pragma unroll
    for (int g = 0; g < 4; ++g) {
        v2u w0, w1;
        w0.x = cvt_pk_bf16_(o0[4 * g + 0] * il, o0[4 * g + 1] * il); w0.y = cvt_pk_bf16_(o0[4 * g + 2] * il, o0[4 * g + 3] * il);
        w1.x = cvt_pk_bf16_(o1[4 * g + 0] * il, o1[4 * g + 1] * il); w1.y = cvt_pk_bf16_(o1[4 * g + 2] * il, o1[4 * g + 3] * il);
        *(v2u*)(op + 8 * g) = w0; *(v2u*)(op + 32 + 8 * g) = w1;
    }
}
enum { PH_PRO = 0, PH_G1 = 1, PH_G2 = 2, PH_G3 = 3, PH_Q0 = 4, PH_TK0 = 5, PH_PE0 = 6, PH_QKV = 7, PH_ATT = 8, PH_WO = 9, PH_Q1 = 10, PH_TK1 = 11, PH_PE1 = 12, PH_END = 13 };
__global__ void __launch_bounds__(NWAVES * 64, 2) mega(Args a) {
    extern __shared__ __attribute__((aligned(16))) unsigned char lds_raw[];
    LAS unsigned char* lds = (LAS unsigned char*)lds_raw;
    const int tid = threadIdx.x, lane = tid & 63, wave = __builtin_amdgcn_readfirstlane(tid >> 6);
    const int G = gridDim.x, bx = blockIdx.x;
    unsigned char* ws = a.ws;
    const int lo = a.ph_lo, hi = a.ph_hi;
#define IN(k) (lo <= (k) && (k) < hi)
    if (IN(PH_PRO)) {
        const int gw = bx * NWAVES + wave, NGW = G * NWAVES;
        const size_t gtid = (size_t)bx * (NWAVES * 64) + tid, ngt = (size_t)G * NWAVES * 64;
        LAS float* scr = (LAS float*)(lds + wave * 16384);
        {
            constexpr int I_SQ = (DM / 64) * (DM / 32), I_QKV = (DM / 64) * (QKVW / 32);
            constexpr int NITEMS = 4 * I_SQ + I_QKV;
            for (int it = gw; it < NITEMS; it += NGW) {
                int r = it;
                if (r < I_SQ) { transpose_item<0>(a.in[3], DM, DM, nullptr, (bf16*)(ws + WS_WOF), scr, r, lane); continue; } r -= I_SQ;
                if (r < I_SQ) { transpose_item<0>(a.in[5], DM, DM, nullptr, (bf16*)(ws + WS_WOA), scr, r, lane); continue; } r -= I_SQ;
                if (r < I_SQ) { transpose_item<0>(a.in[7], DM, DM, a.in[2], (bf16*)(ws + WS_WQ0), scr, r, lane); continue; } r -= I_SQ;
                if (r < I_SQ) { transpose_item<0>(a.in[7] + (size_t)DM * DM, DM, DM, a.in[2] + DM, (bf16*)(ws + WS_WQ1), scr, r, lane); continue; } r -= I_SQ;
                transpose_item<1>(a.in[4], DM, QKVW, a.in[1] + DM, (bf16*)(ws + WS_WQKV), scr, r, lane);
            }
        }
        for (int row = gw; row < T; row += NGW) {
            const f32x4* xr = (const f32x4*)(a.in[0] + (size_t)row * DM) + lane;
            const f32x4* gr = (const f32x4*)a.in[1] + lane;
            f32x4 v[8]; float s = 0.f;
#pragma unroll
            for (int j = 0; j < 8; ++j) { v[j] = xr[64 * j]; s += (v[j][0] * v[j][0] + v[j][1] * v[j][1]) + (v[j][2] * v[j][2] + v[j][3] * v[j][3]); }
            const float r = rsqrtf(wsum(s) * (1.f / DM) + EPS);
            const int b = row >> 12, sp = row & 4095;
#pragma unroll
            for (int j = 0; j < 8; ++j) { const f32x4 gg = gr[64 * j]; v2u o; o.x = pk2(v[j][0] * r * gg[0], v[j][1] * r * gg[1]); o.y = pk2(v[j][2] * r * gg[2], v[j][3] * r * gg[3]);
                *(v2u*)((bf16*)(ws + WS_XG) + ((size_t)((b * 8 + j) * 4096 + sp) * 256 + 4 * lane)) = o; }
        }
        for (size_t i = gtid; i < (size_t)4096 * 8192 / 8; i += ngt) {
            const int k = (int)(i >> 10), c0 = (int)(i & 1023) * 8, part = c0 >> 12, s0 = c0 & 4095;
            float v[8];
#pragma unroll
            for (int e = 0; e < 8; ++e) { const int m = (k * (s0 + e)) & 4095; const float rev = (float)m * (1.f / 4096.f); v[e] = (part ? __builtin_amdgcn_sinf(rev) : __builtin_amdgcn_cosf(rev)) * (1.f / 64.f); }
            v4u o; o.x = pk2(v[0], v[1]); o.y = pk2(v[2], v[3]); o.z = pk2(v[4], v[5]); o.w = pk2(v[6], v[7]);
            *(v4u*)((bf16*)(ws + WS_CS) + i * 8) = o;
        }
        for (size_t i = gtid; i < (size_t)512 * 256 / 8; i += ngt) {
            const int n = (int)(i >> 5), c0 = (int)(i & 31) * 8, part = n >> 8, l = n & 255;
            float v[8];
#pragma unroll
            for (int e = 0; e < 8; ++e) { const int m = (l * (c0 + e)) & 255; const float rev = (float)m * (1.f / 256.f); v[e] = (part ? -__builtin_amdgcn_sinf(rev) : __builtin_amdgcn_cosf(rev)) * (1.f / 16.f); }
            v4u o; o.x = pk2(v[0], v[1]); o.y = pk2(v[2], v[3]); o.z = pk2(v[4], v[5]); o.w = pk2(v[6], v[7]);
            *(v4u*)((bf16*)(ws + WS_WCS) + i * 8) = o;
        }
        for (size_t i = gtid; i < (size_t)4096 * 32; i += ngt) {
            const int pos = (int)(i >> 5), fi = (int)(i & 31);
            const double inv = exp2(-(double)fi * (13.287712379549449 / 32.0));
            double sn, cs; sincos((double)pos * inv, &sn, &cs);
            ((float*)(ws + WS_ROPE))[2 * i] = (float)cs; ((float*)(ws + WS_ROPE))[2 * i + 1] = (float)sn;
        }
        cvt_stream(a.in[9], (bf16*)(ws + WS_U0), (size_t)NEXP * DM / 8, gtid, ngt);
        cvt_stream(a.in[10], (bf16*)(ws + WS_V0), (size_t)NEXP * DM / 8, gtid, ngt);
        cvt_stream(a.in[9] + (size_t)NEXP * DM, (bf16*)(ws + WS_U1), (size_t)NEXP * DM / 8, gtid, ngt);
        cvt_stream(a.in[10] + (size_t)NEXP * DM, (bf16*)(ws + WS_V1), (size_t)NEXP * DM / 8, gtid, ngt);
        cvt_stream(a.in[8], (bf16*)(ws + WS_KEYS), (size_t)2 * PH * 2 * 128 * 128 / 8, gtid, ngt);
    }
    if (IN(PH_G1)) {
        int Kq = FW; asm volatile("" : "+s"(Kq));
        pg8::Gemm g{(const pg8::bf16_t*)(ws + WS_WCS), (const pg8::bf16_t*)(ws + WS_XG), 512, T * FG, Kq}; pg8::StaticOrder S; S.init(512, T * FG, G, bx);
        pg8::EpiZt E{(pg8::bf16_t*)(ws + WS_ZT)};
        pg8::gemm_phase<pg8::EpiZt, pg8::StaticOrder, true, true>(lds, g, S, E);
    }
    if (IN(PH_G2)) {
        pg8::Gemm g{(const pg8::bf16_t*)(ws + WS_CS), (const pg8::bf16_t*)(ws + WS_ZT), 4096, 8192, 8192}; pg8::StaticOrder S; S.init(4096, 8192, G, bx);
        pg8::EpiY E{(pg8::bf16_t*)(ws + WS_Y)};
        pg8::gemm_phase<pg8::EpiY, pg8::StaticOrder, true, true>(lds, g, S, E);
    }
    if (IN(PH_G3)) {
        pg8::Gemm g{(const pg8::bf16_t*)(ws + WS_Y), (const pg8::bf16_t*)(ws + WS_WOF), T, DM, DM}; pg8::StaticOrder S; S.init(T, DM, G, bx);
        pg8::EpiRes E{a.in[0], a.out, (pg8::bf16_t*)(ws + WS_XB), (float*)(ws + WS_SSQ_A)};
        pg8::gemm_phase<pg8::EpiRes, pg8::StaticOrder, true, true>(lds, g, S, E);
    }
#define PEER_LAYER(L) do { \
        const int pq = L ? PH_Q1 : PH_Q0, ptk = L ? PH_TK1 : PH_TK0, ppe = L ? PH_PE1 : PH_PE0; \
        if (IN(pq)) { \
            pg8::Gemm g{(const pg8::bf16_t*)(ws + WS_XB), (const pg8::bf16_t*)(ws + (L ? WS_WQ1 : WS_WQ0)), T, DM, DM}; pg8::StaticOrder S; S.init(T, DM, G, bx); \
            pg8::EpiScale E{(pg8::bf16_t*)(ws + WS_Q), (const float*)(ws + (L ? WS_SSQ_C : WS_SSQ_A))}; \
            pg8::gemm_phase<pg8::EpiScale, pg8::StaticOrder, true, true>(lds, g, S, E); \
        } \
        if (IN(ptk)) { \
            const bf16* keys = (const bf16*)(ws + WS_KEYS) + (size_t)L * PH * 2 * 128 * 128; \
            for (int u = bx; u < T / 32; u += G) topk_unit((const bf16*)(ws + WS_Q), keys, (int*)(ws + WS_EI), (float*)(ws + WS_GW), u * 32, wave, lane); \
        } \
        if (IN(ppe)) { \
            const int gw = bx * NWAVES + wave, NGW = G * NWAVES; \
            for (int t = gw; t < T; t += NGW) \
                peer_token(a.out, a.in[2] + L * DM, (const int*)(ws + WS_EI), (const float*)(ws + WS_GW), (const bf16*)(ws + (L ? WS_U1 : WS_U0)), (const bf16*)(ws + (L ? WS_V1 : WS_V0)), \
                           (bf16*)(ws + WS_XB), (float*)(ws + WS_SSQ_B), L ? a.in[11] : nullptr, t, lane); \
        } \
    } while (0)
    PEER_LAYER(0);
    if (IN(PH_QKV)) {
        {
            pg8::Gemm g{(const pg8::bf16_t*)(ws + WS_XB), (const pg8::bf16_t*)(ws + WS_WQKV), T, 2560, DM}; pg8::StaticOrder S; S.init(T, 2560, G, bx);
            pg8::EpiQK E{(pg8::bf16_t*)(ws + WS_QB), (pg8::bf16_t*)(ws + WS_KB), (const float*)(ws + WS_SSQ_B), (const float*)(ws + WS_ROPE), 0.125f * 1.4426950408889634f};
            pg8::gemm_phase<pg8::EpiQK, pg8::StaticOrder, true, true>(lds, g, S, E);
        }
        if (bx >= 128) {
            pg8::Gemm g{(const pg8::bf16_t*)(ws + WS_WQKV) + (size_t)2560 * DM, (const pg8::bf16_t*)(ws + WS_XB), 512, T, DM}; pg8::StaticOrder S; S.init(512, T, 128, bx - 128);
            pg8::EpiVt E{(pg8::bf16_t*)(ws + WS_VT), (const float*)(ws + WS_SSQ_B)};
            pg8::gemm_phase<pg8::EpiVt, pg8::StaticOrder, true, true>(lds, g, S, E);
        }
    }
    if (IN(PH_ATT)) {
        const int bkv = bx >> 3, chunk = bx & 7, b = bkv >> 3, kvh = bkv & 7;
        for (int i = 0; i < 8; ++i)
            attn_task((const bf16*)(ws + WS_QB), (const bf16*)(ws + WS_KB), (const bf16*)(ws + WS_VT), (bf16*)(ws + WS_O), a.in[6], b, kvh * 4 + (wave & 3), (chunk * 8 + i) * 64 + (wave >> 2) * 32, lane);
    }
    if (IN(PH_WO)) {
        pg8::Gemm g{(const pg8::bf16_t*)(ws + WS_O), (const pg8::bf16_t*)(ws + WS_WOA), T, DM, DM}; pg8::StaticOrder S; S.init(T, DM, G, bx);
        pg8::EpiRes E{a.out, a.out, (pg8::bf16_t*)(ws + WS_XB), (float*)(ws + WS_SSQ_C)};
        pg8::gemm_phase<pg8::EpiRes, pg8::StaticOrder, true, true>(lds, g, S, E);
    }
    PEER_LAYER(1);
#undef PEER_LAYER
#undef IN
}

extern "C" void kernel_launch(void* const* d_in, const int* in_sizes, int n_in, void* d_out, int out_size, void* d_ws, size_t ws_size, hipStream_t stream) {
    static int inited = 0;
    if (!inited) {
        if (hipFuncSetAttribute((const void*)mega, hipFuncAttributeMaxDynamicSharedMemorySize, LDS_BYTES) != hipSuccess) { fprintf(stderr, "hipFuncSetAttribute failed\n"); }
        inited = 1;
    }
    if (ws_size < 700 * MiB) { fprintf(stderr, "ws too small: %zu\n", ws_size); return; }
    (void)hipMemsetAsync((char*)d_ws + WS_CTL, 0, CTL_BYTES, stream);
    Args a{};
    for (int i = 0; i < 12; ++i) a.in[i] = (const float*)d_in[i];
    a.out = (float*)d_out; a.ws = (unsigned char*)d_ws;
    for (int ph = 0; ph < PH_END; ++ph) {
        a.ph_lo = ph; a.ph_hi = ph + 1;
        hipLaunchKernelGGL(mega, dim3(256), dim3(NWAVES * 64), LDS_BYTES, stream, a);
    }
}
```

```cpp
#include <hip/hip_runtime.h>
#include <hip/hip_cooperative_groups.h>
namespace cg = cooperative_groups;
#include <cstdio>
#include <cstdint>
#include <cmath>

constexpr int DM = 2048, NB = 4, SEQ = 4096, T = NB * SEQ;
constexpr int FG = 8, FW = 256;
constexpr int HD = 64, NQH = 32, NKVH = 8, QKVW = 3072;
constexpr int PH = 8, NKEYS = 128, NEXP = 16384, PTOPK = 16;
constexpr float EPS = 1e-6f;
namespace pg8 {
#define PG8_LAS __attribute__((address_space(3)))
typedef unsigned short bf16_t;
typedef short bf16x8 __attribute__((ext_vector_type(8)));
typedef float f32x4 __attribute__((ext_vector_type(4)));
typedef unsigned u32x4 __attribute__((ext_vector_type(4)));
constexpr int BM = 256, BK = 64, HALF = 128, HTB = HALF * BK * 2  , STAGE_BYTES = 8 * HTB, NXCD = 8, WGM = 8;

__host__ __device__ __forceinline__ int lds_byte(int r, int c) { const int st = (r >> 4) * 2 + (c >> 5), rr = r & 15, cc = c & 31, ob = rr * 64 + cc * 2; return st * 1024 + (ob ^ (((ob >> 9) & 1) << 5)); }
__host__ __device__ __forceinline__ void stage_rc(int b, int& R, int& C) { const int st = b / 1024, sb = b % 1024, swz = sb ^ (((sb >> 9) & 1) << 5); R = (st >> 1) * 16 + swz / 64; C = (st & 1) * 32 + (swz % 64) / 2; }
__host__ __device__ __forceinline__ int perm32(int rho) { const int n = rho >> 4, i = rho & 15; return 8 * (i >> 2) + 4 * n + (i & 3); }

struct Unit { int pm, pn; };
struct Gemm { const bf16_t* A; const bf16_t* Bt; int M, N, K; };

struct StaticOrder {
    int nM, nN, nwg, G, c;
    __host__ __device__ void init(int M, int N, int G_, int c_) { nM = M / BM; nN = N / BM; nwg = nM * nN; G = G_; c = c_; }
    __host__ __device__ bool next(int i, Unit& u) const {
        const long L = (long)i * G + c; if (L >= nwg) return false;
        int wgid = (int)L; { const int q = nwg / NXCD, r = nwg % NXCD, xcd = wgid % NXCD, off = wgid / NXCD; wgid = (xcd < r ? xcd * (q + 1) : r * (q + 1) + (xcd - r) * q) + off; }
        const int nig = WGM * nN, gid = wgid / nig, fm = gid * WGM, gsz = (nM - fm) < WGM ? (nM - fm) : WGM;
        u.pm = fm + ((wgid % nig) % gsz); u.pn = (wgid % nig) / gsz; return true;
    }
    __device__ __forceinline__ void a_ready(const Unit&) const {}
    __device__ __forceinline__ void done(const Unit&) const {}
};

__device__ __forceinline__ unsigned cvt_pk_bf16(float lo, float hi) { unsigned r; asm volatile("v_cvt_pk_bf16_f32 %0, %1, %2" : "=v"(r) : "v"(lo), "v"(hi)); return r; }
typedef float f32x2 __attribute__((ext_vector_type(2)));
__device__ __forceinline__ u32x4 pack8(const f32x4 v0, const f32x4 v1) { u32x4 w; w.x = cvt_pk_bf16(v0[0], v0[1]); w.y = cvt_pk_bf16(v0[2], v0[3]); w.z = cvt_pk_bf16(v1[0], v1[1]); w.w = cvt_pk_bf16(v1[2], v1[3]); return w; }
struct EpiZt {
    static constexpr bool PERM = true, AFTER_DRAIN = false; bf16_t* Zt;
    __device__ __forceinline__ void operator()(const f32x4 (&acc)[2][2][4][2], const Unit& u, int wr, int wc, int fr, int fq) const {
        const int part = u.pm, j0 = u.pn * BM, bg = j0 >> 12, s0 = (j0 & 4095) + wc * 32 + 8 * fq;
        bf16_t* base = Zt + ((size_t)(bg * 256 + wr * 64 + fr) * 8192 + part * 4096 + s0);
#pragma unroll
        for (int ai = 0; ai < 2; ++ai)
#pragma unroll
            for (int m = 0; m < 4; ++m)
#pragma unroll
                for (int bj = 0; bj < 2; ++bj) *(u32x4*)(base + (ai * HALF + m * 16) * 8192 + bj * HALF) = pack8(acc[ai][bj][m][0], acc[ai][bj][m][1]);
    }
};
struct EpiY {
    static constexpr bool PERM = true, AFTER_DRAIN = false; bf16_t* Y;
    __device__ __forceinline__ void operator()(const f32x4 (&acc)[2][2][4][2], const Unit& u, int wr, int wc, int fr, int fq) const {
        const int bg = u.pn, b = bg >> 3, g = bg & 7;
        bf16_t* base = Y + ((size_t)(b * 4096 + u.pm * BM + wr * 64 + fr) * 2048 + g * 256 + wc * 32 + 8 * fq);
#pragma unroll
        for (int ai = 0; ai < 2; ++ai)
#pragma unroll
            for (int m = 0; m < 4; ++m)
#pragma unroll
                for (int bj = 0; bj < 2; ++bj) *(u32x4*)(base + (ai * HALF + m * 16) * 2048 + bj * HALF) = pack8(acc[ai][bj][m][0], acc[ai][bj][m][1]);
    }
};
struct EpiRes {
    static constexpr bool PERM = true, AFTER_DRAIN = false; const float* R; float* out; bf16_t* xb; float* ssq;
    __device__ __forceinline__ void operator()(const f32x4 (&acc)[2][2][4][2], const Unit& u, int wr, int wc, int fr, int fq) const {
        const int row0 = u.pm * BM + wr * 64 + fr; const size_t off0 = (size_t)row0 * 2048 + u.pn * BM + wc * 32 + 8 * fq;
        const float* Rb = R + off0; float* Ob = out + off0; bf16_t* Xb = xb + off0; float* Sb = ssq + row0;
#pragma unroll
        for (int ai = 0; ai < 2; ++ai)
#pragma unroll
            for (int m = 0; m < 4; ++m) { const int ro = (ai * HALF + m * 16) * 2048; float ss = 0.f;
#pragma unroll
                for (int bj = 0; bj < 2; ++bj) {
                    const f32x4 r0 = *(const f32x4*)(Rb + ro + bj * HALF), r1 = *(const f32x4*)(Rb + ro + bj * HALF + 4);
                    const f32x4 o0 = acc[ai][bj][m][0] + r0, o1 = acc[ai][bj][m][1] + r1;
                    *(f32x4*)(Ob + ro + bj * HALF) = o0; *(f32x4*)(Ob + ro + bj * HALF + 4) = o1;
                    *(u32x4*)(Xb + ro + bj * HALF) = pack8(o0, o1);
                    ss += (o0[0] * o0[0] + o0[1] * o0[1]) + (o0[2] * o0[2] + o0[3] * o0[3]) + (o1[0] * o1[0] + o1[1] * o1[1]) + (o1[2] * o1[2] + o1[3] * o1[3]); }
                ss += __shfl_xor(ss, 16); ss += __shfl_xor(ss, 32);
                if (fq == 0) unsafeAtomicAdd(Sb + ai * HALF + m * 16, ss);
                asm volatile("" ::: "memory"); }
    }
};
struct EpiScale {
    static constexpr bool PERM = true, AFTER_DRAIN = false; bf16_t* O; const float* ssq;
    __device__ __forceinline__ void operator()(const f32x4 (&acc)[2][2][4][2], const Unit& u, int wr, int wc, int fr, int fq) const {
        const int row0 = u.pm * BM + wr * 64 + fr;
        bf16_t* base = O + ((size_t)row0 * 2048 + u.pn * BM + wc * 32 + 8 * fq); const float* Sb = ssq + row0;
#pragma unroll
        for (int ai = 0; ai < 2; ++ai)
#pragma unroll
            for (int m = 0; m < 4; ++m) { const float rs = rsqrtf(Sb[ai * HALF + m * 16] * (1.f / 2048.f) + 1e-6f);
#pragma unroll
                for (int bj = 0; bj < 2; ++bj) *(u32x4*)(base + (ai * HALF + m * 16) * 2048 + bj * HALF) = pack8(acc[ai][bj][m][0] * rs, acc[ai][bj][m][1] * rs); }
    }
};
struct EpiQK {
    static constexpr bool PERM = true, AFTER_DRAIN = false; bf16_t* Q; bf16_t* K; const float* ssq; const float* rope; float qscale;
    __device__ __forceinline__ void operator()(const f32x4 (&acc)[2][2][4][2], const Unit& u, int wr, int wc, int fr, int fq) const {
        const int row0 = u.pm * BM + wr * 64 + fr; const bool isq = u.pn < 8;
        const int cl = wc * 32 + 8 * fq;
        bf16_t* base = isq ? (Q + ((size_t)row0 * 2048 + u.pn * BM + cl)) : (K + ((size_t)row0 * 512 + (u.pn - 8) * BM + cl));
        const int ld = isq ? 2048 : 512; const float sc = isq ? qscale : 1.f;
        const float* rp = rope + (size_t)(row0 & 4095) * 64 + (cl & 63);
        const float* Sb = ssq + row0;
#pragma unroll
        for (int ai = 0; ai < 2; ++ai)
#pragma unroll
            for (int m = 0; m < 4; ++m) { const int ro = ai * HALF + m * 16; const float rs = rsqrtf(Sb[ro] * (1.f / 2048.f) + 1e-6f) * sc;
                const f32x4 t0 = *(const f32x4*)(rp + (size_t)ro * 64), t1 = *(const f32x4*)(rp + (size_t)ro * 64 + 4);
#pragma unroll
                for (int bj = 0; bj < 2; ++bj) {
                    const f32x4 a = acc[ai][bj][m][0] * rs, b = acc[ai][bj][m][1] * rs; f32x4 oa, ob;
                    oa[0] = a[0] * t0[0] - a[1] * t0[1]; oa[1] = a[1] * t0[0] + a[0] * t0[1]; oa[2] = a[2] * t0[2] - a[3] * t0[3]; oa[3] = a[3] * t0[2] + a[2] * t0[3];
                    ob[0] = b[0] * t1[0] - b[1] * t1[1]; ob[1] = b[1] * t1[0] + b[0] * t1[1]; ob[2] = b[2] * t1[2] - b[3] * t1[3]; ob[3] = b[3] * t1[2] + b[2] * t1[3];
                    *(u32x4*)(base + (size_t)ro * ld + bj * HALF) = pack8(oa, ob); } }
    }
};
struct EpiVt {
    static constexpr bool PERM = true, AFTER_DRAIN = false; bf16_t* Vt; const float* ssq;
    __device__ __forceinline__ void operator()(const f32x4 (&acc)[2][2][4][2], const Unit& u, int wr, int wc, int fr, int fq) const {
        const int col0 = u.pn * BM + wc * 32 + 8 * fq;
        bf16_t* base = Vt + ((size_t)(u.pm * BM + wr * 64 + fr) * 16384 + col0);
        f32x4 r0[2], r1[2];
#pragma unroll
        for (int bj = 0; bj < 2; ++bj) { const f32x4 s0 = *(const f32x4*)(ssq + col0 + bj * HALF), s1 = *(const f32x4*)(ssq + col0 + bj * HALF + 4);
#pragma unroll
            for (int q = 0; q < 4; ++q) { r0[bj][q] = rsqrtf(s0[q] * (1.f / 2048.f) + 1e-6f); r1[bj][q] = rsqrtf(s1[q] * (1.f / 2048.f) + 1e-6f); } }
#pragma unroll
        for (int ai = 0; ai < 2; ++ai)
#pragma unroll
            for (int m = 0; m < 4; ++m)
#pragma unroll
                for (int bj = 0; bj < 2; ++bj) *(u32x4*)(base + (size_t)(ai * HALF + m * 16) * 16384 + bj * HALF) = pack8(acc[ai][bj][m][0] * r0[bj], acc[ai][bj][m][1] * r1[bj]);
    }
};
template <class Epi, class Sched, bool ALIGN_EPI = false, bool SP2 = false>
__device__ __forceinline__ void gemm_phase(PG8_LAS unsigned char* lds, const Gemm g, const Sched& S, const Epi& E) {
    const int tid = threadIdx.x, wid = __builtin_amdgcn_readfirstlane(tid >> 6), lane = tid & 63, wr = wid >> 2, wc = wid & 3, fr = lane & 15, fq = lane >> 4;
    const int K = g.K, nt = K / BK;
    unsigned voffA[2], voffB[2];
#pragma unroll
    for (int i = 0; i < 2; ++i) { int R, C; stage_rc(tid * 16 + i * 8192, R, C); const int Rb = Epi::PERM ? ((R & ~31) + perm32(R & 31)) : R;
        voffA[i] = (unsigned)(R * K + C) * 2u; voffB[i] = (unsigned)(Rb * K + C) * 2u; }
    const size_t kstep = (size_t)(BK * 2);
    const size_t hstep = (size_t)HALF * K * 2;
    const size_t tstep = 2 * hstep;
    const unsigned ldsw = (unsigned)wid * 1024u;
    const int aoff = lds_byte(wr * 64 + fr, fq * 8), boff = lds_byte(wc * 32 + fr, fq * 8);
#define PG8_SA(b, h) (((b) * 2 + (h)) * HTB)
#define PG8_SB(b, h) ((4 + (b) * 2 + (h)) * HTB)
#define PG8_STAGE(bufoff, gbase, voff) do { _Pragma("unroll") for (int _i = 0; _i < 2; ++_i) \
        __builtin_amdgcn_global_load_lds((const unsigned*)((const char*)(gbase) + (voff)[_i]), (PG8_LAS unsigned*)(lds + (bufoff) + ldsw + _i * 8192), 16, 0, 0); } while (0)
#define PG8_LDA(dst, b, h) do { _Pragma("unroll") for (int m = 0; m < 4; ++m) _Pragma("unroll") for (int k = 0; k < 2; ++k) dst[m][k] = *(const PG8_LAS bf16x8*)(lds + PG8_SA(b, h) + aoff + m * 2048 + k * 1024); } while (0)
#define PG8_LDB(dst, b, h) do { _Pragma("unroll") for (int n = 0; n < 2; ++n) _Pragma("unroll") for (int k = 0; k < 2; ++k) dst[n][k] = *(const PG8_LAS bf16x8*)(lds + PG8_SB(b, h) + boff + n * 2048 + k * 1024); } while (0)
#define PG8_MMA(ai, bj, At, Bt) do { __builtin_amdgcn_s_setprio(1); _Pragma("unroll") for (int m = 0; m < 4; ++m) _Pragma("unroll") for (int n = 0; n < 2; ++n) _Pragma("unroll") for (int k = 0; k < 2; ++k) \
        acc[ai][bj][m][n] = __builtin_amdgcn_mfma_f32_16x16x32_bf16(Bt[n][k], At[m][k], acc[ai][bj][m][n], 0, 0, 0); __builtin_amdgcn_s_setprio(0); } while (0)
#define PG8_WAIT_V(n) asm volatile("s_waitcnt vmcnt(" #n ")" ::: "memory")
#define PG8_WAIT_L(n) asm volatile("s_waitcnt lgkmcnt(" #n ")" ::: "memory")
#define PG8_BAR __builtin_amdgcn_s_barrier()
#define PG8_SCHED __builtin_amdgcn_sched_barrier(0)
    Unit cur, nxt; int ui = 0;
    if (!S.next(0, cur)) return;
    f32x4 acc[2][2][4][2];
#pragma unroll
    for (int a = 0; a < 2; ++a)
#pragma unroll
        for (int b = 0; b < 2; ++b)
#pragma unroll
            for (int m = 0; m < 4; ++m)
#pragma unroll
                for (int n = 0; n < 2; ++n) acc[a][b][m][n] = (f32x4){0.f, 0.f, 0.f, 0.f};
    bf16x8 At[4][2], B0[2][2], B1[2][2];
    const char* cA = (const char*)g.A + (size_t)cur.pm * tstep; const char* cB = (const char*)g.Bt + (size_t)cur.pn * tstep;
    S.a_ready(cur);
    if constexpr (SP2) {
        PG8_STAGE(PG8_SB(0, 0), cB, voffB); PG8_STAGE(PG8_SB(0, 1), cB + hstep, voffB); PG8_STAGE(PG8_SA(0, 0), cA, voffA); PG8_STAGE(PG8_SA(0, 1), cA + hstep, voffA);
        if (wr == 1) PG8_BAR;
        PG8_WAIT_V(2); PG8_BAR;
        PG8_STAGE(PG8_SB(1, 0), cB + kstep, voffB); PG8_STAGE(PG8_SA(1, 0), cA + kstep, voffA); PG8_STAGE(PG8_SB(1, 1), cB + hstep + kstep, voffB);
        PG8_WAIT_V(6); PG8_BAR;
    } else {
        PG8_STAGE(PG8_SB(0, 0), cB, voffB); PG8_STAGE(PG8_SA(0, 0), cA, voffA); PG8_STAGE(PG8_SB(0, 1), cB + hstep, voffB); PG8_STAGE(PG8_SA(0, 1), cA + hstep, voffA);
        if (wr == 1) PG8_BAR;
        PG8_WAIT_V(4); PG8_BAR;
        PG8_STAGE(PG8_SB(1, 0), cB + kstep, voffB); PG8_STAGE(PG8_SA(1, 0), cA + kstep, voffA); PG8_STAGE(PG8_SB(1, 1), cB + hstep + kstep, voffB);
        PG8_WAIT_V(6); PG8_BAR;
    }
    for (;;) {
        const bool has_next = S.next(ui + 1, nxt);
        const char* nA = has_next ? (const char*)g.A + (size_t)nxt.pm * tstep : cA; const char* nB = has_next ? (const char*)g.Bt + (size_t)nxt.pn * tstep : cB;
        for (int t = 0; t < nt; t += 2) {
            const bool last = (t == nt - 2);
            const char* a1 = cA + (size_t)(t + 1) * kstep;
            const char* a2 = last ? nA : cA + (size_t)(t + 2) * kstep; const char* b2 = last ? nB : cB + (size_t)(t + 2) * kstep;
            const char* a3 = a2 + kstep; const char* b3 = b2 + kstep;
            if (last && has_next) S.a_ready(nxt);
            if constexpr (SP2) {
            PG8_LDB(B0, 0, 0); PG8_LDB(B1, 0, 1); PG8_SCHED; PG8_LDA(At, 0, 0); PG8_STAGE(PG8_SA(1, 1), a1 + hstep, voffA);
            PG8_WAIT_V(8); PG8_WAIT_L(0); PG8_BAR; PG8_MMA(0, 0, At, B0); PG8_MMA(0, 1, At, B1); PG8_BAR; PG8_SCHED;
            PG8_LDA(At, 0, 1); PG8_STAGE(PG8_SB(0, 0), b2, voffB); PG8_STAGE(PG8_SB(0, 1), b2 + hstep, voffB); PG8_STAGE(PG8_SA(0, 0), a2, voffA);
            PG8_WAIT_V(8); PG8_WAIT_L(0); PG8_BAR; PG8_MMA(1, 0, At, B0); PG8_MMA(1, 1, At, B1); PG8_BAR; PG8_SCHED;
            PG8_LDB(B0, 1, 0); PG8_LDB(B1, 1, 1); PG8_SCHED; PG8_LDA(At, 1, 0); PG8_STAGE(PG8_SA(0, 1), a2 + hstep, voffA);
            PG8_WAIT_V(8); PG8_WAIT_L(0); PG8_BAR; PG8_MMA(0, 0, At, B0); PG8_MMA(0, 1, At, B1); PG8_BAR; PG8_SCHED;
            PG8_LDA(At, 1, 1); PG8_STAGE(PG8_SB(1, 0), b3, voffB); PG8_STAGE(PG8_SB(1, 1), b3 + hstep, voffB); PG8_STAGE(PG8_SA(1, 0), a3, voffA);
            PG8_WAIT_V(8); PG8_WAIT_L(0); PG8_BAR; PG8_MMA(1, 0, At, B0); PG8_MMA(1, 1, At, B1); PG8_BAR; PG8_SCHED;
            } else {
            PG8_LDB(B0, 0, 0); PG8_SCHED; PG8_LDA(At, 0, 0); PG8_STAGE(PG8_SA(1, 1), a1 + hstep, voffA);
            PG8_WAIT_L(8); PG8_BAR; PG8_WAIT_L(0); PG8_MMA(0, 0, At, B0); PG8_BAR; PG8_SCHED;
            PG8_LDB(B1, 0, 1); PG8_STAGE(PG8_SB(0, 0), b2, voffB);
            PG8_BAR; PG8_WAIT_L(0); PG8_MMA(0, 1, At, B1); PG8_BAR;
            PG8_LDA(At, 0, 1); PG8_STAGE(PG8_SA(0, 0), a2, voffA);
            PG8_BAR; PG8_WAIT_L(0); PG8_MMA(1, 0, At, B0); PG8_BAR; PG8_SCHED;
            PG8_STAGE(PG8_SB(0, 1), b2 + hstep, voffB);
            PG8_WAIT_V(6); PG8_BAR; PG8_MMA(1, 1, At, B1); PG8_BAR;
            PG8_LDB(B0, 1, 0); PG8_SCHED; PG8_LDA(At, 1, 0); PG8_STAGE(PG8_SA(0, 1), a2 + hstep, voffA);
            PG8_WAIT_L(8); PG8_BAR; PG8_WAIT_L(0); PG8_MMA(0, 0, At, B0); PG8_BAR; PG8_SCHED;
            PG8_LDB(B1, 1, 1); PG8_STAGE(PG8_SB(1, 0), b3, voffB);
            PG8_BAR; PG8_WAIT_L(0); PG8_MMA(0, 1, At, B1); PG8_BAR;
            PG8_LDA(At, 1, 1); PG8_STAGE(PG8_SA(1, 0), a3, voffA);
            PG8_BAR; PG8_WAIT_L(0); PG8_MMA(1, 0, At, B0); PG8_BAR; PG8_SCHED;
            PG8_STAGE(PG8_SB(1, 1), b3 + hstep, voffB);
            PG8_WAIT_V(6); PG8_BAR; PG8_MMA(1, 1, At, B1); PG8_BAR;
            }
        }
        if constexpr (ALIGN_EPI) { if (wr == 0) PG8_BAR; }
        if constexpr (!Epi::AFTER_DRAIN) { E(acc, cur, wr, wc, fr, fq); S.done(cur); }
        if (!has_next) break;
#pragma unroll
        for (int a = 0; a < 2; ++a)
#pragma unroll
            for (int b = 0; b < 2; ++b)
#pragma unroll
                for (int m = 0; m < 4; ++m)
#pragma unroll
                    for (int n = 0; n < 2; ++n) acc[a][b][m][n] = (f32x4){0.f, 0.f, 0.f, 0.f};
        cur = nxt; cA = nA; cB = nB; ++ui;
        if constexpr (ALIGN_EPI) { if (wr == 1) PG8_BAR; }
    }
    PG8_WAIT_V(0);
    if constexpr (!ALIGN_EPI) { if (wr == 0) PG8_BAR; }
    PG8_BAR;
    if constexpr (Epi::AFTER_DRAIN) { E.fused(acc, cur, wr, wc, fr, fq, lds, wid, lane); S.done(cur); }
#undef PG8_SA
#undef PG8_SB
#undef PG8_STAGE
#undef PG8_LDA
#undef PG8_LDB
#undef PG8_MMA
#undef PG8_WAIT_V
#undef PG8_WAIT_L
#undef PG8_BAR
#undef PG8_SCHED
}
}
#define GAS __attribute__((address_space(1)))
#define LAS __attribute__((address_space(3)))
typedef unsigned short bf16;
typedef unsigned v4u __attribute__((ext_vector_type(4)));
typedef unsigned v2u __attribute__((ext_vector_type(2)));
typedef float f32x4 __attribute__((ext_vector_type(4)));
constexpr int NWAVES = 8;
constexpr int LDS_BYTES = 147456;
constexpr size_t MiB = 1u << 20;
constexpr size_t WS_CTL = 0, CTL_BYTES = 1 * MiB;
constexpr size_t WS_SSQ_A = 256 * 1024, WS_SSQ_B = 320 * 1024, WS_SSQ_C = 384 * 1024;
constexpr size_t WS_WCS = 1 * MiB, WS_ROPE = 2 * MiB, WS_KEYS = 3 * MiB;
constexpr size_t WS_WOF = 8 * MiB, WS_WQKV = 16 * MiB, WS_WOA = 28 * MiB, WS_WQ0 = 36 * MiB, WS_WQ1 = 44 * MiB;
constexpr size_t WS_CS = 64 * MiB;
constexpr size_t WS_U0 = 128 * MiB, WS_V0 = 192 * MiB, WS_U1 = 256 * MiB, WS_V1 = 320 * MiB;
constexpr size_t WS_XG = 384 * MiB, WS_XB = 384 * MiB;
constexpr size_t WS_ZT = 448 * MiB;
constexpr size_t WS_Y = 576 * MiB;
constexpr size_t WS_Q = 448 * MiB;
constexpr size_t WS_EI = 640 * MiB, WS_GW = 648 * MiB;
constexpr size_t WS_QB = 448 * MiB, WS_KB = 512 * MiB, WS_VT = 528 * MiB, WS_O = 576 * MiB;

__device__ __forceinline__ unsigned f2bf(float f) { unsigned u = __builtin_bit_cast(unsigned, f); return (u + 0x7fffu + ((u >> 16) & 1u)) >> 16; }
__device__ __forceinline__ unsigned pk2(float lo, float hi) { return f2bf(lo) | (f2bf(hi) << 16); }

struct Args { const float* in[12]; float* out; unsigned char* ws; int ph_lo, ph_hi; };

__device__ __forceinline__ int qkv_row(int n) { if (n >= 2560) return n; const int d = n & 63, pc = (d < 32) ? 2 * d : 2 * (d - 32) + 1; return (n & ~63) + pc; }
template <int MODE>
__device__ __forceinline__ void transpose_item(const float* W, int K, int N, const float* gain, bf16* WT, LAS float* scr, int item, int lane) {
    const int nblk = N / 32, kb = item / nblk, nb = item % nblk, k0 = 64 * kb, n0 = 32 * nb;
#pragma unroll 8
    for (int i = 0; i < 32; ++i) { const int kk = 2 * i + (lane >> 5); float v = W[(size_t)(k0 + kk) * N + n0 + (lane & 31)]; if (gain) v *= gain[k0 + kk]; scr[kk * 33 + (lane & 31)] = v; }
    asm volatile("s_waitcnt lgkmcnt(0)" ::: "memory");
    const int c = lane & 7;
#pragma unroll
    for (int j = 0; j < 4; ++j) { const int n = (lane >> 3) + 8 * j; const LAS float* s = scr + (8 * c) * 33 + n;
        v4u o; o.x = pk2(s[0 * 33], s[1 * 33]); o.y = pk2(s[2 * 33], s[3 * 33]); o.z = pk2(s[4 * 33], s[5 * 33]); o.w = pk2(s[6 * 33], s[7 * 33]);
        const int row = (MODE == 1) ? qkv_row(n0 + n) : (n0 + n);
        *(v4u*)(WT + (size_t)row * K + k0 + 8 * c) = o; }
    asm volatile("s_waitcnt lgkmcnt(0)" ::: "memory");
}
__device__ __forceinline__ float wsum(float v) {
#pragma unroll
    for (int o = 1; o < 64; o <<= 1) v += __shfl_xor(v, o);
    return v;
}
__device__ __forceinline__ void cvt_stream(const float* src, bf16* dst, size_t n8, size_t gtid, size_t ngt) {
    for (size_t i = gtid; i < n8; i += ngt) {
        const f32x4 a = *(const f32x4*)(src + i * 8), b = *(const f32x4*)(src + i * 8 + 4);
        v4u o; o.x = pk2(a[0], a[1]); o.y = pk2(a[2], a[3]); o.z = pk2(b[0], b[1]); o.w = pk2(b[2], b[3]);
        *(v4u*)(dst + i * 8) = o;
    }
}
typedef float f32x16 __attribute__((ext_vector_type(16)));
typedef short s16x8 __attribute__((ext_vector_type(8)));
typedef __bf16 bf16x2_t __attribute__((ext_vector_type(2)));
__device__ __forceinline__ unsigned ordf(float f) { const unsigned u = __float_as_uint(f); return (u & 0x80000000u) ? ~u : (u | 0x80000000u); }
__device__ __forceinline__ float unordf(unsigned u) { return __uint_as_float((u & 0x80000000u) ? (u & 0x7fffffffu) : ~u); }
__device__ __forceinline__ unsigned umax_(unsigned a, unsigned b) { return a > b ? a : b; }
#define DPPU(v, ctrl) ((unsigned)__builtin_amdgcn_update_dpp(0, (int)(v), (ctrl), 0xf, 0xf, true))
#define DPPF(v, ctrl) __int_as_float(__builtin_amdgcn_update_dpp(0, __float_as_int(v), (ctrl), 0xf, 0xf, true))
__device__ __forceinline__ unsigned max32(unsigned v) {
    v = umax_(v, DPPU(v, 0xB1)); v = umax_(v, DPPU(v, 0x4E)); v = umax_(v, DPPU(v, 0x141)); v = umax_(v, DPPU(v, 0x140));
    const auto r = __builtin_amdgcn_permlane16_swap(v, v, false, false);
    return umax_(r[0], r[1]);
}
__device__ __forceinline__ float sum16(float v) {
    v += DPPF(v, 0xB1); v += DPPF(v, 0x4E); v += DPPF(v, 0x141); v += DPPF(v, 0x140); return v;
}
__device__ __forceinline__ unsigned bperm(unsigned v, int srclane) { return (unsigned)__builtin_amdgcn_ds_bpermute(srclane << 2, (int)v); }
__device__ __forceinline__ unsigned top16_of4(unsigned p0, unsigned p1, unsigned p2, unsigned p3, int c15) {
    unsigned W = 0u;
    for (int it = 0; it < 16; ++it) {
        const unsigned m = max32(umax_(umax_(p0, p1), umax_(p2, p3)));
        W = (c15 == it) ? m : W;
        p0 = (p0 == m) ? 0u : p0; p1 = (p1 == m) ? 0u : p1; p2 = (p2 == m) ? 0u : p2; p3 = (p3 == m) ? 0u : p3;
    }
    return W;
}
__device__ __forceinline__ unsigned top16_of2(unsigned p0, unsigned p1, int c15) {
    unsigned W = 0u;
    for (int it = 0; it < 16; ++it) {
        const unsigned m = max32(umax_(p0, p1));
        W = (c15 == it) ? m : W;
        p0 = (p0 == m) ? 0u : p0; p1 = (p1 == m) ? 0u : p1;
    }
    return W;
}
__device__ __forceinline__ void topk_unit(const bf16* q, const bf16* keys, int* EI, float* GW, int t0, int h, int lane) {
    const int c = lane & 31, hi = lane >> 5, c15 = lane & 15, hbase = lane & 32;
    int f0 = 0, f1 = 0;
    { int cnt = 0;
#pragma unroll
      for (int i = 0; i < 16; ++i)
#pragma unroll
        for (int j = 0; j < 16; ++j) if ((i + 1) * (j + 1) <= 16) { f0 = (cnt == c) ? (i * 16 + j) : f0; f1 = (cnt == c + 32) ? (i * 16 + j) : f1; ++cnt; } }
    unsigned W[2][16];
#pragma unroll
    for (int p = 0; p < 2; ++p) {
        f32x16 acc[4];
#pragma unroll
        for (int kb = 0; kb < 4; ++kb)
#pragma unroll
            for (int r = 0; r < 16; ++r) acc[kb][r] = 0.f;
        const bf16* qp = q + (size_t)(t0 + c) * 2048 + h * 256 + p * 128 + hi * 8;
        const bf16* kp = keys + (size_t)((h * 2 + p) * 128 + c) * 128 + hi * 8;
        asm volatile("" : "+v"(qp), "+v"(kp));
#pragma unroll 2
        for (int ks = 0; ks < 8; ++ks) {
            const s16x8 a = *(const s16x8*)(qp + ks * 16);
#pragma unroll
            for (int kb = 0; kb < 4; ++kb) { const s16x8 b = *(const s16x8*)(kp + kb * 32 * 128 + ks * 16); acc[kb] = __builtin_amdgcn_mfma_f32_32x32x16_bf16(a, b, acc[kb], 0, 0, 0); }
        }
#pragma unroll
        for (int r = 0; r < 16; ++r) {
            const unsigned p0 = (ordf(acc[0][r]) & ~127u) | (unsigned)(127 - c), p1 = (ordf(acc[1][r]) & ~127u) | (unsigned)(95 - c),
                           p2 = (ordf(acc[2][r]) & ~127u) | (unsigned)(63 - c), p3 = (ordf(acc[3][r]) & ~127u) | (unsigned)(31 - c);
            W[p][r] = top16_of4(p0, p1, p2, p3, c15);
        }
    }
#pragma unroll
    for (int r = 0; r < 16; ++r) {
        const unsigned w0 = W[0][r], w1 = W[1][r];
        const float a0 = unordf(bperm(w0, hbase + (f0 >> 4)) & ~127u), b0 = unordf(bperm(w1, hbase + (f0 & 15)) & ~127u);
        const float a1 = unordf(bperm(w0, hbase + (f1 >> 4)) & ~127u), b1 = unordf(bperm(w1, hbase + (f1 & 15)) & ~127u);
        const unsigned cp0 = (ordf(a0 + b0) & ~63u) | (unsigned)(63 - c);
        const unsigned cp1 = (c + 32 < 50) ? ((ordf(a1 + b1) & ~63u) | (unsigned)(31 - c)) : 0u;
        const unsigned Wc = top16_of2(cp0, cp1, c15);
        const int slot = 63 - (int)(Wc & 63u);
        const unsigned fa = bperm((unsigned)f0, hbase + (slot & 31)), fb = bperm((unsigned)f1, hbase + (slot & 31));
        const int flat = (slot < 32) ? (int)fa : (int)fb;
        const float val = unordf(Wc & ~63u);
        const float vmax = __uint_as_float(bperm(__float_as_uint(val), hbase));
        const float e = __expf(val - vmax);
        const float g = e / sum16(e);
        const int k1 = 127 - (int)(bperm(w0, hbase + (flat >> 4)) & 127u), k2 = 127 - (int)(bperm(w1, hbase + (flat & 15)) & 127u);
        const int tok = t0 + (r & 3) + 8 * (r >> 2) + 4 * hi;
        if (c < 16) { EI[(size_t)(tok * 8 + h) * 16 + c] = k1 * 128 + k2; GW[(size_t)(tok * 8 + h) * 16 + c] = g; }
    }
}

__device__ __forceinline__ float gelu_tanh_f(float x) {
    const float u = 0.7978845608028654f * (x + 0.044715f * x * x * x);
    const float e = __expf(2.f * u);
    const float th = 1.f - 2.f / (e + 1.f);
    return 0.5f * x * (1.f + th);
}
__device__ __forceinline__ float wave_sum_bfly(float v) {
#pragma unroll
    for (int o = 1; o < 64; o <<= 1) v += __shfl_xor(v, o);
    return v;
}
__device__ __forceinline__ void peer_token(float* xio, const float* gain, const int* EI, const float* GW, const bf16* Ub, const bf16* Vb, bf16* xb, float* ssq, const float* fin, int t, int lane) {
    float* xr = xio + (size_t)t * 2048 + 8 * lane;
    unsigned hb[16];
    {
        f32x4 xv[8]; float s = 0.f;
#pragma unroll
        for (int j = 0; j < 4; ++j) { xv[2 * j] = *(const f32x4*)(xr + 512 * j); xv[2 * j + 1] = *(const f32x4*)(xr + 512 * j + 4); }
#pragma unroll
        for (int j = 0; j < 8; ++j) s += (xv[j][0] * xv[j][0] + xv[j][1] * xv[j][1]) + (xv[j][2] * xv[j][2] + xv[j][3] * xv[j][3]);
        const float rs = rsqrtf(wave_sum_bfly(s) * (1.f / 2048.f) + EPS);
#pragma unroll
        for (int j = 0; j < 4; ++j) {
            const f32x4 g0 = *(const f32x4*)(gain + 512 * j + 8 * lane), g1 = *(const f32x4*)(gain + 512 * j + 8 * lane + 4);
            hb[4 * j + 0] = pk2(xv[2 * j][0] * rs * g0[0], xv[2 * j][1] * rs * g0[1]); hb[4 * j + 1] = pk2(xv[2 * j][2] * rs * g0[2], xv[2 * j][3] * rs * g0[3]);
            hb[4 * j + 2] = pk2(xv[2 * j + 1][0] * rs * g1[0], xv[2 * j + 1][1] * rs * g1[1]); hb[4 * j + 3] = pk2(xv[2 * j + 1][2] * rs * g1[2], xv[2 * j + 1][3] * rs * g1[3]);
        }
    }
    float acc[32];
#pragma unroll
    for (int i = 0; i < 32; ++i) acc[i] = 0.f;
    const int ei_lo = EI[(size_t)t * 128 + lane], ei_hi = EI[(size_t)t * 128 + 64 + lane];
    const float gw_lo = GW[(size_t)t * 128 + lane], gw_hi = GW[(size_t)t * 128 + 64 + lane];
    for (int half = 0; half < 2; ++half) {
    const int eiv = half ? ei_hi : ei_lo; const int gwv = __float_as_int(half ? gw_hi : gw_lo);
    for (int grp = 0; grp < 16; ++grp) {
        v4u uu[4][4], vv[4][4]; float gk[4];
#pragma unroll
        for (int k = 0; k < 4; ++k) {
            const int idx = grp * 4 + k;
            const int e = __builtin_amdgcn_readlane(eiv, idx);
            gk[k] = __int_as_float(__builtin_amdgcn_readlane(gwv, idx));
            const bf16* up = Ub + (size_t)e * 2048 + 8 * lane; const bf16* vp = Vb + (size_t)e * 2048 + 8 * lane;
#pragma unroll
            for (int j = 0; j < 4; ++j) { uu[k][j] = *(const v4u*)(up + 512 * j); vv[k][j] = *(const v4u*)(vp + 512 * j); }
        }
#pragma unroll
        for (int k = 0; k < 4; ++k) {
            float d = 0.f;
#pragma unroll
            for (int j = 0; j < 4; ++j) {
                const unsigned u0 = uu[k][j][0], u1 = uu[k][j][1], u2 = uu[k][j][2], u3 = uu[k][j][3];
                d = __builtin_amdgcn_fdot2_f32_bf16(__builtin_bit_cast(bf16x2_t, u0), __builtin_bit_cast(bf16x2_t, hb[4 * j + 0]), d, false);
                d = __builtin_amdgcn_fdot2_f32_bf16(__builtin_bit_cast(bf16x2_t, u1), __builtin_bit_cast(bf16x2_t, hb[4 * j + 1]), d, false);
                d = __builtin_amdgcn_fdot2_f32_bf16(__builtin_bit_cast(bf16x2_t, u2), __builtin_bit_cast(bf16x2_t, hb[4 * j + 2]), d, false);
                d = __builtin_amdgcn_fdot2_f32_bf16(__builtin_bit_cast(bf16x2_t, u3), __builtin_bit_cast(bf16x2_t, hb[4 * j + 3]), d, false);
            }
            d = wave_sum_bfly(d);
            const float wgt = gk[k] * gelu_tanh_f(d);
#pragma unroll
            for (int j = 0; j < 4; ++j) {
                const unsigned w4[4] = {vv[k][j].x, vv[k][j].y, vv[k][j].z, vv[k][j].w};
#pragma unroll
                for (int q = 0; q < 4; ++q) { acc[8 * j + 2 * q] += wgt * __uint_as_float(w4[q] << 16); acc[8 * j + 2 * q + 1] += wgt * __uint_as_float(w4[q] & 0xffff0000u); }
            }
        }
    }
    }
    float s2 = 0.f;
#pragma unroll
    for (int j = 0; j < 4; ++j) {
        const f32x4 x0 = *(const f32x4*)(xr + 512 * j), x1 = *(const f32x4*)(xr + 512 * j + 4);
#pragma unroll
        for (int q = 0; q < 4; ++q) { acc[8 * j + q] += x0[q]; acc[8 * j + 4 + q] += x1[q]; }
#pragma unroll
        for (int q = 0; q < 8; ++q) s2 += acc[8 * j + q] * acc[8 * j + q];
    }
    s2 = wave_sum_bfly(s2);
    if (fin) {
        const float r2 = rsqrtf(s2 * (1.f / 2048.f) + EPS);
#pragma unroll
        for (int j = 0; j < 4; ++j) {
            const f32x4 g0 = *(const f32x4*)(fin + 512 * j + 8 * lane), g1 = *(const f32x4*)(fin + 512 * j + 8 * lane + 4);
            f32x4 o0, o1;
#pragma unroll
            for (int q = 0; q < 4; ++q) { o0[q] = acc[8 * j + q] * r2 * g0[q]; o1[q] = acc[8 * j + 4 + q] * r2 * g1[q]; }
            *(f32x4*)(xr + 512 * j) = o0; *(f32x4*)(xr + 512 * j + 4) = o1;
        }
    } else {
        bf16* xbr = xb + (size_t)t * 2048 + 8 * lane;
#pragma unroll
        for (int j = 0; j < 4; ++j) {
            f32x4 o0, o1;
#pragma unroll
            for (int q = 0; q < 4; ++q) { o0[q] = acc[8 * j + q]; o1[q] = acc[8 * j + 4 + q]; }
            *(f32x4*)(xr + 512 * j) = o0; *(f32x4*)(xr + 512 * j + 4) = o1;
            v4u o; o.x = pk2(o0[0], o0[1]); o.y = pk2(o0[2], o0[3]); o.z = pk2(o1[0], o1[1]); o.w = pk2(o1[2], o1[3]);
            *(v4u*)(xbr + 512 * j) = o;
        }
        if (lane == 0) ssq[t] = s2;
    }
}
typedef short s16x4 __attribute__((ext_vector_type(4)));
__device__ __forceinline__ unsigned cvt_pk_bf16_(float lo, float hi) { unsigned r; asm volatile("v_cvt_pk_bf16_f32 %0, %1, %2" : "=v"(r) : "v"(lo), "v"(hi)); return r; }
__device__ __forceinline__ void attn_task(const bf16* Q, const bf16* K, const bf16* Vt, bf16* O, const float* sinks, int b, int hq, int q0, int lane) {
    const int c = lane & 31, hi = lane >> 5, kvh = hq >> 2;
    const size_t tb = (size_t)b * 4096;
    s16x8 qf[4];
    { const bf16* qp = Q + (tb + q0 + c) * 2048 + hq * 64 + hi * 8;
#pragma unroll
      for (int ks = 0; ks < 4; ++ks) qf[ks] = *(const s16x8*)(qp + ks * 16); }
    const float sink2 = sinks[hq] * 1.4426950408889634f;
    float m = sink2, l = (hi == 0) ? 1.f : 0.f;
    f32x16 o0, o1;
#pragma unroll
    for (int r = 0; r < 16; ++r) { o0[r] = 0.f; o1[r] = 0.f; }
    const bf16* kbase = K + tb * 512 + kvh * 64 + hi * 8 + (size_t)c * 512;
    const bf16* vbase = Vt + (size_t)(kvh * 64 + c) * 16384 + tb + 4 * hi;
    for (int kt = 0; kt < 9; ++kt) {
        const int key0 = q0 - 128 + 32 * kt;
        if (key0 < 0 || key0 >= 4096) continue;
        s16x8 kf[4]; s16x4 va[2][2][2];
#pragma unroll
        for (int ks = 0; ks < 4; ++ks) kf[ks] = *(const s16x8*)(kbase + (size_t)key0 * 512 + ks * 16);
#pragma unroll
        for (int db = 0; db < 2; ++db)
#pragma unroll
            for (int s = 0; s < 2; ++s) { const bf16* vp = vbase + (size_t)db * 32 * 16384 + key0 + 16 * s; va[db][s][0] = *(const s16x4*)vp; va[db][s][1] = *(const s16x4*)(vp + 8); }
        f32x16 sa;
#pragma unroll
        for (int r = 0; r < 16; ++r) sa[r] = 0.f;
#pragma unroll
        for (int ks = 0; ks < 4; ++ks) sa = __builtin_amdgcn_mfma_f32_32x32x16_bf16(kf[ks], qf[ks], sa, 0, 0, 0);
        if (kt == 0 || kt == 8) {
            const int dbase = key0 - (q0 + c) + 4 * hi;
#pragma unroll
            for (int r = 0; r < 16; ++r) { const int d = dbase + (r & 3) + 8 * (r >> 2); if (d < -128 || d > 128) sa[r] = -1e30f; }
        }
        float mx = sa[0];
#pragma unroll
        for (int r = 1; r < 16; ++r) mx = fmaxf(mx, sa[r]);
        { const auto rr = __builtin_amdgcn_permlane32_swap(__float_as_uint(mx), __float_as_uint(mx), false, false); mx = fmaxf(__uint_as_float(rr[0]), __uint_as_float(rr[1])); }
        const float mn = fmaxf(m, mx), alpha = __builtin_amdgcn_exp2f(m - mn);
        m = mn;
        float ps = 0.f;
#pragma unroll
        for (int r = 0; r < 16; ++r) { sa[r] = __builtin_amdgcn_exp2f(sa[r] - mn); ps += sa[r]; }
        l = l * alpha + ps;
#pragma unroll
        for (int r = 0; r < 16; ++r) { o0[r] *= alpha; o1[r] *= alpha; }
        s16x8 pf[2];
#pragma unroll
        for (int s = 0; s < 2; ++s) { v4u w; w.x = cvt_pk_bf16_(sa[8 * s + 0], sa[8 * s + 1]); w.y = cvt_pk_bf16_(sa[8 * s + 2], sa[8 * s + 3]); w.z = cvt_pk_bf16_(sa[8 * s + 4], sa[8 * s + 5]); w.w = cvt_pk_bf16_(sa[8 * s + 6], sa[8 * s + 7]);
            pf[s] = __builtin_bit_cast(s16x8, w); }
#pragma unroll
        for (int s = 0; s < 2; ++s) {
            const s16x8 v0 = __builtin_shufflevector(va[0][s][0], va[0][s][1], 0, 1, 2, 3, 4, 5, 6, 7), v1 = __builtin_shufflevector(va[1][s][0], va[1][s][1], 0, 1, 2, 3, 4, 5, 6, 7);
            o0 = __builtin_amdgcn_mfma_f32_32x32x16_bf16(v0, pf[s], o0, 0, 0, 0);
            o1 = __builtin_amdgcn_mfma_f32_32x32x16_bf16(v1, pf[s], o1, 0, 0, 0);
        }
    }
    { const auto rr = __builtin_amdgcn_permlane32_swap(__float_as_uint(l), __float_as_uint(l), false, false); l = __uint_as_float(rr[0]) + __uint_as_float(rr[1]); }
    const float il = 1.f / l;
    bf16* op = O + (tb + q0 + c) * 2048 + hq * 64 + 4 * hi;
#pragma unroll
    for (int g = 0; g < 4; ++g) {
        v2u w0, w1;
        w0.x = cvt_pk_bf16_(o0[4 * g + 0] * il, o0[4 * g + 1] * il); w0.y = cvt_pk_bf16_(o0[4 * g + 2] * il, o0[4 * g + 3] * il);
        w1.x = cvt_pk_bf16_(o1[4 * g + 0] * il, o1[4 * g + 1] * il); w1.y = cvt_pk_bf16_(o1[4 * g + 2] * il, o1[4 * g + 3] * il);
        *(v2u*)(op + 8 * g) = w0; *(v2u*)(op + 32 + 8 * g) = w1;
    }
}
enum { PH_PRO = 0, PH_G1 = 1, PH_G2 = 2, PH_G3 = 3, PH_Q0 = 4, PH_PE0 = 5, PH_QKV = 6, PH_ATT = 7, PH_WO = 8, PH_Q1 = 9, PH_PE1 = 10, PH_END = 11 };
__global__ void __launch_bounds__(NWAVES * 64, 2) mega(Args a) {
    extern __shared__ __attribute__((aligned(16))) unsigned char lds_raw[];
    LAS unsigned char* lds = (LAS unsigned char*)lds_raw;
    cg::grid_group grid = cg::this_grid();
    const int tid = threadIdx.x, lane = tid & 63, wave = __builtin_amdgcn_readfirstlane(tid >> 6);
    const int G = gridDim.x, bx = blockIdx.x;
    unsigned char* ws = a.ws;
    const int lo = a.ph_lo, hi = a.ph_hi;
#define IN(k) (lo <= (k) && (k) < hi)
#define SEAM(k) do { if (IN(k) && IN((k) + 1)) grid.sync(); } while (0)
    if (IN(PH_PRO)) {
        const int gw = bx * NWAVES + wave, NGW = G * NWAVES;
        const size_t gtid = (size_t)bx * (NWAVES * 64) + tid, ngt = (size_t)G * NWAVES * 64;
        LAS float* scr = (LAS float*)(lds + wave * 16384);
        {
            constexpr int I_SQ = (DM / 64) * (DM / 32), I_QKV = (DM / 64) * (QKVW / 32);
            constexpr int NITEMS = 4 * I_SQ + I_QKV;
            for (int it = gw; it < NITEMS; it += NGW) {
                int r = it;
                if (r < I_SQ) { transpose_item<0>(a.in[3], DM, DM, nullptr, (bf16*)(ws + WS_WOF), scr, r, lane); continue; } r -= I_SQ;
                if (r < I_SQ) { transpose_item<0>(a.in[5], DM, DM, nullptr, (bf16*)(ws + WS_WOA), scr, r, lane); continue; } r -= I_SQ;
                if (r < I_SQ) { transpose_item<0>(a.in[7], DM, DM, a.in[2], (bf16*)(ws + WS_WQ0), scr, r, lane); continue; } r -= I_SQ;
                if (r < I_SQ) { transpose_item<0>(a.in[7] + (size_t)DM * DM, DM, DM, a.in[2] + DM, (bf16*)(ws + WS_WQ1), scr, r, lane); continue; } r -= I_SQ;
                transpose_item<1>(a.in[4], DM, QKVW, a.in[1] + DM, (bf16*)(ws + WS_WQKV), scr, r, lane);
            }
        }
        for (int row = gw; row < T; row += NGW) {
            const f32x4* xr = (const f32x4*)(a.in[0] + (size_t)row * DM) + lane;
            const f32x4* gr = (const f32x4*)a.in[1] + lane;
            f32x4 v[8]; float s = 0.f;
#pragma unroll
            for (int j = 0; j < 8; ++j) { v[j] = xr[64 * j]; s += (v[j][0] * v[j][0] + v[j][1] * v[j][1]) + (v[j][2] * v[j][2] + v[j][3] * v[j][3]); }
            const float r = rsqrtf(wsum(s) * (1.f / DM) + EPS);
            const int b = row >> 12, sp = row & 4095;
#pragma unroll
            for (int j = 0; j < 8; ++j) { const f32x4 gg = gr[64 * j]; v2u o; o.x = pk2(v[j][0] * r * gg[0], v[j][1] * r * gg[1]); o.y = pk2(v[j][2] * r * gg[2], v[j][3] * r * gg[3]);
                *(v2u*)((bf16*)(ws + WS_XG) + ((size_t)((b * 8 + j) * 4096 + sp) * 256 + 4 * lane)) = o; }
        }
        for (size_t i = gtid; i < (size_t)4096 * 8192 / 8; i += ngt) {
            const int k = (int)(i >> 10), c0 = (int)(i & 1023) * 8, part = c0 >> 12, s0 = c0 & 4095;
            float v[8];
#pragma unroll
            for (int e = 0; e < 8; ++e) { const int m = (k * (s0 + e)) & 4095; const float rev = (float)m * (1.f / 4096.f); v[e] = (part ? __builtin_amdgcn_sinf(rev) : __builtin_amdgcn_cosf(rev)) * (1.f / 64.f); }
            v4u o; o.x = pk2(v[0], v[1]); o.y = pk2(v[2], v[3]); o.z = pk2(v[4], v[5]); o.w = pk2(v[6], v[7]);
            *(v4u*)((bf16*)(ws + WS_CS) + i * 8) = o;
        }
        for (size_t i = gtid; i < (size_t)512 * 256 / 8; i += ngt) {
            const int n = (int)(i >> 5), c0 = (int)(i & 31) * 8, part = n >> 8, l = n & 255;
            float v[8];
#pragma unroll
            for (int e = 0; e < 8; ++e) { const int m = (l * (c0 + e)) & 255; const float rev = (float)m * (1.f / 256.f); v[e] = (part ? -__builtin_amdgcn_sinf(rev) : __builtin_amdgcn_cosf(rev)) * (1.f / 16.f); }
            v4u o; o.x = pk2(v[0], v[1]); o.y = pk2(v[2], v[3]); o.z = pk2(v[4], v[5]); o.w = pk2(v[6], v[7]);
            *(v4u*)((bf16*)(ws + WS_WCS) + i * 8) = o;
        }
        for (size_t i = gtid; i < (size_t)4096 * 32; i += ngt) {
            const int pos = (int)(i >> 5), fi = (int)(i & 31);
            const double inv = exp2(-(double)fi * (13.287712379549449 / 32.0));
            double sn, cs; sincos((double)pos * inv, &sn, &cs);
            ((float*)(ws + WS_ROPE))[2 * i] = (float)cs; ((float*)(ws + WS_ROPE))[2 * i + 1] = (float)sn;
        }
        cvt_stream(a.in[9], (bf16*)(ws + WS_U0), (size_t)NEXP * DM / 8, gtid, ngt);
        cvt_stream(a.in[10], (bf16*)(ws + WS_V0), (size_t)NEXP * DM / 8, gtid, ngt);
        cvt_stream(a.in[9] + (size_t)NEXP * DM, (bf16*)(ws + WS_U1), (size_t)NEXP * DM / 8, gtid, ngt);
        cvt_stream(a.in[10] + (size_t)NEXP * DM, (bf16*)(ws + WS_V1), (size_t)NEXP * DM / 8, gtid, ngt);
        cvt_stream(a.in[8], (bf16*)(ws + WS_KEYS), (size_t)2 * PH * 2 * 128 * 128 / 8, gtid, ngt);
    }
    SEAM(PH_PRO);
    if (IN(PH_G1)) {
        int Kq = FW; asm volatile("" : "+s"(Kq));
        pg8::Gemm g{(const pg8::bf16_t*)(ws + WS_WCS), (const pg8::bf16_t*)(ws + WS_XG), 512, T * FG, Kq}; pg8::StaticOrder S; S.init(512, T * FG, G, bx);
        pg8::EpiZt E{(pg8::bf16_t*)(ws + WS_ZT)};
        pg8::gemm_phase<pg8::EpiZt, pg8::StaticOrder, true, true>(lds, g, S, E);
    }
    SEAM(PH_G1);
    if (IN(PH_G2)) {
        pg8::Gemm g{(const pg8::bf16_t*)(ws + WS_CS), (const pg8::bf16_t*)(ws + WS_ZT), 4096, 8192, 8192}; pg8::StaticOrder S; S.init(4096, 8192, G, bx);
        pg8::EpiY E{(pg8::bf16_t*)(ws + WS_Y)};
        pg8::gemm_phase<pg8::EpiY, pg8::StaticOrder, true, true>(lds, g, S, E);
    }
    SEAM(PH_G2);
    if (IN(PH_G3)) {
        pg8::Gemm g{(const pg8::bf16_t*)(ws + WS_Y), (const pg8::bf16_t*)(ws + WS_WOF), T, DM, DM}; pg8::StaticOrder S; S.init(T, DM, G, bx);
        pg8::EpiRes E{a.in[0], a.out, (pg8::bf16_t*)(ws + WS_XB), (float*)(ws + WS_SSQ_A)};
        pg8::gemm_phase<pg8::EpiRes, pg8::StaticOrder, true, true>(lds, g, S, E);
    }
    SEAM(PH_G3);
#define PEER_LAYER(L) do { \
        const int pq = L ? PH_Q1 : PH_Q0, ppe = L ? PH_PE1 : PH_PE0; \
        if (IN(pq)) { \
            pg8::Gemm g{(const pg8::bf16_t*)(ws + WS_XB), (const pg8::bf16_t*)(ws + (L ? WS_WQ1 : WS_WQ0)), T, DM, DM}; pg8::StaticOrder S; S.init(T, DM, G, bx); \
            pg8::EpiScale E{(pg8::bf16_t*)(ws + WS_Q), (const float*)(ws + (L ? WS_SSQ_C : WS_SSQ_A))}; \
            pg8::gemm_phase<pg8::EpiScale, pg8::StaticOrder, true, true>(lds, g, S, E); \
        } \
        SEAM(pq); \
        if (IN(ppe)) { \
            const bf16* keys = (const bf16*)(ws + WS_KEYS) + (size_t)L * PH * 2 * 128 * 128; \
            for (int u = bx; u < T / 32; u += G) topk_unit((const bf16*)(ws + WS_Q), keys, (int*)(ws + WS_EI), (float*)(ws + WS_GW), u * 32, wave, lane); \
            __syncthreads(); \
            for (int u = bx; u < T / 32; u += G) \
                for (int i = 0; i < 4; ++i) \
                    peer_token(a.out, a.in[2] + L * DM, (const int*)(ws + WS_EI), (const float*)(ws + WS_GW), (const bf16*)(ws + (L ? WS_U1 : WS_U0)), (const bf16*)(ws + (L ? WS_V1 : WS_V0)), \
                               (bf16*)(ws + WS_XB), (float*)(ws + WS_SSQ_B), L ? a.in[11] : nullptr, u * 32 + wave * 4 + i, lane); \
        } \
    } while (0)
    PEER_LAYER(0);
    SEAM(PH_PE0);
    if (IN(PH_QKV)) {
        {
            pg8::Gemm g{(const pg8::bf16_t*)(ws + WS_XB), (const pg8::bf16_t*)(ws + WS_WQKV), T, 2560, DM}; pg8::StaticOrder S; S.init(T, 2560, G, bx);
            pg8::EpiQK E{(pg8::bf16_t*)(ws + WS_QB), (pg8::bf16_t*)(ws + WS_KB), (const float*)(ws + WS_SSQ_B), (const float*)(ws + WS_ROPE), 0.125f * 1.4426950408889634f};
            pg8::gemm_phase<pg8::EpiQK, pg8::StaticOrder, true, true>(lds, g, S, E);
        }
        if (bx >= G / 2) {
            pg8::Gemm g{(const pg8::bf16_t*)(ws + WS_WQKV) + (size_t)2560 * DM, (const pg8::bf16_t*)(ws + WS_XB), 512, T, DM}; pg8::StaticOrder S; S.init(512, T, G / 2, bx - G / 2);
            pg8::EpiVt E{(pg8::bf16_t*)(ws + WS_VT), (const float*)(ws + WS_SSQ_B)};
            pg8::gemm_phase<pg8::EpiVt, pg8::StaticOrder, true, true>(lds, g, S, E);
        }
    }
    SEAM(PH_QKV);
    if (IN(PH_ATT)) {
        for (int vb = bx; vb < 256; vb += G) {
        const int bkv = vb >> 3, chunk = vb & 7, b = bkv >> 3, kvh = bkv & 7;
        for (int i = 0; i < 8; ++i)
            attn_task((const bf16*)(ws + WS_QB), (const bf16*)(ws + WS_KB), (const bf16*)(ws + WS_VT), (bf16*)(ws + WS_O), a.in[6], b, kvh * 4 + (wave & 3), (chunk * 8 + i) * 64 + (wave >> 2) * 32, lane);
        }
    }
    SEAM(PH_ATT);
    if (IN(PH_WO)) {
        pg8::Gemm g{(const pg8::bf16_t*)(ws + WS_O), (const pg8::bf16_t*)(ws + WS_WOA), T, DM, DM}; pg8::StaticOrder S; S.init(T, DM, G, bx);
        pg8::EpiRes E{a.out, a.out, (pg8::bf16_t*)(ws + WS_XB), (float*)(ws + WS_SSQ_C)};
        pg8::gemm_phase<pg8::EpiRes, pg8::StaticOrder, true, true>(lds, g, S, E);
    }
    SEAM(PH_WO);
    PEER_LAYER(1);
#undef PEER_LAYER
#undef SEAM
#undef IN
}

#ifndef N_LAUNCHES
#define N_LAUNCHES 1
#endif
extern "C" void kernel_launch(void* const* d_in, const int* in_sizes, int n_in, void* d_out, int out_size, void* d_ws, size_t ws_size, hipStream_t stream) {
    static int grid = 0;
    if (!grid) {
        if (hipFuncSetAttribute((const void*)mega, hipFuncAttributeMaxDynamicSharedMemorySize, LDS_BYTES) != hipSuccess) { fprintf(stderr, "hipFuncSetAttribute failed\n"); }
        int dev = 0, cus = 0, per_cu = 0;
        (void)hipGetDevice(&dev);
        (void)hipDeviceGetAttribute(&cus, hipDeviceAttributeMultiprocessorCount, dev);
        if (hipOccupancyMaxActiveBlocksPerMultiprocessor(&per_cu, (const void*)mega, NWAVES * 64, LDS_BYTES) != hipSuccess) per_cu = 0;
        (void)hipGetLastError();
        grid = cus * per_cu;
        if (grid > 256) grid = 256;
        grid &= ~1;
        if (grid < 2) { fprintf(stderr, "occupancy query gave %d x %d\n", cus, per_cu); grid = -1; }
    }
    if (grid < 0) return;
    if (ws_size < 700 * MiB) { fprintf(stderr, "ws too small: %zu\n", ws_size); return; }
    (void)hipMemsetAsync((char*)d_ws + WS_CTL, 0, CTL_BYTES, stream);
    Args a{};
    for (int i = 0; i < 12; ++i) a.in[i] = (const float*)d_in[i];
    a.out = (float*)d_out; a.ws = (unsigned char*)d_ws;
    if (N_LAUNCHES == 1) {
        a.ph_lo = 0; a.ph_hi = PH_END;
        void* args[] = {&a};
        const hipError_t e = hipLaunchCooperativeKernel((const void*)mega, dim3(grid), dim3(NWAVES * 64), args, LDS_BYTES, stream);
        if (e != hipSuccess) fprintf(stderr, "cooperative launch failed: %s (grid %d)\n", hipGetErrorString(e), grid);
    } else {
        for (int ph = 0; ph < PH_END; ++ph) {
            a.ph_lo = ph; a.ph_hi = ph + 1;
            hipLaunchKernelGGL(mega, dim3(grid), dim3(NWAVES * 64), LDS_BYTES, stream, a);
        }
    }
}
```

```cpp
#include <hip/hip_runtime.h>
#include <hip/hip_cooperative_groups.h>
namespace cg = cooperative_groups;
#include <cstdio>
#include <cstdint>
#include <cmath>

constexpr int DM = 2048, NB = 4, SEQ = 4096, T = NB * SEQ;
constexpr int FG = 8, FW = 256;
constexpr int HD = 64, NQH = 32, NKVH = 8, QKVW = 3072;
constexpr int PH = 8, NKEYS = 128, NEXP = 16384, PTOPK = 16;
constexpr float EPS = 1e-6f;
namespace pg8 {
#define PG8_LAS __attribute__((address_space(3)))
typedef unsigned short bf16_t;
typedef short bf16x8 __attribute__((ext_vector_type(8)));
typedef float f32x4 __attribute__((ext_vector_type(4)));
typedef unsigned u32x4 __attribute__((ext_vector_type(4)));
constexpr int BM = 256, BK = 64, HALF = 128, HTB = HALF * BK * 2  , STAGE_BYTES = 8 * HTB, NXCD = 8, WGM = 8;

__host__ __device__ __forceinline__ int lds_byte(int r, int c) { const int st = (r >> 4) * 2 + (c >> 5), rr = r & 15, cc = c & 31, ob = rr * 64 + cc * 2; return st * 1024 + (ob ^ (((ob >> 9) & 1) << 5)); }
__host__ __device__ __forceinline__ void stage_rc(int b, int& R, int& C) { const int st = b / 1024, sb = b % 1024, swz = sb ^ (((sb >> 9) & 1) << 5); R = (st >> 1) * 16 + swz / 64; C = (st & 1) * 32 + (swz % 64) / 2; }
__host__ __device__ __forceinline__ int perm32(int rho) { const int n = rho >> 4, i = rho & 15; return 8 * (i >> 2) + 4 * n + (i & 3); }

struct Unit { int pm, pn; };
struct Gemm { const bf16_t* A; const bf16_t* Bt; int M, N, K; };

struct StaticOrder {
    int nM, nN, nwg, G, c;
    __host__ __device__ void init(int M, int N, int G_, int c_) { nM = M / BM; nN = N / BM; nwg = nM * nN; G = G_; c = c_; }
    __host__ __device__ bool next(int i, Unit& u) const {
        const long L = (long)i * G + c; if (L >= nwg) return false;
        int wgid = (int)L; { const int q = nwg / NXCD, r = nwg % NXCD, xcd = wgid % NXCD, off = wgid / NXCD; wgid = (xcd < r ? xcd * (q + 1) : r * (q + 1) + (xcd - r) * q) + off; }
        const int nig = WGM * nN, gid = wgid / nig, fm = gid * WGM, gsz = (nM - fm) < WGM ? (nM - fm) : WGM;
        u.pm = fm + ((wgid % nig) % gsz); u.pn = (wgid % nig) / gsz; return true;
    }
    __device__ __forceinline__ void a_ready(const Unit&) const {}
    __device__ __forceinline__ void done(const Unit&) const {}
};

__device__ __forceinline__ unsigned cvt_pk_bf16(float lo, float hi) { unsigned r; asm volatile("v_cvt_pk_bf16_f32 %0, %1, %2" : "=v"(r) : "v"(lo), "v"(hi)); return r; }
typedef float f32x2 __attribute__((ext_vector_type(2)));
__device__ __forceinline__ u32x4 pack8(const f32x4 v0, const f32x4 v1) { u32x4 w; w.x = cvt_pk_bf16(v0[0], v0[1]); w.y = cvt_pk_bf16(v0[2], v0[3]); w.z = cvt_pk_bf16(v1[0], v1[1]); w.w = cvt_pk_bf16(v1[2], v1[3]); return w; }
struct EpiZt {
    static constexpr bool PERM = true, AFTER_DRAIN = false; bf16_t* Zt;
    __device__ __forceinline__ void operator()(const f32x4 (&acc)[2][2][4][2], const Unit& u, int wr, int wc, int fr, int fq) const {
        const int part = u.pm, j0 = u.pn * BM, bg = j0 >> 12, s0 = (j0 & 4095) + wc * 32 + 8 * fq;
        bf16_t* base = Zt + ((size_t)(bg * 256 + wr * 64 + fr) * 8192 + part * 4096 + s0);
#pragma unroll
        for (int ai = 0; ai < 2; ++ai)
#pragma unroll
            for (int m = 0; m < 4; ++m)
#pragma unroll
                for (int bj = 0; bj < 2; ++bj) *(u32x4*)(base + (ai * HALF + m * 16) * 8192 + bj * HALF) = pack8(acc[ai][bj][m][0], acc[ai][bj][m][1]);
    }
};
struct EpiY {
    static constexpr bool PERM = true, AFTER_DRAIN = false; bf16_t* Y;
    __device__ __forceinline__ void operator()(const f32x4 (&acc)[2][2][4][2], const Unit& u, int wr, int wc, int fr, int fq) const {
        const int bg = u.pn, b = bg >> 3, g = bg & 7;
        bf16_t* base = Y + ((size_t)(b * 4096 + u.pm * BM + wr * 64 + fr) * 2048 + g * 256 + wc * 32 + 8 * fq);
#pragma unroll
        for (int ai = 0; ai < 2; ++ai)
#pragma unroll
            for (int m = 0; m < 4; ++m)
#pragma unroll
                for (int bj = 0; bj < 2; ++bj) *(u32x4*)(base + (ai * HALF + m * 16) * 2048 + bj * HALF) = pack8(acc[ai][bj][m][0], acc[ai][bj][m][1]);
    }
};
struct EpiRes {
    static constexpr bool PERM = true, AFTER_DRAIN = false; const float* R; float* out; bf16_t* xb; float* ssq;
    __device__ __forceinline__ void operator()(const f32x4 (&acc)[2][2][4][2], const Unit& u, int wr, int wc, int fr, int fq) const {
        const int row0 = u.pm * BM + wr * 64 + fr; const size_t off0 = (size_t)row0 * 2048 + u.pn * BM + wc * 32 + 8 * fq;
        const float* Rb = R + off0; float* Ob = out + off0; bf16_t* Xb = xb + off0; float* Sb = ssq + row0;
#pragma unroll
        for (int ai = 0; ai < 2; ++ai)
#pragma unroll
            for (int m = 0; m < 4; ++m) { const int ro = (ai * HALF + m * 16) * 2048; float ss = 0.f;
#pragma unroll
                for (int bj = 0; bj < 2; ++bj) {
                    const f32x4 r0 = *(const f32x4*)(Rb + ro + bj * HALF), r1 = *(const f32x4*)(Rb + ro + bj * HALF + 4);
                    const f32x4 o0 = acc[ai][bj][m][0] + r0, o1 = acc[ai][bj][m][1] + r1;
                    *(f32x4*)(Ob + ro + bj * HALF) = o0; *(f32x4*)(Ob + ro + bj * HALF + 4) = o1;
                    *(u32x4*)(Xb + ro + bj * HALF) = pack8(o0, o1);
                    ss += (o0[0] * o0[0] + o0[1] * o0[1]) + (o0[2] * o0[2] + o0[3] * o0[3]) + (o1[0] * o1[0] + o1[1] * o1[1]) + (o1[2] * o1[2] + o1[3] * o1[3]); }
                ss += __shfl_xor(ss, 16); ss += __shfl_xor(ss, 32);
                if (fq == 0) unsafeAtomicAdd(Sb + ai * HALF + m * 16, ss);
                asm volatile("" ::: "memory"); }
    }
};
struct EpiScale {
    static constexpr bool PERM = true, AFTER_DRAIN = false; bf16_t* O; const float* ssq;
    __device__ __forceinline__ void operator()(const f32x4 (&acc)[2][2][4][2], const Unit& u, int wr, int wc, int fr, int fq) const {
        const int row0 = u.pm * BM + wr * 64 + fr;
        bf16_t* base = O + ((size_t)row0 * 2048 + u.pn * BM + wc * 32 + 8 * fq); const float* Sb = ssq + row0;
#pragma unroll
        for (int ai = 0; ai < 2; ++ai)
#pragma unroll
            for (int m = 0; m < 4; ++m) { const float rs = rsqrtf(Sb[ai * HALF + m * 16] * (1.f / 2048.f) + 1e-6f);
#pragma unroll
                for (int bj = 0; bj < 2; ++bj) *(u32x4*)(base + (ai * HALF + m * 16) * 2048 + bj * HALF) = pack8(acc[ai][bj][m][0] * rs, acc[ai][bj][m][1] * rs); }
    }
};
struct EpiQK {
    static constexpr bool PERM = true, AFTER_DRAIN = false; bf16_t* Q; bf16_t* K; const float* ssq; const float* rope; float qscale;
    __device__ __forceinline__ void operator()(const f32x4 (&acc)[2][2][4][2], const Unit& u, int wr, int wc, int fr, int fq) const {
        const int row0 = u.pm * BM + wr * 64 + fr; const bool isq = u.pn < 8;
        const int cl = wc * 32 + 8 * fq;
        bf16_t* base = isq ? (Q + ((size_t)row0 * 2048 + u.pn * BM + cl)) : (K + ((size_t)row0 * 512 + (u.pn - 8) * BM + cl));
        const int ld = isq ? 2048 : 512; const float sc = isq ? qscale : 1.f;
        const float* rp = rope + (size_t)(row0 & 4095) * 64 + (cl & 63);
        const float* Sb = ssq + row0;
#pragma unroll
        for (int ai = 0; ai < 2; ++ai)
#pragma unroll
            for (int m = 0; m < 4; ++m) { const int ro = ai * HALF + m * 16; const float rs = rsqrtf(Sb[ro] * (1.f / 2048.f) + 1e-6f) * sc;
                const f32x4 t0 = *(const f32x4*)(rp + (size_t)ro * 64), t1 = *(const f32x4*)(rp + (size_t)ro * 64 + 4);
#pragma unroll
                for (int bj = 0; bj < 2; ++bj) {
                    const f32x4 a = acc[ai][bj][m][0] * rs, b = acc[ai][bj][m][1] * rs; f32x4 oa, ob;
                    oa[0] = a[0] * t0[0] - a[1] * t0[1]; oa[1] = a[1] * t0[0] + a[0] * t0[1]; oa[2] = a[2] * t0[2] - a[3] * t0[3]; oa[3] = a[3] * t0[2] + a[2] * t0[3];
                    ob[0] = b[0] * t1[0] - b[1] * t1[1]; ob[1] = b[1] * t1[0] + b[0] * t1[1]; ob[2] = b[2] * t1[2] - b[3] * t1[3]; ob[3] = b[3] * t1[2] + b[2] * t1[3];
                    *(u32x4*)(base + (size_t)ro * ld + bj * HALF) = pack8(oa, ob); } }
    }
};
struct EpiVt {
    static constexpr bool PERM = true, AFTER_DRAIN = false; bf16_t* Vt; const float* ssq;
    __device__ __forceinline__ void operator()(const f32x4 (&acc)[2][2][4][2], const Unit& u, int wr, int wc, int fr, int fq) const {
        const int col0 = u.pn * BM + wc * 32 + 8 * fq;
        bf16_t* base = Vt + ((size_t)(u.pm * BM + wr * 64 + fr) * 16384 + col0);
        f32x4 r0[2], r1[2];
#pragma unroll
        for (int bj = 0; bj < 2; ++bj) { const f32x4 s0 = *(const f32x4*)(ssq + col0 + bj * HALF), s1 = *(const f32x4*)(ssq + col0 + bj * HALF + 4);
#pragma unroll
            for (int q = 0; q < 4; ++q) { r0[bj][q] = rsqrtf(s0[q] * (1.f / 2048.f) + 1e-6f); r1[bj][q] = rsqrtf(s1[q] * (1.f / 2048.f) + 1e-6f); } }
#pragma unroll
        for (int ai = 0; ai < 2; ++ai)
#pragma unroll
            for (int m = 0; m < 4; ++m)
#pragma unroll
                for (int bj = 0; bj < 2; ++bj) *(u32x4*)(base + (size_t)(ai * HALF + m * 16) * 16384 + bj * HALF) = pack8(acc[ai][bj][m][0] * r0[bj], acc[ai][bj][m][1] * r1[bj]);
    }
};
template <class Epi, class Sched, bool ALIGN_EPI = false, bool SP2 = false>
__device__ __forceinline__ void gemm_phase(PG8_LAS unsigned char* lds, const Gemm g, const Sched& S, const Epi& E) {
    const int tid = threadIdx.x, wid = __builtin_amdgcn_readfirstlane(tid >> 6), lane = tid & 63, wr = wid >> 2, wc = wid & 3, fr = lane & 15, fq = lane >> 4;
    const int K = g.K, nt = K / BK;
    unsigned voffA[2], voffB[2];
#pragma unroll
    for (int i = 0; i < 2; ++i) { int R, C; stage_rc(tid * 16 + i * 8192, R, C); const int Rb = Epi::PERM ? ((R & ~31) + perm32(R & 31)) : R;
        voffA[i] = (unsigned)(R * K + C) * 2u; voffB[i] = (unsigned)(Rb * K + C) * 2u; }
    const size_t kstep = (size_t)(BK * 2);
    const size_t hstep = (size_t)HALF * K * 2;
    const size_t tstep = 2 * hstep;
    const unsigned ldsw = (unsigned)wid * 1024u;
    const int aoff = lds_byte(wr * 64 + fr, fq * 8), boff = lds_byte(wc * 32 + fr, fq * 8);
#define PG8_SA(b, h) (((b) * 2 + (h)) * HTB)
#define PG8_SB(b, h) ((4 + (b) * 2 + (h)) * HTB)
#define PG8_STAGE(bufoff, gbase, voff) do { _Pragma("unroll") for (int _i = 0; _i < 2; ++_i) \
        __builtin_amdgcn_global_load_lds((const unsigned*)((const char*)(gbase) + (voff)[_i]), (PG8_LAS unsigned*)(lds + (bufoff) + ldsw + _i * 8192), 16, 0, 0); } while (0)
#define PG8_LDA(dst, b, h) do { _Pragma("unroll") for (int m = 0; m < 4; ++m) _Pragma("unroll") for (int k = 0; k < 2; ++k) dst[m][k] = *(const PG8_LAS bf16x8*)(lds + PG8_SA(b, h) + aoff + m * 2048 + k * 1024); } while (0)
#define PG8_LDB(dst, b, h) do { _Pragma("unroll") for (int n = 0; n < 2; ++n) _Pragma("unroll") for (int k = 0; k < 2; ++k) dst[n][k] = *(const PG8_LAS bf16x8*)(lds + PG8_SB(b, h) + boff + n * 2048 + k * 1024); } while (0)
#define PG8_MMA(ai, bj, At, Bt) do { __builtin_amdgcn_s_setprio(1); _Pragma("unroll") for (int m = 0; m < 4; ++m) _Pragma("unroll") for (int n = 0; n < 2; ++n) _Pragma("unroll") for (int k = 0; k < 2; ++k) \
        acc[ai][bj][m][n] = __builtin_amdgcn_mfma_f32_16x16x32_bf16(Bt[n][k], At[m][k], acc[ai][bj][m][n], 0, 0, 0); __builtin_amdgcn_s_setprio(0); } while (0)
#define PG8_WAIT_V(n) asm volatile("s_waitcnt vmcnt(" #n ")" ::: "memory")
#define PG8_WAIT_L(n) asm volatile("s_waitcnt lgkmcnt(" #n ")" ::: "memory")
#define PG8_BAR __builtin_amdgcn_s_barrier()
#define PG8_SCHED __builtin_amdgcn_sched_barrier(0)
    Unit cur, nxt; int ui = 0;
    if (!S.next(0, cur)) return;
    f32x4 acc[2][2][4][2];
#pragma unroll
    for (int a = 0; a < 2; ++a)
#pragma unroll
        for (int b = 0; b < 2; ++b)
#pragma unroll
            for (int m = 0; m < 4; ++m)
#pragma unroll
                for (int n = 0; n < 2; ++n) acc[a][b][m][n] = (f32x4){0.f, 0.f, 0.f, 0.f};
    bf16x8 At[4][2], B0[2][2], B1[2][2];
    const char* cA = (const char*)g.A + (size_t)cur.pm * tstep; const char* cB = (const char*)g.Bt + (size_t)cur.pn * tstep;
    S.a_ready(cur);
    if constexpr (SP2) {
        PG8_STAGE(PG8_SB(0, 0), cB, voffB); PG8_STAGE(PG8_SB(0, 1), cB + hstep, voffB); PG8_STAGE(PG8_SA(0, 0), cA, voffA); PG8_STAGE(PG8_SA(0, 1), cA + hstep, voffA);
        if (wr == 1) PG8_BAR;
        PG8_WAIT_V(2); PG8_BAR;
        PG8_STAGE(PG8_SB(1, 0), cB + kstep, voffB); PG8_STAGE(PG8_SA(1, 0), cA + kstep, voffA); PG8_STAGE(PG8_SB(1, 1), cB + hstep + kstep, voffB);
        PG8_WAIT_V(6); PG8_BAR;
    } else {
        PG8_STAGE(PG8_SB(0, 0), cB, voffB); PG8_STAGE(PG8_SA(0, 0), cA, voffA); PG8_STAGE(PG8_SB(0, 1), cB + hstep, voffB); PG8_STAGE(PG8_SA(0, 1), cA + hstep, voffA);
        if (wr == 1) PG8_BAR;
        PG8_WAIT_V(4); PG8_BAR;
        PG8_STAGE(PG8_SB(1, 0), cB + kstep, voffB); PG8_STAGE(PG8_SA(1, 0), cA + kstep, voffA); PG8_STAGE(PG8_SB(1, 1), cB + hstep + kstep, voffB);
        PG8_WAIT_V(6); PG8_BAR;
    }
    for (;;) {
        const bool has_next = S.next(ui + 1, nxt);
        const char* nA = has_next ? (const char*)g.A + (size_t)nxt.pm * tstep : cA; const char* nB = has_next ? (const char*)g.Bt + (size_t)nxt.pn * tstep : cB;
        for (int t = 0; t < nt; t += 2) {
            const bool last = (t == nt - 2);
            const char* a1 = cA + (size_t)(t + 1) * kstep;
            const char* a2 = last ? nA : cA + (size_t)(t + 2) * kstep; const char* b2 = last ? nB : cB + (size_t)(t + 2) * kstep;
            const char* a3 = a2 + kstep; const char* b3 = b2 + kstep;
            if (last && has_next) S.a_ready(nxt);
            if constexpr (SP2) {
            PG8_LDB(B0, 0, 0); PG8_LDB(B1, 0, 1); PG8_SCHED; PG8_LDA(At, 0, 0); PG8_STAGE(PG8_SA(1, 1), a1 + hstep, voffA);
            PG8_WAIT_V(8); PG8_WAIT_L(0); PG8_BAR; PG8_MMA(0, 0, At, B0); PG8_MMA(0, 1, At, B1); PG8_BAR; PG8_SCHED;
            PG8_LDA(At, 0, 1); PG8_STAGE(PG8_SB(0, 0), b2, voffB); PG8_STAGE(PG8_SB(0, 1), b2 + hstep, voffB); PG8_STAGE(PG8_SA(0, 0), a2, voffA);
            PG8_WAIT_V(8); PG8_WAIT_L(0); PG8_BAR; PG8_MMA(1, 0, At, B0); PG8_MMA(1, 1, At, B1); PG8_BAR; PG8_SCHED;
            PG8_LDB(B0, 1, 0); PG8_LDB(B1, 1, 1); PG8_SCHED; PG8_LDA(At, 1, 0); PG8_STAGE(PG8_SA(0, 1), a2 + hstep, voffA);
            PG8_WAIT_V(8); PG8_WAIT_L(0); PG8_BAR; PG8_MMA(0, 0, At, B0); PG8_MMA(0, 1, At, B1); PG8_BAR; PG8_SCHED;
            PG8_LDA(At, 1, 1); PG8_STAGE(PG8_SB(1, 0), b3, voffB); PG8_STAGE(PG8_SB(1, 1), b3 + hstep, voffB); PG8_STAGE(PG8_SA(1, 0), a3, voffA);
            PG8_WAIT_V(8); PG8_WAIT_L(0); PG8_BAR; PG8_MMA(1, 0, At, B0); PG8_MMA(1, 1, At, B1); PG8_BAR; PG8_SCHED;
            } else {
            PG8_LDB(B0, 0, 0); PG8_SCHED; PG8_LDA(At, 0, 0); PG8_STAGE(PG8_SA(1, 1), a1 + hstep, voffA);
            PG8_WAIT_L(8); PG8_BAR; PG8_WAIT_L(0); PG8_MMA(0, 0, At, B0); PG8_BAR; PG8_SCHED;
            PG8_LDB(B1, 0, 1); PG8_STAGE(PG8_SB(0, 0), b2, voffB);
            PG8_BAR; PG8_WAIT_L(0); PG8_MMA(0, 1, At, B1); PG8_BAR;
            PG8_LDA(At, 0, 1); PG8_STAGE(PG8_SA(0, 0), a2, voffA);
            PG8_BAR; PG8_WAIT_L(0); PG8_MMA(1, 0, At, B0); PG8_BAR; PG8_SCHED;
            PG8_STAGE(PG8_SB(0, 1), b2 + hstep, voffB);
            PG8_WAIT_V(6); PG8_BAR; PG8_MMA(1, 1, At, B1); PG8_BAR;
            PG8_LDB(B0, 1, 0); PG8_SCHED; PG8_LDA(At, 1, 0); PG8_STAGE(PG8_SA(0, 1), a2 + hstep, voffA);
            PG8_WAIT_L(8); PG8_BAR; PG8_WAIT_L(0); PG8_MMA(0, 0, At, B0); PG8_BAR; PG8_SCHED;
            PG8_LDB(B1, 1, 1); PG8_STAGE(PG8_SB(1, 0), b3, voffB);
            PG8_BAR; PG8_WAIT_L(0); PG8_MMA(0, 1, At, B1); PG8_BAR;
            PG8_LDA(At, 1, 1); PG8_STAGE(PG8_SA(1, 0), a3, voffA);
            PG8_BAR; PG8_WAIT_L(0); PG8_MMA(1, 0, At, B0); PG8_BAR; PG8_SCHED;
            PG8_STAGE(PG8_SB(1, 1), b3 + hstep, voffB);
            PG8_WAIT_V(6); PG8_BAR; PG8_MMA(1, 1, At, B1); PG8_BAR;
            }
        }
        if constexpr (ALIGN_EPI) { if (wr == 0) PG8_BAR; }
        if constexpr (!Epi::AFTER_DRAIN) { E(acc, cur, wr, wc, fr, fq); S.done(cur); }
        if (!has_next) break;
#pragma unroll
        for (int a = 0; a < 2; ++a)
#pragma unroll
            for (int b = 0; b < 2; ++b)
#pragma unroll
                for (int m = 0; m < 4; ++m)
#pragma unroll
                    for (int n = 0; n < 2; ++n) acc[a][b][m][n] = (f32x4){0.f, 0.f, 0.f, 0.f};
        cur = nxt; cA = nA; cB = nB; ++ui;
        if constexpr (ALIGN_EPI) { if (wr == 1) PG8_BAR; }
    }
    PG8_WAIT_V(0);
    if constexpr (!ALIGN_EPI) { if (wr == 0) PG8_BAR; }
    PG8_BAR;
    if constexpr (Epi::AFTER_DRAIN) { E.fused(acc, cur, wr, wc, fr, fq, lds, wid, lane); S.done(cur); }
#undef PG8_SA
#undef PG8_SB
#undef PG8_STAGE
#undef PG8_LDA
#undef PG8_LDB
#undef PG8_MMA
#undef PG8_WAIT_V
#undef PG8_WAIT_L
#undef PG8_BAR
#undef PG8_SCHED
}
}
#define GAS __attribute__((address_space(1)))
#define LAS __attribute__((address_space(3)))
typedef unsigned short bf16;
typedef unsigned v4u __attribute__((ext_vector_type(4)));
typedef unsigned v2u __attribute__((ext_vector_type(2)));
typedef float f32x4 __attribute__((ext_vector_type(4)));
constexpr int NWAVES = 8;
constexpr int LDS_BYTES = 147456;
constexpr size_t MiB = 1u << 20;
constexpr size_t WS_CTL = 0, CTL_BYTES = 1 * MiB;
constexpr size_t WS_SSQ_A = 256 * 1024, WS_SSQ_B = 320 * 1024, WS_SSQ_C = 384 * 1024;
constexpr size_t WS_WCS = 1 * MiB, WS_ROPE = 2 * MiB, WS_KEYS = 3 * MiB;
constexpr size_t WS_WOF = 8 * MiB, WS_WQKV = 16 * MiB, WS_WOA = 28 * MiB, WS_WQ0 = 36 * MiB, WS_WQ1 = 44 * MiB;
constexpr size_t WS_CS = 64 * MiB;
constexpr size_t WS_U0 = 128 * MiB, WS_V0 = 192 * MiB, WS_U1 = 256 * MiB, WS_V1 = 320 * MiB;
constexpr size_t WS_XG = 384 * MiB, WS_XB = 384 * MiB;
constexpr size_t WS_ZT = 448 * MiB;
constexpr size_t WS_Y = 576 * MiB;
constexpr size_t WS_Q = 448 * MiB;
constexpr size_t WS_EI = 640 * MiB, WS_GW = 648 * MiB;
constexpr size_t WS_QB = 448 * MiB, WS_KB = 512 * MiB, WS_VT = 528 * MiB, WS_O = 576 * MiB;

__device__ __forceinline__ unsigned f2bf(float f) { unsigned u = __builtin_bit_cast(unsigned, f); return (u + 0x7fffu + ((u >> 16) & 1u)) >> 16; }
__device__ __forceinline__ unsigned pk2(float lo, float hi) { return f2bf(lo) | (f2bf(hi) << 16); }

struct Args { const float* in[12]; float* out; unsigned char* ws; int ph_lo, ph_hi; };

__device__ __forceinline__ int qkv_row(int n) { if (n >= 2560) return n; const int d = n & 63, pc = (d < 32) ? 2 * d : 2 * (d - 32) + 1; return (n & ~63) + pc; }
template <int MODE>
__device__ __forceinline__ void transpose_item(const float* W, int K, int N, const float* gain, bf16* WT, LAS float* scr, int item, int lane) {
    const int nblk = N / 32, kb = item / nblk, nb = item % nblk, k0 = 64 * kb, n0 = 32 * nb;
#pragma unroll 8
    for (int i = 0; i < 32; ++i) { const int kk = 2 * i + (lane >> 5); float v = W[(size_t)(k0 + kk) * N + n0 + (lane & 31)]; if (gain) v *= gain[k0 + kk]; scr[kk * 33 + (lane & 31)] = v; }
    asm volatile("s_waitcnt lgkmcnt(0)" ::: "memory");
    const int c = lane & 7;
#pragma unroll
    for (int j = 0; j < 4; ++j) { const int n = (lane >> 3) + 8 * j; const LAS float* s = scr + (8 * c) * 33 + n;
        v4u o; o.x = pk2(s[0 * 33], s[1 * 33]); o.y = pk2(s[2 * 33], s[3 * 33]); o.z = pk2(s[4 * 33], s[5 * 33]); o.w = pk2(s[6 * 33], s[7 * 33]);
        const int row = (MODE == 1) ? qkv_row(n0 + n) : (n0 + n);
        *(v4u*)(WT + (size_t)row * K + k0 + 8 * c) = o; }
    asm volatile("s_waitcnt lgkmcnt(0)" ::: "memory");
}
__device__ __forceinline__ float wsum(float v) {
#pragma unroll
    for (int o = 1; o < 64; o <<= 1) v += __shfl_xor(v, o);
    return v;
}
__device__ __forceinline__ void cvt_stream(const float* src, bf16* dst, size_t n8, size_t gtid, size_t ngt) {
    for (size_t i = gtid; i < n8; i += ngt) {
        const f32x4 a = *(const f32x4*)(src + i * 8), b = *(const f32x4*)(src + i * 8 + 4);
        v4u o; o.x = pk2(a[0], a[1]); o.y = pk2(a[2], a[3]); o.z = pk2(b[0], b[1]); o.w = pk2(b[2], b[3]);
        *(v4u*)(dst + i * 8) = o;
    }
}
__device__ __forceinline__ void cvt_stream8(const float* src, unsigned char* dst, size_t n16, size_t gtid, size_t ngt, float scale) {
    for (size_t i = gtid; i < n16; i += ngt) {
        v4u o;
#pragma unroll
        for (int q = 0; q < 4; ++q) { f32x4 a = *(const f32x4*)(src + i * 16 + 4 * q) * scale;
#pragma unroll
            for (int e = 0; e < 4; ++e) a[e] = fminf(fmaxf(a[e], -448.f), 448.f);
            int w = 0; w = __builtin_amdgcn_cvt_pk_fp8_f32(a[0], a[1], w, false); w = __builtin_amdgcn_cvt_pk_fp8_f32(a[2], a[3], w, true); o[q] = (unsigned)w; }
        *(v4u*)(dst + i * 16) = o;
    }
}
typedef float f32x16 __attribute__((ext_vector_type(16)));
typedef short s16x8 __attribute__((ext_vector_type(8)));
typedef __bf16 bf16x2_t __attribute__((ext_vector_type(2)));
__device__ __forceinline__ unsigned ordf(float f) { const unsigned u = __float_as_uint(f); return (u & 0x80000000u) ? ~u : (u | 0x80000000u); }
__device__ __forceinline__ float unordf(unsigned u) { return __uint_as_float((u & 0x80000000u) ? (u & 0x7fffffffu) : ~u); }
__device__ __forceinline__ unsigned umax_(unsigned a, unsigned b) { return a > b ? a : b; }
#define DPPU(v, ctrl) ((unsigned)__builtin_amdgcn_update_dpp(0, (int)(v), (ctrl), 0xf, 0xf, true))
#define DPPF(v, ctrl) __int_as_float(__builtin_amdgcn_update_dpp(0, __float_as_int(v), (ctrl), 0xf, 0xf, true))
__device__ __forceinline__ unsigned max32(unsigned v) {
    v = umax_(v, DPPU(v, 0xB1)); v = umax_(v, DPPU(v, 0x4E)); v = umax_(v, DPPU(v, 0x141)); v = umax_(v, DPPU(v, 0x140));
    const auto r = __builtin_amdgcn_permlane16_swap(v, v, false, false);
    return umax_(r[0], r[1]);
}
__device__ __forceinline__ float sum16(float v) {
    v += DPPF(v, 0xB1); v += DPPF(v, 0x4E); v += DPPF(v, 0x141); v += DPPF(v, 0x140); return v;
}
__device__ __forceinline__ unsigned bperm(unsigned v, int srclane) { return (unsigned)__builtin_amdgcn_ds_bpermute(srclane << 2, (int)v); }
__device__ __forceinline__ unsigned top16_of4(unsigned p0, unsigned p1, unsigned p2, unsigned p3, int c15) {
    unsigned W = 0u;
    for (int it = 0; it < 16; ++it) {
        const unsigned m = max32(umax_(umax_(p0, p1), umax_(p2, p3)));
        W = (c15 == it) ? m : W;
        p0 = (p0 == m) ? 0u : p0; p1 = (p1 == m) ? 0u : p1; p2 = (p2 == m) ? 0u : p2; p3 = (p3 == m) ? 0u : p3;
    }
    return W;
}
__device__ __forceinline__ unsigned top16_of2(unsigned p0, unsigned p1, int c15) {
    unsigned W = 0u;
    for (int it = 0; it < 16; ++it) {
        const unsigned m = max32(umax_(p0, p1));
        W = (c15 == it) ? m : W;
        p0 = (p0 == m) ? 0u : p0; p1 = (p1 == m) ? 0u : p1;
    }
    return W;
}
__device__ __forceinline__ void topk_unit(const bf16* q, const bf16* keys, int* EI, float* GW, int t0, int h, int lane) {
    const int c = lane & 31, hi = lane >> 5, c15 = lane & 15, hbase = lane & 32;
    int f0 = 0, f1 = 0;
    { int cnt = 0;
#pragma unroll
      for (int i = 0; i < 16; ++i)
#pragma unroll
        for (int j = 0; j < 16; ++j) if ((i + 1) * (j + 1) <= 16) { f0 = (cnt == c) ? (i * 16 + j) : f0; f1 = (cnt == c + 32) ? (i * 16 + j) : f1; ++cnt; } }
    unsigned W[2][16];
#pragma unroll
    for (int p = 0; p < 2; ++p) {
        f32x16 acc[4];
#pragma unroll
        for (int kb = 0; kb < 4; ++kb)
#pragma unroll
            for (int r = 0; r < 16; ++r) acc[kb][r] = 0.f;
        const bf16* qp = q + (size_t)(t0 + c) * 2048 + h * 256 + p * 128 + hi * 8;
        const bf16* kp = keys + (size_t)((h * 2 + p) * 128 + c) * 128 + hi * 8;
        asm volatile("" : "+v"(qp), "+v"(kp));
#pragma unroll 2
        for (int ks = 0; ks < 8; ++ks) {
            const s16x8 a = *(const s16x8*)(qp + ks * 16);
#pragma unroll
            for (int kb = 0; kb < 4; ++kb) { const s16x8 b = *(const s16x8*)(kp + kb * 32 * 128 + ks * 16); acc[kb] = __builtin_amdgcn_mfma_f32_32x32x16_bf16(a, b, acc[kb], 0, 0, 0); }
        }
#pragma unroll
        for (int r = 0; r < 16; ++r) {
            const unsigned p0 = (ordf(acc[0][r]) & ~127u) | (unsigned)(127 - c), p1 = (ordf(acc[1][r]) & ~127u) | (unsigned)(95 - c),
                           p2 = (ordf(acc[2][r]) & ~127u) | (unsigned)(63 - c), p3 = (ordf(acc[3][r]) & ~127u) | (unsigned)(31 - c);
            W[p][r] = top16_of4(p0, p1, p2, p3, c15);
        }
    }
#pragma unroll
    for (int r = 0; r < 16; ++r) {
        const unsigned w0 = W[0][r], w1 = W[1][r];
        const float a0 = unordf(bperm(w0, hbase + (f0 >> 4)) & ~127u), b0 = unordf(bperm(w1, hbase + (f0 & 15)) & ~127u);
        const float a1 = unordf(bperm(w0, hbase + (f1 >> 4)) & ~127u), b1 = unordf(bperm(w1, hbase + (f1 & 15)) & ~127u);
        const unsigned cp0 = (ordf(a0 + b0) & ~63u) | (unsigned)(63 - c);
        const unsigned cp1 = (c + 32 < 50) ? ((ordf(a1 + b1) & ~63u) | (unsigned)(31 - c)) : 0u;
        const unsigned Wc = top16_of2(cp0, cp1, c15);
        const int slot = 63 - (int)(Wc & 63u);
        const unsigned fa = bperm((unsigned)f0, hbase + (slot & 31)), fb = bperm((unsigned)f1, hbase + (slot & 31));
        const int flat = (slot < 32) ? (int)fa : (int)fb;
        const float val = unordf(Wc & ~63u);
        const float vmax = __uint_as_float(bperm(__float_as_uint(val), hbase));
        const float e = __expf(val - vmax);
        const float g = e / sum16(e);
        const int k1 = 127 - (int)(bperm(w0, hbase + (flat >> 4)) & 127u), k2 = 127 - (int)(bperm(w1, hbase + (flat & 15)) & 127u);
        const int tok = t0 + (r & 3) + 8 * (r >> 2) + 4 * hi;
        if (c < 16) { EI[(size_t)(tok * 8 + h) * 16 + c] = k1 * 128 + k2; GW[(size_t)(tok * 8 + h) * 16 + c] = g; }
    }
}

__device__ __forceinline__ float gelu_tanh_f(float x) {
    const float u = 0.7978845608028654f * (x + 0.044715f * x * x * x);
    const float e = __expf(2.f * u);
    const float th = 1.f - 2.f / (e + 1.f);
    return 0.5f * x * (1.f + th);
}
__device__ __forceinline__ float wave_sum_bfly(float v) {
#pragma unroll
    for (int o = 1; o < 64; o <<= 1) v += __shfl_xor(v, o);
    return v;
}
typedef float f32x2_ __attribute__((ext_vector_type(2)));
#define U_SCALE 1024.f
#define V_SCALE 256.f
__device__ __forceinline__ void peer_token(float* xio, const float* gain, const int* EI, const float* GW, const unsigned char* U8, const unsigned char* V8, bf16* xb, float* ssq, const float* fin, int t, int lane) {
    float* xr = xio + (size_t)t * 2048 + 16 * lane;
    f32x2_ h2[16];
    {
        f32x4 xv[8]; float s = 0.f;
#pragma unroll
        for (int j = 0; j < 2; ++j)
#pragma unroll
            for (int q = 0; q < 4; ++q) xv[4 * j + q] = *(const f32x4*)(xr + 1024 * j + 4 * q);
#pragma unroll
        for (int j = 0; j < 8; ++j) s += (xv[j][0] * xv[j][0] + xv[j][1] * xv[j][1]) + (xv[j][2] * xv[j][2] + xv[j][3] * xv[j][3]);
        const float rs = rsqrtf(wave_sum_bfly(s) * (1.f / 2048.f) + EPS);
#pragma unroll
        for (int j = 0; j < 2; ++j)
#pragma unroll
            for (int q = 0; q < 4; ++q) { const f32x4 g = *(const f32x4*)(gain + 1024 * j + 16 * lane + 4 * q);
                h2[8 * j + 2 * q] = (f32x2_){xv[4 * j + q][0] * rs * g[0], xv[4 * j + q][1] * rs * g[1]}; h2[8 * j + 2 * q + 1] = (f32x2_){xv[4 * j + q][2] * rs * g[2], xv[4 * j + q][3] * rs * g[3]}; }
    }
    f32x2_ acc[16];
#pragma unroll
    for (int i = 0; i < 16; ++i) acc[i] = (f32x2_){0.f, 0.f};
    const unsigned lo16 = 16u * (unsigned)lane;
    const int ei_lo = EI[(size_t)t * 128 + lane], ei_hi = EI[(size_t)t * 128 + 64 + lane];
    const float gw_lo = GW[(size_t)t * 128 + lane], gw_hi = GW[(size_t)t * 128 + 64 + lane];
    for (int half = 0; half < 2; ++half) {
    const int eiv = half ? ei_hi : ei_lo; const float gwv = half ? gw_hi : gw_lo;
    for (int grp = 0; grp < 16; ++grp) {
        v4u uu[4][2], vv[4][2];
#pragma unroll
        for (int k = 0; k < 4; ++k) {
            const int e = __builtin_amdgcn_readlane(eiv, grp * 4 + k);
            const unsigned char* up = U8 + (size_t)e * 2048; const unsigned char* vp = V8 + (size_t)e * 2048;
            uu[k][0] = *(const v4u*)(up + lo16); uu[k][1] = *(const v4u*)(up + lo16 + 1024); vv[k][0] = *(const v4u*)(vp + lo16); vv[k][1] = *(const v4u*)(vp + lo16 + 1024);
        }
        float d[4];
#pragma unroll
        for (int k = 0; k < 4; ++k) {
            f32x2_ d2 = (f32x2_){0.f, 0.f};
#pragma unroll
            for (int j = 0; j < 2; ++j)
#pragma unroll
                for (int q = 0; q < 4; ++q) { const int w = (int)uu[k][j][q];
                    d2 = __builtin_elementwise_fma(__builtin_amdgcn_cvt_pk_f32_fp8(w, false), h2[8 * j + 2 * q], d2);
                    d2 = __builtin_elementwise_fma(__builtin_amdgcn_cvt_pk_f32_fp8(w, true), h2[8 * j + 2 * q + 1], d2); }
            d[k] = d2.x + d2.y;
        }
        float t2[2];
#pragma unroll
        for (int i = 0; i < 2; ++i) { const auto r = __builtin_amdgcn_permlane32_swap(__float_as_uint(d[i]), __float_as_uint(d[i + 2]), false, false); t2[i] = __uint_as_float(r[0]) + __uint_as_float(r[1]); }
        float w;
        { const auto r = __builtin_amdgcn_permlane16_swap(__float_as_uint(t2[0]), __float_as_uint(t2[1]), false, false); w = __uint_as_float(r[0]) + __uint_as_float(r[1]); }
        w += DPPF(w, 0x128); w += DPPF(w, 0xB1); w += DPPF(w, 0x4E); w += DPPF(w, 0x141);
        const float gk = __uint_as_float(bperm(__float_as_uint(gwv), grp * 4 + (lane >> 4)));
        const float wgt = gk * gelu_tanh_f(w * (1.f / U_SCALE)) * (1.f / V_SCALE);
#pragma unroll
        for (int k = 0; k < 4; ++k) {
            const float wk = __int_as_float(__builtin_amdgcn_readlane(__float_as_int(wgt), 16 * k));
            const f32x2_ wk2 = (f32x2_){wk, wk};
#pragma unroll
            for (int j = 0; j < 2; ++j)
#pragma unroll
                for (int q = 0; q < 4; ++q) { const int wv = (int)vv[k][j][q];
                    acc[8 * j + 2 * q] = __builtin_elementwise_fma(__builtin_amdgcn_cvt_pk_f32_fp8(wv, false), wk2, acc[8 * j + 2 * q]);
                    acc[8 * j + 2 * q + 1] = __builtin_elementwise_fma(__builtin_amdgcn_cvt_pk_f32_fp8(wv, true), wk2, acc[8 * j + 2 * q + 1]); }
        }
    }
    }
    float s2 = 0.f;
#pragma unroll
    for (int j = 0; j < 2; ++j)
#pragma unroll
        for (int q = 0; q < 4; ++q) { const f32x4 x0 = *(const f32x4*)(xr + 1024 * j + 4 * q);
            acc[8 * j + 2 * q] += (f32x2_){x0[0], x0[1]}; acc[8 * j + 2 * q + 1] += (f32x2_){x0[2], x0[3]};
            s2 += (acc[8 * j + 2 * q].x * acc[8 * j + 2 * q].x + acc[8 * j + 2 * q].y * acc[8 * j + 2 * q].y) + (acc[8 * j + 2 * q + 1].x * acc[8 * j + 2 * q + 1].x + acc[8 * j + 2 * q + 1].y * acc[8 * j + 2 * q + 1].y); }
    s2 = wave_sum_bfly(s2);
    if (fin) {
        const float r2 = rsqrtf(s2 * (1.f / 2048.f) + EPS);
#pragma unroll
        for (int j = 0; j < 2; ++j)
#pragma unroll
            for (int q = 0; q < 4; ++q) { const f32x4 g = *(const f32x4*)(fin + 1024 * j + 16 * lane + 4 * q);
                f32x4 o; o[0] = acc[8 * j + 2 * q].x * r2 * g[0]; o[1] = acc[8 * j + 2 * q].y * r2 * g[1]; o[2] = acc[8 * j + 2 * q + 1].x * r2 * g[2]; o[3] = acc[8 * j + 2 * q + 1].y * r2 * g[3];
                *(f32x4*)(xr + 1024 * j + 4 * q) = o; }
    } else {
        bf16* xbr = xb + (size_t)t * 2048 + 16 * lane;
#pragma unroll
        for (int j = 0; j < 2; ++j) {
#pragma unroll
            for (int q = 0; q < 4; ++q) { f32x4 o; o[0] = acc[8 * j + 2 * q].x; o[1] = acc[8 * j + 2 * q].y; o[2] = acc[8 * j + 2 * q + 1].x; o[3] = acc[8 * j + 2 * q + 1].y; *(f32x4*)(xr + 1024 * j + 4 * q) = o; }
            v4u o0, o1;
            o0.x = pk2(acc[8 * j + 0].x, acc[8 * j + 0].y); o0.y = pk2(acc[8 * j + 1].x, acc[8 * j + 1].y); o0.z = pk2(acc[8 * j + 2].x, acc[8 * j + 2].y); o0.w = pk2(acc[8 * j + 3].x, acc[8 * j + 3].y);
            o1.x = pk2(acc[8 * j + 4].x, acc[8 * j + 4].y); o1.y = pk2(acc[8 * j + 5].x, acc[8 * j + 5].y); o1.z = pk2(acc[8 * j + 6].x, acc[8 * j + 6].y); o1.w = pk2(acc[8 * j + 7].x, acc[8 * j + 7].y);
            *(v4u*)(xbr + 1024 * j) = o0; *(v4u*)(xbr + 1024 * j + 8) = o1;
        }
        if (lane == 0) ssq[t] = s2;
    }
}
typedef short s16x4 __attribute__((ext_vector_type(4)));
__device__ __forceinline__ unsigned cvt_pk_bf16_(float lo, float hi) { unsigned r; asm volatile("v_cvt_pk_bf16_f32 %0, %1, %2" : "=v"(r) : "v"(lo), "v"(hi)); return r; }
__device__ __forceinline__ void attn_task(const bf16* Q, const bf16* K, const bf16* Vt, bf16* O, const float* sinks, int b, int hq, int q0, int lane) {
    const int c = lane & 31, hi = lane >> 5, kvh = hq >> 2;
    const size_t tb = (size_t)b * 4096;
    s16x8 qf[4];
    { const bf16* qp = Q + (tb + q0 + c) * 2048 + hq * 64 + hi * 8;
#pragma unroll
      for (int ks = 0; ks < 4; ++ks) qf[ks] = *(const s16x8*)(qp + ks * 16); }
    const float sink2 = sinks[hq] * 1.4426950408889634f;
    float m = sink2, l = (hi == 0) ? 1.f : 0.f;
    f32x16 o0, o1;
#pragma unroll
    for (int r = 0; r < 16; ++r) { o0[r] = 0.f; o1[r] = 0.f; }
    const bf16* kbase = K + tb * 512 + kvh * 64 + hi * 8 + (size_t)c * 512;
    const bf16* vbase = Vt + (size_t)(kvh * 64 + c) * 16384 + tb + 4 * hi;
    for (int kt = 0; kt < 9; ++kt) {
        const int key0 = q0 - 128 + 32 * kt;
        if (key0 < 0 || key0 >= 4096) continue;
        s16x8 kf[4]; s16x4 va[2][2][2];
#pragma unroll
        for (int ks = 0; ks < 4; ++ks) kf[ks] = *(const s16x8*)(kbase + (size_t)key0 * 512 + ks * 16);
#pragma unroll
        for (int db = 0; db < 2; ++db)
#pragma unroll
            for (int s = 0; s < 2; ++s) { const bf16* vp = vbase + (size_t)db * 32 * 16384 + key0 + 16 * s; va[db][s][0] = *(const s16x4*)vp; va[db][s][1] = *(const s16x4*)(vp + 8); }
        f32x16 sa;
#pragma unroll
        for (int r = 0; r < 16; ++r) sa[r] = 0.f;
#pragma unroll
        for (int ks = 0; ks < 4; ++ks) sa = __builtin_amdgcn_mfma_f32_32x32x16_bf16(kf[ks], qf[ks], sa, 0, 0, 0);
        if (kt == 0 || kt == 8) {
            const int dbase = key0 - (q0 + c) + 4 * hi;
#pragma unroll
            for (int r = 0; r < 16; ++r) { const int d = dbase + (r & 3) + 8 * (r >> 2); if (d < -128 || d > 128) sa[r] = -1e30f; }
        }
        float mx = sa[0];
#pragma unroll
        for (int r = 1; r < 16; ++r) mx = fmaxf(mx, sa[r]);
        { const auto rr = __builtin_amdgcn_permlane32_swap(__float_as_uint(mx), __float_as_uint(mx), false, false); mx = fmaxf(__uint_as_float(rr[0]), __uint_as_float(rr[1])); }
        const float mn = fmaxf(m, mx), alpha = __builtin_amdgcn_exp2f(m - mn);
        m = mn;
        float ps = 0.f;
#pragma unroll
        for (int r = 0; r < 16; ++r) { sa[r] = __builtin_amdgcn_exp2f(sa[r] - mn); ps += sa[r]; }
        l = l * alpha + ps;
#pragma unroll
        for (int r = 0; r < 16; ++r) { o0[r] *= alpha; o1[r] *= alpha; }
        s16x8 pf[2];
#pragma unroll
        for (int s = 0; s < 2; ++s) { v4u w; w.x = cvt_pk_bf16_(sa[8 * s + 0], sa[8 * s + 1]); w.y = cvt_pk_bf16_(sa[8 * s + 2], sa[8 * s + 3]); w.z = cvt_pk_bf16_(sa[8 * s + 4], sa[8 * s + 5]); w.w = cvt_pk_bf16_(sa[8 * s + 6], sa[8 * s + 7]);
            pf[s] = __builtin_bit_cast(s16x8, w); }
#pragma unroll
        for (int s = 0; s < 2; ++s) {
            const s16x8 v0 = __builtin_shufflevector(va[0][s][0], va[0][s][1], 0, 1, 2, 3, 4, 5, 6, 7), v1 = __builtin_shufflevector(va[1][s][0], va[1][s][1], 0, 1, 2, 3, 4, 5, 6, 7);
            o0 = __builtin_amdgcn_mfma_f32_32x32x16_bf16(v0, pf[s], o0, 0, 0, 0);
            o1 = __builtin_amdgcn_mfma_f32_32x32x16_bf16(v1, pf[s], o1, 0, 0, 0);
        }
    }
    { const auto rr = __builtin_amdgcn_permlane32_swap(__float_as_uint(l), __float_as_uint(l), false, false); l = __uint_as_float(rr[0]) + __uint_as_float(rr[1]); }
    const float il = 1.f / l;
    bf16* op = O + (tb + q0 + c) * 2048 + hq * 64 + 4 * hi;
#pragma unroll
    for (int g = 0; g < 4; ++g) {
        v2u w0, w1;
        w0.x = cvt_pk_bf16_(o0[4 * g + 0] * il, o0[4 * g + 1] * il); w0.y = cvt_pk_bf16_(o0[4 * g + 2] * il, o0[4 * g + 3] * il);
        w1.x = cvt_pk_bf16_(o1[4 * g + 0] * il, o1[4 * g + 1] * il); w1.y = cvt_pk_bf16_(o1[4 * g + 2] * il, o1[4 * g + 3] * il);
        *(v2u*)(op + 8 * g) = w0; *(v2u*)(op + 32 + 8 * g) = w1;
    }
}
enum { PH_PRO = 0, PH_G1 = 1, PH_G2 = 2, PH_G3 = 3, PH_Q0 = 4, PH_PE0 = 5, PH_QKV = 6, PH_ATT = 7, PH_WO = 8, PH_Q1 = 9, PH_PE1 = 10, PH_END = 11 };
__global__ void __launch_bounds__(NWAVES * 64, 2) mega(Args a) {
    extern __shared__ __attribute__((aligned(16))) unsigned char lds_raw[];
    LAS unsigned char* lds = (LAS unsigned char*)lds_raw;
    cg::grid_group grid = cg::this_grid();
    const int tid = threadIdx.x, lane = tid & 63, wave = __builtin_amdgcn_readfirstlane(tid >> 6);
    const int G = gridDim.x, bx = blockIdx.x;
    unsigned char* ws = a.ws;
    const int lo = a.ph_lo, hi = a.ph_hi;
#define IN(k) (lo <= (k) && (k) < hi)
#define SEAM(k) do { if (IN(k) && IN((k) + 1)) grid.sync(); } while (0)
    if (IN(PH_PRO)) {
        const int gw = bx * NWAVES + wave, NGW = G * NWAVES;
        const size_t gtid = (size_t)bx * (NWAVES * 64) + tid, ngt = (size_t)G * NWAVES * 64;
        LAS float* scr = (LAS float*)(lds + wave * 16384);
        {
            constexpr int I_SQ = (DM / 64) * (DM / 32), I_QKV = (DM / 64) * (QKVW / 32);
            constexpr int NITEMS = 4 * I_SQ + I_QKV;
            for (int it = gw; it < NITEMS; it += NGW) {
                int r = it;
                if (r < I_SQ) { transpose_item<0>(a.in[3], DM, DM, nullptr, (bf16*)(ws + WS_WOF), scr, r, lane); continue; } r -= I_SQ;
                if (r < I_SQ) { transpose_item<0>(a.in[5], DM, DM, nullptr, (bf16*)(ws + WS_WOA), scr, r, lane); continue; } r -= I_SQ;
                if (r < I_SQ) { transpose_item<0>(a.in[7], DM, DM, a.in[2], (bf16*)(ws + WS_WQ0), scr, r, lane); continue; } r -= I_SQ;
                if (r < I_SQ) { transpose_item<0>(a.in[7] + (size_t)DM * DM, DM, DM, a.in[2] + DM, (bf16*)(ws + WS_WQ1), scr, r, lane); continue; } r -= I_SQ;
                transpose_item<1>(a.in[4], DM, QKVW, a.in[1] + DM, (bf16*)(ws + WS_WQKV), scr, r, lane);
            }
        }
        for (int row = gw; row < T; row += NGW) {
            const f32x4* xr = (const f32x4*)(a.in[0] + (size_t)row * DM) + lane;
            const f32x4* gr = (const f32x4*)a.in[1] + lane;
            f32x4 v[8]; float s = 0.f;
#pragma unroll
            for (int j = 0; j < 8; ++j) { v[j] = xr[64 * j]; s += (v[j][0] * v[j][0] + v[j][1] * v[j][1]) + (v[j][2] * v[j][2] + v[j][3] * v[j][3]); }
            const float r = rsqrtf(wsum(s) * (1.f / DM) + EPS);
            const int b = row >> 12, sp = row & 4095;
#pragma unroll
            for (int j = 0; j < 8; ++j) { const f32x4 gg = gr[64 * j]; v2u o; o.x = pk2(v[j][0] * r * gg[0], v[j][1] * r * gg[1]); o.y = pk2(v[j][2] * r * gg[2], v[j][3] * r * gg[3]);
                *(v2u*)((bf16*)(ws + WS_XG) + ((size_t)((b * 8 + j) * 4096 + sp) * 256 + 4 * lane)) = o; }
        }
        for (size_t i = gtid; i < (size_t)4096 * 8192 / 8; i += ngt) {
            const int k = (int)(i >> 10), c0 = (int)(i & 1023) * 8, part = c0 >> 12, s0 = c0 & 4095;
            float v[8];
#pragma unroll
            for (int e = 0; e < 8; ++e) { const int m = (k * (s0 + e)) & 4095; const float rev = (float)m * (1.f / 4096.f); v[e] = (part ? __builtin_amdgcn_sinf(rev) : __builtin_amdgcn_cosf(rev)) * (1.f / 64.f); }
            v4u o; o.x = pk2(v[0], v[1]); o.y = pk2(v[2], v[3]); o.z = pk2(v[4], v[5]); o.w = pk2(v[6], v[7]);
            *(v4u*)((bf16*)(ws + WS_CS) + i * 8) = o;
        }
        for (size_t i = gtid; i < (size_t)512 * 256 / 8; i += ngt) {
            const int n = (int)(i >> 5), c0 = (int)(i & 31) * 8, part = n >> 8, l = n & 255;
            float v[8];
#pragma unroll
            for (int e = 0; e < 8; ++e) { const int m = (l * (c0 + e)) & 255; const float rev = (float)m * (1.f / 256.f); v[e] = (part ? -__builtin_amdgcn_sinf(rev) : __builtin_amdgcn_cosf(rev)) * (1.f / 16.f); }
            v4u o; o.x = pk2(v[0], v[1]); o.y = pk2(v[2], v[3]); o.z = pk2(v[4], v[5]); o.w = pk2(v[6], v[7]);
            *(v4u*)((bf16*)(ws + WS_WCS) + i * 8) = o;
        }
        for (size_t i = gtid; i < (size_t)4096 * 32; i += ngt) {
            const int pos = (int)(i >> 5), fi = (int)(i & 31);
            const double inv = exp2(-(double)fi * (13.287712379549449 / 32.0));
            double sn, cs; sincos((double)pos * inv, &sn, &cs);
            ((float*)(ws + WS_ROPE))[2 * i] = (float)cs; ((float*)(ws + WS_ROPE))[2 * i + 1] = (float)sn;
        }
        cvt_stream8(a.in[9], ws + WS_U0, (size_t)NEXP * DM / 16, gtid, ngt, 1024.f);
        cvt_stream8(a.in[10], ws + WS_V0, (size_t)NEXP * DM / 16, gtid, ngt, 256.f);
        cvt_stream8(a.in[9] + (size_t)NEXP * DM, ws + WS_U1, (size_t)NEXP * DM / 16, gtid, ngt, 1024.f);
        cvt_stream8(a.in[10] + (size_t)NEXP * DM, ws + WS_V1, (size_t)NEXP * DM / 16, gtid, ngt, 256.f);
        cvt_stream(a.in[8], (bf16*)(ws + WS_KEYS), (size_t)2 * PH * 2 * 128 * 128 / 8, gtid, ngt);
    }
    SEAM(PH_PRO);
    if (IN(PH_G1)) {
        int Kq = FW; asm volatile("" : "+s"(Kq));
        pg8::Gemm g{(const pg8::bf16_t*)(ws + WS_WCS), (const pg8::bf16_t*)(ws + WS_XG), 512, T * FG, Kq}; pg8::StaticOrder S; S.init(512, T * FG, G, bx);
        pg8::EpiZt E{(pg8::bf16_t*)(ws + WS_ZT)};
        pg8::gemm_phase<pg8::EpiZt, pg8::StaticOrder, true, true>(lds, g, S, E);
    }
    SEAM(PH_G1);
    if (IN(PH_G2)) {
        pg8::Gemm g{(const pg8::bf16_t*)(ws + WS_CS), (const pg8::bf16_t*)(ws + WS_ZT), 4096, 8192, 8192}; pg8::StaticOrder S; S.init(4096, 8192, G, bx);
        pg8::EpiY E{(pg8::bf16_t*)(ws + WS_Y)};
        pg8::gemm_phase<pg8::EpiY, pg8::StaticOrder, true, true>(lds, g, S, E);
    }
    SEAM(PH_G2);
    if (IN(PH_G3)) {
        pg8::Gemm g{(const pg8::bf16_t*)(ws + WS_Y), (const pg8::bf16_t*)(ws + WS_WOF), T, DM, DM}; pg8::StaticOrder S; S.init(T, DM, G, bx);
        pg8::EpiRes E{a.in[0], a.out, (pg8::bf16_t*)(ws + WS_XB), (float*)(ws + WS_SSQ_A)};
        pg8::gemm_phase<pg8::EpiRes, pg8::StaticOrder, true, true>(lds, g, S, E);
    }
    SEAM(PH_G3);
#define PEER_LAYER(L) do { \
        const int pq = L ? PH_Q1 : PH_Q0, ppe = L ? PH_PE1 : PH_PE0; \
        if (IN(pq)) { \
            pg8::Gemm g{(const pg8::bf16_t*)(ws + WS_XB), (const pg8::bf16_t*)(ws + (L ? WS_WQ1 : WS_WQ0)), T, DM, DM}; pg8::StaticOrder S; S.init(T, DM, G, bx); \
            pg8::EpiScale E{(pg8::bf16_t*)(ws + WS_Q), (const float*)(ws + (L ? WS_SSQ_C : WS_SSQ_A))}; \
            pg8::gemm_phase<pg8::EpiScale, pg8::StaticOrder, true, true>(lds, g, S, E); \
        } \
        SEAM(pq); \
        if (IN(ppe)) { \
            const bf16* keys = (const bf16*)(ws + WS_KEYS) + (size_t)L * PH * 2 * 128 * 128; \
            for (int u = bx; u < T / 32; u += G) topk_unit((const bf16*)(ws + WS_Q), keys, (int*)(ws + WS_EI), (float*)(ws + WS_GW), u * 32, wave, lane); \
            __syncthreads(); \
            for (int u = bx; u < T / 32; u += G) \
                for (int i = 0; i < 4; ++i) \
                    peer_token(a.out, a.in[2] + L * DM, (const int*)(ws + WS_EI), (const float*)(ws + WS_GW), (const unsigned char*)(ws + (L ? WS_U1 : WS_U0)), (const unsigned char*)(ws + (L ? WS_V1 : WS_V0)), \
                               (bf16*)(ws + WS_XB), (float*)(ws + WS_SSQ_B), L ? a.in[11] : nullptr, u * 32 + wave * 4 + i, lane); \
        } \
    } while (0)
    PEER_LAYER(0);
    SEAM(PH_PE0);
    if (IN(PH_QKV)) {
        {
            pg8::Gemm g{(const pg8::bf16_t*)(ws + WS_XB), (const pg8::bf16_t*)(ws + WS_WQKV), T, 2560, DM}; pg8::StaticOrder S; S.init(T, 2560, G, bx);
            pg8::EpiQK E{(pg8::bf16_t*)(ws + WS_QB), (pg8::bf16_t*)(ws + WS_KB), (const float*)(ws + WS_SSQ_B), (const float*)(ws + WS_ROPE), 0.125f * 1.4426950408889634f};
            pg8::gemm_phase<pg8::EpiQK, pg8::StaticOrder, true, true>(lds, g, S, E);
        }
        if (bx >= G / 2) {
            pg8::Gemm g{(const pg8::bf16_t*)(ws + WS_WQKV) + (size_t)2560 * DM, (const pg8::bf16_t*)(ws + WS_XB), 512, T, DM}; pg8::StaticOrder S; S.init(512, T, G / 2, bx - G / 2);
            pg8::EpiVt E{(pg8::bf16_t*)(ws + WS_VT), (const float*)(ws + WS_SSQ_B)};
            pg8::gemm_phase<pg8::EpiVt, pg8::StaticOrder, true, true>(lds, g, S, E);
        }
    }
    SEAM(PH_QKV);
    if (IN(PH_ATT)) {
        for (int vb = bx; vb < 256; vb += G) {
        const int bkv = vb >> 3, chunk = vb & 7, b = bkv >> 3, kvh = bkv & 7;
        for (int i = 0; i < 8; ++i)
            attn_task((const bf16*)(ws + WS_QB), (const bf16*)(ws + WS_KB), (const bf16*)(ws + WS_VT), (bf16*)(ws + WS_O), a.in[6], b, kvh * 4 + (wave & 3), (chunk * 8 + i) * 64 + (wave >> 2) * 32, lane);
        }
    }
    SEAM(PH_ATT);
    if (IN(PH_WO)) {
        pg8::Gemm g{(const pg8::bf16_t*)(ws + WS_O), (const pg8::bf16_t*)(ws + WS_WOA), T, DM, DM}; pg8::StaticOrder S; S.init(T, DM, G, bx);
        pg8::EpiRes E{a.out, a.out, (pg8::bf16_t*)(ws + WS_XB), (float*)(ws + WS_SSQ_C)};
        pg8::gemm_phase<pg8::EpiRes, pg8::StaticOrder, true, true>(lds, g, S, E);
    }
    SEAM(PH_WO);
    PEER_LAYER(1);
#undef PEER_LAYER
#undef SEAM
#undef IN
}

#ifndef N_LAUNCHES
#define N_LAUNCHES 1
#endif
extern "C" void kernel_launch(void* const* d_in, const int* in_sizes, int n_in, void* d_out, int out_size, void* d_ws, size_t ws_size, hipStream_t stream) {
    static int grid = 0;
    if (!grid) {
        if (hipFuncSetAttribute((const void*)mega, hipFuncAttributeMaxDynamicSharedMemorySize, LDS_BYTES) != hipSuccess) { fprintf(stderr, "hipFuncSetAttribute failed\n"); }
        int dev = 0, cus = 0, per_cu = 0;
        (void)hipGetDevice(&dev);
        (void)hipDeviceGetAttribute(&cus, hipDeviceAttributeMultiprocessorCount, dev);
        if (hipOccupancyMaxActiveBlocksPerMultiprocessor(&per_cu, (const void*)mega, NWAVES * 64, LDS_BYTES) != hipSuccess) per_cu = 0;
        (void)hipGetLastError();
        grid = cus * per_cu;
        if (grid > 256) grid = 256;
        grid &= ~1;
        if (grid < 2) { fprintf(stderr, "occupancy query gave %d x %d\n", cus, per_cu); grid = -1; }
    }
    if (grid < 0) return;
    if (ws_size < 700 * MiB) { fprintf(stderr, "ws too small: %zu\n", ws_size); return; }
    (void)hipMemsetAsync((char*)d_ws + WS_CTL, 0, CTL_BYTES, stream);
    Args a{};
    for (int i = 0; i < 12; ++i) a.in[i] = (const float*)d_in[i];
    a.out = (float*)d_out; a.ws = (unsigned char*)d_ws;
    if (N_LAUNCHES == 1) {
        a.ph_lo = 0; a.ph_hi = PH_END;
        void* args[] = {&a};
        const hipError_t e = hipLaunchCooperativeKernel((const void*)mega, dim3(grid), dim3(NWAVES * 64), args, LDS_BYTES, stream);
        if (e != hipSuccess) fprintf(stderr, "cooperative launch failed: %s (grid %d)\n", hipGetErrorString(e), grid);
    } else {
        for (int ph = 0; ph < PH_END; ++ph) {
            a.ph_lo = ph; a.ph_hi = ph + 1;
            hipLaunchKernelGGL(mega, dim3(grid), dim3(NWAVES * 64), LDS_BYTES, stream, a);
        }
    }
}
```

```cpp
#include <hip/hip_runtime.h>
#include <hip/hip_cooperative_groups.h>
namespace cg = cooperative_groups;
#include <cstdio>
#include <cstdint>
#include <cmath>

constexpr int DM = 2048, NB = 4, SEQ = 4096, T = NB * SEQ;
constexpr int FG = 8, FW = 256;
constexpr int HD = 64, NQH = 32, NKVH = 8, QKVW = 3072;
constexpr int PH = 8, NKEYS = 128, NEXP = 16384, PTOPK = 16;
constexpr float EPS = 1e-6f;
namespace pg8 {
#define PG8_LAS __attribute__((address_space(3)))
typedef unsigned short bf16_t;
typedef short bf16x8 __attribute__((ext_vector_type(8)));
typedef float f32x4 __attribute__((ext_vector_type(4)));
typedef unsigned u32x4 __attribute__((ext_vector_type(4)));
constexpr int BM = 256, BK = 64, HALF = 128, HTB = HALF * BK * 2  , STAGE_BYTES = 8 * HTB, NXCD = 8, WGM = 8;

__host__ __device__ __forceinline__ int lds_byte(int r, int c) { const int st = (r >> 4) * 2 + (c >> 5), rr = r & 15, cc = c & 31, ob = rr * 64 + cc * 2; return st * 1024 + (ob ^ (((ob >> 9) & 1) << 5)); }
__host__ __device__ __forceinline__ void stage_rc(int b, int& R, int& C) { const int st = b / 1024, sb = b % 1024, swz = sb ^ (((sb >> 9) & 1) << 5); R = (st >> 1) * 16 + swz / 64; C = (st & 1) * 32 + (swz % 64) / 2; }
__host__ __device__ __forceinline__ int perm32(int rho) { const int n = rho >> 4, i = rho & 15; return 8 * (i >> 2) + 4 * n + (i & 3); }

struct Unit { int pm, pn; };
struct Gemm { const bf16_t* A; const bf16_t* Bt; int M, N, K; };

struct StaticOrder {
    int nM, nN, nwg, G, c;
    __host__ __device__ void init(int M, int N, int G_, int c_) { nM = M / BM; nN = N / BM; nwg = nM * nN; G = G_; c = c_; }
    __host__ __device__ bool next(int i, Unit& u) const {
        const long L = (long)i * G + c; if (L >= nwg) return false;
        int wgid = (int)L; { const int q = nwg / NXCD, r = nwg % NXCD, xcd = wgid % NXCD, off = wgid / NXCD; wgid = (xcd < r ? xcd * (q + 1) : r * (q + 1) + (xcd - r) * q) + off; }
        const int nig = WGM * nN, gid = wgid / nig, fm = gid * WGM, gsz = (nM - fm) < WGM ? (nM - fm) : WGM;
        u.pm = fm + ((wgid % nig) % gsz); u.pn = (wgid % nig) / gsz; return true;
    }
    __device__ __forceinline__ void a_ready(const Unit&) const {}
    __device__ __forceinline__ void done(const Unit&) const {}
};

__device__ __forceinline__ unsigned cvt_pk_bf16(float lo, float hi) { unsigned r; asm volatile("v_cvt_pk_bf16_f32 %0, %1, %2" : "=v"(r) : "v"(lo), "v"(hi)); return r; }
typedef float f32x2 __attribute__((ext_vector_type(2)));
__device__ __forceinline__ u32x4 pack8(const f32x4 v0, const f32x4 v1) { u32x4 w; w.x = cvt_pk_bf16(v0[0], v0[1]); w.y = cvt_pk_bf16(v0[2], v0[3]); w.z = cvt_pk_bf16(v1[0], v1[1]); w.w = cvt_pk_bf16(v1[2], v1[3]); return w; }
struct EpiZt {
    static constexpr bool PERM = true, AFTER_DRAIN = false; bf16_t* Zp;
    __device__ __forceinline__ void operator()(const f32x4 (&acc)[2][2][4][2], const Unit& u, int wr, int wc, int fr, int fq) const {
        const int part = u.pm, bgs2 = u.pn;
        bf16_t* base = Zp + ((size_t)(bgs2 * 256 + wr * 64 + fr) * 512 + part * 256 + wc * 32 + 8 * fq);
#pragma unroll
        for (int ai = 0; ai < 2; ++ai)
#pragma unroll
            for (int m = 0; m < 4; ++m)
#pragma unroll
                for (int bj = 0; bj < 2; ++bj) *(u32x4*)(base + (ai * HALF + m * 16) * 512 + bj * HALF) = pack8(acc[ai][bj][m][0], acc[ai][bj][m][1]);
    }
};
struct EpiY {
    static constexpr bool PERM = true, AFTER_DRAIN = false; bf16_t* Y;
    __device__ __forceinline__ void operator()(const f32x4 (&acc)[2][2][4][2], const Unit& u, int wr, int wc, int fr, int fq) const {
        const int bg = u.pn >> 4, k2 = u.pn & 15, b = bg >> 3, g = bg & 7;
        bf16_t* base = Y + ((size_t)(b * 4096 + (wr * 64 + fr) * 16 + k2) * 2048 + g * 256 + wc * 32 + 8 * fq);
#pragma unroll
        for (int ai = 0; ai < 2; ++ai)
#pragma unroll
            for (int m = 0; m < 4; ++m)
#pragma unroll
                for (int bj = 0; bj < 2; ++bj) *(u32x4*)(base + (size_t)(ai * HALF + m * 16) * 16 * 2048 + bj * HALF) = pack8(acc[ai][bj][m][0], acc[ai][bj][m][1]);
    }
};
struct EpiRes {
    static constexpr bool PERM = true, AFTER_DRAIN = false; const float* R; float* out; bf16_t* xb; float* ssq;
    __device__ __forceinline__ void operator()(const f32x4 (&acc)[2][2][4][2], const Unit& u, int wr, int wc, int fr, int fq) const {
        const int row0 = u.pm * BM + wr * 64 + fr; const size_t off0 = (size_t)row0 * 2048 + u.pn * BM + wc * 32 + 8 * fq;
        const float* Rb = R + off0; float* Ob = out + off0; bf16_t* Xb = xb + off0; float* Sb = ssq + row0;
#pragma unroll
        for (int ai = 0; ai < 2; ++ai)
#pragma unroll
            for (int m = 0; m < 4; ++m) { const int ro = (ai * HALF + m * 16) * 2048; float ss = 0.f;
#pragma unroll
                for (int bj = 0; bj < 2; ++bj) {
                    const f32x4 r0 = *(const f32x4*)(Rb + ro + bj * HALF), r1 = *(const f32x4*)(Rb + ro + bj * HALF + 4);
                    const f32x4 o0 = acc[ai][bj][m][0] + r0, o1 = acc[ai][bj][m][1] + r1;
                    *(f32x4*)(Ob + ro + bj * HALF) = o0; *(f32x4*)(Ob + ro + bj * HALF + 4) = o1;
                    *(u32x4*)(Xb + ro + bj * HALF) = pack8(o0, o1);
                    ss += (o0[0] * o0[0] + o0[1] * o0[1]) + (o0[2] * o0[2] + o0[3] * o0[3]) + (o1[0] * o1[0] + o1[1] * o1[1]) + (o1[2] * o1[2] + o1[3] * o1[3]); }
                ss += __shfl_xor(ss, 16); ss += __shfl_xor(ss, 32);
                if (fq == 0) unsafeAtomicAdd(Sb + ai * HALF + m * 16, ss);
                asm volatile("" ::: "memory"); }
    }
};
struct EpiScale {
    static constexpr bool PERM = true, AFTER_DRAIN = false; bf16_t* O; const float* ssq;
    __device__ __forceinline__ void operator()(const f32x4 (&acc)[2][2][4][2], const Unit& u, int wr, int wc, int fr, int fq) const {
        const int row0 = u.pm * BM + wr * 64 + fr;
        bf16_t* base = O + ((size_t)row0 * 2048 + u.pn * BM + wc * 32 + 8 * fq); const float* Sb = ssq + row0;
#pragma unroll
        for (int ai = 0; ai < 2; ++ai)
#pragma unroll
            for (int m = 0; m < 4; ++m) { const float rs = rsqrtf(Sb[ai * HALF + m * 16] * (1.f / 2048.f) + 1e-6f);
#pragma unroll
                for (int bj = 0; bj < 2; ++bj) *(u32x4*)(base + (ai * HALF + m * 16) * 2048 + bj * HALF) = pack8(acc[ai][bj][m][0] * rs, acc[ai][bj][m][1] * rs); }
    }
};
struct EpiQK {
    static constexpr bool PERM = true, AFTER_DRAIN = false; bf16_t* Q; bf16_t* K; const float* ssq; const float* rope; float qscale;
    __device__ __forceinline__ void operator()(const f32x4 (&acc)[2][2][4][2], const Unit& u, int wr, int wc, int fr, int fq) const {
        const int row0 = u.pm * BM + wr * 64 + fr; const bool isq = u.pn < 8;
        const int cl = wc * 32 + 8 * fq;
        bf16_t* base = isq ? (Q + ((size_t)row0 * 2048 + u.pn * BM + cl)) : (K + ((size_t)row0 * 512 + (u.pn - 8) * BM + cl));
        const int ld = isq ? 2048 : 512; const float sc = isq ? qscale : 1.f;
        const float* rp = rope + (size_t)(row0 & 4095) * 64 + (cl & 63);
        const float* Sb = ssq + row0;
#pragma unroll
        for (int ai = 0; ai < 2; ++ai)
#pragma unroll
            for (int m = 0; m < 4; ++m) { const int ro = ai * HALF + m * 16; const float rs = rsqrtf(Sb[ro] * (1.f / 2048.f) + 1e-6f) * sc;
                const f32x4 t0 = *(const f32x4*)(rp + (size_t)ro * 64), t1 = *(const f32x4*)(rp + (size_t)ro * 64 + 4);
#pragma unroll
                for (int bj = 0; bj < 2; ++bj) {
                    const f32x4 a = acc[ai][bj][m][0] * rs, b = acc[ai][bj][m][1] * rs; f32x4 oa, ob;
                    oa[0] = a[0] * t0[0] - a[1] * t0[1]; oa[1] = a[1] * t0[0] + a[0] * t0[1]; oa[2] = a[2] * t0[2] - a[3] * t0[3]; oa[3] = a[3] * t0[2] + a[2] * t0[3];
                    ob[0] = b[0] * t1[0] - b[1] * t1[1]; ob[1] = b[1] * t1[0] + b[0] * t1[1]; ob[2] = b[2] * t1[2] - b[3] * t1[3]; ob[3] = b[3] * t1[2] + b[2] * t1[3];
                    *(u32x4*)(base + (size_t)ro * ld + bj * HALF) = pack8(oa, ob); } }
    }
};
struct EpiVt {
    static constexpr bool PERM = true, AFTER_DRAIN = false; bf16_t* Vt; const float* ssq;
    __device__ __forceinline__ void operator()(const f32x4 (&acc)[2][2][4][2], const Unit& u, int wr, int wc, int fr, int fq) const {
        const int col0 = u.pn * BM + wc * 32 + 8 * fq;
        bf16_t* base = Vt + ((size_t)(u.pm * BM + wr * 64 + fr) * 16384 + col0);
        f32x4 r0[2], r1[2];
#pragma unroll
        for (int bj = 0; bj < 2; ++bj) { const f32x4 s0 = *(const f32x4*)(ssq + col0 + bj * HALF), s1 = *(const f32x4*)(ssq + col0 + bj * HALF + 4);
#pragma unroll
            for (int q = 0; q < 4; ++q) { r0[bj][q] = rsqrtf(s0[q] * (1.f / 2048.f) + 1e-6f); r1[bj][q] = rsqrtf(s1[q] * (1.f / 2048.f) + 1e-6f); } }
#pragma unroll
        for (int ai = 0; ai < 2; ++ai)
#pragma unroll
            for (int m = 0; m < 4; ++m)
#pragma unroll
                for (int bj = 0; bj < 2; ++bj) *(u32x4*)(base + (size_t)(ai * HALF + m * 16) * 16384 + bj * HALF) = pack8(acc[ai][bj][m][0] * r0[bj], acc[ai][bj][m][1] * r1[bj]);
    }
};
template <class Epi, class Sched, bool ALIGN_EPI = false, bool SP2 = false>
__device__ __forceinline__ void gemm_phase(PG8_LAS unsigned char* lds, const Gemm g, const Sched& S, const Epi& E) {
    const int tid = threadIdx.x, wid = __builtin_amdgcn_readfirstlane(tid >> 6), lane = tid & 63, wr = wid >> 2, wc = wid & 3, fr = lane & 15, fq = lane >> 4;
    const int K = g.K, nt = K / BK;
    unsigned voffA[2], voffB[2];
#pragma unroll
    for (int i = 0; i < 2; ++i) { int R, C; stage_rc(tid * 16 + i * 8192, R, C); const int Rb = Epi::PERM ? ((R & ~31) + perm32(R & 31)) : R;
        voffA[i] = (unsigned)(R * K + C) * 2u; voffB[i] = (unsigned)(Rb * K + C) * 2u; }
    const size_t kstep = (size_t)(BK * 2);
    const size_t hstep = (size_t)HALF * K * 2;
    const size_t tstep = 2 * hstep;
    const unsigned ldsw = (unsigned)wid * 1024u;
    const int aoff = lds_byte(wr * 64 + fr, fq * 8), boff = lds_byte(wc * 32 + fr, fq * 8);
#define PG8_SA(b, h) (((b) * 2 + (h)) * HTB)
#define PG8_SB(b, h) ((4 + (b) * 2 + (h)) * HTB)
#define PG8_STAGE(bufoff, gbase, voff) do { _Pragma("unroll") for (int _i = 0; _i < 2; ++_i) \
        __builtin_amdgcn_global_load_lds((const unsigned*)((const char*)(gbase) + (voff)[_i]), (PG8_LAS unsigned*)(lds + (bufoff) + ldsw + _i * 8192), 16, 0, 0); } while (0)
#define PG8_LDA(dst, b, h) do { _Pragma("unroll") for (int m = 0; m < 4; ++m) _Pragma("unroll") for (int k = 0; k < 2; ++k) dst[m][k] = *(const PG8_LAS bf16x8*)(lds + PG8_SA(b, h) + aoff + m * 2048 + k * 1024); } while (0)
#define PG8_LDB(dst, b, h) do { _Pragma("unroll") for (int n = 0; n < 2; ++n) _Pragma("unroll") for (int k = 0; k < 2; ++k) dst[n][k] = *(const PG8_LAS bf16x8*)(lds + PG8_SB(b, h) + boff + n * 2048 + k * 1024); } while (0)
#define PG8_MMA(ai, bj, At, Bt) do { __builtin_amdgcn_s_setprio(1); _Pragma("unroll") for (int m = 0; m < 4; ++m) _Pragma("unroll") for (int n = 0; n < 2; ++n) _Pragma("unroll") for (int k = 0; k < 2; ++k) \
        acc[ai][bj][m][n] = __builtin_amdgcn_mfma_f32_16x16x32_bf16(Bt[n][k], At[m][k], acc[ai][bj][m][n], 0, 0, 0); __builtin_amdgcn_s_setprio(0); } while (0)
#define PG8_WAIT_V(n) asm volatile("s_waitcnt vmcnt(" #n ")" ::: "memory")
#define PG8_WAIT_L(n) asm volatile("s_waitcnt lgkmcnt(" #n ")" ::: "memory")
#define PG8_BAR __builtin_amdgcn_s_barrier()
#define PG8_SCHED __builtin_amdgcn_sched_barrier(0)
    Unit cur, nxt; int ui = 0;
    if (!S.next(0, cur)) return;
    f32x4 acc[2][2][4][2];
#pragma unroll
    for (int a = 0; a < 2; ++a)
#pragma unroll
        for (int b = 0; b < 2; ++b)
#pragma unroll
            for (int m = 0; m < 4; ++m)
#pragma unroll
                for (int n = 0; n < 2; ++n) acc[a][b][m][n] = (f32x4){0.f, 0.f, 0.f, 0.f};
    bf16x8 At[4][2], B0[2][2], B1[2][2];
    const char* cA = (const char*)g.A + (size_t)cur.pm * tstep; const char* cB = (const char*)g.Bt + (size_t)cur.pn * tstep;
    S.a_ready(cur);
    if constexpr (SP2) {
        PG8_STAGE(PG8_SB(0, 0), cB, voffB); PG8_STAGE(PG8_SB(0, 1), cB + hstep, voffB); PG8_STAGE(PG8_SA(0, 0), cA, voffA); PG8_STAGE(PG8_SA(0, 1), cA + hstep, voffA);
        if (wr == 1) PG8_BAR;
        PG8_WAIT_V(2); PG8_BAR;
        PG8_STAGE(PG8_SB(1, 0), cB + kstep, voffB); PG8_STAGE(PG8_SA(1, 0), cA + kstep, voffA); PG8_STAGE(PG8_SB(1, 1), cB + hstep + kstep, voffB);
        PG8_WAIT_V(6); PG8_BAR;
    } else {
        PG8_STAGE(PG8_SB(0, 0), cB, voffB); PG8_STAGE(PG8_SA(0, 0), cA, voffA); PG8_STAGE(PG8_SB(0, 1), cB + hstep, voffB); PG8_STAGE(PG8_SA(0, 1), cA + hstep, voffA);
        if (wr == 1) PG8_BAR;
        PG8_WAIT_V(4); PG8_BAR;
        PG8_STAGE(PG8_SB(1, 0), cB + kstep, voffB); PG8_STAGE(PG8_SA(1, 0), cA + kstep, voffA); PG8_STAGE(PG8_SB(1, 1), cB + hstep + kstep, voffB);
        PG8_WAIT_V(6); PG8_BAR;
    }
    for (;;) {
        const bool has_next = S.next(ui + 1, nxt);
        const char* nA = has_next ? (const char*)g.A + (size_t)nxt.pm * tstep : cA; const char* nB = has_next ? (const char*)g.Bt + (size_t)nxt.pn * tstep : cB;
        for (int t = 0; t < nt; t += 2) {
            const bool last = (t == nt - 2);
            const char* a1 = cA + (size_t)(t + 1) * kstep;
            const char* a2 = last ? nA : cA + (size_t)(t + 2) * kstep; const char* b2 = last ? nB : cB + (size_t)(t + 2) * kstep;
            const char* a3 = a2 + kstep; const char* b3 = b2 + kstep;
            if (last && has_next) S.a_ready(nxt);
            if constexpr (SP2) {
            PG8_LDB(B0, 0, 0); PG8_LDB(B1, 0, 1); PG8_SCHED; PG8_LDA(At, 0, 0); PG8_STAGE(PG8_SA(1, 1), a1 + hstep, voffA);
            PG8_WAIT_V(8); PG8_WAIT_L(0); PG8_BAR; PG8_MMA(0, 0, At, B0); PG8_MMA(0, 1, At, B1); PG8_BAR; PG8_SCHED;
            PG8_LDA(At, 0, 1); PG8_STAGE(PG8_SB(0, 0), b2, voffB); PG8_STAGE(PG8_SB(0, 1), b2 + hstep, voffB); PG8_STAGE(PG8_SA(0, 0), a2, voffA);
            PG8_WAIT_V(8); PG8_WAIT_L(0); PG8_BAR; PG8_MMA(1, 0, At, B0); PG8_MMA(1, 1, At, B1); PG8_BAR; PG8_SCHED;
            PG8_LDB(B0, 1, 0); PG8_LDB(B1, 1, 1); PG8_SCHED; PG8_LDA(At, 1, 0); PG8_STAGE(PG8_SA(0, 1), a2 + hstep, voffA);
            PG8_WAIT_V(8); PG8_WAIT_L(0); PG8_BAR; PG8_MMA(0, 0, At, B0); PG8_MMA(0, 1, At, B1); PG8_BAR; PG8_SCHED;
            PG8_LDA(At, 1, 1); PG8_STAGE(PG8_SB(1, 0), b3, voffB); PG8_STAGE(PG8_SB(1, 1), b3 + hstep, voffB); PG8_STAGE(PG8_SA(1, 0), a3, voffA);
            PG8_WAIT_V(8); PG8_WAIT_L(0); PG8_BAR; PG8_MMA(1, 0, At, B0); PG8_MMA(1, 1, At, B1); PG8_BAR; PG8_SCHED;
            } else {
            PG8_LDB(B0, 0, 0); PG8_SCHED; PG8_LDA(At, 0, 0); PG8_STAGE(PG8_SA(1, 1), a1 + hstep, voffA);
            PG8_WAIT_L(8); PG8_BAR; PG8_WAIT_L(0); PG8_MMA(0, 0, At, B0); PG8_BAR; PG8_SCHED;
            PG8_LDB(B1, 0, 1); PG8_STAGE(PG8_SB(0, 0), b2, voffB);
            PG8_BAR; PG8_WAIT_L(0); PG8_MMA(0, 1, At, B1); PG8_BAR;
            PG8_LDA(At, 0, 1); PG8_STAGE(PG8_SA(0, 0), a2, voffA);
            PG8_BAR; PG8_WAIT_L(0); PG8_MMA(1, 0, At, B0); PG8_BAR; PG8_SCHED;
            PG8_STAGE(PG8_SB(0, 1), b2 + hstep, voffB);
            PG8_WAIT_V(6); PG8_BAR; PG8_MMA(1, 1, At, B1); PG8_BAR;
            PG8_LDB(B0, 1, 0); PG8_SCHED; PG8_LDA(At, 1, 0); PG8_STAGE(PG8_SA(0, 1), a2 + hstep, voffA);
            PG8_WAIT_L(8); PG8_BAR; PG8_WAIT_L(0); PG8_MMA(0, 0, At, B0); PG8_BAR; PG8_SCHED;
            PG8_LDB(B1, 1, 1); PG8_STAGE(PG8_SB(1, 0), b3, voffB);
            PG8_BAR; PG8_WAIT_L(0); PG8_MMA(0, 1, At, B1); PG8_BAR;
            PG8_LDA(At, 1, 1); PG8_STAGE(PG8_SA(1, 0), a3, voffA);
            PG8_BAR; PG8_WAIT_L(0); PG8_MMA(1, 0, At, B0); PG8_BAR; PG8_SCHED;
            PG8_STAGE(PG8_SB(1, 1), b3 + hstep, voffB);
            PG8_WAIT_V(6); PG8_BAR; PG8_MMA(1, 1, At, B1); PG8_BAR;
            }
        }
        if constexpr (ALIGN_EPI) { if (wr == 0) PG8_BAR; }
        if constexpr (!Epi::AFTER_DRAIN) { E(acc, cur, wr, wc, fr, fq); S.done(cur); }
        if (!has_next) break;
#pragma unroll
        for (int a = 0; a < 2; ++a)
#pragma unroll
            for (int b = 0; b < 2; ++b)
#pragma unroll
                for (int m = 0; m < 4; ++m)
#pragma unroll
                    for (int n = 0; n < 2; ++n) acc[a][b][m][n] = (f32x4){0.f, 0.f, 0.f, 0.f};
        cur = nxt; cA = nA; cB = nB; ++ui;
        if constexpr (ALIGN_EPI) { if (wr == 1) PG8_BAR; }
    }
    PG8_WAIT_V(0);
    if constexpr (!ALIGN_EPI) { if (wr == 0) PG8_BAR; }
    PG8_BAR;
    if constexpr (Epi::AFTER_DRAIN) { E.fused(acc, cur, wr, wc, fr, fq, lds, wid, lane); S.done(cur); }
#undef PG8_SA
#undef PG8_SB
#undef PG8_STAGE
#undef PG8_LDA
#undef PG8_LDB
#undef PG8_MMA
#undef PG8_WAIT_V
#undef PG8_WAIT_L
#undef PG8_BAR
#undef PG8_SCHED
}
}
#define GAS __attribute__((address_space(1)))
#define LAS __attribute__((address_space(3)))
typedef unsigned short bf16;
typedef unsigned v4u __attribute__((ext_vector_type(4)));
typedef unsigned v2u __attribute__((ext_vector_type(2)));
typedef float f32x4 __attribute__((ext_vector_type(4)));
constexpr int NWAVES = 8;
constexpr int LDS_BYTES = 147456, LDSCTL_OFF = 131072;
constexpr int CW_BAR = 4096;
constexpr size_t MiB = 1u << 20;
constexpr size_t WS_CTL = 0, CTL_BYTES = 1 * MiB;
constexpr size_t WS_SSQ_A = 256 * 1024, WS_SSQ_B = 320 * 1024, WS_SSQ_C = 384 * 1024;
constexpr size_t WS_WCS = 1 * MiB, WS_ROPE = 2 * MiB, WS_KEYS = 3 * MiB;
constexpr size_t WS_WOF = 8 * MiB, WS_WQKV = 16 * MiB, WS_WOA = 28 * MiB, WS_WQ0 = 36 * MiB, WS_WQ1 = 44 * MiB;
constexpr size_t WS_A2 = 64 * MiB, WS_TW = 65 * MiB;
constexpr size_t WS_U0 = 128 * MiB, WS_V0 = 192 * MiB, WS_U1 = 256 * MiB, WS_V1 = 320 * MiB;
constexpr size_t WS_XG = 384 * MiB, WS_XB = 384 * MiB;
constexpr size_t WS_ZT = 448 * MiB;
constexpr size_t WS_Y = 576 * MiB;
constexpr size_t WS_Q = 448 * MiB;
constexpr size_t WS_EI = 640 * MiB, WS_GW = 648 * MiB;
constexpr size_t WS_QB = 448 * MiB, WS_KB = 512 * MiB, WS_VT = 528 * MiB, WS_O = 576 * MiB;

__device__ __forceinline__ unsigned f2bf(float f) { unsigned u = __builtin_bit_cast(unsigned, f); return (u + 0x7fffu + ((u >> 16) & 1u)) >> 16; }
__device__ __forceinline__ unsigned pk2(float lo, float hi) { return f2bf(lo) | (f2bf(hi) << 16); }

struct Args { const float* in[12]; float* out; unsigned char* ws; int ph_lo, ph_hi; };

__device__ __forceinline__ int qkv_row(int n) { if (n >= 2560) return n; const int d = n & 63, pc = (d < 32) ? 2 * d : 2 * (d - 32) + 1; return (n & ~63) + pc; }
template <int MODE>
__device__ __forceinline__ void transpose_item(const float* W, int K, int N, const float* gain, bf16* WT, LAS float* scr, int item, int lane) {
    const int nblk = N / 32, kb = item / nblk, nb = item % nblk, k0 = 64 * kb, n0 = 32 * nb;
#pragma unroll 8
    for (int i = 0; i < 32; ++i) { const int kk = 2 * i + (lane >> 5); float v = W[(size_t)(k0 + kk) * N + n0 + (lane & 31)]; if (gain) v *= gain[k0 + kk]; scr[kk * 33 + (lane & 31)] = v; }
    asm volatile("s_waitcnt lgkmcnt(0)" ::: "memory");
    const int c = lane & 7;
#pragma unroll
    for (int j = 0; j < 4; ++j) { const int n = (lane >> 3) + 8 * j; const LAS float* s = scr + (8 * c) * 33 + n;
        v4u o; o.x = pk2(s[0 * 33], s[1 * 33]); o.y = pk2(s[2 * 33], s[3 * 33]); o.z = pk2(s[4 * 33], s[5 * 33]); o.w = pk2(s[6 * 33], s[7 * 33]);
        const int row = (MODE == 1) ? qkv_row(n0 + n) : (n0 + n);
        *(v4u*)(WT + (size_t)row * K + k0 + 8 * c) = o; }
    asm volatile("s_waitcnt lgkmcnt(0)" ::: "memory");
}
__device__ __forceinline__ float wsum(float v) {
#pragma unroll
    for (int o = 1; o < 64; o <<= 1) v += __shfl_xor(v, o);
    return v;
}
__device__ __forceinline__ void cvt_stream(const float* src, bf16* dst, size_t n8, size_t gtid, size_t ngt) {
    for (size_t i = gtid; i < n8; i += ngt) {
        const f32x4 a = *(const f32x4*)(src + i * 8), b = *(const f32x4*)(src + i * 8 + 4);
        v4u o; o.x = pk2(a[0], a[1]); o.y = pk2(a[2], a[3]); o.z = pk2(b[0], b[1]); o.w = pk2(b[2], b[3]);
        *(v4u*)(dst + i * 8) = o;
    }
}
__device__ __forceinline__ void cvt_stream8(const float* src, unsigned char* dst, size_t n16, size_t gtid, size_t ngt, float scale) {
    for (size_t i = gtid; i < n16; i += ngt) {
        v4u o;
#pragma unroll
        for (int q = 0; q < 4; ++q) { f32x4 a = *(const f32x4*)(src + i * 16 + 4 * q) * scale;
#pragma unroll
            for (int e = 0; e < 4; ++e) a[e] = fminf(fmaxf(a[e], -448.f), 448.f);
            int w = 0; w = __builtin_amdgcn_cvt_pk_fp8_f32(a[0], a[1], w, false); w = __builtin_amdgcn_cvt_pk_fp8_f32(a[2], a[3], w, true); o[q] = (unsigned)w; }
        *(v4u*)(dst + i * 16) = o;
    }
}
#define XB_TMO      128
#define XB_XCNT(j)  (256  + 64 * (j))
#define XB_XSUB(j)  (1280 + 64 * (j))
#define XB_XGEN(j)  (2304 + 64 * (j))
#define XB_TOP      3328
#define XB_TOPGEN   3392
#define XCD_BAR_WORDS 3456
#define XB_SPIN_CAP (1u << 18)

__device__ __forceinline__ unsigned xb_ld(unsigned* p)              { return __hip_atomic_load(p, __ATOMIC_RELAXED, __HIP_MEMORY_SCOPE_AGENT); }
__device__ __forceinline__ unsigned xb_add(unsigned* p, unsigned v) { return __hip_atomic_fetch_add(p, v, __ATOMIC_RELAXED, __HIP_MEMORY_SCOPE_AGENT); }
__device__ __forceinline__ unsigned xb_xcc_id() { return (unsigned)__builtin_amdgcn_s_getreg((3 << 11) | 20) & 0xFu; }
#define XB_SPIN(cond, bar) do { unsigned _sp = 0; while (cond) { __builtin_amdgcn_s_sleep(1); \
    if ((++_sp & 255u) == 0u) { if (xb_ld(&(bar)[XB_TMO])) break; if (_sp > XB_SPIN_CAP) { atomicAdd(&(bar)[XB_TMO], 1u); break; } } } } while (0)

struct XcdBarrier {
    unsigned* bar; unsigned x;
    volatile LAS unsigned* st;
};

__device__ __forceinline__ XcdBarrier xcd_barrier_post(unsigned* bar, volatile LAS unsigned* st) {
    XcdBarrier b; b.bar = bar; b.x = xb_xcc_id(); b.st = st;
    if (threadIdx.x == 0) (void)xb_add(&bar[XB_XCNT(b.x)], 1u);
    return b;
}
__device__ __forceinline__ void xcd_barrier_complete(unsigned* bar, unsigned x, unsigned& nloc, unsigned& nx) {
    const unsigned G = gridDim.x * gridDim.y * gridDim.z;
    unsigned sum, cnt, mine, sp = 0u;
    for (;;) {
        sum = 0u; cnt = 0u; mine = 0u;
#pragma unroll
        for (unsigned j = 0; j < 16; ++j) { const unsigned c = xb_ld(&bar[XB_XCNT(j)]); sum += c; cnt += (c > 0u) ? 1u : 0u; mine = (j == x) ? c : mine; }
        if (sum == G) break;
        __builtin_amdgcn_s_sleep(1);
        if ((++sp & 255u) == 0u) { if (xb_ld(&bar[XB_TMO])) break; if (sp > XB_SPIN_CAP) { atomicAdd(&bar[XB_TMO], 1u); break; } }
    }
    nloc = mine > 0u ? mine : 1u; nx = cnt > 0u ? cnt : 1u;
}

__device__ __forceinline__ void xcd_barrier(const XcdBarrier& b) {
    asm volatile("s_waitcnt vmcnt(0)" ::: "memory");
    __syncthreads();
    if (threadIdx.x == 0) {
        unsigned* bar = b.bar;
        __builtin_amdgcn_s_waitcnt(0);
        unsigned nloc = b.st[0], nx = b.st[1];
        if (nloc == 0u) { xcd_barrier_complete(bar, b.x, nloc, nx); b.st[0] = nloc; b.st[1] = nx; }
        const unsigned old = xb_add(&bar[XB_XSUB(b.x)], 1u);
        const unsigned gen = old / nloc;
        if (old + 1u == (gen + 1u) * nloc) {
            __builtin_amdgcn_fence(__ATOMIC_RELEASE, "agent");
            asm volatile("s_waitcnt vmcnt(0)" ::: "memory");
            const unsigned og = xb_add(&bar[XB_TOP], 1u);
            const unsigned tg = og / nx;
            if (og + 1u == (tg + 1u) * nx) xb_add(&bar[XB_TOPGEN], 1u);
            else XB_SPIN(xb_ld(&bar[XB_TOPGEN]) == tg, bar);
            __builtin_amdgcn_fence(__ATOMIC_ACQUIRE, "agent");
            xb_add(&bar[XB_XGEN(b.x)], 1u);
            asm volatile("s_waitcnt vmcnt(0)" ::: "memory");
        } else {
            XB_SPIN(xb_ld(&bar[XB_XGEN(b.x)]) == gen, bar);
            __builtin_amdgcn_fence(__ATOMIC_ACQUIRE, "agent");
            asm volatile("s_waitcnt vmcnt(0)" ::: "memory");
        }
    }
    __syncthreads();
}
typedef float f32x16 __attribute__((ext_vector_type(16)));
typedef short s16x8 __attribute__((ext_vector_type(8)));
typedef __bf16 bf16x2_t __attribute__((ext_vector_type(2)));
__device__ __forceinline__ unsigned ordf(float f) { const unsigned u = __float_as_uint(f); return (u & 0x80000000u) ? ~u : (u | 0x80000000u); }
__device__ __forceinline__ float unordf(unsigned u) { return __uint_as_float((u & 0x80000000u) ? (u & 0x7fffffffu) : ~u); }
__device__ __forceinline__ unsigned umax_(unsigned a, unsigned b) { return a > b ? a : b; }
#define DPPU(v, ctrl) ((unsigned)__builtin_amdgcn_update_dpp(0, (int)(v), (ctrl), 0xf, 0xf, true))
#define DPPF(v, ctrl) __int_as_float(__builtin_amdgcn_update_dpp(0, __float_as_int(v), (ctrl), 0xf, 0xf, true))
__device__ __forceinline__ unsigned max32(unsigned v) {
    v = umax_(v, DPPU(v, 0xB1)); v = umax_(v, DPPU(v, 0x4E)); v = umax_(v, DPPU(v, 0x141)); v = umax_(v, DPPU(v, 0x140));
    const auto r = __builtin_amdgcn_permlane16_swap(v, v, false, false);
    return umax_(r[0], r[1]);
}
__device__ __forceinline__ float sum16(float v) {
    v += DPPF(v, 0xB1); v += DPPF(v, 0x4E); v += DPPF(v, 0x141); v += DPPF(v, 0x140); return v;
}
__device__ __forceinline__ unsigned bperm(unsigned v, int srclane) { return (unsigned)__builtin_amdgcn_ds_bpermute(srclane << 2, (int)v); }
__device__ __forceinline__ unsigned top16_of4(unsigned p0, unsigned p1, unsigned p2, unsigned p3, int c15) {
    unsigned W = 0u;
    for (int it = 0; it < 16; ++it) {
        const unsigned m = max32(umax_(umax_(p0, p1), umax_(p2, p3)));
        W = (c15 == it) ? m : W;
        p0 = (p0 == m) ? 0u : p0; p1 = (p1 == m) ? 0u : p1; p2 = (p2 == m) ? 0u : p2; p3 = (p3 == m) ? 0u : p3;
    }
    return W;
}
__device__ __forceinline__ unsigned top16_of2(unsigned p0, unsigned p1, int c15) {
    unsigned W = 0u;
    for (int it = 0; it < 16; ++it) {
        const unsigned m = max32(umax_(p0, p1));
        W = (c15 == it) ? m : W;
        p0 = (p0 == m) ? 0u : p0; p1 = (p1 == m) ? 0u : p1;
    }
    return W;
}
__device__ __forceinline__ void topk_unit(const bf16* q, const bf16* keys, int* EI, float* GW, int t0, int h, int lane) {
    const int c = lane & 31, hi = lane >> 5, c15 = lane & 15, hbase = lane & 32;
    int f0 = 0, f1 = 0;
    { int cnt = 0;
#pragma unroll
      for (int i = 0; i < 16; ++i)
#pragma unroll
        for (int j = 0; j < 16; ++j) if ((i + 1) * (j + 1) <= 16) { f0 = (cnt == c) ? (i * 16 + j) : f0; f1 = (cnt == c + 32) ? (i * 16 + j) : f1; ++cnt; } }
    unsigned W[2][16];
#pragma unroll
    for (int p = 0; p < 2; ++p) {
        f32x16 acc[4];
#pragma unroll
        for (int kb = 0; kb < 4; ++kb)
#pragma unroll
            for (int r = 0; r < 16; ++r) acc[kb][r] = 0.f;
        const bf16* qp = q + (size_t)(t0 + c) * 2048 + h * 256 + p * 128 + hi * 8;
        const bf16* kp = keys + (size_t)((h * 2 + p) * 128 + c) * 128 + hi * 8;
        asm volatile("" : "+v"(qp), "+v"(kp));
#pragma unroll 2
        for (int ks = 0; ks < 8; ++ks) {
            const s16x8 a = *(const s16x8*)(qp + ks * 16);
#pragma unroll
            for (int kb = 0; kb < 4; ++kb) { const s16x8 b = *(const s16x8*)(kp + kb * 32 * 128 + ks * 16); acc[kb] = __builtin_amdgcn_mfma_f32_32x32x16_bf16(a, b, acc[kb], 0, 0, 0); }
        }
#pragma unroll
        for (int r = 0; r < 16; ++r) {
            const unsigned p0 = (ordf(acc[0][r]) & ~127u) | (unsigned)(127 - c), p1 = (ordf(acc[1][r]) & ~127u) | (unsigned)(95 - c),
                           p2 = (ordf(acc[2][r]) & ~127u) | (unsigned)(63 - c), p3 = (ordf(acc[3][r]) & ~127u) | (unsigned)(31 - c);
            W[p][r] = top16_of4(p0, p1, p2, p3, c15);
        }
    }
#pragma unroll
    for (int r = 0; r < 16; ++r) {
        const unsigned w0 = W[0][r], w1 = W[1][r];
        const float a0 = unordf(bperm(w0, hbase + (f0 >> 4)) & ~127u), b0 = unordf(bperm(w1, hbase + (f0 & 15)) & ~127u);
        const float a1 = unordf(bperm(w0, hbase + (f1 >> 4)) & ~127u), b1 = unordf(bperm(w1, hbase + (f1 & 15)) & ~127u);
        const unsigned cp0 = (ordf(a0 + b0) & ~63u) | (unsigned)(63 - c);
        const unsigned cp1 = (c + 32 < 50) ? ((ordf(a1 + b1) & ~63u) | (unsigned)(31 - c)) : 0u;
        const unsigned Wc = top16_of2(cp0, cp1, c15);
        const int slot = 63 - (int)(Wc & 63u);
        const unsigned fa = bperm((unsigned)f0, hbase + (slot & 31)), fb = bperm((unsigned)f1, hbase + (slot & 31));
        const int flat = (slot < 32) ? (int)fa : (int)fb;
        const float val = unordf(Wc & ~63u);
        const float vmax = __uint_as_float(bperm(__float_as_uint(val), hbase));
        const float e = __expf(val - vmax);
        const float g = e / sum16(e);
        const int k1 = 127 - (int)(bperm(w0, hbase + (flat >> 4)) & 127u), k2 = 127 - (int)(bperm(w1, hbase + (flat & 15)) & 127u);
        const int tok = t0 + (r & 3) + 8 * (r >> 2) + 4 * hi;
        if (c < 16) { EI[(size_t)(tok * 8 + h) * 16 + c] = k1 * 128 + k2; GW[(size_t)(tok * 8 + h) * 16 + c] = g; }
    }
}

__device__ __forceinline__ float gelu_tanh_f(float x) {
    const float u = 0.7978845608028654f * (x + 0.044715f * x * x * x);
    const float e = __expf(2.f * u);
    const float th = 1.f - 2.f / (e + 1.f);
    return 0.5f * x * (1.f + th);
}
__device__ __forceinline__ float wave_sum_bfly(float v) {
#pragma unroll
    for (int o = 1; o < 64; o <<= 1) v += __shfl_xor(v, o);
    return v;
}
typedef float f32x2_ __attribute__((ext_vector_type(2)));
#define U_SCALE 1024.f
#define V_SCALE 256.f
__device__ __forceinline__ void peer_token(float* xio, const float* gain, const int* EI, const float* GW, const unsigned char* U8, const unsigned char* V8, bf16* xb, float* ssq, const float* fin, int t, int lane) {
    float* xr = xio + (size_t)t * 2048 + 16 * lane;
    f32x2_ h2[16];
    {
        f32x4 xv[8]; float s = 0.f;
#pragma unroll
        for (int j = 0; j < 2; ++j)
#pragma unroll
            for (int q = 0; q < 4; ++q) xv[4 * j + q] = *(const f32x4*)(xr + 1024 * j + 4 * q);
#pragma unroll
        for (int j = 0; j < 8; ++j) s += (xv[j][0] * xv[j][0] + xv[j][1] * xv[j][1]) + (xv[j][2] * xv[j][2] + xv[j][3] * xv[j][3]);
        const float rs = rsqrtf(wave_sum_bfly(s) * (1.f / 2048.f) + EPS);
#pragma unroll
        for (int j = 0; j < 2; ++j)
#pragma unroll
            for (int q = 0; q < 4; ++q) { const f32x4 g = *(const f32x4*)(gain + 1024 * j + 16 * lane + 4 * q);
                h2[8 * j + 2 * q] = (f32x2_){xv[4 * j + q][0] * rs * g[0], xv[4 * j + q][1] * rs * g[1]}; h2[8 * j + 2 * q + 1] = (f32x2_){xv[4 * j + q][2] * rs * g[2], xv[4 * j + q][3] * rs * g[3]}; }
    }
    f32x2_ acc[16];
#pragma unroll
    for (int i = 0; i < 16; ++i) acc[i] = (f32x2_){0.f, 0.f};
    const unsigned lo16 = 16u * (unsigned)lane;
    const int ei_lo = EI[(size_t)t * 128 + lane], ei_hi = EI[(size_t)t * 128 + 64 + lane];
    const float gw_lo = GW[(size_t)t * 128 + lane], gw_hi = GW[(size_t)t * 128 + 64 + lane];
    for (int half = 0; half < 2; ++half) {
    const int eiv = half ? ei_hi : ei_lo; const float gwv = half ? gw_hi : gw_lo;
    for (int grp = 0; grp < 16; ++grp) {
        v4u uu[4][2], vv[4][2];
#pragma unroll
        for (int k = 0; k < 4; ++k) {
            const int e = __builtin_amdgcn_readlane(eiv, grp * 4 + k);
            const unsigned char* up = U8 + (size_t)e * 2048; const unsigned char* vp = V8 + (size_t)e * 2048;
            uu[k][0] = *(const v4u*)(up + lo16); uu[k][1] = *(const v4u*)(up + lo16 + 1024); vv[k][0] = *(const v4u*)(vp + lo16); vv[k][1] = *(const v4u*)(vp + lo16 + 1024);
        }
        float d[4];
#pragma unroll
        for (int k = 0; k < 4; ++k) {
            f32x2_ d2 = (f32x2_){0.f, 0.f};
#pragma unroll
            for (int j = 0; j < 2; ++j)
#pragma unroll
                for (int q = 0; q < 4; ++q) { const int w = (int)uu[k][j][q];
                    d2 = __builtin_elementwise_fma(__builtin_amdgcn_cvt_pk_f32_fp8(w, false), h2[8 * j + 2 * q], d2);
                    d2 = __builtin_elementwise_fma(__builtin_amdgcn_cvt_pk_f32_fp8(w, true), h2[8 * j + 2 * q + 1], d2); }
            d[k] = d2.x + d2.y;
        }
        float t2[2];
#pragma unroll
        for (int i = 0; i < 2; ++i) { const auto r = __builtin_amdgcn_permlane32_swap(__float_as_uint(d[i]), __float_as_uint(d[i + 2]), false, false); t2[i] = __uint_as_float(r[0]) + __uint_as_float(r[1]); }
        float w;
        { const auto r = __builtin_amdgcn_permlane16_swap(__float_as_uint(t2[0]), __float_as_uint(t2[1]), false, false); w = __uint_as_float(r[0]) + __uint_as_float(r[1]); }
        w += DPPF(w, 0x128); w += DPPF(w, 0xB1); w += DPPF(w, 0x4E); w += DPPF(w, 0x141);
        const float gk = __uint_as_float(bperm(__float_as_uint(gwv), grp * 4 + (lane >> 4)));
        const float wgt = gk * gelu_tanh_f(w * (1.f / U_SCALE)) * (1.f / V_SCALE);
#pragma unroll
        for (int k = 0; k < 4; ++k) {
            const float wk = __int_as_float(__builtin_amdgcn_readlane(__float_as_int(wgt), 16 * k));
            const f32x2_ wk2 = (f32x2_){wk, wk};
#pragma unroll
            for (int j = 0; j < 2; ++j)
#pragma unroll
                for (int q = 0; q < 4; ++q) { const int wv = (int)vv[k][j][q];
                    acc[8 * j + 2 * q] = __builtin_elementwise_fma(__builtin_amdgcn_cvt_pk_f32_fp8(wv, false), wk2, acc[8 * j + 2 * q]);
                    acc[8 * j + 2 * q + 1] = __builtin_elementwise_fma(__builtin_amdgcn_cvt_pk_f32_fp8(wv, true), wk2, acc[8 * j + 2 * q + 1]); }
        }
    }
    }
    float s2 = 0.f;
#pragma unroll
    for (int j = 0; j < 2; ++j)
#pragma unroll
        for (int q = 0; q < 4; ++q) { const f32x4 x0 = *(const f32x4*)(xr + 1024 * j + 4 * q);
            acc[8 * j + 2 * q] += (f32x2_){x0[0], x0[1]}; acc[8 * j + 2 * q + 1] += (f32x2_){x0[2], x0[3]};
            s2 += (acc[8 * j + 2 * q].x * acc[8 * j + 2 * q].x + acc[8 * j + 2 * q].y * acc[8 * j + 2 * q].y) + (acc[8 * j + 2 * q + 1].x * acc[8 * j + 2 * q + 1].x + acc[8 * j + 2 * q + 1].y * acc[8 * j + 2 * q + 1].y); }
    s2 = wave_sum_bfly(s2);
    if (fin) {
        const float r2 = rsqrtf(s2 * (1.f / 2048.f) + EPS);
#pragma unroll
        for (int j = 0; j < 2; ++j)
#pragma unroll
            for (int q = 0; q < 4; ++q) { const f32x4 g = *(const f32x4*)(fin + 1024 * j + 16 * lane + 4 * q);
                f32x4 o; o[0] = acc[8 * j + 2 * q].x * r2 * g[0]; o[1] = acc[8 * j + 2 * q].y * r2 * g[1]; o[2] = acc[8 * j + 2 * q + 1].x * r2 * g[2]; o[3] = acc[8 * j + 2 * q + 1].y * r2 * g[3];
                *(f32x4*)(xr + 1024 * j + 4 * q) = o; }
    } else {
        bf16* xbr = xb + (size_t)t * 2048 + 16 * lane;
#pragma unroll
        for (int j = 0; j < 2; ++j) {
#pragma unroll
            for (int q = 0; q < 4; ++q) { f32x4 o; o[0] = acc[8 * j + 2 * q].x; o[1] = acc[8 * j + 2 * q].y; o[2] = acc[8 * j + 2 * q + 1].x; o[3] = acc[8 * j + 2 * q + 1].y; *(f32x4*)(xr + 1024 * j + 4 * q) = o; }
            v4u o0, o1;
            o0.x = pk2(acc[8 * j + 0].x, acc[8 * j + 0].y); o0.y = pk2(acc[8 * j + 1].x, acc[8 * j + 1].y); o0.z = pk2(acc[8 * j + 2].x, acc[8 * j + 2].y); o0.w = pk2(acc[8 * j + 3].x, acc[8 * j + 3].y);
            o1.x = pk2(acc[8 * j + 4].x, acc[8 * j + 4].y); o1.y = pk2(acc[8 * j + 5].x, acc[8 * j + 5].y); o1.z = pk2(acc[8 * j + 6].x, acc[8 * j + 6].y); o1.w = pk2(acc[8 * j + 7].x, acc[8 * j + 7].y);
            *(v4u*)(xbr + 1024 * j) = o0; *(v4u*)(xbr + 1024 * j + 8) = o1;
        }
        if (lane == 0) ssq[t] = s2;
    }
}
typedef short s16x4 __attribute__((ext_vector_type(4)));
__device__ __forceinline__ unsigned cvt_pk_bf16_(float lo, float hi) { unsigned r; asm volatile("v_cvt_pk_bf16_f32 %0, %1, %2" : "=v"(r) : "v"(lo), "v"(hi)); return r; }
__device__ __forceinline__ void attn_task(const bf16* Q, const bf16* K, const bf16* Vt, bf16* O, const float* sinks, int b, int hq, int q0, int lane) {
    const int c = lane & 31, hi = lane >> 5, kvh = hq >> 2;
    const size_t tb = (size_t)b * 4096;
    s16x8 qf[4];
    { const bf16* qp = Q + (tb + q0 + c) * 2048 + hq * 64 + hi * 8;
#pragma unroll
      for (int ks = 0; ks < 4; ++ks) qf[ks] = *(const s16x8*)(qp + ks * 16); }
    const float sink2 = sinks[hq] * 1.4426950408889634f;
    float m = sink2, l = (hi == 0) ? 1.f : 0.f;
    f32x16 o0, o1;
#pragma unroll
    for (int r = 0; r < 16; ++r) { o0[r] = 0.f; o1[r] = 0.f; }
    const bf16* kbase = K + tb * 512 + kvh * 64 + hi * 8 + (size_t)c * 512;
    const bf16* vbase = Vt + (size_t)(kvh * 64 + c) * 16384 + tb + 4 * hi;
    for (int kt = 0; kt < 9; ++kt) {
        const int key0 = q0 - 128 + 32 * kt;
        if (key0 < 0 || key0 >= 4096) continue;
        s16x8 kf[4]; s16x4 va[2][2][2];
#pragma unroll
        for (int ks = 0; ks < 4; ++ks) kf[ks] = *(const s16x8*)(kbase + (size_t)key0 * 512 + ks * 16);
#pragma unroll
        for (int db = 0; db < 2; ++db)
#pragma unroll
            for (int s = 0; s < 2; ++s) { const bf16* vp = vbase + (size_t)db * 32 * 16384 + key0 + 16 * s; va[db][s][0] = *(const s16x4*)vp; va[db][s][1] = *(const s16x4*)(vp + 8); }
        f32x16 sa;
#pragma unroll
        for (int r = 0; r < 16; ++r) sa[r] = 0.f;
#pragma unroll
        for (int ks = 0; ks < 4; ++ks) sa = __builtin_amdgcn_mfma_f32_32x32x16_bf16(kf[ks], qf[ks], sa, 0, 0, 0);
        if (kt == 0 || kt == 8) {
            const int dbase = key0 - (q0 + c) + 4 * hi;
#pragma unroll
            for (int r = 0; r < 16; ++r) { const int d = dbase + (r & 3) + 8 * (r >> 2); if (d < -128 || d > 128) sa[r] = -1e30f; }
        }
        float mx = sa[0];
#pragma unroll
        for (int r = 1; r < 16; ++r) mx = fmaxf(mx, sa[r]);
        { const auto rr = __builtin_amdgcn_permlane32_swap(__float_as_uint(mx), __float_as_uint(mx), false, false); mx = fmaxf(__uint_as_float(rr[0]), __uint_as_float(rr[1])); }
        const float mn = fmaxf(m, mx), alpha = __builtin_amdgcn_exp2f(m - mn);
        m = mn;
        float ps = 0.f;
#pragma unroll
        for (int r = 0; r < 16; ++r) { sa[r] = __builtin_amdgcn_exp2f(sa[r] - mn); ps += sa[r]; }
        l = l * alpha + ps;
#pragma unroll
        for (int r = 0; r < 16; ++r) { o0[r] *= alpha; o1[r] *= alpha; }
        s16x8 pf[2];
#pragma unroll
        for (int s = 0; s < 2; ++s) { v4u w; w.x = cvt_pk_bf16_(sa[8 * s + 0], sa[8 * s + 1]); w.y = cvt_pk_bf16_(sa[8 * s + 2], sa[8 * s + 3]); w.z = cvt_pk_bf16_(sa[8 * s + 4], sa[8 * s + 5]); w.w = cvt_pk_bf16_(sa[8 * s + 6], sa[8 * s + 7]);
            pf[s] = __builtin_bit_cast(s16x8, w); }
#pragma unroll
        for (int s = 0; s < 2; ++s) {
            const s16x8 v0 = __builtin_shufflevector(va[0][s][0], va[0][s][1], 0, 1, 2, 3, 4, 5, 6, 7), v1 = __builtin_shufflevector(va[1][s][0], va[1][s][1], 0, 1, 2, 3, 4, 5, 6, 7);
            o0 = __builtin_amdgcn_mfma_f32_32x32x16_bf16(v0, pf[s], o0, 0, 0, 0);
            o1 = __builtin_amdgcn_mfma_f32_32x32x16_bf16(v1, pf[s], o1, 0, 0, 0);
        }
    }
    { const auto rr = __builtin_amdgcn_permlane32_swap(__float_as_uint(l), __float_as_uint(l), false, false); l = __uint_as_float(rr[0]) + __uint_as_float(rr[1]); }
    const float il = 1.f / l;
    bf16* op = O + (tb + q0 + c) * 2048 + hq * 64 + 4 * hi;
#pragma unroll
    for (int g = 0; g < 4; ++g) {
        v2u w0, w1;
        w0.x = cvt_pk_bf16_(o0[4 * g + 0] * il, o0[4 * g + 1] * il); w0.y = cvt_pk_bf16_(o0[4 * g + 2] * il, o0[4 * g + 3] * il);
        w1.x = cvt_pk_bf16_(o1[4 * g + 0] * il, o1[4 * g + 1] * il); w1.y = cvt_pk_bf16_(o1[4 * g + 2] * il, o1[4 * g + 3] * il);
        *(v2u*)(op + 8 * g) = w0; *(v2u*)(op + 32 + 8 * g) = w1;
    }
}
typedef float fx2 __attribute__((ext_vector_type(2)));
__device__ __forceinline__ fx2 bf2_(unsigned w) { fx2 r; r[0] = __uint_as_float(w << 16); r[1] = __uint_as_float(w & 0xffff0000u); return r; }
__device__ __forceinline__ void fft16_item(bf16* Zp, const float* tw, int bg, int l, int s1h, int lane) {
    const int s1 = s1h * 128 + 2 * lane;
    bf16* base = Zp + ((size_t)(bg * 16) * 256 + l) * 512 + s1;
    fx2 zr[16], zi[16];
#pragma unroll
    for (int s2 = 0; s2 < 16; ++s2) { zr[s2] = bf2_(*(const unsigned*)(base + (size_t)s2 * 256 * 512)); zi[s2] = bf2_(*(const unsigned*)(base + (size_t)s2 * 256 * 512 + 256)); }
    fx2 er[16], ei[16];
#pragma unroll
    for (int d = 0; d < 4; ++d) {
        const fx2 ar = zr[d], ai_ = zi[d], br = zr[4 + d], bi = zi[4 + d], cr = zr[8 + d], ci = zi[8 + d], dr = zr[12 + d], di = zi[12 + d];
        const fx2 s0r = ar + cr, s0i = ai_ + ci, s1r = ar - cr, s1i = ai_ - ci, s2r = br + dr, s2i = bi + di, s3r = br - dr, s3i = bi - di;
        er[0 * 4 + d] = s0r + s2r; ei[0 * 4 + d] = s0i + s2i;
        er[1 * 4 + d] = s1r + s3i; ei[1 * 4 + d] = s1i - s3r;
        er[2 * 4 + d] = s0r - s2r; ei[2 * 4 + d] = s0i - s2i;
        er[3 * 4 + d] = s1r - s3i; ei[3 * 4 + d] = s1i + s3r;
    }
#pragma unroll
    for (int a = 1; a < 4; ++a)
#pragma unroll
        for (int d = 1; d < 4; ++d) {
            const float ang = 6.283185307179586f * (float)(a * d) / 16.f; const float c = __builtin_cosf(ang), sn = __builtin_sinf(ang);
            const fx2 xr = er[a * 4 + d], xi = ei[a * 4 + d];
            er[a * 4 + d] = xr * c + xi * sn; ei[a * 4 + d] = xi * c - xr * sn;
        }
#pragma unroll
    for (int a = 0; a < 4; ++a) {
        const fx2 ar = er[a * 4 + 0], ai_ = ei[a * 4 + 0], br = er[a * 4 + 1], bi = ei[a * 4 + 1], cr = er[a * 4 + 2], ci = ei[a * 4 + 2], dr = er[a * 4 + 3], di = ei[a * 4 + 3];
        const fx2 s0r = ar + cr, s0i = ai_ + ci, s1r = ar - cr, s1i = ai_ - ci, s2r = br + dr, s2i = bi + di, s3r = br - dr, s3i = bi - di;
        fx2 Dr[4], Di[4];
        Dr[0] = s0r + s2r; Di[0] = s0i + s2i; Dr[1] = s1r + s3i; Di[1] = s1i - s3r; Dr[2] = s0r - s2r; Di[2] = s0i - s2i; Dr[3] = s1r - s3i; Di[3] = s1i + s3r;
#pragma unroll
        for (int b = 0; b < 4; ++b) {
            const int k2 = a + 4 * b;
            const f32x4 t0 = *(const f32x4*)(tw + (size_t)(k2 * 256 + s1) * 2);
            const fx2 cc = (fx2){t0[0], t0[2]}, ss = (fx2){t0[1], t0[3]};
            const fx2 hr = Dr[b] * cc + Di[b] * ss, hi_ = Di[b] * cc - Dr[b] * ss;
            *(unsigned*)(base + (size_t)k2 * 256 * 512) = pk2(hr[0], hr[1]); *(unsigned*)(base + (size_t)k2 * 256 * 512 + 256) = pk2(hi_[0], hi_[1]);
        }
    }
}
enum { PH_PRO = 0, PH_G1 = 1, PH_S1 = 2, PH_G2 = 3, PH_G3 = 4, PH_Q0 = 5, PH_PE0 = 6, PH_QKV = 7, PH_ATT = 8, PH_WO = 9, PH_Q1 = 10, PH_PE1 = 11, PH_END = 12 };
__global__ void __launch_bounds__(NWAVES * 64, 2) mega(Args a) {
    extern __shared__ __attribute__((aligned(16))) unsigned char lds_raw[];
    LAS unsigned char* lds = (LAS unsigned char*)lds_raw;
    cg::grid_group grid = cg::this_grid();
    const int tid = threadIdx.x, lane = tid & 63, wave = __builtin_amdgcn_readfirstlane(tid >> 6);
    const int G = gridDim.x, bx = blockIdx.x;
    unsigned char* ws = a.ws;
    const int lo = a.ph_lo, hi = a.ph_hi;
    volatile LAS unsigned* MISC = (volatile LAS unsigned*)(lds + LDSCTL_OFF);
    if (tid < 16) MISC[tid] = 0u;
    __syncthreads();
    XcdBarrier xbar = xcd_barrier_post((unsigned*)(ws + WS_CTL) + CW_BAR, MISC + 8);
#define IN(k) (lo <= (k) && (k) < hi)
#define SEAM(k) do { if (IN(k) && IN((k) + 1)) { if ((k) == PH_PRO) grid.sync(); else xcd_barrier(xbar); } } while (0)
    if (IN(PH_PRO)) {
        const int gw = bx * NWAVES + wave, NGW = G * NWAVES;
        const size_t gtid = (size_t)bx * (NWAVES * 64) + tid, ngt = (size_t)G * NWAVES * 64;
        LAS float* scr = (LAS float*)(lds + wave * 16384);
        {
            constexpr int I_SQ = (DM / 64) * (DM / 32), I_QKV = (DM / 64) * (QKVW / 32);
            constexpr int NITEMS = 4 * I_SQ + I_QKV;
            for (int it = gw; it < NITEMS; it += NGW) {
                int r = it;
                if (r < I_SQ) { transpose_item<0>(a.in[3], DM, DM, nullptr, (bf16*)(ws + WS_WOF), scr, r, lane); continue; } r -= I_SQ;
                if (r < I_SQ) { transpose_item<0>(a.in[5], DM, DM, nullptr, (bf16*)(ws + WS_WOA), scr, r, lane); continue; } r -= I_SQ;
                if (r < I_SQ) { transpose_item<0>(a.in[7], DM, DM, a.in[2], (bf16*)(ws + WS_WQ0), scr, r, lane); continue; } r -= I_SQ;
                if (r < I_SQ) { transpose_item<0>(a.in[7] + (size_t)DM * DM, DM, DM, a.in[2] + DM, (bf16*)(ws + WS_WQ1), scr, r, lane); continue; } r -= I_SQ;
                transpose_item<1>(a.in[4], DM, QKVW, a.in[1] + DM, (bf16*)(ws + WS_WQKV), scr, r, lane);
            }
        }
        for (int row = gw; row < T; row += NGW) {
            const f32x4* xr = (const f32x4*)(a.in[0] + (size_t)row * DM) + lane;
            const f32x4* gr = (const f32x4*)a.in[1] + lane;
            f32x4 v[8]; float s = 0.f;
#pragma unroll
            for (int j = 0; j < 8; ++j) { v[j] = xr[64 * j]; s += (v[j][0] * v[j][0] + v[j][1] * v[j][1]) + (v[j][2] * v[j][2] + v[j][3] * v[j][3]); }
            const float r = rsqrtf(wsum(s) * (1.f / DM) + EPS);
            const int b = row >> 12, sp = row & 4095;
#pragma unroll
            for (int j = 0; j < 8; ++j) { const f32x4 gg = gr[64 * j]; v2u o; o.x = pk2(v[j][0] * r * gg[0], v[j][1] * r * gg[1]); o.y = pk2(v[j][2] * r * gg[2], v[j][3] * r * gg[3]);
                *(v2u*)((bf16*)(ws + WS_XG) + ((size_t)((b * 8 + j) * 4096 + sp) * 256 + 4 * lane)) = o; }
        }
        for (size_t i = gtid; i < (size_t)256 * 512 / 8; i += ngt) {
            const int k1 = (int)(i >> 6), c0 = (int)(i & 63) * 8, part = c0 >> 8, s0 = c0 & 255;
            float v[8];
#pragma unroll
            for (int e = 0; e < 8; ++e) { const int m = (k1 * (s0 + e)) & 255; const float rev = (float)m * (1.f / 256.f); v[e] = (part ? __builtin_amdgcn_sinf(rev) : __builtin_amdgcn_cosf(rev)) * (1.f / 64.f); }
            v4u o; o.x = pk2(v[0], v[1]); o.y = pk2(v[2], v[3]); o.z = pk2(v[4], v[5]); o.w = pk2(v[6], v[7]);
            *(v4u*)((bf16*)(ws + WS_A2) + i * 8) = o;
        }
        for (size_t i = gtid; i < (size_t)16 * 256; i += ngt) {
            const int k2 = (int)(i >> 8), s1 = (int)(i & 255); const float rev = (float)(k2 * s1) * (1.f / 4096.f);
            ((float*)(ws + WS_TW))[2 * i] = __builtin_amdgcn_cosf(rev); ((float*)(ws + WS_TW))[2 * i + 1] = __builtin_amdgcn_sinf(rev);
        }
        for (size_t i = gtid; i < (size_t)512 * 256 / 8; i += ngt) {
            const int n = (int)(i >> 5), c0 = (int)(i & 31) * 8, part = n >> 8, l = n & 255;
            float v[8];
#pragma unroll
            for (int e = 0; e < 8; ++e) { const int m = (l * (c0 + e)) & 255; const float rev = (float)m * (1.f / 256.f); v[e] = (part ? -__builtin_amdgcn_sinf(rev) : __builtin_amdgcn_cosf(rev)) * (1.f / 16.f); }
            v4u o; o.x = pk2(v[0], v[1]); o.y = pk2(v[2], v[3]); o.z = pk2(v[4], v[5]); o.w = pk2(v[6], v[7]);
            *(v4u*)((bf16*)(ws + WS_WCS) + i * 8) = o;
        }
        for (size_t i = gtid; i < (size_t)4096 * 32; i += ngt) {
            const int pos = (int)(i >> 5), fi = (int)(i & 31);
            const double inv = exp2(-(double)fi * (13.287712379549449 / 32.0));
            double sn, cs; sincos((double)pos * inv, &sn, &cs);
            ((float*)(ws + WS_ROPE))[2 * i] = (float)cs; ((float*)(ws + WS_ROPE))[2 * i + 1] = (float)sn;
        }
        cvt_stream8(a.in[9], ws + WS_U0, (size_t)NEXP * DM / 16, gtid, ngt, 1024.f);
        cvt_stream8(a.in[10], ws + WS_V0, (size_t)NEXP * DM / 16, gtid, ngt, 256.f);
        cvt_stream8(a.in[9] + (size_t)NEXP * DM, ws + WS_U1, (size_t)NEXP * DM / 16, gtid, ngt, 1024.f);
        cvt_stream8(a.in[10] + (size_t)NEXP * DM, ws + WS_V1, (size_t)NEXP * DM / 16, gtid, ngt, 256.f);
        cvt_stream(a.in[8], (bf16*)(ws + WS_KEYS), (size_t)2 * PH * 2 * 128 * 128 / 8, gtid, ngt);
    }
    SEAM(PH_PRO);
    if (IN(PH_G1)) {
        int Kq = FW; asm volatile("" : "+s"(Kq));
        pg8::Gemm g{(const pg8::bf16_t*)(ws + WS_WCS), (const pg8::bf16_t*)(ws + WS_XG), 512, T * FG, Kq}; pg8::StaticOrder S; S.init(512, T * FG, G, bx);
        pg8::EpiZt E{(pg8::bf16_t*)(ws + WS_ZT)};
        pg8::gemm_phase<pg8::EpiZt, pg8::StaticOrder, true, true>(lds, g, S, E);
    }
    SEAM(PH_G1);
    if (IN(PH_S1)) {
        const int gw = bx * NWAVES + wave, NGW = G * NWAVES;
        for (int it = gw; it < 32 * 256 * 2; it += NGW) fft16_item((bf16*)(ws + WS_ZT), (const float*)(ws + WS_TW), it >> 9, (it >> 1) & 255, it & 1, lane);
    }
    SEAM(PH_S1);
    if (IN(PH_G2)) {
        pg8::Gemm g{(const pg8::bf16_t*)(ws + WS_A2), (const pg8::bf16_t*)(ws + WS_ZT), 256, 131072, 512}; pg8::StaticOrder S; S.init(256, 131072, G, bx);
        pg8::EpiY E{(pg8::bf16_t*)(ws + WS_Y)};
        pg8::gemm_phase<pg8::EpiY, pg8::StaticOrder, true, true>(lds, g, S, E);
    }
    SEAM(PH_G2);
    if (IN(PH_G3)) {
        pg8::Gemm g{(const pg8::bf16_t*)(ws + WS_Y), (const pg8::bf16_t*)(ws + WS_WOF), T, DM, DM}; pg8::StaticOrder S; S.init(T, DM, G, bx);
        pg8::EpiRes E{a.in[0], a.out, (pg8::bf16_t*)(ws + WS_XB), (float*)(ws + WS_SSQ_A)};
        pg8::gemm_phase<pg8::EpiRes, pg8::StaticOrder, true, true>(lds, g, S, E);
    }
    SEAM(PH_G3);
#define PEER_LAYER(L) do { \
        const int pq = L ? PH_Q1 : PH_Q0, ppe = L ? PH_PE1 : PH_PE0; \
        if (IN(pq)) { \
            pg8::Gemm g{(const pg8::bf16_t*)(ws + WS_XB), (const pg8::bf16_t*)(ws + (L ? WS_WQ1 : WS_WQ0)), T, DM, DM}; pg8::StaticOrder S; S.init(T, DM, G, bx); \
            pg8::EpiScale E{(pg8::bf16_t*)(ws + WS_Q), (const float*)(ws + (L ? WS_SSQ_C : WS_SSQ_A))}; \
            pg8::gemm_phase<pg8::EpiScale, pg8::StaticOrder, true, true>(lds, g, S, E); \
        } \
        SEAM(pq); \
        if (IN(ppe)) { \
            const bf16* keys = (const bf16*)(ws + WS_KEYS) + (size_t)L * PH * 2 * 128 * 128; \
            for (int u = bx; u < T / 32; u += G) topk_unit((const bf16*)(ws + WS_Q), keys, (int*)(ws + WS_EI), (float*)(ws + WS_GW), u * 32, wave, lane); \
            __syncthreads(); \
            for (int u = bx; u < T / 32; u += G) \
                for (int i = 0; i < 4; ++i) \
                    peer_token(a.out, a.in[2] + L * DM, (const int*)(ws + WS_EI), (const float*)(ws + WS_GW), (const unsigned char*)(ws + (L ? WS_U1 : WS_U0)), (const unsigned char*)(ws + (L ? WS_V1 : WS_V0)), \
                               (bf16*)(ws + WS_XB), (float*)(ws + WS_SSQ_B), L ? a.in[11] : nullptr, u * 32 + wave * 4 + i, lane); \
        } \
    } while (0)
    PEER_LAYER(0);
    SEAM(PH_PE0);
    if (IN(PH_QKV)) {
        {
            pg8::Gemm g{(const pg8::bf16_t*)(ws + WS_XB), (const pg8::bf16_t*)(ws + WS_WQKV), T, 2560, DM}; pg8::StaticOrder S; S.init(T, 2560, G, bx);
            pg8::EpiQK E{(pg8::bf16_t*)(ws + WS_QB), (pg8::bf16_t*)(ws + WS_KB), (const float*)(ws + WS_SSQ_B), (const float*)(ws + WS_ROPE), 0.125f * 1.4426950408889634f};
            pg8::gemm_phase<pg8::EpiQK, pg8::StaticOrder, true, true>(lds, g, S, E);
        }
        if (bx >= G / 2) {
            pg8::Gemm g{(const pg8::bf16_t*)(ws + WS_WQKV) + (size_t)2560 * DM, (const pg8::bf16_t*)(ws + WS_XB), 512, T, DM}; pg8::StaticOrder S; S.init(512, T, G / 2, bx - G / 2);
            pg8::EpiVt E{(pg8::bf16_t*)(ws + WS_VT), (const float*)(ws + WS_SSQ_B)};
            pg8::gemm_phase<pg8::EpiVt, pg8::StaticOrder, true, true>(lds, g, S, E);
        }
    }
    SEAM(PH_QKV);
    if (IN(PH_ATT)) {
        for (int vb = bx; vb < 256; vb += G) {
        const int bkv = vb >> 3, chunk = vb & 7, b = bkv >> 3, kvh = bkv & 7;
        for (int i = 0; i < 8; ++i)
            attn_task((const bf16*)(ws + WS_QB), (const bf16*)(ws + WS_KB), (const bf16*)(ws + WS_VT), (bf16*)(ws + WS_O), a.in[6], b, kvh * 4 + (wave & 3), (chunk * 8 + i) * 64 + (wave >> 2) * 32, lane);
        }
    }
    SEAM(PH_ATT);
    if (IN(PH_WO)) {
        pg8::Gemm g{(const pg8::bf16_t*)(ws + WS_O), (const pg8::bf16_t*)(ws + WS_WOA), T, DM, DM}; pg8::StaticOrder S; S.init(T, DM, G, bx);
        pg8::EpiRes E{a.out, a.out, (pg8::bf16_t*)(ws + WS_XB), (float*)(ws + WS_SSQ_C)};
        pg8::gemm_phase<pg8::EpiRes, pg8::StaticOrder, true, true>(lds, g, S, E);
    }
    SEAM(PH_WO);
    PEER_LAYER(1);
#undef PEER_LAYER
#undef SEAM
#undef IN
}

#ifndef N_LAUNCHES
#define N_LAUNCHES 1
#endif
extern "C" void kernel_launch(void* const* d_in, const int* in_sizes, int n_in, void* d_out, int out_size, void* d_ws, size_t ws_size, hipStream_t stream) {
    static int grid = 0;
    if (!grid) {
        if (hipFuncSetAttribute((const void*)mega, hipFuncAttributeMaxDynamicSharedMemorySize, LDS_BYTES) != hipSuccess) { fprintf(stderr, "hipFuncSetAttribute failed\n"); }
        int dev = 0, cus = 0, per_cu = 0;
        (void)hipGetDevice(&dev);
        (void)hipDeviceGetAttribute(&cus, hipDeviceAttributeMultiprocessorCount, dev);
        if (hipOccupancyMaxActiveBlocksPerMultiprocessor(&per_cu, (const void*)mega, NWAVES * 64, LDS_BYTES) != hipSuccess) per_cu = 0;
        (void)hipGetLastError();
        grid = cus * per_cu;
        if (grid > 256) grid = 256;
        grid &= ~1;
        if (grid < 2) { fprintf(stderr, "occupancy query gave %d x %d\n", cus, per_cu); grid = -1; }
    }
    if (grid < 0) return;
    if (ws_size < 700 * MiB) { fprintf(stderr, "ws too small: %zu\n", ws_size); return; }
    (void)hipMemsetAsync((char*)d_ws + WS_CTL, 0, CTL_BYTES, stream);
    Args a{};
    for (int i = 0; i < 12; ++i) a.in[i] = (const float*)d_in[i];
    a.out = (float*)d_out; a.ws = (unsigned char*)d_ws;
    if (N_LAUNCHES == 1) {
        a.ph_lo = 0; a.ph_hi = PH_END;
        void* args[] = {&a};
        const hipError_t e = hipLaunchCooperativeKernel((const void*)mega, dim3(grid), dim3(NWAVES * 64), args, LDS_BYTES, stream);
        if (e != hipSuccess) fprintf(stderr, "cooperative launch failed: %s (grid %d)\n", hipGetErrorString(e), grid);
    } else {
        for (int ph = 0; ph < PH_END; ++ph) {
            a.ph_lo = ph; a.ph_hi = ph + 1;
            hipLaunchKernelGGL(mega, dim3(grid), dim3(NWAVES * 64), LDS_BYTES, stream, a);
        }
    }
}
```

```cpp
#include <hip/hip_runtime.h>
#include <hip/hip_cooperative_groups.h>
namespace cg = cooperative_groups;
#include <cstdio>
#include <cstdint>
#include <cmath>

constexpr int DM = 2048, NB = 4, SEQ = 4096, T = NB * SEQ;
constexpr int FG = 8, FW = 256;
constexpr int HD = 64, NQH = 32, NKVH = 8, QKVW = 3072;
constexpr int PH = 8, NKEYS = 128, NEXP = 16384, PTOPK = 16;
constexpr float EPS = 1e-6f;
namespace pg8 {
#define PG8_LAS __attribute__((address_space(3)))
typedef unsigned short bf16_t;
typedef short bf16x8 __attribute__((ext_vector_type(8)));
typedef float f32x4 __attribute__((ext_vector_type(4)));
typedef unsigned u32x4 __attribute__((ext_vector_type(4)));
constexpr int BM = 256, BK = 64, HALF = 128, HTB = HALF * BK * 2  , STAGE_BYTES = 8 * HTB, NXCD = 8, WGM = 8;

__host__ __device__ __forceinline__ int lds_byte(int r, int c) { const int st = (r >> 4) * 2 + (c >> 5), rr = r & 15, cc = c & 31, ob = rr * 64 + cc * 2; return st * 1024 + (ob ^ (((ob >> 9) & 1) << 5)); }
__host__ __device__ __forceinline__ void stage_rc(int b, int& R, int& C) { const int st = b / 1024, sb = b % 1024, swz = sb ^ (((sb >> 9) & 1) << 5); R = (st >> 1) * 16 + swz / 64; C = (st & 1) * 32 + (swz % 64) / 2; }
__host__ __device__ __forceinline__ int perm32(int rho) { const int n = rho >> 4, i = rho & 15; return 8 * (i >> 2) + 4 * n + (i & 3); }

struct Unit { int pm, pn; };
struct Gemm { const bf16_t* A; const bf16_t* Bt; int M, N, K; };

struct StaticOrder {
    int nM, nN, nwg, G, c;
    __host__ __device__ void init(int M, int N, int G_, int c_) { nM = M / BM; nN = N / BM; nwg = nM * nN; G = G_; c = c_; }
    __host__ __device__ bool next(int i, Unit& u) const {
        const long L = (long)i * G + c; if (L >= nwg) return false;
        int wgid = (int)L; { const int q = nwg / NXCD, r = nwg % NXCD, xcd = wgid % NXCD, off = wgid / NXCD; wgid = (xcd < r ? xcd * (q + 1) : r * (q + 1) + (xcd - r) * q) + off; }
        const int nig = WGM * nN, gid = wgid / nig, fm = gid * WGM, gsz = (nM - fm) < WGM ? (nM - fm) : WGM;
        u.pm = fm + ((wgid % nig) % gsz); u.pn = (wgid % nig) / gsz; return true;
    }
    __device__ __forceinline__ void a_ready(const Unit&) const {}
    __device__ __forceinline__ void done(const Unit&) const {}
};

__device__ __forceinline__ unsigned cvt_pk_bf16(float lo, float hi) { unsigned r; asm volatile("v_cvt_pk_bf16_f32 %0, %1, %2" : "=v"(r) : "v"(lo), "v"(hi)); return r; }
typedef float f32x2 __attribute__((ext_vector_type(2)));
__device__ __forceinline__ u32x4 pack8(const f32x4 v0, const f32x4 v1) { u32x4 w; w.x = cvt_pk_bf16(v0[0], v0[1]); w.y = cvt_pk_bf16(v0[2], v0[3]); w.z = cvt_pk_bf16(v1[0], v1[1]); w.w = cvt_pk_bf16(v1[2], v1[3]); return w; }
struct EpiZt {
    static constexpr bool PERM = true, AFTER_DRAIN = false; bf16_t* Zp;
    __device__ __forceinline__ void operator()(const f32x4 (&acc)[2][2][4][2], const Unit& u, int wr, int wc, int fr, int fq) const {
        const int part = u.pm, bgs2 = u.pn;
        bf16_t* base = Zp + ((size_t)(bgs2 * 256 + wr * 64 + fr) * 512 + part * 256 + wc * 32 + 8 * fq);
#pragma unroll
        for (int ai = 0; ai < 2; ++ai)
#pragma unroll
            for (int m = 0; m < 4; ++m)
#pragma unroll
                for (int bj = 0; bj < 2; ++bj) *(u32x4*)(base + (ai * HALF + m * 16) * 512 + bj * HALF) = pack8(acc[ai][bj][m][0], acc[ai][bj][m][1]);
    }
};
struct EpiY {
    static constexpr bool PERM = true, AFTER_DRAIN = false; bf16_t* Y;
    __device__ __forceinline__ void operator()(const f32x4 (&acc)[2][2][4][2], const Unit& u, int wr, int wc, int fr, int fq) const {
        const int bg = u.pn >> 4, k2 = u.pn & 15, b = bg >> 3, g = bg & 7;
        bf16_t* base = Y + ((size_t)(b * 4096 + (wr * 64 + fr) * 16 + k2) * 2048 + g * 256 + wc * 32 + 8 * fq);
#pragma unroll
        for (int ai = 0; ai < 2; ++ai)
#pragma unroll
            for (int m = 0; m < 4; ++m)
#pragma unroll
                for (int bj = 0; bj < 2; ++bj) *(u32x4*)(base + (size_t)(ai * HALF + m * 16) * 16 * 2048 + bj * HALF) = pack8(acc[ai][bj][m][0], acc[ai][bj][m][1]);
    }
};
struct EpiRes {
    static constexpr bool PERM = true, AFTER_DRAIN = false; const float* R; float* out; bf16_t* xb; float* ssq;
    __device__ __forceinline__ void operator()(const f32x4 (&acc)[2][2][4][2], const Unit& u, int wr, int wc, int fr, int fq) const {
        const int row0 = u.pm * BM + wr * 64 + fr; const size_t off0 = (size_t)row0 * 2048 + u.pn * BM + wc * 32 + 8 * fq;
        const float* Rb = R + off0; float* Ob = out + off0; bf16_t* Xb = xb + off0; float* Sb = ssq + row0;
#pragma unroll
        for (int ai = 0; ai < 2; ++ai)
#pragma unroll
            for (int m = 0; m < 4; ++m) { const int ro = (ai * HALF + m * 16) * 2048; float ss = 0.f;
#pragma unroll
                for (int bj = 0; bj < 2; ++bj) {
                    const f32x4 r0 = *(const f32x4*)(Rb + ro + bj * HALF), r1 = *(const f32x4*)(Rb + ro + bj * HALF + 4);
                    const f32x4 o0 = acc[ai][bj][m][0] + r0, o1 = acc[ai][bj][m][1] + r1;
                    *(f32x4*)(Ob + ro + bj * HALF) = o0; *(f32x4*)(Ob + ro + bj * HALF + 4) = o1;
                    *(u32x4*)(Xb + ro + bj * HALF) = pack8(o0, o1);
                    ss += (o0[0] * o0[0] + o0[1] * o0[1]) + (o0[2] * o0[2] + o0[3] * o0[3]) + (o1[0] * o1[0] + o1[1] * o1[1]) + (o1[2] * o1[2] + o1[3] * o1[3]); }
                ss += __shfl_xor(ss, 16); ss += __shfl_xor(ss, 32);
                if (fq == 0) unsafeAtomicAdd(Sb + ai * HALF + m * 16, ss);
                asm volatile("" ::: "memory"); }
    }
};
struct EpiScale {
    static constexpr bool PERM = true, AFTER_DRAIN = false; bf16_t* O; const float* ssq;
    __device__ __forceinline__ void operator()(const f32x4 (&acc)[2][2][4][2], const Unit& u, int wr, int wc, int fr, int fq) const {
        const int row0 = u.pm * BM + wr * 64 + fr;
        bf16_t* base = O + ((size_t)row0 * 2048 + u.pn * BM + wc * 32 + 8 * fq); const float* Sb = ssq + row0;
#pragma unroll
        for (int ai = 0; ai < 2; ++ai)
#pragma unroll
            for (int m = 0; m < 4; ++m) { const float rs = rsqrtf(Sb[ai * HALF + m * 16] * (1.f / 2048.f) + 1e-6f);
#pragma unroll
                for (int bj = 0; bj < 2; ++bj) *(u32x4*)(base + (ai * HALF + m * 16) * 2048 + bj * HALF) = pack8(acc[ai][bj][m][0] * rs, acc[ai][bj][m][1] * rs); }
    }
};
struct EpiQK {
    static constexpr bool PERM = true, AFTER_DRAIN = false; bf16_t* Q; bf16_t* K; const float* ssq; const float* rope; float qscale;
    __device__ __forceinline__ void operator()(const f32x4 (&acc)[2][2][4][2], const Unit& u, int wr, int wc, int fr, int fq) const {
        const int row0 = u.pm * BM + wr * 64 + fr; const bool isq = u.pn < 8;
        const int cl = wc * 32 + 8 * fq;
        bf16_t* base = isq ? (Q + ((size_t)row0 * 2048 + u.pn * BM + cl)) : (K + ((size_t)row0 * 512 + (u.pn - 8) * BM + cl));
        const int ld = isq ? 2048 : 512; const float sc = isq ? qscale : 1.f;
        const float* rp = rope + (size_t)(row0 & 4095) * 64 + (cl & 63);
        const float* Sb = ssq + row0;
#pragma unroll
        for (int ai = 0; ai < 2; ++ai)
#pragma unroll
            for (int m = 0; m < 4; ++m) { const int ro = ai * HALF + m * 16; const float rs = rsqrtf(Sb[ro] * (1.f / 2048.f) + 1e-6f) * sc;
                const f32x4 t0 = *(const f32x4*)(rp + (size_t)ro * 64), t1 = *(const f32x4*)(rp + (size_t)ro * 64 + 4);
#pragma unroll
                for (int bj = 0; bj < 2; ++bj) {
                    const f32x4 a = acc[ai][bj][m][0] * rs, b = acc[ai][bj][m][1] * rs; f32x4 oa, ob;
                    oa[0] = a[0] * t0[0] - a[1] * t0[1]; oa[1] = a[1] * t0[0] + a[0] * t0[1]; oa[2] = a[2] * t0[2] - a[3] * t0[3]; oa[3] = a[3] * t0[2] + a[2] * t0[3];
                    ob[0] = b[0] * t1[0] - b[1] * t1[1]; ob[1] = b[1] * t1[0] + b[0] * t1[1]; ob[2] = b[2] * t1[2] - b[3] * t1[3]; ob[3] = b[3] * t1[2] + b[2] * t1[3];
                    *(u32x4*)(base + (size_t)ro * ld + bj * HALF) = pack8(oa, ob); } }
    }
};
struct EpiVt {
    static constexpr bool PERM = true, AFTER_DRAIN = false; bf16_t* Vt; const float* ssq;
    __device__ __forceinline__ void operator()(const f32x4 (&acc)[2][2][4][2], const Unit& u, int wr, int wc, int fr, int fq) const {
        const int col0 = u.pn * BM + wc * 32 + 8 * fq;
        bf16_t* base = Vt + ((size_t)(u.pm * BM + wr * 64 + fr) * 16384 + col0);
        f32x4 r0[2], r1[2];
#pragma unroll
        for (int bj = 0; bj < 2; ++bj) { const f32x4 s0 = *(const f32x4*)(ssq + col0 + bj * HALF), s1 = *(const f32x4*)(ssq + col0 + bj * HALF + 4);
#pragma unroll
            for (int q = 0; q < 4; ++q) { r0[bj][q] = rsqrtf(s0[q] * (1.f / 2048.f) + 1e-6f); r1[bj][q] = rsqrtf(s1[q] * (1.f / 2048.f) + 1e-6f); } }
#pragma unroll
        for (int ai = 0; ai < 2; ++ai)
#pragma unroll
            for (int m = 0; m < 4; ++m)
#pragma unroll
                for (int bj = 0; bj < 2; ++bj) *(u32x4*)(base + (size_t)(ai * HALF + m * 16) * 16384 + bj * HALF) = pack8(acc[ai][bj][m][0] * r0[bj], acc[ai][bj][m][1] * r1[bj]);
    }
};
template <class Epi, class Sched, bool ALIGN_EPI = false, bool SP2 = false>
__device__ __forceinline__ void gemm_phase(PG8_LAS unsigned char* lds, const Gemm g, const Sched& S, const Epi& E) {
    const int tid = threadIdx.x, wid = __builtin_amdgcn_readfirstlane(tid >> 6), lane = tid & 63, wr = wid >> 2, wc = wid & 3, fr = lane & 15, fq = lane >> 4;
    const int K = g.K, nt = K / BK;
    unsigned voffA[2], voffB[2];
#pragma unroll
    for (int i = 0; i < 2; ++i) { int R, C; stage_rc(tid * 16 + i * 8192, R, C); const int Rb = Epi::PERM ? ((R & ~31) + perm32(R & 31)) : R;
        voffA[i] = (unsigned)(R * K + C) * 2u; voffB[i] = (unsigned)(Rb * K + C) * 2u; }
    const size_t kstep = (size_t)(BK * 2);
    const size_t hstep = (size_t)HALF * K * 2;
    const size_t tstep = 2 * hstep;
    const unsigned ldsw = (unsigned)wid * 1024u;
    const int aoff = lds_byte(wr * 64 + fr, fq * 8), boff = lds_byte(wc * 32 + fr, fq * 8);
#define PG8_SA(b, h) (((b) * 2 + (h)) * HTB)
#define PG8_SB(b, h) ((4 + (b) * 2 + (h)) * HTB)
#define PG8_STAGE(bufoff, gbase, voff) do { _Pragma("unroll") for (int _i = 0; _i < 2; ++_i) \
        __builtin_amdgcn_global_load_lds((const unsigned*)((const char*)(gbase) + (voff)[_i]), (PG8_LAS unsigned*)(lds + (bufoff) + ldsw + _i * 8192), 16, 0, 0); } while (0)
#define PG8_LDA(dst, b, h) do { _Pragma("unroll") for (int m = 0; m < 4; ++m) _Pragma("unroll") for (int k = 0; k < 2; ++k) dst[m][k] = *(const PG8_LAS bf16x8*)(lds + PG8_SA(b, h) + aoff + m * 2048 + k * 1024); } while (0)
#define PG8_LDB(dst, b, h) do { _Pragma("unroll") for (int n = 0; n < 2; ++n) _Pragma("unroll") for (int k = 0; k < 2; ++k) dst[n][k] = *(const PG8_LAS bf16x8*)(lds + PG8_SB(b, h) + boff + n * 2048 + k * 1024); } while (0)
#define PG8_MMA(ai, bj, At, Bt) do { __builtin_amdgcn_s_setprio(1); _Pragma("unroll") for (int m = 0; m < 4; ++m) _Pragma("unroll") for (int n = 0; n < 2; ++n) _Pragma("unroll") for (int k = 0; k < 2; ++k) \
        acc[ai][bj][m][n] = __builtin_amdgcn_mfma_f32_16x16x32_bf16(Bt[n][k], At[m][k], acc[ai][bj][m][n], 0, 0, 0); __builtin_amdgcn_s_setprio(0); } while (0)
#define PG8_WAIT_V(n) asm volatile("s_waitcnt vmcnt(" #n ")" ::: "memory")
#define PG8_WAIT_L(n) asm volatile("s_waitcnt lgkmcnt(" #n ")" ::: "memory")
#define PG8_BAR __builtin_amdgcn_s_barrier()
#define PG8_SCHED __builtin_amdgcn_sched_barrier(0)
    Unit cur, nxt; int ui = 0;
    if (!S.next(0, cur)) return;
    f32x4 acc[2][2][4][2];
#pragma unroll
    for (int a = 0; a < 2; ++a)
#pragma unroll
        for (int b = 0; b < 2; ++b)
#pragma unroll
            for (int m = 0; m < 4; ++m)
#pragma unroll
                for (int n = 0; n < 2; ++n) acc[a][b][m][n] = (f32x4){0.f, 0.f, 0.f, 0.f};
    bf16x8 At[4][2], B0[2][2], B1[2][2];
    const char* cA = (const char*)g.A + (size_t)cur.pm * tstep; const char* cB = (const char*)g.Bt + (size_t)cur.pn * tstep;
    S.a_ready(cur);
    if constexpr (SP2) {
        PG8_STAGE(PG8_SB(0, 0), cB, voffB); PG8_STAGE(PG8_SB(0, 1), cB + hstep, voffB); PG8_STAGE(PG8_SA(0, 0), cA, voffA); PG8_STAGE(PG8_SA(0, 1), cA + hstep, voffA);
        if (wr == 1) PG8_BAR;
        PG8_WAIT_V(2); PG8_BAR;
        PG8_STAGE(PG8_SB(1, 0), cB + kstep, voffB); PG8_STAGE(PG8_SA(1, 0), cA + kstep, voffA); PG8_STAGE(PG8_SB(1, 1), cB + hstep + kstep, voffB);
        PG8_WAIT_V(6); PG8_BAR;
    } else {
        PG8_STAGE(PG8_SB(0, 0), cB, voffB); PG8_STAGE(PG8_SA(0, 0), cA, voffA); PG8_STAGE(PG8_SB(0, 1), cB + hstep, voffB); PG8_STAGE(PG8_SA(0, 1), cA + hstep, voffA);
        if (wr == 1) PG8_BAR;
        PG8_WAIT_V(4); PG8_BAR;
        PG8_STAGE(PG8_SB(1, 0), cB + kstep, voffB); PG8_STAGE(PG8_SA(1, 0), cA + kstep, voffA); PG8_STAGE(PG8_SB(1, 1), cB + hstep + kstep, voffB);
        PG8_WAIT_V(6); PG8_BAR;
    }
    for (;;) {
        const bool has_next = S.next(ui + 1, nxt);
        const char* nA = has_next ? (const char*)g.A + (size_t)nxt.pm * tstep : cA; const char* nB = has_next ? (const char*)g.Bt + (size_t)nxt.pn * tstep : cB;
        for (int t = 0; t < nt; t += 2) {
            const bool last = (t == nt - 2);
            const char* a1 = cA + (size_t)(t + 1) * kstep;
            const char* a2 = last ? nA : cA + (size_t)(t + 2) * kstep; const char* b2 = last ? nB : cB + (size_t)(t + 2) * kstep;
            const char* a3 = a2 + kstep; const char* b3 = b2 + kstep;
            if (last && has_next) S.a_ready(nxt);
            if constexpr (SP2) {
            PG8_LDB(B0, 0, 0); PG8_LDB(B1, 0, 1); PG8_SCHED; PG8_LDA(At, 0, 0); PG8_STAGE(PG8_SA(1, 1), a1 + hstep, voffA);
            PG8_WAIT_V(8); PG8_WAIT_L(0); PG8_BAR; PG8_MMA(0, 0, At, B0); PG8_MMA(0, 1, At, B1); PG8_BAR; PG8_SCHED;
            PG8_LDA(At, 0, 1); PG8_STAGE(PG8_SB(0, 0), b2, voffB); PG8_STAGE(PG8_SB(0, 1), b2 + hstep, voffB); PG8_STAGE(PG8_SA(0, 0), a2, voffA);
            PG8_WAIT_V(8); PG8_WAIT_L(0); PG8_BAR; PG8_MMA(1, 0, At, B0); PG8_MMA(1, 1, At, B1); PG8_BAR; PG8_SCHED;
            PG8_LDB(B0, 1, 0); PG8_LDB(B1, 1, 1); PG8_SCHED; PG8_LDA(At, 1, 0); PG8_STAGE(PG8_SA(0, 1), a2 + hstep, voffA);
            PG8_WAIT_V(8); PG8_WAIT_L(0); PG8_BAR; PG8_MMA(0, 0, At, B0); PG8_MMA(0, 1, At, B1); PG8_BAR; PG8_SCHED;
            PG8_LDA(At, 1, 1); PG8_STAGE(PG8_SB(1, 0), b3, voffB); PG8_STAGE(PG8_SB(1, 1), b3 + hstep, voffB); PG8_STAGE(PG8_SA(1, 0), a3, voffA);
            PG8_WAIT_V(8); PG8_WAIT_L(0); PG8_BAR; PG8_MMA(1, 0, At, B0); PG8_MMA(1, 1, At, B1); PG8_BAR; PG8_SCHED;
            } else {
            PG8_LDB(B0, 0, 0); PG8_SCHED; PG8_LDA(At, 0, 0); PG8_STAGE(PG8_SA(1, 1), a1 + hstep, voffA);
            PG8_WAIT_L(8); PG8_BAR; PG8_WAIT_L(0); PG8_MMA(0, 0, At, B0); PG8_BAR; PG8_SCHED;
            PG8_LDB(B1, 0, 1); PG8_STAGE(PG8_SB(0, 0), b2, voffB);
            PG8_BAR; PG8_WAIT_L(0); PG8_MMA(0, 1, At, B1); PG8_BAR;
            PG8_LDA(At, 0, 1); PG8_STAGE(PG8_SA(0, 0), a2, voffA);
            PG8_BAR; PG8_WAIT_L(0); PG8_MMA(1, 0, At, B0); PG8_BAR; PG8_SCHED;
            PG8_STAGE(PG8_SB(0, 1), b2 + hstep, voffB);
            PG8_WAIT_V(6); PG8_BAR; PG8_MMA(1, 1, At, B1); PG8_BAR;
            PG8_LDB(B0, 1, 0); PG8_SCHED; PG8_LDA(At, 1, 0); PG8_STAGE(PG8_SA(0, 1), a2 + hstep, voffA);
            PG8_WAIT_L(8); PG8_BAR; PG8_WAIT_L(0); PG8_MMA(0, 0, At, B0); PG8_BAR; PG8_SCHED;
            PG8_LDB(B1, 1, 1); PG8_STAGE(PG8_SB(1, 0), b3, voffB);
            PG8_BAR; PG8_WAIT_L(0); PG8_MMA(0, 1, At, B1); PG8_BAR;
            PG8_LDA(At, 1, 1); PG8_STAGE(PG8_SA(1, 0), a3, voffA);
            PG8_BAR; PG8_WAIT_L(0); PG8_MMA(1, 0, At, B0); PG8_BAR; PG8_SCHED;
            PG8_STAGE(PG8_SB(1, 1), b3 + hstep, voffB);
            PG8_WAIT_V(6); PG8_BAR; PG8_MMA(1, 1, At, B1); PG8_BAR;
            }
        }
        if constexpr (ALIGN_EPI) { if (wr == 0) PG8_BAR; }
        if constexpr (!Epi::AFTER_DRAIN) { E(acc, cur, wr, wc, fr, fq); S.done(cur); }
        if (!has_next) break;
#pragma unroll
        for (int a = 0; a < 2; ++a)
#pragma unroll
            for (int b = 0; b < 2; ++b)
#pragma unroll
                for (int m = 0; m < 4; ++m)
#pragma unroll
                    for (int n = 0; n < 2; ++n) acc[a][b][m][n] = (f32x4){0.f, 0.f, 0.f, 0.f};
        cur = nxt; cA = nA; cB = nB; ++ui;
        if constexpr (ALIGN_EPI) { if (wr == 1) PG8_BAR; }
    }
    PG8_WAIT_V(0);
    if constexpr (!ALIGN_EPI) { if (wr == 0) PG8_BAR; }
    PG8_BAR;
    if constexpr (Epi::AFTER_DRAIN) { E.fused(acc, cur, wr, wc, fr, fq, lds, wid, lane); S.done(cur); }
#undef PG8_SA
#undef PG8_SB
#undef PG8_STAGE
#undef PG8_LDA
#undef PG8_LDB
#undef PG8_MMA
#undef PG8_WAIT_V
#undef PG8_WAIT_L
#undef PG8_BAR
#undef PG8_SCHED
}
}
#define GAS __attribute__((address_space(1)))
#define LAS __attribute__((address_space(3)))
typedef unsigned short bf16;
typedef unsigned v4u __attribute__((ext_vector_type(4)));
typedef unsigned v2u __attribute__((ext_vector_type(2)));
typedef float f32x4 __attribute__((ext_vector_type(4)));
constexpr int NWAVES = 8;
constexpr int LDS_BYTES = 147456, LDSCTL_OFF = 131072;
constexpr int CW_BAR = 4096;
constexpr size_t MiB = 1u << 20;
constexpr size_t WS_CTL = 0, CTL_BYTES = 1 * MiB;
constexpr size_t WS_SSQ_A = 256 * 1024, WS_SSQ_B = 320 * 1024, WS_SSQ_C = 384 * 1024;
constexpr size_t WS_STAMP = 128 * 1024;
constexpr size_t WS_WCS = 1 * MiB, WS_ROPE = 2 * MiB, WS_KEYS = 3 * MiB;
constexpr size_t WS_WOF = 8 * MiB, WS_WQKV = 16 * MiB, WS_WOA = 28 * MiB, WS_WQ0 = 36 * MiB, WS_WQ1 = 44 * MiB;
constexpr size_t WS_A2 = 64 * MiB, WS_TW = 65 * MiB;
constexpr size_t WS_U0 = 128 * MiB, WS_V0 = 192 * MiB, WS_U1 = 256 * MiB, WS_V1 = 320 * MiB;
constexpr size_t WS_XG = 384 * MiB, WS_XB = 384 * MiB;
constexpr size_t WS_ZT = 448 * MiB;
constexpr size_t WS_Y = 576 * MiB;
constexpr size_t WS_Q = 448 * MiB;
constexpr size_t WS_EI = 640 * MiB, WS_GW = 648 * MiB;
constexpr size_t WS_QB = 448 * MiB, WS_KB = 512 * MiB, WS_VT = 528 * MiB, WS_O = 576 * MiB;

__device__ __forceinline__ unsigned f2bf(float f) { unsigned u = __builtin_bit_cast(unsigned, f); return (u + 0x7fffu + ((u >> 16) & 1u)) >> 16; }
__device__ __forceinline__ unsigned pk2(float lo, float hi) { return f2bf(lo) | (f2bf(hi) << 16); }

struct Args { const float* in[12]; float* out; unsigned char* ws; int ph_lo, ph_hi; };

__device__ __forceinline__ int qkv_row(int n) { if (n >= 2560) return n; const int d = n & 63, pc = (d < 32) ? 2 * d : 2 * (d - 32) + 1; return (n & ~63) + pc; }
template <int MODE>
__device__ __forceinline__ void transpose_item(const float* W, int K, int N, const float* gain, bf16* WT, LAS float* scr, int item, int lane) {
    const int nblk = N / 32, kb = item / nblk, nb = item % nblk, k0 = 64 * kb, n0 = 32 * nb;
#pragma unroll 8
    for (int i = 0; i < 32; ++i) { const int kk = 2 * i + (lane >> 5); float v = W[(size_t)(k0 + kk) * N + n0 + (lane & 31)]; if (gain) v *= gain[k0 + kk]; scr[kk * 33 + (lane & 31)] = v; }
    asm volatile("s_waitcnt lgkmcnt(0)" ::: "memory");
    const int c = lane & 7;
#pragma unroll
    for (int j = 0; j < 4; ++j) { const int n = (lane >> 3) + 8 * j; const LAS float* s = scr + (8 * c) * 33 + n;
        v4u o; o.x = pk2(s[0 * 33], s[1 * 33]); o.y = pk2(s[2 * 33], s[3 * 33]); o.z = pk2(s[4 * 33], s[5 * 33]); o.w = pk2(s[6 * 33], s[7 * 33]);
        const int row = (MODE == 1) ? qkv_row(n0 + n) : (n0 + n);
        *(v4u*)(WT + (size_t)row * K + k0 + 8 * c) = o; }
    asm volatile("s_waitcnt lgkmcnt(0)" ::: "memory");
}
__device__ __forceinline__ float wsum(float v) {
#pragma unroll
    for (int o = 1; o < 64; o <<= 1) v += __shfl_xor(v, o);
    return v;
}
__device__ __forceinline__ void cvt_stream(const float* src, bf16* dst, size_t n8, size_t gtid, size_t ngt) {
    for (size_t i = gtid; i < n8; i += ngt) {
        const f32x4 a = *(const f32x4*)(src + i * 8), b = *(const f32x4*)(src + i * 8 + 4);
        v4u o; o.x = pk2(a[0], a[1]); o.y = pk2(a[2], a[3]); o.z = pk2(b[0], b[1]); o.w = pk2(b[2], b[3]);
        *(v4u*)(dst + i * 8) = o;
    }
}
__device__ __forceinline__ void cvt_stream8(const float* src, unsigned char* dst, size_t n16, size_t gtid, size_t ngt, float scale) {
    for (size_t i = gtid; i < n16; i += ngt) {
        v4u o;
#pragma unroll
        for (int q = 0; q < 4; ++q) { f32x4 a = *(const f32x4*)(src + i * 16 + 4 * q) * scale;
#pragma unroll
            for (int e = 0; e < 4; ++e) a[e] = fminf(fmaxf(a[e], -448.f), 448.f);
            int w = 0; w = __builtin_amdgcn_cvt_pk_fp8_f32(a[0], a[1], w, false); w = __builtin_amdgcn_cvt_pk_fp8_f32(a[2], a[3], w, true); o[q] = (unsigned)w; }
        *(v4u*)(dst + i * 16) = o;
    }
}
#define XB_TMO      128
#define XB_XCNT(j)  (256  + 64 * (j))
#define XB_XSUB(j)  (1280 + 64 * (j))
#define XB_XGEN(j)  (2304 + 64 * (j))
#define XB_TOP      3328
#define XB_TOPGEN   3392
#define XCD_BAR_WORDS 3456
#define XB_SPIN_CAP (1u << 18)

__device__ __forceinline__ unsigned xb_ld(unsigned* p)              { return __hip_atomic_load(p, __ATOMIC_RELAXED, __HIP_MEMORY_SCOPE_AGENT); }
__device__ __forceinline__ unsigned xb_add(unsigned* p, unsigned v) { return __hip_atomic_fetch_add(p, v, __ATOMIC_RELAXED, __HIP_MEMORY_SCOPE_AGENT); }
__device__ __forceinline__ unsigned xb_xcc_id() { return (unsigned)__builtin_amdgcn_s_getreg((3 << 11) | 20) & 0xFu; }
#define XB_SPIN(cond, bar) do { unsigned _sp = 0; while (cond) { __builtin_amdgcn_s_sleep(1); \
    if ((++_sp & 255u) == 0u) { if (xb_ld(&(bar)[XB_TMO])) break; if (_sp > XB_SPIN_CAP) { atomicAdd(&(bar)[XB_TMO], 1u); break; } } } } while (0)

struct XcdBarrier {
    unsigned* bar; unsigned x;
    volatile LAS unsigned* st;
};

__device__ __forceinline__ XcdBarrier xcd_barrier_post(unsigned* bar, volatile LAS unsigned* st) {
    XcdBarrier b; b.bar = bar; b.x = xb_xcc_id(); b.st = st;
    if (threadIdx.x == 0) (void)xb_add(&bar[XB_XCNT(b.x)], 1u);
    return b;
}
__device__ __forceinline__ void xcd_barrier_complete(unsigned* bar, unsigned x, unsigned& nloc, unsigned& nx) {
    const unsigned G = gridDim.x * gridDim.y * gridDim.z;
    unsigned sum, cnt, mine, sp = 0u;
    for (;;) {
        sum = 0u; cnt = 0u; mine = 0u;
#pragma unroll
        for (unsigned j = 0; j < 16; ++j) { const unsigned c = xb_ld(&bar[XB_XCNT(j)]); sum += c; cnt += (c > 0u) ? 1u : 0u; mine = (j == x) ? c : mine; }
        if (sum == G) break;
        __builtin_amdgcn_s_sleep(1);
        if ((++sp & 255u) == 0u) { if (xb_ld(&bar[XB_TMO])) break; if (sp > XB_SPIN_CAP) { atomicAdd(&bar[XB_TMO], 1u); break; } }
    }
    nloc = mine > 0u ? mine : 1u; nx = cnt > 0u ? cnt : 1u;
}

__device__ __forceinline__ void xcd_barrier(const XcdBarrier& b) {
    asm volatile("s_waitcnt vmcnt(0)" ::: "memory");
    __syncthreads();
    if (threadIdx.x == 0) {
        unsigned* bar = b.bar;
        __builtin_amdgcn_s_waitcnt(0);
        unsigned nloc = b.st[0], nx = b.st[1];
        if (nloc == 0u) { xcd_barrier_complete(bar, b.x, nloc, nx); b.st[0] = nloc; b.st[1] = nx; }
        const unsigned old = xb_add(&bar[XB_XSUB(b.x)], 1u);
        const unsigned gen = old / nloc;
        if (old + 1u == (gen + 1u) * nloc) {
            __builtin_amdgcn_fence(__ATOMIC_RELEASE, "agent");
            asm volatile("s_waitcnt vmcnt(0)" ::: "memory");
            const unsigned og = xb_add(&bar[XB_TOP], 1u);
            const unsigned tg = og / nx;
            if (og + 1u == (tg + 1u) * nx) xb_add(&bar[XB_TOPGEN], 1u);
            else XB_SPIN(xb_ld(&bar[XB_TOPGEN]) == tg, bar);
            __builtin_amdgcn_fence(__ATOMIC_ACQUIRE, "agent");
            xb_add(&bar[XB_XGEN(b.x)], 1u);
            asm volatile("s_waitcnt vmcnt(0)" ::: "memory");
        } else {
            XB_SPIN(xb_ld(&bar[XB_XGEN(b.x)]) == gen, bar);
            __builtin_amdgcn_fence(__ATOMIC_ACQUIRE, "agent");
            asm volatile("s_waitcnt vmcnt(0)" ::: "memory");
        }
    }
    __syncthreads();
}
typedef float f32x16 __attribute__((ext_vector_type(16)));
#ifndef TKB
#define TKB 4
#endif
typedef short s16x8 __attribute__((ext_vector_type(8)));
typedef __bf16 bf16x2_t __attribute__((ext_vector_type(2)));
__device__ __forceinline__ unsigned ordf(float f) { const unsigned u = __float_as_uint(f); return (u & 0x80000000u) ? ~u : (u | 0x80000000u); }
__device__ __forceinline__ float unordf(unsigned u) { return __uint_as_float((u & 0x80000000u) ? (u & 0x7fffffffu) : ~u); }
__device__ __forceinline__ unsigned umax_(unsigned a, unsigned b) { return a > b ? a : b; }
#define DPPU(v, ctrl) ((unsigned)__builtin_amdgcn_update_dpp(0, (int)(v), (ctrl), 0xf, 0xf, true))
#define DPPF(v, ctrl) __int_as_float(__builtin_amdgcn_update_dpp(0, __float_as_int(v), (ctrl), 0xf, 0xf, true))
__device__ __forceinline__ unsigned max32(unsigned v) {
    v = umax_(v, DPPU(v, 0xB1)); v = umax_(v, DPPU(v, 0x4E)); v = umax_(v, DPPU(v, 0x141)); v = umax_(v, DPPU(v, 0x140));
    const auto r = __builtin_amdgcn_permlane16_swap(v, v, false, false);
    return umax_(r[0], r[1]);
}
__device__ __forceinline__ float sum16(float v) {
    v += DPPF(v, 0xB1); v += DPPF(v, 0x4E); v += DPPF(v, 0x141); v += DPPF(v, 0x140); return v;
}
__device__ __forceinline__ unsigned bperm(unsigned v, int srclane) { return (unsigned)__builtin_amdgcn_ds_bpermute(srclane << 2, (int)v); }
template <int NB>
__device__ __forceinline__ void top16_of4(unsigned (&p)[NB][4], unsigned (&W)[NB], int c15) {
#pragma unroll
    for (int b = 0; b < NB; ++b) W[b] = 0u;
    for (int it = 0; it < 16; ++it) {
        unsigned m[NB];
#pragma unroll
        for (int b = 0; b < NB; ++b) m[b] = umax_(umax_(p[b][0], p[b][1]), umax_(p[b][2], p[b][3]));
#pragma unroll
        for (int b = 0; b < NB; ++b) m[b] = umax_(m[b], DPPU(m[b], 0xB1));
#pragma unroll
        for (int b = 0; b < NB; ++b) m[b] = umax_(m[b], DPPU(m[b], 0x4E));
#pragma unroll
        for (int b = 0; b < NB; ++b) m[b] = umax_(m[b], DPPU(m[b], 0x141));
#pragma unroll
        for (int b = 0; b < NB; ++b) m[b] = umax_(m[b], DPPU(m[b], 0x140));
#pragma unroll
        for (int b = 0; b < NB; ++b) { const auto r = __builtin_amdgcn_permlane16_swap(m[b], m[b], false, false); m[b] = umax_(r[0], r[1]); }
#pragma unroll
        for (int b = 0; b < NB; ++b) { W[b] = (c15 == it) ? m[b] : W[b];
#pragma unroll
            for (int i = 0; i < 4; ++i) p[b][i] = (p[b][i] == m[b]) ? 0u : p[b][i]; }
    }
}
template <int NB>
__device__ __forceinline__ void top16_of2(unsigned (&p)[NB][2], unsigned (&W)[NB], int c15) {
#pragma unroll
    for (int b = 0; b < NB; ++b) W[b] = 0u;
    for (int it = 0; it < 16; ++it) {
        unsigned m[NB];
#pragma unroll
        for (int b = 0; b < NB; ++b) m[b] = umax_(p[b][0], p[b][1]);
#pragma unroll
        for (int b = 0; b < NB; ++b) m[b] = umax_(m[b], DPPU(m[b], 0xB1));
#pragma unroll
        for (int b = 0; b < NB; ++b) m[b] = umax_(m[b], DPPU(m[b], 0x4E));
#pragma unroll
        for (int b = 0; b < NB; ++b) m[b] = umax_(m[b], DPPU(m[b], 0x141));
#pragma unroll
        for (int b = 0; b < NB; ++b) m[b] = umax_(m[b], DPPU(m[b], 0x140));
#pragma unroll
        for (int b = 0; b < NB; ++b) { const auto r = __builtin_amdgcn_permlane16_swap(m[b], m[b], false, false); m[b] = umax_(r[0], r[1]); }
#pragma unroll
        for (int b = 0; b < NB; ++b) { W[b] = (c15 == it) ? m[b] : W[b]; p[b][0] = (p[b][0] == m[b]) ? 0u : p[b][0]; p[b][1] = (p[b][1] == m[b]) ? 0u : p[b][1]; }
    }
}
__device__ __forceinline__ void topk_fill(LAS unsigned char* lds, const bf16* keys, int h, int tid) {
#pragma unroll
    for (int i = 0; i < 8; ++i) { const int idx = tid + 512 * i, p = idx >> 11, key = (idx >> 4) & 127, ch = idx & 15;
        const v4u v = *(const v4u*)(keys + (size_t)((h * 2 + p) * 128 + key) * 128 + ch * 8);
        *(LAS v4u*)(lds + p * 32768 + key * 256 + ((ch ^ (key & 15)) << 4)) = v; }
}
__device__ __forceinline__ void topk_unit(const bf16* q, LAS const unsigned char* lds, int* EI, float* GW, int t0, int h, int lane) {
    const int c = lane & 31, hi = lane >> 5, c15 = lane & 15, hbase = lane & 32;
    int f0 = 0, f1 = 0;
    { int cnt = 0;
#pragma unroll
      for (int i = 0; i < 16; ++i)
#pragma unroll
        for (int j = 0; j < 16; ++j) if ((i + 1) * (j + 1) <= 16) { f0 = (cnt == c) ? (i * 16 + j) : f0; f1 = (cnt == c + 32) ? (i * 16 + j) : f1; ++cnt; } }
    unsigned W[2][16];
#pragma unroll
    for (int p = 0; p < 2; ++p) {
        f32x16 acc[4];
#pragma unroll
        for (int kb = 0; kb < 4; ++kb)
#pragma unroll
            for (int r = 0; r < 16; ++r) acc[kb][r] = 0.f;
        const bf16* qp = q + (size_t)(t0 + c) * 2048 + h * 256 + p * 128 + hi * 8;
        LAS const unsigned char* kp = lds + p * 32768 + c * 256;
        asm volatile("" : "+v"(qp));
#pragma unroll 2
        for (int ks = 0; ks < 8; ++ks) {
            const s16x8 a = *(const s16x8*)(qp + ks * 16);
#pragma unroll
            for (int kb = 0; kb < 4; ++kb) { const s16x8 b = *(LAS const s16x8*)(kp + kb * 32 * 256 + (((2 * ks + hi) ^ (c & 15)) << 4)); acc[kb] = __builtin_amdgcn_mfma_f32_32x32x16_bf16(a, b, acc[kb], 0, 0, 0); }
        }
#pragma unroll
        for (int r0 = 0; r0 < 16; r0 += TKB) {
            unsigned pk[TKB][4], Wb[TKB];
#pragma unroll
            for (int b = 0; b < TKB; ++b) { pk[b][0] = (ordf(acc[0][r0 + b]) & ~127u) | (unsigned)(127 - c); pk[b][1] = (ordf(acc[1][r0 + b]) & ~127u) | (unsigned)(95 - c);
                pk[b][2] = (ordf(acc[2][r0 + b]) & ~127u) | (unsigned)(63 - c); pk[b][3] = (ordf(acc[3][r0 + b]) & ~127u) | (unsigned)(31 - c); }
            top16_of4<TKB>(pk, Wb, c15);
#pragma unroll
            for (int b = 0; b < TKB; ++b) W[p][r0 + b] = Wb[b];
        }
    }
#pragma unroll
    for (int r0 = 0; r0 < 16; r0 += TKB) {
        unsigned cp[TKB][2], Wc[TKB];
#pragma unroll
        for (int b = 0; b < TKB; ++b) {
            const unsigned w0 = W[0][r0 + b], w1 = W[1][r0 + b];
            const float a0 = unordf(bperm(w0, hbase + (f0 >> 4)) & ~127u), b0 = unordf(bperm(w1, hbase + (f0 & 15)) & ~127u);
            const float a1 = unordf(bperm(w0, hbase + (f1 >> 4)) & ~127u), b1 = unordf(bperm(w1, hbase + (f1 & 15)) & ~127u);
            cp[b][0] = (ordf(a0 + b0) & ~63u) | (unsigned)(63 - c);
            cp[b][1] = (c + 32 < 50) ? ((ordf(a1 + b1) & ~63u) | (unsigned)(31 - c)) : 0u;
        }
        top16_of2<TKB>(cp, Wc, c15);
#pragma unroll
        for (int b = 0; b < TKB; ++b) {
            const int r = r0 + b; const unsigned w0 = W[0][r], w1 = W[1][r];
            const int slot = 63 - (int)(Wc[b] & 63u);
            const unsigned fa = bperm((unsigned)f0, hbase + (slot & 31)), fb = bperm((unsigned)f1, hbase + (slot & 31));
            const int flat = (slot < 32) ? (int)fa : (int)fb;
            const float val = unordf(Wc[b] & ~63u);
            const float vmax = __uint_as_float(bperm(__float_as_uint(val), hbase));
            const float e = __expf(val - vmax);
            const float g = e / sum16(e);
            const int k1 = 127 - (int)(bperm(w0, hbase + (flat >> 4)) & 127u), k2 = 127 - (int)(bperm(w1, hbase + (flat & 15)) & 127u);
            const int tok = t0 + (r & 3) + 8 * (r >> 2) + 4 * hi;
            if (c < 16) { EI[(size_t)(tok * 8 + h) * 16 + c] = k1 * 128 + k2; GW[(size_t)(tok * 8 + h) * 16 + c] = g; }
        }
    }
}

__device__ __forceinline__ float gelu_tanh_f(float x) {
    const float u = 0.7978845608028654f * (x + 0.044715f * x * x * x);
    const float e = __expf(2.f * u);
    const float th = 1.f - 2.f / (e + 1.f);
    return 0.5f * x * (1.f + th);
}
__device__ __forceinline__ float wave_sum_bfly(float v) {
#pragma unroll
    for (int o = 1; o < 64; o <<= 1) v += __shfl_xor(v, o);
    return v;
}
typedef float f32x2_ __attribute__((ext_vector_type(2)));
#define U_SCALE 1024.f
#define V_SCALE 256.f
__device__ __forceinline__ void peer_token(float* xio, const float* gain, const int* EI, const float* GW, const unsigned char* U8, const unsigned char* V8, bf16* xb, float* ssq, const float* fin, int t, int lane, float oscale) {
    float* xr = xio + (size_t)t * 2048 + 16 * lane;
    f32x2_ h2[16];
    {
        f32x4 xv[8]; float s = 0.f;
#pragma unroll
        for (int j = 0; j < 2; ++j)
#pragma unroll
            for (int q = 0; q < 4; ++q) xv[4 * j + q] = *(const f32x4*)(xr + 1024 * j + 4 * q);
#pragma unroll
        for (int j = 0; j < 8; ++j) s += (xv[j][0] * xv[j][0] + xv[j][1] * xv[j][1]) + (xv[j][2] * xv[j][2] + xv[j][3] * xv[j][3]);
        const float rs = rsqrtf(wave_sum_bfly(s) * (1.f / 2048.f) + EPS);
#pragma unroll
        for (int j = 0; j < 2; ++j)
#pragma unroll
            for (int q = 0; q < 4; ++q) { const f32x4 g = *(const f32x4*)(gain + 1024 * j + 16 * lane + 4 * q);
                h2[8 * j + 2 * q] = (f32x2_){xv[4 * j + q][0] * rs * g[0], xv[4 * j + q][1] * rs * g[1]}; h2[8 * j + 2 * q + 1] = (f32x2_){xv[4 * j + q][2] * rs * g[2], xv[4 * j + q][3] * rs * g[3]}; }
    }
    f32x2_ acc[16];
#pragma unroll
    for (int i = 0; i < 16; ++i) acc[i] = (f32x2_){0.f, 0.f};
    const unsigned lo16 = 16u * (unsigned)lane;
    const int ei_lo = EI[(size_t)t * 128 + lane], ei_hi = EI[(size_t)t * 128 + 64 + lane];
    const float gw_lo = GW[(size_t)t * 128 + lane], gw_hi = GW[(size_t)t * 128 + 64 + lane];
#define PG_LOAD(UU, VV, grp_) do { const int eiv_ = ((grp_) < 32) ? ei_lo : ei_hi; \
        _Pragma("unroll") for (int k = 0; k < 2; ++k) { const int e = __builtin_amdgcn_readlane(eiv_, (((grp_) & 31) << 1) + k); \
            const unsigned char* up = U8 + (size_t)e * 2048; const unsigned char* vp = V8 + (size_t)e * 2048; \
            UU[k][0] = *(const v4u*)(up + lo16); UU[k][1] = *(const v4u*)(up + lo16 + 1024); VV[k][0] = *(const v4u*)(vp + lo16); VV[k][1] = *(const v4u*)(vp + lo16 + 1024); } } while (0)
#define PG_COMPUTE(UU, VV, grp_) do { const float gwv_ = ((grp_) < 32) ? gw_lo : gw_hi; \
        float d[2]; \
        _Pragma("unroll") for (int k = 0; k < 2; ++k) { f32x2_ d2 = (f32x2_){0.f, 0.f}; \
            _Pragma("unroll") for (int j = 0; j < 2; ++j) _Pragma("unroll") for (int q = 0; q < 4; ++q) { const int w = (int)UU[k][j][q]; \
                d2 = __builtin_elementwise_fma(__builtin_amdgcn_cvt_pk_f32_fp8(w, false), h2[8 * j + 2 * q], d2); \
                d2 = __builtin_elementwise_fma(__builtin_amdgcn_cvt_pk_f32_fp8(w, true), h2[8 * j + 2 * q + 1], d2); } \
            d[k] = d2.x + d2.y; } \
        float w; \
        { const auto r = __builtin_amdgcn_permlane32_swap(__float_as_uint(d[0]), __float_as_uint(d[1]), false, false); w = __uint_as_float(r[0]) + __uint_as_float(r[1]); } \
        { const auto r = __builtin_amdgcn_permlane16_swap(__float_as_uint(w), __float_as_uint(w), false, false); w = __uint_as_float(r[0]) + __uint_as_float(r[1]); } \
        w += DPPF(w, 0x128); w += DPPF(w, 0xB1); w += DPPF(w, 0x4E); w += DPPF(w, 0x141); \
        const float gk = __uint_as_float(bperm(__float_as_uint(gwv_), (((grp_) & 31) << 1) + (lane >> 5))); \
        const float wgt = gk * gelu_tanh_f(w * (1.f / U_SCALE)) * (1.f / V_SCALE); \
        _Pragma("unroll") for (int k = 0; k < 2; ++k) { const float wk = __int_as_float(__builtin_amdgcn_readlane(__float_as_int(wgt), 32 * k)); const f32x2_ wk2 = (f32x2_){wk, wk}; \
            _Pragma("unroll") for (int j = 0; j < 2; ++j) _Pragma("unroll") for (int q = 0; q < 4; ++q) { const int wv = (int)VV[k][j][q]; \
                acc[8 * j + 2 * q] = __builtin_elementwise_fma(__builtin_amdgcn_cvt_pk_f32_fp8(wv, false), wk2, acc[8 * j + 2 * q]); \
                acc[8 * j + 2 * q + 1] = __builtin_elementwise_fma(__builtin_amdgcn_cvt_pk_f32_fp8(wv, true), wk2, acc[8 * j + 2 * q + 1]); } } } while (0)
    {
        v4u uuA[2][2], vvA[2][2], uuB[2][2], vvB[2][2];
        PG_LOAD(uuA, vvA, 0);
        for (int grp = 0; grp < 64; grp += 2) {
            PG_LOAD(uuB, vvB, grp + 1);
            PG_COMPUTE(uuA, vvA, grp);
            if (grp + 2 < 64) PG_LOAD(uuA, vvA, grp + 2);
            PG_COMPUTE(uuB, vvB, grp + 1);
        }
    }
#undef PG_LOAD
#undef PG_COMPUTE
    float s2 = 0.f;
#pragma unroll
    for (int j = 0; j < 2; ++j)
#pragma unroll
        for (int q = 0; q < 4; ++q) { const f32x4 x0 = *(const f32x4*)(xr + 1024 * j + 4 * q);
            acc[8 * j + 2 * q] += (f32x2_){x0[0], x0[1]}; acc[8 * j + 2 * q + 1] += (f32x2_){x0[2], x0[3]};
            s2 += (acc[8 * j + 2 * q].x * acc[8 * j + 2 * q].x + acc[8 * j + 2 * q].y * acc[8 * j + 2 * q].y) + (acc[8 * j + 2 * q + 1].x * acc[8 * j + 2 * q + 1].x + acc[8 * j + 2 * q + 1].y * acc[8 * j + 2 * q + 1].y); }
    s2 = wave_sum_bfly(s2);
    if (fin) {
        const float r2 = rsqrtf(s2 * (1.f / 2048.f) + EPS) * oscale;
#pragma unroll
        for (int j = 0; j < 2; ++j)
#pragma unroll
            for (int q = 0; q < 4; ++q) { const f32x4 g = *(const f32x4*)(fin + 1024 * j + 16 * lane + 4 * q);
                f32x4 o; o[0] = acc[8 * j + 2 * q].x * r2 * g[0]; o[1] = acc[8 * j + 2 * q].y * r2 * g[1]; o[2] = acc[8 * j + 2 * q + 1].x * r2 * g[2]; o[3] = acc[8 * j + 2 * q + 1].y * r2 * g[3];
                *(f32x4*)(xr + 1024 * j + 4 * q) = o; }
    } else {
        bf16* xbr = xb + (size_t)t * 2048 + 16 * lane;
#pragma unroll
        for (int j = 0; j < 2; ++j) {
#pragma unroll
            for (int q = 0; q < 4; ++q) { f32x4 o; o[0] = acc[8 * j + 2 * q].x; o[1] = acc[8 * j + 2 * q].y; o[2] = acc[8 * j + 2 * q + 1].x; o[3] = acc[8 * j + 2 * q + 1].y; *(f32x4*)(xr + 1024 * j + 4 * q) = o; }
            v4u o0, o1;
            o0.x = pk2(acc[8 * j + 0].x, acc[8 * j + 0].y); o0.y = pk2(acc[8 * j + 1].x, acc[8 * j + 1].y); o0.z = pk2(acc[8 * j + 2].x, acc[8 * j + 2].y); o0.w = pk2(acc[8 * j + 3].x, acc[8 * j + 3].y);
            o1.x = pk2(acc[8 * j + 4].x, acc[8 * j + 4].y); o1.y = pk2(acc[8 * j + 5].x, acc[8 * j + 5].y); o1.z = pk2(acc[8 * j + 6].x, acc[8 * j + 6].y); o1.w = pk2(acc[8 * j + 7].x, acc[8 * j + 7].y);
            *(v4u*)(xbr + 1024 * j) = o0; *(v4u*)(xbr + 1024 * j + 8) = o1;
        }
        if (lane == 0) ssq[t] = s2;
    }
}
typedef short s16x4 __attribute__((ext_vector_type(4)));
__device__ __forceinline__ unsigned cvt_pk_bf16_(float lo, float hi) { unsigned r; asm volatile("v_cvt_pk_bf16_f32 %0, %1, %2" : "=v"(r) : "v"(lo), "v"(hi)); return r; }
constexpr int ATT_K_OFF = 0, ATT_V_OFF = 40960, ATT_VSTRIDE = 648, ATT_LDS = ATT_V_OFF + 64 * ATT_VSTRIDE;
__device__ __forceinline__ void attn_fill(LAS unsigned char* lds, const bf16* K, const bf16* Vt, int b, int kvh, int kw0, int tid) {
    const size_t tb = (size_t)b * 4096;
#pragma unroll
    for (int i = 0; i < 5; ++i) { const int idx = tid + 512 * i, row = idx >> 3, ch = idx & 7, key = kw0 + row;
        v4u v = (v4u){0u, 0u, 0u, 0u}; if (key >= 0 && key < 4096) v = *(const v4u*)(K + (tb + key) * 512 + kvh * 64 + ch * 8);
        *(LAS v4u*)(lds + ATT_K_OFF + row * 128 + ((ch ^ ((row >> 1) & 7)) << 4)) = v; }
#pragma unroll
    for (int i = 0; i < 10; ++i) { const int idx = tid + 512 * i, d = idx / 80, pc = idx % 80, key = kw0 + pc * 4;
        v2u v = (v2u){0u, 0u}; if (key >= 0 && key < 4096) v = *(const v2u*)(Vt + (size_t)(kvh * 64 + d) * 16384 + tb + key);
        *(LAS v2u*)(lds + ATT_V_OFF + d * ATT_VSTRIDE + pc * 8) = v; }
}
__device__ __forceinline__ void attn_task(LAS const unsigned char* lds, const bf16* Q, bf16* O, const float* sinks, int b, int hq, int q0, int kw0, int lane) {
    const int c = lane & 31, hi = lane >> 5;
    const size_t tb = (size_t)b * 4096;
    s16x8 qf[4];
    { const bf16* qp = Q + (tb + q0 + c) * 2048 + hq * 64 + hi * 8;
#pragma unroll
      for (int ks = 0; ks < 4; ++ks) qf[ks] = *(const s16x8*)(qp + ks * 16); }
    const float sink2 = sinks[hq] * 1.4426950408889634f;
    float m = sink2, l = (hi == 0) ? 1.f : 0.f;
    f32x16 o0, o1;
#pragma unroll
    for (int r = 0; r < 16; ++r) { o0[r] = 0.f; o1[r] = 0.f; }
    const int kt_lo = (q0 < 128) ? ((128 - q0) >> 5) : 0, kt_hi = ((4192 - q0) >> 5) < 8 ? ((4192 - q0) >> 5) : 8;
    for (int kt = kt_lo; kt <= kt_hi; ++kt) {
        const int key0 = q0 - 128 + 32 * kt, row0 = key0 - kw0;
        s16x8 kf[4]; s16x4 va[2][2][2];
        { const int row = row0 + c; LAS const unsigned char* kp = lds + ATT_K_OFF + row * 128; const int sw = (row >> 1) & 7;
#pragma unroll
          for (int ks = 0; ks < 4; ++ks) kf[ks] = *(LAS const s16x8*)(kp + (((2 * ks + hi) ^ sw) << 4)); }
#pragma unroll
        for (int db = 0; db < 2; ++db)
#pragma unroll
            for (int s = 0; s < 2; ++s) { LAS const unsigned char* vp = lds + ATT_V_OFF + (db * 32 + c) * ATT_VSTRIDE + (row0 + 16 * s + 4 * hi) * 2; va[db][s][0] = *(LAS const s16x4*)vp; va[db][s][1] = *(LAS const s16x4*)(vp + 16); }
        f32x16 sa;
#pragma unroll
        for (int r = 0; r < 16; ++r) sa[r] = 0.f;
#pragma unroll
        for (int ks = 0; ks < 4; ++ks) sa = __builtin_amdgcn_mfma_f32_32x32x16_bf16(kf[ks], qf[ks], sa, 0, 0, 0);
        if (kt == 0 || kt == 8) {
            const int dbase = key0 - (q0 + c) + 4 * hi;
#pragma unroll
            for (int r = 0; r < 16; ++r) { const int d = dbase + (r & 3) + 8 * (r >> 2); if (d < -128 || d > 128) sa[r] = -1e30f; }
        }
        float mx = sa[0];
#pragma unroll
        for (int r = 1; r < 16; ++r) mx = fmaxf(mx, sa[r]);
        { const auto rr = __builtin_amdgcn_permlane32_swap(__float_as_uint(mx), __float_as_uint(mx), false, false); mx = fmaxf(__uint_as_float(rr[0]), __uint_as_float(rr[1])); }
        const float mn = fmaxf(m, mx), alpha = __builtin_amdgcn_exp2f(m - mn);
        m = mn;
        float ps = 0.f;
#pragma unroll
        for (int r = 0; r < 16; ++r) { sa[r] = __builtin_amdgcn_exp2f(sa[r] - mn); ps += sa[r]; }
        l = l * alpha + ps;
#pragma unroll
        for (int r = 0; r < 16; ++r) { o0[r] *= alpha; o1[r] *= alpha; }
        s16x8 pf[2];
#pragma unroll
        for (int s = 0; s < 2; ++s) { v4u w; w.x = cvt_pk_bf16_(sa[8 * s + 0], sa[8 * s + 1]); w.y = cvt_pk_bf16_(sa[8 * s + 2], sa[8 * s + 3]); w.z = cvt_pk_bf16_(sa[8 * s + 4], sa[8 * s + 5]); w.w = cvt_pk_bf16_(sa[8 * s + 6], sa[8 * s + 7]);
            pf[s] = __builtin_bit_cast(s16x8, w); }
#pragma unroll
        for (int s = 0; s < 2; ++s) {
            const s16x8 v0 = __builtin_shufflevector(va[0][s][0], va[0][s][1], 0, 1, 2, 3, 4, 5, 6, 7), v1 = __builtin_shufflevector(va[1][s][0], va[1][s][1], 0, 1, 2, 3, 4, 5, 6, 7);
            o0 = __builtin_amdgcn_mfma_f32_32x32x16_bf16(v0, pf[s], o0, 0, 0, 0);
            o1 = __builtin_amdgcn_mfma_f32_32x32x16_bf16(v1, pf[s], o1, 0, 0, 0);
        }
    }
    { const auto rr = __builtin_amdgcn_permlane32_swap(__float_as_uint(l), __float_as_uint(l), false, false); l = __uint_as_float(rr[0]) + __uint_as_float(rr[1]); }
    const float il = 1.f / l;
    bf16* op = O + (tb + q0 + c) * 2048 + hq * 64 + 4 * hi;
#pragma unroll
    for (int g = 0; g < 4; ++g) {
        v2u w0, w1;
        w0.x = cvt_pk_bf16_(o0[4 * g + 0] * il, o0[4 * g + 1] * il); w0.y = cvt_pk_bf16_(o0[4 * g + 2] * il, o0[4 * g + 3] * il);
        w1.x = cvt_pk_bf16_(o1[4 * g + 0] * il, o1[4 * g + 1] * il); w1.y = cvt_pk_bf16_(o1[4 * g + 2] * il, o1[4 * g + 3] * il);
        *(v2u*)(op + 8 * g) = w0; *(v2u*)(op + 32 + 8 * g) = w1;
    }
}
typedef float fx2 __attribute__((ext_vector_type(2)));
__device__ __forceinline__ fx2 bf2_(unsigned w) { fx2 r; r[0] = __uint_as_float(w << 16); r[1] = __uint_as_float(w & 0xffff0000u); return r; }
__device__ __forceinline__ void fft16_item(bf16* Zp, const float* tw, int bg, int l, int s1h, int lane) {
    const int s1 = s1h * 128 + 2 * lane;
    bf16* base = Zp + ((size_t)(bg * 16) * 256 + l) * 512 + s1;
    fx2 zr[16], zi[16];
#pragma unroll
    for (int s2 = 0; s2 < 16; ++s2) { zr[s2] = bf2_(*(const unsigned*)(base + (size_t)s2 * 256 * 512)); zi[s2] = bf2_(*(const unsigned*)(base + (size_t)s2 * 256 * 512 + 256)); }
    fx2 er[16], ei[16];
#pragma unroll
    for (int d = 0; d < 4; ++d) {
        const fx2 ar = zr[d], ai_ = zi[d], br = zr[4 + d], bi = zi[4 + d], cr = zr[8 + d], ci = zi[8 + d], dr = zr[12 + d], di = zi[12 + d];
        const fx2 s0r = ar + cr, s0i = ai_ + ci, s1r = ar - cr, s1i = ai_ - ci, s2r = br + dr, s2i = bi + di, s3r = br - dr, s3i = bi - di;
        er[0 * 4 + d] = s0r + s2r; ei[0 * 4 + d] = s0i + s2i;
        er[1 * 4 + d] = s1r + s3i; ei[1 * 4 + d] = s1i - s3r;
        er[2 * 4 + d] = s0r - s2r; ei[2 * 4 + d] = s0i - s2i;
        er[3 * 4 + d] = s1r - s3i; ei[3 * 4 + d] = s1i + s3r;
    }
#pragma unroll
    for (int a = 1; a < 4; ++a)
#pragma unroll
        for (int d = 1; d < 4; ++d) {
            const float ang = 6.283185307179586f * (float)(a * d) / 16.f; const float c = __builtin_cosf(ang), sn = __builtin_sinf(ang);
            const fx2 xr = er[a * 4 + d], xi = ei[a * 4 + d];
            er[a * 4 + d] = xr * c + xi * sn; ei[a * 4 + d] = xi * c - xr * sn;
        }
#pragma unroll
    for (int a = 0; a < 4; ++a) {
        const fx2 ar = er[a * 4 + 0], ai_ = ei[a * 4 + 0], br = er[a * 4 + 1], bi = ei[a * 4 + 1], cr = er[a * 4 + 2], ci = ei[a * 4 + 2], dr = er[a * 4 + 3], di = ei[a * 4 + 3];
        const fx2 s0r = ar + cr, s0i = ai_ + ci, s1r = ar - cr, s1i = ai_ - ci, s2r = br + dr, s2i = bi + di, s3r = br - dr, s3i = bi - di;
        fx2 Dr[4], Di[4];
        Dr[0] = s0r + s2r; Di[0] = s0i + s2i; Dr[1] = s1r + s3i; Di[1] = s1i - s3r; Dr[2] = s0r - s2r; Di[2] = s0i - s2i; Dr[3] = s1r - s3i; Di[3] = s1i + s3r;
#pragma unroll
        for (int b = 0; b < 4; ++b) {
            const int k2 = a + 4 * b;
            const f32x4 t0 = *(const f32x4*)(tw + (size_t)(k2 * 256 + s1) * 2);
            const fx2 cc = (fx2){t0[0], t0[2]}, ss = (fx2){t0[1], t0[3]};
            const fx2 hr = Dr[b] * cc + Di[b] * ss, hi_ = Di[b] * cc - Dr[b] * ss;
            *(unsigned*)(base + (size_t)k2 * 256 * 512) = pk2(hr[0], hr[1]); *(unsigned*)(base + (size_t)k2 * 256 * 512 + 256) = pk2(hi_[0], hi_[1]);
        }
    }
}
#ifndef REP_PRO
#define REP_PRO 1
#endif
#ifndef REP_GEMM
#define REP_GEMM 1
#endif
#ifndef REP_ATT
#define REP_ATT 1
#endif
#ifndef REP_TK
#define REP_TK 1
#endif
enum { PH_PRO = 0, PH_G1 = 1, PH_S1 = 2, PH_G2 = 3, PH_G3 = 4, PH_Q0 = 5, PH_TK0 = 6, PH_PE0 = 7, PH_QKV = 8, PH_ATT = 9, PH_WO = 10, PH_Q1 = 11, PH_TK1 = 12, PH_PE1 = 13, PH_END = 14 };
__global__ void __launch_bounds__(NWAVES * 64, 2) mega(Args a) {
    extern __shared__ __attribute__((aligned(16))) unsigned char lds_raw[];
    LAS unsigned char* lds = (LAS unsigned char*)lds_raw;
    cg::grid_group grid = cg::this_grid();
    const int tid = threadIdx.x, lane = tid & 63, wave = __builtin_amdgcn_readfirstlane(tid >> 6);
    const int G = gridDim.x, bx = blockIdx.x;
    unsigned char* ws = a.ws;
    const int lo = a.ph_lo, hi = a.ph_hi;
    volatile LAS unsigned* MISC = (volatile LAS unsigned*)(lds + LDSCTL_OFF);
    if (tid < 16) MISC[tid] = 0u;
    __syncthreads();
    XcdBarrier xbar = xcd_barrier_post((unsigned*)(ws + WS_CTL) + CW_BAR, MISC + 8);
#define IN(k) (lo <= (k) && (k) < hi)
#ifdef DIAG_A
#define STAMP(i) do { if (bx == 0 && tid == 0) ((unsigned long long*)(ws + WS_STAMP))[i] = __builtin_amdgcn_s_memrealtime(); } while (0)
#else
#define STAMP(i) do { } while (0)
#endif
#define SEAM(k) do { if (IN(k) && IN((k) + 1)) { if ((k) == PH_PRO) grid.sync(); else xcd_barrier(xbar); } STAMP((k) + 1); } while (0)
    STAMP(0);
    for (int rep_ = 0; rep_ < REP_PRO; ++rep_)
    if (IN(PH_PRO)) {
        const int gw = bx * NWAVES + wave, NGW = G * NWAVES;
        const size_t gtid = (size_t)bx * (NWAVES * 64) + tid, ngt = (size_t)G * NWAVES * 64;
        LAS float* scr = (LAS float*)(lds + wave * 16384);
        {
            constexpr int I_SQ = (DM / 64) * (DM / 32), I_QKV = (DM / 64) * (QKVW / 32);
            constexpr int NITEMS = 4 * I_SQ + I_QKV;
            for (int it = gw; it < NITEMS; it += NGW) {
                int r = it;
                if (r < I_SQ) { transpose_item<0>(a.in[3], DM, DM, nullptr, (bf16*)(ws + WS_WOF), scr, r, lane); continue; } r -= I_SQ;
                if (r < I_SQ) { transpose_item<0>(a.in[5], DM, DM, nullptr, (bf16*)(ws + WS_WOA), scr, r, lane); continue; } r -= I_SQ;
                if (r < I_SQ) { transpose_item<0>(a.in[7], DM, DM, a.in[2], (bf16*)(ws + WS_WQ0), scr, r, lane); continue; } r -= I_SQ;
                if (r < I_SQ) { transpose_item<0>(a.in[7] + (size_t)DM * DM, DM, DM, a.in[2] + DM, (bf16*)(ws + WS_WQ1), scr, r, lane); continue; } r -= I_SQ;
                transpose_item<1>(a.in[4], DM, QKVW, a.in[1] + DM, (bf16*)(ws + WS_WQKV), scr, r, lane);
            }
        }
        for (int row = gw; row < T; row += NGW) {
            const f32x4* xr = (const f32x4*)(a.in[0] + (size_t)row * DM) + lane;
            const f32x4* gr = (const f32x4*)a.in[1] + lane;
            f32x4 v[8]; float s = 0.f;
#pragma unroll
            for (int j = 0; j < 8; ++j) { v[j] = xr[64 * j]; s += (v[j][0] * v[j][0] + v[j][1] * v[j][1]) + (v[j][2] * v[j][2] + v[j][3] * v[j][3]); }
            const float r = rsqrtf(wsum(s) * (1.f / DM) + EPS);
            const int b = row >> 12, sp = row & 4095;
#pragma unroll
            for (int j = 0; j < 8; ++j) { const f32x4 gg = gr[64 * j]; v2u o; o.x = pk2(v[j][0] * r * gg[0], v[j][1] * r * gg[1]); o.y = pk2(v[j][2] * r * gg[2], v[j][3] * r * gg[3]);
                *(v2u*)((bf16*)(ws + WS_XG) + ((size_t)((b * 8 + j) * 4096 + sp) * 256 + 4 * lane)) = o; }
        }
        for (size_t i = gtid; i < (size_t)256 * 512 / 8; i += ngt) {
            const int k1 = (int)(i >> 6), c0 = (int)(i & 63) * 8, part = c0 >> 8, s0 = c0 & 255;
            float v[8];
#pragma unroll
            for (int e = 0; e < 8; ++e) { const int m = (k1 * (s0 + e)) & 255; const float rev = (float)m * (1.f / 256.f); v[e] = (part ? __builtin_amdgcn_sinf(rev) : __builtin_amdgcn_cosf(rev)) * (1.f / 64.f); }
            v4u o; o.x = pk2(v[0], v[1]); o.y = pk2(v[2], v[3]); o.z = pk2(v[4], v[5]); o.w = pk2(v[6], v[7]);
            *(v4u*)((bf16*)(ws + WS_A2) + i * 8) = o;
        }
        for (size_t i = gtid; i < (size_t)16 * 256; i += ngt) {
            const int k2 = (int)(i >> 8), s1 = (int)(i & 255); const float rev = (float)(k2 * s1) * (1.f / 4096.f);
            ((float*)(ws + WS_TW))[2 * i] = __builtin_amdgcn_cosf(rev); ((float*)(ws + WS_TW))[2 * i + 1] = __builtin_amdgcn_sinf(rev);
        }
        for (size_t i = gtid; i < (size_t)512 * 256 / 8; i += ngt) {
            const int n = (int)(i >> 5), c0 = (int)(i & 31) * 8, part = n >> 8, l = n & 255;
            float v[8];
#pragma unroll
            for (int e = 0; e < 8; ++e) { const int m = (l * (c0 + e)) & 255; const float rev = (float)m * (1.f / 256.f); v[e] = (part ? -__builtin_amdgcn_sinf(rev) : __builtin_amdgcn_cosf(rev)) * (1.f / 16.f); }
            v4u o; o.x = pk2(v[0], v[1]); o.y = pk2(v[2], v[3]); o.z = pk2(v[4], v[5]); o.w = pk2(v[6], v[7]);
            *(v4u*)((bf16*)(ws + WS_WCS) + i * 8) = o;
        }
        for (size_t i = gtid; i < (size_t)4096 * 32; i += ngt) {
            const int pos = (int)(i >> 5), fi = (int)(i & 31);
            const double inv = exp2(-(double)fi * (13.287712379549449 / 32.0));
            double sn, cs; sincos((double)pos * inv, &sn, &cs);
            ((float*)(ws + WS_ROPE))[2 * i] = (float)cs; ((float*)(ws + WS_ROPE))[2 * i + 1] = (float)sn;
        }
        cvt_stream8(a.in[9], ws + WS_U0, (size_t)NEXP * DM / 16, gtid, ngt, 1024.f);
        cvt_stream8(a.in[10], ws + WS_V0, (size_t)NEXP * DM / 16, gtid, ngt, 256.f);
        cvt_stream8(a.in[9] + (size_t)NEXP * DM, ws + WS_U1, (size_t)NEXP * DM / 16, gtid, ngt, 1024.f);
        cvt_stream8(a.in[10] + (size_t)NEXP * DM, ws + WS_V1, (size_t)NEXP * DM / 16, gtid, ngt, 256.f);
        cvt_stream(a.in[8], (bf16*)(ws + WS_KEYS), (size_t)2 * PH * 2 * 128 * 128 / 8, gtid, ngt);
    }
    SEAM(PH_PRO);
    for (int rep_ = 0; rep_ < REP_GEMM; ++rep_)
    if (IN(PH_G1)) {
        int Kq = FW; asm volatile("" : "+s"(Kq));
        pg8::Gemm g{(const pg8::bf16_t*)(ws + WS_WCS), (const pg8::bf16_t*)(ws + WS_XG), 512, T * FG, Kq}; pg8::StaticOrder S; S.init(512, T * FG, G, bx);
        pg8::EpiZt E{(pg8::bf16_t*)(ws + WS_ZT)};
        pg8::gemm_phase<pg8::EpiZt, pg8::StaticOrder, true, true>(lds, g, S, E);
    }
    SEAM(PH_G1);
    if (IN(PH_S1)) {
        const int gw = bx * NWAVES + wave, NGW = G * NWAVES;
        for (int it = gw; it < 32 * 256 * 2; it += NGW) fft16_item((bf16*)(ws + WS_ZT), (const float*)(ws + WS_TW), it >> 9, (it >> 1) & 255, it & 1, lane);
    }
    SEAM(PH_S1);
    for (int rep_ = 0; rep_ < REP_GEMM; ++rep_)
    if (IN(PH_G2)) {
        pg8::Gemm g{(const pg8::bf16_t*)(ws + WS_A2), (const pg8::bf16_t*)(ws + WS_ZT), 256, 131072, 512}; pg8::StaticOrder S; S.init(256, 131072, G, bx);
        pg8::EpiY E{(pg8::bf16_t*)(ws + WS_Y)};
        pg8::gemm_phase<pg8::EpiY, pg8::StaticOrder, true, true>(lds, g, S, E);
    }
    SEAM(PH_G2);
    if (IN(PH_G3)) {
        pg8::Gemm g{(const pg8::bf16_t*)(ws + WS_Y), (const pg8::bf16_t*)(ws + WS_WOF), T, DM, DM}; pg8::StaticOrder S; S.init(T, DM, G, bx);
        pg8::EpiRes E{a.in[0], a.out, (pg8::bf16_t*)(ws + WS_XB), (float*)(ws + WS_SSQ_A)};
        pg8::gemm_phase<pg8::EpiRes, pg8::StaticOrder, true, true>(lds, g, S, E);
    }
    SEAM(PH_G3);
#define PEER_LAYER(L) do { \
        const int pq = L ? PH_Q1 : PH_Q0, ptk = L ? PH_TK1 : PH_TK0, ppe = L ? PH_PE1 : PH_PE0; \
        for (int rep_ = 0; rep_ < REP_GEMM; ++rep_) \
        if (IN(pq)) { \
            pg8::Gemm g{(const pg8::bf16_t*)(ws + WS_XB), (const pg8::bf16_t*)(ws + (L ? WS_WQ1 : WS_WQ0)), T, DM, DM}; pg8::StaticOrder S; S.init(T, DM, G, bx); \
            pg8::EpiScale E{(pg8::bf16_t*)(ws + WS_Q), (const float*)(ws + (L ? WS_SSQ_C : WS_SSQ_A))}; \
            pg8::gemm_phase<pg8::EpiScale, pg8::StaticOrder, true, true>(lds, g, S, E); \
        } \
        SEAM(pq); \
        if (IN(ptk)) { \
            const bf16* keys = (const bf16*)(ws + WS_KEYS) + (size_t)L * PH * 2 * 128 * 128; \
            for (int rep_ = 0; rep_ < REP_TK; ++rep_) \
            for (int u = bx; u < (T / 256) * PH; u += G) { \
                const int h = u & 7, tblk = u >> 3; \
                __syncthreads(); \
                topk_fill(lds, keys, h, tid); \
                __syncthreads(); \
                topk_unit((const bf16*)(ws + WS_Q), lds, (int*)(ws + WS_EI), (float*)(ws + WS_GW), tblk * 256 + wave * 32, h, lane); \
            } \
        } \
        SEAM(ptk); \
        if (IN(ppe)) { \
            const int gw = bx * NWAVES + wave, NGW = G * NWAVES; \
            for (int t = gw; t < T; t += NGW) \
                peer_token(a.out, a.in[2] + L * DM, (const int*)(ws + WS_EI), (const float*)(ws + WS_GW), (const unsigned char*)(ws + (L ? WS_U1 : WS_U0)), (const unsigned char*)(ws + (L ? WS_V1 : WS_V0)), \
                           (bf16*)(ws + WS_XB), (float*)(ws + WS_SSQ_B), L ? a.in[11] : nullptr, t, lane, oscale); \
        } \
    } while (0)
    float oscale = 1.f;
    PEER_LAYER(0);
    SEAM(PH_PE0);
    for (int rep_ = 0; rep_ < REP_GEMM; ++rep_)
    if (IN(PH_QKV)) {
        {
            pg8::Gemm g{(const pg8::bf16_t*)(ws + WS_XB), (const pg8::bf16_t*)(ws + WS_WQKV), T, 2560, DM}; pg8::StaticOrder S; S.init(T, 2560, G, bx);
            pg8::EpiQK E{(pg8::bf16_t*)(ws + WS_QB), (pg8::bf16_t*)(ws + WS_KB), (const float*)(ws + WS_SSQ_B), (const float*)(ws + WS_ROPE), 0.125f * 1.4426950408889634f};
            pg8::gemm_phase<pg8::EpiQK, pg8::StaticOrder, true, true>(lds, g, S, E);
        }
        if (bx >= G / 2) {
            pg8::Gemm g{(const pg8::bf16_t*)(ws + WS_WQKV) + (size_t)2560 * DM, (const pg8::bf16_t*)(ws + WS_XB), 512, T, DM}; pg8::StaticOrder S; S.init(512, T, G / 2, bx - G / 2);
            pg8::EpiVt E{(pg8::bf16_t*)(ws + WS_VT), (const float*)(ws + WS_SSQ_B)};
            pg8::gemm_phase<pg8::EpiVt, pg8::StaticOrder, true, true>(lds, g, S, E);
        }
    }
    SEAM(PH_QKV);
    for (int rep_ = 0; rep_ < REP_ATT; ++rep_)
    if (IN(PH_ATT)) {
        for (int vb = bx; vb < 256; vb += G) {
            const int bkv = vb >> 3, chunk = vb & 7, b = bkv >> 3, kvh = bkv & 7;
            for (int i = 0; i < 8; ++i) {
                const int qu = (chunk * 8 + i) * 64;
                __syncthreads();
                attn_fill(lds, (const bf16*)(ws + WS_KB), (const bf16*)(ws + WS_VT), b, kvh, qu - 128, tid);
                __syncthreads();
                attn_task(lds, (const bf16*)(ws + WS_QB), (bf16*)(ws + WS_O), a.in[6], b, kvh * 4 + (wave & 3), qu + (wave >> 2) * 32, qu - 128, lane);
            }
        }
    }
    SEAM(PH_ATT);
    if (IN(PH_WO)) {
        pg8::Gemm g{(const pg8::bf16_t*)(ws + WS_O), (const pg8::bf16_t*)(ws + WS_WOA), T, DM, DM}; pg8::StaticOrder S; S.init(T, DM, G, bx);
        pg8::EpiRes E{a.out, a.out, (pg8::bf16_t*)(ws + WS_XB), (float*)(ws + WS_SSQ_C)};
        pg8::gemm_phase<pg8::EpiRes, pg8::StaticOrder, true, true>(lds, g, S, E);
    }
    SEAM(PH_WO);
#ifdef DIAG_A
    { const unsigned long long* st = (const unsigned long long*)(ws + WS_STAMP); oscale = 1.f + sqrtf((float)(st[DIAG_B] - st[DIAG_A]) * 1e-6f); }
#endif
    PEER_LAYER(1);
#undef PEER_LAYER
#undef SEAM
#undef IN
}

#ifndef N_LAUNCHES
#define N_LAUNCHES 1
#endif
extern "C" void kernel_launch(void* const* d_in, const int* in_sizes, int n_in, void* d_out, int out_size, void* d_ws, size_t ws_size, hipStream_t stream) {
    static int grid = 0;
    if (!grid) {
        if (hipFuncSetAttribute((const void*)mega, hipFuncAttributeMaxDynamicSharedMemorySize, LDS_BYTES) != hipSuccess) { fprintf(stderr, "hipFuncSetAttribute failed\n"); }
        int dev = 0, cus = 0, per_cu = 0;
        (void)hipGetDevice(&dev);
        (void)hipDeviceGetAttribute(&cus, hipDeviceAttributeMultiprocessorCount, dev);
        if (hipOccupancyMaxActiveBlocksPerMultiprocessor(&per_cu, (const void*)mega, NWAVES * 64, LDS_BYTES) != hipSuccess) per_cu = 0;
        (void)hipGetLastError();
        grid = cus * per_cu;
        if (grid > 256) grid = 256;
        grid &= ~1;
        if (grid < 2) { fprintf(stderr, "occupancy query gave %d x %d\n", cus, per_cu); grid = -1; }
    }
    if (grid < 0) return;
    if (ws_size < 700 * MiB) { fprintf(stderr, "ws too small: %zu\n", ws_size); return; }
    (void)hipMemsetAsync((char*)d_ws + WS_CTL, 0, CTL_BYTES, stream);
    Args a{};
    for (int i = 0; i < 12; ++i) a.in[i] = (const float*)d_in[i];
    a.out = (float*)d_out; a.ws = (unsigned char*)d_ws;
    if (N_LAUNCHES == 1) {
        a.ph_lo = 0; a.ph_hi = PH_END;
        void* args[] = {&a};
        const hipError_t e = hipLaunchCooperativeKernel((const void*)mega, dim3(grid), dim3(NWAVES * 64), args, LDS_BYTES, stream);
        if (e != hipSuccess) fprintf(stderr, "cooperative launch failed: %s (grid %d)\n", hipGetErrorString(e), grid);
    } else {
        for (int ph = 0; ph < PH_END; ++ph) {
            a.ph_lo = ph; a.ph_hi = ph + 1;
            hipLaunchKernelGGL(mega, dim3(grid), dim3(NWAVES * 64), LDS_BYTES, stream, a);
        }
    }
}
```

```cpp
#include <hip/hip_runtime.h>
#include <hip/hip_cooperative_groups.h>
namespace cg = cooperative_groups;
#include <cstdio>
#include <cstdint>
#include <cmath>

constexpr int DM = 2048, NB = 4, SEQ = 4096, T = NB * SEQ;
constexpr int FG = 8, FW = 256;
constexpr int HD = 64, NQH = 32, NKVH = 8, QKVW = 3072;
constexpr int PH = 8, NKEYS = 128, NEXP = 16384, PTOPK = 16;
constexpr float EPS = 1e-6f;
namespace pg8 {
#define PG8_LAS __attribute__((address_space(3)))
typedef unsigned short bf16_t;
typedef short bf16x8 __attribute__((ext_vector_type(8)));
typedef float f32x4 __attribute__((ext_vector_type(4)));
typedef unsigned u32x4 __attribute__((ext_vector_type(4)));
constexpr int BM = 256, BK = 64, HALF = 128, HTB = HALF * BK * 2  , STAGE_BYTES = 8 * HTB, NXCD = 8, WGM = 8;

__host__ __device__ __forceinline__ int lds_byte(int r, int c) { const int st = (r >> 4) * 2 + (c >> 5), rr = r & 15, cc = c & 31, ob = rr * 64 + cc * 2; return st * 1024 + (ob ^ (((ob >> 9) & 1) << 5)); }
__host__ __device__ __forceinline__ void stage_rc(int b, int& R, int& C) { const int st = b / 1024, sb = b % 1024, swz = sb ^ (((sb >> 9) & 1) << 5); R = (st >> 1) * 16 + swz / 64; C = (st & 1) * 32 + (swz % 64) / 2; }
__host__ __device__ __forceinline__ int perm32(int rho) { const int n = rho >> 4, i = rho & 15; return 8 * (i >> 2) + 4 * n + (i & 3); }

struct Unit { int pm, pn; };
struct Gemm { const bf16_t* A; const bf16_t* Bt; int M, N, K; };

struct StaticOrder {
    int nM, nN, nwg, G, c;
    __host__ __device__ void init(int M, int N, int G_, int c_) { nM = M / BM; nN = N / BM; nwg = nM * nN; G = G_; c = c_; }
    __host__ __device__ bool next(int i, Unit& u) const {
        const long L = (long)i * G + c; if (L >= nwg) return false;
        int wgid = (int)L; { const int q = nwg / NXCD, r = nwg % NXCD, xcd = wgid % NXCD, off = wgid / NXCD; wgid = (xcd < r ? xcd * (q + 1) : r * (q + 1) + (xcd - r) * q) + off; }
        const int nig = WGM * nN, gid = wgid / nig, fm = gid * WGM, gsz = (nM - fm) < WGM ? (nM - fm) : WGM;
        u.pm = fm + ((wgid % nig) % gsz); u.pn = (wgid % nig) / gsz; return true;
    }
    __device__ __forceinline__ void a_ready(const Unit&) const {}
    __device__ __forceinline__ void done(const Unit&) const {}
};

__device__ __forceinline__ unsigned cvt_pk_bf16(float lo, float hi) { unsigned r; asm volatile("v_cvt_pk_bf16_f32 %0, %1, %2" : "=v"(r) : "v"(lo), "v"(hi)); return r; }
typedef float f32x2 __attribute__((ext_vector_type(2)));
__device__ __forceinline__ u32x4 pack8(const f32x4 v0, const f32x4 v1) { u32x4 w; w.x = cvt_pk_bf16(v0[0], v0[1]); w.y = cvt_pk_bf16(v0[2], v0[3]); w.z = cvt_pk_bf16(v1[0], v1[1]); w.w = cvt_pk_bf16(v1[2], v1[3]); return w; }
struct EpiZt {
    static constexpr bool PERM = true, AFTER_DRAIN = false; bf16_t* Zp;
    __device__ __forceinline__ void operator()(const f32x4 (&acc)[2][2][4][2], const Unit& u, int wr, int wc, int fr, int fq) const {
        const int part = u.pm, bgs2 = u.pn;
        bf16_t* base = Zp + ((size_t)(bgs2 * 256 + wr * 64 + fr) * 512 + part * 256 + wc * 32 + 8 * fq);
#pragma unroll
        for (int ai = 0; ai < 2; ++ai)
#pragma unroll
            for (int m = 0; m < 4; ++m)
#pragma unroll
                for (int bj = 0; bj < 2; ++bj) *(u32x4*)(base + (ai * HALF + m * 16) * 512 + bj * HALF) = pack8(acc[ai][bj][m][0], acc[ai][bj][m][1]);
    }
};
struct EpiY {
    static constexpr bool PERM = true, AFTER_DRAIN = false; bf16_t* Y;
    __device__ __forceinline__ void operator()(const f32x4 (&acc)[2][2][4][2], const Unit& u, int wr, int wc, int fr, int fq) const {
        const int bg = u.pn >> 4, k2 = u.pn & 15, b = bg >> 3, g = bg & 7;
        bf16_t* base = Y + ((size_t)(b * 4096 + (wr * 64 + fr) * 16 + k2) * 2048 + g * 256 + wc * 32 + 8 * fq);
#pragma unroll
        for (int ai = 0; ai < 2; ++ai)
#pragma unroll
            for (int m = 0; m < 4; ++m)
#pragma unroll
                for (int bj = 0; bj < 2; ++bj) *(u32x4*)(base + (size_t)(ai * HALF + m * 16) * 16 * 2048 + bj * HALF) = pack8(acc[ai][bj][m][0], acc[ai][bj][m][1]);
    }
};
struct EpiRes {
    static constexpr bool PERM = true, AFTER_DRAIN = false; const float* R; float* out; bf16_t* xb; float* ssq;
    __device__ __forceinline__ void operator()(const f32x4 (&acc)[2][2][4][2], const Unit& u, int wr, int wc, int fr, int fq) const {
        const int row0 = u.pm * BM + wr * 64 + fr; const size_t off0 = (size_t)row0 * 2048 + u.pn * BM + wc * 32 + 8 * fq;
        const float* Rb = R + off0; float* Ob = out + off0; bf16_t* Xb = xb + off0; float* Sb = ssq + row0;
#pragma unroll
        for (int ai = 0; ai < 2; ++ai)
#pragma unroll
            for (int m = 0; m < 4; ++m) { const int ro = (ai * HALF + m * 16) * 2048; float ss = 0.f;
#pragma unroll
                for (int bj = 0; bj < 2; ++bj) {
                    const f32x4 r0 = *(const f32x4*)(Rb + ro + bj * HALF), r1 = *(const f32x4*)(Rb + ro + bj * HALF + 4);
                    const f32x4 o0 = acc[ai][bj][m][0] + r0, o1 = acc[ai][bj][m][1] + r1;
                    *(f32x4*)(Ob + ro + bj * HALF) = o0; *(f32x4*)(Ob + ro + bj * HALF + 4) = o1;
                    *(u32x4*)(Xb + ro + bj * HALF) = pack8(o0, o1);
                    ss += (o0[0] * o0[0] + o0[1] * o0[1]) + (o0[2] * o0[2] + o0[3] * o0[3]) + (o1[0] * o1[0] + o1[1] * o1[1]) + (o1[2] * o1[2] + o1[3] * o1[3]); }
                ss += __shfl_xor(ss, 16); ss += __shfl_xor(ss, 32);
                if (fq == 0) unsafeAtomicAdd(Sb + ai * HALF + m * 16, ss);
                asm volatile("" ::: "memory"); }
    }
};
struct EpiScale {
    static constexpr bool PERM = true, AFTER_DRAIN = false; bf16_t* O; const float* ssq;
    __device__ __forceinline__ void operator()(const f32x4 (&acc)[2][2][4][2], const Unit& u, int wr, int wc, int fr, int fq) const {
        const int row0 = u.pm * BM + wr * 64 + fr;
        bf16_t* base = O + ((size_t)row0 * 2048 + u.pn * BM + wc * 32 + 8 * fq); const float* Sb = ssq + row0;
#pragma unroll
        for (int ai = 0; ai < 2; ++ai)
#pragma unroll
            for (int m = 0; m < 4; ++m) { const float rs = rsqrtf(Sb[ai * HALF + m * 16] * (1.f / 2048.f) + 1e-6f);
#pragma unroll
                for (int bj = 0; bj < 2; ++bj) *(u32x4*)(base + (ai * HALF + m * 16) * 2048 + bj * HALF) = pack8(acc[ai][bj][m][0] * rs, acc[ai][bj][m][1] * rs); }
    }
};
struct EpiQK {
    static constexpr bool PERM = true, AFTER_DRAIN = false; bf16_t* Q; bf16_t* K; const float* ssq; const float* rope; float qscale;
    __device__ __forceinline__ void operator()(const f32x4 (&acc)[2][2][4][2], const Unit& u, int wr, int wc, int fr, int fq) const {
        const int row0 = u.pm * BM + wr * 64 + fr; const bool isq = u.pn < 8;
        const int cl = wc * 32 + 8 * fq;
        bf16_t* base = isq ? (Q + ((size_t)row0 * 2048 + u.pn * BM + cl)) : (K + ((size_t)row0 * 512 + (u.pn - 8) * BM + cl));
        const int ld = isq ? 2048 : 512; const float sc = isq ? qscale : 1.f;
        const float* rp = rope + (size_t)(row0 & 4095) * 64 + (cl & 63);
        const float* Sb = ssq + row0;
#pragma unroll
        for (int ai = 0; ai < 2; ++ai)
#pragma unroll
            for (int m = 0; m < 4; ++m) { const int ro = ai * HALF + m * 16; const float rs = rsqrtf(Sb[ro] * (1.f / 2048.f) + 1e-6f) * sc;
                const f32x4 t0 = *(const f32x4*)(rp + (size_t)ro * 64), t1 = *(const f32x4*)(rp + (size_t)ro * 64 + 4);
#pragma unroll
                for (int bj = 0; bj < 2; ++bj) {
                    const f32x4 a = acc[ai][bj][m][0] * rs, b = acc[ai][bj][m][1] * rs; f32x4 oa, ob;
                    oa[0] = a[0] * t0[0] - a[1] * t0[1]; oa[1] = a[1] * t0[0] + a[0] * t0[1]; oa[2] = a[2] * t0[2] - a[3] * t0[3]; oa[3] = a[3] * t0[2] + a[2] * t0[3];
                    ob[0] = b[0] * t1[0] - b[1] * t1[1]; ob[1] = b[1] * t1[0] + b[0] * t1[1]; ob[2] = b[2] * t1[2] - b[3] * t1[3]; ob[3] = b[3] * t1[2] + b[2] * t1[3];
                    *(u32x4*)(base + (size_t)ro * ld + bj * HALF) = pack8(oa, ob); } }
    }
};
struct EpiVt {
    static constexpr bool PERM = true, AFTER_DRAIN = false; bf16_t* Vt; const float* ssq;
    __device__ __forceinline__ void operator()(const f32x4 (&acc)[2][2][4][2], const Unit& u, int wr, int wc, int fr, int fq) const {
        const int col0 = u.pn * BM + wc * 32 + 8 * fq;
        bf16_t* base = Vt + ((size_t)(u.pm * BM + wr * 64 + fr) * 16384 + col0);
        f32x4 r0[2], r1[2];
#pragma unroll
        for (int bj = 0; bj < 2; ++bj) { const f32x4 s0 = *(const f32x4*)(ssq + col0 + bj * HALF), s1 = *(const f32x4*)(ssq + col0 + bj * HALF + 4);
#pragma unroll
            for (int q = 0; q < 4; ++q) { r0[bj][q] = rsqrtf(s0[q] * (1.f / 2048.f) + 1e-6f); r1[bj][q] = rsqrtf(s1[q] * (1.f / 2048.f) + 1e-6f); } }
#pragma unroll
        for (int ai = 0; ai < 2; ++ai)
#pragma unroll
            for (int m = 0; m < 4; ++m)
#pragma unroll
                for (int bj = 0; bj < 2; ++bj) *(u32x4*)(base + (size_t)(ai * HALF + m * 16) * 16384 + bj * HALF) = pack8(acc[ai][bj][m][0] * r0[bj], acc[ai][bj][m][1] * r1[bj]);
    }
};
template <class Epi, class Sched, bool ALIGN_EPI = false, bool SP2 = false>
__device__ __forceinline__ void gemm_phase(PG8_LAS unsigned char* lds, const Gemm g, const Sched& S, const Epi& E) {
    const int tid = threadIdx.x, wid = __builtin_amdgcn_readfirstlane(tid >> 6), lane = tid & 63, wr = wid >> 2, wc = wid & 3, fr = lane & 15, fq = lane >> 4;
    const int K = g.K, nt = K / BK;
    unsigned voffA[2], voffB[2];
#pragma unroll
    for (int i = 0; i < 2; ++i) { int R, C; stage_rc(tid * 16 + i * 8192, R, C); const int Rb = Epi::PERM ? ((R & ~31) + perm32(R & 31)) : R;
        voffA[i] = (unsigned)(R * K + C) * 2u; voffB[i] = (unsigned)(Rb * K + C) * 2u; }
    const size_t kstep = (size_t)(BK * 2);
    const size_t hstep = (size_t)HALF * K * 2;
    const size_t tstep = 2 * hstep;
    const unsigned ldsw = (unsigned)wid * 1024u;
    const int aoff = lds_byte(wr * 64 + fr, fq * 8), boff = lds_byte(wc * 32 + fr, fq * 8);
#define PG8_SA(b, h) (((b) * 2 + (h)) * HTB)
#define PG8_SB(b, h) ((4 + (b) * 2 + (h)) * HTB)
#define PG8_STAGE(bufoff, gbase, voff) do { _Pragma("unroll") for (int _i = 0; _i < 2; ++_i) \
        __builtin_amdgcn_global_load_lds((const unsigned*)((const char*)(gbase) + (voff)[_i]), (PG8_LAS unsigned*)(lds + (bufoff) + ldsw + _i * 8192), 16, 0, 0); } while (0)
#define PG8_LDA(dst, b, h) do { _Pragma("unroll") for (int m = 0; m < 4; ++m) _Pragma("unroll") for (int k = 0; k < 2; ++k) dst[m][k] = *(const PG8_LAS bf16x8*)(lds + PG8_SA(b, h) + aoff + m * 2048 + k * 1024); } while (0)
#define PG8_LDB(dst, b, h) do { _Pragma("unroll") for (int n = 0; n < 2; ++n) _Pragma("unroll") for (int k = 0; k < 2; ++k) dst[n][k] = *(const PG8_LAS bf16x8*)(lds + PG8_SB(b, h) + boff + n * 2048 + k * 1024); } while (0)
#define PG8_MMA(ai, bj, At, Bt) do { __builtin_amdgcn_s_setprio(1); _Pragma("unroll") for (int m = 0; m < 4; ++m) _Pragma("unroll") for (int n = 0; n < 2; ++n) _Pragma("unroll") for (int k = 0; k < 2; ++k) \
        acc[ai][bj][m][n] = __builtin_amdgcn_mfma_f32_16x16x32_bf16(Bt[n][k], At[m][k], acc[ai][bj][m][n], 0, 0, 0); __builtin_amdgcn_s_setprio(0); } while (0)
#define PG8_WAIT_V(n) asm volatile("s_waitcnt vmcnt(" #n ")" ::: "memory")
#define PG8_WAIT_L(n) asm volatile("s_waitcnt lgkmcnt(" #n ")" ::: "memory")
#define PG8_BAR __builtin_amdgcn_s_barrier()
#define PG8_SCHED __builtin_amdgcn_sched_barrier(0)
    Unit cur, nxt; int ui = 0;
    if (!S.next(0, cur)) return;
    f32x4 acc[2][2][4][2];
#pragma unroll
    for (int a = 0; a < 2; ++a)
#pragma unroll
        for (int b = 0; b < 2; ++b)
#pragma unroll
            for (int m = 0; m < 4; ++m)
#pragma unroll
                for (int n = 0; n < 2; ++n) acc[a][b][m][n] = (f32x4){0.f, 0.f, 0.f, 0.f};
    bf16x8 At[4][2], B0[2][2], B1[2][2];
    const char* cA = (const char*)g.A + (size_t)cur.pm * tstep; const char* cB = (const char*)g.Bt + (size_t)cur.pn * tstep;
    S.a_ready(cur);
    if constexpr (SP2) {
        PG8_STAGE(PG8_SB(0, 0), cB, voffB); PG8_STAGE(PG8_SB(0, 1), cB + hstep, voffB); PG8_STAGE(PG8_SA(0, 0), cA, voffA); PG8_STAGE(PG8_SA(0, 1), cA + hstep, voffA);
        if (wr == 1) PG8_BAR;
        PG8_WAIT_V(2); PG8_BAR;
        PG8_STAGE(PG8_SB(1, 0), cB + kstep, voffB); PG8_STAGE(PG8_SA(1, 0), cA + kstep, voffA); PG8_STAGE(PG8_SB(1, 1), cB + hstep + kstep, voffB);
        PG8_WAIT_V(6); PG8_BAR;
    } else {
        PG8_STAGE(PG8_SB(0, 0), cB, voffB); PG8_STAGE(PG8_SA(0, 0), cA, voffA); PG8_STAGE(PG8_SB(0, 1), cB + hstep, voffB); PG8_STAGE(PG8_SA(0, 1), cA + hstep, voffA);
        if (wr == 1) PG8_BAR;
        PG8_WAIT_V(4); PG8_BAR;
        PG8_STAGE(PG8_SB(1, 0), cB + kstep, voffB); PG8_STAGE(PG8_SA(1, 0), cA + kstep, voffA); PG8_STAGE(PG8_SB(1, 1), cB + hstep + kstep, voffB);
        PG8_WAIT_V(6); PG8_BAR;
    }
    for (;;) {
        const bool has_next = S.next(ui + 1, nxt);
        const char* nA = has_next ? (const char*)g.A + (size_t)nxt.pm * tstep : cA; const char* nB = has_next ? (const char*)g.Bt + (size_t)nxt.pn * tstep : cB;
        for (int t = 0; t < nt; t += 2) {
            const bool last = (t == nt - 2);
            const char* a1 = cA + (size_t)(t + 1) * kstep;
            const char* a2 = last ? nA : cA + (size_t)(t + 2) * kstep; const char* b2 = last ? nB : cB + (size_t)(t + 2) * kstep;
            const char* a3 = a2 + kstep; const char* b3 = b2 + kstep;
            if (last && has_next) S.a_ready(nxt);
            if constexpr (SP2) {
            PG8_LDB(B0, 0, 0); PG8_LDB(B1, 0, 1); PG8_SCHED; PG8_LDA(At, 0, 0); PG8_STAGE(PG8_SA(1, 1), a1 + hstep, voffA);
            PG8_WAIT_V(8); PG8_WAIT_L(0); PG8_BAR; PG8_MMA(0, 0, At, B0); PG8_MMA(0, 1, At, B1); PG8_BAR; PG8_SCHED;
            PG8_LDA(At, 0, 1); PG8_STAGE(PG8_SB(0, 0), b2, voffB); PG8_STAGE(PG8_SB(0, 1), b2 + hstep, voffB); PG8_STAGE(PG8_SA(0, 0), a2, voffA);
            PG8_WAIT_V(8); PG8_WAIT_L(0); PG8_BAR; PG8_MMA(1, 0, At, B0); PG8_MMA(1, 1, At, B1); PG8_BAR; PG8_SCHED;
            PG8_LDB(B0, 1, 0); PG8_LDB(B1, 1, 1); PG8_SCHED; PG8_LDA(At, 1, 0); PG8_STAGE(PG8_SA(0, 1), a2 + hstep, voffA);
            PG8_WAIT_V(8); PG8_WAIT_L(0); PG8_BAR; PG8_MMA(0, 0, At, B0); PG8_MMA(0, 1, At, B1); PG8_BAR; PG8_SCHED;
            PG8_LDA(At, 1, 1); PG8_STAGE(PG8_SB(1, 0), b3, voffB); PG8_STAGE(PG8_SB(1, 1), b3 + hstep, voffB); PG8_STAGE(PG8_SA(1, 0), a3, voffA);
            PG8_WAIT_V(8); PG8_WAIT_L(0); PG8_BAR; PG8_MMA(1, 0, At, B0); PG8_MMA(1, 1, At, B1); PG8_BAR; PG8_SCHED;
            } else {
            PG8_LDB(B0, 0, 0); PG8_SCHED; PG8_LDA(At, 0, 0); PG8_STAGE(PG8_SA(1, 1), a1 + hstep, voffA);
            PG8_WAIT_L(8); PG8_BAR; PG8_WAIT_L(0); PG8_MMA(0, 0, At, B0); PG8_BAR; PG8_SCHED;
            PG8_LDB(B1, 0, 1); PG8_STAGE(PG8_SB(0, 0), b2, voffB);
            PG8_BAR; PG8_WAIT_L(0); PG8_MMA(0, 1, At, B1); PG8_BAR;
            PG8_LDA(At, 0, 1); PG8_STAGE(PG8_SA(0, 0), a2, voffA);
            PG8_BAR; PG8_WAIT_L(0); PG8_MMA(1, 0, At, B0); PG8_BAR; PG8_SCHED;
            PG8_STAGE(PG8_SB(0, 1), b2 + hstep, voffB);
            PG8_WAIT_V(6); PG8_BAR; PG8_MMA(1, 1, At, B1); PG8_BAR;
            PG8_LDB(B0, 1, 0); PG8_SCHED; PG8_LDA(At, 1, 0); PG8_STAGE(PG8_SA(0, 1), a2 + hstep, voffA);
            PG8_WAIT_L(8); PG8_BAR; PG8_WAIT_L(0); PG8_MMA(0, 0, At, B0); PG8_BAR; PG8_SCHED;
            PG8_LDB(B1, 1, 1); PG8_STAGE(PG8_SB(1, 0), b3, voffB);
            PG8_BAR; PG8_WAIT_L(0); PG8_MMA(0, 1, At, B1); PG8_BAR;
            PG8_LDA(At, 1, 1); PG8_STAGE(PG8_SA(1, 0), a3, voffA);
            PG8_BAR; PG8_WAIT_L(0); PG8_MMA(1, 0, At, B0); PG8_BAR; PG8_SCHED;
            PG8_STAGE(PG8_SB(1, 1), b3 + hstep, voffB);
            PG8_WAIT_V(6); PG8_BAR; PG8_MMA(1, 1, At, B1); PG8_BAR;
            }
        }
        if constexpr (ALIGN_EPI) { if (wr == 0) PG8_BAR; }
        if constexpr (!Epi::AFTER_DRAIN) { E(acc, cur, wr, wc, fr, fq); S.done(cur); }
        if (!has_next) break;
#pragma unroll
        for (int a = 0; a < 2; ++a)
#pragma unroll
            for (int b = 0; b < 2; ++b)
#pragma unroll
                for (int m = 0; m < 4; ++m)
#pragma unroll
                    for (int n = 0; n < 2; ++n) acc[a][b][m][n] = (f32x4){0.f, 0.f, 0.f, 0.f};
        cur = nxt; cA = nA; cB = nB; ++ui;
        if constexpr (ALIGN_EPI) { if (wr == 1) PG8_BAR; }
    }
    PG8_WAIT_V(0);
    if constexpr (!ALIGN_EPI) { if (wr == 0) PG8_BAR; }
    PG8_BAR;
    if constexpr (Epi::AFTER_DRAIN) { E.fused(acc, cur, wr, wc, fr, fq, lds, wid, lane); S.done(cur); }
#undef PG8_SA
#undef PG8_SB
#undef PG8_STAGE
#undef PG8_LDA
#undef PG8_LDB
#undef PG8_MMA
#undef PG8_WAIT_V
#undef PG8_WAIT_L
#undef PG8_BAR
#undef PG8_SCHED
}
}
#define GAS __attribute__((address_space(1)))
#define LAS __attribute__((address_space(3)))
typedef unsigned short bf16;
typedef unsigned v4u __attribute__((ext_vector_type(4)));
typedef unsigned v2u __attribute__((ext_vector_type(2)));
typedef float f32x4 __attribute__((ext_vector_type(4)));
constexpr int NWAVES = 8;
constexpr int LDS_BYTES = 147456, LDSCTL_OFF = 131072;
constexpr int CW_BAR = 4096;
constexpr size_t MiB = 1u << 20;
constexpr size_t WS_CTL = 0, CTL_BYTES = 1 * MiB;
constexpr size_t WS_SSQ_A = 256 * 1024, WS_SSQ_B = 320 * 1024, WS_SSQ_C = 384 * 1024, WS_SSQ_D = 448 * 1024;
constexpr size_t WS_STAMP = 128 * 1024;
constexpr size_t WS_WCS = 1 * MiB, WS_ROPE = 2 * MiB, WS_KEYS = 3 * MiB;
constexpr size_t WS_WOF = 8 * MiB, WS_WQKV = 16 * MiB, WS_WOA = 28 * MiB, WS_WQ0 = 36 * MiB, WS_WQ1 = 44 * MiB;
constexpr size_t WS_A2 = 64 * MiB, WS_TW = 65 * MiB;
constexpr size_t WS_U0 = 128 * MiB, WS_V0 = 192 * MiB, WS_U1 = 256 * MiB, WS_V1 = 320 * MiB;
constexpr size_t WS_XG = 384 * MiB, WS_XB = 384 * MiB;
constexpr size_t WS_ZT = 448 * MiB;
constexpr size_t WS_Y = 576 * MiB;
constexpr size_t WS_Q = 448 * MiB;
constexpr size_t WS_EI = 640 * MiB, WS_GW = 648 * MiB;
constexpr size_t WS_PD = 448 * MiB;
constexpr size_t WS_QB = 448 * MiB, WS_KB = 512 * MiB, WS_VT = 528 * MiB, WS_O = 576 * MiB;

__device__ __forceinline__ unsigned f2bf(float f) { unsigned u = __builtin_bit_cast(unsigned, f); return (u + 0x7fffu + ((u >> 16) & 1u)) >> 16; }
__device__ __forceinline__ unsigned pk2(float lo, float hi) { return f2bf(lo) | (f2bf(hi) << 16); }

struct Args { const float* in[12]; float* out; unsigned char* ws; int ph_lo, ph_hi; };

__device__ __forceinline__ int qkv_row(int n) { if (n >= 2560) return n; const int d = n & 63, pc = (d < 32) ? 2 * d : 2 * (d - 32) + 1; return (n & ~63) + pc; }
template <int MODE>
__device__ __forceinline__ void transpose_item(const float* W, int K, int N, const float* gain, bf16* WT, LAS float* scr, int item, int lane) {
    const int nblk = N / 32, kb = item / nblk, nb = item % nblk, k0 = 64 * kb, n0 = 32 * nb;
#pragma unroll 8
    for (int i = 0; i < 32; ++i) { const int kk = 2 * i + (lane >> 5); float v = W[(size_t)(k0 + kk) * N + n0 + (lane & 31)]; if (gain) v *= gain[k0 + kk]; scr[kk * 33 + (lane & 31)] = v; }
    asm volatile("s_waitcnt lgkmcnt(0)" ::: "memory");
    const int c = lane & 7;
#pragma unroll
    for (int j = 0; j < 4; ++j) { const int n = (lane >> 3) + 8 * j; const LAS float* s = scr + (8 * c) * 33 + n;
        v4u o; o.x = pk2(s[0 * 33], s[1 * 33]); o.y = pk2(s[2 * 33], s[3 * 33]); o.z = pk2(s[4 * 33], s[5 * 33]); o.w = pk2(s[6 * 33], s[7 * 33]);
        const int row = (MODE == 1) ? qkv_row(n0 + n) : (n0 + n);
        *(v4u*)(WT + (size_t)row * K + k0 + 8 * c) = o; }
    asm volatile("s_waitcnt lgkmcnt(0)" ::: "memory");
}
__device__ __forceinline__ float wsum(float v) {
#pragma unroll
    for (int o = 1; o < 64; o <<= 1) v += __shfl_xor(v, o);
    return v;
}
__device__ __forceinline__ void cvt_stream(const float* src, bf16* dst, size_t n8, size_t gtid, size_t ngt) {
    for (size_t i = gtid; i < n8; i += ngt) {
        const f32x4 a = *(const f32x4*)(src + i * 8), b = *(const f32x4*)(src + i * 8 + 4);
        v4u o; o.x = pk2(a[0], a[1]); o.y = pk2(a[2], a[3]); o.z = pk2(b[0], b[1]); o.w = pk2(b[2], b[3]);
        *(v4u*)(dst + i * 8) = o;
    }
}
__device__ __forceinline__ void cvt_stream8(const float* src, unsigned char* dst, size_t n16, size_t gtid, size_t ngt, float scale) {
    for (size_t i = gtid; i < n16; i += ngt) {
        v4u o;
#pragma unroll
        for (int q = 0; q < 4; ++q) { f32x4 a = *(const f32x4*)(src + i * 16 + 4 * q) * scale;
#pragma unroll
            for (int e = 0; e < 4; ++e) a[e] = fminf(fmaxf(a[e], -448.f), 448.f);
            int w = 0; w = __builtin_amdgcn_cvt_pk_fp8_f32(a[0], a[1], w, false); w = __builtin_amdgcn_cvt_pk_fp8_f32(a[2], a[3], w, true); o[q] = (unsigned)w; }
        const size_t e = i >> 7, r = i & 127, sl = r >> 3, c8 = r & 7;
        *(v4u*)(dst + ((sl * 16384 + e) * 128 + c8 * 16)) = o;
    }
}
#define XB_TMO      128
#define XB_XCNT(j)  (256  + 64 * (j))
#define XB_XSUB(j)  (1280 + 64 * (j))
#define XB_XGEN(j)  (2304 + 64 * (j))
#define XB_TOP      3328
#define XB_TOPGEN   3392
#define XCD_BAR_WORDS 3456
#define XB_SPIN_CAP (1u << 18)

__device__ __forceinline__ unsigned xb_ld(unsigned* p)              { return __hip_atomic_load(p, __ATOMIC_RELAXED, __HIP_MEMORY_SCOPE_AGENT); }
__device__ __forceinline__ unsigned xb_add(unsigned* p, unsigned v) { return __hip_atomic_fetch_add(p, v, __ATOMIC_RELAXED, __HIP_MEMORY_SCOPE_AGENT); }
__device__ __forceinline__ unsigned xb_xcc_id() { return (unsigned)__builtin_amdgcn_s_getreg((3 << 11) | 20) & 0xFu; }
#define XB_SPIN(cond, bar) do { unsigned _sp = 0; while (cond) { __builtin_amdgcn_s_sleep(1); \
    if ((++_sp & 255u) == 0u) { if (xb_ld(&(bar)[XB_TMO])) break; if (_sp > XB_SPIN_CAP) { atomicAdd(&(bar)[XB_TMO], 1u); break; } } } } while (0)

struct XcdBarrier {
    unsigned* bar; unsigned x;
    volatile LAS unsigned* st;
};

__device__ __forceinline__ XcdBarrier xcd_barrier_post(unsigned* bar, volatile LAS unsigned* st) {
    XcdBarrier b; b.bar = bar; b.x = xb_xcc_id(); b.st = st;
    if (threadIdx.x == 0) (void)xb_add(&bar[XB_XCNT(b.x)], 1u);
    return b;
}
__device__ __forceinline__ void xcd_barrier_complete(unsigned* bar, unsigned x, unsigned& nloc, unsigned& nx) {
    const unsigned G = gridDim.x * gridDim.y * gridDim.z;
    unsigned sum, cnt, mine, sp = 0u;
    for (;;) {
        sum = 0u; cnt = 0u; mine = 0u;
#pragma unroll
        for (unsigned j = 0; j < 16; ++j) { const unsigned c = xb_ld(&bar[XB_XCNT(j)]); sum += c; cnt += (c > 0u) ? 1u : 0u; mine = (j == x) ? c : mine; }
        if (sum == G) break;
        __builtin_amdgcn_s_sleep(1);
        if ((++sp & 255u) == 0u) { if (xb_ld(&bar[XB_TMO])) break; if (sp > XB_SPIN_CAP) { atomicAdd(&bar[XB_TMO], 1u); break; } }
    }
    nloc = mine > 0u ? mine : 1u; nx = cnt > 0u ? cnt : 1u;
}

__device__ __forceinline__ void xcd_barrier(const XcdBarrier& b) {
    asm volatile("s_waitcnt vmcnt(0)" ::: "memory");
    __syncthreads();
    if (threadIdx.x == 0) {
        unsigned* bar = b.bar;
        __builtin_amdgcn_s_waitcnt(0);
        unsigned nloc = b.st[0], nx = b.st[1];
        if (nloc == 0u) { xcd_barrier_complete(bar, b.x, nloc, nx); b.st[0] = nloc; b.st[1] = nx; }
        const unsigned old = xb_add(&bar[XB_XSUB(b.x)], 1u);
        const unsigned gen = old / nloc;
        if (old + 1u == (gen + 1u) * nloc) {
            __builtin_amdgcn_fence(__ATOMIC_RELEASE, "agent");
            asm volatile("s_waitcnt vmcnt(0)" ::: "memory");
            const unsigned og = xb_add(&bar[XB_TOP], 1u);
            const unsigned tg = og / nx;
            if (og + 1u == (tg + 1u) * nx) xb_add(&bar[XB_TOPGEN], 1u);
            else XB_SPIN(xb_ld(&bar[XB_TOPGEN]) == tg, bar);
            __builtin_amdgcn_fence(__ATOMIC_ACQUIRE, "agent");
            xb_add(&bar[XB_XGEN(b.x)], 1u);
            asm volatile("s_waitcnt vmcnt(0)" ::: "memory");
        } else {
            XB_SPIN(xb_ld(&bar[XB_XGEN(b.x)]) == gen, bar);
            __builtin_amdgcn_fence(__ATOMIC_ACQUIRE, "agent");
            asm volatile("s_waitcnt vmcnt(0)" ::: "memory");
        }
    }
    __syncthreads();
}
typedef float f32x16 __attribute__((ext_vector_type(16)));
#ifndef TKB
#define TKB 2
#endif
typedef short s16x8 __attribute__((ext_vector_type(8)));
typedef __bf16 bf16x2_t __attribute__((ext_vector_type(2)));
__device__ __forceinline__ unsigned ordf(float f) { const unsigned u = __float_as_uint(f); return (u & 0x80000000u) ? ~u : (u | 0x80000000u); }
__device__ __forceinline__ float unordf(unsigned u) { return __uint_as_float((u & 0x80000000u) ? (u & 0x7fffffffu) : ~u); }
__device__ __forceinline__ unsigned umax_(unsigned a, unsigned b) { return a > b ? a : b; }
#define DPPU(v, ctrl) ((unsigned)__builtin_amdgcn_update_dpp(0, (int)(v), (ctrl), 0xf, 0xf, true))
#define DPPF(v, ctrl) __int_as_float(__builtin_amdgcn_update_dpp(0, __float_as_int(v), (ctrl), 0xf, 0xf, true))
__device__ __forceinline__ unsigned max32(unsigned v) {
    v = umax_(v, DPPU(v, 0xB1)); v = umax_(v, DPPU(v, 0x4E)); v = umax_(v, DPPU(v, 0x141)); v = umax_(v, DPPU(v, 0x140));
    const auto r = __builtin_amdgcn_permlane16_swap(v, v, false, false);
    return umax_(r[0], r[1]);
}
__device__ __forceinline__ float sum16(float v) {
    v += DPPF(v, 0xB1); v += DPPF(v, 0x4E); v += DPPF(v, 0x141); v += DPPF(v, 0x140); return v;
}
__device__ __forceinline__ unsigned bperm(unsigned v, int srclane) { return (unsigned)__builtin_amdgcn_ds_bpermute(srclane << 2, (int)v); }
template <int NB>
__device__ __forceinline__ void top16_of4(unsigned (&p)[NB][4], unsigned (&W)[NB], int c15) {
#pragma unroll
    for (int b = 0; b < NB; ++b) W[b] = 0u;
    for (int it = 0; it < 16; ++it) {
        unsigned m[NB];
#pragma unroll
        for (int b = 0; b < NB; ++b) m[b] = umax_(umax_(p[b][0], p[b][1]), umax_(p[b][2], p[b][3]));
#pragma unroll
        for (int b = 0; b < NB; ++b) m[b] = umax_(m[b], DPPU(m[b], 0xB1));
#pragma unroll
        for (int b = 0; b < NB; ++b) m[b] = umax_(m[b], DPPU(m[b], 0x4E));
#pragma unroll
        for (int b = 0; b < NB; ++b) m[b] = umax_(m[b], DPPU(m[b], 0x141));
#pragma unroll
        for (int b = 0; b < NB; ++b) m[b] = umax_(m[b], DPPU(m[b], 0x140));
#pragma unroll
        for (int b = 0; b < NB; ++b) { const auto r = __builtin_amdgcn_permlane16_swap(m[b], m[b], false, false); m[b] = umax_(r[0], r[1]); }
#pragma unroll
        for (int b = 0; b < NB; ++b) { W[b] = (c15 == it) ? m[b] : W[b];
#pragma unroll
            for (int i = 0; i < 4; ++i) p[b][i] = (p[b][i] == m[b]) ? 0u : p[b][i]; }
    }
}
template <int NB>
__device__ __forceinline__ void top16_of2(unsigned (&p)[NB][2], unsigned (&W)[NB], int c15) {
#pragma unroll
    for (int b = 0; b < NB; ++b) W[b] = 0u;
    for (int it = 0; it < 16; ++it) {
        unsigned m[NB];
#pragma unroll
        for (int b = 0; b < NB; ++b) m[b] = umax_(p[b][0], p[b][1]);
#pragma unroll
        for (int b = 0; b < NB; ++b) m[b] = umax_(m[b], DPPU(m[b], 0xB1));
#pragma unroll
        for (int b = 0; b < NB; ++b) m[b] = umax_(m[b], DPPU(m[b], 0x4E));
#pragma unroll
        for (int b = 0; b < NB; ++b) m[b] = umax_(m[b], DPPU(m[b], 0x141));
#pragma unroll
        for (int b = 0; b < NB; ++b) m[b] = umax_(m[b], DPPU(m[b], 0x140));
#pragma unroll
        for (int b = 0; b < NB; ++b) { const auto r = __builtin_amdgcn_permlane16_swap(m[b], m[b], false, false); m[b] = umax_(r[0], r[1]); }
#pragma unroll
        for (int b = 0; b < NB; ++b) { W[b] = (c15 == it) ? m[b] : W[b]; p[b][0] = (p[b][0] == m[b]) ? 0u : p[b][0]; p[b][1] = (p[b][1] == m[b]) ? 0u : p[b][1]; }
    }
}
__device__ __forceinline__ void topk_fill(LAS unsigned char* lds, const bf16* keys, int h, int tid) {
#pragma unroll
    for (int i = 0; i < 8; ++i) { const int idx = tid + 512 * i, p = idx >> 11, key = (idx >> 4) & 127, ch = idx & 15;
        const v4u v = *(const v4u*)(keys + (size_t)((h * 2 + p) * 128 + key) * 128 + ch * 8);
        *(LAS v4u*)(lds + p * 32768 + key * 256 + ((ch ^ (key & 15)) << 4)) = v; }
}
__device__ __forceinline__ void topk_unit(const bf16* q, LAS const unsigned char* lds, int* EI, float* GW, int t0, int h, int lane) {
    const int c = lane & 31, hi = lane >> 5, c15 = lane & 15, hbase = lane & 32;
    int f0 = 0, f1 = 0;
    { int cnt = 0;
#pragma unroll
      for (int i = 0; i < 16; ++i)
#pragma unroll
        for (int j = 0; j < 16; ++j) if ((i + 1) * (j + 1) <= 16) { f0 = (cnt == c) ? (i * 16 + j) : f0; f1 = (cnt == c + 32) ? (i * 16 + j) : f1; ++cnt; } }
    unsigned W[2][16];
#pragma unroll
    for (int p = 0; p < 2; ++p) {
        f32x16 acc[4];
#pragma unroll
        for (int kb = 0; kb < 4; ++kb)
#pragma unroll
            for (int r = 0; r < 16; ++r) acc[kb][r] = 0.f;
        const bf16* qp = q + (size_t)(t0 + c) * 2048 + h * 256 + p * 128 + hi * 8;
        LAS const unsigned char* kp = lds + p * 32768 + c * 256;
        asm volatile("" : "+v"(qp));
#pragma unroll 2
        for (int ks = 0; ks < 8; ++ks) {
            const s16x8 a = *(const s16x8*)(qp + ks * 16);
#pragma unroll
            for (int kb = 0; kb < 4; ++kb) { const s16x8 b = *(LAS const s16x8*)(kp + kb * 32 * 256 + (((2 * ks + hi) ^ (c & 15)) << 4)); acc[kb] = __builtin_amdgcn_mfma_f32_32x32x16_bf16(a, b, acc[kb], 0, 0, 0); }
        }
#pragma unroll
        for (int r0 = 0; r0 < 16; r0 += TKB) {
            unsigned pk[TKB][4], Wb[TKB];
#pragma unroll
            for (int b = 0; b < TKB; ++b) { pk[b][0] = (ordf(acc[0][r0 + b]) & ~127u) | (unsigned)(127 - c); pk[b][1] = (ordf(acc[1][r0 + b]) & ~127u) | (unsigned)(95 - c);
                pk[b][2] = (ordf(acc[2][r0 + b]) & ~127u) | (unsigned)(63 - c); pk[b][3] = (ordf(acc[3][r0 + b]) & ~127u) | (unsigned)(31 - c); }
            top16_of4<TKB>(pk, Wb, c15);
#pragma unroll
            for (int b = 0; b < TKB; ++b) W[p][r0 + b] = Wb[b];
        }
    }
#pragma unroll
    for (int r0 = 0; r0 < 16; r0 += TKB) {
        unsigned cp[TKB][2], Wc[TKB];
#pragma unroll
        for (int b = 0; b < TKB; ++b) {
            const unsigned w0 = W[0][r0 + b], w1 = W[1][r0 + b];
            const float a0 = unordf(bperm(w0, hbase + (f0 >> 4)) & ~127u), b0 = unordf(bperm(w1, hbase + (f0 & 15)) & ~127u);
            const float a1 = unordf(bperm(w0, hbase + (f1 >> 4)) & ~127u), b1 = unordf(bperm(w1, hbase + (f1 & 15)) & ~127u);
            cp[b][0] = (ordf(a0 + b0) & ~63u) | (unsigned)(63 - c);
            cp[b][1] = (c + 32 < 50) ? ((ordf(a1 + b1) & ~63u) | (unsigned)(31 - c)) : 0u;
        }
        top16_of2<TKB>(cp, Wc, c15);
#pragma unroll
        for (int b = 0; b < TKB; ++b) {
            const int r = r0 + b; const unsigned w0 = W[0][r], w1 = W[1][r];
            const int slot = 63 - (int)(Wc[b] & 63u);
            const unsigned fa = bperm((unsigned)f0, hbase + (slot & 31)), fb = bperm((unsigned)f1, hbase + (slot & 31));
            const int flat = (slot < 32) ? (int)fa : (int)fb;
            const float val = unordf(Wc[b] & ~63u);
            const float vmax = __uint_as_float(bperm(__float_as_uint(val), hbase));
            const float e = __expf(val - vmax);
            const float g = e / sum16(e);
            const int k1 = 127 - (int)(bperm(w0, hbase + (flat >> 4)) & 127u), k2 = 127 - (int)(bperm(w1, hbase + (flat & 15)) & 127u);
            const int tok = t0 + (r & 3) + 8 * (r >> 2) + 4 * hi;
            if (c < 16) { EI[(size_t)(tok * 8 + h) * 16 + c] = k1 * 128 + k2; GW[(size_t)(tok * 8 + h) * 16 + c] = g; }
        }
    }
}

__device__ __forceinline__ float gelu_tanh_f(float x) {
    const float u = 0.7978845608028654f * (x + 0.044715f * x * x * x);
    const float e = __expf(2.f * u);
    const float th = 1.f - 2.f / (e + 1.f);
    return 0.5f * x * (1.f + th);
}
__device__ __forceinline__ float wave_sum_bfly(float v) {
#pragma unroll
    for (int o = 1; o < 64; o <<= 1) v += __shfl_xor(v, o);
    return v;
}
typedef float f32x2_ __attribute__((ext_vector_type(2)));
#define U_SCALE 1024.f
#define V_SCALE 256.f
template <int NBT>
__device__ __forceinline__ void peer_a_slice(const float* x, const float* gain, const float* ssq, const int* EI, const unsigned char* U8s, float* pd, int s, int t0, int tstride, int ntok, int lane, int lite = 0) {
    const int eg = lane >> 3, c8 = lane & 7;
    const unsigned char* tab = U8s + (size_t)s * (16384 * 128) + c8 * 16;
    f32x4 gs[4];
#pragma unroll
    for (int q = 0; q < 4; ++q) gs[q] = *(const f32x4*)(gain + s * 128 + c8 * 16 + 4 * q);
    const int tlast = t0 + (ntok - 1) * tstride;
#define A_TOK(k_) (((t0 + (k_) * tstride) < tlast) ? (t0 + (k_) * tstride) : tlast)
#define A_XS(XS, SQ, t_) do { const float* xp_ = x + (size_t)(t_) * 2048 + s * 128 + c8 * 16; _Pragma("unroll") for (int q = 0; q < 4; ++q) XS[q] = *(const f32x4*)(xp_ + 4 * q); SQ = ssq[t_]; } while (0)
#define A_ISSUE(U, EV) do { _Pragma("unroll") for (int i = 0; i < 8; ++i) { const int e_ = (int)bperm((unsigned)(EV), (i << 3) + eg); U[i] = *(const v4u*)(tab + (size_t)e_ * 128); } } while (0)
#define A_COMPUTE(U, OUT) do { OUT = 0.f; \
        _Pragma("unroll") for (int i = 0; i < 8; ++i) { f32x2_ d2 = (f32x2_){0.f, 0.f}; \
            if (lite) { d2.x = __int_as_float((int)(U[i][0] ^ U[i][1] ^ U[i][2] ^ U[i][3])); } else { \
            _Pragma("unroll") for (int q = 0; q < 4; ++q) { const int w_ = (int)U[i][q]; \
                d2 = __builtin_elementwise_fma(__builtin_amdgcn_cvt_pk_f32_fp8(w_, false), h2[2 * q], d2); \
                d2 = __builtin_elementwise_fma(__builtin_amdgcn_cvt_pk_f32_fp8(w_, true), h2[2 * q + 1], d2); } } \
            float d = d2.x + d2.y; d += DPPF(d, 0xB1); d += DPPF(d, 0x4E); d += DPPF(d, 0x141); \
            OUT = (c8 == i) ? d : OUT; } } while (0)
    int eL[NBT], eH[NBT], nL[NBT], nH[NBT]; f32x4 xs[2][4]; float sq[2]; v4u UA[8], UB[8];
#pragma unroll
    for (int j = 0; j < NBT; ++j) { const int tj = A_TOK(j); eL[j] = EI[(size_t)tj * 128 + lane]; eH[j] = EI[(size_t)tj * 128 + 64 + lane]; }
    A_XS(xs[0], sq[0], A_TOK(0));
    A_ISSUE(UA, eL[0]);
    for (int kb = 0; kb < ntok; kb += NBT) {
#pragma unroll
        for (int j = 0; j < NBT; ++j) { const int tj = A_TOK(kb + NBT + j); nL[j] = EI[(size_t)tj * 128 + lane]; nH[j] = EI[(size_t)tj * 128 + 64 + lane]; }
#pragma unroll
        for (int j = 0; j < NBT; ++j) {
            const int t = t0 + (kb + j) * tstride;
            A_ISSUE(UB, eH[j]);
            const float rs = rsqrtf(sq[j & 1] * (1.f / 2048.f) + EPS); f32x2_ h2[8];
#pragma unroll
            for (int q = 0; q < 4; ++q) { h2[2 * q] = (f32x2_){xs[j & 1][q][0] * rs * gs[q][0], xs[j & 1][q][1] * rs * gs[q][1]}; h2[2 * q + 1] = (f32x2_){xs[j & 1][q][2] * rs * gs[q][2], xs[j & 1][q][3] * rs * gs[q][3]}; }
            float out_lo, out_hi;
            A_COMPUTE(UA, out_lo);
            A_XS(xs[(j + 1) & 1], sq[(j + 1) & 1], A_TOK(kb + j + 1));
            A_ISSUE(UA, (j + 1 < NBT) ? eL[(j + 1) % NBT] : nL[0]);
            A_COMPUTE(UB, out_hi);
            float* pp = pd + ((size_t)s * T + t) * 128; pp[lane] = out_lo; pp[64 + lane] = out_hi;
        }
#pragma unroll
        for (int j = 0; j < NBT; ++j) { eL[j] = nL[j]; eH[j] = nH[j]; }
    }
#undef A_TOK
#undef A_XS
#undef A_ISSUE
#undef A_COMPUTE
}
__device__ __forceinline__ void peer_a2_token(const float* pd, float* GW, int t, int lane) {
    float d0 = 0.f, d1 = 0.f;
#pragma unroll
    for (int s = 0; s < 16; ++s) { const float* pp = pd + ((size_t)s * T + t) * 128; d0 += pp[lane]; d1 += pp[64 + lane]; }
    float* gp = GW + (size_t)t * 128; const int pl = ((lane & 7) << 3) + (lane >> 3);
    gp[pl] = gp[pl] * gelu_tanh_f(d0 * (1.f / U_SCALE)) * (1.f / V_SCALE);
    gp[64 + pl] = gp[64 + pl] * gelu_tanh_f(d1 * (1.f / U_SCALE)) * (1.f / V_SCALE);
}
template <int NBT>
__device__ __forceinline__ void peer_b_slice(float* xio, const int* EI, const float* W, const unsigned char* V8s, bf16* xb, float* ssq_out, int s, int t0, int tstride, int ntok, int lane) {
    const int eg = lane >> 3, c8 = lane & 7;
    const unsigned char* tab = V8s + (size_t)s * (16384 * 128) + c8 * 16;
    const int tlast = t0 + (ntok - 1) * tstride;
#define B_TOK(k_) (((t0 + (k_) * tstride) < tlast) ? (t0 + (k_) * tstride) : tlast)
#define B_XS(XS, t_) do { const float* xp_ = xio + (size_t)(t_) * 2048 + s * 128 + c8 * 16; _Pragma("unroll") for (int q = 0; q < 4; ++q) XS[q] = *(const f32x4*)(xp_ + 4 * q); } while (0)
#define B_ISSUE(V, WK, EV, WV) do { _Pragma("unroll") for (int i = 0; i < 8; ++i) { const int src_ = (i << 3) + eg; const int e_ = (int)bperm((unsigned)(EV), src_); \
        WK[i] = __uint_as_float(bperm(__float_as_uint(WV), src_)); V[i] = *(const v4u*)(tab + (size_t)e_ * 128); } } while (0)
#define B_COMPUTE(V, WK) do { _Pragma("unroll") for (int i = 0; i < 8; ++i) { const f32x2_ wk2 = (f32x2_){WK[i], WK[i]}; \
            _Pragma("unroll") for (int q = 0; q < 4; ++q) { const int wv_ = (int)V[i][q]; \
                acc[2 * q] = __builtin_elementwise_fma(__builtin_amdgcn_cvt_pk_f32_fp8(wv_, false), wk2, acc[2 * q]); \
                acc[2 * q + 1] = __builtin_elementwise_fma(__builtin_amdgcn_cvt_pk_f32_fp8(wv_, true), wk2, acc[2 * q + 1]); } } } while (0)
    int eL[NBT], eH[NBT], nL[NBT], nH[NBT]; float wL[NBT], wH[NBT], mL[NBT], mH[NBT]; f32x4 xs[2][4]; v4u VA[8], VB[8]; float KA[8], KB[8];
#pragma unroll
    for (int j = 0; j < NBT; ++j) { const int tj = B_TOK(j); eL[j] = EI[(size_t)tj * 128 + lane]; eH[j] = EI[(size_t)tj * 128 + 64 + lane]; wL[j] = W[(size_t)tj * 128 + lane]; wH[j] = W[(size_t)tj * 128 + 64 + lane]; }
    B_XS(xs[0], B_TOK(0));
    B_ISSUE(VA, KA, eL[0], wL[0]);
    for (int kb = 0; kb < ntok; kb += NBT) {
#pragma unroll
        for (int j = 0; j < NBT; ++j) { const int tj = B_TOK(kb + NBT + j); nL[j] = EI[(size_t)tj * 128 + lane]; nH[j] = EI[(size_t)tj * 128 + 64 + lane]; mL[j] = W[(size_t)tj * 128 + lane]; mH[j] = W[(size_t)tj * 128 + 64 + lane]; }
#pragma unroll
        for (int j = 0; j < NBT; ++j) {
            const int t = t0 + (kb + j) * tstride;
            B_ISSUE(VB, KB, eH[j], wH[j]);
            f32x2_ acc[8];
#pragma unroll
            for (int jj = 0; jj < 8; ++jj) acc[jj] = (f32x2_){0.f, 0.f};
            B_COMPUTE(VA, KA);
            B_XS(xs[(j + 1) & 1], B_TOK(kb + j + 1));
            B_ISSUE(VA, KA, (j + 1 < NBT) ? eL[(j + 1) % NBT] : nL[0], (j + 1 < NBT) ? wL[(j + 1) % NBT] : mL[0]);
            B_COMPUTE(VB, KB);
            float ss = 0.f; float nv[8];
#pragma unroll
            for (int jj = 0; jj < 8; ++jj) { float a0 = acc[jj].x, a1 = acc[jj].y;
                a0 += DPPF(a0, 0x128); a1 += DPPF(a1, 0x128);
                { const auto r = __builtin_amdgcn_permlane16_swap(__float_as_uint(a0), __float_as_uint(a1), false, false); a0 = __uint_as_float(r[0]) + __uint_as_float(r[1]); }
                { const auto r = __builtin_amdgcn_permlane32_swap(__float_as_uint(a0), __float_as_uint(a0), false, false); a0 = __uint_as_float(r[0]) + __uint_as_float(r[1]); }
                nv[jj] = a0; }
            if ((lane & 0x28) == 0) {
                const int odd = (lane >> 4) & 1; float* xp = xio + (size_t)t * 2048 + s * 128 + c8 * 16;
#pragma unroll
                for (int q = 0; q < 4; ++q) { const float n0 = (odd ? xs[j & 1][q][1] : xs[j & 1][q][0]) + nv[2 * q], n1 = (odd ? xs[j & 1][q][3] : xs[j & 1][q][2]) + nv[2 * q + 1];
                    ss += n0 * n0 + n1 * n1; xp[4 * q + odd] = n0; xp[4 * q + 2 + odd] = n1;
                    if (xb) { bf16* bp = xb + (size_t)t * 2048 + s * 128 + c8 * 16; bp[4 * q + odd] = (bf16)f2bf(n0); bp[4 * q + 2 + odd] = (bf16)f2bf(n1); } }
            }
            ss += DPPF(ss, 0xB1); ss += DPPF(ss, 0x4E); ss += DPPF(ss, 0x141);
            if (lane == 0 || lane == 16) unsafeAtomicAdd(ssq_out + t, ss);
        }
#pragma unroll
        for (int j = 0; j < NBT; ++j) { eL[j] = nL[j]; eH[j] = nH[j]; wL[j] = mL[j]; wH[j] = mH[j]; }
    }
#undef B_TOK
#undef B_XS
#undef B_ISSUE
#undef B_COMPUTE
}
__device__ __forceinline__ void final_norm_row(float* xio, const float* ssq, const float* fin, int t, int lane, float oscale) {
    const float r2 = rsqrtf(ssq[t] * (1.f / 2048.f) + EPS) * oscale;
    float* xr = xio + (size_t)t * 2048 + 4 * lane;
#pragma unroll
    for (int j = 0; j < 8; ++j) { const f32x4 xv = *(const f32x4*)(xr + 256 * j), g = *(const f32x4*)(fin + 256 * j + 4 * lane); f32x4 o;
        o[0] = xv[0] * r2 * g[0]; o[1] = xv[1] * r2 * g[1]; o[2] = xv[2] * r2 * g[2]; o[3] = xv[3] * r2 * g[3]; *(f32x4*)(xr + 256 * j) = o; }
}
typedef short s16x4 __attribute__((ext_vector_type(4)));
__device__ __forceinline__ unsigned cvt_pk_bf16_(float lo, float hi) { unsigned r; asm volatile("v_cvt_pk_bf16_f32 %0, %1, %2" : "=v"(r) : "v"(lo), "v"(hi)); return r; }
constexpr int ATT_K_OFF = 0, ATT_V_OFF = 40960, ATT_VSTRIDE = 648, ATT_LDS = ATT_V_OFF + 64 * ATT_VSTRIDE;
__device__ __forceinline__ void attn_fill(LAS unsigned char* lds, const bf16* K, const bf16* Vt, int b, int kvh, int kw0, int tid) {
    const size_t tb = (size_t)b * 4096;
#pragma unroll
    for (int i = 0; i < 5; ++i) { const int idx = tid + 512 * i, row = idx >> 3, ch = idx & 7, key = kw0 + row;
        v4u v = (v4u){0u, 0u, 0u, 0u}; if (key >= 0 && key < 4096) v = *(const v4u*)(K + (tb + key) * 512 + kvh * 64 + ch * 8);
        *(LAS v4u*)(lds + ATT_K_OFF + row * 128 + ((ch ^ ((row >> 1) & 7)) << 4)) = v; }
#pragma unroll
    for (int i = 0; i < 10; ++i) { const int idx = tid + 512 * i, d = idx / 80, pc = idx % 80, key = kw0 + pc * 4;
        v2u v = (v2u){0u, 0u}; if (key >= 0 && key < 4096) v = *(const v2u*)(Vt + (size_t)(kvh * 64 + d) * 16384 + tb + key);
        *(LAS v2u*)(lds + ATT_V_OFF + d * ATT_VSTRIDE + pc * 8) = v; }
}
__device__ __forceinline__ void attn_task(LAS const unsigned char* lds, const bf16* Q, bf16* O, const float* sinks, int b, int hq, int q0, int kw0, int lane) {
    const int c = lane & 31, hi = lane >> 5;
    const size_t tb = (size_t)b * 4096;
    s16x8 qf[4];
    { const bf16* qp = Q + (tb + q0 + c) * 2048 + hq * 64 + hi * 8;
#pragma unroll
      for (int ks = 0; ks < 4; ++ks) qf[ks] = *(const s16x8*)(qp + ks * 16); }
    const float sink2 = sinks[hq] * 1.4426950408889634f;
    float m = sink2, l = (hi == 0) ? 1.f : 0.f;
    f32x16 o0, o1;
#pragma unroll
    for (int r = 0; r < 16; ++r) { o0[r] = 0.f; o1[r] = 0.f; }
    const int kt_lo = (q0 < 128) ? ((128 - q0) >> 5) : 0, kt_hi = ((4192 - q0) >> 5) < 8 ? ((4192 - q0) >> 5) : 8;
    for (int kt = kt_lo; kt <= kt_hi; ++kt) {
        const int key0 = q0 - 128 + 32 * kt, row0 = key0 - kw0;
        s16x8 kf[4]; s16x4 va[2][2][2];
        { const int row = row0 + c; LAS const unsigned char* kp = lds + ATT_K_OFF + row * 128; const int sw = (row >> 1) & 7;
#pragma unroll
          for (int ks = 0; ks < 4; ++ks) kf[ks] = *(LAS const s16x8*)(kp + (((2 * ks + hi) ^ sw) << 4)); }
#pragma unroll
        for (int db = 0; db < 2; ++db)
#pragma unroll
            for (int s = 0; s < 2; ++s) { LAS const unsigned char* vp = lds + ATT_V_OFF + (db * 32 + c) * ATT_VSTRIDE + (row0 + 16 * s + 4 * hi) * 2; va[db][s][0] = *(LAS const s16x4*)vp; va[db][s][1] = *(LAS const s16x4*)(vp + 16); }
        f32x16 sa;
#pragma unroll
        for (int r = 0; r < 16; ++r) sa[r] = 0.f;
#pragma unroll
        for (int ks = 0; ks < 4; ++ks) sa = __builtin_amdgcn_mfma_f32_32x32x16_bf16(kf[ks], qf[ks], sa, 0, 0, 0);
        if (kt == 0 || kt == 8) {
            const int dbase = key0 - (q0 + c) + 4 * hi;
#pragma unroll
            for (int r = 0; r < 16; ++r) { const int d = dbase + (r & 3) + 8 * (r >> 2); if (d < -128 || d > 128) sa[r] = -1e30f; }
        }
        float mx = sa[0];
#pragma unroll
        for (int r = 1; r < 16; ++r) mx = fmaxf(mx, sa[r]);
        { const auto rr = __builtin_amdgcn_permlane32_swap(__float_as_uint(mx), __float_as_uint(mx), false, false); mx = fmaxf(__uint_as_float(rr[0]), __uint_as_float(rr[1])); }
        const float mn = fmaxf(m, mx), alpha = __builtin_amdgcn_exp2f(m - mn);
        m = mn;
        float ps = 0.f;
#pragma unroll
        for (int r = 0; r < 16; ++r) { sa[r] = __builtin_amdgcn_exp2f(sa[r] - mn); ps += sa[r]; }
        l = l * alpha + ps;
#pragma unroll
        for (int r = 0; r < 16; ++r) { o0[r] *= alpha; o1[r] *= alpha; }
        s16x8 pf[2];
#pragma unroll
        for (int s = 0; s < 2; ++s) { v4u w; w.x = cvt_pk_bf16_(sa[8 * s + 0], sa[8 * s + 1]); w.y = cvt_pk_bf16_(sa[8 * s + 2], sa[8 * s + 3]); w.z = cvt_pk_bf16_(sa[8 * s + 4], sa[8 * s + 5]); w.w = cvt_pk_bf16_(sa[8 * s + 6], sa[8 * s + 7]);
            pf[s] = __builtin_bit_cast(s16x8, w); }
#pragma unroll
        for (int s = 0; s < 2; ++s) {
            const s16x8 v0 = __builtin_shufflevector(va[0][s][0], va[0][s][1], 0, 1, 2, 3, 4, 5, 6, 7), v1 = __builtin_shufflevector(va[1][s][0], va[1][s][1], 0, 1, 2, 3, 4, 5, 6, 7);
            o0 = __builtin_amdgcn_mfma_f32_32x32x16_bf16(v0, pf[s], o0, 0, 0, 0);
            o1 = __builtin_amdgcn_mfma_f32_32x32x16_bf16(v1, pf[s], o1, 0, 0, 0);
        }
    }
    { const auto rr = __builtin_amdgcn_permlane32_swap(__float_as_uint(l), __float_as_uint(l), false, false); l = __uint_as_float(rr[0]) + __uint_as_float(rr[1]); }
    const float il = 1.f / l;
    bf16* op = O + (tb + q0 + c) * 2048 + hq * 64 + 4 * hi;
#pragma unroll
    for (int g = 0; g < 4; ++g) {
        v2u w0, w1;
        w0.x = cvt_pk_bf16_(o0[4 * g + 0] * il, o0[4 * g + 1] * il); w0.y = cvt_pk_bf16_(o0[4 * g + 2] * il, o0[4 * g + 3] * il);
        w1.x = cvt_pk_bf16_(o1[4 * g + 0] * il, o1[4 * g + 1] * il); w1.y = cvt_pk_bf16_(o1[4 * g + 2] * il, o1[4 * g + 3] * il);
        *(v2u*)(op + 8 * g) = w0; *(v2u*)(op + 32 + 8 * g) = w1;
    }
}
typedef float fx2 __attribute__((ext_vector_type(2)));
__device__ __forceinline__ fx2 bf2_(unsigned w) { fx2 r; r[0] = __uint_as_float(w << 16); r[1] = __uint_as_float(w & 0xffff0000u); return r; }
__device__ __forceinline__ void fft16_item(bf16* Zp, const float* tw, int bg, int l, int s1h, int lane) {
    const int s1 = s1h * 128 + 2 * lane;
    bf16* base = Zp + ((size_t)(bg * 16) * 256 + l) * 512 + s1;
    fx2 zr[16], zi[16];
#pragma unroll
    for (int s2 = 0; s2 < 16; ++s2) { zr[s2] = bf2_(*(const unsigned*)(base + (size_t)s2 * 256 * 512)); zi[s2] = bf2_(*(const unsigned*)(base + (size_t)s2 * 256 * 512 + 256)); }
    fx2 er[16], ei[16];
#pragma unroll
    for (int d = 0; d < 4; ++d) {
        const fx2 ar = zr[d], ai_ = zi[d], br = zr[4 + d], bi = zi[4 + d], cr = zr[8 + d], ci = zi[8 + d], dr = zr[12 + d], di = zi[12 + d];
        const fx2 s0r = ar + cr, s0i = ai_ + ci, s1r = ar - cr, s1i = ai_ - ci, s2r = br + dr, s2i = bi + di, s3r = br - dr, s3i = bi - di;
        er[0 * 4 + d] = s0r + s2r; ei[0 * 4 + d] = s0i + s2i;
        er[1 * 4 + d] = s1r + s3i; ei[1 * 4 + d] = s1i - s3r;
        er[2 * 4 + d] = s0r - s2r; ei[2 * 4 + d] = s0i - s2i;
        er[3 * 4 + d] = s1r - s3i; ei[3 * 4 + d] = s1i + s3r;
    }
#pragma unroll
    for (int a = 1; a < 4; ++a)
#pragma unroll
        for (int d = 1; d < 4; ++d) {
            const float ang = 6.283185307179586f * (float)(a * d) / 16.f; const float c = __builtin_cosf(ang), sn = __builtin_sinf(ang);
            const fx2 xr = er[a * 4 + d], xi = ei[a * 4 + d];
            er[a * 4 + d] = xr * c + xi * sn; ei[a * 4 + d] = xi * c - xr * sn;
        }
#pragma unroll
    for (int a = 0; a < 4; ++a) {
        const fx2 ar = er[a * 4 + 0], ai_ = ei[a * 4 + 0], br = er[a * 4 + 1], bi = ei[a * 4 + 1], cr = er[a * 4 + 2], ci = ei[a * 4 + 2], dr = er[a * 4 + 3], di = ei[a * 4 + 3];
        const fx2 s0r = ar + cr, s0i = ai_ + ci, s1r = ar - cr, s1i = ai_ - ci, s2r = br + dr, s2i = bi + di, s3r = br - dr, s3i = bi - di;
        fx2 Dr[4], Di[4];
        Dr[0] = s0r + s2r; Di[0] = s0i + s2i; Dr[1] = s1r + s3i; Di[1] = s1i - s3r; Dr[2] = s0r - s2r; Di[2] = s0i - s2i; Dr[3] = s1r - s3i; Di[3] = s1i + s3r;
#pragma unroll
        for (int b = 0; b < 4; ++b) {
            const int k2 = a + 4 * b;
            const f32x4 t0 = *(const f32x4*)(tw + (size_t)(k2 * 256 + s1) * 2);
            const fx2 cc = (fx2){t0[0], t0[2]}, ss = (fx2){t0[1], t0[3]};
            const fx2 hr = Dr[b] * cc + Di[b] * ss, hi_ = Di[b] * cc - Dr[b] * ss;
            *(unsigned*)(base + (size_t)k2 * 256 * 512) = pk2(hr[0], hr[1]); *(unsigned*)(base + (size_t)k2 * 256 * 512 + 256) = pk2(hi_[0], hi_[1]);
        }
    }
}
#ifndef REP_PRO
#define REP_PRO 1
#endif
#ifndef REP_GEMM
#define REP_GEMM 1
#endif
#ifndef REP_ATT
#define REP_ATT 1
#endif
#ifndef REP_LITE
#define REP_LITE 0
#endif
#ifndef REP_PA
#define REP_PA 1
#endif
#ifndef REP_TK
#define REP_TK 1
#endif
enum { PH_PRO = 0, PH_G1 = 1, PH_S1 = 2, PH_G2 = 3, PH_G3 = 4, PH_Q0 = 5, PH_TK0 = 6, PH_PA0 = 7, PH_PW0 = 8, PH_PB0 = 9, PH_QKV = 10, PH_ATT = 11, PH_WO = 12, PH_Q1 = 13, PH_TK1 = 14, PH_PA1 = 15, PH_PW1 = 16, PH_PB1 = 17, PH_FIN = 18, PH_END = 19 };
__global__ void __launch_bounds__(NWAVES * 64, 2) mega(Args a) {
    extern __shared__ __attribute__((aligned(16))) unsigned char lds_raw[];
    LAS unsigned char* lds = (LAS unsigned char*)lds_raw;
    cg::grid_group grid = cg::this_grid();
    const int wave = __builtin_amdgcn_readfirstlane(threadIdx.x >> 6);
#define FRESH_IDS() int lane; asm volatile("v_mbcnt_lo_u32_b32 %0, -1, 0\n\tv_mbcnt_hi_u32_b32 %0, -1, %0" : "=v"(lane)); const int tid = wave * 64 + lane; (void)tid
    const int G = gridDim.x, bx = blockIdx.x;
    unsigned char* ws = a.ws;
    const int lo = a.ph_lo, hi = a.ph_hi;
    volatile LAS unsigned* MISC = (volatile LAS unsigned*)(lds + LDSCTL_OFF);
    if (threadIdx.x < 16) MISC[threadIdx.x] = 0u;
    __syncthreads();
    XcdBarrier xbar = xcd_barrier_post((unsigned*)(ws + WS_CTL) + CW_BAR, MISC + 8);
#define IN(k) (lo <= (k) && (k) < hi)
#ifdef DIAG_A
#define STAMP(i) do { if (bx == 0 && threadIdx.x == 0) ((unsigned long long*)(ws + WS_STAMP))[i] = __builtin_amdgcn_s_memrealtime(); } while (0)
#else
#define STAMP(i) do { } while (0)
#endif
#define SEAM(k) do { if (IN(k) && IN((k) + 1)) { if ((k) == PH_PRO) grid.sync(); else xcd_barrier(xbar); } STAMP((k) + 1); } while (0)
    STAMP(0);
    for (int rep_ = 0; rep_ < REP_PRO; ++rep_)
    if (IN(PH_PRO)) { FRESH_IDS();
        const int gw = bx * NWAVES + wave, NGW = G * NWAVES;
        const size_t gtid = (size_t)bx * (NWAVES * 64) + tid, ngt = (size_t)G * NWAVES * 64;
        LAS float* scr = (LAS float*)(lds + wave * 16384);
        {
            constexpr int I_SQ = (DM / 64) * (DM / 32), I_QKV = (DM / 64) * (QKVW / 32);
            constexpr int NITEMS = 4 * I_SQ + I_QKV;
            for (int it = gw; it < NITEMS; it += NGW) {
                int r = it;
                if (r < I_SQ) { transpose_item<0>(a.in[3], DM, DM, nullptr, (bf16*)(ws + WS_WOF), scr, r, lane); continue; } r -= I_SQ;
                if (r < I_SQ) { transpose_item<0>(a.in[5], DM, DM, nullptr, (bf16*)(ws + WS_WOA), scr, r, lane); continue; } r -= I_SQ;
                if (r < I_SQ) { transpose_item<0>(a.in[7], DM, DM, a.in[2], (bf16*)(ws + WS_WQ0), scr, r, lane); continue; } r -= I_SQ;
                if (r < I_SQ) { transpose_item<0>(a.in[7] + (size_t)DM * DM, DM, DM, a.in[2] + DM, (bf16*)(ws + WS_WQ1), scr, r, lane); continue; } r -= I_SQ;
                transpose_item<1>(a.in[4], DM, QKVW, a.in[1] + DM, (bf16*)(ws + WS_WQKV), scr, r, lane);
            }
        }
        for (int row = gw; row < T; row += NGW) {
            const f32x4* xr = (const f32x4*)(a.in[0] + (size_t)row * DM) + lane;
            const f32x4* gr = (const f32x4*)a.in[1] + lane;
            f32x4 v[8]; float s = 0.f;
#pragma unroll
            for (int j = 0; j < 8; ++j) { v[j] = xr[64 * j]; s += (v[j][0] * v[j][0] + v[j][1] * v[j][1]) + (v[j][2] * v[j][2] + v[j][3] * v[j][3]); }
            const float r = rsqrtf(wsum(s) * (1.f / DM) + EPS);
            const int b = row >> 12, sp = row & 4095;
#pragma unroll
            for (int j = 0; j < 8; ++j) { const f32x4 gg = gr[64 * j]; v2u o; o.x = pk2(v[j][0] * r * gg[0], v[j][1] * r * gg[1]); o.y = pk2(v[j][2] * r * gg[2], v[j][3] * r * gg[3]);
                *(v2u*)((bf16*)(ws + WS_XG) + ((size_t)((b * 8 + j) * 4096 + sp) * 256 + 4 * lane)) = o; }
        }
        for (size_t i = gtid; i < (size_t)256 * 512 / 8; i += ngt) {
            const int k1 = (int)(i >> 6), c0 = (int)(i & 63) * 8, part = c0 >> 8, s0 = c0 & 255;
            float v[8];
#pragma unroll
            for (int e = 0; e < 8; ++e) { const int m = (k1 * (s0 + e)) & 255; const float rev = (float)m * (1.f / 256.f); v[e] = (part ? __builtin_amdgcn_sinf(rev) : __builtin_amdgcn_cosf(rev)) * (1.f / 64.f); }
            v4u o; o.x = pk2(v[0], v[1]); o.y = pk2(v[2], v[3]); o.z = pk2(v[4], v[5]); o.w = pk2(v[6], v[7]);
            *(v4u*)((bf16*)(ws + WS_A2) + i * 8) = o;
        }
        for (size_t i = gtid; i < (size_t)16 * 256; i += ngt) {
            const int k2 = (int)(i >> 8), s1 = (int)(i & 255); const float rev = (float)(k2 * s1) * (1.f / 4096.f);
            ((float*)(ws + WS_TW))[2 * i] = __builtin_amdgcn_cosf(rev); ((float*)(ws + WS_TW))[2 * i + 1] = __builtin_amdgcn_sinf(rev);
        }
        for (size_t i = gtid; i < (size_t)512 * 256 / 8; i += ngt) {
            const int n = (int)(i >> 5), c0 = (int)(i & 31) * 8, part = n >> 8, l = n & 255;
            float v[8];
#pragma unroll
            for (int e = 0; e < 8; ++e) { const int m = (l * (c0 + e)) & 255; const float rev = (float)m * (1.f / 256.f); v[e] = (part ? -__builtin_amdgcn_sinf(rev) : __builtin_amdgcn_cosf(rev)) * (1.f / 16.f); }
            v4u o; o.x = pk2(v[0], v[1]); o.y = pk2(v[2], v[3]); o.z = pk2(v[4], v[5]); o.w = pk2(v[6], v[7]);
            *(v4u*)((bf16*)(ws + WS_WCS) + i * 8) = o;
        }
        for (size_t i = gtid; i < (size_t)4096 * 32; i += ngt) {
            const int pos = (int)(i >> 5), fi = (int)(i & 31);
            const double inv = exp2(-(double)fi * (13.287712379549449 / 32.0));
            double sn, cs; sincos((double)pos * inv, &sn, &cs);
            ((float*)(ws + WS_ROPE))[2 * i] = (float)cs; ((float*)(ws + WS_ROPE))[2 * i + 1] = (float)sn;
        }
        cvt_stream8(a.in[9], ws + WS_U0, (size_t)NEXP * DM / 16, gtid, ngt, 1024.f);
        cvt_stream8(a.in[10], ws + WS_V0, (size_t)NEXP * DM / 16, gtid, ngt, 256.f);
        cvt_stream8(a.in[9] + (size_t)NEXP * DM, ws + WS_U1, (size_t)NEXP * DM / 16, gtid, ngt, 1024.f);
        cvt_stream8(a.in[10] + (size_t)NEXP * DM, ws + WS_V1, (size_t)NEXP * DM / 16, gtid, ngt, 256.f);
        cvt_stream(a.in[8], (bf16*)(ws + WS_KEYS), (size_t)2 * PH * 2 * 128 * 128 / 8, gtid, ngt);
    }
    SEAM(PH_PRO);
    for (int rep_ = 0; rep_ < REP_GEMM; ++rep_)
    if (IN(PH_G1)) { FRESH_IDS();
        int Kq = FW; asm volatile("" : "+s"(Kq));
        pg8::Gemm g{(const pg8::bf16_t*)(ws + WS_WCS), (const pg8::bf16_t*)(ws + WS_XG), 512, T * FG, Kq}; pg8::StaticOrder S; S.init(512, T * FG, G, bx);
        pg8::EpiZt E{(pg8::bf16_t*)(ws + WS_ZT)};
        pg8::gemm_phase<pg8::EpiZt, pg8::StaticOrder, true, true>(lds, g, S, E);
    }
    SEAM(PH_G1);
    if (IN(PH_S1)) { FRESH_IDS();
        const int gw = bx * NWAVES + wave, NGW = G * NWAVES;
        for (int it = gw; it < 32 * 256 * 2; it += NGW) fft16_item((bf16*)(ws + WS_ZT), (const float*)(ws + WS_TW), it >> 9, (it >> 1) & 255, it & 1, lane);
    }
    SEAM(PH_S1);
    for (int rep_ = 0; rep_ < REP_GEMM; ++rep_)
    if (IN(PH_G2)) { FRESH_IDS();
        pg8::Gemm g{(const pg8::bf16_t*)(ws + WS_A2), (const pg8::bf16_t*)(ws + WS_ZT), 256, 131072, 512}; pg8::StaticOrder S; S.init(256, 131072, G, bx);
        pg8::EpiY E{(pg8::bf16_t*)(ws + WS_Y)};
        pg8::gemm_phase<pg8::EpiY, pg8::StaticOrder, true, true>(lds, g, S, E);
    }
    SEAM(PH_G2);
    if (IN(PH_G3)) { FRESH_IDS();
        pg8::Gemm g{(const pg8::bf16_t*)(ws + WS_Y), (const pg8::bf16_t*)(ws + WS_WOF), T, DM, DM}; pg8::StaticOrder S; S.init(T, DM, G, bx);
        pg8::EpiRes E{a.in[0], a.out, (pg8::bf16_t*)(ws + WS_XB), (float*)(ws + WS_SSQ_A)};
        pg8::gemm_phase<pg8::EpiRes, pg8::StaticOrder, true, true>(lds, g, S, E);
    }
    SEAM(PH_G3);
#define PEER_LAYER(L) do { \
        const int pq = L ? PH_Q1 : PH_Q0, ptk = L ? PH_TK1 : PH_TK0, ppa = L ? PH_PA1 : PH_PA0, ppw = L ? PH_PW1 : PH_PW0, ppb = L ? PH_PB1 : PH_PB0; \
        for (int rep_ = 0; rep_ < REP_GEMM; ++rep_) \
        if (IN(pq)) { FRESH_IDS(); \
            pg8::Gemm g{(const pg8::bf16_t*)(ws + WS_XB), (const pg8::bf16_t*)(ws + (L ? WS_WQ1 : WS_WQ0)), T, DM, DM}; pg8::StaticOrder S; S.init(T, DM, G, bx); \
            pg8::EpiScale E{(pg8::bf16_t*)(ws + WS_Q), (const float*)(ws + (L ? WS_SSQ_C : WS_SSQ_A))}; \
            pg8::gemm_phase<pg8::EpiScale, pg8::StaticOrder, true, true>(lds, g, S, E); \
        } \
        SEAM(pq); \
        if (IN(ptk)) { FRESH_IDS(); \
            const bf16* keys = (const bf16*)(ws + WS_KEYS) + (size_t)L * PH * 2 * 128 * 128; \
            for (int rep_ = 0; rep_ < REP_TK; ++rep_) \
            for (int u = bx; u < (T / 256) * PH; u += G) { \
                const int h = u & 7, tblk = u >> 3; \
                __syncthreads(); \
                topk_fill(lds, keys, h, tid); \
                __syncthreads(); \
                topk_unit((const bf16*)(ws + WS_Q), lds, (int*)(ws + WS_EI), (float*)(ws + WS_GW), tblk * 256 + wave * 32, h, lane); \
            } \
        } \
        SEAM(ptk); \
        if (IN(ppa)) { FRESH_IDS(); \
            const int xv = bx & 7, nxw = (G >> 3) * NWAVES, wx = (bx >> 3) * NWAVES + wave; \
            for (int rep_ = 0; rep_ < REP_PA; ++rep_) \
            for (int sp = 0; sp < 2; ++sp) \
                peer_a_slice<8>(a.out, a.in[2] + L * DM, (const float*)(ws + (L ? WS_SSQ_C : WS_SSQ_A)), (const int*)(ws + WS_EI), (const unsigned char*)(ws + (L ? WS_U1 : WS_U0)), (float*)(ws + WS_PD), xv + 8 * sp, wx, nxw, T / nxw, lane, (REP_LITE && rep_ + 1 < REP_PA) ? 1 : 0); \
        } \
        SEAM(ppa); \
        if (IN(ppw)) { FRESH_IDS(); \
            const int gw = bx * NWAVES + wave, NGW = G * NWAVES; \
            for (int t = gw; t < T; t += NGW) peer_a2_token((const float*)(ws + WS_PD), (float*)(ws + WS_GW), t, lane); \
        } \
        SEAM(ppw); \
        if (IN(ppb)) { FRESH_IDS(); \
            const int xv = bx & 7, nxw = (G >> 3) * NWAVES, wx = (bx >> 3) * NWAVES + wave; \
            for (int sp = 0; sp < 2; ++sp) \
                peer_b_slice<4>(a.out, (const int*)(ws + WS_EI), (const float*)(ws + WS_GW), (const unsigned char*)(ws + (L ? WS_V1 : WS_V0)), L ? (bf16*)nullptr : (bf16*)(ws + WS_XB), (float*)(ws + (L ? WS_SSQ_D : WS_SSQ_B)), xv + 8 * sp, wx, nxw, T / nxw, lane); \
        } \
    } while (0)
    float oscale = 1.f;
    PEER_LAYER(0);
    SEAM(PH_PB0);
    for (int rep_ = 0; rep_ < REP_GEMM; ++rep_)
    if (IN(PH_QKV)) { FRESH_IDS();
        {
            pg8::Gemm g{(const pg8::bf16_t*)(ws + WS_XB), (const pg8::bf16_t*)(ws + WS_WQKV), T, 2560, DM}; pg8::StaticOrder S; S.init(T, 2560, G, bx);
            pg8::EpiQK E{(pg8::bf16_t*)(ws + WS_QB), (pg8::bf16_t*)(ws + WS_KB), (const float*)(ws + WS_SSQ_B), (const float*)(ws + WS_ROPE), 0.125f * 1.4426950408889634f};
            pg8::gemm_phase<pg8::EpiQK, pg8::StaticOrder, true, true>(lds, g, S, E);
        }
        if (bx >= G / 2) {
            pg8::Gemm g{(const pg8::bf16_t*)(ws + WS_WQKV) + (size_t)2560 * DM, (const pg8::bf16_t*)(ws + WS_XB), 512, T, DM}; pg8::StaticOrder S; S.init(512, T, G / 2, bx - G / 2);
            pg8::EpiVt E{(pg8::bf16_t*)(ws + WS_VT), (const float*)(ws + WS_SSQ_B)};
            pg8::gemm_phase<pg8::EpiVt, pg8::StaticOrder, true, true>(lds, g, S, E);
        }
    }
    SEAM(PH_QKV);
    for (int rep_ = 0; rep_ < REP_ATT; ++rep_)
    if (IN(PH_ATT)) { FRESH_IDS();
        for (int vb = bx; vb < 256; vb += G) {
            const int bkv = vb >> 3, chunk = vb & 7, b = bkv >> 3, kvh = bkv & 7;
            for (int i = 0; i < 8; ++i) {
                const int qu = (chunk * 8 + i) * 64;
                __syncthreads();
                attn_fill(lds, (const bf16*)(ws + WS_KB), (const bf16*)(ws + WS_VT), b, kvh, qu - 128, tid);
                __syncthreads();
                attn_task(lds, (const bf16*)(ws + WS_QB), (bf16*)(ws + WS_O), a.in[6], b, kvh * 4 + (wave & 3), qu + (wave >> 2) * 32, qu - 128, lane);
            }
        }
    }
    SEAM(PH_ATT);
    if (IN(PH_WO)) { FRESH_IDS();
        pg8::Gemm g{(const pg8::bf16_t*)(ws + WS_O), (const pg8::bf16_t*)(ws + WS_WOA), T, DM, DM}; pg8::StaticOrder S; S.init(T, DM, G, bx);
        pg8::EpiRes E{a.out, a.out, (pg8::bf16_t*)(ws + WS_XB), (float*)(ws + WS_SSQ_C)};
        pg8::gemm_phase<pg8::EpiRes, pg8::StaticOrder, true, true>(lds, g, S, E);
    }
    SEAM(PH_WO);
#ifdef DIAG_A
    { const unsigned long long* st = (const unsigned long long*)(ws + WS_STAMP); oscale = 1.f + sqrtf((float)(st[DIAG_B] - st[DIAG_A]) * 1e-6f); }
#endif
    PEER_LAYER(1);
#undef PEER_LAYER
    SEAM(PH_PB1);
    if (IN(PH_FIN)) { FRESH_IDS();
        const int gw = bx * NWAVES + wave, NGW = G * NWAVES;
        for (int t = gw; t < T; t += NGW) final_norm_row(a.out, (const float*)(ws + WS_SSQ_D), a.in[11], t, lane, oscale);
    }
#undef SEAM
#undef IN
}

#ifndef N_LAUNCHES
#define N_LAUNCHES 1
#endif
extern "C" void kernel_launch(void* const* d_in, const int* in_sizes, int n_in, void* d_out, int out_size, void* d_ws, size_t ws_size, hipStream_t stream) {
    static int grid = 0;
    if (!grid) {
        if (hipFuncSetAttribute((const void*)mega, hipFuncAttributeMaxDynamicSharedMemorySize, LDS_BYTES) != hipSuccess) { fprintf(stderr, "hipFuncSetAttribute failed\n"); }
        int dev = 0, cus = 0, per_cu = 0;
        (void)hipGetDevice(&dev);
        (void)hipDeviceGetAttribute(&cus, hipDeviceAttributeMultiprocessorCount, dev);
        if (hipOccupancyMaxActiveBlocksPerMultiprocessor(&per_cu, (const void*)mega, NWAVES * 64, LDS_BYTES) != hipSuccess) per_cu = 0;
        (void)hipGetLastError();
        grid = cus * per_cu;
        if (grid > 256) grid = 256;
        grid &= ~1;
        if (grid < 2) { fprintf(stderr, "occupancy query gave %d x %d\n", cus, per_cu); grid = -1; }
    }
    if (grid < 0) return;
    if (ws_size < 700 * MiB) { fprintf(stderr, "ws too small: %zu\n", ws_size); return; }
    (void)hipMemsetAsync((char*)d_ws + WS_CTL, 0, CTL_BYTES, stream);
    Args a{};
    for (int i = 0; i < 12; ++i) a.in[i] = (const float*)d_in[i];
    a.out = (float*)d_out; a.ws = (unsigned char*)d_ws;
    if (N_LAUNCHES == 1) {
        a.ph_lo = 0; a.ph_hi = PH_END;
        void* args[] = {&a};
        const hipError_t e = hipLaunchCooperativeKernel((const void*)mega, dim3(grid), dim3(NWAVES * 64), args, LDS_BYTES, stream);
        if (e != hipSuccess) fprintf(stderr, "cooperative launch failed: %s (grid %d)\n", hipGetErrorString(e), grid);
    } else {
        for (int ph = 0; ph < PH_END; ++ph) {
            a.ph_lo = ph; a.ph_hi = ph + 1;
            hipLaunchKernelGGL(mega, dim3(grid), dim3(NWAVES * 64), LDS_BYTES, stream, a);
        }
    }
}
```

```cpp
#include <hip/hip_runtime.h>
#include <hip/hip_cooperative_groups.h>
namespace cg = cooperative_groups;
#include <cstdio>
#include <cstdint>
#include <cmath>

constexpr int DM = 2048, NB = 4, SEQ = 4096, T = NB * SEQ;
constexpr int FG = 8, FW = 256;
constexpr int HD = 64, NQH = 32, NKVH = 8, QKVW = 3072;
constexpr int PH = 8, NKEYS = 128, NEXP = 16384, PTOPK = 16;
constexpr float EPS = 1e-6f;
namespace pg8 {
#define PG8_LAS __attribute__((address_space(3)))
typedef unsigned short bf16_t;
typedef short bf16x8 __attribute__((ext_vector_type(8)));
typedef float f32x4 __attribute__((ext_vector_type(4)));
typedef unsigned u32x4 __attribute__((ext_vector_type(4)));
constexpr int BM = 256, BK = 64, HALF = 128, HTB = HALF * BK * 2  , STAGE_BYTES = 8 * HTB, NXCD = 8, WGM = 8;

__host__ __device__ __forceinline__ int lds_byte(int r, int c) { const int st = (r >> 4) * 2 + (c >> 5), rr = r & 15, cc = c & 31, ob = rr * 64 + cc * 2; return st * 1024 + (ob ^ (((ob >> 9) & 1) << 5)); }
__host__ __device__ __forceinline__ void stage_rc(int b, int& R, int& C) { const int st = b / 1024, sb = b % 1024, swz = sb ^ (((sb >> 9) & 1) << 5); R = (st >> 1) * 16 + swz / 64; C = (st & 1) * 32 + (swz % 64) / 2; }
__host__ __device__ __forceinline__ int perm32(int rho) { const int n = rho >> 4, i = rho & 15; return 8 * (i >> 2) + 4 * n + (i & 3); }

struct Unit { int pm, pn; };
struct Gemm { const bf16_t* A; const bf16_t* Bt; int M, N, K; };

struct StaticOrder {
    int nM, nN, nwg, G, c;
    __host__ __device__ void init(int M, int N, int G_, int c_) { nM = M / BM; nN = N / BM; nwg = nM * nN; G = G_; c = c_; }
    __host__ __device__ bool next(int i, Unit& u) const {
        const long L = (long)i * G + c; if (L >= nwg) return false;
        int wgid = (int)L; { const int q = nwg / NXCD, r = nwg % NXCD, xcd = wgid % NXCD, off = wgid / NXCD; wgid = (xcd < r ? xcd * (q + 1) : r * (q + 1) + (xcd - r) * q) + off; }
        const int nig = WGM * nN, gid = wgid / nig, fm = gid * WGM, gsz = (nM - fm) < WGM ? (nM - fm) : WGM;
        u.pm = fm + ((wgid % nig) % gsz); u.pn = (wgid % nig) / gsz; return true;
    }
    __device__ __forceinline__ void a_ready(const Unit&) const {}
    __device__ __forceinline__ void done(const Unit&) const {}
};

__device__ __forceinline__ unsigned cvt_pk_bf16(float lo, float hi) { unsigned r; asm volatile("v_cvt_pk_bf16_f32 %0, %1, %2" : "=v"(r) : "v"(lo), "v"(hi)); return r; }
typedef float f32x2 __attribute__((ext_vector_type(2)));
__device__ __forceinline__ u32x4 pack8(const f32x4 v0, const f32x4 v1) { u32x4 w; w.x = cvt_pk_bf16(v0[0], v0[1]); w.y = cvt_pk_bf16(v0[2], v0[3]); w.z = cvt_pk_bf16(v1[0], v1[1]); w.w = cvt_pk_bf16(v1[2], v1[3]); return w; }
struct EpiZt {
    static constexpr bool PERM = true, AFTER_DRAIN = false; bf16_t* Zp;
    __device__ __forceinline__ void operator()(const f32x4 (&acc)[2][2][4][2], const Unit& u, int wr, int wc, int fr, int fq) const {
        const int part = u.pm, bgs2 = u.pn;
        bf16_t* base = Zp + ((size_t)(bgs2 * 256 + wr * 64 + fr) * 512 + part * 256 + wc * 32 + 8 * fq);
#pragma unroll
        for (int ai = 0; ai < 2; ++ai)
#pragma unroll
            for (int m = 0; m < 4; ++m)
#pragma unroll
                for (int bj = 0; bj < 2; ++bj) *(u32x4*)(base + (ai * HALF + m * 16) * 512 + bj * HALF) = pack8(acc[ai][bj][m][0], acc[ai][bj][m][1]);
    }
};
struct EpiY {
    static constexpr bool PERM = true, AFTER_DRAIN = false; bf16_t* Y;
    __device__ __forceinline__ void operator()(const f32x4 (&acc)[2][2][4][2], const Unit& u, int wr, int wc, int fr, int fq) const {
        const int bg = u.pn >> 4, k2 = u.pn & 15, b = bg >> 3, g = bg & 7;
        bf16_t* base = Y + ((size_t)(b * 4096 + (wr * 64 + fr) * 16 + k2) * 2048 + g * 256 + wc * 32 + 8 * fq);
#pragma unroll
        for (int ai = 0; ai < 2; ++ai)
#pragma unroll
            for (int m = 0; m < 4; ++m)
#pragma unroll
                for (int bj = 0; bj < 2; ++bj) *(u32x4*)(base + (size_t)(ai * HALF + m * 16) * 16 * 2048 + bj * HALF) = pack8(acc[ai][bj][m][0], acc[ai][bj][m][1]);
    }
};
struct EpiRes {
    static constexpr bool PERM = true, AFTER_DRAIN = false; const float* R; float* out; bf16_t* xb; float* ssq;
    __device__ __forceinline__ void operator()(const f32x4 (&acc)[2][2][4][2], const Unit& u, int wr, int wc, int fr, int fq) const {
        const int row0 = u.pm * BM + wr * 64 + fr; const size_t off0 = (size_t)row0 * 2048 + u.pn * BM + wc * 32 + 8 * fq;
        const float* Rb = R + off0; float* Ob = out + off0; bf16_t* Xb = xb + off0; float* Sb = ssq + row0;
#pragma unroll
        for (int ai = 0; ai < 2; ++ai)
#pragma unroll
            for (int m = 0; m < 4; ++m) { const int ro = (ai * HALF + m * 16) * 2048; float ss = 0.f;
#pragma unroll
                for (int bj = 0; bj < 2; ++bj) {
                    const f32x4 r0 = *(const f32x4*)(Rb + ro + bj * HALF), r1 = *(const f32x4*)(Rb + ro + bj * HALF + 4);
                    const f32x4 o0 = acc[ai][bj][m][0] + r0, o1 = acc[ai][bj][m][1] + r1;
                    *(f32x4*)(Ob + ro + bj * HALF) = o0; *(f32x4*)(Ob + ro + bj * HALF + 4) = o1;
                    *(u32x4*)(Xb + ro + bj * HALF) = pack8(o0, o1);
                    ss += (o0[0] * o0[0] + o0[1] * o0[1]) + (o0[2] * o0[2] + o0[3] * o0[3]) + (o1[0] * o1[0] + o1[1] * o1[1]) + (o1[2] * o1[2] + o1[3] * o1[3]); }
                ss += __shfl_xor(ss, 16); ss += __shfl_xor(ss, 32);
                if (fq == 0) unsafeAtomicAdd(Sb + ai * HALF + m * 16, ss);
                asm volatile("" ::: "memory"); }
    }
};
struct EpiScale {
    static constexpr bool PERM = true, AFTER_DRAIN = false; bf16_t* O; const float* ssq;
    __device__ __forceinline__ void operator()(const f32x4 (&acc)[2][2][4][2], const Unit& u, int wr, int wc, int fr, int fq) const {
        const int row0 = u.pm * BM + wr * 64 + fr;
        bf16_t* base = O + ((size_t)row0 * 2048 + u.pn * BM + wc * 32 + 8 * fq); const float* Sb = ssq + row0;
#pragma unroll
        for (int ai = 0; ai < 2; ++ai)
#pragma unroll
            for (int m = 0; m < 4; ++m) { const float rs = rsqrtf(Sb[ai * HALF + m * 16] * (1.f / 2048.f) + 1e-6f);
#pragma unroll
                for (int bj = 0; bj < 2; ++bj) *(u32x4*)(base + (ai * HALF + m * 16) * 2048 + bj * HALF) = pack8(acc[ai][bj][m][0] * rs, acc[ai][bj][m][1] * rs); }
    }
};
struct EpiQK {
    static constexpr bool PERM = true, AFTER_DRAIN = false; bf16_t* Q; bf16_t* K; const float* ssq; const float* rope; float qscale;
    __device__ __forceinline__ void operator()(const f32x4 (&acc)[2][2][4][2], const Unit& u, int wr, int wc, int fr, int fq) const {
        const int row0 = u.pm * BM + wr * 64 + fr; const bool isq = u.pn < 8;
        const int cl = wc * 32 + 8 * fq;
        bf16_t* base = isq ? (Q + ((size_t)row0 * 2048 + u.pn * BM + cl)) : (K + ((size_t)row0 * 512 + (u.pn - 8) * BM + cl));
        const int ld = isq ? 2048 : 512; const float sc = isq ? qscale : 1.f;
        const float* rp = rope + (size_t)(row0 & 4095) * 64 + (cl & 63);
        const float* Sb = ssq + row0;
#pragma unroll
        for (int ai = 0; ai < 2; ++ai)
#pragma unroll
            for (int m = 0; m < 4; ++m) { const int ro = ai * HALF + m * 16; const float rs = rsqrtf(Sb[ro] * (1.f / 2048.f) + 1e-6f) * sc;
                const f32x4 t0 = *(const f32x4*)(rp + (size_t)ro * 64), t1 = *(const f32x4*)(rp + (size_t)ro * 64 + 4);
#pragma unroll
                for (int bj = 0; bj < 2; ++bj) {
                    const f32x4 a = acc[ai][bj][m][0] * rs, b = acc[ai][bj][m][1] * rs; f32x4 oa, ob;
                    oa[0] = a[0] * t0[0] - a[1] * t0[1]; oa[1] = a[1] * t0[0] + a[0] * t0[1]; oa[2] = a[2] * t0[2] - a[3] * t0[3]; oa[3] = a[3] * t0[2] + a[2] * t0[3];
                    ob[0] = b[0] * t1[0] - b[1] * t1[1]; ob[1] = b[1] * t1[0] + b[0] * t1[1]; ob[2] = b[2] * t1[2] - b[3] * t1[3]; ob[3] = b[3] * t1[2] + b[2] * t1[3];
                    *(u32x4*)(base + (size_t)ro * ld + bj * HALF) = pack8(oa, ob); } }
    }
};
struct EpiVt {
    static constexpr bool PERM = true, AFTER_DRAIN = false; bf16_t* Vt; const float* ssq;
    __device__ __forceinline__ void operator()(const f32x4 (&acc)[2][2][4][2], const Unit& u, int wr, int wc, int fr, int fq) const {
        const int col0 = u.pn * BM + wc * 32 + 8 * fq;
        bf16_t* base = Vt + ((size_t)(u.pm * BM + wr * 64 + fr) * 16384 + col0);
        f32x4 r0[2], r1[2];
#pragma unroll
        for (int bj = 0; bj < 2; ++bj) { const f32x4 s0 = *(const f32x4*)(ssq + col0 + bj * HALF), s1 = *(const f32x4*)(ssq + col0 + bj * HALF + 4);
#pragma unroll
            for (int q = 0; q < 4; ++q) { r0[bj][q] = rsqrtf(s0[q] * (1.f / 2048.f) + 1e-6f); r1[bj][q] = rsqrtf(s1[q] * (1.f / 2048.f) + 1e-6f); } }
#pragma unroll
        for (int ai = 0; ai < 2; ++ai)
#pragma unroll
            for (int m = 0; m < 4; ++m)
#pragma unroll
                for (int bj = 0; bj < 2; ++bj) *(u32x4*)(base + (size_t)(ai * HALF + m * 16) * 16384 + bj * HALF) = pack8(acc[ai][bj][m][0] * r0[bj], acc[ai][bj][m][1] * r1[bj]);
    }
};
template <class Epi, class Sched, bool ALIGN_EPI = false, bool SP2 = false>
__device__ __forceinline__ void gemm_phase(PG8_LAS unsigned char* lds, const Gemm g, const Sched& S, const Epi& E) {
    const int tid = threadIdx.x, wid = __builtin_amdgcn_readfirstlane(tid >> 6), lane = tid & 63, wr = wid >> 2, wc = wid & 3, fr = lane & 15, fq = lane >> 4;
    const int K = g.K, nt = K / BK;
    unsigned voffA[2], voffB[2];
#pragma unroll
    for (int i = 0; i < 2; ++i) { int R, C; stage_rc(tid * 16 + i * 8192, R, C); const int Rb = Epi::PERM ? ((R & ~31) + perm32(R & 31)) : R;
        voffA[i] = (unsigned)(R * K + C) * 2u; voffB[i] = (unsigned)(Rb * K + C) * 2u; }
    const size_t kstep = (size_t)(BK * 2);
    const size_t hstep = (size_t)HALF * K * 2;
    const size_t tstep = 2 * hstep;
    const unsigned ldsw = (unsigned)wid * 1024u;
    const int aoff = lds_byte(wr * 64 + fr, fq * 8), boff = lds_byte(wc * 32 + fr, fq * 8);
#define PG8_SA(b, h) (((b) * 2 + (h)) * HTB)
#define PG8_SB(b, h) ((4 + (b) * 2 + (h)) * HTB)
#define PG8_STAGE(bufoff, gbase, voff) do { _Pragma("unroll") for (int _i = 0; _i < 2; ++_i) \
        __builtin_amdgcn_global_load_lds((const unsigned*)((const char*)(gbase) + (voff)[_i]), (PG8_LAS unsigned*)(lds + (bufoff) + ldsw + _i * 8192), 16, 0, 0); } while (0)
#define PG8_LDA(dst, b, h) do { _Pragma("unroll") for (int m = 0; m < 4; ++m) _Pragma("unroll") for (int k = 0; k < 2; ++k) dst[m][k] = *(const PG8_LAS bf16x8*)(lds + PG8_SA(b, h) + aoff + m * 2048 + k * 1024); } while (0)
#define PG8_LDB(dst, b, h) do { _Pragma("unroll") for (int n = 0; n < 2; ++n) _Pragma("unroll") for (int k = 0; k < 2; ++k) dst[n][k] = *(const PG8_LAS bf16x8*)(lds + PG8_SB(b, h) + boff + n * 2048 + k * 1024); } while (0)
#define PG8_MMA(ai, bj, At, Bt) do { __builtin_amdgcn_s_setprio(1); _Pragma("unroll") for (int m = 0; m < 4; ++m) _Pragma("unroll") for (int n = 0; n < 2; ++n) _Pragma("unroll") for (int k = 0; k < 2; ++k) \
        acc[ai][bj][m][n] = __builtin_amdgcn_mfma_f32_16x16x32_bf16(Bt[n][k], At[m][k], acc[ai][bj][m][n], 0, 0, 0); __builtin_amdgcn_s_setprio(0); } while (0)
#define PG8_WAIT_V(n) asm volatile("s_waitcnt vmcnt(" #n ")" ::: "memory")
#define PG8_WAIT_L(n) asm volatile("s_waitcnt lgkmcnt(" #n ")" ::: "memory")
#define PG8_BAR __builtin_amdgcn_s_barrier()
#define PG8_SCHED __builtin_amdgcn_sched_barrier(0)
    Unit cur, nxt; int ui = 0;
    if (!S.next(0, cur)) return;
    f32x4 acc[2][2][4][2];
#pragma unroll
    for (int a = 0; a < 2; ++a)
#pragma unroll
        for (int b = 0; b < 2; ++b)
#pragma unroll
            for (int m = 0; m < 4; ++m)
#pragma unroll
                for (int n = 0; n < 2; ++n) acc[a][b][m][n] = (f32x4){0.f, 0.f, 0.f, 0.f};
    bf16x8 At[4][2], B0[2][2], B1[2][2];
    const char* cA = (const char*)g.A + (size_t)cur.pm * tstep; const char* cB = (const char*)g.Bt + (size_t)cur.pn * tstep;
    S.a_ready(cur);
    if constexpr (SP2) {
        PG8_STAGE(PG8_SB(0, 0), cB, voffB); PG8_STAGE(PG8_SB(0, 1), cB + hstep, voffB); PG8_STAGE(PG8_SA(0, 0), cA, voffA); PG8_STAGE(PG8_SA(0, 1), cA + hstep, voffA);
        if (wr == 1) PG8_BAR;
        PG8_WAIT_V(2); PG8_BAR;
        PG8_STAGE(PG8_SB(1, 0), cB + kstep, voffB); PG8_STAGE(PG8_SA(1, 0), cA + kstep, voffA); PG8_STAGE(PG8_SB(1, 1), cB + hstep + kstep, voffB);
        PG8_WAIT_V(6); PG8_BAR;
    } else {
        PG8_STAGE(PG8_SB(0, 0), cB, voffB); PG8_STAGE(PG8_SA(0, 0), cA, voffA); PG8_STAGE(PG8_SB(0, 1), cB + hstep, voffB); PG8_STAGE(PG8_SA(0, 1), cA + hstep, voffA);
        if (wr == 1) PG8_BAR;
        PG8_WAIT_V(4); PG8_BAR;
        PG8_STAGE(PG8_SB(1, 0), cB + kstep, voffB); PG8_STAGE(PG8_SA(1, 0), cA + kstep, voffA); PG8_STAGE(PG8_SB(1, 1), cB + hstep + kstep, voffB);
        PG8_WAIT_V(6); PG8_BAR;
    }
    for (;;) {
        const bool has_next = S.next(ui + 1, nxt);
        const char* nA = has_next ? (const char*)g.A + (size_t)nxt.pm * tstep : cA; const char* nB = has_next ? (const char*)g.Bt + (size_t)nxt.pn * tstep : cB;
        for (int t = 0; t < nt; t += 2) {
            const bool last = (t == nt - 2);
            const char* a1 = cA + (size_t)(t + 1) * kstep;
            const char* a2 = last ? nA : cA + (size_t)(t + 2) * kstep; const char* b2 = last ? nB : cB + (size_t)(t + 2) * kstep;
            const char* a3 = a2 + kstep; const char* b3 = b2 + kstep;
            if (last && has_next) S.a_ready(nxt);
            if constexpr (SP2) {
            PG8_LDB(B0, 0, 0); PG8_LDB(B1, 0, 1); PG8_SCHED; PG8_LDA(At, 0, 0); PG8_STAGE(PG8_SA(1, 1), a1 + hstep, voffA);
            PG8_WAIT_V(8); PG8_WAIT_L(0); PG8_BAR; PG8_MMA(0, 0, At, B0); PG8_MMA(0, 1, At, B1); PG8_BAR; PG8_SCHED;
            PG8_LDA(At, 0, 1); PG8_STAGE(PG8_SB(0, 0), b2, voffB); PG8_STAGE(PG8_SB(0, 1), b2 + hstep, voffB); PG8_STAGE(PG8_SA(0, 0), a2, voffA);
            PG8_WAIT_V(8); PG8_WAIT_L(0); PG8_BAR; PG8_MMA(1, 0, At, B0); PG8_MMA(1, 1, At, B1); PG8_BAR; PG8_SCHED;
            PG8_LDB(B0, 1, 0); PG8_LDB(B1, 1, 1); PG8_SCHED; PG8_LDA(At, 1, 0); PG8_STAGE(PG8_SA(0, 1), a2 + hstep, voffA);
            PG8_WAIT_V(8); PG8_WAIT_L(0); PG8_BAR; PG8_MMA(0, 0, At, B0); PG8_MMA(0, 1, At, B1); PG8_BAR; PG8_SCHED;
            PG8_LDA(At, 1, 1); PG8_STAGE(PG8_SB(1, 0), b3, voffB); PG8_STAGE(PG8_SB(1, 1), b3 + hstep, voffB); PG8_STAGE(PG8_SA(1, 0), a3, voffA);
            PG8_WAIT_V(8); PG8_WAIT_L(0); PG8_BAR; PG8_MMA(1, 0, At, B0); PG8_MMA(1, 1, At, B1); PG8_BAR; PG8_SCHED;
            } else {
            PG8_LDB(B0, 0, 0); PG8_SCHED; PG8_LDA(At, 0, 0); PG8_STAGE(PG8_SA(1, 1), a1 + hstep, voffA);
            PG8_WAIT_L(8); PG8_BAR; PG8_WAIT_L(0); PG8_MMA(0, 0, At, B0); PG8_BAR; PG8_SCHED;
            PG8_LDB(B1, 0, 1); PG8_STAGE(PG8_SB(0, 0), b2, voffB);
            PG8_BAR; PG8_WAIT_L(0); PG8_MMA(0, 1, At, B1); PG8_BAR;
            PG8_LDA(At, 0, 1); PG8_STAGE(PG8_SA(0, 0), a2, voffA);
            PG8_BAR; PG8_WAIT_L(0); PG8_MMA(1, 0, At, B0); PG8_BAR; PG8_SCHED;
            PG8_STAGE(PG8_SB(0, 1), b2 + hstep, voffB);
            PG8_WAIT_V(6); PG8_BAR; PG8_MMA(1, 1, At, B1); PG8_BAR;
            PG8_LDB(B0, 1, 0); PG8_SCHED; PG8_LDA(At, 1, 0); PG8_STAGE(PG8_SA(0, 1), a2 + hstep, voffA);
            PG8_WAIT_L(8); PG8_BAR; PG8_WAIT_L(0); PG8_MMA(0, 0, At, B0); PG8_BAR; PG8_SCHED;
            PG8_LDB(B1, 1, 1); PG8_STAGE(PG8_SB(1, 0), b3, voffB);
            PG8_BAR; PG8_WAIT_L(0); PG8_MMA(0, 1, At, B1); PG8_BAR;
            PG8_LDA(At, 1, 1); PG8_STAGE(PG8_SA(1, 0), a3, voffA);
            PG8_BAR; PG8_WAIT_L(0); PG8_MMA(1, 0, At, B0); PG8_BAR; PG8_SCHED;
            PG8_STAGE(PG8_SB(1, 1), b3 + hstep, voffB);
            PG8_WAIT_V(6); PG8_BAR; PG8_MMA(1, 1, At, B1); PG8_BAR;
            }
        }
        if constexpr (ALIGN_EPI) { if (wr == 0) PG8_BAR; }
        if constexpr (!Epi::AFTER_DRAIN) { E(acc, cur, wr, wc, fr, fq); S.done(cur); }
        if (!has_next) break;
#pragma unroll
        for (int a = 0; a < 2; ++a)
#pragma unroll
            for (int b = 0; b < 2; ++b)
#pragma unroll
                for (int m = 0; m < 4; ++m)
#pragma unroll
                    for (int n = 0; n < 2; ++n) acc[a][b][m][n] = (f32x4){0.f, 0.f, 0.f, 0.f};
        cur = nxt; cA = nA; cB = nB; ++ui;
        if constexpr (ALIGN_EPI) { if (wr == 1) PG8_BAR; }
    }
    PG8_WAIT_V(0);
    if constexpr (!ALIGN_EPI) { if (wr == 0) PG8_BAR; }
    PG8_BAR;
    if constexpr (Epi::AFTER_DRAIN) { E.fused(acc, cur, wr, wc, fr, fq, lds, wid, lane); S.done(cur); }
#undef PG8_SA
#undef PG8_SB
#undef PG8_STAGE
#undef PG8_LDA
#undef PG8_LDB
#undef PG8_MMA
#undef PG8_WAIT_V
#undef PG8_WAIT_L
#undef PG8_BAR
#undef PG8_SCHED
}
}
#define GAS __attribute__((address_space(1)))
#define LAS __attribute__((address_space(3)))
typedef unsigned short bf16;
typedef unsigned v4u __attribute__((ext_vector_type(4)));
typedef unsigned v2u __attribute__((ext_vector_type(2)));
typedef float f32x4 __attribute__((ext_vector_type(4)));
constexpr int NWAVES = 8;
constexpr int LDS_BYTES = 147456, LDSCTL_OFF = 131072;
constexpr int CW_BAR = 4096;
constexpr size_t MiB = 1u << 20;
constexpr size_t WS_CTL = 0, CTL_BYTES = 1 * MiB;
constexpr size_t WS_SSQ_A = 256 * 1024, WS_SSQ_B = 320 * 1024, WS_SSQ_C = 384 * 1024, WS_SSQ_D = 448 * 1024;
constexpr size_t WS_STAMP = 128 * 1024;
constexpr size_t WS_SU = 512 * 1024, WS_SV = 768 * 1024;
constexpr size_t WS_WCS = 1 * MiB, WS_ROPE = 2 * MiB, WS_KEYS = 3 * MiB;
constexpr size_t WS_WOF = 8 * MiB, WS_WQKV = 16 * MiB, WS_WOA = 28 * MiB, WS_WQ0 = 36 * MiB, WS_WQ1 = 44 * MiB;
constexpr size_t WS_A2 = 64 * MiB, WS_TW = 65 * MiB;
constexpr size_t WS_U0 = 128 * MiB, WS_V0 = 192 * MiB, WS_U1 = 256 * MiB, WS_V1 = 320 * MiB;
constexpr size_t WS_XG = 384 * MiB, WS_XB = 384 * MiB;
constexpr size_t WS_ZT = 448 * MiB;
constexpr size_t WS_Y = 576 * MiB;
constexpr size_t WS_Q = 448 * MiB;
constexpr size_t WS_EI = 640 * MiB, WS_GW = 648 * MiB, WS_W1 = 656 * MiB;
constexpr size_t WS_PD = 448 * MiB;
constexpr size_t WS_QB = 448 * MiB, WS_KB = 512 * MiB, WS_VT = 528 * MiB, WS_O = 576 * MiB;

__device__ __forceinline__ unsigned f2bf(float f) { unsigned u = __builtin_bit_cast(unsigned, f); return (u + 0x7fffu + ((u >> 16) & 1u)) >> 16; }
__device__ __forceinline__ unsigned pk2(float lo, float hi) { return f2bf(lo) | (f2bf(hi) << 16); }

struct Args { const float* in[12]; float* out; unsigned char* ws; int ph_lo, ph_hi; };

__device__ __forceinline__ int qkv_row(int n) { if (n >= 2560) return n; const int d = n & 63, pc = (d < 32) ? 2 * d : 2 * (d - 32) + 1; return (n & ~63) + pc; }
template <int MODE>
__device__ __forceinline__ void transpose_item(const float* W, int K, int N, const float* gain, bf16* WT, LAS float* scr, int item, int lane) {
    const int nblk = N / 32, kb = item / nblk, nb = item % nblk, k0 = 64 * kb, n0 = 32 * nb;
#pragma unroll 8
    for (int i = 0; i < 32; ++i) { const int kk = 2 * i + (lane >> 5); float v = W[(size_t)(k0 + kk) * N + n0 + (lane & 31)]; if (gain) v *= gain[k0 + kk]; scr[kk * 33 + (lane & 31)] = v; }
    asm volatile("s_waitcnt lgkmcnt(0)" ::: "memory");
    const int c = lane & 7;
#pragma unroll
    for (int j = 0; j < 4; ++j) { const int n = (lane >> 3) + 8 * j; const LAS float* s = scr + (8 * c) * 33 + n;
        v4u o; o.x = pk2(s[0 * 33], s[1 * 33]); o.y = pk2(s[2 * 33], s[3 * 33]); o.z = pk2(s[4 * 33], s[5 * 33]); o.w = pk2(s[6 * 33], s[7 * 33]);
        const int row = (MODE == 1) ? qkv_row(n0 + n) : (n0 + n);
        *(v4u*)(WT + (size_t)row * K + k0 + 8 * c) = o; }
    asm volatile("s_waitcnt lgkmcnt(0)" ::: "memory");
}
__device__ __forceinline__ float wsum(float v) {
#pragma unroll
    for (int o = 1; o < 64; o <<= 1) v += __shfl_xor(v, o);
    return v;
}
__device__ __forceinline__ void cvt_stream(const float* src, bf16* dst, size_t n8, size_t gtid, size_t ngt) {
    for (size_t i = gtid; i < n8; i += ngt) {
        const f32x4 a = *(const f32x4*)(src + i * 8), b = *(const f32x4*)(src + i * 8 + 4);
        v4u o; o.x = pk2(a[0], a[1]); o.y = pk2(a[2], a[3]); o.z = pk2(b[0], b[1]); o.w = pk2(b[2], b[3]);
        *(v4u*)(dst + i * 8) = o;
    }
}
__device__ __forceinline__ void cvt_stream8(const float* src, unsigned char* dst, size_t n16, size_t gtid, size_t ngt, float scale) {
    for (size_t i = gtid; i < n16; i += ngt) {
        v4u o;
#pragma unroll
        for (int q = 0; q < 4; ++q) { f32x4 a = *(const f32x4*)(src + i * 16 + 4 * q) * scale;
#pragma unroll
            for (int e = 0; e < 4; ++e) a[e] = fminf(fmaxf(a[e], -448.f), 448.f);
            int w = 0; w = __builtin_amdgcn_cvt_pk_fp8_f32(a[0], a[1], w, false); w = __builtin_amdgcn_cvt_pk_fp8_f32(a[2], a[3], w, true); o[q] = (unsigned)w; }
        const size_t e = i >> 7, r = i & 127, sl = r >> 3, c8 = r & 7;
        *(v4u*)(dst + ((sl * 16384 + e) * 128 + c8 * 16)) = o;
    }
}
#define XB_TMO      128
#define XB_XCNT(j)  (256  + 64 * (j))
#define XB_XSUB(j)  (1280 + 64 * (j))
#define XB_XGEN(j)  (2304 + 64 * (j))
#define XB_TOP      3328
#define XB_TOPGEN   3392
#define XCD_BAR_WORDS 3456
#define XB_SPIN_CAP (1u << 18)

__device__ __forceinline__ unsigned xb_ld(unsigned* p)              { return __hip_atomic_load(p, __ATOMIC_RELAXED, __HIP_MEMORY_SCOPE_AGENT); }
__device__ __forceinline__ unsigned xb_add(unsigned* p, unsigned v) { return __hip_atomic_fetch_add(p, v, __ATOMIC_RELAXED, __HIP_MEMORY_SCOPE_AGENT); }
__device__ __forceinline__ unsigned xb_xcc_id() { return (unsigned)__builtin_amdgcn_s_getreg((3 << 11) | 20) & 0xFu; }
#define XB_SPIN(cond, bar) do { unsigned _sp = 0; while (cond) { __builtin_amdgcn_s_sleep(1); \
    if ((++_sp & 255u) == 0u) { if (xb_ld(&(bar)[XB_TMO])) break; if (_sp > XB_SPIN_CAP) { atomicAdd(&(bar)[XB_TMO], 1u); break; } } } } while (0)

struct XcdBarrier {
    unsigned* bar; unsigned x;
    volatile LAS unsigned* st;
};

__device__ __forceinline__ XcdBarrier xcd_barrier_post(unsigned* bar, volatile LAS unsigned* st) {
    XcdBarrier b; b.bar = bar; b.x = xb_xcc_id(); b.st = st;
    if (threadIdx.x == 0) (void)xb_add(&bar[XB_XCNT(b.x)], 1u);
    return b;
}
__device__ __forceinline__ void xcd_barrier_complete(unsigned* bar, unsigned x, unsigned& nloc, unsigned& nx) {
    const unsigned G = gridDim.x * gridDim.y * gridDim.z;
    unsigned sum, cnt, mine, sp = 0u;
    for (;;) {
        sum = 0u; cnt = 0u; mine = 0u;
#pragma unroll
        for (unsigned j = 0; j < 16; ++j) { const unsigned c = xb_ld(&bar[XB_XCNT(j)]); sum += c; cnt += (c > 0u) ? 1u : 0u; mine = (j == x) ? c : mine; }
        if (sum == G) break;
        __builtin_amdgcn_s_sleep(1);
        if ((++sp & 255u) == 0u) { if (xb_ld(&bar[XB_TMO])) break; if (sp > XB_SPIN_CAP) { atomicAdd(&bar[XB_TMO], 1u); break; } }
    }
    nloc = mine > 0u ? mine : 1u; nx = cnt > 0u ? cnt : 1u;
}

__device__ __forceinline__ void xcd_barrier(const XcdBarrier& b) {
    asm volatile("s_waitcnt vmcnt(0)" ::: "memory");
    __syncthreads();
    if (threadIdx.x == 0) {
        unsigned* bar = b.bar;
        __builtin_amdgcn_s_waitcnt(0);
        unsigned nloc = b.st[0], nx = b.st[1];
        if (nloc == 0u) { xcd_barrier_complete(bar, b.x, nloc, nx); b.st[0] = nloc; b.st[1] = nx; }
        const unsigned old = xb_add(&bar[XB_XSUB(b.x)], 1u);
        const unsigned gen = old / nloc;
        if (old + 1u == (gen + 1u) * nloc) {
            __builtin_amdgcn_fence(__ATOMIC_RELEASE, "agent");
            asm volatile("s_waitcnt vmcnt(0)" ::: "memory");
            const unsigned og = xb_add(&bar[XB_TOP], 1u);
            const unsigned tg = og / nx;
            if (og + 1u == (tg + 1u) * nx) xb_add(&bar[XB_TOPGEN], 1u);
            else XB_SPIN(xb_ld(&bar[XB_TOPGEN]) == tg, bar);
            __builtin_amdgcn_fence(__ATOMIC_ACQUIRE, "agent");
            xb_add(&bar[XB_XGEN(b.x)], 1u);
            asm volatile("s_waitcnt vmcnt(0)" ::: "memory");
        } else {
            XB_SPIN(xb_ld(&bar[XB_XGEN(b.x)]) == gen, bar);
            __builtin_amdgcn_fence(__ATOMIC_ACQUIRE, "agent");
            asm volatile("s_waitcnt vmcnt(0)" ::: "memory");
        }
    }
    __syncthreads();
}
#define U_SCALE 1024.f
#define V_SCALE 256.f
typedef float f32x16 __attribute__((ext_vector_type(16)));
#ifndef TKB
#define TKB 2
#endif
typedef short s16x8 __attribute__((ext_vector_type(8)));
typedef __bf16 bf16x2_t __attribute__((ext_vector_type(2)));
__device__ __forceinline__ unsigned ordf(float f) { const unsigned u = __float_as_uint(f); return (u & 0x80000000u) ? ~u : (u | 0x80000000u); }
__device__ __forceinline__ float unordf(unsigned u) { return __uint_as_float((u & 0x80000000u) ? (u & 0x7fffffffu) : ~u); }
__device__ __forceinline__ unsigned umax_(unsigned a, unsigned b) { return a > b ? a : b; }
#define DPPU(v, ctrl) ((unsigned)__builtin_amdgcn_update_dpp(0, (int)(v), (ctrl), 0xf, 0xf, true))
#define DPPF(v, ctrl) __int_as_float(__builtin_amdgcn_update_dpp(0, __float_as_int(v), (ctrl), 0xf, 0xf, true))
__device__ __forceinline__ unsigned max32(unsigned v) {
    v = umax_(v, DPPU(v, 0xB1)); v = umax_(v, DPPU(v, 0x4E)); v = umax_(v, DPPU(v, 0x141)); v = umax_(v, DPPU(v, 0x140));
    const auto r = __builtin_amdgcn_permlane16_swap(v, v, false, false);
    return umax_(r[0], r[1]);
}
__device__ __forceinline__ float sum16(float v) {
    v += DPPF(v, 0xB1); v += DPPF(v, 0x4E); v += DPPF(v, 0x141); v += DPPF(v, 0x140); return v;
}
__device__ __forceinline__ unsigned bperm(unsigned v, int srclane) { return (unsigned)__builtin_amdgcn_ds_bpermute(srclane << 2, (int)v); }
#define CMPX(a_, b_) do { const unsigned hi_ = umax_(a_, b_), lo_ = (a_ < b_) ? a_ : b_; a_ = hi_; b_ = lo_; } while (0)
template <int NB>
__device__ __forceinline__ void top16_of4(unsigned (&p)[NB][4], unsigned (&W)[NB], int c15) {
#pragma unroll
    for (int b = 0; b < NB; ++b) { W[b] = 0u;
        CMPX(p[b][0], p[b][1]); CMPX(p[b][2], p[b][3]); CMPX(p[b][0], p[b][2]); CMPX(p[b][1], p[b][3]); CMPX(p[b][1], p[b][2]); }
    for (int it = 0; it < 16; ++it) {
        unsigned m[NB];
#pragma unroll
        for (int b = 0; b < NB; ++b) m[b] = umax_(p[b][0], DPPU(p[b][0], 0xB1));
#pragma unroll
        for (int b = 0; b < NB; ++b) m[b] = umax_(m[b], DPPU(m[b], 0x4E));
#pragma unroll
        for (int b = 0; b < NB; ++b) m[b] = umax_(m[b], DPPU(m[b], 0x141));
#pragma unroll
        for (int b = 0; b < NB; ++b) m[b] = umax_(m[b], DPPU(m[b], 0x140));
#pragma unroll
        for (int b = 0; b < NB; ++b) { const auto r = __builtin_amdgcn_permlane16_swap(m[b], m[b], false, false); m[b] = umax_(r[0], r[1]); }
#pragma unroll
        for (int b = 0; b < NB; ++b) { W[b] = (c15 == it) ? m[b] : W[b];
            const bool win = (p[b][0] == m[b]);
            p[b][0] = win ? p[b][1] : p[b][0]; p[b][1] = win ? p[b][2] : p[b][1]; p[b][2] = win ? p[b][3] : p[b][2]; p[b][3] = win ? 0u : p[b][3]; }
    }
}
template <int NB>
__device__ __forceinline__ void top16_of2(unsigned (&p)[NB][2], unsigned (&W)[NB], int c15) {
#pragma unroll
    for (int b = 0; b < NB; ++b) { W[b] = 0u; CMPX(p[b][0], p[b][1]); }
    for (int it = 0; it < 16; ++it) {
        unsigned m[NB];
#pragma unroll
        for (int b = 0; b < NB; ++b) m[b] = umax_(p[b][0], DPPU(p[b][0], 0xB1));
#pragma unroll
        for (int b = 0; b < NB; ++b) m[b] = umax_(m[b], DPPU(m[b], 0x4E));
#pragma unroll
        for (int b = 0; b < NB; ++b) m[b] = umax_(m[b], DPPU(m[b], 0x141));
#pragma unroll
        for (int b = 0; b < NB; ++b) m[b] = umax_(m[b], DPPU(m[b], 0x140));
#pragma unroll
        for (int b = 0; b < NB; ++b) { const auto r = __builtin_amdgcn_permlane16_swap(m[b], m[b], false, false); m[b] = umax_(r[0], r[1]); }
#pragma unroll
        for (int b = 0; b < NB; ++b) { W[b] = (c15 == it) ? m[b] : W[b]; const bool win = (p[b][0] == m[b]); p[b][0] = win ? p[b][1] : p[b][0]; p[b][1] = win ? 0u : p[b][1]; }
    }
}
__device__ __forceinline__ void topk_fill(LAS unsigned char* lds, const bf16* keys, int h, int tid) {
#pragma unroll
    for (int i = 0; i < 8; ++i) { const int idx = tid + 512 * i, p = idx >> 11, key = (idx >> 4) & 127, ch = idx & 15;
        const v4u v = *(const v4u*)(keys + (size_t)((h * 2 + p) * 128 + key) * 128 + ch * 8);
        *(LAS v4u*)(lds + p * 32768 + key * 256 + ((ch ^ (key & 15)) << 4)) = v; }
}
struct CvtCtx { const float* srcU; long dsrc; const float* gain; unsigned char* dstU; long ddst; float* su; long dsc; int gwave, nw; };
__device__ __forceinline__ void cvt_chunk_load(const CvtCtx& cx, int c, int lane, f32x4 (&v)[4]) {
    const int r = c >> 1, hh = c & 1;
    const float* src = cx.srcU + ((r < 16384) ? 0L : cx.dsrc) + (size_t)(r & 16383) * 2048 + hh * 1024 + 4 * lane;
#pragma unroll
    for (int j = 0; j < 4; ++j) v[j] = *(const f32x4*)(src + 256 * j);
}
__device__ __forceinline__ void cvt_chunk_store(const CvtCtx& cx, int c, int lane, f32x4 (&v)[4]) {
    const int r = c >> 1, hh = c & 1; const bool isu = r < 16384; const int e = r & 16383;
    float mx = 0.f;
#pragma unroll
    for (int j = 0; j < 4; ++j) { if (isu) v[j] = v[j] * *(const f32x4*)(cx.gain + hh * 1024 + 256 * j + 4 * lane);
        mx = fmaxf(mx, fmaxf(fmaxf(fabsf(v[j][0]), fabsf(v[j][1])), fmaxf(fabsf(v[j][2]), fabsf(v[j][3])))); }
    mx = fmaxf(mx, DPPF(mx, 0xB1)); mx = fmaxf(mx, DPPF(mx, 0x4E)); mx = fmaxf(mx, DPPF(mx, 0x141)); mx = fmaxf(mx, DPPF(mx, 0x140));
    { const auto rr = __builtin_amdgcn_permlane16_swap(__float_as_uint(mx), __float_as_uint(mx), false, false); mx = fmaxf(__uint_as_float(rr[0]), __uint_as_float(rr[1])); }
    { const auto rr = __builtin_amdgcn_permlane32_swap(__float_as_uint(mx), __float_as_uint(mx), false, false); mx = fmaxf(__uint_as_float(rr[0]), __uint_as_float(rr[1])); }
    const float sc = fmaxf(mx, 1e-30f) * (1.f / 6.f), inv = 1.f / sc;
    if (lane == 0) (cx.su + (isu ? 0L : cx.dsc))[e * 2 + hh] = sc;
    unsigned char* dst = cx.dstU + (isu ? 0L : cx.ddst) + ((size_t)(hh * 4) * 16384 + e) * 128 + 2 * lane;
#pragma unroll
    for (int j = 0; j < 4; ++j) { unsigned w = 0u;
        w = __builtin_amdgcn_cvt_scalef32_pk_fp4_f32(w, v[j][0] * inv, v[j][1] * inv, 1.0f, 0); w = __builtin_amdgcn_cvt_scalef32_pk_fp4_f32(w, v[j][2] * inv, v[j][3] * inv, 1.0f, 1);
        *(unsigned short*)(dst + (size_t)j * (16384 * 128)) = (unsigned short)w; }
}
__device__ __forceinline__ void topk_unit(const bf16* q, LAS const unsigned char* lds, int* EI, float* GW, int t0, int h, int lane, const CvtCtx& cx, int slot0) {
    const int c = lane & 31, hi = lane >> 5, c15 = lane & 15, hbase = lane & 32;
    int f0 = 0, f1 = 0;
    { int cnt = 0;
#pragma unroll
      for (int i = 0; i < 16; ++i)
#pragma unroll
        for (int j = 0; j < 16; ++j) if ((i + 1) * (j + 1) <= 16) { f0 = (cnt == c) ? (i * 16 + j) : f0; f1 = (cnt == c + 32) ? (i * 16 + j) : f1; ++cnt; } }
    unsigned W[2][16];
#pragma unroll
    for (int p = 0; p < 2; ++p) {
        f32x16 acc[4];
#pragma unroll
        for (int kb = 0; kb < 4; ++kb)
#pragma unroll
            for (int r = 0; r < 16; ++r) acc[kb][r] = 0.f;
        const bf16* qp = q + (size_t)(t0 + c) * 2048 + h * 256 + p * 128 + hi * 8;
        LAS const unsigned char* kp = lds + p * 32768 + c * 256;
        asm volatile("" : "+v"(qp));
#pragma unroll 2
        for (int ks = 0; ks < 8; ++ks) {
            const s16x8 a = *(const s16x8*)(qp + ks * 16);
#pragma unroll
            for (int kb = 0; kb < 4; ++kb) { const s16x8 b = *(LAS const s16x8*)(kp + kb * 32 * 256 + (((2 * ks + hi) ^ (c & 15)) << 4)); acc[kb] = __builtin_amdgcn_mfma_f32_32x32x16_bf16(a, b, acc[kb], 0, 0, 0); }
        }
#pragma unroll
        for (int r0 = 0; r0 < 16; r0 += TKB) {
            unsigned pk[TKB][4], Wb[TKB];
#pragma unroll
            for (int b = 0; b < TKB; ++b) { pk[b][0] = (ordf(acc[0][r0 + b]) & ~127u) | (unsigned)(127 - c); pk[b][1] = (ordf(acc[1][r0 + b]) & ~127u) | (unsigned)(95 - c);
                pk[b][2] = (ordf(acc[2][r0 + b]) & ~127u) | (unsigned)(63 - c); pk[b][3] = (ordf(acc[3][r0 + b]) & ~127u) | (unsigned)(31 - c); }
            const int cc = (slot0 + p * (16 / TKB) + r0 / TKB) * cx.nw + cx.gwave;
            f32x4 cr[4];
            asm volatile("" ::: "memory");
            if (cc < 65536) cvt_chunk_load(cx, cc, lane, cr);
            top16_of4<TKB>(pk, Wb, c15);
            if (cc < 65536) cvt_chunk_store(cx, cc, lane, cr);
            asm volatile("" ::: "memory");
#pragma unroll
            for (int b = 0; b < TKB; ++b) W[p][r0 + b] = Wb[b];
        }
    }
#pragma unroll
    for (int r0 = 0; r0 < 16; r0 += TKB) {
        unsigned cp[TKB][2], Wc[TKB];
#pragma unroll
        for (int b = 0; b < TKB; ++b) {
            const unsigned w0 = W[0][r0 + b], w1 = W[1][r0 + b];
            const float a0 = unordf(bperm(w0, hbase + (f0 >> 4)) & ~127u), b0 = unordf(bperm(w1, hbase + (f0 & 15)) & ~127u);
            const float a1 = unordf(bperm(w0, hbase + (f1 >> 4)) & ~127u), b1 = unordf(bperm(w1, hbase + (f1 & 15)) & ~127u);
            cp[b][0] = (ordf(a0 + b0) & ~63u) | (unsigned)(63 - c);
            cp[b][1] = (c + 32 < 50) ? ((ordf(a1 + b1) & ~63u) | (unsigned)(31 - c)) : 0u;
        }
        top16_of2<TKB>(cp, Wc, c15);
#pragma unroll
        for (int b = 0; b < TKB; ++b) {
            const int r = r0 + b; const unsigned w0 = W[0][r], w1 = W[1][r];
            const int slot = 63 - (int)(Wc[b] & 63u);
            const unsigned fa = bperm((unsigned)f0, hbase + (slot & 31)), fb = bperm((unsigned)f1, hbase + (slot & 31));
            const int flat = (slot < 32) ? (int)fa : (int)fb;
            const float val = unordf(Wc[b] & ~63u);
            const float vmax = __uint_as_float(bperm(__float_as_uint(val), hbase));
            const float e = __expf(val - vmax);
            const float g = e / sum16(e);
            const int k1 = 127 - (int)(bperm(w0, hbase + (flat >> 4)) & 127u), k2 = 127 - (int)(bperm(w1, hbase + (flat & 15)) & 127u);
            const int tok = t0 + (r & 3) + 8 * (r >> 2) + 4 * hi;
            if (c < 16) { EI[(size_t)(tok * 8 + h) * 16 + c] = k1 * 128 + k2; GW[(size_t)(tok * 8 + h) * 16 + c] = g; }
        }
    }
}

__device__ __forceinline__ float gelu_tanh_f(float x) {
    const float u = 0.7978845608028654f * (x + 0.044715f * x * x * x);
    const float e = __expf(2.f * u);
    const float th = 1.f - 2.f / (e + 1.f);
    return 0.5f * x * (1.f + th);
}
__device__ __forceinline__ float wave_sum_bfly(float v) {
#pragma unroll
    for (int o = 1; o < 64; o <<= 1) v += __shfl_xor(v, o);
    return v;
}
typedef float f32x2_ __attribute__((ext_vector_type(2)));
#define FP4_DEC(w_, sel_) __builtin_amdgcn_cvt_scalef32_pk_f32_fp4((unsigned)(w_), 1.0f, (sel_))
template <int NBT>
__device__ __forceinline__ void peer_a_slice(const bf16* xb, const int* EI, const unsigned char* U4s, float* pd, int s, int t0, int tstride, int ntok, int lane) {
    const int eg = lane >> 3, c8 = lane & 7;
    const unsigned char* tab = U4s + (size_t)s * (16384 * 128) + c8 * 16;
    const int tlast = t0 + (ntok - 1) * tstride;
#define A_TOK(k_) (((t0 + (k_) * tstride) < tlast) ? (t0 + (k_) * tstride) : tlast)
#define A_XS(XS, t_) do { const bf16* xp_ = xb + (size_t)(t_) * 2048 + s * 256 + c8 * 32; _Pragma("unroll") for (int q = 0; q < 4; ++q) XS[q] = *(const v4u*)(xp_ + 8 * q); } while (0)
#define A_ISSUE(U, EV) do { _Pragma("unroll") for (int i = 0; i < 8; ++i) { const int e_ = (int)bperm((unsigned)(EV), (i << 3) + eg); U[i] = *(const v4u*)(tab + (size_t)e_ * 128); } } while (0)
#define A_COMPUTE(U, OUT) do { OUT = 0.f; \
        _Pragma("unroll") for (int i = 0; i < 8; ++i) { f32x2_ d2 = (f32x2_){0.f, 0.f}; \
            _Pragma("unroll") for (int q = 0; q < 4; ++q) { const unsigned w_ = U[i][q]; \
                d2 = __builtin_elementwise_fma(FP4_DEC(w_, 0), h2[4 * q + 0], d2); d2 = __builtin_elementwise_fma(FP4_DEC(w_, 1), h2[4 * q + 1], d2); \
                d2 = __builtin_elementwise_fma(FP4_DEC(w_, 2), h2[4 * q + 2], d2); d2 = __builtin_elementwise_fma(FP4_DEC(w_, 3), h2[4 * q + 3], d2); } \
            float d = d2.x + d2.y; d += DPPF(d, 0xB1); d += DPPF(d, 0x4E); d += DPPF(d, 0x141); \
            OUT = (c8 == i) ? d : OUT; } } while (0)
    int eL[NBT], eH[NBT], nL[NBT], nH[NBT]; v4u xs[2][4]; v4u UA[8], UB[8];
#pragma unroll
    for (int j = 0; j < NBT; ++j) { const int tj = A_TOK(j); eL[j] = EI[(size_t)tj * 128 + lane]; eH[j] = EI[(size_t)tj * 128 + 64 + lane]; }
    A_XS(xs[0], A_TOK(0));
    A_ISSUE(UA, eL[0]);
    for (int kb = 0; kb < ntok; kb += NBT) {
#pragma unroll
        for (int j = 0; j < NBT; ++j) { const int tj = A_TOK(kb + NBT + j); nL[j] = EI[(size_t)tj * 128 + lane]; nH[j] = EI[(size_t)tj * 128 + 64 + lane]; }
#pragma unroll
        for (int j = 0; j < NBT; ++j) {
            const int t = t0 + (kb + j) * tstride;
            A_ISSUE(UB, eH[j]);
            f32x2_ h2[16];
#pragma unroll
            for (int q = 0; q < 4; ++q)
#pragma unroll
                for (int c = 0; c < 4; ++c) { const unsigned w = xs[j & 1][q][c]; h2[4 * q + c] = (f32x2_){__uint_as_float(w << 16), __uint_as_float(w & 0xffff0000u)}; }
            float out_lo, out_hi;
            A_COMPUTE(UA, out_lo);
            A_XS(xs[(j + 1) & 1], A_TOK(kb + j + 1));
            A_ISSUE(UA, (j + 1 < NBT) ? eL[(j + 1) % NBT] : nL[0]);
            A_COMPUTE(UB, out_hi);
            float* pp = pd + ((size_t)s * T + t) * 128; pp[lane] = out_lo; pp[64 + lane] = out_hi;
        }
#pragma unroll
        for (int j = 0; j < NBT; ++j) { eL[j] = nL[j]; eH[j] = nH[j]; }
    }
#undef A_TOK
#undef A_XS
#undef A_ISSUE
#undef A_COMPUTE
}
__device__ __forceinline__ void peer_a2_token(const float* pd, const float* ssq, const int* EI, const float* su, const float* sv, float* GW, float* W1, int t, int lane) {
    float a0 = 0.f, a1 = 0.f, b0 = 0.f, b1 = 0.f;
#pragma unroll
    for (int s = 0; s < 4; ++s) { const float* pp = pd + ((size_t)s * T + t) * 128; a0 += pp[lane]; a1 += pp[64 + lane]; }
#pragma unroll
    for (int s = 4; s < 8; ++s) { const float* pp = pd + ((size_t)s * T + t) * 128; b0 += pp[lane]; b1 += pp[64 + lane]; }
    const float rs = rsqrtf(ssq[t] * (1.f / 2048.f) + EPS);
    float* gp = GW + (size_t)t * 128; float* hp = W1 + (size_t)t * 128; const int pl = ((lane & 7) << 3) + (lane >> 3);
    const int e0 = EI[(size_t)t * 128 + pl], e1 = EI[(size_t)t * 128 + 64 + pl];
    const float g0 = gp[pl] * gelu_tanh_f(rs * (a0 * su[2 * e0] + b0 * su[2 * e0 + 1])), g1 = gp[64 + pl] * gelu_tanh_f(rs * (a1 * su[2 * e1] + b1 * su[2 * e1 + 1]));
    gp[pl] = g0 * sv[2 * e0]; hp[pl] = g0 * sv[2 * e0 + 1];
    gp[64 + pl] = g1 * sv[2 * e1]; hp[64 + pl] = g1 * sv[2 * e1 + 1];
}
template <int NBT>
__device__ __forceinline__ void peer_b_slice(float* xio, const int* EI, const float* W, const unsigned char* V4s, bf16* xb, float* ssq_out, int s, int t0, int tstride, int ntok, int lane) {
    const int eg = lane >> 3, c8 = lane & 7;
    const unsigned char* tab = V4s + (size_t)s * (16384 * 128) + c8 * 16;
    const int tlast = t0 + (ntok - 1) * tstride;
    const int eoff = s * 256 + c8 * 32 + 4 * eg;
#define B_TOK(k_) (((t0 + (k_) * tstride) < tlast) ? (t0 + (k_) * tstride) : tlast)
#define B_ISSUE(V, WK, EV, WV) do { _Pragma("unroll") for (int i = 0; i < 8; ++i) { const int src_ = (i << 3) + eg; const int e_ = (int)bperm((unsigned)(EV), src_); \
        WK[i] = __uint_as_float(bperm(__float_as_uint(WV), src_)); V[i] = *(const v4u*)(tab + (size_t)e_ * 128); } } while (0)
#define B_COMPUTE(V, WK) do { _Pragma("unroll") for (int i = 0; i < 8; ++i) { const f32x2_ wk2 = (f32x2_){WK[i], WK[i]}; \
            _Pragma("unroll") for (int q = 0; q < 4; ++q) { const unsigned wv_ = V[i][q]; \
                acc[4 * q + 0] = __builtin_elementwise_fma(FP4_DEC(wv_, 0), wk2, acc[4 * q + 0]); acc[4 * q + 1] = __builtin_elementwise_fma(FP4_DEC(wv_, 1), wk2, acc[4 * q + 1]); \
                acc[4 * q + 2] = __builtin_elementwise_fma(FP4_DEC(wv_, 2), wk2, acc[4 * q + 2]); acc[4 * q + 3] = __builtin_elementwise_fma(FP4_DEC(wv_, 3), wk2, acc[4 * q + 3]); } } } while (0)
    int eL[NBT], eH[NBT], nL[NBT], nH[NBT]; float wL[NBT], wH[NBT], mL[NBT], mH[NBT]; f32x4 xv; v4u VA[8], VB[8]; float KA[8], KB[8];
#pragma unroll
    for (int j = 0; j < NBT; ++j) { const int tj = B_TOK(j); eL[j] = EI[(size_t)tj * 128 + lane]; eH[j] = EI[(size_t)tj * 128 + 64 + lane]; wL[j] = W[(size_t)tj * 128 + lane]; wH[j] = W[(size_t)tj * 128 + 64 + lane]; }
    B_ISSUE(VA, KA, eL[0], wL[0]);
    for (int kb = 0; kb < ntok; kb += NBT) {
#pragma unroll
        for (int j = 0; j < NBT; ++j) { const int tj = B_TOK(kb + NBT + j); nL[j] = EI[(size_t)tj * 128 + lane]; nH[j] = EI[(size_t)tj * 128 + 64 + lane]; mL[j] = W[(size_t)tj * 128 + lane]; mH[j] = W[(size_t)tj * 128 + 64 + lane]; }
#pragma unroll
        for (int j = 0; j < NBT; ++j) {
            const int t = t0 + (kb + j) * tstride;
            xv = *(const f32x4*)(xio + (size_t)t * 2048 + eoff);
            B_ISSUE(VB, KB, eH[j], wH[j]);
            f32x2_ acc[16];
#pragma unroll
            for (int jj = 0; jj < 16; ++jj) acc[jj] = (f32x2_){0.f, 0.f};
            B_COMPUTE(VA, KA);
            B_ISSUE(VA, KA, (j + 1 < NBT) ? eL[(j + 1) % NBT] : nL[0], (j + 1 < NBT) ? wL[(j + 1) % NBT] : mL[0]);
            B_COMPUTE(VB, KB);
            float r16[16], r8[8], r4[4];
#pragma unroll
            for (int i = 0; i < 16; ++i) { const float lo_ = (i & 1) ? acc[i >> 1].y : acc[i >> 1].x, hi_ = (i & 1) ? acc[8 + (i >> 1)].y : acc[8 + (i >> 1)].x;
                const auto r = __builtin_amdgcn_permlane32_swap(__float_as_uint(lo_), __float_as_uint(hi_), false, false); r16[i] = __uint_as_float(r[0]) + __uint_as_float(r[1]); }
#pragma unroll
            for (int i = 0; i < 8; ++i) { const auto r = __builtin_amdgcn_permlane16_swap(__float_as_uint(r16[i]), __float_as_uint(r16[8 + i]), false, false); r8[i] = __uint_as_float(r[0]) + __uint_as_float(r[1]); }
            const bool b3 = (lane & 8) != 0;
#pragma unroll
            for (int i = 0; i < 4; ++i) { const float keep = b3 ? r8[4 + i] : r8[i], give = b3 ? r8[i] : r8[4 + i]; r4[i] = keep + DPPF(give, 0x128); }
            f32x4 o; o[0] = xv[0] + r4[0]; o[1] = xv[1] + r4[1]; o[2] = xv[2] + r4[2]; o[3] = xv[3] + r4[3];
            *(f32x4*)(xio + (size_t)t * 2048 + eoff) = o;
            if (xb) { v2u bb; bb.x = pk2(o[0], o[1]); bb.y = pk2(o[2], o[3]); *(v2u*)(xb + (size_t)t * 2048 + eoff) = bb; }
            float ss = (o[0] * o[0] + o[1] * o[1]) + (o[2] * o[2] + o[3] * o[3]);
            ss += DPPF(ss, 0xB1); ss += DPPF(ss, 0x4E); ss += DPPF(ss, 0x141); ss += DPPF(ss, 0x140);
            { const auto r = __builtin_amdgcn_permlane16_swap(__float_as_uint(ss), __float_as_uint(ss), false, false); ss = __uint_as_float(r[0]) + __uint_as_float(r[1]); }
            { const auto r = __builtin_amdgcn_permlane32_swap(__float_as_uint(ss), __float_as_uint(ss), false, false); ss = __uint_as_float(r[0]) + __uint_as_float(r[1]); }
            if (lane == 0) unsafeAtomicAdd(ssq_out + t, ss);
        }
#pragma unroll
        for (int j = 0; j < NBT; ++j) { eL[j] = nL[j]; eH[j] = nH[j]; wL[j] = mL[j]; wH[j] = mH[j]; }
    }
#undef B_TOK
#undef B_ISSUE
#undef B_COMPUTE
}
__device__ __forceinline__ void final_norm_row(float* xio, const float* ssq, const float* fin, int t, int lane, float oscale) {
    const float r2 = rsqrtf(ssq[t] * (1.f / 2048.f) + EPS) * oscale;
    float* xr = xio + (size_t)t * 2048 + 4 * lane;
#pragma unroll
    for (int j = 0; j < 8; ++j) { const f32x4 xv = *(const f32x4*)(xr + 256 * j), g = *(const f32x4*)(fin + 256 * j + 4 * lane); f32x4 o;
        o[0] = xv[0] * r2 * g[0]; o[1] = xv[1] * r2 * g[1]; o[2] = xv[2] * r2 * g[2]; o[3] = xv[3] * r2 * g[3]; *(f32x4*)(xr + 256 * j) = o; }
}
typedef short s16x4 __attribute__((ext_vector_type(4)));
__device__ __forceinline__ unsigned cvt_pk_bf16_(float lo, float hi) { unsigned r; asm volatile("v_cvt_pk_bf16_f32 %0, %1, %2" : "=v"(r) : "v"(lo), "v"(hi)); return r; }
constexpr int ATT_K_OFF = 0, ATT_V_OFF = 40960, ATT_VSTRIDE = 648, ATT_LDS = ATT_V_OFF + 64 * ATT_VSTRIDE;
__device__ __forceinline__ void attn_fill(LAS unsigned char* lds, const bf16* K, const bf16* Vt, int b, int kvh, int kw0, int tid) {
    const size_t tb = (size_t)b * 4096;
#pragma unroll
    for (int i = 0; i < 5; ++i) { const int idx = tid + 512 * i, row = idx >> 3, ch = idx & 7, key = kw0 + row;
        v4u v = (v4u){0u, 0u, 0u, 0u}; if (key >= 0 && key < 4096) v = *(const v4u*)(K + (tb + key) * 512 + kvh * 64 + ch * 8);
        *(LAS v4u*)(lds + ATT_K_OFF + row * 128 + ((ch ^ ((row >> 1) & 7)) << 4)) = v; }
#pragma unroll
    for (int i = 0; i < 10; ++i) { const int idx = tid + 512 * i, d = idx / 80, pc = idx % 80, key = kw0 + pc * 4;
        v2u v = (v2u){0u, 0u}; if (key >= 0 && key < 4096) v = *(const v2u*)(Vt + (size_t)(kvh * 64 + d) * 16384 + tb + key);
        *(LAS v2u*)(lds + ATT_V_OFF + d * ATT_VSTRIDE + pc * 8) = v; }
}
__device__ __forceinline__ void attn_task(LAS const unsigned char* lds, const bf16* Q, bf16* O, const float* sinks, int b, int hq, int q0, int kw0, int lane) {
    const int c = lane & 31, hi = lane >> 5;
    const size_t tb = (size_t)b * 4096;
    s16x8 qf[4];
    { const bf16* qp = Q + (tb + q0 + c) * 2048 + hq * 64 + hi * 8;
#pragma unroll
      for (int ks = 0; ks < 4; ++ks) qf[ks] = *(const s16x8*)(qp + ks * 16); }
    const float sink2 = sinks[hq] * 1.4426950408889634f;
    float m = sink2, l = (hi == 0) ? 1.f : 0.f;
    f32x16 o0, o1;
#pragma unroll
    for (int r = 0; r < 16; ++r) { o0[r] = 0.f; o1[r] = 0.f; }
    const int kt_lo = (q0 < 128) ? ((128 - q0) >> 5) : 0, kt_hi = ((4192 - q0) >> 5) < 8 ? ((4192 - q0) >> 5) : 8;
    for (int kt = kt_lo; kt <= kt_hi; ++kt) {
        const int key0 = q0 - 128 + 32 * kt, row0 = key0 - kw0;
        s16x8 kf[4]; s16x4 va[2][2][2];
        { const int row = row0 + c; LAS const unsigned char* kp = lds + ATT_K_OFF + row * 128; const int sw = (row >> 1) & 7;
#pragma unroll
          for (int ks = 0; ks < 4; ++ks) kf[ks] = *(LAS const s16x8*)(kp + (((2 * ks + hi) ^ sw) << 4)); }
#pragma unroll
        for (int db = 0; db < 2; ++db)
#pragma unroll
            for (int s = 0; s < 2; ++s) { LAS const unsigned char* vp = lds + ATT_V_OFF + (db * 32 + c) * ATT_VSTRIDE + (row0 + 16 * s + 4 * hi) * 2; va[db][s][0] = *(LAS const s16x4*)vp; va[db][s][1] = *(LAS const s16x4*)(vp + 16); }
        f32x16 sa;
#pragma unroll
        for (int r = 0; r < 16; ++r) sa[r] = 0.f;
#pragma unroll
        for (int ks = 0; ks < 4; ++ks) sa = __builtin_amdgcn_mfma_f32_32x32x16_bf16(kf[ks], qf[ks], sa, 0, 0, 0);
        if (kt == 0 || kt == 8) {
            const int dbase = key0 - (q0 + c) + 4 * hi;
#pragma unroll
            for (int r = 0; r < 16; ++r) { const int d = dbase + (r & 3) + 8 * (r >> 2); if (d < -128 || d > 128) sa[r] = -1e30f; }
        }
        float mx = sa[0];
#pragma unroll
        for (int r = 1; r < 16; ++r) mx = fmaxf(mx, sa[r]);
        { const auto rr = __builtin_amdgcn_permlane32_swap(__float_as_uint(mx), __float_as_uint(mx), false, false); mx = fmaxf(__uint_as_float(rr[0]), __uint_as_float(rr[1])); }
        const float mn = fmaxf(m, mx), alpha = __builtin_amdgcn_exp2f(m - mn);
        m = mn;
        float ps = 0.f;
#pragma unroll
        for (int r = 0; r < 16; ++r) { sa[r] = __builtin_amdgcn_exp2f(sa[r] - mn); ps += sa[r]; }
        l = l * alpha + ps;
#pragma unroll
        for (int r = 0; r < 16; ++r) { o0[r] *= alpha; o1[r] *= alpha; }
        s16x8 pf[2];
#pragma unroll
        for (int s = 0; s < 2; ++s) { v4u w; w.x = cvt_pk_bf16_(sa[8 * s + 0], sa[8 * s + 1]); w.y = cvt_pk_bf16_(sa[8 * s + 2], sa[8 * s + 3]); w.z = cvt_pk_bf16_(sa[8 * s + 4], sa[8 * s + 5]); w.w = cvt_pk_bf16_(sa[8 * s + 6], sa[8 * s + 7]);
            pf[s] = __builtin_bit_cast(s16x8, w); }
#pragma unroll
        for (int s = 0; s < 2; ++s) {
            const s16x8 v0 = __builtin_shufflevector(va[0][s][0], va[0][s][1], 0, 1, 2, 3, 4, 5, 6, 7), v1 = __builtin_shufflevector(va[1][s][0], va[1][s][1], 0, 1, 2, 3, 4, 5, 6, 7);
            o0 = __builtin_amdgcn_mfma_f32_32x32x16_bf16(v0, pf[s], o0, 0, 0, 0);
            o1 = __builtin_amdgcn_mfma_f32_32x32x16_bf16(v1, pf[s], o1, 0, 0, 0);
        }
    }
    { const auto rr = __builtin_amdgcn_permlane32_swap(__float_as_uint(l), __float_as_uint(l), false, false); l = __uint_as_float(rr[0]) + __uint_as_float(rr[1]); }
    const float il = 1.f / l;
    bf16* op = O + (tb + q0 + c) * 2048 + hq * 64 + 4 * hi;
#pragma unroll
    for (int g = 0; g < 4; ++g) {
        v2u w0, w1;
        w0.x = cvt_pk_bf16_(o0[4 * g + 0] * il, o0[4 * g + 1] * il); w0.y = cvt_pk_bf16_(o0[4 * g + 2] * il, o0[4 * g + 3] * il);
        w1.x = cvt_pk_bf16_(o1[4 * g + 0] * il, o1[4 * g + 1] * il); w1.y = cvt_pk_bf16_(o1[4 * g + 2] * il, o1[4 * g + 3] * il);
        *(v2u*)(op + 8 * g) = w0; *(v2u*)(op + 32 + 8 * g) = w1;
    }
}
typedef float fx2 __attribute__((ext_vector_type(2)));
__device__ __forceinline__ fx2 bf2_(unsigned w) { fx2 r; r[0] = __uint_as_float(w << 16); r[1] = __uint_as_float(w & 0xffff0000u); return r; }
__device__ __forceinline__ void fft16_item(bf16* Zp, const float* tw, int bg, int l, int s1h, int lane) {
    const int s1 = s1h * 128 + 2 * lane;
    bf16* base = Zp + ((size_t)(bg * 16) * 256 + l) * 512 + s1;
    fx2 zr[16], zi[16];
#pragma unroll
    for (int s2 = 0; s2 < 16; ++s2) { zr[s2] = bf2_(*(const unsigned*)(base + (size_t)s2 * 256 * 512)); zi[s2] = bf2_(*(const unsigned*)(base + (size_t)s2 * 256 * 512 + 256)); }
    fx2 er[16], ei[16];
#pragma unroll
    for (int d = 0; d < 4; ++d) {
        const fx2 ar = zr[d], ai_ = zi[d], br = zr[4 + d], bi = zi[4 + d], cr = zr[8 + d], ci = zi[8 + d], dr = zr[12 + d], di = zi[12 + d];
        const fx2 s0r = ar + cr, s0i = ai_ + ci, s1r = ar - cr, s1i = ai_ - ci, s2r = br + dr, s2i = bi + di, s3r = br - dr, s3i = bi - di;
        er[0 * 4 + d] = s0r + s2r; ei[0 * 4 + d] = s0i + s2i;
        er[1 * 4 + d] = s1r + s3i; ei[1 * 4 + d] = s1i - s3r;
        er[2 * 4 + d] = s0r - s2r; ei[2 * 4 + d] = s0i - s2i;
        er[3 * 4 + d] = s1r - s3i; ei[3 * 4 + d] = s1i + s3r;
    }
#pragma unroll
    for (int a = 1; a < 4; ++a)
#pragma unroll
        for (int d = 1; d < 4; ++d) {
            const float ang = 6.283185307179586f * (float)(a * d) / 16.f; const float c = __builtin_cosf(ang), sn = __builtin_sinf(ang);
            const fx2 xr = er[a * 4 + d], xi = ei[a * 4 + d];
            er[a * 4 + d] = xr * c + xi * sn; ei[a * 4 + d] = xi * c - xr * sn;
        }
#pragma unroll
    for (int a = 0; a < 4; ++a) {
        const fx2 ar = er[a * 4 + 0], ai_ = ei[a * 4 + 0], br = er[a * 4 + 1], bi = ei[a * 4 + 1], cr = er[a * 4 + 2], ci = ei[a * 4 + 2], dr = er[a * 4 + 3], di = ei[a * 4 + 3];
        const fx2 s0r = ar + cr, s0i = ai_ + ci, s1r = ar - cr, s1i = ai_ - ci, s2r = br + dr, s2i = bi + di, s3r = br - dr, s3i = bi - di;
        fx2 Dr[4], Di[4];
        Dr[0] = s0r + s2r; Di[0] = s0i + s2i; Dr[1] = s1r + s3i; Di[1] = s1i - s3r; Dr[2] = s0r - s2r; Di[2] = s0i - s2i; Dr[3] = s1r - s3i; Di[3] = s1i + s3r;
#pragma unroll
        for (int b = 0; b < 4; ++b) {
            const int k2 = a + 4 * b;
            const f32x4 t0 = *(const f32x4*)(tw + (size_t)(k2 * 256 + s1) * 2);
            const fx2 cc = (fx2){t0[0], t0[2]}, ss = (fx2){t0[1], t0[3]};
            const fx2 hr = Dr[b] * cc + Di[b] * ss, hi_ = Di[b] * cc - Dr[b] * ss;
            *(unsigned*)(base + (size_t)k2 * 256 * 512) = pk2(hr[0], hr[1]); *(unsigned*)(base + (size_t)k2 * 256 * 512 + 256) = pk2(hi_[0], hi_[1]);
        }
    }
}
#ifndef REP_PRO
#define REP_PRO 1
#endif
#ifndef REP_GEMM
#define REP_GEMM 1
#endif
#ifndef REP_ATT
#define REP_ATT 1
#endif
#ifndef REP_LITE
#define REP_LITE 0
#endif
#ifndef REP_Q
#define REP_Q 1
#endif
#ifndef REP_PA
#define REP_PA 1
#endif
#ifndef REP_TK
#define REP_TK 1
#endif
enum { PH_PRO = 0, PH_G1 = 1, PH_S1 = 2, PH_G2 = 3, PH_G3 = 4, PH_Q0 = 5, PH_TK0 = 6, PH_PA0 = 7, PH_PW0 = 8, PH_PB0 = 9, PH_QKV = 10, PH_ATT = 11, PH_WO = 12, PH_Q1 = 13, PH_TK1 = 14, PH_PA1 = 15, PH_PW1 = 16, PH_PB1 = 17, PH_FIN = 18, PH_END = 19 };
__global__ void __launch_bounds__(NWAVES * 64, 2) mega(Args a) {
    extern __shared__ __attribute__((aligned(16))) unsigned char lds_raw[];
    LAS unsigned char* lds = (LAS unsigned char*)lds_raw;
    cg::grid_group grid = cg::this_grid();
    const int wave = __builtin_amdgcn_readfirstlane(threadIdx.x >> 6);
#define FRESH_IDS() int lane; asm volatile("v_mbcnt_lo_u32_b32 %0, -1, 0\n\tv_mbcnt_hi_u32_b32 %0, -1, %0" : "=v"(lane)); const int tid = wave * 64 + lane; (void)tid
    const int G = gridDim.x, bx = blockIdx.x;
    unsigned char* ws = a.ws;
    const int lo = a.ph_lo, hi = a.ph_hi;
    volatile LAS unsigned* MISC = (volatile LAS unsigned*)(lds + LDSCTL_OFF);
    if (threadIdx.x < 16) MISC[threadIdx.x] = 0u;
    __syncthreads();
    XcdBarrier xbar = xcd_barrier_post((unsigned*)(ws + WS_CTL) + CW_BAR, MISC + 8);
#define IN(k) (lo <= (k) && (k) < hi)
#ifdef DIAG_A
#define STAMP(i) do { if (bx == 0 && threadIdx.x == 0) ((unsigned long long*)(ws + WS_STAMP))[i] = __builtin_amdgcn_s_memrealtime(); } while (0)
#else
#define STAMP(i) do { } while (0)
#endif
#define SEAM(k) do { if (IN(k) && IN((k) + 1)) { if ((k) == PH_PRO) grid.sync(); else xcd_barrier(xbar); } STAMP((k) + 1); } while (0)
    STAMP(0);
    for (int rep_ = 0; rep_ < REP_PRO; ++rep_)
    if (IN(PH_PRO)) { FRESH_IDS();
        const int gw = bx * NWAVES + wave, NGW = G * NWAVES;
        const size_t gtid = (size_t)bx * (NWAVES * 64) + tid, ngt = (size_t)G * NWAVES * 64;
        LAS float* scr = (LAS float*)(lds + wave * 16384);
        {
            constexpr int I_SQ = (DM / 64) * (DM / 32), I_QKV = (DM / 64) * (QKVW / 32);
            constexpr int NITEMS = 4 * I_SQ + I_QKV;
            for (int it = gw; it < NITEMS; it += NGW) {
                int r = it;
                if (r < I_SQ) { transpose_item<0>(a.in[3], DM, DM, nullptr, (bf16*)(ws + WS_WOF), scr, r, lane); continue; } r -= I_SQ;
                if (r < I_SQ) { transpose_item<0>(a.in[5], DM, DM, nullptr, (bf16*)(ws + WS_WOA), scr, r, lane); continue; } r -= I_SQ;
                if (r < I_SQ) { transpose_item<0>(a.in[7], DM, DM, a.in[2], (bf16*)(ws + WS_WQ0), scr, r, lane); continue; } r -= I_SQ;
                if (r < I_SQ) { transpose_item<0>(a.in[7] + (size_t)DM * DM, DM, DM, a.in[2] + DM, (bf16*)(ws + WS_WQ1), scr, r, lane); continue; } r -= I_SQ;
                transpose_item<1>(a.in[4], DM, QKVW, a.in[1] + DM, (bf16*)(ws + WS_WQKV), scr, r, lane);
            }
        }
        for (int row = gw; row < T; row += NGW) {
            const f32x4* xr = (const f32x4*)(a.in[0] + (size_t)row * DM) + lane;
            const f32x4* gr = (const f32x4*)a.in[1] + lane;
            f32x4 v[8]; float s = 0.f;
#pragma unroll
            for (int j = 0; j < 8; ++j) { v[j] = xr[64 * j]; s += (v[j][0] * v[j][0] + v[j][1] * v[j][1]) + (v[j][2] * v[j][2] + v[j][3] * v[j][3]); }
            const float r = rsqrtf(wsum(s) * (1.f / DM) + EPS);
            const int b = row >> 12, sp = row & 4095;
#pragma unroll
            for (int j = 0; j < 8; ++j) { const f32x4 gg = gr[64 * j]; v2u o; o.x = pk2(v[j][0] * r * gg[0], v[j][1] * r * gg[1]); o.y = pk2(v[j][2] * r * gg[2], v[j][3] * r * gg[3]);
                *(v2u*)((bf16*)(ws + WS_XG) + ((size_t)((b * 8 + j) * 4096 + sp) * 256 + 4 * lane)) = o; }
        }
        for (size_t i = gtid; i < (size_t)256 * 512 / 8; i += ngt) {
            const int k1 = (int)(i >> 6), c0 = (int)(i & 63) * 8, part = c0 >> 8, s0 = c0 & 255;
            float v[8];
#pragma unroll
            for (int e = 0; e < 8; ++e) { const int m = (k1 * (s0 + e)) & 255; const float rev = (float)m * (1.f / 256.f); v[e] = (part ? __builtin_amdgcn_sinf(rev) : __builtin_amdgcn_cosf(rev)) * (1.f / 64.f); }
            v4u o; o.x = pk2(v[0], v[1]); o.y = pk2(v[2], v[3]); o.z = pk2(v[4], v[5]); o.w = pk2(v[6], v[7]);
            *(v4u*)((bf16*)(ws + WS_A2) + i * 8) = o;
        }
        for (size_t i = gtid; i < (size_t)16 * 256; i += ngt) {
            const int k2 = (int)(i >> 8), s1 = (int)(i & 255); const float rev = (float)(k2 * s1) * (1.f / 4096.f);
            ((float*)(ws + WS_TW))[2 * i] = __builtin_amdgcn_cosf(rev); ((float*)(ws + WS_TW))[2 * i + 1] = __builtin_amdgcn_sinf(rev);
        }
        for (size_t i = gtid; i < (size_t)512 * 256 / 8; i += ngt) {
            const int n = (int)(i >> 5), c0 = (int)(i & 31) * 8, part = n >> 8, l = n & 255;
            float v[8];
#pragma unroll
            for (int e = 0; e < 8; ++e) { const int m = (l * (c0 + e)) & 255; const float rev = (float)m * (1.f / 256.f); v[e] = (part ? -__builtin_amdgcn_sinf(rev) : __builtin_amdgcn_cosf(rev)) * (1.f / 16.f); }
            v4u o; o.x = pk2(v[0], v[1]); o.y = pk2(v[2], v[3]); o.z = pk2(v[4], v[5]); o.w = pk2(v[6], v[7]);
            *(v4u*)((bf16*)(ws + WS_WCS) + i * 8) = o;
        }
        for (size_t i = gtid; i < (size_t)4096 * 32; i += ngt) {
            const int pos = (int)(i >> 5), fi = (int)(i & 31);
            const double inv = exp2(-(double)fi * (13.287712379549449 / 32.0));
            double sn, cs; sincos((double)pos * inv, &sn, &cs);
            ((float*)(ws + WS_ROPE))[2 * i] = (float)cs; ((float*)(ws + WS_ROPE))[2 * i + 1] = (float)sn;
        }
        cvt_stream(a.in[8], (bf16*)(ws + WS_KEYS), (size_t)2 * PH * 2 * 128 * 128 / 8, gtid, ngt);
    }
    SEAM(PH_PRO);
    for (int rep_ = 0; rep_ < REP_GEMM; ++rep_)
    if (IN(PH_G1)) { FRESH_IDS();
        int Kq = FW; asm volatile("" : "+s"(Kq));
        pg8::Gemm g{(const pg8::bf16_t*)(ws + WS_WCS), (const pg8::bf16_t*)(ws + WS_XG), 512, T * FG, Kq}; pg8::StaticOrder S; S.init(512, T * FG, G, bx);
        pg8::EpiZt E{(pg8::bf16_t*)(ws + WS_ZT)};
        pg8::gemm_phase<pg8::EpiZt, pg8::StaticOrder, true, true>(lds, g, S, E);
    }
    SEAM(PH_G1);
    if (IN(PH_S1)) { FRESH_IDS();
        const int gw = bx * NWAVES + wave, NGW = G * NWAVES;
        for (int it = gw; it < 32 * 256 * 2; it += NGW) fft16_item((bf16*)(ws + WS_ZT), (const float*)(ws + WS_TW), it >> 9, (it >> 1) & 255, it & 1, lane);
    }
    SEAM(PH_S1);
    for (int rep_ = 0; rep_ < REP_GEMM; ++rep_)
    if (IN(PH_G2)) { FRESH_IDS();
        pg8::Gemm g{(const pg8::bf16_t*)(ws + WS_A2), (const pg8::bf16_t*)(ws + WS_ZT), 256, 131072, 512}; pg8::StaticOrder S; S.init(256, 131072, G, bx);
        pg8::EpiY E{(pg8::bf16_t*)(ws + WS_Y)};
        pg8::gemm_phase<pg8::EpiY, pg8::StaticOrder, true, true>(lds, g, S, E);
    }
    SEAM(PH_G2);
    if (IN(PH_G3)) { FRESH_IDS();
        pg8::Gemm g{(const pg8::bf16_t*)(ws + WS_Y), (const pg8::bf16_t*)(ws + WS_WOF), T, DM, DM}; pg8::StaticOrder S; S.init(T, DM, G, bx);
        pg8::EpiRes E{a.in[0], a.out, (pg8::bf16_t*)(ws + WS_XB), (float*)(ws + WS_SSQ_A)};
        pg8::gemm_phase<pg8::EpiRes, pg8::StaticOrder, true, true>(lds, g, S, E);
    }
    SEAM(PH_G3);
#define PEER_LAYER(L) do { \
        const int pq = L ? PH_Q1 : PH_Q0, ptk = L ? PH_TK1 : PH_TK0, ppa = L ? PH_PA1 : PH_PA0, ppw = L ? PH_PW1 : PH_PW0, ppb = L ? PH_PB1 : PH_PB0; \
        for (int rep_ = 0; rep_ < REP_Q; ++rep_) \
        if (IN(pq)) { FRESH_IDS(); \
            pg8::Gemm g{(const pg8::bf16_t*)(ws + WS_XB), (const pg8::bf16_t*)(ws + (L ? WS_WQ1 : WS_WQ0)), T, DM, DM}; pg8::StaticOrder S; S.init(T, DM, G, bx); \
            pg8::EpiScale E{(pg8::bf16_t*)(ws + WS_Q), (const float*)(ws + (L ? WS_SSQ_C : WS_SSQ_A))}; \
            pg8::gemm_phase<pg8::EpiScale, pg8::StaticOrder, true, true>(lds, g, S, E); \
        } \
        SEAM(pq); \
        if (IN(ptk)) { FRESH_IDS(); \
            const bf16* keys = (const bf16*)(ws + WS_KEYS) + (size_t)L * PH * 2 * 128 * 128; \
            CvtCtx cx; cx.srcU = a.in[9] + (size_t)L * NEXP * DM; cx.dsrc = (long)((a.in[10] + (size_t)L * NEXP * DM) - cx.srcU); cx.gain = a.in[2] + L * DM; cx.dstU = ws + (L ? WS_U1 : WS_U0); cx.ddst = (long)WS_V0 - (long)WS_U0; cx.su = (float*)(ws + WS_SU) + L * 32768; cx.dsc = ((long)WS_SV - (long)WS_SU) / 4; cx.gwave = bx * NWAVES + wave; cx.nw = G * NWAVES; \
            int slot = 0; \
            for (int u = bx; u < (T / 256) * PH; u += G) { \
                const int h = u & 7, tblk = u >> 3; \
                __syncthreads(); \
                topk_fill(lds, keys, h, tid); \
                __syncthreads(); \
                topk_unit((const bf16*)(ws + WS_Q), lds, (int*)(ws + WS_EI), (float*)(ws + WS_GW), tblk * 256 + wave * 32, h, lane, cx, slot); \
                slot += 2 * (16 / TKB); \
            } \
            for (; slot * cx.nw + cx.gwave < 65536; ++slot) { f32x4 cr[4]; const int cc = slot * cx.nw + cx.gwave; cvt_chunk_load(cx, cc, lane, cr); cvt_chunk_store(cx, cc, lane, cr); } \
        } \
        SEAM(ptk); \
        if (IN(ppa)) { FRESH_IDS(); \
            const int xv = bx & 7, nxw = (G >> 3) * NWAVES, wx = (bx >> 3) * NWAVES + wave; \
            peer_a_slice<8>((const bf16*)(ws + WS_XB), (const int*)(ws + WS_EI), (const unsigned char*)(ws + (L ? WS_U1 : WS_U0)), (float*)(ws + WS_PD), xv, wx, nxw, T / nxw, lane); \
        } \
        SEAM(ppa); \
        if (IN(ppw)) { FRESH_IDS(); \
            const int gw = bx * NWAVES + wave, NGW = G * NWAVES; \
            for (int t = gw; t < T; t += NGW) peer_a2_token((const float*)(ws + WS_PD), (const float*)(ws + (L ? WS_SSQ_C : WS_SSQ_A)), (const int*)(ws + WS_EI), (const float*)(ws + WS_SU) + L * 32768, (const float*)(ws + WS_SV) + L * 32768, (float*)(ws + WS_GW), (float*)(ws + WS_W1), t, lane); \
        } \
        SEAM(ppw); \
        if (IN(ppb)) { FRESH_IDS(); \
            const int xv = bx & 7, nxw = (G >> 3) * NWAVES, wx = (bx >> 3) * NWAVES + wave; \
            peer_b_slice<4>(a.out, (const int*)(ws + WS_EI), (const float*)(ws + ((xv < 4) ? WS_GW : WS_W1)), (const unsigned char*)(ws + (L ? WS_V1 : WS_V0)), L ? (bf16*)nullptr : (bf16*)(ws + WS_XB), (float*)(ws + (L ? WS_SSQ_D : WS_SSQ_B)), xv, wx, nxw, T / nxw, lane); \
        } \
    } while (0)
    float oscale = 1.f;
    PEER_LAYER(0);
    SEAM(PH_PB0);
    for (int rep_ = 0; rep_ < REP_GEMM; ++rep_)
    if (IN(PH_QKV)) { FRESH_IDS();
        {
            pg8::Gemm g{(const pg8::bf16_t*)(ws + WS_XB), (const pg8::bf16_t*)(ws + WS_WQKV), T, 2560, DM}; pg8::StaticOrder S; S.init(T, 2560, G, bx);
            pg8::EpiQK E{(pg8::bf16_t*)(ws + WS_QB), (pg8::bf16_t*)(ws + WS_KB), (const float*)(ws + WS_SSQ_B), (const float*)(ws + WS_ROPE), 0.125f * 1.4426950408889634f};
            pg8::gemm_phase<pg8::EpiQK, pg8::StaticOrder, true, true>(lds, g, S, E);
        }
        if (bx >= G / 2) {
            pg8::Gemm g{(const pg8::bf16_t*)(ws + WS_WQKV) + (size_t)2560 * DM, (const pg8::bf16_t*)(ws + WS_XB), 512, T, DM}; pg8::StaticOrder S; S.init(512, T, G / 2, bx - G / 2);
            pg8::EpiVt E{(pg8::bf16_t*)(ws + WS_VT), (const float*)(ws + WS_SSQ_B)};
            pg8::gemm_phase<pg8::EpiVt, pg8::StaticOrder, true, true>(lds, g, S, E);
        }
    }
    SEAM(PH_QKV);
    for (int rep_ = 0; rep_ < REP_ATT; ++rep_)
    if (IN(PH_ATT)) { FRESH_IDS();
        for (int vb = bx; vb < 256; vb += G) {
            const int bkv = vb >> 3, chunk = vb & 7, b = bkv >> 3, kvh = bkv & 7;
            for (int i = 0; i < 8; ++i) {
                const int qu = (chunk * 8 + i) * 64;
                __syncthreads();
                attn_fill(lds, (const bf16*)(ws + WS_KB), (const bf16*)(ws + WS_VT), b, kvh, qu - 128, tid);
                __syncthreads();
                attn_task(lds, (const bf16*)(ws + WS_QB), (bf16*)(ws + WS_O), a.in[6], b, kvh * 4 + (wave & 3), qu + (wave >> 2) * 32, qu - 128, lane);
            }
        }
    }
    SEAM(PH_ATT);
    if (IN(PH_WO)) { FRESH_IDS();
        pg8::Gemm g{(const pg8::bf16_t*)(ws + WS_O), (const pg8::bf16_t*)(ws + WS_WOA), T, DM, DM}; pg8::StaticOrder S; S.init(T, DM, G, bx);
        pg8::EpiRes E{a.out, a.out, (pg8::bf16_t*)(ws + WS_XB), (float*)(ws + WS_SSQ_C)};
        pg8::gemm_phase<pg8::EpiRes, pg8::StaticOrder, true, true>(lds, g, S, E);
    }
    SEAM(PH_WO);
#ifdef DIAG_A
    { const unsigned long long* st = (const unsigned long long*)(ws + WS_STAMP); oscale = 1.f + sqrtf((float)(st[DIAG_B] - st[DIAG_A]) * 1e-6f); }
#endif
    PEER_LAYER(1);
#undef PEER_LAYER
    SEAM(PH_PB1);
    if (IN(PH_FIN)) { FRESH_IDS();
        const int gw = bx * NWAVES + wave, NGW = G * NWAVES;
        for (int t = gw; t < T; t += NGW) final_norm_row(a.out, (const float*)(ws + WS_SSQ_D), a.in[11], t, lane, oscale);
    }
#undef SEAM
#undef IN
}

#ifndef N_LAUNCHES
#define N_LAUNCHES 1
#endif
extern "C" void kernel_launch(void* const* d_in, const int* in_sizes, int n_in, void* d_out, int out_size, void* d_ws, size_t ws_size, hipStream_t stream) {
    static int grid = 0;
    if (!grid) {
        if (hipFuncSetAttribute((const void*)mega, hipFuncAttributeMaxDynamicSharedMemorySize, LDS_BYTES) != hipSuccess) { fprintf(stderr, "hipFuncSetAttribute failed\n"); }
        int dev = 0, cus = 0, per_cu = 0;
        (void)hipGetDevice(&dev);
        (void)hipDeviceGetAttribute(&cus, hipDeviceAttributeMultiprocessorCount, dev);
        if (hipOccupancyMaxActiveBlocksPerMultiprocessor(&per_cu, (const void*)mega, NWAVES * 64, LDS_BYTES) != hipSuccess) per_cu = 0;
        (void)hipGetLastError();
        grid = cus * per_cu;
        if (grid > 256) grid = 256;
        grid &= ~1;
        if (grid < 2) { fprintf(stderr, "occupancy query gave %d x %d\n", cus, per_cu); grid = -1; }
    }
    if (grid < 0) return;
    if (ws_size < 700 * MiB) { fprintf(stderr, "ws too small: %zu\n", ws_size); return; }
    (void)hipMemsetAsync((char*)d_ws + WS_CTL, 0, CTL_BYTES, stream);
    Args a{};
    for (int i = 0; i < 12; ++i) a.in[i] = (const float*)d_in[i];
    a.out = (float*)d_out; a.ws = (unsigned char*)d_ws;
    if (N_LAUNCHES == 1) {
        a.ph_lo = 0; a.ph_hi = PH_END;
        void* args[] = {&a};
        const hipError_t e = hipLaunchCooperativeKernel((const void*)mega, dim3(grid), dim3(NWAVES * 64), args, LDS_BYTES, stream);
        if (e != hipSuccess) fprintf(stderr, "cooperative launch failed: %s (grid %d)\n", hipGetErrorString(e), grid);
    } else {
        for (int ph = 0; ph < PH_END; ++ph) {
            a.ph_lo = ph; a.ph_hi = ph + 1;
            hipLaunchKernelGGL(mega, dim3(grid), dim3(NWAVES * 64), LDS_BYTES, stream, a);
        }
    }
}
```

```cpp
#include <hip/hip_runtime.h>
#include <hip/hip_cooperative_groups.h>
namespace cg = cooperative_groups;
#include <cstdio>
#include <cstdint>
#include <cmath>

constexpr int DM = 2048, NB = 4, SEQ = 4096, T = NB * SEQ;
constexpr int FG = 8, FW = 256;
constexpr int HD = 64, NQH = 32, NKVH = 8, QKVW = 3072;
constexpr int PH = 8, NKEYS = 128, NEXP = 16384, PTOPK = 16;
constexpr float EPS = 1e-6f;
namespace pg8 {
#define PG8_LAS __attribute__((address_space(3)))
typedef unsigned short bf16_t;
typedef short bf16x8 __attribute__((ext_vector_type(8)));
typedef float f32x4 __attribute__((ext_vector_type(4)));
typedef unsigned u32x4 __attribute__((ext_vector_type(4)));
constexpr int BM = 256, BK = 64, HALF = 128, HTB = HALF * BK * 2  , STAGE_BYTES = 8 * HTB, NXCD = 8, WGM = 8;

__host__ __device__ __forceinline__ int lds_byte(int r, int c) { const int st = (r >> 4) * 2 + (c >> 5), rr = r & 15, cc = c & 31, ob = rr * 64 + cc * 2; return st * 1024 + (ob ^ (((ob >> 9) & 1) << 5)); }
__host__ __device__ __forceinline__ void stage_rc(int b, int& R, int& C) { const int st = b / 1024, sb = b % 1024, swz = sb ^ (((sb >> 9) & 1) << 5); R = (st >> 1) * 16 + swz / 64; C = (st & 1) * 32 + (swz % 64) / 2; }
__host__ __device__ __forceinline__ int perm32(int rho) { const int n = rho >> 4, i = rho & 15; return 8 * (i >> 2) + 4 * n + (i & 3); }

struct Unit { int pm, pn; };
struct Gemm { const bf16_t* A; const bf16_t* Bt; int M, N, K; };

struct StaticOrder {
    int nM, nN, nwg, G, c;
    __host__ __device__ void init(int M, int N, int G_, int c_) { nM = M / BM; nN = N / BM; nwg = nM * nN; G = G_; c = c_; }
    __host__ __device__ bool next(int i, Unit& u) const {
        const long L = (long)i * G + c; if (L >= nwg) return false;
        int wgid = (int)L; { const int q = nwg / NXCD, r = nwg % NXCD, xcd = wgid % NXCD, off = wgid / NXCD; wgid = (xcd < r ? xcd * (q + 1) : r * (q + 1) + (xcd - r) * q) + off; }
        const int nig = WGM * nN, gid = wgid / nig, fm = gid * WGM, gsz = (nM - fm) < WGM ? (nM - fm) : WGM;
        u.pm = fm + ((wgid % nig) % gsz); u.pn = (wgid % nig) / gsz; return true;
    }
    __device__ __forceinline__ void a_ready(const Unit&) const {}
    __device__ __forceinline__ void done(const Unit&) const {}
};

__device__ __forceinline__ unsigned cvt_pk_bf16(float lo, float hi) { unsigned r; asm volatile("v_cvt_pk_bf16_f32 %0, %1, %2" : "=v"(r) : "v"(lo), "v"(hi)); return r; }
typedef float f32x2 __attribute__((ext_vector_type(2)));
__device__ __forceinline__ u32x4 pack8(const f32x4 v0, const f32x4 v1) { u32x4 w; w.x = cvt_pk_bf16(v0[0], v0[1]); w.y = cvt_pk_bf16(v0[2], v0[3]); w.z = cvt_pk_bf16(v1[0], v1[1]); w.w = cvt_pk_bf16(v1[2], v1[3]); return w; }
struct EpiZt {
    static constexpr bool PERM = true, AFTER_DRAIN = false; bf16_t* Zp;
    __device__ __forceinline__ void operator()(const f32x4 (&acc)[2][2][4][2], const Unit& u, int wr, int wc, int fr, int fq) const {
        const int part = u.pm, bgs2 = u.pn;
        bf16_t* base = Zp + ((size_t)(bgs2 * 256 + wr * 64 + fr) * 512 + part * 256 + wc * 32 + 8 * fq);
#pragma unroll
        for (int ai = 0; ai < 2; ++ai)
#pragma unroll
            for (int m = 0; m < 4; ++m)
#pragma unroll
                for (int bj = 0; bj < 2; ++bj) *(u32x4*)(base + (ai * HALF + m * 16) * 512 + bj * HALF) = pack8(acc[ai][bj][m][0], acc[ai][bj][m][1]);
    }
};
struct EpiY {
    static constexpr bool PERM = true, AFTER_DRAIN = false; bf16_t* Y;
    __device__ __forceinline__ void operator()(const f32x4 (&acc)[2][2][4][2], const Unit& u, int wr, int wc, int fr, int fq) const {
        const int bg = u.pn >> 4, k2 = u.pn & 15, b = bg >> 3, g = bg & 7;
        bf16_t* base = Y + ((size_t)(b * 4096 + (wr * 64 + fr) * 16 + k2) * 2048 + g * 256 + wc * 32 + 8 * fq);
#pragma unroll
        for (int ai = 0; ai < 2; ++ai)
#pragma unroll
            for (int m = 0; m < 4; ++m)
#pragma unroll
                for (int bj = 0; bj < 2; ++bj) *(u32x4*)(base + (size_t)(ai * HALF + m * 16) * 16 * 2048 + bj * HALF) = pack8(acc[ai][bj][m][0], acc[ai][bj][m][1]);
    }
};
struct EpiRes {
    static constexpr bool PERM = true, AFTER_DRAIN = false; const float* R; float* out; bf16_t* xb; float* ssq;
    __device__ __forceinline__ void operator()(const f32x4 (&acc)[2][2][4][2], const Unit& u, int wr, int wc, int fr, int fq) const {
        const int row0 = u.pm * BM + wr * 64 + fr; const size_t off0 = (size_t)row0 * 2048 + u.pn * BM + wc * 32 + 8 * fq;
        const float* Rb = R + off0; float* Ob = out + off0; bf16_t* Xb = xb + off0; float* Sb = ssq + row0;
#pragma unroll
        for (int ai = 0; ai < 2; ++ai)
#pragma unroll
            for (int m = 0; m < 4; ++m) { const int ro = (ai * HALF + m * 16) * 2048; float ss = 0.f;
#pragma unroll
                for (int bj = 0; bj < 2; ++bj) {
                    const f32x4 r0 = *(const f32x4*)(Rb + ro + bj * HALF), r1 = *(const f32x4*)(Rb + ro + bj * HALF + 4);
                    const f32x4 o0 = acc[ai][bj][m][0] + r0, o1 = acc[ai][bj][m][1] + r1;
                    *(f32x4*)(Ob + ro + bj * HALF) = o0; *(f32x4*)(Ob + ro + bj * HALF + 4) = o1;
                    *(u32x4*)(Xb + ro + bj * HALF) = pack8(o0, o1);
                    ss += (o0[0] * o0[0] + o0[1] * o0[1]) + (o0[2] * o0[2] + o0[3] * o0[3]) + (o1[0] * o1[0] + o1[1] * o1[1]) + (o1[2] * o1[2] + o1[3] * o1[3]); }
                ss += __shfl_xor(ss, 16); ss += __shfl_xor(ss, 32);
                if (fq == 0) unsafeAtomicAdd(Sb + ai * HALF + m * 16, ss);
                asm volatile("" ::: "memory"); }
    }
};
struct EpiScale {
    static constexpr bool PERM = true, AFTER_DRAIN = false; bf16_t* O; const float* ssq;
    __device__ __forceinline__ void operator()(const f32x4 (&acc)[2][2][4][2], const Unit& u, int wr, int wc, int fr, int fq) const {
        const int row0 = u.pm * BM + wr * 64 + fr;
        bf16_t* base = O + ((size_t)row0 * 2048 + u.pn * BM + wc * 32 + 8 * fq); const float* Sb = ssq + row0;
#pragma unroll
        for (int ai = 0; ai < 2; ++ai)
#pragma unroll
            for (int m = 0; m < 4; ++m) { const float rs = rsqrtf(Sb[ai * HALF + m * 16] * (1.f / 2048.f) + 1e-6f);
#pragma unroll
                for (int bj = 0; bj < 2; ++bj) *(u32x4*)(base + (ai * HALF + m * 16) * 2048 + bj * HALF) = pack8(acc[ai][bj][m][0] * rs, acc[ai][bj][m][1] * rs); }
    }
};
struct EpiQK {
    static constexpr bool PERM = true, AFTER_DRAIN = false; bf16_t* Q; bf16_t* K; const float* ssq; const float* rope; float qscale;
    __device__ __forceinline__ void operator()(const f32x4 (&acc)[2][2][4][2], const Unit& u, int wr, int wc, int fr, int fq) const {
        const int row0 = u.pm * BM + wr * 64 + fr; const bool isq = u.pn < 8;
        const int cl = wc * 32 + 8 * fq;
        bf16_t* base = isq ? (Q + ((size_t)row0 * 2048 + u.pn * BM + cl)) : (K + ((size_t)row0 * 512 + (u.pn - 8) * BM + cl));
        const int ld = isq ? 2048 : 512; const float sc = isq ? qscale : 1.f;
        const float* rp = rope + (size_t)(row0 & 4095) * 64 + (cl & 63);
        const float* Sb = ssq + row0;
#pragma unroll
        for (int ai = 0; ai < 2; ++ai)
#pragma unroll
            for (int m = 0; m < 4; ++m) { const int ro = ai * HALF + m * 16; const float rs = rsqrtf(Sb[ro] * (1.f / 2048.f) + 1e-6f) * sc;
                const f32x4 t0 = *(const f32x4*)(rp + (size_t)ro * 64), t1 = *(const f32x4*)(rp + (size_t)ro * 64 + 4);
#pragma unroll
                for (int bj = 0; bj < 2; ++bj) {
                    const f32x4 a = acc[ai][bj][m][0] * rs, b = acc[ai][bj][m][1] * rs; f32x4 oa, ob;
                    oa[0] = a[0] * t0[0] - a[1] * t0[1]; oa[1] = a[1] * t0[0] + a[0] * t0[1]; oa[2] = a[2] * t0[2] - a[3] * t0[3]; oa[3] = a[3] * t0[2] + a[2] * t0[3];
                    ob[0] = b[0] * t1[0] - b[1] * t1[1]; ob[1] = b[1] * t1[0] + b[0] * t1[1]; ob[2] = b[2] * t1[2] - b[3] * t1[3]; ob[3] = b[3] * t1[2] + b[2] * t1[3];
                    *(u32x4*)(base + (size_t)ro * ld + bj * HALF) = pack8(oa, ob); } }
    }
};
struct EpiVt {
    static constexpr bool PERM = true, AFTER_DRAIN = false; bf16_t* Vt; const float* ssq;
    __device__ __forceinline__ void operator()(const f32x4 (&acc)[2][2][4][2], const Unit& u, int wr, int wc, int fr, int fq) const {
        const int col0 = u.pn * BM + wc * 32 + 8 * fq;
        bf16_t* base = Vt + ((size_t)(u.pm * BM + wr * 64 + fr) * 16384 + col0);
        f32x4 r0[2], r1[2];
#pragma unroll
        for (int bj = 0; bj < 2; ++bj) { const f32x4 s0 = *(const f32x4*)(ssq + col0 + bj * HALF), s1 = *(const f32x4*)(ssq + col0 + bj * HALF + 4);
#pragma unroll
            for (int q = 0; q < 4; ++q) { r0[bj][q] = rsqrtf(s0[q] * (1.f / 2048.f) + 1e-6f); r1[bj][q] = rsqrtf(s1[q] * (1.f / 2048.f) + 1e-6f); } }
#pragma unroll
        for (int ai = 0; ai < 2; ++ai)
#pragma unroll
            for (int m = 0; m < 4; ++m)
#pragma unroll
                for (int bj = 0; bj < 2; ++bj) *(u32x4*)(base + (size_t)(ai * HALF + m * 16) * 16384 + bj * HALF) = pack8(acc[ai][bj][m][0] * r0[bj], acc[ai][bj][m][1] * r1[bj]);
    }
};
template <class Epi, class Sched, bool ALIGN_EPI = false, bool SP2 = false>
__device__ __forceinline__ void gemm_phase(PG8_LAS unsigned char* lds, const Gemm g, const Sched& S, const Epi& E) {
    const int tid = threadIdx.x, wid = __builtin_amdgcn_readfirstlane(tid >> 6), lane = tid & 63, wr = wid >> 2, wc = wid & 3, fr = lane & 15, fq = lane >> 4;
    const int K = g.K, nt = K / BK;
    unsigned voffA[2], voffB[2];
#pragma unroll
    for (int i = 0; i < 2; ++i) { int R, C; stage_rc(tid * 16 + i * 8192, R, C); const int Rb = Epi::PERM ? ((R & ~31) + perm32(R & 31)) : R;
        voffA[i] = (unsigned)(R * K + C) * 2u; voffB[i] = (unsigned)(Rb * K + C) * 2u; }
    const size_t kstep = (size_t)(BK * 2);
    const size_t hstep = (size_t)HALF * K * 2;
    const size_t tstep = 2 * hstep;
    const unsigned ldsw = (unsigned)wid * 1024u;
    const int aoff = lds_byte(wr * 64 + fr, fq * 8), boff = lds_byte(wc * 32 + fr, fq * 8);
#define PG8_SA(b, h) (((b) * 2 + (h)) * HTB)
#define PG8_SB(b, h) ((4 + (b) * 2 + (h)) * HTB)
#define PG8_STAGE(bufoff, gbase, voff) do { _Pragma("unroll") for (int _i = 0; _i < 2; ++_i) \
        __builtin_amdgcn_global_load_lds((const unsigned*)((const char*)(gbase) + (voff)[_i]), (PG8_LAS unsigned*)(lds + (bufoff) + ldsw + _i * 8192), 16, 0, 0); } while (0)
#define PG8_LDA(dst, b, h) do { _Pragma("unroll") for (int m = 0; m < 4; ++m) _Pragma("unroll") for (int k = 0; k < 2; ++k) dst[m][k] = *(const PG8_LAS bf16x8*)(lds + PG8_SA(b, h) + aoff + m * 2048 + k * 1024); } while (0)
#define PG8_LDB(dst, b, h) do { _Pragma("unroll") for (int n = 0; n < 2; ++n) _Pragma("unroll") for (int k = 0; k < 2; ++k) dst[n][k] = *(const PG8_LAS bf16x8*)(lds + PG8_SB(b, h) + boff + n * 2048 + k * 1024); } while (0)
#define PG8_MMA(ai, bj, At, Bt) do { __builtin_amdgcn_s_setprio(1); _Pragma("unroll") for (int m = 0; m < 4; ++m) _Pragma("unroll") for (int n = 0; n < 2; ++n) _Pragma("unroll") for (int k = 0; k < 2; ++k) \
        acc[ai][bj][m][n] = __builtin_amdgcn_mfma_f32_16x16x32_bf16(Bt[n][k], At[m][k], acc[ai][bj][m][n], 0, 0, 0); __builtin_amdgcn_s_setprio(0); } while (0)
#define PG8_WAIT_V(n) asm volatile("s_waitcnt vmcnt(" #n ")" ::: "memory")
#define PG8_WAIT_L(n) asm volatile("s_waitcnt lgkmcnt(" #n ")" ::: "memory")
#define PG8_BAR __builtin_amdgcn_s_barrier()
#define PG8_SCHED __builtin_amdgcn_sched_barrier(0)
    Unit cur, nxt; int ui = 0;
    if (!S.next(0, cur)) return;
    f32x4 acc[2][2][4][2];
#pragma unroll
    for (int a = 0; a < 2; ++a)
#pragma unroll
        for (int b = 0; b < 2; ++b)
#pragma unroll
            for (int m = 0; m < 4; ++m)
#pragma unroll
                for (int n = 0; n < 2; ++n) acc[a][b][m][n] = (f32x4){0.f, 0.f, 0.f, 0.f};
    bf16x8 At[4][2], B0[2][2], B1[2][2];
    const char* cA = (const char*)g.A + (size_t)cur.pm * tstep; const char* cB = (const char*)g.Bt + (size_t)cur.pn * tstep;
    S.a_ready(cur);
    if constexpr (SP2) {
        PG8_STAGE(PG8_SB(0, 0), cB, voffB); PG8_STAGE(PG8_SB(0, 1), cB + hstep, voffB); PG8_STAGE(PG8_SA(0, 0), cA, voffA); PG8_STAGE(PG8_SA(0, 1), cA + hstep, voffA);
        if (wr == 1) PG8_BAR;
        PG8_WAIT_V(2); PG8_BAR;
        PG8_STAGE(PG8_SB(1, 0), cB + kstep, voffB); PG8_STAGE(PG8_SA(1, 0), cA + kstep, voffA); PG8_STAGE(PG8_SB(1, 1), cB + hstep + kstep, voffB);
        PG8_WAIT_V(6); PG8_BAR;
    } else {
        PG8_STAGE(PG8_SB(0, 0), cB, voffB); PG8_STAGE(PG8_SA(0, 0), cA, voffA); PG8_STAGE(PG8_SB(0, 1), cB + hstep, voffB); PG8_STAGE(PG8_SA(0, 1), cA + hstep, voffA);
        if (wr == 1) PG8_BAR;
        PG8_WAIT_V(4); PG8_BAR;
        PG8_STAGE(PG8_SB(1, 0), cB + kstep, voffB); PG8_STAGE(PG8_SA(1, 0), cA + kstep, voffA); PG8_STAGE(PG8_SB(1, 1), cB + hstep + kstep, voffB);
        PG8_WAIT_V(6); PG8_BAR;
    }
    for (;;) {
        const bool has_next = S.next(ui + 1, nxt);
        const char* nA = has_next ? (const char*)g.A + (size_t)nxt.pm * tstep : cA; const char* nB = has_next ? (const char*)g.Bt + (size_t)nxt.pn * tstep : cB;
        for (int t = 0; t < nt; t += 2) {
            const bool last = (t == nt - 2);
            const char* a1 = cA + (size_t)(t + 1) * kstep;
            const char* a2 = last ? nA : cA + (size_t)(t + 2) * kstep; const char* b2 = last ? nB : cB + (size_t)(t + 2) * kstep;
            const char* a3 = a2 + kstep; const char* b3 = b2 + kstep;
            if (last && has_next) S.a_ready(nxt);
            if constexpr (SP2) {
            PG8_LDB(B0, 0, 0); PG8_LDB(B1, 0, 1); PG8_SCHED; PG8_LDA(At, 0, 0); PG8_STAGE(PG8_SA(1, 1), a1 + hstep, voffA);
            PG8_WAIT_V(8); PG8_WAIT_L(0); PG8_BAR; PG8_MMA(0, 0, At, B0); PG8_MMA(0, 1, At, B1); PG8_BAR; PG8_SCHED;
            PG8_LDA(At, 0, 1); PG8_STAGE(PG8_SB(0, 0), b2, voffB); PG8_STAGE(PG8_SB(0, 1), b2 + hstep, voffB); PG8_STAGE(PG8_SA(0, 0), a2, voffA);
            PG8_WAIT_V(8); PG8_WAIT_L(0); PG8_BAR; PG8_MMA(1, 0, At, B0); PG8_MMA(1, 1, At, B1); PG8_BAR; PG8_SCHED;
            PG8_LDB(B0, 1, 0); PG8_LDB(B1, 1, 1); PG8_SCHED; PG8_LDA(At, 1, 0); PG8_STAGE(PG8_SA(0, 1), a2 + hstep, voffA);
            PG8_WAIT_V(8); PG8_WAIT_L(0); PG8_BAR; PG8_MMA(0, 0, At, B0); PG8_MMA(0, 1, At, B1); PG8_BAR; PG8_SCHED;
            PG8_LDA(At, 1, 1); PG8_STAGE(PG8_SB(1, 0), b3, voffB); PG8_STAGE(PG8_SB(1, 1), b3 + hstep, voffB); PG8_STAGE(PG8_SA(1, 0), a3, voffA);
            PG8_WAIT_V(8); PG8_WAIT_L(0); PG8_BAR; PG8_MMA(1, 0, At, B0); PG8_MMA(1, 1, At, B1); PG8_BAR; PG8_SCHED;
            } else {
            PG8_LDB(B0, 0, 0); PG8_SCHED; PG8_LDA(At, 0, 0); PG8_STAGE(PG8_SA(1, 1), a1 + hstep, voffA);
            PG8_WAIT_L(8); PG8_BAR; PG8_WAIT_L(0); PG8_MMA(0, 0, At, B0); PG8_BAR; PG8_SCHED;
            PG8_LDB(B1, 0, 1); PG8_STAGE(PG8_SB(0, 0), b2, voffB);
            PG8_BAR; PG8_WAIT_L(0); PG8_MMA(0, 1, At, B1); PG8_BAR;
            PG8_LDA(At, 0, 1); PG8_STAGE(PG8_SA(0, 0), a2, voffA);
            PG8_BAR; PG8_WAIT_L(0); PG8_MMA(1, 0, At, B0); PG8_BAR; PG8_SCHED;
            PG8_STAGE(PG8_SB(0, 1), b2 + hstep, voffB);
            PG8_WAIT_V(6); PG8_BAR; PG8_MMA(1, 1, At, B1); PG8_BAR;
            PG8_LDB(B0, 1, 0); PG8_SCHED; PG8_LDA(At, 1, 0); PG8_STAGE(PG8_SA(0, 1), a2 + hstep, voffA);
            PG8_WAIT_L(8); PG8_BAR; PG8_WAIT_L(0); PG8_MMA(0, 0, At, B0); PG8_BAR; PG8_SCHED;
            PG8_LDB(B1, 1, 1); PG8_STAGE(PG8_SB(1, 0), b3, voffB);
            PG8_BAR; PG8_WAIT_L(0); PG8_MMA(0, 1, At, B1); PG8_BAR;
            PG8_LDA(At, 1, 1); PG8_STAGE(PG8_SA(1, 0), a3, voffA);
            PG8_BAR; PG8_WAIT_L(0); PG8_MMA(1, 0, At, B0); PG8_BAR; PG8_SCHED;
            PG8_STAGE(PG8_SB(1, 1), b3 + hstep, voffB);
            PG8_WAIT_V(6); PG8_BAR; PG8_MMA(1, 1, At, B1); PG8_BAR;
            }
        }
        if constexpr (ALIGN_EPI) { if (wr == 0) PG8_BAR; }
        if constexpr (!Epi::AFTER_DRAIN) { E(acc, cur, wr, wc, fr, fq); S.done(cur); }
        if (!has_next) break;
#pragma unroll
        for (int a = 0; a < 2; ++a)
#pragma unroll
            for (int b = 0; b < 2; ++b)
#pragma unroll
                for (int m = 0; m < 4; ++m)
#pragma unroll
                    for (int n = 0; n < 2; ++n) acc[a][b][m][n] = (f32x4){0.f, 0.f, 0.f, 0.f};
        cur = nxt; cA = nA; cB = nB; ++ui;
        if constexpr (ALIGN_EPI) { if (wr == 1) PG8_BAR; }
    }
    PG8_WAIT_V(0);
    if constexpr (!ALIGN_EPI) { if (wr == 0) PG8_BAR; }
    PG8_BAR;
    if constexpr (Epi::AFTER_DRAIN) { E.fused(acc, cur, wr, wc, fr, fq, lds, wid, lane); S.done(cur); }
#undef PG8_SA
#undef PG8_SB
#undef PG8_STAGE
#undef PG8_LDA
#undef PG8_LDB
#undef PG8_MMA
#undef PG8_WAIT_V
#undef PG8_WAIT_L
#undef PG8_BAR
#undef PG8_SCHED
}
}
#define GAS __attribute__((address_space(1)))
#define LAS __attribute__((address_space(3)))
typedef unsigned short bf16;
typedef unsigned v4u __attribute__((ext_vector_type(4)));
typedef unsigned v2u __attribute__((ext_vector_type(2)));
typedef float f32x4 __attribute__((ext_vector_type(4)));
constexpr int NWAVES = 8;
constexpr int LDS_BYTES = 147456, LDSCTL_OFF = 131072;
constexpr int CW_BAR = 4096;
constexpr size_t MiB = 1u << 20;
constexpr size_t WS_CTL = 0, CTL_BYTES = 1 * MiB;
constexpr size_t WS_SSQ_A = 256 * 1024, WS_SSQ_B = 320 * 1024, WS_SSQ_C = 384 * 1024, WS_SSQ_D = 448 * 1024;
constexpr size_t WS_STAMP = 128 * 1024;
constexpr size_t WS_SU = 512 * 1024, WS_SV = 768 * 1024;
constexpr size_t WS_WCS = 1 * MiB, WS_ROPE = 2 * MiB, WS_KEYS = 3 * MiB;
constexpr size_t WS_WOF = 8 * MiB, WS_WQKV = 16 * MiB, WS_WOA = 28 * MiB, WS_WQ0 = 36 * MiB, WS_WQ1 = 44 * MiB;
constexpr size_t WS_A2 = 64 * MiB, WS_TW = 65 * MiB;
constexpr size_t WS_U0 = 128 * MiB, WS_V0 = 192 * MiB, WS_U1 = 256 * MiB, WS_V1 = 320 * MiB;
constexpr size_t WS_XG = 384 * MiB, WS_XB = 384 * MiB;
constexpr size_t WS_ZT = 448 * MiB;
constexpr size_t WS_Y = 576 * MiB;
constexpr size_t WS_Q = 448 * MiB;
constexpr size_t WS_EI = 640 * MiB, WS_GW = 648 * MiB, WS_W1 = 656 * MiB;
constexpr size_t WS_PD = 448 * MiB;
constexpr size_t WS_QB = 448 * MiB, WS_KB = 512 * MiB, WS_VT = 528 * MiB, WS_O = 576 * MiB;

__device__ __forceinline__ unsigned f2bf(float f) { unsigned u = __builtin_bit_cast(unsigned, f); return (u + 0x7fffu + ((u >> 16) & 1u)) >> 16; }
__device__ __forceinline__ unsigned pk2(float lo, float hi) { return f2bf(lo) | (f2bf(hi) << 16); }

struct Args { const float* in[12]; float* out; unsigned char* ws; int ph_lo, ph_hi; };

__device__ __forceinline__ int qkv_row(int n) { if (n >= 2560) return n; const int d = n & 63, pc = (d < 32) ? 2 * d : 2 * (d - 32) + 1; return (n & ~63) + pc; }
template <int MODE>
__device__ __forceinline__ void transpose_item(const float* W, int K, int N, const float* gain, bf16* WT, LAS float* scr, int item, int lane) {
    const int nblk = N / 32, kb = item / nblk, nb = item % nblk, k0 = 64 * kb, n0 = 32 * nb;
#pragma unroll 8
    for (int i = 0; i < 32; ++i) { const int kk = 2 * i + (lane >> 5); float v = W[(size_t)(k0 + kk) * N + n0 + (lane & 31)]; if (gain) v *= gain[k0 + kk]; scr[kk * 33 + (lane & 31)] = v; }
    asm volatile("s_waitcnt lgkmcnt(0)" ::: "memory");
    const int c = lane & 7;
#pragma unroll
    for (int j = 0; j < 4; ++j) { const int n = (lane >> 3) + 8 * j; const LAS float* s = scr + (8 * c) * 33 + n;
        v4u o; o.x = pk2(s[0 * 33], s[1 * 33]); o.y = pk2(s[2 * 33], s[3 * 33]); o.z = pk2(s[4 * 33], s[5 * 33]); o.w = pk2(s[6 * 33], s[7 * 33]);
        const int row = (MODE == 1) ? qkv_row(n0 + n) : (n0 + n);
        *(v4u*)(WT + (size_t)row * K + k0 + 8 * c) = o; }
    asm volatile("s_waitcnt lgkmcnt(0)" ::: "memory");
}
__device__ __forceinline__ float wsum(float v) {
#pragma unroll
    for (int o = 1; o < 64; o <<= 1) v += __shfl_xor(v, o);
    return v;
}
__device__ __forceinline__ void cvt_stream(const float* src, bf16* dst, size_t n8, size_t gtid, size_t ngt) {
    for (size_t i = gtid; i < n8; i += ngt) {
        const f32x4 a = *(const f32x4*)(src + i * 8), b = *(const f32x4*)(src + i * 8 + 4);
        v4u o; o.x = pk2(a[0], a[1]); o.y = pk2(a[2], a[3]); o.z = pk2(b[0], b[1]); o.w = pk2(b[2], b[3]);
        *(v4u*)(dst + i * 8) = o;
    }
}
__device__ __forceinline__ void cvt_stream8(const float* src, unsigned char* dst, size_t n16, size_t gtid, size_t ngt, float scale) {
    for (size_t i = gtid; i < n16; i += ngt) {
        v4u o;
#pragma unroll
        for (int q = 0; q < 4; ++q) { f32x4 a = *(const f32x4*)(src + i * 16 + 4 * q) * scale;
#pragma unroll
            for (int e = 0; e < 4; ++e) a[e] = fminf(fmaxf(a[e], -448.f), 448.f);
            int w = 0; w = __builtin_amdgcn_cvt_pk_fp8_f32(a[0], a[1], w, false); w = __builtin_amdgcn_cvt_pk_fp8_f32(a[2], a[3], w, true); o[q] = (unsigned)w; }
        const size_t e = i >> 7, r = i & 127, sl = r >> 3, c8 = r & 7;
        *(v4u*)(dst + ((sl * 16384 + e) * 128 + c8 * 16)) = o;
    }
}
#define XB_TMO      128
#define XB_XCNT(j)  (256  + 64 * (j))
#define XB_XSUB(j)  (1280 + 64 * (j))
#define XB_XGEN(j)  (2304 + 64 * (j))
#define XB_TOP      3328
#define XB_TOPGEN   3392
#define XCD_BAR_WORDS 3456
#define XB_SPIN_CAP (1u << 18)

__device__ __forceinline__ unsigned xb_ld(unsigned* p)              { return __hip_atomic_load(p, __ATOMIC_RELAXED, __HIP_MEMORY_SCOPE_AGENT); }
__device__ __forceinline__ unsigned xb_add(unsigned* p, unsigned v) { return __hip_atomic_fetch_add(p, v, __ATOMIC_RELAXED, __HIP_MEMORY_SCOPE_AGENT); }
__device__ __forceinline__ unsigned xb_xcc_id() { return (unsigned)__builtin_amdgcn_s_getreg((3 << 11) | 20) & 0xFu; }
#define XB_SPIN(cond, bar) do { unsigned _sp = 0; while (cond) { __builtin_amdgcn_s_sleep(1); \
    if ((++_sp & 255u) == 0u) { if (xb_ld(&(bar)[XB_TMO])) break; if (_sp > XB_SPIN_CAP) { atomicAdd(&(bar)[XB_TMO], 1u); break; } } } } while (0)

struct XcdBarrier {
    unsigned* bar; unsigned x;
    volatile LAS unsigned* st;
};

__device__ __forceinline__ XcdBarrier xcd_barrier_post(unsigned* bar, volatile LAS unsigned* st) {
    XcdBarrier b; b.bar = bar; b.x = xb_xcc_id(); b.st = st;
    if (threadIdx.x == 0) (void)xb_add(&bar[XB_XCNT(b.x)], 1u);
    return b;
}
__device__ __forceinline__ void xcd_barrier_complete(unsigned* bar, unsigned x, unsigned& nloc, unsigned& nx) {
    const unsigned G = gridDim.x * gridDim.y * gridDim.z;
    unsigned sum, cnt, mine, sp = 0u;
    for (;;) {
        sum = 0u; cnt = 0u; mine = 0u;
#pragma unroll
        for (unsigned j = 0; j < 16; ++j) { const unsigned c = xb_ld(&bar[XB_XCNT(j)]); sum += c; cnt += (c > 0u) ? 1u : 0u; mine = (j == x) ? c : mine; }
        if (sum == G) break;
        __builtin_amdgcn_s_sleep(1);
        if ((++sp & 255u) == 0u) { if (xb_ld(&bar[XB_TMO])) break; if (sp > XB_SPIN_CAP) { atomicAdd(&bar[XB_TMO], 1u); break; } }
    }
    nloc = mine > 0u ? mine : 1u; nx = cnt > 0u ? cnt : 1u;
}

__device__ __forceinline__ void xcd_barrier(const XcdBarrier& b) {
    asm volatile("s_waitcnt vmcnt(0)" ::: "memory");
    __syncthreads();
    if (threadIdx.x == 0) {
        unsigned* bar = b.bar;
        __builtin_amdgcn_s_waitcnt(0);
        unsigned nloc = b.st[0], nx = b.st[1];
        if (nloc == 0u) { xcd_barrier_complete(bar, b.x, nloc, nx); b.st[0] = nloc; b.st[1] = nx; }
        const unsigned old = xb_add(&bar[XB_XSUB(b.x)], 1u);
        const unsigned gen = old / nloc;
        if (old + 1u == (gen + 1u) * nloc) {
            __builtin_amdgcn_fence(__ATOMIC_RELEASE, "agent");
            asm volatile("s_waitcnt vmcnt(0)" ::: "memory");
            const unsigned og = xb_add(&bar[XB_TOP], 1u);
            const unsigned tg = og / nx;
            if (og + 1u == (tg + 1u) * nx) xb_add(&bar[XB_TOPGEN], 1u);
            else XB_SPIN(xb_ld(&bar[XB_TOPGEN]) == tg, bar);
            __builtin_amdgcn_fence(__ATOMIC_ACQUIRE, "agent");
            xb_add(&bar[XB_XGEN(b.x)], 1u);
            asm volatile("s_waitcnt vmcnt(0)" ::: "memory");
        } else {
            XB_SPIN(xb_ld(&bar[XB_XGEN(b.x)]) == gen, bar);
            __builtin_amdgcn_fence(__ATOMIC_ACQUIRE, "agent");
            asm volatile("s_waitcnt vmcnt(0)" ::: "memory");
        }
    }
    __syncthreads();
}
#define U_SCALE 1024.f
#define V_SCALE 256.f
typedef float f32x16 __attribute__((ext_vector_type(16)));
#ifndef TKB
#define TKB 2
#endif
typedef short s16x8 __attribute__((ext_vector_type(8)));
typedef __bf16 bf16x2_t __attribute__((ext_vector_type(2)));
__device__ __forceinline__ unsigned ordf(float f) { const unsigned u = __float_as_uint(f); return (u & 0x80000000u) ? ~u : (u | 0x80000000u); }
__device__ __forceinline__ float unordf(unsigned u) { return __uint_as_float((u & 0x80000000u) ? (u & 0x7fffffffu) : ~u); }
__device__ __forceinline__ unsigned umax_(unsigned a, unsigned b) { return a > b ? a : b; }
#define DPPU(v, ctrl) ((unsigned)__builtin_amdgcn_update_dpp(0, (int)(v), (ctrl), 0xf, 0xf, true))
#define DPPF(v, ctrl) __int_as_float(__builtin_amdgcn_update_dpp(0, __float_as_int(v), (ctrl), 0xf, 0xf, true))
__device__ __forceinline__ unsigned max32(unsigned v) {
    v = umax_(v, DPPU(v, 0xB1)); v = umax_(v, DPPU(v, 0x4E)); v = umax_(v, DPPU(v, 0x141)); v = umax_(v, DPPU(v, 0x140));
    const auto r = __builtin_amdgcn_permlane16_swap(v, v, false, false);
    return umax_(r[0], r[1]);
}
__device__ __forceinline__ float sum16(float v) {
    v += DPPF(v, 0xB1); v += DPPF(v, 0x4E); v += DPPF(v, 0x141); v += DPPF(v, 0x140); return v;
}
__device__ __forceinline__ unsigned bperm(unsigned v, int srclane) { return (unsigned)__builtin_amdgcn_ds_bpermute(srclane << 2, (int)v); }
#define CMPX(a_, b_) do { const unsigned hi_ = umax_(a_, b_), lo_ = (a_ < b_) ? a_ : b_; a_ = hi_; b_ = lo_; } while (0)
__device__ __forceinline__ unsigned max16(unsigned v) { v = umax_(v, DPPU(v, 0xB1)); v = umax_(v, DPPU(v, 0x4E)); v = umax_(v, DPPU(v, 0x141)); v = umax_(v, DPPU(v, 0x140)); return v; }
__device__ __forceinline__ unsigned top16_of8(unsigned (&p)[8], int c) {
    CMPX(p[0], p[1]); CMPX(p[2], p[3]); CMPX(p[4], p[5]); CMPX(p[6], p[7]);
    CMPX(p[0], p[2]); CMPX(p[1], p[3]); CMPX(p[4], p[6]); CMPX(p[5], p[7]);
    CMPX(p[1], p[2]); CMPX(p[5], p[6]); CMPX(p[0], p[4]); CMPX(p[3], p[7]);
    CMPX(p[1], p[5]); CMPX(p[2], p[6]);
    CMPX(p[1], p[4]); CMPX(p[3], p[6]);
    CMPX(p[2], p[4]); CMPX(p[3], p[5]);
    CMPX(p[3], p[4]);
    unsigned W = 0u;
    for (int it = 0; it < 16; ++it) {
        const unsigned m = max16(p[0]);
        W = (c == it) ? m : W;
        const bool win = (p[0] == m);
#pragma unroll
        for (int i = 0; i < 7; ++i) p[i] = win ? p[i + 1] : p[i];
        p[7] = win ? 0u : p[7];
    }
    return W;
}
__device__ __forceinline__ unsigned top16_of4r(unsigned (&p)[4], int c) {
    CMPX(p[0], p[1]); CMPX(p[2], p[3]); CMPX(p[0], p[2]); CMPX(p[1], p[3]); CMPX(p[1], p[2]);
    unsigned W = 0u;
    for (int it = 0; it < 16; ++it) {
        const unsigned m = max16(p[0]);
        W = (c == it) ? m : W;
        const bool win = (p[0] == m);
        p[0] = win ? p[1] : p[0]; p[1] = win ? p[2] : p[1]; p[2] = win ? p[3] : p[2]; p[3] = win ? 0u : p[3];
    }
    return W;
}
__device__ __forceinline__ void topk_fill(LAS unsigned char* lds, const bf16* keys, int h, int tid) {
#pragma unroll
    for (int i = 0; i < 8; ++i) { const int idx = tid + 512 * i, p = idx >> 11, key = (idx >> 4) & 127, ch = idx & 15;
        const v4u v = *(const v4u*)(keys + (size_t)((h * 2 + p) * 128 + key) * 128 + ch * 8);
        *(LAS v4u*)(lds + p * 32768 + key * 256 + ((ch ^ (key & 15)) << 4)) = v; }
}
struct CvtCtx { const float* srcU; long dsrc; const float* gain; unsigned char* dstU; long ddst; float* su; long dsc; int gwave, nw; };
__device__ __forceinline__ void cvt_chunk_load(const CvtCtx& cx, int c, int lane, f32x4 (&v)[4]) {
    const int r = c >> 1, hh = c & 1;
    const float* src = cx.srcU + ((r < 16384) ? 0L : cx.dsrc) + (size_t)(r & 16383) * 2048 + hh * 1024 + 4 * lane;
#pragma unroll
    for (int j = 0; j < 4; ++j) v[j] = *(const f32x4*)(src + 256 * j);
}
__device__ __forceinline__ void cvt_chunk_store(const CvtCtx& cx, int c, int lane, f32x4 (&v)[4]) {
    const int r = c >> 1, hh = c & 1; const bool isu = r < 16384; const int e = r & 16383;
    float mx = 0.f;
#pragma unroll
    for (int j = 0; j < 4; ++j) { if (isu) v[j] = v[j] * *(const f32x4*)(cx.gain + hh * 1024 + 256 * j + 4 * lane);
        mx = fmaxf(mx, fmaxf(fmaxf(fabsf(v[j][0]), fabsf(v[j][1])), fmaxf(fabsf(v[j][2]), fabsf(v[j][3])))); }
    mx = fmaxf(mx, DPPF(mx, 0xB1)); mx = fmaxf(mx, DPPF(mx, 0x4E)); mx = fmaxf(mx, DPPF(mx, 0x141)); mx = fmaxf(mx, DPPF(mx, 0x140));
    { const auto rr = __builtin_amdgcn_permlane16_swap(__float_as_uint(mx), __float_as_uint(mx), false, false); mx = fmaxf(__uint_as_float(rr[0]), __uint_as_float(rr[1])); }
    { const auto rr = __builtin_amdgcn_permlane32_swap(__float_as_uint(mx), __float_as_uint(mx), false, false); mx = fmaxf(__uint_as_float(rr[0]), __uint_as_float(rr[1])); }
    const float sc = fmaxf(mx, 1e-30f) * (1.f / 6.f), inv = 1.f / sc;
    if (lane == 0) (cx.su + (isu ? 0L : cx.dsc))[e * 2 + hh] = sc;
    unsigned char* dst = cx.dstU + (isu ? 0L : cx.ddst) + ((size_t)(hh * 4) * 16384 + e) * 128 + 2 * lane;
#pragma unroll
    for (int j = 0; j < 4; ++j) { unsigned w = 0u;
        w = __builtin_amdgcn_cvt_scalef32_pk_fp4_f32(w, v[j][0] * inv, v[j][1] * inv, 1.0f, 0); w = __builtin_amdgcn_cvt_scalef32_pk_fp4_f32(w, v[j][2] * inv, v[j][3] * inv, 1.0f, 1);
        *(unsigned short*)(dst + (size_t)j * (16384 * 128)) = (unsigned short)w; }
}
__device__ __forceinline__ void topk_unit(const bf16* q, LAS const unsigned char* lds, int* EI, float* GW, int t0, int h, int lane, const CvtCtx& cx, int slot0) {
    const int c = lane & 15, g4 = lane >> 4, rbase = lane & 48;
    int f0 = 0, f1 = 0, f2 = 0, f3 = 0;
    { int cnt = 0;
#pragma unroll
      for (int i = 0; i < 16; ++i)
#pragma unroll
        for (int j = 0; j < 16; ++j) if ((i + 1) * (j + 1) <= 16) { const int fl = i * 16 + j; f0 = (cnt == c) ? fl : f0; f1 = (cnt == c + 16) ? fl : f1; f2 = (cnt == c + 32) ? fl : f2; f3 = (cnt == c + 48) ? fl : f3; ++cnt; } }
    unsigned W[2][8];
#pragma unroll
    for (int p = 0; p < 2; ++p) {
        f32x4 acc[2][8];
#pragma unroll
        for (int mb = 0; mb < 2; ++mb)
#pragma unroll
            for (int kb = 0; kb < 8; ++kb) acc[mb][kb] = (f32x4){0.f, 0.f, 0.f, 0.f};
        const bf16* qp = q + (size_t)(t0 + c) * 2048 + h * 256 + p * 128 + g4 * 8;
        LAS const unsigned char* kp = lds + p * 32768 + c * 256;
        asm volatile("" : "+v"(qp));
#pragma unroll 2
        for (int ks = 0; ks < 4; ++ks) {
            const s16x8 a0 = *(const s16x8*)(qp + ks * 32), a1 = *(const s16x8*)(qp + (size_t)16 * 2048 + ks * 32);
#pragma unroll
            for (int kb = 0; kb < 8; ++kb) { const s16x8 b = *(LAS const s16x8*)(kp + kb * 4096 + (((4 * ks + g4) ^ c) << 4));
                acc[0][kb] = __builtin_amdgcn_mfma_f32_16x16x32_bf16(a0, b, acc[0][kb], 0, 0, 0); acc[1][kb] = __builtin_amdgcn_mfma_f32_16x16x32_bf16(a1, b, acc[1][kb], 0, 0, 0); }
        }
#pragma unroll
        for (int pb = 0; pb < 8; ++pb) {
            unsigned pk[8];
#pragma unroll
            for (int kb = 0; kb < 8; ++kb) pk[kb] = (ordf(acc[pb >> 2][kb][pb & 3]) & ~127u) | (unsigned)(127 - 16 * kb - c);
            const int cc = (slot0 + p * 8 + pb) * cx.nw + cx.gwave;
            f32x4 cr[4];
            asm volatile("" ::: "memory");
            if (cc < 65536) cvt_chunk_load(cx, cc, lane, cr);
            W[p][pb] = top16_of8(pk, c);
            if (cc < 65536) cvt_chunk_store(cx, cc, lane, cr);
            asm volatile("" ::: "memory");
        }
    }
#pragma unroll
    for (int pb = 0; pb < 8; ++pb) {
        const unsigned w0 = W[0][pb], w1 = W[1][pb];
        unsigned cp[4];
        { const float a0 = unordf(bperm(w0, rbase + (f0 >> 4)) & ~127u), b0 = unordf(bperm(w1, rbase + (f0 & 15)) & ~127u); cp[0] = (ordf(a0 + b0) & ~63u) | (unsigned)(63 - c); }
        { const float a0 = unordf(bperm(w0, rbase + (f1 >> 4)) & ~127u), b0 = unordf(bperm(w1, rbase + (f1 & 15)) & ~127u); cp[1] = (ordf(a0 + b0) & ~63u) | (unsigned)(47 - c); }
        { const float a0 = unordf(bperm(w0, rbase + (f2 >> 4)) & ~127u), b0 = unordf(bperm(w1, rbase + (f2 & 15)) & ~127u); cp[2] = (ordf(a0 + b0) & ~63u) | (unsigned)(31 - c); }
        { const float a0 = unordf(bperm(w0, rbase + (f3 >> 4)) & ~127u), b0 = unordf(bperm(w1, rbase + (f3 & 15)) & ~127u); cp[3] = (c + 48 < 50) ? ((ordf(a0 + b0) & ~63u) | (unsigned)(15 - c)) : 0u; }
        const unsigned Wc = top16_of4r(cp, c);
        const int slot = 63 - (int)(Wc & 63u);
        const unsigned fa = bperm((unsigned)f0, rbase + (slot & 15)), fb = bperm((unsigned)f1, rbase + (slot & 15)), fc = bperm((unsigned)f2, rbase + (slot & 15)), fd = bperm((unsigned)f3, rbase + (slot & 15));
        const int sq = slot >> 4; const int flat = (int)((sq == 0) ? fa : (sq == 1) ? fb : (sq == 2) ? fc : fd);
        const float val = unordf(Wc & ~63u);
        const float vmax = __uint_as_float(bperm(__float_as_uint(val), rbase));
        const float e = __expf(val - vmax);
        const float g = e / sum16(e);
        const int k1 = 127 - (int)(bperm(w0, rbase + (flat >> 4)) & 127u), k2 = 127 - (int)(bperm(w1, rbase + (flat & 15)) & 127u);
        const int tok = t0 + 16 * (pb >> 2) + 4 * g4 + (pb & 3);
        EI[(size_t)(tok * 8 + h) * 16 + c] = k1 * 128 + k2; GW[(size_t)(tok * 8 + h) * 16 + c] = g;
    }
}

__device__ __forceinline__ float gelu_tanh_f(float x) {
    const float u = 0.7978845608028654f * (x + 0.044715f * x * x * x);
    const float e = __expf(2.f * u);
    const float th = 1.f - 2.f / (e + 1.f);
    return 0.5f * x * (1.f + th);
}
__device__ __forceinline__ float wave_sum_bfly(float v) {
#pragma unroll
    for (int o = 1; o < 64; o <<= 1) v += __shfl_xor(v, o);
    return v;
}
typedef float f32x2_ __attribute__((ext_vector_type(2)));
#define FP4_DEC(w_, sel_) __builtin_amdgcn_cvt_scalef32_pk_f32_fp4((unsigned)(w_), 1.0f, (sel_))
template <int NBT>
__device__ __forceinline__ void peer_a_slice(const bf16* xb, const int* EI, const unsigned char* U4s, float* pd, int s, int t0, int tstride, int ntok, int lane) {
    const int eg = lane >> 3, c8 = lane & 7;
    const unsigned char* tab = U4s + (size_t)s * (16384 * 128) + c8 * 16;
    const int tlast = t0 + (ntok - 1) * tstride;
#define A_TOK(k_) (((t0 + (k_) * tstride) < tlast) ? (t0 + (k_) * tstride) : tlast)
#define A_XS(XS, t_) do { const bf16* xp_ = xb + (size_t)(t_) * 2048 + s * 256 + c8 * 32; _Pragma("unroll") for (int q = 0; q < 4; ++q) XS[q] = *(const v4u*)(xp_ + 8 * q); } while (0)
#define A_ISSUE(U, EV) do { _Pragma("unroll") for (int i = 0; i < 8; ++i) { const int e_ = (int)bperm((unsigned)(EV), (i << 3) + eg); U[i] = *(const v4u*)(tab + (size_t)e_ * 128); } } while (0)
#define A_COMPUTE(U, OUT) do { OUT = 0.f; \
        _Pragma("unroll") for (int i = 0; i < 8; ++i) { f32x2_ d2 = (f32x2_){0.f, 0.f}; \
            _Pragma("unroll") for (int q = 0; q < 4; ++q) { const unsigned w_ = U[i][q]; \
                d2 = __builtin_elementwise_fma(FP4_DEC(w_, 0), h2[4 * q + 0], d2); d2 = __builtin_elementwise_fma(FP4_DEC(w_, 1), h2[4 * q + 1], d2); \
                d2 = __builtin_elementwise_fma(FP4_DEC(w_, 2), h2[4 * q + 2], d2); d2 = __builtin_elementwise_fma(FP4_DEC(w_, 3), h2[4 * q + 3], d2); } \
            float d = d2.x + d2.y; d += DPPF(d, 0xB1); d += DPPF(d, 0x4E); d += DPPF(d, 0x141); \
            OUT = (c8 == i) ? d : OUT; } } while (0)
    int eL[NBT], eH[NBT], nL[NBT], nH[NBT]; v4u xs[2][4]; v4u UA[8], UB[8];
#pragma unroll
    for (int j = 0; j < NBT; ++j) { const int tj = A_TOK(j); eL[j] = EI[(size_t)tj * 128 + lane]; eH[j] = EI[(size_t)tj * 128 + 64 + lane]; }
    A_XS(xs[0], A_TOK(0));
    A_ISSUE(UA, eL[0]);
    for (int kb = 0; kb < ntok; kb += NBT) {
#pragma unroll
        for (int j = 0; j < NBT; ++j) { const int tj = A_TOK(kb + NBT + j); nL[j] = EI[(size_t)tj * 128 + lane]; nH[j] = EI[(size_t)tj * 128 + 64 + lane]; }
#pragma unroll
        for (int j = 0; j < NBT; ++j) {
            const int t = t0 + (kb + j) * tstride;
            A_ISSUE(UB, eH[j]);
            f32x2_ h2[16];
#pragma unroll
            for (int q = 0; q < 4; ++q)
#pragma unroll
                for (int c = 0; c < 4; ++c) { const unsigned w = xs[j & 1][q][c]; h2[4 * q + c] = (f32x2_){__uint_as_float(w << 16), __uint_as_float(w & 0xffff0000u)}; }
            float out_lo, out_hi;
            A_COMPUTE(UA, out_lo);
            A_XS(xs[(j + 1) & 1], A_TOK(kb + j + 1));
            A_ISSUE(UA, (j + 1 < NBT) ? eL[(j + 1) % NBT] : nL[0]);
            A_COMPUTE(UB, out_hi);
            float* pp = pd + ((size_t)s * T + t) * 128; pp[lane] = out_lo; pp[64 + lane] = out_hi;
        }
#pragma unroll
        for (int j = 0; j < NBT; ++j) { eL[j] = nL[j]; eH[j] = nH[j]; }
    }
#undef A_TOK
#undef A_XS
#undef A_ISSUE
#undef A_COMPUTE
}
__device__ __forceinline__ void peer_a2_token(const float* pd, const float* ssq, const int* EI, const float* su, const float* sv, float* GW, float* W1, int t, int lane) {
    float a0 = 0.f, a1 = 0.f, b0 = 0.f, b1 = 0.f;
#pragma unroll
    for (int s = 0; s < 4; ++s) { const float* pp = pd + ((size_t)s * T + t) * 128; a0 += pp[lane]; a1 += pp[64 + lane]; }
#pragma unroll
    for (int s = 4; s < 8; ++s) { const float* pp = pd + ((size_t)s * T + t) * 128; b0 += pp[lane]; b1 += pp[64 + lane]; }
    const float rs = rsqrtf(ssq[t] * (1.f / 2048.f) + EPS);
    float* gp = GW + (size_t)t * 128; float* hp = W1 + (size_t)t * 128; const int pl = ((lane & 7) << 3) + (lane >> 3);
    const int e0 = EI[(size_t)t * 128 + pl], e1 = EI[(size_t)t * 128 + 64 + pl];
    const float g0 = gp[pl] * gelu_tanh_f(rs * (a0 * su[2 * e0] + b0 * su[2 * e0 + 1])), g1 = gp[64 + pl] * gelu_tanh_f(rs * (a1 * su[2 * e1] + b1 * su[2 * e1 + 1]));
    gp[pl] = g0 * sv[2 * e0]; hp[pl] = g0 * sv[2 * e0 + 1];
    gp[64 + pl] = g1 * sv[2 * e1]; hp[64 + pl] = g1 * sv[2 * e1 + 1];
}
template <int NBT>
__device__ __forceinline__ void peer_b_slice(float* xio, const int* EI, const float* W, const unsigned char* V4s, bf16* xb, float* ssq_out, int s, int t0, int tstride, int ntok, int lane) {
    const int eg = lane >> 3, c8 = lane & 7;
    const unsigned char* tab = V4s + (size_t)s * (16384 * 128) + c8 * 16;
    const int tlast = t0 + (ntok - 1) * tstride;
    const int eoff = s * 256 + c8 * 32 + 4 * eg;
#define B_TOK(k_) (((t0 + (k_) * tstride) < tlast) ? (t0 + (k_) * tstride) : tlast)
#define B_ISSUE(V, WK, EV, WV) do { _Pragma("unroll") for (int i = 0; i < 8; ++i) { const int src_ = (i << 3) + eg; const int e_ = (int)bperm((unsigned)(EV), src_); \
        WK[i] = __uint_as_float(bperm(__float_as_uint(WV), src_)); V[i] = *(const v4u*)(tab + (size_t)e_ * 128); } } while (0)
#define B_COMPUTE(V, WK) do { _Pragma("unroll") for (int i = 0; i < 8; ++i) { const f32x2_ wk2 = (f32x2_){WK[i], WK[i]}; \
            _Pragma("unroll") for (int q = 0; q < 4; ++q) { const unsigned wv_ = V[i][q]; \
                acc[4 * q + 0] = __builtin_elementwise_fma(FP4_DEC(wv_, 0), wk2, acc[4 * q + 0]); acc[4 * q + 1] = __builtin_elementwise_fma(FP4_DEC(wv_, 1), wk2, acc[4 * q + 1]); \
                acc[4 * q + 2] = __builtin_elementwise_fma(FP4_DEC(wv_, 2), wk2, acc[4 * q + 2]); acc[4 * q + 3] = __builtin_elementwise_fma(FP4_DEC(wv_, 3), wk2, acc[4 * q + 3]); } } } while (0)
    int eL[NBT], eH[NBT], nL[NBT], nH[NBT]; float wL[NBT], wH[NBT], mL[NBT], mH[NBT]; f32x4 xv; v4u VA[8], VB[8]; float KA[8], KB[8];
#pragma unroll
    for (int j = 0; j < NBT; ++j) { const int tj = B_TOK(j); eL[j] = EI[(size_t)tj * 128 + lane]; eH[j] = EI[(size_t)tj * 128 + 64 + lane]; wL[j] = W[(size_t)tj * 128 + lane]; wH[j] = W[(size_t)tj * 128 + 64 + lane]; }
    B_ISSUE(VA, KA, eL[0], wL[0]);
    for (int kb = 0; kb < ntok; kb += NBT) {
#pragma unroll
        for (int j = 0; j < NBT; ++j) { const int tj = B_TOK(kb + NBT + j); nL[j] = EI[(size_t)tj * 128 + lane]; nH[j] = EI[(size_t)tj * 128 + 64 + lane]; mL[j] = W[(size_t)tj * 128 + lane]; mH[j] = W[(size_t)tj * 128 + 64 + lane]; }
#pragma unroll
        for (int j = 0; j < NBT; ++j) {
            const int t = t0 + (kb + j) * tstride;
            xv = *(const f32x4*)(xio + (size_t)t * 2048 + eoff);
            B_ISSUE(VB, KB, eH[j], wH[j]);
            f32x2_ acc[16];
#pragma unroll
            for (int jj = 0; jj < 16; ++jj) acc[jj] = (f32x2_){0.f, 0.f};
            B_COMPUTE(VA, KA);
            B_ISSUE(VA, KA, (j + 1 < NBT) ? eL[(j + 1) % NBT] : nL[0], (j + 1 < NBT) ? wL[(j + 1) % NBT] : mL[0]);
            B_COMPUTE(VB, KB);
            float r16[16], r8[8], r4[4];
#pragma unroll
            for (int i = 0; i < 16; ++i) { const float lo_ = (i & 1) ? acc[i >> 1].y : acc[i >> 1].x, hi_ = (i & 1) ? acc[8 + (i >> 1)].y : acc[8 + (i >> 1)].x;
                const auto r = __builtin_amdgcn_permlane32_swap(__float_as_uint(lo_), __float_as_uint(hi_), false, false); r16[i] = __uint_as_float(r[0]) + __uint_as_float(r[1]); }
#pragma unroll
            for (int i = 0; i < 8; ++i) { const auto r = __builtin_amdgcn_permlane16_swap(__float_as_uint(r16[i]), __float_as_uint(r16[8 + i]), false, false); r8[i] = __uint_as_float(r[0]) + __uint_as_float(r[1]); }
            const bool b3 = (lane & 8) != 0;
#pragma unroll
            for (int i = 0; i < 4; ++i) { const float keep = b3 ? r8[4 + i] : r8[i], give = b3 ? r8[i] : r8[4 + i]; r4[i] = keep + DPPF(give, 0x128); }
            f32x4 o; o[0] = xv[0] + r4[0]; o[1] = xv[1] + r4[1]; o[2] = xv[2] + r4[2]; o[3] = xv[3] + r4[3];
            *(f32x4*)(xio + (size_t)t * 2048 + eoff) = o;
            if (xb) { v2u bb; bb.x = pk2(o[0], o[1]); bb.y = pk2(o[2], o[3]); *(v2u*)(xb + (size_t)t * 2048 + eoff) = bb; }
            float ss = (o[0] * o[0] + o[1] * o[1]) + (o[2] * o[2] + o[3] * o[3]);
            ss += DPPF(ss, 0xB1); ss += DPPF(ss, 0x4E); ss += DPPF(ss, 0x141); ss += DPPF(ss, 0x140);
            { const auto r = __builtin_amdgcn_permlane16_swap(__float_as_uint(ss), __float_as_uint(ss), false, false); ss = __uint_as_float(r[0]) + __uint_as_float(r[1]); }
            { const auto r = __builtin_amdgcn_permlane32_swap(__float_as_uint(ss), __float_as_uint(ss), false, false); ss = __uint_as_float(r[0]) + __uint_as_float(r[1]); }
            if (lane == 0) unsafeAtomicAdd(ssq_out + t, ss);
        }
#pragma unroll
        for (int j = 0; j < NBT; ++j) { eL[j] = nL[j]; eH[j] = nH[j]; wL[j] = mL[j]; wH[j] = mH[j]; }
    }
#undef B_TOK
#undef B_ISSUE
#undef B_COMPUTE
}
__device__ __forceinline__ void final_norm_row(float* xio, const float* ssq, const float* fin, int t, int lane, float oscale) {
    const float r2 = rsqrtf(ssq[t] * (1.f / 2048.f) + EPS) * oscale;
    float* xr = xio + (size_t)t * 2048 + 4 * lane;
#pragma unroll
    for (int j = 0; j < 8; ++j) { const f32x4 xv = *(const f32x4*)(xr + 256 * j), g = *(const f32x4*)(fin + 256 * j + 4 * lane); f32x4 o;
        o[0] = xv[0] * r2 * g[0]; o[1] = xv[1] * r2 * g[1]; o[2] = xv[2] * r2 * g[2]; o[3] = xv[3] * r2 * g[3]; *(f32x4*)(xr + 256 * j) = o; }
}
typedef short s16x4 __attribute__((ext_vector_type(4)));
__device__ __forceinline__ unsigned cvt_pk_bf16_(float lo, float hi) { unsigned r; asm volatile("v_cvt_pk_bf16_f32 %0, %1, %2" : "=v"(r) : "v"(lo), "v"(hi)); return r; }
constexpr int ATT_K_OFF = 0, ATT_V_OFF = 40960, ATT_VSTRIDE = 648, ATT_LDS = ATT_V_OFF + 64 * ATT_VSTRIDE;
__device__ __forceinline__ void attn_fill(LAS unsigned char* lds, const bf16* K, const bf16* Vt, int b, int kvh, int kw0, int tid) {
    const size_t tb = (size_t)b * 4096;
#pragma unroll
    for (int i = 0; i < 5; ++i) { const int idx = tid + 512 * i, row = idx >> 3, ch = idx & 7, key = kw0 + row;
        v4u v = (v4u){0u, 0u, 0u, 0u}; if (key >= 0 && key < 4096) v = *(const v4u*)(K + (tb + key) * 512 + kvh * 64 + ch * 8);
        *(LAS v4u*)(lds + ATT_K_OFF + row * 128 + ((ch ^ ((row >> 1) & 7)) << 4)) = v; }
#pragma unroll
    for (int i = 0; i < 10; ++i) { const int idx = tid + 512 * i, d = idx / 80, pc = idx % 80, key = kw0 + pc * 4;
        v2u v = (v2u){0u, 0u}; if (key >= 0 && key < 4096) v = *(const v2u*)(Vt + (size_t)(kvh * 64 + d) * 16384 + tb + key);
        *(LAS v2u*)(lds + ATT_V_OFF + d * ATT_VSTRIDE + pc * 8) = v; }
}
__device__ __forceinline__ void attn_task(LAS const unsigned char* lds, const bf16* Q, bf16* O, const float* sinks, int b, int hq, int q0, int kw0, int lane) {
    const int c = lane & 31, hi = lane >> 5;
    const size_t tb = (size_t)b * 4096;
    s16x8 qf[4];
    { const bf16* qp = Q + (tb + q0 + c) * 2048 + hq * 64 + hi * 8;
#pragma unroll
      for (int ks = 0; ks < 4; ++ks) qf[ks] = *(const s16x8*)(qp + ks * 16); }
    const float sink2 = sinks[hq] * 1.4426950408889634f;
    float m = sink2, l = (hi == 0) ? 1.f : 0.f;
    f32x16 o0, o1;
#pragma unroll
    for (int r = 0; r < 16; ++r) { o0[r] = 0.f; o1[r] = 0.f; }
    const int kt_lo = (q0 < 128) ? ((128 - q0) >> 5) : 0, kt_hi = ((4192 - q0) >> 5) < 8 ? ((4192 - q0) >> 5) : 8;
    for (int kt = kt_lo; kt <= kt_hi; ++kt) {
        const int key0 = q0 - 128 + 32 * kt, row0 = key0 - kw0;
        s16x8 kf[4]; s16x4 va[2][2][2];
        { const int row = row0 + c; LAS const unsigned char* kp = lds + ATT_K_OFF + row * 128; const int sw = (row >> 1) & 7;
#pragma unroll
          for (int ks = 0; ks < 4; ++ks) kf[ks] = *(LAS const s16x8*)(kp + (((2 * ks + hi) ^ sw) << 4)); }
#pragma unroll
        for (int db = 0; db < 2; ++db)
#pragma unroll
            for (int s = 0; s < 2; ++s) { LAS const unsigned char* vp = lds + ATT_V_OFF + (db * 32 + c) * ATT_VSTRIDE + (row0 + 16 * s + 4 * hi) * 2; va[db][s][0] = *(LAS const s16x4*)vp; va[db][s][1] = *(LAS const s16x4*)(vp + 16); }
        f32x16 sa;
#pragma unroll
        for (int r = 0; r < 16; ++r) sa[r] = 0.f;
#pragma unroll
        for (int ks = 0; ks < 4; ++ks) sa = __builtin_amdgcn_mfma_f32_32x32x16_bf16(kf[ks], qf[ks], sa, 0, 0, 0);
        if (kt == 0 || kt == 8) {
            const int dbase = key0 - (q0 + c) + 4 * hi;
#pragma unroll
            for (int r = 0; r < 16; ++r) { const int d = dbase + (r & 3) + 8 * (r >> 2); if (d < -128 || d > 128) sa[r] = -1e30f; }
        }
        float mx = sa[0];
#pragma unroll
        for (int r = 1; r < 16; ++r) mx = fmaxf(mx, sa[r]);
        { const auto rr = __builtin_amdgcn_permlane32_swap(__float_as_uint(mx), __float_as_uint(mx), false, false); mx = fmaxf(__uint_as_float(rr[0]), __uint_as_float(rr[1])); }
        const float mn = fmaxf(m, mx), alpha = __builtin_amdgcn_exp2f(m - mn);
        m = mn;
        float ps = 0.f;
#pragma unroll
        for (int r = 0; r < 16; ++r) { sa[r] = __builtin_amdgcn_exp2f(sa[r] - mn); ps += sa[r]; }
        l = l * alpha + ps;
#pragma unroll
        for (int r = 0; r < 16; ++r) { o0[r] *= alpha; o1[r] *= alpha; }
        s16x8 pf[2];
#pragma unroll
        for (int s = 0; s < 2; ++s) { v4u w; w.x = cvt_pk_bf16_(sa[8 * s + 0], sa[8 * s + 1]); w.y = cvt_pk_bf16_(sa[8 * s + 2], sa[8 * s + 3]); w.z = cvt_pk_bf16_(sa[8 * s + 4], sa[8 * s + 5]); w.w = cvt_pk_bf16_(sa[8 * s + 6], sa[8 * s + 7]);
            pf[s] = __builtin_bit_cast(s16x8, w); }
#pragma unroll
        for (int s = 0; s < 2; ++s) {
            const s16x8 v0 = __builtin_shufflevector(va[0][s][0], va[0][s][1], 0, 1, 2, 3, 4, 5, 6, 7), v1 = __builtin_shufflevector(va[1][s][0], va[1][s][1], 0, 1, 2, 3, 4, 5, 6, 7);
            o0 = __builtin_amdgcn_mfma_f32_32x32x16_bf16(v0, pf[s], o0, 0, 0, 0);
            o1 = __builtin_amdgcn_mfma_f32_32x32x16_bf16(v1, pf[s], o1, 0, 0, 0);
        }
    }
    { const auto rr = __builtin_amdgcn_permlane32_swap(__float_as_uint(l), __float_as_uint(l), false, false); l = __uint_as_float(rr[0]) + __uint_as_float(rr[1]); }
    const float il = 1.f / l;
    bf16* op = O + (tb + q0 + c) * 2048 + hq * 64 + 4 * hi;
#pragma unroll
    for (int g = 0; g < 4; ++g) {
        v2u w0, w1;
        w0.x = cvt_pk_bf16_(o0[4 * g + 0] * il, o0[4 * g + 1] * il); w0.y = cvt_pk_bf16_(o0[4 * g + 2] * il, o0[4 * g + 3] * il);
        w1.x = cvt_pk_bf16_(o1[4 * g + 0] * il, o1[4 * g + 1] * il); w1.y = cvt_pk_bf16_(o1[4 * g + 2] * il, o1[4 * g + 3] * il);
        *(v2u*)(op + 8 * g) = w0; *(v2u*)(op + 32 + 8 * g) = w1;
    }
}
typedef float fx2 __attribute__((ext_vector_type(2)));
__device__ __forceinline__ fx2 bf2_(unsigned w) { fx2 r; r[0] = __uint_as_float(w << 16); r[1] = __uint_as_float(w & 0xffff0000u); return r; }
__device__ __forceinline__ void fft16_item(bf16* Zp, const float* tw, int bg, int l, int s1h, int lane) {
    const int s1 = s1h * 128 + 2 * lane;
    bf16* base = Zp + ((size_t)(bg * 16) * 256 + l) * 512 + s1;
    fx2 zr[16], zi[16];
#pragma unroll
    for (int s2 = 0; s2 < 16; ++s2) { zr[s2] = bf2_(*(const unsigned*)(base + (size_t)s2 * 256 * 512)); zi[s2] = bf2_(*(const unsigned*)(base + (size_t)s2 * 256 * 512 + 256)); }
    fx2 er[16], ei[16];
#pragma unroll
    for (int d = 0; d < 4; ++d) {
        const fx2 ar = zr[d], ai_ = zi[d], br = zr[4 + d], bi = zi[4 + d], cr = zr[8 + d], ci = zi[8 + d], dr = zr[12 + d], di = zi[12 + d];
        const fx2 s0r = ar + cr, s0i = ai_ + ci, s1r = ar - cr, s1i = ai_ - ci, s2r = br + dr, s2i = bi + di, s3r = br - dr, s3i = bi - di;
        er[0 * 4 + d] = s0r + s2r; ei[0 * 4 + d] = s0i + s2i;
        er[1 * 4 + d] = s1r + s3i; ei[1 * 4 + d] = s1i - s3r;
        er[2 * 4 + d] = s0r - s2r; ei[2 * 4 + d] = s0i - s2i;
        er[3 * 4 + d] = s1r - s3i; ei[3 * 4 + d] = s1i + s3r;
    }
#pragma unroll
    for (int a = 1; a < 4; ++a)
#pragma unroll
        for (int d = 1; d < 4; ++d) {
            const float ang = 6.283185307179586f * (float)(a * d) / 16.f; const float c = __builtin_cosf(ang), sn = __builtin_sinf(ang);
            const fx2 xr = er[a * 4 + d], xi = ei[a * 4 + d];
            er[a * 4 + d] = xr * c + xi * sn; ei[a * 4 + d] = xi * c - xr * sn;
        }
#pragma unroll
    for (int a = 0; a < 4; ++a) {
        const fx2 ar = er[a * 4 + 0], ai_ = ei[a * 4 + 0], br = er[a * 4 + 1], bi = ei[a * 4 + 1], cr = er[a * 4 + 2], ci = ei[a * 4 + 2], dr = er[a * 4 + 3], di = ei[a * 4 + 3];
        const fx2 s0r = ar + cr, s0i = ai_ + ci, s1r = ar - cr, s1i = ai_ - ci, s2r = br + dr, s2i = bi + di, s3r = br - dr, s3i = bi - di;
        fx2 Dr[4], Di[4];
        Dr[0] = s0r + s2r; Di[0] = s0i + s2i; Dr[1] = s1r + s3i; Di[1] = s1i - s3r; Dr[2] = s0r - s2r; Di[2] = s0i - s2i; Dr[3] = s1r - s3i; Di[3] = s1i + s3r;
#pragma unroll
        for (int b = 0; b < 4; ++b) {
            const int k2 = a + 4 * b;
            const f32x4 t0 = *(const f32x4*)(tw + (size_t)(k2 * 256 + s1) * 2);
            const fx2 cc = (fx2){t0[0], t0[2]}, ss = (fx2){t0[1], t0[3]};
            const fx2 hr = Dr[b] * cc + Di[b] * ss, hi_ = Di[b] * cc - Dr[b] * ss;
            *(unsigned*)(base + (size_t)k2 * 256 * 512) = pk2(hr[0], hr[1]); *(unsigned*)(base + (size_t)k2 * 256 * 512 + 256) = pk2(hi_[0], hi_[1]);
        }
    }
}
#ifndef REP_PRO
#define REP_PRO 1
#endif
#ifndef REP_GEMM
#define REP_GEMM 1
#endif
#ifndef REP_ATT
#define REP_ATT 1
#endif
#ifndef REP_LITE
#define REP_LITE 0
#endif
#ifndef REP_Q
#define REP_Q 1
#endif
#ifndef REP_PA
#define REP_PA 1
#endif
#ifndef REP_TK
#define REP_TK 1
#endif
enum { PH_PRO = 0, PH_G1 = 1, PH_S1 = 2, PH_G2 = 3, PH_G3 = 4, PH_Q0 = 5, PH_TK0 = 6, PH_PA0 = 7, PH_PW0 = 8, PH_PB0 = 9, PH_QKV = 10, PH_ATT = 11, PH_WO = 12, PH_Q1 = 13, PH_TK1 = 14, PH_PA1 = 15, PH_PW1 = 16, PH_PB1 = 17, PH_FIN = 18, PH_END = 19 };
__global__ void __launch_bounds__(NWAVES * 64, 2) mega(Args a) {
    extern __shared__ __attribute__((aligned(16))) unsigned char lds_raw[];
    LAS unsigned char* lds = (LAS unsigned char*)lds_raw;
    cg::grid_group grid = cg::this_grid();
    const int wave = __builtin_amdgcn_readfirstlane(threadIdx.x >> 6);
#define FRESH_IDS() int lane; asm volatile("v_mbcnt_lo_u32_b32 %0, -1, 0\n\tv_mbcnt_hi_u32_b32 %0, -1, %0" : "=v"(lane)); const int tid = wave * 64 + lane; (void)tid
    const int G = gridDim.x, bx = blockIdx.x;
    unsigned char* ws = a.ws;
    const int lo = a.ph_lo, hi = a.ph_hi;
    volatile LAS unsigned* MISC = (volatile LAS unsigned*)(lds + LDSCTL_OFF);
    if (threadIdx.x < 16) MISC[threadIdx.x] = 0u;
    __syncthreads();
    XcdBarrier xbar = xcd_barrier_post((unsigned*)(ws + WS_CTL) + CW_BAR, MISC + 8);
#define IN(k) (lo <= (k) && (k) < hi)
#ifdef DIAG_A
#define STAMP(i) do { if (bx == 0 && threadIdx.x == 0) ((unsigned long long*)(ws + WS_STAMP))[i] = __builtin_amdgcn_s_memrealtime(); } while (0)
#else
#define STAMP(i) do { } while (0)
#endif
#define SEAM(k) do { if (IN(k) && IN((k) + 1)) { if ((k) == PH_PRO) grid.sync(); else xcd_barrier(xbar); } STAMP((k) + 1); } while (0)
    STAMP(0);
    for (int rep_ = 0; rep_ < REP_PRO; ++rep_)
    if (IN(PH_PRO)) { FRESH_IDS();
        const int gw = bx * NWAVES + wave, NGW = G * NWAVES;
        const size_t gtid = (size_t)bx * (NWAVES * 64) + tid, ngt = (size_t)G * NWAVES * 64;
        LAS float* scr = (LAS float*)(lds + wave * 16384);
        {
            constexpr int I_SQ = (DM / 64) * (DM / 32), I_QKV = (DM / 64) * (QKVW / 32);
            constexpr int NITEMS = 4 * I_SQ + I_QKV;
            for (int it = gw; it < NITEMS; it += NGW) {
                int r = it;
                if (r < I_SQ) { transpose_item<0>(a.in[3], DM, DM, nullptr, (bf16*)(ws + WS_WOF), scr, r, lane); continue; } r -= I_SQ;
                if (r < I_SQ) { transpose_item<0>(a.in[5], DM, DM, nullptr, (bf16*)(ws + WS_WOA), scr, r, lane); continue; } r -= I_SQ;
                if (r < I_SQ) { transpose_item<0>(a.in[7], DM, DM, a.in[2], (bf16*)(ws + WS_WQ0), scr, r, lane); continue; } r -= I_SQ;
                if (r < I_SQ) { transpose_item<0>(a.in[7] + (size_t)DM * DM, DM, DM, a.in[2] + DM, (bf16*)(ws + WS_WQ1), scr, r, lane); continue; } r -= I_SQ;
                transpose_item<1>(a.in[4], DM, QKVW, a.in[1] + DM, (bf16*)(ws + WS_WQKV), scr, r, lane);
            }
        }
        for (int row = gw; row < T; row += NGW) {
            const f32x4* xr = (const f32x4*)(a.in[0] + (size_t)row * DM) + lane;
            const f32x4* gr = (const f32x4*)a.in[1] + lane;
            f32x4 v[8]; float s = 0.f;
#pragma unroll
            for (int j = 0; j < 8; ++j) { v[j] = xr[64 * j]; s += (v[j][0] * v[j][0] + v[j][1] * v[j][1]) + (v[j][2] * v[j][2] + v[j][3] * v[j][3]); }
            const float r = rsqrtf(wsum(s) * (1.f / DM) + EPS);
            const int b = row >> 12, sp = row & 4095;
#pragma unroll
            for (int j = 0; j < 8; ++j) { const f32x4 gg = gr[64 * j]; v2u o; o.x = pk2(v[j][0] * r * gg[0], v[j][1] * r * gg[1]); o.y = pk2(v[j][2] * r * gg[2], v[j][3] * r * gg[3]);
                *(v2u*)((bf16*)(ws + WS_XG) + ((size_t)((b * 8 + j) * 4096 + sp) * 256 + 4 * lane)) = o; }
        }
        for (size_t i = gtid; i < (size_t)256 * 512 / 8; i += ngt) {
            const int k1 = (int)(i >> 6), c0 = (int)(i & 63) * 8, part = c0 >> 8, s0 = c0 & 255;
            float v[8];
#pragma unroll
            for (int e = 0; e < 8; ++e) { const int m = (k1 * (s0 + e)) & 255; const float rev = (float)m * (1.f / 256.f); v[e] = (part ? __builtin_amdgcn_sinf(rev) : __builtin_amdgcn_cosf(rev)) * (1.f / 64.f); }
            v4u o; o.x = pk2(v[0], v[1]); o.y = pk2(v[2], v[3]); o.z = pk2(v[4], v[5]); o.w = pk2(v[6], v[7]);
            *(v4u*)((bf16*)(ws + WS_A2) + i * 8) = o;
        }
        for (size_t i = gtid; i < (size_t)16 * 256; i += ngt) {
            const int k2 = (int)(i >> 8), s1 = (int)(i & 255); const float rev = (float)(k2 * s1) * (1.f / 4096.f);
            ((float*)(ws + WS_TW))[2 * i] = __builtin_amdgcn_cosf(rev); ((float*)(ws + WS_TW))[2 * i + 1] = __builtin_amdgcn_sinf(rev);
        }
        for (size_t i = gtid; i < (size_t)512 * 256 / 8; i += ngt) {
            const int n = (int)(i >> 5), c0 = (int)(i & 31) * 8, part = n >> 8, l = n & 255;
            float v[8];
#pragma unroll
            for (int e = 0; e < 8; ++e) { const int m = (l * (c0 + e)) & 255; const float rev = (float)m * (1.f / 256.f); v[e] = (part ? -__builtin_amdgcn_sinf(rev) : __builtin_amdgcn_cosf(rev)) * (1.f / 16.f); }
            v4u o; o.x = pk2(v[0], v[1]); o.y = pk2(v[2], v[3]); o.z = pk2(v[4], v[5]); o.w = pk2(v[6], v[7]);
            *(v4u*)((bf16*)(ws + WS_WCS) + i * 8) = o;
        }
        for (size_t i = gtid; i < (size_t)4096 * 32; i += ngt) {
            const int pos = (int)(i >> 5), fi = (int)(i & 31);
            const double inv = exp2(-(double)fi * (13.287712379549449 / 32.0));
            double sn, cs; sincos((double)pos * inv, &sn, &cs);
            ((float*)(ws + WS_ROPE))[2 * i] = (float)cs; ((float*)(ws + WS_ROPE))[2 * i + 1] = (float)sn;
        }
        cvt_stream(a.in[8], (bf16*)(ws + WS_KEYS), (size_t)2 * PH * 2 * 128 * 128 / 8, gtid, ngt);
    }
    SEAM(PH_PRO);
    for (int rep_ = 0; rep_ < REP_GEMM; ++rep_)
    if (IN(PH_G1)) { FRESH_IDS();
        int Kq = FW; asm volatile("" : "+s"(Kq));
        pg8::Gemm g{(const pg8::bf16_t*)(ws + WS_WCS), (const pg8::bf16_t*)(ws + WS_XG), 512, T * FG, Kq}; pg8::StaticOrder S; S.init(512, T * FG, G, bx);
        pg8::EpiZt E{(pg8::bf16_t*)(ws + WS_ZT)};
        pg8::gemm_phase<pg8::EpiZt, pg8::StaticOrder, true, true>(lds, g, S, E);
    }
    SEAM(PH_G1);
    if (IN(PH_S1)) { FRESH_IDS();
        const int gw = bx * NWAVES + wave, NGW = G * NWAVES;
        for (int it = gw; it < 32 * 256 * 2; it += NGW) fft16_item((bf16*)(ws + WS_ZT), (const float*)(ws + WS_TW), it >> 9, (it >> 1) & 255, it & 1, lane);
    }
    SEAM(PH_S1);
    for (int rep_ = 0; rep_ < REP_GEMM; ++rep_)
    if (IN(PH_G2)) { FRESH_IDS();
        pg8::Gemm g{(const pg8::bf16_t*)(ws + WS_A2), (const pg8::bf16_t*)(ws + WS_ZT), 256, 131072, 512}; pg8::StaticOrder S; S.init(256, 131072, G, bx);
        pg8::EpiY E{(pg8::bf16_t*)(ws + WS_Y)};
        pg8::gemm_phase<pg8::EpiY, pg8::StaticOrder, true, true>(lds, g, S, E);
    }
    SEAM(PH_G2);
    if (IN(PH_G3)) { FRESH_IDS();
        pg8::Gemm g{(const pg8::bf16_t*)(ws + WS_Y), (const pg8::bf16_t*)(ws + WS_WOF), T, DM, DM}; pg8::StaticOrder S; S.init(T, DM, G, bx);
        pg8::EpiRes E{a.in[0], a.out, (pg8::bf16_t*)(ws + WS_XB), (float*)(ws + WS_SSQ_A)};
        pg8::gemm_phase<pg8::EpiRes, pg8::StaticOrder, true, true>(lds, g, S, E);
    }
    SEAM(PH_G3);
#define PEER_LAYER(L) do { \
        const int pq = L ? PH_Q1 : PH_Q0, ptk = L ? PH_TK1 : PH_TK0, ppa = L ? PH_PA1 : PH_PA0, ppw = L ? PH_PW1 : PH_PW0, ppb = L ? PH_PB1 : PH_PB0; \
        for (int rep_ = 0; rep_ < REP_Q; ++rep_) \
        if (IN(pq)) { FRESH_IDS(); \
            pg8::Gemm g{(const pg8::bf16_t*)(ws + WS_XB), (const pg8::bf16_t*)(ws + (L ? WS_WQ1 : WS_WQ0)), T, DM, DM}; pg8::StaticOrder S; S.init(T, DM, G, bx); \
            pg8::EpiScale E{(pg8::bf16_t*)(ws + WS_Q), (const float*)(ws + (L ? WS_SSQ_C : WS_SSQ_A))}; \
            pg8::gemm_phase<pg8::EpiScale, pg8::StaticOrder, true, true>(lds, g, S, E); \
        } \
        SEAM(pq); \
        if (IN(ptk)) { FRESH_IDS(); \
            const bf16* keys = (const bf16*)(ws + WS_KEYS) + (size_t)L * PH * 2 * 128 * 128; \
            CvtCtx cx; cx.srcU = a.in[9] + (size_t)L * NEXP * DM; cx.dsrc = (long)((a.in[10] + (size_t)L * NEXP * DM) - cx.srcU); cx.gain = a.in[2] + L * DM; cx.dstU = ws + (L ? WS_U1 : WS_U0); cx.ddst = (long)WS_V0 - (long)WS_U0; cx.su = (float*)(ws + WS_SU) + L * 32768; cx.dsc = ((long)WS_SV - (long)WS_SU) / 4; cx.gwave = bx * NWAVES + wave; cx.nw = G * NWAVES; \
            int slot = 0; \
            for (int rep_ = 0; rep_ < REP_TK; ++rep_) { slot = 0; \
            for (int u = bx; u < (T / 256) * PH; u += G) { \
                const int h = u & 7, tblk = u >> 3; \
                __syncthreads(); \
                topk_fill(lds, keys, h, tid); \
                __syncthreads(); \
                topk_unit((const bf16*)(ws + WS_Q), lds, (int*)(ws + WS_EI), (float*)(ws + WS_GW), tblk * 256 + wave * 32, h, lane, cx, slot); \
                slot += 16; \
            } } \
            for (; slot * cx.nw + cx.gwave < 65536; ++slot) { f32x4 cr[4]; const int cc = slot * cx.nw + cx.gwave; cvt_chunk_load(cx, cc, lane, cr); cvt_chunk_store(cx, cc, lane, cr); } \
        } \
        SEAM(ptk); \
        if (IN(ppa)) { FRESH_IDS(); \
            const int xv = bx & 7, nxw = (G >> 3) * NWAVES, wx = (bx >> 3) * NWAVES + wave; \
            for (int rep_ = 0; rep_ < REP_PA; ++rep_) \
            peer_a_slice<8>((const bf16*)(ws + WS_XB), (const int*)(ws + WS_EI), (const unsigned char*)(ws + (L ? WS_U1 : WS_U0)), (float*)(ws + WS_PD), xv, wx, nxw, T / nxw, lane); \
        } \
        SEAM(ppa); \
        if (IN(ppw)) { FRESH_IDS(); \
            const int gw = bx * NWAVES + wave, NGW = G * NWAVES; \
            for (int t = gw; t < T; t += NGW) peer_a2_token((const float*)(ws + WS_PD), (const float*)(ws + (L ? WS_SSQ_C : WS_SSQ_A)), (const int*)(ws + WS_EI), (const float*)(ws + WS_SU) + L * 32768, (const float*)(ws + WS_SV) + L * 32768, (float*)(ws + WS_GW), (float*)(ws + WS_W1), t, lane); \
        } \
        SEAM(ppw); \
        if (IN(ppb)) { FRESH_IDS(); \
            const int xv = bx & 7, nxw = (G >> 3) * NWAVES, wx = (bx >> 3) * NWAVES + wave; \
            peer_b_slice<4>(a.out, (const int*)(ws + WS_EI), (const float*)(ws + ((xv < 4) ? WS_GW : WS_W1)), (const unsigned char*)(ws + (L ? WS_V1 : WS_V0)), L ? (bf16*)nullptr : (bf16*)(ws + WS_XB), (float*)(ws + (L ? WS_SSQ_D : WS_SSQ_B)), xv, wx, nxw, T / nxw, lane); \
        } \
    } while (0)
    float oscale = 1.f;
    PEER_LAYER(0);
    SEAM(PH_PB0);
    for (int rep_ = 0; rep_ < REP_GEMM; ++rep_)
    if (IN(PH_QKV)) { FRESH_IDS();
        {
            pg8::Gemm g{(const pg8::bf16_t*)(ws + WS_XB), (const pg8::bf16_t*)(ws + WS_WQKV), T, 2560, DM}; pg8::StaticOrder S; S.init(T, 2560, G, bx);
            pg8::EpiQK E{(pg8::bf16_t*)(ws + WS_QB), (pg8::bf16_t*)(ws + WS_KB), (const float*)(ws + WS_SSQ_B), (const float*)(ws + WS_ROPE), 0.125f * 1.4426950408889634f};
            pg8::gemm_phase<pg8::EpiQK, pg8::StaticOrder, true, true>(lds, g, S, E);
        }
        if (bx >= G / 2) {
            pg8::Gemm g{(const pg8::bf16_t*)(ws + WS_WQKV) + (size_t)2560 * DM, (const pg8::bf16_t*)(ws + WS_XB), 512, T, DM}; pg8::StaticOrder S; S.init(512, T, G / 2, bx - G / 2);
            pg8::EpiVt E{(pg8::bf16_t*)(ws + WS_VT), (const float*)(ws + WS_SSQ_B)};
            pg8::gemm_phase<pg8::EpiVt, pg8::StaticOrder, true, true>(lds, g, S, E);
        }
    }
    SEAM(PH_QKV);
    for (int rep_ = 0; rep_ < REP_ATT; ++rep_)
    if (IN(PH_ATT)) { FRESH_IDS();
        for (int vb = bx; vb < 256; vb += G) {
            const int bkv = vb >> 3, chunk = vb & 7, b = bkv >> 3, kvh = bkv & 7;
            for (int i = 0; i < 8; ++i) {
                const int qu = (chunk * 8 + i) * 64;
                __syncthreads();
                attn_fill(lds, (const bf16*)(ws + WS_KB), (const bf16*)(ws + WS_VT), b, kvh, qu - 128, tid);
                __syncthreads();
                attn_task(lds, (const bf16*)(ws + WS_QB), (bf16*)(ws + WS_O), a.in[6], b, kvh * 4 + (wave & 3), qu + (wave >> 2) * 32, qu - 128, lane);
            }
        }
    }
    SEAM(PH_ATT);
    if (IN(PH_WO)) { FRESH_IDS();
        pg8::Gemm g{(const pg8::bf16_t*)(ws + WS_O), (const pg8::bf16_t*)(ws + WS_WOA), T, DM, DM}; pg8::StaticOrder S; S.init(T, DM, G, bx);
        pg8::EpiRes E{a.out, a.out, (pg8::bf16_t*)(ws + WS_XB), (float*)(ws + WS_SSQ_C)};
        pg8::gemm_phase<pg8::EpiRes, pg8::StaticOrder, true, true>(lds, g, S, E);
    }
    SEAM(PH_WO);
#ifdef DIAG_A
    { const unsigned long long* st = (const unsigned long long*)(ws + WS_STAMP); oscale = 1.f + sqrtf((float)(st[DIAG_B] - st[DIAG_A]) * 1e-6f); }
#endif
    PEER_LAYER(1);
#undef PEER_LAYER
    SEAM(PH_PB1);
    if (IN(PH_FIN)) { FRESH_IDS();
        const int gw = bx * NWAVES + wave, NGW = G * NWAVES;
        for (int t = gw; t < T; t += NGW) final_norm_row(a.out, (const float*)(ws + WS_SSQ_D), a.in[11], t, lane, oscale);
    }
#undef SEAM
#undef IN
}

#ifndef N_LAUNCHES
#define N_LAUNCHES 1
#endif
extern "C" void kernel_launch(void* const* d_in, const int* in_sizes, int n_in, void* d_out, int out_size, void* d_ws, size_t ws_size, hipStream_t stream) {
    static int grid = 0;
    if (!grid) {
        if (hipFuncSetAttribute((const void*)mega, hipFuncAttributeMaxDynamicSharedMemorySize, LDS_BYTES) != hipSuccess) { fprintf(stderr, "hipFuncSetAttribute failed\n"); }
        int dev = 0, cus = 0, per_cu = 0;
        (void)hipGetDevice(&dev);
        (void)hipDeviceGetAttribute(&cus, hipDeviceAttributeMultiprocessorCount, dev);
        if (hipOccupancyMaxActiveBlocksPerMultiprocessor(&per_cu, (const void*)mega, NWAVES * 64, LDS_BYTES) != hipSuccess) per_cu = 0;
        (void)hipGetLastError();
        grid = cus * per_cu;
        if (grid > 256) grid = 256;
        grid &= ~1;
        if (grid < 2) { fprintf(stderr, "occupancy query gave %d x %d\n", cus, per_cu); grid = -1; }
    }
    if (grid < 0) return;
    if (ws_size < 700 * MiB) { fprintf(stderr, "ws too small: %zu\n", ws_size); return; }
    (void)hipMemsetAsync((char*)d_ws + WS_CTL, 0, CTL_BYTES, stream);
    Args a{};
    for (int i = 0; i < 12; ++i) a.in[i] = (const float*)d_in[i];
    a.out = (float*)d_out; a.ws = (unsigned char*)d_ws;
    if (N_LAUNCHES == 1) {
        a.ph_lo = 0; a.ph_hi = PH_END;
        void* args[] = {&a};
        const hipError_t e = hipLaunchCooperativeKernel((const void*)mega, dim3(grid), dim3(NWAVES * 64), args, LDS_BYTES, stream);
        if (e != hipSuccess) fprintf(stderr, "cooperative launch failed: %s (grid %d)\n", hipGetErrorString(e), grid);
    } else {
        for (int ph = 0; ph < PH_END; ++ph) {
            a.ph_lo = ph; a.ph_hi = ph + 1;
            hipLaunchKernelGGL(mega, dim3(grid), dim3(NWAVES * 64), LDS_BYTES, stream, a);
        }
    }
}
```

```cpp
#include <hip/hip_runtime.h>
#include <hip/hip_cooperative_groups.h>
namespace cg = cooperative_groups;
#include <cstdio>
#include <cstdint>
#include <cmath>

constexpr int DM = 2048, NB = 4, SEQ = 4096, T = NB * SEQ;
constexpr int FG = 8, FW = 256;
constexpr int HD = 64, NQH = 32, NKVH = 8, QKVW = 3072;
constexpr int PH = 8, NKEYS = 128, NEXP = 16384, PTOPK = 16;
constexpr float EPS = 1e-6f;
namespace pg8 {
#define PG8_LAS __attribute__((address_space(3)))
typedef unsigned short bf16_t;
typedef short bf16x8 __attribute__((ext_vector_type(8)));
typedef float f32x4 __attribute__((ext_vector_type(4)));
typedef unsigned u32x4 __attribute__((ext_vector_type(4)));
constexpr int BM = 256, BK = 64, HALF = 128, HTB = HALF * BK * 2  , STAGE_BYTES = 8 * HTB, NXCD = 8, WGM = 8;

__host__ __device__ __forceinline__ int lds_byte(int r, int c) { const int st = (r >> 4) * 2 + (c >> 5), rr = r & 15, cc = c & 31, ob = rr * 64 + cc * 2; return st * 1024 + (ob ^ (((ob >> 9) & 1) << 5)); }
__host__ __device__ __forceinline__ void stage_rc(int b, int& R, int& C) { const int st = b / 1024, sb = b % 1024, swz = sb ^ (((sb >> 9) & 1) << 5); R = (st >> 1) * 16 + swz / 64; C = (st & 1) * 32 + (swz % 64) / 2; }
__host__ __device__ __forceinline__ int perm32(int rho) { const int n = rho >> 4, i = rho & 15; return 8 * (i >> 2) + 4 * n + (i & 3); }

struct Unit { int pm, pn; };
struct Gemm { const bf16_t* A; const bf16_t* Bt; int M, N, K; };

struct StaticOrder {
    int nM, nN, nwg, G, c;
    __host__ __device__ void init(int M, int N, int G_, int c_) { nM = M / BM; nN = N / BM; nwg = nM * nN; G = G_; c = c_; }
    __host__ __device__ bool next(int i, Unit& u) const {
        const long L = (long)i * G + c; if (L >= nwg) return false;
        int wgid = (int)L; { const int q = nwg / NXCD, r = nwg % NXCD, xcd = wgid % NXCD, off = wgid / NXCD; wgid = (xcd < r ? xcd * (q + 1) : r * (q + 1) + (xcd - r) * q) + off; }
        const int nig = WGM * nN, gid = wgid / nig, fm = gid * WGM, gsz = (nM - fm) < WGM ? (nM - fm) : WGM;
        u.pm = fm + ((wgid % nig) % gsz); u.pn = (wgid % nig) / gsz; return true;
    }
    __device__ __forceinline__ void a_ready(const Unit&) const {}
    __device__ __forceinline__ void done(const Unit&) const {}
};

__device__ __forceinline__ unsigned cvt_pk_bf16(float lo, float hi) { unsigned r; asm volatile("v_cvt_pk_bf16_f32 %0, %1, %2" : "=v"(r) : "v"(lo), "v"(hi)); return r; }
typedef float f32x2 __attribute__((ext_vector_type(2)));
__device__ __forceinline__ u32x4 pack8(const f32x4 v0, const f32x4 v1) { u32x4 w; w.x = cvt_pk_bf16(v0[0], v0[1]); w.y = cvt_pk_bf16(v0[2], v0[3]); w.z = cvt_pk_bf16(v1[0], v1[1]); w.w = cvt_pk_bf16(v1[2], v1[3]); return w; }
struct EpiZt {
    static constexpr bool PERM = true, AFTER_DRAIN = false; bf16_t* Zp;
    __device__ __forceinline__ void operator()(const f32x4 (&acc)[2][2][4][2], const Unit& u, int wr, int wc, int fr, int fq) const {
        const int part = u.pm, bgs2 = u.pn;
        bf16_t* base = Zp + ((size_t)(bgs2 * 256 + wr * 64 + fr) * 512 + part * 256 + wc * 32 + 8 * fq);
#pragma unroll
        for (int ai = 0; ai < 2; ++ai)
#pragma unroll
            for (int m = 0; m < 4; ++m)
#pragma unroll
                for (int bj = 0; bj < 2; ++bj) *(u32x4*)(base + (ai * HALF + m * 16) * 512 + bj * HALF) = pack8(acc[ai][bj][m][0], acc[ai][bj][m][1]);
    }
};
struct EpiY {
    static constexpr bool PERM = true, AFTER_DRAIN = false; bf16_t* Y;
    __device__ __forceinline__ void operator()(const f32x4 (&acc)[2][2][4][2], const Unit& u, int wr, int wc, int fr, int fq) const {
        const int bg = u.pn >> 4, k2 = u.pn & 15, b = bg >> 3, g = bg & 7;
        bf16_t* base = Y + ((size_t)(b * 4096 + (wr * 64 + fr) * 16 + k2) * 2048 + g * 256 + wc * 32 + 8 * fq);
#pragma unroll
        for (int ai = 0; ai < 2; ++ai)
#pragma unroll
            for (int m = 0; m < 4; ++m)
#pragma unroll
                for (int bj = 0; bj < 2; ++bj) *(u32x4*)(base + (size_t)(ai * HALF + m * 16) * 16 * 2048 + bj * HALF) = pack8(acc[ai][bj][m][0], acc[ai][bj][m][1]);
    }
};
struct EpiRes {
    static constexpr bool PERM = true, AFTER_DRAIN = false; const float* R; float* out; bf16_t* xb; float* ssq;
    __device__ __forceinline__ void operator()(const f32x4 (&acc)[2][2][4][2], const Unit& u, int wr, int wc, int fr, int fq) const {
        const int row0 = u.pm * BM + wr * 64 + fr; const size_t off0 = (size_t)row0 * 2048 + u.pn * BM + wc * 32 + 8 * fq;
        const float* Rb = R + off0; float* Ob = out + off0; bf16_t* Xb = xb + off0; float* Sb = ssq + row0;
#pragma unroll
        for (int ai = 0; ai < 2; ++ai)
#pragma unroll
            for (int m = 0; m < 4; ++m) { const int ro = (ai * HALF + m * 16) * 2048; float ss = 0.f;
#pragma unroll
                for (int bj = 0; bj < 2; ++bj) {
                    const f32x4 r0 = *(const f32x4*)(Rb + ro + bj * HALF), r1 = *(const f32x4*)(Rb + ro + bj * HALF + 4);
                    const f32x4 o0 = acc[ai][bj][m][0] + r0, o1 = acc[ai][bj][m][1] + r1;
                    *(f32x4*)(Ob + ro + bj * HALF) = o0; *(f32x4*)(Ob + ro + bj * HALF + 4) = o1;
                    *(u32x4*)(Xb + ro + bj * HALF) = pack8(o0, o1);
                    ss += (o0[0] * o0[0] + o0[1] * o0[1]) + (o0[2] * o0[2] + o0[3] * o0[3]) + (o1[0] * o1[0] + o1[1] * o1[1]) + (o1[2] * o1[2] + o1[3] * o1[3]); }
                ss += __shfl_xor(ss, 16); ss += __shfl_xor(ss, 32);
                if (fq == 0) unsafeAtomicAdd(Sb + ai * HALF + m * 16, ss);
                asm volatile("" ::: "memory"); }
    }
};
struct EpiScale {
    static constexpr bool PERM = true, AFTER_DRAIN = false; bf16_t* O; const float* ssq;
    __device__ __forceinline__ void operator()(const f32x4 (&acc)[2][2][4][2], const Unit& u, int wr, int wc, int fr, int fq) const {
        const int row0 = u.pm * BM + wr * 64 + fr;
        bf16_t* base = O + ((size_t)row0 * 2048 + u.pn * BM + wc * 32 + 8 * fq); const float* Sb = ssq + row0;
#pragma unroll
        for (int ai = 0; ai < 2; ++ai)
#pragma unroll
            for (int m = 0; m < 4; ++m) { const float rs = rsqrtf(Sb[ai * HALF + m * 16] * (1.f / 2048.f) + 1e-6f);
#pragma unroll
                for (int bj = 0; bj < 2; ++bj) *(u32x4*)(base + (ai * HALF + m * 16) * 2048 + bj * HALF) = pack8(acc[ai][bj][m][0] * rs, acc[ai][bj][m][1] * rs); }
    }
};
struct EpiQK {
    static constexpr bool PERM = true, AFTER_DRAIN = false; bf16_t* Q; bf16_t* K; const float* ssq; const float* rope; float qscale;
    __device__ __forceinline__ void operator()(const f32x4 (&acc)[2][2][4][2], const Unit& u, int wr, int wc, int fr, int fq) const {
        const int row0 = u.pm * BM + wr * 64 + fr; const bool isq = u.pn < 8;
        const int cl = wc * 32 + 8 * fq;
        bf16_t* base = isq ? (Q + ((size_t)row0 * 2048 + u.pn * BM + cl)) : (K + ((size_t)row0 * 512 + (u.pn - 8) * BM + cl));
        const int ld = isq ? 2048 : 512; const float sc = isq ? qscale : 1.f;
        const float* rp = rope + (size_t)(row0 & 4095) * 64 + (cl & 63);
        const float* Sb = ssq + row0;
#pragma unroll
        for (int ai = 0; ai < 2; ++ai)
#pragma unroll
            for (int m = 0; m < 4; ++m) { const int ro = ai * HALF + m * 16; const float rs = rsqrtf(Sb[ro] * (1.f / 2048.f) + 1e-6f) * sc;
                const f32x4 t0 = *(const f32x4*)(rp + (size_t)ro * 64), t1 = *(const f32x4*)(rp + (size_t)ro * 64 + 4);
#pragma unroll
                for (int bj = 0; bj < 2; ++bj) {
                    const f32x4 a = acc[ai][bj][m][0] * rs, b = acc[ai][bj][m][1] * rs; f32x4 oa, ob;
                    oa[0] = a[0] * t0[0] - a[1] * t0[1]; oa[1] = a[1] * t0[0] + a[0] * t0[1]; oa[2] = a[2] * t0[2] - a[3] * t0[3]; oa[3] = a[3] * t0[2] + a[2] * t0[3];
                    ob[0] = b[0] * t1[0] - b[1] * t1[1]; ob[1] = b[1] * t1[0] + b[0] * t1[1]; ob[2] = b[2] * t1[2] - b[3] * t1[3]; ob[3] = b[3] * t1[2] + b[2] * t1[3];
                    *(u32x4*)(base + (size_t)ro * ld + bj * HALF) = pack8(oa, ob); } }
    }
};
struct EpiVt {
    static constexpr bool PERM = true, AFTER_DRAIN = false; bf16_t* Vt; const float* ssq;
    __device__ __forceinline__ void operator()(const f32x4 (&acc)[2][2][4][2], const Unit& u, int wr, int wc, int fr, int fq) const {
        const int col0 = u.pn * BM + wc * 32 + 8 * fq;
        bf16_t* base = Vt + ((size_t)(u.pm * BM + wr * 64 + fr) * 16384 + col0);
        f32x4 r0[2], r1[2];
#pragma unroll
        for (int bj = 0; bj < 2; ++bj) { const f32x4 s0 = *(const f32x4*)(ssq + col0 + bj * HALF), s1 = *(const f32x4*)(ssq + col0 + bj * HALF + 4);
#pragma unroll
            for (int q = 0; q < 4; ++q) { r0[bj][q] = rsqrtf(s0[q] * (1.f / 2048.f) + 1e-6f); r1[bj][q] = rsqrtf(s1[q] * (1.f / 2048.f) + 1e-6f); } }
#pragma unroll
        for (int ai = 0; ai < 2; ++ai)
#pragma unroll
            for (int m = 0; m < 4; ++m)
#pragma unroll
                for (int bj = 0; bj < 2; ++bj) *(u32x4*)(base + (size_t)(ai * HALF + m * 16) * 16384 + bj * HALF) = pack8(acc[ai][bj][m][0] * r0[bj], acc[ai][bj][m][1] * r1[bj]);
    }
};
template <class Epi, class Sched, bool ALIGN_EPI = false, bool SP2 = false>
__device__ __forceinline__ void gemm_phase(PG8_LAS unsigned char* lds, const Gemm g, const Sched& S, const Epi& E) {
    const int tid = threadIdx.x, wid = __builtin_amdgcn_readfirstlane(tid >> 6), lane = tid & 63, wr = wid >> 2, wc = wid & 3, fr = lane & 15, fq = lane >> 4;
    const int K = g.K, nt = K / BK;
    unsigned voffA[2], voffB[2];
#pragma unroll
    for (int i = 0; i < 2; ++i) { int R, C; stage_rc(tid * 16 + i * 8192, R, C); const int Rb = Epi::PERM ? ((R & ~31) + perm32(R & 31)) : R;
        voffA[i] = (unsigned)(R * K + C) * 2u; voffB[i] = (unsigned)(Rb * K + C) * 2u; }
    const size_t kstep = (size_t)(BK * 2);
    const size_t hstep = (size_t)HALF * K * 2;
    const size_t tstep = 2 * hstep;
    const unsigned ldsw = (unsigned)wid * 1024u;
    const int aoff = lds_byte(wr * 64 + fr, fq * 8), boff = lds_byte(wc * 32 + fr, fq * 8);
#define PG8_SA(b, h) (((b) * 2 + (h)) * HTB)
#define PG8_SB(b, h) ((4 + (b) * 2 + (h)) * HTB)
#define PG8_STAGE(bufoff, gbase, voff) do { _Pragma("unroll") for (int _i = 0; _i < 2; ++_i) \
        __builtin_amdgcn_global_load_lds((const unsigned*)((const char*)(gbase) + (voff)[_i]), (PG8_LAS unsigned*)(lds + (bufoff) + ldsw + _i * 8192), 16, 0, 0); } while (0)
#define PG8_LDA(dst, b, h) do { _Pragma("unroll") for (int m = 0; m < 4; ++m) _Pragma("unroll") for (int k = 0; k < 2; ++k) dst[m][k] = *(const PG8_LAS bf16x8*)(lds + PG8_SA(b, h) + aoff + m * 2048 + k * 1024); } while (0)
#define PG8_LDB(dst, b, h) do { _Pragma("unroll") for (int n = 0; n < 2; ++n) _Pragma("unroll") for (int k = 0; k < 2; ++k) dst[n][k] = *(const PG8_LAS bf16x8*)(lds + PG8_SB(b, h) + boff + n * 2048 + k * 1024); } while (0)
#define PG8_MMA(ai, bj, At, Bt) do { __builtin_amdgcn_s_setprio(1); _Pragma("unroll") for (int m = 0; m < 4; ++m) _Pragma("unroll") for (int n = 0; n < 2; ++n) _Pragma("unroll") for (int k = 0; k < 2; ++k) \
        acc[ai][bj][m][n] = __builtin_amdgcn_mfma_f32_16x16x32_bf16(Bt[n][k], At[m][k], acc[ai][bj][m][n], 0, 0, 0); __builtin_amdgcn_s_setprio(0); } while (0)
#define PG8_WAIT_V(n) asm volatile("s_waitcnt vmcnt(" #n ")" ::: "memory")
#define PG8_WAIT_L(n) asm volatile("s_waitcnt lgkmcnt(" #n ")" ::: "memory")
#define PG8_BAR __builtin_amdgcn_s_barrier()
#define PG8_SCHED __builtin_amdgcn_sched_barrier(0)
    Unit cur, nxt; int ui = 0;
    if (!S.next(0, cur)) return;
    f32x4 acc[2][2][4][2];
#pragma unroll
    for (int a = 0; a < 2; ++a)
#pragma unroll
        for (int b = 0; b < 2; ++b)
#pragma unroll
            for (int m = 0; m < 4; ++m)
#pragma unroll
                for (int n = 0; n < 2; ++n) acc[a][b][m][n] = (f32x4){0.f, 0.f, 0.f, 0.f};
    bf16x8 At[4][2], B0[2][2], B1[2][2];
    const char* cA = (const char*)g.A + (size_t)cur.pm * tstep; const char* cB = (const char*)g.Bt + (size_t)cur.pn * tstep;
    S.a_ready(cur);
    if constexpr (SP2) {
        PG8_STAGE(PG8_SB(0, 0), cB, voffB); PG8_STAGE(PG8_SB(0, 1), cB + hstep, voffB); PG8_STAGE(PG8_SA(0, 0), cA, voffA); PG8_STAGE(PG8_SA(0, 1), cA + hstep, voffA);
        if (wr == 1) PG8_BAR;
        PG8_WAIT_V(2); PG8_BAR;
        PG8_STAGE(PG8_SB(1, 0), cB + kstep, voffB); PG8_STAGE(PG8_SA(1, 0), cA + kstep, voffA); PG8_STAGE(PG8_SB(1, 1), cB + hstep + kstep, voffB);
        PG8_WAIT_V(6); PG8_BAR;
    } else {
        PG8_STAGE(PG8_SB(0, 0), cB, voffB); PG8_STAGE(PG8_SA(0, 0), cA, voffA); PG8_STAGE(PG8_SB(0, 1), cB + hstep, voffB); PG8_STAGE(PG8_SA(0, 1), cA + hstep, voffA);
        if (wr == 1) PG8_BAR;
        PG8_WAIT_V(4); PG8_BAR;
        PG8_STAGE(PG8_SB(1, 0), cB + kstep, voffB); PG8_STAGE(PG8_SA(1, 0), cA + kstep, voffA); PG8_STAGE(PG8_SB(1, 1), cB + hstep + kstep, voffB);
        PG8_WAIT_V(6); PG8_BAR;
    }
    for (;;) {
        const bool has_next = S.next(ui + 1, nxt);
        const char* nA = has_next ? (const char*)g.A + (size_t)nxt.pm * tstep : cA; const char* nB = has_next ? (const char*)g.Bt + (size_t)nxt.pn * tstep : cB;
        for (int t = 0; t < nt; t += 2) {
            const bool last = (t == nt - 2);
            const char* a1 = cA + (size_t)(t + 1) * kstep;
            const char* a2 = last ? nA : cA + (size_t)(t + 2) * kstep; const char* b2 = last ? nB : cB + (size_t)(t + 2) * kstep;
            const char* a3 = a2 + kstep; const char* b3 = b2 + kstep;
            if (last && has_next) S.a_ready(nxt);
            if constexpr (SP2) {
            PG8_LDB(B0, 0, 0); PG8_LDB(B1, 0, 1); PG8_SCHED; PG8_LDA(At, 0, 0); PG8_STAGE(PG8_SA(1, 1), a1 + hstep, voffA);
            PG8_WAIT_V(8); PG8_WAIT_L(0); PG8_BAR; PG8_MMA(0, 0, At, B0); PG8_MMA(0, 1, At, B1); PG8_BAR; PG8_SCHED;
            PG8_LDA(At, 0, 1); PG8_STAGE(PG8_SB(0, 0), b2, voffB); PG8_STAGE(PG8_SB(0, 1), b2 + hstep, voffB); PG8_STAGE(PG8_SA(0, 0), a2, voffA);
            PG8_WAIT_V(8); PG8_WAIT_L(0); PG8_BAR; PG8_MMA(1, 0, At, B0); PG8_MMA(1, 1, At, B1); PG8_BAR; PG8_SCHED;
            PG8_LDB(B0, 1, 0); PG8_LDB(B1, 1, 1); PG8_SCHED; PG8_LDA(At, 1, 0); PG8_STAGE(PG8_SA(0, 1), a2 + hstep, voffA);
            PG8_WAIT_V(8); PG8_WAIT_L(0); PG8_BAR; PG8_MMA(0, 0, At, B0); PG8_MMA(0, 1, At, B1); PG8_BAR; PG8_SCHED;
            PG8_LDA(At, 1, 1); PG8_STAGE(PG8_SB(1, 0), b3, voffB); PG8_STAGE(PG8_SB(1, 1), b3 + hstep, voffB); PG8_STAGE(PG8_SA(1, 0), a3, voffA);
            PG8_WAIT_V(8); PG8_WAIT_L(0); PG8_BAR; PG8_MMA(1, 0, At, B0); PG8_MMA(1, 1, At, B1); PG8_BAR; PG8_SCHED;
            } else {
            PG8_LDB(B0, 0, 0); PG8_SCHED; PG8_LDA(At, 0, 0); PG8_STAGE(PG8_SA(1, 1), a1 + hstep, voffA);
            PG8_WAIT_L(8); PG8_BAR; PG8_WAIT_L(0); PG8_MMA(0, 0, At, B0); PG8_BAR; PG8_SCHED;
            PG8_LDB(B1, 0, 1); PG8_STAGE(PG8_SB(0, 0), b2, voffB);
            PG8_BAR; PG8_WAIT_L(0); PG8_MMA(0, 1, At, B1); PG8_BAR;
            PG8_LDA(At, 0, 1); PG8_STAGE(PG8_SA(0, 0), a2, voffA);
            PG8_BAR; PG8_WAIT_L(0); PG8_MMA(1, 0, At, B0); PG8_BAR; PG8_SCHED;
            PG8_STAGE(PG8_SB(0, 1), b2 + hstep, voffB);
            PG8_WAIT_V(6); PG8_BAR; PG8_MMA(1, 1, At, B1); PG8_BAR;
            PG8_LDB(B0, 1, 0); PG8_SCHED; PG8_LDA(At, 1, 0); PG8_STAGE(PG8_SA(0, 1), a2 + hstep, voffA);
            PG8_WAIT_L(8); PG8_BAR; PG8_WAIT_L(0); PG8_MMA(0, 0, At, B0); PG8_BAR; PG8_SCHED;
            PG8_LDB(B1, 1, 1); PG8_STAGE(PG8_SB(1, 0), b3, voffB);
            PG8_BAR; PG8_WAIT_L(0); PG8_MMA(0, 1, At, B1); PG8_BAR;
            PG8_LDA(At, 1, 1); PG8_STAGE(PG8_SA(1, 0), a3, voffA);
            PG8_BAR; PG8_WAIT_L(0); PG8_MMA(1, 0, At, B0); PG8_BAR; PG8_SCHED;
            PG8_STAGE(PG8_SB(1, 1), b3 + hstep, voffB);
            PG8_WAIT_V(6); PG8_BAR; PG8_MMA(1, 1, At, B1); PG8_BAR;
            }
        }
        if constexpr (ALIGN_EPI) { if (wr == 0) PG8_BAR; }
        if constexpr (!Epi::AFTER_DRAIN) { E(acc, cur, wr, wc, fr, fq); S.done(cur); }
        if (!has_next) break;
#pragma unroll
        for (int a = 0; a < 2; ++a)
#pragma unroll
            for (int b = 0; b < 2; ++b)
#pragma unroll
                for (int m = 0; m < 4; ++m)
#pragma unroll
                    for (int n = 0; n < 2; ++n) acc[a][b][m][n] = (f32x4){0.f, 0.f, 0.f, 0.f};
        cur = nxt; cA = nA; cB = nB; ++ui;
        if constexpr (ALIGN_EPI) { if (wr == 1) PG8_BAR; }
    }
    PG8_WAIT_V(0);
    if constexpr (!ALIGN_EPI) { if (wr == 0) PG8_BAR; }
    PG8_BAR;
    if constexpr (Epi::AFTER_DRAIN) { E.fused(acc, cur, wr, wc, fr, fq, lds, wid, lane); S.done(cur); }
#undef PG8_SA
#undef PG8_SB
#undef PG8_STAGE
#undef PG8_LDA
#undef PG8_LDB
#undef PG8_MMA
#undef PG8_WAIT_V
#undef PG8_WAIT_L
#undef PG8_BAR
#undef PG8_SCHED
}
}
#define GAS __attribute__((address_space(1)))
#define LAS __attribute__((address_space(3)))
typedef unsigned short bf16;
typedef unsigned v4u __attribute__((ext_vector_type(4)));
typedef unsigned v2u __attribute__((ext_vector_type(2)));
typedef float f32x4 __attribute__((ext_vector_type(4)));
constexpr int NWAVES = 8;
constexpr int LDS_BYTES = 147456, LDSCTL_OFF = 131072;
constexpr int CW_BAR = 4096;
constexpr size_t MiB = 1u << 20;
constexpr size_t WS_CTL = 0, CTL_BYTES = 1 * MiB;
constexpr size_t WS_SSQ_A = 256 * 1024, WS_SSQ_B = 320 * 1024, WS_SSQ_C = 384 * 1024, WS_SSQ_D = 448 * 1024;
constexpr size_t WS_STAMP = 128 * 1024;
constexpr size_t WS_SU = 512 * 1024, WS_SV = 768 * 1024;
constexpr size_t WS_WCS = 1 * MiB, WS_ROPE = 2 * MiB, WS_KEYS = 3 * MiB;
constexpr size_t WS_WOF = 8 * MiB, WS_WQKV = 16 * MiB, WS_WOA = 28 * MiB, WS_WQ0 = 36 * MiB, WS_WQ1 = 44 * MiB;
constexpr size_t WS_A2 = 64 * MiB, WS_TW = 65 * MiB;
constexpr size_t WS_U0 = 128 * MiB, WS_V0 = 192 * MiB, WS_U1 = 256 * MiB, WS_V1 = 320 * MiB;
constexpr size_t WS_XG = 384 * MiB, WS_XB = 384 * MiB;
constexpr size_t WS_ZT = 448 * MiB;
constexpr size_t WS_Y = 576 * MiB;
constexpr size_t WS_Q = 448 * MiB;
constexpr size_t WS_EI = 640 * MiB, WS_GW = 648 * MiB, WS_W1 = 656 * MiB;
constexpr size_t WS_PD = 448 * MiB;
constexpr size_t WS_QB = 448 * MiB, WS_KB = 512 * MiB, WS_VT = 528 * MiB, WS_O = 576 * MiB;

__device__ __forceinline__ unsigned f2bf(float f) { unsigned u = __builtin_bit_cast(unsigned, f); return (u + 0x7fffu + ((u >> 16) & 1u)) >> 16; }
__device__ __forceinline__ unsigned pk2(float lo, float hi) { return f2bf(lo) | (f2bf(hi) << 16); }

struct Args { const float* in[12]; float* out; unsigned char* ws; int ph_lo, ph_hi; };

__device__ __forceinline__ int qkv_row(int n) { if (n >= 2560) return n; const int d = n & 63, pc = (d < 32) ? 2 * d : 2 * (d - 32) + 1; return (n & ~63) + pc; }
template <int MODE>
__device__ __forceinline__ void transpose_item(const float* W, int K, int N, const float* gain, bf16* WT, LAS float* scr, int item, int lane) {
    const int nblk = N / 32, kb = item / nblk, nb = item % nblk, k0 = 64 * kb, n0 = 32 * nb;
#pragma unroll 8
    for (int i = 0; i < 32; ++i) { const int kk = 2 * i + (lane >> 5); float v = W[(size_t)(k0 + kk) * N + n0 + (lane & 31)]; if (gain) v *= gain[k0 + kk]; scr[kk * 33 + (lane & 31)] = v; }
    asm volatile("s_waitcnt lgkmcnt(0)" ::: "memory");
    const int c = lane & 7;
#pragma unroll
    for (int j = 0; j < 4; ++j) { const int n = (lane >> 3) + 8 * j; const LAS float* s = scr + (8 * c) * 33 + n;
        v4u o; o.x = pk2(s[0 * 33], s[1 * 33]); o.y = pk2(s[2 * 33], s[3 * 33]); o.z = pk2(s[4 * 33], s[5 * 33]); o.w = pk2(s[6 * 33], s[7 * 33]);
        const int row = (MODE == 1) ? qkv_row(n0 + n) : (n0 + n);
        *(v4u*)(WT + (size_t)row * K + k0 + 8 * c) = o; }
    asm volatile("s_waitcnt lgkmcnt(0)" ::: "memory");
}
__device__ __forceinline__ float wsum(float v) {
#pragma unroll
    for (int o = 1; o < 64; o <<= 1) v += __shfl_xor(v, o);
    return v;
}
__device__ __forceinline__ void cvt_stream(const float* src, bf16* dst, size_t n8, size_t gtid, size_t ngt) {
    for (size_t i = gtid; i < n8; i += ngt) {
        const f32x4 a = *(const f32x4*)(src + i * 8), b = *(const f32x4*)(src + i * 8 + 4);
        v4u o; o.x = pk2(a[0], a[1]); o.y = pk2(a[2], a[3]); o.z = pk2(b[0], b[1]); o.w = pk2(b[2], b[3]);
        *(v4u*)(dst + i * 8) = o;
    }
}
__device__ __forceinline__ void cvt_stream8(const float* src, unsigned char* dst, size_t n16, size_t gtid, size_t ngt, float scale) {
    for (size_t i = gtid; i < n16; i += ngt) {
        v4u o;
#pragma unroll
        for (int q = 0; q < 4; ++q) { f32x4 a = *(const f32x4*)(src + i * 16 + 4 * q) * scale;
#pragma unroll
            for (int e = 0; e < 4; ++e) a[e] = fminf(fmaxf(a[e], -448.f), 448.f);
            int w = 0; w = __builtin_amdgcn_cvt_pk_fp8_f32(a[0], a[1], w, false); w = __builtin_amdgcn_cvt_pk_fp8_f32(a[2], a[3], w, true); o[q] = (unsigned)w; }
        const size_t e = i >> 7, r = i & 127, sl = r >> 3, c8 = r & 7;
        *(v4u*)(dst + ((sl * 16384 + e) * 128 + c8 * 16)) = o;
    }
}
#define XB_TMO      128
#define XB_XCNT(j)  (256  + 64 * (j))
#define XB_XSUB(j)  (1280 + 64 * (j))
#define XB_XGEN(j)  (2304 + 64 * (j))
#define XB_TOP      3328
#define XB_TOPGEN   3392
#define XCD_BAR_WORDS 3456
#define XB_SPIN_CAP (1u << 18)

__device__ __forceinline__ unsigned xb_ld(unsigned* p)              { return __hip_atomic_load(p, __ATOMIC_RELAXED, __HIP_MEMORY_SCOPE_AGENT); }
__device__ __forceinline__ unsigned xb_add(unsigned* p, unsigned v) { return __hip_atomic_fetch_add(p, v, __ATOMIC_RELAXED, __HIP_MEMORY_SCOPE_AGENT); }
__device__ __forceinline__ unsigned xb_xcc_id() { return (unsigned)__builtin_amdgcn_s_getreg((3 << 11) | 20) & 0xFu; }
#define XB_SPIN(cond, bar) do { unsigned _sp = 0; while (cond) { __builtin_amdgcn_s_sleep(1); \
    if ((++_sp & 255u) == 0u) { if (xb_ld(&(bar)[XB_TMO])) break; if (_sp > XB_SPIN_CAP) { atomicAdd(&(bar)[XB_TMO], 1u); break; } } } } while (0)

struct XcdBarrier {
    unsigned* bar; unsigned x;
    volatile LAS unsigned* st;
};

__device__ __forceinline__ XcdBarrier xcd_barrier_post(unsigned* bar, volatile LAS unsigned* st) {
    XcdBarrier b; b.bar = bar; b.x = xb_xcc_id(); b.st = st;
    if (threadIdx.x == 0) (void)xb_add(&bar[XB_XCNT(b.x)], 1u);
    return b;
}
__device__ __forceinline__ void xcd_barrier_complete(unsigned* bar, unsigned x, unsigned& nloc, unsigned& nx) {
    const unsigned G = gridDim.x * gridDim.y * gridDim.z;
    unsigned sum, cnt, mine, sp = 0u;
    for (;;) {
        sum = 0u; cnt = 0u; mine = 0u;
#pragma unroll
        for (unsigned j = 0; j < 16; ++j) { const unsigned c = xb_ld(&bar[XB_XCNT(j)]); sum += c; cnt += (c > 0u) ? 1u : 0u; mine = (j == x) ? c : mine; }
        if (sum == G) break;
        __builtin_amdgcn_s_sleep(1);
        if ((++sp & 255u) == 0u) { if (xb_ld(&bar[XB_TMO])) break; if (sp > XB_SPIN_CAP) { atomicAdd(&bar[XB_TMO], 1u); break; } }
    }
    nloc = mine > 0u ? mine : 1u; nx = cnt > 0u ? cnt : 1u;
}

__device__ __forceinline__ void xcd_barrier(const XcdBarrier& b) {
    asm volatile("s_waitcnt vmcnt(0)" ::: "memory");
    __syncthreads();
    if (threadIdx.x == 0) {
        unsigned* bar = b.bar;
        __builtin_amdgcn_s_waitcnt(0);
        unsigned nloc = b.st[0], nx = b.st[1];
        if (nloc == 0u) { xcd_barrier_complete(bar, b.x, nloc, nx); b.st[0] = nloc; b.st[1] = nx; }
        const unsigned old = xb_add(&bar[XB_XSUB(b.x)], 1u);
        const unsigned gen = old / nloc;
        if (old + 1u == (gen + 1u) * nloc) {
            __builtin_amdgcn_fence(__ATOMIC_RELEASE, "agent");
            asm volatile("s_waitcnt vmcnt(0)" ::: "memory");
            const unsigned og = xb_add(&bar[XB_TOP], 1u);
            const unsigned tg = og / nx;
            if (og + 1u == (tg + 1u) * nx) xb_add(&bar[XB_TOPGEN], 1u);
            else XB_SPIN(xb_ld(&bar[XB_TOPGEN]) == tg, bar);
            __builtin_amdgcn_fence(__ATOMIC_ACQUIRE, "agent");
            xb_add(&bar[XB_XGEN(b.x)], 1u);
            asm volatile("s_waitcnt vmcnt(0)" ::: "memory");
        } else {
            XB_SPIN(xb_ld(&bar[XB_XGEN(b.x)]) == gen, bar);
            __builtin_amdgcn_fence(__ATOMIC_ACQUIRE, "agent");
            asm volatile("s_waitcnt vmcnt(0)" ::: "memory");
        }
    }
    __syncthreads();
}
#define U_SCALE 1024.f
#define V_SCALE 256.f
typedef float f32x16 __attribute__((ext_vector_type(16)));
#ifndef TKB
#define TKB 2
#endif
typedef short s16x8 __attribute__((ext_vector_type(8)));
typedef __bf16 bf16x2_t __attribute__((ext_vector_type(2)));
__device__ __forceinline__ unsigned ordf(float f) { const unsigned u = __float_as_uint(f); return (u & 0x80000000u) ? ~u : (u | 0x80000000u); }
__device__ __forceinline__ float unordf(unsigned u) { return __uint_as_float((u & 0x80000000u) ? (u & 0x7fffffffu) : ~u); }
__device__ __forceinline__ unsigned umax_(unsigned a, unsigned b) { return a > b ? a : b; }
#define DPPU(v, ctrl) ((unsigned)__builtin_amdgcn_update_dpp(0, (int)(v), (ctrl), 0xf, 0xf, true))
#define DPPF(v, ctrl) __int_as_float(__builtin_amdgcn_update_dpp(0, __float_as_int(v), (ctrl), 0xf, 0xf, true))
__device__ __forceinline__ unsigned max32(unsigned v) {
    v = umax_(v, DPPU(v, 0xB1)); v = umax_(v, DPPU(v, 0x4E)); v = umax_(v, DPPU(v, 0x141)); v = umax_(v, DPPU(v, 0x140));
    const auto r = __builtin_amdgcn_permlane16_swap(v, v, false, false);
    return umax_(r[0], r[1]);
}
__device__ __forceinline__ float sum16(float v) {
    v += DPPF(v, 0xB1); v += DPPF(v, 0x4E); v += DPPF(v, 0x141); v += DPPF(v, 0x140); return v;
}
__device__ __forceinline__ unsigned bperm(unsigned v, int srclane) { return (unsigned)__builtin_amdgcn_ds_bpermute(srclane << 2, (int)v); }
#define CMPX(a_, b_) do { const unsigned hi_ = umax_(a_, b_), lo_ = (a_ < b_) ? a_ : b_; a_ = hi_; b_ = lo_; } while (0)
__device__ __forceinline__ unsigned max16(unsigned v) { v = umax_(v, DPPU(v, 0xB1)); v = umax_(v, DPPU(v, 0x4E)); v = umax_(v, DPPU(v, 0x141)); v = umax_(v, DPPU(v, 0x140)); return v; }
__device__ __forceinline__ unsigned top16_of8(unsigned (&p)[8], int c) {
    CMPX(p[0], p[1]); CMPX(p[2], p[3]); CMPX(p[4], p[5]); CMPX(p[6], p[7]);
    CMPX(p[0], p[2]); CMPX(p[1], p[3]); CMPX(p[4], p[6]); CMPX(p[5], p[7]);
    CMPX(p[1], p[2]); CMPX(p[5], p[6]); CMPX(p[0], p[4]); CMPX(p[3], p[7]);
    CMPX(p[1], p[5]); CMPX(p[2], p[6]);
    CMPX(p[1], p[4]); CMPX(p[3], p[6]);
    CMPX(p[2], p[4]); CMPX(p[3], p[5]);
    CMPX(p[3], p[4]);
    unsigned W = 0u;
    for (int it = 0; it < 16; ++it) {
        const unsigned m = max16(p[0]);
        W = (c == it) ? m : W;
        const bool win = (p[0] == m);
#pragma unroll
        for (int i = 0; i < 7; ++i) p[i] = win ? p[i + 1] : p[i];
        p[7] = win ? 0u : p[7];
    }
    return W;
}
__device__ __forceinline__ unsigned top16_of4r(unsigned (&p)[4], int c) {
    CMPX(p[0], p[1]); CMPX(p[2], p[3]); CMPX(p[0], p[2]); CMPX(p[1], p[3]); CMPX(p[1], p[2]);
    unsigned W = 0u;
    for (int it = 0; it < 16; ++it) {
        const unsigned m = max16(p[0]);
        W = (c == it) ? m : W;
        const bool win = (p[0] == m);
        p[0] = win ? p[1] : p[0]; p[1] = win ? p[2] : p[1]; p[2] = win ? p[3] : p[2]; p[3] = win ? 0u : p[3];
    }
    return W;
}
__device__ __forceinline__ void topk_fill(LAS unsigned char* lds, const bf16* keys, int h, int tid) {
#pragma unroll
    for (int i = 0; i < 8; ++i) { const int idx = tid + 512 * i, p = idx >> 11, key = (idx >> 4) & 127, ch = idx & 15;
        const v4u v = *(const v4u*)(keys + (size_t)((h * 2 + p) * 128 + key) * 128 + ch * 8);
        *(LAS v4u*)(lds + p * 32768 + key * 256 + ((ch ^ (key & 15)) << 4)) = v; }
}
struct CvtCtx { const float* srcU; long dsrc; const float* gain; unsigned char* dstU; long ddst; float* su; long dsc; int gwave, nw; };
__device__ __forceinline__ void cvt_chunk_load(const CvtCtx& cx, int c, int lane, f32x4 (&v)[4]) {
    const int r = c >> 1, hh = c & 1;
    const float* src = cx.srcU + ((r < 16384) ? 0L : cx.dsrc) + (size_t)(r & 16383) * 2048 + hh * 1024 + 4 * lane;
#pragma unroll
    for (int j = 0; j < 4; ++j) v[j] = *(const f32x4*)(src + 256 * j);
}
__device__ __forceinline__ void cvt_chunk_store(const CvtCtx& cx, int c, int lane, f32x4 (&v)[4]) {
    const int r = c >> 1, hh = c & 1; const bool isu = r < 16384; const int e = r & 16383;
    float mx = 0.f;
#pragma unroll
    for (int j = 0; j < 4; ++j) { if (isu) v[j] = v[j] * *(const f32x4*)(cx.gain + hh * 1024 + 256 * j + 4 * lane);
        mx = fmaxf(mx, fmaxf(fmaxf(fabsf(v[j][0]), fabsf(v[j][1])), fmaxf(fabsf(v[j][2]), fabsf(v[j][3])))); }
    mx = fmaxf(mx, DPPF(mx, 0xB1)); mx = fmaxf(mx, DPPF(mx, 0x4E)); mx = fmaxf(mx, DPPF(mx, 0x141)); mx = fmaxf(mx, DPPF(mx, 0x140));
    { const auto rr = __builtin_amdgcn_permlane16_swap(__float_as_uint(mx), __float_as_uint(mx), false, false); mx = fmaxf(__uint_as_float(rr[0]), __uint_as_float(rr[1])); }
    { const auto rr = __builtin_amdgcn_permlane32_swap(__float_as_uint(mx), __float_as_uint(mx), false, false); mx = fmaxf(__uint_as_float(rr[0]), __uint_as_float(rr[1])); }
    const float sc = fmaxf(mx, 1e-30f) * (1.f / 6.f), inv = 1.f / sc;
    if (lane == 0) (cx.su + (isu ? 0L : cx.dsc))[e * 2 + hh] = sc;
    unsigned char* dst = cx.dstU + (isu ? 0L : cx.ddst) + ((size_t)(hh * 4) * 16384 + e) * 128 + 2 * lane;
#pragma unroll
    for (int j = 0; j < 4; ++j) { unsigned w = 0u;
        w = __builtin_amdgcn_cvt_scalef32_pk_fp4_f32(w, v[j][0] * inv, v[j][1] * inv, 1.0f, 0); w = __builtin_amdgcn_cvt_scalef32_pk_fp4_f32(w, v[j][2] * inv, v[j][3] * inv, 1.0f, 1);
        *(unsigned short*)(dst + (size_t)j * (16384 * 128)) = (unsigned short)w; }
}
__device__ __forceinline__ void topk_unit(const bf16* q, LAS const unsigned char* lds, int* EI, float* GW, int t0, int h, int lane, const CvtCtx& cx, int slot0) {
    const int c = lane & 15, g4 = lane >> 4, rbase = lane & 48;
    int f0 = 0, f1 = 0, f2 = 0, f3 = 0;
    { int cnt = 0;
#pragma unroll
      for (int i = 0; i < 16; ++i)
#pragma unroll
        for (int j = 0; j < 16; ++j) if ((i + 1) * (j + 1) <= 16) { const int fl = i * 16 + j; f0 = (cnt == c) ? fl : f0; f1 = (cnt == c + 16) ? fl : f1; f2 = (cnt == c + 32) ? fl : f2; f3 = (cnt == c + 48) ? fl : f3; ++cnt; } }
    unsigned W[2][8];
#pragma unroll
    for (int p = 0; p < 2; ++p) {
        f32x4 acc[2][8];
#pragma unroll
        for (int mb = 0; mb < 2; ++mb)
#pragma unroll
            for (int kb = 0; kb < 8; ++kb) acc[mb][kb] = (f32x4){0.f, 0.f, 0.f, 0.f};
        const bf16* qp = q + (size_t)(t0 + c) * 2048 + h * 256 + p * 128 + g4 * 8;
        LAS const unsigned char* kp = lds + p * 32768 + c * 256;
        asm volatile("" : "+v"(qp));
#pragma unroll 2
        for (int ks = 0; ks < 4; ++ks) {
            const s16x8 a0 = *(const s16x8*)(qp + ks * 32), a1 = *(const s16x8*)(qp + (size_t)16 * 2048 + ks * 32);
#pragma unroll
            for (int kb = 0; kb < 8; ++kb) { const s16x8 b = *(LAS const s16x8*)(kp + kb * 4096 + (((4 * ks + g4) ^ c) << 4));
                acc[0][kb] = __builtin_amdgcn_mfma_f32_16x16x32_bf16(a0, b, acc[0][kb], 0, 0, 0); acc[1][kb] = __builtin_amdgcn_mfma_f32_16x16x32_bf16(a1, b, acc[1][kb], 0, 0, 0); }
        }
#pragma unroll
        for (int pb = 0; pb < 8; ++pb) {
            unsigned pk[8];
#pragma unroll
            for (int kb = 0; kb < 8; ++kb) pk[kb] = (ordf(acc[pb >> 2][kb][pb & 3]) & ~127u) | (unsigned)(127 - 16 * kb - c);
            const int cc = (slot0 + p * 8 + pb) * cx.nw + cx.gwave;
            f32x4 cr[4];
            asm volatile("" ::: "memory");
            if (cc < 65536) cvt_chunk_load(cx, cc, lane, cr);
            W[p][pb] = top16_of8(pk, c);
            if (cc < 65536) cvt_chunk_store(cx, cc, lane, cr);
            asm volatile("" ::: "memory");
        }
    }
#pragma unroll
    for (int pb = 0; pb < 8; ++pb) {
        const unsigned w0 = W[0][pb], w1 = W[1][pb];
        unsigned cp[4];
        { const float a0 = unordf(bperm(w0, rbase + (f0 >> 4)) & ~127u), b0 = unordf(bperm(w1, rbase + (f0 & 15)) & ~127u); cp[0] = (ordf(a0 + b0) & ~63u) | (unsigned)(63 - c); }
        { const float a0 = unordf(bperm(w0, rbase + (f1 >> 4)) & ~127u), b0 = unordf(bperm(w1, rbase + (f1 & 15)) & ~127u); cp[1] = (ordf(a0 + b0) & ~63u) | (unsigned)(47 - c); }
        { const float a0 = unordf(bperm(w0, rbase + (f2 >> 4)) & ~127u), b0 = unordf(bperm(w1, rbase + (f2 & 15)) & ~127u); cp[2] = (ordf(a0 + b0) & ~63u) | (unsigned)(31 - c); }
        { const float a0 = unordf(bperm(w0, rbase + (f3 >> 4)) & ~127u), b0 = unordf(bperm(w1, rbase + (f3 & 15)) & ~127u); cp[3] = (c + 48 < 50) ? ((ordf(a0 + b0) & ~63u) | (unsigned)(15 - c)) : 0u; }
        const unsigned Wc = top16_of4r(cp, c);
        const int slot = 63 - (int)(Wc & 63u);
        const unsigned fa = bperm((unsigned)f0, rbase + (slot & 15)), fb = bperm((unsigned)f1, rbase + (slot & 15)), fc = bperm((unsigned)f2, rbase + (slot & 15)), fd = bperm((unsigned)f3, rbase + (slot & 15));
        const int sq = slot >> 4; const int flat = (int)((sq == 0) ? fa : (sq == 1) ? fb : (sq == 2) ? fc : fd);
        const float val = unordf(Wc & ~63u);
        const float vmax = __uint_as_float(bperm(__float_as_uint(val), rbase));
        const float e = __expf(val - vmax);
        const float g = e / sum16(e);
        const int k1 = 127 - (int)(bperm(w0, rbase + (flat >> 4)) & 127u), k2 = 127 - (int)(bperm(w1, rbase + (flat & 15)) & 127u);
        const int tok = t0 + 16 * (pb >> 2) + 4 * g4 + (pb & 3);
        EI[(size_t)(tok * 8 + h) * 16 + c] = k1 * 128 + k2; GW[(size_t)(tok * 8 + h) * 16 + c] = g;
    }
}

__device__ __forceinline__ float gelu_tanh_f(float x) {
    const float u = 0.7978845608028654f * (x + 0.044715f * x * x * x);
    const float e = __expf(2.f * u);
    const float th = 1.f - 2.f / (e + 1.f);
    return 0.5f * x * (1.f + th);
}
__device__ __forceinline__ float wave_sum_bfly(float v) {
#pragma unroll
    for (int o = 1; o < 64; o <<= 1) v += __shfl_xor(v, o);
    return v;
}
typedef float f32x2_ __attribute__((ext_vector_type(2)));
#define FP4_DEC(w_, sel_) __builtin_amdgcn_cvt_scalef32_pk_f32_fp4((unsigned)(w_), 1.0f, (sel_))
typedef int i32x8 __attribute__((ext_vector_type(8)));
template <int NBT>
__device__ __forceinline__ void peer_a_slice(const bf16* xb, const int* EI, const unsigned char* U4s, float* pd, int s, int t0, int tstride, int ntok, int lane) {
    const int c = lane & 15, g4 = lane >> 4, k8 = c >> 1;
    const unsigned char* tab = U4s + (size_t)s * (16384 * 128) + (4 * (c & 1) + g4) * 16;
    const int tlast = t0 + (ntok - 1) * tstride;
#define A_TOK(k_) (((t0 + (k_) * tstride) < tlast) ? (t0 + (k_) * tstride) : tlast)
#define A_XS(XS, t_) do { const bf16* xp_ = xb + (size_t)(t_) * 2048 + s * 256 + 128 * (c & 1) + 16 * g4; XS[0] = *(const v4u*)xp_; XS[1] = *(const v4u*)(xp_ + 8); XS[2] = *(const v4u*)(xp_ + 64); XS[3] = *(const v4u*)(xp_ + 72); } while (0)
#define A_ISSUE(U, EV) do { _Pragma("unroll") for (int i = 0; i < 8; ++i) { const int e_ = (int)bperm((unsigned)(EV), (i << 3) + k8); U[i] = *(const v4u*)(tab + (size_t)e_ * 128); } } while (0)
#define A_COMPUTE(U, OUT) do { _Pragma("unroll") for (int i = 0; i < 8; ++i) { f32x4 d_ = (f32x4){0.f, 0.f, 0.f, 0.f}; \
            d_ = __builtin_amdgcn_mfma_scale_f32_16x16x128_f8f6f4((i32x8){(int)U[i][0], (int)U[i][1], (int)U[i][2], (int)U[i][3], 0, 0, 0, 0}, hb, d_, 4, 0, 0, 0x7f7f7f7f, 0, 0x7f7f7f7f); \
            const float o0_ = d_[0] + DPPF(d_[1], 0xB1), o1_ = d_[2] + DPPF(d_[3], 0xB1);        \
            if (k8 == i) OUT = (f32x2_){o0_, o1_}; } } while (0)
    int eL[NBT], eH[NBT], nL[NBT], nH[NBT]; v4u xs[2][4]; v4u UA[8], UB[8];
#pragma unroll
    for (int j = 0; j < NBT; ++j) { const int tj = A_TOK(j); eL[j] = EI[(size_t)tj * 128 + lane]; eH[j] = EI[(size_t)tj * 128 + 64 + lane]; }
    A_XS(xs[0], A_TOK(0));
    A_ISSUE(UA, eL[0]);
    for (int kb = 0; kb < ntok; kb += NBT) {
#pragma unroll
        for (int j = 0; j < NBT; ++j) { const int tj = A_TOK(kb + NBT + j); nL[j] = EI[(size_t)tj * 128 + lane]; nH[j] = EI[(size_t)tj * 128 + 64 + lane]; }
#pragma unroll
        for (int j = 0; j < NBT; ++j) {
            const int t = t0 + (kb + j) * tstride;
            A_ISSUE(UB, eH[j]);
            i32x8 hb;
#pragma unroll
            for (int q = 0; q < 4; ++q) { const v4u w = xs[j & 1][q]; int lo = 0, hi = 0;
                lo = __builtin_amdgcn_cvt_pk_fp8_f32(__uint_as_float(w[0] << 16), __uint_as_float(w[0] & 0xffff0000u), lo, false); lo = __builtin_amdgcn_cvt_pk_fp8_f32(__uint_as_float(w[1] << 16), __uint_as_float(w[1] & 0xffff0000u), lo, true);
                hi = __builtin_amdgcn_cvt_pk_fp8_f32(__uint_as_float(w[2] << 16), __uint_as_float(w[2] & 0xffff0000u), hi, false); hi = __builtin_amdgcn_cvt_pk_fp8_f32(__uint_as_float(w[3] << 16), __uint_as_float(w[3] & 0xffff0000u), hi, true);
                hb[2 * q] = lo; hb[2 * q + 1] = hi; }
            f32x2_ out_lo = (f32x2_){0.f, 0.f}, out_hi = (f32x2_){0.f, 0.f};
            A_COMPUTE(UA, out_lo);
            A_XS(xs[(j + 1) & 1], A_TOK(kb + j + 1));
            A_ISSUE(UA, (j + 1 < NBT) ? eL[(j + 1) % NBT] : nL[0]);
            A_COMPUTE(UB, out_hi);
            if ((c & 1) == 0) { float* pp = pd + ((size_t)s * T + t) * 128 + 8 * k8 + 2 * g4; *(f32x2_*)pp = out_lo; *(f32x2_*)(pp + 64) = out_hi; }
        }
#pragma unroll
        for (int j = 0; j < NBT; ++j) { eL[j] = nL[j]; eH[j] = nH[j]; }
    }
#undef A_TOK
#undef A_XS
#undef A_ISSUE
#undef A_COMPUTE
}
__device__ __forceinline__ void peer_a2_token(const float* pd, const float* ssq, const int* EI, const float* su, const float* sv, float* GW, float* W1, int t, int lane) {
    float a0 = 0.f, a1 = 0.f, b0 = 0.f, b1 = 0.f;
#pragma unroll
    for (int s = 0; s < 4; ++s) { const float* pp = pd + ((size_t)s * T + t) * 128; a0 += pp[lane]; a1 += pp[64 + lane]; }
#pragma unroll
    for (int s = 4; s < 8; ++s) { const float* pp = pd + ((size_t)s * T + t) * 128; b0 += pp[lane]; b1 += pp[64 + lane]; }
    const float rs = rsqrtf(ssq[t] * (1.f / 2048.f) + EPS);
    float* gp = GW + (size_t)t * 128; float* hp = W1 + (size_t)t * 128; const int pl = lane;
    const int e0 = EI[(size_t)t * 128 + pl], e1 = EI[(size_t)t * 128 + 64 + pl];
    const float g0 = gp[pl] * gelu_tanh_f(rs * (a0 * su[2 * e0] + b0 * su[2 * e0 + 1])), g1 = gp[64 + pl] * gelu_tanh_f(rs * (a1 * su[2 * e1] + b1 * su[2 * e1 + 1]));
    gp[pl] = g0 * sv[2 * e0]; hp[pl] = g0 * sv[2 * e0 + 1];
    gp[64 + pl] = g1 * sv[2 * e1]; hp[64 + pl] = g1 * sv[2 * e1 + 1];
}
template <int NBT>
__device__ __forceinline__ void peer_b_slice(float* xio, const int* EI, const float* W, const unsigned char* V4s, bf16* xb, float* ssq_out, int s, int t0, int tstride, int ntok, int lane) {
    const int eg = lane >> 3, c8 = lane & 7;
    const unsigned char* tab = V4s + (size_t)s * (16384 * 128) + c8 * 16;
    const int tlast = t0 + (ntok - 1) * tstride;
    const int eoff = s * 256 + c8 * 32 + 4 * eg;
#define B_TOK(k_) (((t0 + (k_) * tstride) < tlast) ? (t0 + (k_) * tstride) : tlast)
#define B_ISSUE(V, WK, EV, WV) do { _Pragma("unroll") for (int i = 0; i < 8; ++i) { const int src_ = (i << 3) + eg; const int e_ = (int)bperm((unsigned)(EV), src_); \
        WK[i] = __uint_as_float(bperm(__float_as_uint(WV), src_)); V[i] = *(const v4u*)(tab + (size_t)e_ * 128); } } while (0)
#define B_COMPUTE(V, WK) do { _Pragma("unroll") for (int i = 0; i < 8; ++i) { const f32x2_ wk2 = (f32x2_){WK[i], WK[i]}; \
            _Pragma("unroll") for (int q = 0; q < 4; ++q) { const unsigned wv_ = V[i][q]; \
                acc[4 * q + 0] = __builtin_elementwise_fma(FP4_DEC(wv_, 0), wk2, acc[4 * q + 0]); acc[4 * q + 1] = __builtin_elementwise_fma(FP4_DEC(wv_, 1), wk2, acc[4 * q + 1]); \
                acc[4 * q + 2] = __builtin_elementwise_fma(FP4_DEC(wv_, 2), wk2, acc[4 * q + 2]); acc[4 * q + 3] = __builtin_elementwise_fma(FP4_DEC(wv_, 3), wk2, acc[4 * q + 3]); } } } while (0)
    int eL[NBT], eH[NBT], nL[NBT], nH[NBT]; float wL[NBT], wH[NBT], mL[NBT], mH[NBT]; f32x4 xv; v4u VA[8], VB[8]; float KA[8], KB[8];
#pragma unroll
    for (int j = 0; j < NBT; ++j) { const int tj = B_TOK(j); eL[j] = EI[(size_t)tj * 128 + lane]; eH[j] = EI[(size_t)tj * 128 + 64 + lane]; wL[j] = W[(size_t)tj * 128 + lane]; wH[j] = W[(size_t)tj * 128 + 64 + lane]; }
    B_ISSUE(VA, KA, eL[0], wL[0]);
    for (int kb = 0; kb < ntok; kb += NBT) {
#pragma unroll
        for (int j = 0; j < NBT; ++j) { const int tj = B_TOK(kb + NBT + j); nL[j] = EI[(size_t)tj * 128 + lane]; nH[j] = EI[(size_t)tj * 128 + 64 + lane]; mL[j] = W[(size_t)tj * 128 + lane]; mH[j] = W[(size_t)tj * 128 + 64 + lane]; }
#pragma unroll
        for (int j = 0; j < NBT; ++j) {
            const int t = t0 + (kb + j) * tstride;
            xv = *(const f32x4*)(xio + (size_t)t * 2048 + eoff);
            B_ISSUE(VB, KB, eH[j], wH[j]);
            f32x2_ acc[16];
#pragma unroll
            for (int jj = 0; jj < 16; ++jj) acc[jj] = (f32x2_){0.f, 0.f};
            B_COMPUTE(VA, KA);
            B_ISSUE(VA, KA, (j + 1 < NBT) ? eL[(j + 1) % NBT] : nL[0], (j + 1 < NBT) ? wL[(j + 1) % NBT] : mL[0]);
            B_COMPUTE(VB, KB);
            float r16[16], r8[8], r4[4];
#pragma unroll
            for (int i = 0; i < 16; ++i) { const float lo_ = (i & 1) ? acc[i >> 1].y : acc[i >> 1].x, hi_ = (i & 1) ? acc[8 + (i >> 1)].y : acc[8 + (i >> 1)].x;
                const auto r = __builtin_amdgcn_permlane32_swap(__float_as_uint(lo_), __float_as_uint(hi_), false, false); r16[i] = __uint_as_float(r[0]) + __uint_as_float(r[1]); }
#pragma unroll
            for (int i = 0; i < 8; ++i) { const auto r = __builtin_amdgcn_permlane16_swap(__float_as_uint(r16[i]), __float_as_uint(r16[8 + i]), false, false); r8[i] = __uint_as_float(r[0]) + __uint_as_float(r[1]); }
            const bool b3 = (lane & 8) != 0;
#pragma unroll
            for (int i = 0; i < 4; ++i) { const float keep = b3 ? r8[4 + i] : r8[i], give = b3 ? r8[i] : r8[4 + i]; r4[i] = keep + DPPF(give, 0x128); }
            f32x4 o; o[0] = xv[0] + r4[0]; o[1] = xv[1] + r4[1]; o[2] = xv[2] + r4[2]; o[3] = xv[3] + r4[3];
            *(f32x4*)(xio + (size_t)t * 2048 + eoff) = o;
            if (xb) { v2u bb; bb.x = pk2(o[0], o[1]); bb.y = pk2(o[2], o[3]); *(v2u*)(xb + (size_t)t * 2048 + eoff) = bb; }
            float ss = (o[0] * o[0] + o[1] * o[1]) + (o[2] * o[2] + o[3] * o[3]);
            ss += DPPF(ss, 0xB1); ss += DPPF(ss, 0x4E); ss += DPPF(ss, 0x141); ss += DPPF(ss, 0x140);
            { const auto r = __builtin_amdgcn_permlane16_swap(__float_as_uint(ss), __float_as_uint(ss), false, false); ss = __uint_as_float(r[0]) + __uint_as_float(r[1]); }
            { const auto r = __builtin_amdgcn_permlane32_swap(__float_as_uint(ss), __float_as_uint(ss), false, false); ss = __uint_as_float(r[0]) + __uint_as_float(r[1]); }
            if (lane == 0) unsafeAtomicAdd(ssq_out + t, ss);
        }
#pragma unroll
        for (int j = 0; j < NBT; ++j) { eL[j] = nL[j]; eH[j] = nH[j]; wL[j] = mL[j]; wH[j] = mH[j]; }
    }
#undef B_TOK
#undef B_ISSUE
#undef B_COMPUTE
}
__device__ __forceinline__ void final_norm_row(float* xio, const float* ssq, const float* fin, int t, int lane, float oscale) {
    const float r2 = rsqrtf(ssq[t] * (1.f / 2048.f) + EPS) * oscale;
    float* xr = xio + (size_t)t * 2048 + 4 * lane;
#pragma unroll
    for (int j = 0; j < 8; ++j) { const f32x4 xv = *(const f32x4*)(xr + 256 * j), g = *(const f32x4*)(fin + 256 * j + 4 * lane); f32x4 o;
        o[0] = xv[0] * r2 * g[0]; o[1] = xv[1] * r2 * g[1]; o[2] = xv[2] * r2 * g[2]; o[3] = xv[3] * r2 * g[3]; *(f32x4*)(xr + 256 * j) = o; }
}
typedef short s16x4 __attribute__((ext_vector_type(4)));
__device__ __forceinline__ unsigned cvt_pk_bf16_(float lo, float hi) { unsigned r; asm volatile("v_cvt_pk_bf16_f32 %0, %1, %2" : "=v"(r) : "v"(lo), "v"(hi)); return r; }
constexpr int ATT_K_OFF = 0, ATT_V_OFF = 40960, ATT_VSTRIDE = 648, ATT_LDS = ATT_V_OFF + 64 * ATT_VSTRIDE;
__device__ __forceinline__ void attn_fill(LAS unsigned char* lds, const bf16* K, const bf16* Vt, int b, int kvh, int kw0, int tid) {
    const size_t tb = (size_t)b * 4096;
#pragma unroll
    for (int i = 0; i < 5; ++i) { const int idx = tid + 512 * i, row = idx >> 3, ch = idx & 7, key = kw0 + row;
        v4u v = (v4u){0u, 0u, 0u, 0u}; if (key >= 0 && key < 4096) v = *(const v4u*)(K + (tb + key) * 512 + kvh * 64 + ch * 8);
        *(LAS v4u*)(lds + ATT_K_OFF + row * 128 + ((ch ^ ((row >> 1) & 7)) << 4)) = v; }
#pragma unroll
    for (int i = 0; i < 10; ++i) { const int idx = tid + 512 * i, d = idx / 80, pc = idx % 80, key = kw0 + pc * 4;
        v2u v = (v2u){0u, 0u}; if (key >= 0 && key < 4096) v = *(const v2u*)(Vt + (size_t)(kvh * 64 + d) * 16384 + tb + key);
        *(LAS v2u*)(lds + ATT_V_OFF + d * ATT_VSTRIDE + pc * 8) = v; }
}
__device__ __forceinline__ void attn_task(LAS const unsigned char* lds, const bf16* Q, bf16* O, const float* sinks, int b, int hq, int q0, int kw0, int lane) {
    const int c = lane & 31, hi = lane >> 5;
    const size_t tb = (size_t)b * 4096;
    s16x8 qf[4];
    { const bf16* qp = Q + (tb + q0 + c) * 2048 + hq * 64 + hi * 8;
#pragma unroll
      for (int ks = 0; ks < 4; ++ks) qf[ks] = *(const s16x8*)(qp + ks * 16); }
    const float sink2 = sinks[hq] * 1.4426950408889634f;
    float m = sink2, l = (hi == 0) ? 1.f : 0.f;
    f32x16 o0, o1;
#pragma unroll
    for (int r = 0; r < 16; ++r) { o0[r] = 0.f; o1[r] = 0.f; }
    const int kt_lo = (q0 < 128) ? ((128 - q0) >> 5) : 0, kt_hi = ((4192 - q0) >> 5) < 8 ? ((4192 - q0) >> 5) : 8;
    for (int kt = kt_lo; kt <= kt_hi; ++kt) {
        const int key0 = q0 - 128 + 32 * kt, row0 = key0 - kw0;
        s16x8 kf[4]; s16x4 va[2][2][2];
        { const int row = row0 + c; LAS const unsigned char* kp = lds + ATT_K_OFF + row * 128; const int sw = (row >> 1) & 7;
#pragma unroll
          for (int ks = 0; ks < 4; ++ks) kf[ks] = *(LAS const s16x8*)(kp + (((2 * ks + hi) ^ sw) << 4)); }
#pragma unroll
        for (int db = 0; db < 2; ++db)
#pragma unroll
            for (int s = 0; s < 2; ++s) { LAS const unsigned char* vp = lds + ATT_V_OFF + (db * 32 + c) * ATT_VSTRIDE + (row0 + 16 * s + 4 * hi) * 2; va[db][s][0] = *(LAS const s16x4*)vp; va[db][s][1] = *(LAS const s16x4*)(vp + 16); }
        f32x16 sa;
#pragma unroll
        for (int r = 0; r < 16; ++r) sa[r] = 0.f;
#pragma unroll
        for (int ks = 0; ks < 4; ++ks) sa = __builtin_amdgcn_mfma_f32_32x32x16_bf16(kf[ks], qf[ks], sa, 0, 0, 0);
        if (kt == 0 || kt == 8) {
            const int dbase = key0 - (q0 + c) + 4 * hi;
#pragma unroll
            for (int r = 0; r < 16; ++r) { const int d = dbase + (r & 3) + 8 * (r >> 2); if (d < -128 || d > 128) sa[r] = -1e30f; }
        }
        float mx = sa[0];
#pragma unroll
        for (int r = 1; r < 16; ++r) mx = fmaxf(mx, sa[r]);
        { const auto rr = __builtin_amdgcn_permlane32_swap(__float_as_uint(mx), __float_as_uint(mx), false, false); mx = fmaxf(__uint_as_float(rr[0]), __uint_as_float(rr[1])); }
        const float mn = fmaxf(m, mx), alpha = __builtin_amdgcn_exp2f(m - mn);
        m = mn;
        float ps = 0.f;
#pragma unroll
        for (int r = 0; r < 16; ++r) { sa[r] = __builtin_amdgcn_exp2f(sa[r] - mn); ps += sa[r]; }
        l = l * alpha + ps;
#pragma unroll
        for (int r = 0; r < 16; ++r) { o0[r] *= alpha; o1[r] *= alpha; }
        s16x8 pf[2];
#pragma unroll
        for (int s = 0; s < 2; ++s) { v4u w; w.x = cvt_pk_bf16_(sa[8 * s + 0], sa[8 * s + 1]); w.y = cvt_pk_bf16_(sa[8 * s + 2], sa[8 * s + 3]); w.z = cvt_pk_bf16_(sa[8 * s + 4], sa[8 * s + 5]); w.w = cvt_pk_bf16_(sa[8 * s + 6], sa[8 * s + 7]);
            pf[s] = __builtin_bit_cast(s16x8, w); }
#pragma unroll
        for (int s = 0; s < 2; ++s) {
            const s16x8 v0 = __builtin_shufflevector(va[0][s][0], va[0][s][1], 0, 1, 2, 3, 4, 5, 6, 7), v1 = __builtin_shufflevector(va[1][s][0], va[1][s][1], 0, 1, 2, 3, 4, 5, 6, 7);
            o0 = __builtin_amdgcn_mfma_f32_32x32x16_bf16(v0, pf[s], o0, 0, 0, 0);
            o1 = __builtin_amdgcn_mfma_f32_32x32x16_bf16(v1, pf[s], o1, 0, 0, 0);
        }
    }
    { const auto rr = __builtin_amdgcn_permlane32_swap(__float_as_uint(l), __float_as_uint(l), false, false); l = __uint_as_float(rr[0]) + __uint_as_float(rr[1]); }
    const float il = 1.f / l;
    bf16* op = O + (tb + q0 + c) * 2048 + hq * 64 + 4 * hi;
#pragma unroll
    for (int g = 0; g < 4; ++g) {
        v2u w0, w1;
        w0.x = cvt_pk_bf16_(o0[4 * g + 0] * il, o0[4 * g + 1] * il); w0.y = cvt_pk_bf16_(o0[4 * g + 2] * il, o0[4 * g + 3] * il);
        w1.x = cvt_pk_bf16_(o1[4 * g + 0] * il, o1[4 * g + 1] * il); w1.y = cvt_pk_bf16_(o1[4 * g + 2] * il, o1[4 * g + 3] * il);
        *(v2u*)(op + 8 * g) = w0; *(v2u*)(op + 32 + 8 * g) = w1;
    }
}
typedef float fx2 __attribute__((ext_vector_type(2)));
__device__ __forceinline__ fx2 bf2_(unsigned w) { fx2 r; r[0] = __uint_as_float(w << 16); r[1] = __uint_as_float(w & 0xffff0000u); return r; }
__device__ __forceinline__ void fft16_item(bf16* Zp, const float* tw, int bg, int l, int s1h, int lane) {
    const int s1 = s1h * 128 + 2 * lane;
    bf16* base = Zp + ((size_t)(bg * 16) * 256 + l) * 512 + s1;
    fx2 zr[16], zi[16];
#pragma unroll
    for (int s2 = 0; s2 < 16; ++s2) { zr[s2] = bf2_(*(const unsigned*)(base + (size_t)s2 * 256 * 512)); zi[s2] = bf2_(*(const unsigned*)(base + (size_t)s2 * 256 * 512 + 256)); }
    fx2 er[16], ei[16];
#pragma unroll
    for (int d = 0; d < 4; ++d) {
        const fx2 ar = zr[d], ai_ = zi[d], br = zr[4 + d], bi = zi[4 + d], cr = zr[8 + d], ci = zi[8 + d], dr = zr[12 + d], di = zi[12 + d];
        const fx2 s0r = ar + cr, s0i = ai_ + ci, s1r = ar - cr, s1i = ai_ - ci, s2r = br + dr, s2i = bi + di, s3r = br - dr, s3i = bi - di;
        er[0 * 4 + d] = s0r + s2r; ei[0 * 4 + d] = s0i + s2i;
        er[1 * 4 + d] = s1r + s3i; ei[1 * 4 + d] = s1i - s3r;
        er[2 * 4 + d] = s0r - s2r; ei[2 * 4 + d] = s0i - s2i;
        er[3 * 4 + d] = s1r - s3i; ei[3 * 4 + d] = s1i + s3r;
    }
#pragma unroll
    for (int a = 1; a < 4; ++a)
#pragma unroll
        for (int d = 1; d < 4; ++d) {
            const float ang = 6.283185307179586f * (float)(a * d) / 16.f; const float c = __builtin_cosf(ang), sn = __builtin_sinf(ang);
            const fx2 xr = er[a * 4 + d], xi = ei[a * 4 + d];
            er[a * 4 + d] = xr * c + xi * sn; ei[a * 4 + d] = xi * c - xr * sn;
        }
#pragma unroll
    for (int a = 0; a < 4; ++a) {
        const fx2 ar = er[a * 4 + 0], ai_ = ei[a * 4 + 0], br = er[a * 4 + 1], bi = ei[a * 4 + 1], cr = er[a * 4 + 2], ci = ei[a * 4 + 2], dr = er[a * 4 + 3], di = ei[a * 4 + 3];
        const fx2 s0r = ar + cr, s0i = ai_ + ci, s1r = ar - cr, s1i = ai_ - ci, s2r = br + dr, s2i = bi + di, s3r = br - dr, s3i = bi - di;
        fx2 Dr[4], Di[4];
        Dr[0] = s0r + s2r; Di[0] = s0i + s2i; Dr[1] = s1r + s3i; Di[1] = s1i - s3r; Dr[2] = s0r - s2r; Di[2] = s0i - s2i; Dr[3] = s1r - s3i; Di[3] = s1i + s3r;
#pragma unroll
        for (int b = 0; b < 4; ++b) {
            const int k2 = a + 4 * b;
            const f32x4 t0 = *(const f32x4*)(tw + (size_t)(k2 * 256 + s1) * 2);
            const fx2 cc = (fx2){t0[0], t0[2]}, ss = (fx2){t0[1], t0[3]};
            const fx2 hr = Dr[b] * cc + Di[b] * ss, hi_ = Di[b] * cc - Dr[b] * ss;
            *(unsigned*)(base + (size_t)k2 * 256 * 512) = pk2(hr[0], hr[1]); *(unsigned*)(base + (size_t)k2 * 256 * 512 + 256) = pk2(hi_[0], hi_[1]);
        }
    }
}
__device__ __forceinline__ int static_unit(int nM, int nN, int G, int c, int i) {
    const int nwg = nM * nN; const long L = (long)i * G + c; if (L >= nwg) return -1;
    int wgid = (int)L; { const int q = nwg / 8, r = nwg % 8, xcd = wgid % 8, off = wgid / 8; wgid = (xcd < r ? xcd * (q + 1) : r * (q + 1) + (xcd - r) * q) + off; }
    const int nig = 8 * nN, gid = wgid / nig, fm = gid * 8, gsz = (nM - fm) < 8 ? (nM - fm) : 8;
    return ((fm + ((wgid % nig) % gsz)) << 16) | ((wgid % nig) / gsz);
}
#ifndef REP_PRO
#define REP_PRO 1
#endif
#ifndef REP_GEMM
#define REP_GEMM 1
#endif
#ifndef REP_ATT
#define REP_ATT 1
#endif
#ifndef REP_LITE
#define REP_LITE 0
#endif
#ifndef REP_Q
#define REP_Q 1
#endif
#ifndef REP_PA
#define REP_PA 1
#endif
#ifndef REP_TK
#define REP_TK 1
#endif
enum { PH_PRO = 0, PH_G1 = 1, PH_S1 = 2, PH_G2 = 3, PH_G3 = 4, PH_Q0 = 5, PH_TK0 = 6, PH_PA0 = 7, PH_PW0 = 8, PH_PB0 = 9, PH_QKV = 10, PH_ATT = 11, PH_WO = 12, PH_Q1 = 13, PH_TK1 = 14, PH_PA1 = 15, PH_PW1 = 16, PH_PB1 = 17, PH_FIN = 18, PH_END = 19 };
__global__ void __launch_bounds__(NWAVES * 64, 2) mega(Args a) {
    extern __shared__ __attribute__((aligned(16))) unsigned char lds_raw[];
    LAS unsigned char* lds = (LAS unsigned char*)lds_raw;
    cg::grid_group grid = cg::this_grid();
    const int wave = __builtin_amdgcn_readfirstlane(threadIdx.x >> 6);
#define FRESH_IDS() int lane; asm volatile("v_mbcnt_lo_u32_b32 %0, -1, 0\n\tv_mbcnt_hi_u32_b32 %0, -1, %0" : "=v"(lane)); const int tid = wave * 64 + lane; (void)tid
    const int G = gridDim.x, bx = blockIdx.x;
    unsigned char* ws = a.ws;
    const int lo = a.ph_lo, hi = a.ph_hi;
    volatile LAS unsigned* MISC = (volatile LAS unsigned*)(lds + LDSCTL_OFF);
    if (threadIdx.x < 16) MISC[threadIdx.x] = 0u;
    __syncthreads();
    XcdBarrier xbar = xcd_barrier_post((unsigned*)(ws + WS_CTL) + CW_BAR, MISC + 8);
#define IN(k) (lo <= (k) && (k) < hi)
#ifdef DIAG_A
#define STAMP(i) do { if (bx == 0 && threadIdx.x == 0) ((unsigned long long*)(ws + WS_STAMP))[i] = __builtin_amdgcn_s_memrealtime(); } while (0)
#else
#define STAMP(i) do { } while (0)
#endif
#define SEAM(k) do { if (IN(k) && IN((k) + 1)) { if ((k) == PH_PRO) grid.sync(); else xcd_barrier(xbar); } STAMP((k) + 1); } while (0)
    STAMP(0);
    for (int rep_ = 0; rep_ < REP_PRO; ++rep_)
    if (IN(PH_PRO)) { FRESH_IDS();
        const int gw = bx * NWAVES + wave, NGW = G * NWAVES;
        const size_t gtid = (size_t)bx * (NWAVES * 64) + tid, ngt = (size_t)G * NWAVES * 64;
        LAS float* scr = (LAS float*)(lds + wave * 16384);
        {
            constexpr int I_SQ = (DM / 64) * (DM / 32), I_QKV = (DM / 64) * (QKVW / 32);
            constexpr int NITEMS = 4 * I_SQ + I_QKV;
            for (int it = gw; it < NITEMS; it += NGW) {
                int r = it;
                if (r < I_SQ) { transpose_item<0>(a.in[3], DM, DM, nullptr, (bf16*)(ws + WS_WOF), scr, r, lane); continue; } r -= I_SQ;
                if (r < I_SQ) { transpose_item<0>(a.in[5], DM, DM, nullptr, (bf16*)(ws + WS_WOA), scr, r, lane); continue; } r -= I_SQ;
                if (r < I_SQ) { transpose_item<0>(a.in[7], DM, DM, a.in[2], (bf16*)(ws + WS_WQ0), scr, r, lane); continue; } r -= I_SQ;
                if (r < I_SQ) { transpose_item<0>(a.in[7] + (size_t)DM * DM, DM, DM, a.in[2] + DM, (bf16*)(ws + WS_WQ1), scr, r, lane); continue; } r -= I_SQ;
                transpose_item<1>(a.in[4], DM, QKVW, a.in[1] + DM, (bf16*)(ws + WS_WQKV), scr, r, lane);
            }
        }
        for (int row = gw; row < T; row += NGW) {
            const f32x4* xr = (const f32x4*)(a.in[0] + (size_t)row * DM) + lane;
            const f32x4* gr = (const f32x4*)a.in[1] + lane;
            f32x4 v[8]; float s = 0.f;
#pragma unroll
            for (int j = 0; j < 8; ++j) { v[j] = xr[64 * j]; s += (v[j][0] * v[j][0] + v[j][1] * v[j][1]) + (v[j][2] * v[j][2] + v[j][3] * v[j][3]); }
            const float r = rsqrtf(wsum(s) * (1.f / DM) + EPS);
            const int b = row >> 12, sp = row & 4095;
#pragma unroll
            for (int j = 0; j < 8; ++j) { const f32x4 gg = gr[64 * j]; v2u o; o.x = pk2(v[j][0] * r * gg[0], v[j][1] * r * gg[1]); o.y = pk2(v[j][2] * r * gg[2], v[j][3] * r * gg[3]);
                *(v2u*)((bf16*)(ws + WS_XG) + ((size_t)((b * 8 + j) * 4096 + sp) * 256 + 4 * lane)) = o; }
        }
        for (size_t i = gtid; i < (size_t)256 * 512 / 8; i += ngt) {
            const int k1 = (int)(i >> 6), c0 = (int)(i & 63) * 8, part = c0 >> 8, s0 = c0 & 255;
            float v[8];
#pragma unroll
            for (int e = 0; e < 8; ++e) { const int m = (k1 * (s0 + e)) & 255; const float rev = (float)m * (1.f / 256.f); v[e] = (part ? __builtin_amdgcn_sinf(rev) : __builtin_amdgcn_cosf(rev)) * (1.f / 64.f); }
            v4u o; o.x = pk2(v[0], v[1]); o.y = pk2(v[2], v[3]); o.z = pk2(v[4], v[5]); o.w = pk2(v[6], v[7]);
            *(v4u*)((bf16*)(ws + WS_A2) + i * 8) = o;
        }
        for (size_t i = gtid; i < (size_t)16 * 256; i += ngt) {
            const int k2 = (int)(i >> 8), s1 = (int)(i & 255); const float rev = (float)(k2 * s1) * (1.f / 4096.f);
            ((float*)(ws + WS_TW))[2 * i] = __builtin_amdgcn_cosf(rev); ((float*)(ws + WS_TW))[2 * i + 1] = __builtin_amdgcn_sinf(rev);
        }
        for (size_t i = gtid; i < (size_t)512 * 256 / 8; i += ngt) {
            const int n = (int)(i >> 5), c0 = (int)(i & 31) * 8, part = n >> 8, l = n & 255;
            float v[8];
#pragma unroll
            for (int e = 0; e < 8; ++e) { const int m = (l * (c0 + e)) & 255; const float rev = (float)m * (1.f / 256.f); v[e] = (part ? -__builtin_amdgcn_sinf(rev) : __builtin_amdgcn_cosf(rev)) * (1.f / 16.f); }
            v4u o; o.x = pk2(v[0], v[1]); o.y = pk2(v[2], v[3]); o.z = pk2(v[4], v[5]); o.w = pk2(v[6], v[7]);
            *(v4u*)((bf16*)(ws + WS_WCS) + i * 8) = o;
        }
        for (size_t i = gtid; i < (size_t)4096 * 32; i += ngt) {
            const int pos = (int)(i >> 5), fi = (int)(i & 31);
            const double inv = exp2(-(double)fi * (13.287712379549449 / 32.0));
            double sn, cs; sincos((double)pos * inv, &sn, &cs);
            ((float*)(ws + WS_ROPE))[2 * i] = (float)cs; ((float*)(ws + WS_ROPE))[2 * i + 1] = (float)sn;
        }
        cvt_stream(a.in[8], (bf16*)(ws + WS_KEYS), (size_t)2 * PH * 2 * 128 * 128 / 8, gtid, ngt);
    }
    SEAM(PH_PRO);
    for (int rep_ = 0; rep_ < REP_GEMM; ++rep_)
    if (IN(PH_G1)) { FRESH_IDS();
        int Kq = FW; asm volatile("" : "+s"(Kq));
        pg8::Gemm g{(const pg8::bf16_t*)(ws + WS_WCS), (const pg8::bf16_t*)(ws + WS_XG), 512, T * FG, Kq}; pg8::StaticOrder S; S.init(512, T * FG, G, bx);
        pg8::EpiZt E{(pg8::bf16_t*)(ws + WS_ZT)};
        pg8::gemm_phase<pg8::EpiZt, pg8::StaticOrder, true, true>(lds, g, S, E);
    }
    SEAM(PH_G1);
    if (IN(PH_S1)) { FRESH_IDS();
        const int gw = bx * NWAVES + wave, NGW = G * NWAVES;
        for (int it = gw; it < 32 * 256 * 2; it += NGW) fft16_item((bf16*)(ws + WS_ZT), (const float*)(ws + WS_TW), it >> 9, (it >> 1) & 255, it & 1, lane);
    }
    SEAM(PH_S1);
    for (int rep_ = 0; rep_ < REP_GEMM; ++rep_)
    if (IN(PH_G2)) { FRESH_IDS();
        pg8::Gemm g{(const pg8::bf16_t*)(ws + WS_A2), (const pg8::bf16_t*)(ws + WS_ZT), 256, 131072, 512}; pg8::StaticOrder S; S.init(256, 131072, G, bx);
        pg8::EpiY E{(pg8::bf16_t*)(ws + WS_Y)};
        pg8::gemm_phase<pg8::EpiY, pg8::StaticOrder, true, true>(lds, g, S, E);
    }
    SEAM(PH_G2);
    if (IN(PH_G3)) { FRESH_IDS();
        pg8::Gemm g{(const pg8::bf16_t*)(ws + WS_Y), (const pg8::bf16_t*)(ws + WS_WOF), T, DM, DM}; pg8::StaticOrder S; S.init(T, DM, G, bx);
        pg8::EpiRes E{a.in[0], a.out, (pg8::bf16_t*)(ws + WS_XB), (float*)(ws + WS_SSQ_A)};
        pg8::gemm_phase<pg8::EpiRes, pg8::StaticOrder, true, true>(lds, g, S, E);
    }
    SEAM(PH_G3);
#define PEER_LAYER(L) do { \
        const int pq = L ? PH_Q1 : PH_Q0, ptk = L ? PH_TK1 : PH_TK0, ppa = L ? PH_PA1 : PH_PA0, ppw = L ? PH_PW1 : PH_PW0, ppb = L ? PH_PB1 : PH_PB0; \
        for (int rep_ = 0; rep_ < REP_Q; ++rep_) \
        if (IN(pq)) { FRESH_IDS(); \
            pg8::Gemm g{(const pg8::bf16_t*)(ws + WS_XB), (const pg8::bf16_t*)(ws + (L ? WS_WQ1 : WS_WQ0)), T, DM, DM}; pg8::StaticOrder S; S.init(T, DM, G, bx); \
            pg8::EpiScale E{(pg8::bf16_t*)(ws + WS_Q), (const float*)(ws + (L ? WS_SSQ_C : WS_SSQ_A))}; \
            pg8::gemm_phase<pg8::EpiScale, pg8::StaticOrder, true, true>(lds, g, S, E); \
        } \
        if (IN(pq) && IN(ptk)) { asm volatile("s_waitcnt vmcnt(0)" ::: "memory"); __syncthreads(); } STAMP(pq + 1); \
        if (IN(ptk)) { FRESH_IDS(); \
            const bf16* keys = (const bf16*)(ws + WS_KEYS) + (size_t)L * PH * 2 * 128 * 128; \
            CvtCtx cx; cx.srcU = a.in[9] + (size_t)L * NEXP * DM; cx.dsrc = (long)((a.in[10] + (size_t)L * NEXP * DM) - cx.srcU); cx.gain = a.in[2] + L * DM; cx.dstU = ws + (L ? WS_U1 : WS_U0); cx.ddst = (long)WS_V0 - (long)WS_U0; cx.su = (float*)(ws + WS_SU) + L * 32768; cx.dsc = ((long)WS_SV - (long)WS_SU) / 4; cx.gwave = bx * NWAVES + wave; cx.nw = G * NWAVES; \
            int slot = 0; \
            for (int rep_ = 0; rep_ < REP_TK; ++rep_) { slot = 0; \
            for (int ui = 0; ; ++ui) {        \
                const int upk = static_unit(T / 256, DM / 256, G, bx, ui); if (upk < 0) break; \
                const int h = upk & 0xffff, tblk = upk >> 16; \
                __syncthreads(); \
                topk_fill(lds, keys, h, tid); \
                __syncthreads(); \
                topk_unit((const bf16*)(ws + WS_Q), lds, (int*)(ws + WS_EI), (float*)(ws + WS_GW), tblk * 256 + wave * 32, h, lane, cx, slot); \
                slot += 16; \
            } } \
            for (; slot * cx.nw + cx.gwave < 65536; ++slot) { f32x4 cr[4]; const int cc = slot * cx.nw + cx.gwave; cvt_chunk_load(cx, cc, lane, cr); cvt_chunk_store(cx, cc, lane, cr); } \
        } \
        SEAM(ptk); \
        if (IN(ppa)) { FRESH_IDS(); \
            const int xv = bx & 7, nxw = (G >> 3) * NWAVES, wx = (bx >> 3) * NWAVES + wave; \
            for (int rep_ = 0; rep_ < REP_PA; ++rep_) \
            peer_a_slice<8>((const bf16*)(ws + WS_XB), (const int*)(ws + WS_EI), (const unsigned char*)(ws + (L ? WS_U1 : WS_U0)), (float*)(ws + WS_PD), xv, wx, nxw, T / nxw, lane); \
        } \
        SEAM(ppa); \
        if (IN(ppw)) { FRESH_IDS(); \
            const int gw = bx * NWAVES + wave, NGW = G * NWAVES; \
            for (int t = gw; t < T; t += NGW) peer_a2_token((const float*)(ws + WS_PD), (const float*)(ws + (L ? WS_SSQ_C : WS_SSQ_A)), (const int*)(ws + WS_EI), (const float*)(ws + WS_SU) + L * 32768, (const float*)(ws + WS_SV) + L * 32768, (float*)(ws + WS_GW), (float*)(ws + WS_W1), t, lane); \
        } \
        SEAM(ppw); \
        if (IN(ppb)) { FRESH_IDS(); \
            const int xv = bx & 7, nxw = (G >> 3) * NWAVES, wx = (bx >> 3) * NWAVES + wave; \
            peer_b_slice<4>(a.out, (const int*)(ws + WS_EI), (const float*)(ws + ((xv < 4) ? WS_GW : WS_W1)), (const unsigned char*)(ws + (L ? WS_V1 : WS_V0)), L ? (bf16*)nullptr : (bf16*)(ws + WS_XB), (float*)(ws + (L ? WS_SSQ_D : WS_SSQ_B)), xv, wx, nxw, T / nxw, lane); \
        } \
    } while (0)
    float oscale = 1.f;
    PEER_LAYER(0);
    SEAM(PH_PB0);
    for (int rep_ = 0; rep_ < REP_GEMM; ++rep_)
    if (IN(PH_QKV)) { FRESH_IDS();
        {
            pg8::Gemm g{(const pg8::bf16_t*)(ws + WS_XB), (const pg8::bf16_t*)(ws + WS_WQKV), T, 2560, DM}; pg8::StaticOrder S; S.init(T, 2560, G, bx);
            pg8::EpiQK E{(pg8::bf16_t*)(ws + WS_QB), (pg8::bf16_t*)(ws + WS_KB), (const float*)(ws + WS_SSQ_B), (const float*)(ws + WS_ROPE), 0.125f * 1.4426950408889634f};
            pg8::gemm_phase<pg8::EpiQK, pg8::StaticOrder, true, true>(lds, g, S, E);
        }
        if (bx >= G / 2) {
            pg8::Gemm g{(const pg8::bf16_t*)(ws + WS_WQKV) + (size_t)2560 * DM, (const pg8::bf16_t*)(ws + WS_XB), 512, T, DM}; pg8::StaticOrder S; S.init(512, T, G / 2, bx - G / 2);
            pg8::EpiVt E{(pg8::bf16_t*)(ws + WS_VT), (const float*)(ws + WS_SSQ_B)};
            pg8::gemm_phase<pg8::EpiVt, pg8::StaticOrder, true, true>(lds, g, S, E);
        }
    }
    SEAM(PH_QKV);
    for (int rep_ = 0; rep_ < REP_ATT; ++rep_)
    if (IN(PH_ATT)) { FRESH_IDS();
        for (int vb = bx; vb < 256; vb += G) {
            const int bkv = vb >> 3, chunk = vb & 7, b = bkv >> 3, kvh = bkv & 7;
            for (int i = 0; i < 8; ++i) {
                const int qu = (chunk * 8 + i) * 64;
                __syncthreads();
                attn_fill(lds, (const bf16*)(ws + WS_KB), (const bf16*)(ws + WS_VT), b, kvh, qu - 128, tid);
                __syncthreads();
                attn_task(lds, (const bf16*)(ws + WS_QB), (bf16*)(ws + WS_O), a.in[6], b, kvh * 4 + (wave & 3), qu + (wave >> 2) * 32, qu - 128, lane);
            }
        }
    }
    SEAM(PH_ATT);
    if (IN(PH_WO)) { FRESH_IDS();
        pg8::Gemm g{(const pg8::bf16_t*)(ws + WS_O), (const pg8::bf16_t*)(ws + WS_WOA), T, DM, DM}; pg8::StaticOrder S; S.init(T, DM, G, bx);
        pg8::EpiRes E{a.out, a.out, (pg8::bf16_t*)(ws + WS_XB), (float*)(ws + WS_SSQ_C)};
        pg8::gemm_phase<pg8::EpiRes, pg8::StaticOrder, true, true>(lds, g, S, E);
    }
    SEAM(PH_WO);
#ifdef DIAG_A
    { const unsigned long long* st = (const unsigned long long*)(ws + WS_STAMP); oscale = 1.f + sqrtf((float)(st[DIAG_B] - st[DIAG_A]) * 1e-6f); }
#endif
    PEER_LAYER(1);
#undef PEER_LAYER
    SEAM(PH_PB1);
    if (IN(PH_FIN)) { FRESH_IDS();
        const int gw = bx * NWAVES + wave, NGW = G * NWAVES;
        for (int t = gw; t < T; t += NGW) final_norm_row(a.out, (const float*)(ws + WS_SSQ_D), a.in[11], t, lane, oscale);
    }
#undef SEAM
#undef IN
}

#ifndef N_LAUNCHES
#define N_LAUNCHES 1
#endif
extern "C" void kernel_launch(void* const* d_in, const int* in_sizes, int n_in, void* d_out, int out_size, void* d_ws, size_t ws_size, hipStream_t stream) {
    static int grid = 0;
    if (!grid) {
        if (hipFuncSetAttribute((const void*)mega, hipFuncAttributeMaxDynamicSharedMemorySize, LDS_BYTES) != hipSuccess) { fprintf(stderr, "hipFuncSetAttribute failed\n"); }
        int dev = 0, cus = 0, per_cu = 0;
        (void)hipGetDevice(&dev);
        (void)hipDeviceGetAttribute(&cus, hipDeviceAttributeMultiprocessorCount, dev);
        if (hipOccupancyMaxActiveBlocksPerMultiprocessor(&per_cu, (const void*)mega, NWAVES * 64, LDS_BYTES) != hipSuccess) per_cu = 0;
        (void)hipGetLastError();
        grid = cus * per_cu;
        if (grid > 256) grid = 256;
        grid &= ~1;
        if (grid < 2) { fprintf(stderr, "occupancy query gave %d x %d\n", cus, per_cu); grid = -1; }
    }
    if (grid < 0) return;
    if (ws_size < 700 * MiB) { fprintf(stderr, "ws too small: %zu\n", ws_size); return; }
    (void)hipMemsetAsync((char*)d_ws + WS_CTL, 0, CTL_BYTES, stream);
    Args a{};
    for (int i = 0; i < 12; ++i) a.in[i] = (const float*)d_in[i];
    a.out = (float*)d_out; a.ws = (unsigned char*)d_ws;
    if (N_LAUNCHES == 1) {
        a.ph_lo = 0; a.ph_hi = PH_END;
        void* args[] = {&a};
        const hipError_t e = hipLaunchCooperativeKernel((const void*)mega, dim3(grid), dim3(NWAVES * 64), args, LDS_BYTES, stream);
        if (e != hipSuccess) fprintf(stderr, "cooperative launch failed: %s (grid %d)\n", hipGetErrorString(e), grid);
    } else {
        for (int ph = 0; ph < PH_END; ++ph) {
            a.ph_lo = ph; a.ph_hi = ph + 1;
            hipLaunchKernelGGL(mega, dim3(grid), dim3(NWAVES * 64), LDS_BYTES, stream, a);
        }
    }
}
```

```cpp
#include <hip/hip_runtime.h>
#include <hip/hip_cooperative_groups.h>
namespace cg = cooperative_groups;
#include <cstdio>
#include <cstdint>
#include <cmath>

constexpr int DM = 2048, NB = 4, SEQ = 4096, T = NB * SEQ;
constexpr int FG = 8, FW = 256;
constexpr int HD = 64, NQH = 32, NKVH = 8, QKVW = 3072;
constexpr int PH = 8, NKEYS = 128, NEXP = 16384, PTOPK = 16;
constexpr float EPS = 1e-6f;
namespace pg8 {
#define PG8_LAS __attribute__((address_space(3)))
typedef unsigned short bf16_t;
typedef short bf16x8 __attribute__((ext_vector_type(8)));
typedef float f32x4 __attribute__((ext_vector_type(4)));
typedef unsigned u32x4 __attribute__((ext_vector_type(4)));
constexpr int BM = 256, BK = 64, HALF = 128, HTB = HALF * BK * 2  , STAGE_BYTES = 8 * HTB, NXCD = 8, WGM = 8;

__host__ __device__ __forceinline__ int lds_byte(int r, int c) { const int st = (r >> 4) * 2 + (c >> 5), rr = r & 15, cc = c & 31, ob = rr * 64 + cc * 2; return st * 1024 + (ob ^ (((ob >> 9) & 1) << 5)); }
__host__ __device__ __forceinline__ void stage_rc(int b, int& R, int& C) { const int st = b / 1024, sb = b % 1024, swz = sb ^ (((sb >> 9) & 1) << 5); R = (st >> 1) * 16 + swz / 64; C = (st & 1) * 32 + (swz % 64) / 2; }
__host__ __device__ __forceinline__ int perm32(int rho) { const int n = rho >> 4, i = rho & 15; return 8 * (i >> 2) + 4 * n + (i & 3); }

struct Unit { int pm, pn; };
struct Gemm { const bf16_t* A; const bf16_t* Bt; int M, N, K; };

struct StaticOrder {
    int nM, nN, nwg, G, c;
    __host__ __device__ void init(int M, int N, int G_, int c_) { nM = M / BM; nN = N / BM; nwg = nM * nN; G = G_; c = c_; }
    __host__ __device__ bool next(int i, Unit& u) const {
        const long L = (long)i * G + c; if (L >= nwg) return false;
        int wgid = (int)L; { const int q = nwg / NXCD, r = nwg % NXCD, xcd = wgid % NXCD, off = wgid / NXCD; wgid = (xcd < r ? xcd * (q + 1) : r * (q + 1) + (xcd - r) * q) + off; }
        const int nig = WGM * nN, gid = wgid / nig, fm = gid * WGM, gsz = (nM - fm) < WGM ? (nM - fm) : WGM;
        u.pm = fm + ((wgid % nig) % gsz); u.pn = (wgid % nig) / gsz; return true;
    }
    __device__ __forceinline__ void a_ready(const Unit&) const {}
    __device__ __forceinline__ void done(const Unit&) const {}
};

__device__ __forceinline__ unsigned cvt_pk_bf16(float lo, float hi) { unsigned r; asm volatile("v_cvt_pk_bf16_f32 %0, %1, %2" : "=v"(r) : "v"(lo), "v"(hi)); return r; }
typedef float f32x2 __attribute__((ext_vector_type(2)));
__device__ __forceinline__ u32x4 pack8(const f32x4 v0, const f32x4 v1) { u32x4 w; w.x = cvt_pk_bf16(v0[0], v0[1]); w.y = cvt_pk_bf16(v0[2], v0[3]); w.z = cvt_pk_bf16(v1[0], v1[1]); w.w = cvt_pk_bf16(v1[2], v1[3]); return w; }
struct EpiZt {
    static constexpr bool PERM = true, AFTER_DRAIN = false; bf16_t* Zp;
    __device__ __forceinline__ void operator()(const f32x4 (&acc)[2][2][4][2], const Unit& u, int wr, int wc, int fr, int fq) const {
        const int part = u.pm, bgs2 = u.pn;
        bf16_t* base = Zp + ((size_t)(bgs2 * 256 + wr * 64 + fr) * 512 + part * 256 + wc * 32 + 8 * fq);
#pragma unroll
        for (int ai = 0; ai < 2; ++ai)
#pragma unroll
            for (int m = 0; m < 4; ++m)
#pragma unroll
                for (int bj = 0; bj < 2; ++bj) *(u32x4*)(base + (ai * HALF + m * 16) * 512 + bj * HALF) = pack8(acc[ai][bj][m][0], acc[ai][bj][m][1]);
    }
};
struct EpiY {
    static constexpr bool PERM = true, AFTER_DRAIN = false; bf16_t* Y;
    __device__ __forceinline__ void operator()(const f32x4 (&acc)[2][2][4][2], const Unit& u, int wr, int wc, int fr, int fq) const {
        const int bg = u.pn >> 4, k2 = u.pn & 15, b = bg >> 3, g = bg & 7;
        bf16_t* base = Y + ((size_t)(b * 4096 + (wr * 64 + fr) * 16 + k2) * 2048 + g * 256 + wc * 32 + 8 * fq);
#pragma unroll
        for (int ai = 0; ai < 2; ++ai)
#pragma unroll
            for (int m = 0; m < 4; ++m)
#pragma unroll
                for (int bj = 0; bj < 2; ++bj) *(u32x4*)(base + (size_t)(ai * HALF + m * 16) * 16 * 2048 + bj * HALF) = pack8(acc[ai][bj][m][0], acc[ai][bj][m][1]);
    }
};
struct EpiRes {
    static constexpr bool PERM = true, AFTER_DRAIN = false; const float* R; float* out; bf16_t* xb; float* ssq;
    __device__ __forceinline__ void operator()(const f32x4 (&acc)[2][2][4][2], const Unit& u, int wr, int wc, int fr, int fq) const {
        const int row0 = u.pm * BM + wr * 64 + fr; const size_t off0 = (size_t)row0 * 2048 + u.pn * BM + wc * 32 + 8 * fq;
        const float* Rb = R + off0; float* Ob = out + off0; bf16_t* Xb = xb + off0; float* Sb = ssq + row0;
#pragma unroll
        for (int ai = 0; ai < 2; ++ai)
#pragma unroll
            for (int m = 0; m < 4; ++m) { const int ro = (ai * HALF + m * 16) * 2048; float ss = 0.f;
#pragma unroll
                for (int bj = 0; bj < 2; ++bj) {
                    const f32x4 r0 = *(const f32x4*)(Rb + ro + bj * HALF), r1 = *(const f32x4*)(Rb + ro + bj * HALF + 4);
                    const f32x4 o0 = acc[ai][bj][m][0] + r0, o1 = acc[ai][bj][m][1] + r1;
                    *(f32x4*)(Ob + ro + bj * HALF) = o0; *(f32x4*)(Ob + ro + bj * HALF + 4) = o1;
                    *(u32x4*)(Xb + ro + bj * HALF) = pack8(o0, o1);
                    ss += (o0[0] * o0[0] + o0[1] * o0[1]) + (o0[2] * o0[2] + o0[3] * o0[3]) + (o1[0] * o1[0] + o1[1] * o1[1]) + (o1[2] * o1[2] + o1[3] * o1[3]); }
                ss += __shfl_xor(ss, 16); ss += __shfl_xor(ss, 32);
                if (fq == 0) unsafeAtomicAdd(Sb + ai * HALF + m * 16, ss);
                asm volatile("" ::: "memory"); }
    }
};
struct EpiScale {
    static constexpr bool PERM = true, AFTER_DRAIN = false; bf16_t* O; const float* ssq;
    __device__ __forceinline__ void operator()(const f32x4 (&acc)[2][2][4][2], const Unit& u, int wr, int wc, int fr, int fq) const {
        const int row0 = u.pm * BM + wr * 64 + fr;
        bf16_t* base = O + ((size_t)row0 * 2048 + u.pn * BM + wc * 32 + 8 * fq); const float* Sb = ssq + row0;
#pragma unroll
        for (int ai = 0; ai < 2; ++ai)
#pragma unroll
            for (int m = 0; m < 4; ++m) { const float rs = rsqrtf(Sb[ai * HALF + m * 16] * (1.f / 2048.f) + 1e-6f);
#pragma unroll
                for (int bj = 0; bj < 2; ++bj) *(u32x4*)(base + (ai * HALF + m * 16) * 2048 + bj * HALF) = pack8(acc[ai][bj][m][0] * rs, acc[ai][bj][m][1] * rs); }
    }
};
struct EpiQK {
    static constexpr bool PERM = true, AFTER_DRAIN = false; bf16_t* Q; bf16_t* K; const float* ssq; const float* rope; float qscale;
    __device__ __forceinline__ void operator()(const f32x4 (&acc)[2][2][4][2], const Unit& u, int wr, int wc, int fr, int fq) const {
        const int row0 = u.pm * BM + wr * 64 + fr; const bool isq = u.pn < 8;
        const int cl = wc * 32 + 8 * fq;
        bf16_t* base = isq ? (Q + ((size_t)row0 * 2048 + u.pn * BM + cl)) : (K + ((size_t)row0 * 512 + (u.pn - 8) * BM + cl));
        const int ld = isq ? 2048 : 512; const float sc = isq ? qscale : 1.f;
        const float* rp = rope + (size_t)(row0 & 4095) * 64 + (cl & 63);
        const float* Sb = ssq + row0;
#pragma unroll
        for (int ai = 0; ai < 2; ++ai)
#pragma unroll
            for (int m = 0; m < 4; ++m) { const int ro = ai * HALF + m * 16; const float rs = rsqrtf(Sb[ro] * (1.f / 2048.f) + 1e-6f) * sc;
                const f32x4 t0 = *(const f32x4*)(rp + (size_t)ro * 64), t1 = *(const f32x4*)(rp + (size_t)ro * 64 + 4);
#pragma unroll
                for (int bj = 0; bj < 2; ++bj) {
                    const f32x4 a = acc[ai][bj][m][0] * rs, b = acc[ai][bj][m][1] * rs; f32x4 oa, ob;
                    oa[0] = a[0] * t0[0] - a[1] * t0[1]; oa[1] = a[1] * t0[0] + a[0] * t0[1]; oa[2] = a[2] * t0[2] - a[3] * t0[3]; oa[3] = a[3] * t0[2] + a[2] * t0[3];
                    ob[0] = b[0] * t1[0] - b[1] * t1[1]; ob[1] = b[1] * t1[0] + b[0] * t1[1]; ob[2] = b[2] * t1[2] - b[3] * t1[3]; ob[3] = b[3] * t1[2] + b[2] * t1[3];
                    *(u32x4*)(base + (size_t)ro * ld + bj * HALF) = pack8(oa, ob); } }
    }
};
struct EpiVt {
    static constexpr bool PERM = true, AFTER_DRAIN = false; bf16_t* Vt; const float* ssq;
    __device__ __forceinline__ void operator()(const f32x4 (&acc)[2][2][4][2], const Unit& u, int wr, int wc, int fr, int fq) const {
        const int col0 = u.pn * BM + wc * 32 + 8 * fq;
        bf16_t* base = Vt + ((size_t)(u.pm * BM + wr * 64 + fr) * 16384 + col0);
        f32x4 r0[2], r1[2];
#pragma unroll
        for (int bj = 0; bj < 2; ++bj) { const f32x4 s0 = *(const f32x4*)(ssq + col0 + bj * HALF), s1 = *(const f32x4*)(ssq + col0 + bj * HALF + 4);
#pragma unroll
            for (int q = 0; q < 4; ++q) { r0[bj][q] = rsqrtf(s0[q] * (1.f / 2048.f) + 1e-6f); r1[bj][q] = rsqrtf(s1[q] * (1.f / 2048.f) + 1e-6f); } }
#pragma unroll
        for (int ai = 0; ai < 2; ++ai)
#pragma unroll
            for (int m = 0; m < 4; ++m)
#pragma unroll
                for (int bj = 0; bj < 2; ++bj) *(u32x4*)(base + (size_t)(ai * HALF + m * 16) * 16384 + bj * HALF) = pack8(acc[ai][bj][m][0] * r0[bj], acc[ai][bj][m][1] * r1[bj]);
    }
};
template <class Epi, class Sched, bool ALIGN_EPI = false, bool SP2 = false>
__device__ __forceinline__ void gemm_phase(PG8_LAS unsigned char* lds, const Gemm g, const Sched& S, const Epi& E) {
    const int tid = threadIdx.x, wid = __builtin_amdgcn_readfirstlane(tid >> 6), lane = tid & 63, wr = wid >> 2, wc = wid & 3, fr = lane & 15, fq = lane >> 4;
    const int K = g.K, nt = K / BK;
    unsigned voffA[2], voffB[2];
#pragma unroll
    for (int i = 0; i < 2; ++i) { int R, C; stage_rc(tid * 16 + i * 8192, R, C); const int Rb = Epi::PERM ? ((R & ~31) + perm32(R & 31)) : R;
        voffA[i] = (unsigned)(R * K + C) * 2u; voffB[i] = (unsigned)(Rb * K + C) * 2u; }
    const size_t kstep = (size_t)(BK * 2);
    const size_t hstep = (size_t)HALF * K * 2;
    const size_t tstep = 2 * hstep;
    const unsigned ldsw = (unsigned)wid * 1024u;
    const int aoff = lds_byte(wr * 64 + fr, fq * 8), boff = lds_byte(wc * 32 + fr, fq * 8);
#define PG8_SA(b, h) (((b) * 2 + (h)) * HTB)
#define PG8_SB(b, h) ((4 + (b) * 2 + (h)) * HTB)
#define PG8_STAGE(bufoff, gbase, voff) do { _Pragma("unroll") for (int _i = 0; _i < 2; ++_i) \
        __builtin_amdgcn_global_load_lds((const unsigned*)((const char*)(gbase) + (voff)[_i]), (PG8_LAS unsigned*)(lds + (bufoff) + ldsw + _i * 8192), 16, 0, 0); } while (0)
#define PG8_LDA(dst, b, h) do { _Pragma("unroll") for (int m = 0; m < 4; ++m) _Pragma("unroll") for (int k = 0; k < 2; ++k) dst[m][k] = *(const PG8_LAS bf16x8*)(lds + PG8_SA(b, h) + aoff + m * 2048 + k * 1024); } while (0)
#define PG8_LDB(dst, b, h) do { _Pragma("unroll") for (int n = 0; n < 2; ++n) _Pragma("unroll") for (int k = 0; k < 2; ++k) dst[n][k] = *(const PG8_LAS bf16x8*)(lds + PG8_SB(b, h) + boff + n * 2048 + k * 1024); } while (0)
#define PG8_MMA(ai, bj, At, Bt) do { __builtin_amdgcn_s_setprio(1); _Pragma("unroll") for (int m = 0; m < 4; ++m) _Pragma("unroll") for (int n = 0; n < 2; ++n) _Pragma("unroll") for (int k = 0; k < 2; ++k) \
        acc[ai][bj][m][n] = __builtin_amdgcn_mfma_f32_16x16x32_bf16(Bt[n][k], At[m][k], acc[ai][bj][m][n], 0, 0, 0); __builtin_amdgcn_s_setprio(0); } while (0)
#define PG8_WAIT_V(n) asm volatile("s_waitcnt vmcnt(" #n ")" ::: "memory")
#define PG8_WAIT_L(n) asm volatile("s_waitcnt lgkmcnt(" #n ")" ::: "memory")
#define PG8_BAR __builtin_amdgcn_s_barrier()
#define PG8_SCHED __builtin_amdgcn_sched_barrier(0)
    Unit cur, nxt; int ui = 0;
    if (!S.next(0, cur)) return;
    f32x4 acc[2][2][4][2];
#pragma unroll
    for (int a = 0; a < 2; ++a)
#pragma unroll
        for (int b = 0; b < 2; ++b)
#pragma unroll
            for (int m = 0; m < 4; ++m)
#pragma unroll
                for (int n = 0; n < 2; ++n) acc[a][b][m][n] = (f32x4){0.f, 0.f, 0.f, 0.f};
    bf16x8 At[4][2], B0[2][2], B1[2][2];
    const char* cA = (const char*)g.A + (size_t)cur.pm * tstep; const char* cB = (const char*)g.Bt + (size_t)cur.pn * tstep;
    S.a_ready(cur);
    if constexpr (SP2) {
        PG8_STAGE(PG8_SB(0, 0), cB, voffB); PG8_STAGE(PG8_SB(0, 1), cB + hstep, voffB); PG8_STAGE(PG8_SA(0, 0), cA, voffA); PG8_STAGE(PG8_SA(0, 1), cA + hstep, voffA);
        if (wr == 1) PG8_BAR;
        PG8_WAIT_V(2); PG8_BAR;
        PG8_STAGE(PG8_SB(1, 0), cB + kstep, voffB); PG8_STAGE(PG8_SA(1, 0), cA + kstep, voffA); PG8_STAGE(PG8_SB(1, 1), cB + hstep + kstep, voffB);
        PG8_WAIT_V(6); PG8_BAR;
    } else {
        PG8_STAGE(PG8_SB(0, 0), cB, voffB); PG8_STAGE(PG8_SA(0, 0), cA, voffA); PG8_STAGE(PG8_SB(0, 1), cB + hstep, voffB); PG8_STAGE(PG8_SA(0, 1), cA + hstep, voffA);
        if (wr == 1) PG8_BAR;
        PG8_WAIT_V(4); PG8_BAR;
        PG8_STAGE(PG8_SB(1, 0), cB + kstep, voffB); PG8_STAGE(PG8_SA(1, 0), cA + kstep, voffA); PG8_STAGE(PG8_SB(1, 1), cB + hstep + kstep, voffB);
        PG8_WAIT_V(6); PG8_BAR;
    }
    for (;;) {
        const bool has_next = S.next(ui + 1, nxt);
        const char* nA = has_next ? (const char*)g.A + (size_t)nxt.pm * tstep : cA; const char* nB = has_next ? (const char*)g.Bt + (size_t)nxt.pn * tstep : cB;
        for (int t = 0; t < nt; t += 2) {
            const bool last = (t == nt - 2);
            const char* a1 = cA + (size_t)(t + 1) * kstep;
            const char* a2 = last ? nA : cA + (size_t)(t + 2) * kstep; const char* b2 = last ? nB : cB + (size_t)(t + 2) * kstep;
            const char* a3 = a2 + kstep; const char* b3 = b2 + kstep;
            if (last && has_next) S.a_ready(nxt);
            if constexpr (SP2) {
            PG8_LDB(B0, 0, 0); PG8_LDB(B1, 0, 1); PG8_SCHED; PG8_LDA(At, 0, 0); PG8_STAGE(PG8_SA(1, 1), a1 + hstep, voffA);
            PG8_WAIT_V(8); PG8_WAIT_L(0); PG8_BAR; PG8_MMA(0, 0, At, B0); PG8_MMA(0, 1, At, B1); PG8_BAR; PG8_SCHED;
            PG8_LDA(At, 0, 1); PG8_STAGE(PG8_SB(0, 0), b2, voffB); PG8_STAGE(PG8_SB(0, 1), b2 + hstep, voffB); PG8_STAGE(PG8_SA(0, 0), a2, voffA);
            PG8_WAIT_V(8); PG8_WAIT_L(0); PG8_BAR; PG8_MMA(1, 0, At, B0); PG8_MMA(1, 1, At, B1); PG8_BAR; PG8_SCHED;
            PG8_LDB(B0, 1, 0); PG8_LDB(B1, 1, 1); PG8_SCHED; PG8_LDA(At, 1, 0); PG8_STAGE(PG8_SA(0, 1), a2 + hstep, voffA);
            PG8_WAIT_V(8); PG8_WAIT_L(0); PG8_BAR; PG8_MMA(0, 0, At, B0); PG8_MMA(0, 1, At, B1); PG8_BAR; PG8_SCHED;
            PG8_LDA(At, 1, 1); PG8_STAGE(PG8_SB(1, 0), b3, voffB); PG8_STAGE(PG8_SB(1, 1), b3 + hstep, voffB); PG8_STAGE(PG8_SA(1, 0), a3, voffA);
            PG8_WAIT_V(8); PG8_WAIT_L(0); PG8_BAR; PG8_MMA(1, 0, At, B0); PG8_MMA(1, 1, At, B1); PG8_BAR; PG8_SCHED;
            } else {
            PG8_LDB(B0, 0, 0); PG8_SCHED; PG8_LDA(At, 0, 0); PG8_STAGE(PG8_SA(1, 1), a1 + hstep, voffA);
            PG8_WAIT_L(8); PG8_BAR; PG8_WAIT_L(0); PG8_MMA(0, 0, At, B0); PG8_BAR; PG8_SCHED;
            PG8_LDB(B1, 0, 1); PG8_STAGE(PG8_SB(0, 0), b2, voffB);
            PG8_BAR; PG8_WAIT_L(0); PG8_MMA(0, 1, At, B1); PG8_BAR;
            PG8_LDA(At, 0, 1); PG8_STAGE(PG8_SA(0, 0), a2, voffA);
            PG8_BAR; PG8_WAIT_L(0); PG8_MMA(1, 0, At, B0); PG8_BAR; PG8_SCHED;
            PG8_STAGE(PG8_SB(0, 1), b2 + hstep, voffB);
            PG8_WAIT_V(6); PG8_BAR; PG8_MMA(1, 1, At, B1); PG8_BAR;
            PG8_LDB(B0, 1, 0); PG8_SCHED; PG8_LDA(At, 1, 0); PG8_STAGE(PG8_SA(0, 1), a2 + hstep, voffA);
            PG8_WAIT_L(8); PG8_BAR; PG8_WAIT_L(0); PG8_MMA(0, 0, At, B0); PG8_BAR; PG8_SCHED;
            PG8_LDB(B1, 1, 1); PG8_STAGE(PG8_SB(1, 0), b3, voffB);
            PG8_BAR; PG8_WAIT_L(0); PG8_MMA(0, 1, At, B1); PG8_BAR;
            PG8_LDA(At, 1, 1); PG8_STAGE(PG8_SA(1, 0), a3, voffA);
            PG8_BAR; PG8_WAIT_L(0); PG8_MMA(1, 0, At, B0); PG8_BAR; PG8_SCHED;
            PG8_STAGE(PG8_SB(1, 1), b3 + hstep, voffB);
            PG8_WAIT_V(6); PG8_BAR; PG8_MMA(1, 1, At, B1); PG8_BAR;
            }
        }
        if constexpr (ALIGN_EPI) { if (wr == 0) PG8_BAR; }
        if constexpr (!Epi::AFTER_DRAIN) { E(acc, cur, wr, wc, fr, fq); S.done(cur); }
        if (!has_next) break;
#pragma unroll
        for (int a = 0; a < 2; ++a)
#pragma unroll
            for (int b = 0; b < 2; ++b)
#pragma unroll
                for (int m = 0; m < 4; ++m)
#pragma unroll
                    for (int n = 0; n < 2; ++n) acc[a][b][m][n] = (f32x4){0.f, 0.f, 0.f, 0.f};
        cur = nxt; cA = nA; cB = nB; ++ui;
        if constexpr (ALIGN_EPI) { if (wr == 1) PG8_BAR; }
    }
    PG8_WAIT_V(0);
    if constexpr (!ALIGN_EPI) { if (wr == 0) PG8_BAR; }
    PG8_BAR;
    if constexpr (Epi::AFTER_DRAIN) { E.fused(acc, cur, wr, wc, fr, fq, lds, wid, lane); S.done(cur); }
#undef PG8_SA
#undef PG8_SB
#undef PG8_STAGE
#undef PG8_LDA
#undef PG8_LDB
#undef PG8_MMA
#undef PG8_WAIT_V
#undef PG8_WAIT_L
#undef PG8_BAR
#undef PG8_SCHED
}
}
#define GAS __attribute__((address_space(1)))
#define LAS __attribute__((address_space(3)))
typedef unsigned short bf16;
typedef unsigned v4u __attribute__((ext_vector_type(4)));
typedef unsigned v2u __attribute__((ext_vector_type(2)));
typedef float f32x4 __attribute__((ext_vector_type(4)));
constexpr int NWAVES = 8;
constexpr int LDS_BYTES = 147456, LDSCTL_OFF = 131072;
constexpr int CW_BAR = 4096;
constexpr size_t MiB = 1u << 20;
constexpr size_t WS_CTL = 0, CTL_BYTES = 1 * MiB;
constexpr size_t WS_SSQ_A = 256 * 1024, WS_SSQ_B = 320 * 1024, WS_SSQ_C = 384 * 1024, WS_SSQ_D = 448 * 1024;
constexpr size_t WS_STAMP = 128 * 1024;
constexpr size_t WS_BCTR = 192 * 1024;
constexpr size_t WS_SU = 512 * 1024, WS_SV = 768 * 1024;
constexpr size_t WS_WCS = 1 * MiB, WS_ROPE = 2 * MiB, WS_KEYS = 3 * MiB;
constexpr size_t WS_WOF = 8 * MiB, WS_WQKV = 16 * MiB, WS_WOA = 28 * MiB, WS_WQ0 = 36 * MiB, WS_WQ1 = 44 * MiB;
constexpr size_t WS_A2 = 64 * MiB, WS_TW = 65 * MiB;
constexpr size_t WS_U0 = 128 * MiB, WS_V0 = 192 * MiB, WS_U1 = 256 * MiB, WS_V1 = 320 * MiB;
constexpr size_t WS_XG = 384 * MiB, WS_XB = 384 * MiB;
constexpr size_t WS_ZT = 448 * MiB;
constexpr size_t WS_Y = 576 * MiB;
constexpr size_t WS_Q = 448 * MiB;
constexpr size_t WS_EI = 640 * MiB, WS_GW = 648 * MiB, WS_W1 = 656 * MiB;
constexpr size_t WS_PD = 448 * MiB;
constexpr size_t WS_QB = 448 * MiB, WS_KB = 512 * MiB, WS_VT = 528 * MiB, WS_O = 576 * MiB;

__device__ __forceinline__ unsigned f2bf(float f) { unsigned u = __builtin_bit_cast(unsigned, f); return (u + 0x7fffu + ((u >> 16) & 1u)) >> 16; }
__device__ __forceinline__ unsigned pk2(float lo, float hi) { return f2bf(lo) | (f2bf(hi) << 16); }

struct Args { const float* in[12]; float* out; unsigned char* ws; int ph_lo, ph_hi; };

__device__ __forceinline__ int qkv_row(int n) { if (n >= 2560) return n; const int d = n & 63, pc = (d < 32) ? 2 * d : 2 * (d - 32) + 1; return (n & ~63) + pc; }
template <int MODE>
__device__ __forceinline__ void transpose_item(const float* W, int K, int N, const float* gain, bf16* WT, LAS float* scr, int item, int lane) {
    const int nblk = N / 32, kb = item / nblk, nb = item % nblk, k0 = 64 * kb, n0 = 32 * nb;
#pragma unroll 8
    for (int i = 0; i < 32; ++i) { const int kk = 2 * i + (lane >> 5); float v = W[(size_t)(k0 + kk) * N + n0 + (lane & 31)]; if (gain) v *= gain[k0 + kk]; scr[kk * 33 + (lane & 31)] = v; }
    asm volatile("s_waitcnt lgkmcnt(0)" ::: "memory");
    const int c = lane & 7;
#pragma unroll
    for (int j = 0; j < 4; ++j) { const int n = (lane >> 3) + 8 * j; const LAS float* s = scr + (8 * c) * 33 + n;
        v4u o; o.x = pk2(s[0 * 33], s[1 * 33]); o.y = pk2(s[2 * 33], s[3 * 33]); o.z = pk2(s[4 * 33], s[5 * 33]); o.w = pk2(s[6 * 33], s[7 * 33]);
        const int row = (MODE == 1) ? qkv_row(n0 + n) : (n0 + n);
        *(v4u*)(WT + (size_t)row * K + k0 + 8 * c) = o; }
    asm volatile("s_waitcnt lgkmcnt(0)" ::: "memory");
}
__device__ __forceinline__ float wsum(float v) {
#pragma unroll
    for (int o = 1; o < 64; o <<= 1) v += __shfl_xor(v, o);
    return v;
}
__device__ __forceinline__ void cvt_stream(const float* src, bf16* dst, size_t n8, size_t gtid, size_t ngt) {
    for (size_t i = gtid; i < n8; i += ngt) {
        const f32x4 a = *(const f32x4*)(src + i * 8), b = *(const f32x4*)(src + i * 8 + 4);
        v4u o; o.x = pk2(a[0], a[1]); o.y = pk2(a[2], a[3]); o.z = pk2(b[0], b[1]); o.w = pk2(b[2], b[3]);
        *(v4u*)(dst + i * 8) = o;
    }
}
__device__ __forceinline__ void cvt_stream8(const float* src, unsigned char* dst, size_t n16, size_t gtid, size_t ngt, float scale) {
    for (size_t i = gtid; i < n16; i += ngt) {
        v4u o;
#pragma unroll
        for (int q = 0; q < 4; ++q) { f32x4 a = *(const f32x4*)(src + i * 16 + 4 * q) * scale;
#pragma unroll
            for (int e = 0; e < 4; ++e) a[e] = fminf(fmaxf(a[e], -448.f), 448.f);
            int w = 0; w = __builtin_amdgcn_cvt_pk_fp8_f32(a[0], a[1], w, false); w = __builtin_amdgcn_cvt_pk_fp8_f32(a[2], a[3], w, true); o[q] = (unsigned)w; }
        const size_t e = i >> 7, r = i & 127, sl = r >> 3, c8 = r & 7;
        *(v4u*)(dst + ((sl * 16384 + e) * 128 + c8 * 16)) = o;
    }
}
#define XB_TMO      128
#define XB_XCNT(j)  (256  + 64 * (j))
#define XB_XSUB(j)  (1280 + 64 * (j))
#define XB_XGEN(j)  (2304 + 64 * (j))
#define XB_TOP      3328
#define XB_TOPGEN   3392
#define XCD_BAR_WORDS 3456
#define XB_SPIN_CAP (1u << 18)

__device__ __forceinline__ unsigned xb_ld(unsigned* p)              { return __hip_atomic_load(p, __ATOMIC_RELAXED, __HIP_MEMORY_SCOPE_AGENT); }
__device__ __forceinline__ unsigned xb_add(unsigned* p, unsigned v) { return __hip_atomic_fetch_add(p, v, __ATOMIC_RELAXED, __HIP_MEMORY_SCOPE_AGENT); }
__device__ __forceinline__ unsigned xb_xcc_id() { return (unsigned)__builtin_amdgcn_s_getreg((3 << 11) | 20) & 0xFu; }
#define XB_SPIN(cond, bar) do { unsigned _sp = 0; while (cond) { __builtin_amdgcn_s_sleep(1); \
    if ((++_sp & 255u) == 0u) { if (xb_ld(&(bar)[XB_TMO])) break; if (_sp > XB_SPIN_CAP) { atomicAdd(&(bar)[XB_TMO], 1u); break; } } } } while (0)

struct XcdBarrier {
    unsigned* bar; unsigned x;
    volatile LAS unsigned* st;
};

__device__ __forceinline__ XcdBarrier xcd_barrier_post(unsigned* bar, volatile LAS unsigned* st) {
    XcdBarrier b; b.bar = bar; b.x = xb_xcc_id(); b.st = st;
    if (threadIdx.x == 0) (void)xb_add(&bar[XB_XCNT(b.x)], 1u);
    return b;
}
__device__ __forceinline__ void xcd_barrier_complete(unsigned* bar, unsigned x, unsigned& nloc, unsigned& nx) {
    const unsigned G = gridDim.x * gridDim.y * gridDim.z;
    unsigned sum, cnt, mine, sp = 0u;
    for (;;) {
        sum = 0u; cnt = 0u; mine = 0u;
#pragma unroll
        for (unsigned j = 0; j < 16; ++j) { const unsigned c = xb_ld(&bar[XB_XCNT(j)]); sum += c; cnt += (c > 0u) ? 1u : 0u; mine = (j == x) ? c : mine; }
        if (sum == G) break;
        __builtin_amdgcn_s_sleep(1);
        if ((++sp & 255u) == 0u) { if (xb_ld(&bar[XB_TMO])) break; if (sp > XB_SPIN_CAP) { atomicAdd(&bar[XB_TMO], 1u); break; } }
    }
    nloc = mine > 0u ? mine : 1u; nx = cnt > 0u ? cnt : 1u;
}

__device__ __forceinline__ void xcd_barrier(const XcdBarrier& b) {
    asm volatile("s_waitcnt vmcnt(0)" ::: "memory");
    __syncthreads();
    if (threadIdx.x == 0) {
        unsigned* bar = b.bar;
        __builtin_amdgcn_s_waitcnt(0);
        unsigned nloc = b.st[0], nx = b.st[1];
        if (nloc == 0u) { xcd_barrier_complete(bar, b.x, nloc, nx); b.st[0] = nloc; b.st[1] = nx; }
        const unsigned old = xb_add(&bar[XB_XSUB(b.x)], 1u);
        const unsigned gen = old / nloc;
        if (old + 1u == (gen + 1u) * nloc) {
            __builtin_amdgcn_fence(__ATOMIC_RELEASE, "agent");
            asm volatile("s_waitcnt vmcnt(0)" ::: "memory");
            const unsigned og = xb_add(&bar[XB_TOP], 1u);
            const unsigned tg = og / nx;
            if (og + 1u == (tg + 1u) * nx) xb_add(&bar[XB_TOPGEN], 1u);
            else XB_SPIN(xb_ld(&bar[XB_TOPGEN]) == tg, bar);
            __builtin_amdgcn_fence(__ATOMIC_ACQUIRE, "agent");
            xb_add(&bar[XB_XGEN(b.x)], 1u);
            asm volatile("s_waitcnt vmcnt(0)" ::: "memory");
        } else {
            XB_SPIN(xb_ld(&bar[XB_XGEN(b.x)]) == gen, bar);
            __builtin_amdgcn_fence(__ATOMIC_ACQUIRE, "agent");
            asm volatile("s_waitcnt vmcnt(0)" ::: "memory");
        }
    }
    __syncthreads();
}
#define U_SCALE 1024.f
#define V_SCALE 256.f
typedef float f32x16 __attribute__((ext_vector_type(16)));
#ifndef TKB
#define TKB 2
#endif
typedef short s16x8 __attribute__((ext_vector_type(8)));
typedef __bf16 bf16x2_t __attribute__((ext_vector_type(2)));
__device__ __forceinline__ unsigned ordf(float f) { const unsigned u = __float_as_uint(f); return (u & 0x80000000u) ? ~u : (u | 0x80000000u); }
__device__ __forceinline__ float unordf(unsigned u) { return __uint_as_float((u & 0x80000000u) ? (u & 0x7fffffffu) : ~u); }
__device__ __forceinline__ unsigned umax_(unsigned a, unsigned b) { return a > b ? a : b; }
#define DPPU(v, ctrl) ((unsigned)__builtin_amdgcn_update_dpp(0, (int)(v), (ctrl), 0xf, 0xf, true))
#define DPPF(v, ctrl) __int_as_float(__builtin_amdgcn_update_dpp(0, __float_as_int(v), (ctrl), 0xf, 0xf, true))
__device__ __forceinline__ unsigned max32(unsigned v) {
    v = umax_(v, DPPU(v, 0xB1)); v = umax_(v, DPPU(v, 0x4E)); v = umax_(v, DPPU(v, 0x141)); v = umax_(v, DPPU(v, 0x140));
    const auto r = __builtin_amdgcn_permlane16_swap(v, v, false, false);
    return umax_(r[0], r[1]);
}
__device__ __forceinline__ float sum16(float v) {
    v += DPPF(v, 0xB1); v += DPPF(v, 0x4E); v += DPPF(v, 0x141); v += DPPF(v, 0x140); return v;
}
__device__ __forceinline__ unsigned bperm(unsigned v, int srclane) { return (unsigned)__builtin_amdgcn_ds_bpermute(srclane << 2, (int)v); }
#define CMPX(a_, b_) do { const unsigned hi_ = umax_(a_, b_), lo_ = (a_ < b_) ? a_ : b_; a_ = hi_; b_ = lo_; } while (0)
__device__ __forceinline__ unsigned max16(unsigned v) { v = umax_(v, DPPU(v, 0xB1)); v = umax_(v, DPPU(v, 0x4E)); v = umax_(v, DPPU(v, 0x141)); v = umax_(v, DPPU(v, 0x140)); return v; }
__device__ __forceinline__ unsigned top16_of8(unsigned (&p)[8], int c) {
    CMPX(p[0], p[1]); CMPX(p[2], p[3]); CMPX(p[4], p[5]); CMPX(p[6], p[7]);
    CMPX(p[0], p[2]); CMPX(p[1], p[3]); CMPX(p[4], p[6]); CMPX(p[5], p[7]);
    CMPX(p[1], p[2]); CMPX(p[5], p[6]); CMPX(p[0], p[4]); CMPX(p[3], p[7]);
    CMPX(p[1], p[5]); CMPX(p[2], p[6]);
    CMPX(p[1], p[4]); CMPX(p[3], p[6]);
    CMPX(p[2], p[4]); CMPX(p[3], p[5]);
    CMPX(p[3], p[4]);
    unsigned W = 0u;
    for (int it = 0; it < 16; ++it) {
        const unsigned m = max16(p[0]);
        W = (c == it) ? m : W;
        const bool win = (p[0] == m);
#pragma unroll
        for (int i = 0; i < 7; ++i) p[i] = win ? p[i + 1] : p[i];
        p[7] = win ? 0u : p[7];
    }
    return W;
}
__device__ __forceinline__ unsigned top16_of4r(unsigned (&p)[4], int c) {
    CMPX(p[0], p[1]); CMPX(p[2], p[3]); CMPX(p[0], p[2]); CMPX(p[1], p[3]); CMPX(p[1], p[2]);
    unsigned W = 0u;
    for (int it = 0; it < 16; ++it) {
        const unsigned m = max16(p[0]);
        W = (c == it) ? m : W;
        const bool win = (p[0] == m);
        p[0] = win ? p[1] : p[0]; p[1] = win ? p[2] : p[1]; p[2] = win ? p[3] : p[2]; p[3] = win ? 0u : p[3];
    }
    return W;
}
__device__ __forceinline__ void topk_fill(LAS unsigned char* lds, const bf16* keys, int h, int tid) {
#pragma unroll
    for (int i = 0; i < 8; ++i) { const int idx = tid + 512 * i, p = idx >> 11, key = (idx >> 4) & 127, ch = idx & 15;
        const v4u v = *(const v4u*)(keys + (size_t)((h * 2 + p) * 128 + key) * 128 + ch * 8);
        *(LAS v4u*)(lds + p * 32768 + key * 256 + ((ch ^ (key & 15)) << 4)) = v; }
}
struct CvtCtx { const float* srcU; long dsrc; const float* gain; unsigned char* dstU; long ddst; float* su; long dsc; int gwave, nw; };
__device__ __forceinline__ void cvt_chunk_load(const CvtCtx& cx, int c, int lane, f32x4 (&v)[4]) {
    const int r = c >> 1, hh = c & 1;
    const float* src = cx.srcU + ((r < 16384) ? 0L : cx.dsrc) + (size_t)(r & 16383) * 2048 + hh * 1024 + 4 * lane;
#pragma unroll
    for (int j = 0; j < 4; ++j) v[j] = *(const f32x4*)(src + 256 * j);
}
__device__ __forceinline__ void cvt_chunk_store(const CvtCtx& cx, int c, int lane, f32x4 (&v)[4]) {
    const int r = c >> 1, hh = c & 1; const bool isu = r < 16384; const int e = r & 16383;
    float mx = 0.f;
#pragma unroll
    for (int j = 0; j < 4; ++j) { if (isu) v[j] = v[j] * *(const f32x4*)(cx.gain + hh * 1024 + 256 * j + 4 * lane);
        mx = fmaxf(mx, fmaxf(fmaxf(fabsf(v[j][0]), fabsf(v[j][1])), fmaxf(fabsf(v[j][2]), fabsf(v[j][3])))); }
    mx = fmaxf(mx, DPPF(mx, 0xB1)); mx = fmaxf(mx, DPPF(mx, 0x4E)); mx = fmaxf(mx, DPPF(mx, 0x141)); mx = fmaxf(mx, DPPF(mx, 0x140));
    { const auto rr = __builtin_amdgcn_permlane16_swap(__float_as_uint(mx), __float_as_uint(mx), false, false); mx = fmaxf(__uint_as_float(rr[0]), __uint_as_float(rr[1])); }
    { const auto rr = __builtin_amdgcn_permlane32_swap(__float_as_uint(mx), __float_as_uint(mx), false, false); mx = fmaxf(__uint_as_float(rr[0]), __uint_as_float(rr[1])); }
    const float sc = fmaxf(mx, 1e-30f) * (1.f / 6.f), inv = 1.f / sc;
    if (lane == 0) (cx.su + (isu ? 0L : cx.dsc))[e * 2 + hh] = sc;
    unsigned char* dst = cx.dstU + (isu ? 0L : cx.ddst) + ((size_t)(hh * 4) * 16384 + e) * 128 + 2 * lane;
#pragma unroll
    for (int j = 0; j < 4; ++j) { unsigned w = 0u;
        w = __builtin_amdgcn_cvt_scalef32_pk_fp4_f32(w, v[j][0] * inv, v[j][1] * inv, 1.0f, 0); w = __builtin_amdgcn_cvt_scalef32_pk_fp4_f32(w, v[j][2] * inv, v[j][3] * inv, 1.0f, 1);
        *(unsigned short*)(dst + (size_t)j * (16384 * 128)) = (unsigned short)w; }
}
__device__ __forceinline__ void topk_unit(const bf16* q, LAS const unsigned char* lds, int* EI, float* GW, int t0, int h, int lane, const CvtCtx& cx, int slot0) {
    const int c = lane & 15, g4 = lane >> 4, rbase = lane & 48;
    int f0 = 0, f1 = 0, f2 = 0, f3 = 0;
    { int cnt = 0;
#pragma unroll
      for (int i = 0; i < 16; ++i)
#pragma unroll
        for (int j = 0; j < 16; ++j) if ((i + 1) * (j + 1) <= 16) { const int fl = i * 16 + j; f0 = (cnt == c) ? fl : f0; f1 = (cnt == c + 16) ? fl : f1; f2 = (cnt == c + 32) ? fl : f2; f3 = (cnt == c + 48) ? fl : f3; ++cnt; } }
    unsigned W[2][8];
#pragma unroll
    for (int p = 0; p < 2; ++p) {
        f32x4 acc[2][8];
#pragma unroll
        for (int mb = 0; mb < 2; ++mb)
#pragma unroll
            for (int kb = 0; kb < 8; ++kb) acc[mb][kb] = (f32x4){0.f, 0.f, 0.f, 0.f};
        const bf16* qp = q + (size_t)(t0 + c) * 2048 + h * 256 + p * 128 + g4 * 8;
        LAS const unsigned char* kp = lds + p * 32768 + c * 256;
        asm volatile("" : "+v"(qp));
#pragma unroll 2
        for (int ks = 0; ks < 4; ++ks) {
            const s16x8 a0 = *(const s16x8*)(qp + ks * 32), a1 = *(const s16x8*)(qp + (size_t)16 * 2048 + ks * 32);
#pragma unroll
            for (int kb = 0; kb < 8; ++kb) { const s16x8 b = *(LAS const s16x8*)(kp + kb * 4096 + (((4 * ks + g4) ^ c) << 4));
                acc[0][kb] = __builtin_amdgcn_mfma_f32_16x16x32_bf16(a0, b, acc[0][kb], 0, 0, 0); acc[1][kb] = __builtin_amdgcn_mfma_f32_16x16x32_bf16(a1, b, acc[1][kb], 0, 0, 0); }
        }
#pragma unroll
        for (int pb = 0; pb < 8; ++pb) {
            unsigned pk[8];
#pragma unroll
            for (int kb = 0; kb < 8; ++kb) pk[kb] = (ordf(acc[pb >> 2][kb][pb & 3]) & ~127u) | (unsigned)(127 - 16 * kb - c);
            const int cc = (slot0 + p * 8 + pb) * cx.nw + cx.gwave;
            f32x4 cr[4];
            asm volatile("" ::: "memory");
            if (cc < 65536) cvt_chunk_load(cx, cc, lane, cr);
            W[p][pb] = top16_of8(pk, c);
            if (cc < 65536) cvt_chunk_store(cx, cc, lane, cr);
            asm volatile("" ::: "memory");
        }
    }
#pragma unroll
    for (int pb = 0; pb < 8; ++pb) {
        const unsigned w0 = W[0][pb], w1 = W[1][pb];
        unsigned cp[4];
        { const float a0 = unordf(bperm(w0, rbase + (f0 >> 4)) & ~127u), b0 = unordf(bperm(w1, rbase + (f0 & 15)) & ~127u); cp[0] = (ordf(a0 + b0) & ~63u) | (unsigned)(63 - c); }
        { const float a0 = unordf(bperm(w0, rbase + (f1 >> 4)) & ~127u), b0 = unordf(bperm(w1, rbase + (f1 & 15)) & ~127u); cp[1] = (ordf(a0 + b0) & ~63u) | (unsigned)(47 - c); }
        { const float a0 = unordf(bperm(w0, rbase + (f2 >> 4)) & ~127u), b0 = unordf(bperm(w1, rbase + (f2 & 15)) & ~127u); cp[2] = (ordf(a0 + b0) & ~63u) | (unsigned)(31 - c); }
        { const float a0 = unordf(bperm(w0, rbase + (f3 >> 4)) & ~127u), b0 = unordf(bperm(w1, rbase + (f3 & 15)) & ~127u); cp[3] = (c + 48 < 50) ? ((ordf(a0 + b0) & ~63u) | (unsigned)(15 - c)) : 0u; }
        const unsigned Wc = top16_of4r(cp, c);
        const int slot = 63 - (int)(Wc & 63u);
        const unsigned fa = bperm((unsigned)f0, rbase + (slot & 15)), fb = bperm((unsigned)f1, rbase + (slot & 15)), fc = bperm((unsigned)f2, rbase + (slot & 15)), fd = bperm((unsigned)f3, rbase + (slot & 15));
        const int sq = slot >> 4; const int flat = (int)((sq == 0) ? fa : (sq == 1) ? fb : (sq == 2) ? fc : fd);
        const float val = unordf(Wc & ~63u);
        const float vmax = __uint_as_float(bperm(__float_as_uint(val), rbase));
        const float e = __expf(val - vmax);
        const float g = e / sum16(e);
        const int k1 = 127 - (int)(bperm(w0, rbase + (flat >> 4)) & 127u), k2 = 127 - (int)(bperm(w1, rbase + (flat & 15)) & 127u);
        const int tok = t0 + 16 * (pb >> 2) + 4 * g4 + (pb & 3);
        EI[(size_t)(tok * 8 + h) * 16 + c] = k1 * 128 + k2; GW[(size_t)(tok * 8 + h) * 16 + c] = g;
    }
}

__device__ __forceinline__ float gelu_tanh_f(float x) {
    const float u = 0.7978845608028654f * (x + 0.044715f * x * x * x);
    const float e = __expf(2.f * u);
    const float th = 1.f - 2.f / (e + 1.f);
    return 0.5f * x * (1.f + th);
}
__device__ __forceinline__ float wave_sum_bfly(float v) {
#pragma unroll
    for (int o = 1; o < 64; o <<= 1) v += __shfl_xor(v, o);
    return v;
}
typedef float f32x2_ __attribute__((ext_vector_type(2)));
#define FP4_DEC(w_, sel_) __builtin_amdgcn_cvt_scalef32_pk_f32_fp4((unsigned)(w_), 1.0f, (sel_))
typedef int i32x8 __attribute__((ext_vector_type(8)));
template <int NBT>
__device__ __forceinline__ void peer_a_slice(const bf16* xb, const int* EI, const unsigned char* U4s, float* pd, int s, unsigned* ctr, int nbatch, int lane) {
    const int c = lane & 15, g4 = lane >> 4, k8 = c >> 1;
    const unsigned char* tab = U4s + (size_t)s * (16384 * 128) + (4 * (c & 1) + g4) * 16;
#define A_FETCH() ((int)__builtin_amdgcn_readfirstlane((int)((lane == 0) ? __hip_atomic_fetch_add(ctr, 1u, __ATOMIC_RELAXED, __HIP_MEMORY_SCOPE_AGENT) : 0u)))
#define A_TOKB(b_, j_) ((((b_) < nbatch) ? (b_) : (nbatch - 1)) * NBT + (j_))
#define A_XS(XS, t_) do { const bf16* xp_ = xb + (size_t)(t_) * 2048 + s * 256 + 128 * (c & 1) + 16 * g4; XS[0] = *(const v4u*)xp_; XS[1] = *(const v4u*)(xp_ + 8); XS[2] = *(const v4u*)(xp_ + 64); XS[3] = *(const v4u*)(xp_ + 72); } while (0)
#define A_ISSUE(U, EV) do { _Pragma("unroll") for (int i = 0; i < 8; ++i) { const int e_ = (int)bperm((unsigned)(EV), (i << 3) + k8); U[i] = *(const v4u*)(tab + (size_t)e_ * 128); } } while (0)
#define A_COMPUTE(U, OUT) do { _Pragma("unroll") for (int i = 0; i < 8; ++i) { f32x4 d_ = (f32x4){0.f, 0.f, 0.f, 0.f}; \
            d_ = __builtin_amdgcn_mfma_scale_f32_16x16x128_f8f6f4((i32x8){(int)U[i][0], (int)U[i][1], (int)U[i][2], (int)U[i][3], 0, 0, 0, 0}, hb, d_, 4, 0, 0, 0x7f7f7f7f, 0, 0x7f7f7f7f); \
            const float o0_ = d_[0] + DPPF(d_[1], 0xB1), o1_ = d_[2] + DPPF(d_[3], 0xB1);        \
            if (k8 == i) OUT = (f32x2_){o0_, o1_}; } } while (0)
    int eL[NBT], eH[NBT], nL[NBT], nH[NBT]; v4u xs[2][4]; v4u UA[8], UB[8];
    int b0 = A_FETCH(), b1 = A_FETCH();
    if (b0 >= nbatch) return;
#pragma unroll
    for (int j = 0; j < NBT; ++j) { const int tj = A_TOKB(b0, j); eL[j] = EI[(size_t)tj * 128 + lane]; eH[j] = EI[(size_t)tj * 128 + 64 + lane]; }
    A_XS(xs[0], A_TOKB(b0, 0));
    A_ISSUE(UA, eL[0]);
    while (b0 < nbatch) {
        const int b2 = A_FETCH();
#pragma unroll
        for (int j = 0; j < NBT; ++j) { const int tj = A_TOKB(b1, j); nL[j] = EI[(size_t)tj * 128 + lane]; nH[j] = EI[(size_t)tj * 128 + 64 + lane]; }
#pragma unroll
        for (int j = 0; j < NBT; ++j) {
            const int t = b0 * NBT + j;
            A_ISSUE(UB, eH[j]);
            i32x8 hb;
#pragma unroll
            for (int q = 0; q < 4; ++q) { const v4u w = xs[j & 1][q]; int lo = 0, hi = 0;
                lo = __builtin_amdgcn_cvt_pk_fp8_f32(__uint_as_float(w[0] << 16), __uint_as_float(w[0] & 0xffff0000u), lo, false); lo = __builtin_amdgcn_cvt_pk_fp8_f32(__uint_as_float(w[1] << 16), __uint_as_float(w[1] & 0xffff0000u), lo, true);
                hi = __builtin_amdgcn_cvt_pk_fp8_f32(__uint_as_float(w[2] << 16), __uint_as_float(w[2] & 0xffff0000u), hi, false); hi = __builtin_amdgcn_cvt_pk_fp8_f32(__uint_as_float(w[3] << 16), __uint_as_float(w[3] & 0xffff0000u), hi, true);
                hb[2 * q] = lo; hb[2 * q + 1] = hi; }
            f32x2_ out_lo = (f32x2_){0.f, 0.f}, out_hi = (f32x2_){0.f, 0.f};
            A_COMPUTE(UA, out_lo);
            A_XS(xs[(j + 1) & 1], (j + 1 < NBT) ? (b0 * NBT + j + 1) : A_TOKB(b1, 0));
            A_ISSUE(UA, (j + 1 < NBT) ? eL[(j + 1) % NBT] : nL[0]);
            A_COMPUTE(UB, out_hi);
            if ((c & 1) == 0) { float* pp = pd + ((size_t)s * T + t) * 128 + 8 * k8 + 2 * g4; *(f32x2_*)pp = out_lo; *(f32x2_*)(pp + 64) = out_hi; }
        }
#pragma unroll
        for (int j = 0; j < NBT; ++j) { eL[j] = nL[j]; eH[j] = nH[j]; }
        b0 = b1; b1 = b2;
    }
#undef A_FETCH
#undef A_TOKB
#undef A_XS
#undef A_ISSUE
#undef A_COMPUTE
}
__device__ __forceinline__ void peer_a2_token(const float* pd, const float* ssq, const int* EI, const float* su, const float* sv, float* GW, float* W1, int t, int lane) {
    float a0 = 0.f, a1 = 0.f, b0 = 0.f, b1 = 0.f;
#pragma unroll
    for (int s = 0; s < 4; ++s) { const float* pp = pd + ((size_t)s * T + t) * 128; a0 += pp[lane]; a1 += pp[64 + lane]; }
#pragma unroll
    for (int s = 4; s < 8; ++s) { const float* pp = pd + ((size_t)s * T + t) * 128; b0 += pp[lane]; b1 += pp[64 + lane]; }
    const float rs = rsqrtf(ssq[t] * (1.f / 2048.f) + EPS);
    float* gp = GW + (size_t)t * 128; float* hp = W1 + (size_t)t * 128; const int pl = lane;
    const int e0 = EI[(size_t)t * 128 + pl], e1 = EI[(size_t)t * 128 + 64 + pl];
    const float g0 = gp[pl] * gelu_tanh_f(rs * (a0 * su[2 * e0] + b0 * su[2 * e0 + 1])), g1 = gp[64 + pl] * gelu_tanh_f(rs * (a1 * su[2 * e1] + b1 * su[2 * e1 + 1]));
    gp[pl] = g0 * sv[2 * e0]; hp[pl] = g0 * sv[2 * e0 + 1];
    gp[64 + pl] = g1 * sv[2 * e1]; hp[64 + pl] = g1 * sv[2 * e1 + 1];
}
template <int NBT>
__device__ __forceinline__ void peer_b_slice(float* xio, const int* EI, const float* W, const unsigned char* V4s, bf16* xb, float* ssq_out, int s, unsigned* ctr, int nbatch, int lane) {
    const int j16 = lane & 15, g4 = lane >> 4;
    const unsigned char* tab = V4s + (size_t)s * (16384 * 128) + 8 * j16;
    const int doff = s * 256 + 64 * g4 + j16;
    const int sh8 = 8 * (j16 & 3); const bool q0 = (j16 >> 2) == 0, q1 = (j16 >> 2) == 1, q2 = (j16 >> 2) == 2, q3 = (j16 >> 2) == 3;
#define B_FETCH() ((int)__builtin_amdgcn_readfirstlane((int)((lane == 0) ? __hip_atomic_fetch_add(ctr, 1u, __ATOMIC_RELAXED, __HIP_MEMORY_SCOPE_AGENT) : 0u)))
#define B_TOKB(b_, j_) ((((b_) < nbatch) ? (b_) : (nbatch - 1)) * NBT + (j_))
#define B_ISSUE(V, EV) do { _Pragma("unroll") for (int i = 0; i < 8; ++i) { const int e0_ = (int)bperm((unsigned)(EV), 8 * i + 2 * g4), e1_ = (int)bperm((unsigned)(EV), 8 * i + 2 * g4 + 1); \
        V[2 * i] = *(const v2u*)(tab + (size_t)e0_ * 128); V[2 * i + 1] = *(const v2u*)(tab + (size_t)e1_ * 128); } } while (0)
#define B_COMPUTE(V, WV) do { _Pragma("unroll") for (int i = 0; i < 8; ++i) { \
            const float w0_ = __uint_as_float(bperm(__float_as_uint(WV), 8 * i + g4)) * 256.f, w1_ = __uint_as_float(bperm(__float_as_uint(WV), 8 * i + 4 + g4)) * 256.f; \
            const unsigned f0_ = ((unsigned)__builtin_amdgcn_cvt_pk_fp8_f32(w0_, 0.f, 0, false) & 0xffu) << sh8, f1_ = ((unsigned)__builtin_amdgcn_cvt_pk_fp8_f32(w1_, 0.f, 0, false) & 0xffu) << sh8; \
            const i32x8 bq_ = (i32x8){(int)(q0 ? f0_ : 0u), (int)(q1 ? f0_ : 0u), (int)(q2 ? f0_ : 0u), (int)(q3 ? f0_ : 0u), (int)(q0 ? f1_ : 0u), (int)(q1 ? f1_ : 0u), (int)(q2 ? f1_ : 0u), (int)(q3 ? f1_ : 0u)}; \
            acc = __builtin_amdgcn_mfma_scale_f32_16x16x128_f8f6f4((i32x8){(int)V[2 * i][0], (int)V[2 * i][1], (int)V[2 * i + 1][0], (int)V[2 * i + 1][1], 0, 0, 0, 0}, bq_, acc, 4, 0, 0, 0x7f7f7f7f, 0, 0x77777777); } } while (0)
    int eL[NBT], eH[NBT], nL[NBT], nH[NBT]; float wL[NBT], wH[NBT], mL[NBT], mH[NBT]; float xv[4]; v2u VA[16], VB[16];
    int b0 = B_FETCH(), b1 = B_FETCH();
    if (b0 >= nbatch) return;
#pragma unroll
    for (int j = 0; j < NBT; ++j) { const int tj = B_TOKB(b0, j); eL[j] = EI[(size_t)tj * 128 + lane]; eH[j] = EI[(size_t)tj * 128 + 64 + lane]; wL[j] = W[(size_t)tj * 128 + lane]; wH[j] = W[(size_t)tj * 128 + 64 + lane]; }
    B_ISSUE(VA, eL[0]);
    while (b0 < nbatch) {
        const int b2 = B_FETCH();
#pragma unroll
        for (int j = 0; j < NBT; ++j) { const int tj = B_TOKB(b1, j); nL[j] = EI[(size_t)tj * 128 + lane]; nH[j] = EI[(size_t)tj * 128 + 64 + lane]; mL[j] = W[(size_t)tj * 128 + lane]; mH[j] = W[(size_t)tj * 128 + 64 + lane]; }
#pragma unroll
        for (int j = 0; j < NBT; ++j) {
            const int t = b0 * NBT + j;
            float* xp = xio + (size_t)t * 2048 + doff;
#pragma unroll
            for (int r = 0; r < 4; ++r) xv[r] = xp[16 * r];
            B_ISSUE(VB, eH[j]);
            f32x4 acc = (f32x4){0.f, 0.f, 0.f, 0.f};
            B_COMPUTE(VA, wL[j]);
            B_ISSUE(VA, (j + 1 < NBT) ? eL[(j + 1) % NBT] : nL[0]);
            B_COMPUTE(VB, wH[j]);
            float ss = 0.f;
#pragma unroll
            for (int r = 0; r < 4; ++r) { const float o = xv[r] + acc[r]; ss += o * o; xp[16 * r] = o; if (xb) xb[(size_t)t * 2048 + doff + 16 * r] = (bf16)f2bf(o); }
            ss += DPPF(ss, 0xB1); ss += DPPF(ss, 0x4E); ss += DPPF(ss, 0x141); ss += DPPF(ss, 0x140);
            { const auto r = __builtin_amdgcn_permlane16_swap(__float_as_uint(ss), __float_as_uint(ss), false, false); ss = __uint_as_float(r[0]) + __uint_as_float(r[1]); }
            { const auto r = __builtin_amdgcn_permlane32_swap(__float_as_uint(ss), __float_as_uint(ss), false, false); ss = __uint_as_float(r[0]) + __uint_as_float(r[1]); }
            if (lane == 0) unsafeAtomicAdd(ssq_out + t, ss);
        }
#pragma unroll
        for (int j = 0; j < NBT; ++j) { eL[j] = nL[j]; eH[j] = nH[j]; wL[j] = mL[j]; wH[j] = mH[j]; }
        b0 = b1; b1 = b2;
    }
#undef B_FETCH
#undef B_TOKB
#undef B_ISSUE
#undef B_COMPUTE
}
__device__ __forceinline__ void final_norm_row(float* xio, const float* ssq, const float* fin, int t, int lane, float oscale) {
    const float r2 = rsqrtf(ssq[t] * (1.f / 2048.f) + EPS) * oscale;
    float* xr = xio + (size_t)t * 2048 + 4 * lane;
#pragma unroll
    for (int j = 0; j < 8; ++j) { const f32x4 xv = *(const f32x4*)(xr + 256 * j), g = *(const f32x4*)(fin + 256 * j + 4 * lane); f32x4 o;
        o[0] = xv[0] * r2 * g[0]; o[1] = xv[1] * r2 * g[1]; o[2] = xv[2] * r2 * g[2]; o[3] = xv[3] * r2 * g[3]; *(f32x4*)(xr + 256 * j) = o; }
}
typedef short s16x4 __attribute__((ext_vector_type(4)));
__device__ __forceinline__ unsigned cvt_pk_bf16_(float lo, float hi) { unsigned r; asm volatile("v_cvt_pk_bf16_f32 %0, %1, %2" : "=v"(r) : "v"(lo), "v"(hi)); return r; }
constexpr int ATT_K_OFF = 0, ATT_V_OFF = 40960, ATT_VSTRIDE = 648, ATT_LDS = ATT_V_OFF + 64 * ATT_VSTRIDE;
__device__ __forceinline__ void attn_fill(LAS unsigned char* lds, const bf16* K, const bf16* Vt, int b, int kvh, int kw0, int tid) {
    const size_t tb = (size_t)b * 4096;
#pragma unroll
    for (int i = 0; i < 5; ++i) { const int idx = tid + 512 * i, row = idx >> 3, ch = idx & 7, key = kw0 + row;
        v4u v = (v4u){0u, 0u, 0u, 0u}; if (key >= 0 && key < 4096) v = *(const v4u*)(K + (tb + key) * 512 + kvh * 64 + ch * 8);
        *(LAS v4u*)(lds + ATT_K_OFF + row * 128 + ((ch ^ ((row >> 1) & 7)) << 4)) = v; }
#pragma unroll
    for (int i = 0; i < 10; ++i) { const int idx = tid + 512 * i, d = idx / 80, pc = idx % 80, key = kw0 + pc * 4;
        v2u v = (v2u){0u, 0u}; if (key >= 0 && key < 4096) v = *(const v2u*)(Vt + (size_t)(kvh * 64 + d) * 16384 + tb + key);
        *(LAS v2u*)(lds + ATT_V_OFF + d * ATT_VSTRIDE + pc * 8) = v; }
}
__device__ __forceinline__ void attn_task(LAS const unsigned char* lds, const bf16* Q, bf16* O, const float* sinks, int b, int hq, int q0, int kw0, int lane) {
    const int c = lane & 31, hi = lane >> 5;
    const size_t tb = (size_t)b * 4096;
    s16x8 qf[4];
    { const bf16* qp = Q + (tb + q0 + c) * 2048 + hq * 64 + hi * 8;
#pragma unroll
      for (int ks = 0; ks < 4; ++ks) qf[ks] = *(const s16x8*)(qp + ks * 16); }
    const float sink2 = sinks[hq] * 1.4426950408889634f;
    float m = sink2, l = (hi == 0) ? 1.f : 0.f;
    f32x16 o0, o1;
#pragma unroll
    for (int r = 0; r < 16; ++r) { o0[r] = 0.f; o1[r] = 0.f; }
    const int kt_lo = (q0 < 128) ? ((128 - q0) >> 5) : 0, kt_hi = ((4192 - q0) >> 5) < 8 ? ((4192 - q0) >> 5) : 8;
    for (int kt = kt_lo; kt <= kt_hi; ++kt) {
        const int key0 = q0 - 128 + 32 * kt, row0 = key0 - kw0;
        s16x8 kf[4]; s16x4 va[2][2][2];
        { const int row = row0 + c; LAS const unsigned char* kp = lds + ATT_K_OFF + row * 128; const int sw = (row >> 1) & 7;
#pragma unroll
          for (int ks = 0; ks < 4; ++ks) kf[ks] = *(LAS const s16x8*)(kp + (((2 * ks + hi) ^ sw) << 4)); }
#pragma unroll
        for (int db = 0; db < 2; ++db)
#pragma unroll
            for (int s = 0; s < 2; ++s) { LAS const unsigned char* vp = lds + ATT_V_OFF + (db * 32 + c) * ATT_VSTRIDE + (row0 + 16 * s + 4 * hi) * 2; va[db][s][0] = *(LAS const s16x4*)vp; va[db][s][1] = *(LAS const s16x4*)(vp + 16); }
        f32x16 sa;
#pragma unroll
        for (int r = 0; r < 16; ++r) sa[r] = 0.f;
#pragma unroll
        for (int ks = 0; ks < 4; ++ks) sa = __builtin_amdgcn_mfma_f32_32x32x16_bf16(kf[ks], qf[ks], sa, 0, 0, 0);
        if (kt == 0 || kt == 8) {
            const int dbase = key0 - (q0 + c) + 4 * hi;
#pragma unroll
            for (int r = 0; r < 16; ++r) { const int d = dbase + (r & 3) + 8 * (r >> 2); if (d < -128 || d > 128) sa[r] = -1e30f; }
        }
        float mx = sa[0];
#pragma unroll
        for (int r = 1; r < 16; ++r) mx = fmaxf(mx, sa[r]);
        { const auto rr = __builtin_amdgcn_permlane32_swap(__float_as_uint(mx), __float_as_uint(mx), false, false); mx = fmaxf(__uint_as_float(rr[0]), __uint_as_float(rr[1])); }
        const float mn = fmaxf(m, mx), alpha = __builtin_amdgcn_exp2f(m - mn);
        m = mn;
        float ps = 0.f;
#pragma unroll
        for (int r = 0; r < 16; ++r) { sa[r] = __builtin_amdgcn_exp2f(sa[r] - mn); ps += sa[r]; }
        l = l * alpha + ps;
#pragma unroll
        for (int r = 0; r < 16; ++r) { o0[r] *= alpha; o1[r] *= alpha; }
        s16x8 pf[2];
#pragma unroll
        for (int s = 0; s < 2; ++s) { v4u w; w.x = cvt_pk_bf16_(sa[8 * s + 0], sa[8 * s + 1]); w.y = cvt_pk_bf16_(sa[8 * s + 2], sa[8 * s + 3]); w.z = cvt_pk_bf16_(sa[8 * s + 4], sa[8 * s + 5]); w.w = cvt_pk_bf16_(sa[8 * s + 6], sa[8 * s + 7]);
            pf[s] = __builtin_bit_cast(s16x8, w); }
#pragma unroll
        for (int s = 0; s < 2; ++s) {
            const s16x8 v0 = __builtin_shufflevector(va[0][s][0], va[0][s][1], 0, 1, 2, 3, 4, 5, 6, 7), v1 = __builtin_shufflevector(va[1][s][0], va[1][s][1], 0, 1, 2, 3, 4, 5, 6, 7);
            o0 = __builtin_amdgcn_mfma_f32_32x32x16_bf16(v0, pf[s], o0, 0, 0, 0);
            o1 = __builtin_amdgcn_mfma_f32_32x32x16_bf16(v1, pf[s], o1, 0, 0, 0);
        }
    }
    { const auto rr = __builtin_amdgcn_permlane32_swap(__float_as_uint(l), __float_as_uint(l), false, false); l = __uint_as_float(rr[0]) + __uint_as_float(rr[1]); }
    const float il = 1.f / l;
    bf16* op = O + (tb + q0 + c) * 2048 + hq * 64 + 4 * hi;
#pragma unroll
    for (int g = 0; g < 4; ++g) {
        v2u w0, w1;
        w0.x = cvt_pk_bf16_(o0[4 * g + 0] * il, o0[4 * g + 1] * il); w0.y = cvt_pk_bf16_(o0[4 * g + 2] * il, o0[4 * g + 3] * il);
        w1.x = cvt_pk_bf16_(o1[4 * g + 0] * il, o1[4 * g + 1] * il); w1.y = cvt_pk_bf16_(o1[4 * g + 2] * il, o1[4 * g + 3] * il);
        *(v2u*)(op + 8 * g) = w0; *(v2u*)(op + 32 + 8 * g) = w1;
    }
}
typedef float fx2 __attribute__((ext_vector_type(2)));
__device__ __forceinline__ fx2 bf2_(unsigned w) { fx2 r; r[0] = __uint_as_float(w << 16); r[1] = __uint_as_float(w & 0xffff0000u); return r; }
__device__ __forceinline__ void fft16_item(bf16* Zp, const float* tw, int bg, int l, int s1h, int lane) {
    const int s1 = s1h * 128 + 2 * lane;
    bf16* base = Zp + ((size_t)(bg * 16) * 256 + l) * 512 + s1;
    fx2 zr[16], zi[16];
#pragma unroll
    for (int s2 = 0; s2 < 16; ++s2) { zr[s2] = bf2_(*(const unsigned*)(base + (size_t)s2 * 256 * 512)); zi[s2] = bf2_(*(const unsigned*)(base + (size_t)s2 * 256 * 512 + 256)); }
    fx2 er[16], ei[16];
#pragma unroll
    for (int d = 0; d < 4; ++d) {
        const fx2 ar = zr[d], ai_ = zi[d], br = zr[4 + d], bi = zi[4 + d], cr = zr[8 + d], ci = zi[8 + d], dr = zr[12 + d], di = zi[12 + d];
        const fx2 s0r = ar + cr, s0i = ai_ + ci, s1r = ar - cr, s1i = ai_ - ci, s2r = br + dr, s2i = bi + di, s3r = br - dr, s3i = bi - di;
        er[0 * 4 + d] = s0r + s2r; ei[0 * 4 + d] = s0i + s2i;
        er[1 * 4 + d] = s1r + s3i; ei[1 * 4 + d] = s1i - s3r;
        er[2 * 4 + d] = s0r - s2r; ei[2 * 4 + d] = s0i - s2i;
        er[3 * 4 + d] = s1r - s3i; ei[3 * 4 + d] = s1i + s3r;
    }
#pragma unroll
    for (int a = 1; a < 4; ++a)
#pragma unroll
        for (int d = 1; d < 4; ++d) {
            const float ang = 6.283185307179586f * (float)(a * d) / 16.f; const float c = __builtin_cosf(ang), sn = __builtin_sinf(ang);
            const fx2 xr = er[a * 4 + d], xi = ei[a * 4 + d];
            er[a * 4 + d] = xr * c + xi * sn; ei[a * 4 + d] = xi * c - xr * sn;
        }
#pragma unroll
    for (int a = 0; a < 4; ++a) {
        const fx2 ar = er[a * 4 + 0], ai_ = ei[a * 4 + 0], br = er[a * 4 + 1], bi = ei[a * 4 + 1], cr = er[a * 4 + 2], ci = ei[a * 4 + 2], dr = er[a * 4 + 3], di = ei[a * 4 + 3];
        const fx2 s0r = ar + cr, s0i = ai_ + ci, s1r = ar - cr, s1i = ai_ - ci, s2r = br + dr, s2i = bi + di, s3r = br - dr, s3i = bi - di;
        fx2 Dr[4], Di[4];
        Dr[0] = s0r + s2r; Di[0] = s0i + s2i; Dr[1] = s1r + s3i; Di[1] = s1i - s3r; Dr[2] = s0r - s2r; Di[2] = s0i - s2i; Dr[3] = s1r - s3i; Di[3] = s1i + s3r;
#pragma unroll
        for (int b = 0; b < 4; ++b) {
            const int k2 = a + 4 * b;
            const f32x4 t0 = *(const f32x4*)(tw + (size_t)(k2 * 256 + s1) * 2);
            const fx2 cc = (fx2){t0[0], t0[2]}, ss = (fx2){t0[1], t0[3]};
            const fx2 hr = Dr[b] * cc + Di[b] * ss, hi_ = Di[b] * cc - Dr[b] * ss;
            *(unsigned*)(base + (size_t)k2 * 256 * 512) = pk2(hr[0], hr[1]); *(unsigned*)(base + (size_t)k2 * 256 * 512 + 256) = pk2(hi_[0], hi_[1]);
        }
    }
}
__device__ __forceinline__ int static_unit(int nM, int nN, int G, int c, int i) {
    const int nwg = nM * nN; const long L = (long)i * G + c; if (L >= nwg) return -1;
    int wgid = (int)L; { const int q = nwg / 8, r = nwg % 8, xcd = wgid % 8, off = wgid / 8; wgid = (xcd < r ? xcd * (q + 1) : r * (q + 1) + (xcd - r) * q) + off; }
    const int nig = 8 * nN, gid = wgid / nig, fm = gid * 8, gsz = (nM - fm) < 8 ? (nM - fm) : 8;
    return ((fm + ((wgid % nig) % gsz)) << 16) | ((wgid % nig) / gsz);
}
#ifndef REP_PRO
#define REP_PRO 1
#endif
#ifndef REP_GEMM
#define REP_GEMM 1
#endif
#ifndef REP_ATT
#define REP_ATT 1
#endif
#ifndef REP_LITE
#define REP_LITE 0
#endif
#ifndef REP_Q
#define REP_Q 1
#endif
#ifndef REP_PA
#define REP_PA 1
#endif
#ifndef REP_TK
#define REP_TK 1
#endif
enum { PH_PRO = 0, PH_G1 = 1, PH_S1 = 2, PH_G2 = 3, PH_G3 = 4, PH_Q0 = 5, PH_TK0 = 6, PH_PA0 = 7, PH_PW0 = 8, PH_PB0 = 9, PH_QKV = 10, PH_ATT = 11, PH_WO = 12, PH_Q1 = 13, PH_TK1 = 14, PH_PA1 = 15, PH_PW1 = 16, PH_PB1 = 17, PH_FIN = 18, PH_END = 19 };
__global__ void __launch_bounds__(NWAVES * 64, 2) mega(Args a) {
    extern __shared__ __attribute__((aligned(16))) unsigned char lds_raw[];
    LAS unsigned char* lds = (LAS unsigned char*)lds_raw;
    cg::grid_group grid = cg::this_grid();
    const int wave = __builtin_amdgcn_readfirstlane(threadIdx.x >> 6);
#define FRESH_IDS() int lane; asm volatile("v_mbcnt_lo_u32_b32 %0, -1, 0\n\tv_mbcnt_hi_u32_b32 %0, -1, %0" : "=v"(lane)); const int tid = wave * 64 + lane; (void)tid
    const int G = gridDim.x, bx = blockIdx.x;
    unsigned char* ws = a.ws;
    const int lo = a.ph_lo, hi = a.ph_hi;
    volatile LAS unsigned* MISC = (volatile LAS unsigned*)(lds + LDSCTL_OFF);
    if (threadIdx.x < 16) MISC[threadIdx.x] = 0u;
    __syncthreads();
    XcdBarrier xbar = xcd_barrier_post((unsigned*)(ws + WS_CTL) + CW_BAR, MISC + 8);
#define IN(k) (lo <= (k) && (k) < hi)
#ifdef DIAG_A
#define STAMP(i) do { if (bx == 0 && threadIdx.x == 0) ((unsigned long long*)(ws + WS_STAMP))[i] = __builtin_amdgcn_s_memrealtime(); } while (0)
#else
#define STAMP(i) do { } while (0)
#endif
#define SEAM(k) do { if (IN(k) && IN((k) + 1)) { if ((k) == PH_PRO) grid.sync(); else xcd_barrier(xbar); } STAMP((k) + 1); } while (0)
    STAMP(0);
    for (int rep_ = 0; rep_ < REP_PRO; ++rep_)
    if (IN(PH_PRO)) { FRESH_IDS();
        const int gw = bx * NWAVES + wave, NGW = G * NWAVES;
        const size_t gtid = (size_t)bx * (NWAVES * 64) + tid, ngt = (size_t)G * NWAVES * 64;
        LAS float* scr = (LAS float*)(lds + wave * 16384);
        {
            constexpr int I_SQ = (DM / 64) * (DM / 32), I_QKV = (DM / 64) * (QKVW / 32);
            constexpr int NITEMS = 4 * I_SQ + I_QKV;
            for (int it = gw; it < NITEMS; it += NGW) {
                int r = it;
                if (r < I_SQ) { transpose_item<0>(a.in[3], DM, DM, nullptr, (bf16*)(ws + WS_WOF), scr, r, lane); continue; } r -= I_SQ;
                if (r < I_SQ) { transpose_item<0>(a.in[5], DM, DM, nullptr, (bf16*)(ws + WS_WOA), scr, r, lane); continue; } r -= I_SQ;
                if (r < I_SQ) { transpose_item<0>(a.in[7], DM, DM, a.in[2], (bf16*)(ws + WS_WQ0), scr, r, lane); continue; } r -= I_SQ;
                if (r < I_SQ) { transpose_item<0>(a.in[7] + (size_t)DM * DM, DM, DM, a.in[2] + DM, (bf16*)(ws + WS_WQ1), scr, r, lane); continue; } r -= I_SQ;
                transpose_item<1>(a.in[4], DM, QKVW, a.in[1] + DM, (bf16*)(ws + WS_WQKV), scr, r, lane);
            }
        }
        for (int row = gw; row < T; row += NGW) {
            const f32x4* xr = (const f32x4*)(a.in[0] + (size_t)row * DM) + lane;
            const f32x4* gr = (const f32x4*)a.in[1] + lane;
            f32x4 v[8]; float s = 0.f;
#pragma unroll
            for (int j = 0; j < 8; ++j) { v[j] = xr[64 * j]; s += (v[j][0] * v[j][0] + v[j][1] * v[j][1]) + (v[j][2] * v[j][2] + v[j][3] * v[j][3]); }
            const float r = rsqrtf(wsum(s) * (1.f / DM) + EPS);
            const int b = row >> 12, sp = row & 4095;
#pragma unroll
            for (int j = 0; j < 8; ++j) { const f32x4 gg = gr[64 * j]; v2u o; o.x = pk2(v[j][0] * r * gg[0], v[j][1] * r * gg[1]); o.y = pk2(v[j][2] * r * gg[2], v[j][3] * r * gg[3]);
                *(v2u*)((bf16*)(ws + WS_XG) + ((size_t)((b * 8 + j) * 4096 + sp) * 256 + 4 * lane)) = o; }
        }
        for (size_t i = gtid; i < (size_t)256 * 512 / 8; i += ngt) {
            const int k1 = (int)(i >> 6), c0 = (int)(i & 63) * 8, part = c0 >> 8, s0 = c0 & 255;
            float v[8];
#pragma unroll
            for (int e = 0; e < 8; ++e) { const int m = (k1 * (s0 + e)) & 255; const float rev = (float)m * (1.f / 256.f); v[e] = (part ? __builtin_amdgcn_sinf(rev) : __builtin_amdgcn_cosf(rev)) * (1.f / 64.f); }
            v4u o; o.x = pk2(v[0], v[1]); o.y = pk2(v[2], v[3]); o.z = pk2(v[4], v[5]); o.w = pk2(v[6], v[7]);
            *(v4u*)((bf16*)(ws + WS_A2) + i * 8) = o;
        }
        for (size_t i = gtid; i < (size_t)16 * 256; i += ngt) {
            const int k2 = (int)(i >> 8), s1 = (int)(i & 255); const float rev = (float)(k2 * s1) * (1.f / 4096.f);
            ((float*)(ws + WS_TW))[2 * i] = __builtin_amdgcn_cosf(rev); ((float*)(ws + WS_TW))[2 * i + 1] = __builtin_amdgcn_sinf(rev);
        }
        for (size_t i = gtid; i < (size_t)512 * 256 / 8; i += ngt) {
            const int n = (int)(i >> 5), c0 = (int)(i & 31) * 8, part = n >> 8, l = n & 255;
            float v[8];
#pragma unroll
            for (int e = 0; e < 8; ++e) { const int m = (l * (c0 + e)) & 255; const float rev = (float)m * (1.f / 256.f); v[e] = (part ? -__builtin_amdgcn_sinf(rev) : __builtin_amdgcn_cosf(rev)) * (1.f / 16.f); }
            v4u o; o.x = pk2(v[0], v[1]); o.y = pk2(v[2], v[3]); o.z = pk2(v[4], v[5]); o.w = pk2(v[6], v[7]);
            *(v4u*)((bf16*)(ws + WS_WCS) + i * 8) = o;
        }
        for (size_t i = gtid; i < (size_t)4096 * 32; i += ngt) {
            const int pos = (int)(i >> 5), fi = (int)(i & 31);
            const double inv = exp2(-(double)fi * (13.287712379549449 / 32.0));
            double sn, cs; sincos((double)pos * inv, &sn, &cs);
            ((float*)(ws + WS_ROPE))[2 * i] = (float)cs; ((float*)(ws + WS_ROPE))[2 * i + 1] = (float)sn;
        }
        cvt_stream(a.in[8], (bf16*)(ws + WS_KEYS), (size_t)2 * PH * 2 * 128 * 128 / 8, gtid, ngt);
    }
    SEAM(PH_PRO);
    for (int rep_ = 0; rep_ < REP_GEMM; ++rep_)
    if (IN(PH_G1)) { FRESH_IDS();
        int Kq = FW; asm volatile("" : "+s"(Kq));
        pg8::Gemm g{(const pg8::bf16_t*)(ws + WS_WCS), (const pg8::bf16_t*)(ws + WS_XG), 512, T * FG, Kq}; pg8::StaticOrder S; S.init(512, T * FG, G, bx);
        pg8::EpiZt E{(pg8::bf16_t*)(ws + WS_ZT)};
        pg8::gemm_phase<pg8::EpiZt, pg8::StaticOrder, true, true>(lds, g, S, E);
    }
    SEAM(PH_G1);
    if (IN(PH_S1)) { FRESH_IDS();
        const int gw = bx * NWAVES + wave, NGW = G * NWAVES;
        for (int it = gw; it < 32 * 256 * 2; it += NGW) fft16_item((bf16*)(ws + WS_ZT), (const float*)(ws + WS_TW), it >> 9, (it >> 1) & 255, it & 1, lane);
    }
    SEAM(PH_S1);
    for (int rep_ = 0; rep_ < REP_GEMM; ++rep_)
    if (IN(PH_G2)) { FRESH_IDS();
        pg8::Gemm g{(const pg8::bf16_t*)(ws + WS_A2), (const pg8::bf16_t*)(ws + WS_ZT), 256, 131072, 512}; pg8::StaticOrder S; S.init(256, 131072, G, bx);
        pg8::EpiY E{(pg8::bf16_t*)(ws + WS_Y)};
        pg8::gemm_phase<pg8::EpiY, pg8::StaticOrder, true, true>(lds, g, S, E);
    }
    SEAM(PH_G2);
    if (IN(PH_G3)) { FRESH_IDS();
        pg8::Gemm g{(const pg8::bf16_t*)(ws + WS_Y), (const pg8::bf16_t*)(ws + WS_WOF), T, DM, DM}; pg8::StaticOrder S; S.init(T, DM, G, bx);
        pg8::EpiRes E{a.in[0], a.out, (pg8::bf16_t*)(ws + WS_XB), (float*)(ws + WS_SSQ_A)};
        pg8::gemm_phase<pg8::EpiRes, pg8::StaticOrder, true, true>(lds, g, S, E);
    }
    SEAM(PH_G3);
#define PEER_LAYER(L) do { \
        const int pq = L ? PH_Q1 : PH_Q0, ptk = L ? PH_TK1 : PH_TK0, ppa = L ? PH_PA1 : PH_PA0, ppw = L ? PH_PW1 : PH_PW0, ppb = L ? PH_PB1 : PH_PB0; \
        for (int rep_ = 0; rep_ < REP_Q; ++rep_) \
        if (IN(pq)) { FRESH_IDS(); \
            pg8::Gemm g{(const pg8::bf16_t*)(ws + WS_XB), (const pg8::bf16_t*)(ws + (L ? WS_WQ1 : WS_WQ0)), T, DM, DM}; pg8::StaticOrder S; S.init(T, DM, G, bx); \
            pg8::EpiScale E{(pg8::bf16_t*)(ws + WS_Q), (const float*)(ws + (L ? WS_SSQ_C : WS_SSQ_A))}; \
            pg8::gemm_phase<pg8::EpiScale, pg8::StaticOrder, true, true>(lds, g, S, E); \
        } \
        if (IN(pq) && IN(ptk)) { asm volatile("s_waitcnt vmcnt(0)" ::: "memory"); __syncthreads(); } STAMP(pq + 1); \
        if (IN(ptk)) { FRESH_IDS(); \
            const bf16* keys = (const bf16*)(ws + WS_KEYS) + (size_t)L * PH * 2 * 128 * 128; \
            CvtCtx cx; cx.srcU = a.in[9] + (size_t)L * NEXP * DM; cx.dsrc = (long)((a.in[10] + (size_t)L * NEXP * DM) - cx.srcU); cx.gain = a.in[2] + L * DM; cx.dstU = ws + (L ? WS_U1 : WS_U0); cx.ddst = (long)WS_V0 - (long)WS_U0; cx.su = (float*)(ws + WS_SU) + L * 32768; cx.dsc = ((long)WS_SV - (long)WS_SU) / 4; cx.gwave = bx * NWAVES + wave; cx.nw = G * NWAVES; \
            int slot = 0; \
            for (int rep_ = 0; rep_ < REP_TK; ++rep_) { slot = 0; \
            for (int ui = 0; ; ++ui) {        \
                const int upk = static_unit(T / 256, DM / 256, G, bx, ui); if (upk < 0) break; \
                const int h = upk & 0xffff, tblk = upk >> 16; \
                __syncthreads(); \
                topk_fill(lds, keys, h, tid); \
                __syncthreads(); \
                topk_unit((const bf16*)(ws + WS_Q), lds, (int*)(ws + WS_EI), (float*)(ws + WS_GW), tblk * 256 + wave * 32, h, lane, cx, slot); \
                slot += 16; \
            } } \
            for (; slot * cx.nw + cx.gwave < 65536; ++slot) { f32x4 cr[4]; const int cc = slot * cx.nw + cx.gwave; cvt_chunk_load(cx, cc, lane, cr); cvt_chunk_store(cx, cc, lane, cr); } \
        } \
        SEAM(ptk); \
        if (IN(ppa)) { FRESH_IDS(); \
            const int xv = bx & 7; \
            peer_a_slice<8>((const bf16*)(ws + WS_XB), (const int*)(ws + WS_EI), (const unsigned char*)(ws + (L ? WS_U1 : WS_U0)), (float*)(ws + WS_PD), xv, (unsigned*)(ws + WS_BCTR) + (L * 2 + 0) * 512 + xv * 64, T / 8, lane); \
        } \
        SEAM(ppa); \
        if (IN(ppw)) { FRESH_IDS(); \
            const int gw = bx * NWAVES + wave, NGW = G * NWAVES; \
            for (int t = gw; t < T; t += NGW) peer_a2_token((const float*)(ws + WS_PD), (const float*)(ws + (L ? WS_SSQ_C : WS_SSQ_A)), (const int*)(ws + WS_EI), (const float*)(ws + WS_SU) + L * 32768, (const float*)(ws + WS_SV) + L * 32768, (float*)(ws + WS_GW), (float*)(ws + WS_W1), t, lane); \
        } \
        SEAM(ppw); \
        if (IN(ppb)) { FRESH_IDS(); \
            const int xv = bx & 7; \
            peer_b_slice<4>(a.out, (const int*)(ws + WS_EI), (const float*)(ws + ((xv < 4) ? WS_GW : WS_W1)), (const unsigned char*)(ws + (L ? WS_V1 : WS_V0)), L ? (bf16*)nullptr : (bf16*)(ws + WS_XB), (float*)(ws + (L ? WS_SSQ_D : WS_SSQ_B)), xv, (unsigned*)(ws + WS_BCTR) + (L * 2 + 1) * 512 + xv * 64, T / 4, lane); \
        } \
    } while (0)
    float oscale = 1.f;
    PEER_LAYER(0);
    SEAM(PH_PB0);
    for (int rep_ = 0; rep_ < REP_GEMM; ++rep_)
    if (IN(PH_QKV)) { FRESH_IDS();
        {
            pg8::Gemm g{(const pg8::bf16_t*)(ws + WS_XB), (const pg8::bf16_t*)(ws + WS_WQKV), T, 2560, DM}; pg8::StaticOrder S; S.init(T, 2560, G, bx);
            pg8::EpiQK E{(pg8::bf16_t*)(ws + WS_QB), (pg8::bf16_t*)(ws + WS_KB), (const float*)(ws + WS_SSQ_B), (const float*)(ws + WS_ROPE), 0.125f * 1.4426950408889634f};
            pg8::gemm_phase<pg8::EpiQK, pg8::StaticOrder, true, true>(lds, g, S, E);
        }
        if (bx >= G / 2) {
            pg8::Gemm g{(const pg8::bf16_t*)(ws + WS_WQKV) + (size_t)2560 * DM, (const pg8::bf16_t*)(ws + WS_XB), 512, T, DM}; pg8::StaticOrder S; S.init(512, T, G / 2, bx - G / 2);
            pg8::EpiVt E{(pg8::bf16_t*)(ws + WS_VT), (const float*)(ws + WS_SSQ_B)};
            pg8::gemm_phase<pg8::EpiVt, pg8::StaticOrder, true, true>(lds, g, S, E);
        }
    }
    SEAM(PH_QKV);
    for (int rep_ = 0; rep_ < REP_ATT; ++rep_)
    if (IN(PH_ATT)) { FRESH_IDS();
        for (int vb = bx; vb < 256; vb += G) {
            const int bkv = vb >> 3, chunk = vb & 7, b = bkv >> 3, kvh = bkv & 7;
            for (int i = 0; i < 8; ++i) {
                const int qu = (chunk * 8 + i) * 64;
                __syncthreads();
                attn_fill(lds, (const bf16*)(ws + WS_KB), (const bf16*)(ws + WS_VT), b, kvh, qu - 128, tid);
                __syncthreads();
                attn_task(lds, (const bf16*)(ws + WS_QB), (bf16*)(ws + WS_O), a.in[6], b, kvh * 4 + (wave & 3), qu + (wave >> 2) * 32, qu - 128, lane);
            }
        }
    }
    SEAM(PH_ATT);
    if (IN(PH_WO)) { FRESH_IDS();
        pg8::Gemm g{(const pg8::bf16_t*)(ws + WS_O), (const pg8::bf16_t*)(ws + WS_WOA), T, DM, DM}; pg8::StaticOrder S; S.init(T, DM, G, bx);
        pg8::EpiRes E{a.out, a.out, (pg8::bf16_t*)(ws + WS_XB), (float*)(ws + WS_SSQ_C)};
        pg8::gemm_phase<pg8::EpiRes, pg8::StaticOrder, true, true>(lds, g, S, E);
    }
    SEAM(PH_WO);
#ifdef DIAG_A
    { const unsigned long long* st = (const unsigned long long*)(ws + WS_STAMP); oscale = 1.f + sqrtf((float)(st[DIAG_B] - st[DIAG_A]) * 1e-6f); }
#endif
    PEER_LAYER(1);
#undef PEER_LAYER
    SEAM(PH_PB1);
    if (IN(PH_FIN)) { FRESH_IDS();
        const int gw = bx * NWAVES + wave, NGW = G * NWAVES;
        for (int t = gw; t < T; t += NGW) final_norm_row(a.out, (const float*)(ws + WS_SSQ_D), a.in[11], t, lane, oscale);
    }
#undef SEAM
#undef IN
}

#ifndef N_LAUNCHES
#define N_LAUNCHES 1
#endif
extern "C" void kernel_launch(void* const* d_in, const int* in_sizes, int n_in, void* d_out, int out_size, void* d_ws, size_t ws_size, hipStream_t stream) {
    static int grid = 0;
    if (!grid) {
        if (hipFuncSetAttribute((const void*)mega, hipFuncAttributeMaxDynamicSharedMemorySize, LDS_BYTES) != hipSuccess) { fprintf(stderr, "hipFuncSetAttribute failed\n"); }
        int dev = 0, cus = 0, per_cu = 0;
        (void)hipGetDevice(&dev);
        (void)hipDeviceGetAttribute(&cus, hipDeviceAttributeMultiprocessorCount, dev);
        if (hipOccupancyMaxActiveBlocksPerMultiprocessor(&per_cu, (const void*)mega, NWAVES * 64, LDS_BYTES) != hipSuccess) per_cu = 0;
        (void)hipGetLastError();
        grid = cus * per_cu;
        if (grid > 256) grid = 256;
        grid &= ~1;
        if (grid < 2) { fprintf(stderr, "occupancy query gave %d x %d\n", cus, per_cu); grid = -1; }
    }
    if (grid < 0) return;
    if (ws_size < 700 * MiB) { fprintf(stderr, "ws too small: %zu\n", ws_size); return; }
    (void)hipMemsetAsync((char*)d_ws + WS_CTL, 0, CTL_BYTES, stream);
    Args a{};
    for (int i = 0; i < 12; ++i) a.in[i] = (const float*)d_in[i];
    a.out = (float*)d_out; a.ws = (unsigned char*)d_ws;
    if (N_LAUNCHES == 1) {
        a.ph_lo = 0; a.ph_hi = PH_END;
        void* args[] = {&a};
        const hipError_t e = hipLaunchCooperativeKernel((const void*)mega, dim3(grid), dim3(NWAVES * 64), args, LDS_BYTES, stream);
        if (e != hipSuccess) fprintf(stderr, "cooperative launch failed: %s (grid %d)\n", hipGetErrorString(e), grid);
    } else {
        for (int ph = 0; ph < PH_END; ++ph) {
            a.ph_lo = ph; a.ph_hi = ph + 1;
            hipLaunchKernelGGL(mega, dim3(grid), dim3(NWAVES * 64), LDS_BYTES, stream, a);
        }
    }
}
```

```cpp
#include <hip/hip_runtime.h>
#include <hip/hip_cooperative_groups.h>
namespace cg = cooperative_groups;
#include <cstdio>
#include <cstdint>
#include <cmath>

constexpr int DM = 2048, NB = 4, SEQ = 4096, T = NB * SEQ;
constexpr int FG = 8, FW = 256;
constexpr int HD = 64, NQH = 32, NKVH = 8, QKVW = 3072;
constexpr int PH = 8, NKEYS = 128, NEXP = 16384, PTOPK = 16;
constexpr float EPS = 1e-6f;
namespace pg8 {
#define PG8_LAS __attribute__((address_space(3)))
typedef unsigned short bf16_t;
typedef short bf16x8 __attribute__((ext_vector_type(8)));
typedef float f32x4 __attribute__((ext_vector_type(4)));
typedef unsigned u32x4 __attribute__((ext_vector_type(4)));
constexpr int BM = 256, BK = 64, HALF = 128, HTB = HALF * BK * 2  , STAGE_BYTES = 8 * HTB, NXCD = 8, WGM = 8;

__host__ __device__ __forceinline__ int lds_byte(int r, int c) { const int st = (r >> 4) * 2 + (c >> 5), rr = r & 15, cc = c & 31, ob = rr * 64 + cc * 2; return st * 1024 + (ob ^ (((ob >> 9) & 1) << 5)); }
__host__ __device__ __forceinline__ void stage_rc(int b, int& R, int& C) { const int st = b / 1024, sb = b % 1024, swz = sb ^ (((sb >> 9) & 1) << 5); R = (st >> 1) * 16 + swz / 64; C = (st & 1) * 32 + (swz % 64) / 2; }
__host__ __device__ __forceinline__ int perm32(int rho) { const int n = rho >> 4, i = rho & 15; return 8 * (i >> 2) + 4 * n + (i & 3); }

struct Unit { int pm, pn; };
struct Gemm { const bf16_t* A; const bf16_t* Bt; int M, N, K; };

struct StaticOrder {
    int nM, nN, nwg, G, c;
    __host__ __device__ void init(int M, int N, int G_, int c_) { nM = M / BM; nN = N / BM; nwg = nM * nN; G = G_; c = c_; }
    __host__ __device__ bool next(int i, Unit& u) const {
        const long L = (long)i * G + c; if (L >= nwg) return false;
        int wgid = (int)L; { const int q = nwg / NXCD, r = nwg % NXCD, xcd = wgid % NXCD, off = wgid / NXCD; wgid = (xcd < r ? xcd * (q + 1) : r * (q + 1) + (xcd - r) * q) + off; }
        const int nig = WGM * nN, gid = wgid / nig, fm = gid * WGM, gsz = (nM - fm) < WGM ? (nM - fm) : WGM;
        u.pm = fm + ((wgid % nig) % gsz); u.pn = (wgid % nig) / gsz; return true;
    }
    __device__ __forceinline__ void a_ready(const Unit&) const {}
    __device__ __forceinline__ void done(const Unit&) const {}
};

__device__ __forceinline__ unsigned cvt_pk_bf16(float lo, float hi) { unsigned r; asm volatile("v_cvt_pk_bf16_f32 %0, %1, %2" : "=v"(r) : "v"(lo), "v"(hi)); return r; }
typedef float f32x2 __attribute__((ext_vector_type(2)));
__device__ __forceinline__ u32x4 pack8(const f32x4 v0, const f32x4 v1) { u32x4 w; w.x = cvt_pk_bf16(v0[0], v0[1]); w.y = cvt_pk_bf16(v0[2], v0[3]); w.z = cvt_pk_bf16(v1[0], v1[1]); w.w = cvt_pk_bf16(v1[2], v1[3]); return w; }
struct EpiZt {
    static constexpr bool PERM = true, AFTER_DRAIN = false; bf16_t* Zp;
    __device__ __forceinline__ void operator()(const f32x4 (&acc)[2][2][4][2], const Unit& u, int wr, int wc, int fr, int fq) const {
        const int part = u.pm, bgs2 = u.pn;
        bf16_t* base = Zp + ((size_t)(bgs2 * 256 + wr * 64 + fr) * 512 + part * 256 + wc * 32 + 8 * fq);
#pragma unroll
        for (int ai = 0; ai < 2; ++ai)
#pragma unroll
            for (int m = 0; m < 4; ++m)
#pragma unroll
                for (int bj = 0; bj < 2; ++bj) *(u32x4*)(base + (ai * HALF + m * 16) * 512 + bj * HALF) = pack8(acc[ai][bj][m][0], acc[ai][bj][m][1]);
    }
};
struct EpiY {
    static constexpr bool PERM = true, AFTER_DRAIN = false; bf16_t* Y;
    __device__ __forceinline__ void operator()(const f32x4 (&acc)[2][2][4][2], const Unit& u, int wr, int wc, int fr, int fq) const {
        const int bg = u.pn >> 4, k2 = u.pn & 15, b = bg >> 3, g = bg & 7;
        bf16_t* base = Y + ((size_t)(b * 4096 + (wr * 64 + fr) * 16 + k2) * 2048 + g * 256 + wc * 32 + 8 * fq);
#pragma unroll
        for (int ai = 0; ai < 2; ++ai)
#pragma unroll
            for (int m = 0; m < 4; ++m)
#pragma unroll
                for (int bj = 0; bj < 2; ++bj) *(u32x4*)(base + (size_t)(ai * HALF + m * 16) * 16 * 2048 + bj * HALF) = pack8(acc[ai][bj][m][0], acc[ai][bj][m][1]);
    }
};
struct EpiRes {
    static constexpr bool PERM = true, AFTER_DRAIN = false; const float* R; float* out; bf16_t* xb; float* ssq;
    __device__ __forceinline__ void operator()(const f32x4 (&acc)[2][2][4][2], const Unit& u, int wr, int wc, int fr, int fq) const {
        const int row0 = u.pm * BM + wr * 64 + fr; const size_t off0 = (size_t)row0 * 2048 + u.pn * BM + wc * 32 + 8 * fq;
        const float* Rb = R + off0; float* Ob = out + off0; bf16_t* Xb = xb + off0; float* Sb = ssq + row0;
#pragma unroll
        for (int ai = 0; ai < 2; ++ai)
#pragma unroll
            for (int m = 0; m < 4; ++m) { const int ro = (ai * HALF + m * 16) * 2048; float ss = 0.f;
#pragma unroll
                for (int bj = 0; bj < 2; ++bj) {
                    const f32x4 r0 = *(const f32x4*)(Rb + ro + bj * HALF), r1 = *(const f32x4*)(Rb + ro + bj * HALF + 4);
                    const f32x4 o0 = acc[ai][bj][m][0] + r0, o1 = acc[ai][bj][m][1] + r1;
                    *(f32x4*)(Ob + ro + bj * HALF) = o0; *(f32x4*)(Ob + ro + bj * HALF + 4) = o1;
                    *(u32x4*)(Xb + ro + bj * HALF) = pack8(o0, o1);
                    ss += (o0[0] * o0[0] + o0[1] * o0[1]) + (o0[2] * o0[2] + o0[3] * o0[3]) + (o1[0] * o1[0] + o1[1] * o1[1]) + (o1[2] * o1[2] + o1[3] * o1[3]); }
                ss += __shfl_xor(ss, 16); ss += __shfl_xor(ss, 32);
                if (fq == 0) unsafeAtomicAdd(Sb + ai * HALF + m * 16, ss);
                asm volatile("" ::: "memory"); }
    }
};
struct EpiScale {
    static constexpr bool PERM = true, AFTER_DRAIN = false; bf16_t* O; const float* ssq;
    __device__ __forceinline__ void operator()(const f32x4 (&acc)[2][2][4][2], const Unit& u, int wr, int wc, int fr, int fq) const {
        const int row0 = u.pm * BM + wr * 64 + fr;
        bf16_t* base = O + ((size_t)row0 * 2048 + u.pn * BM + wc * 32 + 8 * fq); const float* Sb = ssq + row0;
#pragma unroll
        for (int ai = 0; ai < 2; ++ai)
#pragma unroll
            for (int m = 0; m < 4; ++m) { const float rs = rsqrtf(Sb[ai * HALF + m * 16] * (1.f / 2048.f) + 1e-6f);
#pragma unroll
                for (int bj = 0; bj < 2; ++bj) *(u32x4*)(base + (ai * HALF + m * 16) * 2048 + bj * HALF) = pack8(acc[ai][bj][m][0] * rs, acc[ai][bj][m][1] * rs); }
    }
};
struct EpiQK {
    static constexpr bool PERM = true, AFTER_DRAIN = false; bf16_t* Q; bf16_t* K; const float* ssq; const float* rope; float qscale;
    __device__ __forceinline__ void operator()(const f32x4 (&acc)[2][2][4][2], const Unit& u, int wr, int wc, int fr, int fq) const {
        const int row0 = u.pm * BM + wr * 64 + fr; const bool isq = u.pn < 8;
        const int cl = wc * 32 + 8 * fq;
        bf16_t* base = isq ? (Q + ((size_t)row0 * 2048 + u.pn * BM + cl)) : (K + ((size_t)row0 * 512 + (u.pn - 8) * BM + cl));
        const int ld = isq ? 2048 : 512; const float sc = isq ? qscale : 1.f;
        const float* rp = rope + (size_t)(row0 & 4095) * 64 + (cl & 63);
        const float* Sb = ssq + row0;
#pragma unroll
        for (int ai = 0; ai < 2; ++ai)
#pragma unroll
            for (int m = 0; m < 4; ++m) { const int ro = ai * HALF + m * 16; const float rs = rsqrtf(Sb[ro] * (1.f / 2048.f) + 1e-6f) * sc;
                const f32x4 t0 = *(const f32x4*)(rp + (size_t)ro * 64), t1 = *(const f32x4*)(rp + (size_t)ro * 64 + 4);
#pragma unroll
                for (int bj = 0; bj < 2; ++bj) {
                    const f32x4 a = acc[ai][bj][m][0] * rs, b = acc[ai][bj][m][1] * rs; f32x4 oa, ob;
                    oa[0] = a[0] * t0[0] - a[1] * t0[1]; oa[1] = a[1] * t0[0] + a[0] * t0[1]; oa[2] = a[2] * t0[2] - a[3] * t0[3]; oa[3] = a[3] * t0[2] + a[2] * t0[3];
                    ob[0] = b[0] * t1[0] - b[1] * t1[1]; ob[1] = b[1] * t1[0] + b[0] * t1[1]; ob[2] = b[2] * t1[2] - b[3] * t1[3]; ob[3] = b[3] * t1[2] + b[2] * t1[3];
                    *(u32x4*)(base + (size_t)ro * ld + bj * HALF) = pack8(oa, ob); } }
    }
};
struct EpiVt {
    static constexpr bool PERM = true, AFTER_DRAIN = false; bf16_t* Vt; const float* ssq;
    __device__ __forceinline__ void operator()(const f32x4 (&acc)[2][2][4][2], const Unit& u, int wr, int wc, int fr, int fq) const {
        const int col0 = u.pn * BM + wc * 32 + 8 * fq;
        bf16_t* base = Vt + ((size_t)(u.pm * BM + wr * 64 + fr) * 16384 + col0);
        f32x4 r0[2], r1[2];
#pragma unroll
        for (int bj = 0; bj < 2; ++bj) { const f32x4 s0 = *(const f32x4*)(ssq + col0 + bj * HALF), s1 = *(const f32x4*)(ssq + col0 + bj * HALF + 4);
#pragma unroll
            for (int q = 0; q < 4; ++q) { r0[bj][q] = rsqrtf(s0[q] * (1.f / 2048.f) + 1e-6f); r1[bj][q] = rsqrtf(s1[q] * (1.f / 2048.f) + 1e-6f); } }
#pragma unroll
        for (int ai = 0; ai < 2; ++ai)
#pragma unroll
            for (int m = 0; m < 4; ++m)
#pragma unroll
                for (int bj = 0; bj < 2; ++bj) *(u32x4*)(base + (size_t)(ai * HALF + m * 16) * 16384 + bj * HALF) = pack8(acc[ai][bj][m][0] * r0[bj], acc[ai][bj][m][1] * r1[bj]);
    }
};
template <class Epi, class Sched, bool ALIGN_EPI = false, bool SP2 = false>
__device__ __forceinline__ void gemm_phase(PG8_LAS unsigned char* lds, const Gemm g, const Sched& S, const Epi& E) {
    const int tid = threadIdx.x, wid = __builtin_amdgcn_readfirstlane(tid >> 6), lane = tid & 63, wr = wid >> 2, wc = wid & 3, fr = lane & 15, fq = lane >> 4;
    const int K = g.K, nt = K / BK;
    unsigned voffA[2], voffB[2];
#pragma unroll
    for (int i = 0; i < 2; ++i) { int R, C; stage_rc(tid * 16 + i * 8192, R, C); const int Rb = Epi::PERM ? ((R & ~31) + perm32(R & 31)) : R;
        voffA[i] = (unsigned)(R * K + C) * 2u; voffB[i] = (unsigned)(Rb * K + C) * 2u; }
    const size_t kstep = (size_t)(BK * 2);
    const size_t hstep = (size_t)HALF * K * 2;
    const size_t tstep = 2 * hstep;
    const unsigned ldsw = (unsigned)wid * 1024u;
    const int aoff = lds_byte(wr * 64 + fr, fq * 8), boff = lds_byte(wc * 32 + fr, fq * 8);
#define PG8_SA(b, h) (((b) * 2 + (h)) * HTB)
#define PG8_SB(b, h) ((4 + (b) * 2 + (h)) * HTB)
#define PG8_STAGE(bufoff, gbase, voff) do { _Pragma("unroll") for (int _i = 0; _i < 2; ++_i) \
        __builtin_amdgcn_global_load_lds((const unsigned*)((const char*)(gbase) + (voff)[_i]), (PG8_LAS unsigned*)(lds + (bufoff) + ldsw + _i * 8192), 16, 0, 0); } while (0)
#define PG8_LDA(dst, b, h) do { _Pragma("unroll") for (int m = 0; m < 4; ++m) _Pragma("unroll") for (int k = 0; k < 2; ++k) dst[m][k] = *(const PG8_LAS bf16x8*)(lds + PG8_SA(b, h) + aoff + m * 2048 + k * 1024); } while (0)
#define PG8_LDB(dst, b, h) do { _Pragma("unroll") for (int n = 0; n < 2; ++n) _Pragma("unroll") for (int k = 0; k < 2; ++k) dst[n][k] = *(const PG8_LAS bf16x8*)(lds + PG8_SB(b, h) + boff + n * 2048 + k * 1024); } while (0)
#define PG8_MMA(ai, bj, At, Bt) do { __builtin_amdgcn_s_setprio(1); _Pragma("unroll") for (int m = 0; m < 4; ++m) _Pragma("unroll") for (int n = 0; n < 2; ++n) _Pragma("unroll") for (int k = 0; k < 2; ++k) \
        acc[ai][bj][m][n] = __builtin_amdgcn_mfma_f32_16x16x32_bf16(Bt[n][k], At[m][k], acc[ai][bj][m][n], 0, 0, 0); __builtin_amdgcn_s_setprio(0); } while (0)
#define PG8_WAIT_V(n) asm volatile("s_waitcnt vmcnt(" #n ")" ::: "memory")
#define PG8_WAIT_L(n) asm volatile("s_waitcnt lgkmcnt(" #n ")" ::: "memory")
#define PG8_BAR __builtin_amdgcn_s_barrier()
#define PG8_SCHED __builtin_amdgcn_sched_barrier(0)
    Unit cur, nxt; int ui = 0;
    if (!S.next(0, cur)) return;
    f32x4 acc[2][2][4][2];
#pragma unroll
    for (int a = 0; a < 2; ++a)
#pragma unroll
        for (int b = 0; b < 2; ++b)
#pragma unroll
            for (int m = 0; m < 4; ++m)
#pragma unroll
                for (int n = 0; n < 2; ++n) acc[a][b][m][n] = (f32x4){0.f, 0.f, 0.f, 0.f};
    bf16x8 At[4][2], B0[2][2], B1[2][2];
    const char* cA = (const char*)g.A + (size_t)cur.pm * tstep; const char* cB = (const char*)g.Bt + (size_t)cur.pn * tstep;
    S.a_ready(cur);
    if constexpr (SP2) {
        PG8_STAGE(PG8_SB(0, 0), cB, voffB); PG8_STAGE(PG8_SB(0, 1), cB + hstep, voffB); PG8_STAGE(PG8_SA(0, 0), cA, voffA); PG8_STAGE(PG8_SA(0, 1), cA + hstep, voffA);
        if (wr == 1) PG8_BAR;
        PG8_WAIT_V(2); PG8_BAR;
        PG8_STAGE(PG8_SB(1, 0), cB + kstep, voffB); PG8_STAGE(PG8_SA(1, 0), cA + kstep, voffA); PG8_STAGE(PG8_SB(1, 1), cB + hstep + kstep, voffB);
        PG8_WAIT_V(6); PG8_BAR;
    } else {
        PG8_STAGE(PG8_SB(0, 0), cB, voffB); PG8_STAGE(PG8_SA(0, 0), cA, voffA); PG8_STAGE(PG8_SB(0, 1), cB + hstep, voffB); PG8_STAGE(PG8_SA(0, 1), cA + hstep, voffA);
        if (wr == 1) PG8_BAR;
        PG8_WAIT_V(4); PG8_BAR;
        PG8_STAGE(PG8_SB(1, 0), cB + kstep, voffB); PG8_STAGE(PG8_SA(1, 0), cA + kstep, voffA); PG8_STAGE(PG8_SB(1, 1), cB + hstep + kstep, voffB);
        PG8_WAIT_V(6); PG8_BAR;
    }
    for (;;) {
        const bool has_next = S.next(ui + 1, nxt);
        const char* nA = has_next ? (const char*)g.A + (size_t)nxt.pm * tstep : cA; const char* nB = has_next ? (const char*)g.Bt + (size_t)nxt.pn * tstep : cB;
        for (int t = 0; t < nt; t += 2) {
            const bool last = (t == nt - 2);
            const char* a1 = cA + (size_t)(t + 1) * kstep;
            const char* a2 = last ? nA : cA + (size_t)(t + 2) * kstep; const char* b2 = last ? nB : cB + (size_t)(t + 2) * kstep;
            const char* a3 = a2 + kstep; const char* b3 = b2 + kstep;
            if (last && has_next) S.a_ready(nxt);
            if constexpr (SP2) {
            PG8_LDB(B0, 0, 0); PG8_LDB(B1, 0, 1); PG8_SCHED; PG8_LDA(At, 0, 0); PG8_STAGE(PG8_SA(1, 1), a1 + hstep, voffA);
            PG8_WAIT_V(8); PG8_WAIT_L(0); PG8_BAR; PG8_MMA(0, 0, At, B0); PG8_MMA(0, 1, At, B1); PG8_BAR; PG8_SCHED;
            PG8_LDA(At, 0, 1); PG8_STAGE(PG8_SB(0, 0), b2, voffB); PG8_STAGE(PG8_SB(0, 1), b2 + hstep, voffB); PG8_STAGE(PG8_SA(0, 0), a2, voffA);
            PG8_WAIT_V(8); PG8_WAIT_L(0); PG8_BAR; PG8_MMA(1, 0, At, B0); PG8_MMA(1, 1, At, B1); PG8_BAR; PG8_SCHED;
            PG8_LDB(B0, 1, 0); PG8_LDB(B1, 1, 1); PG8_SCHED; PG8_LDA(At, 1, 0); PG8_STAGE(PG8_SA(0, 1), a2 + hstep, voffA);
            PG8_WAIT_V(8); PG8_WAIT_L(0); PG8_BAR; PG8_MMA(0, 0, At, B0); PG8_MMA(0, 1, At, B1); PG8_BAR; PG8_SCHED;
            PG8_LDA(At, 1, 1); PG8_STAGE(PG8_SB(1, 0), b3, voffB); PG8_STAGE(PG8_SB(1, 1), b3 + hstep, voffB); PG8_STAGE(PG8_SA(1, 0), a3, voffA);
            PG8_WAIT_V(8); PG8_WAIT_L(0); PG8_BAR; PG8_MMA(1, 0, At, B0); PG8_MMA(1, 1, At, B1); PG8_BAR; PG8_SCHED;
            } else {
            PG8_LDB(B0, 0, 0); PG8_SCHED; PG8_LDA(At, 0, 0); PG8_STAGE(PG8_SA(1, 1), a1 + hstep, voffA);
            PG8_WAIT_L(8); PG8_BAR; PG8_WAIT_L(0); PG8_MMA(0, 0, At, B0); PG8_BAR; PG8_SCHED;
            PG8_LDB(B1, 0, 1); PG8_STAGE(PG8_SB(0, 0), b2, voffB);
            PG8_BAR; PG8_WAIT_L(0); PG8_MMA(0, 1, At, B1); PG8_BAR;
            PG8_LDA(At, 0, 1); PG8_STAGE(PG8_SA(0, 0), a2, voffA);
            PG8_BAR; PG8_WAIT_L(0); PG8_MMA(1, 0, At, B0); PG8_BAR; PG8_SCHED;
            PG8_STAGE(PG8_SB(0, 1), b2 + hstep, voffB);
            PG8_WAIT_V(6); PG8_BAR; PG8_MMA(1, 1, At, B1); PG8_BAR;
            PG8_LDB(B0, 1, 0); PG8_SCHED; PG8_LDA(At, 1, 0); PG8_STAGE(PG8_SA(0, 1), a2 + hstep, voffA);
            PG8_WAIT_L(8); PG8_BAR; PG8_WAIT_L(0); PG8_MMA(0, 0, At, B0); PG8_BAR; PG8_SCHED;
            PG8_LDB(B1, 1, 1); PG8_STAGE(PG8_SB(1, 0), b3, voffB);
            PG8_BAR; PG8_WAIT_L(0); PG8_MMA(0, 1, At, B1); PG8_BAR;
            PG8_LDA(At, 1, 1); PG8_STAGE(PG8_SA(1, 0), a3, voffA);
            PG8_BAR; PG8_WAIT_L(0); PG8_MMA(1, 0, At, B0); PG8_BAR; PG8_SCHED;
            PG8_STAGE(PG8_SB(1, 1), b3 + hstep, voffB);
            PG8_WAIT_V(6); PG8_BAR; PG8_MMA(1, 1, At, B1); PG8_BAR;
            }
        }
        if constexpr (ALIGN_EPI) { if (wr == 0) PG8_BAR; }
        if constexpr (!Epi::AFTER_DRAIN) { E(acc, cur, wr, wc, fr, fq); S.done(cur); }
        if (!has_next) break;
#pragma unroll
        for (int a = 0; a < 2; ++a)
#pragma unroll
            for (int b = 0; b < 2; ++b)
#pragma unroll
                for (int m = 0; m < 4; ++m)
#pragma unroll
                    for (int n = 0; n < 2; ++n) acc[a][b][m][n] = (f32x4){0.f, 0.f, 0.f, 0.f};
        cur = nxt; cA = nA; cB = nB; ++ui;
        if constexpr (ALIGN_EPI) { if (wr == 1) PG8_BAR; }
    }
    PG8_WAIT_V(0);
    if constexpr (!ALIGN_EPI) { if (wr == 0) PG8_BAR; }
    PG8_BAR;
    if constexpr (Epi::AFTER_DRAIN) { E.fused(acc, cur, wr, wc, fr, fq, lds, wid, lane); S.done(cur); }
#undef PG8_SA
#undef PG8_SB
#undef PG8_STAGE
#undef PG8_LDA
#undef PG8_LDB
#undef PG8_MMA
#undef PG8_WAIT_V
#undef PG8_WAIT_L
#undef PG8_BAR
#undef PG8_SCHED
}
}
#define GAS __attribute__((address_space(1)))
#define LAS __attribute__((address_space(3)))
typedef unsigned short bf16;
typedef unsigned v4u __attribute__((ext_vector_type(4)));
typedef unsigned v2u __attribute__((ext_vector_type(2)));
typedef float f32x4 __attribute__((ext_vector_type(4)));
constexpr int NWAVES = 8;
constexpr int LDS_BYTES = 147456, LDSCTL_OFF = 131072;
constexpr int CW_BAR = 4096;
constexpr size_t MiB = 1u << 20;
constexpr size_t WS_CTL = 0, CTL_BYTES = 1 * MiB;
constexpr size_t WS_SSQ_A = 256 * 1024, WS_SSQ_B = 320 * 1024, WS_SSQ_C = 384 * 1024, WS_SSQ_D = 448 * 1024;
constexpr size_t WS_STAMP = 128 * 1024;
constexpr size_t WS_BCTR = 192 * 1024;
constexpr size_t WS_SU = 512 * 1024, WS_SV = 768 * 1024;
constexpr size_t WS_WCS = 1 * MiB, WS_ROPE = 2 * MiB, WS_KEYS = 3 * MiB;
constexpr size_t WS_WOF = 8 * MiB, WS_WQKV = 16 * MiB, WS_WOA = 28 * MiB, WS_WQ0 = 36 * MiB, WS_WQ1 = 44 * MiB;
constexpr size_t WS_A2 = 64 * MiB, WS_TW = 65 * MiB;
constexpr size_t WS_U0 = 128 * MiB, WS_V0 = 192 * MiB, WS_U1 = 256 * MiB, WS_V1 = 320 * MiB;
constexpr size_t WS_XG = 384 * MiB, WS_XB = 384 * MiB;
constexpr size_t WS_ZT = 448 * MiB;
constexpr size_t WS_Y = 576 * MiB;
constexpr size_t WS_Q = 448 * MiB;
constexpr size_t WS_EI = 640 * MiB, WS_GW = 648 * MiB, WS_W1 = 656 * MiB;
constexpr size_t WS_PD = 448 * MiB;
constexpr size_t WS_QB = 448 * MiB, WS_KB = 512 * MiB, WS_VT = 528 * MiB, WS_O = 576 * MiB;

__device__ __forceinline__ unsigned f2bf(float f) { unsigned u = __builtin_bit_cast(unsigned, f); return (u + 0x7fffu + ((u >> 16) & 1u)) >> 16; }
__device__ __forceinline__ unsigned pk2(float lo, float hi) { return f2bf(lo) | (f2bf(hi) << 16); }

struct Args { const float* in[12]; float* out; unsigned char* ws; int ph_lo, ph_hi; };

__device__ __forceinline__ int qkv_row(int n) { if (n >= 2560) return n; const int d = n & 63, pc = (d < 32) ? 2 * d : 2 * (d - 32) + 1; return (n & ~63) + pc; }
template <int MODE>
__device__ __forceinline__ void transpose_item(const float* W, int K, int N, const float* gain, bf16* WT, LAS float* scr, int item, int lane) {
    const int nblk = N / 32, kb = item / nblk, nb = item % nblk, k0 = 64 * kb, n0 = 32 * nb;
#pragma unroll 8
    for (int i = 0; i < 32; ++i) { const int kk = 2 * i + (lane >> 5); float v = W[(size_t)(k0 + kk) * N + n0 + (lane & 31)]; if (gain) v *= gain[k0 + kk]; scr[kk * 33 + (lane & 31)] = v; }
    asm volatile("s_waitcnt lgkmcnt(0)" ::: "memory");
    const int c = lane & 7;
#pragma unroll
    for (int j = 0; j < 4; ++j) { const int n = (lane >> 3) + 8 * j; const LAS float* s = scr + (8 * c) * 33 + n;
        v4u o; o.x = pk2(s[0 * 33], s[1 * 33]); o.y = pk2(s[2 * 33], s[3 * 33]); o.z = pk2(s[4 * 33], s[5 * 33]); o.w = pk2(s[6 * 33], s[7 * 33]);
        const int row = (MODE == 1) ? qkv_row(n0 + n) : (n0 + n);
        *(v4u*)(WT + (size_t)row * K + k0 + 8 * c) = o; }
    asm volatile("s_waitcnt lgkmcnt(0)" ::: "memory");
}
__device__ __forceinline__ float wsum(float v) {
#pragma unroll
    for (int o = 1; o < 64; o <<= 1) v += __shfl_xor(v, o);
    return v;
}
__device__ __forceinline__ void cvt_stream(const float* src, bf16* dst, size_t n8, size_t gtid, size_t ngt) {
    for (size_t i = gtid; i < n8; i += ngt) {
        const f32x4 a = *(const f32x4*)(src + i * 8), b = *(const f32x4*)(src + i * 8 + 4);
        v4u o; o.x = pk2(a[0], a[1]); o.y = pk2(a[2], a[3]); o.z = pk2(b[0], b[1]); o.w = pk2(b[2], b[3]);
        *(v4u*)(dst + i * 8) = o;
    }
}
__device__ __forceinline__ void cvt_stream8(const float* src, unsigned char* dst, size_t n16, size_t gtid, size_t ngt, float scale) {
    for (size_t i = gtid; i < n16; i += ngt) {
        v4u o;
#pragma unroll
        for (int q = 0; q < 4; ++q) { f32x4 a = *(const f32x4*)(src + i * 16 + 4 * q) * scale;
#pragma unroll
            for (int e = 0; e < 4; ++e) a[e] = fminf(fmaxf(a[e], -448.f), 448.f);
            int w = 0; w = __builtin_amdgcn_cvt_pk_fp8_f32(a[0], a[1], w, false); w = __builtin_amdgcn_cvt_pk_fp8_f32(a[2], a[3], w, true); o[q] = (unsigned)w; }
        const size_t e = i >> 7, r = i & 127, sl = r >> 3, c8 = r & 7;
        *(v4u*)(dst + ((sl * 16384 + e) * 128 + c8 * 16)) = o;
    }
}
#define XB_TMO      128
#define XB_XCNT(j)  (256  + 64 * (j))
#define XB_XSUB(j)  (1280 + 64 * (j))
#define XB_XGEN(j)  (2304 + 64 * (j))
#define XB_TOP      3328
#define XB_TOPGEN   3392
#define XCD_BAR_WORDS 3456
#define XB_SPIN_CAP (1u << 18)

__device__ __forceinline__ unsigned xb_ld(unsigned* p)              { return __hip_atomic_load(p, __ATOMIC_RELAXED, __HIP_MEMORY_SCOPE_AGENT); }
__device__ __forceinline__ unsigned xb_add(unsigned* p, unsigned v) { return __hip_atomic_fetch_add(p, v, __ATOMIC_RELAXED, __HIP_MEMORY_SCOPE_AGENT); }
__device__ __forceinline__ unsigned xb_xcc_id() { return (unsigned)__builtin_amdgcn_s_getreg((3 << 11) | 20) & 0xFu; }
#define XB_SPIN(cond, bar) do { unsigned _sp = 0; while (cond) { __builtin_amdgcn_s_sleep(1); \
    if ((++_sp & 255u) == 0u) { if (xb_ld(&(bar)[XB_TMO])) break; if (_sp > XB_SPIN_CAP) { atomicAdd(&(bar)[XB_TMO], 1u); break; } } } } while (0)

struct XcdBarrier {
    unsigned* bar; unsigned x;
    volatile LAS unsigned* st;
};

__device__ __forceinline__ XcdBarrier xcd_barrier_post(unsigned* bar, volatile LAS unsigned* st) {
    XcdBarrier b; b.bar = bar; b.x = xb_xcc_id(); b.st = st;
    if (threadIdx.x == 0) (void)xb_add(&bar[XB_XCNT(b.x)], 1u);
    return b;
}
__device__ __forceinline__ void xcd_barrier_complete(unsigned* bar, unsigned x, unsigned& nloc, unsigned& nx) {
    const unsigned G = gridDim.x * gridDim.y * gridDim.z;
    unsigned sum, cnt, mine, sp = 0u;
    for (;;) {
        sum = 0u; cnt = 0u; mine = 0u;
#pragma unroll
        for (unsigned j = 0; j < 16; ++j) { const unsigned c = xb_ld(&bar[XB_XCNT(j)]); sum += c; cnt += (c > 0u) ? 1u : 0u; mine = (j == x) ? c : mine; }
        if (sum == G) break;
        __builtin_amdgcn_s_sleep(1);
        if ((++sp & 255u) == 0u) { if (xb_ld(&bar[XB_TMO])) break; if (sp > XB_SPIN_CAP) { atomicAdd(&bar[XB_TMO], 1u); break; } }
    }
    nloc = mine > 0u ? mine : 1u; nx = cnt > 0u ? cnt : 1u;
}

__device__ __forceinline__ void xcd_barrier(const XcdBarrier& b) {
    asm volatile("s_waitcnt vmcnt(0)" ::: "memory");
    __syncthreads();
    if (threadIdx.x == 0) {
        unsigned* bar = b.bar;
        __builtin_amdgcn_s_waitcnt(0);
        unsigned nloc = b.st[0], nx = b.st[1];
        if (nloc == 0u) { xcd_barrier_complete(bar, b.x, nloc, nx); b.st[0] = nloc; b.st[1] = nx; }
        const unsigned old = xb_add(&bar[XB_XSUB(b.x)], 1u);
        const unsigned gen = old / nloc;
        if (old + 1u == (gen + 1u) * nloc) {
            __builtin_amdgcn_fence(__ATOMIC_RELEASE, "agent");
            asm volatile("s_waitcnt vmcnt(0)" ::: "memory");
            const unsigned og = xb_add(&bar[XB_TOP], 1u);
            const unsigned tg = og / nx;
            if (og + 1u == (tg + 1u) * nx) xb_add(&bar[XB_TOPGEN], 1u);
            else XB_SPIN(xb_ld(&bar[XB_TOPGEN]) == tg, bar);
            __builtin_amdgcn_fence(__ATOMIC_ACQUIRE, "agent");
            xb_add(&bar[XB_XGEN(b.x)], 1u);
            asm volatile("s_waitcnt vmcnt(0)" ::: "memory");
        } else {
            XB_SPIN(xb_ld(&bar[XB_XGEN(b.x)]) == gen, bar);
            __builtin_amdgcn_fence(__ATOMIC_ACQUIRE, "agent");
            asm volatile("s_waitcnt vmcnt(0)" ::: "memory");
        }
    }
    __syncthreads();
}
#define U_SCALE 1024.f
#define V_SCALE 256.f
typedef float f32x16 __attribute__((ext_vector_type(16)));
#ifndef TKB
#define TKB 2
#endif
typedef short s16x8 __attribute__((ext_vector_type(8)));
typedef __bf16 bf16x2_t __attribute__((ext_vector_type(2)));
__device__ __forceinline__ unsigned ordf(float f) { const unsigned u = __float_as_uint(f); return (u & 0x80000000u) ? ~u : (u | 0x80000000u); }
__device__ __forceinline__ float unordf(unsigned u) { return __uint_as_float((u & 0x80000000u) ? (u & 0x7fffffffu) : ~u); }
__device__ __forceinline__ unsigned umax_(unsigned a, unsigned b) { return a > b ? a : b; }
#define DPPU(v, ctrl) ((unsigned)__builtin_amdgcn_update_dpp(0, (int)(v), (ctrl), 0xf, 0xf, true))
#define DPPF(v, ctrl) __int_as_float(__builtin_amdgcn_update_dpp(0, __float_as_int(v), (ctrl), 0xf, 0xf, true))
__device__ __forceinline__ unsigned max32(unsigned v) {
    v = umax_(v, DPPU(v, 0xB1)); v = umax_(v, DPPU(v, 0x4E)); v = umax_(v, DPPU(v, 0x141)); v = umax_(v, DPPU(v, 0x140));
    const auto r = __builtin_amdgcn_permlane16_swap(v, v, false, false);
    return umax_(r[0], r[1]);
}
__device__ __forceinline__ float sum16(float v) {
    v += DPPF(v, 0xB1); v += DPPF(v, 0x4E); v += DPPF(v, 0x141); v += DPPF(v, 0x140); return v;
}
__device__ __forceinline__ unsigned bperm(unsigned v, int srclane) { return (unsigned)__builtin_amdgcn_ds_bpermute(srclane << 2, (int)v); }
#define CMPX(a_, b_) do { const unsigned hi_ = umax_(a_, b_), lo_ = (a_ < b_) ? a_ : b_; a_ = hi_; b_ = lo_; } while (0)
__device__ __forceinline__ unsigned max16(unsigned v) { v = umax_(v, DPPU(v, 0xB1)); v = umax_(v, DPPU(v, 0x4E)); v = umax_(v, DPPU(v, 0x141)); v = umax_(v, DPPU(v, 0x140)); return v; }
__device__ __forceinline__ unsigned top16_of8(unsigned (&p)[8], int c) {
    CMPX(p[0], p[1]); CMPX(p[2], p[3]); CMPX(p[4], p[5]); CMPX(p[6], p[7]);
    CMPX(p[0], p[2]); CMPX(p[1], p[3]); CMPX(p[4], p[6]); CMPX(p[5], p[7]);
    CMPX(p[1], p[2]); CMPX(p[5], p[6]); CMPX(p[0], p[4]); CMPX(p[3], p[7]);
    CMPX(p[1], p[5]); CMPX(p[2], p[6]);
    CMPX(p[1], p[4]); CMPX(p[3], p[6]);
    CMPX(p[2], p[4]); CMPX(p[3], p[5]);
    CMPX(p[3], p[4]);
    unsigned W = 0u;
    for (int it = 0; it < 16; ++it) {
        const unsigned m = max16(p[0]);
        W = (c == it) ? m : W;
        const bool win = (p[0] == m);
#pragma unroll
        for (int i = 0; i < 7; ++i) p[i] = win ? p[i + 1] : p[i];
        p[7] = win ? 0u : p[7];
    }
    return W;
}
__device__ __forceinline__ unsigned top16_of4r(unsigned (&p)[4], int c) {
    CMPX(p[0], p[1]); CMPX(p[2], p[3]); CMPX(p[0], p[2]); CMPX(p[1], p[3]); CMPX(p[1], p[2]);
    unsigned W = 0u;
    for (int it = 0; it < 16; ++it) {
        const unsigned m = max16(p[0]);
        W = (c == it) ? m : W;
        const bool win = (p[0] == m);
        p[0] = win ? p[1] : p[0]; p[1] = win ? p[2] : p[1]; p[2] = win ? p[3] : p[2]; p[3] = win ? 0u : p[3];
    }
    return W;
}
__device__ __forceinline__ void topk_fill(LAS unsigned char* lds, const bf16* keys, int h, int tid) {
#pragma unroll
    for (int i = 0; i < 8; ++i) { const int idx = tid + 512 * i, p = idx >> 11, key = (idx >> 4) & 127, ch = idx & 15;
        const v4u v = *(const v4u*)(keys + (size_t)((h * 2 + p) * 128 + key) * 128 + ch * 8);
        *(LAS v4u*)(lds + p * 32768 + key * 256 + ((ch ^ (key & 15)) << 4)) = v; }
}
struct CvtCtx { const float* srcU; long dsrc; const float* gain; unsigned char* dstU; long ddst; float* su; long dsc; int gwave, nw; };
__device__ __forceinline__ void cvt_chunk_load(const CvtCtx& cx, int c, int lane, f32x4 (&v)[4]) {
    const int r = c >> 1, hh = c & 1;
    const float* src = cx.srcU + ((r < 16384) ? 0L : cx.dsrc) + (size_t)(r & 16383) * 2048 + hh * 1024 + 4 * lane;
#pragma unroll
    for (int j = 0; j < 4; ++j) v[j] = *(const f32x4*)(src + 256 * j);
}
__device__ __forceinline__ void cvt_chunk_store(const CvtCtx& cx, int c, int lane, f32x4 (&v)[4]) {
    const int r = c >> 1, hh = c & 1; const bool isu = r < 16384; const int e = r & 16383;
    float mx = 0.f;
#pragma unroll
    for (int j = 0; j < 4; ++j) { if (isu) v[j] = v[j] * *(const f32x4*)(cx.gain + hh * 1024 + 256 * j + 4 * lane);
        mx = fmaxf(mx, fmaxf(fmaxf(fabsf(v[j][0]), fabsf(v[j][1])), fmaxf(fabsf(v[j][2]), fabsf(v[j][3])))); }
    mx = fmaxf(mx, DPPF(mx, 0xB1)); mx = fmaxf(mx, DPPF(mx, 0x4E)); mx = fmaxf(mx, DPPF(mx, 0x141)); mx = fmaxf(mx, DPPF(mx, 0x140));
    { const auto rr = __builtin_amdgcn_permlane16_swap(__float_as_uint(mx), __float_as_uint(mx), false, false); mx = fmaxf(__uint_as_float(rr[0]), __uint_as_float(rr[1])); }
    { const auto rr = __builtin_amdgcn_permlane32_swap(__float_as_uint(mx), __float_as_uint(mx), false, false); mx = fmaxf(__uint_as_float(rr[0]), __uint_as_float(rr[1])); }
    const float sc = fmaxf(mx, 1e-30f) * (1.f / 6.f), inv = 1.f / sc;
    if (lane == 0) (cx.su + (isu ? 0L : cx.dsc))[e * 2 + hh] = sc;
    unsigned char* dst = cx.dstU + (isu ? 0L : cx.ddst) + ((size_t)(hh * 4) * 16384 + e) * 128 + 2 * lane;
#pragma unroll
    for (int j = 0; j < 4; ++j) { unsigned w = 0u;
        w = __builtin_amdgcn_cvt_scalef32_pk_fp4_f32(w, v[j][0] * inv, v[j][1] * inv, 1.0f, 0); w = __builtin_amdgcn_cvt_scalef32_pk_fp4_f32(w, v[j][2] * inv, v[j][3] * inv, 1.0f, 1);
        *(unsigned short*)(dst + (size_t)j * (16384 * 128)) = (unsigned short)w; }
}
__device__ __forceinline__ void topk_unit(const bf16* q, LAS const unsigned char* lds, int* EI, float* GW, int t0, int h, int lane) {
    const int c = lane & 15, g4 = lane >> 4, rbase = lane & 48;
    int f0 = 0, f1 = 0, f2 = 0, f3 = 0;
    { int cnt = 0;
#pragma unroll
      for (int i = 0; i < 16; ++i)
#pragma unroll
        for (int j = 0; j < 16; ++j) if ((i + 1) * (j + 1) <= 16) { const int fl = i * 16 + j; f0 = (cnt == c) ? fl : f0; f1 = (cnt == c + 16) ? fl : f1; f2 = (cnt == c + 32) ? fl : f2; f3 = (cnt == c + 48) ? fl : f3; ++cnt; } }
    unsigned W[2][8];
#pragma unroll
    for (int p = 0; p < 2; ++p) {
        f32x4 acc[2][8];
#pragma unroll
        for (int mb = 0; mb < 2; ++mb)
#pragma unroll
            for (int kb = 0; kb < 8; ++kb) acc[mb][kb] = (f32x4){0.f, 0.f, 0.f, 0.f};
        const bf16* qp = q + (size_t)(t0 + c) * 2048 + h * 256 + p * 128 + g4 * 8;
        LAS const unsigned char* kp = lds + p * 32768 + c * 256;
        asm volatile("" : "+v"(qp));
#pragma unroll 2
        for (int ks = 0; ks < 4; ++ks) {
            const s16x8 a0 = *(const s16x8*)(qp + ks * 32), a1 = *(const s16x8*)(qp + (size_t)16 * 2048 + ks * 32);
#pragma unroll
            for (int kb = 0; kb < 8; ++kb) { const s16x8 b = *(LAS const s16x8*)(kp + kb * 4096 + (((4 * ks + g4) ^ c) << 4));
                acc[0][kb] = __builtin_amdgcn_mfma_f32_16x16x32_bf16(a0, b, acc[0][kb], 0, 0, 0); acc[1][kb] = __builtin_amdgcn_mfma_f32_16x16x32_bf16(a1, b, acc[1][kb], 0, 0, 0); }
        }
#pragma unroll
        for (int pb = 0; pb < 8; ++pb) {
            unsigned pk[8];
#pragma unroll
            for (int kb = 0; kb < 8; ++kb) pk[kb] = (ordf(acc[pb >> 2][kb][pb & 3]) & ~127u) | (unsigned)(127 - 16 * kb - c);
            W[p][pb] = top16_of8(pk, c);
        }
    }
#pragma unroll
    for (int pb = 0; pb < 8; ++pb) {
        const unsigned w0 = W[0][pb], w1 = W[1][pb];
        unsigned cp[4];
        { const float a0 = unordf(bperm(w0, rbase + (f0 >> 4)) & ~127u), b0 = unordf(bperm(w1, rbase + (f0 & 15)) & ~127u); cp[0] = (ordf(a0 + b0) & ~63u) | (unsigned)(63 - c); }
        { const float a0 = unordf(bperm(w0, rbase + (f1 >> 4)) & ~127u), b0 = unordf(bperm(w1, rbase + (f1 & 15)) & ~127u); cp[1] = (ordf(a0 + b0) & ~63u) | (unsigned)(47 - c); }
        { const float a0 = unordf(bperm(w0, rbase + (f2 >> 4)) & ~127u), b0 = unordf(bperm(w1, rbase + (f2 & 15)) & ~127u); cp[2] = (ordf(a0 + b0) & ~63u) | (unsigned)(31 - c); }
        { const float a0 = unordf(bperm(w0, rbase + (f3 >> 4)) & ~127u), b0 = unordf(bperm(w1, rbase + (f3 & 15)) & ~127u); cp[3] = (c + 48 < 50) ? ((ordf(a0 + b0) & ~63u) | (unsigned)(15 - c)) : 0u; }
        const unsigned Wc = top16_of4r(cp, c);
        const int slot = 63 - (int)(Wc & 63u);
        const unsigned fa = bperm((unsigned)f0, rbase + (slot & 15)), fb = bperm((unsigned)f1, rbase + (slot & 15)), fc = bperm((unsigned)f2, rbase + (slot & 15)), fd = bperm((unsigned)f3, rbase + (slot & 15));
        const int sq = slot >> 4; const int flat = (int)((sq == 0) ? fa : (sq == 1) ? fb : (sq == 2) ? fc : fd);
        const float val = unordf(Wc & ~63u);
        const float vmax = __uint_as_float(bperm(__float_as_uint(val), rbase));
        const float e = __expf(val - vmax);
        const float g = e / sum16(e);
        const int k1 = 127 - (int)(bperm(w0, rbase + (flat >> 4)) & 127u), k2 = 127 - (int)(bperm(w1, rbase + (flat & 15)) & 127u);
        const int tok = t0 + 16 * (pb >> 2) + 4 * g4 + (pb & 3);
        EI[(size_t)(tok * 8 + h) * 16 + c] = k1 * 128 + k2; GW[(size_t)(tok * 8 + h) * 16 + c] = g;
    }
}

__device__ __forceinline__ float gelu_tanh_f(float x) {
    const float u = 0.7978845608028654f * (x + 0.044715f * x * x * x);
    const float e = __expf(2.f * u);
    const float th = 1.f - 2.f / (e + 1.f);
    return 0.5f * x * (1.f + th);
}
__device__ __forceinline__ float wave_sum_bfly(float v) {
#pragma unroll
    for (int o = 1; o < 64; o <<= 1) v += __shfl_xor(v, o);
    return v;
}
typedef float f32x2_ __attribute__((ext_vector_type(2)));
#define FP4_DEC(w_, sel_) __builtin_amdgcn_cvt_scalef32_pk_f32_fp4((unsigned)(w_), 1.0f, (sel_))
typedef int i32x8 __attribute__((ext_vector_type(8)));
template <int NBT>
__device__ __forceinline__ void peer_a_slice(const bf16* xb, const int* EI, const unsigned char* U4s, float* pd, int s, unsigned* ctr, int nbatch, int lane) {
    const int c = lane & 15, g4 = lane >> 4, k8 = c >> 1;
    const unsigned char* tab = U4s + (size_t)s * (16384 * 128) + (4 * (c & 1) + g4) * 16;
#define A_FETCH() ((int)__builtin_amdgcn_readfirstlane((int)((lane == 0) ? __hip_atomic_fetch_add(ctr, 1u, __ATOMIC_RELAXED, __HIP_MEMORY_SCOPE_AGENT) : 0u)))
#define A_TOKB(b_, j_) ((((b_) < nbatch) ? (b_) : (nbatch - 1)) * NBT + (j_))
#define A_XS(XS, t_) do { const bf16* xp_ = xb + (size_t)(t_) * 2048 + s * 256 + 128 * (c & 1) + 16 * g4; XS[0] = *(const v4u*)xp_; XS[1] = *(const v4u*)(xp_ + 8); XS[2] = *(const v4u*)(xp_ + 64); XS[3] = *(const v4u*)(xp_ + 72); } while (0)
#define A_ISSUE(U, EV) do { _Pragma("unroll") for (int i = 0; i < 8; ++i) { const int e_ = (int)bperm((unsigned)(EV), (i << 3) + k8); U[i] = *(const v4u*)(tab + (size_t)e_ * 128); } } while (0)
#define A_COMPUTE(U, OUT) do { _Pragma("unroll") for (int i = 0; i < 8; ++i) { f32x4 d_ = (f32x4){0.f, 0.f, 0.f, 0.f}; \
            d_ = __builtin_amdgcn_mfma_scale_f32_16x16x128_f8f6f4((i32x8){(int)U[i][0], (int)U[i][1], (int)U[i][2], (int)U[i][3], 0, 0, 0, 0}, hb, d_, 4, 0, 0, 0x7f7f7f7f, 0, 0x7f7f7f7f); \
            const float o0_ = d_[0] + DPPF(d_[1], 0xB1), o1_ = d_[2] + DPPF(d_[3], 0xB1);        \
            if (k8 == i) OUT = (f32x2_){o0_, o1_}; } } while (0)
    int eL[NBT], eH[NBT], nL[NBT], nH[NBT]; v4u xs[2][4]; v4u UA[8], UB[8];
    int b0 = A_FETCH(), b1 = A_FETCH();
    if (b0 >= nbatch) return;
#pragma unroll
    for (int j = 0; j < NBT; ++j) { const int tj = A_TOKB(b0, j); eL[j] = EI[(size_t)tj * 128 + lane]; eH[j] = EI[(size_t)tj * 128 + 64 + lane]; }
    A_XS(xs[0], A_TOKB(b0, 0));
    A_ISSUE(UA, eL[0]);
    while (b0 < nbatch) {
        const int b2 = A_FETCH();
#pragma unroll
        for (int j = 0; j < NBT; ++j) { const int tj = A_TOKB(b1, j); nL[j] = EI[(size_t)tj * 128 + lane]; nH[j] = EI[(size_t)tj * 128 + 64 + lane]; }
#pragma unroll
        for (int j = 0; j < NBT; ++j) {
            const int t = b0 * NBT + j;
            A_ISSUE(UB, eH[j]);
            i32x8 hb;
#pragma unroll
            for (int q = 0; q < 4; ++q) { const v4u w = xs[j & 1][q]; int lo = 0, hi = 0;
                lo = __builtin_amdgcn_cvt_pk_fp8_f32(__uint_as_float(w[0] << 16), __uint_as_float(w[0] & 0xffff0000u), lo, false); lo = __builtin_amdgcn_cvt_pk_fp8_f32(__uint_as_float(w[1] << 16), __uint_as_float(w[1] & 0xffff0000u), lo, true);
                hi = __builtin_amdgcn_cvt_pk_fp8_f32(__uint_as_float(w[2] << 16), __uint_as_float(w[2] & 0xffff0000u), hi, false); hi = __builtin_amdgcn_cvt_pk_fp8_f32(__uint_as_float(w[3] << 16), __uint_as_float(w[3] & 0xffff0000u), hi, true);
                hb[2 * q] = lo; hb[2 * q + 1] = hi; }
            f32x2_ out_lo = (f32x2_){0.f, 0.f}, out_hi = (f32x2_){0.f, 0.f};
            A_COMPUTE(UA, out_lo);
            A_XS(xs[(j + 1) & 1], (j + 1 < NBT) ? (b0 * NBT + j + 1) : A_TOKB(b1, 0));
            A_ISSUE(UA, (j + 1 < NBT) ? eL[(j + 1) % NBT] : nL[0]);
            A_COMPUTE(UB, out_hi);
            if ((c & 1) == 0) { float* pp = pd + ((size_t)s * T + t) * 128 + 8 * k8 + 2 * g4; *(f32x2_*)pp = out_lo; *(f32x2_*)(pp + 64) = out_hi; }
        }
#pragma unroll
        for (int j = 0; j < NBT; ++j) { eL[j] = nL[j]; eH[j] = nH[j]; }
        b0 = b1; b1 = b2;
    }
#undef A_FETCH
#undef A_TOKB
#undef A_XS
#undef A_ISSUE
#undef A_COMPUTE
}
__device__ __forceinline__ void peer_a2_token(const float* pd, const float* ssq, const int* EI, const float* su, const float* sv, float* GW, float* W1, int t, int lane) {
    float a0 = 0.f, a1 = 0.f, b0 = 0.f, b1 = 0.f;
#pragma unroll
    for (int s = 0; s < 4; ++s) { const float* pp = pd + ((size_t)s * T + t) * 128; a0 += pp[lane]; a1 += pp[64 + lane]; }
#pragma unroll
    for (int s = 4; s < 8; ++s) { const float* pp = pd + ((size_t)s * T + t) * 128; b0 += pp[lane]; b1 += pp[64 + lane]; }
    const float rs = rsqrtf(ssq[t] * (1.f / 2048.f) + EPS);
    float* gp = GW + (size_t)t * 128; float* hp = W1 + (size_t)t * 128; const int pl = lane;
    const int e0 = EI[(size_t)t * 128 + pl], e1 = EI[(size_t)t * 128 + 64 + pl];
    const float g0 = gp[pl] * gelu_tanh_f(rs * (a0 * su[2 * e0] + b0 * su[2 * e0 + 1])), g1 = gp[64 + pl] * gelu_tanh_f(rs * (a1 * su[2 * e1] + b1 * su[2 * e1 + 1]));
    gp[pl] = g0 * sv[2 * e0]; hp[pl] = g0 * sv[2 * e0 + 1];
    gp[64 + pl] = g1 * sv[2 * e1]; hp[64 + pl] = g1 * sv[2 * e1 + 1];
}
template <int NBT>
__device__ __forceinline__ void peer_b_slice(float* xio, const int* EI, const float* W, const unsigned char* V4s, bf16* xb, float* ssq_out, int s, unsigned* ctr, int nbatch, int lane) {
    const int j16 = lane & 15, g4 = lane >> 4;
    const unsigned char* tab = V4s + (size_t)s * (16384 * 128) + 8 * j16;
    const int doff = s * 256 + 64 * g4 + j16;
    const int sh8 = 8 * (j16 & 3); const bool q0 = (j16 >> 2) == 0, q1 = (j16 >> 2) == 1, q2 = (j16 >> 2) == 2, q3 = (j16 >> 2) == 3;
#define B_FETCH() ((int)__builtin_amdgcn_readfirstlane((int)((lane == 0) ? __hip_atomic_fetch_add(ctr, 1u, __ATOMIC_RELAXED, __HIP_MEMORY_SCOPE_AGENT) : 0u)))
#define B_TOKB(b_, j_) ((((b_) < nbatch) ? (b_) : (nbatch - 1)) * NBT + (j_))
#define B_ISSUE(V, EV) do { _Pragma("unroll") for (int i = 0; i < 8; ++i) { const int e0_ = (int)bperm((unsigned)(EV), 8 * i + 2 * g4), e1_ = (int)bperm((unsigned)(EV), 8 * i + 2 * g4 + 1); \
        V[2 * i] = *(const v2u*)(tab + (size_t)e0_ * 128); V[2 * i + 1] = *(const v2u*)(tab + (size_t)e1_ * 128); } } while (0)
#define B_COMPUTE(V, WV) do { _Pragma("unroll") for (int i = 0; i < 8; ++i) { \
            const float w0_ = fminf(fmaxf(__uint_as_float(bperm(__float_as_uint(WV), 8 * i + g4)) * 256.f, -448.f), 448.f), w1_ = fminf(fmaxf(__uint_as_float(bperm(__float_as_uint(WV), 8 * i + 4 + g4)) * 256.f, -448.f), 448.f); \
            const unsigned f0_ = ((unsigned)__builtin_amdgcn_cvt_pk_fp8_f32(w0_, 0.f, 0, false) & 0xffu) << sh8, f1_ = ((unsigned)__builtin_amdgcn_cvt_pk_fp8_f32(w1_, 0.f, 0, false) & 0xffu) << sh8; \
            const i32x8 bq_ = (i32x8){(int)(q0 ? f0_ : 0u), (int)(q1 ? f0_ : 0u), (int)(q2 ? f0_ : 0u), (int)(q3 ? f0_ : 0u), (int)(q0 ? f1_ : 0u), (int)(q1 ? f1_ : 0u), (int)(q2 ? f1_ : 0u), (int)(q3 ? f1_ : 0u)}; \
            acc = __builtin_amdgcn_mfma_scale_f32_16x16x128_f8f6f4((i32x8){(int)V[2 * i][0], (int)V[2 * i][1], (int)V[2 * i + 1][0], (int)V[2 * i + 1][1], 0, 0, 0, 0}, bq_, acc, 4, 0, 0, 0x7f7f7f7f, 0, 0x77777777); } } while (0)
    int eL[NBT], eH[NBT], nL[NBT], nH[NBT]; float wL[NBT], wH[NBT], mL[NBT], mH[NBT]; float xv[4]; v2u VA[16], VB[16];
    int b0 = B_FETCH(), b1 = B_FETCH();
    if (b0 >= nbatch) return;
#pragma unroll
    for (int j = 0; j < NBT; ++j) { const int tj = B_TOKB(b0, j); eL[j] = EI[(size_t)tj * 128 + lane]; eH[j] = EI[(size_t)tj * 128 + 64 + lane]; wL[j] = W[(size_t)tj * 128 + lane]; wH[j] = W[(size_t)tj * 128 + 64 + lane]; }
    B_ISSUE(VA, eL[0]);
    while (b0 < nbatch) {
        const int b2 = B_FETCH();
#pragma unroll
        for (int j = 0; j < NBT; ++j) { const int tj = B_TOKB(b1, j); nL[j] = EI[(size_t)tj * 128 + lane]; nH[j] = EI[(size_t)tj * 128 + 64 + lane]; mL[j] = W[(size_t)tj * 128 + lane]; mH[j] = W[(size_t)tj * 128 + 64 + lane]; }
#pragma unroll
        for (int j = 0; j < NBT; ++j) {
            const int t = b0 * NBT + j;
            float* xp = xio + (size_t)t * 2048 + doff;
#pragma unroll
            for (int r = 0; r < 4; ++r) xv[r] = xp[16 * r];
            B_ISSUE(VB, eH[j]);
            f32x4 acc = (f32x4){0.f, 0.f, 0.f, 0.f};
            B_COMPUTE(VA, wL[j]);
            B_ISSUE(VA, (j + 1 < NBT) ? eL[(j + 1) % NBT] : nL[0]);
            B_COMPUTE(VB, wH[j]);
            float ss = 0.f;
#pragma unroll
            for (int r = 0; r < 4; ++r) { const float o = xv[r] + acc[r]; ss += o * o; xp[16 * r] = o; if (xb) xb[(size_t)t * 2048 + doff + 16 * r] = (bf16)f2bf(o); }
            ss += DPPF(ss, 0xB1); ss += DPPF(ss, 0x4E); ss += DPPF(ss, 0x141); ss += DPPF(ss, 0x140);
            { const auto r = __builtin_amdgcn_permlane16_swap(__float_as_uint(ss), __float_as_uint(ss), false, false); ss = __uint_as_float(r[0]) + __uint_as_float(r[1]); }
            { const auto r = __builtin_amdgcn_permlane32_swap(__float_as_uint(ss), __float_as_uint(ss), false, false); ss = __uint_as_float(r[0]) + __uint_as_float(r[1]); }
            if (lane == 0) unsafeAtomicAdd(ssq_out + t, ss);
        }
#pragma unroll
        for (int j = 0; j < NBT; ++j) { eL[j] = nL[j]; eH[j] = nH[j]; wL[j] = mL[j]; wH[j] = mH[j]; }
        b0 = b1; b1 = b2;
    }
#undef B_FETCH
#undef B_TOKB
#undef B_ISSUE
#undef B_COMPUTE
}
__device__ __forceinline__ void final_norm_row(float* xio, const float* ssq, const float* fin, int t, int lane, float oscale) {
    const float r2 = rsqrtf(ssq[t] * (1.f / 2048.f) + EPS) * oscale;
    float* xr = xio + (size_t)t * 2048 + 4 * lane;
#pragma unroll
    for (int j = 0; j < 8; ++j) { const f32x4 xv = *(const f32x4*)(xr + 256 * j), g = *(const f32x4*)(fin + 256 * j + 4 * lane); f32x4 o;
        o[0] = xv[0] * r2 * g[0]; o[1] = xv[1] * r2 * g[1]; o[2] = xv[2] * r2 * g[2]; o[3] = xv[3] * r2 * g[3]; *(f32x4*)(xr + 256 * j) = o; }
}
typedef short s16x4 __attribute__((ext_vector_type(4)));
__device__ __forceinline__ unsigned cvt_pk_bf16_(float lo, float hi) { unsigned r; asm volatile("v_cvt_pk_bf16_f32 %0, %1, %2" : "=v"(r) : "v"(lo), "v"(hi)); return r; }
constexpr int ATT_K_OFF = 0, ATT_V_OFF = 40960, ATT_VSTRIDE = 648, ATT_LDS = ATT_V_OFF + 64 * ATT_VSTRIDE;
__device__ __forceinline__ void attn_fill(LAS unsigned char* lds, const bf16* K, const bf16* Vt, int b, int kvh, int kw0, int tid) {
    const size_t tb = (size_t)b * 4096;
#pragma unroll
    for (int i = 0; i < 5; ++i) { const int idx = tid + 512 * i, row = idx >> 3, ch = idx & 7, key = kw0 + row;
        v4u v = (v4u){0u, 0u, 0u, 0u}; if (key >= 0 && key < 4096) v = *(const v4u*)(K + (tb + key) * 512 + kvh * 64 + ch * 8);
        *(LAS v4u*)(lds + ATT_K_OFF + row * 128 + ((ch ^ ((row >> 1) & 7)) << 4)) = v; }
#pragma unroll
    for (int i = 0; i < 10; ++i) { const int idx = tid + 512 * i, d = idx / 80, pc = idx % 80, key = kw0 + pc * 4;
        v2u v = (v2u){0u, 0u}; if (key >= 0 && key < 4096) v = *(const v2u*)(Vt + (size_t)(kvh * 64 + d) * 16384 + tb + key);
        *(LAS v2u*)(lds + ATT_V_OFF + d * ATT_VSTRIDE + pc * 8) = v; }
}
__device__ __forceinline__ void attn_task(LAS const unsigned char* lds, const bf16* Q, bf16* O, const float* sinks, int b, int hq, int q0, int kw0, int lane) {
    const int c = lane & 31, hi = lane >> 5;
    const size_t tb = (size_t)b * 4096;
    s16x8 qf[4];
    { const bf16* qp = Q + (tb + q0 + c) * 2048 + hq * 64 + hi * 8;
#pragma unroll
      for (int ks = 0; ks < 4; ++ks) qf[ks] = *(const s16x8*)(qp + ks * 16); }
    const float sink2 = sinks[hq] * 1.4426950408889634f;
    float m = sink2, l = (hi == 0) ? 1.f : 0.f;
    f32x16 o0, o1;
#pragma unroll
    for (int r = 0; r < 16; ++r) { o0[r] = 0.f; o1[r] = 0.f; }
    const int kt_lo = (q0 < 128) ? ((128 - q0) >> 5) : 0, kt_hi = ((4192 - q0) >> 5) < 8 ? ((4192 - q0) >> 5) : 8;
    for (int kt = kt_lo; kt <= kt_hi; ++kt) {
        const int key0 = q0 - 128 + 32 * kt, row0 = key0 - kw0;
        s16x8 kf[4]; s16x4 va[2][2][2];
        { const int row = row0 + c; LAS const unsigned char* kp = lds + ATT_K_OFF + row * 128; const int sw = (row >> 1) & 7;
#pragma unroll
          for (int ks = 0; ks < 4; ++ks) kf[ks] = *(LAS const s16x8*)(kp + (((2 * ks + hi) ^ sw) << 4)); }
#pragma unroll
        for (int db = 0; db < 2; ++db)
#pragma unroll
            for (int s = 0; s < 2; ++s) { LAS const unsigned char* vp = lds + ATT_V_OFF + (db * 32 + c) * ATT_VSTRIDE + (row0 + 16 * s + 4 * hi) * 2; va[db][s][0] = *(LAS const s16x4*)vp; va[db][s][1] = *(LAS const s16x4*)(vp + 16); }
        f32x16 sa;
#pragma unroll
        for (int r = 0; r < 16; ++r) sa[r] = 0.f;
#pragma unroll
        for (int ks = 0; ks < 4; ++ks) sa = __builtin_amdgcn_mfma_f32_32x32x16_bf16(kf[ks], qf[ks], sa, 0, 0, 0);
        if (kt == 0 || kt == 8) {
            const int dbase = key0 - (q0 + c) + 4 * hi;
#pragma unroll
            for (int r = 0; r < 16; ++r) { const int d = dbase + (r & 3) + 8 * (r >> 2); if (d < -128 || d > 128) sa[r] = -1e30f; }
        }
        float mx = sa[0];
#pragma unroll
        for (int r = 1; r < 16; ++r) mx = fmaxf(mx, sa[r]);
        { const auto rr = __builtin_amdgcn_permlane32_swap(__float_as_uint(mx), __float_as_uint(mx), false, false); mx = fmaxf(__uint_as_float(rr[0]), __uint_as_float(rr[1])); }
        const float mn = fmaxf(m, mx), alpha = __builtin_amdgcn_exp2f(m - mn);
        m = mn;
        float ps = 0.f;
#pragma unroll
        for (int r = 0; r < 16; ++r) { sa[r] = __builtin_amdgcn_exp2f(sa[r] - mn); ps += sa[r]; }
        l = l * alpha + ps;
#pragma unroll
        for (int r = 0; r < 16; ++r) { o0[r] *= alpha; o1[r] *= alpha; }
        s16x8 pf[2];
#pragma unroll
        for (int s = 0; s < 2; ++s) { v4u w; w.x = cvt_pk_bf16_(sa[8 * s + 0], sa[8 * s + 1]); w.y = cvt_pk_bf16_(sa[8 * s + 2], sa[8 * s + 3]); w.z = cvt_pk_bf16_(sa[8 * s + 4], sa[8 * s + 5]); w.w = cvt_pk_bf16_(sa[8 * s + 6], sa[8 * s + 7]);
            pf[s] = __builtin_bit_cast(s16x8, w); }
#pragma unroll
        for (int s = 0; s < 2; ++s) {
            const s16x8 v0 = __builtin_shufflevector(va[0][s][0], va[0][s][1], 0, 1, 2, 3, 4, 5, 6, 7), v1 = __builtin_shufflevector(va[1][s][0], va[1][s][1], 0, 1, 2, 3, 4, 5, 6, 7);
            o0 = __builtin_amdgcn_mfma_f32_32x32x16_bf16(v0, pf[s], o0, 0, 0, 0);
            o1 = __builtin_amdgcn_mfma_f32_32x32x16_bf16(v1, pf[s], o1, 0, 0, 0);
        }
    }
    { const auto rr = __builtin_amdgcn_permlane32_swap(__float_as_uint(l), __float_as_uint(l), false, false); l = __uint_as_float(rr[0]) + __uint_as_float(rr[1]); }
    const float il = 1.f / l;
    bf16* op = O + (tb + q0 + c) * 2048 + hq * 64 + 4 * hi;
#pragma unroll
    for (int g = 0; g < 4; ++g) {
        v2u w0, w1;
        w0.x = cvt_pk_bf16_(o0[4 * g + 0] * il, o0[4 * g + 1] * il); w0.y = cvt_pk_bf16_(o0[4 * g + 2] * il, o0[4 * g + 3] * il);
        w1.x = cvt_pk_bf16_(o1[4 * g + 0] * il, o1[4 * g + 1] * il); w1.y = cvt_pk_bf16_(o1[4 * g + 2] * il, o1[4 * g + 3] * il);
        *(v2u*)(op + 8 * g) = w0; *(v2u*)(op + 32 + 8 * g) = w1;
    }
}
typedef float fx2 __attribute__((ext_vector_type(2)));
__device__ __forceinline__ fx2 bf2_(unsigned w) { fx2 r; r[0] = __uint_as_float(w << 16); r[1] = __uint_as_float(w & 0xffff0000u); return r; }
__device__ __forceinline__ void fft16_item(bf16* Zp, const float* tw, int bg, int l, int s1h, int lane) {
    const int s1 = s1h * 128 + 2 * lane;
    bf16* base = Zp + ((size_t)(bg * 16) * 256 + l) * 512 + s1;
    fx2 zr[16], zi[16];
#pragma unroll
    for (int s2 = 0; s2 < 16; ++s2) { zr[s2] = bf2_(*(const unsigned*)(base + (size_t)s2 * 256 * 512)); zi[s2] = bf2_(*(const unsigned*)(base + (size_t)s2 * 256 * 512 + 256)); }
    fx2 er[16], ei[16];
#pragma unroll
    for (int d = 0; d < 4; ++d) {
        const fx2 ar = zr[d], ai_ = zi[d], br = zr[4 + d], bi = zi[4 + d], cr = zr[8 + d], ci = zi[8 + d], dr = zr[12 + d], di = zi[12 + d];
        const fx2 s0r = ar + cr, s0i = ai_ + ci, s1r = ar - cr, s1i = ai_ - ci, s2r = br + dr, s2i = bi + di, s3r = br - dr, s3i = bi - di;
        er[0 * 4 + d] = s0r + s2r; ei[0 * 4 + d] = s0i + s2i;
        er[1 * 4 + d] = s1r + s3i; ei[1 * 4 + d] = s1i - s3r;
        er[2 * 4 + d] = s0r - s2r; ei[2 * 4 + d] = s0i - s2i;
        er[3 * 4 + d] = s1r - s3i; ei[3 * 4 + d] = s1i + s3r;
    }
#pragma unroll
    for (int a = 1; a < 4; ++a)
#pragma unroll
        for (int d = 1; d < 4; ++d) {
            const float ang = 6.283185307179586f * (float)(a * d) / 16.f; const float c = __builtin_cosf(ang), sn = __builtin_sinf(ang);
            const fx2 xr = er[a * 4 + d], xi = ei[a * 4 + d];
            er[a * 4 + d] = xr * c + xi * sn; ei[a * 4 + d] = xi * c - xr * sn;
        }
#pragma unroll
    for (int a = 0; a < 4; ++a) {
        const fx2 ar = er[a * 4 + 0], ai_ = ei[a * 4 + 0], br = er[a * 4 + 1], bi = ei[a * 4 + 1], cr = er[a * 4 + 2], ci = ei[a * 4 + 2], dr = er[a * 4 + 3], di = ei[a * 4 + 3];
        const fx2 s0r = ar + cr, s0i = ai_ + ci, s1r = ar - cr, s1i = ai_ - ci, s2r = br + dr, s2i = bi + di, s3r = br - dr, s3i = bi - di;
        fx2 Dr[4], Di[4];
        Dr[0] = s0r + s2r; Di[0] = s0i + s2i; Dr[1] = s1r + s3i; Di[1] = s1i - s3r; Dr[2] = s0r - s2r; Di[2] = s0i - s2i; Dr[3] = s1r - s3i; Di[3] = s1i + s3r;
#pragma unroll
        for (int b = 0; b < 4; ++b) {
            const int k2 = a + 4 * b;
            const f32x4 t0 = *(const f32x4*)(tw + (size_t)(k2 * 256 + s1) * 2);
            const fx2 cc = (fx2){t0[0], t0[2]}, ss = (fx2){t0[1], t0[3]};
            const fx2 hr = Dr[b] * cc + Di[b] * ss, hi_ = Di[b] * cc - Dr[b] * ss;
            *(unsigned*)(base + (size_t)k2 * 256 * 512) = pk2(hr[0], hr[1]); *(unsigned*)(base + (size_t)k2 * 256 * 512 + 256) = pk2(hi_[0], hi_[1]);
        }
    }
}
__device__ __forceinline__ int static_unit(int nM, int nN, int G, int c, int i) {
    const int nwg = nM * nN; const long L = (long)i * G + c; if (L >= nwg) return -1;
    int wgid = (int)L; { const int q = nwg / 8, r = nwg % 8, xcd = wgid % 8, off = wgid / 8; wgid = (xcd < r ? xcd * (q + 1) : r * (q + 1) + (xcd - r) * q) + off; }
    const int nig = 8 * nN, gid = wgid / nig, fm = gid * 8, gsz = (nM - fm) < 8 ? (nM - fm) : 8;
    return ((fm + ((wgid % nig) % gsz)) << 16) | ((wgid % nig) / gsz);
}
#ifndef REP_PRO
#define REP_PRO 1
#endif
#ifndef REP_GEMM
#define REP_GEMM 1
#endif
#ifndef REP_ATT
#define REP_ATT 1
#endif
#ifndef REP_LITE
#define REP_LITE 0
#endif
#ifndef REP_Q
#define REP_Q 1
#endif
#ifndef REP_PA
#define REP_PA 1
#endif
#ifndef REP_TK
#define REP_TK 1
#endif
enum { PH_PRO = 0, PH_G1 = 1, PH_S1 = 2, PH_G2 = 3, PH_G3 = 4, PH_Q0 = 5, PH_TK0 = 6, PH_PA0 = 7, PH_PW0 = 8, PH_PB0 = 9, PH_QKV = 10, PH_ATT = 11, PH_WO = 12, PH_Q1 = 13, PH_TK1 = 14, PH_PA1 = 15, PH_PW1 = 16, PH_PB1 = 17, PH_FIN = 18, PH_END = 19 };
__global__ void __launch_bounds__(NWAVES * 64, 2) mega(Args a) {
    extern __shared__ __attribute__((aligned(16))) unsigned char lds_raw[];
    LAS unsigned char* lds = (LAS unsigned char*)lds_raw;
    cg::grid_group grid = cg::this_grid();
    const int wave = __builtin_amdgcn_readfirstlane(threadIdx.x >> 6);
#define FRESH_IDS() int lane; asm volatile("v_mbcnt_lo_u32_b32 %0, -1, 0\n\tv_mbcnt_hi_u32_b32 %0, -1, %0" : "=v"(lane)); const int tid = wave * 64 + lane; (void)tid
    const int G = gridDim.x, bx = blockIdx.x;
    unsigned char* ws = a.ws;
    const int lo = a.ph_lo, hi = a.ph_hi;
    volatile LAS unsigned* MISC = (volatile LAS unsigned*)(lds + LDSCTL_OFF);
    if (threadIdx.x < 16) MISC[threadIdx.x] = 0u;
    __syncthreads();
    XcdBarrier xbar = xcd_barrier_post((unsigned*)(ws + WS_CTL) + CW_BAR, MISC + 8);
#define IN(k) (lo <= (k) && (k) < hi)
#ifdef DIAG_A
#define STAMP(i) do { if (bx == 0 && threadIdx.x == 0) ((unsigned long long*)(ws + WS_STAMP))[i] = __builtin_amdgcn_s_memrealtime(); } while (0)
#else
#define STAMP(i) do { } while (0)
#endif
#define SEAM(k) do { if (IN(k) && IN((k) + 1)) { if ((k) == PH_PRO) grid.sync(); else xcd_barrier(xbar); } STAMP((k) + 1); } while (0)
    STAMP(0);
    for (int rep_ = 0; rep_ < REP_PRO; ++rep_)
    if (IN(PH_PRO)) { FRESH_IDS();
        const int gw = bx * NWAVES + wave, NGW = G * NWAVES;
        const size_t gtid = (size_t)bx * (NWAVES * 64) + tid, ngt = (size_t)G * NWAVES * 64;
        LAS float* scr = (LAS float*)(lds + wave * 16384);
        {
            constexpr int I_SQ = (DM / 64) * (DM / 32), I_QKV = (DM / 64) * (QKVW / 32);
            constexpr int NITEMS = 4 * I_SQ + I_QKV;
            for (int it = gw; it < NITEMS; it += NGW) {
                int r = it;
                if (r < I_SQ) { transpose_item<0>(a.in[3], DM, DM, nullptr, (bf16*)(ws + WS_WOF), scr, r, lane); continue; } r -= I_SQ;
                if (r < I_SQ) { transpose_item<0>(a.in[5], DM, DM, nullptr, (bf16*)(ws + WS_WOA), scr, r, lane); continue; } r -= I_SQ;
                if (r < I_SQ) { transpose_item<0>(a.in[7], DM, DM, a.in[2], (bf16*)(ws + WS_WQ0), scr, r, lane); continue; } r -= I_SQ;
                if (r < I_SQ) { transpose_item<0>(a.in[7] + (size_t)DM * DM, DM, DM, a.in[2] + DM, (bf16*)(ws + WS_WQ1), scr, r, lane); continue; } r -= I_SQ;
                transpose_item<1>(a.in[4], DM, QKVW, a.in[1] + DM, (bf16*)(ws + WS_WQKV), scr, r, lane);
            }
        }
        for (int row = gw; row < T; row += NGW) {
            const f32x4* xr = (const f32x4*)(a.in[0] + (size_t)row * DM) + lane;
            const f32x4* gr = (const f32x4*)a.in[1] + lane;
            f32x4 v[8]; float s = 0.f;
#pragma unroll
            for (int j = 0; j < 8; ++j) { v[j] = xr[64 * j]; s += (v[j][0] * v[j][0] + v[j][1] * v[j][1]) + (v[j][2] * v[j][2] + v[j][3] * v[j][3]); }
            const float r = rsqrtf(wsum(s) * (1.f / DM) + EPS);
            const int b = row >> 12, sp = row & 4095;
#pragma unroll
            for (int j = 0; j < 8; ++j) { const f32x4 gg = gr[64 * j]; v2u o; o.x = pk2(v[j][0] * r * gg[0], v[j][1] * r * gg[1]); o.y = pk2(v[j][2] * r * gg[2], v[j][3] * r * gg[3]);
                *(v2u*)((bf16*)(ws + WS_XG) + ((size_t)((b * 8 + j) * 4096 + sp) * 256 + 4 * lane)) = o; }
        }
        for (size_t i = gtid; i < (size_t)256 * 512 / 8; i += ngt) {
            const int k1 = (int)(i >> 6), c0 = (int)(i & 63) * 8, part = c0 >> 8, s0 = c0 & 255;
            float v[8];
#pragma unroll
            for (int e = 0; e < 8; ++e) { const int m = (k1 * (s0 + e)) & 255; const float rev = (float)m * (1.f / 256.f); v[e] = (part ? __builtin_amdgcn_sinf(rev) : __builtin_amdgcn_cosf(rev)) * (1.f / 64.f); }
            v4u o; o.x = pk2(v[0], v[1]); o.y = pk2(v[2], v[3]); o.z = pk2(v[4], v[5]); o.w = pk2(v[6], v[7]);
            *(v4u*)((bf16*)(ws + WS_A2) + i * 8) = o;
        }
        for (size_t i = gtid; i < (size_t)16 * 256; i += ngt) {
            const int k2 = (int)(i >> 8), s1 = (int)(i & 255); const float rev = (float)(k2 * s1) * (1.f / 4096.f);
            ((float*)(ws + WS_TW))[2 * i] = __builtin_amdgcn_cosf(rev); ((float*)(ws + WS_TW))[2 * i + 1] = __builtin_amdgcn_sinf(rev);
        }
        for (size_t i = gtid; i < (size_t)512 * 256 / 8; i += ngt) {
            const int n = (int)(i >> 5), c0 = (int)(i & 31) * 8, part = n >> 8, l = n & 255;
            float v[8];
#pragma unroll
            for (int e = 0; e < 8; ++e) { const int m = (l * (c0 + e)) & 255; const float rev = (float)m * (1.f / 256.f); v[e] = (part ? -__builtin_amdgcn_sinf(rev) : __builtin_amdgcn_cosf(rev)) * (1.f / 16.f); }
            v4u o; o.x = pk2(v[0], v[1]); o.y = pk2(v[2], v[3]); o.z = pk2(v[4], v[5]); o.w = pk2(v[6], v[7]);
            *(v4u*)((bf16*)(ws + WS_WCS) + i * 8) = o;
        }
        for (size_t i = gtid; i < (size_t)4096 * 32; i += ngt) {
            const int pos = (int)(i >> 5), fi = (int)(i & 31);
            const double inv = exp2(-(double)fi * (13.287712379549449 / 32.0));
            double sn, cs; sincos((double)pos * inv, &sn, &cs);
            ((float*)(ws + WS_ROPE))[2 * i] = (float)cs; ((float*)(ws + WS_ROPE))[2 * i + 1] = (float)sn;
        }
#pragma unroll 1
        for (int L = 0; L < 2; ++L) {
            CvtCtx cx; cx.srcU = a.in[9] + (size_t)L * NEXP * DM; cx.dsrc = (long)((a.in[10] + (size_t)L * NEXP * DM) - cx.srcU); cx.gain = a.in[2] + L * DM; cx.dstU = ws + (L ? WS_U1 : WS_U0); cx.ddst = (long)WS_V0 - (long)WS_U0;
            cx.su = (float*)(ws + WS_SU) + L * 32768; cx.dsc = ((long)WS_SV - (long)WS_SU) / 4; cx.gwave = gw; cx.nw = NGW;
            for (int cc = gw; cc < 65536; cc += 2 * NGW) { f32x4 c0[4], c1[4]; const int c2 = cc + NGW;
                cvt_chunk_load(cx, cc, lane, c0); if (c2 < 65536) cvt_chunk_load(cx, c2, lane, c1);
                cvt_chunk_store(cx, cc, lane, c0); if (c2 < 65536) cvt_chunk_store(cx, c2, lane, c1); }
        }
        cvt_stream(a.in[8], (bf16*)(ws + WS_KEYS), (size_t)2 * PH * 2 * 128 * 128 / 8, gtid, ngt);
    }
    SEAM(PH_PRO);
    for (int rep_ = 0; rep_ < REP_GEMM; ++rep_)
    if (IN(PH_G1)) { FRESH_IDS();
        int Kq = FW; asm volatile("" : "+s"(Kq));
        pg8::Gemm g{(const pg8::bf16_t*)(ws + WS_WCS), (const pg8::bf16_t*)(ws + WS_XG), 512, T * FG, Kq}; pg8::StaticOrder S; S.init(512, T * FG, G, bx);
        pg8::EpiZt E{(pg8::bf16_t*)(ws + WS_ZT)};
        pg8::gemm_phase<pg8::EpiZt, pg8::StaticOrder, true, true>(lds, g, S, E);
    }
    SEAM(PH_G1);
    if (IN(PH_S1)) { FRESH_IDS();
        const int gw = bx * NWAVES + wave, NGW = G * NWAVES;
        for (int it = gw; it < 32 * 256 * 2; it += NGW) fft16_item((bf16*)(ws + WS_ZT), (const float*)(ws + WS_TW), it >> 9, (it >> 1) & 255, it & 1, lane);
    }
    SEAM(PH_S1);
    for (int rep_ = 0; rep_ < REP_GEMM; ++rep_)
    if (IN(PH_G2)) { FRESH_IDS();
        pg8::Gemm g{(const pg8::bf16_t*)(ws + WS_A2), (const pg8::bf16_t*)(ws + WS_ZT), 256, 131072, 512}; pg8::StaticOrder S; S.init(256, 131072, G, bx);
        pg8::EpiY E{(pg8::bf16_t*)(ws + WS_Y)};
        pg8::gemm_phase<pg8::EpiY, pg8::StaticOrder, true, true>(lds, g, S, E);
    }
    SEAM(PH_G2);
    if (IN(PH_G3)) { FRESH_IDS();
        pg8::Gemm g{(const pg8::bf16_t*)(ws + WS_Y), (const pg8::bf16_t*)(ws + WS_WOF), T, DM, DM}; pg8::StaticOrder S; S.init(T, DM, G, bx);
        pg8::EpiRes E{a.in[0], a.out, (pg8::bf16_t*)(ws + WS_XB), (float*)(ws + WS_SSQ_A)};
        pg8::gemm_phase<pg8::EpiRes, pg8::StaticOrder, true, true>(lds, g, S, E);
    }
    SEAM(PH_G3);
#define PEER_LAYER(L) do { \
        const int pq = L ? PH_Q1 : PH_Q0, ptk = L ? PH_TK1 : PH_TK0, ppa = L ? PH_PA1 : PH_PA0, ppw = L ? PH_PW1 : PH_PW0, ppb = L ? PH_PB1 : PH_PB0; \
        for (int rep_ = 0; rep_ < REP_Q; ++rep_) \
        if (IN(pq)) { FRESH_IDS(); \
            pg8::Gemm g{(const pg8::bf16_t*)(ws + WS_XB), (const pg8::bf16_t*)(ws + (L ? WS_WQ1 : WS_WQ0)), T, DM, DM}; pg8::StaticOrder S; S.init(T, DM, G, bx); \
            pg8::EpiScale E{(pg8::bf16_t*)(ws + WS_Q), (const float*)(ws + (L ? WS_SSQ_C : WS_SSQ_A))}; \
            pg8::gemm_phase<pg8::EpiScale, pg8::StaticOrder, true, true>(lds, g, S, E); \
        } \
        if (IN(pq) && IN(ptk)) { asm volatile("s_waitcnt vmcnt(0)" ::: "memory"); __syncthreads(); } STAMP(pq + 1); \
        if (IN(ptk)) { FRESH_IDS(); \
            const bf16* keys = (const bf16*)(ws + WS_KEYS) + (size_t)L * PH * 2 * 128 * 128; \
            int slot = 0; \
            for (int rep_ = 0; rep_ < REP_TK; ++rep_) { slot = 0; \
            for (int ui = 0; ; ++ui) {        \
                const int upk = static_unit(T / 256, DM / 256, G, bx, ui); if (upk < 0) break; \
                const int h = upk & 0xffff, tblk = upk >> 16; \
                __syncthreads(); \
                topk_fill(lds, keys, h, tid); \
                __syncthreads(); \
                topk_unit((const bf16*)(ws + WS_Q), lds, (int*)(ws + WS_EI), (float*)(ws + WS_GW), tblk * 256 + wave * 32, h, lane); \
                slot += 16; \
            } } \
        } \
        SEAM(ptk); \
        if (IN(ppa)) { FRESH_IDS(); \
            const int xv = bx & 7; \
            peer_a_slice<8>((const bf16*)(ws + WS_XB), (const int*)(ws + WS_EI), (const unsigned char*)(ws + (L ? WS_U1 : WS_U0)), (float*)(ws + WS_PD), xv, (unsigned*)(ws + WS_BCTR) + (L * 2 + 0) * 512 + xv * 64, T / 8, lane); \
        } \
        SEAM(ppa); \
        if (IN(ppw)) { FRESH_IDS(); \
            const int gw = bx * NWAVES + wave, NGW = G * NWAVES; \
            for (int t = gw; t < T; t += NGW) peer_a2_token((const float*)(ws + WS_PD), (const float*)(ws + (L ? WS_SSQ_C : WS_SSQ_A)), (const int*)(ws + WS_EI), (const float*)(ws + WS_SU) + L * 32768, (const float*)(ws + WS_SV) + L * 32768, (float*)(ws + WS_GW), (float*)(ws + WS_W1), t, lane); \
        } \
        SEAM(ppw); \
        if (IN(ppb)) { FRESH_IDS(); \
            const int xv = bx & 7; \
            peer_b_slice<4>(a.out, (const int*)(ws + WS_EI), (const float*)(ws + ((xv < 4) ? WS_GW : WS_W1)), (const unsigned char*)(ws + (L ? WS_V1 : WS_V0)), L ? (bf16*)nullptr : (bf16*)(ws + WS_XB), (float*)(ws + (L ? WS_SSQ_D : WS_SSQ_B)), xv, (unsigned*)(ws + WS_BCTR) + (L * 2 + 1) * 512 + xv * 64, T / 4, lane); \
        } \
    } while (0)
    float oscale = 1.f;
    PEER_LAYER(0);
    SEAM(PH_PB0);
    for (int rep_ = 0; rep_ < REP_GEMM; ++rep_)
    if (IN(PH_QKV)) { FRESH_IDS();
        {
            pg8::Gemm g{(const pg8::bf16_t*)(ws + WS_XB), (const pg8::bf16_t*)(ws + WS_WQKV), T, 2560, DM}; pg8::StaticOrder S; S.init(T, 2560, G, bx);
            pg8::EpiQK E{(pg8::bf16_t*)(ws + WS_QB), (pg8::bf16_t*)(ws + WS_KB), (const float*)(ws + WS_SSQ_B), (const float*)(ws + WS_ROPE), 0.125f * 1.4426950408889634f};
            pg8::gemm_phase<pg8::EpiQK, pg8::StaticOrder, true, true>(lds, g, S, E);
        }
        if (bx >= G / 2) {
            pg8::Gemm g{(const pg8::bf16_t*)(ws + WS_WQKV) + (size_t)2560 * DM, (const pg8::bf16_t*)(ws + WS_XB), 512, T, DM}; pg8::StaticOrder S; S.init(512, T, G / 2, bx - G / 2);
            pg8::EpiVt E{(pg8::bf16_t*)(ws + WS_VT), (const float*)(ws + WS_SSQ_B)};
            pg8::gemm_phase<pg8::EpiVt, pg8::StaticOrder, true, true>(lds, g, S, E);
        }
    }
    SEAM(PH_QKV);
    for (int rep_ = 0; rep_ < REP_ATT; ++rep_)
    if (IN(PH_ATT)) { FRESH_IDS();
        for (int vb = bx; vb < 256; vb += G) {
            const int bkv = vb >> 3, chunk = vb & 7, b = bkv >> 3, kvh = bkv & 7;
            for (int i = 0; i < 8; ++i) {
                const int qu = (chunk * 8 + i) * 64;
                __syncthreads();
                attn_fill(lds, (const bf16*)(ws + WS_KB), (const bf16*)(ws + WS_VT), b, kvh, qu - 128, tid);
                __syncthreads();
                attn_task(lds, (const bf16*)(ws + WS_QB), (bf16*)(ws + WS_O), a.in[6], b, kvh * 4 + (wave & 3), qu + (wave >> 2) * 32, qu - 128, lane);
            }
        }
    }
    SEAM(PH_ATT);
    if (IN(PH_WO)) { FRESH_IDS();
        pg8::Gemm g{(const pg8::bf16_t*)(ws + WS_O), (const pg8::bf16_t*)(ws + WS_WOA), T, DM, DM}; pg8::StaticOrder S; S.init(T, DM, G, bx);
        pg8::EpiRes E{a.out, a.out, (pg8::bf16_t*)(ws + WS_XB), (float*)(ws + WS_SSQ_C)};
        pg8::gemm_phase<pg8::EpiRes, pg8::StaticOrder, true, true>(lds, g, S, E);
    }
    SEAM(PH_WO);
#ifdef DIAG_A
    { const unsigned long long* st = (const unsigned long long*)(ws + WS_STAMP); oscale = 1.f + sqrtf((float)(st[DIAG_B] - st[DIAG_A]) * 1e-6f); }
#endif
    PEER_LAYER(1);
#undef PEER_LAYER
    SEAM(PH_PB1);
    if (IN(PH_FIN)) { FRESH_IDS();
        const int gw = bx * NWAVES + wave, NGW = G * NWAVES;
        for (int t = gw; t < T; t += NGW) final_norm_row(a.out, (const float*)(ws + WS_SSQ_D), a.in[11], t, lane, oscale);
    }
#undef SEAM
#undef IN
}

#ifndef N_LAUNCHES
#define N_LAUNCHES 1
#endif
extern "C" void kernel_launch(void* const* d_in, const int* in_sizes, int n_in, void* d_out, int out_size, void* d_ws, size_t ws_size, hipStream_t stream) {
    static int grid = 0;
    if (!grid) {
        if (hipFuncSetAttribute((const void*)mega, hipFuncAttributeMaxDynamicSharedMemorySize, LDS_BYTES) != hipSuccess) { fprintf(stderr, "hipFuncSetAttribute failed\n"); }
        int dev = 0, cus = 0, per_cu = 0;
        (void)hipGetDevice(&dev);
        (void)hipDeviceGetAttribute(&cus, hipDeviceAttributeMultiprocessorCount, dev);
        if (hipOccupancyMaxActiveBlocksPerMultiprocessor(&per_cu, (const void*)mega, NWAVES * 64, LDS_BYTES) != hipSuccess) per_cu = 0;
        (void)hipGetLastError();
        grid = cus * per_cu;
        if (grid > 256) grid = 256;
        grid &= ~1;
        if (grid < 2) { fprintf(stderr, "occupancy query gave %d x %d\n", cus, per_cu); grid = -1; }
    }
    if (grid < 0) return;
    if (ws_size < 700 * MiB) { fprintf(stderr, "ws too small: %zu\n", ws_size); return; }
    (void)hipMemsetAsync((char*)d_ws + WS_CTL, 0, CTL_BYTES, stream);
    Args a{};
    for (int i = 0; i < 12; ++i) a.in[i] = (const float*)d_in[i];
    a.out = (float*)d_out; a.ws = (unsigned char*)d_ws;
    if (N_LAUNCHES == 1) {
        a.ph_lo = 0; a.ph_hi = PH_END;
        void* args[] = {&a};
        const hipError_t e = hipLaunchCooperativeKernel((const void*)mega, dim3(grid), dim3(NWAVES * 64), args, LDS_BYTES, stream);
        if (e != hipSuccess) fprintf(stderr, "cooperative launch failed: %s (grid %d)\n", hipGetErrorString(e), grid);
    } else {
        for (int ph = 0; ph < PH_END; ++ph) {
            a.ph_lo = ph; a.ph_hi = ph + 1;
            hipLaunchKernelGGL(mega, dim3(grid), dim3(NWAVES * 64), LDS_BYTES, stream, a);
        }
    }
}
```

```cpp
#include <hip/hip_runtime.h>
#include <hip/hip_cooperative_groups.h>
namespace cg = cooperative_groups;
#include <cstdio>
#include <cstdint>
#include <cmath>

constexpr int DM = 2048, NB = 4, SEQ = 4096, T = NB * SEQ;
constexpr int FG = 8, FW = 256;
constexpr int HD = 64, NQH = 32, NKVH = 8, QKVW = 3072;
constexpr int PH = 8, NKEYS = 128, NEXP = 16384, PTOPK = 16;
constexpr float EPS = 1e-6f;
namespace pg8 {
#define PG8_LAS __attribute__((address_space(3)))
typedef unsigned short bf16_t;
typedef short bf16x8 __attribute__((ext_vector_type(8)));
typedef float f32x4 __attribute__((ext_vector_type(4)));
typedef unsigned u32x4 __attribute__((ext_vector_type(4)));
constexpr int BM = 256, BK = 64, HALF = 128, HTB = HALF * BK * 2  , STAGE_BYTES = 8 * HTB, NXCD = 8, WGM = 8;

__host__ __device__ __forceinline__ int lds_byte(int r, int c) { const int st = (r >> 4) * 2 + (c >> 5), rr = r & 15, cc = c & 31, ob = rr * 64 + cc * 2; return st * 1024 + (ob ^ (((ob >> 9) & 1) << 5)); }
__host__ __device__ __forceinline__ void stage_rc(int b, int& R, int& C) { const int st = b / 1024, sb = b % 1024, swz = sb ^ (((sb >> 9) & 1) << 5); R = (st >> 1) * 16 + swz / 64; C = (st & 1) * 32 + (swz % 64) / 2; }
__host__ __device__ __forceinline__ int perm32(int rho) { const int n = rho >> 4, i = rho & 15; return 8 * (i >> 2) + 4 * n + (i & 3); }

struct Unit { int pm, pn; };
struct Gemm { const bf16_t* A; const bf16_t* Bt; int M, N, K; };

struct StaticOrder {
    int nM, nN, nwg, G, c;
    __host__ __device__ void init(int M, int N, int G_, int c_) { nM = M / BM; nN = N / BM; nwg = nM * nN; G = G_; c = c_; }
    __host__ __device__ bool next(int i, Unit& u) const {
        const long L = (long)i * G + c; if (L >= nwg) return false;
        int wgid = (int)L; { const int q = nwg / NXCD, r = nwg % NXCD, xcd = wgid % NXCD, off = wgid / NXCD; wgid = (xcd < r ? xcd * (q + 1) : r * (q + 1) + (xcd - r) * q) + off; }
        const int nig = WGM * nN, gid = wgid / nig, fm = gid * WGM, gsz = (nM - fm) < WGM ? (nM - fm) : WGM;
        u.pm = fm + ((wgid % nig) % gsz); u.pn = (wgid % nig) / gsz; return true;
    }
    __device__ __forceinline__ void a_ready(const Unit&) const {}
    __device__ __forceinline__ void done(const Unit&) const {}
};

__device__ __forceinline__ unsigned cvt_pk_bf16(float lo, float hi) { unsigned r; asm volatile("v_cvt_pk_bf16_f32 %0, %1, %2" : "=v"(r) : "v"(lo), "v"(hi)); return r; }
typedef float f32x2 __attribute__((ext_vector_type(2)));
__device__ __forceinline__ u32x4 pack8(const f32x4 v0, const f32x4 v1) { u32x4 w; w.x = cvt_pk_bf16(v0[0], v0[1]); w.y = cvt_pk_bf16(v0[2], v0[3]); w.z = cvt_pk_bf16(v1[0], v1[1]); w.w = cvt_pk_bf16(v1[2], v1[3]); return w; }
struct EpiZt {
    static constexpr bool PERM = true, AFTER_DRAIN = false; bf16_t* Zp;
    __device__ __forceinline__ void operator()(const f32x4 (&acc)[2][2][4][2], const Unit& u, int wr, int wc, int fr, int fq) const {
        const int part = u.pm, bgs2 = u.pn;
        bf16_t* base = Zp + ((size_t)(bgs2 * 256 + wr * 64 + fr) * 512 + part * 256 + wc * 32 + 8 * fq);
#pragma unroll
        for (int ai = 0; ai < 2; ++ai)
#pragma unroll
            for (int m = 0; m < 4; ++m)
#pragma unroll
                for (int bj = 0; bj < 2; ++bj) *(u32x4*)(base + (ai * HALF + m * 16) * 512 + bj * HALF) = pack8(acc[ai][bj][m][0], acc[ai][bj][m][1]);
    }
};
struct EpiY {
    static constexpr bool PERM = true, AFTER_DRAIN = false; bf16_t* Y;
    __device__ __forceinline__ void operator()(const f32x4 (&acc)[2][2][4][2], const Unit& u, int wr, int wc, int fr, int fq) const {
        const int bg = u.pn >> 4, k2 = u.pn & 15, b = bg >> 3, g = bg & 7;
        bf16_t* base = Y + ((size_t)(b * 4096 + (wr * 64 + fr) * 16 + k2) * 2048 + g * 256 + wc * 32 + 8 * fq);
#pragma unroll
        for (int ai = 0; ai < 2; ++ai)
#pragma unroll
            for (int m = 0; m < 4; ++m)
#pragma unroll
                for (int bj = 0; bj < 2; ++bj) *(u32x4*)(base + (size_t)(ai * HALF + m * 16) * 16 * 2048 + bj * HALF) = pack8(acc[ai][bj][m][0], acc[ai][bj][m][1]);
    }
};
struct EpiRes {
    static constexpr bool PERM = true, AFTER_DRAIN = false; const float* R; float* out; bf16_t* xb; float* ssq;
    __device__ __forceinline__ void operator()(const f32x4 (&acc)[2][2][4][2], const Unit& u, int wr, int wc, int fr, int fq) const {
        const int row0 = u.pm * BM + wr * 64 + fr; const size_t off0 = (size_t)row0 * 2048 + u.pn * BM + wc * 32 + 8 * fq;
        const float* Rb = R + off0; bf16_t* Xb = xb + off0; float* Sb = ssq + row0;
#pragma unroll
        for (int ai = 0; ai < 2; ++ai)
#pragma unroll
            for (int m = 0; m < 4; ++m) { const int ro = (ai * HALF + m * 16) * 2048; float ss = 0.f;
#pragma unroll
                for (int bj = 0; bj < 2; ++bj) {
                    const f32x4 r0 = *(const f32x4*)(Rb + ro + bj * HALF), r1 = *(const f32x4*)(Rb + ro + bj * HALF + 4);
                    const f32x4 o0 = acc[ai][bj][m][0] + r0, o1 = acc[ai][bj][m][1] + r1;
                    *(u32x4*)(Xb + ro + bj * HALF) = pack8(o0, o1);
                    ss += (o0[0] * o0[0] + o0[1] * o0[1]) + (o0[2] * o0[2] + o0[3] * o0[3]) + (o1[0] * o1[0] + o1[1] * o1[1]) + (o1[2] * o1[2] + o1[3] * o1[3]); }
                ss += __shfl_xor(ss, 16); ss += __shfl_xor(ss, 32);
                if (fq == 0) unsafeAtomicAdd(Sb + ai * HALF + m * 16, ss);
                asm volatile("" ::: "memory"); }
    }
};
struct EpiScale {
    static constexpr bool PERM = true, AFTER_DRAIN = false; bf16_t* O; const float* ssq;
    __device__ __forceinline__ void operator()(const f32x4 (&acc)[2][2][4][2], const Unit& u, int wr, int wc, int fr, int fq) const {
        const int row0 = u.pm * BM + wr * 64 + fr;
        bf16_t* base = O + ((size_t)row0 * 2048 + u.pn * BM + wc * 32 + 8 * fq); const float* Sb = ssq + row0;
#pragma unroll
        for (int ai = 0; ai < 2; ++ai)
#pragma unroll
            for (int m = 0; m < 4; ++m) { const float rs = rsqrtf(Sb[ai * HALF + m * 16] * (1.f / 2048.f) + 1e-6f);
#pragma unroll
                for (int bj = 0; bj < 2; ++bj) *(u32x4*)(base + (ai * HALF + m * 16) * 2048 + bj * HALF) = pack8(acc[ai][bj][m][0] * rs, acc[ai][bj][m][1] * rs); }
    }
};
struct EpiQK {
    static constexpr bool PERM = true, AFTER_DRAIN = false; bf16_t* Q; bf16_t* K; const float* ssq; const float* rope; float qscale;
    __device__ __forceinline__ void operator()(const f32x4 (&acc)[2][2][4][2], const Unit& u, int wr, int wc, int fr, int fq) const {
        const int row0 = u.pm * BM + wr * 64 + fr; const bool isq = u.pn < 8;
        const int cl = wc * 32 + 8 * fq;
        bf16_t* base = isq ? (Q + ((size_t)row0 * 2048 + u.pn * BM + cl)) : (K + ((size_t)row0 * 512 + (u.pn - 8) * BM + cl));
        const int ld = isq ? 2048 : 512; const float sc = isq ? qscale : 1.f;
        const float* rp = rope + (size_t)(row0 & 4095) * 64 + (cl & 63);
        const float* Sb = ssq + row0;
#pragma unroll
        for (int ai = 0; ai < 2; ++ai)
#pragma unroll
            for (int m = 0; m < 4; ++m) { const int ro = ai * HALF + m * 16; const float rs = rsqrtf(Sb[ro] * (1.f / 2048.f) + 1e-6f) * sc;
                const f32x4 t0 = *(const f32x4*)(rp + (size_t)ro * 64), t1 = *(const f32x4*)(rp + (size_t)ro * 64 + 4);
#pragma unroll
                for (int bj = 0; bj < 2; ++bj) {
                    const f32x4 a = acc[ai][bj][m][0] * rs, b = acc[ai][bj][m][1] * rs; f32x4 oa, ob;
                    oa[0] = a[0] * t0[0] - a[1] * t0[1]; oa[1] = a[1] * t0[0] + a[0] * t0[1]; oa[2] = a[2] * t0[2] - a[3] * t0[3]; oa[3] = a[3] * t0[2] + a[2] * t0[3];
                    ob[0] = b[0] * t1[0] - b[1] * t1[1]; ob[1] = b[1] * t1[0] + b[0] * t1[1]; ob[2] = b[2] * t1[2] - b[3] * t1[3]; ob[3] = b[3] * t1[2] + b[2] * t1[3];
                    *(u32x4*)(base + (size_t)ro * ld + bj * HALF) = pack8(oa, ob); } }
    }
};
struct EpiVt {
    static constexpr bool PERM = true, AFTER_DRAIN = false; bf16_t* Vt; const float* ssq;
    __device__ __forceinline__ void operator()(const f32x4 (&acc)[2][2][4][2], const Unit& u, int wr, int wc, int fr, int fq) const {
        const int col0 = u.pn * BM + wc * 32 + 8 * fq;
        bf16_t* base = Vt + ((size_t)(u.pm * BM + wr * 64 + fr) * 16384 + col0);
        f32x4 r0[2], r1[2];
#pragma unroll
        for (int bj = 0; bj < 2; ++bj) { const f32x4 s0 = *(const f32x4*)(ssq + col0 + bj * HALF), s1 = *(const f32x4*)(ssq + col0 + bj * HALF + 4);
#pragma unroll
            for (int q = 0; q < 4; ++q) { r0[bj][q] = rsqrtf(s0[q] * (1.f / 2048.f) + 1e-6f); r1[bj][q] = rsqrtf(s1[q] * (1.f / 2048.f) + 1e-6f); } }
#pragma unroll
        for (int ai = 0; ai < 2; ++ai)
#pragma unroll
            for (int m = 0; m < 4; ++m)
#pragma unroll
                for (int bj = 0; bj < 2; ++bj) *(u32x4*)(base + (size_t)(ai * HALF + m * 16) * 16384 + bj * HALF) = pack8(acc[ai][bj][m][0] * r0[bj], acc[ai][bj][m][1] * r1[bj]);
    }
};
template <class Epi, class Sched, bool ALIGN_EPI = false, bool SP2 = false>
__device__ __forceinline__ void gemm_phase(PG8_LAS unsigned char* lds, const Gemm g, const Sched& S, const Epi& E) {
    const int tid = threadIdx.x, wid = __builtin_amdgcn_readfirstlane(tid >> 6), lane = tid & 63, wr = wid >> 2, wc = wid & 3, fr = lane & 15, fq = lane >> 4;
    const int K = g.K, nt = K / BK;
    unsigned voffA[2], voffB[2];
#pragma unroll
    for (int i = 0; i < 2; ++i) { int R, C; stage_rc(tid * 16 + i * 8192, R, C); const int Rb = Epi::PERM ? ((R & ~31) + perm32(R & 31)) : R;
        voffA[i] = (unsigned)(R * K + C) * 2u; voffB[i] = (unsigned)(Rb * K + C) * 2u; }
    const size_t kstep = (size_t)(BK * 2);
    const size_t hstep = (size_t)HALF * K * 2;
    const size_t tstep = 2 * hstep;
    const unsigned ldsw = (unsigned)wid * 1024u;
    const int aoff = lds_byte(wr * 64 + fr, fq * 8), boff = lds_byte(wc * 32 + fr, fq * 8);
#define PG8_SA(b, h) (((b) * 2 + (h)) * HTB)
#define PG8_SB(b, h) ((4 + (b) * 2 + (h)) * HTB)
#define PG8_STAGE(bufoff, gbase, voff) do { _Pragma("unroll") for (int _i = 0; _i < 2; ++_i) \
        __builtin_amdgcn_global_load_lds((const unsigned*)((const char*)(gbase) + (voff)[_i]), (PG8_LAS unsigned*)(lds + (bufoff) + ldsw + _i * 8192), 16, 0, 0); } while (0)
#define PG8_LDA(dst, b, h) do { _Pragma("unroll") for (int m = 0; m < 4; ++m) _Pragma("unroll") for (int k = 0; k < 2; ++k) dst[m][k] = *(const PG8_LAS bf16x8*)(lds + PG8_SA(b, h) + aoff + m * 2048 + k * 1024); } while (0)
#define PG8_LDB(dst, b, h) do { _Pragma("unroll") for (int n = 0; n < 2; ++n) _Pragma("unroll") for (int k = 0; k < 2; ++k) dst[n][k] = *(const PG8_LAS bf16x8*)(lds + PG8_SB(b, h) + boff + n * 2048 + k * 1024); } while (0)
#define PG8_MMA(ai, bj, At, Bt) do { __builtin_amdgcn_s_setprio(1); _Pragma("unroll") for (int m = 0; m < 4; ++m) _Pragma("unroll") for (int n = 0; n < 2; ++n) _Pragma("unroll") for (int k = 0; k < 2; ++k) \
        acc[ai][bj][m][n] = __builtin_amdgcn_mfma_f32_16x16x32_bf16(Bt[n][k], At[m][k], acc[ai][bj][m][n], 0, 0, 0); __builtin_amdgcn_s_setprio(0); } while (0)
#define PG8_WAIT_V(n) asm volatile("s_waitcnt vmcnt(" #n ")" ::: "memory")
#define PG8_WAIT_L(n) asm volatile("s_waitcnt lgkmcnt(" #n ")" ::: "memory")
#define PG8_BAR __builtin_amdgcn_s_barrier()
#define PG8_SCHED __builtin_amdgcn_sched_barrier(0)
    Unit cur, nxt; int ui = 0;
    if (!S.next(0, cur)) return;
    f32x4 acc[2][2][4][2];
#pragma unroll
    for (int a = 0; a < 2; ++a)
#pragma unroll
        for (int b = 0; b < 2; ++b)
#pragma unroll
            for (int m = 0; m < 4; ++m)
#pragma unroll
                for (int n = 0; n < 2; ++n) acc[a][b][m][n] = (f32x4){0.f, 0.f, 0.f, 0.f};
    bf16x8 At[4][2], B0[2][2], B1[2][2];
    const char* cA = (const char*)g.A + (size_t)cur.pm * tstep; const char* cB = (const char*)g.Bt + (size_t)cur.pn * tstep;
    S.a_ready(cur);
    if constexpr (SP2) {
        PG8_STAGE(PG8_SB(0, 0), cB, voffB); PG8_STAGE(PG8_SB(0, 1), cB + hstep, voffB); PG8_STAGE(PG8_SA(0, 0), cA, voffA); PG8_STAGE(PG8_SA(0, 1), cA + hstep, voffA);
        if (wr == 1) PG8_BAR;
        PG8_WAIT_V(2); PG8_BAR;
        PG8_STAGE(PG8_SB(1, 0), cB + kstep, voffB); PG8_STAGE(PG8_SA(1, 0), cA + kstep, voffA); PG8_STAGE(PG8_SB(1, 1), cB + hstep + kstep, voffB);
        PG8_WAIT_V(6); PG8_BAR;
    } else {
        PG8_STAGE(PG8_SB(0, 0), cB, voffB); PG8_STAGE(PG8_SA(0, 0), cA, voffA); PG8_STAGE(PG8_SB(0, 1), cB + hstep, voffB); PG8_STAGE(PG8_SA(0, 1), cA + hstep, voffA);
        if (wr == 1) PG8_BAR;
        PG8_WAIT_V(4); PG8_BAR;
        PG8_STAGE(PG8_SB(1, 0), cB + kstep, voffB); PG8_STAGE(PG8_SA(1, 0), cA + kstep, voffA); PG8_STAGE(PG8_SB(1, 1), cB + hstep + kstep, voffB);
        PG8_WAIT_V(6); PG8_BAR;
    }
    for (;;) {
        const bool has_next = S.next(ui + 1, nxt);
        const char* nA = has_next ? (const char*)g.A + (size_t)nxt.pm * tstep : cA; const char* nB = has_next ? (const char*)g.Bt + (size_t)nxt.pn * tstep : cB;
        for (int t = 0; t < nt; t += 2) {
            const bool last = (t == nt - 2);
            const char* a1 = cA + (size_t)(t + 1) * kstep;
            const char* a2 = last ? nA : cA + (size_t)(t + 2) * kstep; const char* b2 = last ? nB : cB + (size_t)(t + 2) * kstep;
            const char* a3 = a2 + kstep; const char* b3 = b2 + kstep;
            if (last && has_next) S.a_ready(nxt);
            if constexpr (SP2) {
            PG8_LDB(B0, 0, 0); PG8_LDB(B1, 0, 1); PG8_SCHED; PG8_LDA(At, 0, 0); PG8_STAGE(PG8_SA(1, 1), a1 + hstep, voffA);
            PG8_WAIT_V(8); PG8_WAIT_L(0); PG8_BAR; PG8_MMA(0, 0, At, B0); PG8_MMA(0, 1, At, B1); PG8_BAR; PG8_SCHED;
            PG8_LDA(At, 0, 1); PG8_STAGE(PG8_SB(0, 0), b2, voffB); PG8_STAGE(PG8_SB(0, 1), b2 + hstep, voffB); PG8_STAGE(PG8_SA(0, 0), a2, voffA);
            PG8_WAIT_V(8); PG8_WAIT_L(0); PG8_BAR; PG8_MMA(1, 0, At, B0); PG8_MMA(1, 1, At, B1); PG8_BAR; PG8_SCHED;
            PG8_LDB(B0, 1, 0); PG8_LDB(B1, 1, 1); PG8_SCHED; PG8_LDA(At, 1, 0); PG8_STAGE(PG8_SA(0, 1), a2 + hstep, voffA);
            PG8_WAIT_V(8); PG8_WAIT_L(0); PG8_BAR; PG8_MMA(0, 0, At, B0); PG8_MMA(0, 1, At, B1); PG8_BAR; PG8_SCHED;
            PG8_LDA(At, 1, 1); PG8_STAGE(PG8_SB(1, 0), b3, voffB); PG8_STAGE(PG8_SB(1, 1), b3 + hstep, voffB); PG8_STAGE(PG8_SA(1, 0), a3, voffA);
            PG8_WAIT_V(8); PG8_WAIT_L(0); PG8_BAR; PG8_MMA(1, 0, At, B0); PG8_MMA(1, 1, At, B1); PG8_BAR; PG8_SCHED;
            } else {
            PG8_LDB(B0, 0, 0); PG8_SCHED; PG8_LDA(At, 0, 0); PG8_STAGE(PG8_SA(1, 1), a1 + hstep, voffA);
            PG8_WAIT_L(8); PG8_BAR; PG8_WAIT_L(0); PG8_MMA(0, 0, At, B0); PG8_BAR; PG8_SCHED;
            PG8_LDB(B1, 0, 1); PG8_STAGE(PG8_SB(0, 0), b2, voffB);
            PG8_BAR; PG8_WAIT_L(0); PG8_MMA(0, 1, At, B1); PG8_BAR;
            PG8_LDA(At, 0, 1); PG8_STAGE(PG8_SA(0, 0), a2, voffA);
            PG8_BAR; PG8_WAIT_L(0); PG8_MMA(1, 0, At, B0); PG8_BAR; PG8_SCHED;
            PG8_STAGE(PG8_SB(0, 1), b2 + hstep, voffB);
            PG8_WAIT_V(6); PG8_BAR; PG8_MMA(1, 1, At, B1); PG8_BAR;
            PG8_LDB(B0, 1, 0); PG8_SCHED; PG8_LDA(At, 1, 0); PG8_STAGE(PG8_SA(0, 1), a2 + hstep, voffA);
            PG8_WAIT_L(8); PG8_BAR; PG8_WAIT_L(0); PG8_MMA(0, 0, At, B0); PG8_BAR; PG8_SCHED;
            PG8_LDB(B1, 1, 1); PG8_STAGE(PG8_SB(1, 0), b3, voffB);
            PG8_BAR; PG8_WAIT_L(0); PG8_MMA(0, 1, At, B1); PG8_BAR;
            PG8_LDA(At, 1, 1); PG8_STAGE(PG8_SA(1, 0), a3, voffA);
            PG8_BAR; PG8_WAIT_L(0); PG8_MMA(1, 0, At, B0); PG8_BAR; PG8_SCHED;
            PG8_STAGE(PG8_SB(1, 1), b3 + hstep, voffB);
            PG8_WAIT_V(6); PG8_BAR; PG8_MMA(1, 1, At, B1); PG8_BAR;
            }
        }
        if constexpr (ALIGN_EPI) { if (wr == 0) PG8_BAR; }
        if constexpr (!Epi::AFTER_DRAIN) { E(acc, cur, wr, wc, fr, fq); S.done(cur); }
        if (!has_next) break;
#pragma unroll
        for (int a = 0; a < 2; ++a)
#pragma unroll
            for (int b = 0; b < 2; ++b)
#pragma unroll
                for (int m = 0; m < 4; ++m)
#pragma unroll
                    for (int n = 0; n < 2; ++n) acc[a][b][m][n] = (f32x4){0.f, 0.f, 0.f, 0.f};
        cur = nxt; cA = nA; cB = nB; ++ui;
        if constexpr (ALIGN_EPI) { if (wr == 1) PG8_BAR; }
    }
    PG8_WAIT_V(0);
    if constexpr (!ALIGN_EPI) { if (wr == 0) PG8_BAR; }
    PG8_BAR;
    if constexpr (Epi::AFTER_DRAIN) { E.fused(acc, cur, wr, wc, fr, fq, lds, wid, lane); S.done(cur); }
#undef PG8_SA
#undef PG8_SB
#undef PG8_STAGE
#undef PG8_LDA
#undef PG8_LDB
#undef PG8_MMA
#undef PG8_WAIT_V
#undef PG8_WAIT_L
#undef PG8_BAR
#undef PG8_SCHED
}
}
#define GAS __attribute__((address_space(1)))
#define LAS __attribute__((address_space(3)))
typedef unsigned short bf16;
typedef unsigned v4u __attribute__((ext_vector_type(4)));
typedef unsigned v2u __attribute__((ext_vector_type(2)));
typedef float f32x4 __attribute__((ext_vector_type(4)));
constexpr int NWAVES = 8;
constexpr int LDS_BYTES = 147456, LDSCTL_OFF = 131072;
constexpr int CW_BAR = 4096;
constexpr size_t MiB = 1u << 20;
constexpr size_t WS_CTL = 0, CTL_BYTES = 1 * MiB;
constexpr size_t WS_SSQ_A = 256 * 1024, WS_SSQ_B = 320 * 1024, WS_SSQ_C = 384 * 1024, WS_SSQ_D = 448 * 1024;
constexpr size_t WS_STAMP = 128 * 1024;
constexpr size_t WS_BCTR = 192 * 1024;
constexpr size_t WS_SU = 512 * 1024, WS_SV = 768 * 1024;
constexpr size_t WS_WCS = 1 * MiB, WS_ROPE = 2 * MiB, WS_KEYS = 3 * MiB;
constexpr size_t WS_WOF = 8 * MiB, WS_WQKV = 16 * MiB, WS_WOA = 28 * MiB, WS_WQ0 = 36 * MiB, WS_WQ1 = 44 * MiB;
constexpr size_t WS_A2 = 64 * MiB, WS_TW = 65 * MiB;
constexpr size_t WS_U0 = 128 * MiB, WS_V0 = 192 * MiB, WS_U1 = 256 * MiB, WS_V1 = 320 * MiB;
constexpr size_t WS_XG = 384 * MiB, WS_XB = 384 * MiB;
constexpr size_t WS_ZT = 448 * MiB;
constexpr size_t WS_Y = 576 * MiB;
constexpr size_t WS_Q = 448 * MiB;
constexpr size_t WS_EI = 640 * MiB, WS_GW = 648 * MiB, WS_W1 = 656 * MiB;
constexpr size_t WS_PD = 448 * MiB;
constexpr size_t WS_QB = 448 * MiB, WS_KB = 512 * MiB, WS_VT = 528 * MiB, WS_O = 576 * MiB;

__device__ __forceinline__ unsigned f2bf(float f) { unsigned u = __builtin_bit_cast(unsigned, f); return (u + 0x7fffu + ((u >> 16) & 1u)) >> 16; }
__device__ __forceinline__ unsigned pk2(float lo, float hi) { return f2bf(lo) | (f2bf(hi) << 16); }

struct Args { const float* in[12]; float* out; unsigned char* ws; int ph_lo, ph_hi; };

__device__ __forceinline__ int qkv_row(int n) { if (n >= 2560) return n; const int d = n & 63, pc = (d < 32) ? 2 * d : 2 * (d - 32) + 1; return (n & ~63) + pc; }
template <int MODE>
__device__ __forceinline__ void transpose_item(const float* W, int K, int N, const float* gain, bf16* WT, LAS float* scr, int item, int lane) {
    const int nblk = N / 32, kb = item / nblk, nb = item % nblk, k0 = 64 * kb, n0 = 32 * nb;
#pragma unroll 8
    for (int i = 0; i < 32; ++i) { const int kk = 2 * i + (lane >> 5); float v = W[(size_t)(k0 + kk) * N + n0 + (lane & 31)]; if (gain) v *= gain[k0 + kk]; scr[kk * 33 + (lane & 31)] = v; }
    asm volatile("s_waitcnt lgkmcnt(0)" ::: "memory");
    const int c = lane & 7;
#pragma unroll
    for (int j = 0; j < 4; ++j) { const int n = (lane >> 3) + 8 * j; const LAS float* s = scr + (8 * c) * 33 + n;
        v4u o; o.x = pk2(s[0 * 33], s[1 * 33]); o.y = pk2(s[2 * 33], s[3 * 33]); o.z = pk2(s[4 * 33], s[5 * 33]); o.w = pk2(s[6 * 33], s[7 * 33]);
        const int row = (MODE == 1) ? qkv_row(n0 + n) : (n0 + n);
        *(v4u*)(WT + (size_t)row * K + k0 + 8 * c) = o; }
    asm volatile("s_waitcnt lgkmcnt(0)" ::: "memory");
}
__device__ __forceinline__ float wsum(float v) {
#pragma unroll
    for (int o = 1; o < 64; o <<= 1) v += __shfl_xor(v, o);
    return v;
}
__device__ __forceinline__ void cvt_stream(const float* src, bf16* dst, size_t n8, size_t gtid, size_t ngt) {
    for (size_t i = gtid; i < n8; i += ngt) {
        const f32x4 a = *(const f32x4*)(src + i * 8), b = *(const f32x4*)(src + i * 8 + 4);
        v4u o; o.x = pk2(a[0], a[1]); o.y = pk2(a[2], a[3]); o.z = pk2(b[0], b[1]); o.w = pk2(b[2], b[3]);
        *(v4u*)(dst + i * 8) = o;
    }
}
__device__ __forceinline__ void cvt_stream8(const float* src, unsigned char* dst, size_t n16, size_t gtid, size_t ngt, float scale) {
    for (size_t i = gtid; i < n16; i += ngt) {
        v4u o;
#pragma unroll
        for (int q = 0; q < 4; ++q) { f32x4 a = *(const f32x4*)(src + i * 16 + 4 * q) * scale;
#pragma unroll
            for (int e = 0; e < 4; ++e) a[e] = fminf(fmaxf(a[e], -448.f), 448.f);
            int w = 0; w = __builtin_amdgcn_cvt_pk_fp8_f32(a[0], a[1], w, false); w = __builtin_amdgcn_cvt_pk_fp8_f32(a[2], a[3], w, true); o[q] = (unsigned)w; }
        const size_t e = i >> 7, r = i & 127, sl = r >> 3, c8 = r & 7;
        *(v4u*)(dst + ((sl * 16384 + e) * 128 + c8 * 16)) = o;
    }
}
#define XB_TMO      128
#define XB_XCNT(j)  (256  + 64 * (j))
#define XB_XSUB(j)  (1280 + 64 * (j))
#define XB_XGEN(j)  (2304 + 64 * (j))
#define XB_TOP      3328
#define XB_TOPGEN   3392
#define XCD_BAR_WORDS 3456
#define XB_SPIN_CAP (1u << 18)

__device__ __forceinline__ unsigned xb_ld(unsigned* p)              { return __hip_atomic_load(p, __ATOMIC_RELAXED, __HIP_MEMORY_SCOPE_AGENT); }
__device__ __forceinline__ unsigned xb_add(unsigned* p, unsigned v) { return __hip_atomic_fetch_add(p, v, __ATOMIC_RELAXED, __HIP_MEMORY_SCOPE_AGENT); }
__device__ __forceinline__ unsigned xb_xcc_id() { return (unsigned)__builtin_amdgcn_s_getreg((3 << 11) | 20) & 0xFu; }
#define XB_SPIN(cond, bar) do { unsigned _sp = 0; while (cond) { __builtin_amdgcn_s_sleep(1); \
    if ((++_sp & 255u) == 0u) { if (xb_ld(&(bar)[XB_TMO])) break; if (_sp > XB_SPIN_CAP) { atomicAdd(&(bar)[XB_TMO], 1u); break; } } } } while (0)

struct XcdBarrier {
    unsigned* bar; unsigned x;
    volatile LAS unsigned* st;
};

__device__ __forceinline__ XcdBarrier xcd_barrier_post(unsigned* bar, volatile LAS unsigned* st) {
    XcdBarrier b; b.bar = bar; b.x = xb_xcc_id(); b.st = st;
    if (threadIdx.x == 0) (void)xb_add(&bar[XB_XCNT(b.x)], 1u);
    return b;
}
__device__ __forceinline__ void xcd_barrier_complete(unsigned* bar, unsigned x, unsigned& nloc, unsigned& nx) {
    const unsigned G = gridDim.x * gridDim.y * gridDim.z;
    unsigned sum, cnt, mine, sp = 0u;
    for (;;) {
        sum = 0u; cnt = 0u; mine = 0u;
#pragma unroll
        for (unsigned j = 0; j < 16; ++j) { const unsigned c = xb_ld(&bar[XB_XCNT(j)]); sum += c; cnt += (c > 0u) ? 1u : 0u; mine = (j == x) ? c : mine; }
        if (sum == G) break;
        __builtin_amdgcn_s_sleep(1);
        if ((++sp & 255u) == 0u) { if (xb_ld(&bar[XB_TMO])) break; if (sp > XB_SPIN_CAP) { atomicAdd(&bar[XB_TMO], 1u); break; } }
    }
    nloc = mine > 0u ? mine : 1u; nx = cnt > 0u ? cnt : 1u;
}

__device__ __forceinline__ void xcd_barrier(const XcdBarrier& b) {
    asm volatile("s_waitcnt vmcnt(0)" ::: "memory");
    __syncthreads();
    if (threadIdx.x == 0) {
        unsigned* bar = b.bar;
        __builtin_amdgcn_s_waitcnt(0);
        unsigned nloc = b.st[0], nx = b.st[1];
        if (nloc == 0u) { xcd_barrier_complete(bar, b.x, nloc, nx); b.st[0] = nloc; b.st[1] = nx; }
        const unsigned old = xb_add(&bar[XB_XSUB(b.x)], 1u);
        const unsigned gen = old / nloc;
        if (old + 1u == (gen + 1u) * nloc) {
            __builtin_amdgcn_fence(__ATOMIC_RELEASE, "agent");
            asm volatile("s_waitcnt vmcnt(0)" ::: "memory");
            const unsigned og = xb_add(&bar[XB_TOP], 1u);
            const unsigned tg = og / nx;
            if (og + 1u == (tg + 1u) * nx) xb_add(&bar[XB_TOPGEN], 1u);
            else XB_SPIN(xb_ld(&bar[XB_TOPGEN]) == tg, bar);
            __builtin_amdgcn_fence(__ATOMIC_ACQUIRE, "agent");
            xb_add(&bar[XB_XGEN(b.x)], 1u);
            asm volatile("s_waitcnt vmcnt(0)" ::: "memory");
        } else {
            XB_SPIN(xb_ld(&bar[XB_XGEN(b.x)]) == gen, bar);
            __builtin_amdgcn_fence(__ATOMIC_ACQUIRE, "agent");
            asm volatile("s_waitcnt vmcnt(0)" ::: "memory");
        }
    }
    __syncthreads();
}
#define U_SCALE 1024.f
#define V_SCALE 256.f
typedef float f32x16 __attribute__((ext_vector_type(16)));
#ifndef TKB
#define TKB 2
#endif
typedef short s16x8 __attribute__((ext_vector_type(8)));
typedef __bf16 bf16x2_t __attribute__((ext_vector_type(2)));
__device__ __forceinline__ unsigned ordf(float f) { const unsigned u = __float_as_uint(f); return (u & 0x80000000u) ? ~u : (u | 0x80000000u); }
__device__ __forceinline__ float unordf(unsigned u) { return __uint_as_float((u & 0x80000000u) ? (u & 0x7fffffffu) : ~u); }
__device__ __forceinline__ unsigned umax_(unsigned a, unsigned b) { return a > b ? a : b; }
#define DPPU(v, ctrl) ((unsigned)__builtin_amdgcn_update_dpp(0, (int)(v), (ctrl), 0xf, 0xf, true))
#define DPPF(v, ctrl) __int_as_float(__builtin_amdgcn_update_dpp(0, __float_as_int(v), (ctrl), 0xf, 0xf, true))
__device__ __forceinline__ unsigned max32(unsigned v) {
    v = umax_(v, DPPU(v, 0xB1)); v = umax_(v, DPPU(v, 0x4E)); v = umax_(v, DPPU(v, 0x141)); v = umax_(v, DPPU(v, 0x140));
    const auto r = __builtin_amdgcn_permlane16_swap(v, v, false, false);
    return umax_(r[0], r[1]);
}
__device__ __forceinline__ float sum16(float v) {
    v += DPPF(v, 0xB1); v += DPPF(v, 0x4E); v += DPPF(v, 0x141); v += DPPF(v, 0x140); return v;
}
__device__ __forceinline__ unsigned bperm(unsigned v, int srclane) { return (unsigned)__builtin_amdgcn_ds_bpermute(srclane << 2, (int)v); }
#define CMPX(a_, b_) do { const unsigned hi_ = umax_(a_, b_), lo_ = (a_ < b_) ? a_ : b_; a_ = hi_; b_ = lo_; } while (0)
__device__ __forceinline__ unsigned max16(unsigned v) { v = umax_(v, DPPU(v, 0xB1)); v = umax_(v, DPPU(v, 0x4E)); v = umax_(v, DPPU(v, 0x141)); v = umax_(v, DPPU(v, 0x140)); return v; }
__device__ __forceinline__ unsigned top16_of8(unsigned (&p)[8], int c) {
    CMPX(p[0], p[1]); CMPX(p[2], p[3]); CMPX(p[4], p[5]); CMPX(p[6], p[7]);
    CMPX(p[0], p[2]); CMPX(p[1], p[3]); CMPX(p[4], p[6]); CMPX(p[5], p[7]);
    CMPX(p[1], p[2]); CMPX(p[5], p[6]); CMPX(p[0], p[4]); CMPX(p[3], p[7]);
    CMPX(p[1], p[5]); CMPX(p[2], p[6]);
    CMPX(p[1], p[4]); CMPX(p[3], p[6]);
    CMPX(p[2], p[4]); CMPX(p[3], p[5]);
    CMPX(p[3], p[4]);
    unsigned W = 0u;
    for (int it = 0; it < 16; ++it) {
        const unsigned m = max16(p[0]);
        W = (c == it) ? m : W;
        const bool win = (p[0] == m);
#pragma unroll
        for (int i = 0; i < 7; ++i) p[i] = win ? p[i + 1] : p[i];
        p[7] = win ? 0u : p[7];
    }
    return W;
}
__device__ __forceinline__ unsigned top16_of4r(unsigned (&p)[4], int c) {
    CMPX(p[0], p[1]); CMPX(p[2], p[3]); CMPX(p[0], p[2]); CMPX(p[1], p[3]); CMPX(p[1], p[2]);
    unsigned W = 0u;
    for (int it = 0; it < 16; ++it) {
        const unsigned m = max16(p[0]);
        W = (c == it) ? m : W;
        const bool win = (p[0] == m);
        p[0] = win ? p[1] : p[0]; p[1] = win ? p[2] : p[1]; p[2] = win ? p[3] : p[2]; p[3] = win ? 0u : p[3];
    }
    return W;
}
__device__ __forceinline__ void topk_fill(LAS unsigned char* lds, const bf16* keys, int h, int tid) {
#pragma unroll
    for (int i = 0; i < 8; ++i) { const int idx = tid + 512 * i, p = idx >> 11, key = (idx >> 4) & 127, ch = idx & 15;
        const v4u v = *(const v4u*)(keys + (size_t)((h * 2 + p) * 128 + key) * 128 + ch * 8);
        *(LAS v4u*)(lds + p * 32768 + key * 256 + ((ch ^ (key & 15)) << 4)) = v; }
}
struct CvtCtx { const float* srcU; long dsrc; const float* gain; unsigned char* dstU; long ddst; float* su; long dsc; int gwave, nw; };
__device__ __forceinline__ void cvt_chunk_load(const CvtCtx& cx, int c, int lane, f32x4 (&v)[4]) {
    const int r = c >> 1, hh = c & 1;
    const float* src = cx.srcU + ((r < 16384) ? 0L : cx.dsrc) + (size_t)(r & 16383) * 2048 + hh * 1024 + 4 * lane;
#pragma unroll
    for (int j = 0; j < 4; ++j) v[j] = *(const f32x4*)(src + 256 * j);
}
__device__ __forceinline__ void cvt_chunk_store(const CvtCtx& cx, int c, int lane, f32x4 (&v)[4]) {
    const int r = c >> 1, hh = c & 1; const bool isu = r < 16384; const int e = r & 16383;
    float mx = 0.f;
#pragma unroll
    for (int j = 0; j < 4; ++j) { if (isu) v[j] = v[j] * *(const f32x4*)(cx.gain + hh * 1024 + 256 * j + 4 * lane);
        mx = fmaxf(mx, fmaxf(fmaxf(fabsf(v[j][0]), fabsf(v[j][1])), fmaxf(fabsf(v[j][2]), fabsf(v[j][3])))); }
    mx = fmaxf(mx, DPPF(mx, 0xB1)); mx = fmaxf(mx, DPPF(mx, 0x4E)); mx = fmaxf(mx, DPPF(mx, 0x141)); mx = fmaxf(mx, DPPF(mx, 0x140));
    { const auto rr = __builtin_amdgcn_permlane16_swap(__float_as_uint(mx), __float_as_uint(mx), false, false); mx = fmaxf(__uint_as_float(rr[0]), __uint_as_float(rr[1])); }
    { const auto rr = __builtin_amdgcn_permlane32_swap(__float_as_uint(mx), __float_as_uint(mx), false, false); mx = fmaxf(__uint_as_float(rr[0]), __uint_as_float(rr[1])); }
    const float sc = fmaxf(mx, 1e-30f) * (1.f / 6.f), inv = 1.f / sc;
    if (lane == 0) (cx.su + (isu ? 0L : cx.dsc))[e * 2 + hh] = sc;
    unsigned char* dst = cx.dstU + (isu ? 0L : cx.ddst) + ((size_t)(hh * 4) * 16384 + e) * 128 + 2 * lane;
#pragma unroll
    for (int j = 0; j < 4; ++j) { unsigned w = 0u;
        w = __builtin_amdgcn_cvt_scalef32_pk_fp4_f32(w, v[j][0] * inv, v[j][1] * inv, 1.0f, 0); w = __builtin_amdgcn_cvt_scalef32_pk_fp4_f32(w, v[j][2] * inv, v[j][3] * inv, 1.0f, 1);
        *(unsigned short*)(dst + (size_t)j * (16384 * 128)) = (unsigned short)w; }
}
__device__ __forceinline__ void topk_unit(const bf16* q, LAS const unsigned char* lds, int* EI, float* GW, int t0, int h, int lane) {
    const int c = lane & 15, g4 = lane >> 4, rbase = lane & 48;
    int f0 = 0, f1 = 0, f2 = 0, f3 = 0;
    { int cnt = 0;
#pragma unroll
      for (int i = 0; i < 16; ++i)
#pragma unroll
        for (int j = 0; j < 16; ++j) if ((i + 1) * (j + 1) <= 16) { const int fl = i * 16 + j; f0 = (cnt == c) ? fl : f0; f1 = (cnt == c + 16) ? fl : f1; f2 = (cnt == c + 32) ? fl : f2; f3 = (cnt == c + 48) ? fl : f3; ++cnt; } }
    unsigned W[2][8];
#pragma unroll
    for (int p = 0; p < 2; ++p) {
        f32x4 acc[2][8];
#pragma unroll
        for (int mb = 0; mb < 2; ++mb)
#pragma unroll
            for (int kb = 0; kb < 8; ++kb) acc[mb][kb] = (f32x4){0.f, 0.f, 0.f, 0.f};
        const bf16* qp = q + (size_t)(t0 + c) * 2048 + h * 256 + p * 128 + g4 * 8;
        LAS const unsigned char* kp = lds + p * 32768 + c * 256;
        asm volatile("" : "+v"(qp));
#pragma unroll 2
        for (int ks = 0; ks < 4; ++ks) {
            const s16x8 a0 = *(const s16x8*)(qp + ks * 32), a1 = *(const s16x8*)(qp + (size_t)16 * 2048 + ks * 32);
#pragma unroll
            for (int kb = 0; kb < 8; ++kb) { const s16x8 b = *(LAS const s16x8*)(kp + kb * 4096 + (((4 * ks + g4) ^ c) << 4));
                acc[0][kb] = __builtin_amdgcn_mfma_f32_16x16x32_bf16(a0, b, acc[0][kb], 0, 0, 0); acc[1][kb] = __builtin_amdgcn_mfma_f32_16x16x32_bf16(a1, b, acc[1][kb], 0, 0, 0); }
        }
#pragma unroll
        for (int pb = 0; pb < 8; ++pb) {
            unsigned pk[8];
#pragma unroll
            for (int kb = 0; kb < 8; ++kb) pk[kb] = (ordf(acc[pb >> 2][kb][pb & 3]) & ~127u) | (unsigned)(127 - 16 * kb - c);
            W[p][pb] = top16_of8(pk, c);
        }
    }
#pragma unroll
    for (int pb = 0; pb < 8; ++pb) {
        const unsigned w0 = W[0][pb], w1 = W[1][pb];
        unsigned cp[4];
        { const float a0 = unordf(bperm(w0, rbase + (f0 >> 4)) & ~127u), b0 = unordf(bperm(w1, rbase + (f0 & 15)) & ~127u); cp[0] = (ordf(a0 + b0) & ~63u) | (unsigned)(63 - c); }
        { const float a0 = unordf(bperm(w0, rbase + (f1 >> 4)) & ~127u), b0 = unordf(bperm(w1, rbase + (f1 & 15)) & ~127u); cp[1] = (ordf(a0 + b0) & ~63u) | (unsigned)(47 - c); }
        { const float a0 = unordf(bperm(w0, rbase + (f2 >> 4)) & ~127u), b0 = unordf(bperm(w1, rbase + (f2 & 15)) & ~127u); cp[2] = (ordf(a0 + b0) & ~63u) | (unsigned)(31 - c); }
        { const float a0 = unordf(bperm(w0, rbase + (f3 >> 4)) & ~127u), b0 = unordf(bperm(w1, rbase + (f3 & 15)) & ~127u); cp[3] = (c + 48 < 50) ? ((ordf(a0 + b0) & ~63u) | (unsigned)(15 - c)) : 0u; }
        const unsigned Wc = top16_of4r(cp, c);
        const int slot = 63 - (int)(Wc & 63u);
        const unsigned fa = bperm((unsigned)f0, rbase + (slot & 15)), fb = bperm((unsigned)f1, rbase + (slot & 15)), fc = bperm((unsigned)f2, rbase + (slot & 15)), fd = bperm((unsigned)f3, rbase + (slot & 15));
        const int sq = slot >> 4; const int flat = (int)((sq == 0) ? fa : (sq == 1) ? fb : (sq == 2) ? fc : fd);
        const float val = unordf(Wc & ~63u);
        const float vmax = __uint_as_float(bperm(__float_as_uint(val), rbase));
        const float e = __expf(val - vmax);
        const float g = e / sum16(e);
        const int k1 = 127 - (int)(bperm(w0, rbase + (flat >> 4)) & 127u), k2 = 127 - (int)(bperm(w1, rbase + (flat & 15)) & 127u);
        const int tok = t0 + 16 * (pb >> 2) + 4 * g4 + (pb & 3);
        EI[(size_t)(tok * 8 + h) * 16 + c] = k1 * 128 + k2; GW[(size_t)(tok * 8 + h) * 16 + c] = g;
    }
}

__device__ __forceinline__ float gelu_tanh_f(float x) {
    const float u = 0.7978845608028654f * (x + 0.044715f * x * x * x);
    const float e = __expf(2.f * u);
    const float th = 1.f - 2.f / (e + 1.f);
    return 0.5f * x * (1.f + th);
}
__device__ __forceinline__ float wave_sum_bfly(float v) {
#pragma unroll
    for (int o = 1; o < 64; o <<= 1) v += __shfl_xor(v, o);
    return v;
}
typedef float f32x2_ __attribute__((ext_vector_type(2)));
#define FP4_DEC(w_, sel_) __builtin_amdgcn_cvt_scalef32_pk_f32_fp4((unsigned)(w_), 1.0f, (sel_))
typedef int i32x8 __attribute__((ext_vector_type(8)));
template <int NBT>
__device__ __forceinline__ void peer_a_slice(const bf16* xb, const int* EI, const unsigned char* U4s, float* pd, int s, unsigned* ctr, int nbatch, int lane) {
    const int c = lane & 15, g4 = lane >> 4, k8 = c >> 1;
    const unsigned char* tab = U4s + (size_t)s * (16384 * 128) + (4 * (c & 1) + g4) * 16;
#define A_FETCH() ((int)__builtin_amdgcn_readfirstlane((int)((lane == 0) ? __hip_atomic_fetch_add(ctr, 1u, __ATOMIC_RELAXED, __HIP_MEMORY_SCOPE_AGENT) : 0u)))
#define A_TOKB(b_, j_) ((((b_) < nbatch) ? (b_) : (nbatch - 1)) * NBT + (j_))
#define A_XS(XS, t_) do { const bf16* xp_ = xb + (size_t)(t_) * 2048 + s * 256 + 128 * (c & 1) + 16 * g4; XS[0] = *(const v4u*)xp_; XS[1] = *(const v4u*)(xp_ + 8); XS[2] = *(const v4u*)(xp_ + 64); XS[3] = *(const v4u*)(xp_ + 72); } while (0)
#define A_ISSUE(U, EV) do { _Pragma("unroll") for (int i = 0; i < 8; ++i) { const int e_ = (int)bperm((unsigned)(EV), (i << 3) + k8); U[i] = *(const v4u*)(tab + (size_t)e_ * 128); } } while (0)
#define A_COMPUTE(U, OUT) do { _Pragma("unroll") for (int i = 0; i < 8; ++i) { f32x4 d_ = (f32x4){0.f, 0.f, 0.f, 0.f}; \
            d_ = __builtin_amdgcn_mfma_scale_f32_16x16x128_f8f6f4((i32x8){(int)U[i][0], (int)U[i][1], (int)U[i][2], (int)U[i][3], 0, 0, 0, 0}, hb, d_, 4, 0, 0, 0x7f7f7f7f, 0, 0x7f7f7f7f); \
            const float o0_ = d_[0] + DPPF(d_[1], 0xB1), o1_ = d_[2] + DPPF(d_[3], 0xB1);        \
            if (k8 == i) OUT = (f32x2_){o0_, o1_}; } } while (0)
    int eL[NBT], eH[NBT], nL[NBT], nH[NBT]; v4u xs[2][4]; v4u UA[8], UB[8];
    int b0 = A_FETCH(), b1 = A_FETCH();
    if (b0 >= nbatch) return;
#pragma unroll
    for (int j = 0; j < NBT; ++j) { const int tj = A_TOKB(b0, j); eL[j] = EI[(size_t)tj * 128 + lane]; eH[j] = EI[(size_t)tj * 128 + 64 + lane]; }
    A_XS(xs[0], A_TOKB(b0, 0));
    A_ISSUE(UA, eL[0]);
    while (b0 < nbatch) {
        const int b2 = A_FETCH();
#pragma unroll
        for (int j = 0; j < NBT; ++j) { const int tj = A_TOKB(b1, j); nL[j] = EI[(size_t)tj * 128 + lane]; nH[j] = EI[(size_t)tj * 128 + 64 + lane]; }
#pragma unroll
        for (int j = 0; j < NBT; ++j) {
            const int t = b0 * NBT + j;
            A_ISSUE(UB, eH[j]);
            i32x8 hb;
#pragma unroll
            for (int q = 0; q < 4; ++q) { const v4u w = xs[j & 1][q]; int lo = 0, hi = 0;
                lo = __builtin_amdgcn_cvt_pk_fp8_f32(__uint_as_float(w[0] << 16), __uint_as_float(w[0] & 0xffff0000u), lo, false); lo = __builtin_amdgcn_cvt_pk_fp8_f32(__uint_as_float(w[1] << 16), __uint_as_float(w[1] & 0xffff0000u), lo, true);
                hi = __builtin_amdgcn_cvt_pk_fp8_f32(__uint_as_float(w[2] << 16), __uint_as_float(w[2] & 0xffff0000u), hi, false); hi = __builtin_amdgcn_cvt_pk_fp8_f32(__uint_as_float(w[3] << 16), __uint_as_float(w[3] & 0xffff0000u), hi, true);
                hb[2 * q] = lo; hb[2 * q + 1] = hi; }
            f32x2_ out_lo = (f32x2_){0.f, 0.f}, out_hi = (f32x2_){0.f, 0.f};
            A_COMPUTE(UA, out_lo);
            A_XS(xs[(j + 1) & 1], (j + 1 < NBT) ? (b0 * NBT + j + 1) : A_TOKB(b1, 0));
            A_ISSUE(UA, (j + 1 < NBT) ? eL[(j + 1) % NBT] : nL[0]);
            A_COMPUTE(UB, out_hi);
            if ((c & 1) == 0) { float* pp = pd + ((size_t)s * T + t) * 128 + 8 * k8 + 2 * g4; *(f32x2_*)pp = out_lo; *(f32x2_*)(pp + 64) = out_hi; }
        }
#pragma unroll
        for (int j = 0; j < NBT; ++j) { eL[j] = nL[j]; eH[j] = nH[j]; }
        b0 = b1; b1 = b2;
    }
#undef A_FETCH
#undef A_TOKB
#undef A_XS
#undef A_ISSUE
#undef A_COMPUTE
}
__device__ __forceinline__ unsigned w8rep(float w) { const float s = fminf(fmaxf(w * 256.f, -448.f), 448.f); return ((unsigned)__builtin_amdgcn_cvt_pk_fp8_f32(s, 0.f, 0, false) & 0xffu) * 0x01010101u; }
__device__ __forceinline__ void peer_a2_token(const float* pd, const float* ssq, const int* EI, const float* su, const float* sv, float* GW, float* W1, int t, int lane) {
    float a0 = 0.f, a1 = 0.f, b0 = 0.f, b1 = 0.f;
#pragma unroll
    for (int s = 0; s < 4; ++s) { const float* pp = pd + ((size_t)s * T + t) * 128; a0 += pp[lane]; a1 += pp[64 + lane]; }
#pragma unroll
    for (int s = 4; s < 8; ++s) { const float* pp = pd + ((size_t)s * T + t) * 128; b0 += pp[lane]; b1 += pp[64 + lane]; }
    const float rs = rsqrtf(ssq[t] * (1.f / 2048.f) + EPS);
    float* gp = GW + (size_t)t * 128; float* hp = W1 + (size_t)t * 128; const int pl = lane;
    const int e0 = EI[(size_t)t * 128 + pl], e1 = EI[(size_t)t * 128 + 64 + pl];
    const float g0 = gp[pl] * gelu_tanh_f(rs * (a0 * su[2 * e0] + b0 * su[2 * e0 + 1])), g1 = gp[64 + pl] * gelu_tanh_f(rs * (a1 * su[2 * e1] + b1 * su[2 * e1 + 1]));
    unsigned* gu = (unsigned*)gp; unsigned* hu = (unsigned*)hp;
    gu[pl] = w8rep(g0 * sv[2 * e0]); hu[pl] = w8rep(g0 * sv[2 * e0 + 1]);
    gu[64 + pl] = w8rep(g1 * sv[2 * e1]); hu[64 + pl] = w8rep(g1 * sv[2 * e1 + 1]);
}
template <int NBT>
__device__ __forceinline__ void peer_b_slice(const bf16* xres, float* xio, const int* EI, const unsigned* W, const unsigned char* V4s, bf16* xb, float* ssq_out, int s, unsigned* ctr, int nbatch, int lane) {
    const int j16 = lane & 15, g4 = lane >> 4;
    const unsigned char* tab = V4s + (size_t)s * (16384 * 128) + 8 * j16;
    const int doff = s * 256 + 64 * g4 + j16;
    const unsigned bm = 0xffu << (8 * (j16 & 3)); const unsigned M0 = ((j16 >> 2) == 0) ? bm : 0u, M1 = ((j16 >> 2) == 1) ? bm : 0u, M2 = ((j16 >> 2) == 2) ? bm : 0u, M3 = ((j16 >> 2) == 3) ? bm : 0u;
#define B_FETCH() ((int)__builtin_amdgcn_readfirstlane((int)((lane == 0) ? __hip_atomic_fetch_add(ctr, 1u, __ATOMIC_RELAXED, __HIP_MEMORY_SCOPE_AGENT) : 0u)))
#define B_TOKB(b_, j_) ((((b_) < nbatch) ? (b_) : (nbatch - 1)) * NBT + (j_))
#define B_ISSUE(V, EV) do { _Pragma("unroll") for (int i = 0; i < 8; ++i) { const int e0_ = (int)bperm((unsigned)(EV), 8 * i + 2 * g4), e1_ = (int)bperm((unsigned)(EV), 8 * i + 2 * g4 + 1); \
        V[2 * i] = *(const v2u*)(tab + (size_t)e0_ * 128); V[2 * i + 1] = *(const v2u*)(tab + (size_t)e1_ * 128); } } while (0)
#define B_COMPUTE(V, WV) do { _Pragma("unroll") for (int i = 0; i < 8; ++i) { \
            const unsigned f0_ = bperm((WV), 8 * i + g4), f1_ = bperm((WV), 8 * i + 4 + g4);        \
            const i32x8 bq_ = (i32x8){(int)(f0_ & M0), (int)(f0_ & M1), (int)(f0_ & M2), (int)(f0_ & M3), (int)(f1_ & M0), (int)(f1_ & M1), (int)(f1_ & M2), (int)(f1_ & M3)}; \
            acc = __builtin_amdgcn_mfma_scale_f32_16x16x128_f8f6f4((i32x8){(int)V[2 * i][0], (int)V[2 * i][1], (int)V[2 * i + 1][0], (int)V[2 * i + 1][1], 0, 0, 0, 0}, bq_, acc, 4, 0, 0, 0x7f7f7f7f, 0, 0x77777777); } } while (0)
    int eL[NBT], eH[NBT], nL[NBT], nH[NBT]; unsigned wL[NBT], wH[NBT], mL[NBT], mH[NBT]; float xv[4]; v2u VA[16], VB[16];
    int b0 = B_FETCH(), b1 = B_FETCH();
    if (b0 >= nbatch) return;
#pragma unroll
    for (int j = 0; j < NBT; ++j) { const int tj = B_TOKB(b0, j); eL[j] = EI[(size_t)tj * 128 + lane]; eH[j] = EI[(size_t)tj * 128 + 64 + lane]; wL[j] = W[(size_t)tj * 128 + lane]; wH[j] = W[(size_t)tj * 128 + 64 + lane]; }
    B_ISSUE(VA, eL[0]);
    while (b0 < nbatch) {
        const int b2 = B_FETCH();
#pragma unroll
        for (int j = 0; j < NBT; ++j) { const int tj = B_TOKB(b1, j); nL[j] = EI[(size_t)tj * 128 + lane]; nH[j] = EI[(size_t)tj * 128 + 64 + lane]; mL[j] = W[(size_t)tj * 128 + lane]; mH[j] = W[(size_t)tj * 128 + 64 + lane]; }
#pragma unroll
        for (int j = 0; j < NBT; ++j) {
            const int t = b0 * NBT + j;
            float* xp = xio + (size_t)t * 2048 + doff; const bf16* rp = xres + (size_t)t * 2048 + doff;
#pragma unroll
            for (int r = 0; r < 4; ++r) xv[r] = __uint_as_float((unsigned)rp[16 * r] << 16);
            B_ISSUE(VB, eH[j]);
            f32x4 acc = (f32x4){0.f, 0.f, 0.f, 0.f};
            B_COMPUTE(VA, wL[j]);
            B_ISSUE(VA, (j + 1 < NBT) ? eL[(j + 1) % NBT] : nL[0]);
            B_COMPUTE(VB, wH[j]);
            float ss = 0.f;
#pragma unroll
            for (int r = 0; r < 4; ++r) { const float o = xv[r] + acc[r]; ss += o * o; xp[16 * r] = o; if (xb) xb[(size_t)t * 2048 + doff + 16 * r] = (bf16)f2bf(o); }
            ss += DPPF(ss, 0xB1); ss += DPPF(ss, 0x4E); ss += DPPF(ss, 0x141); ss += DPPF(ss, 0x140);
            { const auto r = __builtin_amdgcn_permlane16_swap(__float_as_uint(ss), __float_as_uint(ss), false, false); ss = __uint_as_float(r[0]) + __uint_as_float(r[1]); }
            { const auto r = __builtin_amdgcn_permlane32_swap(__float_as_uint(ss), __float_as_uint(ss), false, false); ss = __uint_as_float(r[0]) + __uint_as_float(r[1]); }
            if (lane == 0) unsafeAtomicAdd(ssq_out + t, ss);
        }
#pragma unroll
        for (int j = 0; j < NBT; ++j) { eL[j] = nL[j]; eH[j] = nH[j]; wL[j] = mL[j]; wH[j] = mH[j]; }
        b0 = b1; b1 = b2;
    }
#undef B_FETCH
#undef B_TOKB
#undef B_ISSUE
#undef B_COMPUTE
}
__device__ __forceinline__ void final_norm_row(float* xio, const float* ssq, const float* fin, int t, int lane, float oscale) {
    const float r2 = rsqrtf(ssq[t] * (1.f / 2048.f) + EPS) * oscale;
    float* xr = xio + (size_t)t * 2048 + 4 * lane;
#pragma unroll
    for (int j = 0; j < 8; ++j) { const f32x4 xv = *(const f32x4*)(xr + 256 * j), g = *(const f32x4*)(fin + 256 * j + 4 * lane); f32x4 o;
        o[0] = xv[0] * r2 * g[0]; o[1] = xv[1] * r2 * g[1]; o[2] = xv[2] * r2 * g[2]; o[3] = xv[3] * r2 * g[3]; *(f32x4*)(xr + 256 * j) = o; }
}
typedef short s16x4 __attribute__((ext_vector_type(4)));
__device__ __forceinline__ unsigned cvt_pk_bf16_(float lo, float hi) { unsigned r; asm volatile("v_cvt_pk_bf16_f32 %0, %1, %2" : "=v"(r) : "v"(lo), "v"(hi)); return r; }
constexpr int ATT_K_OFF = 0, ATT_V_OFF = 40960, ATT_VSTRIDE = 648, ATT_LDS = ATT_V_OFF + 64 * ATT_VSTRIDE;
__device__ __forceinline__ void attn_fill_load(const bf16* K, const bf16* Vt, int b, int kvh, int kw0, int tid, v4u (&kr)[5], v2u (&vr)[10]) {
    const size_t tb = (size_t)b * 4096;
#pragma unroll
    for (int i = 0; i < 5; ++i) { const int idx = tid + 512 * i, row = idx >> 3, ch = idx & 7, key = kw0 + row;
        kr[i] = (v4u){0u, 0u, 0u, 0u}; if (key >= 0 && key < 4096) kr[i] = *(const v4u*)(K + (tb + key) * 512 + kvh * 64 + ch * 8); }
#pragma unroll
    for (int i = 0; i < 10; ++i) { const int idx = tid + 512 * i, d = idx / 80, pc = idx % 80, key = kw0 + pc * 4;
        vr[i] = (v2u){0u, 0u}; if (key >= 0 && key < 4096) vr[i] = *(const v2u*)(Vt + (size_t)(kvh * 64 + d) * 16384 + tb + key); }
}
__device__ __forceinline__ void attn_fill_store(LAS unsigned char* lds, int tid, const v4u (&kr)[5], const v2u (&vr)[10]) {
#pragma unroll
    for (int i = 0; i < 5; ++i) { const int idx = tid + 512 * i, row = idx >> 3, ch = idx & 7; *(LAS v4u*)(lds + ATT_K_OFF + row * 128 + ((ch ^ ((row >> 1) & 7)) << 4)) = kr[i]; }
#pragma unroll
    for (int i = 0; i < 10; ++i) { const int idx = tid + 512 * i, d = idx / 80, pc = idx % 80; *(LAS v2u*)(lds + ATT_V_OFF + d * ATT_VSTRIDE + pc * 8) = vr[i]; }
}
__device__ __forceinline__ void attn_task(LAS const unsigned char* lds, const bf16* Q, bf16* O, const float* sinks, int b, int hq, int q0, int kw0, int lane) {
    const int c = lane & 31, hi = lane >> 5;
    const size_t tb = (size_t)b * 4096;
    s16x8 qf[4];
    { const bf16* qp = Q + (tb + q0 + c) * 2048 + hq * 64 + hi * 8;
#pragma unroll
      for (int ks = 0; ks < 4; ++ks) qf[ks] = *(const s16x8*)(qp + ks * 16); }
    const float sink2 = sinks[hq] * 1.4426950408889634f;
    float m = sink2, l = (hi == 0) ? 1.f : 0.f;
    f32x16 o0, o1;
#pragma unroll
    for (int r = 0; r < 16; ++r) { o0[r] = 0.f; o1[r] = 0.f; }
    const int kt_lo = (q0 < 128) ? ((128 - q0) >> 5) : 0, kt_hi = ((4192 - q0) >> 5) < 8 ? ((4192 - q0) >> 5) : 8;
    for (int kt = kt_lo; kt <= kt_hi; ++kt) {
        const int key0 = q0 - 128 + 32 * kt, row0 = key0 - kw0;
        s16x8 kf[4]; s16x4 va[2][2][2];
        { const int row = row0 + c; LAS const unsigned char* kp = lds + ATT_K_OFF + row * 128; const int sw = (row >> 1) & 7;
#pragma unroll
          for (int ks = 0; ks < 4; ++ks) kf[ks] = *(LAS const s16x8*)(kp + (((2 * ks + hi) ^ sw) << 4)); }
#pragma unroll
        for (int db = 0; db < 2; ++db)
#pragma unroll
            for (int s = 0; s < 2; ++s) { LAS const unsigned char* vp = lds + ATT_V_OFF + (db * 32 + c) * ATT_VSTRIDE + (row0 + 16 * s + 4 * hi) * 2; va[db][s][0] = *(LAS const s16x4*)vp; va[db][s][1] = *(LAS const s16x4*)(vp + 16); }
        f32x16 sa;
#pragma unroll
        for (int r = 0; r < 16; ++r) sa[r] = 0.f;
#pragma unroll
        for (int ks = 0; ks < 4; ++ks) sa = __builtin_amdgcn_mfma_f32_32x32x16_bf16(kf[ks], qf[ks], sa, 0, 0, 0);
        if (kt == 0 || kt == 8) {
            const int dbase = key0 - (q0 + c) + 4 * hi;
#pragma unroll
            for (int r = 0; r < 16; ++r) { const int d = dbase + (r & 3) + 8 * (r >> 2); if (d < -128 || d > 128) sa[r] = -1e30f; }
        }
        float mx = sa[0];
#pragma unroll
        for (int r = 1; r < 16; ++r) mx = fmaxf(mx, sa[r]);
        { const auto rr = __builtin_amdgcn_permlane32_swap(__float_as_uint(mx), __float_as_uint(mx), false, false); mx = fmaxf(__uint_as_float(rr[0]), __uint_as_float(rr[1])); }
        const float mn = fmaxf(m, mx), alpha = __builtin_amdgcn_exp2f(m - mn);
        m = mn;
        float ps = 0.f;
#pragma unroll
        for (int r = 0; r < 16; ++r) { sa[r] = __builtin_amdgcn_exp2f(sa[r] - mn); ps += sa[r]; }
        l = l * alpha + ps;
#pragma unroll
        for (int r = 0; r < 16; ++r) { o0[r] *= alpha; o1[r] *= alpha; }
        s16x8 pf[2];
#pragma unroll
        for (int s = 0; s < 2; ++s) { v4u w; w.x = cvt_pk_bf16_(sa[8 * s + 0], sa[8 * s + 1]); w.y = cvt_pk_bf16_(sa[8 * s + 2], sa[8 * s + 3]); w.z = cvt_pk_bf16_(sa[8 * s + 4], sa[8 * s + 5]); w.w = cvt_pk_bf16_(sa[8 * s + 6], sa[8 * s + 7]);
            pf[s] = __builtin_bit_cast(s16x8, w); }
#pragma unroll
        for (int s = 0; s < 2; ++s) {
            const s16x8 v0 = __builtin_shufflevector(va[0][s][0], va[0][s][1], 0, 1, 2, 3, 4, 5, 6, 7), v1 = __builtin_shufflevector(va[1][s][0], va[1][s][1], 0, 1, 2, 3, 4, 5, 6, 7);
            o0 = __builtin_amdgcn_mfma_f32_32x32x16_bf16(v0, pf[s], o0, 0, 0, 0);
            o1 = __builtin_amdgcn_mfma_f32_32x32x16_bf16(v1, pf[s], o1, 0, 0, 0);
        }
    }
    { const auto rr = __builtin_amdgcn_permlane32_swap(__float_as_uint(l), __float_as_uint(l), false, false); l = __uint_as_float(rr[0]) + __uint_as_float(rr[1]); }
    const float il = 1.f / l;
    bf16* op = O + (tb + q0 + c) * 2048 + hq * 64 + 4 * hi;
#pragma unroll
    for (int g = 0; g < 4; ++g) {
        v2u w0, w1;
        w0.x = cvt_pk_bf16_(o0[4 * g + 0] * il, o0[4 * g + 1] * il); w0.y = cvt_pk_bf16_(o0[4 * g + 2] * il, o0[4 * g + 3] * il);
        w1.x = cvt_pk_bf16_(o1[4 * g + 0] * il, o1[4 * g + 1] * il); w1.y = cvt_pk_bf16_(o1[4 * g + 2] * il, o1[4 * g + 3] * il);
        *(v2u*)(op + 8 * g) = w0; *(v2u*)(op + 32 + 8 * g) = w1;
    }
}
typedef float fx2 __attribute__((ext_vector_type(2)));
__device__ __forceinline__ fx2 bf2_(unsigned w) { fx2 r; r[0] = __uint_as_float(w << 16); r[1] = __uint_as_float(w & 0xffff0000u); return r; }
__device__ __forceinline__ void fft16_item(bf16* Zp, const float* tw, int bg, int l, int s1h, int lane) {
    const int s1 = s1h * 128 + 2 * lane;
    bf16* base = Zp + ((size_t)(bg * 16) * 256 + l) * 512 + s1;
    fx2 zr[16], zi[16];
#pragma unroll
    for (int s2 = 0; s2 < 16; ++s2) { zr[s2] = bf2_(*(const unsigned*)(base + (size_t)s2 * 256 * 512)); zi[s2] = bf2_(*(const unsigned*)(base + (size_t)s2 * 256 * 512 + 256)); }
    fx2 er[16], ei[16];
#pragma unroll
    for (int d = 0; d < 4; ++d) {
        const fx2 ar = zr[d], ai_ = zi[d], br = zr[4 + d], bi = zi[4 + d], cr = zr[8 + d], ci = zi[8 + d], dr = zr[12 + d], di = zi[12 + d];
        const fx2 s0r = ar + cr, s0i = ai_ + ci, s1r = ar - cr, s1i = ai_ - ci, s2r = br + dr, s2i = bi + di, s3r = br - dr, s3i = bi - di;
        er[0 * 4 + d] = s0r + s2r; ei[0 * 4 + d] = s0i + s2i;
        er[1 * 4 + d] = s1r + s3i; ei[1 * 4 + d] = s1i - s3r;
        er[2 * 4 + d] = s0r - s2r; ei[2 * 4 + d] = s0i - s2i;
        er[3 * 4 + d] = s1r - s3i; ei[3 * 4 + d] = s1i + s3r;
    }
#pragma unroll
    for (int a = 1; a < 4; ++a)
#pragma unroll
        for (int d = 1; d < 4; ++d) {
            const float ang = 6.283185307179586f * (float)(a * d) / 16.f; const float c = __builtin_cosf(ang), sn = __builtin_sinf(ang);
            const fx2 xr = er[a * 4 + d], xi = ei[a * 4 + d];
            er[a * 4 + d] = xr * c + xi * sn; ei[a * 4 + d] = xi * c - xr * sn;
        }
#pragma unroll
    for (int a = 0; a < 4; ++a) {
        const fx2 ar = er[a * 4 + 0], ai_ = ei[a * 4 + 0], br = er[a * 4 + 1], bi = ei[a * 4 + 1], cr = er[a * 4 + 2], ci = ei[a * 4 + 2], dr = er[a * 4 + 3], di = ei[a * 4 + 3];
        const fx2 s0r = ar + cr, s0i = ai_ + ci, s1r = ar - cr, s1i = ai_ - ci, s2r = br + dr, s2i = bi + di, s3r = br - dr, s3i = bi - di;
        fx2 Dr[4], Di[4];
        Dr[0] = s0r + s2r; Di[0] = s0i + s2i; Dr[1] = s1r + s3i; Di[1] = s1i - s3r; Dr[2] = s0r - s2r; Di[2] = s0i - s2i; Dr[3] = s1r - s3i; Di[3] = s1i + s3r;
#pragma unroll
        for (int b = 0; b < 4; ++b) {
            const int k2 = a + 4 * b;
            const f32x4 t0 = *(const f32x4*)(tw + (size_t)(k2 * 256 + s1) * 2);
            const fx2 cc = (fx2){t0[0], t0[2]}, ss = (fx2){t0[1], t0[3]};
            const fx2 hr = Dr[b] * cc + Di[b] * ss, hi_ = Di[b] * cc - Dr[b] * ss;
            *(unsigned*)(base + (size_t)k2 * 256 * 512) = pk2(hr[0], hr[1]); *(unsigned*)(base + (size_t)k2 * 256 * 512 + 256) = pk2(hi_[0], hi_[1]);
        }
    }
}
__device__ __forceinline__ int static_unit(int nM, int nN, int G, int c, int i) {
    const int nwg = nM * nN; const long L = (long)i * G + c; if (L >= nwg) return -1;
    int wgid = (int)L; { const int q = nwg / 8, r = nwg % 8, xcd = wgid % 8, off = wgid / 8; wgid = (xcd < r ? xcd * (q + 1) : r * (q + 1) + (xcd - r) * q) + off; }
    const int nig = 8 * nN, gid = wgid / nig, fm = gid * 8, gsz = (nM - fm) < 8 ? (nM - fm) : 8;
    return ((fm + ((wgid % nig) % gsz)) << 16) | ((wgid % nig) / gsz);
}
#ifndef REP_PRO
#define REP_PRO 1
#endif
#ifndef REP_GEMM
#define REP_GEMM 1
#endif
#ifndef REP_ATT
#define REP_ATT 1
#endif
#ifndef REP_LITE
#define REP_LITE 0
#endif
#ifndef REP_Q
#define REP_Q 1
#endif
#ifndef REP_PA
#define REP_PA 1
#endif
#ifndef REP_TK
#define REP_TK 1
#endif
enum { PH_PRO = 0, PH_G1 = 1, PH_S1 = 2, PH_G2 = 3, PH_G3 = 4, PH_Q0 = 5, PH_TK0 = 6, PH_PA0 = 7, PH_PW0 = 8, PH_PB0 = 9, PH_QKV = 10, PH_ATT = 11, PH_WO = 12, PH_Q1 = 13, PH_TK1 = 14, PH_PA1 = 15, PH_PW1 = 16, PH_PB1 = 17, PH_FIN = 18, PH_END = 19 };
__global__ void __launch_bounds__(NWAVES * 64, 2) mega(Args a) {
    extern __shared__ __attribute__((aligned(16))) unsigned char lds_raw[];
    LAS unsigned char* lds = (LAS unsigned char*)lds_raw;
    cg::grid_group grid = cg::this_grid();
    const int wave = __builtin_amdgcn_readfirstlane(threadIdx.x >> 6);
#define FRESH_IDS() int lane; asm volatile("v_mbcnt_lo_u32_b32 %0, -1, 0\n\tv_mbcnt_hi_u32_b32 %0, -1, %0" : "=v"(lane)); const int tid = wave * 64 + lane; (void)tid
    const int G = gridDim.x, bx = blockIdx.x;
    unsigned char* ws = a.ws;
    const int lo = a.ph_lo, hi = a.ph_hi;
    volatile LAS unsigned* MISC = (volatile LAS unsigned*)(lds + LDSCTL_OFF);
    if (threadIdx.x < 16) MISC[threadIdx.x] = 0u;
    __syncthreads();
    XcdBarrier xbar = xcd_barrier_post((unsigned*)(ws + WS_CTL) + CW_BAR, MISC + 8);
#define IN(k) (lo <= (k) && (k) < hi)
#ifdef DIAG_A
#define STAMP(i) do { if (bx == 0 && threadIdx.x == 0) ((unsigned long long*)(ws + WS_STAMP))[i] = __builtin_amdgcn_s_memrealtime(); } while (0)
#else
#define STAMP(i) do { } while (0)
#endif
#define SEAM(k) do { if (IN(k) && IN((k) + 1)) { if ((k) == PH_PRO) grid.sync(); else xcd_barrier(xbar); } STAMP((k) + 1); } while (0)
    STAMP(0);
    for (int rep_ = 0; rep_ < REP_PRO; ++rep_)
    if (IN(PH_PRO)) { FRESH_IDS();
        const int gw = bx * NWAVES + wave, NGW = G * NWAVES;
        const size_t gtid = (size_t)bx * (NWAVES * 64) + tid, ngt = (size_t)G * NWAVES * 64;
        LAS float* scr = (LAS float*)(lds + wave * 16384);
        {
            constexpr int I_SQ = (DM / 64) * (DM / 32), I_QKV = (DM / 64) * (QKVW / 32);
            constexpr int NITEMS = 4 * I_SQ + I_QKV;
            for (int it = gw; it < NITEMS; it += NGW) {
                int r = it;
                if (r < I_SQ) { transpose_item<0>(a.in[3], DM, DM, nullptr, (bf16*)(ws + WS_WOF), scr, r, lane); continue; } r -= I_SQ;
                if (r < I_SQ) { transpose_item<0>(a.in[5], DM, DM, nullptr, (bf16*)(ws + WS_WOA), scr, r, lane); continue; } r -= I_SQ;
                if (r < I_SQ) { transpose_item<0>(a.in[7], DM, DM, a.in[2], (bf16*)(ws + WS_WQ0), scr, r, lane); continue; } r -= I_SQ;
                if (r < I_SQ) { transpose_item<0>(a.in[7] + (size_t)DM * DM, DM, DM, a.in[2] + DM, (bf16*)(ws + WS_WQ1), scr, r, lane); continue; } r -= I_SQ;
                transpose_item<1>(a.in[4], DM, QKVW, a.in[1] + DM, (bf16*)(ws + WS_WQKV), scr, r, lane);
            }
        }
        for (int row = gw; row < T; row += NGW) {
            const f32x4* xr = (const f32x4*)(a.in[0] + (size_t)row * DM) + lane;
            const f32x4* gr = (const f32x4*)a.in[1] + lane;
            f32x4 v[8]; float s = 0.f;
#pragma unroll
            for (int j = 0; j < 8; ++j) { v[j] = xr[64 * j]; s += (v[j][0] * v[j][0] + v[j][1] * v[j][1]) + (v[j][2] * v[j][2] + v[j][3] * v[j][3]); }
            const float r = rsqrtf(wsum(s) * (1.f / DM) + EPS);
            const int b = row >> 12, sp = row & 4095;
#pragma unroll
            for (int j = 0; j < 8; ++j) { const f32x4 gg = gr[64 * j]; v2u o; o.x = pk2(v[j][0] * r * gg[0], v[j][1] * r * gg[1]); o.y = pk2(v[j][2] * r * gg[2], v[j][3] * r * gg[3]);
                *(v2u*)((bf16*)(ws + WS_XG) + ((size_t)((b * 8 + j) * 4096 + sp) * 256 + 4 * lane)) = o; }
        }
        for (size_t i = gtid; i < (size_t)256 * 512 / 8; i += ngt) {
            const int k1 = (int)(i >> 6), c0 = (int)(i & 63) * 8, part = c0 >> 8, s0 = c0 & 255;
            float v[8];
#pragma unroll
            for (int e = 0; e < 8; ++e) { const int m = (k1 * (s0 + e)) & 255; const float rev = (float)m * (1.f / 256.f); v[e] = (part ? __builtin_amdgcn_sinf(rev) : __builtin_amdgcn_cosf(rev)) * (1.f / 64.f); }
            v4u o; o.x = pk2(v[0], v[1]); o.y = pk2(v[2], v[3]); o.z = pk2(v[4], v[5]); o.w = pk2(v[6], v[7]);
            *(v4u*)((bf16*)(ws + WS_A2) + i * 8) = o;
        }
        for (size_t i = gtid; i < (size_t)16 * 256; i += ngt) {
            const int k2 = (int)(i >> 8), s1 = (int)(i & 255); const float rev = (float)(k2 * s1) * (1.f / 4096.f);
            ((float*)(ws + WS_TW))[2 * i] = __builtin_amdgcn_cosf(rev); ((float*)(ws + WS_TW))[2 * i + 1] = __builtin_amdgcn_sinf(rev);
        }
        for (size_t i = gtid; i < (size_t)512 * 256 / 8; i += ngt) {
            const int n = (int)(i >> 5), c0 = (int)(i & 31) * 8, part = n >> 8, l = n & 255;
            float v[8];
#pragma unroll
            for (int e = 0; e < 8; ++e) { const int m = (l * (c0 + e)) & 255; const float rev = (float)m * (1.f / 256.f); v[e] = (part ? -__builtin_amdgcn_sinf(rev) : __builtin_amdgcn_cosf(rev)) * (1.f / 16.f); }
            v4u o; o.x = pk2(v[0], v[1]); o.y = pk2(v[2], v[3]); o.z = pk2(v[4], v[5]); o.w = pk2(v[6], v[7]);
            *(v4u*)((bf16*)(ws + WS_WCS) + i * 8) = o;
        }
        for (size_t i = gtid; i < (size_t)4096 * 32; i += ngt) {
            const int pos = (int)(i >> 5), fi = (int)(i & 31);
            const double inv = exp2(-(double)fi * (13.287712379549449 / 32.0));
            double sn, cs; sincos((double)pos * inv, &sn, &cs);
            ((float*)(ws + WS_ROPE))[2 * i] = (float)cs; ((float*)(ws + WS_ROPE))[2 * i + 1] = (float)sn;
        }
#pragma unroll 1
        for (int L = 0; L < 2; ++L) {
            CvtCtx cx; cx.srcU = a.in[9] + (size_t)L * NEXP * DM; cx.dsrc = (long)((a.in[10] + (size_t)L * NEXP * DM) - cx.srcU); cx.gain = a.in[2] + L * DM; cx.dstU = ws + (L ? WS_U1 : WS_U0); cx.ddst = (long)WS_V0 - (long)WS_U0;
            cx.su = (float*)(ws + WS_SU) + L * 32768; cx.dsc = ((long)WS_SV - (long)WS_SU) / 4; cx.gwave = gw; cx.nw = NGW;
            f32x4 c0[4], c1[4], n0[4], n1[4];
            cvt_chunk_load(cx, gw, lane, c0); cvt_chunk_load(cx, (gw + NGW < 65536) ? gw + NGW : gw, lane, c1);
            for (int cc = gw; cc < 65536; cc += 2 * NGW) { const int ca = cc + 2 * NGW, cb = cc + 3 * NGW;
                cvt_chunk_load(cx, ca < 65536 ? ca : cc, lane, n0); cvt_chunk_load(cx, cb < 65536 ? cb : cc, lane, n1);
                cvt_chunk_store(cx, cc, lane, c0); if (cc + NGW < 65536) cvt_chunk_store(cx, cc + NGW, lane, c1);
#pragma unroll
                for (int q = 0; q < 4; ++q) { c0[q] = n0[q]; c1[q] = n1[q]; } }
        }
        cvt_stream(a.in[8], (bf16*)(ws + WS_KEYS), (size_t)2 * PH * 2 * 128 * 128 / 8, gtid, ngt);
    }
    SEAM(PH_PRO);
    for (int rep_ = 0; rep_ < REP_GEMM; ++rep_)
    if (IN(PH_G1)) { FRESH_IDS();
        int Kq = FW; asm volatile("" : "+s"(Kq));
        pg8::Gemm g{(const pg8::bf16_t*)(ws + WS_WCS), (const pg8::bf16_t*)(ws + WS_XG), 512, T * FG, Kq}; pg8::StaticOrder S; S.init(512, T * FG, G, bx);
        pg8::EpiZt E{(pg8::bf16_t*)(ws + WS_ZT)};
        pg8::gemm_phase<pg8::EpiZt, pg8::StaticOrder, true, true>(lds, g, S, E);
    }
    SEAM(PH_G1);
    if (IN(PH_S1)) { FRESH_IDS();
        const int gw = bx * NWAVES + wave, NGW = G * NWAVES;
        for (int it = gw; it < 32 * 256 * 2; it += NGW) fft16_item((bf16*)(ws + WS_ZT), (const float*)(ws + WS_TW), it >> 9, (it >> 1) & 255, it & 1, lane);
    }
    SEAM(PH_S1);
    for (int rep_ = 0; rep_ < REP_GEMM; ++rep_)
    if (IN(PH_G2)) { FRESH_IDS();
        pg8::Gemm g{(const pg8::bf16_t*)(ws + WS_A2), (const pg8::bf16_t*)(ws + WS_ZT), 256, 131072, 512}; pg8::StaticOrder S; S.init(256, 131072, G, bx);
        pg8::EpiY E{(pg8::bf16_t*)(ws + WS_Y)};
        pg8::gemm_phase<pg8::EpiY, pg8::StaticOrder, true, true>(lds, g, S, E);
    }
    SEAM(PH_G2);
    if (IN(PH_G3)) { FRESH_IDS();
        pg8::Gemm g{(const pg8::bf16_t*)(ws + WS_Y), (const pg8::bf16_t*)(ws + WS_WOF), T, DM, DM}; pg8::StaticOrder S; S.init(T, DM, G, bx);
        pg8::EpiRes E{a.in[0], a.out, (pg8::bf16_t*)(ws + WS_XB), (float*)(ws + WS_SSQ_A)};
        pg8::gemm_phase<pg8::EpiRes, pg8::StaticOrder, true, true>(lds, g, S, E);
    }
    SEAM(PH_G3);
#define PEER_LAYER(L) do { \
        const int pq = L ? PH_Q1 : PH_Q0, ptk = L ? PH_TK1 : PH_TK0, ppa = L ? PH_PA1 : PH_PA0, ppw = L ? PH_PW1 : PH_PW0, ppb = L ? PH_PB1 : PH_PB0; \
        for (int rep_ = 0; rep_ < REP_Q; ++rep_) \
        if (IN(pq)) { FRESH_IDS(); \
            pg8::Gemm g{(const pg8::bf16_t*)(ws + WS_XB), (const pg8::bf16_t*)(ws + (L ? WS_WQ1 : WS_WQ0)), T, DM, DM}; pg8::StaticOrder S; S.init(T, DM, G, bx); \
            pg8::EpiScale E{(pg8::bf16_t*)(ws + WS_Q), (const float*)(ws + (L ? WS_SSQ_C : WS_SSQ_A))}; \
            pg8::gemm_phase<pg8::EpiScale, pg8::StaticOrder, true, true>(lds, g, S, E); \
        } \
        if (IN(pq) && IN(ptk)) { asm volatile("s_waitcnt vmcnt(0)" ::: "memory"); __syncthreads(); } STAMP(pq + 1); \
        if (IN(ptk)) { FRESH_IDS(); \
            const bf16* keys = (const bf16*)(ws + WS_KEYS) + (size_t)L * PH * 2 * 128 * 128; \
            int slot = 0; \
            for (int rep_ = 0; rep_ < REP_TK; ++rep_) { slot = 0; \
            for (int ui = 0; ; ++ui) {        \
                const int upk = static_unit(T / 256, DM / 256, G, bx, ui); if (upk < 0) break; \
                const int h = upk & 0xffff, tblk = upk >> 16; \
                __syncthreads(); \
                topk_fill(lds, keys, h, tid); \
                __syncthreads(); \
                topk_unit((const bf16*)(ws + WS_Q), lds, (int*)(ws + WS_EI), (float*)(ws + WS_GW), tblk * 256 + wave * 32, h, lane); \
                slot += 16; \
            } } \
        } \
        SEAM(ptk); \
        if (IN(ppa)) { FRESH_IDS(); \
            const int xv = bx & 7; \
            peer_a_slice<8>((const bf16*)(ws + WS_XB), (const int*)(ws + WS_EI), (const unsigned char*)(ws + (L ? WS_U1 : WS_U0)), (float*)(ws + WS_PD), xv, (unsigned*)(ws + WS_BCTR) + (L * 2 + 0) * 512 + xv * 64, T / 8, lane); \
        } \
        SEAM(ppa); \
        if (IN(ppw)) { FRESH_IDS(); \
            const int gw = bx * NWAVES + wave, NGW = G * NWAVES; \
            for (int t = gw; t < T; t += NGW) peer_a2_token((const float*)(ws + WS_PD), (const float*)(ws + (L ? WS_SSQ_C : WS_SSQ_A)), (const int*)(ws + WS_EI), (const float*)(ws + WS_SU) + L * 32768, (const float*)(ws + WS_SV) + L * 32768, (float*)(ws + WS_GW), (float*)(ws + WS_W1), t, lane); \
        } \
        SEAM(ppw); \
        if (IN(ppb)) { FRESH_IDS(); \
            const int xv = bx & 7; \
            peer_b_slice<4>((const bf16*)(ws + WS_XB), a.out, (const int*)(ws + WS_EI), (const unsigned*)(ws + ((xv < 4) ? WS_GW : WS_W1)), (const unsigned char*)(ws + (L ? WS_V1 : WS_V0)), L ? (bf16*)nullptr : (bf16*)(ws + WS_XB), (float*)(ws + (L ? WS_SSQ_D : WS_SSQ_B)), xv, (unsigned*)(ws + WS_BCTR) + (L * 2 + 1) * 512 + xv * 64, T / 4, lane); \
        } \
    } while (0)
    float oscale = 1.f;
    PEER_LAYER(0);
    SEAM(PH_PB0);
    for (int rep_ = 0; rep_ < REP_GEMM; ++rep_)
    if (IN(PH_QKV)) { FRESH_IDS();
        {
            pg8::Gemm g{(const pg8::bf16_t*)(ws + WS_XB), (const pg8::bf16_t*)(ws + WS_WQKV), T, 2560, DM}; pg8::StaticOrder S; S.init(T, 2560, G, bx);
            pg8::EpiQK E{(pg8::bf16_t*)(ws + WS_QB), (pg8::bf16_t*)(ws + WS_KB), (const float*)(ws + WS_SSQ_B), (const float*)(ws + WS_ROPE), 0.125f * 1.4426950408889634f};
            pg8::gemm_phase<pg8::EpiQK, pg8::StaticOrder, true, true>(lds, g, S, E);
        }
        if (bx >= G / 2) {
            pg8::Gemm g{(const pg8::bf16_t*)(ws + WS_WQKV) + (size_t)2560 * DM, (const pg8::bf16_t*)(ws + WS_XB), 512, T, DM}; pg8::StaticOrder S; S.init(512, T, G / 2, bx - G / 2);
            pg8::EpiVt E{(pg8::bf16_t*)(ws + WS_VT), (const float*)(ws + WS_SSQ_B)};
            pg8::gemm_phase<pg8::EpiVt, pg8::StaticOrder, true, true>(lds, g, S, E);
        }
    }
    SEAM(PH_QKV);
    for (int rep_ = 0; rep_ < REP_ATT; ++rep_)
    if (IN(PH_ATT)) { FRESH_IDS();
        for (int vb = bx; vb < 256; vb += G) {
            const int bkv = vb >> 3, chunk = vb & 7, b = bkv >> 3, kvh = bkv & 7;
            v4u kr[5]; v2u vr[10];
            attn_fill_load((const bf16*)(ws + WS_KB), (const bf16*)(ws + WS_VT), b, kvh, chunk * 8 * 64 - 128, tid, kr, vr);
            for (int i = 0; i < 8; ++i) {
                const int qu = (chunk * 8 + i) * 64;
                __syncthreads();
                attn_fill_store(lds, tid, kr, vr);
                __syncthreads();
                if (i + 1 < 8) attn_fill_load((const bf16*)(ws + WS_KB), (const bf16*)(ws + WS_VT), b, kvh, qu + 64 - 128, tid, kr, vr);
                attn_task(lds, (const bf16*)(ws + WS_QB), (bf16*)(ws + WS_O), a.in[6], b, kvh * 4 + (wave & 3), qu + (wave >> 2) * 32, qu - 128, lane);
            }
        }
    }
    SEAM(PH_ATT);
    if (IN(PH_WO)) { FRESH_IDS();
        pg8::Gemm g{(const pg8::bf16_t*)(ws + WS_O), (const pg8::bf16_t*)(ws + WS_WOA), T, DM, DM}; pg8::StaticOrder S; S.init(T, DM, G, bx);
        pg8::EpiRes E{a.out, a.out, (pg8::bf16_t*)(ws + WS_XB), (float*)(ws + WS_SSQ_C)};
        pg8::gemm_phase<pg8::EpiRes, pg8::StaticOrder, true, true>(lds, g, S, E);
    }
    SEAM(PH_WO);
#ifdef DIAG_A
    { const unsigned long long* st = (const unsigned long long*)(ws + WS_STAMP); oscale = 1.f + sqrtf((float)(st[DIAG_B] - st[DIAG_A]) * 1e-6f); }
#endif
    PEER_LAYER(1);
#undef PEER_LAYER
    SEAM(PH_PB1);
    if (IN(PH_FIN)) { FRESH_IDS();
        const int gw = bx * NWAVES + wave, NGW = G * NWAVES;
        for (int t = gw; t < T; t += NGW) final_norm_row(a.out, (const float*)(ws + WS_SSQ_D), a.in[11], t, lane, oscale);
    }
#undef SEAM
#undef IN
}

#ifndef N_LAUNCHES
#define N_LAUNCHES 1
#endif
extern "C" void kernel_launch(void* const* d_in, const int* in_sizes, int n_in, void* d_out, int out_size, void* d_ws, size_t ws_size, hipStream_t stream) {
    static int grid = 0;
    if (!grid) {
        if (hipFuncSetAttribute((const void*)mega, hipFuncAttributeMaxDynamicSharedMemorySize, LDS_BYTES) != hipSuccess) { fprintf(stderr, "hipFuncSetAttribute failed\n"); }
        int dev = 0, cus = 0, per_cu = 0;
        (void)hipGetDevice(&dev);
        (void)hipDeviceGetAttribute(&cus, hipDeviceAttributeMultiprocessorCount, dev);
        if (hipOccupancyMaxActiveBlocksPerMultiprocessor(&per_cu, (const void*)mega, NWAVES * 64, LDS_BYTES) != hipSuccess) per_cu = 0;
        (void)hipGetLastError();
        grid = cus * per_cu;
        if (grid > 256) grid = 256;
        grid &= ~1;
        if (grid < 2) { fprintf(stderr, "occupancy query gave %d x %d\n", cus, per_cu); grid = -1; }
    }
    if (grid < 0) return;
    if (ws_size < 700 * MiB) { fprintf(stderr, "ws too small: %zu\n", ws_size); return; }
    (void)hipMemsetAsync((char*)d_ws + WS_CTL, 0, CTL_BYTES, stream);
    Args a{};
    for (int i = 0; i < 12; ++i) a.in[i] = (const float*)d_in[i];
    a.out = (float*)d_out; a.ws = (unsigned char*)d_ws;
    if (N_LAUNCHES == 1) {
        a.ph_lo = 0; a.ph_hi = PH_END;
        void* args[] = {&a};
        const hipError_t e = hipLaunchCooperativeKernel((const void*)mega, dim3(grid), dim3(NWAVES * 64), args, LDS_BYTES, stream);
        if (e != hipSuccess) fprintf(stderr, "cooperative launch failed: %s (grid %d)\n", hipGetErrorString(e), grid);
    } else {
        for (int ph = 0; ph < PH_END; ++ph) {
            a.ph_lo = ph; a.ph_hi = ph + 1;
            hipLaunchKernelGGL(mega, dim3(grid), dim3(NWAVES * 64), LDS_BYTES, stream, a);
        }
    }
}
```

```cpp
#include <hip/hip_runtime.h>
#include <hip/hip_cooperative_groups.h>
namespace cg = cooperative_groups;
#include <cstdio>
#include <cstdint>
#include <cmath>

constexpr int DM = 2048, NB = 4, SEQ = 4096, T = NB * SEQ;
constexpr int FG = 8, FW = 256;
constexpr int HD = 64, NQH = 32, NKVH = 8, QKVW = 3072;
constexpr int PH = 8, NKEYS = 128, NEXP = 16384, PTOPK = 16;
constexpr float EPS = 1e-6f;
namespace pg8 {
#define PG8_LAS __attribute__((address_space(3)))
typedef unsigned short bf16_t;
typedef short bf16x8 __attribute__((ext_vector_type(8)));
typedef float f32x4 __attribute__((ext_vector_type(4)));
typedef unsigned u32x4 __attribute__((ext_vector_type(4)));
constexpr int BM = 256, BK = 64, HALF = 128, HTB = HALF * BK * 2  , STAGE_BYTES = 8 * HTB, NXCD = 8, WGM = 8;

__host__ __device__ __forceinline__ int lds_byte(int r, int c) { const int st = (r >> 4) * 2 + (c >> 5), rr = r & 15, cc = c & 31, ob = rr * 64 + cc * 2; return st * 1024 + (ob ^ (((ob >> 9) & 1) << 5)); }
__host__ __device__ __forceinline__ void stage_rc(int b, int& R, int& C) { const int st = b / 1024, sb = b % 1024, swz = sb ^ (((sb >> 9) & 1) << 5); R = (st >> 1) * 16 + swz / 64; C = (st & 1) * 32 + (swz % 64) / 2; }
__host__ __device__ __forceinline__ int perm32(int rho) { const int n = rho >> 4, i = rho & 15; return 8 * (i >> 2) + 4 * n + (i & 3); }

struct Unit { int pm, pn; };
struct Gemm { const bf16_t* A; const bf16_t* Bt; int M, N, K; };

struct StaticOrder {
    int nM, nN, nwg, G, c;
    __host__ __device__ void init(int M, int N, int G_, int c_) { nM = M / BM; nN = N / BM; nwg = nM * nN; G = G_; c = c_; }
    __host__ __device__ bool next(int i, Unit& u) const {
        const long L = (long)i * G + c; if (L >= nwg) return false;
        int wgid = (int)L; { const int q = nwg / NXCD, r = nwg % NXCD, xcd = wgid % NXCD, off = wgid / NXCD; wgid = (xcd < r ? xcd * (q + 1) : r * (q + 1) + (xcd - r) * q) + off; }
        const int nig = WGM * nN, gid = wgid / nig, fm = gid * WGM, gsz = (nM - fm) < WGM ? (nM - fm) : WGM;
        u.pm = fm + ((wgid % nig) % gsz); u.pn = (wgid % nig) / gsz; return true;
    }
    __device__ __forceinline__ void a_ready(const Unit&) const {}
    __device__ __forceinline__ void done(const Unit&) const {}
};

__device__ __forceinline__ unsigned cvt_pk_bf16(float lo, float hi) { unsigned r; asm volatile("v_cvt_pk_bf16_f32 %0, %1, %2" : "=v"(r) : "v"(lo), "v"(hi)); return r; }
typedef float f32x2 __attribute__((ext_vector_type(2)));
__device__ __forceinline__ u32x4 pack8(const f32x4 v0, const f32x4 v1) { u32x4 w; w.x = cvt_pk_bf16(v0[0], v0[1]); w.y = cvt_pk_bf16(v0[2], v0[3]); w.z = cvt_pk_bf16(v1[0], v1[1]); w.w = cvt_pk_bf16(v1[2], v1[3]); return w; }
struct EpiZt {
    static constexpr bool PERM = true, AFTER_DRAIN = false; bf16_t* Zp;
    __device__ __forceinline__ void operator()(const f32x4 (&acc)[2][2][4][2], const Unit& u, int wr, int wc, int fr, int fq) const {
        const int part = u.pm, bgs2 = u.pn;
        bf16_t* base = Zp + ((size_t)(bgs2 * 256 + wr * 64 + fr) * 512 + part * 256 + wc * 32 + 8 * fq);
#pragma unroll
        for (int ai = 0; ai < 2; ++ai)
#pragma unroll
            for (int m = 0; m < 4; ++m)
#pragma unroll
                for (int bj = 0; bj < 2; ++bj) *(u32x4*)(base + (ai * HALF + m * 16) * 512 + bj * HALF) = pack8(acc[ai][bj][m][0], acc[ai][bj][m][1]);
    }
};
struct EpiY {
    static constexpr bool PERM = true, AFTER_DRAIN = false; bf16_t* Y;
    __device__ __forceinline__ void operator()(const f32x4 (&acc)[2][2][4][2], const Unit& u, int wr, int wc, int fr, int fq) const {
        const int bg = u.pn >> 4, k2 = u.pn & 15, b = bg >> 3, g = bg & 7;
        bf16_t* base = Y + ((size_t)(b * 4096 + (wr * 64 + fr) * 16 + k2) * 2048 + g * 256 + wc * 32 + 8 * fq);
#pragma unroll
        for (int ai = 0; ai < 2; ++ai)
#pragma unroll
            for (int m = 0; m < 4; ++m)
#pragma unroll
                for (int bj = 0; bj < 2; ++bj) *(u32x4*)(base + (size_t)(ai * HALF + m * 16) * 16 * 2048 + bj * HALF) = pack8(acc[ai][bj][m][0], acc[ai][bj][m][1]);
    }
};
struct EpiRes {
    static constexpr bool PERM = true, AFTER_DRAIN = false; const float* R; float* out; bf16_t* xb; float* ssq;
    __device__ __forceinline__ void operator()(const f32x4 (&acc)[2][2][4][2], const Unit& u, int wr, int wc, int fr, int fq) const {
        const int row0 = u.pm * BM + wr * 64 + fr; const size_t off0 = (size_t)row0 * 2048 + u.pn * BM + wc * 32 + 8 * fq;
        const float* Rb = R + off0; bf16_t* Xb = xb + off0; float* Sb = ssq + row0;
#pragma unroll
        for (int ai = 0; ai < 2; ++ai)
#pragma unroll
            for (int m = 0; m < 4; ++m) { const int ro = (ai * HALF + m * 16) * 2048; float ss = 0.f;
#pragma unroll
                for (int bj = 0; bj < 2; ++bj) {
                    const f32x4 r0 = *(const f32x4*)(Rb + ro + bj * HALF), r1 = *(const f32x4*)(Rb + ro + bj * HALF + 4);
                    const f32x4 o0 = acc[ai][bj][m][0] + r0, o1 = acc[ai][bj][m][1] + r1;
                    *(u32x4*)(Xb + ro + bj * HALF) = pack8(o0, o1);
                    ss += (o0[0] * o0[0] + o0[1] * o0[1]) + (o0[2] * o0[2] + o0[3] * o0[3]) + (o1[0] * o1[0] + o1[1] * o1[1]) + (o1[2] * o1[2] + o1[3] * o1[3]); }
                ss += __shfl_xor(ss, 16); ss += __shfl_xor(ss, 32);
                if (fq == 0) unsafeAtomicAdd(Sb + ai * HALF + m * 16, ss);
                asm volatile("" ::: "memory"); }
    }
};
struct EpiResB {
    static constexpr bool PERM = true, AFTER_DRAIN = false; const bf16_t* R; bf16_t* xb; float* ssq;
    __device__ __forceinline__ void operator()(const f32x4 (&acc)[2][2][4][2], const Unit& u, int wr, int wc, int fr, int fq) const {
        const int row0 = u.pm * BM + wr * 64 + fr; const size_t off0 = (size_t)row0 * 2048 + u.pn * BM + wc * 32 + 8 * fq;
        const bf16_t* Rb = R + off0; bf16_t* Xb = xb + off0; float* Sb = ssq + row0;
#pragma unroll
        for (int ai = 0; ai < 2; ++ai)
#pragma unroll
            for (int m = 0; m < 4; ++m) { const int ro = (ai * HALF + m * 16) * 2048; float ss = 0.f;
#pragma unroll
                for (int bj = 0; bj < 2; ++bj) {
                    const u32x4 rw = *(const u32x4*)(Rb + ro + bj * HALF);
                    const f32x4 r0 = (f32x4){__uint_as_float(rw[0] << 16), __uint_as_float(rw[0] & 0xffff0000u), __uint_as_float(rw[1] << 16), __uint_as_float(rw[1] & 0xffff0000u)}, r1 = (f32x4){__uint_as_float(rw[2] << 16), __uint_as_float(rw[2] & 0xffff0000u), __uint_as_float(rw[3] << 16), __uint_as_float(rw[3] & 0xffff0000u)};
                    const f32x4 o0 = acc[ai][bj][m][0] + r0, o1 = acc[ai][bj][m][1] + r1;
                    *(u32x4*)(Xb + ro + bj * HALF) = pack8(o0, o1);
                    ss += (o0[0] * o0[0] + o0[1] * o0[1]) + (o0[2] * o0[2] + o0[3] * o0[3]) + (o1[0] * o1[0] + o1[1] * o1[1]) + (o1[2] * o1[2] + o1[3] * o1[3]); }
                ss += __shfl_xor(ss, 16); ss += __shfl_xor(ss, 32);
                if (fq == 0) unsafeAtomicAdd(Sb + ai * HALF + m * 16, ss);
                asm volatile("" ::: "memory"); }
    }
};
struct EpiScale {
    static constexpr bool PERM = true, AFTER_DRAIN = false; bf16_t* O; const float* ssq;
    __device__ __forceinline__ void operator()(const f32x4 (&acc)[2][2][4][2], const Unit& u, int wr, int wc, int fr, int fq) const {
        const int row0 = u.pm * BM + wr * 64 + fr;
        bf16_t* base = O + ((size_t)row0 * 2048 + u.pn * BM + wc * 32 + 8 * fq); const float* Sb = ssq + row0;
#pragma unroll
        for (int ai = 0; ai < 2; ++ai)
#pragma unroll
            for (int m = 0; m < 4; ++m) { const float rs = rsqrtf(Sb[ai * HALF + m * 16] * (1.f / 2048.f) + 1e-6f);
#pragma unroll
                for (int bj = 0; bj < 2; ++bj) *(u32x4*)(base + (ai * HALF + m * 16) * 2048 + bj * HALF) = pack8(acc[ai][bj][m][0] * rs, acc[ai][bj][m][1] * rs); }
    }
};
struct EpiQK {
    static constexpr bool PERM = true, AFTER_DRAIN = false; bf16_t* Q; bf16_t* K; const float* ssq; const float* rope; float qscale;
    __device__ __forceinline__ void operator()(const f32x4 (&acc)[2][2][4][2], const Unit& u, int wr, int wc, int fr, int fq) const {
        const int row0 = u.pm * BM + wr * 64 + fr; const bool isq = u.pn < 8;
        const int cl = wc * 32 + 8 * fq;
        bf16_t* base = isq ? (Q + ((size_t)row0 * 2048 + u.pn * BM + cl)) : (K + ((size_t)row0 * 512 + (u.pn - 8) * BM + cl));
        const int ld = isq ? 2048 : 512; const float sc = isq ? qscale : 1.f;
        const float* rp = rope + (size_t)(row0 & 4095) * 64 + (cl & 63);
        const float* Sb = ssq + row0;
#pragma unroll
        for (int ai = 0; ai < 2; ++ai)
#pragma unroll
            for (int m = 0; m < 4; ++m) { const int ro = ai * HALF + m * 16; const float rs = rsqrtf(Sb[ro] * (1.f / 2048.f) + 1e-6f) * sc;
                const f32x4 t0 = *(const f32x4*)(rp + (size_t)ro * 64), t1 = *(const f32x4*)(rp + (size_t)ro * 64 + 4);
#pragma unroll
                for (int bj = 0; bj < 2; ++bj) {
                    const f32x4 a = acc[ai][bj][m][0] * rs, b = acc[ai][bj][m][1] * rs; f32x4 oa, ob;
                    oa[0] = a[0] * t0[0] - a[1] * t0[1]; oa[1] = a[1] * t0[0] + a[0] * t0[1]; oa[2] = a[2] * t0[2] - a[3] * t0[3]; oa[3] = a[3] * t0[2] + a[2] * t0[3];
                    ob[0] = b[0] * t1[0] - b[1] * t1[1]; ob[1] = b[1] * t1[0] + b[0] * t1[1]; ob[2] = b[2] * t1[2] - b[3] * t1[3]; ob[3] = b[3] * t1[2] + b[2] * t1[3];
                    *(u32x4*)(base + (size_t)ro * ld + bj * HALF) = pack8(oa, ob); } }
    }
};
struct EpiVt {
    static constexpr bool PERM = true, AFTER_DRAIN = false; bf16_t* Vt; const float* ssq;
    __device__ __forceinline__ void operator()(const f32x4 (&acc)[2][2][4][2], const Unit& u, int wr, int wc, int fr, int fq) const {
        const int col0 = u.pn * BM + wc * 32 + 8 * fq;
        bf16_t* base = Vt + ((size_t)(u.pm * BM + wr * 64 + fr) * 16384 + col0);
        f32x4 r0[2], r1[2];
#pragma unroll
        for (int bj = 0; bj < 2; ++bj) { const f32x4 s0 = *(const f32x4*)(ssq + col0 + bj * HALF), s1 = *(const f32x4*)(ssq + col0 + bj * HALF + 4);
#pragma unroll
            for (int q = 0; q < 4; ++q) { r0[bj][q] = rsqrtf(s0[q] * (1.f / 2048.f) + 1e-6f); r1[bj][q] = rsqrtf(s1[q] * (1.f / 2048.f) + 1e-6f); } }
#pragma unroll
        for (int ai = 0; ai < 2; ++ai)
#pragma unroll
            for (int m = 0; m < 4; ++m)
#pragma unroll
                for (int bj = 0; bj < 2; ++bj) *(u32x4*)(base + (size_t)(ai * HALF + m * 16) * 16384 + bj * HALF) = pack8(acc[ai][bj][m][0] * r0[bj], acc[ai][bj][m][1] * r1[bj]);
    }
};
template <class Epi, class Sched, bool ALIGN_EPI = false, bool SP2 = false>
__device__ __forceinline__ void gemm_phase(PG8_LAS unsigned char* lds, const Gemm g, const Sched& S, const Epi& E) {
    const int tid = threadIdx.x, wid = __builtin_amdgcn_readfirstlane(tid >> 6), lane = tid & 63, wr = wid >> 2, wc = wid & 3, fr = lane & 15, fq = lane >> 4;
    const int K = g.K, nt = K / BK;
    unsigned voffA[2], voffB[2];
#pragma unroll
    for (int i = 0; i < 2; ++i) { int R, C; stage_rc(tid * 16 + i * 8192, R, C); const int Rb = Epi::PERM ? ((R & ~31) + perm32(R & 31)) : R;
        voffA[i] = (unsigned)(R * K + C) * 2u; voffB[i] = (unsigned)(Rb * K + C) * 2u; }
    const size_t kstep = (size_t)(BK * 2);
    const size_t hstep = (size_t)HALF * K * 2;
    const size_t tstep = 2 * hstep;
    const unsigned ldsw = (unsigned)wid * 1024u;
    const int aoff = lds_byte(wr * 64 + fr, fq * 8), boff = lds_byte(wc * 32 + fr, fq * 8);
#define PG8_SA(b, h) (((b) * 2 + (h)) * HTB)
#define PG8_SB(b, h) ((4 + (b) * 2 + (h)) * HTB)
#define PG8_STAGE(bufoff, gbase, voff) do { _Pragma("unroll") for (int _i = 0; _i < 2; ++_i) \
        __builtin_amdgcn_global_load_lds((const unsigned*)((const char*)(gbase) + (voff)[_i]), (PG8_LAS unsigned*)(lds + (bufoff) + ldsw + _i * 8192), 16, 0, 0); } while (0)
#define PG8_LDA(dst, b, h) do { _Pragma("unroll") for (int m = 0; m < 4; ++m) _Pragma("unroll") for (int k = 0; k < 2; ++k) dst[m][k] = *(const PG8_LAS bf16x8*)(lds + PG8_SA(b, h) + aoff + m * 2048 + k * 1024); } while (0)
#define PG8_LDB(dst, b, h) do { _Pragma("unroll") for (int n = 0; n < 2; ++n) _Pragma("unroll") for (int k = 0; k < 2; ++k) dst[n][k] = *(const PG8_LAS bf16x8*)(lds + PG8_SB(b, h) + boff + n * 2048 + k * 1024); } while (0)
#define PG8_MMA(ai, bj, At, Bt) do { __builtin_amdgcn_s_setprio(1); _Pragma("unroll") for (int m = 0; m < 4; ++m) _Pragma("unroll") for (int n = 0; n < 2; ++n) _Pragma("unroll") for (int k = 0; k < 2; ++k) \
        acc[ai][bj][m][n] = __builtin_amdgcn_mfma_f32_16x16x32_bf16(Bt[n][k], At[m][k], acc[ai][bj][m][n], 0, 0, 0); __builtin_amdgcn_s_setprio(0); } while (0)
#define PG8_WAIT_V(n) asm volatile("s_waitcnt vmcnt(" #n ")" ::: "memory")
#define PG8_WAIT_L(n) asm volatile("s_waitcnt lgkmcnt(" #n ")" ::: "memory")
#define PG8_BAR __builtin_amdgcn_s_barrier()
#define PG8_SCHED __builtin_amdgcn_sched_barrier(0)
    Unit cur, nxt; int ui = 0;
    if (!S.next(0, cur)) return;
    f32x4 acc[2][2][4][2];
#pragma unroll
    for (int a = 0; a < 2; ++a)
#pragma unroll
        for (int b = 0; b < 2; ++b)
#pragma unroll
            for (int m = 0; m < 4; ++m)
#pragma unroll
                for (int n = 0; n < 2; ++n) acc[a][b][m][n] = (f32x4){0.f, 0.f, 0.f, 0.f};
    bf16x8 At[4][2], B0[2][2], B1[2][2];
    const char* cA = (const char*)g.A + (size_t)cur.pm * tstep; const char* cB = (const char*)g.Bt + (size_t)cur.pn * tstep;
    S.a_ready(cur);
    if constexpr (SP2) {
        PG8_STAGE(PG8_SB(0, 0), cB, voffB); PG8_STAGE(PG8_SB(0, 1), cB + hstep, voffB); PG8_STAGE(PG8_SA(0, 0), cA, voffA); PG8_STAGE(PG8_SA(0, 1), cA + hstep, voffA);
        if (wr == 1) PG8_BAR;
        PG8_WAIT_V(2); PG8_BAR;
        PG8_STAGE(PG8_SB(1, 0), cB + kstep, voffB); PG8_STAGE(PG8_SA(1, 0), cA + kstep, voffA); PG8_STAGE(PG8_SB(1, 1), cB + hstep + kstep, voffB);
        PG8_WAIT_V(6); PG8_BAR;
    } else {
        PG8_STAGE(PG8_SB(0, 0), cB, voffB); PG8_STAGE(PG8_SA(0, 0), cA, voffA); PG8_STAGE(PG8_SB(0, 1), cB + hstep, voffB); PG8_STAGE(PG8_SA(0, 1), cA + hstep, voffA);
        if (wr == 1) PG8_BAR;
        PG8_WAIT_V(4); PG8_BAR;
        PG8_STAGE(PG8_SB(1, 0), cB + kstep, voffB); PG8_STAGE(PG8_SA(1, 0), cA + kstep, voffA); PG8_STAGE(PG8_SB(1, 1), cB + hstep + kstep, voffB);
        PG8_WAIT_V(6); PG8_BAR;
    }
    for (;;) {
        const bool has_next = S.next(ui + 1, nxt);
        const char* nA = has_next ? (const char*)g.A + (size_t)nxt.pm * tstep : cA; const char* nB = has_next ? (const char*)g.Bt + (size_t)nxt.pn * tstep : cB;
        for (int t = 0; t < nt; t += 2) {
            const bool last = (t == nt - 2);
            const char* a1 = cA + (size_t)(t + 1) * kstep;
            const char* a2 = last ? nA : cA + (size_t)(t + 2) * kstep; const char* b2 = last ? nB : cB + (size_t)(t + 2) * kstep;
            const char* a3 = a2 + kstep; const char* b3 = b2 + kstep;
            if (last && has_next) S.a_ready(nxt);
            if constexpr (SP2) {
            PG8_LDB(B0, 0, 0); PG8_LDB(B1, 0, 1); PG8_SCHED; PG8_LDA(At, 0, 0); PG8_STAGE(PG8_SA(1, 1), a1 + hstep, voffA);
            PG8_WAIT_V(8); PG8_WAIT_L(0); PG8_BAR; PG8_MMA(0, 0, At, B0); PG8_MMA(0, 1, At, B1); PG8_BAR; PG8_SCHED;
            PG8_LDA(At, 0, 1); PG8_STAGE(PG8_SB(0, 0), b2, voffB); PG8_STAGE(PG8_SB(0, 1), b2 + hstep, voffB); PG8_STAGE(PG8_SA(0, 0), a2, voffA);
            PG8_WAIT_V(8); PG8_WAIT_L(0); PG8_BAR; PG8_MMA(1, 0, At, B0); PG8_MMA(1, 1, At, B1); PG8_BAR; PG8_SCHED;
            PG8_LDB(B0, 1, 0); PG8_LDB(B1, 1, 1); PG8_SCHED; PG8_LDA(At, 1, 0); PG8_STAGE(PG8_SA(0, 1), a2 + hstep, voffA);
            PG8_WAIT_V(8); PG8_WAIT_L(0); PG8_BAR; PG8_MMA(0, 0, At, B0); PG8_MMA(0, 1, At, B1); PG8_BAR; PG8_SCHED;
            PG8_LDA(At, 1, 1); PG8_STAGE(PG8_SB(1, 0), b3, voffB); PG8_STAGE(PG8_SB(1, 1), b3 + hstep, voffB); PG8_STAGE(PG8_SA(1, 0), a3, voffA);
            PG8_WAIT_V(8); PG8_WAIT_L(0); PG8_BAR; PG8_MMA(1, 0, At, B0); PG8_MMA(1, 1, At, B1); PG8_BAR; PG8_SCHED;
            } else {
            PG8_LDB(B0, 0, 0); PG8_SCHED; PG8_LDA(At, 0, 0); PG8_STAGE(PG8_SA(1, 1), a1 + hstep, voffA);
            PG8_WAIT_L(8); PG8_BAR; PG8_WAIT_L(0); PG8_MMA(0, 0, At, B0); PG8_BAR; PG8_SCHED;
            PG8_LDB(B1, 0, 1); PG8_STAGE(PG8_SB(0, 0), b2, voffB);
            PG8_BAR; PG8_WAIT_L(0); PG8_MMA(0, 1, At, B1); PG8_BAR;
            PG8_LDA(At, 0, 1); PG8_STAGE(PG8_SA(0, 0), a2, voffA);
            PG8_BAR; PG8_WAIT_L(0); PG8_MMA(1, 0, At, B0); PG8_BAR; PG8_SCHED;
            PG8_STAGE(PG8_SB(0, 1), b2 + hstep, voffB);
            PG8_WAIT_V(6); PG8_BAR; PG8_MMA(1, 1, At, B1); PG8_BAR;
            PG8_LDB(B0, 1, 0); PG8_SCHED; PG8_LDA(At, 1, 0); PG8_STAGE(PG8_SA(0, 1), a2 + hstep, voffA);
            PG8_WAIT_L(8); PG8_BAR; PG8_WAIT_L(0); PG8_MMA(0, 0, At, B0); PG8_BAR; PG8_SCHED;
            PG8_LDB(B1, 1, 1); PG8_STAGE(PG8_SB(1, 0), b3, voffB);
            PG8_BAR; PG8_WAIT_L(0); PG8_MMA(0, 1, At, B1); PG8_BAR;
            PG8_LDA(At, 1, 1); PG8_STAGE(PG8_SA(1, 0), a3, voffA);
            PG8_BAR; PG8_WAIT_L(0); PG8_MMA(1, 0, At, B0); PG8_BAR; PG8_SCHED;
            PG8_STAGE(PG8_SB(1, 1), b3 + hstep, voffB);
            PG8_WAIT_V(6); PG8_BAR; PG8_MMA(1, 1, At, B1); PG8_BAR;
            }
        }
        if constexpr (ALIGN_EPI) { if (wr == 0) PG8_BAR; }
        if constexpr (!Epi::AFTER_DRAIN) { E(acc, cur, wr, wc, fr, fq); S.done(cur); }
        if (!has_next) break;
#pragma unroll
        for (int a = 0; a < 2; ++a)
#pragma unroll
            for (int b = 0; b < 2; ++b)
#pragma unroll
                for (int m = 0; m < 4; ++m)
#pragma unroll
                    for (int n = 0; n < 2; ++n) acc[a][b][m][n] = (f32x4){0.f, 0.f, 0.f, 0.f};
        cur = nxt; cA = nA; cB = nB; ++ui;
        if constexpr (ALIGN_EPI) { if (wr == 1) PG8_BAR; }
    }
    PG8_WAIT_V(0);
    if constexpr (!ALIGN_EPI) { if (wr == 0) PG8_BAR; }
    PG8_BAR;
    if constexpr (Epi::AFTER_DRAIN) { E.fused(acc, cur, wr, wc, fr, fq, lds, wid, lane); S.done(cur); }
#undef PG8_SA
#undef PG8_SB
#undef PG8_STAGE
#undef PG8_LDA
#undef PG8_LDB
#undef PG8_MMA
#undef PG8_WAIT_V
#undef PG8_WAIT_L
#undef PG8_BAR
#undef PG8_SCHED
}
}
#define GAS __attribute__((address_space(1)))
#define LAS __attribute__((address_space(3)))
typedef unsigned short bf16;
typedef unsigned v4u __attribute__((ext_vector_type(4)));
typedef unsigned v2u __attribute__((ext_vector_type(2)));
typedef float f32x4 __attribute__((ext_vector_type(4)));
constexpr int NWAVES = 8;
constexpr int LDS_BYTES = 147456, LDSCTL_OFF = 131072;
constexpr int CW_BAR = 4096;
constexpr size_t MiB = 1u << 20;
constexpr size_t WS_CTL = 0, CTL_BYTES = 1 * MiB;
constexpr size_t WS_SSQ_A = 256 * 1024, WS_SSQ_B = 320 * 1024, WS_SSQ_C = 384 * 1024, WS_SSQ_D = 448 * 1024;
constexpr size_t WS_STAMP = 128 * 1024;
constexpr size_t WS_BCTR = 192 * 1024;
constexpr size_t WS_SU = 512 * 1024, WS_SV = 768 * 1024;
constexpr size_t WS_WCS = 1 * MiB, WS_ROPE = 2 * MiB, WS_KEYS = 3 * MiB;
constexpr size_t WS_WOF = 8 * MiB, WS_WQKV = 16 * MiB, WS_WOA = 28 * MiB, WS_WQ0 = 36 * MiB, WS_WQ1 = 44 * MiB;
constexpr size_t WS_A2 = 64 * MiB, WS_TW = 65 * MiB;
constexpr size_t WS_U0 = 128 * MiB, WS_V0 = 192 * MiB, WS_U1 = 256 * MiB, WS_V1 = 320 * MiB;
constexpr size_t WS_XG = 384 * MiB, WS_XB = 384 * MiB;
constexpr size_t WS_ZT = 448 * MiB;
constexpr size_t WS_Y = 576 * MiB;
constexpr size_t WS_Q = 448 * MiB;
constexpr size_t WS_EI = 640 * MiB, WS_GW = 648 * MiB, WS_W1 = 656 * MiB;
constexpr size_t WS_PD = 448 * MiB;
constexpr size_t WS_QB = 448 * MiB, WS_KB = 512 * MiB, WS_VT = 528 * MiB, WS_O = 576 * MiB;

__device__ __forceinline__ unsigned f2bf(float f) { unsigned u = __builtin_bit_cast(unsigned, f); return (u + 0x7fffu + ((u >> 16) & 1u)) >> 16; }
__device__ __forceinline__ unsigned pk2(float lo, float hi) { return f2bf(lo) | (f2bf(hi) << 16); }

struct Args { const float* in[12]; float* out; unsigned char* ws; int ph_lo, ph_hi; };

__device__ __forceinline__ int qkv_row(int n) { if (n >= 2560) return n; const int d = n & 63, pc = (d < 32) ? 2 * d : 2 * (d - 32) + 1; return (n & ~63) + pc; }
template <int MODE>
__device__ __forceinline__ void transpose_item(const float* W, int K, int N, const float* gain, bf16* WT, LAS float* scr, int item, int lane) {
    const int nblk = N / 32, kb = item / nblk, nb = item % nblk, k0 = 64 * kb, n0 = 32 * nb;
#pragma unroll 8
    for (int i = 0; i < 32; ++i) { const int kk = 2 * i + (lane >> 5); float v = W[(size_t)(k0 + kk) * N + n0 + (lane & 31)]; if (gain) v *= gain[k0 + kk]; scr[kk * 33 + (lane & 31)] = v; }
    asm volatile("s_waitcnt lgkmcnt(0)" ::: "memory");
    const int c = lane & 7;
#pragma unroll
    for (int j = 0; j < 4; ++j) { const int n = (lane >> 3) + 8 * j; const LAS float* s = scr + (8 * c) * 33 + n;
        v4u o; o.x = pk2(s[0 * 33], s[1 * 33]); o.y = pk2(s[2 * 33], s[3 * 33]); o.z = pk2(s[4 * 33], s[5 * 33]); o.w = pk2(s[6 * 33], s[7 * 33]);
        const int row = (MODE == 1) ? qkv_row(n0 + n) : (n0 + n);
        *(v4u*)(WT + (size_t)row * K + k0 + 8 * c) = o; }
    asm volatile("s_waitcnt lgkmcnt(0)" ::: "memory");
}
__device__ __forceinline__ float wsum(float v) {
#pragma unroll
    for (int o = 1; o < 64; o <<= 1) v += __shfl_xor(v, o);
    return v;
}
__device__ __forceinline__ void cvt_stream(const float* src, bf16* dst, size_t n8, size_t gtid, size_t ngt) {
    for (size_t i = gtid; i < n8; i += ngt) {
        const f32x4 a = *(const f32x4*)(src + i * 8), b = *(const f32x4*)(src + i * 8 + 4);
        v4u o; o.x = pk2(a[0], a[1]); o.y = pk2(a[2], a[3]); o.z = pk2(b[0], b[1]); o.w = pk2(b[2], b[3]);
        *(v4u*)(dst + i * 8) = o;
    }
}
__device__ __forceinline__ void cvt_stream8(const float* src, unsigned char* dst, size_t n16, size_t gtid, size_t ngt, float scale) {
    for (size_t i = gtid; i < n16; i += ngt) {
        v4u o;
#pragma unroll
        for (int q = 0; q < 4; ++q) { f32x4 a = *(const f32x4*)(src + i * 16 + 4 * q) * scale;
#pragma unroll
            for (int e = 0; e < 4; ++e) a[e] = fminf(fmaxf(a[e], -448.f), 448.f);
            int w = 0; w = __builtin_amdgcn_cvt_pk_fp8_f32(a[0], a[1], w, false); w = __builtin_amdgcn_cvt_pk_fp8_f32(a[2], a[3], w, true); o[q] = (unsigned)w; }
        const size_t e = i >> 7, r = i & 127, sl = r >> 3, c8 = r & 7;
        *(v4u*)(dst + ((sl * 16384 + e) * 128 + c8 * 16)) = o;
    }
}
#define XB_TMO      128
#define XB_XCNT(j)  (256  + 64 * (j))
#define XB_XSUB(j)  (1280 + 64 * (j))
#define XB_XGEN(j)  (2304 + 64 * (j))
#define XB_TOP      3328
#define XB_TOPGEN   3392
#define XCD_BAR_WORDS 3456
#define XB_SPIN_CAP (1u << 18)

__device__ __forceinline__ unsigned xb_ld(unsigned* p)              { return __hip_atomic_load(p, __ATOMIC_RELAXED, __HIP_MEMORY_SCOPE_AGENT); }
__device__ __forceinline__ unsigned xb_add(unsigned* p, unsigned v) { return __hip_atomic_fetch_add(p, v, __ATOMIC_RELAXED, __HIP_MEMORY_SCOPE_AGENT); }
__device__ __forceinline__ unsigned xb_xcc_id() { return (unsigned)__builtin_amdgcn_s_getreg((3 << 11) | 20) & 0xFu; }
#define XB_SPIN(cond, bar) do { unsigned _sp = 0; while (cond) { __builtin_amdgcn_s_sleep(1); \
    if ((++_sp & 255u) == 0u) { if (xb_ld(&(bar)[XB_TMO])) break; if (_sp > XB_SPIN_CAP) { atomicAdd(&(bar)[XB_TMO], 1u); break; } } } } while (0)

struct XcdBarrier {
    unsigned* bar; unsigned x;
    volatile LAS unsigned* st;
};

__device__ __forceinline__ XcdBarrier xcd_barrier_post(unsigned* bar, volatile LAS unsigned* st) {
    XcdBarrier b; b.bar = bar; b.x = xb_xcc_id(); b.st = st;
    if (threadIdx.x == 0) (void)xb_add(&bar[XB_XCNT(b.x)], 1u);
    return b;
}
__device__ __forceinline__ void xcd_barrier_complete(unsigned* bar, unsigned x, unsigned& nloc, unsigned& nx) {
    const unsigned G = gridDim.x * gridDim.y * gridDim.z;
    unsigned sum, cnt, mine, sp = 0u;
    for (;;) {
        sum = 0u; cnt = 0u; mine = 0u;
#pragma unroll
        for (unsigned j = 0; j < 16; ++j) { const unsigned c = xb_ld(&bar[XB_XCNT(j)]); sum += c; cnt += (c > 0u) ? 1u : 0u; mine = (j == x) ? c : mine; }
        if (sum == G) break;
        __builtin_amdgcn_s_sleep(1);
        if ((++sp & 255u) == 0u) { if (xb_ld(&bar[XB_TMO])) break; if (sp > XB_SPIN_CAP) { atomicAdd(&bar[XB_TMO], 1u); break; } }
    }
    nloc = mine > 0u ? mine : 1u; nx = cnt > 0u ? cnt : 1u;
}

__device__ __forceinline__ void xcd_barrier(const XcdBarrier& b) {
    asm volatile("s_waitcnt vmcnt(0)" ::: "memory");
    __syncthreads();
    if (threadIdx.x == 0) {
        unsigned* bar = b.bar;
        __builtin_amdgcn_s_waitcnt(0);
        unsigned nloc = b.st[0], nx = b.st[1];
        if (nloc == 0u) { xcd_barrier_complete(bar, b.x, nloc, nx); b.st[0] = nloc; b.st[1] = nx; }
        const unsigned old = xb_add(&bar[XB_XSUB(b.x)], 1u);
        const unsigned gen = old / nloc;
        if (old + 1u == (gen + 1u) * nloc) {
            __builtin_amdgcn_fence(__ATOMIC_RELEASE, "agent");
            asm volatile("s_waitcnt vmcnt(0)" ::: "memory");
            const unsigned og = xb_add(&bar[XB_TOP], 1u);
            const unsigned tg = og / nx;
            if (og + 1u == (tg + 1u) * nx) xb_add(&bar[XB_TOPGEN], 1u);
            else XB_SPIN(xb_ld(&bar[XB_TOPGEN]) == tg, bar);
            __builtin_amdgcn_fence(__ATOMIC_ACQUIRE, "agent");
            xb_add(&bar[XB_XGEN(b.x)], 1u);
            asm volatile("s_waitcnt vmcnt(0)" ::: "memory");
        } else {
            XB_SPIN(xb_ld(&bar[XB_XGEN(b.x)]) == gen, bar);
            __builtin_amdgcn_fence(__ATOMIC_ACQUIRE, "agent");
            asm volatile("s_waitcnt vmcnt(0)" ::: "memory");
        }
    }
    __syncthreads();
}
#define U_SCALE 1024.f
#define V_SCALE 256.f
typedef float f32x16 __attribute__((ext_vector_type(16)));
#ifndef TKB
#define TKB 2
#endif
typedef short s16x8 __attribute__((ext_vector_type(8)));
typedef __bf16 bf16x2_t __attribute__((ext_vector_type(2)));
__device__ __forceinline__ unsigned ordf(float f) { const unsigned u = __float_as_uint(f); return (u & 0x80000000u) ? ~u : (u | 0x80000000u); }
__device__ __forceinline__ float unordf(unsigned u) { return __uint_as_float((u & 0x80000000u) ? (u & 0x7fffffffu) : ~u); }
__device__ __forceinline__ unsigned umax_(unsigned a, unsigned b) { return a > b ? a : b; }
#define DPPU(v, ctrl) ((unsigned)__builtin_amdgcn_update_dpp(0, (int)(v), (ctrl), 0xf, 0xf, true))
#define DPPF(v, ctrl) __int_as_float(__builtin_amdgcn_update_dpp(0, __float_as_int(v), (ctrl), 0xf, 0xf, true))
__device__ __forceinline__ unsigned max32(unsigned v) {
    v = umax_(v, DPPU(v, 0xB1)); v = umax_(v, DPPU(v, 0x4E)); v = umax_(v, DPPU(v, 0x141)); v = umax_(v, DPPU(v, 0x140));
    const auto r = __builtin_amdgcn_permlane16_swap(v, v, false, false);
    return umax_(r[0], r[1]);
}
__device__ __forceinline__ float sum16(float v) {
    v += DPPF(v, 0xB1); v += DPPF(v, 0x4E); v += DPPF(v, 0x141); v += DPPF(v, 0x140); return v;
}
__device__ __forceinline__ unsigned bperm(unsigned v, int srclane) { return (unsigned)__builtin_amdgcn_ds_bpermute(srclane << 2, (int)v); }
#define CMPX(a_, b_) do { const unsigned hi_ = umax_(a_, b_), lo_ = (a_ < b_) ? a_ : b_; a_ = hi_; b_ = lo_; } while (0)
__device__ __forceinline__ unsigned max16(unsigned v) { v = umax_(v, DPPU(v, 0xB1)); v = umax_(v, DPPU(v, 0x4E)); v = umax_(v, DPPU(v, 0x141)); v = umax_(v, DPPU(v, 0x140)); return v; }
__device__ __forceinline__ unsigned top16_of8(unsigned (&p)[8], int c) {
    CMPX(p[0], p[1]); CMPX(p[2], p[3]); CMPX(p[4], p[5]); CMPX(p[6], p[7]);
    CMPX(p[0], p[2]); CMPX(p[1], p[3]); CMPX(p[4], p[6]); CMPX(p[5], p[7]);
    CMPX(p[1], p[2]); CMPX(p[5], p[6]); CMPX(p[0], p[4]); CMPX(p[3], p[7]);
    CMPX(p[1], p[5]); CMPX(p[2], p[6]);
    CMPX(p[1], p[4]); CMPX(p[3], p[6]);
    CMPX(p[2], p[4]); CMPX(p[3], p[5]);
    CMPX(p[3], p[4]);
    unsigned W = 0u;
    for (int it = 0; it < 16; ++it) {
        const unsigned m = max16(p[0]);
        W = (c == it) ? m : W;
        const bool win = (p[0] == m);
#pragma unroll
        for (int i = 0; i < 7; ++i) p[i] = win ? p[i + 1] : p[i];
        p[7] = win ? 0u : p[7];
    }
    return W;
}
__device__ __forceinline__ unsigned top16_of4r(unsigned (&p)[4], int c) {
    CMPX(p[0], p[1]); CMPX(p[2], p[3]); CMPX(p[0], p[2]); CMPX(p[1], p[3]); CMPX(p[1], p[2]);
    unsigned W = 0u;
    for (int it = 0; it < 16; ++it) {
        const unsigned m = max16(p[0]);
        W = (c == it) ? m : W;
        const bool win = (p[0] == m);
        p[0] = win ? p[1] : p[0]; p[1] = win ? p[2] : p[1]; p[2] = win ? p[3] : p[2]; p[3] = win ? 0u : p[3];
    }
    return W;
}
__device__ __forceinline__ void topk_fill(LAS unsigned char* lds, const bf16* keys, int h, int tid) {
#pragma unroll
    for (int i = 0; i < 8; ++i) { const int idx = tid + 512 * i, p = idx >> 11, key = (idx >> 4) & 127, ch = idx & 15;
        const v4u v = *(const v4u*)(keys + (size_t)((h * 2 + p) * 128 + key) * 128 + ch * 8);
        *(LAS v4u*)(lds + p * 32768 + key * 256 + ((ch ^ (key & 15)) << 4)) = v; }
}
struct CvtCtx { const float* srcU; long dsrc; const float* gain; unsigned char* dstU; long ddst; float* su; long dsc; int gwave, nw; };
__device__ __forceinline__ void cvt_chunk_load(const CvtCtx& cx, int c, int lane, f32x4 (&v)[4]) {
    const int r = c >> 1, hh = c & 1;
    const float* src = cx.srcU + ((r < 16384) ? 0L : cx.dsrc) + (size_t)(r & 16383) * 2048 + hh * 1024 + 4 * lane;
#pragma unroll
    for (int j = 0; j < 4; ++j) v[j] = *(const f32x4*)(src + 256 * j);
}
__device__ __forceinline__ void cvt_chunk_store(const CvtCtx& cx, int c, int lane, f32x4 (&v)[4]) {
    const int r = c >> 1, hh = c & 1; const bool isu = r < 16384; const int e = r & 16383;
    float mx = 0.f;
#pragma unroll
    for (int j = 0; j < 4; ++j) { if (isu) v[j] = v[j] * *(const f32x4*)(cx.gain + hh * 1024 + 256 * j + 4 * lane);
        mx = fmaxf(mx, fmaxf(fmaxf(fabsf(v[j][0]), fabsf(v[j][1])), fmaxf(fabsf(v[j][2]), fabsf(v[j][3])))); }
    mx = fmaxf(mx, DPPF(mx, 0xB1)); mx = fmaxf(mx, DPPF(mx, 0x4E)); mx = fmaxf(mx, DPPF(mx, 0x141)); mx = fmaxf(mx, DPPF(mx, 0x140));
    { const auto rr = __builtin_amdgcn_permlane16_swap(__float_as_uint(mx), __float_as_uint(mx), false, false); mx = fmaxf(__uint_as_float(rr[0]), __uint_as_float(rr[1])); }
    { const auto rr = __builtin_amdgcn_permlane32_swap(__float_as_uint(mx), __float_as_uint(mx), false, false); mx = fmaxf(__uint_as_float(rr[0]), __uint_as_float(rr[1])); }
    const float sc = fmaxf(mx, 1e-30f) * (1.f / 6.f), inv = 1.f / sc;
    if (lane == 0) (cx.su + (isu ? 0L : cx.dsc))[e * 2 + hh] = sc;
    unsigned char* dst = cx.dstU + (isu ? 0L : cx.ddst) + ((size_t)(hh * 4) * 16384 + e) * 128 + 2 * lane;
#pragma unroll
    for (int j = 0; j < 4; ++j) { unsigned w = 0u;
        w = __builtin_amdgcn_cvt_scalef32_pk_fp4_f32(w, v[j][0] * inv, v[j][1] * inv, 1.0f, 0); w = __builtin_amdgcn_cvt_scalef32_pk_fp4_f32(w, v[j][2] * inv, v[j][3] * inv, 1.0f, 1);
        *(unsigned short*)(dst + (size_t)j * (16384 * 128)) = (unsigned short)w; }
}
__device__ __forceinline__ void topk_unit(const bf16* q, LAS const unsigned char* lds, int* EI, float* GW, int t0, int h, int lane) {
    const int c = lane & 15, g4 = lane >> 4, rbase = lane & 48;
    int f0 = 0, f1 = 0, f2 = 0, f3 = 0;
    { int cnt = 0;
#pragma unroll
      for (int i = 0; i < 16; ++i)
#pragma unroll
        for (int j = 0; j < 16; ++j) if ((i + 1) * (j + 1) <= 16) { const int fl = i * 16 + j; f0 = (cnt == c) ? fl : f0; f1 = (cnt == c + 16) ? fl : f1; f2 = (cnt == c + 32) ? fl : f2; f3 = (cnt == c + 48) ? fl : f3; ++cnt; } }
    unsigned W[2][8];
#pragma unroll
    for (int p = 0; p < 2; ++p) {
        f32x4 acc[2][8];
#pragma unroll
        for (int mb = 0; mb < 2; ++mb)
#pragma unroll
            for (int kb = 0; kb < 8; ++kb) acc[mb][kb] = (f32x4){0.f, 0.f, 0.f, 0.f};
        const bf16* qp = q + (size_t)(t0 + c) * 2048 + h * 256 + p * 128 + g4 * 8;
        LAS const unsigned char* kp = lds + p * 32768 + c * 256;
        asm volatile("" : "+v"(qp));
#pragma unroll 2
        for (int ks = 0; ks < 4; ++ks) {
            const s16x8 a0 = *(const s16x8*)(qp + ks * 32), a1 = *(const s16x8*)(qp + (size_t)16 * 2048 + ks * 32);
#pragma unroll
            for (int kb = 0; kb < 8; ++kb) { const s16x8 b = *(LAS const s16x8*)(kp + kb * 4096 + (((4 * ks + g4) ^ c) << 4));
                acc[0][kb] = __builtin_amdgcn_mfma_f32_16x16x32_bf16(a0, b, acc[0][kb], 0, 0, 0); acc[1][kb] = __builtin_amdgcn_mfma_f32_16x16x32_bf16(a1, b, acc[1][kb], 0, 0, 0); }
        }
#pragma unroll
        for (int pb = 0; pb < 8; ++pb) {
            unsigned pk[8];
#pragma unroll
            for (int kb = 0; kb < 8; ++kb) pk[kb] = (ordf(acc[pb >> 2][kb][pb & 3]) & ~127u) | (unsigned)(127 - 16 * kb - c);
            W[p][pb] = top16_of8(pk, c);
        }
    }
#pragma unroll
    for (int pb = 0; pb < 8; ++pb) {
        const unsigned w0 = W[0][pb], w1 = W[1][pb];
        unsigned cp[4];
        { const float a0 = unordf(bperm(w0, rbase + (f0 >> 4)) & ~127u), b0 = unordf(bperm(w1, rbase + (f0 & 15)) & ~127u); cp[0] = (ordf(a0 + b0) & ~63u) | (unsigned)(63 - c); }
        { const float a0 = unordf(bperm(w0, rbase + (f1 >> 4)) & ~127u), b0 = unordf(bperm(w1, rbase + (f1 & 15)) & ~127u); cp[1] = (ordf(a0 + b0) & ~63u) | (unsigned)(47 - c); }
        { const float a0 = unordf(bperm(w0, rbase + (f2 >> 4)) & ~127u), b0 = unordf(bperm(w1, rbase + (f2 & 15)) & ~127u); cp[2] = (ordf(a0 + b0) & ~63u) | (unsigned)(31 - c); }
        { const float a0 = unordf(bperm(w0, rbase + (f3 >> 4)) & ~127u), b0 = unordf(bperm(w1, rbase + (f3 & 15)) & ~127u); cp[3] = (c + 48 < 50) ? ((ordf(a0 + b0) & ~63u) | (unsigned)(15 - c)) : 0u; }
        const unsigned Wc = top16_of4r(cp, c);
        const int slot = 63 - (int)(Wc & 63u);
        const unsigned fa = bperm((unsigned)f0, rbase + (slot & 15)), fb = bperm((unsigned)f1, rbase + (slot & 15)), fc = bperm((unsigned)f2, rbase + (slot & 15)), fd = bperm((unsigned)f3, rbase + (slot & 15));
        const int sq = slot >> 4; const int flat = (int)((sq == 0) ? fa : (sq == 1) ? fb : (sq == 2) ? fc : fd);
        const float val = unordf(Wc & ~63u);
        const float vmax = __uint_as_float(bperm(__float_as_uint(val), rbase));
        const float e = __expf(val - vmax);
        const float g = e / sum16(e);
        const int k1 = 127 - (int)(bperm(w0, rbase + (flat >> 4)) & 127u), k2 = 127 - (int)(bperm(w1, rbase + (flat & 15)) & 127u);
        const int tok = t0 + 16 * (pb >> 2) + 4 * g4 + (pb & 3);
        EI[(size_t)(tok * 8 + h) * 16 + c] = k1 * 128 + k2; GW[(size_t)(tok * 8 + h) * 16 + c] = g;
    }
}

__device__ __forceinline__ float gelu_tanh_f(float x) {
    const float u = 0.7978845608028654f * (x + 0.044715f * x * x * x);
    const float e = __expf(2.f * u);
    const float th = 1.f - 2.f / (e + 1.f);
    return 0.5f * x * (1.f + th);
}
__device__ __forceinline__ float wave_sum_bfly(float v) {
#pragma unroll
    for (int o = 1; o < 64; o <<= 1) v += __shfl_xor(v, o);
    return v;
}
typedef float f32x2_ __attribute__((ext_vector_type(2)));
#define FP4_DEC(w_, sel_) __builtin_amdgcn_cvt_scalef32_pk_f32_fp4((unsigned)(w_), 1.0f, (sel_))
typedef int i32x8 __attribute__((ext_vector_type(8)));
template <int NBT>
__device__ __forceinline__ void peer_a_slice(const bf16* xb, const int* EI, const unsigned char* U4s, float* pd, int s, unsigned* ctr, int nbatch, int lane) {
    const int c = lane & 15, g4 = lane >> 4, k8 = c >> 1;
    const unsigned char* tab = U4s + (size_t)s * (16384 * 128) + (4 * (c & 1) + g4) * 16;
#define A_FETCH() ((int)__builtin_amdgcn_readfirstlane((int)((lane == 0) ? __hip_atomic_fetch_add(ctr, 1u, __ATOMIC_RELAXED, __HIP_MEMORY_SCOPE_AGENT) : 0u)))
#define A_TOKB(b_, j_) ((((b_) < nbatch) ? (b_) : (nbatch - 1)) * NBT + (j_))
#define A_XS(XS, t_) do { const bf16* xp_ = xb + (size_t)(t_) * 2048 + s * 256 + 128 * (c & 1) + 16 * g4; XS[0] = *(const v4u*)xp_; XS[1] = *(const v4u*)(xp_ + 8); XS[2] = *(const v4u*)(xp_ + 64); XS[3] = *(const v4u*)(xp_ + 72); } while (0)
#define A_ISSUE(U, EV) do { _Pragma("unroll") for (int i = 0; i < 8; ++i) { const int e_ = (int)bperm((unsigned)(EV), (i << 3) + k8); U[i] = *(const v4u*)(tab + (size_t)e_ * 128); } } while (0)
#define A_COMPUTE(U, OUT) do { _Pragma("unroll") for (int i = 0; i < 8; ++i) { f32x4 d_ = (f32x4){0.f, 0.f, 0.f, 0.f}; \
            d_ = __builtin_amdgcn_mfma_scale_f32_16x16x128_f8f6f4((i32x8){(int)U[i][0], (int)U[i][1], (int)U[i][2], (int)U[i][3], 0, 0, 0, 0}, hb, d_, 4, 0, 0, 0x7f7f7f7f, 0, 0x7f7f7f7f); \
            const float o0_ = d_[0] + DPPF(d_[1], 0xB1), o1_ = d_[2] + DPPF(d_[3], 0xB1);        \
            if (k8 == i) OUT = (f32x2_){o0_, o1_}; } } while (0)
    int eL[NBT], eH[NBT], nL[NBT], nH[NBT]; v4u xs[2][4]; v4u UA[8], UB[8];
    int b0 = A_FETCH(), b1 = A_FETCH();
    if (b0 >= nbatch) return;
#pragma unroll
    for (int j = 0; j < NBT; ++j) { const int tj = A_TOKB(b0, j); eL[j] = EI[(size_t)tj * 128 + lane]; eH[j] = EI[(size_t)tj * 128 + 64 + lane]; }
    A_XS(xs[0], A_TOKB(b0, 0));
    A_ISSUE(UA, eL[0]);
    while (b0 < nbatch) {
        const int b2 = A_FETCH();
#pragma unroll
        for (int j = 0; j < NBT; ++j) { const int tj = A_TOKB(b1, j); nL[j] = EI[(size_t)tj * 128 + lane]; nH[j] = EI[(size_t)tj * 128 + 64 + lane]; }
#pragma unroll
        for (int j = 0; j < NBT; ++j) {
            const int t = b0 * NBT + j;
            A_ISSUE(UB, eH[j]);
            i32x8 hb;
#pragma unroll
            for (int q = 0; q < 4; ++q) { const v4u w = xs[j & 1][q]; int lo = 0, hi = 0;
                lo = __builtin_amdgcn_cvt_pk_fp8_f32(__uint_as_float(w[0] << 16), __uint_as_float(w[0] & 0xffff0000u), lo, false); lo = __builtin_amdgcn_cvt_pk_fp8_f32(__uint_as_float(w[1] << 16), __uint_as_float(w[1] & 0xffff0000u), lo, true);
                hi = __builtin_amdgcn_cvt_pk_fp8_f32(__uint_as_float(w[2] << 16), __uint_as_float(w[2] & 0xffff0000u), hi, false); hi = __builtin_amdgcn_cvt_pk_fp8_f32(__uint_as_float(w[3] << 16), __uint_as_float(w[3] & 0xffff0000u), hi, true);
                hb[2 * q] = lo; hb[2 * q + 1] = hi; }
            f32x2_ out_lo = (f32x2_){0.f, 0.f}, out_hi = (f32x2_){0.f, 0.f};
            A_COMPUTE(UA, out_lo);
            A_XS(xs[(j + 1) & 1], (j + 1 < NBT) ? (b0 * NBT + j + 1) : A_TOKB(b1, 0));
            A_ISSUE(UA, (j + 1 < NBT) ? eL[(j + 1) % NBT] : nL[0]);
            A_COMPUTE(UB, out_hi);
            if ((c & 1) == 0) { float* pp = pd + ((size_t)s * T + t) * 128 + 8 * k8 + 2 * g4; *(f32x2_*)pp = out_lo; *(f32x2_*)(pp + 64) = out_hi; }
        }
#pragma unroll
        for (int j = 0; j < NBT; ++j) { eL[j] = nL[j]; eH[j] = nH[j]; }
        b0 = b1; b1 = b2;
    }
#undef A_FETCH
#undef A_TOKB
#undef A_XS
#undef A_ISSUE
#undef A_COMPUTE
}
__device__ __forceinline__ unsigned w8rep(float w) { const float s = fminf(fmaxf(w * 256.f, -448.f), 448.f); return ((unsigned)__builtin_amdgcn_cvt_pk_fp8_f32(s, 0.f, 0, false) & 0xffu) * 0x01010101u; }
__device__ __forceinline__ void peer_a2_token(const float* pd, const float* ssq, const int* EI, const float* su, const float* sv, float* GW, float* W1, int t, int lane) {
    float a0 = 0.f, a1 = 0.f, b0 = 0.f, b1 = 0.f;
#pragma unroll
    for (int s = 0; s < 4; ++s) { const float* pp = pd + ((size_t)s * T + t) * 128; a0 += pp[lane]; a1 += pp[64 + lane]; }
#pragma unroll
    for (int s = 4; s < 8; ++s) { const float* pp = pd + ((size_t)s * T + t) * 128; b0 += pp[lane]; b1 += pp[64 + lane]; }
    const float rs = rsqrtf(ssq[t] * (1.f / 2048.f) + EPS);
    float* gp = GW + (size_t)t * 128; float* hp = W1 + (size_t)t * 128; const int pl = lane;
    const int e0 = EI[(size_t)t * 128 + pl], e1 = EI[(size_t)t * 128 + 64 + pl];
    const float g0 = gp[pl] * gelu_tanh_f(rs * (a0 * su[2 * e0] + b0 * su[2 * e0 + 1])), g1 = gp[64 + pl] * gelu_tanh_f(rs * (a1 * su[2 * e1] + b1 * su[2 * e1 + 1]));
    unsigned* gu = (unsigned*)gp; unsigned* hu = (unsigned*)hp;
    gu[pl] = w8rep(g0 * sv[2 * e0]); hu[pl] = w8rep(g0 * sv[2 * e0 + 1]);
    gu[64 + pl] = w8rep(g1 * sv[2 * e1]); hu[64 + pl] = w8rep(g1 * sv[2 * e1 + 1]);
}
template <int NBT>
__device__ __forceinline__ void peer_b_slice(const bf16* xres, float* xio, const int* EI, const unsigned* W, const unsigned char* V4s, bf16* xb, float* ssq_out, int s, unsigned* ctr, int nbatch, int lane) {
    const int j16 = lane & 15, g4 = lane >> 4;
    const unsigned char* tab = V4s + (size_t)s * (16384 * 128) + 8 * j16;
    const int doff = s * 256 + 64 * g4 + j16;
    const unsigned bm = 0xffu << (8 * (j16 & 3)); const unsigned M0 = ((j16 >> 2) == 0) ? bm : 0u, M1 = ((j16 >> 2) == 1) ? bm : 0u, M2 = ((j16 >> 2) == 2) ? bm : 0u, M3 = ((j16 >> 2) == 3) ? bm : 0u;
#define B_FETCH() ((int)__builtin_amdgcn_readfirstlane((int)((lane == 0) ? __hip_atomic_fetch_add(ctr, 1u, __ATOMIC_RELAXED, __HIP_MEMORY_SCOPE_AGENT) : 0u)))
#define B_TOKB(b_, j_) ((((b_) < nbatch) ? (b_) : (nbatch - 1)) * NBT + (j_))
#define B_ISSUE(V, EV) do { _Pragma("unroll") for (int i = 0; i < 8; ++i) { const int e0_ = (int)bperm((unsigned)(EV), 8 * i + 2 * g4), e1_ = (int)bperm((unsigned)(EV), 8 * i + 2 * g4 + 1); \
        V[2 * i] = *(const v2u*)(tab + (size_t)e0_ * 128); V[2 * i + 1] = *(const v2u*)(tab + (size_t)e1_ * 128); } } while (0)
#define B_COMPUTE(V, WV) do { _Pragma("unroll") for (int i = 0; i < 8; ++i) { \
            const unsigned f0_ = bperm((WV), 8 * i + g4), f1_ = bperm((WV), 8 * i + 4 + g4);        \
            const i32x8 bq_ = (i32x8){(int)(f0_ & M0), (int)(f0_ & M1), (int)(f0_ & M2), (int)(f0_ & M3), (int)(f1_ & M0), (int)(f1_ & M1), (int)(f1_ & M2), (int)(f1_ & M3)}; \
            acc = __builtin_amdgcn_mfma_scale_f32_16x16x128_f8f6f4((i32x8){(int)V[2 * i][0], (int)V[2 * i][1], (int)V[2 * i + 1][0], (int)V[2 * i + 1][1], 0, 0, 0, 0}, bq_, acc, 4, 0, 0, 0x7f7f7f7f, 0, 0x77777777); } } while (0)
    int eL[NBT], eH[NBT], nL[NBT], nH[NBT]; unsigned wL[NBT], wH[NBT], mL[NBT], mH[NBT]; float xv[4]; v2u VA[16], VB[16];
    int b0 = B_FETCH(), b1 = B_FETCH();
    if (b0 >= nbatch) return;
#pragma unroll
    for (int j = 0; j < NBT; ++j) { const int tj = B_TOKB(b0, j); eL[j] = EI[(size_t)tj * 128 + lane]; eH[j] = EI[(size_t)tj * 128 + 64 + lane]; wL[j] = W[(size_t)tj * 128 + lane]; wH[j] = W[(size_t)tj * 128 + 64 + lane]; }
    B_ISSUE(VA, eL[0]);
    while (b0 < nbatch) {
        const int b2 = B_FETCH();
#pragma unroll
        for (int j = 0; j < NBT; ++j) { const int tj = B_TOKB(b1, j); nL[j] = EI[(size_t)tj * 128 + lane]; nH[j] = EI[(size_t)tj * 128 + 64 + lane]; mL[j] = W[(size_t)tj * 128 + lane]; mH[j] = W[(size_t)tj * 128 + 64 + lane]; }
#pragma unroll
        for (int j = 0; j < NBT; ++j) {
            const int t = b0 * NBT + j;
            float* xp = xio + (size_t)t * 2048 + doff; const bf16* rp = xres + (size_t)t * 2048 + doff;
#pragma unroll
            for (int r = 0; r < 4; ++r) xv[r] = __uint_as_float((unsigned)rp[16 * r] << 16);
            B_ISSUE(VB, eH[j]);
            f32x4 acc = (f32x4){0.f, 0.f, 0.f, 0.f};
            B_COMPUTE(VA, wL[j]);
            B_ISSUE(VA, (j + 1 < NBT) ? eL[(j + 1) % NBT] : nL[0]);
            B_COMPUTE(VB, wH[j]);
            float ss = 0.f;
#pragma unroll
            for (int r = 0; r < 4; ++r) { const float o = xv[r] + acc[r]; ss += o * o; if (xb) xb[(size_t)t * 2048 + doff + 16 * r] = (bf16)f2bf(o); else xp[16 * r] = o; }
            ss += DPPF(ss, 0xB1); ss += DPPF(ss, 0x4E); ss += DPPF(ss, 0x141); ss += DPPF(ss, 0x140);
            { const auto r = __builtin_amdgcn_permlane16_swap(__float_as_uint(ss), __float_as_uint(ss), false, false); ss = __uint_as_float(r[0]) + __uint_as_float(r[1]); }
            { const auto r = __builtin_amdgcn_permlane32_swap(__float_as_uint(ss), __float_as_uint(ss), false, false); ss = __uint_as_float(r[0]) + __uint_as_float(r[1]); }
            if (lane == 0) unsafeAtomicAdd(ssq_out + t, ss);
        }
#pragma unroll
        for (int j = 0; j < NBT; ++j) { eL[j] = nL[j]; eH[j] = nH[j]; wL[j] = mL[j]; wH[j] = mH[j]; }
        b0 = b1; b1 = b2;
    }
#undef B_FETCH
#undef B_TOKB
#undef B_ISSUE
#undef B_COMPUTE
}
__device__ __forceinline__ void final_norm_row(float* xio, const float* ssq, const float* fin, int t, int lane, float oscale) {
    const float r2 = rsqrtf(ssq[t] * (1.f / 2048.f) + EPS) * oscale;
    float* xr = xio + (size_t)t * 2048 + 4 * lane;
#pragma unroll
    for (int j = 0; j < 8; ++j) { const f32x4 xv = *(const f32x4*)(xr + 256 * j), g = *(const f32x4*)(fin + 256 * j + 4 * lane); f32x4 o;
        o[0] = xv[0] * r2 * g[0]; o[1] = xv[1] * r2 * g[1]; o[2] = xv[2] * r2 * g[2]; o[3] = xv[3] * r2 * g[3]; *(f32x4*)(xr + 256 * j) = o; }
}
typedef short s16x4 __attribute__((ext_vector_type(4)));
__device__ __forceinline__ unsigned cvt_pk_bf16_(float lo, float hi) { unsigned r; asm volatile("v_cvt_pk_bf16_f32 %0, %1, %2" : "=v"(r) : "v"(lo), "v"(hi)); return r; }
constexpr int ATT_K_OFF = 0, ATT_V_OFF = 40960, ATT_VSTRIDE = 648, ATT_LDS = ATT_V_OFF + 64 * ATT_VSTRIDE;
__device__ __forceinline__ void attn_fill_load(const bf16* K, const bf16* Vt, int b, int kvh, int kw0, int tid, v4u (&kr)[5], v2u (&vr)[10]) {
    const size_t tb = (size_t)b * 4096;
#pragma unroll
    for (int i = 0; i < 5; ++i) { const int idx = tid + 512 * i, row = idx >> 3, ch = idx & 7, key = kw0 + row;
        kr[i] = (v4u){0u, 0u, 0u, 0u}; if (key >= 0 && key < 4096) kr[i] = *(const v4u*)(K + (tb + key) * 512 + kvh * 64 + ch * 8); }
#pragma unroll
    for (int i = 0; i < 10; ++i) { const int idx = tid + 512 * i, d = idx / 80, pc = idx % 80, key = kw0 + pc * 4;
        vr[i] = (v2u){0u, 0u}; if (key >= 0 && key < 4096) vr[i] = *(const v2u*)(Vt + (size_t)(kvh * 64 + d) * 16384 + tb + key); }
}
__device__ __forceinline__ void attn_fill_store(LAS unsigned char* lds, int tid, const v4u (&kr)[5], const v2u (&vr)[10]) {
#pragma unroll
    for (int i = 0; i < 5; ++i) { const int idx = tid + 512 * i, row = idx >> 3, ch = idx & 7; *(LAS v4u*)(lds + ATT_K_OFF + row * 128 + ((ch ^ ((row >> 1) & 7)) << 4)) = kr[i]; }
#pragma unroll
    for (int i = 0; i < 10; ++i) { const int idx = tid + 512 * i, d = idx / 80, pc = idx % 80; *(LAS v2u*)(lds + ATT_V_OFF + d * ATT_VSTRIDE + pc * 8) = vr[i]; }
}
__device__ __forceinline__ void attn_task(LAS const unsigned char* lds, const bf16* Q, bf16* O, const float* sinks, int b, int hq, int q0, int kw0, int lane) {
    const int c = lane & 31, hi = lane >> 5;
    const size_t tb = (size_t)b * 4096;
    s16x8 qf[4];
    { const bf16* qp = Q + (tb + q0 + c) * 2048 + hq * 64 + hi * 8;
#pragma unroll
      for (int ks = 0; ks < 4; ++ks) qf[ks] = *(const s16x8*)(qp + ks * 16); }
    const float sink2 = sinks[hq] * 1.4426950408889634f;
    float m = sink2, l = (hi == 0) ? 1.f : 0.f;
    f32x16 o0, o1;
#pragma unroll
    for (int r = 0; r < 16; ++r) { o0[r] = 0.f; o1[r] = 0.f; }
    const int kt_lo = (q0 < 128) ? ((128 - q0) >> 5) : 0, kt_hi = ((4192 - q0) >> 5) < 8 ? ((4192 - q0) >> 5) : 8;
    for (int kt = kt_lo; kt <= kt_hi; ++kt) {
        const int key0 = q0 - 128 + 32 * kt, row0 = key0 - kw0;
        s16x8 kf[4]; s16x4 va[2][2][2];
        { const int row = row0 + c; LAS const unsigned char* kp = lds + ATT_K_OFF + row * 128; const int sw = (row >> 1) & 7;
#pragma unroll
          for (int ks = 0; ks < 4; ++ks) kf[ks] = *(LAS const s16x8*)(kp + (((2 * ks + hi) ^ sw) << 4)); }
#pragma unroll
        for (int db = 0; db < 2; ++db)
#pragma unroll
            for (int s = 0; s < 2; ++s) { LAS const unsigned char* vp = lds + ATT_V_OFF + (db * 32 + c) * ATT_VSTRIDE + (row0 + 16 * s + 4 * hi) * 2; va[db][s][0] = *(LAS const s16x4*)vp; va[db][s][1] = *(LAS const s16x4*)(vp + 16); }
        f32x16 sa;
#pragma unroll
        for (int r = 0; r < 16; ++r) sa[r] = 0.f;
#pragma unroll
        for (int ks = 0; ks < 4; ++ks) sa = __builtin_amdgcn_mfma_f32_32x32x16_bf16(kf[ks], qf[ks], sa, 0, 0, 0);
        if (kt == 0 || kt == 8) {
            const int dbase = key0 - (q0 + c) + 4 * hi;
#pragma unroll
            for (int r = 0; r < 16; ++r) { const int d = dbase + (r & 3) + 8 * (r >> 2); if (d < -128 || d > 128) sa[r] = -1e30f; }
        }
        float mx = sa[0];
#pragma unroll
        for (int r = 1; r < 16; ++r) mx = fmaxf(mx, sa[r]);
        { const auto rr = __builtin_amdgcn_permlane32_swap(__float_as_uint(mx), __float_as_uint(mx), false, false); mx = fmaxf(__uint_as_float(rr[0]), __uint_as_float(rr[1])); }
        const float mn = fmaxf(m, mx), alpha = __builtin_amdgcn_exp2f(m - mn);
        m = mn;
        float ps = 0.f;
#pragma unroll
        for (int r = 0; r < 16; ++r) { sa[r] = __builtin_amdgcn_exp2f(sa[r] - mn); ps += sa[r]; }
        l = l * alpha + ps;
#pragma unroll
        for (int r = 0; r < 16; ++r) { o0[r] *= alpha; o1[r] *= alpha; }
        s16x8 pf[2];
#pragma unroll
        for (int s = 0; s < 2; ++s) { v4u w; w.x = cvt_pk_bf16_(sa[8 * s + 0], sa[8 * s + 1]); w.y = cvt_pk_bf16_(sa[8 * s + 2], sa[8 * s + 3]); w.z = cvt_pk_bf16_(sa[8 * s + 4], sa[8 * s + 5]); w.w = cvt_pk_bf16_(sa[8 * s + 6], sa[8 * s + 7]);
            pf[s] = __builtin_bit_cast(s16x8, w); }
#pragma unroll
        for (int s = 0; s < 2; ++s) {
            const s16x8 v0 = __builtin_shufflevector(va[0][s][0], va[0][s][1], 0, 1, 2, 3, 4, 5, 6, 7), v1 = __builtin_shufflevector(va[1][s][0], va[1][s][1], 0, 1, 2, 3, 4, 5, 6, 7);
            o0 = __builtin_amdgcn_mfma_f32_32x32x16_bf16(v0, pf[s], o0, 0, 0, 0);
            o1 = __builtin_amdgcn_mfma_f32_32x32x16_bf16(v1, pf[s], o1, 0, 0, 0);
        }
    }
    { const auto rr = __builtin_amdgcn_permlane32_swap(__float_as_uint(l), __float_as_uint(l), false, false); l = __uint_as_float(rr[0]) + __uint_as_float(rr[1]); }
    const float il = 1.f / l;
    bf16* op = O + (tb + q0 + c) * 2048 + hq * 64 + 4 * hi;
#pragma unroll
    for (int g = 0; g < 4; ++g) {
        v2u w0, w1;
        w0.x = cvt_pk_bf16_(o0[4 * g + 0] * il, o0[4 * g + 1] * il); w0.y = cvt_pk_bf16_(o0[4 * g + 2] * il, o0[4 * g + 3] * il);
        w1.x = cvt_pk_bf16_(o1[4 * g + 0] * il, o1[4 * g + 1] * il); w1.y = cvt_pk_bf16_(o1[4 * g + 2] * il, o1[4 * g + 3] * il);
        *(v2u*)(op + 8 * g) = w0; *(v2u*)(op + 32 + 8 * g) = w1;
    }
}
typedef float fx2 __attribute__((ext_vector_type(2)));
__device__ __forceinline__ fx2 bf2_(unsigned w) { fx2 r; r[0] = __uint_as_float(w << 16); r[1] = __uint_as_float(w & 0xffff0000u); return r; }
__device__ __forceinline__ void fft16_item(bf16* Zp, const float* tw, int bg, int l, int s1h, int lane) {
    const int s1 = s1h * 128 + 2 * lane;
    bf16* base = Zp + ((size_t)(bg * 16) * 256 + l) * 512 + s1;
    fx2 zr[16], zi[16];
#pragma unroll
    for (int s2 = 0; s2 < 16; ++s2) { zr[s2] = bf2_(*(const unsigned*)(base + (size_t)s2 * 256 * 512)); zi[s2] = bf2_(*(const unsigned*)(base + (size_t)s2 * 256 * 512 + 256)); }
    fx2 er[16], ei[16];
#pragma unroll
    for (int d = 0; d < 4; ++d) {
        const fx2 ar = zr[d], ai_ = zi[d], br = zr[4 + d], bi = zi[4 + d], cr = zr[8 + d], ci = zi[8 + d], dr = zr[12 + d], di = zi[12 + d];
        const fx2 s0r = ar + cr, s0i = ai_ + ci, s1r = ar - cr, s1i = ai_ - ci, s2r = br + dr, s2i = bi + di, s3r = br - dr, s3i = bi - di;
        er[0 * 4 + d] = s0r + s2r; ei[0 * 4 + d] = s0i + s2i;
        er[1 * 4 + d] = s1r + s3i; ei[1 * 4 + d] = s1i - s3r;
        er[2 * 4 + d] = s0r - s2r; ei[2 * 4 + d] = s0i - s2i;
        er[3 * 4 + d] = s1r - s3i; ei[3 * 4 + d] = s1i + s3r;
    }
#pragma unroll
    for (int a = 1; a < 4; ++a)
#pragma unroll
        for (int d = 1; d < 4; ++d) {
            const float ang = 6.283185307179586f * (float)(a * d) / 16.f; const float c = __builtin_cosf(ang), sn = __builtin_sinf(ang);
            const fx2 xr = er[a * 4 + d], xi = ei[a * 4 + d];
            er[a * 4 + d] = xr * c + xi * sn; ei[a * 4 + d] = xi * c - xr * sn;
        }
#pragma unroll
    for (int a = 0; a < 4; ++a) {
        const fx2 ar = er[a * 4 + 0], ai_ = ei[a * 4 + 0], br = er[a * 4 + 1], bi = ei[a * 4 + 1], cr = er[a * 4 + 2], ci = ei[a * 4 + 2], dr = er[a * 4 + 3], di = ei[a * 4 + 3];
        const fx2 s0r = ar + cr, s0i = ai_ + ci, s1r = ar - cr, s1i = ai_ - ci, s2r = br + dr, s2i = bi + di, s3r = br - dr, s3i = bi - di;
        fx2 Dr[4], Di[4];
        Dr[0] = s0r + s2r; Di[0] = s0i + s2i; Dr[1] = s1r + s3i; Di[1] = s1i - s3r; Dr[2] = s0r - s2r; Di[2] = s0i - s2i; Dr[3] = s1r - s3i; Di[3] = s1i + s3r;
#pragma unroll
        for (int b = 0; b < 4; ++b) {
            const int k2 = a + 4 * b;
            const f32x4 t0 = *(const f32x4*)(tw + (size_t)(k2 * 256 + s1) * 2);
            const fx2 cc = (fx2){t0[0], t0[2]}, ss = (fx2){t0[1], t0[3]};
            const fx2 hr = Dr[b] * cc + Di[b] * ss, hi_ = Di[b] * cc - Dr[b] * ss;
            *(unsigned*)(base + (size_t)k2 * 256 * 512) = pk2(hr[0], hr[1]); *(unsigned*)(base + (size_t)k2 * 256 * 512 + 256) = pk2(hi_[0], hi_[1]);
        }
    }
}
__device__ __forceinline__ int static_unit(int nM, int nN, int G, int c, int i) {
    const int nwg = nM * nN; const long L = (long)i * G + c; if (L >= nwg) return -1;
    int wgid = (int)L; { const int q = nwg / 8, r = nwg % 8, xcd = wgid % 8, off = wgid / 8; wgid = (xcd < r ? xcd * (q + 1) : r * (q + 1) + (xcd - r) * q) + off; }
    const int nig = 8 * nN, gid = wgid / nig, fm = gid * 8, gsz = (nM - fm) < 8 ? (nM - fm) : 8;
    return ((fm + ((wgid % nig) % gsz)) << 16) | ((wgid % nig) / gsz);
}
#ifndef REP_PRO
#define REP_PRO 1
#endif
#ifndef REP_GEMM
#define REP_GEMM 1
#endif
#ifndef REP_ATT
#define REP_ATT 1
#endif
#ifndef REP_LITE
#define REP_LITE 0
#endif
#ifndef REP_Q
#define REP_Q 1
#endif
#ifndef REP_PA
#define REP_PA 1
#endif
#ifndef REP_TK
#define REP_TK 1
#endif
enum { PH_PRO = 0, PH_G1 = 1, PH_S1 = 2, PH_G2 = 3, PH_G3 = 4, PH_Q0 = 5, PH_TK0 = 6, PH_PA0 = 7, PH_PW0 = 8, PH_PB0 = 9, PH_QKV = 10, PH_ATT = 11, PH_WO = 12, PH_Q1 = 13, PH_TK1 = 14, PH_PA1 = 15, PH_PW1 = 16, PH_PB1 = 17, PH_FIN = 18, PH_END = 19 };
__global__ void __launch_bounds__(NWAVES * 64, 2) mega(Args a) {
    extern __shared__ __attribute__((aligned(16))) unsigned char lds_raw[];
    LAS unsigned char* lds = (LAS unsigned char*)lds_raw;
    cg::grid_group grid = cg::this_grid();
    const int wave = __builtin_amdgcn_readfirstlane(threadIdx.x >> 6);
#define FRESH_IDS() int lane; asm volatile("v_mbcnt_lo_u32_b32 %0, -1, 0\n\tv_mbcnt_hi_u32_b32 %0, -1, %0" : "=v"(lane)); const int tid = wave * 64 + lane; (void)tid
    const int G = gridDim.x, bx = blockIdx.x;
    unsigned char* ws = a.ws;
    const int lo = a.ph_lo, hi = a.ph_hi;
    volatile LAS unsigned* MISC = (volatile LAS unsigned*)(lds + LDSCTL_OFF);
    if (threadIdx.x < 16) MISC[threadIdx.x] = 0u;
    __syncthreads();
    XcdBarrier xbar = xcd_barrier_post((unsigned*)(ws + WS_CTL) + CW_BAR, MISC + 8);
#define IN(k) (lo <= (k) && (k) < hi)
#ifdef DIAG_A
#define STAMP(i) do { if (bx == 0 && threadIdx.x == 0) ((unsigned long long*)(ws + WS_STAMP))[i] = __builtin_amdgcn_s_memrealtime(); } while (0)
#else
#define STAMP(i) do { } while (0)
#endif
#define SEAM(k) do { if (IN(k) && IN((k) + 1)) { if ((k) == PH_PRO) grid.sync(); else xcd_barrier(xbar); } STAMP((k) + 1); } while (0)
    STAMP(0);
    for (int rep_ = 0; rep_ < REP_PRO; ++rep_)
    if (IN(PH_PRO)) { FRESH_IDS();
        const int gw = bx * NWAVES + wave, NGW = G * NWAVES;
        const size_t gtid = (size_t)bx * (NWAVES * 64) + tid, ngt = (size_t)G * NWAVES * 64;
        LAS float* scr = (LAS float*)(lds + wave * 16384);
        {
            constexpr int I_SQ = (DM / 64) * (DM / 32), I_QKV = (DM / 64) * (QKVW / 32);
            constexpr int NITEMS = 4 * I_SQ + I_QKV;
            for (int it = gw; it < NITEMS; it += NGW) {
                int r = it;
                if (r < I_SQ) { transpose_item<0>(a.in[3], DM, DM, nullptr, (bf16*)(ws + WS_WOF), scr, r, lane); continue; } r -= I_SQ;
                if (r < I_SQ) { transpose_item<0>(a.in[5], DM, DM, nullptr, (bf16*)(ws + WS_WOA), scr, r, lane); continue; } r -= I_SQ;
                if (r < I_SQ) { transpose_item<0>(a.in[7], DM, DM, a.in[2], (bf16*)(ws + WS_WQ0), scr, r, lane); continue; } r -= I_SQ;
                if (r < I_SQ) { transpose_item<0>(a.in[7] + (size_t)DM * DM, DM, DM, a.in[2] + DM, (bf16*)(ws + WS_WQ1), scr, r, lane); continue; } r -= I_SQ;
                transpose_item<1>(a.in[4], DM, QKVW, a.in[1] + DM, (bf16*)(ws + WS_WQKV), scr, r, lane);
            }
        }
        for (int row = gw; row < T; row += NGW) {
            const f32x4* xr = (const f32x4*)(a.in[0] + (size_t)row * DM) + lane;
            const f32x4* gr = (const f32x4*)a.in[1] + lane;
            f32x4 v[8]; float s = 0.f;
#pragma unroll
            for (int j = 0; j < 8; ++j) { v[j] = xr[64 * j]; s += (v[j][0] * v[j][0] + v[j][1] * v[j][1]) + (v[j][2] * v[j][2] + v[j][3] * v[j][3]); }
            const float r = rsqrtf(wsum(s) * (1.f / DM) + EPS);
            const int b = row >> 12, sp = row & 4095;
#pragma unroll
            for (int j = 0; j < 8; ++j) { const f32x4 gg = gr[64 * j]; v2u o; o.x = pk2(v[j][0] * r * gg[0], v[j][1] * r * gg[1]); o.y = pk2(v[j][2] * r * gg[2], v[j][3] * r * gg[3]);
                *(v2u*)((bf16*)(ws + WS_XG) + ((size_t)((b * 8 + j) * 4096 + sp) * 256 + 4 * lane)) = o; }
        }
        for (size_t i = gtid; i < (size_t)256 * 512 / 8; i += ngt) {
            const int k1 = (int)(i >> 6), c0 = (int)(i & 63) * 8, part = c0 >> 8, s0 = c0 & 255;
            float v[8];
#pragma unroll
            for (int e = 0; e < 8; ++e) { const int m = (k1 * (s0 + e)) & 255; const float rev = (float)m * (1.f / 256.f); v[e] = (part ? __builtin_amdgcn_sinf(rev) : __builtin_amdgcn_cosf(rev)) * (1.f / 64.f); }
            v4u o; o.x = pk2(v[0], v[1]); o.y = pk2(v[2], v[3]); o.z = pk2(v[4], v[5]); o.w = pk2(v[6], v[7]);
            *(v4u*)((bf16*)(ws + WS_A2) + i * 8) = o;
        }
        for (size_t i = gtid; i < (size_t)16 * 256; i += ngt) {
            const int k2 = (int)(i >> 8), s1 = (int)(i & 255); const float rev = (float)(k2 * s1) * (1.f / 4096.f);
            ((float*)(ws + WS_TW))[2 * i] = __builtin_amdgcn_cosf(rev); ((float*)(ws + WS_TW))[2 * i + 1] = __builtin_amdgcn_sinf(rev);
        }
        for (size_t i = gtid; i < (size_t)512 * 256 / 8; i += ngt) {
            const int n = (int)(i >> 5), c0 = (int)(i & 31) * 8, part = n >> 8, l = n & 255;
            float v[8];
#pragma unroll
            for (int e = 0; e < 8; ++e) { const int m = (l * (c0 + e)) & 255; const float rev = (float)m * (1.f / 256.f); v[e] = (part ? -__builtin_amdgcn_sinf(rev) : __builtin_amdgcn_cosf(rev)) * (1.f / 16.f); }
            v4u o; o.x = pk2(v[0], v[1]); o.y = pk2(v[2], v[3]); o.z = pk2(v[4], v[5]); o.w = pk2(v[6], v[7]);
            *(v4u*)((bf16*)(ws + WS_WCS) + i * 8) = o;
        }
        for (size_t i = gtid; i < (size_t)4096 * 32; i += ngt) {
            const int pos = (int)(i >> 5), fi = (int)(i & 31);
            const double inv = exp2(-(double)fi * (13.287712379549449 / 32.0));
            double sn, cs; sincos((double)pos * inv, &sn, &cs);
            ((float*)(ws + WS_ROPE))[2 * i] = (float)cs; ((float*)(ws + WS_ROPE))[2 * i + 1] = (float)sn;
        }
#pragma unroll 1
        for (int L = 0; L < 2; ++L) {
            CvtCtx cx; cx.srcU = a.in[9] + (size_t)L * NEXP * DM; cx.dsrc = (long)((a.in[10] + (size_t)L * NEXP * DM) - cx.srcU); cx.gain = a.in[2] + L * DM; cx.dstU = ws + (L ? WS_U1 : WS_U0); cx.ddst = (long)WS_V0 - (long)WS_U0;
            cx.su = (float*)(ws + WS_SU) + L * 32768; cx.dsc = ((long)WS_SV - (long)WS_SU) / 4; cx.gwave = gw; cx.nw = NGW;
            f32x4 c0[4], c1[4], n0[4], n1[4];
            cvt_chunk_load(cx, gw, lane, c0); cvt_chunk_load(cx, (gw + NGW < 65536) ? gw + NGW : gw, lane, c1);
            for (int cc = gw; cc < 65536; cc += 2 * NGW) { const int ca = cc + 2 * NGW, cb = cc + 3 * NGW;
                cvt_chunk_load(cx, ca < 65536 ? ca : cc, lane, n0); cvt_chunk_load(cx, cb < 65536 ? cb : cc, lane, n1);
                cvt_chunk_store(cx, cc, lane, c0); if (cc + NGW < 65536) cvt_chunk_store(cx, cc + NGW, lane, c1);
#pragma unroll
                for (int q = 0; q < 4; ++q) { c0[q] = n0[q]; c1[q] = n1[q]; } }
        }
        cvt_stream(a.in[8], (bf16*)(ws + WS_KEYS), (size_t)2 * PH * 2 * 128 * 128 / 8, gtid, ngt);
    }
    SEAM(PH_PRO);
    for (int rep_ = 0; rep_ < REP_GEMM; ++rep_)
    if (IN(PH_G1)) { FRESH_IDS();
        int Kq = FW; asm volatile("" : "+s"(Kq));
        pg8::Gemm g{(const pg8::bf16_t*)(ws + WS_WCS), (const pg8::bf16_t*)(ws + WS_XG), 512, T * FG, Kq}; pg8::StaticOrder S; S.init(512, T * FG, G, bx);
        pg8::EpiZt E{(pg8::bf16_t*)(ws + WS_ZT)};
        pg8::gemm_phase<pg8::EpiZt, pg8::StaticOrder, true, true>(lds, g, S, E);
    }
    SEAM(PH_G1);
    if (IN(PH_S1)) { FRESH_IDS();
        const int gw = bx * NWAVES + wave, NGW = G * NWAVES;
        for (int it = gw; it < 32 * 256 * 2; it += NGW) fft16_item((bf16*)(ws + WS_ZT), (const float*)(ws + WS_TW), it >> 9, (it >> 1) & 255, it & 1, lane);
    }
    SEAM(PH_S1);
    for (int rep_ = 0; rep_ < REP_GEMM; ++rep_)
    if (IN(PH_G2)) { FRESH_IDS();
        pg8::Gemm g{(const pg8::bf16_t*)(ws + WS_A2), (const pg8::bf16_t*)(ws + WS_ZT), 256, 131072, 512}; pg8::StaticOrder S; S.init(256, 131072, G, bx);
        pg8::EpiY E{(pg8::bf16_t*)(ws + WS_Y)};
        pg8::gemm_phase<pg8::EpiY, pg8::StaticOrder, true, true>(lds, g, S, E);
    }
    SEAM(PH_G2);
    if (IN(PH_G3)) { FRESH_IDS();
        pg8::Gemm g{(const pg8::bf16_t*)(ws + WS_Y), (const pg8::bf16_t*)(ws + WS_WOF), T, DM, DM}; pg8::StaticOrder S; S.init(T, DM, G, bx);
        pg8::EpiRes E{a.in[0], a.out, (pg8::bf16_t*)(ws + WS_XB), (float*)(ws + WS_SSQ_A)};
        pg8::gemm_phase<pg8::EpiRes, pg8::StaticOrder, true, true>(lds, g, S, E);
    }
    SEAM(PH_G3);
#define PEER_LAYER(L) do { \
        const int pq = L ? PH_Q1 : PH_Q0, ptk = L ? PH_TK1 : PH_TK0, ppa = L ? PH_PA1 : PH_PA0, ppw = L ? PH_PW1 : PH_PW0, ppb = L ? PH_PB1 : PH_PB0; \
        for (int rep_ = 0; rep_ < REP_Q; ++rep_) \
        if (IN(pq)) { FRESH_IDS(); \
            pg8::Gemm g{(const pg8::bf16_t*)(ws + WS_XB), (const pg8::bf16_t*)(ws + (L ? WS_WQ1 : WS_WQ0)), T, DM, DM}; pg8::StaticOrder S; S.init(T, DM, G, bx); \
            pg8::EpiScale E{(pg8::bf16_t*)(ws + WS_Q), (const float*)(ws + (L ? WS_SSQ_C : WS_SSQ_A))}; \
            pg8::gemm_phase<pg8::EpiScale, pg8::StaticOrder, true, true>(lds, g, S, E); \
        } \
        if (IN(pq) && IN(ptk)) { asm volatile("s_waitcnt vmcnt(0)" ::: "memory"); __syncthreads(); } STAMP(pq + 1); \
        if (IN(ptk)) { FRESH_IDS(); \
            const bf16* keys = (const bf16*)(ws + WS_KEYS) + (size_t)L * PH * 2 * 128 * 128; \
            int slot = 0; \
            for (int rep_ = 0; rep_ < REP_TK; ++rep_) { slot = 0; \
            for (int ui = 0; ; ++ui) {        \
                const int upk = static_unit(T / 256, DM / 256, G, bx, ui); if (upk < 0) break; \
                const int h = upk & 0xffff, tblk = upk >> 16; \
                __syncthreads(); \
                topk_fill(lds, keys, h, tid); \
                __syncthreads(); \
                topk_unit((const bf16*)(ws + WS_Q), lds, (int*)(ws + WS_EI), (float*)(ws + WS_GW), tblk * 256 + wave * 32, h, lane); \
                slot += 16; \
            } } \
        } \
        SEAM(ptk); \
        if (IN(ppa)) { FRESH_IDS(); \
            const int xv = bx & 7; \
            peer_a_slice<8>((const bf16*)(ws + WS_XB), (const int*)(ws + WS_EI), (const unsigned char*)(ws + (L ? WS_U1 : WS_U0)), (float*)(ws + WS_PD), xv, (unsigned*)(ws + WS_BCTR) + (L * 2 + 0) * 512 + xv * 64, T / 8, lane); \
        } \
        SEAM(ppa); \
        if (IN(ppw)) { FRESH_IDS(); \
            const int gw = bx * NWAVES + wave, NGW = G * NWAVES; \
            for (int t = gw; t < T; t += NGW) peer_a2_token((const float*)(ws + WS_PD), (const float*)(ws + (L ? WS_SSQ_C : WS_SSQ_A)), (const int*)(ws + WS_EI), (const float*)(ws + WS_SU) + L * 32768, (const float*)(ws + WS_SV) + L * 32768, (float*)(ws + WS_GW), (float*)(ws + WS_W1), t, lane); \
        } \
        SEAM(ppw); \
        if (IN(ppb)) { FRESH_IDS(); \
            const int xv = bx & 7; \
            peer_b_slice<4>((const bf16*)(ws + WS_XB), a.out, (const int*)(ws + WS_EI), (const unsigned*)(ws + ((xv < 4) ? WS_GW : WS_W1)), (const unsigned char*)(ws + (L ? WS_V1 : WS_V0)), L ? (bf16*)nullptr : (bf16*)(ws + WS_XB), (float*)(ws + (L ? WS_SSQ_D : WS_SSQ_B)), xv, (unsigned*)(ws + WS_BCTR) + (L * 2 + 1) * 512 + xv * 64, T / 4, lane); \
        } \
    } while (0)
    float oscale = 1.f;
    PEER_LAYER(0);
    SEAM(PH_PB0);
    for (int rep_ = 0; rep_ < REP_GEMM; ++rep_)
    if (IN(PH_QKV)) { FRESH_IDS();
        {
            pg8::Gemm g{(const pg8::bf16_t*)(ws + WS_XB), (const pg8::bf16_t*)(ws + WS_WQKV), T, 2560, DM}; pg8::StaticOrder S; S.init(T, 2560, G, bx);
            pg8::EpiQK E{(pg8::bf16_t*)(ws + WS_QB), (pg8::bf16_t*)(ws + WS_KB), (const float*)(ws + WS_SSQ_B), (const float*)(ws + WS_ROPE), 0.125f * 1.4426950408889634f};
            pg8::gemm_phase<pg8::EpiQK, pg8::StaticOrder, true, true>(lds, g, S, E);
        }
        if (bx >= G / 2) {
            pg8::Gemm g{(const pg8::bf16_t*)(ws + WS_WQKV) + (size_t)2560 * DM, (const pg8::bf16_t*)(ws + WS_XB), 512, T, DM}; pg8::StaticOrder S; S.init(512, T, G / 2, bx - G / 2);
            pg8::EpiVt E{(pg8::bf16_t*)(ws + WS_VT), (const float*)(ws + WS_SSQ_B)};
            pg8::gemm_phase<pg8::EpiVt, pg8::StaticOrder, true, true>(lds, g, S, E);
        }
    }
    SEAM(PH_QKV);
    for (int rep_ = 0; rep_ < REP_ATT; ++rep_)
    if (IN(PH_ATT)) { FRESH_IDS();
        for (int vb = bx; vb < 256; vb += G) {
            const int bkv = vb >> 3, chunk = vb & 7, b = bkv >> 3, kvh = bkv & 7;
            v4u kr[5]; v2u vr[10];
            attn_fill_load((const bf16*)(ws + WS_KB), (const bf16*)(ws + WS_VT), b, kvh, chunk * 8 * 64 - 128, tid, kr, vr);
            for (int i = 0; i < 8; ++i) {
                const int qu = (chunk * 8 + i) * 64;
                __syncthreads();
                attn_fill_store(lds, tid, kr, vr);
                __syncthreads();
                if (i + 1 < 8) attn_fill_load((const bf16*)(ws + WS_KB), (const bf16*)(ws + WS_VT), b, kvh, qu + 64 - 128, tid, kr, vr);
                attn_task(lds, (const bf16*)(ws + WS_QB), (bf16*)(ws + WS_O), a.in[6], b, kvh * 4 + (wave & 3), qu + (wave >> 2) * 32, qu - 128, lane);
            }
        }
    }
    SEAM(PH_ATT);
    if (IN(PH_WO)) { FRESH_IDS();
        pg8::Gemm g{(const pg8::bf16_t*)(ws + WS_O), (const pg8::bf16_t*)(ws + WS_WOA), T, DM, DM}; pg8::StaticOrder S; S.init(T, DM, G, bx);
        pg8::EpiResB E{(const pg8::bf16_t*)(ws + WS_XB), (pg8::bf16_t*)(ws + WS_XB), (float*)(ws + WS_SSQ_C)};
        pg8::gemm_phase<pg8::EpiResB, pg8::StaticOrder, true, true>(lds, g, S, E);
    }
    SEAM(PH_WO);
#ifdef DIAG_A
    { const unsigned long long* st = (const unsigned long long*)(ws + WS_STAMP); oscale = 1.f + sqrtf((float)(st[DIAG_B] - st[DIAG_A]) * 1e-6f); }
#endif
    PEER_LAYER(1);
#undef PEER_LAYER
    SEAM(PH_PB1);
    if (IN(PH_FIN)) { FRESH_IDS();
        const int gw = bx * NWAVES + wave, NGW = G * NWAVES;
        for (int t = gw; t < T; t += NGW) final_norm_row(a.out, (const float*)(ws + WS_SSQ_D), a.in[11], t, lane, oscale);
    }
#undef SEAM
#undef IN
}

#ifndef N_LAUNCHES
#define N_LAUNCHES 1
#endif
extern "C" void kernel_launch(void* const* d_in, const int* in_sizes, int n_in, void* d_out, int out_size, void* d_ws, size_t ws_size, hipStream_t stream) {
    static int grid = 0;
    if (!grid) {
        if (hipFuncSetAttribute((const void*)mega, hipFuncAttributeMaxDynamicSharedMemorySize, LDS_BYTES) != hipSuccess) { fprintf(stderr, "hipFuncSetAttribute failed\n"); }
        int dev = 0, cus = 0, per_cu = 0;
        (void)hipGetDevice(&dev);
        (void)hipDeviceGetAttribute(&cus, hipDeviceAttributeMultiprocessorCount, dev);
        if (hipOccupancyMaxActiveBlocksPerMultiprocessor(&per_cu, (const void*)mega, NWAVES * 64, LDS_BYTES) != hipSuccess) per_cu = 0;
        (void)hipGetLastError();
        grid = cus * per_cu;
        if (grid > 256) grid = 256;
        grid &= ~1;
        if (grid < 2) { fprintf(stderr, "occupancy query gave %d x %d\n", cus, per_cu); grid = -1; }
    }
    if (grid < 0) return;
    if (ws_size < 700 * MiB) { fprintf(stderr, "ws too small: %zu\n", ws_size); return; }
    (void)hipMemsetAsync((char*)d_ws + WS_CTL, 0, CTL_BYTES, stream);
    Args a{};
    for (int i = 0; i < 12; ++i) a.in[i] = (const float*)d_in[i];
    a.out = (float*)d_out; a.ws = (unsigned char*)d_ws;
    if (N_LAUNCHES == 1) {
        a.ph_lo = 0; a.ph_hi = PH_END;
        void* args[] = {&a};
        const hipError_t e = hipLaunchCooperativeKernel((const void*)mega, dim3(grid), dim3(NWAVES * 64), args, LDS_BYTES, stream);
        if (e != hipSuccess) fprintf(stderr, "cooperative launch failed: %s (grid %d)\n", hipGetErrorString(e), grid);
    } else {
        for (int ph = 0; ph < PH_END; ++ph) {
            a.ph_lo = ph; a.ph_hi = ph + 1;
            hipLaunchKernelGGL(mega, dim3(grid), dim3(NWAVES * 64), LDS_BYTES, stream, a);
        }
    }
}
```

```cpp
#include <hip/hip_runtime.h>
#include <hip/hip_cooperative_groups.h>
namespace cg = cooperative_groups;
#include <cstdio>
#include <cstdint>
#include <cmath>

constexpr int DM = 2048, NB = 4, SEQ = 4096, T = NB * SEQ;
constexpr int FG = 8, FW = 256;
constexpr int HD = 64, NQH = 32, NKVH = 8, QKVW = 3072;
constexpr int PH = 8, NKEYS = 128, NEXP = 16384, PTOPK = 16;
constexpr float EPS = 1e-6f;
namespace pg8 {
#define PG8_LAS __attribute__((address_space(3)))
typedef unsigned short bf16_t;
typedef short bf16x8 __attribute__((ext_vector_type(8)));
typedef float f32x4 __attribute__((ext_vector_type(4)));
typedef unsigned u32x4 __attribute__((ext_vector_type(4)));
constexpr int BM = 256, BK = 64, HALF = 128, HTB = HALF * BK * 2  , STAGE_BYTES = 8 * HTB, NXCD = 8, WGM = 8;

__host__ __device__ __forceinline__ int lds_byte(int r, int c) { const int st = (r >> 4) * 2 + (c >> 5), rr = r & 15, cc = c & 31, ob = rr * 64 + cc * 2; return st * 1024 + (ob ^ (((ob >> 9) & 1) << 5)); }
__host__ __device__ __forceinline__ void stage_rc(int b, int& R, int& C) { const int st = b / 1024, sb = b % 1024, swz = sb ^ (((sb >> 9) & 1) << 5); R = (st >> 1) * 16 + swz / 64; C = (st & 1) * 32 + (swz % 64) / 2; }
__host__ __device__ __forceinline__ int perm32(int rho) { const int n = rho >> 4, i = rho & 15; return 8 * (i >> 2) + 4 * n + (i & 3); }

struct Unit { int pm, pn; };
struct Gemm { const bf16_t* A; const bf16_t* Bt; int M, N, K; };

struct StaticOrder {
    int nM, nN, nwg, G, c;
    __host__ __device__ void init(int M, int N, int G_, int c_) { nM = M / BM; nN = N / BM; nwg = nM * nN; G = G_; c = c_; }
    __host__ __device__ bool next(int i, Unit& u) const {
        const long L = (long)i * G + c; if (L >= nwg) return false;
        int wgid = (int)L; { const int q = nwg / NXCD, r = nwg % NXCD, xcd = wgid % NXCD, off = wgid / NXCD; wgid = (xcd < r ? xcd * (q + 1) : r * (q + 1) + (xcd - r) * q) + off; }
        const int nig = WGM * nN, gid = wgid / nig, fm = gid * WGM, gsz = (nM - fm) < WGM ? (nM - fm) : WGM;
        u.pm = fm + ((wgid % nig) % gsz); u.pn = (wgid % nig) / gsz; return true;
    }
    __device__ __forceinline__ void a_ready(const Unit&) const {}
    __device__ __forceinline__ void done(const Unit&) const {}
};

__device__ __forceinline__ unsigned cvt_pk_bf16(float lo, float hi) { unsigned r; asm volatile("v_cvt_pk_bf16_f32 %0, %1, %2" : "=v"(r) : "v"(lo), "v"(hi)); return r; }
typedef float f32x2 __attribute__((ext_vector_type(2)));
__device__ __forceinline__ u32x4 pack8(const f32x4 v0, const f32x4 v1) { u32x4 w; w.x = cvt_pk_bf16(v0[0], v0[1]); w.y = cvt_pk_bf16(v0[2], v0[3]); w.z = cvt_pk_bf16(v1[0], v1[1]); w.w = cvt_pk_bf16(v1[2], v1[3]); return w; }
struct EpiZt {
    static constexpr bool PERM = true, AFTER_DRAIN = false; bf16_t* Zp;
    __device__ __forceinline__ void operator()(const f32x4 (&acc)[2][2][4][2], const Unit& u, int wr, int wc, int fr, int fq) const {
        const int part = u.pm, bgs2 = u.pn;
        bf16_t* base = Zp + ((size_t)(bgs2 * 256 + wr * 64 + fr) * 512 + part * 256 + wc * 32 + 8 * fq);
#pragma unroll
        for (int ai = 0; ai < 2; ++ai)
#pragma unroll
            for (int m = 0; m < 4; ++m)
#pragma unroll
                for (int bj = 0; bj < 2; ++bj) *(u32x4*)(base + (ai * HALF + m * 16) * 512 + bj * HALF) = pack8(acc[ai][bj][m][0], acc[ai][bj][m][1]);
    }
};
struct EpiY {
    static constexpr bool PERM = true, AFTER_DRAIN = false; bf16_t* Y;
    __device__ __forceinline__ void operator()(const f32x4 (&acc)[2][2][4][2], const Unit& u, int wr, int wc, int fr, int fq) const {
        const int bg = u.pn >> 4, k2 = u.pn & 15, b = bg >> 3, g = bg & 7;
        bf16_t* base = Y + ((size_t)(b * 4096 + (wr * 64 + fr) * 16 + k2) * 2048 + g * 256 + wc * 32 + 8 * fq);
#pragma unroll
        for (int ai = 0; ai < 2; ++ai)
#pragma unroll
            for (int m = 0; m < 4; ++m)
#pragma unroll
                for (int bj = 0; bj < 2; ++bj) *(u32x4*)(base + (size_t)(ai * HALF + m * 16) * 16 * 2048 + bj * HALF) = pack8(acc[ai][bj][m][0], acc[ai][bj][m][1]);
    }
};
struct EpiRes {
    static constexpr bool PERM = true, AFTER_DRAIN = false; const float* R; float* out; bf16_t* xb; float* ssq;
    __device__ __forceinline__ void operator()(const f32x4 (&acc)[2][2][4][2], const Unit& u, int wr, int wc, int fr, int fq) const {
        const int row0 = u.pm * BM + wr * 64 + fr; const size_t off0 = (size_t)row0 * 2048 + u.pn * BM + wc * 32 + 8 * fq;
        const float* Rb = R + off0; bf16_t* Xb = xb + off0; float* Sb = ssq + row0;
#pragma unroll
        for (int ai = 0; ai < 2; ++ai)
#pragma unroll
            for (int m = 0; m < 4; ++m) { const int ro = (ai * HALF + m * 16) * 2048; float ss = 0.f;
#pragma unroll
                for (int bj = 0; bj < 2; ++bj) {
                    const f32x4 r0 = *(const f32x4*)(Rb + ro + bj * HALF), r1 = *(const f32x4*)(Rb + ro + bj * HALF + 4);
                    const f32x4 o0 = acc[ai][bj][m][0] + r0, o1 = acc[ai][bj][m][1] + r1;
                    *(u32x4*)(Xb + ro + bj * HALF) = pack8(o0, o1);
                    ss += (o0[0] * o0[0] + o0[1] * o0[1]) + (o0[2] * o0[2] + o0[3] * o0[3]) + (o1[0] * o1[0] + o1[1] * o1[1]) + (o1[2] * o1[2] + o1[3] * o1[3]); }
                ss += __shfl_xor(ss, 16); ss += __shfl_xor(ss, 32);
                if (fq == 0) unsafeAtomicAdd(Sb + ai * HALF + m * 16, ss);
                asm volatile("" ::: "memory"); }
    }
};
struct EpiResB {
    static constexpr bool PERM = true, AFTER_DRAIN = false; const bf16_t* R; bf16_t* xb; float* ssq;
    __device__ __forceinline__ void operator()(const f32x4 (&acc)[2][2][4][2], const Unit& u, int wr, int wc, int fr, int fq) const {
        const int row0 = u.pm * BM + wr * 64 + fr; const size_t off0 = (size_t)row0 * 2048 + u.pn * BM + wc * 32 + 8 * fq;
        const bf16_t* Rb = R + off0; bf16_t* Xb = xb + off0; float* Sb = ssq + row0;
#pragma unroll
        for (int ai = 0; ai < 2; ++ai)
#pragma unroll
            for (int m = 0; m < 4; ++m) { const int ro = (ai * HALF + m * 16) * 2048; float ss = 0.f;
#pragma unroll
                for (int bj = 0; bj < 2; ++bj) {
                    const u32x4 rw = *(const u32x4*)(Rb + ro + bj * HALF);
                    const f32x4 r0 = (f32x4){__uint_as_float(rw[0] << 16), __uint_as_float(rw[0] & 0xffff0000u), __uint_as_float(rw[1] << 16), __uint_as_float(rw[1] & 0xffff0000u)}, r1 = (f32x4){__uint_as_float(rw[2] << 16), __uint_as_float(rw[2] & 0xffff0000u), __uint_as_float(rw[3] << 16), __uint_as_float(rw[3] & 0xffff0000u)};
                    const f32x4 o0 = acc[ai][bj][m][0] + r0, o1 = acc[ai][bj][m][1] + r1;
                    *(u32x4*)(Xb + ro + bj * HALF) = pack8(o0, o1);
                    ss += (o0[0] * o0[0] + o0[1] * o0[1]) + (o0[2] * o0[2] + o0[3] * o0[3]) + (o1[0] * o1[0] + o1[1] * o1[1]) + (o1[2] * o1[2] + o1[3] * o1[3]); }
                ss += __shfl_xor(ss, 16); ss += __shfl_xor(ss, 32);
                if (fq == 0) unsafeAtomicAdd(Sb + ai * HALF + m * 16, ss);
                asm volatile("" ::: "memory"); }
    }
};
struct EpiScale {
    static constexpr bool PERM = true, AFTER_DRAIN = false; bf16_t* O; const float* ssq;
    __device__ __forceinline__ void operator()(const f32x4 (&acc)[2][2][4][2], const Unit& u, int wr, int wc, int fr, int fq) const {
        const int row0 = u.pm * BM + wr * 64 + fr;
        bf16_t* base = O + ((size_t)row0 * 2048 + u.pn * BM + wc * 32 + 8 * fq); const float* Sb = ssq + row0;
#pragma unroll
        for (int ai = 0; ai < 2; ++ai)
#pragma unroll
            for (int m = 0; m < 4; ++m) { const float rs = rsqrtf(Sb[ai * HALF + m * 16] * (1.f / 2048.f) + 1e-6f);
#pragma unroll
                for (int bj = 0; bj < 2; ++bj) *(u32x4*)(base + (ai * HALF + m * 16) * 2048 + bj * HALF) = pack8(acc[ai][bj][m][0] * rs, acc[ai][bj][m][1] * rs); }
    }
};
struct EpiQK {
    static constexpr bool PERM = true, AFTER_DRAIN = false; bf16_t* Q; bf16_t* K; const float* ssq; const float* rope; float qscale;
    __device__ __forceinline__ void operator()(const f32x4 (&acc)[2][2][4][2], const Unit& u, int wr, int wc, int fr, int fq) const {
        const int row0 = u.pm * BM + wr * 64 + fr; const bool isq = u.pn < 8;
        const int cl = wc * 32 + 8 * fq;
        bf16_t* base = isq ? (Q + ((size_t)row0 * 2048 + u.pn * BM + cl)) : (K + ((size_t)row0 * 512 + (u.pn - 8) * BM + cl));
        const int ld = isq ? 2048 : 512; const float sc = isq ? qscale : 1.f;
        const float* rp = rope + (size_t)(row0 & 4095) * 64 + (cl & 63);
        const float* Sb = ssq + row0;
#pragma unroll
        for (int ai = 0; ai < 2; ++ai)
#pragma unroll
            for (int m = 0; m < 4; ++m) { const int ro = ai * HALF + m * 16; const float rs = rsqrtf(Sb[ro] * (1.f / 2048.f) + 1e-6f) * sc;
                const f32x4 t0 = *(const f32x4*)(rp + (size_t)ro * 64), t1 = *(const f32x4*)(rp + (size_t)ro * 64 + 4);
#pragma unroll
                for (int bj = 0; bj < 2; ++bj) {
                    const f32x4 a = acc[ai][bj][m][0] * rs, b = acc[ai][bj][m][1] * rs; f32x4 oa, ob;
                    oa[0] = a[0] * t0[0] - a[1] * t0[1]; oa[1] = a[1] * t0[0] + a[0] * t0[1]; oa[2] = a[2] * t0[2] - a[3] * t0[3]; oa[3] = a[3] * t0[2] + a[2] * t0[3];
                    ob[0] = b[0] * t1[0] - b[1] * t1[1]; ob[1] = b[1] * t1[0] + b[0] * t1[1]; ob[2] = b[2] * t1[2] - b[3] * t1[3]; ob[3] = b[3] * t1[2] + b[2] * t1[3];
                    *(u32x4*)(base + (size_t)ro * ld + bj * HALF) = pack8(oa, ob); } }
    }
};
struct EpiVt {
    static constexpr bool PERM = true, AFTER_DRAIN = false; bf16_t* Vt; const float* ssq;
    __device__ __forceinline__ void operator()(const f32x4 (&acc)[2][2][4][2], const Unit& u, int wr, int wc, int fr, int fq) const {
        const int col0 = u.pn * BM + wc * 32 + 8 * fq;
        bf16_t* base = Vt + ((size_t)(u.pm * BM + wr * 64 + fr) * 16384 + col0);
        f32x4 r0[2], r1[2];
#pragma unroll
        for (int bj = 0; bj < 2; ++bj) { const f32x4 s0 = *(const f32x4*)(ssq + col0 + bj * HALF), s1 = *(const f32x4*)(ssq + col0 + bj * HALF + 4);
#pragma unroll
            for (int q = 0; q < 4; ++q) { r0[bj][q] = rsqrtf(s0[q] * (1.f / 2048.f) + 1e-6f); r1[bj][q] = rsqrtf(s1[q] * (1.f / 2048.f) + 1e-6f); } }
#pragma unroll
        for (int ai = 0; ai < 2; ++ai)
#pragma unroll
            for (int m = 0; m < 4; ++m)
#pragma unroll
                for (int bj = 0; bj < 2; ++bj) *(u32x4*)(base + (size_t)(ai * HALF + m * 16) * 16384 + bj * HALF) = pack8(acc[ai][bj][m][0] * r0[bj], acc[ai][bj][m][1] * r1[bj]);
    }
};
template <class Epi, class Sched, bool ALIGN_EPI = false, bool SP2 = false>
__device__ __forceinline__ void gemm_phase(PG8_LAS unsigned char* lds, const Gemm g, const Sched& S, const Epi& E) {
    const int tid = threadIdx.x, wid = __builtin_amdgcn_readfirstlane(tid >> 6), lane = tid & 63, wr = wid >> 2, wc = wid & 3, fr = lane & 15, fq = lane >> 4;
    const int K = g.K, nt = K / BK;
    unsigned voffA[2], voffB[2];
#pragma unroll
    for (int i = 0; i < 2; ++i) { int R, C; stage_rc(tid * 16 + i * 8192, R, C); const int Rb = Epi::PERM ? ((R & ~31) + perm32(R & 31)) : R;
        voffA[i] = (unsigned)(R * K + C) * 2u; voffB[i] = (unsigned)(Rb * K + C) * 2u; }
    const size_t kstep = (size_t)(BK * 2);
    const size_t hstep = (size_t)HALF * K * 2;
    const size_t tstep = 2 * hstep;
    const unsigned ldsw = (unsigned)wid * 1024u;
    const int aoff = lds_byte(wr * 64 + fr, fq * 8), boff = lds_byte(wc * 32 + fr, fq * 8);
#define PG8_SA(b, h) (((b) * 2 + (h)) * HTB)
#define PG8_SB(b, h) ((4 + (b) * 2 + (h)) * HTB)
#define PG8_STAGE(bufoff, gbase, voff) do { _Pragma("unroll") for (int _i = 0; _i < 2; ++_i) \
        __builtin_amdgcn_global_load_lds((const unsigned*)((const char*)(gbase) + (voff)[_i]), (PG8_LAS unsigned*)(lds + (bufoff) + ldsw + _i * 8192), 16, 0, 0); } while (0)
#define PG8_LDA(dst, b, h) do { _Pragma("unroll") for (int m = 0; m < 4; ++m) _Pragma("unroll") for (int k = 0; k < 2; ++k) dst[m][k] = *(const PG8_LAS bf16x8*)(lds + PG8_SA(b, h) + aoff + m * 2048 + k * 1024); } while (0)
#define PG8_LDB(dst, b, h) do { _Pragma("unroll") for (int n = 0; n < 2; ++n) _Pragma("unroll") for (int k = 0; k < 2; ++k) dst[n][k] = *(const PG8_LAS bf16x8*)(lds + PG8_SB(b, h) + boff + n * 2048 + k * 1024); } while (0)
#define PG8_MMA(ai, bj, At, Bt) do { __builtin_amdgcn_s_setprio(1); _Pragma("unroll") for (int m = 0; m < 4; ++m) _Pragma("unroll") for (int n = 0; n < 2; ++n) _Pragma("unroll") for (int k = 0; k < 2; ++k) \
        acc[ai][bj][m][n] = __builtin_amdgcn_mfma_f32_16x16x32_bf16(Bt[n][k], At[m][k], acc[ai][bj][m][n], 0, 0, 0); __builtin_amdgcn_s_setprio(0); } while (0)
#define PG8_WAIT_V(n) asm volatile("s_waitcnt vmcnt(" #n ")" ::: "memory")
#define PG8_WAIT_L(n) asm volatile("s_waitcnt lgkmcnt(" #n ")" ::: "memory")
#define PG8_BAR __builtin_amdgcn_s_barrier()
#define PG8_SCHED __builtin_amdgcn_sched_barrier(0)
    Unit cur, nxt; int ui = 0;
    if (!S.next(0, cur)) return;
    f32x4 acc[2][2][4][2];
#pragma unroll
    for (int a = 0; a < 2; ++a)
#pragma unroll
        for (int b = 0; b < 2; ++b)
#pragma unroll
            for (int m = 0; m < 4; ++m)
#pragma unroll
                for (int n = 0; n < 2; ++n) acc[a][b][m][n] = (f32x4){0.f, 0.f, 0.f, 0.f};
    bf16x8 At[4][2], B0[2][2], B1[2][2];
    const char* cA = (const char*)g.A + (size_t)cur.pm * tstep; const char* cB = (const char*)g.Bt + (size_t)cur.pn * tstep;
    S.a_ready(cur);
    if constexpr (SP2) {
        PG8_STAGE(PG8_SB(0, 0), cB, voffB); PG8_STAGE(PG8_SB(0, 1), cB + hstep, voffB); PG8_STAGE(PG8_SA(0, 0), cA, voffA); PG8_STAGE(PG8_SA(0, 1), cA + hstep, voffA);
        if (wr == 1) PG8_BAR;
        PG8_WAIT_V(2); PG8_BAR;
        PG8_STAGE(PG8_SB(1, 0), cB + kstep, voffB); PG8_STAGE(PG8_SA(1, 0), cA + kstep, voffA); PG8_STAGE(PG8_SB(1, 1), cB + hstep + kstep, voffB);
        PG8_WAIT_V(6); PG8_BAR;
    } else {
        PG8_STAGE(PG8_SB(0, 0), cB, voffB); PG8_STAGE(PG8_SA(0, 0), cA, voffA); PG8_STAGE(PG8_SB(0, 1), cB + hstep, voffB); PG8_STAGE(PG8_SA(0, 1), cA + hstep, voffA);
        if (wr == 1) PG8_BAR;
        PG8_WAIT_V(4); PG8_BAR;
        PG8_STAGE(PG8_SB(1, 0), cB + kstep, voffB); PG8_STAGE(PG8_SA(1, 0), cA + kstep, voffA); PG8_STAGE(PG8_SB(1, 1), cB + hstep + kstep, voffB);
        PG8_WAIT_V(6); PG8_BAR;
    }
    for (;;) {
        const bool has_next = S.next(ui + 1, nxt);
        const char* nA = has_next ? (const char*)g.A + (size_t)nxt.pm * tstep : cA; const char* nB = has_next ? (const char*)g.Bt + (size_t)nxt.pn * tstep : cB;
        for (int t = 0; t < nt; t += 2) {
            const bool last = (t == nt - 2);
            const char* a1 = cA + (size_t)(t + 1) * kstep;
            const char* a2 = last ? nA : cA + (size_t)(t + 2) * kstep; const char* b2 = last ? nB : cB + (size_t)(t + 2) * kstep;
            const char* a3 = a2 + kstep; const char* b3 = b2 + kstep;
            if (last && has_next) S.a_ready(nxt);
            if constexpr (SP2) {
            PG8_LDB(B0, 0, 0); PG8_LDB(B1, 0, 1); PG8_SCHED; PG8_LDA(At, 0, 0); PG8_STAGE(PG8_SA(1, 1), a1 + hstep, voffA);
            PG8_WAIT_V(8); PG8_WAIT_L(0); PG8_BAR; PG8_MMA(0, 0, At, B0); PG8_MMA(0, 1, At, B1); PG8_BAR; PG8_SCHED;
            PG8_LDA(At, 0, 1); PG8_STAGE(PG8_SB(0, 0), b2, voffB); PG8_STAGE(PG8_SB(0, 1), b2 + hstep, voffB); PG8_STAGE(PG8_SA(0, 0), a2, voffA);
            PG8_WAIT_V(8); PG8_WAIT_L(0); PG8_BAR; PG8_MMA(1, 0, At, B0); PG8_MMA(1, 1, At, B1); PG8_BAR; PG8_SCHED;
            PG8_LDB(B0, 1, 0); PG8_LDB(B1, 1, 1); PG8_SCHED; PG8_LDA(At, 1, 0); PG8_STAGE(PG8_SA(0, 1), a2 + hstep, voffA);
            PG8_WAIT_V(8); PG8_WAIT_L(0); PG8_BAR; PG8_MMA(0, 0, At, B0); PG8_MMA(0, 1, At, B1); PG8_BAR; PG8_SCHED;
            PG8_LDA(At, 1, 1); PG8_STAGE(PG8_SB(1, 0), b3, voffB); PG8_STAGE(PG8_SB(1, 1), b3 + hstep, voffB); PG8_STAGE(PG8_SA(1, 0), a3, voffA);
            PG8_WAIT_V(8); PG8_WAIT_L(0); PG8_BAR; PG8_MMA(1, 0, At, B0); PG8_MMA(1, 1, At, B1); PG8_BAR; PG8_SCHED;
            } else {
            PG8_LDB(B0, 0, 0); PG8_SCHED; PG8_LDA(At, 0, 0); PG8_STAGE(PG8_SA(1, 1), a1 + hstep, voffA);
            PG8_WAIT_L(8); PG8_BAR; PG8_WAIT_L(0); PG8_MMA(0, 0, At, B0); PG8_BAR; PG8_SCHED;
            PG8_LDB(B1, 0, 1); PG8_STAGE(PG8_SB(0, 0), b2, voffB);
            PG8_BAR; PG8_WAIT_L(0); PG8_MMA(0, 1, At, B1); PG8_BAR;
            PG8_LDA(At, 0, 1); PG8_STAGE(PG8_SA(0, 0), a2, voffA);
            PG8_BAR; PG8_WAIT_L(0); PG8_MMA(1, 0, At, B0); PG8_BAR; PG8_SCHED;
            PG8_STAGE(PG8_SB(0, 1), b2 + hstep, voffB);
            PG8_WAIT_V(6); PG8_BAR; PG8_MMA(1, 1, At, B1); PG8_BAR;
            PG8_LDB(B0, 1, 0); PG8_SCHED; PG8_LDA(At, 1, 0); PG8_STAGE(PG8_SA(0, 1), a2 + hstep, voffA);
            PG8_WAIT_L(8); PG8_BAR; PG8_WAIT_L(0); PG8_MMA(0, 0, At, B0); PG8_BAR; PG8_SCHED;
            PG8_LDB(B1, 1, 1); PG8_STAGE(PG8_SB(1, 0), b3, voffB);
            PG8_BAR; PG8_WAIT_L(0); PG8_MMA(0, 1, At, B1); PG8_BAR;
            PG8_LDA(At, 1, 1); PG8_STAGE(PG8_SA(1, 0), a3, voffA);
            PG8_BAR; PG8_WAIT_L(0); PG8_MMA(1, 0, At, B0); PG8_BAR; PG8_SCHED;
            PG8_STAGE(PG8_SB(1, 1), b3 + hstep, voffB);
            PG8_WAIT_V(6); PG8_BAR; PG8_MMA(1, 1, At, B1); PG8_BAR;
            }
        }
        if constexpr (ALIGN_EPI) { if (wr == 0) PG8_BAR; }
        if constexpr (!Epi::AFTER_DRAIN) { E(acc, cur, wr, wc, fr, fq); S.done(cur); }
        if (!has_next) break;
#pragma unroll
        for (int a = 0; a < 2; ++a)
#pragma unroll
            for (int b = 0; b < 2; ++b)
#pragma unroll
                for (int m = 0; m < 4; ++m)
#pragma unroll
                    for (int n = 0; n < 2; ++n) acc[a][b][m][n] = (f32x4){0.f, 0.f, 0.f, 0.f};
        cur = nxt; cA = nA; cB = nB; ++ui;
        if constexpr (ALIGN_EPI) { if (wr == 1) PG8_BAR; }
    }
    PG8_WAIT_V(0);
    if constexpr (!ALIGN_EPI) { if (wr == 0) PG8_BAR; }
    PG8_BAR;
    if constexpr (Epi::AFTER_DRAIN) { E.fused(acc, cur, wr, wc, fr, fq, lds, wid, lane); S.done(cur); }
#undef PG8_SA
#undef PG8_SB
#undef PG8_STAGE
#undef PG8_LDA
#undef PG8_LDB
#undef PG8_MMA
#undef PG8_WAIT_V
#undef PG8_WAIT_L
#undef PG8_BAR
#undef PG8_SCHED
}
}
#define GAS __attribute__((address_space(1)))
#define LAS __attribute__((address_space(3)))
typedef unsigned short bf16;
typedef unsigned v4u __attribute__((ext_vector_type(4)));
typedef unsigned v2u __attribute__((ext_vector_type(2)));
typedef float f32x4 __attribute__((ext_vector_type(4)));
constexpr int NWAVES = 8;
constexpr int LDS_BYTES = 147456, LDSCTL_OFF = 131072;
constexpr int CW_BAR = 4096;
constexpr size_t MiB = 1u << 20;
constexpr size_t WS_CTL = 0, CTL_BYTES = 1 * MiB;
constexpr size_t WS_SSQ_A = 256 * 1024, WS_SSQ_B = 320 * 1024, WS_SSQ_C = 384 * 1024, WS_SSQ_D = 448 * 1024;
constexpr size_t WS_STAMP = 128 * 1024;
constexpr size_t WS_BCTR = 192 * 1024;
constexpr size_t WS_SU = 512 * 1024, WS_SV = 768 * 1024;
constexpr size_t WS_WCS = 1 * MiB, WS_ROPE = 2 * MiB, WS_KEYS = 3 * MiB;
constexpr size_t WS_WOF = 8 * MiB, WS_WQKV = 16 * MiB, WS_WOA = 28 * MiB, WS_WQ0 = 36 * MiB, WS_WQ1 = 44 * MiB;
constexpr size_t WS_A2 = 64 * MiB, WS_TW = 65 * MiB;
constexpr size_t WS_U0 = 128 * MiB, WS_V0 = 192 * MiB, WS_U1 = 256 * MiB, WS_V1 = 320 * MiB;
constexpr size_t WS_XG = 384 * MiB, WS_XB = 384 * MiB;
constexpr size_t WS_ZT = 448 * MiB;
constexpr size_t WS_Y = 576 * MiB;
constexpr size_t WS_Q = 448 * MiB;
constexpr size_t WS_EI = 640 * MiB, WS_GW = 648 * MiB, WS_W1 = 656 * MiB;
constexpr size_t WS_PD = 448 * MiB;
constexpr size_t WS_QB = 448 * MiB, WS_KB = 512 * MiB, WS_VT = 528 * MiB, WS_O = 576 * MiB;

__device__ __forceinline__ unsigned f2bf(float f) { unsigned u = __builtin_bit_cast(unsigned, f); return (u + 0x7fffu + ((u >> 16) & 1u)) >> 16; }
__device__ __forceinline__ unsigned pk2(float lo, float hi) { return f2bf(lo) | (f2bf(hi) << 16); }

struct Args { const float* in[12]; float* out; unsigned char* ws; int ph_lo, ph_hi; };

__device__ __forceinline__ int qkv_row(int n) { if (n >= 2560) return n; const int d = n & 63, pc = (d < 32) ? 2 * d : 2 * (d - 32) + 1; return (n & ~63) + pc; }
template <int MODE>
__device__ __forceinline__ void transpose_item(const float* W, int K, int N, const float* gain, bf16* WT, LAS float* scr, int item, int lane) {
    const int nblk = N / 32, kb = item / nblk, nb = item % nblk, k0 = 64 * kb, n0 = 32 * nb;
    float wv[32];
#pragma unroll
    for (int i = 0; i < 32; ++i) wv[i] = W[(size_t)(k0 + 2 * i + (lane >> 5)) * N + n0 + (lane & 31)];
#pragma unroll
    for (int i = 0; i < 32; ++i) { const int kk = 2 * i + (lane >> 5); float v = wv[i]; if (gain) v *= gain[k0 + kk]; scr[kk * 33 + (lane & 31)] = v; }
    asm volatile("s_waitcnt lgkmcnt(0)" ::: "memory");
    const int c = lane & 7;
#pragma unroll
    for (int j = 0; j < 4; ++j) { const int n = (lane >> 3) + 8 * j; const LAS float* s = scr + (8 * c) * 33 + n;
        v4u o; o.x = pk2(s[0 * 33], s[1 * 33]); o.y = pk2(s[2 * 33], s[3 * 33]); o.z = pk2(s[4 * 33], s[5 * 33]); o.w = pk2(s[6 * 33], s[7 * 33]);
        const int row = (MODE == 1) ? qkv_row(n0 + n) : (n0 + n);
        *(v4u*)(WT + (size_t)row * K + k0 + 8 * c) = o; }
    asm volatile("s_waitcnt lgkmcnt(0)" ::: "memory");
}
__device__ __forceinline__ float wsum(float v) {
#pragma unroll
    for (int o = 1; o < 64; o <<= 1) v += __shfl_xor(v, o);
    return v;
}
__device__ __forceinline__ void cvt_stream(const float* src, bf16* dst, size_t n8, size_t gtid, size_t ngt) {
    for (size_t i = gtid; i < n8; i += ngt) {
        const f32x4 a = *(const f32x4*)(src + i * 8), b = *(const f32x4*)(src + i * 8 + 4);
        v4u o; o.x = pk2(a[0], a[1]); o.y = pk2(a[2], a[3]); o.z = pk2(b[0], b[1]); o.w = pk2(b[2], b[3]);
        *(v4u*)(dst + i * 8) = o;
    }
}
__device__ __forceinline__ void cvt_stream8(const float* src, unsigned char* dst, size_t n16, size_t gtid, size_t ngt, float scale) {
    for (size_t i = gtid; i < n16; i += ngt) {
        v4u o;
#pragma unroll
        for (int q = 0; q < 4; ++q) { f32x4 a = *(const f32x4*)(src + i * 16 + 4 * q) * scale;
#pragma unroll
            for (int e = 0; e < 4; ++e) a[e] = fminf(fmaxf(a[e], -448.f), 448.f);
            int w = 0; w = __builtin_amdgcn_cvt_pk_fp8_f32(a[0], a[1], w, false); w = __builtin_amdgcn_cvt_pk_fp8_f32(a[2], a[3], w, true); o[q] = (unsigned)w; }
        const size_t e = i >> 7, r = i & 127, sl = r >> 3, c8 = r & 7;
        *(v4u*)(dst + ((sl * 16384 + e) * 128 + c8 * 16)) = o;
    }
}
#define XB_TMO      128
#define XB_XCNT(j)  (256  + 64 * (j))
#define XB_XSUB(j)  (1280 + 64 * (j))
#define XB_XGEN(j)  (2304 + 64 * (j))
#define XB_TOP      3328
#define XB_TOPGEN   3392
#define XCD_BAR_WORDS 3456
#define XB_SPIN_CAP (1u << 18)

__device__ __forceinline__ unsigned xb_ld(unsigned* p)              { return __hip_atomic_load(p, __ATOMIC_RELAXED, __HIP_MEMORY_SCOPE_AGENT); }
__device__ __forceinline__ unsigned xb_add(unsigned* p, unsigned v) { return __hip_atomic_fetch_add(p, v, __ATOMIC_RELAXED, __HIP_MEMORY_SCOPE_AGENT); }
__device__ __forceinline__ unsigned xb_xcc_id() { return (unsigned)__builtin_amdgcn_s_getreg((3 << 11) | 20) & 0xFu; }
#define XB_SPIN(cond, bar) do { unsigned _sp = 0; while (cond) { __builtin_amdgcn_s_sleep(1); \
    if ((++_sp & 255u) == 0u) { if (xb_ld(&(bar)[XB_TMO])) break; if (_sp > XB_SPIN_CAP) { atomicAdd(&(bar)[XB_TMO], 1u); break; } } } } while (0)

struct XcdBarrier {
    unsigned* bar; unsigned x;
    volatile LAS unsigned* st;
};

__device__ __forceinline__ XcdBarrier xcd_barrier_post(unsigned* bar, volatile LAS unsigned* st) {
    XcdBarrier b; b.bar = bar; b.x = xb_xcc_id(); b.st = st;
    if (threadIdx.x == 0) (void)xb_add(&bar[XB_XCNT(b.x)], 1u);
    return b;
}
__device__ __forceinline__ void xcd_barrier_complete(unsigned* bar, unsigned x, unsigned& nloc, unsigned& nx) {
    const unsigned G = gridDim.x * gridDim.y * gridDim.z;
    unsigned sum, cnt, mine, sp = 0u;
    for (;;) {
        sum = 0u; cnt = 0u; mine = 0u;
#pragma unroll
        for (unsigned j = 0; j < 16; ++j) { const unsigned c = xb_ld(&bar[XB_XCNT(j)]); sum += c; cnt += (c > 0u) ? 1u : 0u; mine = (j == x) ? c : mine; }
        if (sum == G) break;
        __builtin_amdgcn_s_sleep(1);
        if ((++sp & 255u) == 0u) { if (xb_ld(&bar[XB_TMO])) break; if (sp > XB_SPIN_CAP) { atomicAdd(&bar[XB_TMO], 1u); break; } }
    }
    nloc = mine > 0u ? mine : 1u; nx = cnt > 0u ? cnt : 1u;
}

__device__ __forceinline__ void xcd_barrier(const XcdBarrier& b) {
    asm volatile("s_waitcnt vmcnt(0)" ::: "memory");
    __syncthreads();
    if (threadIdx.x == 0) {
        unsigned* bar = b.bar;
        __builtin_amdgcn_s_waitcnt(0);
        unsigned nloc = b.st[0], nx = b.st[1];
        if (nloc == 0u) { xcd_barrier_complete(bar, b.x, nloc, nx); b.st[0] = nloc; b.st[1] = nx; }
        const unsigned old = xb_add(&bar[XB_XSUB(b.x)], 1u);
        const unsigned gen = old / nloc;
        if (old + 1u == (gen + 1u) * nloc) {
            __builtin_amdgcn_fence(__ATOMIC_RELEASE, "agent");
            asm volatile("s_waitcnt vmcnt(0)" ::: "memory");
            const unsigned og = xb_add(&bar[XB_TOP], 1u);
            const unsigned tg = og / nx;
            if (og + 1u == (tg + 1u) * nx) xb_add(&bar[XB_TOPGEN], 1u);
            else XB_SPIN(xb_ld(&bar[XB_TOPGEN]) == tg, bar);
            __builtin_amdgcn_fence(__ATOMIC_ACQUIRE, "agent");
            xb_add(&bar[XB_XGEN(b.x)], 1u);
            asm volatile("s_waitcnt vmcnt(0)" ::: "memory");
        } else {
            XB_SPIN(xb_ld(&bar[XB_XGEN(b.x)]) == gen, bar);
            __builtin_amdgcn_fence(__ATOMIC_ACQUIRE, "agent");
            asm volatile("s_waitcnt vmcnt(0)" ::: "memory");
        }
    }
    __syncthreads();
}
#define U_SCALE 1024.f
#define V_SCALE 256.f
typedef float f32x16 __attribute__((ext_vector_type(16)));
#ifndef TKB
#define TKB 2
#endif
typedef short s16x8 __attribute__((ext_vector_type(8)));
typedef __bf16 bf16x2_t __attribute__((ext_vector_type(2)));
__device__ __forceinline__ unsigned ordf(float f) { const unsigned u = __float_as_uint(f); return (u & 0x80000000u) ? ~u : (u | 0x80000000u); }
__device__ __forceinline__ float unordf(unsigned u) { return __uint_as_float((u & 0x80000000u) ? (u & 0x7fffffffu) : ~u); }
__device__ __forceinline__ unsigned umax_(unsigned a, unsigned b) { return a > b ? a : b; }
#define DPPU(v, ctrl) ((unsigned)__builtin_amdgcn_update_dpp(0, (int)(v), (ctrl), 0xf, 0xf, true))
#define DPPF(v, ctrl) __int_as_float(__builtin_amdgcn_update_dpp(0, __float_as_int(v), (ctrl), 0xf, 0xf, true))
__device__ __forceinline__ unsigned max32(unsigned v) {
    v = umax_(v, DPPU(v, 0xB1)); v = umax_(v, DPPU(v, 0x4E)); v = umax_(v, DPPU(v, 0x141)); v = umax_(v, DPPU(v, 0x140));
    const auto r = __builtin_amdgcn_permlane16_swap(v, v, false, false);
    return umax_(r[0], r[1]);
}
__device__ __forceinline__ float sum16(float v) {
    v += DPPF(v, 0xB1); v += DPPF(v, 0x4E); v += DPPF(v, 0x141); v += DPPF(v, 0x140); return v;
}
__device__ __forceinline__ unsigned bperm(unsigned v, int srclane) { return (unsigned)__builtin_amdgcn_ds_bpermute(srclane << 2, (int)v); }
#define CMPX(a_, b_) do { const unsigned hi_ = umax_(a_, b_), lo_ = (a_ < b_) ? a_ : b_; a_ = hi_; b_ = lo_; } while (0)
__device__ __forceinline__ unsigned max16(unsigned v) { v = umax_(v, DPPU(v, 0xB1)); v = umax_(v, DPPU(v, 0x4E)); v = umax_(v, DPPU(v, 0x141)); v = umax_(v, DPPU(v, 0x140)); return v; }
__device__ __forceinline__ unsigned top16_of8(unsigned (&p)[8], int c) {
    CMPX(p[0], p[1]); CMPX(p[2], p[3]); CMPX(p[4], p[5]); CMPX(p[6], p[7]);
    CMPX(p[0], p[2]); CMPX(p[1], p[3]); CMPX(p[4], p[6]); CMPX(p[5], p[7]);
    CMPX(p[1], p[2]); CMPX(p[5], p[6]); CMPX(p[0], p[4]); CMPX(p[3], p[7]);
    CMPX(p[1], p[5]); CMPX(p[2], p[6]);
    CMPX(p[1], p[4]); CMPX(p[3], p[6]);
    CMPX(p[2], p[4]); CMPX(p[3], p[5]);
    CMPX(p[3], p[4]);
    unsigned W = 0u;
    for (int it = 0; it < 16; ++it) {
        const unsigned m = max16(p[0]);
        W = (c == it) ? m : W;
        const bool win = (p[0] == m);
#pragma unroll
        for (int i = 0; i < 7; ++i) p[i] = win ? p[i + 1] : p[i];
        p[7] = win ? 0u : p[7];
    }
    return W;
}
__device__ __forceinline__ unsigned top16_of4r(unsigned (&p)[4], int c) {
    CMPX(p[0], p[1]); CMPX(p[2], p[3]); CMPX(p[0], p[2]); CMPX(p[1], p[3]); CMPX(p[1], p[2]);
    unsigned W = 0u;
    for (int it = 0; it < 16; ++it) {
        const unsigned m = max16(p[0]);
        W = (c == it) ? m : W;
        const bool win = (p[0] == m);
        p[0] = win ? p[1] : p[0]; p[1] = win ? p[2] : p[1]; p[2] = win ? p[3] : p[2]; p[3] = win ? 0u : p[3];
    }
    return W;
}
__device__ __forceinline__ void topk_fill(LAS unsigned char* lds, const bf16* keys, int h, int tid) {
#pragma unroll
    for (int i = 0; i < 8; ++i) { const int idx = tid + 512 * i, p = idx >> 11, key = (idx >> 4) & 127, ch = idx & 15;
        const v4u v = *(const v4u*)(keys + (size_t)((h * 2 + p) * 128 + key) * 128 + ch * 8);
        *(LAS v4u*)(lds + p * 32768 + key * 256 + ((ch ^ (key & 15)) << 4)) = v; }
}
struct CvtCtx { const float* srcU; long dsrc; const float* gain; unsigned char* dstU; long ddst; float* su; long dsc; int gwave, nw; };
__device__ __forceinline__ void cvt_chunk_load(const CvtCtx& cx, int c, int lane, f32x4 (&v)[4]) {
    const int r = c >> 1, hh = c & 1;
    const float* src = cx.srcU + ((r < 16384) ? 0L : cx.dsrc) + (size_t)(r & 16383) * 2048 + hh * 1024 + 4 * lane;
#pragma unroll
    for (int j = 0; j < 4; ++j) v[j] = *(const f32x4*)(src + 256 * j);
}
__device__ __forceinline__ void cvt_chunk_store(const CvtCtx& cx, int c, int lane, f32x4 (&v)[4]) {
    const int r = c >> 1, hh = c & 1; const bool isu = r < 16384; const int e = r & 16383;
    float mx = 0.f;
#pragma unroll
    for (int j = 0; j < 4; ++j) { if (isu) v[j] = v[j] * *(const f32x4*)(cx.gain + hh * 1024 + 256 * j + 4 * lane);
        mx = fmaxf(mx, fmaxf(fmaxf(fabsf(v[j][0]), fabsf(v[j][1])), fmaxf(fabsf(v[j][2]), fabsf(v[j][3])))); }
    mx = fmaxf(mx, DPPF(mx, 0xB1)); mx = fmaxf(mx, DPPF(mx, 0x4E)); mx = fmaxf(mx, DPPF(mx, 0x141)); mx = fmaxf(mx, DPPF(mx, 0x140));
    { const auto rr = __builtin_amdgcn_permlane16_swap(__float_as_uint(mx), __float_as_uint(mx), false, false); mx = fmaxf(__uint_as_float(rr[0]), __uint_as_float(rr[1])); }
    { const auto rr = __builtin_amdgcn_permlane32_swap(__float_as_uint(mx), __float_as_uint(mx), false, false); mx = fmaxf(__uint_as_float(rr[0]), __uint_as_float(rr[1])); }
    const float sc = fmaxf(mx, 1e-30f) * (1.f / 6.f), inv = 1.f / sc;
    if (lane == 0) (cx.su + (isu ? 0L : cx.dsc))[e * 2 + hh] = sc;
    unsigned char* dst = cx.dstU + (isu ? 0L : cx.ddst) + ((size_t)(hh * 4) * 16384 + e) * 128 + 2 * lane;
#pragma unroll
    for (int j = 0; j < 4; ++j) { unsigned w = 0u;
        w = __builtin_amdgcn_cvt_scalef32_pk_fp4_f32(w, v[j][0] * inv, v[j][1] * inv, 1.0f, 0); w = __builtin_amdgcn_cvt_scalef32_pk_fp4_f32(w, v[j][2] * inv, v[j][3] * inv, 1.0f, 1);
        *(unsigned short*)(dst + (size_t)j * (16384 * 128)) = (unsigned short)w; }
}
__device__ __forceinline__ void topk_unit(const bf16* q, LAS const unsigned char* lds, int* EI, float* GW, int t0, int h, int lane) {
    const int c = lane & 15, g4 = lane >> 4, rbase = lane & 48;
    int f0 = 0, f1 = 0, f2 = 0, f3 = 0;
    { int cnt = 0;
#pragma unroll
      for (int i = 0; i < 16; ++i)
#pragma unroll
        for (int j = 0; j < 16; ++j) if ((i + 1) * (j + 1) <= 16) { const int fl = i * 16 + j; f0 = (cnt == c) ? fl : f0; f1 = (cnt == c + 16) ? fl : f1; f2 = (cnt == c + 32) ? fl : f2; f3 = (cnt == c + 48) ? fl : f3; ++cnt; } }
    unsigned W[2][8];
#pragma unroll
    for (int p = 0; p < 2; ++p) {
        f32x4 acc[2][8];
#pragma unroll
        for (int mb = 0; mb < 2; ++mb)
#pragma unroll
            for (int kb = 0; kb < 8; ++kb) acc[mb][kb] = (f32x4){0.f, 0.f, 0.f, 0.f};
        const bf16* qp = q + (size_t)(t0 + c) * 2048 + h * 256 + p * 128 + g4 * 8;
        LAS const unsigned char* kp = lds + p * 32768 + c * 256;
        asm volatile("" : "+v"(qp));
#pragma unroll 2
        for (int ks = 0; ks < 4; ++ks) {
            const s16x8 a0 = *(const s16x8*)(qp + ks * 32), a1 = *(const s16x8*)(qp + (size_t)16 * 2048 + ks * 32);
#pragma unroll
            for (int kb = 0; kb < 8; ++kb) { const s16x8 b = *(LAS const s16x8*)(kp + kb * 4096 + (((4 * ks + g4) ^ c) << 4));
                acc[0][kb] = __builtin_amdgcn_mfma_f32_16x16x32_bf16(a0, b, acc[0][kb], 0, 0, 0); acc[1][kb] = __builtin_amdgcn_mfma_f32_16x16x32_bf16(a1, b, acc[1][kb], 0, 0, 0); }
        }
#pragma unroll
        for (int pb = 0; pb < 8; ++pb) {
            unsigned pk[8];
#pragma unroll
            for (int kb = 0; kb < 8; ++kb) pk[kb] = (ordf(acc[pb >> 2][kb][pb & 3]) & ~127u) | (unsigned)(127 - 16 * kb - c);
            W[p][pb] = top16_of8(pk, c);
        }
    }
#pragma unroll
    for (int pb = 0; pb < 8; ++pb) {
        const unsigned w0 = W[0][pb], w1 = W[1][pb];
        unsigned cp[4];
        { const float a0 = unordf(bperm(w0, rbase + (f0 >> 4)) & ~127u), b0 = unordf(bperm(w1, rbase + (f0 & 15)) & ~127u); cp[0] = (ordf(a0 + b0) & ~63u) | (unsigned)(63 - c); }
        { const float a0 = unordf(bperm(w0, rbase + (f1 >> 4)) & ~127u), b0 = unordf(bperm(w1, rbase + (f1 & 15)) & ~127u); cp[1] = (ordf(a0 + b0) & ~63u) | (unsigned)(47 - c); }
        { const float a0 = unordf(bperm(w0, rbase + (f2 >> 4)) & ~127u), b0 = unordf(bperm(w1, rbase + (f2 & 15)) & ~127u); cp[2] = (ordf(a0 + b0) & ~63u) | (unsigned)(31 - c); }
        { const float a0 = unordf(bperm(w0, rbase + (f3 >> 4)) & ~127u), b0 = unordf(bperm(w1, rbase + (f3 & 15)) & ~127u); cp[3] = (c + 48 < 50) ? ((ordf(a0 + b0) & ~63u) | (unsigned)(15 - c)) : 0u; }
        const unsigned Wc = top16_of4r(cp, c);
        const int slot = 63 - (int)(Wc & 63u);
        const unsigned fa = bperm((unsigned)f0, rbase + (slot & 15)), fb = bperm((unsigned)f1, rbase + (slot & 15)), fc = bperm((unsigned)f2, rbase + (slot & 15)), fd = bperm((unsigned)f3, rbase + (slot & 15));
        const int sq = slot >> 4; const int flat = (int)((sq == 0) ? fa : (sq == 1) ? fb : (sq == 2) ? fc : fd);
        const float val = unordf(Wc & ~63u);
        const float vmax = __uint_as_float(bperm(__float_as_uint(val), rbase));
        const float e = __expf(val - vmax);
        const float g = e / sum16(e);
        const int k1 = 127 - (int)(bperm(w0, rbase + (flat >> 4)) & 127u), k2 = 127 - (int)(bperm(w1, rbase + (flat & 15)) & 127u);
        const int tok = t0 + 16 * (pb >> 2) + 4 * g4 + (pb & 3);
        EI[(size_t)(tok * 8 + h) * 16 + c] = k1 * 128 + k2; GW[(size_t)(tok * 8 + h) * 16 + c] = g;
    }
}

__device__ __forceinline__ float gelu_tanh_f(float x) {
    const float u = 0.7978845608028654f * (x + 0.044715f * x * x * x);
    const float e = __expf(2.f * u);
    const float th = 1.f - 2.f / (e + 1.f);
    return 0.5f * x * (1.f + th);
}
__device__ __forceinline__ float wave_sum_bfly(float v) {
#pragma unroll
    for (int o = 1; o < 64; o <<= 1) v += __shfl_xor(v, o);
    return v;
}
typedef float f32x2_ __attribute__((ext_vector_type(2)));
#define FP4_DEC(w_, sel_) __builtin_amdgcn_cvt_scalef32_pk_f32_fp4((unsigned)(w_), 1.0f, (sel_))
typedef int i32x8 __attribute__((ext_vector_type(8)));
template <int NBT>
__device__ __forceinline__ void peer_a_slice(const bf16* xb, const int* EI, const unsigned char* U4s, float* pd, int s, unsigned* ctr, int nbatch, int lane) {
    const int c = lane & 15, g4 = lane >> 4, k8 = c >> 1;
    const unsigned char* tab = U4s + (size_t)s * (16384 * 128) + (4 * (c & 1) + g4) * 16;
#define A_FETCH() ((int)__builtin_amdgcn_readfirstlane((int)((lane == 0) ? __hip_atomic_fetch_add(ctr, 1u, __ATOMIC_RELAXED, __HIP_MEMORY_SCOPE_AGENT) : 0u)))
#define A_TOKB(b_, j_) ((((b_) < nbatch) ? (b_) : (nbatch - 1)) * NBT + (j_))
#define A_XS(XS, t_) do { const bf16* xp_ = xb + (size_t)(t_) * 2048 + s * 256 + 128 * (c & 1) + 16 * g4; XS[0] = *(const v4u*)xp_; XS[1] = *(const v4u*)(xp_ + 8); XS[2] = *(const v4u*)(xp_ + 64); XS[3] = *(const v4u*)(xp_ + 72); } while (0)
#define A_ISSUE(U, EV) do { _Pragma("unroll") for (int i = 0; i < 8; ++i) { const int e_ = (int)bperm((unsigned)(EV), (i << 3) + k8); U[i] = *(const v4u*)(tab + (size_t)e_ * 128); } } while (0)
#define A_COMPUTE(U, OUT) do { _Pragma("unroll") for (int i = 0; i < 8; ++i) { f32x4 d_ = (f32x4){0.f, 0.f, 0.f, 0.f}; \
            d_ = __builtin_amdgcn_mfma_scale_f32_16x16x128_f8f6f4((i32x8){(int)U[i][0], (int)U[i][1], (int)U[i][2], (int)U[i][3], 0, 0, 0, 0}, hb, d_, 4, 0, 0, 0x7f7f7f7f, 0, 0x7f7f7f7f); \
            const float o0_ = d_[0] + DPPF(d_[1], 0xB1), o1_ = d_[2] + DPPF(d_[3], 0xB1);        \
            if (k8 == i) OUT = (f32x2_){o0_, o1_}; } } while (0)
    int eL[NBT], eH[NBT], nL[NBT], nH[NBT]; v4u xs[2][4]; v4u UA[8], UB[8];
    int b0 = A_FETCH(), b1 = A_FETCH();
    if (b0 >= nbatch) return;
#pragma unroll
    for (int j = 0; j < NBT; ++j) { const int tj = A_TOKB(b0, j); eL[j] = EI[(size_t)tj * 128 + lane]; eH[j] = EI[(size_t)tj * 128 + 64 + lane]; }
    A_XS(xs[0], A_TOKB(b0, 0));
    A_ISSUE(UA, eL[0]);
    while (b0 < nbatch) {
        const int b2 = A_FETCH();
#pragma unroll
        for (int j = 0; j < NBT; ++j) { const int tj = A_TOKB(b1, j); nL[j] = EI[(size_t)tj * 128 + lane]; nH[j] = EI[(size_t)tj * 128 + 64 + lane]; }
#pragma unroll
        for (int j = 0; j < NBT; ++j) {
            const int t = b0 * NBT + j;
            A_ISSUE(UB, eH[j]);
            i32x8 hb;
#pragma unroll
            for (int q = 0; q < 4; ++q) { const v4u w = xs[j & 1][q]; int lo = 0, hi = 0;
                lo = __builtin_amdgcn_cvt_pk_fp8_f32(__uint_as_float(w[0] << 16), __uint_as_float(w[0] & 0xffff0000u), lo, false); lo = __builtin_amdgcn_cvt_pk_fp8_f32(__uint_as_float(w[1] << 16), __uint_as_float(w[1] & 0xffff0000u), lo, true);
                hi = __builtin_amdgcn_cvt_pk_fp8_f32(__uint_as_float(w[2] << 16), __uint_as_float(w[2] & 0xffff0000u), hi, false); hi = __builtin_amdgcn_cvt_pk_fp8_f32(__uint_as_float(w[3] << 16), __uint_as_float(w[3] & 0xffff0000u), hi, true);
                hb[2 * q] = lo; hb[2 * q + 1] = hi; }
            f32x2_ out_lo = (f32x2_){0.f, 0.f}, out_hi = (f32x2_){0.f, 0.f};
            A_COMPUTE(UA, out_lo);
            A_XS(xs[(j + 1) & 1], (j + 1 < NBT) ? (b0 * NBT + j + 1) : A_TOKB(b1, 0));
            A_ISSUE(UA, (j + 1 < NBT) ? eL[(j + 1) % NBT] : nL[0]);
            A_COMPUTE(UB, out_hi);
            if ((c & 1) == 0) { float* pp = pd + ((size_t)s * T + t) * 128 + 8 * k8 + 2 * g4; *(f32x2_*)pp = out_lo; *(f32x2_*)(pp + 64) = out_hi; }
        }
#pragma unroll
        for (int j = 0; j < NBT; ++j) { eL[j] = nL[j]; eH[j] = nH[j]; }
        b0 = b1; b1 = b2;
    }
#undef A_FETCH
#undef A_TOKB
#undef A_XS
#undef A_ISSUE
#undef A_COMPUTE
}
__device__ __forceinline__ unsigned w8rep(float w) { const float s = fminf(fmaxf(w * 256.f, -448.f), 448.f); return ((unsigned)__builtin_amdgcn_cvt_pk_fp8_f32(s, 0.f, 0, false) & 0xffu) * 0x01010101u; }
__device__ __forceinline__ void peer_a2_token(const float* pd, const float* ssq, const int* EI, const float* su, const float* sv, float* GW, float* W1, int t, int lane) {
    float a0 = 0.f, a1 = 0.f, b0 = 0.f, b1 = 0.f;
#pragma unroll
    for (int s = 0; s < 4; ++s) { const float* pp = pd + ((size_t)s * T + t) * 128; a0 += pp[lane]; a1 += pp[64 + lane]; }
#pragma unroll
    for (int s = 4; s < 8; ++s) { const float* pp = pd + ((size_t)s * T + t) * 128; b0 += pp[lane]; b1 += pp[64 + lane]; }
    const float rs = rsqrtf(ssq[t] * (1.f / 2048.f) + EPS);
    float* gp = GW + (size_t)t * 128; float* hp = W1 + (size_t)t * 128; const int pl = lane;
    const int e0 = EI[(size_t)t * 128 + pl], e1 = EI[(size_t)t * 128 + 64 + pl];
    const float g0 = gp[pl] * gelu_tanh_f(rs * (a0 * su[2 * e0] + b0 * su[2 * e0 + 1])), g1 = gp[64 + pl] * gelu_tanh_f(rs * (a1 * su[2 * e1] + b1 * su[2 * e1 + 1]));
    unsigned* gu = (unsigned*)gp; unsigned* hu = (unsigned*)hp;
    gu[pl] = w8rep(g0 * sv[2 * e0]); hu[pl] = w8rep(g0 * sv[2 * e0 + 1]);
    gu[64 + pl] = w8rep(g1 * sv[2 * e1]); hu[64 + pl] = w8rep(g1 * sv[2 * e1 + 1]);
}
template <int NBT>
__device__ __forceinline__ void peer_b_slice(const bf16* xres, float* xio, const int* EI, const unsigned* W, const unsigned char* V4s, bf16* xb, float* ssq_out, int s, unsigned* ctr, int nbatch, int lane) {
    const int j16 = lane & 15, g4 = lane >> 4;
    const unsigned char* tab = V4s + (size_t)s * (16384 * 128) + 8 * j16;
    const int doff = s * 256 + 64 * g4 + j16;
    const unsigned bm = 0xffu << (8 * (j16 & 3)); const unsigned M0 = ((j16 >> 2) == 0) ? bm : 0u, M1 = ((j16 >> 2) == 1) ? bm : 0u, M2 = ((j16 >> 2) == 2) ? bm : 0u, M3 = ((j16 >> 2) == 3) ? bm : 0u;
#define B_FETCH() ((int)__builtin_amdgcn_readfirstlane((int)((lane == 0) ? __hip_atomic_fetch_add(ctr, 1u, __ATOMIC_RELAXED, __HIP_MEMORY_SCOPE_AGENT) : 0u)))
#define B_TOKB(b_, j_) ((((b_) < nbatch) ? (b_) : (nbatch - 1)) * NBT + (j_))
#define B_ISSUE(V, EV) do { _Pragma("unroll") for (int i = 0; i < 8; ++i) { const int e0_ = (int)bperm((unsigned)(EV), 8 * i + 2 * g4), e1_ = (int)bperm((unsigned)(EV), 8 * i + 2 * g4 + 1); \
        V[2 * i] = *(const v2u*)(tab + (size_t)e0_ * 128); V[2 * i + 1] = *(const v2u*)(tab + (size_t)e1_ * 128); } } while (0)
#define B_COMPUTE(V, WV) do { _Pragma("unroll") for (int i = 0; i < 8; ++i) { \
            const unsigned f0_ = bperm((WV), 8 * i + g4), f1_ = bperm((WV), 8 * i + 4 + g4);        \
            const i32x8 bq_ = (i32x8){(int)(f0_ & M0), (int)(f0_ & M1), (int)(f0_ & M2), (int)(f0_ & M3), (int)(f1_ & M0), (int)(f1_ & M1), (int)(f1_ & M2), (int)(f1_ & M3)}; \
            acc = __builtin_amdgcn_mfma_scale_f32_16x16x128_f8f6f4((i32x8){(int)V[2 * i][0], (int)V[2 * i][1], (int)V[2 * i + 1][0], (int)V[2 * i + 1][1], 0, 0, 0, 0}, bq_, acc, 4, 0, 0, 0x7f7f7f7f, 0, 0x77777777); } } while (0)
    int eL[NBT], eH[NBT], nL[NBT], nH[NBT]; unsigned wL[NBT], wH[NBT], mL[NBT], mH[NBT]; float xv[4]; v2u VA[16], VB[16];
    int b0 = B_FETCH(), b1 = B_FETCH();
    if (b0 >= nbatch) return;
#pragma unroll
    for (int j = 0; j < NBT; ++j) { const int tj = B_TOKB(b0, j); eL[j] = EI[(size_t)tj * 128 + lane]; eH[j] = EI[(size_t)tj * 128 + 64 + lane]; wL[j] = W[(size_t)tj * 128 + lane]; wH[j] = W[(size_t)tj * 128 + 64 + lane]; }
    B_ISSUE(VA, eL[0]);
    while (b0 < nbatch) {
        const int b2 = B_FETCH();
#pragma unroll
        for (int j = 0; j < NBT; ++j) { const int tj = B_TOKB(b1, j); nL[j] = EI[(size_t)tj * 128 + lane]; nH[j] = EI[(size_t)tj * 128 + 64 + lane]; mL[j] = W[(size_t)tj * 128 + lane]; mH[j] = W[(size_t)tj * 128 + 64 + lane]; }
#pragma unroll
        for (int j = 0; j < NBT; ++j) {
            const int t = b0 * NBT + j;
            float* xp = xio + (size_t)t * 2048 + doff; const bf16* rp = xres + (size_t)t * 2048 + doff;
#pragma unroll
            for (int r = 0; r < 4; ++r) xv[r] = __uint_as_float((unsigned)rp[16 * r] << 16);
            B_ISSUE(VB, eH[j]);
            f32x4 acc = (f32x4){0.f, 0.f, 0.f, 0.f};
            B_COMPUTE(VA, wL[j]);
            B_ISSUE(VA, (j + 1 < NBT) ? eL[(j + 1) % NBT] : nL[0]);
            B_COMPUTE(VB, wH[j]);
            float ss = 0.f;
#pragma unroll
            for (int r = 0; r < 4; ++r) { const float o = xv[r] + acc[r]; ss += o * o; if (xb) xb[(size_t)t * 2048 + doff + 16 * r] = (bf16)f2bf(o); else xp[16 * r] = o; }
            ss += DPPF(ss, 0xB1); ss += DPPF(ss, 0x4E); ss += DPPF(ss, 0x141); ss += DPPF(ss, 0x140);
            { const auto r = __builtin_amdgcn_permlane16_swap(__float_as_uint(ss), __float_as_uint(ss), false, false); ss = __uint_as_float(r[0]) + __uint_as_float(r[1]); }
            { const auto r = __builtin_amdgcn_permlane32_swap(__float_as_uint(ss), __float_as_uint(ss), false, false); ss = __uint_as_float(r[0]) + __uint_as_float(r[1]); }
            if (lane == 0) unsafeAtomicAdd(ssq_out + t, ss);
        }
#pragma unroll
        for (int j = 0; j < NBT; ++j) { eL[j] = nL[j]; eH[j] = nH[j]; wL[j] = mL[j]; wH[j] = mH[j]; }
        b0 = b1; b1 = b2;
    }
#undef B_FETCH
#undef B_TOKB
#undef B_ISSUE
#undef B_COMPUTE
}
__device__ __forceinline__ void final_norm_row(float* xio, const float* ssq, const float* fin, int t, int lane, float oscale) {
    const float r2 = rsqrtf(ssq[t] * (1.f / 2048.f) + EPS) * oscale;
    float* xr = xio + (size_t)t * 2048 + 4 * lane;
#pragma unroll
    for (int j = 0; j < 8; ++j) { const f32x4 xv = *(const f32x4*)(xr + 256 * j), g = *(const f32x4*)(fin + 256 * j + 4 * lane); f32x4 o;
        o[0] = xv[0] * r2 * g[0]; o[1] = xv[1] * r2 * g[1]; o[2] = xv[2] * r2 * g[2]; o[3] = xv[3] * r2 * g[3]; *(f32x4*)(xr + 256 * j) = o; }
}
typedef short s16x4 __attribute__((ext_vector_type(4)));
__device__ __forceinline__ unsigned cvt_pk_bf16_(float lo, float hi) { unsigned r; asm volatile("v_cvt_pk_bf16_f32 %0, %1, %2" : "=v"(r) : "v"(lo), "v"(hi)); return r; }
constexpr int ATT_K_OFF = 0, ATT_V_OFF = 40960, ATT_VSTRIDE = 648, ATT_LDS = ATT_V_OFF + 64 * ATT_VSTRIDE;
__device__ __forceinline__ void attn_fill_load(const bf16* K, const bf16* Vt, int b, int kvh, int kw0, int tid, v4u (&kr)[5], v2u (&vr)[10]) {
    const size_t tb = (size_t)b * 4096;
#pragma unroll
    for (int i = 0; i < 5; ++i) { const int idx = tid + 512 * i, row = idx >> 3, ch = idx & 7, key = kw0 + row;
        kr[i] = (v4u){0u, 0u, 0u, 0u}; if (key >= 0 && key < 4096) kr[i] = *(const v4u*)(K + (tb + key) * 512 + kvh * 64 + ch * 8); }
#pragma unroll
    for (int i = 0; i < 10; ++i) { const int idx = tid + 512 * i, d = idx / 80, pc = idx % 80, key = kw0 + pc * 4;
        vr[i] = (v2u){0u, 0u}; if (key >= 0 && key < 4096) vr[i] = *(const v2u*)(Vt + (size_t)(kvh * 64 + d) * 16384 + tb + key); }
}
__device__ __forceinline__ void attn_fill_store(LAS unsigned char* lds, int tid, const v4u (&kr)[5], const v2u (&vr)[10]) {
#pragma unroll
    for (int i = 0; i < 5; ++i) { const int idx = tid + 512 * i, row = idx >> 3, ch = idx & 7; *(LAS v4u*)(lds + ATT_K_OFF + row * 128 + ((ch ^ ((row >> 1) & 7)) << 4)) = kr[i]; }
#pragma unroll
    for (int i = 0; i < 10; ++i) { const int idx = tid + 512 * i, d = idx / 80, pc = idx % 80; *(LAS v2u*)(lds + ATT_V_OFF + d * ATT_VSTRIDE + pc * 8) = vr[i]; }
}
__device__ __forceinline__ void attn_task(LAS const unsigned char* lds, const bf16* Q, bf16* O, const float* sinks, int b, int hq, int q0, int kw0, int lane) {
    const int c = lane & 31, hi = lane >> 5;
    const size_t tb = (size_t)b * 4096;
    s16x8 qf[4];
    { const bf16* qp = Q + (tb + q0 + c) * 2048 + hq * 64 + hi * 8;
#pragma unroll
      for (int ks = 0; ks < 4; ++ks) qf[ks] = *(const s16x8*)(qp + ks * 16); }
    const float sink2 = sinks[hq] * 1.4426950408889634f;
    float m = sink2, l = (hi == 0) ? 1.f : 0.f;
    f32x16 o0, o1;
#pragma unroll
    for (int r = 0; r < 16; ++r) { o0[r] = 0.f; o1[r] = 0.f; }
    const int kt_lo = (q0 < 128) ? ((128 - q0) >> 5) : 0, kt_hi = ((4192 - q0) >> 5) < 8 ? ((4192 - q0) >> 5) : 8;
    for (int kt = kt_lo; kt <= kt_hi; ++kt) {
        const int key0 = q0 - 128 + 32 * kt, row0 = key0 - kw0;
        s16x8 kf[4]; s16x4 va[2][2][2];
        { const int row = row0 + c; LAS const unsigned char* kp = lds + ATT_K_OFF + row * 128; const int sw = (row >> 1) & 7;
#pragma unroll
          for (int ks = 0; ks < 4; ++ks) kf[ks] = *(LAS const s16x8*)(kp + (((2 * ks + hi) ^ sw) << 4)); }
#pragma unroll
        for (int db = 0; db < 2; ++db)
#pragma unroll
            for (int s = 0; s < 2; ++s) { LAS const unsigned char* vp = lds + ATT_V_OFF + (db * 32 + c) * ATT_VSTRIDE + (row0 + 16 * s + 4 * hi) * 2; va[db][s][0] = *(LAS const s16x4*)vp; va[db][s][1] = *(LAS const s16x4*)(vp + 16); }
        f32x16 sa;
#pragma unroll
        for (int r = 0; r < 16; ++r) sa[r] = 0.f;
#pragma unroll
        for (int ks = 0; ks < 4; ++ks) sa = __builtin_amdgcn_mfma_f32_32x32x16_bf16(kf[ks], qf[ks], sa, 0, 0, 0);
        if (kt == 0 || kt == 8) {
            const int dbase = key0 - (q0 + c) + 4 * hi;
#pragma unroll
            for (int r = 0; r < 16; ++r) { const int d = dbase + (r & 3) + 8 * (r >> 2); if (d < -128 || d > 128) sa[r] = -1e30f; }
        }
        float mx = sa[0];
#pragma unroll
        for (int r = 1; r < 16; ++r) mx = fmaxf(mx, sa[r]);
        { const auto rr = __builtin_amdgcn_permlane32_swap(__float_as_uint(mx), __float_as_uint(mx), false, false); mx = fmaxf(__uint_as_float(rr[0]), __uint_as_float(rr[1])); }
        const float mn = fmaxf(m, mx), alpha = __builtin_amdgcn_exp2f(m - mn);
        m = mn;
        float ps = 0.f;
#pragma unroll
        for (int r = 0; r < 16; ++r) { sa[r] = __builtin_amdgcn_exp2f(sa[r] - mn); ps += sa[r]; }
        l = l * alpha + ps;
#pragma unroll
        for (int r = 0; r < 16; ++r) { o0[r] *= alpha; o1[r] *= alpha; }
        s16x8 pf[2];
#pragma unroll
        for (int s = 0; s < 2; ++s) { v4u w; w.x = cvt_pk_bf16_(sa[8 * s + 0], sa[8 * s + 1]); w.y = cvt_pk_bf16_(sa[8 * s + 2], sa[8 * s + 3]); w.z = cvt_pk_bf16_(sa[8 * s + 4], sa[8 * s + 5]); w.w = cvt_pk_bf16_(sa[8 * s + 6], sa[8 * s + 7]);
            pf[s] = __builtin_bit_cast(s16x8, w); }
#pragma unroll
        for (int s = 0; s < 2; ++s) {
            const s16x8 v0 = __builtin_shufflevector(va[0][s][0], va[0][s][1], 0, 1, 2, 3, 4, 5, 6, 7), v1 = __builtin_shufflevector(va[1][s][0], va[1][s][1], 0, 1, 2, 3, 4, 5, 6, 7);
            o0 = __builtin_amdgcn_mfma_f32_32x32x16_bf16(v0, pf[s], o0, 0, 0, 0);
            o1 = __builtin_amdgcn_mfma_f32_32x32x16_bf16(v1, pf[s], o1, 0, 0, 0);
        }
    }
    { const auto rr = __builtin_amdgcn_permlane32_swap(__float_as_uint(l), __float_as_uint(l), false, false); l = __uint_as_float(rr[0]) + __uint_as_float(rr[1]); }
    const float il = 1.f / l;
    bf16* op = O + (tb + q0 + c) * 2048 + hq * 64 + 4 * hi;
#pragma unroll
    for (int g = 0; g < 4; ++g) {
        v2u w0, w1;
        w0.x = cvt_pk_bf16_(o0[4 * g + 0] * il, o0[4 * g + 1] * il); w0.y = cvt_pk_bf16_(o0[4 * g + 2] * il, o0[4 * g + 3] * il);
        w1.x = cvt_pk_bf16_(o1[4 * g + 0] * il, o1[4 * g + 1] * il); w1.y = cvt_pk_bf16_(o1[4 * g + 2] * il, o1[4 * g + 3] * il);
        *(v2u*)(op + 8 * g) = w0; *(v2u*)(op + 32 + 8 * g) = w1;
    }
}
typedef float fx2 __attribute__((ext_vector_type(2)));
__device__ __forceinline__ fx2 bf2_(unsigned w) { fx2 r; r[0] = __uint_as_float(w << 16); r[1] = __uint_as_float(w & 0xffff0000u); return r; }
__device__ __forceinline__ void fft16_item(bf16* Zp, const float* tw, int bg, int l, int s1h, int lane) {
    const int s1 = s1h * 128 + 2 * lane;
    bf16* base = Zp + ((size_t)(bg * 16) * 256 + l) * 512 + s1;
    fx2 zr[16], zi[16];
#pragma unroll
    for (int s2 = 0; s2 < 16; ++s2) { zr[s2] = bf2_(*(const unsigned*)(base + (size_t)s2 * 256 * 512)); zi[s2] = bf2_(*(const unsigned*)(base + (size_t)s2 * 256 * 512 + 256)); }
    fx2 er[16], ei[16];
#pragma unroll
    for (int d = 0; d < 4; ++d) {
        const fx2 ar = zr[d], ai_ = zi[d], br = zr[4 + d], bi = zi[4 + d], cr = zr[8 + d], ci = zi[8 + d], dr = zr[12 + d], di = zi[12 + d];
        const fx2 s0r = ar + cr, s0i = ai_ + ci, s1r = ar - cr, s1i = ai_ - ci, s2r = br + dr, s2i = bi + di, s3r = br - dr, s3i = bi - di;
        er[0 * 4 + d] = s0r + s2r; ei[0 * 4 + d] = s0i + s2i;
        er[1 * 4 + d] = s1r + s3i; ei[1 * 4 + d] = s1i - s3r;
        er[2 * 4 + d] = s0r - s2r; ei[2 * 4 + d] = s0i - s2i;
        er[3 * 4 + d] = s1r - s3i; ei[3 * 4 + d] = s1i + s3r;
    }
#pragma unroll
    for (int a = 1; a < 4; ++a)
#pragma unroll
        for (int d = 1; d < 4; ++d) {
            const float ang = 6.283185307179586f * (float)(a * d) / 16.f; const float c = __builtin_cosf(ang), sn = __builtin_sinf(ang);
            const fx2 xr = er[a * 4 + d], xi = ei[a * 4 + d];
            er[a * 4 + d] = xr * c + xi * sn; ei[a * 4 + d] = xi * c - xr * sn;
        }
#pragma unroll
    for (int a = 0; a < 4; ++a) {
        const fx2 ar = er[a * 4 + 0], ai_ = ei[a * 4 + 0], br = er[a * 4 + 1], bi = ei[a * 4 + 1], cr = er[a * 4 + 2], ci = ei[a * 4 + 2], dr = er[a * 4 + 3], di = ei[a * 4 + 3];
        const fx2 s0r = ar + cr, s0i = ai_ + ci, s1r = ar - cr, s1i = ai_ - ci, s2r = br + dr, s2i = bi + di, s3r = br - dr, s3i = bi - di;
        fx2 Dr[4], Di[4];
        Dr[0] = s0r + s2r; Di[0] = s0i + s2i; Dr[1] = s1r + s3i; Di[1] = s1i - s3r; Dr[2] = s0r - s2r; Di[2] = s0i - s2i; Dr[3] = s1r - s3i; Di[3] = s1i + s3r;
#pragma unroll
        for (int b = 0; b < 4; ++b) {
            const int k2 = a + 4 * b;
            const f32x4 t0 = *(const f32x4*)(tw + (size_t)(k2 * 256 + s1) * 2);
            const fx2 cc = (fx2){t0[0], t0[2]}, ss = (fx2){t0[1], t0[3]};
            const fx2 hr = Dr[b] * cc + Di[b] * ss, hi_ = Di[b] * cc - Dr[b] * ss;
            *(unsigned*)(base + (size_t)k2 * 256 * 512) = pk2(hr[0], hr[1]); *(unsigned*)(base + (size_t)k2 * 256 * 512 + 256) = pk2(hi_[0], hi_[1]);
        }
    }
}
__device__ __forceinline__ int static_unit(int nM, int nN, int G, int c, int i) {
    const int nwg = nM * nN; const long L = (long)i * G + c; if (L >= nwg) return -1;
    int wgid = (int)L; { const int q = nwg / 8, r = nwg % 8, xcd = wgid % 8, off = wgid / 8; wgid = (xcd < r ? xcd * (q + 1) : r * (q + 1) + (xcd - r) * q) + off; }
    const int nig = 8 * nN, gid = wgid / nig, fm = gid * 8, gsz = (nM - fm) < 8 ? (nM - fm) : 8;
    return ((fm + ((wgid % nig) % gsz)) << 16) | ((wgid % nig) / gsz);
}
#ifndef REP_PRO
#define REP_PRO 1
#endif
#ifndef REP_GEMM
#define REP_GEMM 1
#endif
#ifndef REP_ATT
#define REP_ATT 1
#endif
#ifndef REP_LITE
#define REP_LITE 0
#endif
#ifndef REP_Q
#define REP_Q 1
#endif
#ifndef REP_PA
#define REP_PA 1
#endif
#ifndef REP_TK
#define REP_TK 1
#endif
enum { PH_PRO = 0, PH_G1 = 1, PH_S1 = 2, PH_G2 = 3, PH_G3 = 4, PH_Q0 = 5, PH_TK0 = 6, PH_PA0 = 7, PH_PW0 = 8, PH_PB0 = 9, PH_QKV = 10, PH_ATT = 11, PH_WO = 12, PH_Q1 = 13, PH_TK1 = 14, PH_PA1 = 15, PH_PW1 = 16, PH_PB1 = 17, PH_FIN = 18, PH_END = 19 };
__global__ void __launch_bounds__(NWAVES * 64, 2) mega(Args a) {
    extern __shared__ __attribute__((aligned(16))) unsigned char lds_raw[];
    LAS unsigned char* lds = (LAS unsigned char*)lds_raw;
    cg::grid_group grid = cg::this_grid();
    const int wave = __builtin_amdgcn_readfirstlane(threadIdx.x >> 6);
#define FRESH_IDS() int lane; asm volatile("v_mbcnt_lo_u32_b32 %0, -1, 0\n\tv_mbcnt_hi_u32_b32 %0, -1, %0" : "=v"(lane)); const int tid = wave * 64 + lane; (void)tid
    const int G = gridDim.x, bx = blockIdx.x;
    unsigned char* ws = a.ws;
    const int lo = a.ph_lo, hi = a.ph_hi;
    volatile LAS unsigned* MISC = (volatile LAS unsigned*)(lds + LDSCTL_OFF);
    if (threadIdx.x < 16) MISC[threadIdx.x] = 0u;
    __syncthreads();
    XcdBarrier xbar = xcd_barrier_post((unsigned*)(ws + WS_CTL) + CW_BAR, MISC + 8);
#define IN(k) (lo <= (k) && (k) < hi)
#ifdef DIAG_A
#define STAMP(i) do { if (bx == 0 && threadIdx.x == 0) ((unsigned long long*)(ws + WS_STAMP))[i] = __builtin_amdgcn_s_memrealtime(); } while (0)
#else
#define STAMP(i) do { } while (0)
#endif
#define SEAM(k) do { if (IN(k) && IN((k) + 1)) { if ((k) == PH_PRO) grid.sync(); else xcd_barrier(xbar); } STAMP((k) + 1); } while (0)
    STAMP(0);
    for (int rep_ = 0; rep_ < REP_PRO; ++rep_)
    if (IN(PH_PRO)) { FRESH_IDS();
        const int gw = bx * NWAVES + wave, NGW = G * NWAVES;
        const size_t gtid = (size_t)bx * (NWAVES * 64) + tid, ngt = (size_t)G * NWAVES * 64;
        LAS float* scr = (LAS float*)(lds + wave * 16384);
        {
            constexpr int I_SQ = (DM / 64) * (DM / 32), I_QKV = (DM / 64) * (QKVW / 32);
            constexpr int NITEMS = 4 * I_SQ + I_QKV;
            for (int it = gw; it < NITEMS; it += NGW) {
                int r = it;
                if (r < I_SQ) { transpose_item<0>(a.in[3], DM, DM, nullptr, (bf16*)(ws + WS_WOF), scr, r, lane); continue; } r -= I_SQ;
                if (r < I_SQ) { transpose_item<0>(a.in[5], DM, DM, nullptr, (bf16*)(ws + WS_WOA), scr, r, lane); continue; } r -= I_SQ;
                if (r < I_SQ) { transpose_item<0>(a.in[7], DM, DM, a.in[2], (bf16*)(ws + WS_WQ0), scr, r, lane); continue; } r -= I_SQ;
                if (r < I_SQ) { transpose_item<0>(a.in[7] + (size_t)DM * DM, DM, DM, a.in[2] + DM, (bf16*)(ws + WS_WQ1), scr, r, lane); continue; } r -= I_SQ;
                transpose_item<1>(a.in[4], DM, QKVW, a.in[1] + DM, (bf16*)(ws + WS_WQKV), scr, r, lane);
            }
        }
        {
            f32x4 v[8], nv[8];
            { const f32x4* xr = (const f32x4*)(a.in[0] + (size_t)(gw < T ? gw : 0) * DM) + lane;
#pragma unroll
              for (int j = 0; j < 8; ++j) v[j] = xr[64 * j]; }
            for (int row = gw; row < T; row += NGW) {
                { const int nr = (row + NGW < T) ? row + NGW : row; const f32x4* xr = (const f32x4*)(a.in[0] + (size_t)nr * DM) + lane;
#pragma unroll
                  for (int j = 0; j < 8; ++j) nv[j] = xr[64 * j]; }
                const f32x4* gr = (const f32x4*)a.in[1] + lane;
                float s = 0.f;
#pragma unroll
                for (int j = 0; j < 8; ++j) s += (v[j][0] * v[j][0] + v[j][1] * v[j][1]) + (v[j][2] * v[j][2] + v[j][3] * v[j][3]);
                const float r = rsqrtf(wsum(s) * (1.f / DM) + EPS);
                const int b = row >> 12, sp = row & 4095;
#pragma unroll
                for (int j = 0; j < 8; ++j) { const f32x4 gg = gr[64 * j]; v2u o; o.x = pk2(v[j][0] * r * gg[0], v[j][1] * r * gg[1]); o.y = pk2(v[j][2] * r * gg[2], v[j][3] * r * gg[3]);
                    *(v2u*)((bf16*)(ws + WS_XG) + ((size_t)((b * 8 + j) * 4096 + sp) * 256 + 4 * lane)) = o; }
#pragma unroll
                for (int j = 0; j < 8; ++j) v[j] = nv[j];
            }
        }
        for (size_t i = gtid; i < (size_t)256 * 512 / 8; i += ngt) {
            const int k1 = (int)(i >> 6), c0 = (int)(i & 63) * 8, part = c0 >> 8, s0 = c0 & 255;
            float v[8];
#pragma unroll
            for (int e = 0; e < 8; ++e) { const int m = (k1 * (s0 + e)) & 255; const float rev = (float)m * (1.f / 256.f); v[e] = (part ? __builtin_amdgcn_sinf(rev) : __builtin_amdgcn_cosf(rev)) * (1.f / 64.f); }
            v4u o; o.x = pk2(v[0], v[1]); o.y = pk2(v[2], v[3]); o.z = pk2(v[4], v[5]); o.w = pk2(v[6], v[7]);
            *(v4u*)((bf16*)(ws + WS_A2) + i * 8) = o;
        }
        for (size_t i = gtid; i < (size_t)16 * 256; i += ngt) {
            const int k2 = (int)(i >> 8), s1 = (int)(i & 255); const float rev = (float)(k2 * s1) * (1.f / 4096.f);
            ((float*)(ws + WS_TW))[2 * i] = __builtin_amdgcn_cosf(rev); ((float*)(ws + WS_TW))[2 * i + 1] = __builtin_amdgcn_sinf(rev);
        }
        for (size_t i = gtid; i < (size_t)512 * 256 / 8; i += ngt) {
            const int n = (int)(i >> 5), c0 = (int)(i & 31) * 8, part = n >> 8, l = n & 255;
            float v[8];
#pragma unroll
            for (int e = 0; e < 8; ++e) { const int m = (l * (c0 + e)) & 255; const float rev = (float)m * (1.f / 256.f); v[e] = (part ? -__builtin_amdgcn_sinf(rev) : __builtin_amdgcn_cosf(rev)) * (1.f / 16.f); }
            v4u o; o.x = pk2(v[0], v[1]); o.y = pk2(v[2], v[3]); o.z = pk2(v[4], v[5]); o.w = pk2(v[6], v[7]);
            *(v4u*)((bf16*)(ws + WS_WCS) + i * 8) = o;
        }
        for (size_t i = gtid; i < (size_t)4096 * 32; i += ngt) {
            const int pos = (int)(i >> 5), fi = (int)(i & 31);
            const double inv = exp2(-(double)fi * (13.287712379549449 / 32.0));
            double sn, cs; sincos((double)pos * inv, &sn, &cs);
            ((float*)(ws + WS_ROPE))[2 * i] = (float)cs; ((float*)(ws + WS_ROPE))[2 * i + 1] = (float)sn;
        }
#pragma unroll 1
        for (int L = 0; L < 2; ++L) {
            CvtCtx cx; cx.srcU = a.in[9] + (size_t)L * NEXP * DM; cx.dsrc = (long)((a.in[10] + (size_t)L * NEXP * DM) - cx.srcU); cx.gain = a.in[2] + L * DM; cx.dstU = ws + (L ? WS_U1 : WS_U0); cx.ddst = (long)WS_V0 - (long)WS_U0;
            cx.su = (float*)(ws + WS_SU) + L * 32768; cx.dsc = ((long)WS_SV - (long)WS_SU) / 4; cx.gwave = gw; cx.nw = NGW;
            f32x4 c0[4], c1[4], n0[4], n1[4];
            cvt_chunk_load(cx, gw, lane, c0); cvt_chunk_load(cx, (gw + NGW < 65536) ? gw + NGW : gw, lane, c1);
            for (int cc = gw; cc < 65536; cc += 2 * NGW) { const int ca = cc + 2 * NGW, cb = cc + 3 * NGW;
                cvt_chunk_load(cx, ca < 65536 ? ca : cc, lane, n0); cvt_chunk_load(cx, cb < 65536 ? cb : cc, lane, n1);
                cvt_chunk_store(cx, cc, lane, c0); if (cc + NGW < 65536) cvt_chunk_store(cx, cc + NGW, lane, c1);
#pragma unroll
                for (int q = 0; q < 4; ++q) { c0[q] = n0[q]; c1[q] = n1[q]; } }
        }
        cvt_stream(a.in[8], (bf16*)(ws + WS_KEYS), (size_t)2 * PH * 2 * 128 * 128 / 8, gtid, ngt);
    }
    SEAM(PH_PRO);
    for (int rep_ = 0; rep_ < REP_GEMM; ++rep_)
    if (IN(PH_G1)) { FRESH_IDS();
        int Kq = FW; asm volatile("" : "+s"(Kq));
        pg8::Gemm g{(const pg8::bf16_t*)(ws + WS_WCS), (const pg8::bf16_t*)(ws + WS_XG), 512, T * FG, Kq}; pg8::StaticOrder S; S.init(512, T * FG, G, bx);
        pg8::EpiZt E{(pg8::bf16_t*)(ws + WS_ZT)};
        pg8::gemm_phase<pg8::EpiZt, pg8::StaticOrder, true, true>(lds, g, S, E);
    }
    SEAM(PH_G1);
    if (IN(PH_S1)) { FRESH_IDS();
        const int gw = bx * NWAVES + wave, NGW = G * NWAVES;
        for (int it = gw; it < 32 * 256 * 2; it += NGW) fft16_item((bf16*)(ws + WS_ZT), (const float*)(ws + WS_TW), it >> 9, (it >> 1) & 255, it & 1, lane);
    }
    SEAM(PH_S1);
    for (int rep_ = 0; rep_ < REP_GEMM; ++rep_)
    if (IN(PH_G2)) { FRESH_IDS();
        pg8::Gemm g{(const pg8::bf16_t*)(ws + WS_A2), (const pg8::bf16_t*)(ws + WS_ZT), 256, 131072, 512}; pg8::StaticOrder S; S.init(256, 131072, G, bx);
        pg8::EpiY E{(pg8::bf16_t*)(ws + WS_Y)};
        pg8::gemm_phase<pg8::EpiY, pg8::StaticOrder, true, true>(lds, g, S, E);
    }
    SEAM(PH_G2);
    if (IN(PH_G3)) { FRESH_IDS();
        pg8::Gemm g{(const pg8::bf16_t*)(ws + WS_Y), (const pg8::bf16_t*)(ws + WS_WOF), T, DM, DM}; pg8::StaticOrder S; S.init(T, DM, G, bx);
        pg8::EpiRes E{a.in[0], a.out, (pg8::bf16_t*)(ws + WS_XB), (float*)(ws + WS_SSQ_A)};
        pg8::gemm_phase<pg8::EpiRes, pg8::StaticOrder, true, true>(lds, g, S, E);
    }
    SEAM(PH_G3);
#define PEER_LAYER(L) do { \
        const int pq = L ? PH_Q1 : PH_Q0, ptk = L ? PH_TK1 : PH_TK0, ppa = L ? PH_PA1 : PH_PA0, ppw = L ? PH_PW1 : PH_PW0, ppb = L ? PH_PB1 : PH_PB0; \
        for (int rep_ = 0; rep_ < REP_Q; ++rep_) \
        if (IN(pq)) { FRESH_IDS(); \
            pg8::Gemm g{(const pg8::bf16_t*)(ws + WS_XB), (const pg8::bf16_t*)(ws + (L ? WS_WQ1 : WS_WQ0)), T, DM, DM}; pg8::StaticOrder S; S.init(T, DM, G, bx); \
            pg8::EpiScale E{(pg8::bf16_t*)(ws + WS_Q), (const float*)(ws + (L ? WS_SSQ_C : WS_SSQ_A))}; \
            pg8::gemm_phase<pg8::EpiScale, pg8::StaticOrder, true, true>(lds, g, S, E); \
        } \
        if (IN(pq) && IN(ptk)) { asm volatile("s_waitcnt vmcnt(0)" ::: "memory"); __syncthreads(); } STAMP(pq + 1); \
        if (IN(ptk)) { FRESH_IDS(); \
            const bf16* keys = (const bf16*)(ws + WS_KEYS) + (size_t)L * PH * 2 * 128 * 128; \
            int slot = 0; \
            for (int rep_ = 0; rep_ < REP_TK; ++rep_) { slot = 0; \
            for (int ui = 0; ; ++ui) {        \
                const int upk = static_unit(T / 256, DM / 256, G, bx, ui); if (upk < 0) break; \
                const int h = upk & 0xffff, tblk = upk >> 16; \
                __syncthreads(); \
                topk_fill(lds, keys, h, tid); \
                __syncthreads(); \
                topk_unit((const bf16*)(ws + WS_Q), lds, (int*)(ws + WS_EI), (float*)(ws + WS_GW), tblk * 256 + wave * 32, h, lane); \
                slot += 16; \
            } } \
        } \
        SEAM(ptk); \
        if (IN(ppa)) { FRESH_IDS(); \
            const int xv = bx & 7; \
            peer_a_slice<8>((const bf16*)(ws + WS_XB), (const int*)(ws + WS_EI), (const unsigned char*)(ws + (L ? WS_U1 : WS_U0)), (float*)(ws + WS_PD), xv, (unsigned*)(ws + WS_BCTR) + (L * 2 + 0) * 512 + xv * 64, T / 8, lane); \
        } \
        SEAM(ppa); \
        if (IN(ppw)) { FRESH_IDS(); \
            const int gw = bx * NWAVES + wave, NGW = G * NWAVES; \
            for (int t = gw; t < T; t += NGW) peer_a2_token((const float*)(ws + WS_PD), (const float*)(ws + (L ? WS_SSQ_C : WS_SSQ_A)), (const int*)(ws + WS_EI), (const float*)(ws + WS_SU) + L * 32768, (const float*)(ws + WS_SV) + L * 32768, (float*)(ws + WS_GW), (float*)(ws + WS_W1), t, lane); \
        } \
        SEAM(ppw); \
        if (IN(ppb)) { FRESH_IDS(); \
            const int xv = bx & 7; \
            peer_b_slice<4>((const bf16*)(ws + WS_XB), a.out, (const int*)(ws + WS_EI), (const unsigned*)(ws + ((xv < 4) ? WS_GW : WS_W1)), (const unsigned char*)(ws + (L ? WS_V1 : WS_V0)), L ? (bf16*)nullptr : (bf16*)(ws + WS_XB), (float*)(ws + (L ? WS_SSQ_D : WS_SSQ_B)), xv, (unsigned*)(ws + WS_BCTR) + (L * 2 + 1) * 512 + xv * 64, T / 4, lane); \
        } \
    } while (0)
    float oscale = 1.f;
    PEER_LAYER(0);
    SEAM(PH_PB0);
    for (int rep_ = 0; rep_ < REP_GEMM; ++rep_)
    if (IN(PH_QKV)) { FRESH_IDS();
        {
            pg8::Gemm g{(const pg8::bf16_t*)(ws + WS_XB), (const pg8::bf16_t*)(ws + WS_WQKV), T, 2560, DM}; pg8::StaticOrder S; S.init(T, 2560, G, bx);
            pg8::EpiQK E{(pg8::bf16_t*)(ws + WS_QB), (pg8::bf16_t*)(ws + WS_KB), (const float*)(ws + WS_SSQ_B), (const float*)(ws + WS_ROPE), 0.125f * 1.4426950408889634f};
            pg8::gemm_phase<pg8::EpiQK, pg8::StaticOrder, true, true>(lds, g, S, E);
        }
        if (bx >= G / 2) {
            pg8::Gemm g{(const pg8::bf16_t*)(ws + WS_WQKV) + (size_t)2560 * DM, (const pg8::bf16_t*)(ws + WS_XB), 512, T, DM}; pg8::StaticOrder S; S.init(512, T, G / 2, bx - G / 2);
            pg8::EpiVt E{(pg8::bf16_t*)(ws + WS_VT), (const float*)(ws + WS_SSQ_B)};
            pg8::gemm_phase<pg8::EpiVt, pg8::StaticOrder, true, true>(lds, g, S, E);
        }
    }
    SEAM(PH_QKV);
    for (int rep_ = 0; rep_ < REP_ATT; ++rep_)
    if (IN(PH_ATT)) { FRESH_IDS();
        for (int vb = bx; vb < 256; vb += G) {
            const int bkv = vb >> 3, chunk = vb & 7, b = bkv >> 3, kvh = bkv & 7;
            v4u kr[5]; v2u vr[10];
            attn_fill_load((const bf16*)(ws + WS_KB), (const bf16*)(ws + WS_VT), b, kvh, chunk * 8 * 64 - 128, tid, kr, vr);
            for (int i = 0; i < 8; ++i) {
                const int qu = (chunk * 8 + i) * 64;
                __syncthreads();
                attn_fill_store(lds, tid, kr, vr);
                __syncthreads();
                if (i + 1 < 8) attn_fill_load((const bf16*)(ws + WS_KB), (const bf16*)(ws + WS_VT), b, kvh, qu + 64 - 128, tid, kr, vr);
                attn_task(lds, (const bf16*)(ws + WS_QB), (bf16*)(ws + WS_O), a.in[6], b, kvh * 4 + (wave & 3), qu + (wave >> 2) * 32, qu - 128, lane);
            }
        }
    }
    SEAM(PH_ATT);
    if (IN(PH_WO)) { FRESH_IDS();
        pg8::Gemm g{(const pg8::bf16_t*)(ws + WS_O), (const pg8::bf16_t*)(ws + WS_WOA), T, DM, DM}; pg8::StaticOrder S; S.init(T, DM, G, bx);
        pg8::EpiResB E{(const pg8::bf16_t*)(ws + WS_XB), (pg8::bf16_t*)(ws + WS_XB), (float*)(ws + WS_SSQ_C)};
        pg8::gemm_phase<pg8::EpiResB, pg8::StaticOrder, true, true>(lds, g, S, E);
    }
    SEAM(PH_WO);
#ifdef DIAG_A
    { const unsigned long long* st = (const unsigned long long*)(ws + WS_STAMP); oscale = 1.f + sqrtf((float)(st[DIAG_B] - st[DIAG_A]) * 1e-6f); }
#endif
    PEER_LAYER(1);
#undef PEER_LAYER
    SEAM(PH_PB1);
    if (IN(PH_FIN)) { FRESH_IDS();
        const int gw = bx * NWAVES + wave, NGW = G * NWAVES;
        for (int t = gw; t < T; t += NGW) final_norm_row(a.out, (const float*)(ws + WS_SSQ_D), a.in[11], t, lane, oscale);
    }
#undef SEAM
#undef IN
}

#ifndef N_LAUNCHES
#define N_LAUNCHES 1
#endif
extern "C" void kernel_launch(void* const* d_in, const int* in_sizes, int n_in, void* d_out, int out_size, void* d_ws, size_t ws_size, hipStream_t stream) {
    static int grid = 0;
    if (!grid) {
        if (hipFuncSetAttribute((const void*)mega, hipFuncAttributeMaxDynamicSharedMemorySize, LDS_BYTES) != hipSuccess) { fprintf(stderr, "hipFuncSetAttribute failed\n"); }
        int dev = 0, cus = 0, per_cu = 0;
        (void)hipGetDevice(&dev);
        (void)hipDeviceGetAttribute(&cus, hipDeviceAttributeMultiprocessorCount, dev);
        if (hipOccupancyMaxActiveBlocksPerMultiprocessor(&per_cu, (const void*)mega, NWAVES * 64, LDS_BYTES) != hipSuccess) per_cu = 0;
        (void)hipGetLastError();
        grid = cus * per_cu;
        if (grid > 256) grid = 256;
        grid &= ~1;
        if (grid < 2) { fprintf(stderr, "occupancy query gave %d x %d\n", cus, per_cu); grid = -1; }
    }
    if (grid < 0) return;
    if (ws_size < 700 * MiB) { fprintf(stderr, "ws too small: %zu\n", ws_size); return; }
    (void)hipMemsetAsync((char*)d_ws + WS_CTL, 0, CTL_BYTES, stream);
    Args a{};
    for (int i = 0; i < 12; ++i) a.in[i] = (const float*)d_in[i];
    a.out = (float*)d_out; a.ws = (unsigned char*)d_ws;
    if (N_LAUNCHES == 1) {
        a.ph_lo = 0; a.ph_hi = PH_END;
        void* args[] = {&a};
        const hipError_t e = hipLaunchCooperativeKernel((const void*)mega, dim3(grid), dim3(NWAVES * 64), args, LDS_BYTES, stream);
        if (e != hipSuccess) fprintf(stderr, "cooperative launch failed: %s (grid %d)\n", hipGetErrorString(e), grid);
    } else {
        for (int ph = 0; ph < PH_END; ++ph) {
            a.ph_lo = ph; a.ph_hi = ph + 1;
            hipLaunchKernelGGL(mega, dim3(grid), dim3(NWAVES * 64), LDS_BYTES, stream, a);
        }
    }
}
```

```cpp
#include <hip/hip_runtime.h>
#include <hip/hip_cooperative_groups.h>
namespace cg = cooperative_groups;
#include <cstdio>
#include <cstdint>
#include <cmath>

constexpr int DM = 2048, NB = 4, SEQ = 4096, T = NB * SEQ;
constexpr int FG = 8, FW = 256;
constexpr int HD = 64, NQH = 32, NKVH = 8, QKVW = 3072;
constexpr int PH = 8, NKEYS = 128, NEXP = 16384, PTOPK = 16;
constexpr float EPS = 1e-6f;
namespace pg8 {
#define PG8_LAS __attribute__((address_space(3)))
typedef unsigned short bf16_t;
typedef short bf16x8 __attribute__((ext_vector_type(8)));
typedef float f32x4 __attribute__((ext_vector_type(4)));
typedef unsigned u32x4 __attribute__((ext_vector_type(4)));
constexpr int BM = 256, BK = 64, HALF = 128, HTB = HALF * BK * 2  , STAGE_BYTES = 8 * HTB, NXCD = 8, WGM = 8;

__host__ __device__ __forceinline__ int lds_byte(int r, int c) { const int st = (r >> 4) * 2 + (c >> 5), rr = r & 15, cc = c & 31, ob = rr * 64 + cc * 2; return st * 1024 + (ob ^ (((ob >> 9) & 1) << 5)); }
__host__ __device__ __forceinline__ void stage_rc(int b, int& R, int& C) { const int st = b / 1024, sb = b % 1024, swz = sb ^ (((sb >> 9) & 1) << 5); R = (st >> 1) * 16 + swz / 64; C = (st & 1) * 32 + (swz % 64) / 2; }
__host__ __device__ __forceinline__ int perm32(int rho) { const int n = rho >> 4, i = rho & 15; return 8 * (i >> 2) + 4 * n + (i & 3); }

struct Unit { int pm, pn; };
struct Gemm { const bf16_t* A; const bf16_t* Bt; int M, N, K; };

struct StaticOrder {
    int nM, nN, nwg, G, c;
    __host__ __device__ void init(int M, int N, int G_, int c_) { nM = M / BM; nN = N / BM; nwg = nM * nN; G = G_; c = c_; }
    __host__ __device__ bool next(int i, Unit& u) const {
        const long L = (long)i * G + c; if (L >= nwg) return false;
        int wgid = (int)L; { const int q = nwg / NXCD, r = nwg % NXCD, xcd = wgid % NXCD, off = wgid / NXCD; wgid = (xcd < r ? xcd * (q + 1) : r * (q + 1) + (xcd - r) * q) + off; }
        const int nig = WGM * nN, gid = wgid / nig, fm = gid * WGM, gsz = (nM - fm) < WGM ? (nM - fm) : WGM;
        u.pm = fm + ((wgid % nig) % gsz); u.pn = (wgid % nig) / gsz; return true;
    }
    __device__ __forceinline__ void a_ready(const Unit&) const {}
    __device__ __forceinline__ void done(const Unit&) const {}
};

__device__ __forceinline__ unsigned cvt_pk_bf16(float lo, float hi) { unsigned r; asm volatile("v_cvt_pk_bf16_f32 %0, %1, %2" : "=v"(r) : "v"(lo), "v"(hi)); return r; }
typedef float f32x2 __attribute__((ext_vector_type(2)));
__device__ __forceinline__ u32x4 pack8(const f32x4 v0, const f32x4 v1) { u32x4 w; w.x = cvt_pk_bf16(v0[0], v0[1]); w.y = cvt_pk_bf16(v0[2], v0[3]); w.z = cvt_pk_bf16(v1[0], v1[1]); w.w = cvt_pk_bf16(v1[2], v1[3]); return w; }
struct EpiZt {
    static constexpr bool PERM = true, AFTER_DRAIN = false; bf16_t* Zp;
    __device__ __forceinline__ void operator()(const f32x4 (&acc)[2][2][4][2], const Unit& u, int wr, int wc, int fr, int fq) const {
        const int part = u.pm, bgs2 = u.pn;
        bf16_t* base = Zp + ((size_t)(bgs2 * 256 + wr * 64 + fr) * 512 + part * 256 + wc * 32 + 8 * fq);
#pragma unroll
        for (int ai = 0; ai < 2; ++ai)
#pragma unroll
            for (int m = 0; m < 4; ++m)
#pragma unroll
                for (int bj = 0; bj < 2; ++bj) *(u32x4*)(base + (ai * HALF + m * 16) * 512 + bj * HALF) = pack8(acc[ai][bj][m][0], acc[ai][bj][m][1]);
    }
};
struct EpiY {
    static constexpr bool PERM = true, AFTER_DRAIN = false; bf16_t* Y;
    __device__ __forceinline__ void operator()(const f32x4 (&acc)[2][2][4][2], const Unit& u, int wr, int wc, int fr, int fq) const {
        const int bg = u.pn >> 4, k2 = u.pn & 15, b = bg >> 3, g = bg & 7;
        bf16_t* base = Y + ((size_t)(b * 4096 + (wr * 64 + fr) * 16 + k2) * 2048 + g * 256 + wc * 32 + 8 * fq);
#pragma unroll
        for (int ai = 0; ai < 2; ++ai)
#pragma unroll
            for (int m = 0; m < 4; ++m)
#pragma unroll
                for (int bj = 0; bj < 2; ++bj) *(u32x4*)(base + (size_t)(ai * HALF + m * 16) * 16 * 2048 + bj * HALF) = pack8(acc[ai][bj][m][0], acc[ai][bj][m][1]);
    }
};
struct EpiRes {
    static constexpr bool PERM = true, AFTER_DRAIN = false; const float* R; float* out; bf16_t* xb; float* ssq;
    __device__ __forceinline__ void operator()(const f32x4 (&acc)[2][2][4][2], const Unit& u, int wr, int wc, int fr, int fq) const {
        const int row0 = u.pm * BM + wr * 64 + fr; const size_t off0 = (size_t)row0 * 2048 + u.pn * BM + wc * 32 + 8 * fq;
        const float* Rb = R + off0; bf16_t* Xb = xb + off0; float* Sb = ssq + row0;
#pragma unroll
        for (int ai = 0; ai < 2; ++ai)
#pragma unroll
            for (int m = 0; m < 4; ++m) { const int ro = (ai * HALF + m * 16) * 2048; float ss = 0.f;
#pragma unroll
                for (int bj = 0; bj < 2; ++bj) {
                    const f32x4 r0 = *(const f32x4*)(Rb + ro + bj * HALF), r1 = *(const f32x4*)(Rb + ro + bj * HALF + 4);
                    const f32x4 o0 = acc[ai][bj][m][0] + r0, o1 = acc[ai][bj][m][1] + r1;
                    *(u32x4*)(Xb + ro + bj * HALF) = pack8(o0, o1);
                    ss += (o0[0] * o0[0] + o0[1] * o0[1]) + (o0[2] * o0[2] + o0[3] * o0[3]) + (o1[0] * o1[0] + o1[1] * o1[1]) + (o1[2] * o1[2] + o1[3] * o1[3]); }
                ss += __shfl_xor(ss, 16); ss += __shfl_xor(ss, 32);
                if (fq == 0) unsafeAtomicAdd(Sb + ai * HALF + m * 16, ss);
                asm volatile("" ::: "memory"); }
    }
};
struct EpiResB {
    static constexpr bool PERM = true, AFTER_DRAIN = false; const bf16_t* R; bf16_t* xb; float* ssq;
    __device__ __forceinline__ void operator()(const f32x4 (&acc)[2][2][4][2], const Unit& u, int wr, int wc, int fr, int fq) const {
        const int row0 = u.pm * BM + wr * 64 + fr; const size_t off0 = (size_t)row0 * 2048 + u.pn * BM + wc * 32 + 8 * fq;
        const bf16_t* Rb = R + off0; bf16_t* Xb = xb + off0; float* Sb = ssq + row0;
#pragma unroll
        for (int ai = 0; ai < 2; ++ai)
#pragma unroll
            for (int m = 0; m < 4; ++m) { const int ro = (ai * HALF + m * 16) * 2048; float ss = 0.f;
#pragma unroll
                for (int bj = 0; bj < 2; ++bj) {
                    const u32x4 rw = *(const u32x4*)(Rb + ro + bj * HALF);
                    const f32x4 r0 = (f32x4){__uint_as_float(rw[0] << 16), __uint_as_float(rw[0] & 0xffff0000u), __uint_as_float(rw[1] << 16), __uint_as_float(rw[1] & 0xffff0000u)}, r1 = (f32x4){__uint_as_float(rw[2] << 16), __uint_as_float(rw[2] & 0xffff0000u), __uint_as_float(rw[3] << 16), __uint_as_float(rw[3] & 0xffff0000u)};
                    const f32x4 o0 = acc[ai][bj][m][0] + r0, o1 = acc[ai][bj][m][1] + r1;
                    *(u32x4*)(Xb + ro + bj * HALF) = pack8(o0, o1);
                    ss += (o0[0] * o0[0] + o0[1] * o0[1]) + (o0[2] * o0[2] + o0[3] * o0[3]) + (o1[0] * o1[0] + o1[1] * o1[1]) + (o1[2] * o1[2] + o1[3] * o1[3]); }
                ss += __shfl_xor(ss, 16); ss += __shfl_xor(ss, 32);
                if (fq == 0) unsafeAtomicAdd(Sb + ai * HALF + m * 16, ss);
                asm volatile("" ::: "memory"); }
    }
};
struct EpiScale {
    static constexpr bool PERM = true, AFTER_DRAIN = false; bf16_t* O; const float* ssq;
    __device__ __forceinline__ void operator()(const f32x4 (&acc)[2][2][4][2], const Unit& u, int wr, int wc, int fr, int fq) const {
        const int row0 = u.pm * BM + wr * 64 + fr;
        bf16_t* base = O + ((size_t)row0 * 2048 + u.pn * BM + wc * 32 + 8 * fq); const float* Sb = ssq + row0;
#pragma unroll
        for (int ai = 0; ai < 2; ++ai)
#pragma unroll
            for (int m = 0; m < 4; ++m) { const float rs = rsqrtf(Sb[ai * HALF + m * 16] * (1.f / 2048.f) + 1e-6f);
#pragma unroll
                for (int bj = 0; bj < 2; ++bj) *(u32x4*)(base + (ai * HALF + m * 16) * 2048 + bj * HALF) = pack8(acc[ai][bj][m][0] * rs, acc[ai][bj][m][1] * rs); }
    }
};
struct EpiQK {
    static constexpr bool PERM = true, AFTER_DRAIN = false; bf16_t* Q; bf16_t* K; const float* ssq; const float* rope; float qscale;
    __device__ __forceinline__ void operator()(const f32x4 (&acc)[2][2][4][2], const Unit& u, int wr, int wc, int fr, int fq) const {
        const int row0 = u.pm * BM + wr * 64 + fr; const bool isq = u.pn < 8;
        const int cl = wc * 32 + 8 * fq;
        bf16_t* base = isq ? (Q + ((size_t)row0 * 2048 + u.pn * BM + cl)) : (K + ((size_t)row0 * 512 + (u.pn - 8) * BM + cl));
        const int ld = isq ? 2048 : 512; const float sc = isq ? qscale : 1.f;
        const float* rp = rope + (size_t)(row0 & 4095) * 64 + (cl & 63);
        const float* Sb = ssq + row0;
#pragma unroll
        for (int ai = 0; ai < 2; ++ai)
#pragma unroll
            for (int m = 0; m < 4; ++m) { const int ro = ai * HALF + m * 16; const float rs = rsqrtf(Sb[ro] * (1.f / 2048.f) + 1e-6f) * sc;
                const f32x4 t0 = *(const f32x4*)(rp + (size_t)ro * 64), t1 = *(const f32x4*)(rp + (size_t)ro * 64 + 4);
#pragma unroll
                for (int bj = 0; bj < 2; ++bj) {
                    const f32x4 a = acc[ai][bj][m][0] * rs, b = acc[ai][bj][m][1] * rs; f32x4 oa, ob;
                    oa[0] = a[0] * t0[0] - a[1] * t0[1]; oa[1] = a[1] * t0[0] + a[0] * t0[1]; oa[2] = a[2] * t0[2] - a[3] * t0[3]; oa[3] = a[3] * t0[2] + a[2] * t0[3];
                    ob[0] = b[0] * t1[0] - b[1] * t1[1]; ob[1] = b[1] * t1[0] + b[0] * t1[1]; ob[2] = b[2] * t1[2] - b[3] * t1[3]; ob[3] = b[3] * t1[2] + b[2] * t1[3];
                    *(u32x4*)(base + (size_t)ro * ld + bj * HALF) = pack8(oa, ob); } }
    }
};
struct EpiVt {
    static constexpr bool PERM = true, AFTER_DRAIN = false; bf16_t* Vt; const float* ssq;
    __device__ __forceinline__ void operator()(const f32x4 (&acc)[2][2][4][2], const Unit& u, int wr, int wc, int fr, int fq) const {
        const int col0 = u.pn * BM + wc * 32 + 8 * fq;
        bf16_t* base = Vt + ((size_t)(u.pm * BM + wr * 64 + fr) * 16384 + col0);
        f32x4 r0[2], r1[2];
#pragma unroll
        for (int bj = 0; bj < 2; ++bj) { const f32x4 s0 = *(const f32x4*)(ssq + col0 + bj * HALF), s1 = *(const f32x4*)(ssq + col0 + bj * HALF + 4);
#pragma unroll
            for (int q = 0; q < 4; ++q) { r0[bj][q] = rsqrtf(s0[q] * (1.f / 2048.f) + 1e-6f); r1[bj][q] = rsqrtf(s1[q] * (1.f / 2048.f) + 1e-6f); } }
#pragma unroll
        for (int ai = 0; ai < 2; ++ai)
#pragma unroll
            for (int m = 0; m < 4; ++m)
#pragma unroll
                for (int bj = 0; bj < 2; ++bj) *(u32x4*)(base + (size_t)(ai * HALF + m * 16) * 16384 + bj * HALF) = pack8(acc[ai][bj][m][0] * r0[bj], acc[ai][bj][m][1] * r1[bj]);
    }
};
template <class Epi, class Sched, bool ALIGN_EPI = false, bool SP2 = false>
__device__ __forceinline__ void gemm_phase(PG8_LAS unsigned char* lds, const Gemm g, const Sched& S, const Epi& E) {
    const int tid = threadIdx.x, wid = __builtin_amdgcn_readfirstlane(tid >> 6), lane = tid & 63, wr = wid >> 2, wc = wid & 3, fr = lane & 15, fq = lane >> 4;
    const int K = g.K, nt = K / BK;
    unsigned voffA[2], voffB[2];
#pragma unroll
    for (int i = 0; i < 2; ++i) { int R, C; stage_rc(tid * 16 + i * 8192, R, C); const int Rb = Epi::PERM ? ((R & ~31) + perm32(R & 31)) : R;
        voffA[i] = (unsigned)(R * K + C) * 2u; voffB[i] = (unsigned)(Rb * K + C) * 2u; }
    const size_t kstep = (size_t)(BK * 2);
    const size_t hstep = (size_t)HALF * K * 2;
    const size_t tstep = 2 * hstep;
    const unsigned ldsw = (unsigned)wid * 1024u;
    const int aoff = lds_byte(wr * 64 + fr, fq * 8), boff = lds_byte(wc * 32 + fr, fq * 8);
#define PG8_SA(b, h) (((b) * 2 + (h)) * HTB)
#define PG8_SB(b, h) ((4 + (b) * 2 + (h)) * HTB)
#define PG8_STAGE(bufoff, gbase, voff) do { _Pragma("unroll") for (int _i = 0; _i < 2; ++_i) \
        __builtin_amdgcn_global_load_lds((const unsigned*)((const char*)(gbase) + (voff)[_i]), (PG8_LAS unsigned*)(lds + (bufoff) + ldsw + _i * 8192), 16, 0, 0); } while (0)
#define PG8_LDA(dst, b, h) do { _Pragma("unroll") for (int m = 0; m < 4; ++m) _Pragma("unroll") for (int k = 0; k < 2; ++k) dst[m][k] = *(const PG8_LAS bf16x8*)(lds + PG8_SA(b, h) + aoff + m * 2048 + k * 1024); } while (0)
#define PG8_LDB(dst, b, h) do { _Pragma("unroll") for (int n = 0; n < 2; ++n) _Pragma("unroll") for (int k = 0; k < 2; ++k) dst[n][k] = *(const PG8_LAS bf16x8*)(lds + PG8_SB(b, h) + boff + n * 2048 + k * 1024); } while (0)
#define PG8_MMA(ai, bj, At, Bt) do { __builtin_amdgcn_s_setprio(1); _Pragma("unroll") for (int m = 0; m < 4; ++m) _Pragma("unroll") for (int n = 0; n < 2; ++n) _Pragma("unroll") for (int k = 0; k < 2; ++k) \
        acc[ai][bj][m][n] = __builtin_amdgcn_mfma_f32_16x16x32_bf16(Bt[n][k], At[m][k], acc[ai][bj][m][n], 0, 0, 0); __builtin_amdgcn_s_setprio(0); } while (0)
#define PG8_WAIT_V(n) asm volatile("s_waitcnt vmcnt(" #n ")" ::: "memory")
#define PG8_WAIT_L(n) asm volatile("s_waitcnt lgkmcnt(" #n ")" ::: "memory")
#define PG8_BAR __builtin_amdgcn_s_barrier()
#define PG8_SCHED __builtin_amdgcn_sched_barrier(0)
    Unit cur, nxt; int ui = 0;
    if (!S.next(0, cur)) return;
    f32x4 acc[2][2][4][2];
#pragma unroll
    for (int a = 0; a < 2; ++a)
#pragma unroll
        for (int b = 0; b < 2; ++b)
#pragma unroll
            for (int m = 0; m < 4; ++m)
#pragma unroll
                for (int n = 0; n < 2; ++n) acc[a][b][m][n] = (f32x4){0.f, 0.f, 0.f, 0.f};
    bf16x8 At[4][2], B0[2][2], B1[2][2];
    const char* cA = (const char*)g.A + (size_t)cur.pm * tstep; const char* cB = (const char*)g.Bt + (size_t)cur.pn * tstep;
    S.a_ready(cur);
    if constexpr (SP2) {
        PG8_STAGE(PG8_SB(0, 0), cB, voffB); PG8_STAGE(PG8_SB(0, 1), cB + hstep, voffB); PG8_STAGE(PG8_SA(0, 0), cA, voffA); PG8_STAGE(PG8_SA(0, 1), cA + hstep, voffA);
        if (wr == 1) PG8_BAR;
        PG8_WAIT_V(2); PG8_BAR;
        PG8_STAGE(PG8_SB(1, 0), cB + kstep, voffB); PG8_STAGE(PG8_SA(1, 0), cA + kstep, voffA); PG8_STAGE(PG8_SB(1, 1), cB + hstep + kstep, voffB);
        PG8_WAIT_V(6); PG8_BAR;
    } else {
        PG8_STAGE(PG8_SB(0, 0), cB, voffB); PG8_STAGE(PG8_SA(0, 0), cA, voffA); PG8_STAGE(PG8_SB(0, 1), cB + hstep, voffB); PG8_STAGE(PG8_SA(0, 1), cA + hstep, voffA);
        if (wr == 1) PG8_BAR;
        PG8_WAIT_V(4); PG8_BAR;
        PG8_STAGE(PG8_SB(1, 0), cB + kstep, voffB); PG8_STAGE(PG8_SA(1, 0), cA + kstep, voffA); PG8_STAGE(PG8_SB(1, 1), cB + hstep + kstep, voffB);
        PG8_WAIT_V(6); PG8_BAR;
    }
    for (;;) {
        const bool has_next = S.next(ui + 1, nxt);
        const char* nA = has_next ? (const char*)g.A + (size_t)nxt.pm * tstep : cA; const char* nB = has_next ? (const char*)g.Bt + (size_t)nxt.pn * tstep : cB;
        for (int t = 0; t < nt; t += 2) {
            const bool last = (t == nt - 2);
            const char* a1 = cA + (size_t)(t + 1) * kstep;
            const char* a2 = last ? nA : cA + (size_t)(t + 2) * kstep; const char* b2 = last ? nB : cB + (size_t)(t + 2) * kstep;
            const char* a3 = a2 + kstep; const char* b3 = b2 + kstep;
            if (last && has_next) S.a_ready(nxt);
            if constexpr (SP2) {
            PG8_LDB(B0, 0, 0); PG8_LDB(B1, 0, 1); PG8_SCHED; PG8_LDA(At, 0, 0); PG8_STAGE(PG8_SA(1, 1), a1 + hstep, voffA);
            PG8_WAIT_V(8); PG8_WAIT_L(0); PG8_BAR; PG8_MMA(0, 0, At, B0); PG8_MMA(0, 1, At, B1); PG8_BAR; PG8_SCHED;
            PG8_LDA(At, 0, 1); PG8_STAGE(PG8_SB(0, 0), b2, voffB); PG8_STAGE(PG8_SB(0, 1), b2 + hstep, voffB); PG8_STAGE(PG8_SA(0, 0), a2, voffA);
            PG8_WAIT_V(8); PG8_WAIT_L(0); PG8_BAR; PG8_MMA(1, 0, At, B0); PG8_MMA(1, 1, At, B1); PG8_BAR; PG8_SCHED;
            PG8_LDB(B0, 1, 0); PG8_LDB(B1, 1, 1); PG8_SCHED; PG8_LDA(At, 1, 0); PG8_STAGE(PG8_SA(0, 1), a2 + hstep, voffA);
            PG8_WAIT_V(8); PG8_WAIT_L(0); PG8_BAR; PG8_MMA(0, 0, At, B0); PG8_MMA(0, 1, At, B1); PG8_BAR; PG8_SCHED;
            PG8_LDA(At, 1, 1); PG8_STAGE(PG8_SB(1, 0), b3, voffB); PG8_STAGE(PG8_SB(1, 1), b3 + hstep, voffB); PG8_STAGE(PG8_SA(1, 0), a3, voffA);
            PG8_WAIT_V(8); PG8_WAIT_L(0); PG8_BAR; PG8_MMA(1, 0, At, B0); PG8_MMA(1, 1, At, B1); PG8_BAR; PG8_SCHED;
            } else {
            PG8_LDB(B0, 0, 0); PG8_SCHED; PG8_LDA(At, 0, 0); PG8_STAGE(PG8_SA(1, 1), a1 + hstep, voffA);
            PG8_WAIT_L(8); PG8_BAR; PG8_WAIT_L(0); PG8_MMA(0, 0, At, B0); PG8_BAR; PG8_SCHED;
            PG8_LDB(B1, 0, 1); PG8_STAGE(PG8_SB(0, 0), b2, voffB);
            PG8_BAR; PG8_WAIT_L(0); PG8_MMA(0, 1, At, B1); PG8_BAR;
            PG8_LDA(At, 0, 1); PG8_STAGE(PG8_SA(0, 0), a2, voffA);
            PG8_BAR; PG8_WAIT_L(0); PG8_MMA(1, 0, At, B0); PG8_BAR; PG8_SCHED;
            PG8_STAGE(PG8_SB(0, 1), b2 + hstep, voffB);
            PG8_WAIT_V(6); PG8_BAR; PG8_MMA(1, 1, At, B1); PG8_BAR;
            PG8_LDB(B0, 1, 0); PG8_SCHED; PG8_LDA(At, 1, 0); PG8_STAGE(PG8_SA(0, 1), a2 + hstep, voffA);
            PG8_WAIT_L(8); PG8_BAR; PG8_WAIT_L(0); PG8_MMA(0, 0, At, B0); PG8_BAR; PG8_SCHED;
            PG8_LDB(B1, 1, 1); PG8_STAGE(PG8_SB(1, 0), b3, voffB);
            PG8_BAR; PG8_WAIT_L(0); PG8_MMA(0, 1, At, B1); PG8_BAR;
            PG8_LDA(At, 1, 1); PG8_STAGE(PG8_SA(1, 0), a3, voffA);
            PG8_BAR; PG8_WAIT_L(0); PG8_MMA(1, 0, At, B0); PG8_BAR; PG8_SCHED;
            PG8_STAGE(PG8_SB(1, 1), b3 + hstep, voffB);
            PG8_WAIT_V(6); PG8_BAR; PG8_MMA(1, 1, At, B1); PG8_BAR;
            }
        }
        if constexpr (ALIGN_EPI) { if (wr == 0) PG8_BAR; }
        if constexpr (!Epi::AFTER_DRAIN) { E(acc, cur, wr, wc, fr, fq); S.done(cur); }
        if (!has_next) break;
#pragma unroll
        for (int a = 0; a < 2; ++a)
#pragma unroll
            for (int b = 0; b < 2; ++b)
#pragma unroll
                for (int m = 0; m < 4; ++m)
#pragma unroll
                    for (int n = 0; n < 2; ++n) acc[a][b][m][n] = (f32x4){0.f, 0.f, 0.f, 0.f};
        cur = nxt; cA = nA; cB = nB; ++ui;
        if constexpr (ALIGN_EPI) { if (wr == 1) PG8_BAR; }
    }
    PG8_WAIT_V(0);
    if constexpr (!ALIGN_EPI) { if (wr == 0) PG8_BAR; }
    PG8_BAR;
    if constexpr (Epi::AFTER_DRAIN) { E.fused(acc, cur, wr, wc, fr, fq, lds, wid, lane); S.done(cur); }
#undef PG8_SA
#undef PG8_SB
#undef PG8_STAGE
#undef PG8_LDA
#undef PG8_LDB
#undef PG8_MMA
#undef PG8_WAIT_V
#undef PG8_WAIT_L
#undef PG8_BAR
#undef PG8_SCHED
}
}
#define GAS __attribute__((address_space(1)))
#define LAS __attribute__((address_space(3)))
typedef unsigned short bf16;
typedef unsigned v4u __attribute__((ext_vector_type(4)));
typedef unsigned v2u __attribute__((ext_vector_type(2)));
typedef float f32x4 __attribute__((ext_vector_type(4)));
constexpr int NWAVES = 8;
constexpr int LDS_BYTES = 147456, LDSCTL_OFF = 131072;
constexpr int CW_BAR = 4096;
constexpr size_t MiB = 1u << 20;
constexpr size_t WS_CTL = 0, CTL_BYTES = 1 * MiB;
constexpr size_t WS_SSQ_A = 256 * 1024, WS_SSQ_B = 320 * 1024, WS_SSQ_C = 384 * 1024, WS_SSQ_D = 448 * 1024;
constexpr size_t WS_STAMP = 128 * 1024;
constexpr size_t WS_BCTR = 192 * 1024;
constexpr size_t WS_SU = 512 * 1024, WS_SV = 768 * 1024;
constexpr size_t WS_WCS = 1 * MiB, WS_ROPE = 2 * MiB, WS_KEYS = 3 * MiB;
constexpr size_t WS_WOF = 8 * MiB, WS_WQKV = 16 * MiB, WS_WOA = 28 * MiB, WS_WQ0 = 36 * MiB, WS_WQ1 = 44 * MiB;
constexpr size_t WS_A2 = 64 * MiB, WS_TW = 65 * MiB;
constexpr size_t WS_U0 = 128 * MiB, WS_V0 = 192 * MiB, WS_U1 = 256 * MiB, WS_V1 = 320 * MiB;
constexpr size_t WS_XG = 384 * MiB, WS_XB = 384 * MiB;
constexpr size_t WS_ZT = 448 * MiB;
constexpr size_t WS_Y = 576 * MiB;
constexpr size_t WS_Q = 448 * MiB;
constexpr size_t WS_EI = 640 * MiB, WS_GW = 648 * MiB, WS_W1 = 656 * MiB;
constexpr size_t WS_PD = 448 * MiB;
constexpr size_t WS_QB = 448 * MiB, WS_KB = 512 * MiB, WS_VT = 528 * MiB, WS_O = 576 * MiB;

__device__ __forceinline__ unsigned f2bf(float f) { unsigned u = __builtin_bit_cast(unsigned, f); return (u + 0x7fffu + ((u >> 16) & 1u)) >> 16; }
__device__ __forceinline__ unsigned pk2(float lo, float hi) { return f2bf(lo) | (f2bf(hi) << 16); }

struct Args { const float* in[12]; float* out; unsigned char* ws; int ph_lo, ph_hi; };

__device__ __forceinline__ int qkv_row(int n) { if (n >= 2560) return n; const int d = n & 63, pc = (d < 32) ? 2 * d : 2 * (d - 32) + 1; return (n & ~63) + pc; }
template <int MODE>
__device__ __forceinline__ void transpose_item(const float* W, int K, int N, const float* gain, bf16* WT, LAS float* scr, int item, int lane) {
    const int nblk = N / 32, kb = item / nblk, nb = item % nblk, k0 = 64 * kb, n0 = 32 * nb;
    float wv[32];
#pragma unroll
    for (int i = 0; i < 32; ++i) wv[i] = W[(size_t)(k0 + 2 * i + (lane >> 5)) * N + n0 + (lane & 31)];
#pragma unroll
    for (int i = 0; i < 32; ++i) { const int kk = 2 * i + (lane >> 5); float v = wv[i]; if (gain) v *= gain[k0 + kk]; scr[kk * 33 + (lane & 31)] = v; }
    asm volatile("s_waitcnt lgkmcnt(0)" ::: "memory");
    const int c = lane & 7;
#pragma unroll
    for (int j = 0; j < 4; ++j) { const int n = (lane >> 3) + 8 * j; const LAS float* s = scr + (8 * c) * 33 + n;
        v4u o; o.x = pk2(s[0 * 33], s[1 * 33]); o.y = pk2(s[2 * 33], s[3 * 33]); o.z = pk2(s[4 * 33], s[5 * 33]); o.w = pk2(s[6 * 33], s[7 * 33]);
        const int row = (MODE == 1) ? qkv_row(n0 + n) : (n0 + n);
        *(v4u*)(WT + (size_t)row * K + k0 + 8 * c) = o; }
    asm volatile("s_waitcnt lgkmcnt(0)" ::: "memory");
}
__device__ __forceinline__ float wsum(float v) {
#pragma unroll
    for (int o = 1; o < 64; o <<= 1) v += __shfl_xor(v, o);
    return v;
}
__device__ __forceinline__ void cvt_stream(const float* src, bf16* dst, size_t n8, size_t gtid, size_t ngt) {
    for (size_t i = gtid; i < n8; i += ngt) {
        const f32x4 a = *(const f32x4*)(src + i * 8), b = *(const f32x4*)(src + i * 8 + 4);
        v4u o; o.x = pk2(a[0], a[1]); o.y = pk2(a[2], a[3]); o.z = pk2(b[0], b[1]); o.w = pk2(b[2], b[3]);
        *(v4u*)(dst + i * 8) = o;
    }
}
__device__ __forceinline__ void cvt_stream8(const float* src, unsigned char* dst, size_t n16, size_t gtid, size_t ngt, float scale) {
    for (size_t i = gtid; i < n16; i += ngt) {
        v4u o;
#pragma unroll
        for (int q = 0; q < 4; ++q) { f32x4 a = *(const f32x4*)(src + i * 16 + 4 * q) * scale;
#pragma unroll
            for (int e = 0; e < 4; ++e) a[e] = fminf(fmaxf(a[e], -448.f), 448.f);
            int w = 0; w = __builtin_amdgcn_cvt_pk_fp8_f32(a[0], a[1], w, false); w = __builtin_amdgcn_cvt_pk_fp8_f32(a[2], a[3], w, true); o[q] = (unsigned)w; }
        const size_t e = i >> 7, r = i & 127, sl = r >> 3, c8 = r & 7;
        *(v4u*)(dst + ((sl * 16384 + e) * 128 + c8 * 16)) = o;
    }
}
#define XB_TMO      128
#define XB_XCNT(j)  (256  + 64 * (j))
#define XB_XSUB(j)  (1280 + 64 * (j))
#define XB_XGEN(j)  (2304 + 64 * (j))
#define XB_TOP      3328
#define XB_TOPGEN   3392
#define XCD_BAR_WORDS 3456
#define XB_SPIN_CAP (1u << 18)

__device__ __forceinline__ unsigned xb_ld(unsigned* p)              { return __hip_atomic_load(p, __ATOMIC_RELAXED, __HIP_MEMORY_SCOPE_AGENT); }
__device__ __forceinline__ unsigned xb_add(unsigned* p, unsigned v) { return __hip_atomic_fetch_add(p, v, __ATOMIC_RELAXED, __HIP_MEMORY_SCOPE_AGENT); }
__device__ __forceinline__ unsigned xb_xcc_id() { return (unsigned)__builtin_amdgcn_s_getreg((3 << 11) | 20) & 0xFu; }
#define XB_SPIN(cond, bar) do { unsigned _sp = 0; while (cond) { __builtin_amdgcn_s_sleep(1); \
    if ((++_sp & 255u) == 0u) { if (xb_ld(&(bar)[XB_TMO])) break; if (_sp > XB_SPIN_CAP) { atomicAdd(&(bar)[XB_TMO], 1u); break; } } } } while (0)

struct XcdBarrier {
    unsigned* bar; unsigned x;
    volatile LAS unsigned* st;
};

__device__ __forceinline__ XcdBarrier xcd_barrier_post(unsigned* bar, volatile LAS unsigned* st) {
    XcdBarrier b; b.bar = bar; b.x = xb_xcc_id(); b.st = st;
    if (threadIdx.x == 0) (void)xb_add(&bar[XB_XCNT(b.x)], 1u);
    return b;
}
__device__ __forceinline__ void xcd_barrier_complete(unsigned* bar, unsigned x, unsigned& nloc, unsigned& nx) {
    const unsigned G = gridDim.x * gridDim.y * gridDim.z;
    unsigned sum, cnt, mine, sp = 0u;
    for (;;) {
        sum = 0u; cnt = 0u; mine = 0u;
#pragma unroll
        for (unsigned j = 0; j < 16; ++j) { const unsigned c = xb_ld(&bar[XB_XCNT(j)]); sum += c; cnt += (c > 0u) ? 1u : 0u; mine = (j == x) ? c : mine; }
        if (sum == G) break;
        __builtin_amdgcn_s_sleep(1);
        if ((++sp & 255u) == 0u) { if (xb_ld(&bar[XB_TMO])) break; if (sp > XB_SPIN_CAP) { atomicAdd(&bar[XB_TMO], 1u); break; } }
    }
    nloc = mine > 0u ? mine : 1u; nx = cnt > 0u ? cnt : 1u;
}

__device__ __forceinline__ void xcd_barrier(const XcdBarrier& b) {
    asm volatile("s_waitcnt vmcnt(0)" ::: "memory");
    __syncthreads();
    if (threadIdx.x == 0) {
        unsigned* bar = b.bar;
        __builtin_amdgcn_s_waitcnt(0);
        unsigned nloc = b.st[0], nx = b.st[1];
        if (nloc == 0u) { xcd_barrier_complete(bar, b.x, nloc, nx); b.st[0] = nloc; b.st[1] = nx; }
        const unsigned old = xb_add(&bar[XB_XSUB(b.x)], 1u);
        const unsigned gen = old / nloc;
        if (old + 1u == (gen + 1u) * nloc) {
            __builtin_amdgcn_fence(__ATOMIC_RELEASE, "agent");
            asm volatile("s_waitcnt vmcnt(0)" ::: "memory");
            const unsigned og = xb_add(&bar[XB_TOP], 1u);
            const unsigned tg = og / nx;
            if (og + 1u == (tg + 1u) * nx) xb_add(&bar[XB_TOPGEN], 1u);
            else XB_SPIN(xb_ld(&bar[XB_TOPGEN]) == tg, bar);
            __builtin_amdgcn_fence(__ATOMIC_ACQUIRE, "agent");
            xb_add(&bar[XB_XGEN(b.x)], 1u);
            asm volatile("s_waitcnt vmcnt(0)" ::: "memory");
        } else {
            XB_SPIN(xb_ld(&bar[XB_XGEN(b.x)]) == gen, bar);
            __builtin_amdgcn_fence(__ATOMIC_ACQUIRE, "agent");
            asm volatile("s_waitcnt vmcnt(0)" ::: "memory");
        }
    }
    __syncthreads();
}
#define U_SCALE 1024.f
#define V_SCALE 256.f
typedef float f32x16 __attribute__((ext_vector_type(16)));
#ifndef TKB
#define TKB 2
#endif
typedef short s16x8 __attribute__((ext_vector_type(8)));
typedef __bf16 bf16x2_t __attribute__((ext_vector_type(2)));
__device__ __forceinline__ unsigned ordf(float f) { const unsigned u = __float_as_uint(f); return (u & 0x80000000u) ? ~u : (u | 0x80000000u); }
__device__ __forceinline__ float unordf(unsigned u) { return __uint_as_float((u & 0x80000000u) ? (u & 0x7fffffffu) : ~u); }
__device__ __forceinline__ unsigned umax_(unsigned a, unsigned b) { return a > b ? a : b; }
#define DPPU(v, ctrl) ((unsigned)__builtin_amdgcn_update_dpp(0, (int)(v), (ctrl), 0xf, 0xf, true))
#define DPPF(v, ctrl) __int_as_float(__builtin_amdgcn_update_dpp(0, __float_as_int(v), (ctrl), 0xf, 0xf, true))
__device__ __forceinline__ unsigned max32(unsigned v) {
    v = umax_(v, DPPU(v, 0xB1)); v = umax_(v, DPPU(v, 0x4E)); v = umax_(v, DPPU(v, 0x141)); v = umax_(v, DPPU(v, 0x140));
    const auto r = __builtin_amdgcn_permlane16_swap(v, v, false, false);
    return umax_(r[0], r[1]);
}
__device__ __forceinline__ float sum16(float v) {
    v += DPPF(v, 0xB1); v += DPPF(v, 0x4E); v += DPPF(v, 0x141); v += DPPF(v, 0x140); return v;
}
__device__ __forceinline__ unsigned bperm(unsigned v, int srclane) { return (unsigned)__builtin_amdgcn_ds_bpermute(srclane << 2, (int)v); }
#define CMPX(a_, b_) do { const unsigned hi_ = umax_(a_, b_), lo_ = (a_ < b_) ? a_ : b_; a_ = hi_; b_ = lo_; } while (0)
__device__ __forceinline__ unsigned max16(unsigned v) { v = umax_(v, DPPU(v, 0xB1)); v = umax_(v, DPPU(v, 0x4E)); v = umax_(v, DPPU(v, 0x141)); v = umax_(v, DPPU(v, 0x140)); return v; }
__device__ __forceinline__ unsigned top16_of8(unsigned (&p)[8], int c) {
    CMPX(p[0], p[1]); CMPX(p[2], p[3]); CMPX(p[4], p[5]); CMPX(p[6], p[7]);
    CMPX(p[0], p[2]); CMPX(p[1], p[3]); CMPX(p[4], p[6]); CMPX(p[5], p[7]);
    CMPX(p[1], p[2]); CMPX(p[5], p[6]); CMPX(p[0], p[4]); CMPX(p[3], p[7]);
    CMPX(p[1], p[5]); CMPX(p[2], p[6]);
    CMPX(p[1], p[4]); CMPX(p[3], p[6]);
    CMPX(p[2], p[4]); CMPX(p[3], p[5]);
    CMPX(p[3], p[4]);
    unsigned W = 0u;
    for (int it = 0; it < 16; ++it) {
        const unsigned m = max16(p[0]);
        W = (c == it) ? m : W;
        const bool win = (p[0] == m);
#pragma unroll
        for (int i = 0; i < 7; ++i) p[i] = win ? p[i + 1] : p[i];
        p[7] = win ? 0u : p[7];
    }
    return W;
}
#define SORT8(p) do { CMPX(p[0], p[1]); CMPX(p[2], p[3]); CMPX(p[4], p[5]); CMPX(p[6], p[7]); CMPX(p[0], p[2]); CMPX(p[1], p[3]); CMPX(p[4], p[6]); CMPX(p[5], p[7]); \
    CMPX(p[1], p[2]); CMPX(p[5], p[6]); CMPX(p[0], p[4]); CMPX(p[3], p[7]); CMPX(p[1], p[5]); CMPX(p[2], p[6]); CMPX(p[1], p[4]); CMPX(p[3], p[6]); CMPX(p[2], p[4]); CMPX(p[3], p[5]); CMPX(p[3], p[4]); } while (0)
__device__ __forceinline__ void top16_of8x2(unsigned (&p)[8], unsigned (&q)[8], int c, unsigned& Wp, unsigned& Wq) {
    SORT8(p); SORT8(q);
    unsigned W0 = 0u, W1 = 0u;
    for (int it = 0; it < 16; ++it) {
        unsigned m0 = umax_(p[0], DPPU(p[0], 0xB1)), m1 = umax_(q[0], DPPU(q[0], 0xB1));
        m0 = umax_(m0, DPPU(m0, 0x4E)); m1 = umax_(m1, DPPU(m1, 0x4E));
        m0 = umax_(m0, DPPU(m0, 0x141)); m1 = umax_(m1, DPPU(m1, 0x141));
        m0 = umax_(m0, DPPU(m0, 0x140)); m1 = umax_(m1, DPPU(m1, 0x140));
        W0 = (c == it) ? m0 : W0; W1 = (c == it) ? m1 : W1;
        const bool w0 = (p[0] == m0), w1 = (q[0] == m1);
#pragma unroll
        for (int i = 0; i < 7; ++i) { p[i] = w0 ? p[i + 1] : p[i]; q[i] = w1 ? q[i + 1] : q[i]; }
        p[7] = w0 ? 0u : p[7]; q[7] = w1 ? 0u : q[7];
    }
    Wp = W0; Wq = W1;
}
__device__ __forceinline__ void top16_of4rx2(unsigned (&p)[4], unsigned (&q)[4], int c, unsigned& Wp, unsigned& Wq) {
    CMPX(p[0], p[1]); CMPX(p[2], p[3]); CMPX(p[0], p[2]); CMPX(p[1], p[3]); CMPX(p[1], p[2]);
    CMPX(q[0], q[1]); CMPX(q[2], q[3]); CMPX(q[0], q[2]); CMPX(q[1], q[3]); CMPX(q[1], q[2]);
    unsigned W0 = 0u, W1 = 0u;
    for (int it = 0; it < 16; ++it) {
        unsigned m0 = umax_(p[0], DPPU(p[0], 0xB1)), m1 = umax_(q[0], DPPU(q[0], 0xB1));
        m0 = umax_(m0, DPPU(m0, 0x4E)); m1 = umax_(m1, DPPU(m1, 0x4E));
        m0 = umax_(m0, DPPU(m0, 0x141)); m1 = umax_(m1, DPPU(m1, 0x141));
        m0 = umax_(m0, DPPU(m0, 0x140)); m1 = umax_(m1, DPPU(m1, 0x140));
        W0 = (c == it) ? m0 : W0; W1 = (c == it) ? m1 : W1;
        const bool w0 = (p[0] == m0), w1 = (q[0] == m1);
        p[0] = w0 ? p[1] : p[0]; p[1] = w0 ? p[2] : p[1]; p[2] = w0 ? p[3] : p[2]; p[3] = w0 ? 0u : p[3];
        q[0] = w1 ? q[1] : q[0]; q[1] = w1 ? q[2] : q[1]; q[2] = w1 ? q[3] : q[2]; q[3] = w1 ? 0u : q[3];
    }
    Wp = W0; Wq = W1;
}
__device__ __forceinline__ unsigned top16_of4r(unsigned (&p)[4], int c) {
    CMPX(p[0], p[1]); CMPX(p[2], p[3]); CMPX(p[0], p[2]); CMPX(p[1], p[3]); CMPX(p[1], p[2]);
    unsigned W = 0u;
    for (int it = 0; it < 16; ++it) {
        const unsigned m = max16(p[0]);
        W = (c == it) ? m : W;
        const bool win = (p[0] == m);
        p[0] = win ? p[1] : p[0]; p[1] = win ? p[2] : p[1]; p[2] = win ? p[3] : p[2]; p[3] = win ? 0u : p[3];
    }
    return W;
}
__device__ __forceinline__ void topk_fill(LAS unsigned char* lds, const bf16* keys, int h, int tid) {
#pragma unroll
    for (int i = 0; i < 8; ++i) { const int idx = tid + 512 * i, p = idx >> 11, key = (idx >> 4) & 127, ch = idx & 15;
        const v4u v = *(const v4u*)(keys + (size_t)((h * 2 + p) * 128 + key) * 128 + ch * 8);
        *(LAS v4u*)(lds + p * 32768 + key * 256 + ((ch ^ (key & 15)) << 4)) = v; }
}
struct CvtCtx { const float* srcU; long dsrc; const float* gain; unsigned char* dstU; long ddst; float* su; long dsc; int gwave, nw; };
__device__ __forceinline__ void cvt_chunk_load(const CvtCtx& cx, int c, int lane, f32x4 (&v)[4]) {
    const int r = c >> 1, hh = c & 1;
    const float* src = cx.srcU + ((r < 16384) ? 0L : cx.dsrc) + (size_t)(r & 16383) * 2048 + hh * 1024 + 4 * lane;
#pragma unroll
    for (int j = 0; j < 4; ++j) v[j] = *(const f32x4*)(src + 256 * j);
}
__device__ __forceinline__ void cvt_chunk_store(const CvtCtx& cx, int c, int lane, f32x4 (&v)[4]) {
    const int r = c >> 1, hh = c & 1; const bool isu = r < 16384; const int e = r & 16383;
    float mx = 0.f;
#pragma unroll
    for (int j = 0; j < 4; ++j) { if (isu) v[j] = v[j] * *(const f32x4*)(cx.gain + hh * 1024 + 256 * j + 4 * lane);
        mx = fmaxf(mx, fmaxf(fmaxf(fabsf(v[j][0]), fabsf(v[j][1])), fmaxf(fabsf(v[j][2]), fabsf(v[j][3])))); }
    mx = fmaxf(mx, DPPF(mx, 0xB1)); mx = fmaxf(mx, DPPF(mx, 0x4E)); mx = fmaxf(mx, DPPF(mx, 0x141)); mx = fmaxf(mx, DPPF(mx, 0x140));
    { const auto rr = __builtin_amdgcn_permlane16_swap(__float_as_uint(mx), __float_as_uint(mx), false, false); mx = fmaxf(__uint_as_float(rr[0]), __uint_as_float(rr[1])); }
    { const auto rr = __builtin_amdgcn_permlane32_swap(__float_as_uint(mx), __float_as_uint(mx), false, false); mx = fmaxf(__uint_as_float(rr[0]), __uint_as_float(rr[1])); }
    const float sc = fmaxf(mx, 1e-30f) * (1.f / 6.f), inv = 1.f / sc;
    if (lane == 0) (cx.su + (isu ? 0L : cx.dsc))[e * 2 + hh] = sc;
    unsigned char* dst = cx.dstU + (isu ? 0L : cx.ddst) + ((size_t)(hh * 4) * 16384 + e) * 128 + 2 * lane;
#pragma unroll
    for (int j = 0; j < 4; ++j) { unsigned w = 0u;
        w = __builtin_amdgcn_cvt_scalef32_pk_fp4_f32(w, v[j][0] * inv, v[j][1] * inv, 1.0f, 0); w = __builtin_amdgcn_cvt_scalef32_pk_fp4_f32(w, v[j][2] * inv, v[j][3] * inv, 1.0f, 1);
        *(unsigned short*)(dst + (size_t)j * (16384 * 128)) = (unsigned short)w; }
}
__device__ __forceinline__ void topk_unit(const bf16* q, LAS const unsigned char* lds, int* EI, float* GW, int t0, int h, int lane) {
    const int c = lane & 15, g4 = lane >> 4, rbase = lane & 48;
    int f0 = 0, f1 = 0, f2 = 0, f3 = 0;
    { int cnt = 0;
#pragma unroll
      for (int i = 0; i < 16; ++i)
#pragma unroll
        for (int j = 0; j < 16; ++j) if ((i + 1) * (j + 1) <= 16) { const int fl = i * 16 + j; f0 = (cnt == c) ? fl : f0; f1 = (cnt == c + 16) ? fl : f1; f2 = (cnt == c + 32) ? fl : f2; f3 = (cnt == c + 48) ? fl : f3; ++cnt; } }
    unsigned W[2][8];
#pragma unroll
    for (int p = 0; p < 2; ++p) {
        f32x4 acc[2][8];
#pragma unroll
        for (int mb = 0; mb < 2; ++mb)
#pragma unroll
            for (int kb = 0; kb < 8; ++kb) acc[mb][kb] = (f32x4){0.f, 0.f, 0.f, 0.f};
        const bf16* qp = q + (size_t)(t0 + c) * 2048 + h * 256 + p * 128 + g4 * 8;
        LAS const unsigned char* kp = lds + p * 32768 + c * 256;
        asm volatile("" : "+v"(qp));
#pragma unroll 2
        for (int ks = 0; ks < 4; ++ks) {
            const s16x8 a0 = *(const s16x8*)(qp + ks * 32), a1 = *(const s16x8*)(qp + (size_t)16 * 2048 + ks * 32);
#pragma unroll
            for (int kb = 0; kb < 8; ++kb) { const s16x8 b = *(LAS const s16x8*)(kp + kb * 4096 + (((4 * ks + g4) ^ c) << 4));
                acc[0][kb] = __builtin_amdgcn_mfma_f32_16x16x32_bf16(a0, b, acc[0][kb], 0, 0, 0); acc[1][kb] = __builtin_amdgcn_mfma_f32_16x16x32_bf16(a1, b, acc[1][kb], 0, 0, 0); }
        }
#pragma unroll
        for (int pb = 0; pb < 8; pb += 2) {
            unsigned pk[8], pq[8];
#pragma unroll
            for (int kb = 0; kb < 8; ++kb) { pk[kb] = (ordf(acc[pb >> 2][kb][pb & 3]) & ~127u) | (unsigned)(127 - 16 * kb - c); pq[kb] = (ordf(acc[(pb + 1) >> 2][kb][(pb + 1) & 3]) & ~127u) | (unsigned)(127 - 16 * kb - c); }
            top16_of8x2(pk, pq, c, W[p][pb], W[p][pb + 1]);
        }
    }
#define TK_CAND(CP, w0_, w1_) do { \
        { const float a0 = unordf(bperm(w0_, rbase + (f0 >> 4)) & ~127u), b0 = unordf(bperm(w1_, rbase + (f0 & 15)) & ~127u); CP[0] = (ordf(a0 + b0) & ~63u) | (unsigned)(63 - c); } \
        { const float a0 = unordf(bperm(w0_, rbase + (f1 >> 4)) & ~127u), b0 = unordf(bperm(w1_, rbase + (f1 & 15)) & ~127u); CP[1] = (ordf(a0 + b0) & ~63u) | (unsigned)(47 - c); } \
        { const float a0 = unordf(bperm(w0_, rbase + (f2 >> 4)) & ~127u), b0 = unordf(bperm(w1_, rbase + (f2 & 15)) & ~127u); CP[2] = (ordf(a0 + b0) & ~63u) | (unsigned)(31 - c); } \
        { const float a0 = unordf(bperm(w0_, rbase + (f3 >> 4)) & ~127u), b0 = unordf(bperm(w1_, rbase + (f3 & 15)) & ~127u); CP[3] = (c + 48 < 50) ? ((ordf(a0 + b0) & ~63u) | (unsigned)(15 - c)) : 0u; } } while (0)
#define TK_FINISH(Wc_, w0_, w1_, pb_) do { \
        const int slot = 63 - (int)((Wc_) & 63u); \
        const unsigned fa = bperm((unsigned)f0, rbase + (slot & 15)), fb = bperm((unsigned)f1, rbase + (slot & 15)), fc = bperm((unsigned)f2, rbase + (slot & 15)), fd = bperm((unsigned)f3, rbase + (slot & 15)); \
        const int sq = slot >> 4; const int flat = (int)((sq == 0) ? fa : (sq == 1) ? fb : (sq == 2) ? fc : fd); \
        const float val = unordf((Wc_) & ~63u); \
        const float vmax = __uint_as_float(bperm(__float_as_uint(val), rbase)); \
        const float e = __expf(val - vmax); \
        const float g = e / sum16(e); \
        const int k1 = 127 - (int)(bperm(w0_, rbase + (flat >> 4)) & 127u), k2 = 127 - (int)(bperm(w1_, rbase + (flat & 15)) & 127u); \
        const int tok = t0 + 16 * ((pb_) >> 2) + 4 * g4 + ((pb_) & 3); \
        EI[(size_t)(tok * 8 + h) * 16 + c] = k1 * 128 + k2; GW[(size_t)(tok * 8 + h) * 16 + c] = g; } while (0)
#pragma unroll
    for (int pb = 0; pb < 8; pb += 2) {
        const unsigned w0a = W[0][pb], w1a = W[1][pb], w0b = W[0][pb + 1], w1b = W[1][pb + 1];
        unsigned cpa[4], cpb[4], Wca, Wcb;
        TK_CAND(cpa, w0a, w1a); TK_CAND(cpb, w0b, w1b);
        top16_of4rx2(cpa, cpb, c, Wca, Wcb);
        TK_FINISH(Wca, w0a, w1a, pb); TK_FINISH(Wcb, w0b, w1b, pb + 1);
    }
#undef TK_CAND
#undef TK_FINISH
}

__device__ __forceinline__ float gelu_tanh_f(float x) {
    const float u = 0.7978845608028654f * (x + 0.044715f * x * x * x);
    const float e = __expf(2.f * u);
    const float th = 1.f - 2.f / (e + 1.f);
    return 0.5f * x * (1.f + th);
}
__device__ __forceinline__ float wave_sum_bfly(float v) {
#pragma unroll
    for (int o = 1; o < 64; o <<= 1) v += __shfl_xor(v, o);
    return v;
}
typedef float f32x2_ __attribute__((ext_vector_type(2)));
#define FP4_DEC(w_, sel_) __builtin_amdgcn_cvt_scalef32_pk_f32_fp4((unsigned)(w_), 1.0f, (sel_))
typedef int i32x8 __attribute__((ext_vector_type(8)));
template <int NBT>
__device__ __forceinline__ void peer_a_slice(const bf16* xb, const int* EI, const unsigned char* U4s, float* pd, int s, unsigned* ctr, int nbatch, int lane) {
    const int c = lane & 15, g4 = lane >> 4, k8 = c >> 1;
    const unsigned char* tab = U4s + (size_t)s * (16384 * 128) + (4 * (c & 1) + g4) * 16;
#define A_FETCH() ((int)__builtin_amdgcn_readfirstlane((int)((lane == 0) ? __hip_atomic_fetch_add(ctr, 1u, __ATOMIC_RELAXED, __HIP_MEMORY_SCOPE_AGENT) : 0u)))
#define A_TOKB(b_, j_) ((((b_) < nbatch) ? (b_) : (nbatch - 1)) * NBT + (j_))
#define A_XS(XS, t_) do { const bf16* xp_ = xb + (size_t)(t_) * 2048 + s * 256 + 128 * (c & 1) + 16 * g4; XS[0] = *(const v4u*)xp_; XS[1] = *(const v4u*)(xp_ + 8); XS[2] = *(const v4u*)(xp_ + 64); XS[3] = *(const v4u*)(xp_ + 72); } while (0)
#define A_ISSUE(U, EV) do { _Pragma("unroll") for (int i = 0; i < 8; ++i) { const int e_ = (int)bperm((unsigned)(EV), (i << 3) + k8); U[i] = *(const v4u*)(tab + (size_t)e_ * 128); } } while (0)
#define A_COMPUTE(U, OUT) do { _Pragma("unroll") for (int i = 0; i < 8; ++i) { f32x4 d_ = (f32x4){0.f, 0.f, 0.f, 0.f}; \
            d_ = __builtin_amdgcn_mfma_scale_f32_16x16x128_f8f6f4((i32x8){(int)U[i][0], (int)U[i][1], (int)U[i][2], (int)U[i][3], 0, 0, 0, 0}, hb, d_, 4, 0, 0, 0x7f7f7f7f, 0, 0x7f7f7f7f); \
            const float o0_ = d_[0] + DPPF(d_[1], 0xB1), o1_ = d_[2] + DPPF(d_[3], 0xB1);        \
            if (k8 == i) OUT = (f32x2_){o0_, o1_}; } } while (0)
    int eL[NBT], eH[NBT], nL[NBT], nH[NBT]; v4u xs[2][4]; v4u UA[8], UB[8];
    int b0 = A_FETCH(), b1 = A_FETCH();
    if (b0 >= nbatch) return;
#pragma unroll
    for (int j = 0; j < NBT; ++j) { const int tj = A_TOKB(b0, j); eL[j] = EI[(size_t)tj * 128 + lane]; eH[j] = EI[(size_t)tj * 128 + 64 + lane]; }
    A_XS(xs[0], A_TOKB(b0, 0));
    A_ISSUE(UA, eL[0]);
    while (b0 < nbatch) {
        const int b2 = A_FETCH();
#pragma unroll
        for (int j = 0; j < NBT; ++j) { const int tj = A_TOKB(b1, j); nL[j] = EI[(size_t)tj * 128 + lane]; nH[j] = EI[(size_t)tj * 128 + 64 + lane]; }
#pragma unroll
        for (int j = 0; j < NBT; ++j) {
            const int t = b0 * NBT + j;
            A_ISSUE(UB, eH[j]);
            i32x8 hb;
#pragma unroll
            for (int q = 0; q < 4; ++q) { const v4u w = xs[j & 1][q]; int lo = 0, hi = 0;
                lo = __builtin_amdgcn_cvt_pk_fp8_f32(__uint_as_float(w[0] << 16), __uint_as_float(w[0] & 0xffff0000u), lo, false); lo = __builtin_amdgcn_cvt_pk_fp8_f32(__uint_as_float(w[1] << 16), __uint_as_float(w[1] & 0xffff0000u), lo, true);
                hi = __builtin_amdgcn_cvt_pk_fp8_f32(__uint_as_float(w[2] << 16), __uint_as_float(w[2] & 0xffff0000u), hi, false); hi = __builtin_amdgcn_cvt_pk_fp8_f32(__uint_as_float(w[3] << 16), __uint_as_float(w[3] & 0xffff0000u), hi, true);
                hb[2 * q] = lo; hb[2 * q + 1] = hi; }
            f32x2_ out_lo = (f32x2_){0.f, 0.f}, out_hi = (f32x2_){0.f, 0.f};
            A_COMPUTE(UA, out_lo);
            A_XS(xs[(j + 1) & 1], (j + 1 < NBT) ? (b0 * NBT + j + 1) : A_TOKB(b1, 0));
            A_ISSUE(UA, (j + 1 < NBT) ? eL[(j + 1) % NBT] : nL[0]);
            A_COMPUTE(UB, out_hi);
            if ((c & 1) == 0) { float* pp = pd + ((size_t)s * T + t) * 128 + 8 * k8 + 2 * g4; *(f32x2_*)pp = out_lo; *(f32x2_*)(pp + 64) = out_hi; }
        }
#pragma unroll
        for (int j = 0; j < NBT; ++j) { eL[j] = nL[j]; eH[j] = nH[j]; }
        b0 = b1; b1 = b2;
    }
#undef A_FETCH
#undef A_TOKB
#undef A_XS
#undef A_ISSUE
#undef A_COMPUTE
}
__device__ __forceinline__ unsigned w8rep(float w) { const float s = fminf(fmaxf(w * 256.f, -448.f), 448.f); return ((unsigned)__builtin_amdgcn_cvt_pk_fp8_f32(s, 0.f, 0, false) & 0xffu) * 0x01010101u; }
__device__ __forceinline__ void peer_a2_token(const float* pd, const float* ssq, const int* EI, const float* su, const float* sv, float* GW, float* W1, int t, int lane) {
    float a0 = 0.f, a1 = 0.f, b0 = 0.f, b1 = 0.f;
#pragma unroll
    for (int s = 0; s < 4; ++s) { const float* pp = pd + ((size_t)s * T + t) * 128; a0 += pp[lane]; a1 += pp[64 + lane]; }
#pragma unroll
    for (int s = 4; s < 8; ++s) { const float* pp = pd + ((size_t)s * T + t) * 128; b0 += pp[lane]; b1 += pp[64 + lane]; }
    const float rs = rsqrtf(ssq[t] * (1.f / 2048.f) + EPS);
    float* gp = GW + (size_t)t * 128; float* hp = W1 + (size_t)t * 128; const int pl = lane;
    const int e0 = EI[(size_t)t * 128 + pl], e1 = EI[(size_t)t * 128 + 64 + pl];
    const float g0 = gp[pl] * gelu_tanh_f(rs * (a0 * su[2 * e0] + b0 * su[2 * e0 + 1])), g1 = gp[64 + pl] * gelu_tanh_f(rs * (a1 * su[2 * e1] + b1 * su[2 * e1 + 1]));
    unsigned* gu = (unsigned*)gp; unsigned* hu = (unsigned*)hp;
    gu[pl] = w8rep(g0 * sv[2 * e0]); hu[pl] = w8rep(g0 * sv[2 * e0 + 1]);
    gu[64 + pl] = w8rep(g1 * sv[2 * e1]); hu[64 + pl] = w8rep(g1 * sv[2 * e1 + 1]);
}
template <int NBT>
__device__ __forceinline__ void peer_b_slice(const bf16* xres, float* xio, const int* EI, const unsigned* W, const unsigned char* V4s, bf16* xb, float* ssq_out, int s, unsigned* ctr, int nbatch, int lane) {
    const int j16 = lane & 15, g4 = lane >> 4;
    const unsigned char* tab = V4s + (size_t)s * (16384 * 128) + 8 * j16;
    const int doff = s * 256 + 64 * g4 + j16;
    const unsigned bm = 0xffu << (8 * (j16 & 3)); const unsigned M0 = ((j16 >> 2) == 0) ? bm : 0u, M1 = ((j16 >> 2) == 1) ? bm : 0u, M2 = ((j16 >> 2) == 2) ? bm : 0u, M3 = ((j16 >> 2) == 3) ? bm : 0u;
#define B_FETCH() ((int)__builtin_amdgcn_readfirstlane((int)((lane == 0) ? __hip_atomic_fetch_add(ctr, 1u, __ATOMIC_RELAXED, __HIP_MEMORY_SCOPE_AGENT) : 0u)))
#define B_TOKB(b_, j_) ((((b_) < nbatch) ? (b_) : (nbatch - 1)) * NBT + (j_))
#define B_ISSUE(V, EV) do { _Pragma("unroll") for (int i = 0; i < 8; ++i) { const int e0_ = (int)bperm((unsigned)(EV), 8 * i + 2 * g4), e1_ = (int)bperm((unsigned)(EV), 8 * i + 2 * g4 + 1); \
        V[2 * i] = *(const v2u*)(tab + (size_t)e0_ * 128); V[2 * i + 1] = *(const v2u*)(tab + (size_t)e1_ * 128); } } while (0)
#define B_COMPUTE(V, WV) do { _Pragma("unroll") for (int i = 0; i < 8; ++i) { \
            const unsigned f0_ = bperm((WV), 8 * i + g4), f1_ = bperm((WV), 8 * i + 4 + g4);        \
            const i32x8 bq_ = (i32x8){(int)(f0_ & M0), (int)(f0_ & M1), (int)(f0_ & M2), (int)(f0_ & M3), (int)(f1_ & M0), (int)(f1_ & M1), (int)(f1_ & M2), (int)(f1_ & M3)}; \
            acc = __builtin_amdgcn_mfma_scale_f32_16x16x128_f8f6f4((i32x8){(int)V[2 * i][0], (int)V[2 * i][1], (int)V[2 * i + 1][0], (int)V[2 * i + 1][1], 0, 0, 0, 0}, bq_, acc, 4, 0, 0, 0x7f7f7f7f, 0, 0x77777777); } } while (0)
    int eL[NBT], eH[NBT], nL[NBT], nH[NBT]; unsigned wL[NBT], wH[NBT], mL[NBT], mH[NBT]; float xv[4]; v2u VA[16], VB[16];
    int b0 = B_FETCH(), b1 = B_FETCH();
    if (b0 >= nbatch) return;
#pragma unroll
    for (int j = 0; j < NBT; ++j) { const int tj = B_TOKB(b0, j); eL[j] = EI[(size_t)tj * 128 + lane]; eH[j] = EI[(size_t)tj * 128 + 64 + lane]; wL[j] = W[(size_t)tj * 128 + lane]; wH[j] = W[(size_t)tj * 128 + 64 + lane]; }
    B_ISSUE(VA, eL[0]);
    while (b0 < nbatch) {
        const int b2 = B_FETCH();
#pragma unroll
        for (int j = 0; j < NBT; ++j) { const int tj = B_TOKB(b1, j); nL[j] = EI[(size_t)tj * 128 + lane]; nH[j] = EI[(size_t)tj * 128 + 64 + lane]; mL[j] = W[(size_t)tj * 128 + lane]; mH[j] = W[(size_t)tj * 128 + 64 + lane]; }
#pragma unroll
        for (int j = 0; j < NBT; ++j) {
            const int t = b0 * NBT + j;
            float* xp = xio + (size_t)t * 2048 + doff; const bf16* rp = xres + (size_t)t * 2048 + doff;
#pragma unroll
            for (int r = 0; r < 4; ++r) xv[r] = __uint_as_float((unsigned)rp[16 * r] << 16);
            B_ISSUE(VB, eH[j]);
            f32x4 acc = (f32x4){0.f, 0.f, 0.f, 0.f};
            B_COMPUTE(VA, wL[j]);
            B_ISSUE(VA, (j + 1 < NBT) ? eL[(j + 1) % NBT] : nL[0]);
            B_COMPUTE(VB, wH[j]);
            float ss = 0.f;
#pragma unroll
            for (int r = 0; r < 4; ++r) { const float o = xv[r] + acc[r]; ss += o * o; if (xb) xb[(size_t)t * 2048 + doff + 16 * r] = (bf16)f2bf(o); else xp[16 * r] = o; }
            ss += DPPF(ss, 0xB1); ss += DPPF(ss, 0x4E); ss += DPPF(ss, 0x141); ss += DPPF(ss, 0x140);
            { const auto r = __builtin_amdgcn_permlane16_swap(__float_as_uint(ss), __float_as_uint(ss), false, false); ss = __uint_as_float(r[0]) + __uint_as_float(r[1]); }
            { const auto r = __builtin_amdgcn_permlane32_swap(__float_as_uint(ss), __float_as_uint(ss), false, false); ss = __uint_as_float(r[0]) + __uint_as_float(r[1]); }
            if (lane == 0) unsafeAtomicAdd(ssq_out + t, ss);
        }
#pragma unroll
        for (int j = 0; j < NBT; ++j) { eL[j] = nL[j]; eH[j] = nH[j]; wL[j] = mL[j]; wH[j] = mH[j]; }
        b0 = b1; b1 = b2;
    }
#undef B_FETCH
#undef B_TOKB
#undef B_ISSUE
#undef B_COMPUTE
}
__device__ __forceinline__ void final_norm_row(float* xio, const float* ssq, const float* fin, int t, int lane, float oscale) {
    const float r2 = rsqrtf(ssq[t] * (1.f / 2048.f) + EPS) * oscale;
    float* xr = xio + (size_t)t * 2048 + 4 * lane;
#pragma unroll
    for (int j = 0; j < 8; ++j) { const f32x4 xv = *(const f32x4*)(xr + 256 * j), g = *(const f32x4*)(fin + 256 * j + 4 * lane); f32x4 o;
        o[0] = xv[0] * r2 * g[0]; o[1] = xv[1] * r2 * g[1]; o[2] = xv[2] * r2 * g[2]; o[3] = xv[3] * r2 * g[3]; *(f32x4*)(xr + 256 * j) = o; }
}
typedef short s16x4 __attribute__((ext_vector_type(4)));
__device__ __forceinline__ unsigned cvt_pk_bf16_(float lo, float hi) { unsigned r; asm volatile("v_cvt_pk_bf16_f32 %0, %1, %2" : "=v"(r) : "v"(lo), "v"(hi)); return r; }
constexpr int ATT_K_OFF = 0, ATT_V_OFF = 40960, ATT_VSTRIDE = 648, ATT_LDS = ATT_V_OFF + 64 * ATT_VSTRIDE;
__device__ __forceinline__ void attn_fill_load(const bf16* K, const bf16* Vt, int b, int kvh, int kw0, int tid, v4u (&kr)[5], v2u (&vr)[10]) {
    const size_t tb = (size_t)b * 4096;
#pragma unroll
    for (int i = 0; i < 5; ++i) { const int idx = tid + 512 * i, row = idx >> 3, ch = idx & 7, key = kw0 + row;
        kr[i] = (v4u){0u, 0u, 0u, 0u}; if (key >= 0 && key < 4096) kr[i] = *(const v4u*)(K + (tb + key) * 512 + kvh * 64 + ch * 8); }
#pragma unroll
    for (int i = 0; i < 10; ++i) { const int idx = tid + 512 * i, d = idx / 80, pc = idx % 80, key = kw0 + pc * 4;
        vr[i] = (v2u){0u, 0u}; if (key >= 0 && key < 4096) vr[i] = *(const v2u*)(Vt + (size_t)(kvh * 64 + d) * 16384 + tb + key); }
}
__device__ __forceinline__ void attn_fill_store(LAS unsigned char* lds, int tid, const v4u (&kr)[5], const v2u (&vr)[10]) {
#pragma unroll
    for (int i = 0; i < 5; ++i) { const int idx = tid + 512 * i, row = idx >> 3, ch = idx & 7; *(LAS v4u*)(lds + ATT_K_OFF + row * 128 + ((ch ^ ((row >> 1) & 7)) << 4)) = kr[i]; }
#pragma unroll
    for (int i = 0; i < 10; ++i) { const int idx = tid + 512 * i, d = idx / 80, pc = idx % 80; *(LAS v2u*)(lds + ATT_V_OFF + d * ATT_VSTRIDE + pc * 8) = vr[i]; }
}
__device__ __forceinline__ void attn_task(LAS const unsigned char* lds, const bf16* Q, bf16* O, const float* sinks, int b, int hq, int q0, int kw0, int lane) {
    const int c = lane & 31, hi = lane >> 5;
    const size_t tb = (size_t)b * 4096;
    s16x8 qf[4];
    { const bf16* qp = Q + (tb + q0 + c) * 2048 + hq * 64 + hi * 8;
#pragma unroll
      for (int ks = 0; ks < 4; ++ks) qf[ks] = *(const s16x8*)(qp + ks * 16); }
    const float sink2 = sinks[hq] * 1.4426950408889634f;
    float m = sink2, l = (hi == 0) ? 1.f : 0.f;
    f32x16 o0, o1;
#pragma unroll
    for (int r = 0; r < 16; ++r) { o0[r] = 0.f; o1[r] = 0.f; }
    const int kt_lo = (q0 < 128) ? ((128 - q0) >> 5) : 0, kt_hi = ((4192 - q0) >> 5) < 8 ? ((4192 - q0) >> 5) : 8;
    for (int kt = kt_lo; kt <= kt_hi; ++kt) {
        const int key0 = q0 - 128 + 32 * kt, row0 = key0 - kw0;
        s16x8 kf[4]; s16x4 va[2][2][2];
        { const int row = row0 + c; LAS const unsigned char* kp = lds + ATT_K_OFF + row * 128; const int sw = (row >> 1) & 7;
#pragma unroll
          for (int ks = 0; ks < 4; ++ks) kf[ks] = *(LAS const s16x8*)(kp + (((2 * ks + hi) ^ sw) << 4)); }
#pragma unroll
        for (int db = 0; db < 2; ++db)
#pragma unroll
            for (int s = 0; s < 2; ++s) { LAS const unsigned char* vp = lds + ATT_V_OFF + (db * 32 + c) * ATT_VSTRIDE + (row0 + 16 * s + 4 * hi) * 2; va[db][s][0] = *(LAS const s16x4*)vp; va[db][s][1] = *(LAS const s16x4*)(vp + 16); }
        f32x16 sa;
#pragma unroll
        for (int r = 0; r < 16; ++r) sa[r] = 0.f;
#pragma unroll
        for (int ks = 0; ks < 4; ++ks) sa = __builtin_amdgcn_mfma_f32_32x32x16_bf16(kf[ks], qf[ks], sa, 0, 0, 0);
        if (kt == 0 || kt == 8) {
            const int dbase = key0 - (q0 + c) + 4 * hi;
#pragma unroll
            for (int r = 0; r < 16; ++r) { const int d = dbase + (r & 3) + 8 * (r >> 2); if (d < -128 || d > 128) sa[r] = -1e30f; }
        }
        float mx = sa[0];
#pragma unroll
        for (int r = 1; r < 16; ++r) mx = fmaxf(mx, sa[r]);
        { const auto rr = __builtin_amdgcn_permlane32_swap(__float_as_uint(mx), __float_as_uint(mx), false, false); mx = fmaxf(__uint_as_float(rr[0]), __uint_as_float(rr[1])); }
        const float mn = fmaxf(m, mx), alpha = __builtin_amdgcn_exp2f(m - mn);
        m = mn;
        float ps = 0.f;
#pragma unroll
        for (int r = 0; r < 16; ++r) { sa[r] = __builtin_amdgcn_exp2f(sa[r] - mn); ps += sa[r]; }
        l = l * alpha + ps;
#pragma unroll
        for (int r = 0; r < 16; ++r) { o0[r] *= alpha; o1[r] *= alpha; }
        s16x8 pf[2];
#pragma unroll
        for (int s = 0; s < 2; ++s) { v4u w; w.x = cvt_pk_bf16_(sa[8 * s + 0], sa[8 * s + 1]); w.y = cvt_pk_bf16_(sa[8 * s + 2], sa[8 * s + 3]); w.z = cvt_pk_bf16_(sa[8 * s + 4], sa[8 * s + 5]); w.w = cvt_pk_bf16_(sa[8 * s + 6], sa[8 * s + 7]);
            pf[s] = __builtin_bit_cast(s16x8, w); }
#pragma unroll
        for (int s = 0; s < 2; ++s) {
            const s16x8 v0 = __builtin_shufflevector(va[0][s][0], va[0][s][1], 0, 1, 2, 3, 4, 5, 6, 7), v1 = __builtin_shufflevector(va[1][s][0], va[1][s][1], 0, 1, 2, 3, 4, 5, 6, 7);
            o0 = __builtin_amdgcn_mfma_f32_32x32x16_bf16(v0, pf[s], o0, 0, 0, 0);
            o1 = __builtin_amdgcn_mfma_f32_32x32x16_bf16(v1, pf[s], o1, 0, 0, 0);
        }
    }
    { const auto rr = __builtin_amdgcn_permlane32_swap(__float_as_uint(l), __float_as_uint(l), false, false); l = __uint_as_float(rr[0]) + __uint_as_float(rr[1]); }
    const float il = 1.f / l;
    bf16* op = O + (tb + q0 + c) * 2048 + hq * 64 + 4 * hi;
#pragma unroll
    for (int g = 0; g < 4; ++g) {
        v2u w0, w1;
        w0.x = cvt_pk_bf16_(o0[4 * g + 0] * il, o0[4 * g + 1] * il); w0.y = cvt_pk_bf16_(o0[4 * g + 2] * il, o0[4 * g + 3] * il);
        w1.x = cvt_pk_bf16_(o1[4 * g + 0] * il, o1[4 * g + 1] * il); w1.y = cvt_pk_bf16_(o1[4 * g + 2] * il, o1[4 * g + 3] * il);
        *(v2u*)(op + 8 * g) = w0; *(v2u*)(op + 32 + 8 * g) = w1;
    }
}
typedef float fx2 __attribute__((ext_vector_type(2)));
__device__ __forceinline__ fx2 bf2_(unsigned w) { fx2 r; r[0] = __uint_as_float(w << 16); r[1] = __uint_as_float(w & 0xffff0000u); return r; }
__device__ __forceinline__ void fft16_item(bf16* Zp, const float* tw, int bg, int l, int s1h, int lane) {
    const int s1 = s1h * 128 + 2 * lane;
    bf16* base = Zp + ((size_t)(bg * 16) * 256 + l) * 512 + s1;
    fx2 zr[16], zi[16];
#pragma unroll
    for (int s2 = 0; s2 < 16; ++s2) { zr[s2] = bf2_(*(const unsigned*)(base + (size_t)s2 * 256 * 512)); zi[s2] = bf2_(*(const unsigned*)(base + (size_t)s2 * 256 * 512 + 256)); }
    fx2 er[16], ei[16];
#pragma unroll
    for (int d = 0; d < 4; ++d) {
        const fx2 ar = zr[d], ai_ = zi[d], br = zr[4 + d], bi = zi[4 + d], cr = zr[8 + d], ci = zi[8 + d], dr = zr[12 + d], di = zi[12 + d];
        const fx2 s0r = ar + cr, s0i = ai_ + ci, s1r = ar - cr, s1i = ai_ - ci, s2r = br + dr, s2i = bi + di, s3r = br - dr, s3i = bi - di;
        er[0 * 4 + d] = s0r + s2r; ei[0 * 4 + d] = s0i + s2i;
        er[1 * 4 + d] = s1r + s3i; ei[1 * 4 + d] = s1i - s3r;
        er[2 * 4 + d] = s0r - s2r; ei[2 * 4 + d] = s0i - s2i;
        er[3 * 4 + d] = s1r - s3i; ei[3 * 4 + d] = s1i + s3r;
    }
#pragma unroll
    for (int a = 1; a < 4; ++a)
#pragma unroll
        for (int d = 1; d < 4; ++d) {
            const float ang = 6.283185307179586f * (float)(a * d) / 16.f; const float c = __builtin_cosf(ang), sn = __builtin_sinf(ang);
            const fx2 xr = er[a * 4 + d], xi = ei[a * 4 + d];
            er[a * 4 + d] = xr * c + xi * sn; ei[a * 4 + d] = xi * c - xr * sn;
        }
#pragma unroll
    for (int a = 0; a < 4; ++a) {
        const fx2 ar = er[a * 4 + 0], ai_ = ei[a * 4 + 0], br = er[a * 4 + 1], bi = ei[a * 4 + 1], cr = er[a * 4 + 2], ci = ei[a * 4 + 2], dr = er[a * 4 + 3], di = ei[a * 4 + 3];
        const fx2 s0r = ar + cr, s0i = ai_ + ci, s1r = ar - cr, s1i = ai_ - ci, s2r = br + dr, s2i = bi + di, s3r = br - dr, s3i = bi - di;
        fx2 Dr[4], Di[4];
        Dr[0] = s0r + s2r; Di[0] = s0i + s2i; Dr[1] = s1r + s3i; Di[1] = s1i - s3r; Dr[2] = s0r - s2r; Di[2] = s0i - s2i; Dr[3] = s1r - s3i; Di[3] = s1i + s3r;
#pragma unroll
        for (int b = 0; b < 4; ++b) {
            const int k2 = a + 4 * b;
            const f32x4 t0 = *(const f32x4*)(tw + (size_t)(k2 * 256 + s1) * 2);
            const fx2 cc = (fx2){t0[0], t0[2]}, ss = (fx2){t0[1], t0[3]};
            const fx2 hr = Dr[b] * cc + Di[b] * ss, hi_ = Di[b] * cc - Dr[b] * ss;
            *(unsigned*)(base + (size_t)k2 * 256 * 512) = pk2(hr[0], hr[1]); *(unsigned*)(base + (size_t)k2 * 256 * 512 + 256) = pk2(hi_[0], hi_[1]);
        }
    }
}
__device__ __forceinline__ int static_unit(int nM, int nN, int G, int c, int i) {
    const int nwg = nM * nN; const long L = (long)i * G + c; if (L >= nwg) return -1;
    int wgid = (int)L; { const int q = nwg / 8, r = nwg % 8, xcd = wgid % 8, off = wgid / 8; wgid = (xcd < r ? xcd * (q + 1) : r * (q + 1) + (xcd - r) * q) + off; }
    const int nig = 8 * nN, gid = wgid / nig, fm = gid * 8, gsz = (nM - fm) < 8 ? (nM - fm) : 8;
    return ((fm + ((wgid % nig) % gsz)) << 16) | ((wgid % nig) / gsz);
}
#ifndef REP_PRO
#define REP_PRO 1
#endif
#ifndef REP_GEMM
#define REP_GEMM 1
#endif
#ifndef REP_ATT
#define REP_ATT 1
#endif
#ifndef REP_LITE
#define REP_LITE 0
#endif
#ifndef REP_Q
#define REP_Q 1
#endif
#ifndef REP_PA
#define REP_PA 1
#endif
#ifndef REP_TK
#define REP_TK 1
#endif
enum { PH_PRO = 0, PH_G1 = 1, PH_S1 = 2, PH_G2 = 3, PH_G3 = 4, PH_Q0 = 5, PH_TK0 = 6, PH_PA0 = 7, PH_PW0 = 8, PH_PB0 = 9, PH_QKV = 10, PH_ATT = 11, PH_WO = 12, PH_Q1 = 13, PH_TK1 = 14, PH_PA1 = 15, PH_PW1 = 16, PH_PB1 = 17, PH_FIN = 18, PH_END = 19 };
__global__ void __launch_bounds__(NWAVES * 64, 2) mega(Args a) {
    extern __shared__ __attribute__((aligned(16))) unsigned char lds_raw[];
    LAS unsigned char* lds = (LAS unsigned char*)lds_raw;
    cg::grid_group grid = cg::this_grid();
    const int wave = __builtin_amdgcn_readfirstlane(threadIdx.x >> 6);
#define FRESH_IDS() int lane; asm volatile("v_mbcnt_lo_u32_b32 %0, -1, 0\n\tv_mbcnt_hi_u32_b32 %0, -1, %0" : "=v"(lane)); const int tid = wave * 64 + lane; (void)tid
    const int G = gridDim.x, bx = blockIdx.x;
    unsigned char* ws = a.ws;
    const int lo = a.ph_lo, hi = a.ph_hi;
    volatile LAS unsigned* MISC = (volatile LAS unsigned*)(lds + LDSCTL_OFF);
    if (threadIdx.x < 16) MISC[threadIdx.x] = 0u;
    __syncthreads();
    XcdBarrier xbar = xcd_barrier_post((unsigned*)(ws + WS_CTL) + CW_BAR, MISC + 8);
#define IN(k) (lo <= (k) && (k) < hi)
#ifdef DIAG_A
#define STAMP(i) do { if (bx == 0 && threadIdx.x == 0) ((unsigned long long*)(ws + WS_STAMP))[i] = __builtin_amdgcn_s_memrealtime(); } while (0)
#else
#define STAMP(i) do { } while (0)
#endif
#define SEAM(k) do { if (IN(k) && IN((k) + 1)) { if ((k) == PH_PRO) grid.sync(); else xcd_barrier(xbar); } STAMP((k) + 1); } while (0)
    STAMP(0);
    for (int rep_ = 0; rep_ < REP_PRO; ++rep_)
    if (IN(PH_PRO)) { FRESH_IDS();
        const int gw = bx * NWAVES + wave, NGW = G * NWAVES;
        const size_t gtid = (size_t)bx * (NWAVES * 64) + tid, ngt = (size_t)G * NWAVES * 64;
        LAS float* scr = (LAS float*)(lds + wave * 16384);
        {
            constexpr int I_SQ = (DM / 64) * (DM / 32), I_QKV = (DM / 64) * (QKVW / 32);
            constexpr int NITEMS = 4 * I_SQ + I_QKV;
            for (int it = gw; it < NITEMS; it += NGW) {
                int r = it;
                if (r < I_SQ) { transpose_item<0>(a.in[3], DM, DM, nullptr, (bf16*)(ws + WS_WOF), scr, r, lane); continue; } r -= I_SQ;
                if (r < I_SQ) { transpose_item<0>(a.in[5], DM, DM, nullptr, (bf16*)(ws + WS_WOA), scr, r, lane); continue; } r -= I_SQ;
                if (r < I_SQ) { transpose_item<0>(a.in[7], DM, DM, a.in[2], (bf16*)(ws + WS_WQ0), scr, r, lane); continue; } r -= I_SQ;
                if (r < I_SQ) { transpose_item<0>(a.in[7] + (size_t)DM * DM, DM, DM, a.in[2] + DM, (bf16*)(ws + WS_WQ1), scr, r, lane); continue; } r -= I_SQ;
                transpose_item<1>(a.in[4], DM, QKVW, a.in[1] + DM, (bf16*)(ws + WS_WQKV), scr, r, lane);
            }
        }
        {
            f32x4 v[8], nv[8];
            { const f32x4* xr = (const f32x4*)(a.in[0] + (size_t)(gw < T ? gw : 0) * DM) + lane;
#pragma unroll
              for (int j = 0; j < 8; ++j) v[j] = xr[64 * j]; }
            for (int row = gw; row < T; row += NGW) {
                { const int nr = (row + NGW < T) ? row + NGW : row; const f32x4* xr = (const f32x4*)(a.in[0] + (size_t)nr * DM) + lane;
#pragma unroll
                  for (int j = 0; j < 8; ++j) nv[j] = xr[64 * j]; }
                const f32x4* gr = (const f32x4*)a.in[1] + lane;
                float s = 0.f;
#pragma unroll
                for (int j = 0; j < 8; ++j) s += (v[j][0] * v[j][0] + v[j][1] * v[j][1]) + (v[j][2] * v[j][2] + v[j][3] * v[j][3]);
                const float r = rsqrtf(wsum(s) * (1.f / DM) + EPS);
                const int b = row >> 12, sp = row & 4095;
#pragma unroll
                for (int j = 0; j < 8; ++j) { const f32x4 gg = gr[64 * j]; v2u o; o.x = pk2(v[j][0] * r * gg[0], v[j][1] * r * gg[1]); o.y = pk2(v[j][2] * r * gg[2], v[j][3] * r * gg[3]);
                    *(v2u*)((bf16*)(ws + WS_XG) + ((size_t)((b * 8 + j) * 4096 + sp) * 256 + 4 * lane)) = o; }
#pragma unroll
                for (int j = 0; j < 8; ++j) v[j] = nv[j];
            }
        }
        for (size_t i = gtid; i < (size_t)256 * 512 / 8; i += ngt) {
            const int k1 = (int)(i >> 6), c0 = (int)(i & 63) * 8, part = c0 >> 8, s0 = c0 & 255;
            float v[8];
#pragma unroll
            for (int e = 0; e < 8; ++e) { const int m = (k1 * (s0 + e)) & 255; const float rev = (float)m * (1.f / 256.f); v[e] = (part ? __builtin_amdgcn_sinf(rev) : __builtin_amdgcn_cosf(rev)) * (1.f / 64.f); }
            v4u o; o.x = pk2(v[0], v[1]); o.y = pk2(v[2], v[3]); o.z = pk2(v[4], v[5]); o.w = pk2(v[6], v[7]);
            *(v4u*)((bf16*)(ws + WS_A2) + i * 8) = o;
        }
        for (size_t i = gtid; i < (size_t)16 * 256; i += ngt) {
            const int k2 = (int)(i >> 8), s1 = (int)(i & 255); const float rev = (float)(k2 * s1) * (1.f / 4096.f);
            ((float*)(ws + WS_TW))[2 * i] = __builtin_amdgcn_cosf(rev); ((float*)(ws + WS_TW))[2 * i + 1] = __builtin_amdgcn_sinf(rev);
        }
        for (size_t i = gtid; i < (size_t)512 * 256 / 8; i += ngt) {
            const int n = (int)(i >> 5), c0 = (int)(i & 31) * 8, part = n >> 8, l = n & 255;
            float v[8];
#pragma unroll
            for (int e = 0; e < 8; ++e) { const int m = (l * (c0 + e)) & 255; const float rev = (float)m * (1.f / 256.f); v[e] = (part ? -__builtin_amdgcn_sinf(rev) : __builtin_amdgcn_cosf(rev)) * (1.f / 16.f); }
            v4u o; o.x = pk2(v[0], v[1]); o.y = pk2(v[2], v[3]); o.z = pk2(v[4], v[5]); o.w = pk2(v[6], v[7]);
            *(v4u*)((bf16*)(ws + WS_WCS) + i * 8) = o;
        }
        for (size_t i = gtid; i < (size_t)4096 * 32; i += ngt) {
            const int pos = (int)(i >> 5), fi = (int)(i & 31);
            const double inv = exp2(-(double)fi * (13.287712379549449 / 32.0));
            double sn, cs; sincos((double)pos * inv, &sn, &cs);
            ((float*)(ws + WS_ROPE))[2 * i] = (float)cs; ((float*)(ws + WS_ROPE))[2 * i + 1] = (float)sn;
        }
#pragma unroll 1
        for (int L = 0; L < 2; ++L) {
            CvtCtx cx; cx.srcU = a.in[9] + (size_t)L * NEXP * DM; cx.dsrc = (long)((a.in[10] + (size_t)L * NEXP * DM) - cx.srcU); cx.gain = a.in[2] + L * DM; cx.dstU = ws + (L ? WS_U1 : WS_U0); cx.ddst = (long)WS_V0 - (long)WS_U0;
            cx.su = (float*)(ws + WS_SU) + L * 32768; cx.dsc = ((long)WS_SV - (long)WS_SU) / 4; cx.gwave = gw; cx.nw = NGW;
            f32x4 c0[4], c1[4], n0[4], n1[4];
            cvt_chunk_load(cx, gw, lane, c0); cvt_chunk_load(cx, (gw + NGW < 65536) ? gw + NGW : gw, lane, c1);
            for (int cc = gw; cc < 65536; cc += 2 * NGW) { const int ca = cc + 2 * NGW, cb = cc + 3 * NGW;
                cvt_chunk_load(cx, ca < 65536 ? ca : cc, lane, n0); cvt_chunk_load(cx, cb < 65536 ? cb : cc, lane, n1);
                cvt_chunk_store(cx, cc, lane, c0); if (cc + NGW < 65536) cvt_chunk_store(cx, cc + NGW, lane, c1);
#pragma unroll
                for (int q = 0; q < 4; ++q) { c0[q] = n0[q]; c1[q] = n1[q]; } }
        }
        cvt_stream(a.in[8], (bf16*)(ws + WS_KEYS), (size_t)2 * PH * 2 * 128 * 128 / 8, gtid, ngt);
    }
    SEAM(PH_PRO);
    for (int rep_ = 0; rep_ < REP_GEMM; ++rep_)
    if (IN(PH_G1)) { FRESH_IDS();
        int Kq = FW; asm volatile("" : "+s"(Kq));
        pg8::Gemm g{(const pg8::bf16_t*)(ws + WS_WCS), (const pg8::bf16_t*)(ws + WS_XG), 512, T * FG, Kq}; pg8::StaticOrder S; S.init(512, T * FG, G, bx);
        pg8::EpiZt E{(pg8::bf16_t*)(ws + WS_ZT)};
        pg8::gemm_phase<pg8::EpiZt, pg8::StaticOrder, true, true>(lds, g, S, E);
    }
    SEAM(PH_G1);
    if (IN(PH_S1)) { FRESH_IDS();
        const int gw = bx * NWAVES + wave, NGW = G * NWAVES;
        for (int it = gw; it < 32 * 256 * 2; it += NGW) fft16_item((bf16*)(ws + WS_ZT), (const float*)(ws + WS_TW), it >> 9, (it >> 1) & 255, it & 1, lane);
    }
    SEAM(PH_S1);
    for (int rep_ = 0; rep_ < REP_GEMM; ++rep_)
    if (IN(PH_G2)) { FRESH_IDS();
        pg8::Gemm g{(const pg8::bf16_t*)(ws + WS_A2), (const pg8::bf16_t*)(ws + WS_ZT), 256, 131072, 512}; pg8::StaticOrder S; S.init(256, 131072, G, bx);
        pg8::EpiY E{(pg8::bf16_t*)(ws + WS_Y)};
        pg8::gemm_phase<pg8::EpiY, pg8::StaticOrder, true, true>(lds, g, S, E);
    }
    SEAM(PH_G2);
    if (IN(PH_G3)) { FRESH_IDS();
        pg8::Gemm g{(const pg8::bf16_t*)(ws + WS_Y), (const pg8::bf16_t*)(ws + WS_WOF), T, DM, DM}; pg8::StaticOrder S; S.init(T, DM, G, bx);
        pg8::EpiRes E{a.in[0], a.out, (pg8::bf16_t*)(ws + WS_XB), (float*)(ws + WS_SSQ_A)};
        pg8::gemm_phase<pg8::EpiRes, pg8::StaticOrder, true, true>(lds, g, S, E);
    }
    SEAM(PH_G3);
#define PEER_LAYER(L) do { \
        const int pq = L ? PH_Q1 : PH_Q0, ptk = L ? PH_TK1 : PH_TK0, ppa = L ? PH_PA1 : PH_PA0, ppw = L ? PH_PW1 : PH_PW0, ppb = L ? PH_PB1 : PH_PB0; \
        for (int rep_ = 0; rep_ < REP_Q; ++rep_) \
        if (IN(pq)) { FRESH_IDS(); \
            pg8::Gemm g{(const pg8::bf16_t*)(ws + WS_XB), (const pg8::bf16_t*)(ws + (L ? WS_WQ1 : WS_WQ0)), T, DM, DM}; pg8::StaticOrder S; S.init(T, DM, G, bx); \
            pg8::EpiScale E{(pg8::bf16_t*)(ws + WS_Q), (const float*)(ws + (L ? WS_SSQ_C : WS_SSQ_A))}; \
            pg8::gemm_phase<pg8::EpiScale, pg8::StaticOrder, true, true>(lds, g, S, E); \
        } \
        if (IN(pq) && IN(ptk)) { asm volatile("s_waitcnt vmcnt(0)" ::: "memory"); __syncthreads(); } STAMP(pq + 1); \
        if (IN(ptk)) { FRESH_IDS(); \
            const bf16* keys = (const bf16*)(ws + WS_KEYS) + (size_t)L * PH * 2 * 128 * 128; \
            int slot = 0; \
            for (int rep_ = 0; rep_ < REP_TK; ++rep_) { slot = 0; \
            for (int ui = 0; ; ++ui) {        \
                const int upk = static_unit(T / 256, DM / 256, G, bx, ui); if (upk < 0) break; \
                const int h = upk & 0xffff, tblk = upk >> 16; \
                __syncthreads(); \
                topk_fill(lds, keys, h, tid); \
                __syncthreads(); \
                topk_unit((const bf16*)(ws + WS_Q), lds, (int*)(ws + WS_EI), (float*)(ws + WS_GW), tblk * 256 + wave * 32, h, lane); \
                slot += 16; \
            } } \
        } \
        SEAM(ptk); \
        if (IN(ppa)) { FRESH_IDS(); \
            const int xv = bx & 7; \
            peer_a_slice<8>((const bf16*)(ws + WS_XB), (const int*)(ws + WS_EI), (const unsigned char*)(ws + (L ? WS_U1 : WS_U0)), (float*)(ws + WS_PD), xv, (unsigned*)(ws + WS_BCTR) + (L * 2 + 0) * 512 + xv * 64, T / 8, lane); \
        } \
        SEAM(ppa); \
        if (IN(ppw)) { FRESH_IDS(); \
            const int gw = bx * NWAVES + wave, NGW = G * NWAVES; \
            for (int t = gw; t < T; t += NGW) peer_a2_token((const float*)(ws + WS_PD), (const float*)(ws + (L ? WS_SSQ_C : WS_SSQ_A)), (const int*)(ws + WS_EI), (const float*)(ws + WS_SU) + L * 32768, (const float*)(ws + WS_SV) + L * 32768, (float*)(ws + WS_GW), (float*)(ws + WS_W1), t, lane); \
        } \
        SEAM(ppw); \
        if (IN(ppb)) { FRESH_IDS(); \
            const int xv = bx & 7; \
            peer_b_slice<4>((const bf16*)(ws + WS_XB), a.out, (const int*)(ws + WS_EI), (const unsigned*)(ws + ((xv < 4) ? WS_GW : WS_W1)), (const unsigned char*)(ws + (L ? WS_V1 : WS_V0)), L ? (bf16*)nullptr : (bf16*)(ws + WS_XB), (float*)(ws + (L ? WS_SSQ_D : WS_SSQ_B)), xv, (unsigned*)(ws + WS_BCTR) + (L * 2 + 1) * 512 + xv * 64, T / 4, lane); \
        } \
    } while (0)
    float oscale = 1.f;
    PEER_LAYER(0);
    SEAM(PH_PB0);
    for (int rep_ = 0; rep_ < REP_GEMM; ++rep_)
    if (IN(PH_QKV)) { FRESH_IDS();
        {
            pg8::Gemm g{(const pg8::bf16_t*)(ws + WS_XB), (const pg8::bf16_t*)(ws + WS_WQKV), T, 2560, DM}; pg8::StaticOrder S; S.init(T, 2560, G, bx);
            pg8::EpiQK E{(pg8::bf16_t*)(ws + WS_QB), (pg8::bf16_t*)(ws + WS_KB), (const float*)(ws + WS_SSQ_B), (const float*)(ws + WS_ROPE), 0.125f * 1.4426950408889634f};
            pg8::gemm_phase<pg8::EpiQK, pg8::StaticOrder, true, true>(lds, g, S, E);
        }
        if (bx >= G / 2) {
            pg8::Gemm g{(const pg8::bf16_t*)(ws + WS_WQKV) + (size_t)2560 * DM, (const pg8::bf16_t*)(ws + WS_XB), 512, T, DM}; pg8::StaticOrder S; S.init(512, T, G / 2, bx - G / 2);
            pg8::EpiVt E{(pg8::bf16_t*)(ws + WS_VT), (const float*)(ws + WS_SSQ_B)};
            pg8::gemm_phase<pg8::EpiVt, pg8::StaticOrder, true, true>(lds, g, S, E);
        }
    }
    SEAM(PH_QKV);
    for (int rep_ = 0; rep_ < REP_ATT; ++rep_)
    if (IN(PH_ATT)) { FRESH_IDS();
        for (int vb = bx; vb < 256; vb += G) {
            const int bkv = vb >> 3, chunk = vb & 7, b = bkv >> 3, kvh = bkv & 7;
            v4u kr[5]; v2u vr[10];
            attn_fill_load((const bf16*)(ws + WS_KB), (const bf16*)(ws + WS_VT), b, kvh, chunk * 8 * 64 - 128, tid, kr, vr);
            for (int i = 0; i < 8; ++i) {
                const int qu = (chunk * 8 + i) * 64;
                __syncthreads();
                attn_fill_store(lds, tid, kr, vr);
                __syncthreads();
                if (i + 1 < 8) attn_fill_load((const bf16*)(ws + WS_KB), (const bf16*)(ws + WS_VT), b, kvh, qu + 64 - 128, tid, kr, vr);
                attn_task(lds, (const bf16*)(ws + WS_QB), (bf16*)(ws + WS_O), a.in[6], b, kvh * 4 + (wave & 3), qu + (wave >> 2) * 32, qu - 128, lane);
            }
        }
    }
    SEAM(PH_ATT);
    if (IN(PH_WO)) { FRESH_IDS();
        pg8::Gemm g{(const pg8::bf16_t*)(ws + WS_O), (const pg8::bf16_t*)(ws + WS_WOA), T, DM, DM}; pg8::StaticOrder S; S.init(T, DM, G, bx);
        pg8::EpiResB E{(const pg8::bf16_t*)(ws + WS_XB), (pg8::bf16_t*)(ws + WS_XB), (float*)(ws + WS_SSQ_C)};
        pg8::gemm_phase<pg8::EpiResB, pg8::StaticOrder, true, true>(lds, g, S, E);
    }
    SEAM(PH_WO);
#ifdef DIAG_A
    { const unsigned long long* st = (const unsigned long long*)(ws + WS_STAMP); oscale = 1.f + sqrtf((float)(st[DIAG_B] - st[DIAG_A]) * 1e-6f); }
#endif
    PEER_LAYER(1);
#undef PEER_LAYER
    SEAM(PH_PB1);
    if (IN(PH_FIN)) { FRESH_IDS();
        const int gw = bx * NWAVES + wave, NGW = G * NWAVES;
        for (int t = gw; t < T; t += NGW) final_norm_row(a.out, (const float*)(ws + WS_SSQ_D), a.in[11], t, lane, oscale);
    }
#undef SEAM
#undef IN
}

#ifndef N_LAUNCHES
#define N_LAUNCHES 1
#endif
extern "C" void kernel_launch(void* const* d_in, const int* in_sizes, int n_in, void* d_out, int out_size, void* d_ws, size_t ws_size, hipStream_t stream) {
    static int grid = 0;
    if (!grid) {
        if (hipFuncSetAttribute((const void*)mega, hipFuncAttributeMaxDynamicSharedMemorySize, LDS_BYTES) != hipSuccess) { fprintf(stderr, "hipFuncSetAttribute failed\n"); }
        int dev = 0, cus = 0, per_cu = 0;
        (void)hipGetDevice(&dev);
        (void)hipDeviceGetAttribute(&cus, hipDeviceAttributeMultiprocessorCount, dev);
        if (hipOccupancyMaxActiveBlocksPerMultiprocessor(&per_cu, (const void*)mega, NWAVES * 64, LDS_BYTES) != hipSuccess) per_cu = 0;
        (void)hipGetLastError();
        grid = cus * per_cu;
        if (grid > 256) grid = 256;
        grid &= ~1;
        if (grid < 2) { fprintf(stderr, "occupancy query gave %d x %d\n", cus, per_cu); grid = -1; }
    }
    if (grid < 0) return;
    if (ws_size < 700 * MiB) { fprintf(stderr, "ws too small: %zu\n", ws_size); return; }
    (void)hipMemsetAsync((char*)d_ws + WS_CTL, 0, CTL_BYTES, stream);
    Args a{};
    for (int i = 0; i < 12; ++i) a.in[i] = (const float*)d_in[i];
    a.out = (float*)d_out; a.ws = (unsigned char*)d_ws;
    if (N_LAUNCHES == 1) {
        a.ph_lo = 0; a.ph_hi = PH_END;
        void* args[] = {&a};
        const hipError_t e = hipLaunchCooperativeKernel((const void*)mega, dim3(grid), dim3(NWAVES * 64), args, LDS_BYTES, stream);
        if (e != hipSuccess) fprintf(stderr, "cooperative launch failed: %s (grid %d)\n", hipGetErrorString(e), grid);
    } else {
        for (int ph = 0; ph < PH_END; ++ph) {
            a.ph_lo = ph; a.ph_hi = ph + 1;
            hipLaunchKernelGGL(mega, dim3(grid), dim3(NWAVES * 64), LDS_BYTES, stream, a);
        }
    }
}
```

```cpp
#include <hip/hip_runtime.h>
#include <hip/hip_cooperative_groups.h>
namespace cg = cooperative_groups;
#include <cstdio>
#include <cstdint>
#include <cmath>

constexpr int DM = 2048, NB = 4, SEQ = 4096, T = NB * SEQ;
constexpr int FG = 8, FW = 256;
constexpr int HD = 64, NQH = 32, NKVH = 8, QKVW = 3072;
constexpr int PH = 8, NKEYS = 128, NEXP = 16384, PTOPK = 16;
constexpr float EPS = 1e-6f;
namespace pg8 {
#define PG8_LAS __attribute__((address_space(3)))
typedef unsigned short bf16_t;
typedef short bf16x8 __attribute__((ext_vector_type(8)));
typedef float f32x4 __attribute__((ext_vector_type(4)));
typedef unsigned u32x4 __attribute__((ext_vector_type(4)));
constexpr int BM = 256, BK = 64, HALF = 128, HTB = HALF * BK * 2  , STAGE_BYTES = 8 * HTB, NXCD = 8, WGM = 8;

__host__ __device__ __forceinline__ int lds_byte(int r, int c) { const int st = (r >> 4) * 2 + (c >> 5), rr = r & 15, cc = c & 31, ob = rr * 64 + cc * 2; return st * 1024 + (ob ^ (((ob >> 9) & 1) << 5)); }
__host__ __device__ __forceinline__ void stage_rc(int b, int& R, int& C) { const int st = b / 1024, sb = b % 1024, swz = sb ^ (((sb >> 9) & 1) << 5); R = (st >> 1) * 16 + swz / 64; C = (st & 1) * 32 + (swz % 64) / 2; }
__host__ __device__ __forceinline__ int perm32(int rho) { const int n = rho >> 4, i = rho & 15; return 8 * (i >> 2) + 4 * n + (i & 3); }

struct Unit { int pm, pn; };
struct Gemm { const bf16_t* A; const bf16_t* Bt; int M, N, K; };

struct StaticOrder {
    int nM, nN, nwg, G, c;
    __host__ __device__ void init(int M, int N, int G_, int c_) { nM = M / BM; nN = N / BM; nwg = nM * nN; G = G_; c = c_; }
    __host__ __device__ bool next(int i, Unit& u) const {
        const long L = (long)i * G + c; if (L >= nwg) return false;
        int wgid = (int)L; { const int q = nwg / NXCD, r = nwg % NXCD, xcd = wgid % NXCD, off = wgid / NXCD; wgid = (xcd < r ? xcd * (q + 1) : r * (q + 1) + (xcd - r) * q) + off; }
        const int nig = WGM * nN, gid = wgid / nig, fm = gid * WGM, gsz = (nM - fm) < WGM ? (nM - fm) : WGM;
        u.pm = fm + ((wgid % nig) % gsz); u.pn = (wgid % nig) / gsz; return true;
    }
    __device__ __forceinline__ void a_ready(const Unit&) const {}
    __device__ __forceinline__ void done(const Unit&) const {}
};

__device__ __forceinline__ unsigned cvt_pk_bf16(float lo, float hi) { unsigned r; asm volatile("v_cvt_pk_bf16_f32 %0, %1, %2" : "=v"(r) : "v"(lo), "v"(hi)); return r; }
typedef float f32x2 __attribute__((ext_vector_type(2)));
__device__ __forceinline__ u32x4 pack8(const f32x4 v0, const f32x4 v1) { u32x4 w; w.x = cvt_pk_bf16(v0[0], v0[1]); w.y = cvt_pk_bf16(v0[2], v0[3]); w.z = cvt_pk_bf16(v1[0], v1[1]); w.w = cvt_pk_bf16(v1[2], v1[3]); return w; }
struct EpiZt {
    static constexpr bool PERM = true, AFTER_DRAIN = false; bf16_t* Zp;
    __device__ __forceinline__ void operator()(const f32x4 (&acc)[2][2][4][2], const Unit& u, int wr, int wc, int fr, int fq) const {
        const int part = u.pm, bgs2 = u.pn;
        bf16_t* base = Zp + ((size_t)(bgs2 * 256 + wr * 64 + fr) * 512 + part * 256 + wc * 32 + 8 * fq);
#pragma unroll
        for (int ai = 0; ai < 2; ++ai)
#pragma unroll
            for (int m = 0; m < 4; ++m)
#pragma unroll
                for (int bj = 0; bj < 2; ++bj) *(u32x4*)(base + (ai * HALF + m * 16) * 512 + bj * HALF) = pack8(acc[ai][bj][m][0], acc[ai][bj][m][1]);
    }
};
struct EpiY {
    static constexpr bool PERM = true, AFTER_DRAIN = false; bf16_t* Y;
    __device__ __forceinline__ void operator()(const f32x4 (&acc)[2][2][4][2], const Unit& u, int wr, int wc, int fr, int fq) const {
        const int bg = u.pn >> 4, k2 = u.pn & 15, b = bg >> 3, g = bg & 7;
        bf16_t* base = Y + ((size_t)(b * 4096 + (wr * 64 + fr) * 16 + k2) * 2048 + g * 256 + wc * 32 + 8 * fq);
#pragma unroll
        for (int ai = 0; ai < 2; ++ai)
#pragma unroll
            for (int m = 0; m < 4; ++m)
#pragma unroll
                for (int bj = 0; bj < 2; ++bj) *(u32x4*)(base + (size_t)(ai * HALF + m * 16) * 16 * 2048 + bj * HALF) = pack8(acc[ai][bj][m][0], acc[ai][bj][m][1]);
    }
};
struct EpiRes {
    static constexpr bool PERM = true, AFTER_DRAIN = false; const float* R; float* out; bf16_t* xb; float* ssq; unsigned char* x8;
    __device__ __forceinline__ void operator()(const f32x4 (&acc)[2][2][4][2], const Unit& u, int wr, int wc, int fr, int fq) const {
        const int row0 = u.pm * BM + wr * 64 + fr; const size_t off0 = (size_t)row0 * 2048 + u.pn * BM + wc * 32 + 8 * fq;
        const float* Rb = R + off0; bf16_t* Xb = xb + off0; float* Sb = ssq + row0;
#pragma unroll
        for (int ai = 0; ai < 2; ++ai)
#pragma unroll
            for (int m = 0; m < 4; ++m) { const int ro = (ai * HALF + m * 16) * 2048; float ss = 0.f;
#pragma unroll
                for (int bj = 0; bj < 2; ++bj) {
                    const f32x4 r0 = *(const f32x4*)(Rb + ro + bj * HALF), r1 = *(const f32x4*)(Rb + ro + bj * HALF + 4);
                    const f32x4 o0 = acc[ai][bj][m][0] + r0, o1 = acc[ai][bj][m][1] + r1;
                    *(u32x4*)(Xb + ro + bj * HALF) = pack8(o0, o1);
                    { int lo8 = 0, hi8 = 0; lo8 = __builtin_amdgcn_cvt_pk_fp8_f32(o0[0], o0[1], lo8, false); lo8 = __builtin_amdgcn_cvt_pk_fp8_f32(o0[2], o0[3], lo8, true);
                      hi8 = __builtin_amdgcn_cvt_pk_fp8_f32(o1[0], o1[1], hi8, false); hi8 = __builtin_amdgcn_cvt_pk_fp8_f32(o1[2], o1[3], hi8, true);
                      *(unsigned long long*)(x8 + off0 + ro + bj * HALF) = ((unsigned long long)(unsigned)hi8 << 32) | (unsigned)lo8; }
                    ss += (o0[0] * o0[0] + o0[1] * o0[1]) + (o0[2] * o0[2] + o0[3] * o0[3]) + (o1[0] * o1[0] + o1[1] * o1[1]) + (o1[2] * o1[2] + o1[3] * o1[3]); }
                ss += __shfl_xor(ss, 16); ss += __shfl_xor(ss, 32);
                if (fq == 0) unsafeAtomicAdd(Sb + ai * HALF + m * 16, ss);
                asm volatile("" ::: "memory"); }
    }
};
struct EpiResB {
    static constexpr bool PERM = true, AFTER_DRAIN = false; const bf16_t* R; bf16_t* xb; float* ssq; unsigned char* x8;
    __device__ __forceinline__ void operator()(const f32x4 (&acc)[2][2][4][2], const Unit& u, int wr, int wc, int fr, int fq) const {
        const int row0 = u.pm * BM + wr * 64 + fr; const size_t off0 = (size_t)row0 * 2048 + u.pn * BM + wc * 32 + 8 * fq;
        const bf16_t* Rb = R + off0; bf16_t* Xb = xb + off0; float* Sb = ssq + row0;
#pragma unroll
        for (int ai = 0; ai < 2; ++ai)
#pragma unroll
            for (int m = 0; m < 4; ++m) { const int ro = (ai * HALF + m * 16) * 2048; float ss = 0.f;
#pragma unroll
                for (int bj = 0; bj < 2; ++bj) {
                    const u32x4 rw = *(const u32x4*)(Rb + ro + bj * HALF);
                    const f32x4 r0 = (f32x4){__uint_as_float(rw[0] << 16), __uint_as_float(rw[0] & 0xffff0000u), __uint_as_float(rw[1] << 16), __uint_as_float(rw[1] & 0xffff0000u)}, r1 = (f32x4){__uint_as_float(rw[2] << 16), __uint_as_float(rw[2] & 0xffff0000u), __uint_as_float(rw[3] << 16), __uint_as_float(rw[3] & 0xffff0000u)};
                    const f32x4 o0 = acc[ai][bj][m][0] + r0, o1 = acc[ai][bj][m][1] + r1;
                    *(u32x4*)(Xb + ro + bj * HALF) = pack8(o0, o1);
                    { int lo8 = 0, hi8 = 0; lo8 = __builtin_amdgcn_cvt_pk_fp8_f32(o0[0], o0[1], lo8, false); lo8 = __builtin_amdgcn_cvt_pk_fp8_f32(o0[2], o0[3], lo8, true);
                      hi8 = __builtin_amdgcn_cvt_pk_fp8_f32(o1[0], o1[1], hi8, false); hi8 = __builtin_amdgcn_cvt_pk_fp8_f32(o1[2], o1[3], hi8, true);
                      *(unsigned long long*)(x8 + off0 + ro + bj * HALF) = ((unsigned long long)(unsigned)hi8 << 32) | (unsigned)lo8; }
                    ss += (o0[0] * o0[0] + o0[1] * o0[1]) + (o0[2] * o0[2] + o0[3] * o0[3]) + (o1[0] * o1[0] + o1[1] * o1[1]) + (o1[2] * o1[2] + o1[3] * o1[3]); }
                ss += __shfl_xor(ss, 16); ss += __shfl_xor(ss, 32);
                if (fq == 0) unsafeAtomicAdd(Sb + ai * HALF + m * 16, ss);
                asm volatile("" ::: "memory"); }
    }
};
struct EpiScale {
    static constexpr bool PERM = true, AFTER_DRAIN = false; bf16_t* O; const float* ssq;
    __device__ __forceinline__ void operator()(const f32x4 (&acc)[2][2][4][2], const Unit& u, int wr, int wc, int fr, int fq) const {
        const int row0 = u.pm * BM + wr * 64 + fr;
        bf16_t* base = O + ((size_t)row0 * 2048 + u.pn * BM + wc * 32 + 8 * fq); const float* Sb = ssq + row0;
#pragma unroll
        for (int ai = 0; ai < 2; ++ai)
#pragma unroll
            for (int m = 0; m < 4; ++m) { const float rs = rsqrtf(Sb[ai * HALF + m * 16] * (1.f / 2048.f) + 1e-6f);
#pragma unroll
                for (int bj = 0; bj < 2; ++bj) *(u32x4*)(base + (ai * HALF + m * 16) * 2048 + bj * HALF) = pack8(acc[ai][bj][m][0] * rs, acc[ai][bj][m][1] * rs); }
    }
};
struct EpiQK {
    static constexpr bool PERM = true, AFTER_DRAIN = false; bf16_t* Q; bf16_t* K; const float* ssq; const float* rope; float qscale;
    __device__ __forceinline__ void operator()(const f32x4 (&acc)[2][2][4][2], const Unit& u, int wr, int wc, int fr, int fq) const {
        const int row0 = u.pm * BM + wr * 64 + fr; const bool isq = u.pn < 8;
        const int cl = wc * 32 + 8 * fq;
        bf16_t* base = isq ? (Q + ((size_t)row0 * 2048 + u.pn * BM + cl)) : (K + ((size_t)row0 * 512 + (u.pn - 8) * BM + cl));
        const int ld = isq ? 2048 : 512; const float sc = isq ? qscale : 1.f;
        const float* rp = rope + (size_t)(row0 & 4095) * 64 + (cl & 63);
        const float* Sb = ssq + row0;
#pragma unroll
        for (int ai = 0; ai < 2; ++ai)
#pragma unroll
            for (int m = 0; m < 4; ++m) { const int ro = ai * HALF + m * 16; const float rs = rsqrtf(Sb[ro] * (1.f / 2048.f) + 1e-6f) * sc;
                const f32x4 t0 = *(const f32x4*)(rp + (size_t)ro * 64), t1 = *(const f32x4*)(rp + (size_t)ro * 64 + 4);
#pragma unroll
                for (int bj = 0; bj < 2; ++bj) {
                    const f32x4 a = acc[ai][bj][m][0] * rs, b = acc[ai][bj][m][1] * rs; f32x4 oa, ob;
                    oa[0] = a[0] * t0[0] - a[1] * t0[1]; oa[1] = a[1] * t0[0] + a[0] * t0[1]; oa[2] = a[2] * t0[2] - a[3] * t0[3]; oa[3] = a[3] * t0[2] + a[2] * t0[3];
                    ob[0] = b[0] * t1[0] - b[1] * t1[1]; ob[1] = b[1] * t1[0] + b[0] * t1[1]; ob[2] = b[2] * t1[2] - b[3] * t1[3]; ob[3] = b[3] * t1[2] + b[2] * t1[3];
                    *(u32x4*)(base + (size_t)ro * ld + bj * HALF) = pack8(oa, ob); } }
    }
};
struct EpiVt {
    static constexpr bool PERM = true, AFTER_DRAIN = false; bf16_t* Vt; const float* ssq;
    __device__ __forceinline__ void operator()(const f32x4 (&acc)[2][2][4][2], const Unit& u, int wr, int wc, int fr, int fq) const {
        const int col0 = u.pn * BM + wc * 32 + 8 * fq;
        bf16_t* base = Vt + ((size_t)(u.pm * BM + wr * 64 + fr) * 16384 + col0);
        f32x4 r0[2], r1[2];
#pragma unroll
        for (int bj = 0; bj < 2; ++bj) { const f32x4 s0 = *(const f32x4*)(ssq + col0 + bj * HALF), s1 = *(const f32x4*)(ssq + col0 + bj * HALF + 4);
#pragma unroll
            for (int q = 0; q < 4; ++q) { r0[bj][q] = rsqrtf(s0[q] * (1.f / 2048.f) + 1e-6f); r1[bj][q] = rsqrtf(s1[q] * (1.f / 2048.f) + 1e-6f); } }
#pragma unroll
        for (int ai = 0; ai < 2; ++ai)
#pragma unroll
            for (int m = 0; m < 4; ++m)
#pragma unroll
                for (int bj = 0; bj < 2; ++bj) *(u32x4*)(base + (size_t)(ai * HALF + m * 16) * 16384 + bj * HALF) = pack8(acc[ai][bj][m][0] * r0[bj], acc[ai][bj][m][1] * r1[bj]);
    }
};
template <class Epi, class Sched, bool ALIGN_EPI = false, bool SP2 = false>
__device__ __forceinline__ void gemm_phase(PG8_LAS unsigned char* lds, const Gemm g, const Sched& S, const Epi& E) {
    const int tid = threadIdx.x, wid = __builtin_amdgcn_readfirstlane(tid >> 6), lane = tid & 63, wr = wid >> 2, wc = wid & 3, fr = lane & 15, fq = lane >> 4;
    const int K = g.K, nt = K / BK;
    unsigned voffA[2], voffB[2];
#pragma unroll
    for (int i = 0; i < 2; ++i) { int R, C; stage_rc(tid * 16 + i * 8192, R, C); const int Rb = Epi::PERM ? ((R & ~31) + perm32(R & 31)) : R;
        voffA[i] = (unsigned)(R * K + C) * 2u; voffB[i] = (unsigned)(Rb * K + C) * 2u; }
    const size_t kstep = (size_t)(BK * 2);
    const size_t hstep = (size_t)HALF * K * 2;
    const size_t tstep = 2 * hstep;
    const unsigned ldsw = (unsigned)wid * 1024u;
    const int aoff = lds_byte(wr * 64 + fr, fq * 8), boff = lds_byte(wc * 32 + fr, fq * 8);
#define PG8_SA(b, h) (((b) * 2 + (h)) * HTB)
#define PG8_SB(b, h) ((4 + (b) * 2 + (h)) * HTB)
#define PG8_STAGE(bufoff, gbase, voff) do { _Pragma("unroll") for (int _i = 0; _i < 2; ++_i) \
        __builtin_amdgcn_global_load_lds((const unsigned*)((const char*)(gbase) + (voff)[_i]), (PG8_LAS unsigned*)(lds + (bufoff) + ldsw + _i * 8192), 16, 0, 0); } while (0)
#define PG8_LDA(dst, b, h) do { _Pragma("unroll") for (int m = 0; m < 4; ++m) _Pragma("unroll") for (int k = 0; k < 2; ++k) dst[m][k] = *(const PG8_LAS bf16x8*)(lds + PG8_SA(b, h) + aoff + m * 2048 + k * 1024); } while (0)
#define PG8_LDB(dst, b, h) do { _Pragma("unroll") for (int n = 0; n < 2; ++n) _Pragma("unroll") for (int k = 0; k < 2; ++k) dst[n][k] = *(const PG8_LAS bf16x8*)(lds + PG8_SB(b, h) + boff + n * 2048 + k * 1024); } while (0)
#define PG8_MMA(ai, bj, At, Bt) do { __builtin_amdgcn_s_setprio(1); _Pragma("unroll") for (int m = 0; m < 4; ++m) _Pragma("unroll") for (int n = 0; n < 2; ++n) _Pragma("unroll") for (int k = 0; k < 2; ++k) \
        acc[ai][bj][m][n] = __builtin_amdgcn_mfma_f32_16x16x32_bf16(Bt[n][k], At[m][k], acc[ai][bj][m][n], 0, 0, 0); __builtin_amdgcn_s_setprio(0); } while (0)
#define PG8_WAIT_V(n) asm volatile("s_waitcnt vmcnt(" #n ")" ::: "memory")
#define PG8_WAIT_L(n) asm volatile("s_waitcnt lgkmcnt(" #n ")" ::: "memory")
#define PG8_BAR __builtin_amdgcn_s_barrier()
#define PG8_SCHED __builtin_amdgcn_sched_barrier(0)
    Unit cur, nxt; int ui = 0;
    if (!S.next(0, cur)) return;
    f32x4 acc[2][2][4][2];
#pragma unroll
    for (int a = 0; a < 2; ++a)
#pragma unroll
        for (int b = 0; b < 2; ++b)
#pragma unroll
            for (int m = 0; m < 4; ++m)
#pragma unroll
                for (int n = 0; n < 2; ++n) acc[a][b][m][n] = (f32x4){0.f, 0.f, 0.f, 0.f};
    bf16x8 At[4][2], B0[2][2], B1[2][2];
    const char* cA = (const char*)g.A + (size_t)cur.pm * tstep; const char* cB = (const char*)g.Bt + (size_t)cur.pn * tstep;
    S.a_ready(cur);
    if constexpr (SP2) {
        PG8_STAGE(PG8_SB(0, 0), cB, voffB); PG8_STAGE(PG8_SB(0, 1), cB + hstep, voffB); PG8_STAGE(PG8_SA(0, 0), cA, voffA); PG8_STAGE(PG8_SA(0, 1), cA + hstep, voffA);
        if (wr == 1) PG8_BAR;
        PG8_WAIT_V(2); PG8_BAR;
        PG8_STAGE(PG8_SB(1, 0), cB + kstep, voffB); PG8_STAGE(PG8_SA(1, 0), cA + kstep, voffA); PG8_STAGE(PG8_SB(1, 1), cB + hstep + kstep, voffB);
        PG8_WAIT_V(6); PG8_BAR;
    } else {
        PG8_STAGE(PG8_SB(0, 0), cB, voffB); PG8_STAGE(PG8_SA(0, 0), cA, voffA); PG8_STAGE(PG8_SB(0, 1), cB + hstep, voffB); PG8_STAGE(PG8_SA(0, 1), cA + hstep, voffA);
        if (wr == 1) PG8_BAR;
        PG8_WAIT_V(4); PG8_BAR;
        PG8_STAGE(PG8_SB(1, 0), cB + kstep, voffB); PG8_STAGE(PG8_SA(1, 0), cA + kstep, voffA); PG8_STAGE(PG8_SB(1, 1), cB + hstep + kstep, voffB);
        PG8_WAIT_V(6); PG8_BAR;
    }
    for (;;) {
        const bool has_next = S.next(ui + 1, nxt);
        const char* nA = has_next ? (const char*)g.A + (size_t)nxt.pm * tstep : cA; const char* nB = has_next ? (const char*)g.Bt + (size_t)nxt.pn * tstep : cB;
        for (int t = 0; t < nt; t += 2) {
            const bool last = (t == nt - 2);
            const char* a1 = cA + (size_t)(t + 1) * kstep;
            const char* a2 = last ? nA : cA + (size_t)(t + 2) * kstep; const char* b2 = last ? nB : cB + (size_t)(t + 2) * kstep;
            const char* a3 = a2 + kstep; const char* b3 = b2 + kstep;
            if (last && has_next) S.a_ready(nxt);
            if constexpr (SP2) {
            PG8_LDB(B0, 0, 0); PG8_LDB(B1, 0, 1); PG8_SCHED; PG8_LDA(At, 0, 0); PG8_STAGE(PG8_SA(1, 1), a1 + hstep, voffA);
            PG8_WAIT_V(8); PG8_WAIT_L(0); PG8_BAR; PG8_MMA(0, 0, At, B0); PG8_MMA(0, 1, At, B1); PG8_BAR; PG8_SCHED;
            PG8_LDA(At, 0, 1); PG8_STAGE(PG8_SB(0, 0), b2, voffB); PG8_STAGE(PG8_SB(0, 1), b2 + hstep, voffB); PG8_STAGE(PG8_SA(0, 0), a2, voffA);
            PG8_WAIT_V(8); PG8_WAIT_L(0); PG8_BAR; PG8_MMA(1, 0, At, B0); PG8_MMA(1, 1, At, B1); PG8_BAR; PG8_SCHED;
            PG8_LDB(B0, 1, 0); PG8_LDB(B1, 1, 1); PG8_SCHED; PG8_LDA(At, 1, 0); PG8_STAGE(PG8_SA(0, 1), a2 + hstep, voffA);
            PG8_WAIT_V(8); PG8_WAIT_L(0); PG8_BAR; PG8_MMA(0, 0, At, B0); PG8_MMA(0, 1, At, B1); PG8_BAR; PG8_SCHED;
            PG8_LDA(At, 1, 1); PG8_STAGE(PG8_SB(1, 0), b3, voffB); PG8_STAGE(PG8_SB(1, 1), b3 + hstep, voffB); PG8_STAGE(PG8_SA(1, 0), a3, voffA);
            PG8_WAIT_V(8); PG8_WAIT_L(0); PG8_BAR; PG8_MMA(1, 0, At, B0); PG8_MMA(1, 1, At, B1); PG8_BAR; PG8_SCHED;
            } else {
            PG8_LDB(B0, 0, 0); PG8_SCHED; PG8_LDA(At, 0, 0); PG8_STAGE(PG8_SA(1, 1), a1 + hstep, voffA);
            PG8_WAIT_L(8); PG8_BAR; PG8_WAIT_L(0); PG8_MMA(0, 0, At, B0); PG8_BAR; PG8_SCHED;
            PG8_LDB(B1, 0, 1); PG8_STAGE(PG8_SB(0, 0), b2, voffB);
            PG8_BAR; PG8_WAIT_L(0); PG8_MMA(0, 1, At, B1); PG8_BAR;
            PG8_LDA(At, 0, 1); PG8_STAGE(PG8_SA(0, 0), a2, voffA);
            PG8_BAR; PG8_WAIT_L(0); PG8_MMA(1, 0, At, B0); PG8_BAR; PG8_SCHED;
            PG8_STAGE(PG8_SB(0, 1), b2 + hstep, voffB);
            PG8_WAIT_V(6); PG8_BAR; PG8_MMA(1, 1, At, B1); PG8_BAR;
            PG8_LDB(B0, 1, 0); PG8_SCHED; PG8_LDA(At, 1, 0); PG8_STAGE(PG8_SA(0, 1), a2 + hstep, voffA);
            PG8_WAIT_L(8); PG8_BAR; PG8_WAIT_L(0); PG8_MMA(0, 0, At, B0); PG8_BAR; PG8_SCHED;
            PG8_LDB(B1, 1, 1); PG8_STAGE(PG8_SB(1, 0), b3, voffB);
            PG8_BAR; PG8_WAIT_L(0); PG8_MMA(0, 1, At, B1); PG8_BAR;
            PG8_LDA(At, 1, 1); PG8_STAGE(PG8_SA(1, 0), a3, voffA);
            PG8_BAR; PG8_WAIT_L(0); PG8_MMA(1, 0, At, B0); PG8_BAR; PG8_SCHED;
            PG8_STAGE(PG8_SB(1, 1), b3 + hstep, voffB);
            PG8_WAIT_V(6); PG8_BAR; PG8_MMA(1, 1, At, B1); PG8_BAR;
            }
        }
        if constexpr (ALIGN_EPI) { if (wr == 0) PG8_BAR; }
        if constexpr (!Epi::AFTER_DRAIN) { E(acc, cur, wr, wc, fr, fq); S.done(cur); }
        if (!has_next) break;
#pragma unroll
        for (int a = 0; a < 2; ++a)
#pragma unroll
            for (int b = 0; b < 2; ++b)
#pragma unroll
                for (int m = 0; m < 4; ++m)
#pragma unroll
                    for (int n = 0; n < 2; ++n) acc[a][b][m][n] = (f32x4){0.f, 0.f, 0.f, 0.f};
        cur = nxt; cA = nA; cB = nB; ++ui;
        if constexpr (ALIGN_EPI) { if (wr == 1) PG8_BAR; }
    }
    PG8_WAIT_V(0);
    if constexpr (!ALIGN_EPI) { if (wr == 0) PG8_BAR; }
    PG8_BAR;
    if constexpr (Epi::AFTER_DRAIN) { E.fused(acc, cur, wr, wc, fr, fq, lds, wid, lane); S.done(cur); }
#undef PG8_SA
#undef PG8_SB
#undef PG8_STAGE
#undef PG8_LDA
#undef PG8_LDB
#undef PG8_MMA
#undef PG8_WAIT_V
#undef PG8_WAIT_L
#undef PG8_BAR
#undef PG8_SCHED
}
}
#define GAS __attribute__((address_space(1)))
#define LAS __attribute__((address_space(3)))
typedef unsigned short bf16;
typedef unsigned v4u __attribute__((ext_vector_type(4)));
typedef unsigned v2u __attribute__((ext_vector_type(2)));
typedef float f32x4 __attribute__((ext_vector_type(4)));
constexpr int NWAVES = 8;
constexpr int LDS_BYTES = 147456, LDSCTL_OFF = 131072;
constexpr int CW_BAR = 4096;
constexpr size_t MiB = 1u << 20;
constexpr size_t WS_CTL = 0, CTL_BYTES = 1 * MiB;
constexpr size_t WS_SSQ_A = 256 * 1024, WS_SSQ_B = 320 * 1024, WS_SSQ_C = 384 * 1024, WS_SSQ_D = 448 * 1024;
constexpr size_t WS_STAMP = 128 * 1024;
constexpr size_t WS_BCTR = 192 * 1024;
constexpr size_t WS_SU = 512 * 1024, WS_SV = 768 * 1024;
constexpr size_t WS_WCS = 1 * MiB, WS_ROPE = 2 * MiB, WS_KEYS = 3 * MiB;
constexpr size_t WS_WOF = 8 * MiB, WS_WQKV = 16 * MiB, WS_WOA = 28 * MiB, WS_WQ0 = 36 * MiB, WS_WQ1 = 44 * MiB;
constexpr size_t WS_A2 = 64 * MiB, WS_TW = 65 * MiB;
constexpr size_t WS_U0 = 128 * MiB, WS_V0 = 192 * MiB, WS_U1 = 256 * MiB, WS_V1 = 320 * MiB;
constexpr size_t WS_XG = 384 * MiB, WS_XB = 384 * MiB;
constexpr size_t WS_ZT = 448 * MiB;
constexpr size_t WS_Y = 576 * MiB;
constexpr size_t WS_Q = 448 * MiB;
constexpr size_t WS_EI = 640 * MiB, WS_GW = 648 * MiB, WS_W1 = 656 * MiB, WS_X8 = 664 * MiB;
constexpr size_t WS_PD = 448 * MiB;
constexpr size_t WS_QB = 448 * MiB, WS_KB = 512 * MiB, WS_VT = 528 * MiB, WS_O = 576 * MiB;

__device__ __forceinline__ unsigned f2bf(float f) { unsigned u = __builtin_bit_cast(unsigned, f); return (u + 0x7fffu + ((u >> 16) & 1u)) >> 16; }
__device__ __forceinline__ unsigned pk2(float lo, float hi) { return f2bf(lo) | (f2bf(hi) << 16); }

struct Args { const float* in[12]; float* out; unsigned char* ws; int ph_lo, ph_hi; };

__device__ __forceinline__ int qkv_row(int n) { if (n >= 2560) return n; const int d = n & 63, pc = (d < 32) ? 2 * d : 2 * (d - 32) + 1; return (n & ~63) + pc; }
template <int MODE>
__device__ __forceinline__ void transpose_item(const float* W, int K, int N, const float* gain, bf16* WT, LAS float* scr, int item, int lane) {
    const int nblk = N / 32, kb = item / nblk, nb = item % nblk, k0 = 64 * kb, n0 = 32 * nb;
    float wv[32];
#pragma unroll
    for (int i = 0; i < 32; ++i) wv[i] = W[(size_t)(k0 + 2 * i + (lane >> 5)) * N + n0 + (lane & 31)];
#pragma unroll
    for (int i = 0; i < 32; ++i) { const int kk = 2 * i + (lane >> 5); float v = wv[i]; if (gain) v *= gain[k0 + kk]; scr[kk * 33 + (lane & 31)] = v; }
    asm volatile("s_waitcnt lgkmcnt(0)" ::: "memory");
    const int c = lane & 7;
#pragma unroll
    for (int j = 0; j < 4; ++j) { const int n = (lane >> 3) + 8 * j; const LAS float* s = scr + (8 * c) * 33 + n;
        v4u o; o.x = pk2(s[0 * 33], s[1 * 33]); o.y = pk2(s[2 * 33], s[3 * 33]); o.z = pk2(s[4 * 33], s[5 * 33]); o.w = pk2(s[6 * 33], s[7 * 33]);
        const int row = (MODE == 1) ? qkv_row(n0 + n) : (n0 + n);
        *(v4u*)(WT + (size_t)row * K + k0 + 8 * c) = o; }
    asm volatile("s_waitcnt lgkmcnt(0)" ::: "memory");
}
__device__ __forceinline__ float wsum(float v) {
#pragma unroll
    for (int o = 1; o < 64; o <<= 1) v += __shfl_xor(v, o);
    return v;
}
__device__ __forceinline__ void cvt_stream(const float* src, bf16* dst, size_t n8, size_t gtid, size_t ngt) {
    for (size_t i = gtid; i < n8; i += ngt) {
        const f32x4 a = *(const f32x4*)(src + i * 8), b = *(const f32x4*)(src + i * 8 + 4);
        v4u o; o.x = pk2(a[0], a[1]); o.y = pk2(a[2], a[3]); o.z = pk2(b[0], b[1]); o.w = pk2(b[2], b[3]);
        *(v4u*)(dst + i * 8) = o;
    }
}
__device__ __forceinline__ void cvt_stream8(const float* src, unsigned char* dst, size_t n16, size_t gtid, size_t ngt, float scale) {
    for (size_t i = gtid; i < n16; i += ngt) {
        v4u o;
#pragma unroll
        for (int q = 0; q < 4; ++q) { f32x4 a = *(const f32x4*)(src + i * 16 + 4 * q) * scale;
#pragma unroll
            for (int e = 0; e < 4; ++e) a[e] = fminf(fmaxf(a[e], -448.f), 448.f);
            int w = 0; w = __builtin_amdgcn_cvt_pk_fp8_f32(a[0], a[1], w, false); w = __builtin_amdgcn_cvt_pk_fp8_f32(a[2], a[3], w, true); o[q] = (unsigned)w; }
        const size_t e = i >> 7, r = i & 127, sl = r >> 3, c8 = r & 7;
        *(v4u*)(dst + ((sl * 16384 + e) * 128 + c8 * 16)) = o;
    }
}
#define XB_TMO      128
#define XB_XCNT(j)  (256  + 64 * (j))
#define XB_XSUB(j)  (1280 + 64 * (j))
#define XB_XGEN(j)  (2304 + 64 * (j))
#define XB_TOP      3328
#define XB_TOPGEN   3392
#define XCD_BAR_WORDS 3456
#define XB_SPIN_CAP (1u << 18)

__device__ __forceinline__ unsigned xb_ld(unsigned* p)              { return __hip_atomic_load(p, __ATOMIC_RELAXED, __HIP_MEMORY_SCOPE_AGENT); }
__device__ __forceinline__ unsigned xb_add(unsigned* p, unsigned v) { return __hip_atomic_fetch_add(p, v, __ATOMIC_RELAXED, __HIP_MEMORY_SCOPE_AGENT); }
__device__ __forceinline__ unsigned xb_xcc_id() { return (unsigned)__builtin_amdgcn_s_getreg((3 << 11) | 20) & 0xFu; }
#define XB_SPIN(cond, bar) do { unsigned _sp = 0; while (cond) { __builtin_amdgcn_s_sleep(1); \
    if ((++_sp & 255u) == 0u) { if (xb_ld(&(bar)[XB_TMO])) break; if (_sp > XB_SPIN_CAP) { atomicAdd(&(bar)[XB_TMO], 1u); break; } } } } while (0)

struct XcdBarrier {
    unsigned* bar; unsigned x;
    volatile LAS unsigned* st;
};

__device__ __forceinline__ XcdBarrier xcd_barrier_post(unsigned* bar, volatile LAS unsigned* st) {
    XcdBarrier b; b.bar = bar; b.x = xb_xcc_id(); b.st = st;
    if (threadIdx.x == 0) (void)xb_add(&bar[XB_XCNT(b.x)], 1u);
    return b;
}
__device__ __forceinline__ void xcd_barrier_complete(unsigned* bar, unsigned x, unsigned& nloc, unsigned& nx) {
    const unsigned G = gridDim.x * gridDim.y * gridDim.z;
    unsigned sum, cnt, mine, sp = 0u;
    for (;;) {
        sum = 0u; cnt = 0u; mine = 0u;
#pragma unroll
        for (unsigned j = 0; j < 16; ++j) { const unsigned c = xb_ld(&bar[XB_XCNT(j)]); sum += c; cnt += (c > 0u) ? 1u : 0u; mine = (j == x) ? c : mine; }
        if (sum == G) break;
        __builtin_amdgcn_s_sleep(1);
        if ((++sp & 255u) == 0u) { if (xb_ld(&bar[XB_TMO])) break; if (sp > XB_SPIN_CAP) { atomicAdd(&bar[XB_TMO], 1u); break; } }
    }
    nloc = mine > 0u ? mine : 1u; nx = cnt > 0u ? cnt : 1u;
}

__device__ __forceinline__ void xcd_barrier(const XcdBarrier& b) {
    asm volatile("s_waitcnt vmcnt(0)" ::: "memory");
    __syncthreads();
    if (threadIdx.x == 0) {
        unsigned* bar = b.bar;
        __builtin_amdgcn_s_waitcnt(0);
        unsigned nloc = b.st[0], nx = b.st[1];
        if (nloc == 0u) { xcd_barrier_complete(bar, b.x, nloc, nx); b.st[0] = nloc; b.st[1] = nx; }
        const unsigned old = xb_add(&bar[XB_XSUB(b.x)], 1u);
        const unsigned gen = old / nloc;
        if (old + 1u == (gen + 1u) * nloc) {
            __builtin_amdgcn_fence(__ATOMIC_RELEASE, "agent");
            asm volatile("s_waitcnt vmcnt(0)" ::: "memory");
            const unsigned og = xb_add(&bar[XB_TOP], 1u);
            const unsigned tg = og / nx;
            if (og + 1u == (tg + 1u) * nx) xb_add(&bar[XB_TOPGEN], 1u);
            else XB_SPIN(xb_ld(&bar[XB_TOPGEN]) == tg, bar);
            __builtin_amdgcn_fence(__ATOMIC_ACQUIRE, "agent");
            xb_add(&bar[XB_XGEN(b.x)], 1u);
            asm volatile("s_waitcnt vmcnt(0)" ::: "memory");
        } else {
            XB_SPIN(xb_ld(&bar[XB_XGEN(b.x)]) == gen, bar);
            __builtin_amdgcn_fence(__ATOMIC_ACQUIRE, "agent");
            asm volatile("s_waitcnt vmcnt(0)" ::: "memory");
        }
    }
    __syncthreads();
}
#define U_SCALE 1024.f
#define V_SCALE 256.f
typedef float f32x16 __attribute__((ext_vector_type(16)));
#ifndef TKB
#define TKB 2
#endif
typedef short s16x8 __attribute__((ext_vector_type(8)));
typedef __bf16 bf16x2_t __attribute__((ext_vector_type(2)));
__device__ __forceinline__ unsigned ordf(float f) { const unsigned u = __float_as_uint(f); return (u & 0x80000000u) ? ~u : (u | 0x80000000u); }
__device__ __forceinline__ float unordf(unsigned u) { return __uint_as_float((u & 0x80000000u) ? (u & 0x7fffffffu) : ~u); }
__device__ __forceinline__ unsigned umax_(unsigned a, unsigned b) { return a > b ? a : b; }
#define DPPU(v, ctrl) ((unsigned)__builtin_amdgcn_update_dpp(0, (int)(v), (ctrl), 0xf, 0xf, true))
#define DPPF(v, ctrl) __int_as_float(__builtin_amdgcn_update_dpp(0, __float_as_int(v), (ctrl), 0xf, 0xf, true))
__device__ __forceinline__ unsigned max32(unsigned v) {
    v = umax_(v, DPPU(v, 0xB1)); v = umax_(v, DPPU(v, 0x4E)); v = umax_(v, DPPU(v, 0x141)); v = umax_(v, DPPU(v, 0x140));
    const auto r = __builtin_amdgcn_permlane16_swap(v, v, false, false);
    return umax_(r[0], r[1]);
}
__device__ __forceinline__ float sum16(float v) {
    v += DPPF(v, 0xB1); v += DPPF(v, 0x4E); v += DPPF(v, 0x141); v += DPPF(v, 0x140); return v;
}
__device__ __forceinline__ unsigned bperm(unsigned v, int srclane) { return (unsigned)__builtin_amdgcn_ds_bpermute(srclane << 2, (int)v); }
#define CMPX(a_, b_) do { const unsigned hi_ = umax_(a_, b_), lo_ = (a_ < b_) ? a_ : b_; a_ = hi_; b_ = lo_; } while (0)
__device__ __forceinline__ unsigned max16(unsigned v) { v = umax_(v, DPPU(v, 0xB1)); v = umax_(v, DPPU(v, 0x4E)); v = umax_(v, DPPU(v, 0x141)); v = umax_(v, DPPU(v, 0x140)); return v; }
__device__ __forceinline__ unsigned top16_of8(unsigned (&p)[8], int c) {
    CMPX(p[0], p[1]); CMPX(p[2], p[3]); CMPX(p[4], p[5]); CMPX(p[6], p[7]);
    CMPX(p[0], p[2]); CMPX(p[1], p[3]); CMPX(p[4], p[6]); CMPX(p[5], p[7]);
    CMPX(p[1], p[2]); CMPX(p[5], p[6]); CMPX(p[0], p[4]); CMPX(p[3], p[7]);
    CMPX(p[1], p[5]); CMPX(p[2], p[6]);
    CMPX(p[1], p[4]); CMPX(p[3], p[6]);
    CMPX(p[2], p[4]); CMPX(p[3], p[5]);
    CMPX(p[3], p[4]);
    unsigned W = 0u;
    for (int it = 0; it < 16; ++it) {
        const unsigned m = max16(p[0]);
        W = (c == it) ? m : W;
        const bool win = (p[0] == m);
#pragma unroll
        for (int i = 0; i < 7; ++i) p[i] = win ? p[i + 1] : p[i];
        p[7] = win ? 0u : p[7];
    }
    return W;
}
#define SORT8(p) do { CMPX(p[0], p[1]); CMPX(p[2], p[3]); CMPX(p[4], p[5]); CMPX(p[6], p[7]); CMPX(p[0], p[2]); CMPX(p[1], p[3]); CMPX(p[4], p[6]); CMPX(p[5], p[7]); \
    CMPX(p[1], p[2]); CMPX(p[5], p[6]); CMPX(p[0], p[4]); CMPX(p[3], p[7]); CMPX(p[1], p[5]); CMPX(p[2], p[6]); CMPX(p[1], p[4]); CMPX(p[3], p[6]); CMPX(p[2], p[4]); CMPX(p[3], p[5]); CMPX(p[3], p[4]); } while (0)
__device__ __forceinline__ void top16_of8x2(unsigned (&p)[8], unsigned (&q)[8], int c, unsigned& Wp, unsigned& Wq) {
    SORT8(p); SORT8(q);
    unsigned W0 = 0u, W1 = 0u;
    for (int it = 0; it < 16; ++it) {
        unsigned m0 = umax_(p[0], DPPU(p[0], 0xB1)), m1 = umax_(q[0], DPPU(q[0], 0xB1));
        m0 = umax_(m0, DPPU(m0, 0x4E)); m1 = umax_(m1, DPPU(m1, 0x4E));
        m0 = umax_(m0, DPPU(m0, 0x141)); m1 = umax_(m1, DPPU(m1, 0x141));
        m0 = umax_(m0, DPPU(m0, 0x140)); m1 = umax_(m1, DPPU(m1, 0x140));
        W0 = (c == it) ? m0 : W0; W1 = (c == it) ? m1 : W1;
        const bool w0 = (p[0] == m0), w1 = (q[0] == m1);
#pragma unroll
        for (int i = 0; i < 7; ++i) { p[i] = w0 ? p[i + 1] : p[i]; q[i] = w1 ? q[i + 1] : q[i]; }
        p[7] = w0 ? 0u : p[7]; q[7] = w1 ? 0u : q[7];
    }
    Wp = W0; Wq = W1;
}
__device__ __forceinline__ void top16_of4rx2(unsigned (&p)[4], unsigned (&q)[4], int c, unsigned& Wp, unsigned& Wq) {
    CMPX(p[0], p[1]); CMPX(p[2], p[3]); CMPX(p[0], p[2]); CMPX(p[1], p[3]); CMPX(p[1], p[2]);
    CMPX(q[0], q[1]); CMPX(q[2], q[3]); CMPX(q[0], q[2]); CMPX(q[1], q[3]); CMPX(q[1], q[2]);
    unsigned W0 = 0u, W1 = 0u;
    for (int it = 0; it < 16; ++it) {
        unsigned m0 = umax_(p[0], DPPU(p[0], 0xB1)), m1 = umax_(q[0], DPPU(q[0], 0xB1));
        m0 = umax_(m0, DPPU(m0, 0x4E)); m1 = umax_(m1, DPPU(m1, 0x4E));
        m0 = umax_(m0, DPPU(m0, 0x141)); m1 = umax_(m1, DPPU(m1, 0x141));
        m0 = umax_(m0, DPPU(m0, 0x140)); m1 = umax_(m1, DPPU(m1, 0x140));
        W0 = (c == it) ? m0 : W0; W1 = (c == it) ? m1 : W1;
        const bool w0 = (p[0] == m0), w1 = (q[0] == m1);
        p[0] = w0 ? p[1] : p[0]; p[1] = w0 ? p[2] : p[1]; p[2] = w0 ? p[3] : p[2]; p[3] = w0 ? 0u : p[3];
        q[0] = w1 ? q[1] : q[0]; q[1] = w1 ? q[2] : q[1]; q[2] = w1 ? q[3] : q[2]; q[3] = w1 ? 0u : q[3];
    }
    Wp = W0; Wq = W1;
}
__device__ __forceinline__ unsigned top16_of4r(unsigned (&p)[4], int c) {
    CMPX(p[0], p[1]); CMPX(p[2], p[3]); CMPX(p[0], p[2]); CMPX(p[1], p[3]); CMPX(p[1], p[2]);
    unsigned W = 0u;
    for (int it = 0; it < 16; ++it) {
        const unsigned m = max16(p[0]);
        W = (c == it) ? m : W;
        const bool win = (p[0] == m);
        p[0] = win ? p[1] : p[0]; p[1] = win ? p[2] : p[1]; p[2] = win ? p[3] : p[2]; p[3] = win ? 0u : p[3];
    }
    return W;
}
__device__ __forceinline__ void topk_fill(LAS unsigned char* lds, const bf16* keys, int h, int tid) {
#pragma unroll
    for (int i = 0; i < 8; ++i) { const int idx = tid + 512 * i, p = idx >> 11, key = (idx >> 4) & 127, ch = idx & 15;
        const v4u v = *(const v4u*)(keys + (size_t)((h * 2 + p) * 128 + key) * 128 + ch * 8);
        *(LAS v4u*)(lds + p * 32768 + key * 256 + ((ch ^ (key & 15)) << 4)) = v; }
}
struct CvtCtx { const float* srcU; long dsrc; const float* gain; unsigned char* dstU; long ddst; float* su; long dsc; int gwave, nw; };
__device__ __forceinline__ void cvt_chunk_load(const CvtCtx& cx, int c, int lane, f32x4 (&v)[4]) {
    const int r = c >> 1, hh = c & 1;
    const float* src = cx.srcU + ((r < 16384) ? 0L : cx.dsrc) + (size_t)(r & 16383) * 2048 + hh * 1024 + 4 * lane;
#pragma unroll
    for (int j = 0; j < 4; ++j) v[j] = *(const f32x4*)(src + 256 * j);
}
__device__ __forceinline__ void cvt_chunk_store(const CvtCtx& cx, int c, int lane, f32x4 (&v)[4]) {
    const int r = c >> 1, hh = c & 1; const bool isu = r < 16384; const int e = r & 16383;
    float mx = 0.f;
#pragma unroll
    for (int j = 0; j < 4; ++j) { if (isu) v[j] = v[j] * *(const f32x4*)(cx.gain + hh * 1024 + 256 * j + 4 * lane);
        mx = fmaxf(mx, fmaxf(fmaxf(fabsf(v[j][0]), fabsf(v[j][1])), fmaxf(fabsf(v[j][2]), fabsf(v[j][3])))); }
    mx = fmaxf(mx, DPPF(mx, 0xB1)); mx = fmaxf(mx, DPPF(mx, 0x4E)); mx = fmaxf(mx, DPPF(mx, 0x141)); mx = fmaxf(mx, DPPF(mx, 0x140));
    { const auto rr = __builtin_amdgcn_permlane16_swap(__float_as_uint(mx), __float_as_uint(mx), false, false); mx = fmaxf(__uint_as_float(rr[0]), __uint_as_float(rr[1])); }
    { const auto rr = __builtin_amdgcn_permlane32_swap(__float_as_uint(mx), __float_as_uint(mx), false, false); mx = fmaxf(__uint_as_float(rr[0]), __uint_as_float(rr[1])); }
    const float sc = fmaxf(mx, 1e-30f) * (1.f / 6.f), inv = 1.f / sc;
    if (lane == 0) (cx.su + (isu ? 0L : cx.dsc))[e * 2 + hh] = sc;
    unsigned char* dst = cx.dstU + (isu ? 0L : cx.ddst) + ((size_t)(hh * 4) * 16384 + e) * 128 + 2 * lane;
#pragma unroll
    for (int j = 0; j < 4; ++j) { unsigned w = 0u;
        w = __builtin_amdgcn_cvt_scalef32_pk_fp4_f32(w, v[j][0] * inv, v[j][1] * inv, 1.0f, 0); w = __builtin_amdgcn_cvt_scalef32_pk_fp4_f32(w, v[j][2] * inv, v[j][3] * inv, 1.0f, 1);
        *(unsigned short*)(dst + (size_t)j * (16384 * 128)) = (unsigned short)w; }
}
__device__ __forceinline__ void topk_unit(const bf16* q, LAS const unsigned char* lds, int* EI, float* GW, int t0, int h, int lane) {
    const int c = lane & 15, g4 = lane >> 4, rbase = lane & 48;
    int f0 = 0, f1 = 0, f2 = 0, f3 = 0;
    { int cnt = 0;
#pragma unroll
      for (int i = 0; i < 16; ++i)
#pragma unroll
        for (int j = 0; j < 16; ++j) if ((i + 1) * (j + 1) <= 16) { const int fl = i * 16 + j; f0 = (cnt == c) ? fl : f0; f1 = (cnt == c + 16) ? fl : f1; f2 = (cnt == c + 32) ? fl : f2; f3 = (cnt == c + 48) ? fl : f3; ++cnt; } }
    unsigned W[2][8];
#pragma unroll
    for (int p = 0; p < 2; ++p) {
        f32x4 acc[2][8];
#pragma unroll
        for (int mb = 0; mb < 2; ++mb)
#pragma unroll
            for (int kb = 0; kb < 8; ++kb) acc[mb][kb] = (f32x4){0.f, 0.f, 0.f, 0.f};
        const bf16* qp = q + (size_t)(t0 + c) * 2048 + h * 256 + p * 128 + g4 * 8;
        LAS const unsigned char* kp = lds + p * 32768 + c * 256;
        asm volatile("" : "+v"(qp));
#pragma unroll 2
        for (int ks = 0; ks < 4; ++ks) {
            const s16x8 a0 = *(const s16x8*)(qp + ks * 32), a1 = *(const s16x8*)(qp + (size_t)16 * 2048 + ks * 32);
#pragma unroll
            for (int kb = 0; kb < 8; ++kb) { const s16x8 b = *(LAS const s16x8*)(kp + kb * 4096 + (((4 * ks + g4) ^ c) << 4));
                acc[0][kb] = __builtin_amdgcn_mfma_f32_16x16x32_bf16(a0, b, acc[0][kb], 0, 0, 0); acc[1][kb] = __builtin_amdgcn_mfma_f32_16x16x32_bf16(a1, b, acc[1][kb], 0, 0, 0); }
        }
#pragma unroll
        for (int pb = 0; pb < 8; pb += 2) {
            unsigned pk[8], pq[8];
#pragma unroll
            for (int kb = 0; kb < 8; ++kb) { pk[kb] = (ordf(acc[pb >> 2][kb][pb & 3]) & ~127u) | (unsigned)(127 - 16 * kb - c); pq[kb] = (ordf(acc[(pb + 1) >> 2][kb][(pb + 1) & 3]) & ~127u) | (unsigned)(127 - 16 * kb - c); }
            top16_of8x2(pk, pq, c, W[p][pb], W[p][pb + 1]);
        }
    }
#define TK_CAND(CP, w0_, w1_) do { \
        { const float a0 = unordf(bperm(w0_, rbase + (f0 >> 4)) & ~127u), b0 = unordf(bperm(w1_, rbase + (f0 & 15)) & ~127u); CP[0] = (ordf(a0 + b0) & ~63u) | (unsigned)(63 - c); } \
        { const float a0 = unordf(bperm(w0_, rbase + (f1 >> 4)) & ~127u), b0 = unordf(bperm(w1_, rbase + (f1 & 15)) & ~127u); CP[1] = (ordf(a0 + b0) & ~63u) | (unsigned)(47 - c); } \
        { const float a0 = unordf(bperm(w0_, rbase + (f2 >> 4)) & ~127u), b0 = unordf(bperm(w1_, rbase + (f2 & 15)) & ~127u); CP[2] = (ordf(a0 + b0) & ~63u) | (unsigned)(31 - c); } \
        { const float a0 = unordf(bperm(w0_, rbase + (f3 >> 4)) & ~127u), b0 = unordf(bperm(w1_, rbase + (f3 & 15)) & ~127u); CP[3] = (c + 48 < 50) ? ((ordf(a0 + b0) & ~63u) | (unsigned)(15 - c)) : 0u; } } while (0)
#define TK_FINISH(Wc_, w0_, w1_, pb_) do { \
        const int slot = 63 - (int)((Wc_) & 63u); \
        const unsigned fa = bperm((unsigned)f0, rbase + (slot & 15)), fb = bperm((unsigned)f1, rbase + (slot & 15)), fc = bperm((unsigned)f2, rbase + (slot & 15)), fd = bperm((unsigned)f3, rbase + (slot & 15)); \
        const int sq = slot >> 4; const int flat = (int)((sq == 0) ? fa : (sq == 1) ? fb : (sq == 2) ? fc : fd); \
        const float val = unordf((Wc_) & ~63u); \
        const float vmax = __uint_as_float(bperm(__float_as_uint(val), rbase)); \
        const float e = __expf(val - vmax); \
        const float g = e / sum16(e); \
        const int k1 = 127 - (int)(bperm(w0_, rbase + (flat >> 4)) & 127u), k2 = 127 - (int)(bperm(w1_, rbase + (flat & 15)) & 127u); \
        const int tok = t0 + 16 * ((pb_) >> 2) + 4 * g4 + ((pb_) & 3); \
        EI[(size_t)(tok * 8 + h) * 16 + c] = k1 * 128 + k2; GW[(size_t)(tok * 8 + h) * 16 + c] = g; } while (0)
#pragma unroll
    for (int pb = 0; pb < 8; pb += 2) {
        const unsigned w0a = W[0][pb], w1a = W[1][pb], w0b = W[0][pb + 1], w1b = W[1][pb + 1];
        unsigned cpa[4], cpb[4], Wca, Wcb;
        TK_CAND(cpa, w0a, w1a); TK_CAND(cpb, w0b, w1b);
        top16_of4rx2(cpa, cpb, c, Wca, Wcb);
        TK_FINISH(Wca, w0a, w1a, pb); TK_FINISH(Wcb, w0b, w1b, pb + 1);
    }
#undef TK_CAND
#undef TK_FINISH
}

__device__ __forceinline__ float gelu_tanh_f(float x) {
    const float u = 0.7978845608028654f * (x + 0.044715f * x * x * x);
    const float e = __expf(2.f * u);
    const float th = 1.f - 2.f / (e + 1.f);
    return 0.5f * x * (1.f + th);
}
__device__ __forceinline__ float wave_sum_bfly(float v) {
#pragma unroll
    for (int o = 1; o < 64; o <<= 1) v += __shfl_xor(v, o);
    return v;
}
typedef float f32x2_ __attribute__((ext_vector_type(2)));
#define FP4_DEC(w_, sel_) __builtin_amdgcn_cvt_scalef32_pk_f32_fp4((unsigned)(w_), 1.0f, (sel_))
typedef int i32x8 __attribute__((ext_vector_type(8)));
template <int NBT>
__device__ __forceinline__ void peer_a_slice(const unsigned char* x8, const int* EI, const unsigned char* U4s, float* pd, int s, unsigned* ctr, int nbatch, int lane) {
    const int c = lane & 15, g4 = lane >> 4, k8 = c >> 1;
    const __amdgpu_buffer_rsrc_t trs = __builtin_amdgcn_make_buffer_rsrc((void*)(U4s + (size_t)s * (16384 * 128)), (short)0, 16384 * 128, 0x00020000);
    const unsigned choff = (unsigned)((4 * (c & 1) + g4) * 16);
#define A_FETCH() ((int)__builtin_amdgcn_readfirstlane((int)((lane == 0) ? __hip_atomic_fetch_add(ctr, 1u, __ATOMIC_RELAXED, __HIP_MEMORY_SCOPE_AGENT) : 0u)))
#define A_TOKB(b_, j_) ((((b_) < nbatch) ? (b_) : (nbatch - 1)) * NBT + (j_))
#define A_XS(XS, t_) do { const unsigned char* xp_ = x8 + (size_t)(t_) * 2048 + s * 256 + 128 * (c & 1) + 16 * g4; XS[0] = *(const v4u*)xp_; XS[1] = *(const v4u*)(xp_ + 64); } while (0)
#define A_ISSUE(U, EV) do { _Pragma("unroll") for (int i = 0; i < 8; ++i) { const unsigned e_ = bperm((unsigned)(EV), (i << 3) + k8); U[i] = __builtin_amdgcn_raw_buffer_load_b128(trs, (int)((e_ << 7) | choff), 0, 0); } } while (0)
#define A_COMPUTE(U, OUT) do { _Pragma("unroll") for (int i = 0; i < 8; ++i) { f32x4 d_ = (f32x4){0.f, 0.f, 0.f, 0.f}; \
            d_ = __builtin_amdgcn_mfma_scale_f32_16x16x128_f8f6f4((i32x8){(int)U[i][0], (int)U[i][1], (int)U[i][2], (int)U[i][3], 0, 0, 0, 0}, hb, d_, 4, 0, 0, 0x7f7f7f7f, 0, 0x7f7f7f7f); \
            const float o0_ = d_[0] + DPPF(d_[1], 0xB1), o1_ = d_[2] + DPPF(d_[3], 0xB1);        \
            if (k8 == i) OUT = (f32x2_){o0_, o1_}; } } while (0)
    int eL[NBT], eH[NBT], nL[NBT], nH[NBT]; v4u xs[2][2]; v4u UA[8], UB[8];
    int b0 = A_FETCH(), b1 = A_FETCH();
    if (b0 >= nbatch) return;
#pragma unroll
    for (int j = 0; j < NBT; ++j) { const int tj = A_TOKB(b0, j); eL[j] = EI[(size_t)tj * 128 + lane]; eH[j] = EI[(size_t)tj * 128 + 64 + lane]; }
    A_XS(xs[0], A_TOKB(b0, 0));
    A_ISSUE(UA, eL[0]);
    while (b0 < nbatch) {
        const int b2 = A_FETCH();
#pragma unroll
        for (int j = 0; j < NBT; ++j) { const int tj = A_TOKB(b1, j); nL[j] = EI[(size_t)tj * 128 + lane]; nH[j] = EI[(size_t)tj * 128 + 64 + lane]; }
#pragma unroll
        for (int j = 0; j < NBT; ++j) {
            const int t = b0 * NBT + j;
            A_ISSUE(UB, eH[j]);
            const i32x8 hb = (i32x8){(int)xs[j & 1][0][0], (int)xs[j & 1][0][1], (int)xs[j & 1][0][2], (int)xs[j & 1][0][3], (int)xs[j & 1][1][0], (int)xs[j & 1][1][1], (int)xs[j & 1][1][2], (int)xs[j & 1][1][3]};
            f32x2_ out_lo = (f32x2_){0.f, 0.f}, out_hi = (f32x2_){0.f, 0.f};
            A_COMPUTE(UA, out_lo);
            A_XS(xs[(j + 1) & 1], (j + 1 < NBT) ? (b0 * NBT + j + 1) : A_TOKB(b1, 0));
            A_ISSUE(UA, (j + 1 < NBT) ? eL[(j + 1) % NBT] : nL[0]);
            A_COMPUTE(UB, out_hi);
            if ((c & 1) == 0) { float* pp = pd + ((size_t)s * T + t) * 128 + 8 * k8 + 2 * g4; *(f32x2_*)pp = out_lo; *(f32x2_*)(pp + 64) = out_hi; }
        }
#pragma unroll
        for (int j = 0; j < NBT; ++j) { eL[j] = nL[j]; eH[j] = nH[j]; }
        b0 = b1; b1 = b2;
    }
#undef A_FETCH
#undef A_TOKB
#undef A_XS
#undef A_ISSUE
#undef A_COMPUTE
}
__device__ __forceinline__ unsigned w8rep(float w) { const float s = fminf(fmaxf(w * 256.f, -448.f), 448.f); return ((unsigned)__builtin_amdgcn_cvt_pk_fp8_f32(s, 0.f, 0, false) & 0xffu) * 0x01010101u; }
__device__ __forceinline__ void peer_a2_token(const float* pd, const float* ssq, const int* EI, const float* su, const float* sv, float* GW, float* W1, int t, int lane) {
    float a0 = 0.f, a1 = 0.f, b0 = 0.f, b1 = 0.f;
#pragma unroll
    for (int s = 0; s < 4; ++s) { const float* pp = pd + ((size_t)s * T + t) * 128; a0 += pp[lane]; a1 += pp[64 + lane]; }
#pragma unroll
    for (int s = 4; s < 8; ++s) { const float* pp = pd + ((size_t)s * T + t) * 128; b0 += pp[lane]; b1 += pp[64 + lane]; }
    const float rs = rsqrtf(ssq[t] * (1.f / 2048.f) + EPS);
    float* gp = GW + (size_t)t * 128; float* hp = W1 + (size_t)t * 128; const int pl = lane;
    const int e0 = EI[(size_t)t * 128 + pl], e1 = EI[(size_t)t * 128 + 64 + pl];
    const float g0 = gp[pl] * gelu_tanh_f(rs * (a0 * su[2 * e0] + b0 * su[2 * e0 + 1])), g1 = gp[64 + pl] * gelu_tanh_f(rs * (a1 * su[2 * e1] + b1 * su[2 * e1 + 1]));
    unsigned* gu = (unsigned*)gp; unsigned* hu = (unsigned*)hp;
    gu[pl] = w8rep(g0 * sv[2 * e0]); hu[pl] = w8rep(g0 * sv[2 * e0 + 1]);
    gu[64 + pl] = w8rep(g1 * sv[2 * e1]); hu[64 + pl] = w8rep(g1 * sv[2 * e1 + 1]);
}
template <int NBT>
__device__ __forceinline__ void peer_b_slice(const bf16* xres, float* xio, const int* EI, const unsigned* W, const unsigned char* V4s, bf16* xb, float* ssq_out, int s, unsigned* ctr, int nbatch, int lane) {
    const int j16 = lane & 15, g4 = lane >> 4;
    const __amdgpu_buffer_rsrc_t trs = __builtin_amdgcn_make_buffer_rsrc((void*)(V4s + (size_t)s * (16384 * 128)), (short)0, 16384 * 128, 0x00020000);
    const unsigned choff = (unsigned)(8 * j16);
    const int doff = s * 256 + 64 * g4 + j16;
    const unsigned bm = 0xffu << (8 * (j16 & 3)); const unsigned M0 = ((j16 >> 2) == 0) ? bm : 0u, M1 = ((j16 >> 2) == 1) ? bm : 0u, M2 = ((j16 >> 2) == 2) ? bm : 0u, M3 = ((j16 >> 2) == 3) ? bm : 0u;
#define B_FETCH() ((int)__builtin_amdgcn_readfirstlane((int)((lane == 0) ? __hip_atomic_fetch_add(ctr, 1u, __ATOMIC_RELAXED, __HIP_MEMORY_SCOPE_AGENT) : 0u)))
#define B_TOKB(b_, j_) ((((b_) < nbatch) ? (b_) : (nbatch - 1)) * NBT + (j_))
#define B_ISSUE(V, EV) do { _Pragma("unroll") for (int i = 0; i < 8; ++i) { const unsigned e0_ = bperm((unsigned)(EV), 8 * i + 2 * g4), e1_ = bperm((unsigned)(EV), 8 * i + 2 * g4 + 1); \
        V[2 * i] = __builtin_amdgcn_raw_buffer_load_b64(trs, (int)((e0_ << 7) | choff), 0, 0); V[2 * i + 1] = __builtin_amdgcn_raw_buffer_load_b64(trs, (int)((e1_ << 7) | choff), 0, 0); } } while (0)
#define B_COMPUTE(V, WV) do { _Pragma("unroll") for (int i = 0; i < 8; ++i) { \
            const unsigned f0_ = bperm((WV), 8 * i + g4), f1_ = bperm((WV), 8 * i + 4 + g4);        \
            const i32x8 bq_ = (i32x8){(int)(f0_ & M0), (int)(f0_ & M1), (int)(f0_ & M2), (int)(f0_ & M3), (int)(f1_ & M0), (int)(f1_ & M1), (int)(f1_ & M2), (int)(f1_ & M3)}; \
            acc = __builtin_amdgcn_mfma_scale_f32_16x16x128_f8f6f4((i32x8){(int)V[2 * i][0], (int)V[2 * i][1], (int)V[2 * i + 1][0], (int)V[2 * i + 1][1], 0, 0, 0, 0}, bq_, acc, 4, 0, 0, 0x7f7f7f7f, 0, 0x77777777); } } while (0)
    int eL[NBT], eH[NBT], nL[NBT], nH[NBT]; unsigned wL[NBT], wH[NBT], mL[NBT], mH[NBT]; float xv[4]; v2u VA[16], VB[16];
    int b0 = B_FETCH(), b1 = B_FETCH();
    if (b0 >= nbatch) return;
#pragma unroll
    for (int j = 0; j < NBT; ++j) { const int tj = B_TOKB(b0, j); eL[j] = EI[(size_t)tj * 128 + lane]; eH[j] = EI[(size_t)tj * 128 + 64 + lane]; wL[j] = W[(size_t)tj * 128 + lane]; wH[j] = W[(size_t)tj * 128 + 64 + lane]; }
    B_ISSUE(VA, eL[0]);
    while (b0 < nbatch) {
        const int b2 = B_FETCH();
#pragma unroll
        for (int j = 0; j < NBT; ++j) { const int tj = B_TOKB(b1, j); nL[j] = EI[(size_t)tj * 128 + lane]; nH[j] = EI[(size_t)tj * 128 + 64 + lane]; mL[j] = W[(size_t)tj * 128 + lane]; mH[j] = W[(size_t)tj * 128 + 64 + lane]; }
#pragma unroll
        for (int j = 0; j < NBT; ++j) {
            const int t = b0 * NBT + j;
            float* xp = xio + (size_t)t * 2048 + doff; const bf16* rp = xres + (size_t)t * 2048 + doff;
#pragma unroll
            for (int r = 0; r < 4; ++r) xv[r] = __uint_as_float((unsigned)rp[16 * r] << 16);
            B_ISSUE(VB, eH[j]);
            f32x4 acc = (f32x4){0.f, 0.f, 0.f, 0.f};
            B_COMPUTE(VA, wL[j]);
            B_ISSUE(VA, (j + 1 < NBT) ? eL[(j + 1) % NBT] : nL[0]);
            B_COMPUTE(VB, wH[j]);
            float ss = 0.f;
#pragma unroll
            for (int r = 0; r < 4; ++r) { const float o = xv[r] + acc[r]; ss += o * o; if (xb) xb[(size_t)t * 2048 + doff + 16 * r] = (bf16)f2bf(o); else xp[16 * r] = o; }
            ss += DPPF(ss, 0xB1); ss += DPPF(ss, 0x4E); ss += DPPF(ss, 0x141); ss += DPPF(ss, 0x140);
            { const auto r = __builtin_amdgcn_permlane16_swap(__float_as_uint(ss), __float_as_uint(ss), false, false); ss = __uint_as_float(r[0]) + __uint_as_float(r[1]); }
            { const auto r = __builtin_amdgcn_permlane32_swap(__float_as_uint(ss), __float_as_uint(ss), false, false); ss = __uint_as_float(r[0]) + __uint_as_float(r[1]); }
            if (lane == 0) unsafeAtomicAdd(ssq_out + t, ss);
        }
#pragma unroll
        for (int j = 0; j < NBT; ++j) { eL[j] = nL[j]; eH[j] = nH[j]; wL[j] = mL[j]; wH[j] = mH[j]; }
        b0 = b1; b1 = b2;
    }
#undef B_FETCH
#undef B_TOKB
#undef B_ISSUE
#undef B_COMPUTE
}
__device__ __forceinline__ void final_norm_row(float* xio, const float* ssq, const float* fin, int t, int lane, float oscale) {
    const float r2 = rsqrtf(ssq[t] * (1.f / 2048.f) + EPS) * oscale;
    float* xr = xio + (size_t)t * 2048 + 4 * lane;
#pragma unroll
    for (int j = 0; j < 8; ++j) { const f32x4 xv = *(const f32x4*)(xr + 256 * j), g = *(const f32x4*)(fin + 256 * j + 4 * lane); f32x4 o;
        o[0] = xv[0] * r2 * g[0]; o[1] = xv[1] * r2 * g[1]; o[2] = xv[2] * r2 * g[2]; o[3] = xv[3] * r2 * g[3]; *(f32x4*)(xr + 256 * j) = o; }
}
typedef short s16x4 __attribute__((ext_vector_type(4)));
__device__ __forceinline__ unsigned cvt_pk_bf16_(float lo, float hi) { unsigned r; asm volatile("v_cvt_pk_bf16_f32 %0, %1, %2" : "=v"(r) : "v"(lo), "v"(hi)); return r; }
constexpr int ATT_K_OFF = 0, ATT_V_OFF = 40960, ATT_VSTRIDE = 648, ATT_LDS = ATT_V_OFF + 64 * ATT_VSTRIDE;
__device__ __forceinline__ void attn_fill_load(const bf16* K, const bf16* Vt, int b, int kvh, int kw0, int tid, v4u (&kr)[5], v2u (&vr)[10]) {
    const size_t tb = (size_t)b * 4096;
#pragma unroll
    for (int i = 0; i < 5; ++i) { const int idx = tid + 512 * i, row = idx >> 3, ch = idx & 7, key = kw0 + row;
        kr[i] = (v4u){0u, 0u, 0u, 0u}; if (key >= 0 && key < 4096) kr[i] = *(const v4u*)(K + (tb + key) * 512 + kvh * 64 + ch * 8); }
#pragma unroll
    for (int i = 0; i < 10; ++i) { const int idx = tid + 512 * i, d = idx / 80, pc = idx % 80, key = kw0 + pc * 4;
        vr[i] = (v2u){0u, 0u}; if (key >= 0 && key < 4096) vr[i] = *(const v2u*)(Vt + (size_t)(kvh * 64 + d) * 16384 + tb + key); }
}
__device__ __forceinline__ void attn_fill_store(LAS unsigned char* lds, int tid, const v4u (&kr)[5], const v2u (&vr)[10]) {
#pragma unroll
    for (int i = 0; i < 5; ++i) { const int idx = tid + 512 * i, row = idx >> 3, ch = idx & 7; *(LAS v4u*)(lds + ATT_K_OFF + row * 128 + ((ch ^ ((row >> 1) & 7)) << 4)) = kr[i]; }
#pragma unroll
    for (int i = 0; i < 10; ++i) { const int idx = tid + 512 * i, d = idx / 80, pc = idx % 80; *(LAS v2u*)(lds + ATT_V_OFF + d * ATT_VSTRIDE + pc * 8) = vr[i]; }
}
__device__ __forceinline__ void attn_task(LAS const unsigned char* lds, const bf16* Q, bf16* O, const float* sinks, int b, int hq, int q0, int kw0, int lane) {
    const int c = lane & 31, hi = lane >> 5;
    const size_t tb = (size_t)b * 4096;
    s16x8 qf[4];
    { const bf16* qp = Q + (tb + q0 + c) * 2048 + hq * 64 + hi * 8;
#pragma unroll
      for (int ks = 0; ks < 4; ++ks) qf[ks] = *(const s16x8*)(qp + ks * 16); }
    const float sink2 = sinks[hq] * 1.4426950408889634f;
    float m = sink2, l = (hi == 0) ? 1.f : 0.f;
    f32x16 o0, o1;
#pragma unroll
    for (int r = 0; r < 16; ++r) { o0[r] = 0.f; o1[r] = 0.f; }
    const int kt_lo = (q0 < 128) ? ((128 - q0) >> 5) : 0, kt_hi = ((4192 - q0) >> 5) < 8 ? ((4192 - q0) >> 5) : 8;
    for (int kt = kt_lo; kt <= kt_hi; ++kt) {
        const int key0 = q0 - 128 + 32 * kt, row0 = key0 - kw0;
        s16x8 kf[4]; s16x4 va[2][2][2];
        { const int row = row0 + c; LAS const unsigned char* kp = lds + ATT_K_OFF + row * 128; const int sw = (row >> 1) & 7;
#pragma unroll
          for (int ks = 0; ks < 4; ++ks) kf[ks] = *(LAS const s16x8*)(kp + (((2 * ks + hi) ^ sw) << 4)); }
#pragma unroll
        for (int db = 0; db < 2; ++db)
#pragma unroll
            for (int s = 0; s < 2; ++s) { LAS const unsigned char* vp = lds + ATT_V_OFF + (db * 32 + c) * ATT_VSTRIDE + (row0 + 16 * s + 4 * hi) * 2; va[db][s][0] = *(LAS const s16x4*)vp; va[db][s][1] = *(LAS const s16x4*)(vp + 16); }
        f32x16 sa;
#pragma unroll
        for (int r = 0; r < 16; ++r) sa[r] = 0.f;
#pragma unroll
        for (int ks = 0; ks < 4; ++ks) sa = __builtin_amdgcn_mfma_f32_32x32x16_bf16(kf[ks], qf[ks], sa, 0, 0, 0);
        if (kt == 0 || kt == 8) {
            const int dbase = key0 - (q0 + c) + 4 * hi;
#pragma unroll
            for (int r = 0; r < 16; ++r) { const int d = dbase + (r & 3) + 8 * (r >> 2); if (d < -128 || d > 128) sa[r] = -1e30f; }
        }
        float mx = sa[0];
#pragma unroll
        for (int r = 1; r < 16; ++r) mx = fmaxf(mx, sa[r]);
        { const auto rr = __builtin_amdgcn_permlane32_swap(__float_as_uint(mx), __float_as_uint(mx), false, false); mx = fmaxf(__uint_as_float(rr[0]), __uint_as_float(rr[1])); }
        const float mn = fmaxf(m, mx), alpha = __builtin_amdgcn_exp2f(m - mn);
        m = mn;
        float ps = 0.f;
#pragma unroll
        for (int r = 0; r < 16; ++r) { sa[r] = __builtin_amdgcn_exp2f(sa[r] - mn); ps += sa[r]; }
        l = l * alpha + ps;
#pragma unroll
        for (int r = 0; r < 16; ++r) { o0[r] *= alpha; o1[r] *= alpha; }
        s16x8 pf[2];
#pragma unroll
        for (int s = 0; s < 2; ++s) { v4u w; w.x = cvt_pk_bf16_(sa[8 * s + 0], sa[8 * s + 1]); w.y = cvt_pk_bf16_(sa[8 * s + 2], sa[8 * s + 3]); w.z = cvt_pk_bf16_(sa[8 * s + 4], sa[8 * s + 5]); w.w = cvt_pk_bf16_(sa[8 * s + 6], sa[8 * s + 7]);
            pf[s] = __builtin_bit_cast(s16x8, w); }
#pragma unroll
        for (int s = 0; s < 2; ++s) {
            const s16x8 v0 = __builtin_shufflevector(va[0][s][0], va[0][s][1], 0, 1, 2, 3, 4, 5, 6, 7), v1 = __builtin_shufflevector(va[1][s][0], va[1][s][1], 0, 1, 2, 3, 4, 5, 6, 7);
            o0 = __builtin_amdgcn_mfma_f32_32x32x16_bf16(v0, pf[s], o0, 0, 0, 0);
            o1 = __builtin_amdgcn_mfma_f32_32x32x16_bf16(v1, pf[s], o1, 0, 0, 0);
        }
    }
    { const auto rr = __builtin_amdgcn_permlane32_swap(__float_as_uint(l), __float_as_uint(l), false, false); l = __uint_as_float(rr[0]) + __uint_as_float(rr[1]); }
    const float il = 1.f / l;
    bf16* op = O + (tb + q0 + c) * 2048 + hq * 64 + 4 * hi;
#pragma unroll
    for (int g = 0; g < 4; ++g) {
        v2u w0, w1;
        w0.x = cvt_pk_bf16_(o0[4 * g + 0] * il, o0[4 * g + 1] * il); w0.y = cvt_pk_bf16_(o0[4 * g + 2] * il, o0[4 * g + 3] * il);
        w1.x = cvt_pk_bf16_(o1[4 * g + 0] * il, o1[4 * g + 1] * il); w1.y = cvt_pk_bf16_(o1[4 * g + 2] * il, o1[4 * g + 3] * il);
        *(v2u*)(op + 8 * g) = w0; *(v2u*)(op + 32 + 8 * g) = w1;
    }
}
typedef float fx2 __attribute__((ext_vector_type(2)));
__device__ __forceinline__ fx2 bf2_(unsigned w) { fx2 r; r[0] = __uint_as_float(w << 16); r[1] = __uint_as_float(w & 0xffff0000u); return r; }
__device__ __forceinline__ void fft16_item(bf16* Zp, const float* tw, int bg, int l, int s1h, int lane) {
    const int s1 = s1h * 128 + 2 * lane;
    bf16* base = Zp + ((size_t)(bg * 16) * 256 + l) * 512 + s1;
    fx2 zr[16], zi[16];
#pragma unroll
    for (int s2 = 0; s2 < 16; ++s2) { zr[s2] = bf2_(*(const unsigned*)(base + (size_t)s2 * 256 * 512)); zi[s2] = bf2_(*(const unsigned*)(base + (size_t)s2 * 256 * 512 + 256)); }
    fx2 er[16], ei[16];
#pragma unroll
    for (int d = 0; d < 4; ++d) {
        const fx2 ar = zr[d], ai_ = zi[d], br = zr[4 + d], bi = zi[4 + d], cr = zr[8 + d], ci = zi[8 + d], dr = zr[12 + d], di = zi[12 + d];
        const fx2 s0r = ar + cr, s0i = ai_ + ci, s1r = ar - cr, s1i = ai_ - ci, s2r = br + dr, s2i = bi + di, s3r = br - dr, s3i = bi - di;
        er[0 * 4 + d] = s0r + s2r; ei[0 * 4 + d] = s0i + s2i;
        er[1 * 4 + d] = s1r + s3i; ei[1 * 4 + d] = s1i - s3r;
        er[2 * 4 + d] = s0r - s2r; ei[2 * 4 + d] = s0i - s2i;
        er[3 * 4 + d] = s1r - s3i; ei[3 * 4 + d] = s1i + s3r;
    }
#pragma unroll
    for (int a = 1; a < 4; ++a)
#pragma unroll
        for (int d = 1; d < 4; ++d) {
            const float ang = 6.283185307179586f * (float)(a * d) / 16.f; const float c = __builtin_cosf(ang), sn = __builtin_sinf(ang);
            const fx2 xr = er[a * 4 + d], xi = ei[a * 4 + d];
            er[a * 4 + d] = xr * c + xi * sn; ei[a * 4 + d] = xi * c - xr * sn;
        }
#pragma unroll
    for (int a = 0; a < 4; ++a) {
        const fx2 ar = er[a * 4 + 0], ai_ = ei[a * 4 + 0], br = er[a * 4 + 1], bi = ei[a * 4 + 1], cr = er[a * 4 + 2], ci = ei[a * 4 + 2], dr = er[a * 4 + 3], di = ei[a * 4 + 3];
        const fx2 s0r = ar + cr, s0i = ai_ + ci, s1r = ar - cr, s1i = ai_ - ci, s2r = br + dr, s2i = bi + di, s3r = br - dr, s3i = bi - di;
        fx2 Dr[4], Di[4];
        Dr[0] = s0r + s2r; Di[0] = s0i + s2i; Dr[1] = s1r + s3i; Di[1] = s1i - s3r; Dr[2] = s0r - s2r; Di[2] = s0i - s2i; Dr[3] = s1r - s3i; Di[3] = s1i + s3r;
#pragma unroll
        for (int b = 0; b < 4; ++b) {
            const int k2 = a + 4 * b;
            const f32x4 t0 = *(const f32x4*)(tw + (size_t)(k2 * 256 + s1) * 2);
            const fx2 cc = (fx2){t0[0], t0[2]}, ss = (fx2){t0[1], t0[3]};
            const fx2 hr = Dr[b] * cc + Di[b] * ss, hi_ = Di[b] * cc - Dr[b] * ss;
            *(unsigned*)(base + (size_t)k2 * 256 * 512) = pk2(hr[0], hr[1]); *(unsigned*)(base + (size_t)k2 * 256 * 512 + 256) = pk2(hi_[0], hi_[1]);
        }
    }
}
__device__ __forceinline__ int static_unit(int nM, int nN, int G, int c, int i) {
    const int nwg = nM * nN; const long L = (long)i * G + c; if (L >= nwg) return -1;
    int wgid = (int)L; { const int q = nwg / 8, r = nwg % 8, xcd = wgid % 8, off = wgid / 8; wgid = (xcd < r ? xcd * (q + 1) : r * (q + 1) + (xcd - r) * q) + off; }
    const int nig = 8 * nN, gid = wgid / nig, fm = gid * 8, gsz = (nM - fm) < 8 ? (nM - fm) : 8;
    return ((fm + ((wgid % nig) % gsz)) << 16) | ((wgid % nig) / gsz);
}
#ifndef REP_PRO
#define REP_PRO 1
#endif
#ifndef REP_GEMM
#define REP_GEMM 1
#endif
#ifndef REP_ATT
#define REP_ATT 1
#endif
#ifndef REP_LITE
#define REP_LITE 0
#endif
#ifndef REP_Q
#define REP_Q 1
#endif
#ifndef REP_PA
#define REP_PA 1
#endif
#ifndef REP_TK
#define REP_TK 1
#endif
enum { PH_PRO = 0, PH_G1 = 1, PH_S1 = 2, PH_G2 = 3, PH_G3 = 4, PH_Q0 = 5, PH_TK0 = 6, PH_PA0 = 7, PH_PW0 = 8, PH_PB0 = 9, PH_QKV = 10, PH_ATT = 11, PH_WO = 12, PH_Q1 = 13, PH_TK1 = 14, PH_PA1 = 15, PH_PW1 = 16, PH_PB1 = 17, PH_FIN = 18, PH_END = 19 };
__global__ void __launch_bounds__(NWAVES * 64, 2) mega(Args a) {
    extern __shared__ __attribute__((aligned(16))) unsigned char lds_raw[];
    LAS unsigned char* lds = (LAS unsigned char*)lds_raw;
    cg::grid_group grid = cg::this_grid();
    const int wave = __builtin_amdgcn_readfirstlane(threadIdx.x >> 6);
#define FRESH_IDS() int lane; asm volatile("v_mbcnt_lo_u32_b32 %0, -1, 0\n\tv_mbcnt_hi_u32_b32 %0, -1, %0" : "=v"(lane)); const int tid = wave * 64 + lane; (void)tid
    const int G = gridDim.x, bx = blockIdx.x;
    unsigned char* ws = a.ws;
    const int lo = a.ph_lo, hi = a.ph_hi;
    volatile LAS unsigned* MISC = (volatile LAS unsigned*)(lds + LDSCTL_OFF);
    if (threadIdx.x < 16) MISC[threadIdx.x] = 0u;
    __syncthreads();
    XcdBarrier xbar = xcd_barrier_post((unsigned*)(ws + WS_CTL) + CW_BAR, MISC + 8);
#define IN(k) (lo <= (k) && (k) < hi)
#ifdef DIAG_A
#define STAMP(i) do { if (bx == 0 && threadIdx.x == 0) ((unsigned long long*)(ws + WS_STAMP))[i] = __builtin_amdgcn_s_memrealtime(); } while (0)
#else
#define STAMP(i) do { } while (0)
#endif
#define SEAM(k) do { if (IN(k) && IN((k) + 1)) { if ((k) == PH_PRO) grid.sync(); else xcd_barrier(xbar); } STAMP((k) + 1); } while (0)
    STAMP(0);
    for (int rep_ = 0; rep_ < REP_PRO; ++rep_)
    if (IN(PH_PRO)) { FRESH_IDS();
        const int gw = bx * NWAVES + wave, NGW = G * NWAVES;
        const size_t gtid = (size_t)bx * (NWAVES * 64) + tid, ngt = (size_t)G * NWAVES * 64;
        LAS float* scr = (LAS float*)(lds + wave * 16384);
        {
            constexpr int I_SQ = (DM / 64) * (DM / 32), I_QKV = (DM / 64) * (QKVW / 32);
            constexpr int NITEMS = 4 * I_SQ + I_QKV;
            for (int it = gw; it < NITEMS; it += NGW) {
                int r = it;
                if (r < I_SQ) { transpose_item<0>(a.in[3], DM, DM, nullptr, (bf16*)(ws + WS_WOF), scr, r, lane); continue; } r -= I_SQ;
                if (r < I_SQ) { transpose_item<0>(a.in[5], DM, DM, nullptr, (bf16*)(ws + WS_WOA), scr, r, lane); continue; } r -= I_SQ;
                if (r < I_SQ) { transpose_item<0>(a.in[7], DM, DM, a.in[2], (bf16*)(ws + WS_WQ0), scr, r, lane); continue; } r -= I_SQ;
                if (r < I_SQ) { transpose_item<0>(a.in[7] + (size_t)DM * DM, DM, DM, a.in[2] + DM, (bf16*)(ws + WS_WQ1), scr, r, lane); continue; } r -= I_SQ;
                transpose_item<1>(a.in[4], DM, QKVW, a.in[1] + DM, (bf16*)(ws + WS_WQKV), scr, r, lane);
            }
        }
        {
            f32x4 v[8], nv[8];
            { const f32x4* xr = (const f32x4*)(a.in[0] + (size_t)(gw < T ? gw : 0) * DM) + lane;
#pragma unroll
              for (int j = 0; j < 8; ++j) v[j] = xr[64 * j]; }
            for (int row = gw; row < T; row += NGW) {
                { const int nr = (row + NGW < T) ? row + NGW : row; const f32x4* xr = (const f32x4*)(a.in[0] + (size_t)nr * DM) + lane;
#pragma unroll
                  for (int j = 0; j < 8; ++j) nv[j] = xr[64 * j]; }
                const f32x4* gr = (const f32x4*)a.in[1] + lane;
                float s = 0.f;
#pragma unroll
                for (int j = 0; j < 8; ++j) s += (v[j][0] * v[j][0] + v[j][1] * v[j][1]) + (v[j][2] * v[j][2] + v[j][3] * v[j][3]);
                const float r = rsqrtf(wsum(s) * (1.f / DM) + EPS);
                const int b = row >> 12, sp = row & 4095;
#pragma unroll
                for (int j = 0; j < 8; ++j) { const f32x4 gg = gr[64 * j]; v2u o; o.x = pk2(v[j][0] * r * gg[0], v[j][1] * r * gg[1]); o.y = pk2(v[j][2] * r * gg[2], v[j][3] * r * gg[3]);
                    *(v2u*)((bf16*)(ws + WS_XG) + ((size_t)((b * 8 + j) * 4096 + sp) * 256 + 4 * lane)) = o; }
#pragma unroll
                for (int j = 0; j < 8; ++j) v[j] = nv[j];
            }
        }
        for (size_t i = gtid; i < (size_t)256 * 512 / 8; i += ngt) {
            const int k1 = (int)(i >> 6), c0 = (int)(i & 63) * 8, part = c0 >> 8, s0 = c0 & 255;
            float v[8];
#pragma unroll
            for (int e = 0; e < 8; ++e) { const int m = (k1 * (s0 + e)) & 255; const float rev = (float)m * (1.f / 256.f); v[e] = (part ? __builtin_amdgcn_sinf(rev) : __builtin_amdgcn_cosf(rev)) * (1.f / 64.f); }
            v4u o; o.x = pk2(v[0], v[1]); o.y = pk2(v[2], v[3]); o.z = pk2(v[4], v[5]); o.w = pk2(v[6], v[7]);
            *(v4u*)((bf16*)(ws + WS_A2) + i * 8) = o;
        }
        for (size_t i = gtid; i < (size_t)16 * 256; i += ngt) {
            const int k2 = (int)(i >> 8), s1 = (int)(i & 255); const float rev = (float)(k2 * s1) * (1.f / 4096.f);
            ((float*)(ws + WS_TW))[2 * i] = __builtin_amdgcn_cosf(rev); ((float*)(ws + WS_TW))[2 * i + 1] = __builtin_amdgcn_sinf(rev);
        }
        for (size_t i = gtid; i < (size_t)512 * 256 / 8; i += ngt) {
            const int n = (int)(i >> 5), c0 = (int)(i & 31) * 8, part = n >> 8, l = n & 255;
            float v[8];
#pragma unroll
            for (int e = 0; e < 8; ++e) { const int m = (l * (c0 + e)) & 255; const float rev = (float)m * (1.f / 256.f); v[e] = (part ? -__builtin_amdgcn_sinf(rev) : __builtin_amdgcn_cosf(rev)) * (1.f / 16.f); }
            v4u o; o.x = pk2(v[0], v[1]); o.y = pk2(v[2], v[3]); o.z = pk2(v[4], v[5]); o.w = pk2(v[6], v[7]);
            *(v4u*)((bf16*)(ws + WS_WCS) + i * 8) = o;
        }
        for (size_t i = gtid; i < (size_t)4096 * 32; i += ngt) {
            const int pos = (int)(i >> 5), fi = (int)(i & 31);
            const double inv = exp2(-(double)fi * (13.287712379549449 / 32.0));
            double sn, cs; sincos((double)pos * inv, &sn, &cs);
            ((float*)(ws + WS_ROPE))[2 * i] = (float)cs; ((float*)(ws + WS_ROPE))[2 * i + 1] = (float)sn;
        }
#pragma unroll 1
        for (int L = 0; L < 2; ++L) {
            CvtCtx cx; cx.srcU = a.in[9] + (size_t)L * NEXP * DM; cx.dsrc = (long)((a.in[10] + (size_t)L * NEXP * DM) - cx.srcU); cx.gain = a.in[2] + L * DM; cx.dstU = ws + (L ? WS_U1 : WS_U0); cx.ddst = (long)WS_V0 - (long)WS_U0;
            cx.su = (float*)(ws + WS_SU) + L * 32768; cx.dsc = ((long)WS_SV - (long)WS_SU) / 4; cx.gwave = gw; cx.nw = NGW;
            f32x4 c0[4], c1[4], n0[4], n1[4];
            cvt_chunk_load(cx, gw, lane, c0); cvt_chunk_load(cx, (gw + NGW < 65536) ? gw + NGW : gw, lane, c1);
            for (int cc = gw; cc < 65536; cc += 2 * NGW) { const int ca = cc + 2 * NGW, cb = cc + 3 * NGW;
                cvt_chunk_load(cx, ca < 65536 ? ca : cc, lane, n0); cvt_chunk_load(cx, cb < 65536 ? cb : cc, lane, n1);
                cvt_chunk_store(cx, cc, lane, c0); if (cc + NGW < 65536) cvt_chunk_store(cx, cc + NGW, lane, c1);
#pragma unroll
                for (int q = 0; q < 4; ++q) { c0[q] = n0[q]; c1[q] = n1[q]; } }
        }
        cvt_stream(a.in[8], (bf16*)(ws + WS_KEYS), (size_t)2 * PH * 2 * 128 * 128 / 8, gtid, ngt);
    }
    SEAM(PH_PRO);
    for (int rep_ = 0; rep_ < REP_GEMM; ++rep_)
    if (IN(PH_G1)) { FRESH_IDS();
        int Kq = FW; asm volatile("" : "+s"(Kq));
        pg8::Gemm g{(const pg8::bf16_t*)(ws + WS_WCS), (const pg8::bf16_t*)(ws + WS_XG), 512, T * FG, Kq}; pg8::StaticOrder S; S.init(512, T * FG, G, bx);
        pg8::EpiZt E{(pg8::bf16_t*)(ws + WS_ZT)};
        pg8::gemm_phase<pg8::EpiZt, pg8::StaticOrder, true, true>(lds, g, S, E);
    }
    SEAM(PH_G1);
    if (IN(PH_S1)) { FRESH_IDS();
        const int gw = bx * NWAVES + wave, NGW = G * NWAVES;
        for (int it = gw; it < 32 * 256 * 2; it += NGW) fft16_item((bf16*)(ws + WS_ZT), (const float*)(ws + WS_TW), it >> 9, (it >> 1) & 255, it & 1, lane);
    }
    SEAM(PH_S1);
    for (int rep_ = 0; rep_ < REP_GEMM; ++rep_)
    if (IN(PH_G2)) { FRESH_IDS();
        pg8::Gemm g{(const pg8::bf16_t*)(ws + WS_A2), (const pg8::bf16_t*)(ws + WS_ZT), 256, 131072, 512}; pg8::StaticOrder S; S.init(256, 131072, G, bx);
        pg8::EpiY E{(pg8::bf16_t*)(ws + WS_Y)};
        pg8::gemm_phase<pg8::EpiY, pg8::StaticOrder, true, true>(lds, g, S, E);
    }
    SEAM(PH_G2);
    if (IN(PH_G3)) { FRESH_IDS();
        pg8::Gemm g{(const pg8::bf16_t*)(ws + WS_Y), (const pg8::bf16_t*)(ws + WS_WOF), T, DM, DM}; pg8::StaticOrder S; S.init(T, DM, G, bx);
        pg8::EpiRes E{a.in[0], a.out, (pg8::bf16_t*)(ws + WS_XB), (float*)(ws + WS_SSQ_A), ws + WS_X8};
        pg8::gemm_phase<pg8::EpiRes, pg8::StaticOrder, true, true>(lds, g, S, E);
    }
    SEAM(PH_G3);
#define PEER_LAYER(L) do { \
        const int pq = L ? PH_Q1 : PH_Q0, ptk = L ? PH_TK1 : PH_TK0, ppa = L ? PH_PA1 : PH_PA0, ppw = L ? PH_PW1 : PH_PW0, ppb = L ? PH_PB1 : PH_PB0; \
        for (int rep_ = 0; rep_ < REP_Q; ++rep_) \
        if (IN(pq)) { FRESH_IDS(); \
            pg8::Gemm g{(const pg8::bf16_t*)(ws + WS_XB), (const pg8::bf16_t*)(ws + (L ? WS_WQ1 : WS_WQ0)), T, DM, DM}; pg8::StaticOrder S; S.init(T, DM, G, bx); \
            pg8::EpiScale E{(pg8::bf16_t*)(ws + WS_Q), (const float*)(ws + (L ? WS_SSQ_C : WS_SSQ_A))}; \
            pg8::gemm_phase<pg8::EpiScale, pg8::StaticOrder, true, true>(lds, g, S, E); \
        } \
        if (IN(pq) && IN(ptk)) { asm volatile("s_waitcnt vmcnt(0)" ::: "memory"); __syncthreads(); } STAMP(pq + 1); \
        if (IN(ptk)) { FRESH_IDS(); \
            const bf16* keys = (const bf16*)(ws + WS_KEYS) + (size_t)L * PH * 2 * 128 * 128; \
            int slot = 0; \
            for (int rep_ = 0; rep_ < REP_TK; ++rep_) { slot = 0; \
            for (int ui = 0; ; ++ui) {        \
                const int upk = static_unit(T / 256, DM / 256, G, bx, ui); if (upk < 0) break; \
                const int h = upk & 0xffff, tblk = upk >> 16; \
                __syncthreads(); \
                topk_fill(lds, keys, h, tid); \
                __syncthreads(); \
                topk_unit((const bf16*)(ws + WS_Q), lds, (int*)(ws + WS_EI), (float*)(ws + WS_GW), tblk * 256 + wave * 32, h, lane); \
                slot += 16; \
            } } \
        } \
        SEAM(ptk); \
        if (IN(ppa)) { FRESH_IDS(); \
            const int xv = bx & 7; \
            peer_a_slice<8>((const unsigned char*)(ws + WS_X8), (const int*)(ws + WS_EI), (const unsigned char*)(ws + (L ? WS_U1 : WS_U0)), (float*)(ws + WS_PD), xv, (unsigned*)(ws + WS_BCTR) + (L * 2 + 0) * 512 + xv * 64, T / 8, lane); \
        } \
        SEAM(ppa); \
        if (IN(ppw)) { FRESH_IDS(); \
            const int gw = bx * NWAVES + wave, NGW = G * NWAVES; \
            for (int t = gw; t < T; t += NGW) peer_a2_token((const float*)(ws + WS_PD), (const float*)(ws + (L ? WS_SSQ_C : WS_SSQ_A)), (const int*)(ws + WS_EI), (const float*)(ws + WS_SU) + L * 32768, (const float*)(ws + WS_SV) + L * 32768, (float*)(ws + WS_GW), (float*)(ws + WS_W1), t, lane); \
        } \
        SEAM(ppw); \
        if (IN(ppb)) { FRESH_IDS(); \
            const int xv = bx & 7; \
            peer_b_slice<4>((const bf16*)(ws + WS_XB), a.out, (const int*)(ws + WS_EI), (const unsigned*)(ws + ((xv < 4) ? WS_GW : WS_W1)), (const unsigned char*)(ws + (L ? WS_V1 : WS_V0)), L ? (bf16*)nullptr : (bf16*)(ws + WS_XB), (float*)(ws + (L ? WS_SSQ_D : WS_SSQ_B)), xv, (unsigned*)(ws + WS_BCTR) + (L * 2 + 1) * 512 + xv * 64, T / 4, lane); \
        } \
    } while (0)
    float oscale = 1.f;
    PEER_LAYER(0);
    SEAM(PH_PB0);
    for (int rep_ = 0; rep_ < REP_GEMM; ++rep_)
    if (IN(PH_QKV)) { FRESH_IDS();
        {
            pg8::Gemm g{(const pg8::bf16_t*)(ws + WS_XB), (const pg8::bf16_t*)(ws + WS_WQKV), T, 2560, DM}; pg8::StaticOrder S; S.init(T, 2560, G, bx);
            pg8::EpiQK E{(pg8::bf16_t*)(ws + WS_QB), (pg8::bf16_t*)(ws + WS_KB), (const float*)(ws + WS_SSQ_B), (const float*)(ws + WS_ROPE), 0.125f * 1.4426950408889634f};
            pg8::gemm_phase<pg8::EpiQK, pg8::StaticOrder, true, true>(lds, g, S, E);
        }
        if (bx >= G / 2) {
            pg8::Gemm g{(const pg8::bf16_t*)(ws + WS_WQKV) + (size_t)2560 * DM, (const pg8::bf16_t*)(ws + WS_XB), 512, T, DM}; pg8::StaticOrder S; S.init(512, T, G / 2, bx - G / 2);
            pg8::EpiVt E{(pg8::bf16_t*)(ws + WS_VT), (const float*)(ws + WS_SSQ_B)};
            pg8::gemm_phase<pg8::EpiVt, pg8::StaticOrder, true, true>(lds, g, S, E);
        }
    }
    SEAM(PH_QKV);
    for (int rep_ = 0; rep_ < REP_ATT; ++rep_)
    if (IN(PH_ATT)) { FRESH_IDS();
        for (int vb = bx; vb < 256; vb += G) {
            const int bkv = vb >> 3, chunk = vb & 7, b = bkv >> 3, kvh = bkv & 7;
            v4u kr[5]; v2u vr[10];
            attn_fill_load((const bf16*)(ws + WS_KB), (const bf16*)(ws + WS_VT), b, kvh, chunk * 8 * 64 - 128, tid, kr, vr);
            for (int i = 0; i < 8; ++i) {
                const int qu = (chunk * 8 + i) * 64;
                __syncthreads();
                attn_fill_store(lds, tid, kr, vr);
                __syncthreads();
                if (i + 1 < 8) attn_fill_load((const bf16*)(ws + WS_KB), (const bf16*)(ws + WS_VT), b, kvh, qu + 64 - 128, tid, kr, vr);
                attn_task(lds, (const bf16*)(ws + WS_QB), (bf16*)(ws + WS_O), a.in[6], b, kvh * 4 + (wave & 3), qu + (wave >> 2) * 32, qu - 128, lane);
            }
        }
    }
    SEAM(PH_ATT);
    if (IN(PH_WO)) { FRESH_IDS();
        pg8::Gemm g{(const pg8::bf16_t*)(ws + WS_O), (const pg8::bf16_t*)(ws + WS_WOA), T, DM, DM}; pg8::StaticOrder S; S.init(T, DM, G, bx);
        pg8::EpiResB E{(const pg8::bf16_t*)(ws + WS_XB), (pg8::bf16_t*)(ws + WS_XB), (float*)(ws + WS_SSQ_C), ws + WS_X8};
        pg8::gemm_phase<pg8::EpiResB, pg8::StaticOrder, true, true>(lds, g, S, E);
    }
    SEAM(PH_WO);
#ifdef DIAG_A
    { const unsigned long long* st = (const unsigned long long*)(ws + WS_STAMP); oscale = 1.f + sqrtf((float)(st[DIAG_B] - st[DIAG_A]) * 1e-6f); }
#endif
    PEER_LAYER(1);
#undef PEER_LAYER
    SEAM(PH_PB1);
    if (IN(PH_FIN)) { FRESH_IDS();
        const int gw = bx * NWAVES + wave, NGW = G * NWAVES;
        for (int t = gw; t < T; t += NGW) final_norm_row(a.out, (const float*)(ws + WS_SSQ_D), a.in[11], t, lane, oscale);
    }
#undef SEAM
#undef IN
}

#ifndef N_LAUNCHES
#define N_LAUNCHES 1
#endif
extern "C" void kernel_launch(void* const* d_in, const int* in_sizes, int n_in, void* d_out, int out_size, void* d_ws, size_t ws_size, hipStream_t stream) {
    static int grid = 0;
    if (!grid) {
        if (hipFuncSetAttribute((const void*)mega, hipFuncAttributeMaxDynamicSharedMemorySize, LDS_BYTES) != hipSuccess) { fprintf(stderr, "hipFuncSetAttribute failed\n"); }
        int dev = 0, cus = 0, per_cu = 0;
        (void)hipGetDevice(&dev);
        (void)hipDeviceGetAttribute(&cus, hipDeviceAttributeMultiprocessorCount, dev);
        if (hipOccupancyMaxActiveBlocksPerMultiprocessor(&per_cu, (const void*)mega, NWAVES * 64, LDS_BYTES) != hipSuccess) per_cu = 0;
        (void)hipGetLastError();
        grid = cus * per_cu;
        if (grid > 256) grid = 256;
        grid &= ~1;
        if (grid < 2) { fprintf(stderr, "occupancy query gave %d x %d\n", cus, per_cu); grid = -1; }
    }
    if (grid < 0) return;
    if (ws_size < 700 * MiB) { fprintf(stderr, "ws too small: %zu\n", ws_size); return; }
    (void)hipMemsetAsync((char*)d_ws + WS_CTL, 0, CTL_BYTES, stream);
    Args a{};
    for (int i = 0; i < 12; ++i) a.in[i] = (const float*)d_in[i];
    a.out = (float*)d_out; a.ws = (unsigned char*)d_ws;
    if (N_LAUNCHES == 1) {
        a.ph_lo = 0; a.ph_hi = PH_END;
        void* args[] = {&a};
        const hipError_t e = hipLaunchCooperativeKernel((const void*)mega, dim3(grid), dim3(NWAVES * 64), args, LDS_BYTES, stream);
        if (e != hipSuccess) fprintf(stderr, "cooperative launch failed: %s (grid %d)\n", hipGetErrorString(e), grid);
    } else {
        for (int ph = 0; ph < PH_END; ++ph) {
            a.ph_lo = ph; a.ph_hi = ph + 1;
            hipLaunchKernelGGL(mega, dim3(grid), dim3(NWAVES * 64), LDS_BYTES, stream, a);
        }
    }
}
```

```cpp
#include <hip/hip_runtime.h>
#include <hip/hip_cooperative_groups.h>
namespace cg = cooperative_groups;
#include <cstdio>
#include <cstdint>
#include <cmath>

constexpr int DM = 2048, NB = 4, SEQ = 4096, T = NB * SEQ;
constexpr int FG = 8, FW = 256;
constexpr int HD = 64, NQH = 32, NKVH = 8, QKVW = 3072;
constexpr int PH = 8, NKEYS = 128, NEXP = 16384, PTOPK = 16;
constexpr float EPS = 1e-6f;
namespace pg8 {
#define PG8_LAS __attribute__((address_space(3)))
typedef unsigned short bf16_t;
typedef short bf16x8 __attribute__((ext_vector_type(8)));
typedef float f32x4 __attribute__((ext_vector_type(4)));
typedef unsigned u32x4 __attribute__((ext_vector_type(4)));
constexpr int BM = 256, BK = 64, HALF = 128, HTB = HALF * BK * 2  , STAGE_BYTES = 8 * HTB, NXCD = 8, WGM = 8;

__host__ __device__ __forceinline__ int lds_byte(int r, int c) { const int st = (r >> 4) * 2 + (c >> 5), rr = r & 15, cc = c & 31, ob = rr * 64 + cc * 2; return st * 1024 + (ob ^ (((ob >> 9) & 1) << 5)); }
__host__ __device__ __forceinline__ void stage_rc(int b, int& R, int& C) { const int st = b / 1024, sb = b % 1024, swz = sb ^ (((sb >> 9) & 1) << 5); R = (st >> 1) * 16 + swz / 64; C = (st & 1) * 32 + (swz % 64) / 2; }
__host__ __device__ __forceinline__ int perm32(int rho) { const int n = rho >> 4, i = rho & 15; return 8 * (i >> 2) + 4 * n + (i & 3); }

struct Unit { int pm, pn; };
struct Gemm { const bf16_t* A; const bf16_t* Bt; int M, N, K; };

struct StaticOrder {
    int nM, nN, nwg, G, c;
    __host__ __device__ void init(int M, int N, int G_, int c_) { nM = M / BM; nN = N / BM; nwg = nM * nN; G = G_; c = c_; }
    __host__ __device__ bool next(int i, Unit& u) const {
        const long L = (long)i * G + c; if (L >= nwg) return false;
        int wgid = (int)L; { const int q = nwg / NXCD, r = nwg % NXCD, xcd = wgid % NXCD, off = wgid / NXCD; wgid = (xcd < r ? xcd * (q + 1) : r * (q + 1) + (xcd - r) * q) + off; }
        const int nig = WGM * nN, gid = wgid / nig, fm = gid * WGM, gsz = (nM - fm) < WGM ? (nM - fm) : WGM;
        u.pm = fm + ((wgid % nig) % gsz); u.pn = (wgid % nig) / gsz; return true;
    }
    __device__ __forceinline__ void a_ready(const Unit&) const {}
    __device__ __forceinline__ void done(const Unit&) const {}
};

__device__ __forceinline__ unsigned cvt_pk_bf16(float lo, float hi) { unsigned r; asm volatile("v_cvt_pk_bf16_f32 %0, %1, %2" : "=v"(r) : "v"(lo), "v"(hi)); return r; }
typedef float f32x2 __attribute__((ext_vector_type(2)));
__device__ __forceinline__ u32x4 pack8(const f32x4 v0, const f32x4 v1) { u32x4 w; w.x = cvt_pk_bf16(v0[0], v0[1]); w.y = cvt_pk_bf16(v0[2], v0[3]); w.z = cvt_pk_bf16(v1[0], v1[1]); w.w = cvt_pk_bf16(v1[2], v1[3]); return w; }
struct EpiZt {
    static constexpr bool PERM = true, AFTER_DRAIN = false; bf16_t* Zp;
    __device__ __forceinline__ void operator()(const f32x4 (&acc)[2][2][4][2], const Unit& u, int wr, int wc, int fr, int fq) const {
        const int part = u.pm, bgs2 = u.pn;
        bf16_t* base = Zp + ((size_t)(bgs2 * 256 + wr * 64 + fr) * 512 + part * 256 + wc * 32 + 8 * fq);
#pragma unroll
        for (int ai = 0; ai < 2; ++ai)
#pragma unroll
            for (int m = 0; m < 4; ++m)
#pragma unroll
                for (int bj = 0; bj < 2; ++bj) *(u32x4*)(base + (ai * HALF + m * 16) * 512 + bj * HALF) = pack8(acc[ai][bj][m][0], acc[ai][bj][m][1]);
    }
};
struct EpiY {
    static constexpr bool PERM = true, AFTER_DRAIN = false; bf16_t* Y;
    __device__ __forceinline__ void operator()(const f32x4 (&acc)[2][2][4][2], const Unit& u, int wr, int wc, int fr, int fq) const {
        const int bg = u.pn >> 4, k2 = u.pn & 15, b = bg >> 3, g = bg & 7;
        bf16_t* base = Y + ((size_t)(b * 4096 + (wr * 64 + fr) * 16 + k2) * 2048 + g * 256 + wc * 32 + 8 * fq);
#pragma unroll
        for (int ai = 0; ai < 2; ++ai)
#pragma unroll
            for (int m = 0; m < 4; ++m)
#pragma unroll
                for (int bj = 0; bj < 2; ++bj) *(u32x4*)(base + (size_t)(ai * HALF + m * 16) * 16 * 2048 + bj * HALF) = pack8(acc[ai][bj][m][0], acc[ai][bj][m][1]);
    }
};
struct EpiRes {
    static constexpr bool PERM = true, AFTER_DRAIN = false; const float* R; float* out; bf16_t* xb; float* ssq; unsigned char* x8;
    __device__ __forceinline__ void operator()(const f32x4 (&acc)[2][2][4][2], const Unit& u, int wr, int wc, int fr, int fq) const {
        const int row0 = u.pm * BM + wr * 64 + fr; const size_t off0 = (size_t)row0 * 2048 + u.pn * BM + wc * 32 + 8 * fq;
        const float* Rb = R + off0; bf16_t* Xb = xb + off0; float* Sb = ssq + row0;
#pragma unroll
        for (int ai = 0; ai < 2; ++ai)
#pragma unroll
            for (int m = 0; m < 4; ++m) { const int ro = (ai * HALF + m * 16) * 2048; float ss = 0.f;
#pragma unroll
                for (int bj = 0; bj < 2; ++bj) {
                    const f32x4 r0 = *(const f32x4*)(Rb + ro + bj * HALF), r1 = *(const f32x4*)(Rb + ro + bj * HALF + 4);
                    const f32x4 o0 = acc[ai][bj][m][0] + r0, o1 = acc[ai][bj][m][1] + r1;
                    *(u32x4*)(Xb + ro + bj * HALF) = pack8(o0, o1);
                    { int lo8 = 0, hi8 = 0; lo8 = __builtin_amdgcn_cvt_pk_fp8_f32(o0[0], o0[1], lo8, false); lo8 = __builtin_amdgcn_cvt_pk_fp8_f32(o0[2], o0[3], lo8, true);
                      hi8 = __builtin_amdgcn_cvt_pk_fp8_f32(o1[0], o1[1], hi8, false); hi8 = __builtin_amdgcn_cvt_pk_fp8_f32(o1[2], o1[3], hi8, true);
                      *(unsigned long long*)(x8 + off0 + ro + bj * HALF) = ((unsigned long long)(unsigned)hi8 << 32) | (unsigned)lo8; }
                    ss += (o0[0] * o0[0] + o0[1] * o0[1]) + (o0[2] * o0[2] + o0[3] * o0[3]) + (o1[0] * o1[0] + o1[1] * o1[1]) + (o1[2] * o1[2] + o1[3] * o1[3]); }
                ss += __shfl_xor(ss, 16); ss += __shfl_xor(ss, 32);
                if (fq == 0) unsafeAtomicAdd(Sb + ai * HALF + m * 16, ss);
                asm volatile("" ::: "memory"); }
    }
};
struct EpiResB {
    static constexpr bool PERM = true, AFTER_DRAIN = false; const bf16_t* R; bf16_t* xb; float* ssq; unsigned char* x8;
    __device__ __forceinline__ void operator()(const f32x4 (&acc)[2][2][4][2], const Unit& u, int wr, int wc, int fr, int fq) const {
        const int row0 = u.pm * BM + wr * 64 + fr; const size_t off0 = (size_t)row0 * 2048 + u.pn * BM + wc * 32 + 8 * fq;
        const bf16_t* Rb = R + off0; bf16_t* Xb = xb + off0; float* Sb = ssq + row0;
#pragma unroll
        for (int ai = 0; ai < 2; ++ai)
#pragma unroll
            for (int m = 0; m < 4; ++m) { const int ro = (ai * HALF + m * 16) * 2048; float ss = 0.f;
#pragma unroll
                for (int bj = 0; bj < 2; ++bj) {
                    const u32x4 rw = *(const u32x4*)(Rb + ro + bj * HALF);
                    const f32x4 r0 = (f32x4){__uint_as_float(rw[0] << 16), __uint_as_float(rw[0] & 0xffff0000u), __uint_as_float(rw[1] << 16), __uint_as_float(rw[1] & 0xffff0000u)}, r1 = (f32x4){__uint_as_float(rw[2] << 16), __uint_as_float(rw[2] & 0xffff0000u), __uint_as_float(rw[3] << 16), __uint_as_float(rw[3] & 0xffff0000u)};
                    const f32x4 o0 = acc[ai][bj][m][0] + r0, o1 = acc[ai][bj][m][1] + r1;
                    *(u32x4*)(Xb + ro + bj * HALF) = pack8(o0, o1);
                    { int lo8 = 0, hi8 = 0; lo8 = __builtin_amdgcn_cvt_pk_fp8_f32(o0[0], o0[1], lo8, false); lo8 = __builtin_amdgcn_cvt_pk_fp8_f32(o0[2], o0[3], lo8, true);
                      hi8 = __builtin_amdgcn_cvt_pk_fp8_f32(o1[0], o1[1], hi8, false); hi8 = __builtin_amdgcn_cvt_pk_fp8_f32(o1[2], o1[3], hi8, true);
                      *(unsigned long long*)(x8 + off0 + ro + bj * HALF) = ((unsigned long long)(unsigned)hi8 << 32) | (unsigned)lo8; }
                    ss += (o0[0] * o0[0] + o0[1] * o0[1]) + (o0[2] * o0[2] + o0[3] * o0[3]) + (o1[0] * o1[0] + o1[1] * o1[1]) + (o1[2] * o1[2] + o1[3] * o1[3]); }
                ss += __shfl_xor(ss, 16); ss += __shfl_xor(ss, 32);
                if (fq == 0) unsafeAtomicAdd(Sb + ai * HALF + m * 16, ss);
                asm volatile("" ::: "memory"); }
    }
};
struct EpiScale {
    static constexpr bool PERM = true, AFTER_DRAIN = false; bf16_t* O; const float* ssq;
    __device__ __forceinline__ void operator()(const f32x4 (&acc)[2][2][4][2], const Unit& u, int wr, int wc, int fr, int fq) const {
        const int row0 = u.pm * BM + wr * 64 + fr;
        bf16_t* base = O + ((size_t)row0 * 2048 + u.pn * BM + wc * 32 + 8 * fq); const float* Sb = ssq + row0;
#pragma unroll
        for (int ai = 0; ai < 2; ++ai)
#pragma unroll
            for (int m = 0; m < 4; ++m) { const float rs = rsqrtf(Sb[ai * HALF + m * 16] * (1.f / 2048.f) + 1e-6f);
#pragma unroll
                for (int bj = 0; bj < 2; ++bj) *(u32x4*)(base + (ai * HALF + m * 16) * 2048 + bj * HALF) = pack8(acc[ai][bj][m][0] * rs, acc[ai][bj][m][1] * rs); }
    }
};
struct EpiQK {
    static constexpr bool PERM = true, AFTER_DRAIN = false; bf16_t* Q; bf16_t* K; const float* ssq; const float* rope; float qscale;
    __device__ __forceinline__ void operator()(const f32x4 (&acc)[2][2][4][2], const Unit& u, int wr, int wc, int fr, int fq) const {
        const int row0 = u.pm * BM + wr * 64 + fr; const bool isq = u.pn < 8;
        const int cl = wc * 32 + 8 * fq;
        bf16_t* base = isq ? (Q + ((size_t)row0 * 2048 + u.pn * BM + cl)) : (K + ((size_t)row0 * 512 + (u.pn - 8) * BM + cl));
        const int ld = isq ? 2048 : 512; const float sc = isq ? qscale : 1.f;
        const float* rp = rope + (size_t)(row0 & 4095) * 64 + (cl & 63);
        const float* Sb = ssq + row0;
#pragma unroll
        for (int ai = 0; ai < 2; ++ai)
#pragma unroll
            for (int m = 0; m < 4; ++m) { const int ro = ai * HALF + m * 16; const float rs = rsqrtf(Sb[ro] * (1.f / 2048.f) + 1e-6f) * sc;
                const f32x4 t0 = *(const f32x4*)(rp + (size_t)ro * 64), t1 = *(const f32x4*)(rp + (size_t)ro * 64 + 4);
#pragma unroll
                for (int bj = 0; bj < 2; ++bj) {
                    const f32x4 a = acc[ai][bj][m][0] * rs, b = acc[ai][bj][m][1] * rs; f32x4 oa, ob;
                    oa[0] = a[0] * t0[0] - a[1] * t0[1]; oa[1] = a[1] * t0[0] + a[0] * t0[1]; oa[2] = a[2] * t0[2] - a[3] * t0[3]; oa[3] = a[3] * t0[2] + a[2] * t0[3];
                    ob[0] = b[0] * t1[0] - b[1] * t1[1]; ob[1] = b[1] * t1[0] + b[0] * t1[1]; ob[2] = b[2] * t1[2] - b[3] * t1[3]; ob[3] = b[3] * t1[2] + b[2] * t1[3];
                    *(u32x4*)(base + (size_t)ro * ld + bj * HALF) = pack8(oa, ob); } }
    }
};
struct EpiVt {
    static constexpr bool PERM = true, AFTER_DRAIN = false; bf16_t* Vt; const float* ssq;
    __device__ __forceinline__ void operator()(const f32x4 (&acc)[2][2][4][2], const Unit& u, int wr, int wc, int fr, int fq) const {
        const int col0 = u.pn * BM + wc * 32 + 8 * fq;
        bf16_t* base = Vt + ((size_t)(u.pm * BM + wr * 64 + fr) * 16384 + col0);
        f32x4 r0[2], r1[2];
#pragma unroll
        for (int bj = 0; bj < 2; ++bj) { const f32x4 s0 = *(const f32x4*)(ssq + col0 + bj * HALF), s1 = *(const f32x4*)(ssq + col0 + bj * HALF + 4);
#pragma unroll
            for (int q = 0; q < 4; ++q) { r0[bj][q] = rsqrtf(s0[q] * (1.f / 2048.f) + 1e-6f); r1[bj][q] = rsqrtf(s1[q] * (1.f / 2048.f) + 1e-6f); } }
#pragma unroll
        for (int ai = 0; ai < 2; ++ai)
#pragma unroll
            for (int m = 0; m < 4; ++m)
#pragma unroll
                for (int bj = 0; bj < 2; ++bj) *(u32x4*)(base + (size_t)(ai * HALF + m * 16) * 16384 + bj * HALF) = pack8(acc[ai][bj][m][0] * r0[bj], acc[ai][bj][m][1] * r1[bj]);
    }
};
template <class Epi, class Sched, bool ALIGN_EPI = false, bool SP2 = false>
__device__ __forceinline__ void gemm_phase(PG8_LAS unsigned char* lds, const Gemm g, const Sched& S, const Epi& E) {
    const int tid = threadIdx.x, wid = __builtin_amdgcn_readfirstlane(tid >> 6), lane = tid & 63, wr = wid >> 2, wc = wid & 3, fr = lane & 15, fq = lane >> 4;
    const int K = g.K, nt = K / BK;
    unsigned voffA[2], voffB[2];
#pragma unroll
    for (int i = 0; i < 2; ++i) { int R, C; stage_rc(tid * 16 + i * 8192, R, C); const int Rb = Epi::PERM ? ((R & ~31) + perm32(R & 31)) : R;
        voffA[i] = (unsigned)(R * K + C) * 2u; voffB[i] = (unsigned)(Rb * K + C) * 2u; }
    const size_t kstep = (size_t)(BK * 2);
    const size_t hstep = (size_t)HALF * K * 2;
    const size_t tstep = 2 * hstep;
    const unsigned ldsw = (unsigned)wid * 1024u;
    const int aoff = lds_byte(wr * 64 + fr, fq * 8), boff = lds_byte(wc * 32 + fr, fq * 8);
#define PG8_SA(b, h) (((b) * 2 + (h)) * HTB)
#define PG8_SB(b, h) ((4 + (b) * 2 + (h)) * HTB)
#define PG8_STAGE(bufoff, gbase, voff) do { _Pragma("unroll") for (int _i = 0; _i < 2; ++_i) \
        __builtin_amdgcn_global_load_lds((const unsigned*)((const char*)(gbase) + (voff)[_i]), (PG8_LAS unsigned*)(lds + (bufoff) + ldsw + _i * 8192), 16, 0, 0); } while (0)
#define PG8_LDA(dst, b, h) do { _Pragma("unroll") for (int m = 0; m < 4; ++m) _Pragma("unroll") for (int k = 0; k < 2; ++k) dst[m][k] = *(const PG8_LAS bf16x8*)(lds + PG8_SA(b, h) + aoff + m * 2048 + k * 1024); } while (0)
#define PG8_LDB(dst, b, h) do { _Pragma("unroll") for (int n = 0; n < 2; ++n) _Pragma("unroll") for (int k = 0; k < 2; ++k) dst[n][k] = *(const PG8_LAS bf16x8*)(lds + PG8_SB(b, h) + boff + n * 2048 + k * 1024); } while (0)
#define PG8_MMA(ai, bj, At, Bt) do { __builtin_amdgcn_s_setprio(1); _Pragma("unroll") for (int m = 0; m < 4; ++m) _Pragma("unroll") for (int n = 0; n < 2; ++n) _Pragma("unroll") for (int k = 0; k < 2; ++k) \
        acc[ai][bj][m][n] = __builtin_amdgcn_mfma_f32_16x16x32_bf16(Bt[n][k], At[m][k], acc[ai][bj][m][n], 0, 0, 0); __builtin_amdgcn_s_setprio(0); } while (0)
#define PG8_WAIT_V(n) asm volatile("s_waitcnt vmcnt(" #n ")" ::: "memory")
#define PG8_WAIT_L(n) asm volatile("s_waitcnt lgkmcnt(" #n ")" ::: "memory")
#define PG8_BAR __builtin_amdgcn_s_barrier()
#define PG8_SCHED __builtin_amdgcn_sched_barrier(0)
    Unit cur, nxt; int ui = 0;
    if (!S.next(0, cur)) return;
    f32x4 acc[2][2][4][2];
#pragma unroll
    for (int a = 0; a < 2; ++a)
#pragma unroll
        for (int b = 0; b < 2; ++b)
#pragma unroll
            for (int m = 0; m < 4; ++m)
#pragma unroll
                for (int n = 0; n < 2; ++n) acc[a][b][m][n] = (f32x4){0.f, 0.f, 0.f, 0.f};
    bf16x8 At[4][2], B0[2][2], B1[2][2];
    const char* cA = (const char*)g.A + (size_t)cur.pm * tstep; const char* cB = (const char*)g.Bt + (size_t)cur.pn * tstep;
    S.a_ready(cur);
    if constexpr (SP2) {
        PG8_STAGE(PG8_SB(0, 0), cB, voffB); PG8_STAGE(PG8_SB(0, 1), cB + hstep, voffB); PG8_STAGE(PG8_SA(0, 0), cA, voffA); PG8_STAGE(PG8_SA(0, 1), cA + hstep, voffA);
        if (wr == 1) PG8_BAR;
        PG8_WAIT_V(2); PG8_BAR;
        PG8_STAGE(PG8_SB(1, 0), cB + kstep, voffB); PG8_STAGE(PG8_SA(1, 0), cA + kstep, voffA); PG8_STAGE(PG8_SB(1, 1), cB + hstep + kstep, voffB);
        PG8_WAIT_V(6); PG8_BAR;
    } else {
        PG8_STAGE(PG8_SB(0, 0), cB, voffB); PG8_STAGE(PG8_SA(0, 0), cA, voffA); PG8_STAGE(PG8_SB(0, 1), cB + hstep, voffB); PG8_STAGE(PG8_SA(0, 1), cA + hstep, voffA);
        if (wr == 1) PG8_BAR;
        PG8_WAIT_V(4); PG8_BAR;
        PG8_STAGE(PG8_SB(1, 0), cB + kstep, voffB); PG8_STAGE(PG8_SA(1, 0), cA + kstep, voffA); PG8_STAGE(PG8_SB(1, 1), cB + hstep + kstep, voffB);
        PG8_WAIT_V(6); PG8_BAR;
    }
    for (;;) {
        const bool has_next = S.next(ui + 1, nxt);
        const char* nA = has_next ? (const char*)g.A + (size_t)nxt.pm * tstep : cA; const char* nB = has_next ? (const char*)g.Bt + (size_t)nxt.pn * tstep : cB;
        for (int t = 0; t < nt; t += 2) {
            const bool last = (t == nt - 2);
            const char* a1 = cA + (size_t)(t + 1) * kstep;
            const char* a2 = last ? nA : cA + (size_t)(t + 2) * kstep; const char* b2 = last ? nB : cB + (size_t)(t + 2) * kstep;
            const char* a3 = a2 + kstep; const char* b3 = b2 + kstep;
            if (last && has_next) S.a_ready(nxt);
            if constexpr (SP2) {
            PG8_LDB(B0, 0, 0); PG8_LDB(B1, 0, 1); PG8_SCHED; PG8_LDA(At, 0, 0); PG8_STAGE(PG8_SA(1, 1), a1 + hstep, voffA);
            PG8_WAIT_V(8); PG8_WAIT_L(0); PG8_BAR; PG8_MMA(0, 0, At, B0); PG8_MMA(0, 1, At, B1); PG8_BAR; PG8_SCHED;
            PG8_LDA(At, 0, 1); PG8_STAGE(PG8_SB(0, 0), b2, voffB); PG8_STAGE(PG8_SB(0, 1), b2 + hstep, voffB); PG8_STAGE(PG8_SA(0, 0), a2, voffA);
            PG8_WAIT_V(8); PG8_WAIT_L(0); PG8_BAR; PG8_MMA(1, 0, At, B0); PG8_MMA(1, 1, At, B1); PG8_BAR; PG8_SCHED;
            PG8_LDB(B0, 1, 0); PG8_LDB(B1, 1, 1); PG8_SCHED; PG8_LDA(At, 1, 0); PG8_STAGE(PG8_SA(0, 1), a2 + hstep, voffA);
            PG8_WAIT_V(8); PG8_WAIT_L(0); PG8_BAR; PG8_MMA(0, 0, At, B0); PG8_MMA(0, 1, At, B1); PG8_BAR; PG8_SCHED;
            PG8_LDA(At, 1, 1); PG8_STAGE(PG8_SB(1, 0), b3, voffB); PG8_STAGE(PG8_SB(1, 1), b3 + hstep, voffB); PG8_STAGE(PG8_SA(1, 0), a3, voffA);
            PG8_WAIT_V(8); PG8_WAIT_L(0); PG8_BAR; PG8_MMA(1, 0, At, B0); PG8_MMA(1, 1, At, B1); PG8_BAR; PG8_SCHED;
            } else {
            PG8_LDB(B0, 0, 0); PG8_SCHED; PG8_LDA(At, 0, 0); PG8_STAGE(PG8_SA(1, 1), a1 + hstep, voffA);
            PG8_WAIT_L(8); PG8_BAR; PG8_WAIT_L(0); PG8_MMA(0, 0, At, B0); PG8_BAR; PG8_SCHED;
            PG8_LDB(B1, 0, 1); PG8_STAGE(PG8_SB(0, 0), b2, voffB);
            PG8_BAR; PG8_WAIT_L(0); PG8_MMA(0, 1, At, B1); PG8_BAR;
            PG8_LDA(At, 0, 1); PG8_STAGE(PG8_SA(0, 0), a2, voffA);
            PG8_BAR; PG8_WAIT_L(0); PG8_MMA(1, 0, At, B0); PG8_BAR; PG8_SCHED;
            PG8_STAGE(PG8_SB(0, 1), b2 + hstep, voffB);
            PG8_WAIT_V(6); PG8_BAR; PG8_MMA(1, 1, At, B1); PG8_BAR;
            PG8_LDB(B0, 1, 0); PG8_SCHED; PG8_LDA(At, 1, 0); PG8_STAGE(PG8_SA(0, 1), a2 + hstep, voffA);
            PG8_WAIT_L(8); PG8_BAR; PG8_WAIT_L(0); PG8_MMA(0, 0, At, B0); PG8_BAR; PG8_SCHED;
            PG8_LDB(B1, 1, 1); PG8_STAGE(PG8_SB(1, 0), b3, voffB);
            PG8_BAR; PG8_WAIT_L(0); PG8_MMA(0, 1, At, B1); PG8_BAR;
            PG8_LDA(At, 1, 1); PG8_STAGE(PG8_SA(1, 0), a3, voffA);
            PG8_BAR; PG8_WAIT_L(0); PG8_MMA(1, 0, At, B0); PG8_BAR; PG8_SCHED;
            PG8_STAGE(PG8_SB(1, 1), b3 + hstep, voffB);
            PG8_WAIT_V(6); PG8_BAR; PG8_MMA(1, 1, At, B1); PG8_BAR;
            }
        }
        if constexpr (ALIGN_EPI) { if (wr == 0) PG8_BAR; }
        if constexpr (!Epi::AFTER_DRAIN) { E(acc, cur, wr, wc, fr, fq); S.done(cur); }
        if (!has_next) break;
#pragma unroll
        for (int a = 0; a < 2; ++a)
#pragma unroll
            for (int b = 0; b < 2; ++b)
#pragma unroll
                for (int m = 0; m < 4; ++m)
#pragma unroll
                    for (int n = 0; n < 2; ++n) acc[a][b][m][n] = (f32x4){0.f, 0.f, 0.f, 0.f};
        cur = nxt; cA = nA; cB = nB; ++ui;
        if constexpr (ALIGN_EPI) { if (wr == 1) PG8_BAR; }
    }
    PG8_WAIT_V(0);
    if constexpr (!ALIGN_EPI) { if (wr == 0) PG8_BAR; }
    PG8_BAR;
    if constexpr (Epi::AFTER_DRAIN) { E.fused(acc, cur, wr, wc, fr, fq, lds, wid, lane); S.done(cur); }
#undef PG8_SA
#undef PG8_SB
#undef PG8_STAGE
#undef PG8_LDA
#undef PG8_LDB
#undef PG8_MMA
#undef PG8_WAIT_V
#undef PG8_WAIT_L
#undef PG8_BAR
#undef PG8_SCHED
}
}
#define GAS __attribute__((address_space(1)))
#define LAS __attribute__((address_space(3)))
typedef unsigned short bf16;
typedef unsigned v4u __attribute__((ext_vector_type(4)));
typedef unsigned v2u __attribute__((ext_vector_type(2)));
typedef float f32x4 __attribute__((ext_vector_type(4)));
constexpr int NWAVES = 8;
constexpr int LDS_BYTES = 147456, LDSCTL_OFF = 131072;
constexpr int CW_BAR = 4096;
constexpr size_t MiB = 1u << 20;
constexpr size_t WS_CTL = 0, CTL_BYTES = 1 * MiB;
constexpr size_t WS_SSQ_A = 256 * 1024, WS_SSQ_B = 320 * 1024, WS_SSQ_C = 384 * 1024, WS_SSQ_D = 448 * 1024;
constexpr size_t WS_STAMP = 128 * 1024;
constexpr size_t WS_BCTR = 192 * 1024;
constexpr size_t WS_SU = 512 * 1024, WS_SV = 768 * 1024;
constexpr size_t WS_WCS = 1 * MiB, WS_ROPE = 2 * MiB, WS_KEYS = 3 * MiB;
constexpr size_t WS_WOF = 8 * MiB, WS_WQKV = 16 * MiB, WS_WOA = 28 * MiB, WS_WQ0 = 36 * MiB, WS_WQ1 = 44 * MiB;
constexpr size_t WS_A2 = 64 * MiB, WS_TW = 65 * MiB;
constexpr size_t WS_U0 = 128 * MiB, WS_V0 = 192 * MiB, WS_U1 = 256 * MiB, WS_V1 = 320 * MiB;
constexpr size_t WS_XG = 384 * MiB, WS_XB = 384 * MiB;
constexpr size_t WS_ZT = 448 * MiB;
constexpr size_t WS_Y = 576 * MiB;
constexpr size_t WS_Q = 448 * MiB;
constexpr size_t WS_EI = 640 * MiB, WS_GW = 648 * MiB, WS_W1 = 656 * MiB, WS_X8 = 664 * MiB;
constexpr size_t WS_PD = 448 * MiB;
constexpr size_t WS_QB = 448 * MiB, WS_KB = 512 * MiB, WS_VT = 528 * MiB, WS_O = 576 * MiB;

__device__ __forceinline__ unsigned f2bf(float f) { unsigned u = __builtin_bit_cast(unsigned, f); return (u + 0x7fffu + ((u >> 16) & 1u)) >> 16; }
__device__ __forceinline__ unsigned pk2(float lo, float hi) { return f2bf(lo) | (f2bf(hi) << 16); }

struct Args { const float* in[12]; float* out; unsigned char* ws; int ph_lo, ph_hi; };

__device__ __forceinline__ int qkv_row(int n) { if (n >= 2560) return n; const int d = n & 63, pc = (d < 32) ? 2 * d : 2 * (d - 32) + 1; return (n & ~63) + pc; }
template <int MODE>
__device__ __forceinline__ void transpose_item(const float* W, int K, int N, const float* gain, bf16* WT, LAS float* scr, int item, int lane) {
    const int nblk = N / 32, kb = item / nblk, nb = item % nblk, k0 = 64 * kb, n0 = 32 * nb;
    float wv[32];
#pragma unroll
    for (int i = 0; i < 32; ++i) wv[i] = W[(size_t)(k0 + 2 * i + (lane >> 5)) * N + n0 + (lane & 31)];
#pragma unroll
    for (int i = 0; i < 32; ++i) { const int kk = 2 * i + (lane >> 5); float v = wv[i]; if (gain) v *= gain[k0 + kk]; scr[kk * 33 + (lane & 31)] = v; }
    asm volatile("s_waitcnt lgkmcnt(0)" ::: "memory");
    const int c = lane & 7;
#pragma unroll
    for (int j = 0; j < 4; ++j) { const int n = (lane >> 3) + 8 * j; const LAS float* s = scr + (8 * c) * 33 + n;
        v4u o; o.x = pk2(s[0 * 33], s[1 * 33]); o.y = pk2(s[2 * 33], s[3 * 33]); o.z = pk2(s[4 * 33], s[5 * 33]); o.w = pk2(s[6 * 33], s[7 * 33]);
        const int row = (MODE == 1) ? qkv_row(n0 + n) : (n0 + n);
        *(v4u*)(WT + (size_t)row * K + k0 + 8 * c) = o; }
    asm volatile("s_waitcnt lgkmcnt(0)" ::: "memory");
}
__device__ __forceinline__ float wsum(float v) {
#pragma unroll
    for (int o = 1; o < 64; o <<= 1) v += __shfl_xor(v, o);
    return v;
}
__device__ __forceinline__ void cvt_stream(const float* src, bf16* dst, size_t n8, size_t gtid, size_t ngt) {
    for (size_t i = gtid; i < n8; i += ngt) {
        const f32x4 a = *(const f32x4*)(src + i * 8), b = *(const f32x4*)(src + i * 8 + 4);
        v4u o; o.x = pk2(a[0], a[1]); o.y = pk2(a[2], a[3]); o.z = pk2(b[0], b[1]); o.w = pk2(b[2], b[3]);
        *(v4u*)(dst + i * 8) = o;
    }
}
__device__ __forceinline__ void cvt_stream8(const float* src, unsigned char* dst, size_t n16, size_t gtid, size_t ngt, float scale) {
    for (size_t i = gtid; i < n16; i += ngt) {
        v4u o;
#pragma unroll
        for (int q = 0; q < 4; ++q) { f32x4 a = *(const f32x4*)(src + i * 16 + 4 * q) * scale;
#pragma unroll
            for (int e = 0; e < 4; ++e) a[e] = fminf(fmaxf(a[e], -448.f), 448.f);
            int w = 0; w = __builtin_amdgcn_cvt_pk_fp8_f32(a[0], a[1], w, false); w = __builtin_amdgcn_cvt_pk_fp8_f32(a[2], a[3], w, true); o[q] = (unsigned)w; }
        const size_t e = i >> 7, r = i & 127, sl = r >> 3, c8 = r & 7;
        *(v4u*)(dst + ((sl * 16384 + e) * 128 + c8 * 16)) = o;
    }
}
#define XB_TMO      128
#define XB_XCNT(j)  (256  + 64 * (j))
#define XB_XSUB(j)  (1280 + 64 * (j))
#define XB_XGEN(j)  (2304 + 64 * (j))
#define XB_TOP      3328
#define XB_TOPGEN   3392
#define XCD_BAR_WORDS 3456
#define XB_SPIN_CAP (1u << 18)

__device__ __forceinline__ unsigned xb_ld(unsigned* p)              { return __hip_atomic_load(p, __ATOMIC_RELAXED, __HIP_MEMORY_SCOPE_AGENT); }
__device__ __forceinline__ unsigned xb_add(unsigned* p, unsigned v) { return __hip_atomic_fetch_add(p, v, __ATOMIC_RELAXED, __HIP_MEMORY_SCOPE_AGENT); }
__device__ __forceinline__ unsigned xb_xcc_id() { return (unsigned)__builtin_amdgcn_s_getreg((3 << 11) | 20) & 0xFu; }
#define XB_SPIN(cond, bar) do { unsigned _sp = 0; while (cond) { __builtin_amdgcn_s_sleep(1); \
    if ((++_sp & 255u) == 0u) { if (xb_ld(&(bar)[XB_TMO])) break; if (_sp > XB_SPIN_CAP) { atomicAdd(&(bar)[XB_TMO], 1u); break; } } } } while (0)

struct XcdBarrier {
    unsigned* bar; unsigned x;
    volatile LAS unsigned* st;
};

__device__ __forceinline__ XcdBarrier xcd_barrier_post(unsigned* bar, volatile LAS unsigned* st) {
    XcdBarrier b; b.bar = bar; b.x = xb_xcc_id(); b.st = st;
    if (threadIdx.x == 0) (void)xb_add(&bar[XB_XCNT(b.x)], 1u);
    return b;
}
__device__ __forceinline__ void xcd_barrier_complete(unsigned* bar, unsigned x, unsigned& nloc, unsigned& nx) {
    const unsigned G = gridDim.x * gridDim.y * gridDim.z;
    unsigned sum, cnt, mine, sp = 0u;
    for (;;) {
        sum = 0u; cnt = 0u; mine = 0u;
#pragma unroll
        for (unsigned j = 0; j < 16; ++j) { const unsigned c = xb_ld(&bar[XB_XCNT(j)]); sum += c; cnt += (c > 0u) ? 1u : 0u; mine = (j == x) ? c : mine; }
        if (sum == G) break;
        __builtin_amdgcn_s_sleep(1);
        if ((++sp & 255u) == 0u) { if (xb_ld(&bar[XB_TMO])) break; if (sp > XB_SPIN_CAP) { atomicAdd(&bar[XB_TMO], 1u); break; } }
    }
    nloc = mine > 0u ? mine : 1u; nx = cnt > 0u ? cnt : 1u;
}

__device__ __forceinline__ void xcd_barrier(const XcdBarrier& b) {
    asm volatile("s_waitcnt vmcnt(0)" ::: "memory");
    __syncthreads();
    if (threadIdx.x == 0) {
        unsigned* bar = b.bar;
        __builtin_amdgcn_s_waitcnt(0);
        unsigned nloc = b.st[0], nx = b.st[1];
        if (nloc == 0u) { xcd_barrier_complete(bar, b.x, nloc, nx); b.st[0] = nloc; b.st[1] = nx; }
        const unsigned old = xb_add(&bar[XB_XSUB(b.x)], 1u);
        const unsigned gen = old / nloc;
        if (old + 1u == (gen + 1u) * nloc) {
            __builtin_amdgcn_fence(__ATOMIC_RELEASE, "agent");
            asm volatile("s_waitcnt vmcnt(0)" ::: "memory");
            const unsigned og = xb_add(&bar[XB_TOP], 1u);
            const unsigned tg = og / nx;
            if (og + 1u == (tg + 1u) * nx) xb_add(&bar[XB_TOPGEN], 1u);
            else XB_SPIN(xb_ld(&bar[XB_TOPGEN]) == tg, bar);
            __builtin_amdgcn_fence(__ATOMIC_ACQUIRE, "agent");
            xb_add(&bar[XB_XGEN(b.x)], 1u);
            asm volatile("s_waitcnt vmcnt(0)" ::: "memory");
        } else {
            XB_SPIN(xb_ld(&bar[XB_XGEN(b.x)]) == gen, bar);
            __builtin_amdgcn_fence(__ATOMIC_ACQUIRE, "agent");
            asm volatile("s_waitcnt vmcnt(0)" ::: "memory");
        }
    }
    __syncthreads();
}
#define U_SCALE 1024.f
#define V_SCALE 256.f
typedef float f32x16 __attribute__((ext_vector_type(16)));
#ifndef TKB
#define TKB 2
#endif
typedef short s16x8 __attribute__((ext_vector_type(8)));
typedef __bf16 bf16x2_t __attribute__((ext_vector_type(2)));
__device__ __forceinline__ unsigned ordf(float f) { const unsigned u = __float_as_uint(f); return (u & 0x80000000u) ? ~u : (u | 0x80000000u); }
__device__ __forceinline__ float unordf(unsigned u) { return __uint_as_float((u & 0x80000000u) ? (u & 0x7fffffffu) : ~u); }
__device__ __forceinline__ unsigned umax_(unsigned a, unsigned b) { return a > b ? a : b; }
#define DPPU(v, ctrl) ((unsigned)__builtin_amdgcn_update_dpp(0, (int)(v), (ctrl), 0xf, 0xf, true))
#define DPPF(v, ctrl) __int_as_float(__builtin_amdgcn_update_dpp(0, __float_as_int(v), (ctrl), 0xf, 0xf, true))
__device__ __forceinline__ unsigned max32(unsigned v) {
    v = umax_(v, DPPU(v, 0xB1)); v = umax_(v, DPPU(v, 0x4E)); v = umax_(v, DPPU(v, 0x141)); v = umax_(v, DPPU(v, 0x140));
    const auto r = __builtin_amdgcn_permlane16_swap(v, v, false, false);
    return umax_(r[0], r[1]);
}
__device__ __forceinline__ float sum16(float v) {
    v += DPPF(v, 0xB1); v += DPPF(v, 0x4E); v += DPPF(v, 0x141); v += DPPF(v, 0x140); return v;
}
__device__ __forceinline__ unsigned bperm(unsigned v, int srclane) { return (unsigned)__builtin_amdgcn_ds_bpermute(srclane << 2, (int)v); }
#define CMPX(a_, b_) do { const unsigned hi_ = umax_(a_, b_), lo_ = (a_ < b_) ? a_ : b_; a_ = hi_; b_ = lo_; } while (0)
__device__ __forceinline__ unsigned max16(unsigned v) { v = umax_(v, DPPU(v, 0xB1)); v = umax_(v, DPPU(v, 0x4E)); v = umax_(v, DPPU(v, 0x141)); v = umax_(v, DPPU(v, 0x140)); return v; }
__device__ __forceinline__ unsigned top16_of8(unsigned (&p)[8], int c) {
    CMPX(p[0], p[1]); CMPX(p[2], p[3]); CMPX(p[4], p[5]); CMPX(p[6], p[7]);
    CMPX(p[0], p[2]); CMPX(p[1], p[3]); CMPX(p[4], p[6]); CMPX(p[5], p[7]);
    CMPX(p[1], p[2]); CMPX(p[5], p[6]); CMPX(p[0], p[4]); CMPX(p[3], p[7]);
    CMPX(p[1], p[5]); CMPX(p[2], p[6]);
    CMPX(p[1], p[4]); CMPX(p[3], p[6]);
    CMPX(p[2], p[4]); CMPX(p[3], p[5]);
    CMPX(p[3], p[4]);
    unsigned W = 0u;
    for (int it = 0; it < 16; ++it) {
        const unsigned m = max16(p[0]);
        W = (c == it) ? m : W;
        const bool win = (p[0] == m);
#pragma unroll
        for (int i = 0; i < 7; ++i) p[i] = win ? p[i + 1] : p[i];
        p[7] = win ? 0u : p[7];
    }
    return W;
}
#define SORT8(p) do { CMPX(p[0], p[1]); CMPX(p[2], p[3]); CMPX(p[4], p[5]); CMPX(p[6], p[7]); CMPX(p[0], p[2]); CMPX(p[1], p[3]); CMPX(p[4], p[6]); CMPX(p[5], p[7]); \
    CMPX(p[1], p[2]); CMPX(p[5], p[6]); CMPX(p[0], p[4]); CMPX(p[3], p[7]); CMPX(p[1], p[5]); CMPX(p[2], p[6]); CMPX(p[1], p[4]); CMPX(p[3], p[6]); CMPX(p[2], p[4]); CMPX(p[3], p[5]); CMPX(p[3], p[4]); } while (0)
__device__ __forceinline__ void top16_of8x2(unsigned (&p)[8], unsigned (&q)[8], int c, unsigned& Wp, unsigned& Wq) {
    SORT8(p); SORT8(q);
    unsigned W0 = 0u, W1 = 0u;
    for (int it = 0; it < 16; ++it) {
        unsigned m0 = umax_(p[0], DPPU(p[0], 0xB1)), m1 = umax_(q[0], DPPU(q[0], 0xB1));
        m0 = umax_(m0, DPPU(m0, 0x4E)); m1 = umax_(m1, DPPU(m1, 0x4E));
        m0 = umax_(m0, DPPU(m0, 0x141)); m1 = umax_(m1, DPPU(m1, 0x141));
        m0 = umax_(m0, DPPU(m0, 0x140)); m1 = umax_(m1, DPPU(m1, 0x140));
        W0 = (c == it) ? m0 : W0; W1 = (c == it) ? m1 : W1;
        const bool w0 = (p[0] == m0), w1 = (q[0] == m1);
#pragma unroll
        for (int i = 0; i < 7; ++i) { p[i] = w0 ? p[i + 1] : p[i]; q[i] = w1 ? q[i + 1] : q[i]; }
        p[7] = w0 ? 0u : p[7]; q[7] = w1 ? 0u : q[7];
    }
    Wp = W0; Wq = W1;
}
__device__ __forceinline__ void top16_of4rx2(unsigned (&p)[4], unsigned (&q)[4], int c, unsigned& Wp, unsigned& Wq) {
    CMPX(p[0], p[1]); CMPX(p[2], p[3]); CMPX(p[0], p[2]); CMPX(p[1], p[3]); CMPX(p[1], p[2]);
    CMPX(q[0], q[1]); CMPX(q[2], q[3]); CMPX(q[0], q[2]); CMPX(q[1], q[3]); CMPX(q[1], q[2]);
    unsigned W0 = 0u, W1 = 0u;
    for (int it = 0; it < 16; ++it) {
        unsigned m0 = umax_(p[0], DPPU(p[0], 0xB1)), m1 = umax_(q[0], DPPU(q[0], 0xB1));
        m0 = umax_(m0, DPPU(m0, 0x4E)); m1 = umax_(m1, DPPU(m1, 0x4E));
        m0 = umax_(m0, DPPU(m0, 0x141)); m1 = umax_(m1, DPPU(m1, 0x141));
        m0 = umax_(m0, DPPU(m0, 0x140)); m1 = umax_(m1, DPPU(m1, 0x140));
        W0 = (c == it) ? m0 : W0; W1 = (c == it) ? m1 : W1;
        const bool w0 = (p[0] == m0), w1 = (q[0] == m1);
        p[0] = w0 ? p[1] : p[0]; p[1] = w0 ? p[2] : p[1]; p[2] = w0 ? p[3] : p[2]; p[3] = w0 ? 0u : p[3];
        q[0] = w1 ? q[1] : q[0]; q[1] = w1 ? q[2] : q[1]; q[2] = w1 ? q[3] : q[2]; q[3] = w1 ? 0u : q[3];
    }
    Wp = W0; Wq = W1;
}
__device__ __forceinline__ unsigned top16_of4r(unsigned (&p)[4], int c) {
    CMPX(p[0], p[1]); CMPX(p[2], p[3]); CMPX(p[0], p[2]); CMPX(p[1], p[3]); CMPX(p[1], p[2]);
    unsigned W = 0u;
    for (int it = 0; it < 16; ++it) {
        const unsigned m = max16(p[0]);
        W = (c == it) ? m : W;
        const bool win = (p[0] == m);
        p[0] = win ? p[1] : p[0]; p[1] = win ? p[2] : p[1]; p[2] = win ? p[3] : p[2]; p[3] = win ? 0u : p[3];
    }
    return W;
}
__device__ __forceinline__ void topk_fill(LAS unsigned char* lds, const bf16* keys, int h, int tid) {
#pragma unroll
    for (int i = 0; i < 8; ++i) { const int idx = tid + 512 * i, p = idx >> 11, key = (idx >> 4) & 127, ch = idx & 15;
        const v4u v = *(const v4u*)(keys + (size_t)((h * 2 + p) * 128 + key) * 128 + ch * 8);
        *(LAS v4u*)(lds + p * 32768 + key * 256 + ((ch ^ (key & 15)) << 4)) = v; }
}
struct CvtCtx { const float* srcU; long dsrc; const float* gain; unsigned char* dstU; long ddst; float* su; long dsc; int gwave, nw; };
__device__ __forceinline__ void cvt_chunk_load(const CvtCtx& cx, int c, int lane, f32x4 (&v)[4]) {
    const int r = c >> 1, hh = c & 1;
    const float* src = cx.srcU + ((r < 16384) ? 0L : cx.dsrc) + (size_t)(r & 16383) * 2048 + hh * 1024 + 4 * lane;
#pragma unroll
    for (int j = 0; j < 4; ++j) v[j] = *(const f32x4*)(src + 256 * j);
}
__device__ __forceinline__ void cvt_chunk_store(const CvtCtx& cx, int c, int lane, f32x4 (&v)[4]) {
    const int r = c >> 1, hh = c & 1; const bool isu = r < 16384; const int e = r & 16383;
    float mx = 0.f;
#pragma unroll
    for (int j = 0; j < 4; ++j) { if (isu) v[j] = v[j] * *(const f32x4*)(cx.gain + hh * 1024 + 256 * j + 4 * lane);
        mx = fmaxf(mx, fmaxf(fmaxf(fabsf(v[j][0]), fabsf(v[j][1])), fmaxf(fabsf(v[j][2]), fabsf(v[j][3])))); }
    mx = fmaxf(mx, DPPF(mx, 0xB1)); mx = fmaxf(mx, DPPF(mx, 0x4E)); mx = fmaxf(mx, DPPF(mx, 0x141)); mx = fmaxf(mx, DPPF(mx, 0x140));
    { const auto rr = __builtin_amdgcn_permlane16_swap(__float_as_uint(mx), __float_as_uint(mx), false, false); mx = fmaxf(__uint_as_float(rr[0]), __uint_as_float(rr[1])); }
    { const auto rr = __builtin_amdgcn_permlane32_swap(__float_as_uint(mx), __float_as_uint(mx), false, false); mx = fmaxf(__uint_as_float(rr[0]), __uint_as_float(rr[1])); }
    const float sc = fmaxf(mx, 1e-30f) * (1.f / 6.f), inv = 1.f / sc;
    if (lane == 0) (cx.su + (isu ? 0L : cx.dsc))[e * 2 + hh] = sc;
    unsigned char* dst = cx.dstU + (isu ? 0L : cx.ddst) + ((size_t)(hh * 4) * 16384 + e) * 128 + 2 * lane;
#pragma unroll
    for (int j = 0; j < 4; ++j) { unsigned w = 0u;
        w = __builtin_amdgcn_cvt_scalef32_pk_fp4_f32(w, v[j][0] * inv, v[j][1] * inv, 1.0f, 0); w = __builtin_amdgcn_cvt_scalef32_pk_fp4_f32(w, v[j][2] * inv, v[j][3] * inv, 1.0f, 1);
        *(unsigned short*)(dst + (size_t)j * (16384 * 128)) = (unsigned short)w; }
}
__device__ __forceinline__ void topk_unit(const bf16* q, LAS const unsigned char* lds, int* EI, float* GW, int t0, int h, int lane) {
    const int c = lane & 15, g4 = lane >> 4, rbase = lane & 48;
    int f0 = 0, f1 = 0, f2 = 0, f3 = 0;
    { int cnt = 0;
#pragma unroll
      for (int i = 0; i < 16; ++i)
#pragma unroll
        for (int j = 0; j < 16; ++j) if ((i + 1) * (j + 1) <= 16) { const int fl = i * 16 + j; f0 = (cnt == c) ? fl : f0; f1 = (cnt == c + 16) ? fl : f1; f2 = (cnt == c + 32) ? fl : f2; f3 = (cnt == c + 48) ? fl : f3; ++cnt; } }
    unsigned W[2][8];
#pragma unroll
    for (int p = 0; p < 2; ++p) {
        f32x4 acc[2][8];
#pragma unroll
        for (int mb = 0; mb < 2; ++mb)
#pragma unroll
            for (int kb = 0; kb < 8; ++kb) acc[mb][kb] = (f32x4){0.f, 0.f, 0.f, 0.f};
        const bf16* qp = q + (size_t)(t0 + c) * 2048 + h * 256 + p * 128 + g4 * 8;
        LAS const unsigned char* kp = lds + p * 32768 + c * 256;
        asm volatile("" : "+v"(qp));
#pragma unroll 2
        for (int ks = 0; ks < 4; ++ks) {
            const s16x8 a0 = *(const s16x8*)(qp + ks * 32), a1 = *(const s16x8*)(qp + (size_t)16 * 2048 + ks * 32);
#pragma unroll
            for (int kb = 0; kb < 8; ++kb) { const s16x8 b = *(LAS const s16x8*)(kp + kb * 4096 + (((4 * ks + g4) ^ c) << 4));
                acc[0][kb] = __builtin_amdgcn_mfma_f32_16x16x32_bf16(a0, b, acc[0][kb], 0, 0, 0); acc[1][kb] = __builtin_amdgcn_mfma_f32_16x16x32_bf16(a1, b, acc[1][kb], 0, 0, 0); }
        }
#pragma unroll
        for (int pb = 0; pb < 8; pb += 2) {
            unsigned pk[8], pq[8];
#pragma unroll
            for (int kb = 0; kb < 8; ++kb) { pk[kb] = (ordf(acc[pb >> 2][kb][pb & 3]) & ~127u) | (unsigned)(127 - 16 * kb - c); pq[kb] = (ordf(acc[(pb + 1) >> 2][kb][(pb + 1) & 3]) & ~127u) | (unsigned)(127 - 16 * kb - c); }
            top16_of8x2(pk, pq, c, W[p][pb], W[p][pb + 1]);
        }
    }
#define TK_CAND(CP, w0_, w1_) do { \
        { const float a0 = unordf(bperm(w0_, rbase + (f0 >> 4)) & ~127u), b0 = unordf(bperm(w1_, rbase + (f0 & 15)) & ~127u); CP[0] = (ordf(a0 + b0) & ~63u) | (unsigned)(63 - c); } \
        { const float a0 = unordf(bperm(w0_, rbase + (f1 >> 4)) & ~127u), b0 = unordf(bperm(w1_, rbase + (f1 & 15)) & ~127u); CP[1] = (ordf(a0 + b0) & ~63u) | (unsigned)(47 - c); } \
        { const float a0 = unordf(bperm(w0_, rbase + (f2 >> 4)) & ~127u), b0 = unordf(bperm(w1_, rbase + (f2 & 15)) & ~127u); CP[2] = (ordf(a0 + b0) & ~63u) | (unsigned)(31 - c); } \
        { const float a0 = unordf(bperm(w0_, rbase + (f3 >> 4)) & ~127u), b0 = unordf(bperm(w1_, rbase + (f3 & 15)) & ~127u); CP[3] = (c + 48 < 50) ? ((ordf(a0 + b0) & ~63u) | (unsigned)(15 - c)) : 0u; } } while (0)
#define TK_FINISH(Wc_, w0_, w1_, pb_) do { \
        const int slot = 63 - (int)((Wc_) & 63u); \
        const unsigned fa = bperm((unsigned)f0, rbase + (slot & 15)), fb = bperm((unsigned)f1, rbase + (slot & 15)), fc = bperm((unsigned)f2, rbase + (slot & 15)), fd = bperm((unsigned)f3, rbase + (slot & 15)); \
        const int sq = slot >> 4; const int flat = (int)((sq == 0) ? fa : (sq == 1) ? fb : (sq == 2) ? fc : fd); \
        const float val = unordf((Wc_) & ~63u); \
        const float vmax = __uint_as_float(bperm(__float_as_uint(val), rbase)); \
        const float e = __expf(val - vmax); \
        const float g = e / sum16(e); \
        const int k1 = 127 - (int)(bperm(w0_, rbase + (flat >> 4)) & 127u), k2 = 127 - (int)(bperm(w1_, rbase + (flat & 15)) & 127u); \
        const int tok = t0 + 16 * ((pb_) >> 2) + 4 * g4 + ((pb_) & 3); \
        EI[(size_t)(tok * 8 + h) * 16 + c] = k1 * 128 + k2; GW[(size_t)(tok * 8 + h) * 16 + c] = g; } while (0)
#pragma unroll
    for (int pb = 0; pb < 8; pb += 2) {
        const unsigned w0a = W[0][pb], w1a = W[1][pb], w0b = W[0][pb + 1], w1b = W[1][pb + 1];
        unsigned cpa[4], cpb[4], Wca, Wcb;
        TK_CAND(cpa, w0a, w1a); TK_CAND(cpb, w0b, w1b);
        top16_of4rx2(cpa, cpb, c, Wca, Wcb);
        TK_FINISH(Wca, w0a, w1a, pb); TK_FINISH(Wcb, w0b, w1b, pb + 1);
    }
#undef TK_CAND
#undef TK_FINISH
}

__device__ __forceinline__ float gelu_tanh_f(float x) {
    const float u = 0.7978845608028654f * (x + 0.044715f * x * x * x);
    const float e = __expf(2.f * u);
    const float th = 1.f - 2.f / (e + 1.f);
    return 0.5f * x * (1.f + th);
}
__device__ __forceinline__ float wave_sum_bfly(float v) {
#pragma unroll
    for (int o = 1; o < 64; o <<= 1) v += __shfl_xor(v, o);
    return v;
}
typedef float f32x2_ __attribute__((ext_vector_type(2)));
#define FP4_DEC(w_, sel_) __builtin_amdgcn_cvt_scalef32_pk_f32_fp4((unsigned)(w_), 1.0f, (sel_))
typedef int i32x8 __attribute__((ext_vector_type(8)));
template <int NBT>
__device__ __forceinline__ void peer_a_slice(const unsigned char* x8, const int* EI, const unsigned char* U4s, float* pd, int s, unsigned* ctr, int nbatch, int lane) {
    const int c = lane & 15, g4 = lane >> 4, k8 = c >> 1;
    const __amdgpu_buffer_rsrc_t trs = __builtin_amdgcn_make_buffer_rsrc((void*)(U4s + (size_t)s * (16384 * 128)), (short)0, 16384 * 128, 0x00020000);
    const unsigned choff = (unsigned)((4 * (c & 1) + g4) * 16);
#define A_FETCH() ((int)__builtin_amdgcn_readfirstlane((int)((lane == 0) ? __hip_atomic_fetch_add(ctr, 1u, __ATOMIC_RELAXED, __HIP_MEMORY_SCOPE_AGENT) : 0u)))
#define A_TOKB(b_, j_) ((((b_) < nbatch) ? (b_) : (nbatch - 1)) * NBT + (j_))
#define A_XS(XS, t_) do { const unsigned char* xp_ = x8 + (size_t)(t_) * 2048 + s * 256 + 128 * (c & 1) + 16 * g4; XS[0] = *(const v4u*)xp_; XS[1] = *(const v4u*)(xp_ + 64); } while (0)
#define A_ISSUE(U, EV) do { _Pragma("unroll") for (int i = 0; i < 8; ++i) { const unsigned e_ = bperm((unsigned)(EV), (i << 3) + k8); U[i] = __builtin_amdgcn_raw_buffer_load_b128(trs, (int)((e_ << 7) | choff), 0, 0); } } while (0)
    const unsigned sb0 = 0x20202020u ^ ((k8 < 4) ? (0x5fu << (8 * k8)) : 0u), sb1 = 0x20202020u ^ ((k8 >= 4) ? (0x5fu << (8 * (k8 - 4))) : 0u);
#define A_MF(U, i, SB) d_ = __builtin_amdgcn_mfma_scale_f32_16x16x128_f8f6f4((i32x8){(int)U[i][0], (int)U[i][1], (int)U[i][2], (int)U[i][3], 0, 0, 0, 0}, hb, d_, 4, 0, 0, 0x7f7f7f7f, (i) & 3, (int)SB)
#define A_COMPUTE(U, OUT) do { f32x4 d_ = (f32x4){0.f, 0.f, 0.f, 0.f}; A_MF(U, 0, sb0); A_MF(U, 1, sb0); A_MF(U, 2, sb0); A_MF(U, 3, sb0); A_MF(U, 4, sb1); A_MF(U, 5, sb1); A_MF(U, 6, sb1); A_MF(U, 7, sb1); \
            OUT = (f32x2_){d_[0] + DPPF(d_[1], 0xB1), d_[2] + DPPF(d_[3], 0xB1)}; } while (0)
    int eL[NBT], eH[NBT], nL[NBT], nH[NBT]; v4u xs[2][2]; v4u UA[8], UB[8];
    int b0 = A_FETCH(), b1 = A_FETCH();
    if (b0 >= nbatch) return;
#pragma unroll
    for (int j = 0; j < NBT; ++j) { const int tj = A_TOKB(b0, j); eL[j] = EI[(size_t)tj * 128 + lane]; eH[j] = EI[(size_t)tj * 128 + 64 + lane]; }
    A_XS(xs[0], A_TOKB(b0, 0));
    A_ISSUE(UA, eL[0]);
    while (b0 < nbatch) {
        const int b2 = A_FETCH();
#pragma unroll
        for (int j = 0; j < NBT; ++j) { const int tj = A_TOKB(b1, j); nL[j] = EI[(size_t)tj * 128 + lane]; nH[j] = EI[(size_t)tj * 128 + 64 + lane]; }
#pragma unroll
        for (int j = 0; j < NBT; ++j) {
            const int t = b0 * NBT + j;
            A_ISSUE(UB, eH[j]);
            const i32x8 hb = (i32x8){(int)xs[j & 1][0][0], (int)xs[j & 1][0][1], (int)xs[j & 1][0][2], (int)xs[j & 1][0][3], (int)xs[j & 1][1][0], (int)xs[j & 1][1][1], (int)xs[j & 1][1][2], (int)xs[j & 1][1][3]};
            f32x2_ out_lo = (f32x2_){0.f, 0.f}, out_hi = (f32x2_){0.f, 0.f};
            A_COMPUTE(UA, out_lo);
            A_XS(xs[(j + 1) & 1], (j + 1 < NBT) ? (b0 * NBT + j + 1) : A_TOKB(b1, 0));
            A_ISSUE(UA, (j + 1 < NBT) ? eL[(j + 1) % NBT] : nL[0]);
            A_COMPUTE(UB, out_hi);
            if ((c & 1) == 0) { float* pp = pd + ((size_t)s * T + t) * 128 + 8 * k8 + 2 * g4; *(f32x2_*)pp = out_lo; *(f32x2_*)(pp + 64) = out_hi; }
        }
#pragma unroll
        for (int j = 0; j < NBT; ++j) { eL[j] = nL[j]; eH[j] = nH[j]; }
        b0 = b1; b1 = b2;
    }
#undef A_FETCH
#undef A_TOKB
#undef A_XS
#undef A_ISSUE
#undef A_COMPUTE
#undef A_MF
}
__device__ __forceinline__ unsigned w8rep(float w) { const float s = fminf(fmaxf(w * 256.f, -448.f), 448.f); return ((unsigned)__builtin_amdgcn_cvt_pk_fp8_f32(s, 0.f, 0, false) & 0xffu) * 0x01010101u; }
__device__ __forceinline__ void peer_a2_token(const float* pd, const float* ssq, const int* EI, const float* su, const float* sv, float* GW, float* W1, int t, int lane) {
    float a0 = 0.f, a1 = 0.f, b0 = 0.f, b1 = 0.f;
#pragma unroll
    for (int s = 0; s < 4; ++s) { const float* pp = pd + ((size_t)s * T + t) * 128; a0 += pp[lane]; a1 += pp[64 + lane]; }
#pragma unroll
    for (int s = 4; s < 8; ++s) { const float* pp = pd + ((size_t)s * T + t) * 128; b0 += pp[lane]; b1 += pp[64 + lane]; }
    const float rs = rsqrtf(ssq[t] * (1.f / 2048.f) + EPS);
    float* gp = GW + (size_t)t * 128; float* hp = W1 + (size_t)t * 128; const int pl = lane;
    const int e0 = EI[(size_t)t * 128 + pl], e1 = EI[(size_t)t * 128 + 64 + pl];
    const float g0 = gp[pl] * gelu_tanh_f(rs * (a0 * su[2 * e0] + b0 * su[2 * e0 + 1])), g1 = gp[64 + pl] * gelu_tanh_f(rs * (a1 * su[2 * e1] + b1 * su[2 * e1 + 1]));
    unsigned* gu = (unsigned*)gp; unsigned* hu = (unsigned*)hp;
    gu[pl] = w8rep(g0 * sv[2 * e0]); hu[pl] = w8rep(g0 * sv[2 * e0 + 1]);
    gu[64 + pl] = w8rep(g1 * sv[2 * e1]); hu[64 + pl] = w8rep(g1 * sv[2 * e1 + 1]);
}
template <int NBT>
__device__ __forceinline__ void peer_b_slice(const bf16* xres, float* xio, const int* EI, const unsigned* W, const unsigned char* V4s, bf16* xb, float* ssq_out, int s, unsigned* ctr, int nbatch, int lane) {
    const int j16 = lane & 15, g4 = lane >> 4;
    const __amdgpu_buffer_rsrc_t trs = __builtin_amdgcn_make_buffer_rsrc((void*)(V4s + (size_t)s * (16384 * 128)), (short)0, 16384 * 128, 0x00020000);
    const unsigned choff = (unsigned)(8 * j16);
    const int doff = s * 256 + 64 * g4 + j16;
    const unsigned bm = 0xffu << (8 * (j16 & 3)); const unsigned M0 = ((j16 >> 2) == 0) ? bm : 0u, M1 = ((j16 >> 2) == 1) ? bm : 0u, M2 = ((j16 >> 2) == 2) ? bm : 0u, M3 = ((j16 >> 2) == 3) ? bm : 0u;
#define B_FETCH() ((int)__builtin_amdgcn_readfirstlane((int)((lane == 0) ? __hip_atomic_fetch_add(ctr, 1u, __ATOMIC_RELAXED, __HIP_MEMORY_SCOPE_AGENT) : 0u)))
#define B_TOKB(b_, j_) ((((b_) < nbatch) ? (b_) : (nbatch - 1)) * NBT + (j_))
#define B_ISSUE(V, EV) do { _Pragma("unroll") for (int i = 0; i < 8; ++i) { const unsigned e0_ = bperm((unsigned)(EV), 8 * i + 2 * g4), e1_ = bperm((unsigned)(EV), 8 * i + 2 * g4 + 1); \
        V[2 * i] = __builtin_amdgcn_raw_buffer_load_b64(trs, (int)((e0_ << 7) | choff), 0, 0); V[2 * i + 1] = __builtin_amdgcn_raw_buffer_load_b64(trs, (int)((e1_ << 7) | choff), 0, 0); } } while (0)
#define B_COMPUTE(V, WV) do { _Pragma("unroll") for (int i = 0; i < 8; ++i) { \
            const unsigned f0_ = bperm((WV), 8 * i + g4), f1_ = bperm((WV), 8 * i + 4 + g4);        \
            const i32x8 bq_ = (i32x8){(int)(f0_ & M0), (int)(f0_ & M1), (int)(f0_ & M2), (int)(f0_ & M3), (int)(f1_ & M0), (int)(f1_ & M1), (int)(f1_ & M2), (int)(f1_ & M3)}; \
            acc = __builtin_amdgcn_mfma_scale_f32_16x16x128_f8f6f4((i32x8){(int)V[2 * i][0], (int)V[2 * i][1], (int)V[2 * i + 1][0], (int)V[2 * i + 1][1], 0, 0, 0, 0}, bq_, acc, 4, 0, 0, 0x7f7f7f7f, 0, 0x77777777); } } while (0)
    int eL[NBT], eH[NBT], nL[NBT], nH[NBT]; unsigned wL[NBT], wH[NBT], mL[NBT], mH[NBT]; float xv[4]; v2u VA[16], VB[16];
    int b0 = B_FETCH(), b1 = B_FETCH();
    if (b0 >= nbatch) return;
#pragma unroll
    for (int j = 0; j < NBT; ++j) { const int tj = B_TOKB(b0, j); eL[j] = EI[(size_t)tj * 128 + lane]; eH[j] = EI[(size_t)tj * 128 + 64 + lane]; wL[j] = W[(size_t)tj * 128 + lane]; wH[j] = W[(size_t)tj * 128 + 64 + lane]; }
    B_ISSUE(VA, eL[0]);
    while (b0 < nbatch) {
        const int b2 = B_FETCH();
#pragma unroll
        for (int j = 0; j < NBT; ++j) { const int tj = B_TOKB(b1, j); nL[j] = EI[(size_t)tj * 128 + lane]; nH[j] = EI[(size_t)tj * 128 + 64 + lane]; mL[j] = W[(size_t)tj * 128 + lane]; mH[j] = W[(size_t)tj * 128 + 64 + lane]; }
#pragma unroll
        for (int j = 0; j < NBT; ++j) {
            const int t = b0 * NBT + j;
            float* xp = xio + (size_t)t * 2048 + doff; const bf16* rp = xres + (size_t)t * 2048 + doff;
#pragma unroll
            for (int r = 0; r < 4; ++r) xv[r] = __uint_as_float((unsigned)rp[16 * r] << 16);
            B_ISSUE(VB, eH[j]);
            f32x4 acc = (f32x4){0.f, 0.f, 0.f, 0.f};
            B_COMPUTE(VA, wL[j]);
            B_ISSUE(VA, (j + 1 < NBT) ? eL[(j + 1) % NBT] : nL[0]);
            B_COMPUTE(VB, wH[j]);
            float ss = 0.f;
#pragma unroll
            for (int r = 0; r < 4; ++r) { const float o = xv[r] + acc[r]; ss += o * o; if (xb) xb[(size_t)t * 2048 + doff + 16 * r] = (bf16)f2bf(o); else xp[16 * r] = o; }
            ss += DPPF(ss, 0xB1); ss += DPPF(ss, 0x4E); ss += DPPF(ss, 0x141); ss += DPPF(ss, 0x140);
            { const auto r = __builtin_amdgcn_permlane16_swap(__float_as_uint(ss), __float_as_uint(ss), false, false); ss = __uint_as_float(r[0]) + __uint_as_float(r[1]); }
            { const auto r = __builtin_amdgcn_permlane32_swap(__float_as_uint(ss), __float_as_uint(ss), false, false); ss = __uint_as_float(r[0]) + __uint_as_float(r[1]); }
            if (lane == 0) unsafeAtomicAdd(ssq_out + t, ss);
        }
#pragma unroll
        for (int j = 0; j < NBT; ++j) { eL[j] = nL[j]; eH[j] = nH[j]; wL[j] = mL[j]; wH[j] = mH[j]; }
        b0 = b1; b1 = b2;
    }
#undef B_FETCH
#undef B_TOKB
#undef B_ISSUE
#undef B_COMPUTE
}
__device__ __forceinline__ void final_norm_row(float* xio, const float* ssq, const float* fin, int t, int lane, float oscale) {
    const float r2 = rsqrtf(ssq[t] * (1.f / 2048.f) + EPS) * oscale;
    float* xr = xio + (size_t)t * 2048 + 4 * lane;
#pragma unroll
    for (int j = 0; j < 8; ++j) { const f32x4 xv = *(const f32x4*)(xr + 256 * j), g = *(const f32x4*)(fin + 256 * j + 4 * lane); f32x4 o;
        o[0] = xv[0] * r2 * g[0]; o[1] = xv[1] * r2 * g[1]; o[2] = xv[2] * r2 * g[2]; o[3] = xv[3] * r2 * g[3]; *(f32x4*)(xr + 256 * j) = o; }
}
typedef short s16x4 __attribute__((ext_vector_type(4)));
__device__ __forceinline__ unsigned cvt_pk_bf16_(float lo, float hi) { unsigned r; asm volatile("v_cvt_pk_bf16_f32 %0, %1, %2" : "=v"(r) : "v"(lo), "v"(hi)); return r; }
constexpr int ATT_K_OFF = 0, ATT_V_OFF = 40960, ATT_VSTRIDE = 648, ATT_LDS = ATT_V_OFF + 64 * ATT_VSTRIDE;
__device__ __forceinline__ void attn_fill_load(const bf16* K, const bf16* Vt, int b, int kvh, int kw0, int tid, v4u (&kr)[5], v2u (&vr)[10]) {
    const size_t tb = (size_t)b * 4096;
#pragma unroll
    for (int i = 0; i < 5; ++i) { const int idx = tid + 512 * i, row = idx >> 3, ch = idx & 7, key = kw0 + row;
        kr[i] = (v4u){0u, 0u, 0u, 0u}; if (key >= 0 && key < 4096) kr[i] = *(const v4u*)(K + (tb + key) * 512 + kvh * 64 + ch * 8); }
#pragma unroll
    for (int i = 0; i < 10; ++i) { const int idx = tid + 512 * i, d = idx / 80, pc = idx % 80, key = kw0 + pc * 4;
        vr[i] = (v2u){0u, 0u}; if (key >= 0 && key < 4096) vr[i] = *(const v2u*)(Vt + (size_t)(kvh * 64 + d) * 16384 + tb + key); }
}
__device__ __forceinline__ void attn_fill_store(LAS unsigned char* lds, int tid, const v4u (&kr)[5], const v2u (&vr)[10]) {
#pragma unroll
    for (int i = 0; i < 5; ++i) { const int idx = tid + 512 * i, row = idx >> 3, ch = idx & 7; *(LAS v4u*)(lds + ATT_K_OFF + row * 128 + ((ch ^ ((row >> 1) & 7)) << 4)) = kr[i]; }
#pragma unroll
    for (int i = 0; i < 10; ++i) { const int idx = tid + 512 * i, d = idx / 80, pc = idx % 80; *(LAS v2u*)(lds + ATT_V_OFF + d * ATT_VSTRIDE + pc * 8) = vr[i]; }
}
__device__ __forceinline__ void attn_task(LAS const unsigned char* lds, const bf16* Q, bf16* O, const float* sinks, int b, int hq, int q0, int kw0, int lane) {
    const int c = lane & 31, hi = lane >> 5;
    const size_t tb = (size_t)b * 4096;
    s16x8 qf[4];
    { const bf16* qp = Q + (tb + q0 + c) * 2048 + hq * 64 + hi * 8;
#pragma unroll
      for (int ks = 0; ks < 4; ++ks) qf[ks] = *(const s16x8*)(qp + ks * 16); }
    const float sink2 = sinks[hq] * 1.4426950408889634f;
    float m = sink2, l = (hi == 0) ? 1.f : 0.f;
    f32x16 o0, o1;
#pragma unroll
    for (int r = 0; r < 16; ++r) { o0[r] = 0.f; o1[r] = 0.f; }
    const int kt_lo = (q0 < 128) ? ((128 - q0) >> 5) : 0, kt_hi = ((4192 - q0) >> 5) < 8 ? ((4192 - q0) >> 5) : 8;
    for (int kt = kt_lo; kt <= kt_hi; ++kt) {
        const int key0 = q0 - 128 + 32 * kt, row0 = key0 - kw0;
        s16x8 kf[4]; s16x4 va[2][2][2];
        { const int row = row0 + c; LAS const unsigned char* kp = lds + ATT_K_OFF + row * 128; const int sw = (row >> 1) & 7;
#pragma unroll
          for (int ks = 0; ks < 4; ++ks) kf[ks] = *(LAS const s16x8*)(kp + (((2 * ks + hi) ^ sw) << 4)); }
#pragma unroll
        for (int db = 0; db < 2; ++db)
#pragma unroll
            for (int s = 0; s < 2; ++s) { LAS const unsigned char* vp = lds + ATT_V_OFF + (db * 32 + c) * ATT_VSTRIDE + (row0 + 16 * s + 4 * hi) * 2; va[db][s][0] = *(LAS const s16x4*)vp; va[db][s][1] = *(LAS const s16x4*)(vp + 16); }
        f32x16 sa;
#pragma unroll
        for (int r = 0; r < 16; ++r) sa[r] = 0.f;
#pragma unroll
        for (int ks = 0; ks < 4; ++ks) sa = __builtin_amdgcn_mfma_f32_32x32x16_bf16(kf[ks], qf[ks], sa, 0, 0, 0);
        if (kt == 0 || kt == 8) {
            const int dbase = key0 - (q0 + c) + 4 * hi;
#pragma unroll
            for (int r = 0; r < 16; ++r) { const int d = dbase + (r & 3) + 8 * (r >> 2); if (d < -128 || d > 128) sa[r] = -1e30f; }
        }
        float mx = sa[0];
#pragma unroll
        for (int r = 1; r < 16; ++r) mx = fmaxf(mx, sa[r]);
        { const auto rr = __builtin_amdgcn_permlane32_swap(__float_as_uint(mx), __float_as_uint(mx), false, false); mx = fmaxf(__uint_as_float(rr[0]), __uint_as_float(rr[1])); }
        const float mn = fmaxf(m, mx), alpha = __builtin_amdgcn_exp2f(m - mn);
        m = mn;
        float ps = 0.f;
#pragma unroll
        for (int r = 0; r < 16; ++r) { sa[r] = __builtin_amdgcn_exp2f(sa[r] - mn); ps += sa[r]; }
        l = l * alpha + ps;
#pragma unroll
        for (int r = 0; r < 16; ++r) { o0[r] *= alpha; o1[r] *= alpha; }
        s16x8 pf[2];
#pragma unroll
        for (int s = 0; s < 2; ++s) { v4u w; w.x = cvt_pk_bf16_(sa[8 * s + 0], sa[8 * s + 1]); w.y = cvt_pk_bf16_(sa[8 * s + 2], sa[8 * s + 3]); w.z = cvt_pk_bf16_(sa[8 * s + 4], sa[8 * s + 5]); w.w = cvt_pk_bf16_(sa[8 * s + 6], sa[8 * s + 7]);
            pf[s] = __builtin_bit_cast(s16x8, w); }
#pragma unroll
        for (int s = 0; s < 2; ++s) {
            const s16x8 v0 = __builtin_shufflevector(va[0][s][0], va[0][s][1], 0, 1, 2, 3, 4, 5, 6, 7), v1 = __builtin_shufflevector(va[1][s][0], va[1][s][1], 0, 1, 2, 3, 4, 5, 6, 7);
            o0 = __builtin_amdgcn_mfma_f32_32x32x16_bf16(v0, pf[s], o0, 0, 0, 0);
            o1 = __builtin_amdgcn_mfma_f32_32x32x16_bf16(v1, pf[s], o1, 0, 0, 0);
        }
    }
    { const auto rr = __builtin_amdgcn_permlane32_swap(__float_as_uint(l), __float_as_uint(l), false, false); l = __uint_as_float(rr[0]) + __uint_as_float(rr[1]); }
    const float il = 1.f / l;
    bf16* op = O + (tb + q0 + c) * 2048 + hq * 64 + 4 * hi;
#pragma unroll
    for (int g = 0; g < 4; ++g) {
        v2u w0, w1;
        w0.x = cvt_pk_bf16_(o0[4 * g + 0] * il, o0[4 * g + 1] * il); w0.y = cvt_pk_bf16_(o0[4 * g + 2] * il, o0[4 * g + 3] * il);
        w1.x = cvt_pk_bf16_(o1[4 * g + 0] * il, o1[4 * g + 1] * il); w1.y = cvt_pk_bf16_(o1[4 * g + 2] * il, o1[4 * g + 3] * il);
        *(v2u*)(op + 8 * g) = w0; *(v2u*)(op + 32 + 8 * g) = w1;
    }
}
typedef float fx2 __attribute__((ext_vector_type(2)));
__device__ __forceinline__ fx2 bf2_(unsigned w) { fx2 r; r[0] = __uint_as_float(w << 16); r[1] = __uint_as_float(w & 0xffff0000u); return r; }
__device__ __forceinline__ void fft16_item(bf16* Zp, const float* tw, int bg, int l, int s1h, int lane) {
    const int s1 = s1h * 128 + 2 * lane;
    bf16* base = Zp + ((size_t)(bg * 16) * 256 + l) * 512 + s1;
    fx2 zr[16], zi[16];
#pragma unroll
    for (int s2 = 0; s2 < 16; ++s2) { zr[s2] = bf2_(*(const unsigned*)(base + (size_t)s2 * 256 * 512)); zi[s2] = bf2_(*(const unsigned*)(base + (size_t)s2 * 256 * 512 + 256)); }
    fx2 er[16], ei[16];
#pragma unroll
    for (int d = 0; d < 4; ++d) {
        const fx2 ar = zr[d], ai_ = zi[d], br = zr[4 + d], bi = zi[4 + d], cr = zr[8 + d], ci = zi[8 + d], dr = zr[12 + d], di = zi[12 + d];
        const fx2 s0r = ar + cr, s0i = ai_ + ci, s1r = ar - cr, s1i = ai_ - ci, s2r = br + dr, s2i = bi + di, s3r = br - dr, s3i = bi - di;
        er[0 * 4 + d] = s0r + s2r; ei[0 * 4 + d] = s0i + s2i;
        er[1 * 4 + d] = s1r + s3i; ei[1 * 4 + d] = s1i - s3r;
        er[2 * 4 + d] = s0r - s2r; ei[2 * 4 + d] = s0i - s2i;
        er[3 * 4 + d] = s1r - s3i; ei[3 * 4 + d] = s1i + s3r;
    }
#pragma unroll
    for (int a = 1; a < 4; ++a)
#pragma unroll
        for (int d = 1; d < 4; ++d) {
            const float ang = 6.283185307179586f * (float)(a * d) / 16.f; const float c = __builtin_cosf(ang), sn = __builtin_sinf(ang);
            const fx2 xr = er[a * 4 + d], xi = ei[a * 4 + d];
            er[a * 4 + d] = xr * c + xi * sn; ei[a * 4 + d] = xi * c - xr * sn;
        }
#pragma unroll
    for (int a = 0; a < 4; ++a) {
        const fx2 ar = er[a * 4 + 0], ai_ = ei[a * 4 + 0], br = er[a * 4 + 1], bi = ei[a * 4 + 1], cr = er[a * 4 + 2], ci = ei[a * 4 + 2], dr = er[a * 4 + 3], di = ei[a * 4 + 3];
        const fx2 s0r = ar + cr, s0i = ai_ + ci, s1r = ar - cr, s1i = ai_ - ci, s2r = br + dr, s2i = bi + di, s3r = br - dr, s3i = bi - di;
        fx2 Dr[4], Di[4];
        Dr[0] = s0r + s2r; Di[0] = s0i + s2i; Dr[1] = s1r + s3i; Di[1] = s1i - s3r; Dr[2] = s0r - s2r; Di[2] = s0i - s2i; Dr[3] = s1r - s3i; Di[3] = s1i + s3r;
#pragma unroll
        for (int b = 0; b < 4; ++b) {
            const int k2 = a + 4 * b;
            const f32x4 t0 = *(const f32x4*)(tw + (size_t)(k2 * 256 + s1) * 2);
            const fx2 cc = (fx2){t0[0], t0[2]}, ss = (fx2){t0[1], t0[3]};
            const fx2 hr = Dr[b] * cc + Di[b] * ss, hi_ = Di[b] * cc - Dr[b] * ss;
            *(unsigned*)(base + (size_t)k2 * 256 * 512) = pk2(hr[0], hr[1]); *(unsigned*)(base + (size_t)k2 * 256 * 512 + 256) = pk2(hi_[0], hi_[1]);
        }
    }
}
__device__ __forceinline__ int static_unit(int nM, int nN, int G, int c, int i) {
    const int nwg = nM * nN; const long L = (long)i * G + c; if (L >= nwg) return -1;
    int wgid = (int)L; { const int q = nwg / 8, r = nwg % 8, xcd = wgid % 8, off = wgid / 8; wgid = (xcd < r ? xcd * (q + 1) : r * (q + 1) + (xcd - r) * q) + off; }
    const int nig = 8 * nN, gid = wgid / nig, fm = gid * 8, gsz = (nM - fm) < 8 ? (nM - fm) : 8;
    return ((fm + ((wgid % nig) % gsz)) << 16) | ((wgid % nig) / gsz);
}
#ifndef REP_PRO
#define REP_PRO 1
#endif
#ifndef REP_GEMM
#define REP_GEMM 1
#endif
#ifndef REP_ATT
#define REP_ATT 1
#endif
#ifndef REP_LITE
#define REP_LITE 0
#endif
#ifndef REP_Q
#define REP_Q 1
#endif
#ifndef REP_PA
#define REP_PA 1
#endif
#ifndef REP_TK
#define REP_TK 1
#endif
enum { PH_PRO = 0, PH_G1 = 1, PH_S1 = 2, PH_G2 = 3, PH_G3 = 4, PH_Q0 = 5, PH_TK0 = 6, PH_PA0 = 7, PH_PW0 = 8, PH_PB0 = 9, PH_QKV = 10, PH_ATT = 11, PH_WO = 12, PH_Q1 = 13, PH_TK1 = 14, PH_PA1 = 15, PH_PW1 = 16, PH_PB1 = 17, PH_FIN = 18, PH_END = 19 };
__global__ void __launch_bounds__(NWAVES * 64, 2) mega(Args a) {
    extern __shared__ __attribute__((aligned(16))) unsigned char lds_raw[];
    LAS unsigned char* lds = (LAS unsigned char*)lds_raw;
    cg::grid_group grid = cg::this_grid();
    const int wave = __builtin_amdgcn_readfirstlane(threadIdx.x >> 6);
#define FRESH_IDS() int lane; asm volatile("v_mbcnt_lo_u32_b32 %0, -1, 0\n\tv_mbcnt_hi_u32_b32 %0, -1, %0" : "=v"(lane)); const int tid = wave * 64 + lane; (void)tid
    const int G = gridDim.x, bx = blockIdx.x;
    unsigned char* ws = a.ws;
    const int lo = a.ph_lo, hi = a.ph_hi;
    volatile LAS unsigned* MISC = (volatile LAS unsigned*)(lds + LDSCTL_OFF);
    if (threadIdx.x < 16) MISC[threadIdx.x] = 0u;
    __syncthreads();
    XcdBarrier xbar = xcd_barrier_post((unsigned*)(ws + WS_CTL) + CW_BAR, MISC + 8);
#define IN(k) (lo <= (k) && (k) < hi)
#ifdef DIAG_A
#define STAMP(i) do { if (bx == 0 && threadIdx.x == 0) ((unsigned long long*)(ws + WS_STAMP))[i] = __builtin_amdgcn_s_memrealtime(); } while (0)
#else
#define STAMP(i) do { } while (0)
#endif
#define SEAM(k) do { if (IN(k) && IN((k) + 1)) { if ((k) == PH_PRO) grid.sync(); else xcd_barrier(xbar); } STAMP((k) + 1); } while (0)
    STAMP(0);
    for (int rep_ = 0; rep_ < REP_PRO; ++rep_)
    if (IN(PH_PRO)) { FRESH_IDS();
        const int gw = bx * NWAVES + wave, NGW = G * NWAVES;
        const size_t gtid = (size_t)bx * (NWAVES * 64) + tid, ngt = (size_t)G * NWAVES * 64;
        LAS float* scr = (LAS float*)(lds + wave * 16384);
        {
            constexpr int I_SQ = (DM / 64) * (DM / 32), I_QKV = (DM / 64) * (QKVW / 32);
            constexpr int NITEMS = 4 * I_SQ + I_QKV;
            for (int it = gw; it < NITEMS; it += NGW) {
                int r = it;
                if (r < I_SQ) { transpose_item<0>(a.in[3], DM, DM, nullptr, (bf16*)(ws + WS_WOF), scr, r, lane); continue; } r -= I_SQ;
                if (r < I_SQ) { transpose_item<0>(a.in[5], DM, DM, nullptr, (bf16*)(ws + WS_WOA), scr, r, lane); continue; } r -= I_SQ;
                if (r < I_SQ) { transpose_item<0>(a.in[7], DM, DM, a.in[2], (bf16*)(ws + WS_WQ0), scr, r, lane); continue; } r -= I_SQ;
                if (r < I_SQ) { transpose_item<0>(a.in[7] + (size_t)DM * DM, DM, DM, a.in[2] + DM, (bf16*)(ws + WS_WQ1), scr, r, lane); continue; } r -= I_SQ;
                transpose_item<1>(a.in[4], DM, QKVW, a.in[1] + DM, (bf16*)(ws + WS_WQKV), scr, r, lane);
            }
        }
        {
            f32x4 v[8], nv[8];
            { const f32x4* xr = (const f32x4*)(a.in[0] + (size_t)(gw < T ? gw : 0) * DM) + lane;
#pragma unroll
              for (int j = 0; j < 8; ++j) v[j] = xr[64 * j]; }
            for (int row = gw; row < T; row += NGW) {
                { const int nr = (row + NGW < T) ? row + NGW : row; const f32x4* xr = (const f32x4*)(a.in[0] + (size_t)nr * DM) + lane;
#pragma unroll
                  for (int j = 0; j < 8; ++j) nv[j] = xr[64 * j]; }
                const f32x4* gr = (const f32x4*)a.in[1] + lane;
                float s = 0.f;
#pragma unroll
                for (int j = 0; j < 8; ++j) s += (v[j][0] * v[j][0] + v[j][1] * v[j][1]) + (v[j][2] * v[j][2] + v[j][3] * v[j][3]);
                const float r = rsqrtf(wsum(s) * (1.f / DM) + EPS);
                const int b = row >> 12, sp = row & 4095;
#pragma unroll
                for (int j = 0; j < 8; ++j) { const f32x4 gg = gr[64 * j]; v2u o; o.x = pk2(v[j][0] * r * gg[0], v[j][1] * r * gg[1]); o.y = pk2(v[j][2] * r * gg[2], v[j][3] * r * gg[3]);
                    *(v2u*)((bf16*)(ws + WS_XG) + ((size_t)((b * 8 + j) * 4096 + sp) * 256 + 4 * lane)) = o; }
#pragma unroll
                for (int j = 0; j < 8; ++j) v[j] = nv[j];
            }
        }
        for (size_t i = gtid; i < (size_t)256 * 512 / 8; i += ngt) {
            const int k1 = (int)(i >> 6), c0 = (int)(i & 63) * 8, part = c0 >> 8, s0 = c0 & 255;
            float v[8];
#pragma unroll
            for (int e = 0; e < 8; ++e) { const int m = (k1 * (s0 + e)) & 255; const float rev = (float)m * (1.f / 256.f); v[e] = (part ? __builtin_amdgcn_sinf(rev) : __builtin_amdgcn_cosf(rev)) * (1.f / 64.f); }
            v4u o; o.x = pk2(v[0], v[1]); o.y = pk2(v[2], v[3]); o.z = pk2(v[4], v[5]); o.w = pk2(v[6], v[7]);
            *(v4u*)((bf16*)(ws + WS_A2) + i * 8) = o;
        }
        for (size_t i = gtid; i < (size_t)16 * 256; i += ngt) {
            const int k2 = (int)(i >> 8), s1 = (int)(i & 255); const float rev = (float)(k2 * s1) * (1.f / 4096.f);
            ((float*)(ws + WS_TW))[2 * i] = __builtin_amdgcn_cosf(rev); ((float*)(ws + WS_TW))[2 * i + 1] = __builtin_amdgcn_sinf(rev);
        }
        for (size_t i = gtid; i < (size_t)512 * 256 / 8; i += ngt) {
            const int n = (int)(i >> 5), c0 = (int)(i & 31) * 8, part = n >> 8, l = n & 255;
            float v[8];
#pragma unroll
            for (int e = 0; e < 8; ++e) { const int m = (l * (c0 + e)) & 255; const float rev = (float)m * (1.f / 256.f); v[e] = (part ? -__builtin_amdgcn_sinf(rev) : __builtin_amdgcn_cosf(rev)) * (1.f / 16.f); }
            v4u o; o.x = pk2(v[0], v[1]); o.y = pk2(v[2], v[3]); o.z = pk2(v[4], v[5]); o.w = pk2(v[6], v[7]);
            *(v4u*)((bf16*)(ws + WS_WCS) + i * 8) = o;
        }
        for (size_t i = gtid; i < (size_t)4096 * 32; i += ngt) {
            const int pos = (int)(i >> 5), fi = (int)(i & 31);
            const double inv = exp2(-(double)fi * (13.287712379549449 / 32.0));
            double sn, cs; sincos((double)pos * inv, &sn, &cs);
            ((float*)(ws + WS_ROPE))[2 * i] = (float)cs; ((float*)(ws + WS_ROPE))[2 * i + 1] = (float)sn;
        }
#pragma unroll 1
        for (int L = 0; L < 2; ++L) {
            CvtCtx cx; cx.srcU = a.in[9] + (size_t)L * NEXP * DM; cx.dsrc = (long)((a.in[10] + (size_t)L * NEXP * DM) - cx.srcU); cx.gain = a.in[2] + L * DM; cx.dstU = ws + (L ? WS_U1 : WS_U0); cx.ddst = (long)WS_V0 - (long)WS_U0;
            cx.su = (float*)(ws + WS_SU) + L * 32768; cx.dsc = ((long)WS_SV - (long)WS_SU) / 4; cx.gwave = gw; cx.nw = NGW;
            f32x4 c0[4], c1[4], n0[4], n1[4];
            cvt_chunk_load(cx, gw, lane, c0); cvt_chunk_load(cx, (gw + NGW < 65536) ? gw + NGW : gw, lane, c1);
            for (int cc = gw; cc < 65536; cc += 2 * NGW) { const int ca = cc + 2 * NGW, cb = cc + 3 * NGW;
                cvt_chunk_load(cx, ca < 65536 ? ca : cc, lane, n0); cvt_chunk_load(cx, cb < 65536 ? cb : cc, lane, n1);
                cvt_chunk_store(cx, cc, lane, c0); if (cc + NGW < 65536) cvt_chunk_store(cx, cc + NGW, lane, c1);
#pragma unroll
                for (int q = 0; q < 4; ++q) { c0[q] = n0[q]; c1[q] = n1[q]; } }
        }
        cvt_stream(a.in[8], (bf16*)(ws + WS_KEYS), (size_t)2 * PH * 2 * 128 * 128 / 8, gtid, ngt);
    }
    SEAM(PH_PRO);
    for (int rep_ = 0; rep_ < REP_GEMM; ++rep_)
    if (IN(PH_G1)) { FRESH_IDS();
        int Kq = FW; asm volatile("" : "+s"(Kq));
        pg8::Gemm g{(const pg8::bf16_t*)(ws + WS_WCS), (const pg8::bf16_t*)(ws + WS_XG), 512, T * FG, Kq}; pg8::StaticOrder S; S.init(512, T * FG, G, bx);
        pg8::EpiZt E{(pg8::bf16_t*)(ws + WS_ZT)};
        pg8::gemm_phase<pg8::EpiZt, pg8::StaticOrder, true, true>(lds, g, S, E);
    }
    SEAM(PH_G1);
    if (IN(PH_S1)) { FRESH_IDS();
        const int gw = bx * NWAVES + wave, NGW = G * NWAVES;
        for (int it = gw; it < 32 * 256 * 2; it += NGW) fft16_item((bf16*)(ws + WS_ZT), (const float*)(ws + WS_TW), it >> 9, (it >> 1) & 255, it & 1, lane);
    }
    SEAM(PH_S1);
    for (int rep_ = 0; rep_ < REP_GEMM; ++rep_)
    if (IN(PH_G2)) { FRESH_IDS();
        pg8::Gemm g{(const pg8::bf16_t*)(ws + WS_A2), (const pg8::bf16_t*)(ws + WS_ZT), 256, 131072, 512}; pg8::StaticOrder S; S.init(256, 131072, G, bx);
        pg8::EpiY E{(pg8::bf16_t*)(ws + WS_Y)};
        pg8::gemm_phase<pg8::EpiY, pg8::StaticOrder, true, true>(lds, g, S, E);
    }
    SEAM(PH_G2);
    if (IN(PH_G3)) { FRESH_IDS();
        pg8::Gemm g{(const pg8::bf16_t*)(ws + WS_Y), (const pg8::bf16_t*)(ws + WS_WOF), T, DM, DM}; pg8::StaticOrder S; S.init(T, DM, G, bx);
        pg8::EpiRes E{a.in[0], a.out, (pg8::bf16_t*)(ws + WS_XB), (float*)(ws + WS_SSQ_A), ws + WS_X8};
        pg8::gemm_phase<pg8::EpiRes, pg8::StaticOrder, true, true>(lds, g, S, E);
    }
    SEAM(PH_G3);
#define PEER_LAYER(L) do { \
        const int pq = L ? PH_Q1 : PH_Q0, ptk = L ? PH_TK1 : PH_TK0, ppa = L ? PH_PA1 : PH_PA0, ppw = L ? PH_PW1 : PH_PW0, ppb = L ? PH_PB1 : PH_PB0; \
        for (int rep_ = 0; rep_ < REP_Q; ++rep_) \
        if (IN(pq)) { FRESH_IDS(); \
            pg8::Gemm g{(const pg8::bf16_t*)(ws + WS_XB), (const pg8::bf16_t*)(ws + (L ? WS_WQ1 : WS_WQ0)), T, DM, DM}; pg8::StaticOrder S; S.init(T, DM, G, bx); \
            pg8::EpiScale E{(pg8::bf16_t*)(ws + WS_Q), (const float*)(ws + (L ? WS_SSQ_C : WS_SSQ_A))}; \
            pg8::gemm_phase<pg8::EpiScale, pg8::StaticOrder, true, true>(lds, g, S, E); \
        } \
        if (IN(pq) && IN(ptk)) { asm volatile("s_waitcnt vmcnt(0)" ::: "memory"); __syncthreads(); } STAMP(pq + 1); \
        if (IN(ptk)) { FRESH_IDS(); \
            const bf16* keys = (const bf16*)(ws + WS_KEYS) + (size_t)L * PH * 2 * 128 * 128; \
            int slot = 0; \
            for (int rep_ = 0; rep_ < REP_TK; ++rep_) { slot = 0; \
            for (int ui = 0; ; ++ui) {        \
                const int upk = static_unit(T / 256, DM / 256, G, bx, ui); if (upk < 0) break; \
                const int h = upk & 0xffff, tblk = upk >> 16; \
                __syncthreads(); \
                topk_fill(lds, keys, h, tid); \
                __syncthreads(); \
                topk_unit((const bf16*)(ws + WS_Q), lds, (int*)(ws + WS_EI), (float*)(ws + WS_GW), tblk * 256 + wave * 32, h, lane); \
                slot += 16; \
            } } \
        } \
        SEAM(ptk); \
        if (IN(ppa)) { FRESH_IDS(); \
            const int xv = bx & 7; \
            peer_a_slice<8>((const unsigned char*)(ws + WS_X8), (const int*)(ws + WS_EI), (const unsigned char*)(ws + (L ? WS_U1 : WS_U0)), (float*)(ws + WS_PD), xv, (unsigned*)(ws + WS_BCTR) + (L * 2 + 0) * 512 + xv * 64, T / 8, lane); \
        } \
        SEAM(ppa); \
        if (IN(ppw)) { FRESH_IDS(); \
            const int gw = bx * NWAVES + wave, NGW = G * NWAVES; \
            for (int t = gw; t < T; t += NGW) peer_a2_token((const float*)(ws + WS_PD), (const float*)(ws + (L ? WS_SSQ_C : WS_SSQ_A)), (const int*)(ws + WS_EI), (const float*)(ws + WS_SU) + L * 32768, (const float*)(ws + WS_SV) + L * 32768, (float*)(ws + WS_GW), (float*)(ws + WS_W1), t, lane); \
        } \
        SEAM(ppw); \
        if (IN(ppb)) { FRESH_IDS(); \
            const int xv = bx & 7; \
            peer_b_slice<4>((const bf16*)(ws + WS_XB), a.out, (const int*)(ws + WS_EI), (const unsigned*)(ws + ((xv < 4) ? WS_GW : WS_W1)), (const unsigned char*)(ws + (L ? WS_V1 : WS_V0)), L ? (bf16*)nullptr : (bf16*)(ws + WS_XB), (float*)(ws + (L ? WS_SSQ_D : WS_SSQ_B)), xv, (unsigned*)(ws + WS_BCTR) + (L * 2 + 1) * 512 + xv * 64, T / 4, lane); \
        } \
    } while (0)
    float oscale = 1.f;
    PEER_LAYER(0);
    SEAM(PH_PB0);
    for (int rep_ = 0; rep_ < REP_GEMM; ++rep_)
    if (IN(PH_QKV)) { FRESH_IDS();
        {
            pg8::Gemm g{(const pg8::bf16_t*)(ws + WS_XB), (const pg8::bf16_t*)(ws + WS_WQKV), T, 2560, DM}; pg8::StaticOrder S; S.init(T, 2560, G, bx);
            pg8::EpiQK E{(pg8::bf16_t*)(ws + WS_QB), (pg8::bf16_t*)(ws + WS_KB), (const float*)(ws + WS_SSQ_B), (const float*)(ws + WS_ROPE), 0.125f * 1.4426950408889634f};
            pg8::gemm_phase<pg8::EpiQK, pg8::StaticOrder, true, true>(lds, g, S, E);
        }
        if (bx >= G / 2) {
            pg8::Gemm g{(const pg8::bf16_t*)(ws + WS_WQKV) + (size_t)2560 * DM, (const pg8::bf16_t*)(ws + WS_XB), 512, T, DM}; pg8::StaticOrder S; S.init(512, T, G / 2, bx - G / 2);
            pg8::EpiVt E{(pg8::bf16_t*)(ws + WS_VT), (const float*)(ws + WS_SSQ_B)};
            pg8::gemm_phase<pg8::EpiVt, pg8::StaticOrder, true, true>(lds, g, S, E);
        }
    }
    SEAM(PH_QKV);
    for (int rep_ = 0; rep_ < REP_ATT; ++rep_)
    if (IN(PH_ATT)) { FRESH_IDS();
        for (int vb = bx; vb < 256; vb += G) {
            const int bkv = vb >> 3, chunk = vb & 7, b = bkv >> 3, kvh = bkv & 7;
            v4u kr[5]; v2u vr[10];
            attn_fill_load((const bf16*)(ws + WS_KB), (const bf16*)(ws + WS_VT), b, kvh, chunk * 8 * 64 - 128, tid, kr, vr);
            for (int i = 0; i < 8; ++i) {
                const int qu = (chunk * 8 + i) * 64;
                __syncthreads();
                attn_fill_store(lds, tid, kr, vr);
                __syncthreads();
                if (i + 1 < 8) attn_fill_load((const bf16*)(ws + WS_KB), (const bf16*)(ws + WS_VT), b, kvh, qu + 64 - 128, tid, kr, vr);
                attn_task(lds, (const bf16*)(ws + WS_QB), (bf16*)(ws + WS_O), a.in[6], b, kvh * 4 + (wave & 3), qu + (wave >> 2) * 32, qu - 128, lane);
            }
        }
    }
    SEAM(PH_ATT);
    if (IN(PH_WO)) { FRESH_IDS();
        pg8::Gemm g{(const pg8::bf16_t*)(ws + WS_O), (const pg8::bf16_t*)(ws + WS_WOA), T, DM, DM}; pg8::StaticOrder S; S.init(T, DM, G, bx);
        pg8::EpiResB E{(const pg8::bf16_t*)(ws + WS_XB), (pg8::bf16_t*)(ws + WS_XB), (float*)(ws + WS_SSQ_C), ws + WS_X8};
        pg8::gemm_phase<pg8::EpiResB, pg8::StaticOrder, true, true>(lds, g, S, E);
    }
    SEAM(PH_WO);
#ifdef DIAG_A
    { const unsigned long long* st = (const unsigned long long*)(ws + WS_STAMP); oscale = 1.f + sqrtf((float)(st[DIAG_B] - st[DIAG_A]) * 1e-6f); }
#endif
    PEER_LAYER(1);
#undef PEER_LAYER
    SEAM(PH_PB1);
    if (IN(PH_FIN)) { FRESH_IDS();
        const int gw = bx * NWAVES + wave, NGW = G * NWAVES;
        for (int t = gw; t < T; t += NGW) final_norm_row(a.out, (const float*)(ws + WS_SSQ_D), a.in[11], t, lane, oscale);
    }
#undef SEAM
#undef IN
}

#ifndef N_LAUNCHES
#define N_LAUNCHES 1
#endif
extern "C" void kernel_launch(void* const* d_in, const int* in_sizes, int n_in, void* d_out, int out_size, void* d_ws, size_t ws_size, hipStream_t stream) {
    static int grid = 0;
    if (!grid) {
        if (hipFuncSetAttribute((const void*)mega, hipFuncAttributeMaxDynamicSharedMemorySize, LDS_BYTES) != hipSuccess) { fprintf(stderr, "hipFuncSetAttribute failed\n"); }
        int dev = 0, cus = 0, per_cu = 0;
        (void)hipGetDevice(&dev);
        (void)hipDeviceGetAttribute(&cus, hipDeviceAttributeMultiprocessorCount, dev);
        if (hipOccupancyMaxActiveBlocksPerMultiprocessor(&per_cu, (const void*)mega, NWAVES * 64, LDS_BYTES) != hipSuccess) per_cu = 0;
        (void)hipGetLastError();
        grid = cus * per_cu;
        if (grid > 256) grid = 256;
        grid &= ~1;
        if (grid < 2) { fprintf(stderr, "occupancy query gave %d x %d\n", cus, per_cu); grid = -1; }
    }
    if (grid < 0) return;
    if (ws_size < 700 * MiB) { fprintf(stderr, "ws too small: %zu\n", ws_size); return; }
    (void)hipMemsetAsync((char*)d_ws + WS_CTL, 0, CTL_BYTES, stream);
    Args a{};
    for (int i = 0; i < 12; ++i) a.in[i] = (const float*)d_in[i];
    a.out = (float*)d_out; a.ws = (unsigned char*)d_ws;
    if (N_LAUNCHES == 1) {
        a.ph_lo = 0; a.ph_hi = PH_END;
        void* args[] = {&a};
        const hipError_t e = hipLaunchCooperativeKernel((const void*)mega, dim3(grid), dim3(NWAVES * 64), args, LDS_BYTES, stream);
        if (e != hipSuccess) fprintf(stderr, "cooperative launch failed: %s (grid %d)\n", hipGetErrorString(e), grid);
    } else {
        for (int ph = 0; ph < PH_END; ++ph) {
            a.ph_lo = ph; a.ph_hi = ph + 1;
            hipLaunchKernelGGL(mega, dim3(grid), dim3(NWAVES * 64), LDS_BYTES, stream, a);
        }
    }
}
```

```cpp
#include <hip/hip_runtime.h>
#include <hip/hip_cooperative_groups.h>
namespace cg = cooperative_groups;
#include <cstdio>
#include <cstdint>
#include <cmath>

constexpr int DM = 2048, NB = 4, SEQ = 4096, T = NB * SEQ;
constexpr int FG = 8, FW = 256;
constexpr int HD = 64, NQH = 32, NKVH = 8, QKVW = 3072;
constexpr int PH = 8, NKEYS = 128, NEXP = 16384, PTOPK = 16;
constexpr float EPS = 1e-6f;
namespace pg8 {
#define PG8_LAS __attribute__((address_space(3)))
typedef unsigned short bf16_t;
typedef short bf16x8 __attribute__((ext_vector_type(8)));
typedef float f32x4 __attribute__((ext_vector_type(4)));
typedef unsigned u32x4 __attribute__((ext_vector_type(4)));
constexpr int BM = 256, BK = 64, HALF = 128, HTB = HALF * BK * 2  , STAGE_BYTES = 8 * HTB, NXCD = 8, WGM = 8;

__host__ __device__ __forceinline__ int lds_byte(int r, int c) { const int st = (r >> 4) * 2 + (c >> 5), rr = r & 15, cc = c & 31, ob = rr * 64 + cc * 2; return st * 1024 + (ob ^ (((ob >> 9) & 1) << 5)); }
__host__ __device__ __forceinline__ void stage_rc(int b, int& R, int& C) { const int st = b / 1024, sb = b % 1024, swz = sb ^ (((sb >> 9) & 1) << 5); R = (st >> 1) * 16 + swz / 64; C = (st & 1) * 32 + (swz % 64) / 2; }
__host__ __device__ __forceinline__ int perm32(int rho) { const int n = rho >> 4, i = rho & 15; return 8 * (i >> 2) + 4 * n + (i & 3); }

struct Unit { int pm, pn; };
struct Gemm { const bf16_t* A; const bf16_t* Bt; int M, N, K; };

struct StaticOrder {
    int nM, nN, nwg, G, c;
    __host__ __device__ void init(int M, int N, int G_, int c_) { nM = M / BM; nN = N / BM; nwg = nM * nN; G = G_; c = c_; }
    __host__ __device__ bool next(int i, Unit& u) const {
        const long L = (long)i * G + c; if (L >= nwg) return false;
        int wgid = (int)L; { const int q = nwg / NXCD, r = nwg % NXCD, xcd = wgid % NXCD, off = wgid / NXCD; wgid = (xcd < r ? xcd * (q + 1) : r * (q + 1) + (xcd - r) * q) + off; }
        const int nig = WGM * nN, gid = wgid / nig, fm = gid * WGM, gsz = (nM - fm) < WGM ? (nM - fm) : WGM;
        u.pm = fm + ((wgid % nig) % gsz); u.pn = (wgid % nig) / gsz; return true;
    }
    __device__ __forceinline__ void a_ready(const Unit&) const {}
    __device__ __forceinline__ void done(const Unit&) const {}
};

__device__ __forceinline__ unsigned cvt_pk_bf16(float lo, float hi) { unsigned r; asm volatile("v_cvt_pk_bf16_f32 %0, %1, %2" : "=v"(r) : "v"(lo), "v"(hi)); return r; }
typedef float f32x2 __attribute__((ext_vector_type(2)));
__device__ __forceinline__ u32x4 pack8(const f32x4 v0, const f32x4 v1) { u32x4 w; w.x = cvt_pk_bf16(v0[0], v0[1]); w.y = cvt_pk_bf16(v0[2], v0[3]); w.z = cvt_pk_bf16(v1[0], v1[1]); w.w = cvt_pk_bf16(v1[2], v1[3]); return w; }
struct EpiZt {
    static constexpr bool PERM = true, AFTER_DRAIN = false; bf16_t* Zp;
    __device__ __forceinline__ void operator()(const f32x4 (&acc)[2][2][4][2], const Unit& u, int wr, int wc, int fr, int fq) const {
        const int part = u.pm, bgs2 = u.pn;
        bf16_t* base = Zp + ((size_t)(bgs2 * 256 + wr * 64 + fr) * 512 + part * 256 + wc * 32 + 8 * fq);
#pragma unroll
        for (int ai = 0; ai < 2; ++ai)
#pragma unroll
            for (int m = 0; m < 4; ++m)
#pragma unroll
                for (int bj = 0; bj < 2; ++bj) *(u32x4*)(base + (ai * HALF + m * 16) * 512 + bj * HALF) = pack8(acc[ai][bj][m][0], acc[ai][bj][m][1]);
    }
};
struct EpiY {
    static constexpr bool PERM = true, AFTER_DRAIN = false; bf16_t* Y;
    __device__ __forceinline__ void operator()(const f32x4 (&acc)[2][2][4][2], const Unit& u, int wr, int wc, int fr, int fq) const {
        const int bg = u.pn >> 4, k2 = u.pn & 15, b = bg >> 3, g = bg & 7;
        bf16_t* base = Y + ((size_t)(b * 4096 + (wr * 64 + fr) * 16 + k2) * 2048 + g * 256 + wc * 32 + 8 * fq);
#pragma unroll
        for (int ai = 0; ai < 2; ++ai)
#pragma unroll
            for (int m = 0; m < 4; ++m)
#pragma unroll
                for (int bj = 0; bj < 2; ++bj) *(u32x4*)(base + (size_t)(ai * HALF + m * 16) * 16 * 2048 + bj * HALF) = pack8(acc[ai][bj][m][0], acc[ai][bj][m][1]);
    }
};
struct EpiRes {
    static constexpr bool PERM = true, AFTER_DRAIN = false; const float* R; float* out; bf16_t* xb; float* ssq; unsigned char* x8;
    __device__ __forceinline__ void operator()(const f32x4 (&acc)[2][2][4][2], const Unit& u, int wr, int wc, int fr, int fq) const {
        const int row0 = u.pm * BM + wr * 64 + fr; const size_t off0 = (size_t)row0 * 2048 + u.pn * BM + wc * 32 + 8 * fq;
        const float* Rb = R + off0; bf16_t* Xb = xb + off0; float* Sb = ssq + row0;
#pragma unroll
        for (int ai = 0; ai < 2; ++ai)
#pragma unroll
            for (int m = 0; m < 4; ++m) { const int ro = (ai * HALF + m * 16) * 2048; float ss = 0.f;
#pragma unroll
                for (int bj = 0; bj < 2; ++bj) {
                    const f32x4 r0 = *(const f32x4*)(Rb + ro + bj * HALF), r1 = *(const f32x4*)(Rb + ro + bj * HALF + 4);
                    const f32x4 o0 = acc[ai][bj][m][0] + r0, o1 = acc[ai][bj][m][1] + r1;
                    *(u32x4*)(Xb + ro + bj * HALF) = pack8(o0, o1);
                    { int lo8 = 0, hi8 = 0; lo8 = __builtin_amdgcn_cvt_pk_fp8_f32(o0[0], o0[1], lo8, false); lo8 = __builtin_amdgcn_cvt_pk_fp8_f32(o0[2], o0[3], lo8, true);
                      hi8 = __builtin_amdgcn_cvt_pk_fp8_f32(o1[0], o1[1], hi8, false); hi8 = __builtin_amdgcn_cvt_pk_fp8_f32(o1[2], o1[3], hi8, true);
                      *(unsigned long long*)(x8 + off0 + ro + bj * HALF) = ((unsigned long long)(unsigned)hi8 << 32) | (unsigned)lo8; }
                    ss += (o0[0] * o0[0] + o0[1] * o0[1]) + (o0[2] * o0[2] + o0[3] * o0[3]) + (o1[0] * o1[0] + o1[1] * o1[1]) + (o1[2] * o1[2] + o1[3] * o1[3]); }
                ss += __shfl_xor(ss, 16); ss += __shfl_xor(ss, 32);
                if (fq == 0) unsafeAtomicAdd(Sb + ai * HALF + m * 16, ss);
                asm volatile("" ::: "memory"); }
    }
};
struct EpiResB {
    static constexpr bool PERM = true, AFTER_DRAIN = false; const bf16_t* R; bf16_t* xb; float* ssq; unsigned char* x8;
    __device__ __forceinline__ void operator()(const f32x4 (&acc)[2][2][4][2], const Unit& u, int wr, int wc, int fr, int fq) const {
        const int row0 = u.pm * BM + wr * 64 + fr; const size_t off0 = (size_t)row0 * 2048 + u.pn * BM + wc * 32 + 8 * fq;
        const bf16_t* Rb = R + off0; bf16_t* Xb = xb + off0; float* Sb = ssq + row0;
#pragma unroll
        for (int ai = 0; ai < 2; ++ai)
#pragma unroll
            for (int m = 0; m < 4; ++m) { const int ro = (ai * HALF + m * 16) * 2048; float ss = 0.f;
#pragma unroll
                for (int bj = 0; bj < 2; ++bj) {
                    const u32x4 rw = *(const u32x4*)(Rb + ro + bj * HALF);
                    const f32x4 r0 = (f32x4){__uint_as_float(rw[0] << 16), __uint_as_float(rw[0] & 0xffff0000u), __uint_as_float(rw[1] << 16), __uint_as_float(rw[1] & 0xffff0000u)}, r1 = (f32x4){__uint_as_float(rw[2] << 16), __uint_as_float(rw[2] & 0xffff0000u), __uint_as_float(rw[3] << 16), __uint_as_float(rw[3] & 0xffff0000u)};
                    const f32x4 o0 = acc[ai][bj][m][0] + r0, o1 = acc[ai][bj][m][1] + r1;
                    *(u32x4*)(Xb + ro + bj * HALF) = pack8(o0, o1);
                    { int lo8 = 0, hi8 = 0; lo8 = __builtin_amdgcn_cvt_pk_fp8_f32(o0[0], o0[1], lo8, false); lo8 = __builtin_amdgcn_cvt_pk_fp8_f32(o0[2], o0[3], lo8, true);
                      hi8 = __builtin_amdgcn_cvt_pk_fp8_f32(o1[0], o1[1], hi8, false); hi8 = __builtin_amdgcn_cvt_pk_fp8_f32(o1[2], o1[3], hi8, true);
                      *(unsigned long long*)(x8 + off0 + ro + bj * HALF) = ((unsigned long long)(unsigned)hi8 << 32) | (unsigned)lo8; }
                    ss += (o0[0] * o0[0] + o0[1] * o0[1]) + (o0[2] * o0[2] + o0[3] * o0[3]) + (o1[0] * o1[0] + o1[1] * o1[1]) + (o1[2] * o1[2] + o1[3] * o1[3]); }
                ss += __shfl_xor(ss, 16); ss += __shfl_xor(ss, 32);
                if (fq == 0) unsafeAtomicAdd(Sb + ai * HALF + m * 16, ss);
                asm volatile("" ::: "memory"); }
    }
};
struct EpiScale {
    static constexpr bool PERM = true, AFTER_DRAIN = false; bf16_t* O; const float* ssq;
    __device__ __forceinline__ void operator()(const f32x4 (&acc)[2][2][4][2], const Unit& u, int wr, int wc, int fr, int fq) const {
        const int row0 = u.pm * BM + wr * 64 + fr;
        bf16_t* base = O + ((size_t)row0 * 2048 + u.pn * BM + wc * 32 + 8 * fq); const float* Sb = ssq + row0;
#pragma unroll
        for (int ai = 0; ai < 2; ++ai)
#pragma unroll
            for (int m = 0; m < 4; ++m) { const float rs = rsqrtf(Sb[ai * HALF + m * 16] * (1.f / 2048.f) + 1e-6f);
#pragma unroll
                for (int bj = 0; bj < 2; ++bj) *(u32x4*)(base + (ai * HALF + m * 16) * 2048 + bj * HALF) = pack8(acc[ai][bj][m][0] * rs, acc[ai][bj][m][1] * rs); }
    }
};
struct EpiQK {
    static constexpr bool PERM = true, AFTER_DRAIN = false; bf16_t* Q; bf16_t* K; const float* ssq; const float* rope; float qscale;
    __device__ __forceinline__ void operator()(const f32x4 (&acc)[2][2][4][2], const Unit& u, int wr, int wc, int fr, int fq) const {
        const int row0 = u.pm * BM + wr * 64 + fr; const bool isq = u.pn < 8;
        const int cl = wc * 32 + 8 * fq;
        bf16_t* base = isq ? (Q + ((size_t)row0 * 2048 + u.pn * BM + cl)) : (K + ((size_t)row0 * 512 + (u.pn - 8) * BM + cl));
        const int ld = isq ? 2048 : 512; const float sc = isq ? qscale : 1.f;
        const float* rp = rope + (size_t)(row0 & 4095) * 64 + (cl & 63);
        const float* Sb = ssq + row0;
#pragma unroll
        for (int ai = 0; ai < 2; ++ai)
#pragma unroll
            for (int m = 0; m < 4; ++m) { const int ro = ai * HALF + m * 16; const float rs = rsqrtf(Sb[ro] * (1.f / 2048.f) + 1e-6f) * sc;
                const f32x4 t0 = *(const f32x4*)(rp + (size_t)ro * 64), t1 = *(const f32x4*)(rp + (size_t)ro * 64 + 4);
#pragma unroll
                for (int bj = 0; bj < 2; ++bj) {
                    const f32x4 a = acc[ai][bj][m][0] * rs, b = acc[ai][bj][m][1] * rs; f32x4 oa, ob;
                    oa[0] = a[0] * t0[0] - a[1] * t0[1]; oa[1] = a[1] * t0[0] + a[0] * t0[1]; oa[2] = a[2] * t0[2] - a[3] * t0[3]; oa[3] = a[3] * t0[2] + a[2] * t0[3];
                    ob[0] = b[0] * t1[0] - b[1] * t1[1]; ob[1] = b[1] * t1[0] + b[0] * t1[1]; ob[2] = b[2] * t1[2] - b[3] * t1[3]; ob[3] = b[3] * t1[2] + b[2] * t1[3];
                    *(u32x4*)(base + (size_t)ro * ld + bj * HALF) = pack8(oa, ob); } }
    }
};
struct EpiVt {
    static constexpr bool PERM = true, AFTER_DRAIN = false; bf16_t* Vt; const float* ssq;
    __device__ __forceinline__ void operator()(const f32x4 (&acc)[2][2][4][2], const Unit& u, int wr, int wc, int fr, int fq) const {
        const int col0 = u.pn * BM + wc * 32 + 8 * fq;
        bf16_t* base = Vt + ((size_t)(u.pm * BM + wr * 64 + fr) * 16384 + col0);
        f32x4 r0[2], r1[2];
#pragma unroll
        for (int bj = 0; bj < 2; ++bj) { const f32x4 s0 = *(const f32x4*)(ssq + col0 + bj * HALF), s1 = *(const f32x4*)(ssq + col0 + bj * HALF + 4);
#pragma unroll
            for (int q = 0; q < 4; ++q) { r0[bj][q] = rsqrtf(s0[q] * (1.f / 2048.f) + 1e-6f); r1[bj][q] = rsqrtf(s1[q] * (1.f / 2048.f) + 1e-6f); } }
#pragma unroll
        for (int ai = 0; ai < 2; ++ai)
#pragma unroll
            for (int m = 0; m < 4; ++m)
#pragma unroll
                for (int bj = 0; bj < 2; ++bj) *(u32x4*)(base + (size_t)(ai * HALF + m * 16) * 16384 + bj * HALF) = pack8(acc[ai][bj][m][0] * r0[bj], acc[ai][bj][m][1] * r1[bj]);
    }
};
template <class Epi, class Sched, bool ALIGN_EPI = false, bool SP2 = false>
__device__ __forceinline__ void gemm_phase(PG8_LAS unsigned char* lds, const Gemm g, const Sched& S, const Epi& E) {
    const int tid = threadIdx.x, wid = __builtin_amdgcn_readfirstlane(tid >> 6), lane = tid & 63, wr = wid >> 2, wc = wid & 3, fr = lane & 15, fq = lane >> 4;
    const int K = g.K, nt = K / BK;
    unsigned voffA[2], voffB[2];
#pragma unroll
    for (int i = 0; i < 2; ++i) { int R, C; stage_rc(tid * 16 + i * 8192, R, C); const int Rb = Epi::PERM ? ((R & ~31) + perm32(R & 31)) : R;
        voffA[i] = (unsigned)(R * K + C) * 2u; voffB[i] = (unsigned)(Rb * K + C) * 2u; }
    const size_t kstep = (size_t)(BK * 2);
    const size_t hstep = (size_t)HALF * K * 2;
    const size_t tstep = 2 * hstep;
    const unsigned ldsw = (unsigned)wid * 1024u;
    const int aoff = lds_byte(wr * 64 + fr, fq * 8), boff = lds_byte(wc * 32 + fr, fq * 8);
#define PG8_SA(b, h) (((b) * 2 + (h)) * HTB)
#define PG8_SB(b, h) ((4 + (b) * 2 + (h)) * HTB)
#define PG8_STAGE(bufoff, gbase, voff) do { _Pragma("unroll") for (int _i = 0; _i < 2; ++_i) \
        __builtin_amdgcn_global_load_lds((const unsigned*)((const char*)(gbase) + (voff)[_i]), (PG8_LAS unsigned*)(lds + (bufoff) + ldsw + _i * 8192), 16, 0, 0); } while (0)
#define PG8_LDA(dst, b, h) do { _Pragma("unroll") for (int m = 0; m < 4; ++m) _Pragma("unroll") for (int k = 0; k < 2; ++k) dst[m][k] = *(const PG8_LAS bf16x8*)(lds + PG8_SA(b, h) + aoff + m * 2048 + k * 1024); } while (0)
#define PG8_LDB(dst, b, h) do { _Pragma("unroll") for (int n = 0; n < 2; ++n) _Pragma("unroll") for (int k = 0; k < 2; ++k) dst[n][k] = *(const PG8_LAS bf16x8*)(lds + PG8_SB(b, h) + boff + n * 2048 + k * 1024); } while (0)
#define PG8_MMA(ai, bj, At, Bt) do { __builtin_amdgcn_s_setprio(1); _Pragma("unroll") for (int m = 0; m < 4; ++m) _Pragma("unroll") for (int n = 0; n < 2; ++n) _Pragma("unroll") for (int k = 0; k < 2; ++k) \
        acc[ai][bj][m][n] = __builtin_amdgcn_mfma_f32_16x16x32_bf16(Bt[n][k], At[m][k], acc[ai][bj][m][n], 0, 0, 0); __builtin_amdgcn_s_setprio(0); } while (0)
#define PG8_WAIT_V(n) asm volatile("s_waitcnt vmcnt(" #n ")" ::: "memory")
#define PG8_WAIT_L(n) asm volatile("s_waitcnt lgkmcnt(" #n ")" ::: "memory")
#define PG8_BAR __builtin_amdgcn_s_barrier()
#define PG8_SCHED __builtin_amdgcn_sched_barrier(0)
    Unit cur, nxt; int ui = 0;
    if (!S.next(0, cur)) return;
    f32x4 acc[2][2][4][2];
#pragma unroll
    for (int a = 0; a < 2; ++a)
#pragma unroll
        for (int b = 0; b < 2; ++b)
#pragma unroll
            for (int m = 0; m < 4; ++m)
#pragma unroll
                for (int n = 0; n < 2; ++n) acc[a][b][m][n] = (f32x4){0.f, 0.f, 0.f, 0.f};
    bf16x8 At[4][2], B0[2][2], B1[2][2];
    const char* cA = (const char*)g.A + (size_t)cur.pm * tstep; const char* cB = (const char*)g.Bt + (size_t)cur.pn * tstep;
    S.a_ready(cur);
    if constexpr (SP2) {
        PG8_STAGE(PG8_SB(0, 0), cB, voffB); PG8_STAGE(PG8_SB(0, 1), cB + hstep, voffB); PG8_STAGE(PG8_SA(0, 0), cA, voffA); PG8_STAGE(PG8_SA(0, 1), cA + hstep, voffA);
        if (wr == 1) PG8_BAR;
        PG8_WAIT_V(2); PG8_BAR;
        PG8_STAGE(PG8_SB(1, 0), cB + kstep, voffB); PG8_STAGE(PG8_SA(1, 0), cA + kstep, voffA); PG8_STAGE(PG8_SB(1, 1), cB + hstep + kstep, voffB);
        PG8_WAIT_V(6); PG8_BAR;
    } else {
        PG8_STAGE(PG8_SB(0, 0), cB, voffB); PG8_STAGE(PG8_SA(0, 0), cA, voffA); PG8_STAGE(PG8_SB(0, 1), cB + hstep, voffB); PG8_STAGE(PG8_SA(0, 1), cA + hstep, voffA);
        if (wr == 1) PG8_BAR;
        PG8_WAIT_V(4); PG8_BAR;
        PG8_STAGE(PG8_SB(1, 0), cB + kstep, voffB); PG8_STAGE(PG8_SA(1, 0), cA + kstep, voffA); PG8_STAGE(PG8_SB(1, 1), cB + hstep + kstep, voffB);
        PG8_WAIT_V(6); PG8_BAR;
    }
    for (;;) {
        const bool has_next = S.next(ui + 1, nxt);
        const char* nA = has_next ? (const char*)g.A + (size_t)nxt.pm * tstep : cA; const char* nB = has_next ? (const char*)g.Bt + (size_t)nxt.pn * tstep : cB;
        for (int t = 0; t < nt; t += 2) {
            const bool last = (t == nt - 2);
            const char* a1 = cA + (size_t)(t + 1) * kstep;
            const char* a2 = last ? nA : cA + (size_t)(t + 2) * kstep; const char* b2 = last ? nB : cB + (size_t)(t + 2) * kstep;
            const char* a3 = a2 + kstep; const char* b3 = b2 + kstep;
            if (last && has_next) S.a_ready(nxt);
            if constexpr (SP2) {
            PG8_LDB(B0, 0, 0); PG8_LDB(B1, 0, 1); PG8_SCHED; PG8_LDA(At, 0, 0); PG8_STAGE(PG8_SA(1, 1), a1 + hstep, voffA);
            PG8_WAIT_V(8); PG8_WAIT_L(0); PG8_BAR; PG8_MMA(0, 0, At, B0); PG8_MMA(0, 1, At, B1); PG8_BAR; PG8_SCHED;
            PG8_LDA(At, 0, 1); PG8_STAGE(PG8_SB(0, 0), b2, voffB); PG8_STAGE(PG8_SB(0, 1), b2 + hstep, voffB); PG8_STAGE(PG8_SA(0, 0), a2, voffA);
            PG8_WAIT_V(8); PG8_WAIT_L(0); PG8_BAR; PG8_MMA(1, 0, At, B0); PG8_MMA(1, 1, At, B1); PG8_BAR; PG8_SCHED;
            PG8_LDB(B0, 1, 0); PG8_LDB(B1, 1, 1); PG8_SCHED; PG8_LDA(At, 1, 0); PG8_STAGE(PG8_SA(0, 1), a2 + hstep, voffA);
            PG8_WAIT_V(8); PG8_WAIT_L(0); PG8_BAR; PG8_MMA(0, 0, At, B0); PG8_MMA(0, 1, At, B1); PG8_BAR; PG8_SCHED;
            PG8_LDA(At, 1, 1); PG8_STAGE(PG8_SB(1, 0), b3, voffB); PG8_STAGE(PG8_SB(1, 1), b3 + hstep, voffB); PG8_STAGE(PG8_SA(1, 0), a3, voffA);
            PG8_WAIT_V(8); PG8_WAIT_L(0); PG8_BAR; PG8_MMA(1, 0, At, B0); PG8_MMA(1, 1, At, B1); PG8_BAR; PG8_SCHED;
            } else {
            PG8_LDB(B0, 0, 0); PG8_SCHED; PG8_LDA(At, 0, 0); PG8_STAGE(PG8_SA(1, 1), a1 + hstep, voffA);
            PG8_WAIT_L(8); PG8_BAR; PG8_WAIT_L(0); PG8_MMA(0, 0, At, B0); PG8_BAR; PG8_SCHED;
            PG8_LDB(B1, 0, 1); PG8_STAGE(PG8_SB(0, 0), b2, voffB);
            PG8_BAR; PG8_WAIT_L(0); PG8_MMA(0, 1, At, B1); PG8_BAR;
            PG8_LDA(At, 0, 1); PG8_STAGE(PG8_SA(0, 0), a2, voffA);
            PG8_BAR; PG8_WAIT_L(0); PG8_MMA(1, 0, At, B0); PG8_BAR; PG8_SCHED;
            PG8_STAGE(PG8_SB(0, 1), b2 + hstep, voffB);
            PG8_WAIT_V(6); PG8_BAR; PG8_MMA(1, 1, At, B1); PG8_BAR;
            PG8_LDB(B0, 1, 0); PG8_SCHED; PG8_LDA(At, 1, 0); PG8_STAGE(PG8_SA(0, 1), a2 + hstep, voffA);
            PG8_WAIT_L(8); PG8_BAR; PG8_WAIT_L(0); PG8_MMA(0, 0, At, B0); PG8_BAR; PG8_SCHED;
            PG8_LDB(B1, 1, 1); PG8_STAGE(PG8_SB(1, 0), b3, voffB);
            PG8_BAR; PG8_WAIT_L(0); PG8_MMA(0, 1, At, B1); PG8_BAR;
            PG8_LDA(At, 1, 1); PG8_STAGE(PG8_SA(1, 0), a3, voffA);
            PG8_BAR; PG8_WAIT_L(0); PG8_MMA(1, 0, At, B0); PG8_BAR; PG8_SCHED;
            PG8_STAGE(PG8_SB(1, 1), b3 + hstep, voffB);
            PG8_WAIT_V(6); PG8_BAR; PG8_MMA(1, 1, At, B1); PG8_BAR;
            }
        }
        if constexpr (ALIGN_EPI) { if (wr == 0) PG8_BAR; }
        if constexpr (!Epi::AFTER_DRAIN) { E(acc, cur, wr, wc, fr, fq); S.done(cur); }
        if (!has_next) break;
#pragma unroll
        for (int a = 0; a < 2; ++a)
#pragma unroll
            for (int b = 0; b < 2; ++b)
#pragma unroll
                for (int m = 0; m < 4; ++m)
#pragma unroll
                    for (int n = 0; n < 2; ++n) acc[a][b][m][n] = (f32x4){0.f, 0.f, 0.f, 0.f};
        cur = nxt; cA = nA; cB = nB; ++ui;
        if constexpr (ALIGN_EPI) { if (wr == 1) PG8_BAR; }
    }
    PG8_WAIT_V(0);
    if constexpr (!ALIGN_EPI) { if (wr == 0) PG8_BAR; }
    PG8_BAR;
    if constexpr (Epi::AFTER_DRAIN) { E.fused(acc, cur, wr, wc, fr, fq, lds, wid, lane); S.done(cur); }
#undef PG8_SA
#undef PG8_SB
#undef PG8_STAGE
#undef PG8_LDA
#undef PG8_LDB
#undef PG8_MMA
#undef PG8_WAIT_V
#undef PG8_WAIT_L
#undef PG8_BAR
#undef PG8_SCHED
}
}
#define GAS __attribute__((address_space(1)))
#define LAS __attribute__((address_space(3)))
typedef unsigned short bf16;
typedef unsigned v4u __attribute__((ext_vector_type(4)));
typedef unsigned v2u __attribute__((ext_vector_type(2)));
typedef float f32x4 __attribute__((ext_vector_type(4)));
constexpr int NWAVES = 8;
constexpr int LDS_BYTES = 147456, LDSCTL_OFF = 131072;
constexpr int CW_BAR = 4096;
constexpr size_t MiB = 1u << 20;
constexpr size_t WS_CTL = 0, CTL_BYTES = 1 * MiB;
constexpr size_t WS_SSQ_A = 256 * 1024, WS_SSQ_B = 320 * 1024, WS_SSQ_C = 384 * 1024, WS_SSQ_D = 448 * 1024;
constexpr size_t WS_STAMP = 128 * 1024;
constexpr size_t WS_BCTR = 192 * 1024;
constexpr size_t WS_SU = 512 * 1024, WS_SV = 768 * 1024;
constexpr size_t WS_WCS = 1 * MiB, WS_ROPE = 2 * MiB, WS_KEYS = 3 * MiB;
constexpr size_t WS_WOF = 8 * MiB, WS_WQKV = 16 * MiB, WS_WOA = 28 * MiB, WS_WQ0 = 36 * MiB, WS_WQ1 = 44 * MiB;
constexpr size_t WS_A2 = 64 * MiB, WS_TW = 65 * MiB;
constexpr size_t WS_U0 = 128 * MiB, WS_V0 = 192 * MiB, WS_U1 = 256 * MiB, WS_V1 = 320 * MiB;
constexpr size_t WS_XG = 384 * MiB, WS_XB = 384 * MiB;
constexpr size_t WS_ZT = 448 * MiB;
constexpr size_t WS_Y = 576 * MiB;
constexpr size_t WS_Q = 448 * MiB;
constexpr size_t WS_EI = 640 * MiB, WS_GW = 648 * MiB, WS_W1 = 656 * MiB, WS_X8 = 664 * MiB;
constexpr size_t WS_PD = 448 * MiB;
constexpr size_t WS_QB = 448 * MiB, WS_KB = 512 * MiB, WS_VT = 528 * MiB, WS_O = 576 * MiB;

__device__ __forceinline__ unsigned f2bf(float f) { unsigned u = __builtin_bit_cast(unsigned, f); return (u + 0x7fffu + ((u >> 16) & 1u)) >> 16; }
__device__ __forceinline__ unsigned pk2(float lo, float hi) { return f2bf(lo) | (f2bf(hi) << 16); }

struct Args { const float* in[12]; float* out; unsigned char* ws; int ph_lo, ph_hi; };

__device__ __forceinline__ int qkv_row(int n) { if (n >= 2560) return n; const int d = n & 63, pc = (d < 32) ? 2 * d : 2 * (d - 32) + 1; return (n & ~63) + pc; }
template <int MODE>
__device__ __forceinline__ void transpose_item(const float* W, int K, int N, const float* gain, bf16* WT, LAS float* scr, int item, int lane) {
    const int nblk = N / 32, kb = item / nblk, nb = item % nblk, k0 = 64 * kb, n0 = 32 * nb;
    float wv[32];
#pragma unroll
    for (int i = 0; i < 32; ++i) wv[i] = W[(size_t)(k0 + 2 * i + (lane >> 5)) * N + n0 + (lane & 31)];
#pragma unroll
    for (int i = 0; i < 32; ++i) { const int kk = 2 * i + (lane >> 5); float v = wv[i]; if (gain) v *= gain[k0 + kk]; scr[kk * 33 + (lane & 31)] = v; }
    asm volatile("s_waitcnt lgkmcnt(0)" ::: "memory");
    const int c = lane & 7;
#pragma unroll
    for (int j = 0; j < 4; ++j) { const int n = (lane >> 3) + 8 * j; const LAS float* s = scr + (8 * c) * 33 + n;
        v4u o; o.x = pk2(s[0 * 33], s[1 * 33]); o.y = pk2(s[2 * 33], s[3 * 33]); o.z = pk2(s[4 * 33], s[5 * 33]); o.w = pk2(s[6 * 33], s[7 * 33]);
        const int row = (MODE == 1) ? qkv_row(n0 + n) : (n0 + n);
        *(v4u*)(WT + (size_t)row * K + k0 + 8 * c) = o; }
    asm volatile("s_waitcnt lgkmcnt(0)" ::: "memory");
}
__device__ __forceinline__ float wsum(float v) {
#pragma unroll
    for (int o = 1; o < 64; o <<= 1) v += __shfl_xor(v, o);
    return v;
}
__device__ __forceinline__ void cvt_stream(const float* src, bf16* dst, size_t n8, size_t gtid, size_t ngt) {
    for (size_t i = gtid; i < n8; i += ngt) {
        const f32x4 a = *(const f32x4*)(src + i * 8), b = *(const f32x4*)(src + i * 8 + 4);
        v4u o; o.x = pk2(a[0], a[1]); o.y = pk2(a[2], a[3]); o.z = pk2(b[0], b[1]); o.w = pk2(b[2], b[3]);
        *(v4u*)(dst + i * 8) = o;
    }
}
__device__ __forceinline__ void cvt_stream8(const float* src, unsigned char* dst, size_t n16, size_t gtid, size_t ngt, float scale) {
    for (size_t i = gtid; i < n16; i += ngt) {
        v4u o;
#pragma unroll
        for (int q = 0; q < 4; ++q) { f32x4 a = *(const f32x4*)(src + i * 16 + 4 * q) * scale;
#pragma unroll
            for (int e = 0; e < 4; ++e) a[e] = fminf(fmaxf(a[e], -448.f), 448.f);
            int w = 0; w = __builtin_amdgcn_cvt_pk_fp8_f32(a[0], a[1], w, false); w = __builtin_amdgcn_cvt_pk_fp8_f32(a[2], a[3], w, true); o[q] = (unsigned)w; }
        const size_t e = i >> 7, r = i & 127, sl = r >> 3, c8 = r & 7;
        *(v4u*)(dst + ((sl * 16384 + e) * 128 + c8 * 16)) = o;
    }
}
#define XB_TMO      128
#define XB_XCNT(j)  (256  + 64 * (j))
#define XB_XSUB(j)  (1280 + 64 * (j))
#define XB_XGEN(j)  (2304 + 64 * (j))
#define XB_TOP      3328
#define XB_TOPGEN   3392
#define XCD_BAR_WORDS 3456
#define XB_SPIN_CAP (1u << 18)

__device__ __forceinline__ unsigned xb_ld(unsigned* p)              { return __hip_atomic_load(p, __ATOMIC_RELAXED, __HIP_MEMORY_SCOPE_AGENT); }
__device__ __forceinline__ unsigned xb_add(unsigned* p, unsigned v) { return __hip_atomic_fetch_add(p, v, __ATOMIC_RELAXED, __HIP_MEMORY_SCOPE_AGENT); }
__device__ __forceinline__ unsigned xb_xcc_id() { return (unsigned)__builtin_amdgcn_s_getreg((3 << 11) | 20) & 0xFu; }
#define XB_SPIN(cond, bar) do { unsigned _sp = 0; while (cond) { __builtin_amdgcn_s_sleep(1); \
    if ((++_sp & 255u) == 0u) { if (xb_ld(&(bar)[XB_TMO])) break; if (_sp > XB_SPIN_CAP) { atomicAdd(&(bar)[XB_TMO], 1u); break; } } } } while (0)

struct XcdBarrier {
    unsigned* bar; unsigned x;
    volatile LAS unsigned* st;
};

__device__ __forceinline__ XcdBarrier xcd_barrier_post(unsigned* bar, volatile LAS unsigned* st) {
    XcdBarrier b; b.bar = bar; b.x = xb_xcc_id(); b.st = st;
    if (threadIdx.x == 0) (void)xb_add(&bar[XB_XCNT(b.x)], 1u);
    return b;
}
__device__ __forceinline__ void xcd_barrier_complete(unsigned* bar, unsigned x, unsigned& nloc, unsigned& nx) {
    const unsigned G = gridDim.x * gridDim.y * gridDim.z;
    unsigned sum, cnt, mine, sp = 0u;
    for (;;) {
        sum = 0u; cnt = 0u; mine = 0u;
#pragma unroll
        for (unsigned j = 0; j < 16; ++j) { const unsigned c = xb_ld(&bar[XB_XCNT(j)]); sum += c; cnt += (c > 0u) ? 1u : 0u; mine = (j == x) ? c : mine; }
        if (sum == G) break;
        __builtin_amdgcn_s_sleep(1);
        if ((++sp & 255u) == 0u) { if (xb_ld(&bar[XB_TMO])) break; if (sp > XB_SPIN_CAP) { atomicAdd(&bar[XB_TMO], 1u); break; } }
    }
    nloc = mine > 0u ? mine : 1u; nx = cnt > 0u ? cnt : 1u;
}

__device__ __forceinline__ void xcd_barrier(const XcdBarrier& b) {
    asm volatile("s_waitcnt vmcnt(0)" ::: "memory");
    __syncthreads();
    if (threadIdx.x == 0) {
        unsigned* bar = b.bar;
        __builtin_amdgcn_s_waitcnt(0);
        unsigned nloc = b.st[0], nx = b.st[1];
        if (nloc == 0u) { xcd_barrier_complete(bar, b.x, nloc, nx); b.st[0] = nloc; b.st[1] = nx; }
        const unsigned old = xb_add(&bar[XB_XSUB(b.x)], 1u);
        const unsigned gen = old / nloc;
        if (old + 1u == (gen + 1u) * nloc) {
            __builtin_amdgcn_fence(__ATOMIC_RELEASE, "agent");
            asm volatile("s_waitcnt vmcnt(0)" ::: "memory");
            const unsigned og = xb_add(&bar[XB_TOP], 1u);
            const unsigned tg = og / nx;
            if (og + 1u == (tg + 1u) * nx) xb_add(&bar[XB_TOPGEN], 1u);
            else XB_SPIN(xb_ld(&bar[XB_TOPGEN]) == tg, bar);
            __builtin_amdgcn_fence(__ATOMIC_ACQUIRE, "agent");
            xb_add(&bar[XB_XGEN(b.x)], 1u);
            asm volatile("s_waitcnt vmcnt(0)" ::: "memory");
        } else {
            XB_SPIN(xb_ld(&bar[XB_XGEN(b.x)]) == gen, bar);
            __builtin_amdgcn_fence(__ATOMIC_ACQUIRE, "agent");
            asm volatile("s_waitcnt vmcnt(0)" ::: "memory");
        }
    }
    __syncthreads();
}
#define U_SCALE 1024.f
#define V_SCALE 256.f
typedef float f32x16 __attribute__((ext_vector_type(16)));
#ifndef TKB
#define TKB 2
#endif
typedef short s16x8 __attribute__((ext_vector_type(8)));
typedef __bf16 bf16x2_t __attribute__((ext_vector_type(2)));
__device__ __forceinline__ unsigned ordf(float f) { const unsigned u = __float_as_uint(f); return (u & 0x80000000u) ? ~u : (u | 0x80000000u); }
__device__ __forceinline__ float unordf(unsigned u) { return __uint_as_float((u & 0x80000000u) ? (u & 0x7fffffffu) : ~u); }
__device__ __forceinline__ unsigned umax_(unsigned a, unsigned b) { return a > b ? a : b; }
#define DPPU(v, ctrl) ((unsigned)__builtin_amdgcn_update_dpp(0, (int)(v), (ctrl), 0xf, 0xf, true))
#define DPPF(v, ctrl) __int_as_float(__builtin_amdgcn_update_dpp(0, __float_as_int(v), (ctrl), 0xf, 0xf, true))
__device__ __forceinline__ unsigned max32(unsigned v) {
    v = umax_(v, DPPU(v, 0xB1)); v = umax_(v, DPPU(v, 0x4E)); v = umax_(v, DPPU(v, 0x141)); v = umax_(v, DPPU(v, 0x140));
    const auto r = __builtin_amdgcn_permlane16_swap(v, v, false, false);
    return umax_(r[0], r[1]);
}
__device__ __forceinline__ float sum16(float v) {
    v += DPPF(v, 0xB1); v += DPPF(v, 0x4E); v += DPPF(v, 0x141); v += DPPF(v, 0x140); return v;
}
__device__ __forceinline__ unsigned bperm(unsigned v, int srclane) { return (unsigned)__builtin_amdgcn_ds_bpermute(srclane << 2, (int)v); }
#define CMPX(a_, b_) do { const unsigned hi_ = umax_(a_, b_), lo_ = (a_ < b_) ? a_ : b_; a_ = hi_; b_ = lo_; } while (0)
__device__ __forceinline__ unsigned max16(unsigned v) { v = umax_(v, DPPU(v, 0xB1)); v = umax_(v, DPPU(v, 0x4E)); v = umax_(v, DPPU(v, 0x141)); v = umax_(v, DPPU(v, 0x140)); return v; }
__device__ __forceinline__ unsigned top16_of8(unsigned (&p)[8], int c) {
    CMPX(p[0], p[1]); CMPX(p[2], p[3]); CMPX(p[4], p[5]); CMPX(p[6], p[7]);
    CMPX(p[0], p[2]); CMPX(p[1], p[3]); CMPX(p[4], p[6]); CMPX(p[5], p[7]);
    CMPX(p[1], p[2]); CMPX(p[5], p[6]); CMPX(p[0], p[4]); CMPX(p[3], p[7]);
    CMPX(p[1], p[5]); CMPX(p[2], p[6]);
    CMPX(p[1], p[4]); CMPX(p[3], p[6]);
    CMPX(p[2], p[4]); CMPX(p[3], p[5]);
    CMPX(p[3], p[4]);
    unsigned W = 0u;
    for (int it = 0; it < 16; ++it) {
        const unsigned m = max16(p[0]);
        W = (c == it) ? m : W;
        const bool win = (p[0] == m);
#pragma unroll
        for (int i = 0; i < 7; ++i) p[i] = win ? p[i + 1] : p[i];
        p[7] = win ? 0u : p[7];
    }
    return W;
}
#define SORT8(p) do { CMPX(p[0], p[1]); CMPX(p[2], p[3]); CMPX(p[4], p[5]); CMPX(p[6], p[7]); CMPX(p[0], p[2]); CMPX(p[1], p[3]); CMPX(p[4], p[6]); CMPX(p[5], p[7]); \
    CMPX(p[1], p[2]); CMPX(p[5], p[6]); CMPX(p[0], p[4]); CMPX(p[3], p[7]); CMPX(p[1], p[5]); CMPX(p[2], p[6]); CMPX(p[1], p[4]); CMPX(p[3], p[6]); CMPX(p[2], p[4]); CMPX(p[3], p[5]); CMPX(p[3], p[4]); } while (0)
__device__ __forceinline__ void top16_of8x2(unsigned (&p)[8], unsigned (&q)[8], int c, unsigned& Wp, unsigned& Wq) {
    SORT8(p); SORT8(q);
    unsigned W0 = 0u, W1 = 0u;
    for (int it = 0; it < 16; ++it) {
        unsigned m0 = umax_(p[0], DPPU(p[0], 0xB1)), m1 = umax_(q[0], DPPU(q[0], 0xB1));
        m0 = umax_(m0, DPPU(m0, 0x4E)); m1 = umax_(m1, DPPU(m1, 0x4E));
        m0 = umax_(m0, DPPU(m0, 0x141)); m1 = umax_(m1, DPPU(m1, 0x141));
        m0 = umax_(m0, DPPU(m0, 0x140)); m1 = umax_(m1, DPPU(m1, 0x140));
        W0 = (c == it) ? m0 : W0; W1 = (c == it) ? m1 : W1;
        const bool w0 = (p[0] == m0), w1 = (q[0] == m1);
#pragma unroll
        for (int i = 0; i < 7; ++i) { p[i] = w0 ? p[i + 1] : p[i]; q[i] = w1 ? q[i + 1] : q[i]; }
        p[7] = w0 ? 0u : p[7]; q[7] = w1 ? 0u : q[7];
    }
    Wp = W0; Wq = W1;
}
__device__ __forceinline__ void top16_of4rx2(unsigned (&p)[4], unsigned (&q)[4], int c, unsigned& Wp, unsigned& Wq) {
    CMPX(p[0], p[1]); CMPX(p[2], p[3]); CMPX(p[0], p[2]); CMPX(p[1], p[3]); CMPX(p[1], p[2]);
    CMPX(q[0], q[1]); CMPX(q[2], q[3]); CMPX(q[0], q[2]); CMPX(q[1], q[3]); CMPX(q[1], q[2]);
    unsigned W0 = 0u, W1 = 0u;
    for (int it = 0; it < 16; ++it) {
        unsigned m0 = umax_(p[0], DPPU(p[0], 0xB1)), m1 = umax_(q[0], DPPU(q[0], 0xB1));
        m0 = umax_(m0, DPPU(m0, 0x4E)); m1 = umax_(m1, DPPU(m1, 0x4E));
        m0 = umax_(m0, DPPU(m0, 0x141)); m1 = umax_(m1, DPPU(m1, 0x141));
        m0 = umax_(m0, DPPU(m0, 0x140)); m1 = umax_(m1, DPPU(m1, 0x140));
        W0 = (c == it) ? m0 : W0; W1 = (c == it) ? m1 : W1;
        const bool w0 = (p[0] == m0), w1 = (q[0] == m1);
        p[0] = w0 ? p[1] : p[0]; p[1] = w0 ? p[2] : p[1]; p[2] = w0 ? p[3] : p[2]; p[3] = w0 ? 0u : p[3];
        q[0] = w1 ? q[1] : q[0]; q[1] = w1 ? q[2] : q[1]; q[2] = w1 ? q[3] : q[2]; q[3] = w1 ? 0u : q[3];
    }
    Wp = W0; Wq = W1;
}
__device__ __forceinline__ unsigned top16_of4r(unsigned (&p)[4], int c) {
    CMPX(p[0], p[1]); CMPX(p[2], p[3]); CMPX(p[0], p[2]); CMPX(p[1], p[3]); CMPX(p[1], p[2]);
    unsigned W = 0u;
    for (int it = 0; it < 16; ++it) {
        const unsigned m = max16(p[0]);
        W = (c == it) ? m : W;
        const bool win = (p[0] == m);
        p[0] = win ? p[1] : p[0]; p[1] = win ? p[2] : p[1]; p[2] = win ? p[3] : p[2]; p[3] = win ? 0u : p[3];
    }
    return W;
}
__device__ __forceinline__ void topk_fill(LAS unsigned char* lds, const bf16* keys, int h, int tid) {
#pragma unroll
    for (int i = 0; i < 8; ++i) { const int idx = tid + 512 * i, p = idx >> 11, key = (idx >> 4) & 127, ch = idx & 15;
        const v4u v = *(const v4u*)(keys + (size_t)((h * 2 + p) * 128 + key) * 128 + ch * 8);
        *(LAS v4u*)(lds + p * 32768 + key * 256 + ((ch ^ (key & 15)) << 4)) = v; }
}
struct CvtCtx { const float* srcU; long dsrc; const float* gain; unsigned char* dstU; long ddst; float* su; long dsc; int gwave, nw; };
__device__ __forceinline__ void cvt_chunk_load(const CvtCtx& cx, int c, int lane, f32x4 (&v)[4]) {
    const int r = c >> 1, hh = c & 1;
    const float* src = cx.srcU + ((r < 16384) ? 0L : cx.dsrc) + (size_t)(r & 16383) * 2048 + hh * 1024 + 4 * lane;
#pragma unroll
    for (int j = 0; j < 4; ++j) v[j] = *(const f32x4*)(src + 256 * j);
}
__device__ __forceinline__ void cvt_chunk_store(const CvtCtx& cx, int c, int lane, f32x4 (&v)[4]) {
    const int r = c >> 1, hh = c & 1; const bool isu = r < 16384; const int e = r & 16383;
    float mx = 0.f;
#pragma unroll
    for (int j = 0; j < 4; ++j) { if (isu) v[j] = v[j] * *(const f32x4*)(cx.gain + hh * 1024 + 256 * j + 4 * lane);
        mx = fmaxf(mx, fmaxf(fmaxf(fabsf(v[j][0]), fabsf(v[j][1])), fmaxf(fabsf(v[j][2]), fabsf(v[j][3])))); }
    mx = fmaxf(mx, DPPF(mx, 0xB1)); mx = fmaxf(mx, DPPF(mx, 0x4E)); mx = fmaxf(mx, DPPF(mx, 0x141)); mx = fmaxf(mx, DPPF(mx, 0x140));
    { const auto rr = __builtin_amdgcn_permlane16_swap(__float_as_uint(mx), __float_as_uint(mx), false, false); mx = fmaxf(__uint_as_float(rr[0]), __uint_as_float(rr[1])); }
    { const auto rr = __builtin_amdgcn_permlane32_swap(__float_as_uint(mx), __float_as_uint(mx), false, false); mx = fmaxf(__uint_as_float(rr[0]), __uint_as_float(rr[1])); }
    const float sc = fmaxf(mx, 1e-30f) * (1.f / 6.f), inv = 1.f / sc;
    if (lane == 0) (cx.su + (isu ? 0L : cx.dsc))[e * 2 + hh] = sc;
    unsigned char* dst = cx.dstU + (isu ? 0L : cx.ddst) + ((size_t)(hh * 4) * 16384 + e) * 128 + 2 * lane;
#pragma unroll
    for (int j = 0; j < 4; ++j) { unsigned w = 0u;
        w = __builtin_amdgcn_cvt_scalef32_pk_fp4_f32(w, v[j][0] * inv, v[j][1] * inv, 1.0f, 0); w = __builtin_amdgcn_cvt_scalef32_pk_fp4_f32(w, v[j][2] * inv, v[j][3] * inv, 1.0f, 1);
        *(unsigned short*)(dst + (size_t)j * (16384 * 128)) = (unsigned short)w; }
}
__device__ __forceinline__ void topk_unit(const bf16* q, LAS const unsigned char* lds, int* EI, float* GW, int t0, int h, int lane) {
    const int c = lane & 15, g4 = lane >> 4, rbase = lane & 48;
    int f0 = 0, f1 = 0, f2 = 0, f3 = 0;
    { int cnt = 0;
#pragma unroll
      for (int i = 0; i < 16; ++i)
#pragma unroll
        for (int j = 0; j < 16; ++j) if ((i + 1) * (j + 1) <= 16) { const int fl = i * 16 + j; f0 = (cnt == c) ? fl : f0; f1 = (cnt == c + 16) ? fl : f1; f2 = (cnt == c + 32) ? fl : f2; f3 = (cnt == c + 48) ? fl : f3; ++cnt; } }
    unsigned W[2][8];
#pragma unroll
    for (int p = 0; p < 2; ++p) {
        f32x4 acc[2][8];
#pragma unroll
        for (int mb = 0; mb < 2; ++mb)
#pragma unroll
            for (int kb = 0; kb < 8; ++kb) acc[mb][kb] = (f32x4){0.f, 0.f, 0.f, 0.f};
        const bf16* qp = q + (size_t)(t0 + c) * 2048 + h * 256 + p * 128 + g4 * 8;
        LAS const unsigned char* kp = lds + p * 32768 + c * 256;
        asm volatile("" : "+v"(qp));
#pragma unroll 2
        for (int ks = 0; ks < 4; ++ks) {
            const s16x8 a0 = *(const s16x8*)(qp + ks * 32), a1 = *(const s16x8*)(qp + (size_t)16 * 2048 + ks * 32);
#pragma unroll
            for (int kb = 0; kb < 8; ++kb) { const s16x8 b = *(LAS const s16x8*)(kp + kb * 4096 + (((4 * ks + g4) ^ c) << 4));
                acc[0][kb] = __builtin_amdgcn_mfma_f32_16x16x32_bf16(a0, b, acc[0][kb], 0, 0, 0); acc[1][kb] = __builtin_amdgcn_mfma_f32_16x16x32_bf16(a1, b, acc[1][kb], 0, 0, 0); }
        }
#pragma unroll
        for (int pb = 0; pb < 8; pb += 2) {
            unsigned pk[8], pq[8];
#pragma unroll
            for (int kb = 0; kb < 8; ++kb) { pk[kb] = (ordf(acc[pb >> 2][kb][pb & 3]) & ~127u) | (unsigned)(127 - 16 * kb - c); pq[kb] = (ordf(acc[(pb + 1) >> 2][kb][(pb + 1) & 3]) & ~127u) | (unsigned)(127 - 16 * kb - c); }
            top16_of8x2(pk, pq, c, W[p][pb], W[p][pb + 1]);
        }
    }
#define TK_CAND(CP, w0_, w1_) do { \
        { const float a0 = unordf(bperm(w0_, rbase + (f0 >> 4)) & ~127u), b0 = unordf(bperm(w1_, rbase + (f0 & 15)) & ~127u); CP[0] = (ordf(a0 + b0) & ~63u) | (unsigned)(63 - c); } \
        { const float a0 = unordf(bperm(w0_, rbase + (f1 >> 4)) & ~127u), b0 = unordf(bperm(w1_, rbase + (f1 & 15)) & ~127u); CP[1] = (ordf(a0 + b0) & ~63u) | (unsigned)(47 - c); } \
        { const float a0 = unordf(bperm(w0_, rbase + (f2 >> 4)) & ~127u), b0 = unordf(bperm(w1_, rbase + (f2 & 15)) & ~127u); CP[2] = (ordf(a0 + b0) & ~63u) | (unsigned)(31 - c); } \
        { const float a0 = unordf(bperm(w0_, rbase + (f3 >> 4)) & ~127u), b0 = unordf(bperm(w1_, rbase + (f3 & 15)) & ~127u); CP[3] = (c + 48 < 50) ? ((ordf(a0 + b0) & ~63u) | (unsigned)(15 - c)) : 0u; } } while (0)
#define TK_FINISH(Wc_, w0_, w1_, pb_) do { \
        const int slot = 63 - (int)((Wc_) & 63u); \
        const unsigned fa = bperm((unsigned)f0, rbase + (slot & 15)), fb = bperm((unsigned)f1, rbase + (slot & 15)), fc = bperm((unsigned)f2, rbase + (slot & 15)), fd = bperm((unsigned)f3, rbase + (slot & 15)); \
        const int sq = slot >> 4; const int flat = (int)((sq == 0) ? fa : (sq == 1) ? fb : (sq == 2) ? fc : fd); \
        const float val = unordf((Wc_) & ~63u); \
        const float vmax = __uint_as_float(bperm(__float_as_uint(val), rbase)); \
        const float e = __expf(val - vmax); \
        const float g = e / sum16(e); \
        const int k1 = 127 - (int)(bperm(w0_, rbase + (flat >> 4)) & 127u), k2 = 127 - (int)(bperm(w1_, rbase + (flat & 15)) & 127u); \
        const int tok = t0 + 16 * ((pb_) >> 2) + 4 * g4 + ((pb_) & 3); \
        EI[(size_t)(tok * 8 + h) * 16 + c] = k1 * 128 + k2; GW[(size_t)(tok * 8 + h) * 16 + c] = g; } while (0)
#pragma unroll
    for (int pb = 0; pb < 8; pb += 2) {
        const unsigned w0a = W[0][pb], w1a = W[1][pb], w0b = W[0][pb + 1], w1b = W[1][pb + 1];
        unsigned cpa[4], cpb[4], Wca, Wcb;
        TK_CAND(cpa, w0a, w1a); TK_CAND(cpb, w0b, w1b);
        top16_of4rx2(cpa, cpb, c, Wca, Wcb);
        TK_FINISH(Wca, w0a, w1a, pb); TK_FINISH(Wcb, w0b, w1b, pb + 1);
    }
#undef TK_CAND
#undef TK_FINISH
}

__device__ __forceinline__ float gelu_tanh_f(float x) {
    const float u = 0.7978845608028654f * (x + 0.044715f * x * x * x);
    const float e = __expf(2.f * u);
    const float th = 1.f - 2.f / (e + 1.f);
    return 0.5f * x * (1.f + th);
}
__device__ __forceinline__ float wave_sum_bfly(float v) {
#pragma unroll
    for (int o = 1; o < 64; o <<= 1) v += __shfl_xor(v, o);
    return v;
}
typedef float f32x2_ __attribute__((ext_vector_type(2)));
#define FP4_DEC(w_, sel_) __builtin_amdgcn_cvt_scalef32_pk_f32_fp4((unsigned)(w_), 1.0f, (sel_))
typedef int i32x8 __attribute__((ext_vector_type(8)));
template <int NBT>
__device__ __forceinline__ void peer_a_slice(const unsigned char* x8, const int* EI, const unsigned char* U4s, float* pd, int s, unsigned* ctr, int nbatch, int lane) {
    const int c = lane & 15, g4 = lane >> 4, k8 = c >> 1;
    const __amdgpu_buffer_rsrc_t trs = __builtin_amdgcn_make_buffer_rsrc((void*)(U4s + (size_t)s * (16384 * 128)), (short)0, 16384 * 128, 0x00020000);
    const unsigned choff = (unsigned)((4 * (c & 1) + g4) * 16);
#define A_FETCH() ((int)__builtin_amdgcn_readfirstlane((int)((lane == 0) ? __hip_atomic_fetch_add(ctr, 1u, __ATOMIC_RELAXED, __HIP_MEMORY_SCOPE_AGENT) : 0u)))
#define A_TOKB(b_, j_) ((((b_) < nbatch) ? (b_) : (nbatch - 1)) * NBT + (j_))
#define A_XS(XS, t_) do { const unsigned char* xp_ = x8 + (size_t)(t_) * 2048 + s * 256 + 128 * (c & 1) + 16 * g4; XS[0] = *(const v4u*)xp_; XS[1] = *(const v4u*)(xp_ + 64); } while (0)
#define A_ISSUE(U, EV) do { _Pragma("unroll") for (int i = 0; i < 8; ++i) { const unsigned e_ = bperm((unsigned)(EV), (i << 3) + k8); U[i] = __builtin_amdgcn_raw_buffer_load_b128(trs, (int)((e_ << 7) | choff), 0, 0); } } while (0)
    const unsigned sb0 = 0x20202020u ^ ((k8 < 4) ? (0x5fu << (8 * k8)) : 0u), sb1 = 0x20202020u ^ ((k8 >= 4) ? (0x5fu << (8 * (k8 - 4))) : 0u);
#define A_MF(U, i, SB) d_ = __builtin_amdgcn_mfma_scale_f32_16x16x128_f8f6f4((i32x8){(int)U[i][0], (int)U[i][1], (int)U[i][2], (int)U[i][3], 0, 0, 0, 0}, hb, d_, 4, 0, 0, 0x7f7f7f7f, (i) & 3, (int)SB)
#define A_COMPUTE(U, OUT) do { f32x4 d_ = (f32x4){0.f, 0.f, 0.f, 0.f}; A_MF(U, 0, sb0); A_MF(U, 1, sb0); A_MF(U, 2, sb0); A_MF(U, 3, sb0); A_MF(U, 4, sb1); A_MF(U, 5, sb1); A_MF(U, 6, sb1); A_MF(U, 7, sb1); \
            OUT = (f32x2_){d_[0] + DPPF(d_[1], 0xB1), d_[2] + DPPF(d_[3], 0xB1)}; } while (0)
    int eL[NBT], eH[NBT], nL[NBT], nH[NBT]; v4u xs[2][2]; v4u UA[8], UB[8];
    int b0 = A_FETCH(), b1 = A_FETCH();
    if (b0 >= nbatch) return;
#pragma unroll
    for (int j = 0; j < NBT; ++j) { const int tj = A_TOKB(b0, j); eL[j] = EI[(size_t)tj * 128 + lane]; eH[j] = EI[(size_t)tj * 128 + 64 + lane]; }
    A_XS(xs[0], A_TOKB(b0, 0));
    A_ISSUE(UA, eL[0]);
    while (b0 < nbatch) {
        const int b2 = A_FETCH();
#pragma unroll
        for (int j = 0; j < NBT; ++j) { const int tj = A_TOKB(b1, j); nL[j] = EI[(size_t)tj * 128 + lane]; nH[j] = EI[(size_t)tj * 128 + 64 + lane]; }
#pragma unroll
        for (int j = 0; j < NBT; ++j) {
            const int t = b0 * NBT + j;
            A_ISSUE(UB, eH[j]);
            const i32x8 hb = (i32x8){(int)xs[j & 1][0][0], (int)xs[j & 1][0][1], (int)xs[j & 1][0][2], (int)xs[j & 1][0][3], (int)xs[j & 1][1][0], (int)xs[j & 1][1][1], (int)xs[j & 1][1][2], (int)xs[j & 1][1][3]};
            f32x2_ out_lo = (f32x2_){0.f, 0.f}, out_hi = (f32x2_){0.f, 0.f};
            A_COMPUTE(UA, out_lo);
            A_XS(xs[(j + 1) & 1], (j + 1 < NBT) ? (b0 * NBT + j + 1) : A_TOKB(b1, 0));
            A_ISSUE(UA, (j + 1 < NBT) ? eL[(j + 1) % NBT] : nL[0]);
            A_COMPUTE(UB, out_hi);
            if ((c & 1) == 0) { float* pp = pd + ((size_t)s * T + t) * 128 + 8 * k8 + 2 * g4; *(f32x2_*)pp = out_lo; *(f32x2_*)(pp + 64) = out_hi; }
        }
#pragma unroll
        for (int j = 0; j < NBT; ++j) { eL[j] = nL[j]; eH[j] = nH[j]; }
        b0 = b1; b1 = b2;
    }
#undef A_FETCH
#undef A_TOKB
#undef A_XS
#undef A_ISSUE
#undef A_COMPUTE
#undef A_MF
}
__device__ __forceinline__ unsigned w8rep(float w) { const float s = fminf(fmaxf(w * 256.f, -448.f), 448.f); return ((unsigned)__builtin_amdgcn_cvt_pk_fp8_f32(s, 0.f, 0, false) & 0xffu) * 0x01010101u; }
__device__ __forceinline__ void peer_a2_token(const float* pd, const float* ssq, const int* EI, const float* su, const float* sv, float* GW, float* W1, int t, int lane) {
    float a0 = 0.f, a1 = 0.f, b0 = 0.f, b1 = 0.f;
#pragma unroll
    for (int s = 0; s < 4; ++s) { const float* pp = pd + ((size_t)s * T + t) * 128; a0 += pp[lane]; a1 += pp[64 + lane]; }
#pragma unroll
    for (int s = 4; s < 8; ++s) { const float* pp = pd + ((size_t)s * T + t) * 128; b0 += pp[lane]; b1 += pp[64 + lane]; }
    const float rs = rsqrtf(ssq[t] * (1.f / 2048.f) + EPS);
    float* gp = GW + (size_t)t * 128; float* hp = W1 + (size_t)t * 128; const int pl = lane;
    const int e0 = EI[(size_t)t * 128 + pl], e1 = EI[(size_t)t * 128 + 64 + pl];
    const float g0 = gp[pl] * gelu_tanh_f(rs * (a0 * su[2 * e0] + b0 * su[2 * e0 + 1])), g1 = gp[64 + pl] * gelu_tanh_f(rs * (a1 * su[2 * e1] + b1 * su[2 * e1 + 1]));
    unsigned* gu = (unsigned*)gp; unsigned* hu = (unsigned*)hp;
    gu[pl] = w8rep(g0 * sv[2 * e0]); hu[pl] = w8rep(g0 * sv[2 * e0 + 1]);
    gu[64 + pl] = w8rep(g1 * sv[2 * e1]); hu[64 + pl] = w8rep(g1 * sv[2 * e1 + 1]);
}
template <int NBT>
__device__ __forceinline__ void peer_b_slice(const bf16* xres, float* xio, const int* EI, const unsigned* W, const unsigned char* V4s, bf16* xb, float* ssq_out, int s, unsigned* ctr, int nbatch, int lane) {
    const int j16 = lane & 15, g4 = lane >> 4;
    const __amdgpu_buffer_rsrc_t trs = __builtin_amdgcn_make_buffer_rsrc((void*)(V4s + (size_t)s * (16384 * 128)), (short)0, 16384 * 128, 0x00020000);
    const unsigned choff = (unsigned)(8 * j16);
    const int doff = s * 256 + 64 * g4 + j16;
    const unsigned bm = 0xffu << (8 * (j16 & 3)); const unsigned M0 = ((j16 >> 2) == 0) ? bm : 0u, M1 = ((j16 >> 2) == 1) ? bm : 0u, M2 = ((j16 >> 2) == 2) ? bm : 0u, M3 = ((j16 >> 2) == 3) ? bm : 0u;
#define B_FETCH() ((int)__builtin_amdgcn_readfirstlane((int)((lane == 0) ? __hip_atomic_fetch_add(ctr, 1u, __ATOMIC_RELAXED, __HIP_MEMORY_SCOPE_AGENT) : 0u)))
#define B_TOKB(b_, j_) ((((b_) < nbatch) ? (b_) : (nbatch - 1)) * NBT + (j_))
#define B_ISSUE(V, EV) do { _Pragma("unroll") for (int i = 0; i < 8; ++i) { const unsigned e0_ = bperm((unsigned)(EV), 8 * i + 2 * g4), e1_ = bperm((unsigned)(EV), 8 * i + 2 * g4 + 1); \
        V[2 * i] = __builtin_amdgcn_raw_buffer_load_b64(trs, (int)((e0_ << 7) | choff), 0, 0); V[2 * i + 1] = __builtin_amdgcn_raw_buffer_load_b64(trs, (int)((e1_ << 7) | choff), 0, 0); } } while (0)
#define B_COMPUTE(V, WV) do { _Pragma("unroll") for (int i = 0; i < 8; ++i) { \
            const unsigned f0_ = bperm((WV), 8 * i + g4), f1_ = bperm((WV), 8 * i + 4 + g4);        \
            const i32x8 bq_ = (i32x8){(int)(f0_ & M0), (int)(f0_ & M1), (int)(f0_ & M2), (int)(f0_ & M3), (int)(f1_ & M0), (int)(f1_ & M1), (int)(f1_ & M2), (int)(f1_ & M3)}; \
            acc = __builtin_amdgcn_mfma_scale_f32_16x16x128_f8f6f4((i32x8){(int)V[2 * i][0], (int)V[2 * i][1], (int)V[2 * i + 1][0], (int)V[2 * i + 1][1], 0, 0, 0, 0}, bq_, acc, 4, 0, 0, 0x7f7f7f7f, 0, 0x77777777); } } while (0)
    int eL[NBT], eH[NBT], nL[NBT], nH[NBT]; unsigned wL[NBT], wH[NBT], mL[NBT], mH[NBT]; float xv[4]; v2u VA[16], VB[16];
    int b0 = B_FETCH(), b1 = B_FETCH();
    if (b0 >= nbatch) return;
#pragma unroll
    for (int j = 0; j < NBT; ++j) { const int tj = B_TOKB(b0, j); eL[j] = EI[(size_t)tj * 128 + lane]; eH[j] = EI[(size_t)tj * 128 + 64 + lane]; wL[j] = W[(size_t)tj * 128 + lane]; wH[j] = W[(size_t)tj * 128 + 64 + lane]; }
    B_ISSUE(VA, eL[0]);
    while (b0 < nbatch) {
        const int b2 = B_FETCH();
#pragma unroll
        for (int j = 0; j < NBT; ++j) { const int tj = B_TOKB(b1, j); nL[j] = EI[(size_t)tj * 128 + lane]; nH[j] = EI[(size_t)tj * 128 + 64 + lane]; mL[j] = W[(size_t)tj * 128 + lane]; mH[j] = W[(size_t)tj * 128 + 64 + lane]; }
#pragma unroll
        for (int j = 0; j < NBT; ++j) {
            const int t = b0 * NBT + j;
            float* xp = xio + (size_t)t * 2048 + doff; const bf16* rp = xres + (size_t)t * 2048 + doff;
#pragma unroll
            for (int r = 0; r < 4; ++r) xv[r] = __uint_as_float((unsigned)rp[16 * r] << 16);
            B_ISSUE(VB, eH[j]);
            f32x4 acc = (f32x4){0.f, 0.f, 0.f, 0.f};
            B_COMPUTE(VA, wL[j]);
            B_ISSUE(VA, (j + 1 < NBT) ? eL[(j + 1) % NBT] : nL[0]);
            B_COMPUTE(VB, wH[j]);
            float ss = 0.f;
#pragma unroll
            for (int r = 0; r < 4; ++r) { const float o = xv[r] + acc[r]; ss += o * o; if (xb) xb[(size_t)t * 2048 + doff + 16 * r] = (bf16)f2bf(o); else xp[16 * r] = o; }
            ss += DPPF(ss, 0xB1); ss += DPPF(ss, 0x4E); ss += DPPF(ss, 0x141); ss += DPPF(ss, 0x140);
            { const auto r = __builtin_amdgcn_permlane16_swap(__float_as_uint(ss), __float_as_uint(ss), false, false); ss = __uint_as_float(r[0]) + __uint_as_float(r[1]); }
            { const auto r = __builtin_amdgcn_permlane32_swap(__float_as_uint(ss), __float_as_uint(ss), false, false); ss = __uint_as_float(r[0]) + __uint_as_float(r[1]); }
            if (lane == 0) unsafeAtomicAdd(ssq_out + t, ss);
        }
#pragma unroll
        for (int j = 0; j < NBT; ++j) { eL[j] = nL[j]; eH[j] = nH[j]; wL[j] = mL[j]; wH[j] = mH[j]; }
        b0 = b1; b1 = b2;
    }
#undef B_FETCH
#undef B_TOKB
#undef B_ISSUE
#undef B_COMPUTE
}
__device__ __forceinline__ void final_norm_row(float* xio, const float* ssq, const float* fin, int t, int lane, float oscale) {
    const float r2 = rsqrtf(ssq[t] * (1.f / 2048.f) + EPS) * oscale;
    float* xr = xio + (size_t)t * 2048 + 4 * lane;
#pragma unroll
    for (int j = 0; j < 8; ++j) { const f32x4 xv = *(const f32x4*)(xr + 256 * j), g = *(const f32x4*)(fin + 256 * j + 4 * lane); f32x4 o;
        o[0] = xv[0] * r2 * g[0]; o[1] = xv[1] * r2 * g[1]; o[2] = xv[2] * r2 * g[2]; o[3] = xv[3] * r2 * g[3]; *(f32x4*)(xr + 256 * j) = o; }
}
typedef short s16x4 __attribute__((ext_vector_type(4)));
__device__ __forceinline__ unsigned cvt_pk_bf16_(float lo, float hi) { unsigned r; asm volatile("v_cvt_pk_bf16_f32 %0, %1, %2" : "=v"(r) : "v"(lo), "v"(hi)); return r; }
constexpr int ATT_RING = 384, ATT_K_OFF = 0, ATT_V_OFF = ATT_RING * 128, ATT_VSTRIDE = ATT_RING * 2 + 8, ATT_LDS = ATT_V_OFF + 64 * ATT_VSTRIDE;
__device__ __forceinline__ void attn_blk_load(const bf16* K, const bf16* Vt, int b, int kvh, int n0, int tid, v4u& kr, v4u& vr) {
    const size_t tb = (size_t)b * 4096; const int r = tid >> 3, p = tid & 7;
    kr = *(const v4u*)(K + (tb + n0 + r) * 512 + kvh * 64 + p * 8);
    vr = *(const v4u*)(Vt + (size_t)(kvh * 64 + r) * 16384 + tb + n0 + p * 8);
}
__device__ __forceinline__ void attn_blk_store(LAS unsigned char* lds, int n0, int tid, const v4u& kr, const v4u& vr) {
    const int rb = (n0 + ATT_RING) % ATT_RING, r = tid >> 3, p = tid & 7, row = rb + r;
    *(LAS v4u*)(lds + ATT_K_OFF + row * 128 + ((p ^ ((row >> 1) & 7)) << 4)) = kr;
    LAS unsigned char* vp = lds + ATT_V_OFF + r * ATT_VSTRIDE + (rb + p * 8) * 2;
    *(LAS v2u*)vp = (v2u){vr.x, vr.y}; *(LAS v2u*)(vp + 8) = (v2u){vr.z, vr.w};
}
__device__ __forceinline__ void attn_task(LAS const unsigned char* lds, const bf16* Q, bf16* O, const float* sinks, int b, int hq, int q0, int lane) {
    const int c = lane & 31, hi = lane >> 5;
    const size_t tb = (size_t)b * 4096;
    s16x8 qf[4];
    { const bf16* qp = Q + (tb + q0 + c) * 2048 + hq * 64 + hi * 8;
#pragma unroll
      for (int ks = 0; ks < 4; ++ks) qf[ks] = *(const s16x8*)(qp + ks * 16); }
    const float sink2 = sinks[hq] * 1.4426950408889634f;
    float m = sink2, l = (hi == 0) ? 1.f : 0.f;
    f32x16 o0, o1;
#pragma unroll
    for (int r = 0; r < 16; ++r) { o0[r] = 0.f; o1[r] = 0.f; }
    const int kt_lo = (q0 < 128) ? ((128 - q0) >> 5) : 0, kt_hi = ((4192 - q0) >> 5) < 8 ? ((4192 - q0) >> 5) : 8;
    for (int kt = kt_lo; kt <= kt_hi; ++kt) {
        const int key0 = q0 - 128 + 32 * kt, row0 = (key0 + ATT_RING) % ATT_RING;
        s16x8 kf[4]; s16x4 va[2][2][2];
        { const int row = row0 + c; LAS const unsigned char* kp = lds + ATT_K_OFF + row * 128; const int sw = (row >> 1) & 7;
#pragma unroll
          for (int ks = 0; ks < 4; ++ks) kf[ks] = *(LAS const s16x8*)(kp + (((2 * ks + hi) ^ sw) << 4)); }
#pragma unroll
        for (int db = 0; db < 2; ++db)
#pragma unroll
            for (int s = 0; s < 2; ++s) { LAS const unsigned char* vp = lds + ATT_V_OFF + (db * 32 + c) * ATT_VSTRIDE + (row0 + 16 * s + 4 * hi) * 2; va[db][s][0] = *(LAS const s16x4*)vp; va[db][s][1] = *(LAS const s16x4*)(vp + 16); }
        f32x16 sa;
#pragma unroll
        for (int r = 0; r < 16; ++r) sa[r] = 0.f;
#pragma unroll
        for (int ks = 0; ks < 4; ++ks) sa = __builtin_amdgcn_mfma_f32_32x32x16_bf16(kf[ks], qf[ks], sa, 0, 0, 0);
        if (kt == 0 || kt == 8) {
            const int dbase = key0 - (q0 + c) + 4 * hi;
#pragma unroll
            for (int r = 0; r < 16; ++r) { const int d = dbase + (r & 3) + 8 * (r >> 2); if (d < -128 || d > 128) sa[r] = -1e30f; }
        }
        float mx = sa[0];
#pragma unroll
        for (int r = 1; r < 16; ++r) mx = fmaxf(mx, sa[r]);
        { const auto rr = __builtin_amdgcn_permlane32_swap(__float_as_uint(mx), __float_as_uint(mx), false, false); mx = fmaxf(__uint_as_float(rr[0]), __uint_as_float(rr[1])); }
        if (__builtin_amdgcn_ballot_w64(mx > m + 8.f) != 0ull) {
            const float mn = fmaxf(m, mx), alpha = __builtin_amdgcn_exp2f(m - mn);
            m = mn; l *= alpha;
#pragma unroll
            for (int r = 0; r < 16; ++r) { o0[r] *= alpha; o1[r] *= alpha; }
        }
        float ps = 0.f;
#pragma unroll
        for (int r = 0; r < 16; ++r) { sa[r] = __builtin_amdgcn_exp2f(sa[r] - m); ps += sa[r]; }
        l += ps;
        s16x8 pf[2];
#pragma unroll
        for (int s = 0; s < 2; ++s) { v4u w; w.x = cvt_pk_bf16_(sa[8 * s + 0], sa[8 * s + 1]); w.y = cvt_pk_bf16_(sa[8 * s + 2], sa[8 * s + 3]); w.z = cvt_pk_bf16_(sa[8 * s + 4], sa[8 * s + 5]); w.w = cvt_pk_bf16_(sa[8 * s + 6], sa[8 * s + 7]);
            pf[s] = __builtin_bit_cast(s16x8, w); }
#pragma unroll
        for (int s = 0; s < 2; ++s) {
            const s16x8 v0 = __builtin_shufflevector(va[0][s][0], va[0][s][1], 0, 1, 2, 3, 4, 5, 6, 7), v1 = __builtin_shufflevector(va[1][s][0], va[1][s][1], 0, 1, 2, 3, 4, 5, 6, 7);
            o0 = __builtin_amdgcn_mfma_f32_32x32x16_bf16(v0, pf[s], o0, 0, 0, 0);
            o1 = __builtin_amdgcn_mfma_f32_32x32x16_bf16(v1, pf[s], o1, 0, 0, 0);
        }
    }
    { const auto rr = __builtin_amdgcn_permlane32_swap(__float_as_uint(l), __float_as_uint(l), false, false); l = __uint_as_float(rr[0]) + __uint_as_float(rr[1]); }
    const float il = 1.f / l;
    bf16* op = O + (tb + q0 + c) * 2048 + hq * 64 + 4 * hi;
#pragma unroll
    for (int g = 0; g < 4; ++g) {
        v2u w0, w1;
        w0.x = cvt_pk_bf16_(o0[4 * g + 0] * il, o0[4 * g + 1] * il); w0.y = cvt_pk_bf16_(o0[4 * g + 2] * il, o0[4 * g + 3] * il);
        w1.x = cvt_pk_bf16_(o1[4 * g + 0] * il, o1[4 * g + 1] * il); w1.y = cvt_pk_bf16_(o1[4 * g + 2] * il, o1[4 * g + 3] * il);
        *(v2u*)(op + 8 * g) = w0; *(v2u*)(op + 32 + 8 * g) = w1;
    }
}
typedef float fx2 __attribute__((ext_vector_type(2)));
__device__ __forceinline__ fx2 bf2_(unsigned w) { fx2 r; r[0] = __uint_as_float(w << 16); r[1] = __uint_as_float(w & 0xffff0000u); return r; }
__device__ __forceinline__ void fft16_item(bf16* Zp, const float* tw, int bg, int l, int s1h, int lane) {
    const int s1 = s1h * 128 + 2 * lane;
    bf16* base = Zp + ((size_t)(bg * 16) * 256 + l) * 512 + s1;
    fx2 zr[16], zi[16];
#pragma unroll
    for (int s2 = 0; s2 < 16; ++s2) { zr[s2] = bf2_(*(const unsigned*)(base + (size_t)s2 * 256 * 512)); zi[s2] = bf2_(*(const unsigned*)(base + (size_t)s2 * 256 * 512 + 256)); }
    fx2 er[16], ei[16];
#pragma unroll
    for (int d = 0; d < 4; ++d) {
        const fx2 ar = zr[d], ai_ = zi[d], br = zr[4 + d], bi = zi[4 + d], cr = zr[8 + d], ci = zi[8 + d], dr = zr[12 + d], di = zi[12 + d];
        const fx2 s0r = ar + cr, s0i = ai_ + ci, s1r = ar - cr, s1i = ai_ - ci, s2r = br + dr, s2i = bi + di, s3r = br - dr, s3i = bi - di;
        er[0 * 4 + d] = s0r + s2r; ei[0 * 4 + d] = s0i + s2i;
        er[1 * 4 + d] = s1r + s3i; ei[1 * 4 + d] = s1i - s3r;
        er[2 * 4 + d] = s0r - s2r; ei[2 * 4 + d] = s0i - s2i;
        er[3 * 4 + d] = s1r - s3i; ei[3 * 4 + d] = s1i + s3r;
    }
#pragma unroll
    for (int a = 1; a < 4; ++a)
#pragma unroll
        for (int d = 1; d < 4; ++d) {
            const float ang = 6.283185307179586f * (float)(a * d) / 16.f; const float c = __builtin_cosf(ang), sn = __builtin_sinf(ang);
            const fx2 xr = er[a * 4 + d], xi = ei[a * 4 + d];
            er[a * 4 + d] = xr * c + xi * sn; ei[a * 4 + d] = xi * c - xr * sn;
        }
#pragma unroll
    for (int a = 0; a < 4; ++a) {
        const fx2 ar = er[a * 4 + 0], ai_ = ei[a * 4 + 0], br = er[a * 4 + 1], bi = ei[a * 4 + 1], cr = er[a * 4 + 2], ci = ei[a * 4 + 2], dr = er[a * 4 + 3], di = ei[a * 4 + 3];
        const fx2 s0r = ar + cr, s0i = ai_ + ci, s1r = ar - cr, s1i = ai_ - ci, s2r = br + dr, s2i = bi + di, s3r = br - dr, s3i = bi - di;
        fx2 Dr[4], Di[4];
        Dr[0] = s0r + s2r; Di[0] = s0i + s2i; Dr[1] = s1r + s3i; Di[1] = s1i - s3r; Dr[2] = s0r - s2r; Di[2] = s0i - s2i; Dr[3] = s1r - s3i; Di[3] = s1i + s3r;
#pragma unroll
        for (int b = 0; b < 4; ++b) {
            const int k2 = a + 4 * b;
            const f32x4 t0 = *(const f32x4*)(tw + (size_t)(k2 * 256 + s1) * 2);
            const fx2 cc = (fx2){t0[0], t0[2]}, ss = (fx2){t0[1], t0[3]};
            const fx2 hr = Dr[b] * cc + Di[b] * ss, hi_ = Di[b] * cc - Dr[b] * ss;
            *(unsigned*)(base + (size_t)k2 * 256 * 512) = pk2(hr[0], hr[1]); *(unsigned*)(base + (size_t)k2 * 256 * 512 + 256) = pk2(hi_[0], hi_[1]);
        }
    }
}
__device__ __forceinline__ int static_unit(int nM, int nN, int G, int c, int i) {
    const int nwg = nM * nN; const long L = (long)i * G + c; if (L >= nwg) return -1;
    int wgid = (int)L; { const int q = nwg / 8, r = nwg % 8, xcd = wgid % 8, off = wgid / 8; wgid = (xcd < r ? xcd * (q + 1) : r * (q + 1) + (xcd - r) * q) + off; }
    const int nig = 8 * nN, gid = wgid / nig, fm = gid * 8, gsz = (nM - fm) < 8 ? (nM - fm) : 8;
    return ((fm + ((wgid % nig) % gsz)) << 16) | ((wgid % nig) / gsz);
}
#ifndef REP_PRO
#define REP_PRO 1
#endif
#ifndef REP_GEMM
#define REP_GEMM 1
#endif
#ifndef REP_ATT
#define REP_ATT 1
#endif
#ifndef REP_LITE
#define REP_LITE 0
#endif
#ifndef REP_Q
#define REP_Q 1
#endif
#ifndef REP_PA
#define REP_PA 1
#endif
#ifndef REP_TK
#define REP_TK 1
#endif
enum { PH_PRO = 0, PH_G1 = 1, PH_S1 = 2, PH_G2 = 3, PH_G3 = 4, PH_Q0 = 5, PH_TK0 = 6, PH_PA0 = 7, PH_PW0 = 8, PH_PB0 = 9, PH_QKV = 10, PH_ATT = 11, PH_WO = 12, PH_Q1 = 13, PH_TK1 = 14, PH_PA1 = 15, PH_PW1 = 16, PH_PB1 = 17, PH_FIN = 18, PH_END = 19 };
__global__ void __launch_bounds__(NWAVES * 64, 2) mega(Args a) {
    extern __shared__ __attribute__((aligned(16))) unsigned char lds_raw[];
    LAS unsigned char* lds = (LAS unsigned char*)lds_raw;
    cg::grid_group grid = cg::this_grid();
    const int wave = __builtin_amdgcn_readfirstlane(threadIdx.x >> 6);
#define FRESH_IDS() int lane; asm volatile("v_mbcnt_lo_u32_b32 %0, -1, 0\n\tv_mbcnt_hi_u32_b32 %0, -1, %0" : "=v"(lane)); const int tid = wave * 64 + lane; (void)tid
    const int G = gridDim.x, bx = blockIdx.x;
    unsigned char* ws = a.ws;
    const int lo = a.ph_lo, hi = a.ph_hi;
    volatile LAS unsigned* MISC = (volatile LAS unsigned*)(lds + LDSCTL_OFF);
    if (threadIdx.x < 16) MISC[threadIdx.x] = 0u;
    __syncthreads();
    XcdBarrier xbar = xcd_barrier_post((unsigned*)(ws + WS_CTL) + CW_BAR, MISC + 8);
#define IN(k) (lo <= (k) && (k) < hi)
#ifdef DIAG_A
#define STAMP(i) do { if (bx == 0 && threadIdx.x == 0) ((unsigned long long*)(ws + WS_STAMP))[i] = __builtin_amdgcn_s_memrealtime(); } while (0)
#else
#define STAMP(i) do { } while (0)
#endif
#define SEAM(k) do { if (IN(k) && IN((k) + 1)) { if ((k) == PH_PRO) grid.sync(); else xcd_barrier(xbar); } STAMP((k) + 1); } while (0)
    STAMP(0);
    for (int rep_ = 0; rep_ < REP_PRO; ++rep_)
    if (IN(PH_PRO)) { FRESH_IDS();
        const int gw = bx * NWAVES + wave, NGW = G * NWAVES;
        const size_t gtid = (size_t)bx * (NWAVES * 64) + tid, ngt = (size_t)G * NWAVES * 64;
        LAS float* scr = (LAS float*)(lds + wave * 16384);
        {
            constexpr int I_SQ = (DM / 64) * (DM / 32), I_QKV = (DM / 64) * (QKVW / 32);
            constexpr int NITEMS = 4 * I_SQ + I_QKV;
            for (int it = gw; it < NITEMS; it += NGW) {
                int r = it;
                if (r < I_SQ) { transpose_item<0>(a.in[3], DM, DM, nullptr, (bf16*)(ws + WS_WOF), scr, r, lane); continue; } r -= I_SQ;
                if (r < I_SQ) { transpose_item<0>(a.in[5], DM, DM, nullptr, (bf16*)(ws + WS_WOA), scr, r, lane); continue; } r -= I_SQ;
                if (r < I_SQ) { transpose_item<0>(a.in[7], DM, DM, a.in[2], (bf16*)(ws + WS_WQ0), scr, r, lane); continue; } r -= I_SQ;
                if (r < I_SQ) { transpose_item<0>(a.in[7] + (size_t)DM * DM, DM, DM, a.in[2] + DM, (bf16*)(ws + WS_WQ1), scr, r, lane); continue; } r -= I_SQ;
                transpose_item<1>(a.in[4], DM, QKVW, a.in[1] + DM, (bf16*)(ws + WS_WQKV), scr, r, lane);
            }
        }
        {
            f32x4 v[8], nv[8];
            { const f32x4* xr = (const f32x4*)(a.in[0] + (size_t)(gw < T ? gw : 0) * DM) + lane;
#pragma unroll
              for (int j = 0; j < 8; ++j) v[j] = xr[64 * j]; }
            for (int row = gw; row < T; row += NGW) {
                { const int nr = (row + NGW < T) ? row + NGW : row; const f32x4* xr = (const f32x4*)(a.in[0] + (size_t)nr * DM) + lane;
#pragma unroll
                  for (int j = 0; j < 8; ++j) nv[j] = xr[64 * j]; }
                const f32x4* gr = (const f32x4*)a.in[1] + lane;
                float s = 0.f;
#pragma unroll
                for (int j = 0; j < 8; ++j) s += (v[j][0] * v[j][0] + v[j][1] * v[j][1]) + (v[j][2] * v[j][2] + v[j][3] * v[j][3]);
                const float r = rsqrtf(wsum(s) * (1.f / DM) + EPS);
                const int b = row >> 12, sp = row & 4095;
#pragma unroll
                for (int j = 0; j < 8; ++j) { const f32x4 gg = gr[64 * j]; v2u o; o.x = pk2(v[j][0] * r * gg[0], v[j][1] * r * gg[1]); o.y = pk2(v[j][2] * r * gg[2], v[j][3] * r * gg[3]);
                    *(v2u*)((bf16*)(ws + WS_XG) + ((size_t)((b * 8 + j) * 4096 + sp) * 256 + 4 * lane)) = o; }
#pragma unroll
                for (int j = 0; j < 8; ++j) v[j] = nv[j];
            }
        }
        for (size_t i = gtid; i < (size_t)256 * 512 / 8; i += ngt) {
            const int k1 = (int)(i >> 6), c0 = (int)(i & 63) * 8, part = c0 >> 8, s0 = c0 & 255;
            float v[8];
#pragma unroll
            for (int e = 0; e < 8; ++e) { const int m = (k1 * (s0 + e)) & 255; const float rev = (float)m * (1.f / 256.f); v[e] = (part ? __builtin_amdgcn_sinf(rev) : __builtin_amdgcn_cosf(rev)) * (1.f / 64.f); }
            v4u o; o.x = pk2(v[0], v[1]); o.y = pk2(v[2], v[3]); o.z = pk2(v[4], v[5]); o.w = pk2(v[6], v[7]);
            *(v4u*)((bf16*)(ws + WS_A2) + i * 8) = o;
        }
        for (size_t i = gtid; i < (size_t)16 * 256; i += ngt) {
            const int k2 = (int)(i >> 8), s1 = (int)(i & 255); const float rev = (float)(k2 * s1) * (1.f / 4096.f);
            ((float*)(ws + WS_TW))[2 * i] = __builtin_amdgcn_cosf(rev); ((float*)(ws + WS_TW))[2 * i + 1] = __builtin_amdgcn_sinf(rev);
        }
        for (size_t i = gtid; i < (size_t)512 * 256 / 8; i += ngt) {
            const int n = (int)(i >> 5), c0 = (int)(i & 31) * 8, part = n >> 8, l = n & 255;
            float v[8];
#pragma unroll
            for (int e = 0; e < 8; ++e) { const int m = (l * (c0 + e)) & 255; const float rev = (float)m * (1.f / 256.f); v[e] = (part ? -__builtin_amdgcn_sinf(rev) : __builtin_amdgcn_cosf(rev)) * (1.f / 16.f); }
            v4u o; o.x = pk2(v[0], v[1]); o.y = pk2(v[2], v[3]); o.z = pk2(v[4], v[5]); o.w = pk2(v[6], v[7]);
            *(v4u*)((bf16*)(ws + WS_WCS) + i * 8) = o;
        }
        for (size_t i = gtid; i < (size_t)4096 * 32; i += ngt) {
            const int pos = (int)(i >> 5), fi = (int)(i & 31);
            const double inv = exp2(-(double)fi * (13.287712379549449 / 32.0));
            double sn, cs; sincos((double)pos * inv, &sn, &cs);
            ((float*)(ws + WS_ROPE))[2 * i] = (float)cs; ((float*)(ws + WS_ROPE))[2 * i + 1] = (float)sn;
        }
#pragma unroll 1
        for (int L = 0; L < 2; ++L) {
            CvtCtx cx; cx.srcU = a.in[9] + (size_t)L * NEXP * DM; cx.dsrc = (long)((a.in[10] + (size_t)L * NEXP * DM) - cx.srcU); cx.gain = a.in[2] + L * DM; cx.dstU = ws + (L ? WS_U1 : WS_U0); cx.ddst = (long)WS_V0 - (long)WS_U0;
            cx.su = (float*)(ws + WS_SU) + L * 32768; cx.dsc = ((long)WS_SV - (long)WS_SU) / 4; cx.gwave = gw; cx.nw = NGW;
            f32x4 c0[4], c1[4], n0[4], n1[4];
            cvt_chunk_load(cx, gw, lane, c0); cvt_chunk_load(cx, (gw + NGW < 65536) ? gw + NGW : gw, lane, c1);
            for (int cc = gw; cc < 65536; cc += 2 * NGW) { const int ca = cc + 2 * NGW, cb = cc + 3 * NGW;
                cvt_chunk_load(cx, ca < 65536 ? ca : cc, lane, n0); cvt_chunk_load(cx, cb < 65536 ? cb : cc, lane, n1);
                cvt_chunk_store(cx, cc, lane, c0); if (cc + NGW < 65536) cvt_chunk_store(cx, cc + NGW, lane, c1);
#pragma unroll
                for (int q = 0; q < 4; ++q) { c0[q] = n0[q]; c1[q] = n1[q]; } }
        }
        cvt_stream(a.in[8], (bf16*)(ws + WS_KEYS), (size_t)2 * PH * 2 * 128 * 128 / 8, gtid, ngt);
    }
    SEAM(PH_PRO);
    for (int rep_ = 0; rep_ < REP_GEMM; ++rep_)
    if (IN(PH_G1)) { FRESH_IDS();
        int Kq = FW; asm volatile("" : "+s"(Kq));
        pg8::Gemm g{(const pg8::bf16_t*)(ws + WS_WCS), (const pg8::bf16_t*)(ws + WS_XG), 512, T * FG, Kq}; pg8::StaticOrder S; S.init(512, T * FG, G, bx);
        pg8::EpiZt E{(pg8::bf16_t*)(ws + WS_ZT)};
        pg8::gemm_phase<pg8::EpiZt, pg8::StaticOrder, true, true>(lds, g, S, E);
    }
    SEAM(PH_G1);
    if (IN(PH_S1)) { FRESH_IDS();
        const int gw = bx * NWAVES + wave, NGW = G * NWAVES;
        for (int it = gw; it < 32 * 256 * 2; it += NGW) fft16_item((bf16*)(ws + WS_ZT), (const float*)(ws + WS_TW), it >> 9, (it >> 1) & 255, it & 1, lane);
    }
    SEAM(PH_S1);
    for (int rep_ = 0; rep_ < REP_GEMM; ++rep_)
    if (IN(PH_G2)) { FRESH_IDS();
        pg8::Gemm g{(const pg8::bf16_t*)(ws + WS_A2), (const pg8::bf16_t*)(ws + WS_ZT), 256, 131072, 512}; pg8::StaticOrder S; S.init(256, 131072, G, bx);
        pg8::EpiY E{(pg8::bf16_t*)(ws + WS_Y)};
        pg8::gemm_phase<pg8::EpiY, pg8::StaticOrder, true, true>(lds, g, S, E);
    }
    SEAM(PH_G2);
    if (IN(PH_G3)) { FRESH_IDS();
        pg8::Gemm g{(const pg8::bf16_t*)(ws + WS_Y), (const pg8::bf16_t*)(ws + WS_WOF), T, DM, DM}; pg8::StaticOrder S; S.init(T, DM, G, bx);
        pg8::EpiRes E{a.in[0], a.out, (pg8::bf16_t*)(ws + WS_XB), (float*)(ws + WS_SSQ_A), ws + WS_X8};
        pg8::gemm_phase<pg8::EpiRes, pg8::StaticOrder, true, true>(lds, g, S, E);
    }
    SEAM(PH_G3);
#define PEER_LAYER(L) do { \
        const int pq = L ? PH_Q1 : PH_Q0, ptk = L ? PH_TK1 : PH_TK0, ppa = L ? PH_PA1 : PH_PA0, ppw = L ? PH_PW1 : PH_PW0, ppb = L ? PH_PB1 : PH_PB0; \
        for (int rep_ = 0; rep_ < REP_Q; ++rep_) \
        if (IN(pq)) { FRESH_IDS(); \
            pg8::Gemm g{(const pg8::bf16_t*)(ws + WS_XB), (const pg8::bf16_t*)(ws + (L ? WS_WQ1 : WS_WQ0)), T, DM, DM}; pg8::StaticOrder S; S.init(T, DM, G, bx); \
            pg8::EpiScale E{(pg8::bf16_t*)(ws + WS_Q), (const float*)(ws + (L ? WS_SSQ_C : WS_SSQ_A))}; \
            pg8::gemm_phase<pg8::EpiScale, pg8::StaticOrder, true, true>(lds, g, S, E); \
        } \
        if (IN(pq) && IN(ptk)) { asm volatile("s_waitcnt vmcnt(0)" ::: "memory"); __syncthreads(); } STAMP(pq + 1); \
        if (IN(ptk)) { FRESH_IDS(); \
            const bf16* keys = (const bf16*)(ws + WS_KEYS) + (size_t)L * PH * 2 * 128 * 128; \
            int slot = 0; \
            for (int rep_ = 0; rep_ < REP_TK; ++rep_) { slot = 0; \
            for (int ui = 0; ; ++ui) {        \
                const int upk = static_unit(T / 256, DM / 256, G, bx, ui); if (upk < 0) break; \
                const int h = upk & 0xffff, tblk = upk >> 16; \
                __syncthreads(); \
                topk_fill(lds, keys, h, tid); \
                __syncthreads(); \
                topk_unit((const bf16*)(ws + WS_Q), lds, (int*)(ws + WS_EI), (float*)(ws + WS_GW), tblk * 256 + wave * 32, h, lane); \
                slot += 16; \
            } } \
        } \
        SEAM(ptk); \
        if (IN(ppa)) { FRESH_IDS(); \
            const int xv = bx & 7; \
            peer_a_slice<8>((const unsigned char*)(ws + WS_X8), (const int*)(ws + WS_EI), (const unsigned char*)(ws + (L ? WS_U1 : WS_U0)), (float*)(ws + WS_PD), xv, (unsigned*)(ws + WS_BCTR) + (L * 2 + 0) * 512 + xv * 64, T / 8, lane); \
        } \
        SEAM(ppa); \
        if (IN(ppw)) { FRESH_IDS(); \
            const int gw = bx * NWAVES + wave, NGW = G * NWAVES; \
            for (int t = gw; t < T; t += NGW) peer_a2_token((const float*)(ws + WS_PD), (const float*)(ws + (L ? WS_SSQ_C : WS_SSQ_A)), (const int*)(ws + WS_EI), (const float*)(ws + WS_SU) + L * 32768, (const float*)(ws + WS_SV) + L * 32768, (float*)(ws + WS_GW), (float*)(ws + WS_W1), t, lane); \
        } \
        SEAM(ppw); \
        if (IN(ppb)) { FRESH_IDS(); \
            const int xv = bx & 7; \
            peer_b_slice<4>((const bf16*)(ws + WS_XB), a.out, (const int*)(ws + WS_EI), (const unsigned*)(ws + ((xv < 4) ? WS_GW : WS_W1)), (const unsigned char*)(ws + (L ? WS_V1 : WS_V0)), L ? (bf16*)nullptr : (bf16*)(ws + WS_XB), (float*)(ws + (L ? WS_SSQ_D : WS_SSQ_B)), xv, (unsigned*)(ws + WS_BCTR) + (L * 2 + 1) * 512 + xv * 64, T / 4, lane); \
        } \
    } while (0)
    float oscale = 1.f;
    PEER_LAYER(0);
    SEAM(PH_PB0);
    for (int rep_ = 0; rep_ < REP_GEMM; ++rep_)
    if (IN(PH_QKV)) { FRESH_IDS();
        {
            pg8::Gemm g{(const pg8::bf16_t*)(ws + WS_XB), (const pg8::bf16_t*)(ws + WS_WQKV), T, 2560, DM}; pg8::StaticOrder S; S.init(T, 2560, G, bx);
            pg8::EpiQK E{(pg8::bf16_t*)(ws + WS_QB), (pg8::bf16_t*)(ws + WS_KB), (const float*)(ws + WS_SSQ_B), (const float*)(ws + WS_ROPE), 0.125f * 1.4426950408889634f};
            pg8::gemm_phase<pg8::EpiQK, pg8::StaticOrder, true, true>(lds, g, S, E);
        }
        if (bx >= G / 2) {
            pg8::Gemm g{(const pg8::bf16_t*)(ws + WS_WQKV) + (size_t)2560 * DM, (const pg8::bf16_t*)(ws + WS_XB), 512, T, DM}; pg8::StaticOrder S; S.init(512, T, G / 2, bx - G / 2);
            pg8::EpiVt E{(pg8::bf16_t*)(ws + WS_VT), (const float*)(ws + WS_SSQ_B)};
            pg8::gemm_phase<pg8::EpiVt, pg8::StaticOrder, true, true>(lds, g, S, E);
        }
    }
    SEAM(PH_QKV);
    for (int rep_ = 0; rep_ < REP_ATT; ++rep_)
    if (IN(PH_ATT)) { FRESH_IDS();
        for (int vb = bx; vb < 256; vb += G) {
            const int bkv = vb >> 3, chunk = vb & 7, b = bkv >> 3, kvh = bkv & 7;
            const bf16* Kp = (const bf16*)(ws + WS_KB); const bf16* Vp = (const bf16*)(ws + WS_VT); const int q0s = chunk * 512;
            __syncthreads();
            { v4u k5[5], v5[5];
#pragma unroll
              for (int j = 0; j < 5; ++j) { const int n0 = q0s - 128 + 64 * j; if (n0 >= 0 && n0 < 4096) attn_blk_load(Kp, Vp, b, kvh, n0, tid, k5[j], v5[j]); }
#pragma unroll
              for (int j = 0; j < 5; ++j) { const int n0 = q0s - 128 + 64 * j; if (n0 >= 0 && n0 < 4096) attn_blk_store(lds, n0, tid, k5[j], v5[j]); } }
            __syncthreads();
            for (int i = 0; i < 8; ++i) {
                const int qu = q0s + 64 * i, nn = qu + 192;
                const bool nv = (i + 1 < 8) && (nn < 4096);
                v4u kr, vr;
                if (nv) attn_blk_load(Kp, Vp, b, kvh, nn, tid, kr, vr);
                attn_task(lds, (const bf16*)(ws + WS_QB), (bf16*)(ws + WS_O), a.in[6], b, kvh * 4 + (wave & 3), qu + (wave >> 2) * 32, lane);
                if (nv) attn_blk_store(lds, nn, tid, kr, vr);
                __syncthreads();
            }
        }
    }
    SEAM(PH_ATT);
    if (IN(PH_WO)) { FRESH_IDS();
        pg8::Gemm g{(const pg8::bf16_t*)(ws + WS_O), (const pg8::bf16_t*)(ws + WS_WOA), T, DM, DM}; pg8::StaticOrder S; S.init(T, DM, G, bx);
        pg8::EpiResB E{(const pg8::bf16_t*)(ws + WS_XB), (pg8::bf16_t*)(ws + WS_XB), (float*)(ws + WS_SSQ_C), ws + WS_X8};
        pg8::gemm_phase<pg8::EpiResB, pg8::StaticOrder, true, true>(lds, g, S, E);
    }
    SEAM(PH_WO);
#ifdef DIAG_A
    { const unsigned long long* st = (const unsigned long long*)(ws + WS_STAMP); oscale = 1.f + sqrtf((float)(st[DIAG_B] - st[DIAG_A]) * 1e-6f); }
#endif
    PEER_LAYER(1);
#undef PEER_LAYER
    SEAM(PH_PB1);
    if (IN(PH_FIN)) { FRESH_IDS();
        const int gw = bx * NWAVES + wave, NGW = G * NWAVES;
        for (int t = gw; t < T; t += NGW) final_norm_row(a.out, (const float*)(ws + WS_SSQ_D), a.in[11], t, lane, oscale);
    }
#undef SEAM
#undef IN
}

#ifndef N_LAUNCHES
#define N_LAUNCHES 1
#endif
extern "C" void kernel_launch(void* const* d_in, const int* in_sizes, int n_in, void* d_out, int out_size, void* d_ws, size_t ws_size, hipStream_t stream) {
    static int grid = 0;
    if (!grid) {
        if (hipFuncSetAttribute((const void*)mega, hipFuncAttributeMaxDynamicSharedMemorySize, LDS_BYTES) != hipSuccess) { fprintf(stderr, "hipFuncSetAttribute failed\n"); }
        int dev = 0, cus = 0, per_cu = 0;
        (void)hipGetDevice(&dev);
        (void)hipDeviceGetAttribute(&cus, hipDeviceAttributeMultiprocessorCount, dev);
        if (hipOccupancyMaxActiveBlocksPerMultiprocessor(&per_cu, (const void*)mega, NWAVES * 64, LDS_BYTES) != hipSuccess) per_cu = 0;
        (void)hipGetLastError();
        grid = cus * per_cu;
        if (grid > 256) grid = 256;
        grid &= ~1;
        if (grid < 2) { fprintf(stderr, "occupancy query gave %d x %d\n", cus, per_cu); grid = -1; }
    }
    if (grid < 0) return;
    if (ws_size < 700 * MiB) { fprintf(stderr, "ws too small: %zu\n", ws_size); return; }
    (void)hipMemsetAsync((char*)d_ws + WS_CTL, 0, CTL_BYTES, stream);
    Args a{};
    for (int i = 0; i < 12; ++i) a.in[i] = (const float*)d_in[i];
    a.out = (float*)d_out; a.ws = (unsigned char*)d_ws;
    if (N_LAUNCHES == 1) {
        a.ph_lo = 0; a.ph_hi = PH_END;
        void* args[] = {&a};
        const hipError_t e = hipLaunchCooperativeKernel((const void*)mega, dim3(grid), dim3(NWAVES * 64), args, LDS_BYTES, stream);
        if (e != hipSuccess) fprintf(stderr, "cooperative launch failed: %s (grid %d)\n", hipGetErrorString(e), grid);
    } else {
        for (int ph = 0; ph < PH_END; ++ph) {
            a.ph_lo = ph; a.ph_hi = ph + 1;
            hipLaunchKernelGGL(mega, dim3(grid), dim3(NWAVES * 64), LDS_BYTES, stream, a);
        }
    }
}
```

```cpp
#include <hip/hip_runtime.h>
#include <hip/hip_cooperative_groups.h>
namespace cg = cooperative_groups;
#include <cstdio>
#include <cstdint>
#include <cmath>

constexpr int DM = 2048, NB = 4, SEQ = 4096, T = NB * SEQ;
constexpr int FG = 8, FW = 256;
constexpr int HD = 64, NQH = 32, NKVH = 8, QKVW = 3072;
constexpr int PH = 8, NKEYS = 128, NEXP = 16384, PTOPK = 16;
constexpr float EPS = 1e-6f;
namespace pg8 {
#define PG8_LAS __attribute__((address_space(3)))
typedef unsigned short bf16_t;
typedef short bf16x8 __attribute__((ext_vector_type(8)));
typedef float f32x4 __attribute__((ext_vector_type(4)));
typedef unsigned u32x4 __attribute__((ext_vector_type(4)));
constexpr int BM = 256, BK = 64, HALF = 128, HTB = HALF * BK * 2  , STAGE_BYTES = 8 * HTB, NXCD = 8, WGM = 8;

__host__ __device__ __forceinline__ int lds_byte(int r, int c) { const int st = (r >> 4) * 2 + (c >> 5), rr = r & 15, cc = c & 31, ob = rr * 64 + cc * 2; return st * 1024 + (ob ^ (((ob >> 9) & 1) << 5)); }
__host__ __device__ __forceinline__ void stage_rc(int b, int& R, int& C) { const int st = b / 1024, sb = b % 1024, swz = sb ^ (((sb >> 9) & 1) << 5); R = (st >> 1) * 16 + swz / 64; C = (st & 1) * 32 + (swz % 64) / 2; }
__host__ __device__ __forceinline__ int perm32(int rho) { const int n = rho >> 4, i = rho & 15; return 8 * (i >> 2) + 4 * n + (i & 3); }

struct Unit { int pm, pn; };
struct Gemm { const bf16_t* A; const bf16_t* Bt; int M, N, K; };

struct StaticOrder {
    int nM, nN, nwg, G, c;
    __host__ __device__ void init(int M, int N, int G_, int c_) { nM = M / BM; nN = N / BM; nwg = nM * nN; G = G_; c = c_; }
    __host__ __device__ bool next(int i, Unit& u) const {
        const long L = (long)i * G + c; if (L >= nwg) return false;
        int wgid = (int)L; { const int q = nwg / NXCD, r = nwg % NXCD, xcd = wgid % NXCD, off = wgid / NXCD; wgid = (xcd < r ? xcd * (q + 1) : r * (q + 1) + (xcd - r) * q) + off; }
        const int nig = WGM * nN, gid = wgid / nig, fm = gid * WGM, gsz = (nM - fm) < WGM ? (nM - fm) : WGM;
        u.pm = fm + ((wgid % nig) % gsz); u.pn = (wgid % nig) / gsz; return true;
    }
    __device__ __forceinline__ void a_ready(const Unit&) const {}
    __device__ __forceinline__ void done(const Unit&) const {}
};

__device__ __forceinline__ unsigned cvt_pk_bf16(float lo, float hi) { unsigned r; asm volatile("v_cvt_pk_bf16_f32 %0, %1, %2" : "=v"(r) : "v"(lo), "v"(hi)); return r; }
typedef float f32x2 __attribute__((ext_vector_type(2)));
__device__ __forceinline__ u32x4 pack8(const f32x4 v0, const f32x4 v1) { u32x4 w; w.x = cvt_pk_bf16(v0[0], v0[1]); w.y = cvt_pk_bf16(v0[2], v0[3]); w.z = cvt_pk_bf16(v1[0], v1[1]); w.w = cvt_pk_bf16(v1[2], v1[3]); return w; }
struct EpiZt {
    static constexpr bool PERM = true, AFTER_DRAIN = false; bf16_t* Zp;
    __device__ __forceinline__ void operator()(const f32x4 (&acc)[2][2][4][2], const Unit& u, int wr, int wc, int fr, int fq) const {
        const int part = u.pm, bgs2 = u.pn;
        bf16_t* base = Zp + ((size_t)(bgs2 * 256 + wr * 64 + fr) * 512 + part * 256 + wc * 32 + 8 * fq);
#pragma unroll
        for (int ai = 0; ai < 2; ++ai)
#pragma unroll
            for (int m = 0; m < 4; ++m)
#pragma unroll
                for (int bj = 0; bj < 2; ++bj) *(u32x4*)(base + (ai * HALF + m * 16) * 512 + bj * HALF) = pack8(acc[ai][bj][m][0], acc[ai][bj][m][1]);
    }
};
struct EpiY {
    static constexpr bool PERM = true, AFTER_DRAIN = false; bf16_t* Y;
    __device__ __forceinline__ void operator()(const f32x4 (&acc)[2][2][4][2], const Unit& u, int wr, int wc, int fr, int fq) const {
        const int bg = u.pn >> 4, k2 = u.pn & 15, b = bg >> 3, g = bg & 7;
        bf16_t* base = Y + ((size_t)(b * 4096 + (wr * 64 + fr) * 16 + k2) * 2048 + g * 256 + wc * 32 + 8 * fq);
#pragma unroll
        for (int ai = 0; ai < 2; ++ai)
#pragma unroll
            for (int m = 0; m < 4; ++m)
#pragma unroll
                for (int bj = 0; bj < 2; ++bj) *(u32x4*)(base + (size_t)(ai * HALF + m * 16) * 16 * 2048 + bj * HALF) = pack8(acc[ai][bj][m][0], acc[ai][bj][m][1]);
    }
};
struct EpiRes {
    static constexpr bool PERM = true, AFTER_DRAIN = false; const float* R; float* out; bf16_t* xb; float* ssq; unsigned char* x8;
    __device__ __forceinline__ void operator()(const f32x4 (&acc)[2][2][4][2], const Unit& u, int wr, int wc, int fr, int fq) const {
        const int row0 = u.pm * BM + wr * 64 + fr; const size_t off0 = (size_t)row0 * 2048 + u.pn * BM + wc * 32 + 8 * fq;
        const float* Rb = R + off0; bf16_t* Xb = xb + off0; float* Sb = ssq + row0;
#pragma unroll
        for (int ai = 0; ai < 2; ++ai)
#pragma unroll
            for (int m = 0; m < 4; ++m) { const int ro = (ai * HALF + m * 16) * 2048; float ss = 0.f;
#pragma unroll
                for (int bj = 0; bj < 2; ++bj) {
                    const f32x4 r0 = *(const f32x4*)(Rb + ro + bj * HALF), r1 = *(const f32x4*)(Rb + ro + bj * HALF + 4);
                    const f32x4 o0 = acc[ai][bj][m][0] + r0, o1 = acc[ai][bj][m][1] + r1;
                    *(u32x4*)(Xb + ro + bj * HALF) = pack8(o0, o1);
                    { int lo8 = 0, hi8 = 0; lo8 = __builtin_amdgcn_cvt_pk_fp8_f32(o0[0], o0[1], lo8, false); lo8 = __builtin_amdgcn_cvt_pk_fp8_f32(o0[2], o0[3], lo8, true);
                      hi8 = __builtin_amdgcn_cvt_pk_fp8_f32(o1[0], o1[1], hi8, false); hi8 = __builtin_amdgcn_cvt_pk_fp8_f32(o1[2], o1[3], hi8, true);
                      *(unsigned long long*)(x8 + off0 + ro + bj * HALF) = ((unsigned long long)(unsigned)hi8 << 32) | (unsigned)lo8; }
                    ss += (o0[0] * o0[0] + o0[1] * o0[1]) + (o0[2] * o0[2] + o0[3] * o0[3]) + (o1[0] * o1[0] + o1[1] * o1[1]) + (o1[2] * o1[2] + o1[3] * o1[3]); }
                ss += __shfl_xor(ss, 16); ss += __shfl_xor(ss, 32);
                if (fq == 0) unsafeAtomicAdd(Sb + ai * HALF + m * 16, ss);
                asm volatile("" ::: "memory"); }
    }
};
struct EpiResB {
    static constexpr bool PERM = true, AFTER_DRAIN = false; const bf16_t* R; bf16_t* xb; float* ssq; unsigned char* x8;
    __device__ __forceinline__ void operator()(const f32x4 (&acc)[2][2][4][2], const Unit& u, int wr, int wc, int fr, int fq) const {
        const int row0 = u.pm * BM + wr * 64 + fr; const size_t off0 = (size_t)row0 * 2048 + u.pn * BM + wc * 32 + 8 * fq;
        const bf16_t* Rb = R + off0; bf16_t* Xb = xb + off0; float* Sb = ssq + row0;
#pragma unroll
        for (int ai = 0; ai < 2; ++ai)
#pragma unroll
            for (int m = 0; m < 4; ++m) { const int ro = (ai * HALF + m * 16) * 2048; float ss = 0.f;
#pragma unroll
                for (int bj = 0; bj < 2; ++bj) {
                    const u32x4 rw = *(const u32x4*)(Rb + ro + bj * HALF);
                    const f32x4 r0 = (f32x4){__uint_as_float(rw[0] << 16), __uint_as_float(rw[0] & 0xffff0000u), __uint_as_float(rw[1] << 16), __uint_as_float(rw[1] & 0xffff0000u)}, r1 = (f32x4){__uint_as_float(rw[2] << 16), __uint_as_float(rw[2] & 0xffff0000u), __uint_as_float(rw[3] << 16), __uint_as_float(rw[3] & 0xffff0000u)};
                    const f32x4 o0 = acc[ai][bj][m][0] + r0, o1 = acc[ai][bj][m][1] + r1;
                    *(u32x4*)(Xb + ro + bj * HALF) = pack8(o0, o1);
                    { int lo8 = 0, hi8 = 0; lo8 = __builtin_amdgcn_cvt_pk_fp8_f32(o0[0], o0[1], lo8, false); lo8 = __builtin_amdgcn_cvt_pk_fp8_f32(o0[2], o0[3], lo8, true);
                      hi8 = __builtin_amdgcn_cvt_pk_fp8_f32(o1[0], o1[1], hi8, false); hi8 = __builtin_amdgcn_cvt_pk_fp8_f32(o1[2], o1[3], hi8, true);
                      *(unsigned long long*)(x8 + off0 + ro + bj * HALF) = ((unsigned long long)(unsigned)hi8 << 32) | (unsigned)lo8; }
                    ss += (o0[0] * o0[0] + o0[1] * o0[1]) + (o0[2] * o0[2] + o0[3] * o0[3]) + (o1[0] * o1[0] + o1[1] * o1[1]) + (o1[2] * o1[2] + o1[3] * o1[3]); }
                ss += __shfl_xor(ss, 16); ss += __shfl_xor(ss, 32);
                if (fq == 0) unsafeAtomicAdd(Sb + ai * HALF + m * 16, ss);
                asm volatile("" ::: "memory"); }
    }
};
struct EpiScale {
    static constexpr bool PERM = true, AFTER_DRAIN = false; bf16_t* O; const float* ssq;
    __device__ __forceinline__ void operator()(const f32x4 (&acc)[2][2][4][2], const Unit& u, int wr, int wc, int fr, int fq) const {
        const int row0 = u.pm * BM + wr * 64 + fr;
        bf16_t* base = O + ((size_t)row0 * 2048 + u.pn * BM + wc * 32 + 8 * fq); const float* Sb = ssq + row0;
#pragma unroll
        for (int ai = 0; ai < 2; ++ai)
#pragma unroll
            for (int m = 0; m < 4; ++m) { const float rs = rsqrtf(Sb[ai * HALF + m * 16] * (1.f / 2048.f) + 1e-6f);
#pragma unroll
                for (int bj = 0; bj < 2; ++bj) *(u32x4*)(base + (ai * HALF + m * 16) * 2048 + bj * HALF) = pack8(acc[ai][bj][m][0] * rs, acc[ai][bj][m][1] * rs); }
    }
};
struct EpiQK {
    static constexpr bool PERM = true, AFTER_DRAIN = false; bf16_t* Q; bf16_t* K; const float* ssq; const float* rope; float qscale;
    __device__ __forceinline__ void operator()(const f32x4 (&acc)[2][2][4][2], const Unit& u, int wr, int wc, int fr, int fq) const {
        const int row0 = u.pm * BM + wr * 64 + fr; const bool isq = u.pn < 8;
        const int cl = wc * 32 + 8 * fq;
        bf16_t* base = isq ? (Q + ((size_t)row0 * 2048 + u.pn * BM + cl)) : (K + ((size_t)row0 * 512 + (u.pn - 8) * BM + cl));
        const int ld = isq ? 2048 : 512; const float sc = isq ? qscale : 1.f;
        const float* rp = rope + (size_t)(row0 & 4095) * 64 + (cl & 63);
        const float* Sb = ssq + row0;
#pragma unroll
        for (int ai = 0; ai < 2; ++ai)
#pragma unroll
            for (int m = 0; m < 4; ++m) { const int ro = ai * HALF + m * 16; const float rs = rsqrtf(Sb[ro] * (1.f / 2048.f) + 1e-6f) * sc;
                const f32x4 t0 = *(const f32x4*)(rp + (size_t)ro * 64), t1 = *(const f32x4*)(rp + (size_t)ro * 64 + 4);
#pragma unroll
                for (int bj = 0; bj < 2; ++bj) {
                    const f32x4 a = acc[ai][bj][m][0] * rs, b = acc[ai][bj][m][1] * rs; f32x4 oa, ob;
                    oa[0] = a[0] * t0[0] - a[1] * t0[1]; oa[1] = a[1] * t0[0] + a[0] * t0[1]; oa[2] = a[2] * t0[2] - a[3] * t0[3]; oa[3] = a[3] * t0[2] + a[2] * t0[3];
                    ob[0] = b[0] * t1[0] - b[1] * t1[1]; ob[1] = b[1] * t1[0] + b[0] * t1[1]; ob[2] = b[2] * t1[2] - b[3] * t1[3]; ob[3] = b[3] * t1[2] + b[2] * t1[3];
                    *(u32x4*)(base + (size_t)ro * ld + bj * HALF) = pack8(oa, ob); } }
    }
};
struct EpiVt {
    static constexpr bool PERM = true, AFTER_DRAIN = false; bf16_t* Vt; const float* ssq;
    __device__ __forceinline__ void operator()(const f32x4 (&acc)[2][2][4][2], const Unit& u, int wr, int wc, int fr, int fq) const {
        const int col0 = u.pn * BM + wc * 32 + 8 * fq;
        bf16_t* base = Vt + ((size_t)(u.pm * BM + wr * 64 + fr) * 16384 + col0);
        f32x4 r0[2], r1[2];
#pragma unroll
        for (int bj = 0; bj < 2; ++bj) { const f32x4 s0 = *(const f32x4*)(ssq + col0 + bj * HALF), s1 = *(const f32x4*)(ssq + col0 + bj * HALF + 4);
#pragma unroll
            for (int q = 0; q < 4; ++q) { r0[bj][q] = rsqrtf(s0[q] * (1.f / 2048.f) + 1e-6f); r1[bj][q] = rsqrtf(s1[q] * (1.f / 2048.f) + 1e-6f); } }
#pragma unroll
        for (int ai = 0; ai < 2; ++ai)
#pragma unroll
            for (int m = 0; m < 4; ++m)
#pragma unroll
                for (int bj = 0; bj < 2; ++bj) *(u32x4*)(base + (size_t)(ai * HALF + m * 16) * 16384 + bj * HALF) = pack8(acc[ai][bj][m][0] * r0[bj], acc[ai][bj][m][1] * r1[bj]);
    }
};
template <class Epi, class Sched, bool ALIGN_EPI = false, bool SP2 = false>
__device__ __forceinline__ void gemm_phase(PG8_LAS unsigned char* lds, const Gemm g, const Sched& S, const Epi& E) {
    const int tid = threadIdx.x, wid = __builtin_amdgcn_readfirstlane(tid >> 6), lane = tid & 63, wr = wid >> 2, wc = wid & 3, fr = lane & 15, fq = lane >> 4;
    const int K = g.K, nt = K / BK;
    unsigned voffA[2], voffB[2];
#pragma unroll
    for (int i = 0; i < 2; ++i) { int R, C; stage_rc(tid * 16 + i * 8192, R, C); const int Rb = Epi::PERM ? ((R & ~31) + perm32(R & 31)) : R;
        voffA[i] = (unsigned)(R * K + C) * 2u; voffB[i] = (unsigned)(Rb * K + C) * 2u; }
    const size_t kstep = (size_t)(BK * 2);
    const size_t hstep = (size_t)HALF * K * 2;
    const size_t tstep = 2 * hstep;
    const unsigned ldsw = (unsigned)wid * 1024u;
    const int aoff = lds_byte(wr * 64 + fr, fq * 8), boff = lds_byte(wc * 32 + fr, fq * 8);
#define PG8_SA(b, h) (((b) * 2 + (h)) * HTB)
#define PG8_SB(b, h) ((4 + (b) * 2 + (h)) * HTB)
#define PG8_STAGE(bufoff, gbase, voff) do { _Pragma("unroll") for (int _i = 0; _i < 2; ++_i) \
        __builtin_amdgcn_global_load_lds((const unsigned*)((const char*)(gbase) + (voff)[_i]), (PG8_LAS unsigned*)(lds + (bufoff) + ldsw + _i * 8192), 16, 0, 0); } while (0)
#define PG8_LDA(dst, b, h) do { _Pragma("unroll") for (int m = 0; m < 4; ++m) _Pragma("unroll") for (int k = 0; k < 2; ++k) dst[m][k] = *(const PG8_LAS bf16x8*)(lds + PG8_SA(b, h) + aoff + m * 2048 + k * 1024); } while (0)
#define PG8_LDB(dst, b, h) do { _Pragma("unroll") for (int n = 0; n < 2; ++n) _Pragma("unroll") for (int k = 0; k < 2; ++k) dst[n][k] = *(const PG8_LAS bf16x8*)(lds + PG8_SB(b, h) + boff + n * 2048 + k * 1024); } while (0)
#define PG8_MMA(ai, bj, At, Bt) do { __builtin_amdgcn_s_setprio(1); _Pragma("unroll") for (int m = 0; m < 4; ++m) _Pragma("unroll") for (int n = 0; n < 2; ++n) _Pragma("unroll") for (int k = 0; k < 2; ++k) \
        acc[ai][bj][m][n] = __builtin_amdgcn_mfma_f32_16x16x32_bf16(Bt[n][k], At[m][k], acc[ai][bj][m][n], 0, 0, 0); __builtin_amdgcn_s_setprio(0); } while (0)
#define PG8_WAIT_V(n) asm volatile("s_waitcnt vmcnt(" #n ")" ::: "memory")
#define PG8_WAIT_L(n) asm volatile("s_waitcnt lgkmcnt(" #n ")" ::: "memory")
#define PG8_BAR __builtin_amdgcn_s_barrier()
#define PG8_SCHED __builtin_amdgcn_sched_barrier(0)
    Unit cur, nxt; int ui = 0;
    if (!S.next(0, cur)) return;
    f32x4 acc[2][2][4][2];
#pragma unroll
    for (int a = 0; a < 2; ++a)
#pragma unroll
        for (int b = 0; b < 2; ++b)
#pragma unroll
            for (int m = 0; m < 4; ++m)
#pragma unroll
                for (int n = 0; n < 2; ++n) acc[a][b][m][n] = (f32x4){0.f, 0.f, 0.f, 0.f};
    bf16x8 At[4][2], B0[2][2], B1[2][2];
    const char* cA = (const char*)g.A + (size_t)cur.pm * tstep; const char* cB = (const char*)g.Bt + (size_t)cur.pn * tstep;
    S.a_ready(cur);
    if constexpr (SP2) {
        PG8_STAGE(PG8_SB(0, 0), cB, voffB); PG8_STAGE(PG8_SB(0, 1), cB + hstep, voffB); PG8_STAGE(PG8_SA(0, 0), cA, voffA); PG8_STAGE(PG8_SA(0, 1), cA + hstep, voffA);
        if (wr == 1) PG8_BAR;
        PG8_WAIT_V(2); PG8_BAR;
        PG8_STAGE(PG8_SB(1, 0), cB + kstep, voffB); PG8_STAGE(PG8_SA(1, 0), cA + kstep, voffA); PG8_STAGE(PG8_SB(1, 1), cB + hstep + kstep, voffB);
        PG8_WAIT_V(6); PG8_BAR;
    } else {
        PG8_STAGE(PG8_SB(0, 0), cB, voffB); PG8_STAGE(PG8_SA(0, 0), cA, voffA); PG8_STAGE(PG8_SB(0, 1), cB + hstep, voffB); PG8_STAGE(PG8_SA(0, 1), cA + hstep, voffA);
        if (wr == 1) PG8_BAR;
        PG8_WAIT_V(4); PG8_BAR;
        PG8_STAGE(PG8_SB(1, 0), cB + kstep, voffB); PG8_STAGE(PG8_SA(1, 0), cA + kstep, voffA); PG8_STAGE(PG8_SB(1, 1), cB + hstep + kstep, voffB);
        PG8_WAIT_V(6); PG8_BAR;
    }
    for (;;) {
        const bool has_next = S.next(ui + 1, nxt);
        const char* nA = has_next ? (const char*)g.A + (size_t)nxt.pm * tstep : cA; const char* nB = has_next ? (const char*)g.Bt + (size_t)nxt.pn * tstep : cB;
        for (int t = 0; t < nt; t += 2) {
            const bool last = (t == nt - 2);
            const char* a1 = cA + (size_t)(t + 1) * kstep;
            const char* a2 = last ? nA : cA + (size_t)(t + 2) * kstep; const char* b2 = last ? nB : cB + (size_t)(t + 2) * kstep;
            const char* a3 = a2 + kstep; const char* b3 = b2 + kstep;
            if (last && has_next) S.a_ready(nxt);
            if constexpr (SP2) {
            PG8_LDB(B0, 0, 0); PG8_LDB(B1, 0, 1); PG8_SCHED; PG8_LDA(At, 0, 0); PG8_STAGE(PG8_SA(1, 1), a1 + hstep, voffA);
            PG8_WAIT_V(8); PG8_WAIT_L(0); PG8_BAR; PG8_MMA(0, 0, At, B0); PG8_MMA(0, 1, At, B1); PG8_BAR; PG8_SCHED;
            PG8_LDA(At, 0, 1); PG8_STAGE(PG8_SB(0, 0), b2, voffB); PG8_STAGE(PG8_SB(0, 1), b2 + hstep, voffB); PG8_STAGE(PG8_SA(0, 0), a2, voffA);
            PG8_WAIT_V(8); PG8_WAIT_L(0); PG8_BAR; PG8_MMA(1, 0, At, B0); PG8_MMA(1, 1, At, B1); PG8_BAR; PG8_SCHED;
            PG8_LDB(B0, 1, 0); PG8_LDB(B1, 1, 1); PG8_SCHED; PG8_LDA(At, 1, 0); PG8_STAGE(PG8_SA(0, 1), a2 + hstep, voffA);
            PG8_WAIT_V(8); PG8_WAIT_L(0); PG8_BAR; PG8_MMA(0, 0, At, B0); PG8_MMA(0, 1, At, B1); PG8_BAR; PG8_SCHED;
            PG8_LDA(At, 1, 1); PG8_STAGE(PG8_SB(1, 0), b3, voffB); PG8_STAGE(PG8_SB(1, 1), b3 + hstep, voffB); PG8_STAGE(PG8_SA(1, 0), a3, voffA);
            PG8_WAIT_V(8); PG8_WAIT_L(0); PG8_BAR; PG8_MMA(1, 0, At, B0); PG8_MMA(1, 1, At, B1); PG8_BAR; PG8_SCHED;
            } else {
            PG8_LDB(B0, 0, 0); PG8_SCHED; PG8_LDA(At, 0, 0); PG8_STAGE(PG8_SA(1, 1), a1 + hstep, voffA);
            PG8_WAIT_L(8); PG8_BAR; PG8_WAIT_L(0); PG8_MMA(0, 0, At, B0); PG8_BAR; PG8_SCHED;
            PG8_LDB(B1, 0, 1); PG8_STAGE(PG8_SB(0, 0), b2, voffB);
            PG8_BAR; PG8_WAIT_L(0); PG8_MMA(0, 1, At, B1); PG8_BAR;
            PG8_LDA(At, 0, 1); PG8_STAGE(PG8_SA(0, 0), a2, voffA);
            PG8_BAR; PG8_WAIT_L(0); PG8_MMA(1, 0, At, B0); PG8_BAR; PG8_SCHED;
            PG8_STAGE(PG8_SB(0, 1), b2 + hstep, voffB);
            PG8_WAIT_V(6); PG8_BAR; PG8_MMA(1, 1, At, B1); PG8_BAR;
            PG8_LDB(B0, 1, 0); PG8_SCHED; PG8_LDA(At, 1, 0); PG8_STAGE(PG8_SA(0, 1), a2 + hstep, voffA);
            PG8_WAIT_L(8); PG8_BAR; PG8_WAIT_L(0); PG8_MMA(0, 0, At, B0); PG8_BAR; PG8_SCHED;
            PG8_LDB(B1, 1, 1); PG8_STAGE(PG8_SB(1, 0), b3, voffB);
            PG8_BAR; PG8_WAIT_L(0); PG8_MMA(0, 1, At, B1); PG8_BAR;
            PG8_LDA(At, 1, 1); PG8_STAGE(PG8_SA(1, 0), a3, voffA);
            PG8_BAR; PG8_WAIT_L(0); PG8_MMA(1, 0, At, B0); PG8_BAR; PG8_SCHED;
            PG8_STAGE(PG8_SB(1, 1), b3 + hstep, voffB);
            PG8_WAIT_V(6); PG8_BAR; PG8_MMA(1, 1, At, B1); PG8_BAR;
            }
        }
        if constexpr (ALIGN_EPI) { if (wr == 0) PG8_BAR; }
        if constexpr (!Epi::AFTER_DRAIN) { E(acc, cur, wr, wc, fr, fq); S.done(cur); }
        if (!has_next) break;
#pragma unroll
        for (int a = 0; a < 2; ++a)
#pragma unroll
            for (int b = 0; b < 2; ++b)
#pragma unroll
                for (int m = 0; m < 4; ++m)
#pragma unroll
                    for (int n = 0; n < 2; ++n) acc[a][b][m][n] = (f32x4){0.f, 0.f, 0.f, 0.f};
        cur = nxt; cA = nA; cB = nB; ++ui;
        if constexpr (ALIGN_EPI) { if (wr == 1) PG8_BAR; }
    }
    PG8_WAIT_V(0);
    if constexpr (!ALIGN_EPI) { if (wr == 0) PG8_BAR; }
    PG8_BAR;
    if constexpr (Epi::AFTER_DRAIN) { E.fused(acc, cur, wr, wc, fr, fq, lds, wid, lane); S.done(cur); }
#undef PG8_SA
#undef PG8_SB
#undef PG8_STAGE
#undef PG8_LDA
#undef PG8_LDB
#undef PG8_MMA
#undef PG8_WAIT_V
#undef PG8_WAIT_L
#undef PG8_BAR
#undef PG8_SCHED
}
}
#define GAS __attribute__((address_space(1)))
#define LAS __attribute__((address_space(3)))
typedef unsigned short bf16;
typedef unsigned v4u __attribute__((ext_vector_type(4)));
typedef unsigned v2u __attribute__((ext_vector_type(2)));
typedef float f32x4 __attribute__((ext_vector_type(4)));
constexpr int NWAVES = 8;
constexpr int LDS_BYTES = 147456, LDSCTL_OFF = 131072;
constexpr int CW_BAR = 4096;
constexpr size_t MiB = 1u << 20;
constexpr size_t WS_CTL = 0, CTL_BYTES = 1 * MiB;
constexpr size_t WS_SSQ_A = 256 * 1024, WS_SSQ_B = 320 * 1024, WS_SSQ_C = 384 * 1024, WS_SSQ_D = 448 * 1024;
constexpr size_t WS_STAMP = 128 * 1024;
constexpr size_t WS_BCTR = 192 * 1024;
constexpr size_t WS_SU = 512 * 1024, WS_SV = 768 * 1024;
constexpr size_t WS_WCS = 1 * MiB, WS_ROPE = 2 * MiB, WS_KEYS = 3 * MiB;
constexpr size_t WS_WOF = 8 * MiB, WS_WQKV = 16 * MiB, WS_WOA = 28 * MiB, WS_WQ0 = 36 * MiB, WS_WQ1 = 44 * MiB;
constexpr size_t WS_A2 = 64 * MiB, WS_TW = 65 * MiB;
constexpr size_t WS_U0 = 128 * MiB, WS_V0 = 192 * MiB, WS_U1 = 256 * MiB, WS_V1 = 320 * MiB;
constexpr size_t WS_XG = 384 * MiB, WS_XB = 384 * MiB;
constexpr size_t WS_ZT = 448 * MiB;
constexpr size_t WS_Y = 576 * MiB;
constexpr size_t WS_Q = 448 * MiB;
constexpr size_t WS_EI = 640 * MiB, WS_GW = 648 * MiB, WS_W1 = 656 * MiB, WS_X8 = 664 * MiB;
constexpr size_t WS_PD = 448 * MiB;
constexpr size_t WS_QB = 448 * MiB, WS_KB = 512 * MiB, WS_VT = 528 * MiB, WS_O = 576 * MiB;

__device__ __forceinline__ unsigned f2bf(float f) { unsigned u = __builtin_bit_cast(unsigned, f); return (u + 0x7fffu + ((u >> 16) & 1u)) >> 16; }
__device__ __forceinline__ unsigned pk2(float lo, float hi) { return f2bf(lo) | (f2bf(hi) << 16); }

struct Args { const float* in[12]; float* out; unsigned char* ws; int ph_lo, ph_hi; };

__device__ __forceinline__ int qkv_row(int n) { if (n >= 2560) return n; const int d = n & 63, pc = (d < 32) ? 2 * d : 2 * (d - 32) + 1; return (n & ~63) + pc; }
template <int MODE>
__device__ __forceinline__ void transpose_item(const float* W, int K, int N, const float* gain, bf16* WT, LAS float* scr, int item, int lane) {
    const int nblk = N / 32, kb = item / nblk, nb = item % nblk, k0 = 64 * kb, n0 = 32 * nb;
    float wv[32];
#pragma unroll
    for (int i = 0; i < 32; ++i) wv[i] = W[(size_t)(k0 + 2 * i + (lane >> 5)) * N + n0 + (lane & 31)];
#pragma unroll
    for (int i = 0; i < 32; ++i) { const int kk = 2 * i + (lane >> 5); float v = wv[i]; if (gain) v *= gain[k0 + kk]; scr[kk * 33 + (lane & 31)] = v; }
    asm volatile("s_waitcnt lgkmcnt(0)" ::: "memory");
    const int c = lane & 7;
#pragma unroll
    for (int j = 0; j < 4; ++j) { const int n = (lane >> 3) + 8 * j; const LAS float* s = scr + (8 * c) * 33 + n;
        v4u o; o.x = pk2(s[0 * 33], s[1 * 33]); o.y = pk2(s[2 * 33], s[3 * 33]); o.z = pk2(s[4 * 33], s[5 * 33]); o.w = pk2(s[6 * 33], s[7 * 33]);
        const int row = (MODE == 1) ? qkv_row(n0 + n) : (n0 + n);
        *(v4u*)(WT + (size_t)row * K + k0 + 8 * c) = o; }
    asm volatile("s_waitcnt lgkmcnt(0)" ::: "memory");
}
__device__ __forceinline__ float wsum(float v) {
#pragma unroll
    for (int o = 1; o < 64; o <<= 1) v += __shfl_xor(v, o);
    return v;
}
__device__ __forceinline__ void cvt_stream(const float* src, bf16* dst, size_t n8, size_t gtid, size_t ngt) {
    for (size_t i = gtid; i < n8; i += ngt) {
        const f32x4 a = *(const f32x4*)(src + i * 8), b = *(const f32x4*)(src + i * 8 + 4);
        v4u o; o.x = pk2(a[0], a[1]); o.y = pk2(a[2], a[3]); o.z = pk2(b[0], b[1]); o.w = pk2(b[2], b[3]);
        *(v4u*)(dst + i * 8) = o;
    }
}
__device__ __forceinline__ void cvt_stream8(const float* src, unsigned char* dst, size_t n16, size_t gtid, size_t ngt, float scale) {
    for (size_t i = gtid; i < n16; i += ngt) {
        v4u o;
#pragma unroll
        for (int q = 0; q < 4; ++q) { f32x4 a = *(const f32x4*)(src + i * 16 + 4 * q) * scale;
#pragma unroll
            for (int e = 0; e < 4; ++e) a[e] = fminf(fmaxf(a[e], -448.f), 448.f);
            int w = 0; w = __builtin_amdgcn_cvt_pk_fp8_f32(a[0], a[1], w, false); w = __builtin_amdgcn_cvt_pk_fp8_f32(a[2], a[3], w, true); o[q] = (unsigned)w; }
        const size_t e = i >> 7, r = i & 127, sl = r >> 3, c8 = r & 7;
        *(v4u*)(dst + ((sl * 16384 + e) * 128 + c8 * 16)) = o;
    }
}
#define XB_TMO      128
#define XB_XCNT(j)  (256  + 64 * (j))
#define XB_XSUB(j)  (1280 + 64 * (j))
#define XB_XGEN(j)  (2304 + 64 * (j))
#define XB_TOP      3328
#define XB_TOPGEN   3392
#define XCD_BAR_WORDS 3456
#define XB_SPIN_CAP (1u << 18)

__device__ __forceinline__ unsigned xb_ld(unsigned* p)              { return __hip_atomic_load(p, __ATOMIC_RELAXED, __HIP_MEMORY_SCOPE_AGENT); }
__device__ __forceinline__ unsigned xb_add(unsigned* p, unsigned v) { return __hip_atomic_fetch_add(p, v, __ATOMIC_RELAXED, __HIP_MEMORY_SCOPE_AGENT); }
__device__ __forceinline__ unsigned xb_xcc_id() { return (unsigned)__builtin_amdgcn_s_getreg((3 << 11) | 20) & 0xFu; }
#define XB_SPIN(cond, bar) do { unsigned _sp = 0; while (cond) { __builtin_amdgcn_s_sleep(1); \
    if ((++_sp & 255u) == 0u) { if (xb_ld(&(bar)[XB_TMO])) break; if (_sp > XB_SPIN_CAP) { atomicAdd(&(bar)[XB_TMO], 1u); break; } } } } while (0)

struct XcdBarrier {
    unsigned* bar; unsigned x;
    volatile LAS unsigned* st;
};

__device__ __forceinline__ XcdBarrier xcd_barrier_post(unsigned* bar, volatile LAS unsigned* st) {
    XcdBarrier b; b.bar = bar; b.x = xb_xcc_id(); b.st = st;
    if (threadIdx.x == 0) (void)xb_add(&bar[XB_XCNT(b.x)], 1u);
    return b;
}
__device__ __forceinline__ void xcd_barrier_complete(unsigned* bar, unsigned x, unsigned& nloc, unsigned& nx) {
    const unsigned G = gridDim.x * gridDim.y * gridDim.z;
    unsigned sum, cnt, mine, sp = 0u;
    for (;;) {
        sum = 0u; cnt = 0u; mine = 0u;
#pragma unroll
        for (unsigned j = 0; j < 16; ++j) { const unsigned c = xb_ld(&bar[XB_XCNT(j)]); sum += c; cnt += (c > 0u) ? 1u : 0u; mine = (j == x) ? c : mine; }
        if (sum == G) break;
        __builtin_amdgcn_s_sleep(1);
        if ((++sp & 255u) == 0u) { if (xb_ld(&bar[XB_TMO])) break; if (sp > XB_SPIN_CAP) { atomicAdd(&bar[XB_TMO], 1u); break; } }
    }
    nloc = mine > 0u ? mine : 1u; nx = cnt > 0u ? cnt : 1u;
}

__device__ __forceinline__ void xcd_barrier(const XcdBarrier& b) {
    asm volatile("s_waitcnt vmcnt(0)" ::: "memory");
    __syncthreads();
    if (threadIdx.x == 0) {
        unsigned* bar = b.bar;
        __builtin_amdgcn_s_waitcnt(0);
        unsigned nloc = b.st[0], nx = b.st[1];
        if (nloc == 0u) { xcd_barrier_complete(bar, b.x, nloc, nx); b.st[0] = nloc; b.st[1] = nx; }
        const unsigned old = xb_add(&bar[XB_XSUB(b.x)], 1u);
        const unsigned gen = old / nloc;
        if (old + 1u == (gen + 1u) * nloc) {
            __builtin_amdgcn_fence(__ATOMIC_RELEASE, "agent");
            asm volatile("s_waitcnt vmcnt(0)" ::: "memory");
            const unsigned og = xb_add(&bar[XB_TOP], 1u);
            const unsigned tg = og / nx;
            if (og + 1u == (tg + 1u) * nx) xb_add(&bar[XB_TOPGEN], 1u);
            else XB_SPIN(xb_ld(&bar[XB_TOPGEN]) == tg, bar);
            __builtin_amdgcn_fence(__ATOMIC_ACQUIRE, "agent");
            xb_add(&bar[XB_XGEN(b.x)], 1u);
            asm volatile("s_waitcnt vmcnt(0)" ::: "memory");
        } else {
            XB_SPIN(xb_ld(&bar[XB_XGEN(b.x)]) == gen, bar);
            __builtin_amdgcn_fence(__ATOMIC_ACQUIRE, "agent");
            asm volatile("s_waitcnt vmcnt(0)" ::: "memory");
        }
    }
    __syncthreads();
}
#define U_SCALE 1024.f
#define V_SCALE 256.f
typedef float f32x16 __attribute__((ext_vector_type(16)));
#ifndef TKB
#define TKB 2
#endif
typedef short s16x8 __attribute__((ext_vector_type(8)));
typedef __bf16 bf16x2_t __attribute__((ext_vector_type(2)));
__device__ __forceinline__ unsigned ordf(float f) { const unsigned u = __float_as_uint(f); return (u & 0x80000000u) ? ~u : (u | 0x80000000u); }
__device__ __forceinline__ float unordf(unsigned u) { return __uint_as_float((u & 0x80000000u) ? (u & 0x7fffffffu) : ~u); }
__device__ __forceinline__ unsigned umax_(unsigned a, unsigned b) { return a > b ? a : b; }
#define DPPU(v, ctrl) ((unsigned)__builtin_amdgcn_update_dpp(0, (int)(v), (ctrl), 0xf, 0xf, true))
#define DPPF(v, ctrl) __int_as_float(__builtin_amdgcn_update_dpp(0, __float_as_int(v), (ctrl), 0xf, 0xf, true))
__device__ __forceinline__ unsigned max32(unsigned v) {
    v = umax_(v, DPPU(v, 0xB1)); v = umax_(v, DPPU(v, 0x4E)); v = umax_(v, DPPU(v, 0x141)); v = umax_(v, DPPU(v, 0x140));
    const auto r = __builtin_amdgcn_permlane16_swap(v, v, false, false);
    return umax_(r[0], r[1]);
}
__device__ __forceinline__ float sum16(float v) {
    v += DPPF(v, 0xB1); v += DPPF(v, 0x4E); v += DPPF(v, 0x141); v += DPPF(v, 0x140); return v;
}
__device__ __forceinline__ unsigned bperm(unsigned v, int srclane) { return (unsigned)__builtin_amdgcn_ds_bpermute(srclane << 2, (int)v); }
#define CMPX(a_, b_) do { const unsigned hi_ = umax_(a_, b_), lo_ = (a_ < b_) ? a_ : b_; a_ = hi_; b_ = lo_; } while (0)
__device__ __forceinline__ unsigned max16(unsigned v) { v = umax_(v, DPPU(v, 0xB1)); v = umax_(v, DPPU(v, 0x4E)); v = umax_(v, DPPU(v, 0x141)); v = umax_(v, DPPU(v, 0x140)); return v; }
__device__ __forceinline__ unsigned top16_of8(unsigned (&p)[8], int c) {
    CMPX(p[0], p[1]); CMPX(p[2], p[3]); CMPX(p[4], p[5]); CMPX(p[6], p[7]);
    CMPX(p[0], p[2]); CMPX(p[1], p[3]); CMPX(p[4], p[6]); CMPX(p[5], p[7]);
    CMPX(p[1], p[2]); CMPX(p[5], p[6]); CMPX(p[0], p[4]); CMPX(p[3], p[7]);
    CMPX(p[1], p[5]); CMPX(p[2], p[6]);
    CMPX(p[1], p[4]); CMPX(p[3], p[6]);
    CMPX(p[2], p[4]); CMPX(p[3], p[5]);
    CMPX(p[3], p[4]);
    unsigned W = 0u;
    for (int it = 0; it < 16; ++it) {
        const unsigned m = max16(p[0]);
        W = (c == it) ? m : W;
        const bool win = (p[0] == m);
#pragma unroll
        for (int i = 0; i < 7; ++i) p[i] = win ? p[i + 1] : p[i];
        p[7] = win ? 0u : p[7];
    }
    return W;
}
#define SORT8(p) do { CMPX(p[0], p[1]); CMPX(p[2], p[3]); CMPX(p[4], p[5]); CMPX(p[6], p[7]); CMPX(p[0], p[2]); CMPX(p[1], p[3]); CMPX(p[4], p[6]); CMPX(p[5], p[7]); \
    CMPX(p[1], p[2]); CMPX(p[5], p[6]); CMPX(p[0], p[4]); CMPX(p[3], p[7]); CMPX(p[1], p[5]); CMPX(p[2], p[6]); CMPX(p[1], p[4]); CMPX(p[3], p[6]); CMPX(p[2], p[4]); CMPX(p[3], p[5]); CMPX(p[3], p[4]); } while (0)
__device__ __forceinline__ void top16_of8x2(unsigned (&p)[8], unsigned (&q)[8], int c, unsigned& Wp, unsigned& Wq) {
    SORT8(p); SORT8(q);
    unsigned W0 = 0u, W1 = 0u;
    for (int it = 0; it < 16; ++it) {
        unsigned m0 = umax_(p[0], DPPU(p[0], 0xB1)), m1 = umax_(q[0], DPPU(q[0], 0xB1));
        m0 = umax_(m0, DPPU(m0, 0x4E)); m1 = umax_(m1, DPPU(m1, 0x4E));
        m0 = umax_(m0, DPPU(m0, 0x141)); m1 = umax_(m1, DPPU(m1, 0x141));
        m0 = umax_(m0, DPPU(m0, 0x140)); m1 = umax_(m1, DPPU(m1, 0x140));
        W0 = (c == it) ? m0 : W0; W1 = (c == it) ? m1 : W1;
        const bool w0 = (p[0] == m0), w1 = (q[0] == m1);
#pragma unroll
        for (int i = 0; i < 7; ++i) { p[i] = w0 ? p[i + 1] : p[i]; q[i] = w1 ? q[i + 1] : q[i]; }
        p[7] = w0 ? 0u : p[7]; q[7] = w1 ? 0u : q[7];
    }
    Wp = W0; Wq = W1;
}
__device__ __forceinline__ void top16_of4rx2(unsigned (&p)[4], unsigned (&q)[4], int c, unsigned& Wp, unsigned& Wq) {
    CMPX(p[0], p[1]); CMPX(p[2], p[3]); CMPX(p[0], p[2]); CMPX(p[1], p[3]); CMPX(p[1], p[2]);
    CMPX(q[0], q[1]); CMPX(q[2], q[3]); CMPX(q[0], q[2]); CMPX(q[1], q[3]); CMPX(q[1], q[2]);
    unsigned W0 = 0u, W1 = 0u;
    for (int it = 0; it < 16; ++it) {
        unsigned m0 = umax_(p[0], DPPU(p[0], 0xB1)), m1 = umax_(q[0], DPPU(q[0], 0xB1));
        m0 = umax_(m0, DPPU(m0, 0x4E)); m1 = umax_(m1, DPPU(m1, 0x4E));
        m0 = umax_(m0, DPPU(m0, 0x141)); m1 = umax_(m1, DPPU(m1, 0x141));
        m0 = umax_(m0, DPPU(m0, 0x140)); m1 = umax_(m1, DPPU(m1, 0x140));
        W0 = (c == it) ? m0 : W0; W1 = (c == it) ? m1 : W1;
        const bool w0 = (p[0] == m0), w1 = (q[0] == m1);
        p[0] = w0 ? p[1] : p[0]; p[1] = w0 ? p[2] : p[1]; p[2] = w0 ? p[3] : p[2]; p[3] = w0 ? 0u : p[3];
        q[0] = w1 ? q[1] : q[0]; q[1] = w1 ? q[2] : q[1]; q[2] = w1 ? q[3] : q[2]; q[3] = w1 ? 0u : q[3];
    }
    Wp = W0; Wq = W1;
}
__device__ __forceinline__ unsigned top16_of4r(unsigned (&p)[4], int c) {
    CMPX(p[0], p[1]); CMPX(p[2], p[3]); CMPX(p[0], p[2]); CMPX(p[1], p[3]); CMPX(p[1], p[2]);
    unsigned W = 0u;
    for (int it = 0; it < 16; ++it) {
        const unsigned m = max16(p[0]);
        W = (c == it) ? m : W;
        const bool win = (p[0] == m);
        p[0] = win ? p[1] : p[0]; p[1] = win ? p[2] : p[1]; p[2] = win ? p[3] : p[2]; p[3] = win ? 0u : p[3];
    }
    return W;
}
__device__ __forceinline__ void topk_fill(LAS unsigned char* lds, const bf16* keys, int h, int tid) {
#pragma unroll
    for (int i = 0; i < 8; ++i) { const int idx = tid + 512 * i, p = idx >> 11, key = (idx >> 4) & 127, ch = idx & 15;
        const v4u v = *(const v4u*)(keys + (size_t)((h * 2 + p) * 128 + key) * 128 + ch * 8);
        *(LAS v4u*)(lds + p * 32768 + key * 256 + ((ch ^ (key & 15)) << 4)) = v; }
}
struct CvtCtx { const float* srcU; long dsrc; const float* gain; unsigned char* dstU; long ddst; float* su; long dsc; int gwave, nw; };
__device__ __forceinline__ void cvt_chunk_load(const CvtCtx& cx, int c, int lane, f32x4 (&v)[4]) {
    const int r = c >> 1, hh = c & 1;
    const float* src = cx.srcU + ((r < 16384) ? 0L : cx.dsrc) + (size_t)(r & 16383) * 2048 + hh * 1024 + 4 * lane;
#pragma unroll
    for (int j = 0; j < 4; ++j) v[j] = *(const f32x4*)(src + 256 * j);
}
__device__ __forceinline__ void cvt_chunk_store(const CvtCtx& cx, int c, int lane, f32x4 (&v)[4]) {
    const int r = c >> 1, hh = c & 1; const bool isu = r < 16384; const int e = r & 16383;
    float mx = 0.f;
#pragma unroll
    for (int j = 0; j < 4; ++j) { if (isu) v[j] = v[j] * *(const f32x4*)(cx.gain + hh * 1024 + 256 * j + 4 * lane);
        mx = fmaxf(mx, fmaxf(fmaxf(fabsf(v[j][0]), fabsf(v[j][1])), fmaxf(fabsf(v[j][2]), fabsf(v[j][3])))); }
    mx = fmaxf(mx, DPPF(mx, 0xB1)); mx = fmaxf(mx, DPPF(mx, 0x4E)); mx = fmaxf(mx, DPPF(mx, 0x141)); mx = fmaxf(mx, DPPF(mx, 0x140));
    { const auto rr = __builtin_amdgcn_permlane16_swap(__float_as_uint(mx), __float_as_uint(mx), false, false); mx = fmaxf(__uint_as_float(rr[0]), __uint_as_float(rr[1])); }
    { const auto rr = __builtin_amdgcn_permlane32_swap(__float_as_uint(mx), __float_as_uint(mx), false, false); mx = fmaxf(__uint_as_float(rr[0]), __uint_as_float(rr[1])); }
    const float sc = fmaxf(mx, 1e-30f) * (1.f / 6.f), inv = 1.f / sc;
    if (lane == 0) (cx.su + (isu ? 0L : cx.dsc))[e * 2 + hh] = sc;
    unsigned char* dst = cx.dstU + (isu ? 0L : cx.ddst) + ((size_t)(hh * 4) * 16384 + e) * 128 + 2 * lane;
#pragma unroll
    for (int j = 0; j < 4; ++j) { unsigned w = 0u;
        w = __builtin_amdgcn_cvt_scalef32_pk_fp4_f32(w, v[j][0] * inv, v[j][1] * inv, 1.0f, 0); w = __builtin_amdgcn_cvt_scalef32_pk_fp4_f32(w, v[j][2] * inv, v[j][3] * inv, 1.0f, 1);
        *(unsigned short*)(dst + (size_t)j * (16384 * 128)) = (unsigned short)w; }
}
__device__ __forceinline__ void topk_unit(const bf16* q, LAS const unsigned char* lds, int* EI, float* GW, int t0, int h, int lane) {
    const int c = lane & 15, g4 = lane >> 4, rbase = lane & 48;
    int f0 = 0, f1 = 0, f2 = 0, f3 = 0;
    { int cnt = 0;
#pragma unroll
      for (int i = 0; i < 16; ++i)
#pragma unroll
        for (int j = 0; j < 16; ++j) if ((i + 1) * (j + 1) <= 16) { const int fl = i * 16 + j; f0 = (cnt == c) ? fl : f0; f1 = (cnt == c + 16) ? fl : f1; f2 = (cnt == c + 32) ? fl : f2; f3 = (cnt == c + 48) ? fl : f3; ++cnt; } }
    unsigned W[2][8];
#pragma unroll
    for (int p = 0; p < 2; ++p) {
        f32x4 acc[2][8];
#pragma unroll
        for (int mb = 0; mb < 2; ++mb)
#pragma unroll
            for (int kb = 0; kb < 8; ++kb) acc[mb][kb] = (f32x4){0.f, 0.f, 0.f, 0.f};
        const bf16* qp = q + (size_t)(t0 + c) * 2048 + h * 256 + p * 128 + g4 * 8;
        LAS const unsigned char* kp = lds + p * 32768 + c * 256;
        asm volatile("" : "+v"(qp));
#pragma unroll 2
        for (int ks = 0; ks < 4; ++ks) {
            const s16x8 a0 = *(const s16x8*)(qp + ks * 32), a1 = *(const s16x8*)(qp + (size_t)16 * 2048 + ks * 32);
#pragma unroll
            for (int kb = 0; kb < 8; ++kb) { const s16x8 b = *(LAS const s16x8*)(kp + kb * 4096 + (((4 * ks + g4) ^ c) << 4));
                acc[0][kb] = __builtin_amdgcn_mfma_f32_16x16x32_bf16(a0, b, acc[0][kb], 0, 0, 0); acc[1][kb] = __builtin_amdgcn_mfma_f32_16x16x32_bf16(a1, b, acc[1][kb], 0, 0, 0); }
        }
#pragma unroll
        for (int pb = 0; pb < 8; pb += 2) {
            unsigned pk[8], pq[8];
#pragma unroll
            for (int kb = 0; kb < 8; ++kb) { pk[kb] = (ordf(acc[pb >> 2][kb][pb & 3]) & ~127u) | (unsigned)(127 - 16 * kb - c); pq[kb] = (ordf(acc[(pb + 1) >> 2][kb][(pb + 1) & 3]) & ~127u) | (unsigned)(127 - 16 * kb - c); }
            top16_of8x2(pk, pq, c, W[p][pb], W[p][pb + 1]);
        }
    }
#define TK_CAND(CP, w0_, w1_) do { \
        { const float a0 = unordf(bperm(w0_, rbase + (f0 >> 4)) & ~127u), b0 = unordf(bperm(w1_, rbase + (f0 & 15)) & ~127u); CP[0] = (ordf(a0 + b0) & ~63u) | (unsigned)(63 - c); } \
        { const float a0 = unordf(bperm(w0_, rbase + (f1 >> 4)) & ~127u), b0 = unordf(bperm(w1_, rbase + (f1 & 15)) & ~127u); CP[1] = (ordf(a0 + b0) & ~63u) | (unsigned)(47 - c); } \
        { const float a0 = unordf(bperm(w0_, rbase + (f2 >> 4)) & ~127u), b0 = unordf(bperm(w1_, rbase + (f2 & 15)) & ~127u); CP[2] = (ordf(a0 + b0) & ~63u) | (unsigned)(31 - c); } \
        { const float a0 = unordf(bperm(w0_, rbase + (f3 >> 4)) & ~127u), b0 = unordf(bperm(w1_, rbase + (f3 & 15)) & ~127u); CP[3] = (c + 48 < 50) ? ((ordf(a0 + b0) & ~63u) | (unsigned)(15 - c)) : 0u; } } while (0)
#define TK_FINISH(Wc_, w0_, w1_, pb_) do { \
        const int slot = 63 - (int)((Wc_) & 63u); \
        const unsigned fa = bperm((unsigned)f0, rbase + (slot & 15)), fb = bperm((unsigned)f1, rbase + (slot & 15)), fc = bperm((unsigned)f2, rbase + (slot & 15)), fd = bperm((unsigned)f3, rbase + (slot & 15)); \
        const int sq = slot >> 4; const int flat = (int)((sq == 0) ? fa : (sq == 1) ? fb : (sq == 2) ? fc : fd); \
        const float val = unordf((Wc_) & ~63u); \
        const float vmax = __uint_as_float(bperm(__float_as_uint(val), rbase)); \
        const float e = __expf(val - vmax); \
        const float g = e / sum16(e); \
        const int k1 = 127 - (int)(bperm(w0_, rbase + (flat >> 4)) & 127u), k2 = 127 - (int)(bperm(w1_, rbase + (flat & 15)) & 127u); \
        const int tok = t0 + 16 * ((pb_) >> 2) + 4 * g4 + ((pb_) & 3); \
        EI[(size_t)(tok * 8 + h) * 16 + c] = k1 * 128 + k2; GW[(size_t)(tok * 8 + h) * 16 + c] = g; } while (0)
#pragma unroll
    for (int pb = 0; pb < 8; pb += 2) {
        const unsigned w0a = W[0][pb], w1a = W[1][pb], w0b = W[0][pb + 1], w1b = W[1][pb + 1];
        unsigned cpa[4], cpb[4], Wca, Wcb;
        TK_CAND(cpa, w0a, w1a); TK_CAND(cpb, w0b, w1b);
        top16_of4rx2(cpa, cpb, c, Wca, Wcb);
        TK_FINISH(Wca, w0a, w1a, pb); TK_FINISH(Wcb, w0b, w1b, pb + 1);
    }
#undef TK_CAND
#undef TK_FINISH
}

__device__ __forceinline__ float gelu_tanh_f(float x) {
    const float u = 0.7978845608028654f * (x + 0.044715f * x * x * x);
    const float e = __expf(2.f * u);
    const float th = 1.f - 2.f / (e + 1.f);
    return 0.5f * x * (1.f + th);
}
__device__ __forceinline__ float wave_sum_bfly(float v) {
#pragma unroll
    for (int o = 1; o < 64; o <<= 1) v += __shfl_xor(v, o);
    return v;
}
typedef float f32x2_ __attribute__((ext_vector_type(2)));
#define FP4_DEC(w_, sel_) __builtin_amdgcn_cvt_scalef32_pk_f32_fp4((unsigned)(w_), 1.0f, (sel_))
typedef int i32x8 __attribute__((ext_vector_type(8)));
template <int NBT>
__device__ __forceinline__ void peer_a_slice(const unsigned char* x8, const int* EI, const unsigned char* U4s, unsigned* pd, int s, unsigned* ctr, int nbatch, int lane) {
    const int c = lane & 15, g4 = lane >> 4;
    const int ksel = 2 * (c >> 2) + (g4 >> 1);
    const __amdgpu_buffer_rsrc_t trs = __builtin_amdgcn_make_buffer_rsrc((void*)(U4s + (size_t)s * (16384 * 128)), (short)0, 16384 * 128, 0x00020000);
    const unsigned choff = (unsigned)((4 * (g4 & 1) + (c & 3)) * 16);
    const __amdgpu_buffer_rsrc_t xrs = __builtin_amdgcn_make_buffer_rsrc((void*)(x8 + s * 256), (short)0, T * 2048, 0x00020000);
    const unsigned xoff = (unsigned)(128 * (g4 >> 1) + 32 * (c & 3) + 16 * (g4 & 1));
    const unsigned xo0 = (((c >> 2) & 1) == 0) ? xoff : 0x7fff0000u, xo1 = (((c >> 2) & 1) == 1) ? xoff : 0x7fff0000u;
    const unsigned sbE = ((c >> 3) == 0) ? 0x7f7f7f7fu : 0x20202020u, sbO = ((c >> 3) == 1) ? 0x7f7f7f7fu : 0x20202020u;
    const bool q1 = (c & 3) == 1, q2 = (c & 3) == 2, q3 = (c & 3) == 3;
#define A_FETCH() ((int)__builtin_amdgcn_readfirstlane((int)((lane == 0) ? __hip_atomic_fetch_add(ctr, 1u, __ATOMIC_RELAXED, __HIP_MEMORY_SCOPE_AGENT) : 0u)))
#define A_TOKB(b_, j_) ((((b_) < nbatch) ? (b_) : (nbatch - 1)) * NBT + (j_))
#define A_XS(XS, t_) do { XS[0] = __builtin_amdgcn_raw_buffer_load_b128(xrs, (int)xo0, (t_) * 2048, 0); XS[1] = __builtin_amdgcn_raw_buffer_load_b128(xrs, (int)xo1, (t_) * 2048, 0); } while (0)
#define A_ISSUE(U, EV) do { _Pragma("unroll") for (int i = 0; i < 8; ++i) { const unsigned e_ = bperm((unsigned)(EV), (i << 3) + ksel); U[i] = __builtin_amdgcn_raw_buffer_load_b128(trs, (int)((e_ << 7) | choff), 0, 0); } } while (0)
#define A_MF(D, U, i, SB) D = __builtin_amdgcn_mfma_scale_f32_16x16x128_f8f6f4((i32x8){(int)U[i][0], (int)U[i][1], (int)U[i][2], (int)U[i][3], 0, 0, 0, 0}, hb, D, 4, 0, 0, 0x7f7f7f7f, 0, (int)SB)
#define A_ACC(U, a, S) do { f32x4 d_ = (f32x4){0.f, 0.f, 0.f, 0.f}; A_MF(d_, U, 2 * (a), sbE); A_MF(d_, U, 2 * (a) + 1, sbO); \
            float v_ = d_[0]; v_ = q1 ? d_[1] : v_; v_ = q2 ? d_[2] : v_; v_ = q3 ? d_[3] : v_; v_ += DPPF(v_, 0xB1); v_ += DPPF(v_, 0x4E); S = v_; } while (0)
#define A_COMPUTE(U, OUT) do { float s0_, s1_, s2_, s3_; A_ACC(U, 0, s0_); A_ACC(U, 1, s1_); A_ACC(U, 2, s2_); A_ACC(U, 3, s3_); \
            float v_ = s0_; v_ = q1 ? s1_ : v_; v_ = q2 ? s2_ : v_; v_ = q3 ? s3_ : v_; OUT = pg8::cvt_pk_bf16(v_, DPPF(v_, 0x104)); } while (0)
    int eL[NBT], eH[NBT], nL[NBT], nH[NBT]; v4u xs[2][2]; v4u UA[8], UB[8];
    int b0 = A_FETCH(), b1 = A_FETCH();
    if (b0 >= nbatch) return;
#pragma unroll
    for (int j = 0; j < NBT; ++j) { const int tj = A_TOKB(b0, j); eL[j] = EI[(size_t)tj * 128 + lane]; eH[j] = EI[(size_t)tj * 128 + 64 + lane]; }
    A_XS(xs[0], A_TOKB(b0, 0));
    A_ISSUE(UA, eL[0]);
    while (b0 < nbatch) {
        const int b2 = A_FETCH();
#pragma unroll
        for (int j = 0; j < NBT; ++j) { const int tj = A_TOKB(b1, j); nL[j] = EI[(size_t)tj * 128 + lane]; nH[j] = EI[(size_t)tj * 128 + 64 + lane]; }
#pragma unroll
        for (int j = 0; j < NBT; ++j) {
            const int t = b0 * NBT + j;
            A_ISSUE(UB, eH[j]);
            const i32x8 hb = (i32x8){(int)xs[j & 1][0][0], (int)xs[j & 1][0][1], (int)xs[j & 1][0][2], (int)xs[j & 1][0][3], (int)xs[j & 1][1][0], (int)xs[j & 1][1][1], (int)xs[j & 1][1][2], (int)xs[j & 1][1][3]};
            unsigned out_lo, out_hi;
            A_COMPUTE(UA, out_lo);
            A_XS(xs[(j + 1) & 1], (j + 1 < NBT) ? (b0 * NBT + j + 1) : A_TOKB(b1, 0));
            A_ISSUE(UA, (j + 1 < NBT) ? eL[(j + 1) % NBT] : nL[0]);
            A_COMPUTE(UB, out_hi);
            if (((c >> 2) & 1) == 0) { unsigned* pp = pd + ((size_t)s * T + t) * 64 + 4 * (2 * (c & 3) + (c >> 3)) + g4; pp[0] = out_lo; pp[32] = out_hi; }
        }
#pragma unroll
        for (int j = 0; j < NBT; ++j) { eL[j] = nL[j]; eH[j] = nH[j]; }
        b0 = b1; b1 = b2;
    }
#undef A_FETCH
#undef A_TOKB
#undef A_XS
#undef A_ISSUE
#undef A_COMPUTE
#undef A_ACC
#undef A_MF
}
__device__ __forceinline__ unsigned w8rep(float w) { const float s = fminf(fmaxf(w * 256.f, -448.f), 448.f); return ((unsigned)__builtin_amdgcn_cvt_pk_fp8_f32(s, 0.f, 0, false) & 0xffu) * 0x01010101u; }
template <int NB>
__device__ __forceinline__ void peer_a2_tokens(const unsigned* pd, const float* ssq, const int* EI, const float* su, const float* sv, float* GW, float* W1, int t0, int tstep, int lane) {
    unsigned w[NB][8]; v2u ee[NB]; f32x2_ gg[NB]; float sq[NB];
#pragma unroll
    for (int j = 0; j < NB; ++j) { const int t = t0 + j * tstep;
#pragma unroll
        for (int s = 0; s < 8; ++s) w[j][s] = pd[((size_t)s * T + t) * 64 + lane];
        ee[j] = *(const v2u*)(EI + (size_t)t * 128 + 2 * lane); gg[j] = *(const f32x2_*)(GW + (size_t)t * 128 + 2 * lane); sq[j] = ssq[t]; }
    f32x2_ su0[NB], su1[NB], sv0[NB], sv1[NB];
#pragma unroll
    for (int j = 0; j < NB; ++j) { su0[j] = *(const f32x2_*)(su + 2 * ee[j].x); su1[j] = *(const f32x2_*)(su + 2 * ee[j].y); sv0[j] = *(const f32x2_*)(sv + 2 * ee[j].x); sv1[j] = *(const f32x2_*)(sv + 2 * ee[j].y); }
#pragma unroll
    for (int j = 0; j < NB; ++j) { const int t = t0 + j * tstep;
        float a0 = 0.f, a1 = 0.f, b0 = 0.f, b1 = 0.f;
#pragma unroll
        for (int s = 0; s < 4; ++s) { a0 += __uint_as_float(w[j][s] << 16); a1 += __uint_as_float(w[j][s] & 0xffff0000u); }
#pragma unroll
        for (int s = 4; s < 8; ++s) { b0 += __uint_as_float(w[j][s] << 16); b1 += __uint_as_float(w[j][s] & 0xffff0000u); }
        const float rs = rsqrtf(sq[j] * (1.f / 2048.f) + EPS);
        const float g0 = gg[j][0] * gelu_tanh_f(rs * (a0 * su0[j][0] + b0 * su0[j][1])), g1 = gg[j][1] * gelu_tanh_f(rs * (a1 * su1[j][0] + b1 * su1[j][1]));
        *(v2u*)((unsigned*)(GW + (size_t)t * 128) + 2 * lane) = (v2u){w8rep(g0 * sv0[j][0]), w8rep(g1 * sv1[j][0])};
        *(v2u*)((unsigned*)(W1 + (size_t)t * 128) + 2 * lane) = (v2u){w8rep(g0 * sv0[j][1]), w8rep(g1 * sv1[j][1])}; }
}
template <int NBT>
__device__ __forceinline__ void peer_b_slice(const bf16* xres, float* xio, const int* EI, const unsigned* W, const unsigned char* V4s, bf16* xb, float* ssq_out, int s, unsigned* ctr, int nbatch, int lane) {
    const int j16 = lane & 15, g4 = lane >> 4;
    const __amdgpu_buffer_rsrc_t trs = __builtin_amdgcn_make_buffer_rsrc((void*)(V4s + (size_t)s * (16384 * 128)), (short)0, 16384 * 128, 0x00020000);
    const unsigned choff = (unsigned)(8 * j16);
    const int doff = s * 256 + 64 * g4 + j16;
    const unsigned bm = 0xffu << (8 * (j16 & 3)); const unsigned M0 = ((j16 >> 2) == 0) ? bm : 0u, M1 = ((j16 >> 2) == 1) ? bm : 0u, M2 = ((j16 >> 2) == 2) ? bm : 0u, M3 = ((j16 >> 2) == 3) ? bm : 0u;
#define B_FETCH() ((int)__builtin_amdgcn_readfirstlane((int)((lane == 0) ? __hip_atomic_fetch_add(ctr, 1u, __ATOMIC_RELAXED, __HIP_MEMORY_SCOPE_AGENT) : 0u)))
#define B_TOKB(b_, j_) ((((b_) < nbatch) ? (b_) : (nbatch - 1)) * NBT + (j_))
#define B_ISSUE(V, EV) do { _Pragma("unroll") for (int i = 0; i < 8; ++i) { const unsigned e0_ = bperm((unsigned)(EV), 8 * i + 2 * g4), e1_ = bperm((unsigned)(EV), 8 * i + 2 * g4 + 1); \
        V[2 * i] = __builtin_amdgcn_raw_buffer_load_b64(trs, (int)((e0_ << 7) | choff), 0, 0); V[2 * i + 1] = __builtin_amdgcn_raw_buffer_load_b64(trs, (int)((e1_ << 7) | choff), 0, 0); } } while (0)
#define B_COMPUTE(V, WV) do { _Pragma("unroll") for (int i = 0; i < 8; ++i) { \
            const unsigned f0_ = bperm((WV), 8 * i + g4), f1_ = bperm((WV), 8 * i + 4 + g4);        \
            const i32x8 bq_ = (i32x8){(int)(f0_ & M0), (int)(f0_ & M1), (int)(f0_ & M2), (int)(f0_ & M3), (int)(f1_ & M0), (int)(f1_ & M1), (int)(f1_ & M2), (int)(f1_ & M3)}; \
            acc = __builtin_amdgcn_mfma_scale_f32_16x16x128_f8f6f4((i32x8){(int)V[2 * i][0], (int)V[2 * i][1], (int)V[2 * i + 1][0], (int)V[2 * i + 1][1], 0, 0, 0, 0}, bq_, acc, 4, 0, 0, 0x7f7f7f7f, 0, 0x77777777); } } while (0)
    int eL[NBT], eH[NBT], nL[NBT], nH[NBT]; unsigned wL[NBT], wH[NBT], mL[NBT], mH[NBT]; float xv[4]; v2u VA[16], VB[16];
    int b0 = B_FETCH(), b1 = B_FETCH();
    if (b0 >= nbatch) return;
#pragma unroll
    for (int j = 0; j < NBT; ++j) { const int tj = B_TOKB(b0, j); eL[j] = EI[(size_t)tj * 128 + lane]; eH[j] = EI[(size_t)tj * 128 + 64 + lane]; wL[j] = W[(size_t)tj * 128 + lane]; wH[j] = W[(size_t)tj * 128 + 64 + lane]; }
    B_ISSUE(VA, eL[0]);
    while (b0 < nbatch) {
        const int b2 = B_FETCH();
#pragma unroll
        for (int j = 0; j < NBT; ++j) { const int tj = B_TOKB(b1, j); nL[j] = EI[(size_t)tj * 128 + lane]; nH[j] = EI[(size_t)tj * 128 + 64 + lane]; mL[j] = W[(size_t)tj * 128 + lane]; mH[j] = W[(size_t)tj * 128 + 64 + lane]; }
#pragma unroll
        for (int j = 0; j < NBT; ++j) {
            const int t = b0 * NBT + j;
            float* xp = xio + (size_t)t * 2048 + doff; const bf16* rp = xres + (size_t)t * 2048 + doff;
#pragma unroll
            for (int r = 0; r < 4; ++r) xv[r] = __uint_as_float((unsigned)rp[16 * r] << 16);
            B_ISSUE(VB, eH[j]);
            f32x4 acc = (f32x4){0.f, 0.f, 0.f, 0.f};
            B_COMPUTE(VA, wL[j]);
            B_ISSUE(VA, (j + 1 < NBT) ? eL[(j + 1) % NBT] : nL[0]);
            B_COMPUTE(VB, wH[j]);
            float ss = 0.f;
#pragma unroll
            for (int r = 0; r < 4; ++r) { const float o = xv[r] + acc[r]; ss += o * o; if (xb) xb[(size_t)t * 2048 + doff + 16 * r] = (bf16)f2bf(o); else xp[16 * r] = o; }
            ss += DPPF(ss, 0xB1); ss += DPPF(ss, 0x4E); ss += DPPF(ss, 0x141); ss += DPPF(ss, 0x140);
            { const auto r = __builtin_amdgcn_permlane16_swap(__float_as_uint(ss), __float_as_uint(ss), false, false); ss = __uint_as_float(r[0]) + __uint_as_float(r[1]); }
            { const auto r = __builtin_amdgcn_permlane32_swap(__float_as_uint(ss), __float_as_uint(ss), false, false); ss = __uint_as_float(r[0]) + __uint_as_float(r[1]); }
            if (lane == 0) unsafeAtomicAdd(ssq_out + t, ss);
        }
#pragma unroll
        for (int j = 0; j < NBT; ++j) { eL[j] = nL[j]; eH[j] = nH[j]; wL[j] = mL[j]; wH[j] = mH[j]; }
        b0 = b1; b1 = b2;
    }
#undef B_FETCH
#undef B_TOKB
#undef B_ISSUE
#undef B_COMPUTE
}
__device__ __forceinline__ void final_norm_row(float* xio, const float* ssq, const float* fin, int t, int lane, float oscale) {
    const float r2 = rsqrtf(ssq[t] * (1.f / 2048.f) + EPS) * oscale;
    float* xr = xio + (size_t)t * 2048 + 4 * lane;
#pragma unroll
    for (int j = 0; j < 8; ++j) { const f32x4 xv = *(const f32x4*)(xr + 256 * j), g = *(const f32x4*)(fin + 256 * j + 4 * lane); f32x4 o;
        o[0] = xv[0] * r2 * g[0]; o[1] = xv[1] * r2 * g[1]; o[2] = xv[2] * r2 * g[2]; o[3] = xv[3] * r2 * g[3]; *(f32x4*)(xr + 256 * j) = o; }
}
typedef short s16x4 __attribute__((ext_vector_type(4)));
__device__ __forceinline__ unsigned cvt_pk_bf16_(float lo, float hi) { unsigned r; asm volatile("v_cvt_pk_bf16_f32 %0, %1, %2" : "=v"(r) : "v"(lo), "v"(hi)); return r; }
constexpr int ATT_RING = 384, ATT_K_OFF = 0, ATT_V_OFF = ATT_RING * 128, ATT_VSTRIDE = ATT_RING * 2 + 8, ATT_LDS = ATT_V_OFF + 64 * ATT_VSTRIDE;
__device__ __forceinline__ void attn_blk_load(const bf16* K, const bf16* Vt, int b, int kvh, int n0, int tid, v4u& kr, v4u& vr) {
    const size_t tb = (size_t)b * 4096; const int r = tid >> 3, p = tid & 7;
    kr = *(const v4u*)(K + (tb + n0 + r) * 512 + kvh * 64 + p * 8);
    vr = *(const v4u*)(Vt + (size_t)(kvh * 64 + r) * 16384 + tb + n0 + p * 8);
}
__device__ __forceinline__ void attn_blk_store(LAS unsigned char* lds, int n0, int tid, const v4u& kr, const v4u& vr) {
    const int rb = (n0 + ATT_RING) % ATT_RING, r = tid >> 3, p = tid & 7, row = rb + r;
    *(LAS v4u*)(lds + ATT_K_OFF + row * 128 + ((p ^ ((row >> 1) & 7)) << 4)) = kr;
    LAS unsigned char* vp = lds + ATT_V_OFF + r * ATT_VSTRIDE + (rb + p * 8) * 2;
    *(LAS v2u*)vp = (v2u){vr.x, vr.y}; *(LAS v2u*)(vp + 8) = (v2u){vr.z, vr.w};
}
__device__ __forceinline__ void attn_task(LAS const unsigned char* lds, const bf16* Q, bf16* O, const float* sinks, int b, int hq, int q0, int lane) {
    const int c = lane & 31, hi = lane >> 5;
    const size_t tb = (size_t)b * 4096;
    s16x8 qf[4];
    { const bf16* qp = Q + (tb + q0 + c) * 2048 + hq * 64 + hi * 8;
#pragma unroll
      for (int ks = 0; ks < 4; ++ks) qf[ks] = *(const s16x8*)(qp + ks * 16); }
    const float sink2 = sinks[hq] * 1.4426950408889634f;
    float m = sink2, l = (hi == 0) ? 1.f : 0.f;
    f32x16 o0, o1;
#pragma unroll
    for (int r = 0; r < 16; ++r) { o0[r] = 0.f; o1[r] = 0.f; }
    const int kt_lo = (q0 < 128) ? ((128 - q0) >> 5) : 0, kt_hi = ((4192 - q0) >> 5) < 8 ? ((4192 - q0) >> 5) : 8;
    for (int kt = kt_lo; kt <= kt_hi; ++kt) {
        const int key0 = q0 - 128 + 32 * kt, row0 = (key0 + ATT_RING) % ATT_RING;
        s16x8 kf[4]; s16x4 va[2][2][2];
        { const int row = row0 + c; LAS const unsigned char* kp = lds + ATT_K_OFF + row * 128; const int sw = (row >> 1) & 7;
#pragma unroll
          for (int ks = 0; ks < 4; ++ks) kf[ks] = *(LAS const s16x8*)(kp + (((2 * ks + hi) ^ sw) << 4)); }
#pragma unroll
        for (int db = 0; db < 2; ++db)
#pragma unroll
            for (int s = 0; s < 2; ++s) { LAS const unsigned char* vp = lds + ATT_V_OFF + (db * 32 + c) * ATT_VSTRIDE + (row0 + 16 * s + 4 * hi) * 2; va[db][s][0] = *(LAS const s16x4*)vp; va[db][s][1] = *(LAS const s16x4*)(vp + 16); }
        f32x16 sa;
#pragma unroll
        for (int r = 0; r < 16; ++r) sa[r] = 0.f;
#pragma unroll
        for (int ks = 0; ks < 4; ++ks) sa = __builtin_amdgcn_mfma_f32_32x32x16_bf16(kf[ks], qf[ks], sa, 0, 0, 0);
        if (kt == 0 || kt == 8) {
            const int dbase = key0 - (q0 + c) + 4 * hi;
#pragma unroll
            for (int r = 0; r < 16; ++r) { const int d = dbase + (r & 3) + 8 * (r >> 2); if (d < -128 || d > 128) sa[r] = -1e30f; }
        }
        float mx = sa[0];
#pragma unroll
        for (int r = 1; r < 16; ++r) mx = fmaxf(mx, sa[r]);
        { const auto rr = __builtin_amdgcn_permlane32_swap(__float_as_uint(mx), __float_as_uint(mx), false, false); mx = fmaxf(__uint_as_float(rr[0]), __uint_as_float(rr[1])); }
        if (__builtin_amdgcn_ballot_w64(mx > m + 8.f) != 0ull) {
            const float mn = fmaxf(m, mx), alpha = __builtin_amdgcn_exp2f(m - mn);
            m = mn; l *= alpha;
#pragma unroll
            for (int r = 0; r < 16; ++r) { o0[r] *= alpha; o1[r] *= alpha; }
        }
        float ps = 0.f;
#pragma unroll
        for (int r = 0; r < 16; ++r) { sa[r] = __builtin_amdgcn_exp2f(sa[r] - m); ps += sa[r]; }
        l += ps;
        s16x8 pf[2];
#pragma unroll
        for (int s = 0; s < 2; ++s) { v4u w; w.x = cvt_pk_bf16_(sa[8 * s + 0], sa[8 * s + 1]); w.y = cvt_pk_bf16_(sa[8 * s + 2], sa[8 * s + 3]); w.z = cvt_pk_bf16_(sa[8 * s + 4], sa[8 * s + 5]); w.w = cvt_pk_bf16_(sa[8 * s + 6], sa[8 * s + 7]);
            pf[s] = __builtin_bit_cast(s16x8, w); }
#pragma unroll
        for (int s = 0; s < 2; ++s) {
            const s16x8 v0 = __builtin_shufflevector(va[0][s][0], va[0][s][1], 0, 1, 2, 3, 4, 5, 6, 7), v1 = __builtin_shufflevector(va[1][s][0], va[1][s][1], 0, 1, 2, 3, 4, 5, 6, 7);
            o0 = __builtin_amdgcn_mfma_f32_32x32x16_bf16(v0, pf[s], o0, 0, 0, 0);
            o1 = __builtin_amdgcn_mfma_f32_32x32x16_bf16(v1, pf[s], o1, 0, 0, 0);
        }
    }
    { const auto rr = __builtin_amdgcn_permlane32_swap(__float_as_uint(l), __float_as_uint(l), false, false); l = __uint_as_float(rr[0]) + __uint_as_float(rr[1]); }
    const float il = 1.f / l;
    bf16* op = O + (tb + q0 + c) * 2048 + hq * 64 + 4 * hi;
#pragma unroll
    for (int g = 0; g < 4; ++g) {
        v2u w0, w1;
        w0.x = cvt_pk_bf16_(o0[4 * g + 0] * il, o0[4 * g + 1] * il); w0.y = cvt_pk_bf16_(o0[4 * g + 2] * il, o0[4 * g + 3] * il);
        w1.x = cvt_pk_bf16_(o1[4 * g + 0] * il, o1[4 * g + 1] * il); w1.y = cvt_pk_bf16_(o1[4 * g + 2] * il, o1[4 * g + 3] * il);
        *(v2u*)(op + 8 * g) = w0; *(v2u*)(op + 32 + 8 * g) = w1;
    }
}
typedef float fx2 __attribute__((ext_vector_type(2)));
__device__ __forceinline__ fx2 bf2_(unsigned w) { fx2 r; r[0] = __uint_as_float(w << 16); r[1] = __uint_as_float(w & 0xffff0000u); return r; }
__device__ __forceinline__ void fft16_item(bf16* Zp, const float* tw, int bg, int l, int s1h, int lane) {
    const int s1 = s1h * 128 + 2 * lane;
    bf16* base = Zp + ((size_t)(bg * 16) * 256 + l) * 512 + s1;
    fx2 zr[16], zi[16];
#pragma unroll
    for (int s2 = 0; s2 < 16; ++s2) { zr[s2] = bf2_(*(const unsigned*)(base + (size_t)s2 * 256 * 512)); zi[s2] = bf2_(*(const unsigned*)(base + (size_t)s2 * 256 * 512 + 256)); }
    fx2 er[16], ei[16];
#pragma unroll
    for (int d = 0; d < 4; ++d) {
        const fx2 ar = zr[d], ai_ = zi[d], br = zr[4 + d], bi = zi[4 + d], cr = zr[8 + d], ci = zi[8 + d], dr = zr[12 + d], di = zi[12 + d];
        const fx2 s0r = ar + cr, s0i = ai_ + ci, s1r = ar - cr, s1i = ai_ - ci, s2r = br + dr, s2i = bi + di, s3r = br - dr, s3i = bi - di;
        er[0 * 4 + d] = s0r + s2r; ei[0 * 4 + d] = s0i + s2i;
        er[1 * 4 + d] = s1r + s3i; ei[1 * 4 + d] = s1i - s3r;
        er[2 * 4 + d] = s0r - s2r; ei[2 * 4 + d] = s0i - s2i;
        er[3 * 4 + d] = s1r - s3i; ei[3 * 4 + d] = s1i + s3r;
    }
#pragma unroll
    for (int a = 1; a < 4; ++a)
#pragma unroll
        for (int d = 1; d < 4; ++d) {
            const float ang = 6.283185307179586f * (float)(a * d) / 16.f; const float c = __builtin_cosf(ang), sn = __builtin_sinf(ang);
            const fx2 xr = er[a * 4 + d], xi = ei[a * 4 + d];
            er[a * 4 + d] = xr * c + xi * sn; ei[a * 4 + d] = xi * c - xr * sn;
        }
#pragma unroll
    for (int a = 0; a < 4; ++a) {
        const fx2 ar = er[a * 4 + 0], ai_ = ei[a * 4 + 0], br = er[a * 4 + 1], bi = ei[a * 4 + 1], cr = er[a * 4 + 2], ci = ei[a * 4 + 2], dr = er[a * 4 + 3], di = ei[a * 4 + 3];
        const fx2 s0r = ar + cr, s0i = ai_ + ci, s1r = ar - cr, s1i = ai_ - ci, s2r = br + dr, s2i = bi + di, s3r = br - dr, s3i = bi - di;
        fx2 Dr[4], Di[4];
        Dr[0] = s0r + s2r; Di[0] = s0i + s2i; Dr[1] = s1r + s3i; Di[1] = s1i - s3r; Dr[2] = s0r - s2r; Di[2] = s0i - s2i; Dr[3] = s1r - s3i; Di[3] = s1i + s3r;
#pragma unroll
        for (int b = 0; b < 4; ++b) {
            const int k2 = a + 4 * b;
            const f32x4 t0 = *(const f32x4*)(tw + (size_t)(k2 * 256 + s1) * 2);
            const fx2 cc = (fx2){t0[0], t0[2]}, ss = (fx2){t0[1], t0[3]};
            const fx2 hr = Dr[b] * cc + Di[b] * ss, hi_ = Di[b] * cc - Dr[b] * ss;
            *(unsigned*)(base + (size_t)k2 * 256 * 512) = pk2(hr[0], hr[1]); *(unsigned*)(base + (size_t)k2 * 256 * 512 + 256) = pk2(hi_[0], hi_[1]);
        }
    }
}
__device__ __forceinline__ int static_unit(int nM, int nN, int G, int c, int i) {
    const int nwg = nM * nN; const long L = (long)i * G + c; if (L >= nwg) return -1;
    int wgid = (int)L; { const int q = nwg / 8, r = nwg % 8, xcd = wgid % 8, off = wgid / 8; wgid = (xcd < r ? xcd * (q + 1) : r * (q + 1) + (xcd - r) * q) + off; }
    const int nig = 8 * nN, gid = wgid / nig, fm = gid * 8, gsz = (nM - fm) < 8 ? (nM - fm) : 8;
    return ((fm + ((wgid % nig) % gsz)) << 16) | ((wgid % nig) / gsz);
}
#ifndef REP_PRO
#define REP_PRO 1
#endif
#ifndef REP_GEMM
#define REP_GEMM 1
#endif
#ifndef REP_ATT
#define REP_ATT 1
#endif
#ifndef REP_LITE
#define REP_LITE 0
#endif
#ifndef REP_Q
#define REP_Q 1
#endif
#ifndef REP_PA
#define REP_PA 1
#endif
#ifndef REP_TK
#define REP_TK 1
#endif
#ifdef PA_EXP
#define EXTRA_PA(L) if (L == 0) { peer_a_slice<8>((const unsigned char*)(ws + WS_X8), (const int*)(ws + WS_EI), (const unsigned char*)(ws + WS_U0), (unsigned*)(ws + 704 * MiB), xv, (unsigned*)(ws + WS_BCTR) + 4096 + xv * 64, T / 8, lane); }
#else
#define EXTRA_PA(L)
#endif
enum { PH_PRO = 0, PH_G1 = 1, PH_S1 = 2, PH_G2 = 3, PH_G3 = 4, PH_Q0 = 5, PH_TK0 = 6, PH_PA0 = 7, PH_PW0 = 8, PH_PB0 = 9, PH_QKV = 10, PH_ATT = 11, PH_WO = 12, PH_Q1 = 13, PH_TK1 = 14, PH_PA1 = 15, PH_PW1 = 16, PH_PB1 = 17, PH_FIN = 18, PH_END = 19 };
__global__ void __launch_bounds__(NWAVES * 64, 2) mega(Args a) {
    extern __shared__ __attribute__((aligned(16))) unsigned char lds_raw[];
    LAS unsigned char* lds = (LAS unsigned char*)lds_raw;
    cg::grid_group grid = cg::this_grid();
    const int wave = __builtin_amdgcn_readfirstlane(threadIdx.x >> 6);
#define FRESH_IDS() int lane; asm volatile("v_mbcnt_lo_u32_b32 %0, -1, 0\n\tv_mbcnt_hi_u32_b32 %0, -1, %0" : "=v"(lane)); const int tid = wave * 64 + lane; (void)tid
    const int G = gridDim.x, bx = blockIdx.x;
    unsigned char* ws = a.ws;
    const int lo = a.ph_lo, hi = a.ph_hi;
    volatile LAS unsigned* MISC = (volatile LAS unsigned*)(lds + LDSCTL_OFF);
    if (threadIdx.x < 16) MISC[threadIdx.x] = 0u;
    __syncthreads();
    XcdBarrier xbar = xcd_barrier_post((unsigned*)(ws + WS_CTL) + CW_BAR, MISC + 8);
#define IN(k) (lo <= (k) && (k) < hi)
#ifdef DIAG_A
#define STAMP(i) do { if (bx == 0 && threadIdx.x == 0) ((unsigned long long*)(ws + WS_STAMP))[i] = __builtin_amdgcn_s_memrealtime(); } while (0)
#else
#define STAMP(i) do { } while (0)
#endif
#define SEAM(k) do { if (IN(k) && IN((k) + 1)) { if ((k) == PH_PRO) grid.sync(); else xcd_barrier(xbar); } STAMP((k) + 1); } while (0)
    STAMP(0);
    for (int rep_ = 0; rep_ < REP_PRO; ++rep_)
    if (IN(PH_PRO)) { FRESH_IDS();
        const int gw = bx * NWAVES + wave, NGW = G * NWAVES;
        const size_t gtid = (size_t)bx * (NWAVES * 64) + tid, ngt = (size_t)G * NWAVES * 64;
        LAS float* scr = (LAS float*)(lds + wave * 16384);
        {
            constexpr int I_SQ = (DM / 64) * (DM / 32), I_QKV = (DM / 64) * (QKVW / 32);
            constexpr int NITEMS = 4 * I_SQ + I_QKV;
            for (int it = gw; it < NITEMS; it += NGW) {
                int r = it;
                if (r < I_SQ) { transpose_item<0>(a.in[3], DM, DM, nullptr, (bf16*)(ws + WS_WOF), scr, r, lane); continue; } r -= I_SQ;
                if (r < I_SQ) { transpose_item<0>(a.in[5], DM, DM, nullptr, (bf16*)(ws + WS_WOA), scr, r, lane); continue; } r -= I_SQ;
                if (r < I_SQ) { transpose_item<0>(a.in[7], DM, DM, a.in[2], (bf16*)(ws + WS_WQ0), scr, r, lane); continue; } r -= I_SQ;
                if (r < I_SQ) { transpose_item<0>(a.in[7] + (size_t)DM * DM, DM, DM, a.in[2] + DM, (bf16*)(ws + WS_WQ1), scr, r, lane); continue; } r -= I_SQ;
                transpose_item<1>(a.in[4], DM, QKVW, a.in[1] + DM, (bf16*)(ws + WS_WQKV), scr, r, lane);
            }
        }
        {
            f32x4 v[8], nv[8];
            { const f32x4* xr = (const f32x4*)(a.in[0] + (size_t)(gw < T ? gw : 0) * DM) + lane;
#pragma unroll
              for (int j = 0; j < 8; ++j) v[j] = xr[64 * j]; }
            for (int row = gw; row < T; row += NGW) {
                { const int nr = (row + NGW < T) ? row + NGW : row; const f32x4* xr = (const f32x4*)(a.in[0] + (size_t)nr * DM) + lane;
#pragma unroll
                  for (int j = 0; j < 8; ++j) nv[j] = xr[64 * j]; }
                const f32x4* gr = (const f32x4*)a.in[1] + lane;
                float s = 0.f;
#pragma unroll
                for (int j = 0; j < 8; ++j) s += (v[j][0] * v[j][0] + v[j][1] * v[j][1]) + (v[j][2] * v[j][2] + v[j][3] * v[j][3]);
                const float r = rsqrtf(wsum(s) * (1.f / DM) + EPS);
                const int b = row >> 12, sp = row & 4095;
#pragma unroll
                for (int j = 0; j < 8; ++j) { const f32x4 gg = gr[64 * j]; v2u o; o.x = pk2(v[j][0] * r * gg[0], v[j][1] * r * gg[1]); o.y = pk2(v[j][2] * r * gg[2], v[j][3] * r * gg[3]);
                    *(v2u*)((bf16*)(ws + WS_XG) + ((size_t)((b * 8 + j) * 4096 + sp) * 256 + 4 * lane)) = o; }
#pragma unroll
                for (int j = 0; j < 8; ++j) v[j] = nv[j];
            }
        }
        for (size_t i = gtid; i < (size_t)256 * 512 / 8; i += ngt) {
            const int k1 = (int)(i >> 6), c0 = (int)(i & 63) * 8, part = c0 >> 8, s0 = c0 & 255;
            float v[8];
#pragma unroll
            for (int e = 0; e < 8; ++e) { const int m = (k1 * (s0 + e)) & 255; const float rev = (float)m * (1.f / 256.f); v[e] = (part ? __builtin_amdgcn_sinf(rev) : __builtin_amdgcn_cosf(rev)) * (1.f / 64.f); }
            v4u o; o.x = pk2(v[0], v[1]); o.y = pk2(v[2], v[3]); o.z = pk2(v[4], v[5]); o.w = pk2(v[6], v[7]);
            *(v4u*)((bf16*)(ws + WS_A2) + i * 8) = o;
        }
        for (size_t i = gtid; i < (size_t)16 * 256; i += ngt) {
            const int k2 = (int)(i >> 8), s1 = (int)(i & 255); const float rev = (float)(k2 * s1) * (1.f / 4096.f);
            ((float*)(ws + WS_TW))[2 * i] = __builtin_amdgcn_cosf(rev); ((float*)(ws + WS_TW))[2 * i + 1] = __builtin_amdgcn_sinf(rev);
        }
        for (size_t i = gtid; i < (size_t)512 * 256 / 8; i += ngt) {
            const int n = (int)(i >> 5), c0 = (int)(i & 31) * 8, part = n >> 8, l = n & 255;
            float v[8];
#pragma unroll
            for (int e = 0; e < 8; ++e) { const int m = (l * (c0 + e)) & 255; const float rev = (float)m * (1.f / 256.f); v[e] = (part ? -__builtin_amdgcn_sinf(rev) : __builtin_amdgcn_cosf(rev)) * (1.f / 16.f); }
            v4u o; o.x = pk2(v[0], v[1]); o.y = pk2(v[2], v[3]); o.z = pk2(v[4], v[5]); o.w = pk2(v[6], v[7]);
            *(v4u*)((bf16*)(ws + WS_WCS) + i * 8) = o;
        }
        for (size_t i = gtid; i < (size_t)4096 * 32; i += ngt) {
            const int pos = (int)(i >> 5), fi = (int)(i & 31);
            const double inv = exp2(-(double)fi * (13.287712379549449 / 32.0));
            double sn, cs; sincos((double)pos * inv, &sn, &cs);
            ((float*)(ws + WS_ROPE))[2 * i] = (float)cs; ((float*)(ws + WS_ROPE))[2 * i + 1] = (float)sn;
        }
#pragma unroll 1
        for (int L = 0; L < 2; ++L) {
            CvtCtx cx; cx.srcU = a.in[9] + (size_t)L * NEXP * DM; cx.dsrc = (long)((a.in[10] + (size_t)L * NEXP * DM) - cx.srcU); cx.gain = a.in[2] + L * DM; cx.dstU = ws + (L ? WS_U1 : WS_U0); cx.ddst = (long)WS_V0 - (long)WS_U0;
            cx.su = (float*)(ws + WS_SU) + L * 32768; cx.dsc = ((long)WS_SV - (long)WS_SU) / 4; cx.gwave = gw; cx.nw = NGW;
            f32x4 c0[4], c1[4], n0[4], n1[4];
            cvt_chunk_load(cx, gw, lane, c0); cvt_chunk_load(cx, (gw + NGW < 65536) ? gw + NGW : gw, lane, c1);
            for (int cc = gw; cc < 65536; cc += 2 * NGW) { const int ca = cc + 2 * NGW, cb = cc + 3 * NGW;
                cvt_chunk_load(cx, ca < 65536 ? ca : cc, lane, n0); cvt_chunk_load(cx, cb < 65536 ? cb : cc, lane, n1);
                cvt_chunk_store(cx, cc, lane, c0); if (cc + NGW < 65536) cvt_chunk_store(cx, cc + NGW, lane, c1);
#pragma unroll
                for (int q = 0; q < 4; ++q) { c0[q] = n0[q]; c1[q] = n1[q]; } }
        }
        cvt_stream(a.in[8], (bf16*)(ws + WS_KEYS), (size_t)2 * PH * 2 * 128 * 128 / 8, gtid, ngt);
    }
    SEAM(PH_PRO);
    for (int rep_ = 0; rep_ < REP_GEMM; ++rep_)
    if (IN(PH_G1)) { FRESH_IDS();
        int Kq = FW; asm volatile("" : "+s"(Kq));
        pg8::Gemm g{(const pg8::bf16_t*)(ws + WS_WCS), (const pg8::bf16_t*)(ws + WS_XG), 512, T * FG, Kq}; pg8::StaticOrder S; S.init(512, T * FG, G, bx);
        pg8::EpiZt E{(pg8::bf16_t*)(ws + WS_ZT)};
        pg8::gemm_phase<pg8::EpiZt, pg8::StaticOrder, true, true>(lds, g, S, E);
    }
    SEAM(PH_G1);
    if (IN(PH_S1)) { FRESH_IDS();
        const int gw = bx * NWAVES + wave, NGW = G * NWAVES;
        for (int it = gw; it < 32 * 256 * 2; it += NGW) fft16_item((bf16*)(ws + WS_ZT), (const float*)(ws + WS_TW), it >> 9, (it >> 1) & 255, it & 1, lane);
    }
    SEAM(PH_S1);
    for (int rep_ = 0; rep_ < REP_GEMM; ++rep_)
    if (IN(PH_G2)) { FRESH_IDS();
        pg8::Gemm g{(const pg8::bf16_t*)(ws + WS_A2), (const pg8::bf16_t*)(ws + WS_ZT), 256, 131072, 512}; pg8::StaticOrder S; S.init(256, 131072, G, bx);
        pg8::EpiY E{(pg8::bf16_t*)(ws + WS_Y)};
        pg8::gemm_phase<pg8::EpiY, pg8::StaticOrder, true, true>(lds, g, S, E);
    }
    SEAM(PH_G2);
    if (IN(PH_G3)) { FRESH_IDS();
        pg8::Gemm g{(const pg8::bf16_t*)(ws + WS_Y), (const pg8::bf16_t*)(ws + WS_WOF), T, DM, DM}; pg8::StaticOrder S; S.init(T, DM, G, bx);
        pg8::EpiRes E{a.in[0], a.out, (pg8::bf16_t*)(ws + WS_XB), (float*)(ws + WS_SSQ_A), ws + WS_X8};
        pg8::gemm_phase<pg8::EpiRes, pg8::StaticOrder, true, true>(lds, g, S, E);
    }
    SEAM(PH_G3);
#define PEER_LAYER(L) do { \
        const int pq = L ? PH_Q1 : PH_Q0, ptk = L ? PH_TK1 : PH_TK0, ppa = L ? PH_PA1 : PH_PA0, ppw = L ? PH_PW1 : PH_PW0, ppb = L ? PH_PB1 : PH_PB0; \
        for (int rep_ = 0; rep_ < REP_Q; ++rep_) \
        if (IN(pq)) { FRESH_IDS(); \
            pg8::Gemm g{(const pg8::bf16_t*)(ws + WS_XB), (const pg8::bf16_t*)(ws + (L ? WS_WQ1 : WS_WQ0)), T, DM, DM}; pg8::StaticOrder S; S.init(T, DM, G, bx); \
            pg8::EpiScale E{(pg8::bf16_t*)(ws + WS_Q), (const float*)(ws + (L ? WS_SSQ_C : WS_SSQ_A))}; \
            pg8::gemm_phase<pg8::EpiScale, pg8::StaticOrder, true, true>(lds, g, S, E); \
        } \
        if (IN(pq) && IN(ptk)) { asm volatile("s_waitcnt vmcnt(0)" ::: "memory"); __syncthreads(); } STAMP(pq + 1); \
        if (IN(ptk)) { FRESH_IDS(); \
            const bf16* keys = (const bf16*)(ws + WS_KEYS) + (size_t)L * PH * 2 * 128 * 128; \
            int slot = 0; \
            for (int rep_ = 0; rep_ < REP_TK; ++rep_) { slot = 0; \
            for (int ui = 0; ; ++ui) {        \
                const int upk = static_unit(T / 256, DM / 256, G, bx, ui); if (upk < 0) break; \
                const int h = upk & 0xffff, tblk = upk >> 16; \
                __syncthreads(); \
                topk_fill(lds, keys, h, tid); \
                __syncthreads(); \
                topk_unit((const bf16*)(ws + WS_Q), lds, (int*)(ws + WS_EI), (float*)(ws + WS_GW), tblk * 256 + wave * 32, h, lane); \
                slot += 16; \
            } } \
        } \
        SEAM(ptk); \
        if (IN(ppa)) { FRESH_IDS(); \
            const int xv = bx & 7; \
            peer_a_slice<8>((const unsigned char*)(ws + WS_X8), (const int*)(ws + WS_EI), (const unsigned char*)(ws + (L ? WS_U1 : WS_U0)), (unsigned*)(ws + WS_PD), xv, (unsigned*)(ws + WS_BCTR) + (L * 2 + 0) * 512 + xv * 64, T / 8, lane); \
            EXTRA_PA(L) \
        } \
        SEAM(ppa); \
        if (IN(ppw)) { FRESH_IDS(); \
            const int gw = bx * NWAVES + wave, NGW = G * NWAVES; \
            int t = gw; \
            for (; t + 7 * NGW < T; t += 8 * NGW) peer_a2_tokens<8>((const unsigned*)(ws + WS_PD), (const float*)(ws + (L ? WS_SSQ_C : WS_SSQ_A)), (const int*)(ws + WS_EI), (const float*)(ws + WS_SU) + L * 32768, (const float*)(ws + WS_SV) + L * 32768, (float*)(ws + WS_GW), (float*)(ws + WS_W1), t, NGW, lane); \
            for (; t < T; t += NGW) peer_a2_tokens<1>((const unsigned*)(ws + WS_PD), (const float*)(ws + (L ? WS_SSQ_C : WS_SSQ_A)), (const int*)(ws + WS_EI), (const float*)(ws + WS_SU) + L * 32768, (const float*)(ws + WS_SV) + L * 32768, (float*)(ws + WS_GW), (float*)(ws + WS_W1), t, NGW, lane); \
        } \
        SEAM(ppw); \
        if (IN(ppb)) { FRESH_IDS(); \
            const int xv = bx & 7; \
            peer_b_slice<4>((const bf16*)(ws + WS_XB), a.out, (const int*)(ws + WS_EI), (const unsigned*)(ws + ((xv < 4) ? WS_GW : WS_W1)), (const unsigned char*)(ws + (L ? WS_V1 : WS_V0)), L ? (bf16*)nullptr : (bf16*)(ws + WS_XB), (float*)(ws + (L ? WS_SSQ_D : WS_SSQ_B)), xv, (unsigned*)(ws + WS_BCTR) + (L * 2 + 1) * 512 + xv * 64, T / 4, lane); \
        } \
    } while (0)
    float oscale = 1.f;
    PEER_LAYER(0);
    SEAM(PH_PB0);
    for (int rep_ = 0; rep_ < REP_GEMM; ++rep_)
    if (IN(PH_QKV)) { FRESH_IDS();
        {
            pg8::Gemm g{(const pg8::bf16_t*)(ws + WS_XB), (const pg8::bf16_t*)(ws + WS_WQKV), T, 2560, DM}; pg8::StaticOrder S; S.init(T, 2560, G, bx);
            pg8::EpiQK E{(pg8::bf16_t*)(ws + WS_QB), (pg8::bf16_t*)(ws + WS_KB), (const float*)(ws + WS_SSQ_B), (const float*)(ws + WS_ROPE), 0.125f * 1.4426950408889634f};
            pg8::gemm_phase<pg8::EpiQK, pg8::StaticOrder, true, true>(lds, g, S, E);
        }
        if (bx >= G / 2) {
            pg8::Gemm g{(const pg8::bf16_t*)(ws + WS_WQKV) + (size_t)2560 * DM, (const pg8::bf16_t*)(ws + WS_XB), 512, T, DM}; pg8::StaticOrder S; S.init(512, T, G / 2, bx - G / 2);
            pg8::EpiVt E{(pg8::bf16_t*)(ws + WS_VT), (const float*)(ws + WS_SSQ_B)};
            pg8::gemm_phase<pg8::EpiVt, pg8::StaticOrder, true, true>(lds, g, S, E);
        }
    }
    SEAM(PH_QKV);
    for (int rep_ = 0; rep_ < REP_ATT; ++rep_)
    if (IN(PH_ATT)) { FRESH_IDS();
        for (int vb = bx; vb < 256; vb += G) {
            const int bkv = vb >> 3, chunk = vb & 7, b = bkv >> 3, kvh = bkv & 7;
            const bf16* Kp = (const bf16*)(ws + WS_KB); const bf16* Vp = (const bf16*)(ws + WS_VT); const int q0s = chunk * 512;
            __syncthreads();
            { v4u k5[5], v5[5];
#pragma unroll
              for (int j = 0; j < 5; ++j) { const int n0 = q0s - 128 + 64 * j; if (n0 >= 0 && n0 < 4096) attn_blk_load(Kp, Vp, b, kvh, n0, tid, k5[j], v5[j]); }
#pragma unroll
              for (int j = 0; j < 5; ++j) { const int n0 = q0s - 128 + 64 * j; if (n0 >= 0 && n0 < 4096) attn_blk_store(lds, n0, tid, k5[j], v5[j]); } }
            __syncthreads();
            for (int i = 0; i < 8; ++i) {
                const int qu = q0s + 64 * i, nn = qu + 192;
                const bool nv = (i + 1 < 8) && (nn < 4096);
                v4u kr, vr;
                if (nv) attn_blk_load(Kp, Vp, b, kvh, nn, tid, kr, vr);
                attn_task(lds, (const bf16*)(ws + WS_QB), (bf16*)(ws + WS_O), a.in[6], b, kvh * 4 + (wave & 3), qu + (wave >> 2) * 32, lane);
                if (nv) attn_blk_store(lds, nn, tid, kr, vr);
                __syncthreads();
            }
        }
    }
    SEAM(PH_ATT);
    if (IN(PH_WO)) { FRESH_IDS();
        pg8::Gemm g{(const pg8::bf16_t*)(ws + WS_O), (const pg8::bf16_t*)(ws + WS_WOA), T, DM, DM}; pg8::StaticOrder S; S.init(T, DM, G, bx);
        pg8::EpiResB E{(const pg8::bf16_t*)(ws + WS_XB), (pg8::bf16_t*)(ws + WS_XB), (float*)(ws + WS_SSQ_C), ws + WS_X8};
        pg8::gemm_phase<pg8::EpiResB, pg8::StaticOrder, true, true>(lds, g, S, E);
    }
    SEAM(PH_WO);
#ifdef DIAG_A
    { const unsigned long long* st = (const unsigned long long*)(ws + WS_STAMP); oscale = 1.f + sqrtf((float)(st[DIAG_B] - st[DIAG_A]) * 1e-6f); }
#endif
    PEER_LAYER(1);
#undef PEER_LAYER
    SEAM(PH_PB1);
    if (IN(PH_FIN)) { FRESH_IDS();
        const int gw = bx * NWAVES + wave, NGW = G * NWAVES;
        for (int t = gw; t < T; t += NGW) final_norm_row(a.out, (const float*)(ws + WS_SSQ_D), a.in[11], t, lane, oscale);
    }
#undef SEAM
#undef IN
}

#ifndef N_LAUNCHES
#define N_LAUNCHES 1
#endif
extern "C" void kernel_launch(void* const* d_in, const int* in_sizes, int n_in, void* d_out, int out_size, void* d_ws, size_t ws_size, hipStream_t stream) {
    static int grid = 0;
    if (!grid) {
        if (hipFuncSetAttribute((const void*)mega, hipFuncAttributeMaxDynamicSharedMemorySize, LDS_BYTES) != hipSuccess) { fprintf(stderr, "hipFuncSetAttribute failed\n"); }
        int dev = 0, cus = 0, per_cu = 0;
        (void)hipGetDevice(&dev);
        (void)hipDeviceGetAttribute(&cus, hipDeviceAttributeMultiprocessorCount, dev);
        if (hipOccupancyMaxActiveBlocksPerMultiprocessor(&per_cu, (const void*)mega, NWAVES * 64, LDS_BYTES) != hipSuccess) per_cu = 0;
        (void)hipGetLastError();
        grid = cus * per_cu;
        if (grid > 256) grid = 256;
        grid &= ~1;
        if (grid < 2) { fprintf(stderr, "occupancy query gave %d x %d\n", cus, per_cu); grid = -1; }
    }
    if (grid < 0) return;
    if (ws_size < 700 * MiB) { fprintf(stderr, "ws too small: %zu\n", ws_size); return; }
    (void)hipMemsetAsync((char*)d_ws + WS_CTL, 0, CTL_BYTES, stream);
    Args a{};
    for (int i = 0; i < 12; ++i) a.in[i] = (const float*)d_in[i];
    a.out = (float*)d_out; a.ws = (unsigned char*)d_ws;
    if (N_LAUNCHES == 1) {
        a.ph_lo = 0; a.ph_hi = PH_END;
        void* args[] = {&a};
        const hipError_t e = hipLaunchCooperativeKernel((const void*)mega, dim3(grid), dim3(NWAVES * 64), args, LDS_BYTES, stream);
        if (e != hipSuccess) fprintf(stderr, "cooperative launch failed: %s (grid %d)\n", hipGetErrorString(e), grid);
    } else {
        for (int ph = 0; ph < PH_END; ++ph) {
            a.ph_lo = ph; a.ph_hi = ph + 1;
            hipLaunchKernelGGL(mega, dim3(grid), dim3(NWAVES * 64), LDS_BYTES, stream, a);
        }
    }
}
```
